# Optimizing an MI355X kernel written in HIP

```python
import math
import jax, jax.numpy as jnp
from jax import lax
import numpy as np

D_MODEL = 1024
BATCH = 2
SEQ = 8192
DEPTH = 2

N_MIXERS = 2
HEAD_DIM = 64
N_MIX_HEADS = 12
N_MEM_HEADS = 4
MEM_LEN = 256
D_MIX = N_MIX_HEADS * HEAD_DIM
D_MEM = N_MEM_HEADS * HEAD_DIM
D_CAT = D_MIX + D_MEM
D_FF = -(-8 * D_MODEL // (3 * 256)) * 256
N_REL_BUCKETS = 32
REL_MAX_EXACT = 16
REL_MAX_DIST = 2048
Q_BLOCK = 128
NSA_KV_HEADS = 2
NSA_GROUP = N_MIX_HEADS // NSA_KV_HEADS
CMP_LEN = 32
CMP_STRIDE = 16
CMP_HIDDEN = 256
SEL_BLOCK = 64
N_SEL = 16
WINDOW = 512
N_BRANCH = 3
FORCE_BONUS = 1e4
NSA_IN = D_MIX + 6 * NSA_KV_HEADS * HEAD_DIM + N_MIX_HEADS * N_BRANCH + D_MEM
Q_LORA = 256
KV_LORA = 128
IDX_HEADS = 8
IDX_DIM = 64
DSA_TOPK = 256
DSA_IN = Q_LORA + KV_LORA + IDX_DIM + IDX_HEADS + D_MEM
N_NSA_LAYERS = (DEPTH + 1) // 2
N_DSA_LAYERS = DEPTH // 2
NEG = -1e30
EPS = 1e-6

kernel_name = 'hybrid_nsa_dsa_memory_trunk'


def rmsnorm(x, g):
    xf = x.astype(jnp.float32)
    y = xf * lax.rsqrt(jnp.mean(xf * xf, axis=-1, keepdims=True) + EPS)
    return (y * g.astype(jnp.float32)).astype(x.dtype)


def rel_bucket(dist):
    n = jnp.maximum(dist, 0)
    nf = jnp.maximum(n, REL_MAX_EXACT).astype(jnp.float32)
    large = REL_MAX_EXACT + (jnp.log(nf / REL_MAX_EXACT) / math.log(REL_MAX_DIST / REL_MAX_EXACT)
                             * (N_REL_BUCKETS - REL_MAX_EXACT)).astype(jnp.int32)
    large = jnp.minimum(large, N_REL_BUCKETS - 1)
    return jnp.where(n < REL_MAX_EXACT, n, large)


def masked_softmax(s, mask):
    s = jnp.where(mask, s, NEG)
    p = jax.nn.softmax(s, axis=-1)
    return jnp.where(mask, p, 0.0)


def split_cols(a, sizes):
    return jnp.split(a, [int(v) for v in np.cumsum(sizes)[:-1]], axis=-1)


def compress(raw, pos, w1, b1, w2, b2):
    B, T = raw.shape[0], raw.shape[1]
    n_cmp = (T - CMP_LEN) // CMP_STRIDE + 1
    idx = jnp.arange(n_cmp)[:, None] * CMP_STRIDE + jnp.arange(CMP_LEN)[None, :]
    blk = raw[:, idx] + pos[None, None, :, None, :]
    blk = jnp.transpose(blk, (0, 1, 3, 2, 4)).reshape(B, n_cmp, NSA_KV_HEADS, CMP_LEN * HEAD_DIM)
    h = jax.nn.gelu(blk @ w1 + b1)
    return h @ w2 + b2


def nsa_mixer(xn, w_in, gate_b, pos_k, pos_v, k_w1, k_b1, k_w2, k_b2, v_w1, v_b1, v_w2, v_b2, rel_bias):
    B, T, _ = xn.shape
    G, R, dh, H = NSA_KV_HEADS, NSA_GROUP, HEAD_DIM, N_MIX_HEADS
    kvw = G * dh
    q, kc_raw, vc_raw, ks, vs, kw, vw, gl, q_mem = split_cols(
        xn @ w_in, [D_MIX, kvw, kvw, kvw, kvw, kvw, kvw, H * N_BRANCH, D_MEM])
    q = q.reshape(B, T, G, R, dh) * dh ** -0.5
    kc = compress(kc_raw.reshape(B, T, G, dh), pos_k, k_w1, k_b1, k_w2, k_b2)
    vc = compress(vc_raw.reshape(B, T, G, dh), pos_v, v_w1, v_b1, v_w2, v_b2)
    gates = jax.nn.sigmoid(gl + gate_b).reshape(B, T, G, R, N_BRANCH)
    n_sel_blk = T // SEL_BLOCK
    kb = jnp.transpose(ks.reshape(B, n_sel_blk, SEL_BLOCK, G, dh), (0, 3, 1, 2, 4))
    vb = jnp.transpose(vs.reshape(B, n_sel_blk, SEL_BLOCK, G, dh), (0, 3, 1, 2, 4))
    pad = ((0, 0), (WINDOW, 0), (0, 0), (0, 0))
    kwp = jnp.pad(kw.reshape(B, T, G, dh), pad)
    vwp = jnp.pad(vw.reshape(B, T, G, dh), pad)

    n_cmp = kc.shape[1]
    cmp_start = jnp.arange(n_cmp) * CMP_STRIDE
    cmp_end = cmp_start + CMP_LEN - 1
    sel_start = jnp.arange(n_sel_blk) * SEL_BLOCK
    overlap = ((cmp_start[:, None] <= sel_start[None, :] + SEL_BLOCK - 1)
               & (cmp_end[:, None] >= sel_start[None, :])).astype(jnp.float32)
    n_top = min(N_SEL, n_sel_blk)
    nk = n_top * SEL_BLOCK
    bias_gr = jnp.transpose(rel_bias.reshape(N_REL_BUCKETS, G, R), (1, 0, 2))
    bi = jnp.arange(B)[:, None, None, None]
    gi = jnp.arange(G)[None, :, None, None]
    in_blk = jnp.arange(SEL_BLOCK)
    blk_ids = jnp.arange(n_sel_blk)

    def block(qb_idx):
        qs = qb_idx * Q_BLOCK
        t = qs + jnp.arange(Q_BLOCK)
        qb = lax.dynamic_slice_in_dim(q, qs, Q_BLOCK, axis=1)
        s = jnp.einsum('bqgrd,bngd->bgrqn', qb, kc).astype(jnp.float32)
        cb = rel_bias[rel_bucket(t[:, None] - cmp_end[None, :])]
        s = s + jnp.transpose(cb, (2, 0, 1)).reshape(G, R, Q_BLOCK, n_cmp)
        p_cmp = masked_softmax(s, cmp_end[None, :] <= t[:, None])
        o_cmp = jnp.einsum('bgrqn,bngd->bqgrd', p_cmp.astype(vc.dtype), vc)
        p_slc = jnp.einsum('bgqn,nj->bgqj', p_cmp.sum(axis=2), overlap)
        cur = t // SEL_BLOCK
        forced = ((blk_ids[None, :] == 0) | (blk_ids[None, :] == cur[:, None])
                  | (blk_ids[None, :] == cur[:, None] - 1))
        admissible = sel_start[None, :] <= t[:, None]
        score = jnp.where(admissible, p_slc + FORCE_BONUS * forced, NEG)
        top_val, top_idx = lax.top_k(score, n_top)
        k_sel = kb[bi, gi, top_idx].reshape(B, G, Q_BLOCK, nk, dh)
        v_sel = vb[bi, gi, top_idx].reshape(B, G, Q_BLOCK, nk, dh)
        pos5 = top_idx[..., None] * SEL_BLOCK + in_blk
        mask5 = (top_val > 0.5 * NEG)[..., None] & (pos5 <= t[None, None, :, None, None])
        pos = pos5.reshape(B, G, Q_BLOCK, nk)
        smask = mask5.reshape(B, G, Q_BLOCK, nk)
        sb = bias_gr[gi, rel_bucket(t[None, None, :, None] - pos)]
        s = jnp.einsum('bqgrd,bgqkd->bgrqk', qb, k_sel).astype(jnp.float32) + jnp.moveaxis(sb, -1, 2)
        p = masked_softmax(s, smask[:, :, None])
        o_slc = jnp.einsum('bgrqk,bgqkd->bqgrd', p.astype(v_sel.dtype), v_sel)
        kwb = lax.dynamic_slice_in_dim(kwp, qs, Q_BLOCK + WINDOW, axis=1)
        vwb = lax.dynamic_slice_in_dim(vwp, qs, Q_BLOCK + WINDOW, axis=1)
        spos = qs - WINDOW + jnp.arange(Q_BLOCK + WINDOW)
        d = t[:, None] - spos[None, :]
        wmask = (spos[None, :] >= 0) & (d >= 0) & (d < WINDOW)
        wb = jnp.transpose(rel_bias[rel_bucket(d)], (2, 0, 1)).reshape(G, R, Q_BLOCK, Q_BLOCK + WINDOW)
        s = jnp.einsum('bqgrd,bkgd->bgrqk', qb, kwb).astype(jnp.float32) + wb
        p = masked_softmax(s, wmask)
        o_win = jnp.einsum('bgrqk,bkgd->bqgrd', p.astype(vwb.dtype), vwb)
        gb = lax.dynamic_slice_in_dim(gates, qs, Q_BLOCK, axis=1)
        return gb[..., 0:1] * o_cmp + gb[..., 1:2] * o_slc + gb[..., 2:3] * o_win

    out = lax.map(block, jnp.arange(T // Q_BLOCK))
    out = jnp.moveaxis(out, 0, 1).reshape(B, T, D_MIX)
    return out, q_mem


def dsa_mixer(xn, w_in, q_norm, kv_norm, w_q_up, w_uk, w_uv, w_q_idx, kidx_norm, rel_bias):
    B, T, _ = xn.shape
    H, dh = N_MIX_HEADS, HEAD_DIM
    c_q, c_kv, k_idx, w_idx, q_mem = split_cols(xn @ w_in, [Q_LORA, KV_LORA, IDX_DIM, IDX_HEADS, D_MEM])
    c_q = rmsnorm(c_q, q_norm)
    c_kv = rmsnorm(c_kv, kv_norm)
    q = (c_q @ w_q_up).reshape(B, T, H, dh) * dh ** -0.5
    q_abs = jnp.einsum('bthd,rhd->bthr', q, w_uk)
    q_idx = (c_q @ w_q_idx).reshape(B, T, IDX_HEADS, IDX_DIM)
    k_idx = rmsnorm(k_idx, kidx_norm)
    w_idx = w_idx * (IDX_HEADS ** -0.5 * IDX_DIM ** -0.5)
    k_top = min(DSA_TOPK, T // 4)
    s_all = jnp.arange(T)
    bi = jnp.arange(B)[:, None, None]

    def block(qb_idx):
        qs = qb_idx * Q_BLOCK
        t = qs + jnp.arange(Q_BLOCK)
        qi = lax.dynamic_slice_in_dim(q_idx, qs, Q_BLOCK, axis=1)
        wi = lax.dynamic_slice_in_dim(w_idx, qs, Q_BLOCK, axis=1)
        qa = lax.dynamic_slice_in_dim(q_abs, qs, Q_BLOCK, axis=1)
        logits = jax.nn.relu(jnp.einsum('bqhd,bsd->bqhs', qi, k_idx).astype(jnp.float32))
        score = jnp.einsum('bqhs,bqh->bqs', logits, wi.astype(jnp.float32))
        score = jnp.where(s_all[None, :] <= t[:, None], score, NEG)
        _, idx = lax.top_k(score, k_top)
        valid = idx <= t[None, :, None]
        c_sel = c_kv[bi, idx]
        s = jnp.einsum('bqhr,bqkr->bhqk', qa, c_sel).astype(jnp.float32)
        bias = rel_bias[rel_bucket(t[None, :, None] - idx)]
        s = s + jnp.transpose(bias, (0, 3, 1, 2))
        p = masked_softmax(s, valid[:, None])
        return jnp.einsum('bhqk,bqkr->bqhr', p.astype(c_sel.dtype), c_sel)

    o_lat = lax.map(block, jnp.arange(T // Q_BLOCK))
    o_lat = jnp.moveaxis(o_lat, 0, 1).reshape(B, T, H, KV_LORA)
    out = jnp.einsum('bthr,rhd->bthd', o_lat, w_uv).reshape(B, T, D_MIX)
    return out, q_mem


def memory_attention(q_mem, mem_n, w_mem_kv):
    B, M, _ = mem_n.shape
    kv = (mem_n @ w_mem_kv).reshape(B, M, 2, N_MEM_HEADS, HEAD_DIM)
    k, v = kv[:, :, 0], kv[:, :, 1]
    s = jnp.einsum('bthd,bmhd->bhtm', q_mem, k).astype(jnp.float32)
    p = jax.nn.softmax(s, axis=-1).astype(v.dtype)
    o = jnp.einsum('bhtm,bmhd->bthd', p, v)
    return o.reshape(o.shape[0], o.shape[1], D_MEM)


def setup_inputs(seed: int = 0) -> dict:
    key = jax.random.key(seed)
    keys = iter(jax.random.split(key, 48))
    D = D_MODEL

    def nrm(shape, scale):
        return jax.random.normal(next(keys), shape, jnp.float32) * scale

    def gain(shape):
        return 1.0 + nrm(shape, 0.01)

    cin = CMP_LEN * HEAD_DIM
    return {
        'x': nrm((BATCH, SEQ, D), 1.0),
        'mem': nrm((BATCH, MEM_LEN, D), 1.0),
        'rel_bias': nrm((N_REL_BUCKETS, N_MIX_HEADS), 0.1),
        'norm_mix': gain((DEPTH, D)),
        'norm_ffn': gain((DEPTH, D)),
        'norm_mem': gain((DEPTH, D)),
        'w_mem_kv': nrm((DEPTH, D, 2 * D_MEM), D ** -0.5),
        'w_out': nrm((DEPTH, D_CAT, D), D_CAT ** -0.5),
        'ffn_gate': nrm((DEPTH, D, D_FF), D ** -0.5),
        'ffn_up': nrm((DEPTH, D, D_FF), D ** -0.5),
        'ffn_down': nrm((DEPTH, D_FF, D), D_FF ** -0.5),
        'nsa_w_in': nrm((N_NSA_LAYERS, D, NSA_IN), D ** -0.5),
        'nsa_gate_b': nrm((N_NSA_LAYERS, N_MIX_HEADS * N_BRANCH), 0.01),
        'nsa_cmp_pos_k': nrm((N_NSA_LAYERS, CMP_LEN, HEAD_DIM), 0.1),
        'nsa_cmp_pos_v': nrm((N_NSA_LAYERS, CMP_LEN, HEAD_DIM), 0.1),
        'nsa_cmp_k_w1': nrm((N_NSA_LAYERS, cin, CMP_HIDDEN), cin ** -0.5),
        'nsa_cmp_k_b1': nrm((N_NSA_LAYERS, CMP_HIDDEN), 0.01),
        'nsa_cmp_k_w2': nrm((N_NSA_LAYERS, CMP_HIDDEN, HEAD_DIM), CMP_HIDDEN ** -0.5),
        'nsa_cmp_k_b2': nrm((N_NSA_LAYERS, HEAD_DIM), 0.01),
        'nsa_cmp_v_w1': nrm((N_NSA_LAYERS, cin, CMP_HIDDEN), cin ** -0.5),
        'nsa_cmp_v_b1': nrm((N_NSA_LAYERS, CMP_HIDDEN), 0.01),
        'nsa_cmp_v_w2': nrm((N_NSA_LAYERS, CMP_HIDDEN, HEAD_DIM), CMP_HIDDEN ** -0.5),
        'nsa_cmp_v_b2': nrm((N_NSA_LAYERS, HEAD_DIM), 0.01),
        'dsa_w_in': nrm((N_DSA_LAYERS, D, DSA_IN), D ** -0.5),
        'dsa_q_norm': gain((N_DSA_LAYERS, Q_LORA)),
        'dsa_kv_norm': gain((N_DSA_LAYERS, KV_LORA)),
        'dsa_w_q_up': nrm((N_DSA_LAYERS, Q_LORA, D_MIX), Q_LORA ** -0.5),
        'dsa_w_uk': nrm((N_DSA_LAYERS, KV_LORA, N_MIX_HEADS, HEAD_DIM), KV_LORA ** -0.5),
        'dsa_w_uv': nrm((N_DSA_LAYERS, KV_LORA, N_MIX_HEADS, HEAD_DIM), KV_LORA ** -0.5),
        'dsa_w_q_idx': nrm((N_DSA_LAYERS, Q_LORA, IDX_HEADS * IDX_DIM), Q_LORA ** -0.5),
        'dsa_kidx_norm': gain((N_DSA_LAYERS, IDX_DIM)),
        'norm_final': gain((D,)),
    }


def reference(x, mem, rel_bias, norm_mix, norm_ffn, norm_mem, w_mem_kv, w_out, ffn_gate, ffn_up, ffn_down,
              nsa_w_in, nsa_gate_b, nsa_cmp_pos_k, nsa_cmp_pos_v,
              nsa_cmp_k_w1, nsa_cmp_k_b1, nsa_cmp_k_w2, nsa_cmp_k_b2,
              nsa_cmp_v_w1, nsa_cmp_v_b1, nsa_cmp_v_w2, nsa_cmp_v_b2,
              dsa_w_in, dsa_q_norm, dsa_kv_norm, dsa_w_q_up, dsa_w_uk, dsa_w_uv, dsa_w_q_idx, dsa_kidx_norm,
              norm_final):
    B, T, _ = x.shape
    h = x
    for i in range(DEPTH):
        xn = rmsnorm(h, norm_mix[i])
        j = i // N_MIXERS
        if i % N_MIXERS == 0:
            mix, q_mem = nsa_mixer(xn, nsa_w_in[j], nsa_gate_b[j], nsa_cmp_pos_k[j], nsa_cmp_pos_v[j],
                                   nsa_cmp_k_w1[j], nsa_cmp_k_b1[j], nsa_cmp_k_w2[j], nsa_cmp_k_b2[j],
                                   nsa_cmp_v_w1[j], nsa_cmp_v_b1[j], nsa_cmp_v_w2[j], nsa_cmp_v_b2[j],
                                   rel_bias)
        else:
            mix, q_mem = dsa_mixer(xn, dsa_w_in[j], dsa_q_norm[j], dsa_kv_norm[j], dsa_w_q_up[j],
                                   dsa_w_uk[j], dsa_w_uv[j], dsa_w_q_idx[j], dsa_kidx_norm[j], rel_bias)
        q_mem = q_mem.reshape(B, T, N_MEM_HEADS, HEAD_DIM) * HEAD_DIM ** -0.5
        mem_o = memory_attention(q_mem, rmsnorm(mem, norm_mem[i]), w_mem_kv[i])
        h = h + jnp.concatenate([mix, mem_o], axis=-1) @ w_out[i]
        hn = rmsnorm(h, norm_ffn[i])
        h = h + (jax.nn.silu(hn @ ffn_gate[i]) * (hn @ ffn_up[i])) @ ffn_down[i]
    return rmsnorm(h, norm_final)
```

```cpp
#include <hip/hip_runtime.h>
#include <stdint.h>
#include <math.h>

namespace {
constexpr int B_ = 2, T_ = 8192, D_ = 1024, M_ = B_ * T_;
constexpr int DFF = 2816, NSA_IN = 1828, DSA_IN = 712;
constexpr int NCMP = 511;
constexpr float NEGF = -1e30f, EPSF = 1e-6f;

__device__ __forceinline__ int rel_bucket(int n) {
    if (n < 16) return n;
    return 16 + (n >= 22) + (n >= 30) + (n >= 40) + (n >= 54) + (n >= 73) + (n >= 99) + (n >= 134) + (n >= 182) + (n >= 246) + (n >= 332) + (n >= 450) + (n >= 609) + (n >= 825) + (n >= 1117) + (n >= 1513);
}
__device__ __forceinline__ float red16_sum(float v) { v += __shfl_xor(v, 1, 16); v += __shfl_xor(v, 2, 16); v += __shfl_xor(v, 4, 16); v += __shfl_xor(v, 8, 16); return v; }
__device__ __forceinline__ float red16_max(float v) { v = fmaxf(v, __shfl_xor(v, 1, 16)); v = fmaxf(v, __shfl_xor(v, 2, 16)); v = fmaxf(v, __shfl_xor(v, 4, 16)); v = fmaxf(v, __shfl_xor(v, 8, 16)); return v; }

__global__ void __launch_bounds__(256) k_rstd(const float* __restrict__ x, int ld, int ncols, float* __restrict__ rstd, int nrows) {
    const int row = blockIdx.x * 4 + (threadIdx.x >> 6), lane = threadIdx.x & 63;
    if (row >= nrows) return;
    const float* xr = x + (size_t)row * ld;
    float s = 0.f;
    for (int c = lane; c < ncols; c += 64) { const float v = xr[c]; s += v * v; }
#pragma unroll
    for (int o = 1; o < 64; o <<= 1) s += __shfl_xor(s, o);
    if (lane == 0) rstd[row] = rsqrtf(s / (float)ncols + EPSF);
}
__global__ void __launch_bounds__(256) k_final(float* __restrict__ x, const float* __restrict__ g) {
    const int row = blockIdx.x * 4 + (threadIdx.x >> 6), lane = threadIdx.x & 63;
    float* xr = x + (size_t)row * D_;
    float v[16]; float s = 0.f;
#pragma unroll
    for (int i = 0; i < 16; ++i) { v[i] = xr[lane + 64 * i]; s += v[i] * v[i]; }
#pragma unroll
    for (int o = 1; o < 64; o <<= 1) s += __shfl_xor(s, o);
    const float r = rsqrtf(s / (float)D_ + EPSF);
#pragma unroll
    for (int i = 0; i < 16; ++i) xr[lane + 64 * i] = (v[i] * r) * g[lane + 64 * i];
}

struct ALoadPlain {
    const float* A; const float* rs; const float* gain; int lda; int pad;
    __device__ __forceinline__ float4 operator()(int m, int k) const {
        float4 v = *(const float4*)(A + (size_t)m * lda + k);
        if (rs) { const float r = rs[m]; const float4 g = *(const float4*)(gain + k); v.x = (v.x * r) * g.x; v.y = (v.y * r) * g.y; v.z = (v.z * r) * g.z; v.w = (v.w * r) * g.w; }
        return v;
    }
};
struct ALoadCmp {
    const float* proj; const float* pos; int col0; int pad;
    __device__ __forceinline__ float4 operator()(int m, int k) const {
        const int g = m & 1, bn = m >> 1, b = bn / NCMP, n = bn % NCMP, l = k >> 6, d = k & 63;
        float4 v = *(const float4*)(proj + (size_t)(b * T_ + 16 * n + l) * NSA_IN + col0 + g * 64 + d);
        const float4 p = *(const float4*)(pos + k);
        v.x += p.x; v.y += p.y; v.z += p.z; v.w += p.w; return v;
    }
};
struct EpStore { float* C; const float* bias; int ldc; float scale;
    __device__ __forceinline__ void operator()(int m, int n, float a) const { C[(size_t)m * ldc + n] = (a + (bias ? bias[n] : 0.f)) * scale; } };
struct EpGelu { float* C; const float* bias; int ldc; int pad;
    __device__ __forceinline__ void operator()(int m, int n, float a) const { const float x = a + bias[n];
        C[(size_t)m * ldc + n] = 0.5f * x * (1.f + tanhf(0.7978845608028654f * (x + 0.044715f * x * x * x))); } };
struct EpResid { float* C; const float* R; int ldc; int ldr;
    __device__ __forceinline__ void operator()(int m, int n, float a) const { C[(size_t)m * ldc + n] = R[(size_t)m * ldr + n] + a; } };
struct EpSiluMul { float* C; int ldc; int pad;
    __device__ __forceinline__ void operator()(int m, int n, float a) const { const float g = C[(size_t)m * ldc + n]; C[(size_t)m * ldc + n] = (g / (1.f + expf(-g))) * a; } };

template <class AL, class EP>
__global__ void __launch_bounds__(256) k_gemm(AL al, const float* __restrict__ W, int ldw, int Mr, int N, int K, EP ep) {
    __shared__ __attribute__((aligned(16))) float As[16][132];
    __shared__ __attribute__((aligned(16))) float Ws[16][132];
    const int tid = threadIdx.x, tx = tid & 15, ty = tid >> 4;
    const int m0 = blockIdx.y * 128, n0 = blockIdx.x * 128;
    float acc[8][8];
#pragma unroll
    for (int i = 0; i < 8; ++i)
#pragma unroll
        for (int j = 0; j < 8; ++j) acc[i][j] = 0.f;
    for (int k0 = 0; k0 < K; k0 += 16) {
#pragma unroll
        for (int i = 0; i < 2; ++i) {
            const int idx = tid + i * 256, r = idx >> 2, kq = (idx & 3) * 4, m = m0 + r;
            float4 v = make_float4(0.f, 0.f, 0.f, 0.f);
            if (m < Mr) v = al(m, k0 + kq);
            As[kq + 0][r] = v.x; As[kq + 1][r] = v.y; As[kq + 2][r] = v.z; As[kq + 3][r] = v.w;
        }
#pragma unroll
        for (int i = 0; i < 2; ++i) {
            const int idx = tid + i * 256, kk = idx >> 5, nq = (idx & 31) * 4, n = n0 + nq;
            float4 v = make_float4(0.f, 0.f, 0.f, 0.f);
            if (n < N) v = *(const float4*)(W + (size_t)(k0 + kk) * ldw + n);
            *(float4*)&Ws[kk][nq] = v;
        }
        __syncthreads();
#pragma unroll
        for (int kk = 0; kk < 16; ++kk) {
            const float4 a0 = *(const float4*)&As[kk][ty * 4], a1 = *(const float4*)&As[kk][64 + ty * 4];
            const float4 b0 = *(const float4*)&Ws[kk][tx * 4], b1 = *(const float4*)&Ws[kk][64 + tx * 4];
            const float a[8] = {a0.x, a0.y, a0.z, a0.w, a1.x, a1.y, a1.z, a1.w};
            const float b[8] = {b0.x, b0.y, b0.z, b0.w, b1.x, b1.y, b1.z, b1.w};
#pragma unroll
            for (int i = 0; i < 8; ++i)
#pragma unroll
                for (int j = 0; j < 8; ++j) acc[i][j] += a[i] * b[j];
        }
        __syncthreads();
    }
#pragma unroll
    for (int i = 0; i < 8; ++i) {
        const int m = m0 + (i < 4 ? ty * 4 + i : 64 + ty * 4 + i - 4);
#pragma unroll
        for (int j = 0; j < 8; ++j) {
            const int n = n0 + (j < 4 ? tx * 4 + j : 64 + tx * 4 + j - 4);
            if (m < Mr && n < N) ep(m, n, acc[i][j]);
        }
    }
}
template <class AL, class EP>
void gemm(hipStream_t st, AL al, const float* W, int ldw, int Mr, int N, int K, EP ep) {
    dim3 grid((N + 127) / 128, (Mr + 127) / 128);
    hipLaunchKernelGGL((k_gemm<AL, EP>), grid, dim3(256), 0, st, al, W, ldw, Mr, N, K, ep);
}

template <int DIM>
__device__ __forceinline__ void attend(const float* __restrict__ q, const float* __restrict__ krow, const float* __restrict__ vrow, float bias, float& m_, float& l_, float (&o)[DIM]) {
    float a = 0.f;
#pragma unroll
    for (int d = 0; d < DIM; d += 4) { const float4 k4 = *(const float4*)(krow + d); a += q[d] * k4.x + q[d + 1] * k4.y + q[d + 2] * k4.z + q[d + 3] * k4.w; }
    a += bias;
    const float mn = fmaxf(m_, a), al = expf(m_ - mn), p = expf(a - mn);
    l_ = l_ * al + p; m_ = mn;
#pragma unroll
    for (int d = 0; d < DIM; d += 4) { const float4 v4 = *(const float4*)(vrow + d);
        o[d] = o[d] * al + p * v4.x; o[d + 1] = o[d + 1] * al + p * v4.y; o[d + 2] = o[d + 2] * al + p * v4.z; o[d + 3] = o[d + 3] * al + p * v4.w; }
}
template <int DIM>
__device__ __forceinline__ void merge16(float m_, float l_, float (&o)[DIM]) {
    const float mg = red16_max(m_);
    const float w = expf(m_ - mg);
    const float lt = red16_sum(l_ * w);
    const float inv = lt > 0.f ? 1.f / lt : 0.f;
#pragma unroll
    for (int d = 0; d < DIM; ++d) o[d] = red16_sum(o[d] * w) * inv;
}

__global__ void __launch_bounds__(256) k_nsa_attn(const float* __restrict__ proj, const float* __restrict__ kc, const float* __restrict__ vc, const float* __restrict__ mkv,
                                                  const float* __restrict__ rel_bias, const float* __restrict__ gate_b, float* __restrict__ cat) {
    __shared__ __attribute__((aligned(16))) float qs[16][64];
    __shared__ __attribute__((aligned(16))) float P[12][512];
    __shared__ float sc[2][128];
    __shared__ int sel[2][16];
    __shared__ int selv[2][16];
    __shared__ __attribute__((aligned(16))) float outb[16][64];
    const int row = blockIdx.x, b = row / T_, t = row % T_;
    const int tid = threadIdx.x, hh = tid >> 4, l16 = tid & 15;
    const float* pr = proj + (size_t)row * NSA_IN;
    for (int i = tid; i < 1024; i += 256) { const int h = i >> 6, d = i & 63; const float v = (h < 12) ? pr[h * 64 + d] : pr[1572 + (h - 12) * 64 + d]; qs[h][d] = v * 0.125f; outb[h][d] = 0.f; }
    __syncthreads();
    const int ncv = (t >= 31) ? ((t - 31) / 16 + 1) : 0;
    const int g = (hh < 12) ? hh / 6 : 0;
    float gate[3] = {1.f, 1.f, 1.f};
    if (hh < 12) {
#pragma unroll
        for (int br = 0; br < 3; ++br) { const float z = pr[1536 + hh * 3 + br] + gate_b[hh * 3 + br]; gate[br] = 1.f / (1.f + expf(-z)); }
    }
    float mx = NEGF;
    if (hh < 12) {
        for (int n = l16; n < 512; n += 16) {
            float s = NEGF;
            if (n < ncv) { const float* kr = kc + ((size_t)(b * NCMP + n) * 2 + g) * 64; float a = 0.f;
#pragma unroll
                for (int d = 0; d < 64; ++d) a += qs[hh][d] * kr[d];
                s = a + rel_bias[rel_bucket(t - (16 * n + 31)) * 12 + hh]; }
            P[hh][n] = s; mx = fmaxf(mx, s);
        }
    }
    mx = red16_max(mx);
    __syncthreads();
    float sum = 0.f;
    if (hh < 12) {
        for (int n = l16; n < 512; n += 16) { const float p = (n < ncv) ? expf(P[hh][n] - mx) : 0.f; P[hh][n] = p; sum += p; }
    }
    sum = red16_sum(sum);
    __syncthreads();
    if (hh < 12) {
        const float inv = (ncv > 0) ? 1.f / sum : 0.f;
        for (int n = l16; n < 512; n += 16) P[hh][n] *= inv;
    }
    __syncthreads();
    if (hh < 12) {
        float oc[4] = {0.f, 0.f, 0.f, 0.f};
        for (int n = 0; n < ncv; ++n) { const float p = P[hh][n]; const float4 v4 = *(const float4*)(vc + ((size_t)(b * NCMP + n) * 2 + g) * 64 + l16 * 4);
            oc[0] += p * v4.x; oc[1] += p * v4.y; oc[2] += p * v4.z; oc[3] += p * v4.w; }
#pragma unroll
        for (int i = 0; i < 4; ++i) outb[hh][l16 * 4 + i] += gate[0] * oc[i];
    }
    {
        const int gg = tid >> 7, j = tid & 127;
        float ps = 0.f; const int nlo = (4 * j - 1 > 0) ? 4 * j - 1 : 0, nhi = (4 * j + 3 < NCMP - 1) ? 4 * j + 3 : NCMP - 1;
        for (int n = nlo; n <= nhi; ++n) { float sr = 0.f;
#pragma unroll
            for (int r = 0; r < 6; ++r) sr += P[gg * 6 + r][n];
            ps += sr; }
        const int cur = t >> 6; const bool adm = (j <= cur), forced = (j == 0) || (j == cur) || (j == cur - 1);
        sc[gg][j] = adm ? ps + (forced ? 1e4f : 0.f) : NEGF;
    }
    __syncthreads();
    {
        const int gg = tid >> 7, j = tid & 127; const float v = sc[gg][j]; int rank = 0;
        for (int k = 0; k < 128; ++k) { const float u = sc[gg][k]; rank += ((u > v) || (u == v && k < j)) ? 1 : 0; }
        if (rank < 16) { sel[gg][rank] = j; selv[gg][rank] = (v > 0.5f * NEGF) ? 1 : 0; }
    }
    __syncthreads();
    if (hh < 12) {
        float m_ = NEGF, l_ = 0.f; float o[64];
#pragma unroll
        for (int d = 0; d < 64; ++d) o[d] = 0.f;
        for (int s = 0; s < 16; ++s) {
            if (!selv[g][s]) continue;
            const int j = sel[g][s];
            for (int c = 0; c < 4; ++c) { const int pos = 64 * j + l16 + 16 * c;
                if (pos <= t) { const float* kr = proj + (size_t)(b * T_ + pos) * NSA_IN + 1024 + g * 64; attend<64>(qs[hh], kr, kr + 128, rel_bias[rel_bucket(t - pos) * 12 + hh], m_, l_, o); } }
        }
        merge16<64>(m_, l_, o);
#pragma unroll
        for (int d = 0; d < 64; ++d) if ((d >> 2) == l16) outb[hh][d] += gate[1] * o[d];
        m_ = NEGF; l_ = 0.f;
#pragma unroll
        for (int d = 0; d < 64; ++d) o[d] = 0.f;
        const int lo = (t - 511 > 0) ? t - 511 : 0;
        for (int pos = lo + l16; pos <= t; pos += 16) { const float* kr = proj + (size_t)(b * T_ + pos) * NSA_IN + 1280 + g * 64;
            attend<64>(qs[hh], kr, kr + 128, rel_bias[rel_bucket(t - pos) * 12 + hh], m_, l_, o); }
        merge16<64>(m_, l_, o);
#pragma unroll
        for (int d = 0; d < 64; ++d) if ((d >> 2) == l16) outb[hh][d] += gate[2] * o[d];
    } else {
        const int hm = hh - 12;
        float m_ = NEGF, l_ = 0.f; float o[64];
#pragma unroll
        for (int d = 0; d < 64; ++d) o[d] = 0.f;
        for (int mm = l16; mm < 256; mm += 16) { const float* kr = mkv + (size_t)(b * 256 + mm) * 512 + hm * 64; attend<64>(qs[hh], kr, kr + 256, 0.f, m_, l_, o); }
        merge16<64>(m_, l_, o);
#pragma unroll
        for (int d = 0; d < 64; ++d) if ((d >> 2) == l16) outb[hh][d] += o[d];
    }
    __syncthreads();
    for (int i = tid; i < 1024; i += 256) cat[(size_t)row * 1024 + i] = outb[i >> 6][i & 63];
}

__global__ void __launch_bounds__(256) k_dsa_norm(float* __restrict__ proj, const float* __restrict__ qn, const float* __restrict__ kvn, const float* __restrict__ kin) {
    const int row = blockIdx.x * 4 + (threadIdx.x >> 6), lane = threadIdx.x & 63;
    float* pr = proj + (size_t)row * DSA_IN;
    float v[4]; float s = 0.f;
#pragma unroll
    for (int i = 0; i < 4; ++i) { v[i] = pr[lane + 64 * i]; s += v[i] * v[i]; }
#pragma unroll
    for (int o = 1; o < 64; o <<= 1) s += __shfl_xor(s, o);
    float r = rsqrtf(s / 256.f + EPSF);
#pragma unroll
    for (int i = 0; i < 4; ++i) pr[lane + 64 * i] = (v[i] * r) * qn[lane + 64 * i];
    float u0 = pr[256 + lane], u1 = pr[320 + lane]; s = u0 * u0 + u1 * u1;
#pragma unroll
    for (int o = 1; o < 64; o <<= 1) s += __shfl_xor(s, o);
    r = rsqrtf(s / 128.f + EPSF);
    pr[256 + lane] = (u0 * r) * kvn[lane]; pr[320 + lane] = (u1 * r) * kvn[64 + lane];
    const float w = pr[384 + lane]; s = w * w;
#pragma unroll
    for (int o = 1; o < 64; o <<= 1) s += __shfl_xor(s, o);
    r = rsqrtf(s / 64.f + EPSF);
    pr[384 + lane] = (w * r) * kin[lane];
    if (lane < 8) pr[448 + lane] = pr[448 + lane] * (0.35355339059327373f * 0.125f);
}

__device__ __forceinline__ unsigned f2key(float f) { f = f + 0.f; const unsigned u = __float_as_uint(f); return (u & 0x80000000u) ? ~u : (u | 0x80000000u); }
__global__ void __launch_bounds__(256) k_dsa_index(const float* __restrict__ proj, const float* __restrict__ qi, int* __restrict__ selo, int* __restrict__ cnto) {
    __shared__ __attribute__((aligned(16))) float qs[8][64];
    __shared__ float ws_[8];
    __shared__ unsigned keys[8192];
    __shared__ unsigned hist[256];
    __shared__ unsigned short ties[8192];
    __shared__ unsigned sh_prefix, sh_kk, sh_cnt, sh_nt;
    const int row = blockIdx.x, b = row / T_, t = row % T_, tid = threadIdx.x;
    int* so = selo + (size_t)row * 256;
    if (t < 256) { if (tid <= t) so[tid] = tid; if (tid == 0) cnto[row] = t + 1; return; }
    for (int i = tid; i < 512; i += 256) qs[i >> 6][i & 63] = qi[(size_t)row * 512 + i];
    if (tid < 8) ws_[tid] = proj[(size_t)row * DSA_IN + 448 + tid];
    if (tid == 0) { sh_prefix = 0u; sh_kk = 256u; sh_cnt = 0u; sh_nt = 0u; }
    __syncthreads();
    for (int s = tid; s <= t; s += 256) {
        const float* kr = proj + (size_t)(b * T_ + s) * DSA_IN + 384;
        float k[64];
#pragma unroll
        for (int d = 0; d < 64; d += 4) { const float4 k4 = *(const float4*)(kr + d); k[d] = k4.x; k[d + 1] = k4.y; k[d + 2] = k4.z; k[d + 3] = k4.w; }
        float scv = 0.f;
#pragma unroll
        for (int h = 0; h < 8; ++h) { float a = 0.f;
#pragma unroll
            for (int d = 0; d < 64; ++d) a += qs[h][d] * k[d];
            scv += fmaxf(a, 0.f) * ws_[h]; }
        keys[s] = f2key(scv);
    }
    __syncthreads();
    for (int pass = 0; pass < 4; ++pass) {
        const int shift = 24 - 8 * pass;
        hist[tid] = 0u;
        __syncthreads();
        const unsigned prefix = sh_prefix, himask = (pass == 0) ? 0u : (0xFFFFFFFFu << (shift + 8));
        for (int s = tid; s <= t; s += 256) { const unsigned k = keys[s]; if ((k & himask) == prefix) atomicAdd(&hist[(k >> shift) & 255u], 1u); }
        __syncthreads();
        if (tid == 0) { unsigned kk = sh_kk, cum = 0u; int d = 255;
            for (; d > 0; --d) { if (cum + hist[d] >= kk) break; cum += hist[d]; }
            sh_kk = kk - cum; sh_prefix = prefix | ((unsigned)d << shift); }
        __syncthreads();
    }
    const unsigned tau = sh_prefix, kk = sh_kk;
    for (int s = tid; s <= t; s += 256) { const unsigned k = keys[s];
        if (k > tau) { const unsigned p = atomicAdd(&sh_cnt, 1u); so[p] = s; }
        else if (k == tau) { const unsigned p = atomicAdd(&sh_nt, 1u); ties[p] = (unsigned short)s; } }
    __syncthreads();
    const unsigned nt = sh_nt, base = sh_cnt;
    for (unsigned i = tid; i < nt; i += 256) { const unsigned me = ties[i]; unsigned rank = 0u;
        for (unsigned j = 0; j < nt; ++j) rank += (ties[j] < me) ? 1u : 0u;
        if (rank < kk) so[base + rank] = (int)me; }
    if (tid == 0) cnto[row] = 256;
}

__global__ void __launch_bounds__(256) k_dsa_attn(const float* __restrict__ proj, const float* __restrict__ q1, const int* __restrict__ selo, const int* __restrict__ cnto, const float* __restrict__ w_uk,
                                                  const float* __restrict__ w_uv, const float* __restrict__ mkv, const float* __restrict__ rel_bias, float* __restrict__ cat) {
    __shared__ __attribute__((aligned(16))) float qa[12][128];
    __shared__ __attribute__((aligned(16))) float qm[4][64];
    __shared__ __attribute__((aligned(16))) float ol[12][128];
    __shared__ float q768[768];
    __shared__ int sidx[256];
    const int row = blockIdx.x, b = row / T_, t = row % T_, tid = threadIdx.x, hh = tid >> 4, l16 = tid & 15;
    const int cnt = cnto[row];
    for (int i = tid; i < 768; i += 256) q768[i] = q1[(size_t)row * 768 + i];
    qm[tid >> 6][tid & 63] = proj[(size_t)row * DSA_IN + 456 + tid] * 0.125f;
    sidx[tid] = (tid < cnt) ? selo[(size_t)row * 256 + tid] : 0;
    __syncthreads();
    for (int i = tid; i < 1536; i += 256) { const int h = i >> 7, r = i & 127; const float* wr = w_uk + (size_t)r * 768 + h * 64; float a = 0.f;
#pragma unroll
        for (int d = 0; d < 64; ++d) a += q768[h * 64 + d] * wr[d];
        qa[h][r] = a; }
    __syncthreads();
    if (hh < 12) {
        float m_ = NEGF, l_ = 0.f; float o[128];
#pragma unroll
        for (int d = 0; d < 128; ++d) o[d] = 0.f;
        for (int i = l16; i < cnt; i += 16) { const int idx = sidx[i]; const float* kr = proj + (size_t)(b * T_ + idx) * DSA_IN + 256;
            attend<128>(qa[hh], kr, kr, rel_bias[rel_bucket(t - idx) * 12 + hh], m_, l_, o); }
        merge16<128>(m_, l_, o);
#pragma unroll
        for (int d = 0; d < 128; ++d) if ((d >> 3) == l16) ol[hh][d] = o[d];
    } else {
        const int hm = hh - 12;
        float m_ = NEGF, l_ = 0.f; float o[64];
#pragma unroll
        for (int d = 0; d < 64; ++d) o[d] = 0.f;
        for (int mm = l16; mm < 256; mm += 16) { const float* kr = mkv + (size_t)(b * 256 + mm) * 512 + hm * 64; attend<64>(qm[hm], kr, kr + 256, 0.f, m_, l_, o); }
        merge16<64>(m_, l_, o);
#pragma unroll
        for (int d = 0; d < 64; ++d) if ((d >> 2) == l16) cat[(size_t)row * 1024 + 768 + hm * 64 + d] = o[d];
    }
    __syncthreads();
    for (int i = tid; i < 768; i += 256) { const int h = i >> 6, d = i & 63; float a = 0.f;
        for (int r = 0; r < 128; ++r) a += ol[h][r] * w_uv[(size_t)r * 768 + h * 64 + d];
        cat[(size_t)row * 1024 + i] = a; }
}
}

extern "C" void kernel_launch(void* const* d_in, const int* in_sizes, int n_in, void* d_out, int out_size, void* d_ws, size_t ws_size, hipStream_t stream) {
    const float* x = (const float*)d_in[0];        const float* mem = (const float*)d_in[1];      const float* rel_bias = (const float*)d_in[2];
    const float* norm_mix = (const float*)d_in[3]; const float* norm_ffn = (const float*)d_in[4]; const float* norm_mem = (const float*)d_in[5];
    const float* w_mem_kv = (const float*)d_in[6]; const float* w_out = (const float*)d_in[7];    const float* ffn_gate = (const float*)d_in[8];
    const float* ffn_up = (const float*)d_in[9];   const float* ffn_down = (const float*)d_in[10];
    const float* nsa_w_in = (const float*)d_in[11]; const float* nsa_gate_b = (const float*)d_in[12];
    const float* pos_k = (const float*)d_in[13];   const float* pos_v = (const float*)d_in[14];
    const float* k_w1 = (const float*)d_in[15];    const float* k_b1 = (const float*)d_in[16];    const float* k_w2 = (const float*)d_in[17]; const float* k_b2 = (const float*)d_in[18];
    const float* v_w1 = (const float*)d_in[19];    const float* v_b1 = (const float*)d_in[20];    const float* v_w2 = (const float*)d_in[21]; const float* v_b2 = (const float*)d_in[22];
    const float* dsa_w_in = (const float*)d_in[23]; const float* dsa_q_norm = (const float*)d_in[24]; const float* dsa_kv_norm = (const float*)d_in[25];
    const float* dsa_w_q_up = (const float*)d_in[26]; const float* dsa_w_uk = (const float*)d_in[27]; const float* dsa_w_uv = (const float*)d_in[28];
    const float* dsa_w_q_idx = (const float*)d_in[29]; const float* dsa_kidx_norm = (const float*)d_in[30]; const float* norm_final = (const float*)d_in[31];
    float* out = (float*)d_out;
    char* ws = (char*)d_ws;
    const size_t MiB = 1u << 20;
    float* RSTD = (float*)(ws + 0);
    float* KC = (float*)(ws + 1 * MiB);  float* VC = (float*)(ws + 2 * MiB);
    float* HIDK = (float*)(ws + 3 * MiB); float* HIDV = (float*)(ws + 5 * MiB);
    float* MKV0 = (float*)(ws + 8 * MiB); float* MKV1 = (float*)(ws + 9 * MiB);
    int* SEL = (int*)(ws + 10 * MiB);     int* CNT = (int*)(ws + 27 * MiB);
    float* PROJ = (float*)(ws + 32 * MiB);
    float* Q1 = (float*)(ws + 80 * MiB);
    float* QI = (float*)(ws + 132 * MiB);
    float* CAT = (float*)(ws + 168 * MiB);
    float* ACT = (float*)(ws + 32 * MiB);
    float* MRS = RSTD + M_;
    const int NCR = B_ * NCMP * 2;

    hipLaunchKernelGGL(k_rstd, dim3(128), dim3(256), 0, stream, mem, D_, D_, MRS, 512);
    for (int i = 0; i < 2; ++i)
        gemm(stream, ALoadPlain{mem, MRS, norm_mem + i * D_, D_, 0}, w_mem_kv + (size_t)i * D_ * 512, 512, 512, 512, D_, EpStore{i ? MKV1 : MKV0, nullptr, 512, 1.f});

    for (int layer = 0; layer < 2; ++layer) {
        const float* hin = layer == 0 ? x : out;
        hipLaunchKernelGGL(k_rstd, dim3(M_ / 4), dim3(256), 0, stream, hin, D_, D_, RSTD, M_);
        if (layer == 0) {
            gemm(stream, ALoadPlain{hin, RSTD, norm_mix, D_, 0}, nsa_w_in, NSA_IN, M_, NSA_IN, D_, EpStore{PROJ, nullptr, NSA_IN, 1.f});
            gemm(stream, ALoadCmp{PROJ, pos_k, 768, 0}, k_w1, 256, NCR, 256, 2048, EpGelu{HIDK, k_b1, 256, 0});
            gemm(stream, ALoadPlain{HIDK, nullptr, nullptr, 256, 0}, k_w2, 64, NCR, 64, 256, EpStore{KC, k_b2, 64, 1.f});
            gemm(stream, ALoadCmp{PROJ, pos_v, 896, 0}, v_w1, 256, NCR, 256, 2048, EpGelu{HIDV, v_b1, 256, 0});
            gemm(stream, ALoadPlain{HIDV, nullptr, nullptr, 256, 0}, v_w2, 64, NCR, 64, 256, EpStore{VC, v_b2, 64, 1.f});
            hipLaunchKernelGGL(k_nsa_attn, dim3(M_), dim3(256), 0, stream, PROJ, KC, VC, MKV0, rel_bias, nsa_gate_b, CAT);
        } else {
            gemm(stream, ALoadPlain{hin, RSTD, norm_mix + D_, D_, 0}, dsa_w_in, DSA_IN, M_, DSA_IN, D_, EpStore{PROJ, nullptr, DSA_IN, 1.f});
            hipLaunchKernelGGL(k_dsa_norm, dim3(M_ / 4), dim3(256), 0, stream, PROJ, dsa_q_norm, dsa_kv_norm, dsa_kidx_norm);
            gemm(stream, ALoadPlain{PROJ, nullptr, nullptr, DSA_IN, 0}, dsa_w_q_up, 768, M_, 768, 256, EpStore{Q1, nullptr, 768, 0.125f});
            gemm(stream, ALoadPlain{PROJ, nullptr, nullptr, DSA_IN, 0}, dsa_w_q_idx, 512, M_, 512, 256, EpStore{QI, nullptr, 512, 1.f});
            hipLaunchKernelGGL(k_dsa_index, dim3(M_), dim3(256), 0, stream, PROJ, QI, SEL, CNT);
            hipLaunchKernelGGL(k_dsa_attn, dim3(M_), dim3(256), 0, stream, PROJ, Q1, SEL, CNT, dsa_w_uk, dsa_w_uv, MKV1, rel_bias, CAT);
        }
        gemm(stream, ALoadPlain{CAT, nullptr, nullptr, D_, 0}, w_out + (size_t)layer * D_ * D_, D_, M_, D_, D_, EpResid{out, hin, D_, D_});
        hipLaunchKernelGGL(k_rstd, dim3(M_ / 4), dim3(256), 0, stream, out, D_, D_, RSTD, M_);
        for (int c = 0; c < 8; ++c) {
            float* hc = out + (size_t)c * 2048 * D_;
            const ALoadPlain al{hc, RSTD + c * 2048, norm_ffn + layer * D_, D_, 0};
            gemm(stream, al, ffn_gate + (size_t)layer * D_ * DFF, DFF, 2048, DFF, D_, EpStore{ACT, nullptr, DFF, 1.f});
            gemm(stream, al, ffn_up + (size_t)layer * D_ * DFF, DFF, 2048, DFF, D_, EpSiluMul{ACT, DFF, 0});
            gemm(stream, ALoadPlain{ACT, nullptr, nullptr, DFF, 0}, ffn_down + (size_t)layer * DFF * D_, D_, 2048, D_, DFF, EpResid{hc, hc, D_, D_});
        }
    }
    hipLaunchKernelGGL(k_final, dim3(M_ / 4), dim3(256), 0, stream, out, norm_final);
}
```

```cpp
#include <hip/hip_runtime.h>
#include <cstdio>
#include <cstdint>
#include <math.h>

namespace pg8 {
#define PG8_LAS __attribute__((address_space(3)))
typedef unsigned short bf16_t;
typedef short bf16x8 __attribute__((ext_vector_type(8)));
typedef float f32x4 __attribute__((ext_vector_type(4)));
typedef unsigned u32x4 __attribute__((ext_vector_type(4)));
constexpr int BM = 256, BK = 64, HALF = 128, HTB = HALF * BK * 2  , STAGE_BYTES = 8 * HTB, NXCD = 8, WGM = 8;

__host__ __device__ __forceinline__ int lds_byte(int r, int c) { const int st = (r >> 4) * 2 + (c >> 5), rr = r & 15, cc = c & 31, ob = rr * 64 + cc * 2; return st * 1024 + (ob ^ (((ob >> 9) & 1) << 5)); }
__host__ __device__ __forceinline__ void stage_rc(int b, int& R, int& C) { const int st = b / 1024, sb = b % 1024, swz = sb ^ (((sb >> 9) & 1) << 5); R = (st >> 1) * 16 + swz / 64; C = (st & 1) * 32 + (swz % 64) / 2; }
__host__ __device__ __forceinline__ int perm32(int rho) { const int n = rho >> 4, i = rho & 15; return 8 * (i >> 2) + 4 * n + (i & 3); }

struct Unit { int pm, pn; };
struct Gemm { const bf16_t* A; const bf16_t* Bt; int M, N, K; };

struct StaticOrder {
    int nM, nN, nwg, G, c;
    __host__ __device__ void init(int M, int N, int G_, int c_) { nM = M / BM; nN = N / BM; nwg = nM * nN; G = G_; c = c_; }
    __host__ __device__ bool next(int i, Unit& u) const {
        const long L = (long)i * G + c; if (L >= nwg) return false;
        int wgid = (int)L; { const int q = nwg / NXCD, r = nwg % NXCD, xcd = wgid % NXCD, off = wgid / NXCD; wgid = (xcd < r ? xcd * (q + 1) : r * (q + 1) + (xcd - r) * q) + off; }
        const int nig = WGM * nN, gid = wgid / nig, fm = gid * WGM, gsz = (nM - fm) < WGM ? (nM - fm) : WGM;
        u.pm = fm + ((wgid % nig) % gsz); u.pn = (wgid % nig) / gsz; return true;
    }
    __device__ __forceinline__ void a_ready(const Unit&) const {}
    __device__ __forceinline__ void done(const Unit&) const {}
};

__device__ __forceinline__ unsigned cvt_pk_bf16(float lo, float hi) { unsigned r; asm volatile("v_cvt_pk_bf16_f32 %0, %1, %2" : "=v"(r) : "v"(lo), "v"(hi)); return r; }
template <int ROUTE> struct EpiRoute {
    static constexpr bool PERM = true, AFTER_DRAIN = false;
    unsigned char* ws;
    __device__ __forceinline__ void operator()(const f32x4 (&acc)[2][2][4][2], const Unit& u, int wr, int wc, int fr, int fq) const {
        asm volatile("" : "+v"(fr), "+v"(fq));
        const int pn = u.pn; size_t off; int ld, t0; float sc;
        if constexpr (ROUTE == 0) {
            off = pn < 3 ? (size_t)(88u << 20) : pn < 6 ? (size_t)(112u << 20) : pn < 7 ? (size_t)(136u << 20) : (size_t)(144u << 20);
            ld = pn < 6 ? 768 : 256; t0 = pn < 3 ? 0 : pn < 6 ? 3 : pn < 7 ? 6 : 7; sc = (pn < 3 || pn == 6) ? 0.125f : 1.f;
        } else if constexpr (ROUTE == 1) { off = (size_t)(88u << 20); ld = 768; t0 = 0; sc = 1.f; }
        else { off = pn < 6 ? (size_t)(128u << 20) : (size_t)(176u << 20); ld = pn < 6 ? 1536 : 512; t0 = pn < 6 ? 0 : 6; sc = 1.f; }
        bf16_t* base = (bf16_t*)(ws + off);
        const int row0 = u.pm * BM + wr * 64 + fr, col0 = (pn - t0) * BM + wc * 32 + 8 * fq;
#pragma unroll
        for (int ai = 0; ai < 2; ++ai)
#pragma unroll
            for (int m = 0; m < 4; ++m) { bf16_t* rowp = base + (size_t)(row0 + ai * HALF + m * 16) * ld + col0;
#pragma unroll
                for (int bj = 0; bj < 2; ++bj) { const f32x4 v0 = acc[ai][bj][m][0] * sc, v1 = acc[ai][bj][m][1] * sc;
                    u32x4 w; w.x = cvt_pk_bf16(v0[0], v0[1]); w.y = cvt_pk_bf16(v0[2], v0[3]); w.z = cvt_pk_bf16(v1[0], v1[1]); w.w = cvt_pk_bf16(v1[2], v1[3]);
                    *(u32x4*)(rowp + bj * HALF) = w; } }
    }
};
struct EpiResid {
    static constexpr bool PERM = true, AFTER_DRAIN = false;
    const float* res; float* out; int ldc; int pad;
    __device__ __forceinline__ void operator()(const f32x4 (&acc)[2][2][4][2], const Unit& u, int wr, int wc, int fr, int fq) const {
        asm volatile("" : "+v"(fr), "+v"(fq));
        const int row0 = u.pm * BM + wr * 64 + fr, col0 = u.pn * BM + wc * 32 + 8 * fq;
#pragma unroll
        for (int ai = 0; ai < 2; ++ai)
#pragma unroll
            for (int m = 0; m < 4; ++m) { const size_t off = (size_t)(row0 + ai * HALF + m * 16) * ldc + col0;
#pragma unroll
                for (int bj = 0; bj < 2; ++bj)
#pragma unroll
                    for (int n = 0; n < 2; ++n) { const f32x4 r = *(const f32x4*)(res + off + bj * HALF + 4 * n); *(f32x4*)(out + off + bj * HALF + 4 * n) = r + acc[ai][bj][m][n]; } }
    }
};
struct EpiSwiglu {
    static constexpr bool PERM = true, AFTER_DRAIN = false;
    bf16_t* O; int ldc; int pad;
    __device__ __forceinline__ void operator()(const f32x4 (&acc)[2][2][4][2], const Unit& u, int wr, int wc, int fr, int fq) const {
        asm volatile("" : "+v"(fr), "+v"(fq));
        const int row0 = u.pm * BM + wr * 64 + fr, col0 = u.pn * HALF + wc * 32 + 8 * fq;
#pragma unroll
        for (int ai = 0; ai < 2; ++ai)
#pragma unroll
            for (int m = 0; m < 4; ++m) { float o[8];
#pragma unroll
                for (int n = 0; n < 2; ++n)
#pragma unroll
                    for (int e = 0; e < 4; ++e) { const float g = acc[ai][0][m][n][e], up = acc[ai][1][m][n][e]; o[4 * n + e] = (g * __builtin_amdgcn_rcpf(1.f + __expf(-g))) * up; }
                u32x4 w; w.x = cvt_pk_bf16(o[0], o[1]); w.y = cvt_pk_bf16(o[2], o[3]); w.z = cvt_pk_bf16(o[4], o[5]); w.w = cvt_pk_bf16(o[6], o[7]);
                *(u32x4*)(O + (size_t)(row0 + ai * HALF + m * 16) * ldc + col0) = w; }
    }
};
template <class Epi, class Sched, bool ALIGN_EPI = false, bool SP2 = false>
__device__ __forceinline__ void gemm_phase(PG8_LAS unsigned char* lds, const Gemm g, const Sched& S, const Epi& E) {
    const int tid = threadIdx.x, wid = __builtin_amdgcn_readfirstlane(tid >> 6), lane = tid & 63, wr = wid >> 2, wc = wid & 3, fr = lane & 15, fq = lane >> 4;
    int K = g.K; asm volatile("" : "+s"(K));
    const int nt = K / BK;
    unsigned voffA[2], voffB[2];
#pragma unroll
    for (int i = 0; i < 2; ++i) { int R, C; stage_rc(tid * 16 + i * 8192, R, C); const int Rb = Epi::PERM ? ((R & ~31) + perm32(R & 31)) : R;
        voffA[i] = (unsigned)(R * K + C) * 2u; voffB[i] = (unsigned)(Rb * K + C) * 2u; }
    const size_t kstep = (size_t)(BK * 2);
    const size_t hstep = (size_t)HALF * K * 2;
    const size_t tstep = 2 * hstep;
    const unsigned ldsw = (unsigned)wid * 1024u;
    const int aoff = lds_byte(wr * 64 + fr, fq * 8), boff = lds_byte(wc * 32 + fr, fq * 8);
#define PG8_SA(b, h) (((b) * 2 + (h)) * HTB)
#define PG8_SB(b, h) ((4 + (b) * 2 + (h)) * HTB)
#define PG8_STAGE(bufoff, gbase, voff) do { _Pragma("unroll") for (int _i = 0; _i < 2; ++_i) \
        __builtin_amdgcn_global_load_lds((const unsigned*)((const char*)(gbase) + (voff)[_i]), (PG8_LAS unsigned*)(lds + (bufoff) + ldsw + _i * 8192), 16, 0, 0); } while (0)
#define PG8_LDA(dst, b, h) do { _Pragma("unroll") for (int m = 0; m < 4; ++m) _Pragma("unroll") for (int k = 0; k < 2; ++k) dst[m][k] = *(const PG8_LAS bf16x8*)(lds + PG8_SA(b, h) + aoff + m * 2048 + k * 1024); } while (0)
#define PG8_LDB(dst, b, h) do { _Pragma("unroll") for (int n = 0; n < 2; ++n) _Pragma("unroll") for (int k = 0; k < 2; ++k) dst[n][k] = *(const PG8_LAS bf16x8*)(lds + PG8_SB(b, h) + boff + n * 2048 + k * 1024); } while (0)
#define PG8_MMA(ai, bj, At, Bt) do { __builtin_amdgcn_s_setprio(1); _Pragma("unroll") for (int m = 0; m < 4; ++m) _Pragma("unroll") for (int n = 0; n < 2; ++n) _Pragma("unroll") for (int k = 0; k < 2; ++k) \
        acc[ai][bj][m][n] = __builtin_amdgcn_mfma_f32_16x16x32_bf16(Bt[n][k], At[m][k], acc[ai][bj][m][n], 0, 0, 0); __builtin_amdgcn_s_setprio(0); } while (0)
#define PG8_WAIT_V(n) asm volatile("s_waitcnt vmcnt(" #n ")" ::: "memory")
#define PG8_WAIT_L(n) asm volatile("s_waitcnt lgkmcnt(" #n ")" ::: "memory")
#define PG8_BAR __builtin_amdgcn_s_barrier()
#define PG8_SCHED __builtin_amdgcn_sched_barrier(0)
    Unit cur, nxt; int ui = 0;
    if (!S.next(0, cur)) return;
    f32x4 acc[2][2][4][2];
#pragma unroll
    for (int a = 0; a < 2; ++a)
#pragma unroll
        for (int b = 0; b < 2; ++b)
#pragma unroll
            for (int m = 0; m < 4; ++m)
#pragma unroll
                for (int n = 0; n < 2; ++n) acc[a][b][m][n] = (f32x4){0.f, 0.f, 0.f, 0.f};
    bf16x8 At[4][2], B0[2][2], B1[2][2];
    const char* cA = (const char*)g.A + (size_t)cur.pm * tstep; const char* cB = (const char*)g.Bt + (size_t)cur.pn * tstep;
    S.a_ready(cur);
    if constexpr (SP2) {
        PG8_STAGE(PG8_SB(0, 0), cB, voffB); PG8_STAGE(PG8_SB(0, 1), cB + hstep, voffB); PG8_STAGE(PG8_SA(0, 0), cA, voffA); PG8_STAGE(PG8_SA(0, 1), cA + hstep, voffA);
        if (wr == 1) PG8_BAR;
        PG8_WAIT_V(2); PG8_BAR;
        PG8_STAGE(PG8_SB(1, 0), cB + kstep, voffB); PG8_STAGE(PG8_SA(1, 0), cA + kstep, voffA); PG8_STAGE(PG8_SB(1, 1), cB + hstep + kstep, voffB);
        PG8_WAIT_V(6); PG8_BAR;
    } else {
        PG8_STAGE(PG8_SB(0, 0), cB, voffB); PG8_STAGE(PG8_SA(0, 0), cA, voffA); PG8_STAGE(PG8_SB(0, 1), cB + hstep, voffB); PG8_STAGE(PG8_SA(0, 1), cA + hstep, voffA);
        if (wr == 1) PG8_BAR;
        PG8_WAIT_V(4); PG8_BAR;
        PG8_STAGE(PG8_SB(1, 0), cB + kstep, voffB); PG8_STAGE(PG8_SA(1, 0), cA + kstep, voffA); PG8_STAGE(PG8_SB(1, 1), cB + hstep + kstep, voffB);
        PG8_WAIT_V(6); PG8_BAR;
    }
    for (;;) {
        const bool has_next = S.next(ui + 1, nxt);
        const char* nA = has_next ? (const char*)g.A + (size_t)nxt.pm * tstep : cA; const char* nB = has_next ? (const char*)g.Bt + (size_t)nxt.pn * tstep : cB;
        for (int t = 0; t < nt; t += 2) {
            const bool last = (t == nt - 2);
            const char* a1 = cA + (size_t)(t + 1) * kstep;
            const char* a2 = last ? nA : cA + (size_t)(t + 2) * kstep; const char* b2 = last ? nB : cB + (size_t)(t + 2) * kstep;
            const char* a3 = a2 + kstep; const char* b3 = b2 + kstep;
            if (last && has_next) S.a_ready(nxt);
            if constexpr (SP2) {
            PG8_LDB(B0, 0, 0); PG8_LDB(B1, 0, 1); PG8_SCHED; PG8_LDA(At, 0, 0); PG8_STAGE(PG8_SA(1, 1), a1 + hstep, voffA);
            PG8_WAIT_V(8); PG8_WAIT_L(0); PG8_BAR; PG8_MMA(0, 0, At, B0); PG8_MMA(0, 1, At, B1); PG8_BAR; PG8_SCHED;
            PG8_LDA(At, 0, 1); PG8_STAGE(PG8_SB(0, 0), b2, voffB); PG8_STAGE(PG8_SB(0, 1), b2 + hstep, voffB); PG8_STAGE(PG8_SA(0, 0), a2, voffA);
            PG8_WAIT_V(8); PG8_WAIT_L(0); PG8_BAR; PG8_MMA(1, 0, At, B0); PG8_MMA(1, 1, At, B1); PG8_BAR; PG8_SCHED;
            PG8_LDB(B0, 1, 0); PG8_LDB(B1, 1, 1); PG8_SCHED; PG8_LDA(At, 1, 0); PG8_STAGE(PG8_SA(0, 1), a2 + hstep, voffA);
            PG8_WAIT_V(8); PG8_WAIT_L(0); PG8_BAR; PG8_MMA(0, 0, At, B0); PG8_MMA(0, 1, At, B1); PG8_BAR; PG8_SCHED;
            PG8_LDA(At, 1, 1); PG8_STAGE(PG8_SB(1, 0), b3, voffB); PG8_STAGE(PG8_SB(1, 1), b3 + hstep, voffB); PG8_STAGE(PG8_SA(1, 0), a3, voffA);
            PG8_WAIT_V(8); PG8_WAIT_L(0); PG8_BAR; PG8_MMA(1, 0, At, B0); PG8_MMA(1, 1, At, B1); PG8_BAR; PG8_SCHED;
            } else {
            PG8_LDB(B0, 0, 0); PG8_SCHED; PG8_LDA(At, 0, 0); PG8_STAGE(PG8_SA(1, 1), a1 + hstep, voffA);
            PG8_WAIT_L(8); PG8_BAR; PG8_WAIT_L(0); PG8_MMA(0, 0, At, B0); PG8_BAR; PG8_SCHED;
            PG8_LDB(B1, 0, 1); PG8_STAGE(PG8_SB(0, 0), b2, voffB);
            PG8_BAR; PG8_WAIT_L(0); PG8_MMA(0, 1, At, B1); PG8_BAR;
            PG8_LDA(At, 0, 1); PG8_STAGE(PG8_SA(0, 0), a2, voffA);
            PG8_BAR; PG8_WAIT_L(0); PG8_MMA(1, 0, At, B0); PG8_BAR; PG8_SCHED;
            PG8_STAGE(PG8_SB(0, 1), b2 + hstep, voffB);
            PG8_WAIT_V(6); PG8_BAR; PG8_MMA(1, 1, At, B1); PG8_BAR;
            PG8_LDB(B0, 1, 0); PG8_SCHED; PG8_LDA(At, 1, 0); PG8_STAGE(PG8_SA(0, 1), a2 + hstep, voffA);
            PG8_WAIT_L(8); PG8_BAR; PG8_WAIT_L(0); PG8_MMA(0, 0, At, B0); PG8_BAR; PG8_SCHED;
            PG8_LDB(B1, 1, 1); PG8_STAGE(PG8_SB(1, 0), b3, voffB);
            PG8_BAR; PG8_WAIT_L(0); PG8_MMA(0, 1, At, B1); PG8_BAR;
            PG8_LDA(At, 1, 1); PG8_STAGE(PG8_SA(1, 0), a3, voffA);
            PG8_BAR; PG8_WAIT_L(0); PG8_MMA(1, 0, At, B0); PG8_BAR; PG8_SCHED;
            PG8_STAGE(PG8_SB(1, 1), b3 + hstep, voffB);
            PG8_WAIT_V(6); PG8_BAR; PG8_MMA(1, 1, At, B1); PG8_BAR;
            }
        }
        if constexpr (ALIGN_EPI) { if (wr == 0) PG8_BAR; }
        if constexpr (!Epi::AFTER_DRAIN) { E(acc, cur, wr, wc, fr, fq); S.done(cur); }
        if (!has_next) break;
#pragma unroll
        for (int a = 0; a < 2; ++a)
#pragma unroll
            for (int b = 0; b < 2; ++b)
#pragma unroll
                for (int m = 0; m < 4; ++m)
#pragma unroll
                    for (int n = 0; n < 2; ++n) acc[a][b][m][n] = (f32x4){0.f, 0.f, 0.f, 0.f};
        cur = nxt; cA = nA; cB = nB; ++ui;
        if constexpr (ALIGN_EPI) { if (wr == 1) PG8_BAR; }
    }
    PG8_WAIT_V(0);
    if constexpr (!ALIGN_EPI) { if (wr == 0) PG8_BAR; }
    PG8_BAR;
    if constexpr (Epi::AFTER_DRAIN) { E.fused(acc, cur, wr, wc, fr, fq, lds, wid, lane); S.done(cur); }
#undef PG8_SA
#undef PG8_SB
#undef PG8_STAGE
#undef PG8_LDA
#undef PG8_LDB
#undef PG8_MMA
#undef PG8_WAIT_V
#undef PG8_WAIT_L
#undef PG8_BAR
#undef PG8_SCHED
}
}
constexpr int NWAVES = 8;
constexpr int BATCH = 2, T = 8192, D = 1024, M = BATCH * T, DFF = 2816, NSA_IN = 1828, DSA_IN = 712, NCMP = 511, NCR = BATCH * NCMP * 2;
constexpr float NEGF = -1e30f, EPSF = 1e-6f;
#ifndef MK_SPLIT
#define MK_SPLIT 0
#endif
constexpr int N_PHASES = 19;
constexpr size_t MiB = 1u << 20;
constexpr size_t WS_CTL = 0, CTL_ZERO_BYTES = 1 * MiB;
constexpr size_t WS_KC = 1 * MiB, WS_VC = 2 * MiB, WS_MKV = 3 * MiB  , WS_WIDX = 5 * MiB  , WS_CNT = 6 * MiB  ;
constexpr size_t WS_WIN0 = 8 * MiB, WS_WO = 12 * MiB, WS_WGU = 16 * MiB, WS_WD = 38 * MiB, WS_WIN1 = 49 * MiB, WS_WQ2 = 51 * MiB;
constexpr size_t WS_XN = 56 * MiB;
constexpr size_t WS_Q0 = 88 * MiB, WS_KV0 = 112 * MiB, WS_QM = 136 * MiB, WS_G0 = 144 * MiB;
static_assert(WS_Q0 == (88u << 20) && WS_KV0 == (112u << 20) && WS_QM == (136u << 20) && WS_G0 == (144u << 20), "EpiRoute tables");
constexpr size_t WS_ACT = 88 * MiB;
constexpr size_t WS_PROJ1 = 88 * MiB, WS_CQ = 112 * MiB, WS_CKV = 120 * MiB, WS_KIDX = 124 * MiB, WS_QA = 128 * MiB, WS_QI = 176 * MiB, WS_SEL = 192 * MiB;
constexpr size_t WS_CAT = 200 * MiB, WS_END = 232 * MiB;
static_assert(WS_PROJ1 == (88u << 20) && WS_QA == (128u << 20) && WS_QI == (176u << 20), "EpiRoute tables");
static_assert(WS_ACT + (size_t)M * DFF * 2 <= WS_CAT + 0 * MiB || true, "map");
constexpr int CW_BAR = 4096;
constexpr int RING_OFF = 0, RING_BYTES = 131072, LDSCTL_OFF = RING_BYTES, MISC_OFF = LDSCTL_OFF + 320, LDS_BYTES = 147456;
#define GAS __attribute__((address_space(1)))
#define LAS __attribute__((address_space(3)))
typedef unsigned short bf16;
typedef unsigned v4u __attribute__((ext_vector_type(4)));
typedef float f32x4 __attribute__((ext_vector_type(4)));
typedef short bf16x8 __attribute__((ext_vector_type(8)));
typedef GAS unsigned gu32;
typedef GAS unsigned long long gu64;
#define RLX_AGENT __ATOMIC_RELAXED, __HIP_MEMORY_SCOPE_AGENT
#define LDS_WAIT() asm volatile("s_waitcnt lgkmcnt(0)" ::: "memory")
#define VM_WAIT() asm volatile("s_waitcnt vmcnt(0)" ::: "memory")
__device__ __forceinline__ unsigned long long rt() { return __builtin_amdgcn_s_memrealtime(); }
__device__ __forceinline__ unsigned f2bf(float f) { unsigned u = __builtin_bit_cast(unsigned, f); return (u + 0x7fffu + ((u >> 16) & 1u)) >> 16; }
__device__ __forceinline__ unsigned pk2(float lo, float hi) { return f2bf(lo) | (f2bf(hi) << 16); }
#define XB_TMO      128
#define XB_XCNT(j)  (256  + 64 * (j))
#define XB_XSUB(j)  (1280 + 64 * (j))
#define XB_XGEN(j)  (2304 + 64 * (j))
#define XB_TOP      3328
#define XB_TOPGEN   3392
#define XCD_BAR_WORDS 3456
#define XB_SPIN_CAP (1u << 18)

__device__ __forceinline__ unsigned xb_ld(unsigned* p)              { return __hip_atomic_load(p, __ATOMIC_RELAXED, __HIP_MEMORY_SCOPE_AGENT); }
__device__ __forceinline__ unsigned xb_add(unsigned* p, unsigned v) { return __hip_atomic_fetch_add(p, v, __ATOMIC_RELAXED, __HIP_MEMORY_SCOPE_AGENT); }
__device__ __forceinline__ unsigned xb_xcc_id() { return (unsigned)__builtin_amdgcn_s_getreg((3 << 11) | 20) & 0xFu; }
#define XB_SPIN(cond, bar) do { unsigned _sp = 0; while (cond) { __builtin_amdgcn_s_sleep(1); \
    if ((++_sp & 255u) == 0u) { if (xb_ld(&(bar)[XB_TMO])) break; if (_sp > XB_SPIN_CAP) { atomicAdd(&(bar)[XB_TMO], 1u); break; } } } } while (0)

struct XcdBarrier {
    unsigned* bar; unsigned x;
    volatile LAS unsigned* st;
};

__device__ __forceinline__ XcdBarrier xcd_barrier_post(unsigned* bar, volatile LAS unsigned* st) {
    XcdBarrier b; b.bar = bar; b.x = xb_xcc_id(); b.st = st;
    if (threadIdx.x == 0) (void)xb_add(&bar[XB_XCNT(b.x)], 1u);
    return b;
}
__device__ __forceinline__ void xcd_barrier_complete(unsigned* bar, unsigned x, unsigned& nloc, unsigned& nx) {
    const unsigned G = gridDim.x * gridDim.y * gridDim.z;
    unsigned sum, cnt, mine, sp = 0u;
    for (;;) {
        sum = 0u; cnt = 0u; mine = 0u;
#pragma unroll
        for (unsigned j = 0; j < 16; ++j) { const unsigned c = xb_ld(&bar[XB_XCNT(j)]); sum += c; cnt += (c > 0u) ? 1u : 0u; mine = (j == x) ? c : mine; }
        if (sum == G) break;
        __builtin_amdgcn_s_sleep(1);
        if ((++sp & 255u) == 0u) { if (xb_ld(&bar[XB_TMO])) break; if (sp > XB_SPIN_CAP) { atomicAdd(&bar[XB_TMO], 1u); break; } }
    }
    nloc = mine > 0u ? mine : 1u; nx = cnt > 0u ? cnt : 1u;
}

__device__ __forceinline__ void xcd_barrier(const XcdBarrier& b) {
    asm volatile("s_waitcnt vmcnt(0)" ::: "memory");
    __syncthreads();
    if (threadIdx.x == 0) {
        unsigned* bar = b.bar;
        __builtin_amdgcn_s_waitcnt(0);
        unsigned nloc = b.st[0], nx = b.st[1];
        if (nloc == 0u) { xcd_barrier_complete(bar, b.x, nloc, nx); b.st[0] = nloc; b.st[1] = nx; }
        const unsigned old = xb_add(&bar[XB_XSUB(b.x)], 1u);
        const unsigned gen = old / nloc;
        if (old + 1u == (gen + 1u) * nloc) {
            __builtin_amdgcn_fence(__ATOMIC_RELEASE, "agent");
            asm volatile("s_waitcnt vmcnt(0)" ::: "memory");
            const unsigned og = xb_add(&bar[XB_TOP], 1u);
            const unsigned tg = og / nx;
            if (og + 1u == (tg + 1u) * nx) xb_add(&bar[XB_TOPGEN], 1u);
            else XB_SPIN(xb_ld(&bar[XB_TOPGEN]) == tg, bar);
            __builtin_amdgcn_fence(__ATOMIC_ACQUIRE, "agent");
            xb_add(&bar[XB_XGEN(b.x)], 1u);
            asm volatile("s_waitcnt vmcnt(0)" ::: "memory");
        } else {
            XB_SPIN(xb_ld(&bar[XB_XGEN(b.x)]) == gen, bar);
            __builtin_amdgcn_fence(__ATOMIC_ACQUIRE, "agent");
            asm volatile("s_waitcnt vmcnt(0)" ::: "memory");
        }
    }
    __syncthreads();
}

struct Frame {
    LAS unsigned char* lds; volatile LAS unsigned* MISC; gu32* ctl;
    int tid, lane, wave, vcu, G;
};
__device__ __forceinline__ float bf2f(unsigned short u) { return __uint_as_float((unsigned)u << 16); }
__device__ __forceinline__ float bflo(unsigned u) { return __uint_as_float(u << 16); }
__device__ __forceinline__ float bfhi(unsigned u) { return __uint_as_float(u & 0xffff0000u); }
__device__ __forceinline__ float wave_sum(float v) {
#pragma unroll
    for (int o = 1; o < 64; o <<= 1) v += __shfl_xor(v, o);
    return v;
}
__device__ __forceinline__ float red16_sum(float v) { v += __shfl_xor(v, 1, 16); v += __shfl_xor(v, 2, 16); v += __shfl_xor(v, 4, 16); v += __shfl_xor(v, 8, 16); return v; }
__device__ __forceinline__ float red16_max(float v) { v = fmaxf(v, __shfl_xor(v, 1, 16)); v = fmaxf(v, __shfl_xor(v, 2, 16)); v = fmaxf(v, __shfl_xor(v, 4, 16)); v = fmaxf(v, __shfl_xor(v, 8, 16)); return v; }
__device__ __forceinline__ int rel_bucket(int n) {
    if (n < 16) return n;
    return 16 + (n >= 22) + (n >= 30) + (n >= 40) + (n >= 54) + (n >= 73) + (n >= 99) + (n >= 134) + (n >= 182) + (n >= 246) + (n >= 332) + (n >= 450) + (n >= 609) + (n >= 825) + (n >= 1117) + (n >= 1513);
}

__device__ __forceinline__ void xpose_item(const float* W, int ldw, int c0, int nvalid, int k0, bf16* WT, int Kd, int drow0, LAS float* scr, int lane) {
#pragma unroll 8
    for (int i = 0; i < 32; ++i) { const int kk = 2 * i + (lane >> 5), n = lane & 31; scr[kk * 33 + n] = (n < nvalid) ? W[(size_t)(k0 + kk) * ldw + c0 + n] : 0.f; }
    LDS_WAIT(); asm volatile("" ::: "memory");
    const int c = lane & 7;
#pragma unroll
    for (int j = 0; j < 4; ++j) { const int n = (lane >> 3) + 8 * j; const LAS float* s = scr + (8 * c) * 33 + n;
        v4u o; o.x = pk2(s[0 * 33], s[1 * 33]); o.y = pk2(s[2 * 33], s[3 * 33]); o.z = pk2(s[4 * 33], s[5 * 33]); o.w = pk2(s[6 * 33], s[7 * 33]);
        *(GAS v4u*)(WT + (size_t)(drow0 + n) * Kd + k0 + 8 * c) = o; }
    LDS_WAIT(); asm volatile("" ::: "memory");
}
__device__ __forceinline__ void rms_row_to_bf16(const float* xrow, const float* gain, bf16* orow, int lane) {
    const GAS f32x4* xr = (const GAS f32x4*)xrow + lane; const GAS f32x4* gr = (const GAS f32x4*)gain + lane;
    f32x4 v[4]; float s = 0.f;
#pragma unroll
    for (int j = 0; j < 4; ++j) { v[j] = xr[64 * j]; s += (v[j].x * v[j].x + v[j].y * v[j].y) + (v[j].z * v[j].z + v[j].w * v[j].w); }
    const float r = rsqrtf(wave_sum(s) * (1.f / D) + EPSF);
    GAS unsigned long long* o8 = (GAS unsigned long long*)orow + lane;
#pragma unroll
    for (int j = 0; j < 4; ++j) { const f32x4 g = gr[64 * j]; o8[64 * j] = (unsigned long long)pk2((v[j].x * r) * g.x, (v[j].y * r) * g.y) | ((unsigned long long)pk2((v[j].z * r) * g.z, (v[j].w * r) * g.w) << 32); }
}
#define OPAQUE_TID() int tid_ = threadIdx.x; asm volatile("" : "+v"(tid_))
__device__ __forceinline__ void norm_phase(Frame& F, const float* x, const float* gain, bf16* xn) {
    OPAQUE_TID(); const int lane_ = tid_ & 63, wave_ = tid_ >> 6;
    const int gw = F.vcu * NWAVES + wave_, NGW = F.G * NWAVES;
    for (int m = gw; m < M; m += NGW) rms_row_to_bf16(x + (size_t)m * D, gain, xn + (size_t)m * D, lane_);
}

template <int DL>
__device__ __forceinline__ void coop_attend(const float (&q)[DL], const float (&k)[DL], const float (&v)[DL], float bias, float& m_, float& l_, float (&o)[DL]) {
    float a = 0.f;
#pragma unroll
    for (int d = 0; d < DL; ++d) a += q[d] * k[d];
    a = red16_sum(a) + bias;
    const float mn = fmaxf(m_, a), al = __expf(m_ - mn), p = __expf(a - mn);
    l_ = l_ * al + p; m_ = mn;
#pragma unroll
    for (int d = 0; d < DL; ++d) o[d] = o[d] * al + p * v[d];
}
__device__ __forceinline__ void ld4bf(const bf16* p, float (&x)[4]) { const uint2 u = *(const uint2*)p; x[0] = bflo(u.x); x[1] = bfhi(u.x); x[2] = bflo(u.y); x[3] = bfhi(u.y); }
__device__ __forceinline__ void ld8bf(const bf16* p, float (&x)[8]) { const uint4 u = *(const uint4*)p; x[0] = bflo(u.x); x[1] = bfhi(u.x); x[2] = bflo(u.y); x[3] = bfhi(u.y); x[4] = bflo(u.z); x[5] = bfhi(u.z); x[6] = bflo(u.w); x[7] = bfhi(u.w); }
__device__ __forceinline__ void ld4f(const float* p, float (&x)[4]) { const float4 u = *(const float4*)p; x[0] = u.x; x[1] = u.y; x[2] = u.z; x[3] = u.w; }

struct In {
    const float *x, *mem, *rel_bias, *norm_mix, *norm_ffn, *norm_mem, *w_mem_kv, *w_out, *ffn_gate, *ffn_up, *ffn_down, *nsa_w_in, *nsa_gate_b, *pos_k, *pos_v,
        *k_w1, *k_b1, *k_w2, *k_b2, *v_w1, *v_b1, *v_w2, *v_b2, *dsa_w_in, *q_norm, *kv_norm, *w_q_up, *w_uk, *w_uv, *w_q_idx, *kidx_norm, *norm_final;
};
__device__ __forceinline__ void p0_prologue(Frame& F, const In& I, unsigned char* ws) {
    OPAQUE_TID(); const int lane_ = tid_ & 63, wave_ = __builtin_amdgcn_readfirstlane(tid_ >> 6);
    LAS float* scr = (LAS float*)(F.lds + RING_OFF + wave_ * 16384);
    const int gw = F.vcu * NWAVES + wave_, NGW = F.G * NWAVES;
    bf16* WIN0 = (bf16*)(ws + WS_WIN0); bf16* WO = (bf16*)(ws + WS_WO); bf16* WGU = (bf16*)(ws + WS_WGU); bf16* WD = (bf16*)(ws + WS_WD); bf16* WIN1 = (bf16*)(ws + WS_WIN1); bf16* WQ2 = (bf16*)(ws + WS_WQ2);
    constexpr int I_A = 16 * 64, I_B = 2 * 16 * 32, I_C = 2 * 16 * 176, I_D = 2 * 44 * 32, I_E = 16 * 24, I_F = 4 * 16, NITEMS = I_A + I_B + I_C + I_D + I_E + I_F;
    for (int it = gw; it < NITEMS; it += NGW) {
        int r = it;
        if (r < I_A) { const int kb = r / 64, nb = r % 64, r0 = 32 * nb; int c0, nv;
            if (r0 < 1536) { c0 = r0; nv = 32; } else if (r0 < 1792) { c0 = r0 + 36; nv = 32; } else if (r0 == 1792) { c0 = 1536; nv = 32; } else if (r0 == 1824) { c0 = 1568; nv = 4; } else { c0 = 0; nv = 0; }
            xpose_item(I.nsa_w_in, NSA_IN, c0, nv, 64 * kb, WIN0, D, r0, scr, lane_); continue; } r -= I_A;
        if (r < I_B) { const int l = r / 512, q = r % 512, kb = q / 32, nb = q % 32;
            xpose_item(I.w_out + (size_t)l * D * D, D, 32 * nb, 32, 64 * kb, WO + (size_t)l * D * D, D, 32 * nb, scr, lane_); continue; } r -= I_B;
        if (r < I_C) { const int l = r / (16 * 176), q = r % (16 * 176), kb = q / 176, nb = q % 176, r0 = 32 * nb, pn = r0 >> 8, w0 = r0 & 255;
            const float* src = ((w0 < 128) ? I.ffn_gate : I.ffn_up) + (size_t)l * D * DFF;
            xpose_item(src, DFF, 128 * pn + (w0 & 127), 32, 64 * kb, WGU + (size_t)l * 2 * DFF * D, D, r0, scr, lane_); continue; } r -= I_C;
        if (r < I_D) { const int l = r / (44 * 32), q = r % (44 * 32), kb = q / 32, nb = q % 32;
            xpose_item(I.ffn_down + (size_t)l * DFF * D, D, 32 * nb, 32, 64 * kb, WD + (size_t)l * D * DFF, DFF, 32 * nb, scr, lane_); continue; } r -= I_D;
        if (r < I_E) { const int kb = r / 24, nb = r % 24, r0 = 32 * nb; int nv = DSA_IN - r0; nv = nv > 32 ? 32 : (nv < 0 ? 0 : nv);
            xpose_item(I.dsa_w_in, DSA_IN, r0, nv, 64 * kb, WIN1, D, r0, scr, lane_); continue; } r -= I_E;
        { const int kb = r / 16, nb = r % 16; xpose_item(I.w_q_idx, 512, 32 * nb, 32, 64 * kb, WQ2, 256, 1536 + 32 * nb, scr, lane_); }
    }
    for (int idx = (F.vcu * NWAVES * 64) + tid_; idx < 1536 * 256; idx += F.G * NWAVES * 64) {
        const int n = idx >> 8, c = idx & 255, h = n >> 7, rr = n & 127; const float* a = I.w_q_up + (size_t)c * 768 + h * 64; const float* b = I.w_uk + (size_t)rr * 768 + h * 64; float s = 0.f;
#pragma unroll 8
        for (int d = 0; d < 64; ++d) s += a[d] * b[d];
        WQ2[idx] = (bf16)f2bf(s * 0.125f);
    }
    norm_phase(F, I.x, I.norm_mix, (bf16*)(ws + WS_XN));
}

__device__ __forceinline__ void p2_small(Frame& F, const In& I, unsigned char* ws) {
    OPAQUE_TID(); const int lane_ = tid_ & 63;
    const int hb = tid_ >> 8, t256 = tid_ & 255, ghb = blockIdx.x * 2 + hb, NHB = F.G * 2;
    float* MKV = (float*)(ws + WS_MKV); float* KC = (float*)(ws + WS_KC); float* VC = (float*)(ws + WS_VC);
    const bf16* KV0 = (const bf16*)(ws + WS_KV0);
    for (int m = ghb; m < 512; m += NHB) {
        const float* mr = I.mem + (size_t)m * D; float s = 0.f;
        for (int k = lane_; k < D; k += 64) { const float v = mr[k]; s += v * v; }
        const float rs = rsqrtf(wave_sum(s) * (1.f / D) + EPSF);
        float a00 = 0.f, a01 = 0.f, a10 = 0.f, a11 = 0.f;
        const float* w0 = I.w_mem_kv + t256; const float* w1 = I.w_mem_kv + (size_t)D * 512 + t256;
#pragma unroll 4
        for (int k = 0; k < D; ++k) { const float xv = mr[k] * rs; const float x0 = xv * I.norm_mem[k], x1 = xv * I.norm_mem[D + k];
            a00 += x0 * w0[(size_t)k * 512]; a01 += x0 * w0[(size_t)k * 512 + 256]; a10 += x1 * w1[(size_t)k * 512]; a11 += x1 * w1[(size_t)k * 512 + 256]; }
        MKV[(size_t)m * 512 + t256] = a00; MKV[(size_t)m * 512 + 256 + t256] = a01; MKV[(size_t)(512 + m) * 512 + t256] = a10; MKV[(size_t)(512 + m) * 512 + 256 + t256] = a11;
    }
    LAS float* hid = (LAS float*)(F.lds + RING_OFF + hb * 8192);
    constexpr int UPK = (NCR + 3) / 4, NU = 2 * UPK; const int iters = (NU + NHB - 1) / NHB;
    for (int it = 0; it < iters; ++it) {
        const int u = it * NHB + ghb; const bool act = u < NU; const int kv = act ? u / UPK : 0, r0 = act ? (u % UPK) * 4 : 0;
        const float* w1 = kv ? I.v_w1 : I.k_w1; const float* b1 = kv ? I.v_b1 : I.k_b1; const float* w2 = kv ? I.v_w2 : I.k_w2; const float* b2 = kv ? I.v_b2 : I.k_b2; const float* pos = kv ? I.pos_v : I.pos_k;
        const bf16* rp[4];
#pragma unroll
        for (int i = 0; i < 4; ++i) { int row = r0 + i; if (row >= NCR) row = NCR - 1; const int g = row & 1, bn = row >> 1, b = bn / NCMP, n = bn % NCMP; rp[i] = KV0 + (size_t)(b * T + 16 * n) * 768 + kv * 128 + g * 64; }
        float h0 = 0.f, h1 = 0.f, h2 = 0.f, h3 = 0.f;
        if (act) {
            for (int l = 0; l < 32; ++l)
#pragma unroll 8
                for (int d = 0; d < 64; ++d) { const float w = w1[(size_t)(l * 64 + d) * 256 + t256], p = pos[l * 64 + d];
                    h0 += (bf2f(rp[0][l * 768 + d]) + p) * w; h1 += (bf2f(rp[1][l * 768 + d]) + p) * w; h2 += (bf2f(rp[2][l * 768 + d]) + p) * w; h3 += (bf2f(rp[3][l * 768 + d]) + p) * w; }
        }
        { const float bb = b1[t256]; float hv[4] = {h0 + bb, h1 + bb, h2 + bb, h3 + bb};
#pragma unroll
          for (int i = 0; i < 4; ++i) { const float xg = hv[i]; hid[i * 256 + t256] = 0.5f * xg * (1.f + tanhf(0.7978845608028654f * (xg + 0.044715f * xg * xg * xg))); } }
        __syncthreads();
        { const int i = t256 >> 6, d = t256 & 63; float s = b2[d];
          for (int c = 0; c < 256; ++c) s += hid[i * 256 + c] * w2[c * 64 + d];
          if (act && r0 + i < NCR) (kv ? VC : KC)[(size_t)(r0 + i) * 64 + d] = s; }
        __syncthreads();
    }
}

__device__ __forceinline__ void p3_nsa_attn(Frame& F, const In& I, unsigned char* ws) {
    OPAQUE_TID(); const int lane_ = tid_ & 63;
    const int hb = tid_ >> 8, t256 = tid_ & 255, hh = t256 >> 4, l16 = t256 & 15, ghb = blockIdx.x * 2 + hb, NHB = F.G * 2;
    LAS unsigned char* base = F.lds + RING_OFF + hb * 65536;
    LAS float* qs = (LAS float*)base;
    LAS float* P = (LAS float*)(base + 4096);
    LAS float* sc = (LAS float*)(base + 28672);
    LAS int* sel = (LAS int*)(base + 29696);
    LAS int* selv = (LAS int*)(base + 29824);
    const bf16* Q0 = (const bf16*)(ws + WS_Q0); const bf16* KV0 = (const bf16*)(ws + WS_KV0); const bf16* QM = (const bf16*)(ws + WS_QM); const bf16* G0 = (const bf16*)(ws + WS_G0);
    const float* KC = (const float*)(ws + WS_KC); const float* VC = (const float*)(ws + WS_VC); const float* MKV = (const float*)(ws + WS_MKV);
    bf16* CAT = (bf16*)(ws + WS_CAT);
    const int iters = (M + NHB - 1) / NHB;
    for (int it = 0; it < iters; ++it) {
        const int row = it * NHB + ghb, b = row / T, t = row % T;
        for (int i = t256; i < 1024; i += 256) { const int h = i >> 6, d = i & 63; qs[i] = (h < 12) ? bf2f(Q0[(size_t)row * 768 + i]) : bf2f(QM[(size_t)row * 256 + (h - 12) * 64 + d]); }
        __syncthreads();
        const int ncv = (t >= 31) ? ((t - 31) / 16 + 1) : 0;
        const int g = (hh < 12) ? hh / 6 : 0;
        float gate0 = 1.f, gate1 = 1.f, gate2 = 1.f;
        if (hh < 12) { gate0 = 1.f / (1.f + __expf(-(bf2f(G0[(size_t)row * 256 + hh * 3 + 0]) + I.nsa_gate_b[hh * 3 + 0])));
                       gate1 = 1.f / (1.f + __expf(-(bf2f(G0[(size_t)row * 256 + hh * 3 + 1]) + I.nsa_gate_b[hh * 3 + 1])));
                       gate2 = 1.f / (1.f + __expf(-(bf2f(G0[(size_t)row * 256 + hh * 3 + 2]) + I.nsa_gate_b[hh * 3 + 2]))); }
        float q[4];
#pragma unroll
        for (int i = 0; i < 4; ++i) q[i] = qs[hh * 64 + 4 * l16 + i];
        float mx = NEGF;
        if (hh < 12) {
            for (int n = l16; n < 512; n += 16) { float s = NEGF;
                if (n < ncv) { const float* kr = KC + ((size_t)(b * NCMP + n) * 2 + g) * 64; float a = 0.f;
#pragma unroll
                    for (int d = 0; d < 64; d += 4) { const float4 k4 = *(const float4*)(kr + d); a += qs[hh * 64 + d] * k4.x + qs[hh * 64 + d + 1] * k4.y + qs[hh * 64 + d + 2] * k4.z + qs[hh * 64 + d + 3] * k4.w; }
                    s = a + I.rel_bias[rel_bucket(t - (16 * n + 31)) * 12 + hh]; }
                P[hh * 512 + n] = s; mx = fmaxf(mx, s); }
        }
        mx = red16_max(mx);
        float sum = 0.f;
        if (hh < 12) for (int n = l16; n < 512; n += 16) { const float p = (n < ncv) ? __expf(P[hh * 512 + n] - mx) : 0.f; P[hh * 512 + n] = p; sum += p; }
        sum = red16_sum(sum);
        if (hh < 12) { const float inv = (ncv > 0) ? 1.f / sum : 0.f; for (int n = l16; n < 512; n += 16) P[hh * 512 + n] *= inv; }
        __syncthreads();
        float oc[4] = {0.f, 0.f, 0.f, 0.f};
        if (hh < 12) for (int n = 0; n < ncv; ++n) { const float p = P[hh * 512 + n]; const float4 v4 = *(const float4*)(VC + ((size_t)(b * NCMP + n) * 2 + g) * 64 + l16 * 4);
            oc[0] += p * v4.x; oc[1] += p * v4.y; oc[2] += p * v4.z; oc[3] += p * v4.w; }
        { const int gg = t256 >> 7, j = t256 & 127; float ps = 0.f; const int nlo = (4 * j - 1 > 0) ? 4 * j - 1 : 0, nhi = (4 * j + 3 < NCMP - 1) ? 4 * j + 3 : NCMP - 1;
          for (int n = nlo; n <= nhi; ++n) { float sr = 0.f;
#pragma unroll
              for (int r = 0; r < 6; ++r) sr += P[(gg * 6 + r) * 512 + n];
              ps += sr; }
          const int cur = t >> 6; const bool adm = (j <= cur), forced = (j == 0) || (j == cur) || (j == cur - 1);
          sc[gg * 128 + j] = adm ? ps + (forced ? 1e4f : 0.f) : NEGF; }
        __syncthreads();
        { const int gg = t256 >> 7, j = t256 & 127; const float v = sc[gg * 128 + j]; int rank = 0;
          for (int k = 0; k < 128; ++k) { const float u = sc[gg * 128 + k]; rank += ((u > v) || (u == v && k < j)) ? 1 : 0; }
          if (rank < 16) { sel[gg * 16 + rank] = j; selv[gg * 16 + rank] = (v > 0.5f * NEGF) ? 1 : 0; } }
        __syncthreads();
        float res[4] = {0.f, 0.f, 0.f, 0.f};
        if (hh < 12) {
            const bf16* kvb = KV0 + (size_t)b * T * 768 + g * 64 + 4 * l16;
            float m_ = NEGF, l_ = 0.f, o[4] = {0.f, 0.f, 0.f, 0.f};
            for (int s = 0; s < 16; ++s) { if (!selv[g * 16 + s]) continue; const int j = sel[g * 16 + s]; const int kend = (t - 64 * j >= 63) ? 63 : t - 64 * j;
#pragma unroll 4
                for (int c = 0; c <= kend; ++c) { const int pos = 64 * j + c; float kk[4], vv[4]; ld4bf(kvb + (size_t)pos * 768 + 256, kk); ld4bf(kvb + (size_t)pos * 768 + 384, vv);
                    coop_attend<4>(q, kk, vv, I.rel_bias[rel_bucket(t - pos) * 12 + hh], m_, l_, o); } }
            const float il = l_ > 0.f ? 1.f / l_ : 0.f;
#pragma unroll
            for (int i = 0; i < 4; ++i) res[i] = gate0 * oc[i] + gate1 * (o[i] * il);
            m_ = NEGF; l_ = 0.f; o[0] = o[1] = o[2] = o[3] = 0.f;
            const int lo = (t - 511 > 0) ? t - 511 : 0;
#pragma unroll 4
            for (int pos = lo; pos <= t; ++pos) { float kk[4], vv[4]; ld4bf(kvb + (size_t)pos * 768 + 512, kk); ld4bf(kvb + (size_t)pos * 768 + 640, vv);
                coop_attend<4>(q, kk, vv, I.rel_bias[rel_bucket(t - pos) * 12 + hh], m_, l_, o); }
            const float il2 = 1.f / l_;
#pragma unroll
            for (int i = 0; i < 4; ++i) res[i] += gate2 * (o[i] * il2);
            *(uint2*)(CAT + (size_t)row * 1024 + hh * 64 + 4 * l16) = make_uint2(pk2(res[0], res[1]), pk2(res[2], res[3]));
        } else {
            const int hm = hh - 12; const float* kb_ = MKV + (size_t)(b * 256) * 512 + hm * 64 + 4 * l16;
            float m_ = NEGF, l_ = 0.f, o[4] = {0.f, 0.f, 0.f, 0.f};
#pragma unroll 4
            for (int mm = 0; mm < 256; ++mm) { float kk[4], vv[4]; ld4f(kb_ + (size_t)mm * 512, kk); ld4f(kb_ + (size_t)mm * 512 + 256, vv); coop_attend<4>(q, kk, vv, 0.f, m_, l_, o); }
            const float il = 1.f / l_;
            *(uint2*)(CAT + (size_t)row * 1024 + 768 + hm * 64 + 4 * l16) = make_uint2(pk2(o[0] * il, o[1] * il), pk2(o[2] * il, o[3] * il));
        }
        __syncthreads();
    }
}

__device__ __forceinline__ void p10_dsa_norm(Frame& F, const In& I, unsigned char* ws) {
    OPAQUE_TID(); const int gw = F.vcu * NWAVES + (tid_ >> 6), NGW = F.G * NWAVES, lane = tid_ & 63;
    const bf16* PR = (const bf16*)(ws + WS_PROJ1); bf16* CQ = (bf16*)(ws + WS_CQ); bf16* CKV = (bf16*)(ws + WS_CKV); bf16* KIDX = (bf16*)(ws + WS_KIDX); float* WIDX = (float*)(ws + WS_WIDX);
    for (int m = gw; m < M; m += NGW) {
        const bf16* pr = PR + (size_t)m * 768;
        float a[4]; ld4bf(pr + 4 * lane, a);
        float s = wave_sum(a[0] * a[0] + a[1] * a[1] + a[2] * a[2] + a[3] * a[3]); float r = rsqrtf(s * (1.f / 256.f) + EPSF);
        const float4 gq = *(const float4*)(I.q_norm + 4 * lane);
        *(uint2*)(CQ + (size_t)m * 256 + 4 * lane) = make_uint2(pk2((a[0] * r) * gq.x, (a[1] * r) * gq.y), pk2((a[2] * r) * gq.z, (a[3] * r) * gq.w));
        const unsigned u = *(const unsigned*)(pr + 256 + 2 * lane); const float c0 = bflo(u), c1 = bfhi(u);
        s = wave_sum(c0 * c0 + c1 * c1); r = rsqrtf(s * (1.f / 128.f) + EPSF);
        *(unsigned*)(CKV + (size_t)m * 128 + 2 * lane) = pk2((c0 * r) * I.kv_norm[2 * lane], (c1 * r) * I.kv_norm[2 * lane + 1]);
        const float k0 = bf2f(pr[384 + lane]);
        s = wave_sum(k0 * k0); r = rsqrtf(s * (1.f / 64.f) + EPSF);
        KIDX[(size_t)m * 64 + lane] = (bf16)f2bf((k0 * r) * I.kidx_norm[lane]);
        if (lane < 8) WIDX[(size_t)m * 8 + lane] = bf2f(pr[448 + lane]) * (0.35355339059327373f * 0.125f);
    }
}

__device__ __forceinline__ unsigned f2key(float f) { f = f + 0.f; const unsigned u = __float_as_uint(f); return (u & 0x80000000u) ? ~u : (u | 0x80000000u); }
__device__ __forceinline__ void p12_dsa_index(Frame& F, const In& I, unsigned char* ws) {
    OPAQUE_TID(); const int lane_ = tid_ & 63;
    const int hb = tid_ >> 8, t256 = tid_ & 255, ghb = blockIdx.x * 2 + hb, NHB = F.G * 2;
    LAS unsigned char* base = F.lds + RING_OFF + hb * 65536;
    LAS unsigned* keys = (LAS unsigned*)base;
    LAS unsigned short* ties = (LAS unsigned short*)(base + 32768);
    LAS float* qs = (LAS float*)(base + 49152);
    LAS float* wsh = (LAS float*)(base + 51200);
    LAS unsigned* hist = (LAS unsigned*)(base + 51232);
    LAS unsigned* shv = (LAS unsigned*)(base + 52256);
    const bf16* QI = (const bf16*)(ws + WS_QI); const bf16* KIDX = (const bf16*)(ws + WS_KIDX); const float* WIDX = (const float*)(ws + WS_WIDX);
    unsigned short* SEL = (unsigned short*)(ws + WS_SEL); int* CNT = (int*)(ws + WS_CNT);
    const int iters = (M + NHB - 1) / NHB;
    for (int it = 0; it < iters; ++it) {
        const int row = it * NHB + ghb, b = row / T, t = row % T; const bool big = t >= 256;
        unsigned short* so = SEL + (size_t)row * 256;
        if (!big) { so[t256] = (unsigned short)((t256 <= t) ? t256 : 0); if (t256 == 0) CNT[row] = t + 1; }
        for (int i = t256; i < 512; i += 256) qs[i] = bf2f(QI[(size_t)row * 512 + i]);
        if (t256 < 8) wsh[t256] = WIDX[(size_t)row * 8 + t256];
        if (t256 == 0) { shv[0] = 0u; shv[1] = 256u; shv[2] = 0u; shv[3] = 0u; }
        __syncthreads();
        if (big) for (int s = t256; s <= t; s += 256) {
            const bf16* kr = KIDX + (size_t)(b * T + s) * 64; float acc[8] = {0.f, 0.f, 0.f, 0.f, 0.f, 0.f, 0.f, 0.f};
#pragma unroll 2
            for (int c = 0; c < 8; ++c) { float k8[8]; ld8bf(kr + 8 * c, k8);
#pragma unroll
                for (int h = 0; h < 8; ++h)
#pragma unroll
                    for (int d = 0; d < 8; ++d) acc[h] += qs[h * 64 + 8 * c + d] * k8[d]; }
            float scv = 0.f;
#pragma unroll
            for (int h = 0; h < 8; ++h) scv += fmaxf(acc[h], 0.f) * wsh[h];
            keys[s] = f2key(scv);
        }
        __syncthreads();
        for (int pass = 0; pass < 4; ++pass) {
            const int shift = 24 - 8 * pass;
            hist[t256] = 0u;
            __syncthreads();
            const unsigned prefix = shv[0], himask = (pass == 0) ? 0u : (0xFFFFFFFFu << (shift + 8));
            if (big) for (int s = t256; s <= t; s += 256) { const unsigned k = keys[s]; if ((k & himask) == prefix) atomicAdd((unsigned*)&hist[(k >> shift) & 255u], 1u); }
            __syncthreads();
            if (t256 == 0) { unsigned kk = shv[1], cum = 0u; int d = 255;
                for (; d > 0; --d) { const unsigned hv = hist[d]; if (cum + hv >= kk) break; cum += hv; }
                shv[1] = kk - cum; shv[0] = prefix | ((unsigned)d << shift); }
            __syncthreads();
        }
        const unsigned tau = shv[0], kk = shv[1];
        if (big) for (int s = t256; s <= t; s += 256) { const unsigned k = keys[s];
            if (k > tau) { const unsigned p = atomicAdd((unsigned*)&shv[2], 1u); so[p] = (unsigned short)s; }
            else if (k == tau) { const unsigned p = atomicAdd((unsigned*)&shv[3], 1u); ties[p] = (unsigned short)s; } }
        __syncthreads();
        if (big) { const unsigned nt = shv[3], bs = shv[2];
            for (unsigned i = t256; i < nt; i += 256) { const unsigned me = ties[i]; unsigned rank = 0u;
                for (unsigned j = 0; j < nt; ++j) rank += (ties[j] < me) ? 1u : 0u;
                if (rank < kk) so[bs + rank] = (unsigned short)me; }
            if (t256 == 0) CNT[row] = 256; }
        __syncthreads();
    }
}

__device__ __forceinline__ void p13_dsa_attn(Frame& F, const In& I, unsigned char* ws) {
    OPAQUE_TID(); const int lane_ = tid_ & 63;
    const int hb = tid_ >> 8, t256 = tid_ & 255, hh = t256 >> 4, l16 = t256 & 15, ghb = blockIdx.x * 2 + hb, NHB = F.G * 2;
    LAS unsigned char* base = F.lds + RING_OFF + hb * 65536;
    LAS float* ol = (LAS float*)base;
    LAS int* sidx = (LAS int*)(base + 6144);
    const bf16* QA = (const bf16*)(ws + WS_QA); const bf16* CKV = (const bf16*)(ws + WS_CKV); const bf16* PR = (const bf16*)(ws + WS_PROJ1);
    const unsigned short* SEL = (const unsigned short*)(ws + WS_SEL); const int* CNT = (const int*)(ws + WS_CNT); const float* MKV = (const float*)(ws + WS_MKV) + (size_t)512 * 512;
    bf16* CAT = (bf16*)(ws + WS_CAT);
    const int iters = (M + NHB - 1) / NHB;
    for (int it = 0; it < iters; ++it) {
        const int row = it * NHB + ghb, b = row / T, t = row % T;
        const int cnt = CNT[row];
        sidx[t256] = (t256 < cnt) ? (int)SEL[(size_t)row * 256 + t256] : 0;
        __syncthreads();
        if (hh < 12) {
            float q[8]; ld8bf(QA + (size_t)row * 1536 + hh * 128 + 8 * l16, q);
            const bf16* cb = CKV + (size_t)b * T * 128 + 8 * l16;
            float m_ = NEGF, l_ = 0.f, o[8] = {0.f, 0.f, 0.f, 0.f, 0.f, 0.f, 0.f, 0.f};
#pragma unroll 4
            for (int i = 0; i < cnt; ++i) { const int idx = sidx[i]; float kk[8]; ld8bf(cb + (size_t)idx * 128, kk);
                coop_attend<8>(q, kk, kk, I.rel_bias[rel_bucket(t - idx) * 12 + hh], m_, l_, o); }
            const float il = 1.f / l_;
#pragma unroll
            for (int i = 0; i < 8; ++i) ol[hh * 128 + 8 * l16 + i] = o[i] * il;
        } else {
            const int hm = hh - 12; float q[4]; ld4bf(PR + (size_t)row * 768 + 456 + hm * 64 + 4 * l16, q);
#pragma unroll
            for (int i = 0; i < 4; ++i) q[i] *= 0.125f;
            const float* kb_ = MKV + (size_t)(b * 256) * 512 + hm * 64 + 4 * l16;
            float m_ = NEGF, l_ = 0.f, o[4] = {0.f, 0.f, 0.f, 0.f};
#pragma unroll 4
            for (int mm = 0; mm < 256; ++mm) { float kk[4], vv[4]; ld4f(kb_ + (size_t)mm * 512, kk); ld4f(kb_ + (size_t)mm * 512 + 256, vv); coop_attend<4>(q, kk, vv, 0.f, m_, l_, o); }
            const float il = 1.f / l_;
            *(uint2*)(CAT + (size_t)row * 1024 + 768 + hm * 64 + 4 * l16) = make_uint2(pk2(o[0] * il, o[1] * il), pk2(o[2] * il, o[3] * il));
        }
        __syncthreads();
        for (int i = t256; i < 768; i += 256) { const int h = i >> 6; float a = 0.f; const float* w = I.w_uv + i;
#pragma unroll 8
            for (int r = 0; r < 128; ++r) a += ol[h * 128 + r] * w[(size_t)r * 768];
            CAT[(size_t)row * 1024 + i] = (bf16)f2bf(a); }
        __syncthreads();
    }
}

struct Args { In in; float* out; unsigned char* ws; int ph_lo, ph_hi; };
__global__ void __launch_bounds__(NWAVES * 64, 2) mk_fwd(Args args) {
    extern __shared__ __attribute__((aligned(16))) unsigned char lds[];
    Frame F;
    F.lds = (LAS unsigned char*)lds; F.MISC = (volatile LAS unsigned*)(F.lds + MISC_OFF);
    F.tid = threadIdx.x; F.lane = F.tid & 63; F.wave = __builtin_amdgcn_readfirstlane(F.tid >> 6);
    F.G = gridDim.x; { const int bx = blockIdx.x; F.vcu = (F.G % 8 == 0) ? (bx % 8) * (F.G / 8) + bx / 8 : bx; }
    unsigned char* ws = args.ws; const In& I = args.in; float* out = args.out;
    F.ctl = (gu32*)(ws + WS_CTL);
    for (int u = F.tid; u < (LDS_BYTES - LDSCTL_OFF) / 4; u += NWAVES * 64) ((LAS unsigned*)(F.lds + LDSCTL_OFF))[u] = 0u;
    __syncthreads();
    XcdBarrier bar; bar.bar = (unsigned*)(F.ctl + CW_BAR); bar.x = 0; bar.st = nullptr;
    if (!MK_SPLIT) bar = xcd_barrier_post((unsigned*)(F.ctl + CW_BAR), F.MISC + 8);
    const int lo = args.ph_lo, hi = args.ph_hi;
#ifndef PH_MASK
#define PH_MASK 0xFFFFFFFFu
#endif
#define IN(k) ((((PH_MASK) >> ((k) % 32)) & 1u) && lo <= (k) && (k) < hi)
#define SEAM(k) do { if (IN(k) && IN((k) + 1)) xcd_barrier(bar); } while (0)
    bf16* XN = (bf16*)(ws + WS_XN); bf16* CAT = (bf16*)(ws + WS_CAT); bf16* ACT = (bf16*)(ws + WS_ACT);

    if (IN(0)) { p0_prologue(F, I, ws); SEAM(0); }
#pragma unroll 1
    for (int L = 0; L < 2; ++L) {
        if (L == 0) {
            if (IN(1)) {
                pg8::Gemm g{XN, (const bf16*)(ws + WS_WIN0), M, 2048, D}; pg8::StaticOrder S; S.init(M, 2048, F.G, (int)blockIdx.x);
                pg8::EpiRoute<0> E{ws};
                pg8::gemm_phase<pg8::EpiRoute<0>, pg8::StaticOrder, true, true>(F.lds + RING_OFF, g, S, E);
                SEAM(1);
            }
            if (IN(2)) { p2_small(F, I, ws); SEAM(2); }
            if (IN(3)) { p3_nsa_attn(F, I, ws); SEAM(3); }
        } else {
            if (IN(9)) {
                pg8::Gemm g{XN, (const bf16*)(ws + WS_WIN1), M, 768, D}; pg8::StaticOrder S; S.init(M, 768, F.G, (int)blockIdx.x);
                pg8::EpiRoute<1> E{ws};
                pg8::gemm_phase<pg8::EpiRoute<1>, pg8::StaticOrder, true, true>(F.lds + RING_OFF, g, S, E);
                SEAM(9);
            }
            if (IN(10)) { p10_dsa_norm(F, I, ws); SEAM(10); }
            if (IN(11)) {
                pg8::Gemm g{(const bf16*)(ws + WS_CQ), (const bf16*)(ws + WS_WQ2), M, 2048, 256}; pg8::StaticOrder S; S.init(M, 2048, F.G, (int)blockIdx.x);
                pg8::EpiRoute<2> E{ws};
                pg8::gemm_phase<pg8::EpiRoute<2>, pg8::StaticOrder, true, true>(F.lds + RING_OFF, g, S, E);
                SEAM(11);
            }
            if (IN(12)) { p12_dsa_index(F, I, ws); SEAM(12); }
            if (IN(13)) { p13_dsa_attn(F, I, ws); SEAM(13); }
        }
        const int pb = L ? 14 : 4;
        if (IN(pb)) {
            pg8::Gemm g{CAT, (const bf16*)(ws + WS_WO) + (size_t)L * D * D, M, D, D}; pg8::StaticOrder S; S.init(M, D, F.G, (int)blockIdx.x);
            pg8::EpiResid E{L ? (const float*)out : I.x, out, D, 0};
            pg8::gemm_phase<pg8::EpiResid, pg8::StaticOrder, true, true>(F.lds + RING_OFF, g, S, E);
            SEAM(pb);
        }
        if (IN(pb + 1)) { norm_phase(F, out, I.norm_ffn + L * D, XN); SEAM(pb + 1); }
        if (IN(pb + 2)) {
            pg8::Gemm g{XN, (const bf16*)(ws + WS_WGU) + (size_t)L * 2 * DFF * D, M, 2 * DFF, D}; pg8::StaticOrder S; S.init(M, 2 * DFF, F.G, (int)blockIdx.x);
            pg8::EpiSwiglu E{ACT, DFF, 0};
            pg8::gemm_phase<pg8::EpiSwiglu, pg8::StaticOrder, true, true>(F.lds + RING_OFF, g, S, E);
            SEAM(pb + 2);
        }
        if (IN(pb + 3)) {
            pg8::Gemm g{ACT, (const bf16*)(ws + WS_WD) + (size_t)L * D * DFF, M, D, DFF}; pg8::StaticOrder S; S.init(M, D, F.G, (int)blockIdx.x);
            pg8::EpiResid E{out, out, D, 0};
            pg8::gemm_phase<pg8::EpiResid, pg8::StaticOrder, true, true>(F.lds + RING_OFF, g, S, E);
            SEAM(pb + 3);
        }
        if (L == 0 && IN(8)) { norm_phase(F, out, I.norm_mix + D, XN); SEAM(8); }
    }
    if (IN(18)) {
        OPAQUE_TID(); const int lane_ = tid_ & 63;
        const int gw = F.vcu * NWAVES + (tid_ >> 6), NGW = F.G * NWAVES;
        for (int m = gw; m < M; m += NGW) { GAS f32x4* xr = (GAS f32x4*)(out + (size_t)m * D) + lane_; const GAS f32x4* gr = (const GAS f32x4*)I.norm_final + lane_;
            f32x4 v[4]; float s = 0.f;
#pragma unroll
            for (int j = 0; j < 4; ++j) { v[j] = xr[64 * j]; s += (v[j].x * v[j].x + v[j].y * v[j].y) + (v[j].z * v[j].z + v[j].w * v[j].w); }
            const float r = rsqrtf(wave_sum(s) * (1.f / D) + EPSF);
#pragma unroll
            for (int j = 0; j < 4; ++j) { const f32x4 g = gr[64 * j]; xr[64 * j] = (v[j] * r) * g; } }
    }
#undef IN
#undef SEAM
}

extern "C" void kernel_launch(void* const* d_in, const int* in_sizes, int n_in, void* d_out, int out_size, void* d_ws, size_t ws_size, hipStream_t stream) {
    static int grid = 0;
    if (grid == 0) {
        if (n_in != 32 || out_size != M * D || ws_size < WS_END) { fprintf(stderr, "kernel_launch: unexpected shapes (n_in %d out %d ws %zu)\n", n_in, out_size, ws_size); grid = -1; return; }
        int dev = 0, cus = 0, per_cu = 0;
        if (hipGetDevice(&dev) != hipSuccess || hipDeviceGetAttribute(&cus, hipDeviceAttributeMultiprocessorCount, dev) != hipSuccess) { grid = -1; return; }
        if (hipFuncSetAttribute((const void*)mk_fwd, hipFuncAttributeMaxDynamicSharedMemorySize, LDS_BYTES) != hipSuccess) { grid = -1; return; }
        if (hipOccupancyMaxActiveBlocksPerMultiprocessor(&per_cu, (const void*)mk_fwd, NWAVES * 64, LDS_BYTES) != hipSuccess || per_cu < 1) fprintf(stderr, "kernel_launch: occupancy query reports %d\n", per_cu);
        (void)hipGetLastError();
        grid = cus;
        if (grid > 256) grid = 256;
    }
    if (grid < 0) return;
    if (hipMemsetAsync((char*)d_ws + WS_CTL, 0, CTL_ZERO_BYTES, stream) != hipSuccess) return;
    Args a{};
    const float** ip = (const float**)&a.in;
    for (int i = 0; i < 32; ++i) ip[i] = (const float*)d_in[i];
    a.out = (float*)d_out; a.ws = (unsigned char*)d_ws;
#if MK_SPLIT
    for (int k = 0; k < N_PHASES; ++k) { a.ph_lo = k; a.ph_hi = k + 1; hipLaunchKernelGGL(mk_fwd, dim3(grid), dim3(NWAVES * 64), LDS_BYTES, stream, a); }
#else
    a.ph_lo = 0; a.ph_hi = N_PHASES; hipLaunchKernelGGL(mk_fwd, dim3(grid), dim3(NWAVES * 64), LDS_BYTES, stream, a);
#endif
}
```

```cpp
#include <hip/hip_runtime.h>
#include <cstdio>
#include <cstdint>
#include <math.h>

namespace pg8 {
#define PG8_LAS __attribute__((address_space(3)))
typedef unsigned short bf16_t;
typedef short bf16x8 __attribute__((ext_vector_type(8)));
typedef float f32x4 __attribute__((ext_vector_type(4)));
typedef unsigned u32x4 __attribute__((ext_vector_type(4)));
constexpr int BM = 256, BK = 64, HALF = 128, HTB = HALF * BK * 2  , STAGE_BYTES = 8 * HTB, NXCD = 8, WGM = 8;

__host__ __device__ __forceinline__ int lds_byte(int r, int c) { const int st = (r >> 4) * 2 + (c >> 5), rr = r & 15, cc = c & 31, ob = rr * 64 + cc * 2; return st * 1024 + (ob ^ (((ob >> 9) & 1) << 5)); }
__host__ __device__ __forceinline__ void stage_rc(int b, int& R, int& C) { const int st = b / 1024, sb = b % 1024, swz = sb ^ (((sb >> 9) & 1) << 5); R = (st >> 1) * 16 + swz / 64; C = (st & 1) * 32 + (swz % 64) / 2; }
__host__ __device__ __forceinline__ int perm32(int rho) { const int n = rho >> 4, i = rho & 15; return 8 * (i >> 2) + 4 * n + (i & 3); }

struct Unit { int pm, pn; };
struct Gemm { const bf16_t* A; const bf16_t* Bt; int M, N, K; };

struct StaticOrder {
    int nM, nN, nwg, G, c;
    __host__ __device__ void init(int M, int N, int G_, int c_) { nM = M / BM; nN = N / BM; nwg = nM * nN; G = G_; c = c_; }
    __host__ __device__ bool next(int i, Unit& u) const {
        const long L = (long)i * G + c; if (L >= nwg) return false;
        int wgid = (int)L; { const int q = nwg / NXCD, r = nwg % NXCD, xcd = wgid % NXCD, off = wgid / NXCD; wgid = (xcd < r ? xcd * (q + 1) : r * (q + 1) + (xcd - r) * q) + off; }
        const int nig = WGM * nN, gid = wgid / nig, fm = gid * WGM, gsz = (nM - fm) < WGM ? (nM - fm) : WGM;
        u.pm = fm + ((wgid % nig) % gsz); u.pn = (wgid % nig) / gsz; return true;
    }
    __device__ __forceinline__ void a_ready(const Unit&) const {}
    __device__ __forceinline__ void done(const Unit&) const {}
};

__device__ __forceinline__ unsigned cvt_pk_bf16(float lo, float hi) { unsigned r; asm volatile("v_cvt_pk_bf16_f32 %0, %1, %2" : "=v"(r) : "v"(lo), "v"(hi)); return r; }
template <int ROUTE> struct EpiRoute {
    static constexpr bool PERM = true, AFTER_DRAIN = false;
    unsigned char* ws;
    __device__ __forceinline__ void operator()(const f32x4 (&acc)[2][2][4][2], const Unit& u, int wr, int wc, int fr, int fq) const {
        asm volatile("" : "+v"(fr), "+v"(fq));
        const int pn = u.pn; size_t off; int ld, t0; float sc;
        if constexpr (ROUTE == 0) {
            off = pn < 3 ? (size_t)(88u << 20) : pn < 5 ? (size_t)(112u << 20) : pn < 6 ? (size_t)(136u << 20) : (size_t)(144u << 20);
            ld = pn < 3 ? 768 : pn < 5 ? 512 : 256; t0 = pn < 3 ? 0 : pn < 5 ? 3 : pn < 6 ? 5 : 6; sc = (pn < 3 || pn == 5) ? 0.18033688011112042f : 1.f;
        } else if constexpr (ROUTE == 1) { off = (size_t)(88u << 20); ld = 768; t0 = 0; sc = 1.f; }
        else if constexpr (ROUTE == 3) { off = (size_t)(152u << 20); ld = 16384; t0 = 0; sc = 1.f; }
        else { off = pn < 6 ? (size_t)(128u << 20) : (size_t)(176u << 20); ld = pn < 6 ? 1536 : 512; t0 = pn < 6 ? 0 : 6; sc = 1.f; }
        bf16_t* base = (bf16_t*)(ws + off);
        const int row0 = u.pm * BM + wr * 64 + fr, col0 = (pn - t0) * BM + wc * 32 + 8 * fq;
#pragma unroll
        for (int ai = 0; ai < 2; ++ai)
#pragma unroll
            for (int m = 0; m < 4; ++m) { bf16_t* rowp = base + (size_t)(row0 + ai * HALF + m * 16) * ld + col0;
#pragma unroll
                for (int bj = 0; bj < 2; ++bj) { const f32x4 v0 = acc[ai][bj][m][0] * sc, v1 = acc[ai][bj][m][1] * sc;
                    u32x4 w; w.x = cvt_pk_bf16(v0[0], v0[1]); w.y = cvt_pk_bf16(v0[2], v0[3]); w.z = cvt_pk_bf16(v1[0], v1[1]); w.w = cvt_pk_bf16(v1[2], v1[3]);
                    *(u32x4*)(rowp + bj * HALF) = w; } }
    }
};
struct EpiResid {
    static constexpr bool PERM = true, AFTER_DRAIN = false;
    const float* res; float* out; int ldc; int pad;
    __device__ __forceinline__ void operator()(const f32x4 (&acc)[2][2][4][2], const Unit& u, int wr, int wc, int fr, int fq) const {
        asm volatile("" : "+v"(fr), "+v"(fq));
        const int row0 = u.pm * BM + wr * 64 + fr, col0 = u.pn * BM + wc * 32 + 8 * fq;
#pragma unroll
        for (int ai = 0; ai < 2; ++ai)
#pragma unroll
            for (int m = 0; m < 4; ++m) { const size_t off = (size_t)(row0 + ai * HALF + m * 16) * ldc + col0;
#pragma unroll
                for (int bj = 0; bj < 2; ++bj)
#pragma unroll
                    for (int n = 0; n < 2; ++n) { const f32x4 r = *(const f32x4*)(res + off + bj * HALF + 4 * n); *(f32x4*)(out + off + bj * HALF + 4 * n) = r + acc[ai][bj][m][n]; } }
    }
};
struct EpiSwiglu {
    static constexpr bool PERM = true, AFTER_DRAIN = false;
    bf16_t* O; int ldc; int pad;
    __device__ __forceinline__ void operator()(const f32x4 (&acc)[2][2][4][2], const Unit& u, int wr, int wc, int fr, int fq) const {
        asm volatile("" : "+v"(fr), "+v"(fq));
        const int row0 = u.pm * BM + wr * 64 + fr, col0 = u.pn * HALF + wc * 32 + 8 * fq;
#pragma unroll
        for (int ai = 0; ai < 2; ++ai)
#pragma unroll
            for (int m = 0; m < 4; ++m) { float o[8];
#pragma unroll
                for (int n = 0; n < 2; ++n)
#pragma unroll
                    for (int e = 0; e < 4; ++e) { const float g = acc[ai][0][m][n][e], up = acc[ai][1][m][n][e]; o[4 * n + e] = (g * __builtin_amdgcn_rcpf(1.f + __expf(-g))) * up; }
                u32x4 w; w.x = cvt_pk_bf16(o[0], o[1]); w.y = cvt_pk_bf16(o[2], o[3]); w.z = cvt_pk_bf16(o[4], o[5]); w.w = cvt_pk_bf16(o[6], o[7]);
                *(u32x4*)(O + (size_t)(row0 + ai * HALF + m * 16) * ldc + col0) = w; }
    }
};
template <class Epi, class Sched, bool ALIGN_EPI = false, bool SP2 = false>
__device__ __forceinline__ void gemm_phase(PG8_LAS unsigned char* lds, const Gemm g, const Sched& S, const Epi& E) {
    int tid = threadIdx.x; asm volatile("" : "+v"(tid));
    const int wid = __builtin_amdgcn_readfirstlane(tid >> 6), lane = tid & 63, wr = wid >> 2, wc = wid & 3, fr = lane & 15, fq = lane >> 4;
    int K = g.K; asm volatile("" : "+s"(K));
    const int nt = K / BK;
    unsigned voffA[2], voffB[2];
#pragma unroll
    for (int i = 0; i < 2; ++i) { int R, C; stage_rc(tid * 16 + i * 8192, R, C); const int Rb = Epi::PERM ? ((R & ~31) + perm32(R & 31)) : R;
        voffA[i] = (unsigned)(R * K + C) * 2u; voffB[i] = (unsigned)(Rb * K + C) * 2u; }
    const size_t kstep = (size_t)(BK * 2);
    const size_t hstep = (size_t)HALF * K * 2;
    const size_t tstep = 2 * hstep;
    const unsigned ldsw = (unsigned)wid * 1024u;
    const int aoff = lds_byte(wr * 64 + fr, fq * 8), boff = lds_byte(wc * 32 + fr, fq * 8);
#define PG8_SA(b, h) (((b) * 2 + (h)) * HTB)
#define PG8_SB(b, h) ((4 + (b) * 2 + (h)) * HTB)
#define PG8_STAGE(bufoff, gbase, voff) do { _Pragma("unroll") for (int _i = 0; _i < 2; ++_i) \
        __builtin_amdgcn_global_load_lds((const unsigned*)((const char*)(gbase) + (voff)[_i]), (PG8_LAS unsigned*)(lds + (bufoff) + ldsw + _i * 8192), 16, 0, 0); } while (0)
#define PG8_LDA(dst, b, h) do { _Pragma("unroll") for (int m = 0; m < 4; ++m) _Pragma("unroll") for (int k = 0; k < 2; ++k) dst[m][k] = *(const PG8_LAS bf16x8*)(lds + PG8_SA(b, h) + aoff + m * 2048 + k * 1024); } while (0)
#define PG8_LDB(dst, b, h) do { _Pragma("unroll") for (int n = 0; n < 2; ++n) _Pragma("unroll") for (int k = 0; k < 2; ++k) dst[n][k] = *(const PG8_LAS bf16x8*)(lds + PG8_SB(b, h) + boff + n * 2048 + k * 1024); } while (0)
#define PG8_MMA(ai, bj, At, Bt) do { __builtin_amdgcn_s_setprio(1); _Pragma("unroll") for (int m = 0; m < 4; ++m) _Pragma("unroll") for (int n = 0; n < 2; ++n) _Pragma("unroll") for (int k = 0; k < 2; ++k) \
        acc[ai][bj][m][n] = __builtin_amdgcn_mfma_f32_16x16x32_bf16(Bt[n][k], At[m][k], acc[ai][bj][m][n], 0, 0, 0); __builtin_amdgcn_s_setprio(0); } while (0)
#define PG8_WAIT_V(n) asm volatile("s_waitcnt vmcnt(" #n ")" ::: "memory")
#define PG8_WAIT_L(n) asm volatile("s_waitcnt lgkmcnt(" #n ")" ::: "memory")
#define PG8_BAR __builtin_amdgcn_s_barrier()
#define PG8_SCHED __builtin_amdgcn_sched_barrier(0)
    Unit cur, nxt; int ui = 0;
    if (!S.next(0, cur)) return;
    f32x4 acc[2][2][4][2];
#pragma unroll
    for (int a = 0; a < 2; ++a)
#pragma unroll
        for (int b = 0; b < 2; ++b)
#pragma unroll
            for (int m = 0; m < 4; ++m)
#pragma unroll
                for (int n = 0; n < 2; ++n) acc[a][b][m][n] = (f32x4){0.f, 0.f, 0.f, 0.f};
    bf16x8 At[4][2], B0[2][2], B1[2][2];
    const char* cA = (const char*)g.A + (size_t)cur.pm * tstep; const char* cB = (const char*)g.Bt + (size_t)cur.pn * tstep;
    S.a_ready(cur);
    if constexpr (SP2) {
        PG8_STAGE(PG8_SB(0, 0), cB, voffB); PG8_STAGE(PG8_SB(0, 1), cB + hstep, voffB); PG8_STAGE(PG8_SA(0, 0), cA, voffA); PG8_STAGE(PG8_SA(0, 1), cA + hstep, voffA);
        if (wr == 1) PG8_BAR;
        PG8_WAIT_V(2); PG8_BAR;
        PG8_STAGE(PG8_SB(1, 0), cB + kstep, voffB); PG8_STAGE(PG8_SA(1, 0), cA + kstep, voffA); PG8_STAGE(PG8_SB(1, 1), cB + hstep + kstep, voffB);
        PG8_WAIT_V(6); PG8_BAR;
    } else {
        PG8_STAGE(PG8_SB(0, 0), cB, voffB); PG8_STAGE(PG8_SA(0, 0), cA, voffA); PG8_STAGE(PG8_SB(0, 1), cB + hstep, voffB); PG8_STAGE(PG8_SA(0, 1), cA + hstep, voffA);
        if (wr == 1) PG8_BAR;
        PG8_WAIT_V(4); PG8_BAR;
        PG8_STAGE(PG8_SB(1, 0), cB + kstep, voffB); PG8_STAGE(PG8_SA(1, 0), cA + kstep, voffA); PG8_STAGE(PG8_SB(1, 1), cB + hstep + kstep, voffB);
        PG8_WAIT_V(6); PG8_BAR;
    }
    for (;;) {
        const bool has_next = S.next(ui + 1, nxt);
        const char* nA = has_next ? (const char*)g.A + (size_t)nxt.pm * tstep : cA; const char* nB = has_next ? (const char*)g.Bt + (size_t)nxt.pn * tstep : cB;
        for (int t = 0; t < nt; t += 2) {
            const bool last = (t == nt - 2);
            const char* a1 = cA + (size_t)(t + 1) * kstep;
            const char* a2 = last ? nA : cA + (size_t)(t + 2) * kstep; const char* b2 = last ? nB : cB + (size_t)(t + 2) * kstep;
            const char* a3 = a2 + kstep; const char* b3 = b2 + kstep;
            if (last && has_next) S.a_ready(nxt);
            if constexpr (SP2) {
            PG8_LDB(B0, 0, 0); PG8_LDB(B1, 0, 1); PG8_SCHED; PG8_LDA(At, 0, 0); PG8_STAGE(PG8_SA(1, 1), a1 + hstep, voffA);
            PG8_WAIT_V(8); PG8_WAIT_L(0); PG8_BAR; PG8_MMA(0, 0, At, B0); PG8_MMA(0, 1, At, B1); PG8_BAR; PG8_SCHED;
            PG8_LDA(At, 0, 1); PG8_STAGE(PG8_SB(0, 0), b2, voffB); PG8_STAGE(PG8_SB(0, 1), b2 + hstep, voffB); PG8_STAGE(PG8_SA(0, 0), a2, voffA);
            PG8_WAIT_V(8); PG8_WAIT_L(0); PG8_BAR; PG8_MMA(1, 0, At, B0); PG8_MMA(1, 1, At, B1); PG8_BAR; PG8_SCHED;
            PG8_LDB(B0, 1, 0); PG8_LDB(B1, 1, 1); PG8_SCHED; PG8_LDA(At, 1, 0); PG8_STAGE(PG8_SA(0, 1), a2 + hstep, voffA);
            PG8_WAIT_V(8); PG8_WAIT_L(0); PG8_BAR; PG8_MMA(0, 0, At, B0); PG8_MMA(0, 1, At, B1); PG8_BAR; PG8_SCHED;
            PG8_LDA(At, 1, 1); PG8_STAGE(PG8_SB(1, 0), b3, voffB); PG8_STAGE(PG8_SB(1, 1), b3 + hstep, voffB); PG8_STAGE(PG8_SA(1, 0), a3, voffA);
            PG8_WAIT_V(8); PG8_WAIT_L(0); PG8_BAR; PG8_MMA(1, 0, At, B0); PG8_MMA(1, 1, At, B1); PG8_BAR; PG8_SCHED;
            } else {
            PG8_LDB(B0, 0, 0); PG8_SCHED; PG8_LDA(At, 0, 0); PG8_STAGE(PG8_SA(1, 1), a1 + hstep, voffA);
            PG8_WAIT_L(8); PG8_BAR; PG8_WAIT_L(0); PG8_MMA(0, 0, At, B0); PG8_BAR; PG8_SCHED;
            PG8_LDB(B1, 0, 1); PG8_STAGE(PG8_SB(0, 0), b2, voffB);
            PG8_BAR; PG8_WAIT_L(0); PG8_MMA(0, 1, At, B1); PG8_BAR;
            PG8_LDA(At, 0, 1); PG8_STAGE(PG8_SA(0, 0), a2, voffA);
            PG8_BAR; PG8_WAIT_L(0); PG8_MMA(1, 0, At, B0); PG8_BAR; PG8_SCHED;
            PG8_STAGE(PG8_SB(0, 1), b2 + hstep, voffB);
            PG8_WAIT_V(6); PG8_BAR; PG8_MMA(1, 1, At, B1); PG8_BAR;
            PG8_LDB(B0, 1, 0); PG8_SCHED; PG8_LDA(At, 1, 0); PG8_STAGE(PG8_SA(0, 1), a2 + hstep, voffA);
            PG8_WAIT_L(8); PG8_BAR; PG8_WAIT_L(0); PG8_MMA(0, 0, At, B0); PG8_BAR; PG8_SCHED;
            PG8_LDB(B1, 1, 1); PG8_STAGE(PG8_SB(1, 0), b3, voffB);
            PG8_BAR; PG8_WAIT_L(0); PG8_MMA(0, 1, At, B1); PG8_BAR;
            PG8_LDA(At, 1, 1); PG8_STAGE(PG8_SA(1, 0), a3, voffA);
            PG8_BAR; PG8_WAIT_L(0); PG8_MMA(1, 0, At, B0); PG8_BAR; PG8_SCHED;
            PG8_STAGE(PG8_SB(1, 1), b3 + hstep, voffB);
            PG8_WAIT_V(6); PG8_BAR; PG8_MMA(1, 1, At, B1); PG8_BAR;
            }
        }
        if constexpr (ALIGN_EPI) { if (wr == 0) PG8_BAR; }
        if constexpr (!Epi::AFTER_DRAIN) { E(acc, cur, wr, wc, fr, fq); S.done(cur); }
        if (!has_next) break;
#pragma unroll
        for (int a = 0; a < 2; ++a)
#pragma unroll
            for (int b = 0; b < 2; ++b)
#pragma unroll
                for (int m = 0; m < 4; ++m)
#pragma unroll
                    for (int n = 0; n < 2; ++n) acc[a][b][m][n] = (f32x4){0.f, 0.f, 0.f, 0.f};
        cur = nxt; cA = nA; cB = nB; ++ui;
        if constexpr (ALIGN_EPI) { if (wr == 1) PG8_BAR; }
    }
    PG8_WAIT_V(0);
    if constexpr (!ALIGN_EPI) { if (wr == 0) PG8_BAR; }
    PG8_BAR;
    if constexpr (Epi::AFTER_DRAIN) { E.fused(acc, cur, wr, wc, fr, fq, lds, wid, lane); S.done(cur); }
#undef PG8_SA
#undef PG8_SB
#undef PG8_STAGE
#undef PG8_LDA
#undef PG8_LDB
#undef PG8_MMA
#undef PG8_WAIT_V
#undef PG8_WAIT_L
#undef PG8_BAR
#undef PG8_SCHED
}
}
constexpr int NWAVES = 8;
constexpr int BATCH = 2, T = 8192, D = 1024, M = BATCH * T, DFF = 2816, NSA_IN = 1828, DSA_IN = 712, NCMP = 511, NCR = BATCH * NCMP * 2;
constexpr float NEGF = -1e30f, EPSF = 1e-6f;
#ifndef MK_SPLIT
#define MK_SPLIT 0
#endif
constexpr int N_PHASES = 19;
constexpr size_t MiB = 1u << 20;
constexpr size_t WS_CTL = 0, CTL_ZERO_BYTES = 1 * MiB;
constexpr size_t WS_KCB = 1 * MiB  , WS_VCT = 1 * MiB + 512 * 1024  , WS_MKB = 2 * MiB  , WS_MVT = 2 * MiB + 512 * 1024  , WS_MKV = 3 * MiB  , WS_WIDX = 5 * MiB  , WS_CNT = 6 * MiB  ;
constexpr size_t WS_WIN0 = 8 * MiB, WS_WO = 12 * MiB, WS_WGU = 16 * MiB, WS_WD = 38 * MiB, WS_WIN1 = 49 * MiB, WS_WQ2 = 51 * MiB, WS_WVT = 52 * MiB  ;
constexpr size_t WS_XN = 56 * MiB;
constexpr size_t WS_Q0 = 88 * MiB, WS_KV0 = 112 * MiB  , WS_QM = 136 * MiB, WS_G0 = 144 * MiB, WS_VT = 152 * MiB  ;
static_assert(WS_Q0 == (88u << 20) && WS_KV0 == (112u << 20) && WS_QM == (136u << 20) && WS_G0 == (144u << 20), "EpiRoute tables");
constexpr size_t WS_ACT = 88 * MiB;
constexpr size_t WS_PROJ1 = 88 * MiB, WS_CQ = 112 * MiB, WS_CKV = 120 * MiB, WS_KIDX = 124 * MiB, WS_QA = 128 * MiB, WS_QI = 176 * MiB, WS_SEL = 192 * MiB;
constexpr size_t WS_CAT = 200 * MiB, WS_END = 232 * MiB;
static_assert(WS_PROJ1 == (88u << 20) && WS_QA == (128u << 20) && WS_QI == (176u << 20) && WS_VT == (152u << 20), "EpiRoute tables");
static_assert(WS_ACT + (size_t)M * DFF * 2 <= WS_CAT + 0 * MiB || true, "map");
constexpr int CW_BAR = 4096;
constexpr int RING_OFF = 0, RING_BYTES = 131072, LDSCTL_OFF = RING_BYTES, MISC_OFF = LDSCTL_OFF + 320, LDS_BYTES = 147456;
#define GAS __attribute__((address_space(1)))
#define LAS __attribute__((address_space(3)))
typedef unsigned short bf16;
typedef unsigned v4u __attribute__((ext_vector_type(4)));
typedef float f32x4 __attribute__((ext_vector_type(4)));
typedef short bf16x8 __attribute__((ext_vector_type(8)));
typedef GAS unsigned gu32;
typedef GAS unsigned long long gu64;
#define RLX_AGENT __ATOMIC_RELAXED, __HIP_MEMORY_SCOPE_AGENT
#define LDS_WAIT() asm volatile("s_waitcnt lgkmcnt(0)" ::: "memory")
#define VM_WAIT() asm volatile("s_waitcnt vmcnt(0)" ::: "memory")
__device__ __forceinline__ unsigned long long rt() { return __builtin_amdgcn_s_memrealtime(); }
__device__ __forceinline__ unsigned f2bf(float f) { unsigned u = __builtin_bit_cast(unsigned, f); return (u + 0x7fffu + ((u >> 16) & 1u)) >> 16; }
__device__ __forceinline__ unsigned pk2(float lo, float hi) { return f2bf(lo) | (f2bf(hi) << 16); }
#define XB_TMO      128
#define XB_XCNT(j)  (256  + 64 * (j))
#define XB_XSUB(j)  (1280 + 64 * (j))
#define XB_XGEN(j)  (2304 + 64 * (j))
#define XB_TOP      3328
#define XB_TOPGEN   3392
#define XCD_BAR_WORDS 3456
#define XB_SPIN_CAP (1u << 18)

__device__ __forceinline__ unsigned xb_ld(unsigned* p)              { return __hip_atomic_load(p, __ATOMIC_RELAXED, __HIP_MEMORY_SCOPE_AGENT); }
__device__ __forceinline__ unsigned xb_add(unsigned* p, unsigned v) { return __hip_atomic_fetch_add(p, v, __ATOMIC_RELAXED, __HIP_MEMORY_SCOPE_AGENT); }
__device__ __forceinline__ unsigned xb_xcc_id() { return (unsigned)__builtin_amdgcn_s_getreg((3 << 11) | 20) & 0xFu; }
#define XB_SPIN(cond, bar) do { unsigned _sp = 0; while (cond) { __builtin_amdgcn_s_sleep(1); \
    if ((++_sp & 255u) == 0u) { if (xb_ld(&(bar)[XB_TMO])) break; if (_sp > XB_SPIN_CAP) { atomicAdd(&(bar)[XB_TMO], 1u); break; } } } } while (0)

struct XcdBarrier {
    unsigned* bar; unsigned x;
    volatile LAS unsigned* st;
};

__device__ __forceinline__ XcdBarrier xcd_barrier_post(unsigned* bar, volatile LAS unsigned* st) {
    XcdBarrier b; b.bar = bar; b.x = xb_xcc_id(); b.st = st;
    if (threadIdx.x == 0) (void)xb_add(&bar[XB_XCNT(b.x)], 1u);
    return b;
}
__device__ __forceinline__ void xcd_barrier_complete(unsigned* bar, unsigned x, unsigned& nloc, unsigned& nx) {
    const unsigned G = gridDim.x * gridDim.y * gridDim.z;
    unsigned sum, cnt, mine, sp = 0u;
    for (;;) {
        sum = 0u; cnt = 0u; mine = 0u;
#pragma unroll
        for (unsigned j = 0; j < 16; ++j) { const unsigned c = xb_ld(&bar[XB_XCNT(j)]); sum += c; cnt += (c > 0u) ? 1u : 0u; mine = (j == x) ? c : mine; }
        if (sum == G) break;
        __builtin_amdgcn_s_sleep(1);
        if ((++sp & 255u) == 0u) { if (xb_ld(&bar[XB_TMO])) break; if (sp > XB_SPIN_CAP) { atomicAdd(&bar[XB_TMO], 1u); break; } }
    }
    nloc = mine > 0u ? mine : 1u; nx = cnt > 0u ? cnt : 1u;
}

__device__ __forceinline__ void xcd_barrier(const XcdBarrier& b) {
    asm volatile("s_waitcnt vmcnt(0)" ::: "memory");
    __syncthreads();
    if (threadIdx.x == 0) {
        unsigned* bar = b.bar;
        __builtin_amdgcn_s_waitcnt(0);
        unsigned nloc = b.st[0], nx = b.st[1];
        if (nloc == 0u) { xcd_barrier_complete(bar, b.x, nloc, nx); b.st[0] = nloc; b.st[1] = nx; }
        const unsigned old = xb_add(&bar[XB_XSUB(b.x)], 1u);
        const unsigned gen = old / nloc;
        if (old + 1u == (gen + 1u) * nloc) {
            __builtin_amdgcn_fence(__ATOMIC_RELEASE, "agent");
            asm volatile("s_waitcnt vmcnt(0)" ::: "memory");
            const unsigned og = xb_add(&bar[XB_TOP], 1u);
            const unsigned tg = og / nx;
            if (og + 1u == (tg + 1u) * nx) xb_add(&bar[XB_TOPGEN], 1u);
            else XB_SPIN(xb_ld(&bar[XB_TOPGEN]) == tg, bar);
            __builtin_amdgcn_fence(__ATOMIC_ACQUIRE, "agent");
            xb_add(&bar[XB_XGEN(b.x)], 1u);
            asm volatile("s_waitcnt vmcnt(0)" ::: "memory");
        } else {
            XB_SPIN(xb_ld(&bar[XB_XGEN(b.x)]) == gen, bar);
            __builtin_amdgcn_fence(__ATOMIC_ACQUIRE, "agent");
            asm volatile("s_waitcnt vmcnt(0)" ::: "memory");
        }
    }
    __syncthreads();
}

struct Frame {
    LAS unsigned char* lds; volatile LAS unsigned* MISC; gu32* ctl;
    int tid, lane, wave, vcu, G;
};
__device__ __forceinline__ float bf2f(unsigned short u) { return __uint_as_float((unsigned)u << 16); }
__device__ __forceinline__ float bflo(unsigned u) { return __uint_as_float(u << 16); }
__device__ __forceinline__ float bfhi(unsigned u) { return __uint_as_float(u & 0xffff0000u); }
__device__ __forceinline__ float wave_sum(float v) {
#pragma unroll
    for (int o = 1; o < 64; o <<= 1) v += __shfl_xor(v, o);
    return v;
}
__device__ __forceinline__ float red16_sum(float v) { v += __shfl_xor(v, 1, 16); v += __shfl_xor(v, 2, 16); v += __shfl_xor(v, 4, 16); v += __shfl_xor(v, 8, 16); return v; }
__device__ __forceinline__ float red16_max(float v) { v = fmaxf(v, __shfl_xor(v, 1, 16)); v = fmaxf(v, __shfl_xor(v, 2, 16)); v = fmaxf(v, __shfl_xor(v, 4, 16)); v = fmaxf(v, __shfl_xor(v, 8, 16)); return v; }
__device__ __forceinline__ int rel_bucket(int n) {
    if (n < 16) return n;
    return 16 + (n >= 22) + (n >= 30) + (n >= 40) + (n >= 54) + (n >= 73) + (n >= 99) + (n >= 134) + (n >= 182) + (n >= 246) + (n >= 332) + (n >= 450) + (n >= 609) + (n >= 825) + (n >= 1117) + (n >= 1513);
}

__device__ __forceinline__ void xpose_item(const float* W, int ldw, int c0, int nvalid, int k0, bf16* WT, int Kd, int drow0, LAS float* scr, int lane) {
#pragma unroll 8
    for (int i = 0; i < 32; ++i) { const int kk = 2 * i + (lane >> 5), n = lane & 31; scr[kk * 33 + n] = (n < nvalid) ? W[(size_t)(k0 + kk) * ldw + c0 + n] : 0.f; }
    LDS_WAIT(); asm volatile("" ::: "memory");
    const int c = lane & 7;
#pragma unroll
    for (int j = 0; j < 4; ++j) { const int n = (lane >> 3) + 8 * j; const LAS float* s = scr + (8 * c) * 33 + n;
        v4u o; o.x = pk2(s[0 * 33], s[1 * 33]); o.y = pk2(s[2 * 33], s[3 * 33]); o.z = pk2(s[4 * 33], s[5 * 33]); o.w = pk2(s[6 * 33], s[7 * 33]);
        *(GAS v4u*)(WT + (size_t)(drow0 + n) * Kd + k0 + 8 * c) = o; }
    LDS_WAIT(); asm volatile("" ::: "memory");
}
__device__ __forceinline__ void rms_row_to_bf16(const float* xrow, const float* gain, bf16* orow, int lane) {
    const GAS f32x4* xr = (const GAS f32x4*)xrow + lane; const GAS f32x4* gr = (const GAS f32x4*)gain + lane;
    f32x4 v[4]; float s = 0.f;
#pragma unroll
    for (int j = 0; j < 4; ++j) { v[j] = xr[64 * j]; s += (v[j].x * v[j].x + v[j].y * v[j].y) + (v[j].z * v[j].z + v[j].w * v[j].w); }
    const float r = rsqrtf(wave_sum(s) * (1.f / D) + EPSF);
    GAS unsigned long long* o8 = (GAS unsigned long long*)orow + lane;
#pragma unroll
    for (int j = 0; j < 4; ++j) { const f32x4 g = gr[64 * j]; o8[64 * j] = (unsigned long long)pk2((v[j].x * r) * g.x, (v[j].y * r) * g.y) | ((unsigned long long)pk2((v[j].z * r) * g.z, (v[j].w * r) * g.w) << 32); }
}
#define OPAQUE_TID() int tid_ = threadIdx.x; asm volatile("" : "+v"(tid_))
__device__ __forceinline__ void norm_phase(Frame& F, const float* x, const float* gain, bf16* xn) {
    OPAQUE_TID(); const int lane_ = tid_ & 63, wave_ = tid_ >> 6;
    const int gw = F.vcu * NWAVES + wave_, NGW = F.G * NWAVES;
    for (int m = gw; m < M; m += NGW) rms_row_to_bf16(x + (size_t)m * D, gain, xn + (size_t)m * D, lane_);
}

template <int DL>
__device__ __forceinline__ void coop_attend(const float (&q)[DL], const float (&k)[DL], const float (&v)[DL], float bias, float& m_, float& l_, float (&o)[DL]) {
    float a = 0.f;
#pragma unroll
    for (int d = 0; d < DL; ++d) a += q[d] * k[d];
    a = red16_sum(a) + bias;
    const float mn = fmaxf(m_, a), al = __expf(m_ - mn), p = __expf(a - mn);
    l_ = l_ * al + p; m_ = mn;
#pragma unroll
    for (int d = 0; d < DL; ++d) o[d] = o[d] * al + p * v[d];
}
__device__ __forceinline__ void ld4bf(const bf16* p, float (&x)[4]) { const uint2 u = *(const uint2*)p; x[0] = bflo(u.x); x[1] = bfhi(u.x); x[2] = bflo(u.y); x[3] = bfhi(u.y); }
__device__ __forceinline__ void ld8bf(const bf16* p, float (&x)[8]) { const uint4 u = *(const uint4*)p; x[0] = bflo(u.x); x[1] = bfhi(u.x); x[2] = bflo(u.y); x[3] = bfhi(u.y); x[4] = bflo(u.z); x[5] = bfhi(u.z); x[6] = bflo(u.w); x[7] = bfhi(u.w); }
__device__ __forceinline__ void ld4f(const float* p, float (&x)[4]) { const float4 u = *(const float4*)p; x[0] = u.x; x[1] = u.y; x[2] = u.z; x[3] = u.w; }

struct In {
    const float *x, *mem, *rel_bias, *norm_mix, *norm_ffn, *norm_mem, *w_mem_kv, *w_out, *ffn_gate, *ffn_up, *ffn_down, *nsa_w_in, *nsa_gate_b, *pos_k, *pos_v,
        *k_w1, *k_b1, *k_w2, *k_b2, *v_w1, *v_b1, *v_w2, *v_b2, *dsa_w_in, *q_norm, *kv_norm, *w_q_up, *w_uk, *w_uv, *w_q_idx, *kidx_norm, *norm_final;
};
__device__ __forceinline__ void p0_prologue(Frame& F, const In& I, unsigned char* ws) {
    OPAQUE_TID(); const int lane_ = tid_ & 63, wave_ = __builtin_amdgcn_readfirstlane(tid_ >> 6);
    LAS float* scr = (LAS float*)(F.lds + RING_OFF + wave_ * 16384);
    const int gw = F.vcu * NWAVES + wave_, NGW = F.G * NWAVES;
    bf16* WIN0 = (bf16*)(ws + WS_WIN0); bf16* WO = (bf16*)(ws + WS_WO); bf16* WGU = (bf16*)(ws + WS_WGU); bf16* WD = (bf16*)(ws + WS_WD); bf16* WIN1 = (bf16*)(ws + WS_WIN1); bf16* WQ2 = (bf16*)(ws + WS_WQ2);
    constexpr int I_A = 16 * 56, I_G = 16 * 8, I_B = 2 * 16 * 32, I_C = 2 * 16 * 176, I_D = 2 * 44 * 32, I_E = 16 * 24, I_F = 4 * 16, NITEMS = I_A + I_B + I_C + I_D + I_E + I_F + I_G;
    for (int it = gw; it < NITEMS; it += NGW) {
        int r = it;
        if (r < I_A) { const int kb = r / 56, nb = r % 56, r0 = 32 * nb; int c0, nv;
            if (r0 < 1152) { c0 = r0; nv = 32; } else if (r0 < 1280) { c0 = r0 + 128; nv = 32; } else if (r0 < 1536) { c0 = r0 + 292; nv = 32; } else if (r0 == 1536) { c0 = 1536; nv = 32; } else if (r0 == 1568) { c0 = 1568; nv = 4; } else { c0 = 0; nv = 0; }
            xpose_item(I.nsa_w_in, NSA_IN, c0, nv, 64 * kb, WIN0, D, r0, scr, lane_); continue; } r -= I_A;
        if (r < I_B) { const int l = r / 512, q = r % 512, kb = q / 32, nb = q % 32;
            xpose_item(I.w_out + (size_t)l * D * D, D, 32 * nb, 32, 64 * kb, WO + (size_t)l * D * D, D, 32 * nb, scr, lane_); continue; } r -= I_B;
        if (r < I_C) { const int l = r / (16 * 176), q = r % (16 * 176), kb = q / 176, nb = q % 176, r0 = 32 * nb, pn = r0 >> 8, w0 = r0 & 255;
            const float* src = ((w0 < 128) ? I.ffn_gate : I.ffn_up) + (size_t)l * D * DFF;
            xpose_item(src, DFF, 128 * pn + (w0 & 127), 32, 64 * kb, WGU + (size_t)l * 2 * DFF * D, D, r0, scr, lane_); continue; } r -= I_C;
        if (r < I_D) { const int l = r / (44 * 32), q = r % (44 * 32), kb = q / 32, nb = q % 32;
            xpose_item(I.ffn_down + (size_t)l * DFF * D, D, 32 * nb, 32, 64 * kb, WD + (size_t)l * D * DFF, DFF, 32 * nb, scr, lane_); continue; } r -= I_D;
        if (r < I_E) { const int kb = r / 24, nb = r % 24, r0 = 32 * nb; int nv = DSA_IN - r0; nv = nv > 32 ? 32 : (nv < 0 ? 0 : nv);
            xpose_item(I.dsa_w_in, DSA_IN, r0, nv, 64 * kb, WIN1, D, r0, scr, lane_); continue; } r -= I_E;
        if (r < I_F) { const int kb = r / 16, nb = r % 16; xpose_item(I.w_q_idx, 512, 32 * nb, 32, 64 * kb, WQ2, 256, 1536 + 32 * nb, scr, lane_); continue; } r -= I_F;
        { const int kb = r / 8, nb = r % 8, r0 = 32 * nb;
            xpose_item(I.nsa_w_in, NSA_IN, (r0 < 128) ? 1152 + r0 : 1408 + (r0 - 128), 32, 64 * kb, (bf16*)(ws + WS_WVT), D, r0, scr, lane_); }
    }
    for (int idx = (F.vcu * NWAVES * 64) + tid_; idx < 1536 * 256; idx += F.G * NWAVES * 64) {
        const int n = idx >> 8, c = idx & 255, h = n >> 7, rr = n & 127; const float* a = I.w_q_up + (size_t)c * 768 + h * 64; const float* b = I.w_uk + (size_t)rr * 768 + h * 64; float s = 0.f;
#pragma unroll 8
        for (int d = 0; d < 64; ++d) s += a[d] * b[d];
        WQ2[idx] = (bf16)f2bf(s * 0.125f);
    }
    norm_phase(F, I.x, I.norm_mix, (bf16*)(ws + WS_XN));
}

__device__ __forceinline__ void p2_small(Frame& F, const In& I, unsigned char* ws) {
    OPAQUE_TID(); const int lane_ = tid_ & 63;
    const int hb = tid_ >> 8, t256 = tid_ & 255, ghb = blockIdx.x * 2 + hb, NHB = F.G * 2;
    float* MKV = (float*)(ws + WS_MKV); bf16* KCB = (bf16*)(ws + WS_KCB); bf16* VCT = (bf16*)(ws + WS_VCT); bf16* MKB = (bf16*)(ws + WS_MKB); bf16* MVT = (bf16*)(ws + WS_MVT);
    const bf16* KV0 = (const bf16*)(ws + WS_KV0);
    for (int m = ghb; m < 512; m += NHB) {
        const float* mr = I.mem + (size_t)m * D; float s = 0.f;
        for (int k = lane_; k < D; k += 64) { const float v = mr[k]; s += v * v; }
        const float rs = rsqrtf(wave_sum(s) * (1.f / D) + EPSF);
        float a00 = 0.f, a01 = 0.f, a10 = 0.f, a11 = 0.f;
        const float* w0 = I.w_mem_kv + t256; const float* w1 = I.w_mem_kv + (size_t)D * 512 + t256;
#pragma unroll 4
        for (int k = 0; k < D; ++k) { const float xv = mr[k] * rs; const float x0 = xv * I.norm_mem[k], x1 = xv * I.norm_mem[D + k];
            a00 += x0 * w0[(size_t)k * 512]; a01 += x0 * w0[(size_t)k * 512 + 256]; a10 += x1 * w1[(size_t)k * 512]; a11 += x1 * w1[(size_t)k * 512 + 256]; }
        MKV[(size_t)m * 512 + t256] = a00; MKV[(size_t)m * 512 + 256 + t256] = a01; MKV[(size_t)(512 + m) * 512 + t256] = a10; MKV[(size_t)(512 + m) * 512 + 256 + t256] = a11;
        MKB[(size_t)m * 256 + t256] = (bf16)f2bf(a00); MVT[(size_t)t256 * 512 + m] = (bf16)f2bf(a01); MKB[(size_t)(512 + m) * 256 + t256] = (bf16)f2bf(a10); MVT[(size_t)(256 + t256) * 512 + m] = (bf16)f2bf(a11);
    }
    if (ghb == 0) { KCB[(size_t)((t256 >> 6) * 512 + 511) * 64 + (t256 & 63)] = 0; VCT[(size_t)t256 * 512 + 511] = 0; }
    LAS float* hid = (LAS float*)(F.lds + RING_OFF + hb * 8192);
    constexpr int UPK = (NCR + 3) / 4, NU = 2 * UPK; const int iters = (NU + NHB - 1) / NHB;
    for (int it = 0; it < iters; ++it) {
        const int u = it * NHB + ghb; const bool act = u < NU; const int kv = act ? u / UPK : 0, r0 = act ? (u % UPK) * 4 : 0;
        const float* w1 = kv ? I.v_w1 : I.k_w1; const float* b1 = kv ? I.v_b1 : I.k_b1; const float* w2 = kv ? I.v_w2 : I.k_w2; const float* b2 = kv ? I.v_b2 : I.k_b2; const float* pos = kv ? I.pos_v : I.pos_k;
        const bf16* rp[4];
#pragma unroll
        for (int i = 0; i < 4; ++i) { int row = r0 + i; if (row >= NCR) row = NCR - 1; const int g = row & 1, bn = row >> 1, b = bn / NCMP, n = bn % NCMP; rp[i] = KV0 + (size_t)(b * T + 16 * n) * 512 + kv * 128 + g * 64; }
        float h0 = 0.f, h1 = 0.f, h2 = 0.f, h3 = 0.f;
        if (act) {
            for (int l = 0; l < 32; ++l)
#pragma unroll 8
                for (int d = 0; d < 64; ++d) { const float w = w1[(size_t)(l * 64 + d) * 256 + t256], p = pos[l * 64 + d];
                    h0 += (bf2f(rp[0][l * 512 + d]) + p) * w; h1 += (bf2f(rp[1][l * 512 + d]) + p) * w; h2 += (bf2f(rp[2][l * 512 + d]) + p) * w; h3 += (bf2f(rp[3][l * 512 + d]) + p) * w; }
        }
        { const float bb = b1[t256]; float hv[4] = {h0 + bb, h1 + bb, h2 + bb, h3 + bb};
#pragma unroll
          for (int i = 0; i < 4; ++i) { const float xg = hv[i]; hid[i * 256 + t256] = 0.5f * xg * (1.f + tanhf(0.7978845608028654f * (xg + 0.044715f * xg * xg * xg))); } }
        __syncthreads();
        { const int i = t256 >> 6, d = t256 & 63; float s = b2[d];
          for (int c = 0; c < 256; ++c) s += hid[i * 256 + c] * w2[c * 64 + d];
          if (act && r0 + i < NCR) { const int row = r0 + i, gI = row & 1, bn = row >> 1, bI = bn / NCMP, nI = bn % NCMP, bgi = bI * 2 + gI;
              if (kv) VCT[(size_t)(bgi * 64 + d) * 512 + nI] = (bf16)f2bf(s); else KCB[(size_t)(bgi * 512 + nI) * 64 + d] = (bf16)f2bf(s); } }
        __syncthreads();
    }
}

#define MFMA16(A, B, C) __builtin_amdgcn_mfma_f32_16x16x32_bf16((A), (B), (C), 0, 0, 0)
constexpr float LOG2E = 1.4426950408889634f;
constexpr int TAB_OFF = LDSCTL_OFF + 1024, TAB_BKT = TAB_OFF, TAB_B12 = TAB_OFF + 1536, TAB_SEL = TAB_B12 + 2048;
static_assert(TAB_SEL + 8 * 512 <= LDS_BYTES, "LDS tables");
enum { MD_CMP = 0, MD_WIN = 1, MD_BLK = 2, MD_MEM = 3 };
struct KF { bf16x8 a0, a1, b0, b1; };
struct VF { bf16x8 v[4]; };
__device__ __forceinline__ bf16x8 ldg16(const bf16* p) { return *(const bf16x8*)p; }
typedef float f32x2_t __attribute__((ext_vector_type(2))); typedef __bf16 bf16x2_t __attribute__((ext_vector_type(2)));
__device__ __forceinline__ unsigned cvtpk_s(float lo, float hi) { f32x2_t v = {lo, hi}; bf16x2_t b = __builtin_convertvector(v, bf16x2_t); return __builtin_bit_cast(unsigned, b); }
__device__ __forceinline__ bf16x8 pack8(const f32x4& a, const f32x4& b) { v4u w; w.x = cvtpk_s(a[0], a[1]); w.y = cvtpk_s(a[2], a[3]); w.z = cvtpk_s(b[0], b[1]); w.w = cvtpk_s(b[2], b[3]); return __builtin_bit_cast(bf16x8, w); }
__device__ __forceinline__ void load_k(KF& k, const bf16* kb, int kstride, int key0, int r, int kq) {
    const bf16* pa = kb + (size_t)(key0 + 8 * (r >> 2) + (r & 3)) * kstride + 8 * kq; const bf16* pb = pa + 4 * (size_t)kstride;
    k.a0 = ldg16(pa); k.a1 = ldg16(pa + 32); k.b0 = ldg16(pb); k.b1 = ldg16(pb + 32);
}
__device__ __forceinline__ void load_vt(VF& v, const bf16* vt, int vstride, int key0, int r, int kq) {
#pragma unroll
    for (int dt = 0; dt < 4; ++dt) v.v[dt] = ldg16(vt + (size_t)(16 * dt + r) * vstride + key0 + 8 * kq);
}
__device__ __forceinline__ void qk(f32x4& sa, f32x4& sb, const KF& k, const bf16x8 (&q)[2]) {
    const f32x4 z = {0.f, 0.f, 0.f, 0.f};
    sa = MFMA16(k.a0, q[0], z); sa = MFMA16(k.a1, q[1], sa); sb = MFMA16(k.b0, q[0], z); sb = MFMA16(k.b1, q[1], sb);
}
template <int MODE>
__device__ __forceinline__ void maskbias(f32x4& s, int kpos, int tcol, bool colok, const LAS unsigned char* bkt, const LAS float* b12c) {
    if (MODE == MD_MEM) return;
#pragma unroll
    for (int i = 0; i < 4; ++i) {
        int dist; bool ok;
        if (MODE == MD_CMP) { dist = tcol - 31 - 16 * (kpos + i); ok = dist >= 0; }
        else if (MODE == MD_WIN) { dist = tcol - (kpos + i); ok = (unsigned)dist <= 511u; }
        else { dist = tcol - (kpos + i); ok = dist >= 0; }
        int dc = dist < 0 ? 0 : dist; dc = dc > 1535 ? 1535 : dc;
        const float bias = b12c[(int)bkt[dc] * 16];
        s[i] = (ok && colok) ? s[i] + bias : -INFINITY;
    }
}
__device__ __forceinline__ float colmax(const f32x4& sa, const f32x4& sb) {
    float mx = fmaxf(fmaxf(fmaxf(sa[0], sa[1]), fmaxf(sa[2], sa[3])), fmaxf(fmaxf(sb[0], sb[1]), fmaxf(sb[2], sb[3])));
    mx = fmaxf(mx, __shfl_xor(mx, 16)); mx = fmaxf(mx, __shfl_xor(mx, 32)); return mx;
}
__device__ __forceinline__ bf16x8 sm_update(const f32x4& sa, const f32x4& sb, float& m, float& l, f32x4 (&O)[4]) {
    const float mn = fmaxf(m, colmax(sa, sb)); const float al = __builtin_amdgcn_exp2f(m - mn); m = mn;
    f32x4 pa, pb; float sum = 0.f;
#pragma unroll
    for (int i = 0; i < 4; ++i) { pa[i] = __builtin_amdgcn_exp2f(sa[i] - mn); pb[i] = __builtin_amdgcn_exp2f(sb[i] - mn); sum += pa[i] + pb[i]; }
    l = l * al + sum;
#pragma unroll
    for (int dt = 0; dt < 4; ++dt) O[dt] = O[dt] * al;
    return pack8(pa, pb);
}
__device__ __forceinline__ void pv(f32x4 (&O)[4], const VF& v, const bf16x8& pf) {
#pragma unroll
    for (int dt = 0; dt < 4; ++dt) O[dt] = MFMA16(v.v[dt], pf, O[dt]);
}
__device__ __forceinline__ float kqsum(float v) { v += __shfl_xor(v, 16); v += __shfl_xor(v, 32); return v; }
__device__ __forceinline__ float wmax64(float v) {
#pragma unroll
    for (int o = 1; o < 64; o <<= 1) v = fmaxf(v, __shfl_xor(v, o));
    return v;
}
__device__ __forceinline__ void out_add(LAS float* OUTw, int p, int n, int kq, const f32x4 (&O)[4], float scale, bool first) {
    const int q = 2 * p + (n >> 3), hd = n & 7;
    if (hd < 6) { LAS f32x4* dst = (LAS f32x4*)(OUTw + (q * 6 + hd) * 64) + kq;
#pragma unroll
        for (int dt = 0; dt < 4; ++dt) { f32x4 v = O[dt] * scale; if (!first) v = v + dst[4 * dt]; dst[4 * dt] = v; } }
}

__device__ __forceinline__ void p3_nsa_mfma(Frame& F, const In& I, unsigned char* ws) {
    OPAQUE_TID(); const int lane = tid_ & 63, wave = __builtin_amdgcn_readfirstlane(tid_ >> 6), n = lane & 15, kq = lane >> 4, r = n, hd = n & 7, qsel = n >> 3; const bool colv = hd < 6;
    LAS unsigned char* bkt = F.lds + TAB_BKT; LAS float* b12 = (LAS float*)(F.lds + TAB_B12); LAS int* SELw = (LAS int*)(F.lds + TAB_SEL) + wave * 128;
    LAS float* OUTw = (LAS float*)(F.lds + RING_OFF + wave * 16384); LAS float* PSw = OUTw + 3072;
    for (int i = tid_; i < 1536; i += NWAVES * 64) bkt[i] = (unsigned char)rel_bucket(i);
    for (int i = tid_; i < 512; i += NWAVES * 64) b12[i] = ((i & 15) < 12) ? I.rel_bias[(i >> 4) * 12 + (i & 15)] * LOG2E : 0.f;
    __syncthreads();
    const bf16* Q0 = (const bf16*)(ws + WS_Q0); const bf16* KV0 = (const bf16*)(ws + WS_KV0); const bf16* QM = (const bf16*)(ws + WS_QM); const bf16* G0 = (const bf16*)(ws + WS_G0);
    const bf16* VT = (const bf16*)(ws + WS_VT); const bf16* KCB = (const bf16*)(ws + WS_KCB); const bf16* VCT = (const bf16*)(ws + WS_VCT);
    const bf16* MKB = (const bf16*)(ws + WS_MKB); const bf16* MVT = (const bf16*)(ws + WS_MVT);
    bf16* CAT = (bf16*)(ws + WS_CAT);
    const int nun = 4 * 128;
    for (int ui = blockIdx.x; ui < nun; ui += F.G) {
        int bg, qt;
        if (F.G == 256) { bg = blockIdx.x & 3; const int idx = blockIdx.x >> 2; qt = (ui < 256) ? idx : 127 - idx; }
        else { bg = ui & 3; qt = ui >> 2; }
        const int b = bg >> 1, g = bg & 1, t0w = 64 * qt + 8 * wave, rowb = b * T;
        const int habs = g * 6 + (colv ? hd : 0);
        const LAS float* b12c = b12 + habs;
        bf16x8 qf[4][2];
#pragma unroll
        for (int p = 0; p < 4; ++p) { const bf16* qp = Q0 + (size_t)(rowb + t0w + 2 * p + qsel) * 768 + habs * 64 + 8 * kq;
#pragma unroll
            for (int ks = 0; ks < 2; ++ks) { bf16x8 v = ldg16(qp + 32 * ks); if (!colv) v = (bf16x8){0, 0, 0, 0, 0, 0, 0, 0}; qf[p][ks] = v; } }
        for (int i = lane; i < 1024; i += 64) PSw[i] = 0.f;
        float m[4], l[4]; f32x4 O[4][4];
        const int ncmax = (t0w + 7 >= 31) ? ((t0w + 7 - 31) / 16 + 1) : 0;
        const bf16* kcb = KCB + (size_t)(bg * 512) * 64; const bf16* vct = VCT + (size_t)(bg * 64) * 512;
#pragma unroll
        for (int p = 0; p < 4; ++p) { m[p] = -1e30f; l[p] = 0.f; }
        for (int key0 = 0; key0 < ncmax; key0 += 32) {
            int r_ = r, kq_ = kq; asm volatile("" : "+v"(r_), "+v"(kq_)); KF k; load_k(k, kcb, 64, key0, r_, kq_);
#pragma unroll
            for (int p = 0; p < 4; ++p) { f32x4 sa, sb; qk(sa, sb, k, qf[p]); const int tcol = t0w + 2 * p + qsel;
                maskbias<MD_CMP>(sa, key0 + 8 * kq_, tcol, true, bkt, b12c); maskbias<MD_CMP>(sb, key0 + 8 * kq_ + 4, tcol, true, bkt, b12c);
                const float mn = fmaxf(m[p], colmax(sa, sb)); float sum = 0.f;
#pragma unroll
                for (int i = 0; i < 4; ++i) sum += __builtin_amdgcn_exp2f(sa[i] - mn) + __builtin_amdgcn_exp2f(sb[i] - mn);
                l[p] = l[p] * __builtin_amdgcn_exp2f(m[p] - mn) + sum; m[p] = mn; __builtin_amdgcn_sched_barrier(0); }
        }
        float invl[4];
#pragma unroll
        for (int p = 0; p < 4; ++p) { const float lt = kqsum(l[p]); invl[p] = lt > 0.f ? 1.f / lt : 0.f; }
#pragma unroll
        for (int p = 0; p < 4; ++p)
#pragma unroll
            for (int dt = 0; dt < 4; ++dt) O[p][dt] = (f32x4){0.f, 0.f, 0.f, 0.f};
        float carry[4] = {0.f, 0.f, 0.f, 0.f};
        for (int key0 = 0; key0 < ncmax; key0 += 32) {
            int r_ = r, kq_ = kq; asm volatile("" : "+v"(r_), "+v"(kq_)); KF k; load_k(k, kcb, 64, key0, r_, kq_); VF v; load_vt(v, vct, 512, key0, r_, kq_);
#pragma unroll
            for (int p = 0; p < 4; ++p) { f32x4 sa, sb; qk(sa, sb, k, qf[p]); const int tcol = t0w + 2 * p + qsel;
                maskbias<MD_CMP>(sa, key0 + 8 * kq_, tcol, true, bkt, b12c); maskbias<MD_CMP>(sb, key0 + 8 * kq_ + 4, tcol, true, bkt, b12c);
                f32x4 pa, pb;
#pragma unroll
                for (int i = 0; i < 4; ++i) { pa[i] = __builtin_amdgcn_exp2f(sa[i] - m[p]) * invl[p]; pb[i] = __builtin_amdgcn_exp2f(sb[i] - m[p]) * invl[p]; }
                pv(O[p], v, pack8(pa, pb));
                float wA = (pa[0] + pa[1]) + (pa[2] + pa[3]), wB = pa[3] + ((pb[0] + pb[1]) + (pb[2] + pb[3])), wC = pb[3];
                if (!colv) { wA = 0.f; wB = 0.f; wC = 0.f; }
                const float up = __shfl(wC, (lane + 48) & 63);
                const float prevC = (kq == 0) ? carry[p] : up; carry[p] = up;
                float a0 = wA + prevC, a1 = wB;
                a0 += __shfl_xor(a0, 1); a1 += __shfl_xor(a1, 1); a0 += __shfl_xor(a0, 2); a1 += __shfl_xor(a1, 2); a0 += __shfl_xor(a0, 4); a1 += __shfl_xor(a1, 4);
                if (hd == 0) { LAS float* ps = PSw + (2 * p + qsel) * 128 + (key0 >> 2) + 2 * kq; ps[0] = a0; ps[1] = a1; } __builtin_amdgcn_sched_barrier(0); }
        }
        if (ncmax > 0 && ncmax <= 480) {
            const int jn = ((ncmax + 31) >> 5) * 8;
#pragma unroll
            for (int p = 0; p < 4; ++p) { float a0 = carry[p]; a0 += __shfl_xor(a0, 1); a0 += __shfl_xor(a0, 2); a0 += __shfl_xor(a0, 4); if (hd == 0 && kq == 0) PSw[(2 * p + qsel) * 128 + jn] = a0; }
        }
        {
#pragma unroll
            for (int p = 0; p < 4; ++p) { const size_t row = (size_t)(rowb + t0w + 2 * p + qsel);
                const float gz = bf2f(G0[row * 256 + habs * 3 + 0]) + I.nsa_gate_b[habs * 3 + 0]; out_add(OUTw, p, n, kq, O[p], 1.f / (1.f + __expf(-gz)), true); }
        }
        if (qt >= 16) {
            for (int q = 0; q < 8; ++q) {
                float v0 = PSw[q * 128 + lane], v1 = PSw[q * 128 + 64 + lane];
                if (lane < 1 || lane > qt - 2) v0 = -1.f; if (lane + 64 > qt - 2) v1 = -1.f;
                for (int s = 0; s < 13; ++s) { const float mx = wmax64(fmaxf(v0, v1));
                    const unsigned long long b0 = __ballot(v0 == mx); int j;
                    if (b0) { j = __builtin_ctzll(b0); if (lane == j) v0 = -1.f; } else { const unsigned long long b1 = __ballot(v1 == mx); j = __builtin_ctzll(b1); if (lane == j) v1 = -1.f; j += 64; }
                    if (lane == 0) SELw[q * 16 + s] = j; }
            }
        }
        const bf16* ksb = KV0 + (size_t)rowb * 512 + 256 + g * 64; const bf16* vst = VT + (size_t)(g * 64) * M + rowb;
#pragma unroll
        for (int p = 0; p < 4; ++p) {
            float ms = -1e30f, ls = 0.f; f32x4 Os[4];
#pragma unroll
            for (int dt = 0; dt < 4; ++dt) Os[dt] = (f32x4){0.f, 0.f, 0.f, 0.f};
            const int tcol = t0w + 2 * p + qsel;
            const int nd = (qt >= 16) ? 3 : qt + 1;
            for (int di = 0; di < nd; ++di) { const int j = (qt >= 16) ? (di == 0 ? 0 : qt - 2 + di) : di;
#pragma unroll
                for (int h2 = 0; h2 < 2; ++h2) { const int key0 = 64 * j + 32 * h2;
                    int r_ = r, kq_ = kq; asm volatile("" : "+v"(r_), "+v"(kq_)); KF k; load_k(k, ksb, 512, key0, r_, kq_); VF v; load_vt(v, vst, M, key0, r_, kq_);
                    f32x4 sa, sb; qk(sa, sb, k, qf[p]);
                    maskbias<MD_BLK>(sa, key0 + 8 * kq_, tcol, true, bkt, b12c); maskbias<MD_BLK>(sb, key0 + 8 * kq_ + 4, tcol, true, bkt, b12c);
                    pv(Os, v, sm_update(sa, sb, ms, ls, Os)); } }
            if (qt >= 16) {
                for (int e = 0; e < 26; ++e) { const int qi = e / 13, sl = e % 13; const int j = __builtin_amdgcn_readfirstlane(SELw[(2 * p + qi) * 16 + sl]);
#pragma unroll
                    for (int h2 = 0; h2 < 2; ++h2) { const int key0 = 64 * j + 32 * h2;
                        int r_ = r, kq_ = kq; asm volatile("" : "+v"(r_), "+v"(kq_)); KF k; load_k(k, ksb, 512, key0, r_, kq_); VF v; load_vt(v, vst, M, key0, r_, kq_);
                        f32x4 sa, sb; qk(sa, sb, k, qf[p]);
                        maskbias<MD_BLK>(sa, key0 + 8 * kq_, tcol, qsel == qi, bkt, b12c); maskbias<MD_BLK>(sb, key0 + 8 * kq_ + 4, tcol, qsel == qi, bkt, b12c);
                        pv(Os, v, sm_update(sa, sb, ms, ls, Os)); } }
            }
            { const size_t row = (size_t)(rowb + tcol);
              const float gz = bf2f(G0[row * 256 + habs * 3 + 1]) + I.nsa_gate_b[habs * 3 + 1]; out_add(OUTw, p, n, kq, Os, (1.f / (1.f + __expf(-gz))) / kqsum(ls), false); }
        }
        const bf16* kwb = KV0 + (size_t)rowb * 512 + 384 + g * 64; const bf16* vwt = VT + (size_t)(128 + g * 64) * M + rowb;
#pragma unroll
        for (int p = 0; p < 4; ++p) { m[p] = -1e30f; l[p] = 0.f;
#pragma unroll
            for (int dt = 0; dt < 4; ++dt) O[p][dt] = (f32x4){0.f, 0.f, 0.f, 0.f}; }
        { const int kstart = (t0w - 511 > 0) ? ((t0w - 511) & ~31) : 0;
          for (int key0 = kstart; key0 <= t0w + 7; key0 += 32) {
              int r_ = r, kq_ = kq; asm volatile("" : "+v"(r_), "+v"(kq_)); KF k; load_k(k, kwb, 512, key0, r_, kq_); VF v; load_vt(v, vwt, M, key0, r_, kq_);
#pragma unroll
              for (int p = 0; p < 4; ++p) { f32x4 sa, sb; qk(sa, sb, k, qf[p]); const int tcol = t0w + 2 * p + qsel;
                  maskbias<MD_WIN>(sa, key0 + 8 * kq_, tcol, true, bkt, b12c); maskbias<MD_WIN>(sb, key0 + 8 * kq_ + 4, tcol, true, bkt, b12c);
                  pv(O[p], v, sm_update(sa, sb, m[p], l[p], O[p])); __builtin_amdgcn_sched_barrier(0); } } }
#pragma unroll
        for (int p = 0; p < 4; ++p) { const size_t row = (size_t)(rowb + t0w + 2 * p + qsel);
            const float gz = bf2f(G0[row * 256 + habs * 3 + 2]) + I.nsa_gate_b[habs * 3 + 2]; out_add(OUTw, p, n, kq, O[p], (1.f / (1.f + __expf(-gz))) / kqsum(l[p]), false); }
        int ln_ = lane; asm volatile("" : "+v"(ln_));
#pragma unroll 1
        for (int i = 0; i < 12; ++i) { const int e = i * 64 + ln_, q = e / 96, c4 = e % 96; const f32x4 v = ((const LAS f32x4*)OUTw)[e];
            *(uint2*)(CAT + (size_t)(rowb + t0w + q) * 1024 + g * 384 + 4 * c4) = make_uint2(pk2(v[0], v[1]), pk2(v[2], v[3])); }
#pragma unroll 1
        for (int h2 = 0; h2 < 2; ++h2) { const int hm = 2 * g + h2;
            bf16x8 qm[2]; { const bf16* qp = QM + (size_t)(rowb + t0w + (n & 7)) * 256 + hm * 64 + 8 * kq; qm[0] = ldg16(qp); qm[1] = ldg16(qp + 32); if (n >= 8) { qm[0] = (bf16x8){0, 0, 0, 0, 0, 0, 0, 0}; qm[1] = qm[0]; } }
            float mm = -1e30f, ll = 0.f; f32x4 Om[4];
#pragma unroll
            for (int dt = 0; dt < 4; ++dt) Om[dt] = (f32x4){0.f, 0.f, 0.f, 0.f};
            const bf16* mk = MKB + (size_t)(b * 256) * 256 + hm * 64; const bf16* mvt = MVT + (size_t)(hm * 64) * 512 + b * 256;
            for (int key0 = 0; key0 < 256; key0 += 32) { int r_ = r, kq_ = kq; asm volatile("" : "+v"(r_), "+v"(kq_)); KF k; load_k(k, mk, 256, key0, r_, kq_); VF v; load_vt(v, mvt, 512, key0, r_, kq_);
                f32x4 sa, sb; qk(sa, sb, k, qm); pv(Om, v, sm_update(sa, sb, mm, ll, Om)); }
            const float il = 1.f / kqsum(ll);
            if (n < 8) { bf16* op = CAT + (size_t)(rowb + t0w + n) * 1024 + 768 + hm * 64 + 4 * kq;
#pragma unroll
                for (int dt = 0; dt < 4; ++dt) *(uint2*)(op + 16 * dt) = make_uint2(pk2(Om[dt][0] * il, Om[dt][1] * il), pk2(Om[dt][2] * il, Om[dt][3] * il)); }
        }
    }
}

__device__ __forceinline__ void p10_dsa_norm(Frame& F, const In& I, unsigned char* ws) {
    OPAQUE_TID(); const int gw = F.vcu * NWAVES + (tid_ >> 6), NGW = F.G * NWAVES, lane = tid_ & 63;
    const bf16* PR = (const bf16*)(ws + WS_PROJ1); bf16* CQ = (bf16*)(ws + WS_CQ); bf16* CKV = (bf16*)(ws + WS_CKV); bf16* KIDX = (bf16*)(ws + WS_KIDX); float* WIDX = (float*)(ws + WS_WIDX);
    for (int m = gw; m < M; m += NGW) {
        const bf16* pr = PR + (size_t)m * 768;
        float a[4]; ld4bf(pr + 4 * lane, a);
        float s = wave_sum(a[0] * a[0] + a[1] * a[1] + a[2] * a[2] + a[3] * a[3]); float r = rsqrtf(s * (1.f / 256.f) + EPSF);
        const float4 gq = *(const float4*)(I.q_norm + 4 * lane);
        *(uint2*)(CQ + (size_t)m * 256 + 4 * lane) = make_uint2(pk2((a[0] * r) * gq.x, (a[1] * r) * gq.y), pk2((a[2] * r) * gq.z, (a[3] * r) * gq.w));
        const unsigned u = *(const unsigned*)(pr + 256 + 2 * lane); const float c0 = bflo(u), c1 = bfhi(u);
        s = wave_sum(c0 * c0 + c1 * c1); r = rsqrtf(s * (1.f / 128.f) + EPSF);
        *(unsigned*)(CKV + (size_t)m * 128 + 2 * lane) = pk2((c0 * r) * I.kv_norm[2 * lane], (c1 * r) * I.kv_norm[2 * lane + 1]);
        const float k0 = bf2f(pr[384 + lane]);
        s = wave_sum(k0 * k0); r = rsqrtf(s * (1.f / 64.f) + EPSF);
        KIDX[(size_t)m * 64 + lane] = (bf16)f2bf((k0 * r) * I.kidx_norm[lane]);
        if (lane < 8) WIDX[(size_t)m * 8 + lane] = bf2f(pr[448 + lane]) * (0.35355339059327373f * 0.125f);
    }
}

__device__ __forceinline__ unsigned f2key(float f) { f = f + 0.f; const unsigned u = __float_as_uint(f); return (u & 0x80000000u) ? ~u : (u | 0x80000000u); }
__device__ __forceinline__ void p12_dsa_index(Frame& F, const In& I, unsigned char* ws) {
    OPAQUE_TID(); const int lane_ = tid_ & 63;
    const int hb = tid_ >> 8, t256 = tid_ & 255, ghb = blockIdx.x * 2 + hb, NHB = F.G * 2;
    LAS unsigned char* base = F.lds + RING_OFF + hb * 65536;
    LAS unsigned* keys = (LAS unsigned*)base;
    LAS unsigned short* ties = (LAS unsigned short*)(base + 32768);
    LAS float* qs = (LAS float*)(base + 49152);
    LAS float* wsh = (LAS float*)(base + 51200);
    LAS unsigned* hist = (LAS unsigned*)(base + 51232);
    LAS unsigned* shv = (LAS unsigned*)(base + 52256);
    const bf16* QI = (const bf16*)(ws + WS_QI); const bf16* KIDX = (const bf16*)(ws + WS_KIDX); const float* WIDX = (const float*)(ws + WS_WIDX);
    unsigned short* SEL = (unsigned short*)(ws + WS_SEL); int* CNT = (int*)(ws + WS_CNT);
    const int iters = (M + NHB - 1) / NHB;
    for (int it = 0; it < iters; ++it) {
        const int row = it * NHB + ghb, b = row / T, t = row % T; const bool big = t >= 256;
        unsigned short* so = SEL + (size_t)row * 256;
        if (!big) { so[t256] = (unsigned short)((t256 <= t) ? t256 : 0); if (t256 == 0) CNT[row] = t + 1; }
        for (int i = t256; i < 512; i += 256) qs[i] = bf2f(QI[(size_t)row * 512 + i]);
        if (t256 < 8) wsh[t256] = WIDX[(size_t)row * 8 + t256];
        if (t256 == 0) { unsigned z_ = 0u, k_ = 256u; asm volatile("" : "+v"(z_), "+v"(k_)); shv[0] = z_; shv[1] = k_; shv[2] = z_; shv[3] = z_; }
        __syncthreads();
        if (big) for (int s = t256; s <= t; s += 256) {
            const bf16* kr = KIDX + (size_t)(b * T + s) * 64; float acc[8] = {0.f, 0.f, 0.f, 0.f, 0.f, 0.f, 0.f, 0.f};
#pragma unroll 2
            for (int c = 0; c < 8; ++c) { float k8[8]; ld8bf(kr + 8 * c, k8);
#pragma unroll
                for (int h = 0; h < 8; ++h)
#pragma unroll
                    for (int d = 0; d < 8; ++d) acc[h] += qs[h * 64 + 8 * c + d] * k8[d]; }
            float scv = 0.f;
#pragma unroll
            for (int h = 0; h < 8; ++h) scv += fmaxf(acc[h], 0.f) * wsh[h];
            keys[s] = f2key(scv);
        }
        __syncthreads();
        for (int pass = 0; pass < 4; ++pass) {
            const int shift = 24 - 8 * pass;
            hist[t256] = 0u;
            __syncthreads();
            const unsigned prefix = shv[0], himask = (pass == 0) ? 0u : (0xFFFFFFFFu << (shift + 8));
            if (big) for (int s = t256; s <= t; s += 256) { const unsigned k = keys[s]; if ((k & himask) == prefix) atomicAdd((unsigned*)&hist[(k >> shift) & 255u], 1u); }
            __syncthreads();
            if (t256 == 0) { unsigned kk = shv[1], cum = 0u; int d = 255;
                for (; d > 0; --d) { const unsigned hv = hist[d]; if (cum + hv >= kk) break; cum += hv; }
                shv[1] = kk - cum; shv[0] = prefix | ((unsigned)d << shift); }
            __syncthreads();
        }
        const unsigned tau = shv[0], kk = shv[1];
        if (big) for (int s = t256; s <= t; s += 256) { const unsigned k = keys[s];
            if (k > tau) { const unsigned p = atomicAdd((unsigned*)&shv[2], 1u); so[p] = (unsigned short)s; }
            else if (k == tau) { const unsigned p = atomicAdd((unsigned*)&shv[3], 1u); ties[p] = (unsigned short)s; } }
        __syncthreads();
        if (big) { const unsigned nt = shv[3], bs = shv[2];
            for (unsigned i = t256; i < nt; i += 256) { const unsigned me = ties[i]; unsigned rank = 0u;
                for (unsigned j = 0; j < nt; ++j) rank += (ties[j] < me) ? 1u : 0u;
                if (rank < kk) so[bs + rank] = (unsigned short)me; }
            if (t256 == 0) { int k_ = 256; asm volatile("" : "+v"(k_)); CNT[row] = k_; } }
        __syncthreads();
    }
}

__device__ __forceinline__ void p13_dsa_attn(Frame& F, const In& I, unsigned char* ws) {
    OPAQUE_TID(); const int lane_ = tid_ & 63;
    const int hb = tid_ >> 8, t256 = tid_ & 255, hh = t256 >> 4, l16 = t256 & 15, ghb = blockIdx.x * 2 + hb, NHB = F.G * 2;
    LAS unsigned char* base = F.lds + RING_OFF + hb * 65536;
    LAS float* ol = (LAS float*)base;
    LAS int* sidx = (LAS int*)(base + 6144);
    const bf16* QA = (const bf16*)(ws + WS_QA); const bf16* CKV = (const bf16*)(ws + WS_CKV); const bf16* PR = (const bf16*)(ws + WS_PROJ1);
    const unsigned short* SEL = (const unsigned short*)(ws + WS_SEL); const int* CNT = (const int*)(ws + WS_CNT); const float* MKV = (const float*)(ws + WS_MKV) + (size_t)512 * 512;
    bf16* CAT = (bf16*)(ws + WS_CAT);
    const int iters = (M + NHB - 1) / NHB;
    for (int it = 0; it < iters; ++it) {
        const int row = it * NHB + ghb, b = row / T, t = row % T;
        const int cnt = CNT[row];
        sidx[t256] = (t256 < cnt) ? (int)SEL[(size_t)row * 256 + t256] : 0;
        __syncthreads();
        if (hh < 12) {
            float q[8]; ld8bf(QA + (size_t)row * 1536 + hh * 128 + 8 * l16, q);
            const bf16* cb = CKV + (size_t)b * T * 128 + 8 * l16;
            float m_ = NEGF, l_ = 0.f, o[8] = {0.f, 0.f, 0.f, 0.f, 0.f, 0.f, 0.f, 0.f};
#pragma unroll 4
            for (int i = 0; i < cnt; ++i) { const int idx = sidx[i]; float kk[8]; ld8bf(cb + (size_t)idx * 128, kk);
                coop_attend<8>(q, kk, kk, I.rel_bias[rel_bucket(t - idx) * 12 + hh], m_, l_, o); }
            const float il = 1.f / l_;
#pragma unroll
            for (int i = 0; i < 8; ++i) ol[hh * 128 + 8 * l16 + i] = o[i] * il;
        } else {
            const int hm = hh - 12; float q[4]; ld4bf(PR + (size_t)row * 768 + 456 + hm * 64 + 4 * l16, q);
#pragma unroll
            for (int i = 0; i < 4; ++i) q[i] *= 0.125f;
            const float* kb_ = MKV + (size_t)(b * 256) * 512 + hm * 64 + 4 * l16;
            float m_ = NEGF, l_ = 0.f, o[4] = {0.f, 0.f, 0.f, 0.f};
#pragma unroll 4
            for (int mm = 0; mm < 256; ++mm) { float kk[4], vv[4]; ld4f(kb_ + (size_t)mm * 512, kk); ld4f(kb_ + (size_t)mm * 512 + 256, vv); coop_attend<4>(q, kk, vv, 0.f, m_, l_, o); }
            const float il = 1.f / l_;
            *(uint2*)(CAT + (size_t)row * 1024 + 768 + hm * 64 + 4 * l16) = make_uint2(pk2(o[0] * il, o[1] * il), pk2(o[2] * il, o[3] * il));
        }
        __syncthreads();
        for (int i = t256; i < 768; i += 256) { const int h = i >> 6; float a = 0.f; const float* w = I.w_uv + i;
#pragma unroll 8
            for (int r = 0; r < 128; ++r) a += ol[h * 128 + r] * w[(size_t)r * 768];
            CAT[(size_t)row * 1024 + i] = (bf16)f2bf(a); }
        __syncthreads();
    }
}

struct Args { In in; float* out; unsigned char* ws; int ph_lo, ph_hi; };
__global__ void __launch_bounds__(NWAVES * 64, 2) mk_fwd(Args args) {
    extern __shared__ __attribute__((aligned(16))) unsigned char lds[];
    Frame F;
    F.lds = (LAS unsigned char*)lds; F.MISC = (volatile LAS unsigned*)(F.lds + MISC_OFF);
    F.tid = threadIdx.x; F.lane = F.tid & 63; F.wave = __builtin_amdgcn_readfirstlane(F.tid >> 6);
    F.G = gridDim.x; { const int bx = blockIdx.x; F.vcu = (F.G % 8 == 0) ? (bx % 8) * (F.G / 8) + bx / 8 : bx; }
    unsigned char* ws = args.ws; const In& I = args.in; float* out = args.out;
    F.ctl = (gu32*)(ws + WS_CTL);
    for (int u = F.tid; u < (LDS_BYTES - LDSCTL_OFF) / 4; u += NWAVES * 64) ((LAS unsigned*)(F.lds + LDSCTL_OFF))[u] = 0u;
    __syncthreads();
    XcdBarrier bar; bar.bar = (unsigned*)(F.ctl + CW_BAR); bar.x = 0; bar.st = nullptr;
    if (!MK_SPLIT) bar = xcd_barrier_post((unsigned*)(F.ctl + CW_BAR), F.MISC + 8);
    const int lo = args.ph_lo, hi = args.ph_hi;
#ifndef PH_MASK
#define PH_MASK 0xFFFFFFFFu
#endif
#define IN(k) ((((PH_MASK) >> ((k) % 32)) & 1u) && lo <= (k) && (k) < hi)
#define SEAM(k) do { if (IN(k) && IN((k) + 1)) xcd_barrier(bar); } while (0)
    bf16* XN = (bf16*)(ws + WS_XN); bf16* CAT = (bf16*)(ws + WS_CAT); bf16* ACT = (bf16*)(ws + WS_ACT);

    if (IN(0)) { p0_prologue(F, I, ws); SEAM(0); }
#pragma unroll 1
    for (int L = 0; L < 2; ++L) {
        if (L == 0) {
            if (IN(1)) {
                pg8::Gemm g{XN, (const bf16*)(ws + WS_WIN0), M, 1792, D}; pg8::StaticOrder S; S.init(M, 1792, F.G, (int)blockIdx.x);
                pg8::EpiRoute<0> E{ws};
                pg8::gemm_phase<pg8::EpiRoute<0>, pg8::StaticOrder, true, true>(F.lds + RING_OFF, g, S, E);
                pg8::Gemm g2{(const bf16*)(ws + WS_WVT), XN, 256, M, D}; pg8::StaticOrder S2; S2.init(256, M, F.G, (int)((blockIdx.x + 64) % F.G));
                pg8::EpiRoute<3> E2{ws};
                pg8::gemm_phase<pg8::EpiRoute<3>, pg8::StaticOrder, true, true>(F.lds + RING_OFF, g2, S2, E2);
                SEAM(1);
            }
            if (IN(2)) { p2_small(F, I, ws); SEAM(2); }
            if (IN(3)) { p3_nsa_mfma(F, I, ws); SEAM(3); }
        } else {
            if (IN(9)) {
                pg8::Gemm g{XN, (const bf16*)(ws + WS_WIN1), M, 768, D}; pg8::StaticOrder S; S.init(M, 768, F.G, (int)blockIdx.x);
                pg8::EpiRoute<1> E{ws};
                pg8::gemm_phase<pg8::EpiRoute<1>, pg8::StaticOrder, true, true>(F.lds + RING_OFF, g, S, E);
                SEAM(9);
            }
            if (IN(10)) { p10_dsa_norm(F, I, ws); SEAM(10); }
            if (IN(11)) {
                pg8::Gemm g{(const bf16*)(ws + WS_CQ), (const bf16*)(ws + WS_WQ2), M, 2048, 256}; pg8::StaticOrder S; S.init(M, 2048, F.G, (int)blockIdx.x);
                pg8::EpiRoute<2> E{ws};
                pg8::gemm_phase<pg8::EpiRoute<2>, pg8::StaticOrder, true, true>(F.lds + RING_OFF, g, S, E);
                SEAM(11);
            }
            if (IN(12)) { p12_dsa_index(F, I, ws); SEAM(12); }
            if (IN(13)) { p13_dsa_attn(F, I, ws); SEAM(13); }
        }
        const int pb = L ? 14 : 4;
        if (IN(pb)) {
            pg8::Gemm g{CAT, (const bf16*)(ws + WS_WO) + (size_t)L * D * D, M, D, D}; pg8::StaticOrder S; S.init(M, D, F.G, (int)blockIdx.x);
            pg8::EpiResid E{L ? (const float*)out : I.x, out, D, 0};
            pg8::gemm_phase<pg8::EpiResid, pg8::StaticOrder, true, true>(F.lds + RING_OFF, g, S, E);
            SEAM(pb);
        }
        if (IN(pb + 1)) { norm_phase(F, out, I.norm_ffn + L * D, XN); SEAM(pb + 1); }
        if (IN(pb + 2)) {
            pg8::Gemm g{XN, (const bf16*)(ws + WS_WGU) + (size_t)L * 2 * DFF * D, M, 2 * DFF, D}; pg8::StaticOrder S; S.init(M, 2 * DFF, F.G, (int)blockIdx.x);
            pg8::EpiSwiglu E{ACT, DFF, 0};
            pg8::gemm_phase<pg8::EpiSwiglu, pg8::StaticOrder, true, true>(F.lds + RING_OFF, g, S, E);
            SEAM(pb + 2);
        }
        if (IN(pb + 3)) {
            pg8::Gemm g{ACT, (const bf16*)(ws + WS_WD) + (size_t)L * D * DFF, M, D, DFF}; pg8::StaticOrder S; S.init(M, D, F.G, (int)blockIdx.x);
            pg8::EpiResid E{out, out, D, 0};
            pg8::gemm_phase<pg8::EpiResid, pg8::StaticOrder, true, true>(F.lds + RING_OFF, g, S, E);
            SEAM(pb + 3);
        }
        if (L == 0 && IN(8)) { norm_phase(F, out, I.norm_mix + D, XN); SEAM(8); }
    }
    if (IN(18)) {
        OPAQUE_TID(); const int lane_ = tid_ & 63;
        const int gw = F.vcu * NWAVES + (tid_ >> 6), NGW = F.G * NWAVES;
        for (int m = gw; m < M; m += NGW) { GAS f32x4* xr = (GAS f32x4*)(out + (size_t)m * D) + lane_; const GAS f32x4* gr = (const GAS f32x4*)I.norm_final + lane_;
            f32x4 v[4]; float s = 0.f;
#pragma unroll
            for (int j = 0; j < 4; ++j) { v[j] = xr[64 * j]; s += (v[j].x * v[j].x + v[j].y * v[j].y) + (v[j].z * v[j].z + v[j].w * v[j].w); }
            const float r = rsqrtf(wave_sum(s) * (1.f / D) + EPSF);
#pragma unroll
            for (int j = 0; j < 4; ++j) { const f32x4 g = gr[64 * j]; xr[64 * j] = (v[j] * r) * g; } }
    }
#undef IN
#undef SEAM
}

extern "C" void kernel_launch(void* const* d_in, const int* in_sizes, int n_in, void* d_out, int out_size, void* d_ws, size_t ws_size, hipStream_t stream) {
    static int grid = 0;
    if (grid == 0) {
        if (n_in != 32 || out_size != M * D || ws_size < WS_END) { fprintf(stderr, "kernel_launch: unexpected shapes (n_in %d out %d ws %zu)\n", n_in, out_size, ws_size); grid = -1; return; }
        int dev = 0, cus = 0, per_cu = 0;
        if (hipGetDevice(&dev) != hipSuccess || hipDeviceGetAttribute(&cus, hipDeviceAttributeMultiprocessorCount, dev) != hipSuccess) { grid = -1; return; }
        if (hipFuncSetAttribute((const void*)mk_fwd, hipFuncAttributeMaxDynamicSharedMemorySize, LDS_BYTES) != hipSuccess) { grid = -1; return; }
        if (hipOccupancyMaxActiveBlocksPerMultiprocessor(&per_cu, (const void*)mk_fwd, NWAVES * 64, LDS_BYTES) != hipSuccess || per_cu < 1) fprintf(stderr, "kernel_launch: occupancy query reports %d\n", per_cu);
        (void)hipGetLastError();
        grid = cus;
        if (grid > 256) grid = 256;
    }
    if (grid < 0) return;
    if (hipMemsetAsync((char*)d_ws + WS_CTL, 0, CTL_ZERO_BYTES, stream) != hipSuccess) return;
    Args a{};
    const float** ip = (const float**)&a.in;
    for (int i = 0; i < 32; ++i) ip[i] = (const float*)d_in[i];
    a.out = (float*)d_out; a.ws = (unsigned char*)d_ws;
#if MK_SPLIT
    for (int k = 0; k < N_PHASES; ++k) { a.ph_lo = k; a.ph_hi = k + 1; hipLaunchKernelGGL(mk_fwd, dim3(grid), dim3(NWAVES * 64), LDS_BYTES, stream, a); }
#else
    a.ph_lo = 0; a.ph_hi = N_PHASES; hipLaunchKernelGGL(mk_fwd, dim3(grid), dim3(NWAVES * 64), LDS_BYTES, stream, a);
#endif
}
```

```cpp
#include <hip/hip_runtime.h>
#include <cstdio>
#include <cstdint>
#include <math.h>

namespace pg8 {
#define PG8_LAS __attribute__((address_space(3)))
typedef unsigned short bf16_t;
typedef short bf16x8 __attribute__((ext_vector_type(8)));
typedef float f32x4 __attribute__((ext_vector_type(4)));
typedef unsigned u32x4 __attribute__((ext_vector_type(4)));
constexpr int BM = 256, BK = 64, HALF = 128, HTB = HALF * BK * 2  , STAGE_BYTES = 8 * HTB, NXCD = 8, WGM = 8;

__host__ __device__ __forceinline__ int lds_byte(int r, int c) { const int st = (r >> 4) * 2 + (c >> 5), rr = r & 15, cc = c & 31, ob = rr * 64 + cc * 2; return st * 1024 + (ob ^ (((ob >> 9) & 1) << 5)); }
__host__ __device__ __forceinline__ void stage_rc(int b, int& R, int& C) { const int st = b / 1024, sb = b % 1024, swz = sb ^ (((sb >> 9) & 1) << 5); R = (st >> 1) * 16 + swz / 64; C = (st & 1) * 32 + (swz % 64) / 2; }
__host__ __device__ __forceinline__ int perm32(int rho) { const int n = rho >> 4, i = rho & 15; return 8 * (i >> 2) + 4 * n + (i & 3); }

struct Unit { int pm, pn; };
struct Gemm { const bf16_t* A; const bf16_t* Bt; int M, N, K; };

struct StaticOrder {
    int nM, nN, nwg, G, c;
    __host__ __device__ void init(int M, int N, int G_, int c_) { nM = M / BM; nN = N / BM; nwg = nM * nN; G = G_; c = c_; }
    __host__ __device__ bool next(int i, Unit& u) const {
        const long L = (long)i * G + c; if (L >= nwg) return false;
        int wgid = (int)L; { const int q = nwg / NXCD, r = nwg % NXCD, xcd = wgid % NXCD, off = wgid / NXCD; wgid = (xcd < r ? xcd * (q + 1) : r * (q + 1) + (xcd - r) * q) + off; }
        const int nig = WGM * nN, gid = wgid / nig, fm = gid * WGM, gsz = (nM - fm) < WGM ? (nM - fm) : WGM;
        u.pm = fm + ((wgid % nig) % gsz); u.pn = (wgid % nig) / gsz; return true;
    }
    __device__ __forceinline__ void a_ready(const Unit&) const {}
    __device__ __forceinline__ void done(const Unit&) const {}
};

__device__ __forceinline__ unsigned cvt_pk_bf16(float lo, float hi) { unsigned r; asm volatile("v_cvt_pk_bf16_f32 %0, %1, %2" : "=v"(r) : "v"(lo), "v"(hi)); return r; }
template <int ROUTE> struct EpiRoute {
    static constexpr bool PERM = true, AFTER_DRAIN = false;
    unsigned char* ws;
    __device__ __forceinline__ void operator()(const f32x4 (&acc)[2][2][4][2], const Unit& u, int wr, int wc, int fr, int fq) const {
        asm volatile("" : "+v"(fr), "+v"(fq));
        const int pn = u.pn; size_t off; int ld, t0; float sc;
        if constexpr (ROUTE == 0) {
            off = pn < 3 ? (size_t)(88u << 20) : pn < 5 ? (size_t)(112u << 20) : pn < 6 ? (size_t)(136u << 20) : (size_t)(144u << 20);
            ld = pn < 3 ? 768 : pn < 5 ? 512 : 256; t0 = pn < 3 ? 0 : pn < 5 ? 3 : pn < 6 ? 5 : 6; sc = (pn < 3 || pn == 5) ? 0.18033688011112042f : 1.f;
        } else if constexpr (ROUTE == 1) { off = (size_t)(88u << 20); ld = 768; t0 = 0; sc = 1.f; }
        else if constexpr (ROUTE == 3) { off = (size_t)(152u << 20); ld = 16384; t0 = 0; sc = 1.f; }
        else { off = pn < 6 ? (size_t)(128u << 20) : (size_t)(176u << 20); ld = pn < 6 ? 1536 : 512; t0 = pn < 6 ? 0 : 6; sc = 1.f; }
        bf16_t* base = (bf16_t*)(ws + off);
        const int row0 = u.pm * BM + wr * 64 + fr, col0 = (pn - t0) * BM + wc * 32 + 8 * fq;
#pragma unroll
        for (int ai = 0; ai < 2; ++ai)
#pragma unroll
            for (int m = 0; m < 4; ++m) { bf16_t* rowp = base + (size_t)(row0 + ai * HALF + m * 16) * ld + col0;
#pragma unroll
                for (int bj = 0; bj < 2; ++bj) { const f32x4 v0 = acc[ai][bj][m][0] * sc, v1 = acc[ai][bj][m][1] * sc;
                    u32x4 w; w.x = cvt_pk_bf16(v0[0], v0[1]); w.y = cvt_pk_bf16(v0[2], v0[3]); w.z = cvt_pk_bf16(v1[0], v1[1]); w.w = cvt_pk_bf16(v1[2], v1[3]);
                    *(u32x4*)(rowp + bj * HALF) = w; } }
    }
};
struct EpiResid {
    static constexpr bool PERM = true, AFTER_DRAIN = false;
    const float* res; float* out; int ldc; int pad;
    __device__ __forceinline__ void operator()(const f32x4 (&acc)[2][2][4][2], const Unit& u, int wr, int wc, int fr, int fq) const {
        asm volatile("" : "+v"(fr), "+v"(fq));
        const int row0 = u.pm * BM + wr * 64 + fr, col0 = u.pn * BM + wc * 32 + 8 * fq;
#pragma unroll
        for (int ai = 0; ai < 2; ++ai)
#pragma unroll
            for (int m = 0; m < 4; ++m) { const size_t off = (size_t)(row0 + ai * HALF + m * 16) * ldc + col0;
#pragma unroll
                for (int bj = 0; bj < 2; ++bj)
#pragma unroll
                    for (int n = 0; n < 2; ++n) { const f32x4 r = *(const f32x4*)(res + off + bj * HALF + 4 * n); *(f32x4*)(out + off + bj * HALF + 4 * n) = r + acc[ai][bj][m][n]; } }
    }
};
struct EpiSwiglu {
    static constexpr bool PERM = true, AFTER_DRAIN = false;
    bf16_t* O; int ldc; int pad;
    __device__ __forceinline__ void operator()(const f32x4 (&acc)[2][2][4][2], const Unit& u, int wr, int wc, int fr, int fq) const {
        asm volatile("" : "+v"(fr), "+v"(fq));
        const int row0 = u.pm * BM + wr * 64 + fr, col0 = u.pn * HALF + wc * 32 + 8 * fq;
#pragma unroll
        for (int ai = 0; ai < 2; ++ai)
#pragma unroll
            for (int m = 0; m < 4; ++m) { float o[8];
#pragma unroll
                for (int n = 0; n < 2; ++n)
#pragma unroll
                    for (int e = 0; e < 4; ++e) { const float g = acc[ai][0][m][n][e], up = acc[ai][1][m][n][e]; o[4 * n + e] = (g * __builtin_amdgcn_rcpf(1.f + __expf(-g))) * up; }
                u32x4 w; w.x = cvt_pk_bf16(o[0], o[1]); w.y = cvt_pk_bf16(o[2], o[3]); w.z = cvt_pk_bf16(o[4], o[5]); w.w = cvt_pk_bf16(o[6], o[7]);
                *(u32x4*)(O + (size_t)(row0 + ai * HALF + m * 16) * ldc + col0) = w; }
    }
};
template <class Epi, class Sched, bool ALIGN_EPI = false, bool SP2 = false>
__device__ __forceinline__ void gemm_phase(PG8_LAS unsigned char* lds, const Gemm g, const Sched& S, const Epi& E) {
    int tid = threadIdx.x; asm volatile("" : "+v"(tid));
    const int wid = __builtin_amdgcn_readfirstlane(tid >> 6), lane = tid & 63, wr = wid >> 2, wc = wid & 3, fr = lane & 15, fq = lane >> 4;
    int K = g.K; asm volatile("" : "+s"(K));
    const int nt = K / BK;
    unsigned voffA[2], voffB[2];
#pragma unroll
    for (int i = 0; i < 2; ++i) { int R, C; stage_rc(tid * 16 + i * 8192, R, C); const int Rb = Epi::PERM ? ((R & ~31) + perm32(R & 31)) : R;
        voffA[i] = (unsigned)(R * K + C) * 2u; voffB[i] = (unsigned)(Rb * K + C) * 2u; }
    const size_t kstep = (size_t)(BK * 2);
    const size_t hstep = (size_t)HALF * K * 2;
    const size_t tstep = 2 * hstep;
    const unsigned ldsw = (unsigned)wid * 1024u;
    const int aoff = lds_byte(wr * 64 + fr, fq * 8), boff = lds_byte(wc * 32 + fr, fq * 8);
#define PG8_SA(b, h) (((b) * 2 + (h)) * HTB)
#define PG8_SB(b, h) ((4 + (b) * 2 + (h)) * HTB)
#define PG8_STAGE(bufoff, gbase, voff) do { _Pragma("unroll") for (int _i = 0; _i < 2; ++_i) \
        __builtin_amdgcn_global_load_lds((const unsigned*)((const char*)(gbase) + (voff)[_i]), (PG8_LAS unsigned*)(lds + (bufoff) + ldsw + _i * 8192), 16, 0, 0); } while (0)
#define PG8_LDA(dst, b, h) do { _Pragma("unroll") for (int m = 0; m < 4; ++m) _Pragma("unroll") for (int k = 0; k < 2; ++k) dst[m][k] = *(const PG8_LAS bf16x8*)(lds + PG8_SA(b, h) + aoff + m * 2048 + k * 1024); } while (0)
#define PG8_LDB(dst, b, h) do { _Pragma("unroll") for (int n = 0; n < 2; ++n) _Pragma("unroll") for (int k = 0; k < 2; ++k) dst[n][k] = *(const PG8_LAS bf16x8*)(lds + PG8_SB(b, h) + boff + n * 2048 + k * 1024); } while (0)
#define PG8_MMA(ai, bj, At, Bt) do { __builtin_amdgcn_s_setprio(1); _Pragma("unroll") for (int m = 0; m < 4; ++m) _Pragma("unroll") for (int n = 0; n < 2; ++n) _Pragma("unroll") for (int k = 0; k < 2; ++k) \
        acc[ai][bj][m][n] = __builtin_amdgcn_mfma_f32_16x16x32_bf16(Bt[n][k], At[m][k], acc[ai][bj][m][n], 0, 0, 0); __builtin_amdgcn_s_setprio(0); } while (0)
#define PG8_WAIT_V(n) asm volatile("s_waitcnt vmcnt(" #n ")" ::: "memory")
#define PG8_WAIT_L(n) asm volatile("s_waitcnt lgkmcnt(" #n ")" ::: "memory")
#define PG8_BAR __builtin_amdgcn_s_barrier()
#define PG8_SCHED __builtin_amdgcn_sched_barrier(0)
    Unit cur, nxt; int ui = 0;
    if (!S.next(0, cur)) return;
    f32x4 acc[2][2][4][2];
#pragma unroll
    for (int a = 0; a < 2; ++a)
#pragma unroll
        for (int b = 0; b < 2; ++b)
#pragma unroll
            for (int m = 0; m < 4; ++m)
#pragma unroll
                for (int n = 0; n < 2; ++n) acc[a][b][m][n] = (f32x4){0.f, 0.f, 0.f, 0.f};
    bf16x8 At[4][2], B0[2][2], B1[2][2];
    const char* cA = (const char*)g.A + (size_t)cur.pm * tstep; const char* cB = (const char*)g.Bt + (size_t)cur.pn * tstep;
    S.a_ready(cur);
    if constexpr (SP2) {
        PG8_STAGE(PG8_SB(0, 0), cB, voffB); PG8_STAGE(PG8_SB(0, 1), cB + hstep, voffB); PG8_STAGE(PG8_SA(0, 0), cA, voffA); PG8_STAGE(PG8_SA(0, 1), cA + hstep, voffA);
        if (wr == 1) PG8_BAR;
        PG8_WAIT_V(2); PG8_BAR;
        PG8_STAGE(PG8_SB(1, 0), cB + kstep, voffB); PG8_STAGE(PG8_SA(1, 0), cA + kstep, voffA); PG8_STAGE(PG8_SB(1, 1), cB + hstep + kstep, voffB);
        PG8_WAIT_V(6); PG8_BAR;
    } else {
        PG8_STAGE(PG8_SB(0, 0), cB, voffB); PG8_STAGE(PG8_SA(0, 0), cA, voffA); PG8_STAGE(PG8_SB(0, 1), cB + hstep, voffB); PG8_STAGE(PG8_SA(0, 1), cA + hstep, voffA);
        if (wr == 1) PG8_BAR;
        PG8_WAIT_V(4); PG8_BAR;
        PG8_STAGE(PG8_SB(1, 0), cB + kstep, voffB); PG8_STAGE(PG8_SA(1, 0), cA + kstep, voffA); PG8_STAGE(PG8_SB(1, 1), cB + hstep + kstep, voffB);
        PG8_WAIT_V(6); PG8_BAR;
    }
    for (;;) {
        const bool has_next = S.next(ui + 1, nxt);
        const char* nA = has_next ? (const char*)g.A + (size_t)nxt.pm * tstep : cA; const char* nB = has_next ? (const char*)g.Bt + (size_t)nxt.pn * tstep : cB;
        for (int t = 0; t < nt; t += 2) {
            const bool last = (t == nt - 2);
            const char* a1 = cA + (size_t)(t + 1) * kstep;
            const char* a2 = last ? nA : cA + (size_t)(t + 2) * kstep; const char* b2 = last ? nB : cB + (size_t)(t + 2) * kstep;
            const char* a3 = a2 + kstep; const char* b3 = b2 + kstep;
            if (last && has_next) S.a_ready(nxt);
            if constexpr (SP2) {
            PG8_LDB(B0, 0, 0); PG8_LDB(B1, 0, 1); PG8_SCHED; PG8_LDA(At, 0, 0); PG8_STAGE(PG8_SA(1, 1), a1 + hstep, voffA);
            PG8_WAIT_V(8); PG8_WAIT_L(0); PG8_BAR; PG8_MMA(0, 0, At, B0); PG8_MMA(0, 1, At, B1); PG8_BAR; PG8_SCHED;
            PG8_LDA(At, 0, 1); PG8_STAGE(PG8_SB(0, 0), b2, voffB); PG8_STAGE(PG8_SB(0, 1), b2 + hstep, voffB); PG8_STAGE(PG8_SA(0, 0), a2, voffA);
            PG8_WAIT_V(8); PG8_WAIT_L(0); PG8_BAR; PG8_MMA(1, 0, At, B0); PG8_MMA(1, 1, At, B1); PG8_BAR; PG8_SCHED;
            PG8_LDB(B0, 1, 0); PG8_LDB(B1, 1, 1); PG8_SCHED; PG8_LDA(At, 1, 0); PG8_STAGE(PG8_SA(0, 1), a2 + hstep, voffA);
            PG8_WAIT_V(8); PG8_WAIT_L(0); PG8_BAR; PG8_MMA(0, 0, At, B0); PG8_MMA(0, 1, At, B1); PG8_BAR; PG8_SCHED;
            PG8_LDA(At, 1, 1); PG8_STAGE(PG8_SB(1, 0), b3, voffB); PG8_STAGE(PG8_SB(1, 1), b3 + hstep, voffB); PG8_STAGE(PG8_SA(1, 0), a3, voffA);
            PG8_WAIT_V(8); PG8_WAIT_L(0); PG8_BAR; PG8_MMA(1, 0, At, B0); PG8_MMA(1, 1, At, B1); PG8_BAR; PG8_SCHED;
            } else {
            PG8_LDB(B0, 0, 0); PG8_SCHED; PG8_LDA(At, 0, 0); PG8_STAGE(PG8_SA(1, 1), a1 + hstep, voffA);
            PG8_WAIT_L(8); PG8_BAR; PG8_WAIT_L(0); PG8_MMA(0, 0, At, B0); PG8_BAR; PG8_SCHED;
            PG8_LDB(B1, 0, 1); PG8_STAGE(PG8_SB(0, 0), b2, voffB);
            PG8_BAR; PG8_WAIT_L(0); PG8_MMA(0, 1, At, B1); PG8_BAR;
            PG8_LDA(At, 0, 1); PG8_STAGE(PG8_SA(0, 0), a2, voffA);
            PG8_BAR; PG8_WAIT_L(0); PG8_MMA(1, 0, At, B0); PG8_BAR; PG8_SCHED;
            PG8_STAGE(PG8_SB(0, 1), b2 + hstep, voffB);
            PG8_WAIT_V(6); PG8_BAR; PG8_MMA(1, 1, At, B1); PG8_BAR;
            PG8_LDB(B0, 1, 0); PG8_SCHED; PG8_LDA(At, 1, 0); PG8_STAGE(PG8_SA(0, 1), a2 + hstep, voffA);
            PG8_WAIT_L(8); PG8_BAR; PG8_WAIT_L(0); PG8_MMA(0, 0, At, B0); PG8_BAR; PG8_SCHED;
            PG8_LDB(B1, 1, 1); PG8_STAGE(PG8_SB(1, 0), b3, voffB);
            PG8_BAR; PG8_WAIT_L(0); PG8_MMA(0, 1, At, B1); PG8_BAR;
            PG8_LDA(At, 1, 1); PG8_STAGE(PG8_SA(1, 0), a3, voffA);
            PG8_BAR; PG8_WAIT_L(0); PG8_MMA(1, 0, At, B0); PG8_BAR; PG8_SCHED;
            PG8_STAGE(PG8_SB(1, 1), b3 + hstep, voffB);
            PG8_WAIT_V(6); PG8_BAR; PG8_MMA(1, 1, At, B1); PG8_BAR;
            }
        }
        if constexpr (ALIGN_EPI) { if (wr == 0) PG8_BAR; }
        if constexpr (!Epi::AFTER_DRAIN) { E(acc, cur, wr, wc, fr, fq); S.done(cur); }
        if (!has_next) break;
#pragma unroll
        for (int a = 0; a < 2; ++a)
#pragma unroll
            for (int b = 0; b < 2; ++b)
#pragma unroll
                for (int m = 0; m < 4; ++m)
#pragma unroll
                    for (int n = 0; n < 2; ++n) acc[a][b][m][n] = (f32x4){0.f, 0.f, 0.f, 0.f};
        cur = nxt; cA = nA; cB = nB; ++ui;
        if constexpr (ALIGN_EPI) { if (wr == 1) PG8_BAR; }
    }
    PG8_WAIT_V(0);
    if constexpr (!ALIGN_EPI) { if (wr == 0) PG8_BAR; }
    PG8_BAR;
    if constexpr (Epi::AFTER_DRAIN) { E.fused(acc, cur, wr, wc, fr, fq, lds, wid, lane); S.done(cur); }
#undef PG8_SA
#undef PG8_SB
#undef PG8_STAGE
#undef PG8_LDA
#undef PG8_LDB
#undef PG8_MMA
#undef PG8_WAIT_V
#undef PG8_WAIT_L
#undef PG8_BAR
#undef PG8_SCHED
}
}
constexpr int NWAVES = 8;
constexpr int BATCH = 2, T = 8192, D = 1024, M = BATCH * T, DFF = 2816, NSA_IN = 1828, DSA_IN = 712, NCMP = 511, NCR = BATCH * NCMP * 2;
constexpr float NEGF = -1e30f, EPSF = 1e-6f;
#ifndef MK_SPLIT
#define MK_SPLIT 0
#endif
constexpr int N_PHASES = 19;
constexpr size_t MiB = 1u << 20;
constexpr size_t WS_CTL = 0, CTL_ZERO_BYTES = 1 * MiB;
constexpr size_t WS_KCB = 1 * MiB  , WS_VCT = 1 * MiB + 512 * 1024  , WS_MKB = 2 * MiB  , WS_MVT = 2 * MiB + 512 * 1024  , WS_MKV = 3 * MiB  , WS_WIDX = 5 * MiB  , WS_CNT = 6 * MiB  ;
constexpr size_t WS_WIN0 = 8 * MiB, WS_WO = 12 * MiB, WS_WGU = 16 * MiB, WS_WD = 38 * MiB, WS_WIN1 = 49 * MiB, WS_WQ2 = 51 * MiB, WS_WVT = 52 * MiB  ;
constexpr size_t WS_W1T = 232 * MiB, WS_MEMN = 234 * MiB, WS_WMKT = 236 * MiB, WS_W2T = 238 * MiB, WS_B1F = 238 * MiB + 64 * 1024;
constexpr size_t WS_XN = 56 * MiB;
constexpr size_t WS_Q0 = 88 * MiB, WS_KV0 = 112 * MiB  , WS_QM = 136 * MiB, WS_G0 = 144 * MiB, WS_VT = 152 * MiB  ;
static_assert(WS_Q0 == (88u << 20) && WS_KV0 == (112u << 20) && WS_QM == (136u << 20) && WS_G0 == (144u << 20), "EpiRoute tables");
constexpr size_t WS_ACT = 88 * MiB;
constexpr size_t WS_PROJ1 = 88 * MiB, WS_CQ = 112 * MiB, WS_CKV = 120 * MiB, WS_KIDX = 124 * MiB, WS_QA = 128 * MiB, WS_QI = 176 * MiB, WS_SEL = 112 * MiB  , WS_CAT1 = 176 * MiB  , WS_WO1F = 52 * MiB + 512 * 1024  ;
constexpr size_t WS_CAT = 200 * MiB, WS_END = 239 * MiB;
static_assert(WS_PROJ1 == (88u << 20) && WS_QA == (128u << 20) && WS_QI == (176u << 20) && WS_VT == (152u << 20), "EpiRoute tables");
static_assert(WS_ACT + (size_t)M * DFF * 2 <= WS_CAT + 0 * MiB || true, "map");
constexpr int CW_BAR = 4096;
constexpr int RING_OFF = 0, RING_BYTES = 131072, LDSCTL_OFF = RING_BYTES, MISC_OFF = LDSCTL_OFF + 320, LDS_BYTES = 151552;
#define GAS __attribute__((address_space(1)))
#define LAS __attribute__((address_space(3)))
typedef unsigned short bf16;
typedef unsigned v4u __attribute__((ext_vector_type(4)));
typedef float f32x4 __attribute__((ext_vector_type(4)));
typedef short bf16x8 __attribute__((ext_vector_type(8)));
typedef GAS unsigned gu32;
typedef GAS unsigned long long gu64;
#define RLX_AGENT __ATOMIC_RELAXED, __HIP_MEMORY_SCOPE_AGENT
#define LDS_WAIT() asm volatile("s_waitcnt lgkmcnt(0)" ::: "memory")
#define VM_WAIT() asm volatile("s_waitcnt vmcnt(0)" ::: "memory")
__device__ __forceinline__ unsigned long long rt() { return __builtin_amdgcn_s_memrealtime(); }
__device__ __forceinline__ unsigned f2bf(float f) { unsigned u = __builtin_bit_cast(unsigned, f); return (u + 0x7fffu + ((u >> 16) & 1u)) >> 16; }
__device__ __forceinline__ unsigned pk2(float lo, float hi) { return f2bf(lo) | (f2bf(hi) << 16); }
#define XB_TMO      128
#define XB_XCNT(j)  (256  + 64 * (j))
#define XB_XSUB(j)  (1280 + 64 * (j))
#define XB_XGEN(j)  (2304 + 64 * (j))
#define XB_TOP      3328
#define XB_TOPGEN   3392
#define XCD_BAR_WORDS 3456
#define XB_SPIN_CAP (1u << 18)

__device__ __forceinline__ unsigned xb_ld(unsigned* p)              { return __hip_atomic_load(p, __ATOMIC_RELAXED, __HIP_MEMORY_SCOPE_AGENT); }
__device__ __forceinline__ unsigned xb_add(unsigned* p, unsigned v) { return __hip_atomic_fetch_add(p, v, __ATOMIC_RELAXED, __HIP_MEMORY_SCOPE_AGENT); }
__device__ __forceinline__ unsigned xb_xcc_id() { return (unsigned)__builtin_amdgcn_s_getreg((3 << 11) | 20) & 0xFu; }
#define XB_SPIN(cond, bar) do { unsigned _sp = 0; while (cond) { __builtin_amdgcn_s_sleep(1); \
    if ((++_sp & 255u) == 0u) { if (xb_ld(&(bar)[XB_TMO])) break; if (_sp > XB_SPIN_CAP) { atomicAdd(&(bar)[XB_TMO], 1u); break; } } } } while (0)

struct XcdBarrier {
    unsigned* bar; unsigned x;
    volatile LAS unsigned* st;
};

__device__ __forceinline__ XcdBarrier xcd_barrier_post(unsigned* bar, volatile LAS unsigned* st) {
    XcdBarrier b; b.bar = bar; b.x = xb_xcc_id(); b.st = st;
    if (threadIdx.x == 0) (void)xb_add(&bar[XB_XCNT(b.x)], 1u);
    return b;
}
__device__ __forceinline__ void xcd_barrier_complete(unsigned* bar, unsigned x, unsigned& nloc, unsigned& nx) {
    const unsigned G = gridDim.x * gridDim.y * gridDim.z;
    unsigned sum, cnt, mine, sp = 0u;
    for (;;) {
        sum = 0u; cnt = 0u; mine = 0u;
#pragma unroll
        for (unsigned j = 0; j < 16; ++j) { const unsigned c = xb_ld(&bar[XB_XCNT(j)]); sum += c; cnt += (c > 0u) ? 1u : 0u; mine = (j == x) ? c : mine; }
        if (sum == G) break;
        __builtin_amdgcn_s_sleep(1);
        if ((++sp & 255u) == 0u) { if (xb_ld(&bar[XB_TMO])) break; if (sp > XB_SPIN_CAP) { atomicAdd(&bar[XB_TMO], 1u); break; } }
    }
    nloc = mine > 0u ? mine : 1u; nx = cnt > 0u ? cnt : 1u;
}

__device__ __forceinline__ void xcd_barrier(const XcdBarrier& b) {
    asm volatile("s_waitcnt vmcnt(0)" ::: "memory");
    __syncthreads();
    if (threadIdx.x == 0) {
        unsigned* bar = b.bar;
        __builtin_amdgcn_s_waitcnt(0);
        unsigned nloc = b.st[0], nx = b.st[1];
        if (nloc == 0u) { xcd_barrier_complete(bar, b.x, nloc, nx); b.st[0] = nloc; b.st[1] = nx; }
        const unsigned old = xb_add(&bar[XB_XSUB(b.x)], 1u);
        const unsigned gen = old / nloc;
        if (old + 1u == (gen + 1u) * nloc) {
            __builtin_amdgcn_fence(__ATOMIC_RELEASE, "agent");
            asm volatile("s_waitcnt vmcnt(0)" ::: "memory");
            const unsigned og = xb_add(&bar[XB_TOP], 1u);
            const unsigned tg = og / nx;
            if (og + 1u == (tg + 1u) * nx) xb_add(&bar[XB_TOPGEN], 1u);
            else XB_SPIN(xb_ld(&bar[XB_TOPGEN]) == tg, bar);
            __builtin_amdgcn_fence(__ATOMIC_ACQUIRE, "agent");
            xb_add(&bar[XB_XGEN(b.x)], 1u);
            asm volatile("s_waitcnt vmcnt(0)" ::: "memory");
        } else {
            XB_SPIN(xb_ld(&bar[XB_XGEN(b.x)]) == gen, bar);
            __builtin_amdgcn_fence(__ATOMIC_ACQUIRE, "agent");
            asm volatile("s_waitcnt vmcnt(0)" ::: "memory");
        }
    }
    __syncthreads();
}

struct Frame {
    LAS unsigned char* lds; volatile LAS unsigned* MISC; gu32* ctl;
    int tid, lane, wave, vcu, G;
};
__device__ __forceinline__ float bf2f(unsigned short u) { return __uint_as_float((unsigned)u << 16); }
__device__ __forceinline__ float bflo(unsigned u) { return __uint_as_float(u << 16); }
__device__ __forceinline__ float bfhi(unsigned u) { return __uint_as_float(u & 0xffff0000u); }
__device__ __forceinline__ float wave_sum(float v) {
#pragma unroll
    for (int o = 1; o < 64; o <<= 1) v += __shfl_xor(v, o);
    return v;
}
__device__ __forceinline__ float red16_sum(float v) { v += __shfl_xor(v, 1, 16); v += __shfl_xor(v, 2, 16); v += __shfl_xor(v, 4, 16); v += __shfl_xor(v, 8, 16); return v; }
__device__ __forceinline__ float red16_max(float v) { v = fmaxf(v, __shfl_xor(v, 1, 16)); v = fmaxf(v, __shfl_xor(v, 2, 16)); v = fmaxf(v, __shfl_xor(v, 4, 16)); v = fmaxf(v, __shfl_xor(v, 8, 16)); return v; }
__device__ __forceinline__ int rel_bucket(int n) {
    if (n < 16) return n;
    return 16 + (n >= 22) + (n >= 30) + (n >= 40) + (n >= 54) + (n >= 73) + (n >= 99) + (n >= 134) + (n >= 182) + (n >= 246) + (n >= 332) + (n >= 450) + (n >= 609) + (n >= 825) + (n >= 1117) + (n >= 1513);
}

__device__ __forceinline__ void xpose_item(const float* W, int ldw, int c0, int nvalid, int k0, bf16* WT, int Kd, int drow0, LAS float* scr, int lane) {
#pragma unroll 8
    for (int i = 0; i < 32; ++i) { const int kk = 2 * i + (lane >> 5), n = lane & 31; scr[kk * 33 + n] = (n < nvalid) ? W[(size_t)(k0 + kk) * ldw + c0 + n] : 0.f; }
    LDS_WAIT(); asm volatile("" ::: "memory");
    const int c = lane & 7;
#pragma unroll
    for (int j = 0; j < 4; ++j) { const int n = (lane >> 3) + 8 * j; const LAS float* s = scr + (8 * c) * 33 + n;
        v4u o; o.x = pk2(s[0 * 33], s[1 * 33]); o.y = pk2(s[2 * 33], s[3 * 33]); o.z = pk2(s[4 * 33], s[5 * 33]); o.w = pk2(s[6 * 33], s[7 * 33]);
        *(GAS v4u*)(WT + (size_t)(drow0 + n) * Kd + k0 + 8 * c) = o; }
    LDS_WAIT(); asm volatile("" ::: "memory");
}
__device__ __forceinline__ void rms_row_to_bf16(const float* xrow, const float* gain, bf16* orow, int lane) {
    const GAS f32x4* xr = (const GAS f32x4*)xrow + lane; const GAS f32x4* gr = (const GAS f32x4*)gain + lane;
    f32x4 v[4]; float s = 0.f;
#pragma unroll
    for (int j = 0; j < 4; ++j) { v[j] = xr[64 * j]; s += (v[j].x * v[j].x + v[j].y * v[j].y) + (v[j].z * v[j].z + v[j].w * v[j].w); }
    const float r = rsqrtf(wave_sum(s) * (1.f / D) + EPSF);
    GAS unsigned long long* o8 = (GAS unsigned long long*)orow + lane;
#pragma unroll
    for (int j = 0; j < 4; ++j) { const f32x4 g = gr[64 * j]; o8[64 * j] = (unsigned long long)pk2((v[j].x * r) * g.x, (v[j].y * r) * g.y) | ((unsigned long long)pk2((v[j].z * r) * g.z, (v[j].w * r) * g.w) << 32); }
}
#define OPAQUE_TID() int tid_ = threadIdx.x; asm volatile("" : "+v"(tid_))
__device__ __forceinline__ void norm_phase(Frame& F, const float* x, const float* gain, bf16* xn) {
    OPAQUE_TID(); const int lane_ = tid_ & 63, wave_ = tid_ >> 6;
    const int gw = F.vcu * NWAVES + wave_, NGW = F.G * NWAVES;
    for (int m = gw; m < M; m += NGW) rms_row_to_bf16(x + (size_t)m * D, gain, xn + (size_t)m * D, lane_);
}

template <int DL>
__device__ __forceinline__ void coop_attend(const float (&q)[DL], const float (&k)[DL], const float (&v)[DL], float bias, float& m_, float& l_, float (&o)[DL]) {
    float a = 0.f;
#pragma unroll
    for (int d = 0; d < DL; ++d) a += q[d] * k[d];
    a = red16_sum(a) + bias;
    const float mn = fmaxf(m_, a), al = __expf(m_ - mn), p = __expf(a - mn);
    l_ = l_ * al + p; m_ = mn;
#pragma unroll
    for (int d = 0; d < DL; ++d) o[d] = o[d] * al + p * v[d];
}
__device__ __forceinline__ void ld4bf(const bf16* p, float (&x)[4]) { const uint2 u = *(const uint2*)p; x[0] = bflo(u.x); x[1] = bfhi(u.x); x[2] = bflo(u.y); x[3] = bfhi(u.y); }
__device__ __forceinline__ void ld8bf(const bf16* p, float (&x)[8]) { const uint4 u = *(const uint4*)p; x[0] = bflo(u.x); x[1] = bfhi(u.x); x[2] = bflo(u.y); x[3] = bfhi(u.y); x[4] = bflo(u.z); x[5] = bfhi(u.z); x[6] = bflo(u.w); x[7] = bfhi(u.w); }
__device__ __forceinline__ void ld4f(const float* p, float (&x)[4]) { const float4 u = *(const float4*)p; x[0] = u.x; x[1] = u.y; x[2] = u.z; x[3] = u.w; }

struct In {
    const float *x, *mem, *rel_bias, *norm_mix, *norm_ffn, *norm_mem, *w_mem_kv, *w_out, *ffn_gate, *ffn_up, *ffn_down, *nsa_w_in, *nsa_gate_b, *pos_k, *pos_v,
        *k_w1, *k_b1, *k_w2, *k_b2, *v_w1, *v_b1, *v_w2, *v_b2, *dsa_w_in, *q_norm, *kv_norm, *w_q_up, *w_uk, *w_uv, *w_q_idx, *kidx_norm, *norm_final;
};
__device__ __forceinline__ void p0_prologue(Frame& F, const In& I, unsigned char* ws) {
    OPAQUE_TID(); const int lane_ = tid_ & 63, wave_ = __builtin_amdgcn_readfirstlane(tid_ >> 6);
    LAS float* scr = (LAS float*)(F.lds + RING_OFF + wave_ * 16384);
    const int gw = F.vcu * NWAVES + wave_, NGW = F.G * NWAVES;
    bf16* WIN0 = (bf16*)(ws + WS_WIN0); bf16* WO = (bf16*)(ws + WS_WO); bf16* WGU = (bf16*)(ws + WS_WGU); bf16* WD = (bf16*)(ws + WS_WD); bf16* WIN1 = (bf16*)(ws + WS_WIN1); bf16* WQ2 = (bf16*)(ws + WS_WQ2);
    constexpr int I_A = 16 * 56, I_G = 16 * 8, I_B = 2 * 16 * 32, I_C = 2 * 16 * 176, I_D = 2 * 44 * 32, I_E = 16 * 24, I_F = 4 * 16, NITEMS = I_A + I_B + I_C + I_D + I_E + I_F + I_G;
    for (int it = gw; it < NITEMS; it += NGW) {
        int r = it;
        if (r < I_A) { const int kb = r / 56, nb = r % 56, r0 = 32 * nb; int c0, nv;
            if (r0 < 1152) { c0 = r0; nv = 32; } else if (r0 < 1280) { c0 = r0 + 128; nv = 32; } else if (r0 < 1536) { c0 = r0 + 292; nv = 32; } else if (r0 == 1536) { c0 = 1536; nv = 32; } else if (r0 == 1568) { c0 = 1568; nv = 4; } else { c0 = 0; nv = 0; }
            xpose_item(I.nsa_w_in, NSA_IN, c0, nv, 64 * kb, WIN0, D, r0, scr, lane_); continue; } r -= I_A;
        if (r < I_B) { const int l = r / 512, q = r % 512, kb = q / 32, nb = q % 32;
            xpose_item(I.w_out + (size_t)l * D * D, D, 32 * nb, 32, 64 * kb, WO + (size_t)l * D * D, D, 32 * nb, scr, lane_); continue; } r -= I_B;
        if (r < I_C) { const int l = r / (16 * 176), q = r % (16 * 176), kb = q / 176, nb = q % 176, r0 = 32 * nb, pn = r0 >> 8, w0 = r0 & 255;
            const float* src = ((w0 < 128) ? I.ffn_gate : I.ffn_up) + (size_t)l * D * DFF;
            xpose_item(src, DFF, 128 * pn + (w0 & 127), 32, 64 * kb, WGU + (size_t)l * 2 * DFF * D, D, r0, scr, lane_); continue; } r -= I_C;
        if (r < I_D) { const int l = r / (44 * 32), q = r % (44 * 32), kb = q / 32, nb = q % 32;
            xpose_item(I.ffn_down + (size_t)l * DFF * D, D, 32 * nb, 32, 64 * kb, WD + (size_t)l * D * DFF, DFF, 32 * nb, scr, lane_); continue; } r -= I_D;
        if (r < I_E) { const int kb = r / 24, nb = r % 24, r0 = 32 * nb; int nv = DSA_IN - r0; nv = nv > 32 ? 32 : (nv < 0 ? 0 : nv);
            xpose_item(I.dsa_w_in, DSA_IN, r0, nv, 64 * kb, WIN1, D, r0, scr, lane_); continue; } r -= I_E;
        if (r < I_F) { const int kb = r / 16, nb = r % 16; xpose_item(I.w_q_idx, 512, 32 * nb, 32, 64 * kb, WQ2, 256, 1536 + 32 * nb, scr, lane_); continue; } r -= I_F;
        { const int kb = r / 8, nb = r % 8, r0 = 32 * nb;
            xpose_item(I.nsa_w_in, NSA_IN, (r0 < 128) ? 1152 + r0 : 1408 + (r0 - 128), 32, 64 * kb, (bf16*)(ws + WS_WVT), D, r0, scr, lane_); }
    }
    for (int idx = (F.vcu * NWAVES * 64) + tid_; idx < 1536 * 256; idx += F.G * NWAVES * 64) {
        const int n = idx >> 8, c = idx & 255, h = n >> 7, rr = n & 127; const float* a = I.w_q_up + (size_t)c * 768 + h * 64; const float* b = I.w_uk + (size_t)rr * 768 + h * 64; float s = 0.f;
#pragma unroll 8
        for (int d = 0; d < 64; ++d) s += a[d] * b[d];
        WQ2[idx] = (bf16)f2bf(s * (0.125f * 1.4426950408889634f));
    }
    { bf16* WO1F = (bf16*)(ws + WS_WO1F); const float* wo1 = I.w_out + (size_t)D * D;
      for (int idx = (F.vcu * NWAVES * 64) + tid_; idx < 1536 * 1024; idx += F.G * NWAVES * 64) {
          const int nn = idx & 1023, hr = idx >> 10, h = hr >> 7, rr = hr & 127; const float* a = I.w_uv + (size_t)rr * 768 + h * 64; const float* bcol = wo1 + (size_t)(h * 64) * D + nn; float sacc = 0.f;
#pragma unroll 8
          for (int d = 0; d < 64; ++d) sacc += a[d] * bcol[(size_t)d * D];
          WO1F[(size_t)nn * 1792 + hr] = (bf16)f2bf(sacc); }
      for (int it = gw; it < 4 * 32; it += NGW) { const int kb = it / 32, nb = it % 32;
          xpose_item(wo1 + (size_t)768 * D, D, 32 * nb, 32, 64 * kb, WO1F + 1536, 1792, 32 * nb, scr, lane_); } }
    { bf16* W1T = (bf16*)(ws + WS_W1T); bf16* W2T = (bf16*)(ws + WS_W2T); bf16* WMKT = (bf16*)(ws + WS_WMKT); float* B1F = (float*)(ws + WS_B1F); bf16* MEMN = (bf16*)(ws + WS_MEMN);
      constexpr int J_1 = 2 * 32 * 8, J_2 = 2 * 4 * 2, J_M = 2 * 16 * 16;
      for (int it = gw; it < J_1 + J_2 + J_M; it += NGW) { int r2 = it;
          if (r2 < J_1) { const int kv = r2 / 256, q = r2 % 256, kb = q / 8, nb = q % 8; xpose_item(kv ? I.v_w1 : I.k_w1, 256, 32 * nb, 32, 64 * kb, W1T + (size_t)kv * 256 * 2048, 2048, 32 * nb, scr, lane_); continue; } r2 -= J_1;
          if (r2 < J_2) { const int kv = r2 / 8, q = r2 % 8, kb = q / 2, nb = q % 2; xpose_item(kv ? I.v_w2 : I.k_w2, 64, 32 * nb, 32, 64 * kb, W2T + (size_t)kv * 64 * 256, 256, 32 * nb, scr, lane_); continue; } r2 -= J_2;
          { const int l = r2 / 256, q = r2 % 256, kb = q / 16, nb = q % 16; xpose_item(I.w_mem_kv + (size_t)l * D * 512, 512, 32 * nb, 32, 64 * kb, WMKT + (size_t)l * 512 * D, D, 32 * nb, scr, lane_); } }
      for (int idx = (F.vcu * NWAVES * 64) + tid_; idx < 512; idx += F.G * NWAVES * 64) { const int kv = idx >> 8, c = idx & 255; const float* w1 = kv ? I.v_w1 : I.k_w1; const float* pos = kv ? I.pos_v : I.pos_k; float sacc = (kv ? I.v_b1 : I.k_b1)[c];
          for (int k = 0; k < 2048; ++k) sacc += pos[k] * w1[(size_t)k * 256 + c];
          B1F[idx] = sacc; }
      for (int m = gw; m < 1024; m += NGW) rms_row_to_bf16(I.mem + (size_t)(m & 511) * D, I.norm_mem + (m >> 9) * D, MEMN + (size_t)m * D, lane_); }
    norm_phase(F, I.x, I.norm_mix, (bf16*)(ws + WS_XN));
}

#define MFMA16(A, B, C) __builtin_amdgcn_mfma_f32_16x16x32_bf16((A), (B), (C), 0, 0, 0)
constexpr float LOG2E = 1.4426950408889634f;
constexpr int TAB_OFF = LDSCTL_OFF + 1024, TAB_BKT = TAB_OFF, TAB_B12 = TAB_OFF + 1536, TAB_SEL = TAB_B12 + 2048;
static_assert(TAB_SEL + 8 * 512 <= LDS_BYTES, "LDS tables");
enum { MD_CMP = 0, MD_WIN = 1, MD_BLK = 2, MD_MEM = 3 };
struct KF { bf16x8 a0, a1, b0, b1; };
struct VF { bf16x8 v[4]; };
__device__ __forceinline__ bf16x8 ldg16(const bf16* p) { return *(const bf16x8*)p; }
typedef float f32x2_t __attribute__((ext_vector_type(2))); typedef __bf16 bf16x2_t __attribute__((ext_vector_type(2)));
__device__ __forceinline__ unsigned cvtpk_s(float lo, float hi) { f32x2_t v = {lo, hi}; bf16x2_t b = __builtin_convertvector(v, bf16x2_t); return __builtin_bit_cast(unsigned, b); }
__device__ __forceinline__ bf16x8 pack8(const f32x4& a, const f32x4& b) { v4u w; w.x = cvtpk_s(a[0], a[1]); w.y = cvtpk_s(a[2], a[3]); w.z = cvtpk_s(b[0], b[1]); w.w = cvtpk_s(b[2], b[3]); return __builtin_bit_cast(bf16x8, w); }
__device__ __forceinline__ void load_k(KF& k, const bf16* kb, int kstride, int key0, int r, int kq) {
    const bf16* pa = kb + (size_t)(key0 + 8 * (r >> 2) + (r & 3)) * kstride + 8 * kq; const bf16* pb = pa + 4 * (size_t)kstride;
    k.a0 = ldg16(pa); k.a1 = ldg16(pa + 32); k.b0 = ldg16(pb); k.b1 = ldg16(pb + 32);
}
__device__ __forceinline__ void load_vt(VF& v, const bf16* vt, int vstride, int key0, int r, int kq) {
#pragma unroll
    for (int dt = 0; dt < 4; ++dt) v.v[dt] = ldg16(vt + (size_t)(16 * dt + r) * vstride + key0 + 8 * kq);
}
__device__ __forceinline__ void qk(f32x4& sa, f32x4& sb, const KF& k, const bf16x8 (&q)[2]) {
    const f32x4 z = {0.f, 0.f, 0.f, 0.f};
    sa = MFMA16(k.a0, q[0], z); sa = MFMA16(k.a1, q[1], sa); sb = MFMA16(k.b0, q[0], z); sb = MFMA16(k.b1, q[1], sb);
}
template <int MODE>
__device__ __forceinline__ void maskbias(f32x4& s, int kpos, int tcol, bool colok, const LAS unsigned char* bkt, const LAS float* b12c) {
    if (MODE == MD_MEM) return;
#pragma unroll
    for (int i = 0; i < 4; ++i) {
        int dist; bool ok;
        if (MODE == MD_CMP) { dist = tcol - 31 - 16 * (kpos + i); ok = dist >= 0; }
        else if (MODE == MD_WIN) { dist = tcol - (kpos + i); ok = (unsigned)dist <= 511u; }
        else { dist = tcol - (kpos + i); ok = dist >= 0; }
        int dc = dist < 0 ? 0 : dist; dc = dc > 1535 ? 1535 : dc;
        const float bias = b12c[(int)bkt[dc] * 16];
        s[i] = (ok && colok) ? s[i] + bias : -INFINITY;
    }
}
__device__ __forceinline__ float colmax(const f32x4& sa, const f32x4& sb) {
    float mx = fmaxf(fmaxf(fmaxf(sa[0], sa[1]), fmaxf(sa[2], sa[3])), fmaxf(fmaxf(sb[0], sb[1]), fmaxf(sb[2], sb[3])));
    mx = fmaxf(mx, __shfl_xor(mx, 16)); mx = fmaxf(mx, __shfl_xor(mx, 32)); return mx;
}
__device__ __forceinline__ bf16x8 sm_update(const f32x4& sa, const f32x4& sb, float& m, float& l, f32x4 (&O)[4]) {
    const float mn = fmaxf(m, colmax(sa, sb)); const float al = __builtin_amdgcn_exp2f(m - mn); m = mn;
    f32x4 pa, pb; float sum = 0.f;
#pragma unroll
    for (int i = 0; i < 4; ++i) { pa[i] = __builtin_amdgcn_exp2f(sa[i] - mn); pb[i] = __builtin_amdgcn_exp2f(sb[i] - mn); sum += pa[i] + pb[i]; }
    l = l * al + sum;
#pragma unroll
    for (int dt = 0; dt < 4; ++dt) O[dt] = O[dt] * al;
    return pack8(pa, pb);
}
__device__ __forceinline__ void pv(f32x4 (&O)[4], const VF& v, const bf16x8& pf) {
#pragma unroll
    for (int dt = 0; dt < 4; ++dt) O[dt] = MFMA16(v.v[dt], pf, O[dt]);
}
__device__ __forceinline__ float kqsum(float v) { v += __shfl_xor(v, 16); v += __shfl_xor(v, 32); return v; }
__device__ __forceinline__ float wmax64(float v) {
#pragma unroll
    for (int o = 1; o < 64; o <<= 1) v = fmaxf(v, __shfl_xor(v, o));
    return v;
}
__device__ __forceinline__ void out_add(LAS float* OUTw, int p, int n, int kq, const f32x4 (&O)[4], float scale, bool first) {
    const int q = 2 * p + (n >> 3), hd = n & 7;
    if (hd < 6) { LAS f32x4* dst = (LAS f32x4*)(OUTw + (q * 6 + hd) * 64) + kq;
#pragma unroll
        for (int dt = 0; dt < 4; ++dt) { f32x4 v = O[dt] * scale; if (!first) v = v + dst[4 * dt]; dst[4 * dt] = v; } }
}

__device__ __forceinline__ void p2_mfma(Frame& F, const In& I, unsigned char* ws) {
    OPAQUE_TID(); const int lane = tid_ & 63, wave = __builtin_amdgcn_readfirstlane(tid_ >> 6), r = lane & 15, kq = lane >> 4;
    const bf16* KV0 = (const bf16*)(ws + WS_KV0); const bf16* W1T = (const bf16*)(ws + WS_W1T); const bf16* W2T = (const bf16*)(ws + WS_W2T); const float* B1F = (const float*)(ws + WS_B1F);
    const bf16* MEMN = (const bf16*)(ws + WS_MEMN); const bf16* WMKT = (const bf16*)(ws + WS_WMKT);
    bf16* KCB = (bf16*)(ws + WS_KCB); bf16* VCT = (bf16*)(ws + WS_VCT); bf16* MKB = (bf16*)(ws + WS_MKB); bf16* MVT = (bf16*)(ws + WS_MVT);
    LAS unsigned char* hid = F.lds + RING_OFF;
    for (int u = blockIdx.x; u < 192; u += F.G) {
        const bool cmp = u < 128;
        const bf16* ap[2]; const bf16* bp[2]; int K, kjump;
        int kv = 0, bg = 0, n0 = 0, lay = 0, m0 = 0, ch = 0;
        if (cmp) { kv = u >> 6; bg = (u >> 4) & 3; n0 = (u & 15) * 32; const int b = bg >> 1, g = bg & 1; K = 2048; kjump = 512 - 64;
#pragma unroll
            for (int rt = 0; rt < 2; ++rt) { int nn = n0 + 16 * rt + r; nn = nn > 510 ? 510 : nn; ap[rt] = KV0 + (size_t)(b * T + 16 * nn) * 512 + kv * 128 + g * 64 + 8 * kq; }
#pragma unroll
            for (int ct = 0; ct < 2; ++ct) bp[ct] = W1T + (size_t)(kv * 256 + 32 * wave + 16 * ct + r) * 2048 + 8 * kq;
        } else { const int v = u - 128; lay = v >> 5; m0 = ((v >> 1) & 15) * 32; ch = v & 1; K = 1024; kjump = 0;
#pragma unroll
            for (int rt = 0; rt < 2; ++rt) ap[rt] = MEMN + (size_t)(lay * 512 + m0 + 16 * rt + r) * 1024 + 8 * kq;
#pragma unroll
            for (int ct = 0; ct < 2; ++ct) bp[ct] = WMKT + (size_t)(lay * 512 + ch * 256 + 32 * wave + 16 * ct + r) * 1024 + 8 * kq;
        }
        f32x4 acc[2][2];
#pragma unroll
        for (int rt = 0; rt < 2; ++rt)
#pragma unroll
            for (int ct = 0; ct < 2; ++ct) acc[rt][ct] = (f32x4){0.f, 0.f, 0.f, 0.f};
        for (int kb = 0; kb < K; kb += 64) { const int ao = kb + (kb >> 6) * kjump;
            bf16x8 a[2][2], bb[2][2];
#pragma unroll
            for (int h2 = 0; h2 < 2; ++h2) {
#pragma unroll
                for (int rt = 0; rt < 2; ++rt) a[rt][h2] = ldg16(ap[rt] + ao + 32 * h2);
#pragma unroll
                for (int ct = 0; ct < 2; ++ct) bb[ct][h2] = ldg16(bp[ct] + kb + 32 * h2); }
#pragma unroll
            for (int h2 = 0; h2 < 2; ++h2)
#pragma unroll
                for (int rt = 0; rt < 2; ++rt)
#pragma unroll
                    for (int ct = 0; ct < 2; ++ct) acc[rt][ct] = MFMA16(a[rt][h2], bb[ct][h2], acc[rt][ct]);
        }
        if (cmp) {
#pragma unroll
            for (int ct = 0; ct < 2; ++ct) { const int col = 32 * wave + 16 * ct + r; const float bias = B1F[kv * 256 + col];
#pragma unroll
                for (int rt = 0; rt < 2; ++rt)
#pragma unroll
                    for (int i = 0; i < 4; ++i) { const float xg = acc[rt][ct][i] + bias; const float hv = 0.5f * xg * (1.f + tanhf(0.7978845608028654f * (xg + 0.044715f * xg * xg * xg)));
                        *(LAS unsigned short*)(hid + (16 * rt + 4 * kq + i) * 528 + 2 * col) = (unsigned short)f2bf(hv); } }
            __syncthreads();
            { const int rt2 = wave >> 2, ct2 = wave & 3; f32x4 o = {0.f, 0.f, 0.f, 0.f};
              const bf16* w2p = W2T + (size_t)(kv * 64 + 16 * ct2 + r) * 256 + 8 * kq;
#pragma unroll
              for (int ks = 0; ks < 8; ++ks) { const bf16x8 av = *(const LAS bf16x8*)(hid + (16 * rt2 + r) * 528 + 64 * ks + 16 * kq); o = MFMA16(av, ldg16(w2p + 32 * ks), o); }
              const int d = 16 * ct2 + r; const float b2v = (kv ? I.v_b2 : I.k_b2)[d];
#pragma unroll
              for (int i = 0; i < 4; ++i) { const int nn = n0 + 16 * rt2 + 4 * kq + i; const unsigned short ov = (nn < NCMP) ? (unsigned short)f2bf(o[i] + b2v) : (unsigned short)0;
                  if (kv) VCT[(size_t)(bg * 64 + d) * 512 + nn] = ov; else KCB[(size_t)(bg * 512 + nn) * 64 + d] = ov; } }
            __syncthreads();
        } else {
#pragma unroll
            for (int ct = 0; ct < 2; ++ct) { const int col = 32 * wave + 16 * ct + r;
#pragma unroll
                for (int rt = 0; rt < 2; ++rt)
#pragma unroll
                    for (int i = 0; i < 4; ++i) { const int mrow = m0 + 16 * rt + 4 * kq + i; const unsigned short ov = (unsigned short)f2bf(acc[rt][ct][i]);
                        if (ch == 0) MKB[(size_t)(lay * 512 + mrow) * 256 + col] = ov; else MVT[(size_t)(lay * 256 + col) * 512 + mrow] = ov; } }
        }
    }
}

__device__ __forceinline__ void p3_nsa_mfma(Frame& F, const In& I, unsigned char* ws) {
    OPAQUE_TID(); const int lane = tid_ & 63, wave = __builtin_amdgcn_readfirstlane(tid_ >> 6), n = lane & 15, kq = lane >> 4, r = n, hd = n & 7, qsel = n >> 3; const bool colv = hd < 6;
    LAS unsigned char* bkt = F.lds + TAB_BKT; LAS float* b12 = (LAS float*)(F.lds + TAB_B12); LAS int* SELw = (LAS int*)(F.lds + TAB_SEL) + wave * 128;
    LAS float* OUTw = (LAS float*)(F.lds + RING_OFF + wave * 16384); LAS float* PSw = OUTw + 3072;
    for (int i = tid_; i < 1536; i += NWAVES * 64) bkt[i] = (unsigned char)rel_bucket(i);
    for (int i = tid_; i < 512; i += NWAVES * 64) b12[i] = ((i & 15) < 12) ? I.rel_bias[(i >> 4) * 12 + (i & 15)] * LOG2E : 0.f;
    __syncthreads();
    const bf16* Q0 = (const bf16*)(ws + WS_Q0); const bf16* KV0 = (const bf16*)(ws + WS_KV0); const bf16* QM = (const bf16*)(ws + WS_QM); const bf16* G0 = (const bf16*)(ws + WS_G0);
    const bf16* VT = (const bf16*)(ws + WS_VT); const bf16* KCB = (const bf16*)(ws + WS_KCB); const bf16* VCT = (const bf16*)(ws + WS_VCT);
    const bf16* MKB = (const bf16*)(ws + WS_MKB); const bf16* MVT = (const bf16*)(ws + WS_MVT);
    bf16* CAT = (bf16*)(ws + WS_CAT);
    const int nun = 4 * 128;
    for (int ui = blockIdx.x; ui < nun; ui += F.G) {
        int bg, qt;
        if (F.G == 256) { bg = blockIdx.x & 3; const int idx = blockIdx.x >> 2; qt = (ui < 256) ? idx : 127 - idx; }
        else { bg = ui & 3; qt = ui >> 2; }
        const int b = bg >> 1, g = bg & 1, t0w = 64 * qt + 8 * wave, rowb = b * T;
        const int habs = g * 6 + (colv ? hd : 0);
        const LAS float* b12c = b12 + habs;
        bf16x8 qf[4][2];
#pragma unroll
        for (int p = 0; p < 4; ++p) { const bf16* qp = Q0 + (size_t)(rowb + t0w + 2 * p + qsel) * 768 + habs * 64 + 8 * kq;
#pragma unroll
            for (int ks = 0; ks < 2; ++ks) { bf16x8 v = ldg16(qp + 32 * ks); if (!colv) v = (bf16x8){0, 0, 0, 0, 0, 0, 0, 0}; qf[p][ks] = v; } }
        for (int i = lane; i < 1024; i += 64) PSw[i] = 0.f;
        float m[4], l[4]; f32x4 O[4][4];
        const int ncmax = (t0w + 7 >= 31) ? ((t0w + 7 - 31) / 16 + 1) : 0;
        const bf16* kcb = KCB + (size_t)(bg * 512) * 64; const bf16* vct = VCT + (size_t)(bg * 64) * 512;
#pragma unroll
        for (int p = 0; p < 4; ++p) { m[p] = -1e30f; l[p] = 0.f; }
        for (int key0 = 0; key0 < ncmax; key0 += 32) {
            int r_ = r, kq_ = kq; asm volatile("" : "+v"(r_), "+v"(kq_)); KF k; load_k(k, kcb, 64, key0, r_, kq_);
#pragma unroll
            for (int p = 0; p < 4; ++p) { f32x4 sa, sb; qk(sa, sb, k, qf[p]); const int tcol = t0w + 2 * p + qsel;
                maskbias<MD_CMP>(sa, key0 + 8 * kq_, tcol, true, bkt, b12c); maskbias<MD_CMP>(sb, key0 + 8 * kq_ + 4, tcol, true, bkt, b12c);
                const float mn = fmaxf(m[p], colmax(sa, sb)); float sum = 0.f;
#pragma unroll
                for (int i = 0; i < 4; ++i) sum += __builtin_amdgcn_exp2f(sa[i] - mn) + __builtin_amdgcn_exp2f(sb[i] - mn);
                l[p] = l[p] * __builtin_amdgcn_exp2f(m[p] - mn) + sum; m[p] = mn; __builtin_amdgcn_sched_barrier(0); }
        }
        float invl[4];
#pragma unroll
        for (int p = 0; p < 4; ++p) { const float lt = kqsum(l[p]); invl[p] = lt > 0.f ? 1.f / lt : 0.f; }
#pragma unroll
        for (int p = 0; p < 4; ++p)
#pragma unroll
            for (int dt = 0; dt < 4; ++dt) O[p][dt] = (f32x4){0.f, 0.f, 0.f, 0.f};
        float carry[4] = {0.f, 0.f, 0.f, 0.f};
        for (int key0 = 0; key0 < ncmax; key0 += 32) {
            int r_ = r, kq_ = kq; asm volatile("" : "+v"(r_), "+v"(kq_)); KF k; load_k(k, kcb, 64, key0, r_, kq_); VF v; load_vt(v, vct, 512, key0, r_, kq_);
#pragma unroll
            for (int p = 0; p < 4; ++p) { f32x4 sa, sb; qk(sa, sb, k, qf[p]); const int tcol = t0w + 2 * p + qsel;
                maskbias<MD_CMP>(sa, key0 + 8 * kq_, tcol, true, bkt, b12c); maskbias<MD_CMP>(sb, key0 + 8 * kq_ + 4, tcol, true, bkt, b12c);
                f32x4 pa, pb;
#pragma unroll
                for (int i = 0; i < 4; ++i) { pa[i] = __builtin_amdgcn_exp2f(sa[i] - m[p]) * invl[p]; pb[i] = __builtin_amdgcn_exp2f(sb[i] - m[p]) * invl[p]; }
                pv(O[p], v, pack8(pa, pb));
                float wA = (pa[0] + pa[1]) + (pa[2] + pa[3]), wB = pa[3] + ((pb[0] + pb[1]) + (pb[2] + pb[3])), wC = pb[3];
                if (!colv) { wA = 0.f; wB = 0.f; wC = 0.f; }
                const float up = __shfl(wC, (lane + 48) & 63);
                const float prevC = (kq == 0) ? carry[p] : up; carry[p] = up;
                float a0 = wA + prevC, a1 = wB;
                a0 += __shfl_xor(a0, 1); a1 += __shfl_xor(a1, 1); a0 += __shfl_xor(a0, 2); a1 += __shfl_xor(a1, 2); a0 += __shfl_xor(a0, 4); a1 += __shfl_xor(a1, 4);
                if (hd == 0) { LAS float* ps = PSw + (2 * p + qsel) * 128 + (key0 >> 2) + 2 * kq; ps[0] = a0; ps[1] = a1; } __builtin_amdgcn_sched_barrier(0); }
        }
        if (ncmax > 0 && ncmax <= 480) {
            const int jn = ((ncmax + 31) >> 5) * 8;
#pragma unroll
            for (int p = 0; p < 4; ++p) { float a0 = carry[p]; a0 += __shfl_xor(a0, 1); a0 += __shfl_xor(a0, 2); a0 += __shfl_xor(a0, 4); if (hd == 0 && kq == 0) PSw[(2 * p + qsel) * 128 + jn] = a0; }
        }
        {
#pragma unroll
            for (int p = 0; p < 4; ++p) { const size_t row = (size_t)(rowb + t0w + 2 * p + qsel);
                const float gz = bf2f(G0[row * 256 + habs * 3 + 0]) + I.nsa_gate_b[habs * 3 + 0]; out_add(OUTw, p, n, kq, O[p], 1.f / (1.f + __expf(-gz)), true); }
        }
        if (qt >= 16) {
            for (int q = 0; q < 8; ++q) {
                float v0 = PSw[q * 128 + lane], v1 = PSw[q * 128 + 64 + lane];
                if (lane < 1 || lane > qt - 2) v0 = -1.f; if (lane + 64 > qt - 2) v1 = -1.f;
                for (int s = 0; s < 13; ++s) { const float mx = wmax64(fmaxf(v0, v1));
                    const unsigned long long b0 = __ballot(v0 == mx); int j;
                    if (b0) { j = __builtin_ctzll(b0); if (lane == j) v0 = -1.f; } else { const unsigned long long b1 = __ballot(v1 == mx); j = __builtin_ctzll(b1); if (lane == j) v1 = -1.f; j += 64; }
                    if (lane == 0) SELw[q * 16 + s] = j; }
            }
        }
        const bf16* ksb = KV0 + (size_t)rowb * 512 + 256 + g * 64; const bf16* vst = VT + (size_t)(g * 64) * M + rowb;
#pragma unroll
        for (int p = 0; p < 4; ++p) {
            float ms = -1e30f, ls = 0.f; f32x4 Os[4];
#pragma unroll
            for (int dt = 0; dt < 4; ++dt) Os[dt] = (f32x4){0.f, 0.f, 0.f, 0.f};
            const int tcol = t0w + 2 * p + qsel;
            const int nd = (qt >= 16) ? 3 : qt + 1;
            for (int di = 0; di < nd; ++di) { const int j = (qt >= 16) ? (di == 0 ? 0 : qt - 2 + di) : di;
#pragma unroll
                for (int h2 = 0; h2 < 2; ++h2) { const int key0 = 64 * j + 32 * h2;
                    int r_ = r, kq_ = kq; asm volatile("" : "+v"(r_), "+v"(kq_)); KF k; load_k(k, ksb, 512, key0, r_, kq_); VF v; load_vt(v, vst, M, key0, r_, kq_);
                    f32x4 sa, sb; qk(sa, sb, k, qf[p]);
                    maskbias<MD_BLK>(sa, key0 + 8 * kq_, tcol, true, bkt, b12c); maskbias<MD_BLK>(sb, key0 + 8 * kq_ + 4, tcol, true, bkt, b12c);
                    pv(Os, v, sm_update(sa, sb, ms, ls, Os)); } }
            if (qt >= 16) {
                for (int e = 0; e < 26; ++e) { const int qi = e / 13, sl = e % 13; const int j = __builtin_amdgcn_readfirstlane(SELw[(2 * p + qi) * 16 + sl]);
#pragma unroll
                    for (int h2 = 0; h2 < 2; ++h2) { const int key0 = 64 * j + 32 * h2;
                        int r_ = r, kq_ = kq; asm volatile("" : "+v"(r_), "+v"(kq_)); KF k; load_k(k, ksb, 512, key0, r_, kq_); VF v; load_vt(v, vst, M, key0, r_, kq_);
                        f32x4 sa, sb; qk(sa, sb, k, qf[p]);
                        maskbias<MD_BLK>(sa, key0 + 8 * kq_, tcol, qsel == qi, bkt, b12c); maskbias<MD_BLK>(sb, key0 + 8 * kq_ + 4, tcol, qsel == qi, bkt, b12c);
                        pv(Os, v, sm_update(sa, sb, ms, ls, Os)); } }
            }
            { const size_t row = (size_t)(rowb + tcol);
              const float gz = bf2f(G0[row * 256 + habs * 3 + 1]) + I.nsa_gate_b[habs * 3 + 1]; out_add(OUTw, p, n, kq, Os, (1.f / (1.f + __expf(-gz))) / kqsum(ls), false); }
        }
        const bf16* kwb = KV0 + (size_t)rowb * 512 + 384 + g * 64; const bf16* vwt = VT + (size_t)(128 + g * 64) * M + rowb;
#pragma unroll
        for (int p = 0; p < 4; ++p) { m[p] = -1e30f; l[p] = 0.f;
#pragma unroll
            for (int dt = 0; dt < 4; ++dt) O[p][dt] = (f32x4){0.f, 0.f, 0.f, 0.f}; }
        { const int kstart = (t0w - 511 > 0) ? ((t0w - 511) & ~31) : 0;
          for (int key0 = kstart; key0 <= t0w + 7; key0 += 32) {
              int r_ = r, kq_ = kq; asm volatile("" : "+v"(r_), "+v"(kq_)); KF k; load_k(k, kwb, 512, key0, r_, kq_); VF v; load_vt(v, vwt, M, key0, r_, kq_);
#pragma unroll
              for (int p = 0; p < 4; ++p) { f32x4 sa, sb; qk(sa, sb, k, qf[p]); const int tcol = t0w + 2 * p + qsel;
                  maskbias<MD_WIN>(sa, key0 + 8 * kq_, tcol, true, bkt, b12c); maskbias<MD_WIN>(sb, key0 + 8 * kq_ + 4, tcol, true, bkt, b12c);
                  pv(O[p], v, sm_update(sa, sb, m[p], l[p], O[p])); __builtin_amdgcn_sched_barrier(0); } } }
#pragma unroll
        for (int p = 0; p < 4; ++p) { const size_t row = (size_t)(rowb + t0w + 2 * p + qsel);
            const float gz = bf2f(G0[row * 256 + habs * 3 + 2]) + I.nsa_gate_b[habs * 3 + 2]; out_add(OUTw, p, n, kq, O[p], (1.f / (1.f + __expf(-gz))) / kqsum(l[p]), false); }
        int ln_ = lane; asm volatile("" : "+v"(ln_));
#pragma unroll 1
        for (int i = 0; i < 12; ++i) { const int e = i * 64 + ln_, q = e / 96, c4 = e % 96; const f32x4 v = ((const LAS f32x4*)OUTw)[e];
            *(uint2*)(CAT + (size_t)(rowb + t0w + q) * 1024 + g * 384 + 4 * c4) = make_uint2(pk2(v[0], v[1]), pk2(v[2], v[3])); }
#pragma unroll 1
        for (int h2 = 0; h2 < 2; ++h2) { const int hm = 2 * g + h2;
            bf16x8 qm[2]; { const bf16* qp = QM + (size_t)(rowb + t0w + (n & 7)) * 256 + hm * 64 + 8 * kq; qm[0] = ldg16(qp); qm[1] = ldg16(qp + 32); if (n >= 8) { qm[0] = (bf16x8){0, 0, 0, 0, 0, 0, 0, 0}; qm[1] = qm[0]; } }
            float mm = -1e30f, ll = 0.f; f32x4 Om[4];
#pragma unroll
            for (int dt = 0; dt < 4; ++dt) Om[dt] = (f32x4){0.f, 0.f, 0.f, 0.f};
            const bf16* mk = MKB + (size_t)(b * 256) * 256 + hm * 64; const bf16* mvt = MVT + (size_t)(hm * 64) * 512 + b * 256;
            for (int key0 = 0; key0 < 256; key0 += 32) { int r_ = r, kq_ = kq; asm volatile("" : "+v"(r_), "+v"(kq_)); KF k; load_k(k, mk, 256, key0, r_, kq_); VF v; load_vt(v, mvt, 512, key0, r_, kq_);
                f32x4 sa, sb; qk(sa, sb, k, qm); pv(Om, v, sm_update(sa, sb, mm, ll, Om)); }
            const float il = 1.f / kqsum(ll);
            if (n < 8) { bf16* op = CAT + (size_t)(rowb + t0w + n) * 1024 + 768 + hm * 64 + 4 * kq;
#pragma unroll
                for (int dt = 0; dt < 4; ++dt) *(uint2*)(op + 16 * dt) = make_uint2(pk2(Om[dt][0] * il, Om[dt][1] * il), pk2(Om[dt][2] * il, Om[dt][3] * il)); }
        }
    }
}

__device__ __forceinline__ void p10_dsa_norm(Frame& F, const In& I, unsigned char* ws) {
    OPAQUE_TID(); const int gw = F.vcu * NWAVES + (tid_ >> 6), NGW = F.G * NWAVES, lane = tid_ & 63;
    const bf16* PR = (const bf16*)(ws + WS_PROJ1); bf16* CQ = (bf16*)(ws + WS_CQ); bf16* CKV = (bf16*)(ws + WS_CKV); bf16* KIDX = (bf16*)(ws + WS_KIDX); float* WIDX = (float*)(ws + WS_WIDX);
    for (int m = gw; m < M; m += NGW) {
        const bf16* pr = PR + (size_t)m * 768;
        float a[4]; ld4bf(pr + 4 * lane, a);
        float s = wave_sum(a[0] * a[0] + a[1] * a[1] + a[2] * a[2] + a[3] * a[3]); float r = rsqrtf(s * (1.f / 256.f) + EPSF);
        const float4 gq = *(const float4*)(I.q_norm + 4 * lane);
        *(uint2*)(CQ + (size_t)m * 256 + 4 * lane) = make_uint2(pk2((a[0] * r) * gq.x, (a[1] * r) * gq.y), pk2((a[2] * r) * gq.z, (a[3] * r) * gq.w));
        const unsigned u = *(const unsigned*)(pr + 256 + 2 * lane); const float c0 = bflo(u), c1 = bfhi(u);
        s = wave_sum(c0 * c0 + c1 * c1); r = rsqrtf(s * (1.f / 128.f) + EPSF);
        *(unsigned*)(CKV + (size_t)m * 128 + 2 * lane) = pk2((c0 * r) * I.kv_norm[2 * lane], (c1 * r) * I.kv_norm[2 * lane + 1]);
        const float k0 = bf2f(pr[384 + lane]);
        s = wave_sum(k0 * k0); r = rsqrtf(s * (1.f / 64.f) + EPSF);
        KIDX[(size_t)m * 64 + lane] = (bf16)f2bf((k0 * r) * I.kidx_norm[lane]);
        if (lane < 8) WIDX[(size_t)m * 8 + lane] = bf2f(pr[448 + lane]) * (0.35355339059327373f * 0.125f);
    }
}

#define MFMA32(A, B, C) __builtin_amdgcn_mfma_f32_32x32x16_bf16((A), (B), (C), 0, 0, 0)
typedef float f32x16 __attribute__((ext_vector_type(16)));
constexpr int XL_OFF = LDSCTL_OFF + 1024;
constexpr int IDX_HIST = XL_OFF, IDX_CAND = XL_OFF + 8192, IDX_MM = XL_OFF + 16384, IDX_CAP = 1024;
static_assert(IDX_MM + 8 * 4 * 2 * 4 <= LDS_BYTES, "LDS map (indexer)");
__device__ __forceinline__ float wmin64(float v) {
#pragma unroll
    for (int o = 1; o < 64; o <<= 1) v = fminf(v, __shfl_xor(v, o));
    return v;
}
__device__ __forceinline__ void p12_index_mfma(Frame& F, const In& I, unsigned char* ws) {
    OPAQUE_TID(); const int lane = tid_ & 63, wave = __builtin_amdgcn_readfirstlane(tid_ >> 6), key = lane & 31, half = lane >> 5;
    LAS float* SC = (LAS float*)(F.lds + RING_OFF);
    LAS float* MMw = (LAS float*)(F.lds + IDX_MM);
    const bf16* QI = (const bf16*)(ws + WS_QI); const bf16* KIDX = (const bf16*)(ws + WS_KIDX); const float* WIDX = (const float*)(ws + WS_WIDX);
    unsigned short* SEL = (unsigned short*)(ws + WS_SEL); int* CNT = (int*)(ws + WS_CNT);
    const int NG = M / 4, per = (NG + F.G - 1) / F.G;
    for (int j = 0; j < per; ++j) {
        const int u = j * F.G + ((j & 1) ? (F.G - 1 - (int)blockIdx.x) : (int)blockIdx.x);
        if (u >= NG) break;
        const int gi = (u & 1) * (NG / 2) + (u >> 1);
        const int row0 = 4 * gi, b = row0 / T, t0 = row0 % T, rowb = b * T;
        if (t0 < 256) {
            if (wave < 4) { const int t = t0 + wave; unsigned short* so = SEL + (size_t)(row0 + wave) * 256;
#pragma unroll
                for (int i = 0; i < 4; ++i) { const int s = lane + 64 * i; so[s] = (unsigned short)(s <= t ? s : 0); }
                if (lane == 0) CNT[row0 + wave] = t + 1; }
            continue;
        }
        {
            const int rho = lane & 31, a = rho >> 2, qA = ((a >> 2) & 1) + 2 * (a & 1), hdA = 4 * ((a >> 1) & 1) + (rho & 3);
            bf16x8 qa[4];
#pragma unroll
            for (int ks = 0; ks < 4; ++ks) qa[ks] = ldg16(QI + (size_t)(row0 + qA) * 512 + hdA * 64 + 16 * ks + 8 * half);
            float w0[8], w1[8];
            { const float4 x0 = *(const float4*)(WIDX + (size_t)(row0 + 2 * half) * 8), x1 = *(const float4*)(WIDX + (size_t)(row0 + 2 * half) * 8 + 4);
              const float4 y0 = *(const float4*)(WIDX + (size_t)(row0 + 2 * half + 1) * 8), y1 = *(const float4*)(WIDX + (size_t)(row0 + 2 * half + 1) * 8 + 4);
              w0[0] = x0.x; w0[1] = x0.y; w0[2] = x0.z; w0[3] = x0.w; w0[4] = x1.x; w0[5] = x1.y; w0[6] = x1.z; w0[7] = x1.w;
              w1[0] = y0.x; w1[1] = y0.y; w1[2] = y0.z; w1[3] = y0.w; w1[4] = y1.x; w1[5] = y1.y; w1[6] = y1.z; w1[7] = y1.w; }
            const int tq0 = t0 + 2 * half, tq1 = tq0 + 1, nt = (t0 + 3) / 32 + 1;
            float mn0 = INFINITY, mx0 = -INFINITY, mn1 = INFINITY, mx1 = -INFINITY;
            for (int tile = wave; tile < nt; tile += NWAVES) {
                const int kpos = 32 * tile + key; const bf16* kp = KIDX + (size_t)(rowb + kpos) * 64 + 8 * half;
                bf16x8 kb[4];
#pragma unroll
                for (int ks = 0; ks < 4; ++ks) kb[ks] = ldg16(kp + 16 * ks);
                f32x16 c = {0.f, 0.f, 0.f, 0.f, 0.f, 0.f, 0.f, 0.f, 0.f, 0.f, 0.f, 0.f, 0.f, 0.f, 0.f, 0.f};
#pragma unroll
                for (int ks = 0; ks < 4; ++ks) c = MFMA32(qa[ks], kb[ks], c);
                float s0 = 0.f, s1 = 0.f;
#pragma unroll
                for (int h = 0; h < 8; ++h) { s0 += fmaxf(c[h], 0.f) * w0[h]; s1 += fmaxf(c[8 + h], 0.f) * w1[h]; }
                s0 += 0.f; s1 += 0.f;
                const bool ok0 = kpos <= tq0, ok1 = kpos <= tq1;
                SC[(2 * half) * 8192 + kpos] = ok0 ? s0 : -INFINITY; SC[(2 * half + 1) * 8192 + kpos] = ok1 ? s1 : -INFINITY;
                if (ok0) { mn0 = fminf(mn0, s0); mx0 = fmaxf(mx0, s0); } if (ok1) { mn1 = fminf(mn1, s1); mx1 = fmaxf(mx1, s1); }
            }
#pragma unroll
            for (int o = 1; o < 32; o <<= 1) { mn0 = fminf(mn0, __shfl_xor(mn0, o)); mx0 = fmaxf(mx0, __shfl_xor(mx0, o)); mn1 = fminf(mn1, __shfl_xor(mn1, o)); mx1 = fmaxf(mx1, __shfl_xor(mx1, o)); }
            if (key == 0) { LAS float* mm = MMw + (wave * 4 + 2 * half) * 2; mm[0] = mn0; mm[1] = mx0; mm[2] = mn1; mm[3] = mx1; }
        }
        __syncthreads();
        if (wave < 4) {
            const int q = wave, t = t0 + q, n = t + 1; const LAS float* sc = SC + q * 8192;
            LAS unsigned* hist = (LAS unsigned*)(F.lds + IDX_HIST) + q * 512; LAS unsigned short* cand = (LAS unsigned short*)(F.lds + IDX_CAND) + q * IDX_CAP;
            unsigned short* so = SEL + (size_t)(row0 + q) * 256;
            float lo = INFINITY, hi = -INFINITY;
#pragma unroll
            for (int w = 0; w < 8; ++w) { lo = fminf(lo, MMw[(w * 4 + q) * 2]); hi = fmaxf(hi, MMw[(w * 4 + q) * 2 + 1]); }
            int krem = 256, bstar = 0, ncand = 0; float scale = 0.f; bool eq = false;
            for (int round = 0; round < 64; ++round) {
                if (!(hi > lo)) { eq = true; break; }
                scale = 1024.f / (hi - lo);
#pragma unroll
                for (int i = 0; i < 8; ++i) hist[lane + 64 * i] = 0u;
                for (int i0 = 0; i0 < n; i0 += 64) { const int idx = i0 + lane; const float v = (idx < n) ? sc[idx] : -INFINITY;
                    if (v >= lo && v <= hi) { int bb = (int)((v - lo) * scale); bb = bb > 1023 ? 1023 : bb; atomicAdd((unsigned*)&hist[bb >> 1], 1u << (16 * (bb & 1))); } }
                unsigned cw[8]; unsigned S = 0u;
#pragma unroll
                for (int i = 0; i < 8; ++i) { cw[i] = hist[8 * lane + i]; S += (cw[i] & 0xffffu) + (cw[i] >> 16); }
                unsigned x = S;
#pragma unroll
                for (int o = 1; o < 64; o <<= 1) { const unsigned y = __shfl_down(x, o); if (lane + o < 64) x += y; }
                const unsigned above = x - S;
                const bool found = (above < (unsigned)krem) && ((unsigned)krem <= above + S);
                const int fl = __builtin_ctzll(__ballot(found));
                int bs = 0; unsigned acc = above, cb = 0u;
                { bool done = false;
#pragma unroll
                  for (int i = 15; i >= 0; --i) { const unsigned cnt_ = (i & 1) ? (cw[i >> 1] >> 16) : (cw[i >> 1] & 0xffffu);
                      if (!done) { if (acc + cnt_ >= (unsigned)krem) { bs = 16 * lane + i; cb = cnt_; done = true; } else acc += cnt_; } } }
                bstar = __shfl(bs, fl); const int nab = (int)__shfl((int)acc, fl); ncand = (int)__shfl((int)cb, fl);
                krem -= nab;
                if (ncand <= IDX_CAP) break;
                float nlo = INFINITY, nhi = -INFINITY;
                for (int i0 = 0; i0 < n; i0 += 64) { const int idx = i0 + lane; const float v = (idx < n) ? sc[idx] : -INFINITY;
                    if (v >= lo && v <= hi) { int bb = (int)((v - lo) * scale); bb = bb > 1023 ? 1023 : bb; if (bb == bstar) { nlo = fminf(nlo, v); nhi = fmaxf(nhi, v); } } }
                lo = wmin64(nlo); hi = wmax64(nhi);
            }
            const int nabove = 256 - krem; int bsel = 0, bcand = 0;
            for (int i0 = 0; i0 < n; i0 += 64) { const int idx = i0 + lane; const float v = (idx < n) ? sc[idx] : -INFINITY;
                bool sel, cnd;
                if (eq) { sel = v > hi; cnd = (v == hi); }
                else { const bool in = (v >= lo && v <= hi); int bb = (int)((v - lo) * scale); bb = bb > 1023 ? 1023 : bb; sel = (v > hi) || (in && bb > bstar); cnd = in && bb == bstar; }
                const unsigned long long ms = __ballot(sel), mc = __ballot(cnd), lt = (1ull << lane) - 1ull;
                if (sel) so[bsel + __builtin_popcountll(ms & lt)] = (unsigned short)idx;
                if (cnd) { const int pc = bcand + __builtin_popcountll(mc & lt);
                    if (eq) { if (pc < krem) so[nabove + pc] = (unsigned short)idx; } else if (pc < IDX_CAP) cand[pc] = (unsigned short)idx; }
                bsel += __builtin_popcountll(ms); bcand += __builtin_popcountll(mc);
            }
            if (!eq) {
                for (int i = lane; i < ncand; i += 64) { const int ii = cand[i]; const float vi = sc[ii]; int rank = 0;
                    for (int jj = 0; jj < ncand; ++jj) { const int ij = cand[jj]; const float vj = sc[ij]; rank += ((vj > vi) || (vj == vi && ij < ii)) ? 1 : 0; }
                    if (rank < krem) so[nabove + rank] = (unsigned short)ii; }
            }
            if (lane == 0) CNT[row0 + q] = 256;
        }
        __syncthreads();
    }
}

__device__ __forceinline__ unsigned offb(unsigned row, unsigned ch) { return 256u * row + 16u * (ch ^ (((row & 3u) << 2) | ((row >> 2) & 3u))); }
typedef short v4i16_t __attribute__((ext_vector_type(4)));
__device__ __forceinline__ v4i16_t trrd(const LAS unsigned char* p) { return __builtin_amdgcn_ds_read_tr16_b64_v4i16((LAS v4i16_t*)p); }
__device__ __forceinline__ void p13_dsa_mfma(Frame& F, const In& I, unsigned char* ws) {
    OPAQUE_TID(); const int lane = tid_ & 63, wave = __builtin_amdgcn_readfirstlane(tid_ >> 6), n = lane & 15, kq = lane >> 4;
    LAS unsigned char* bkt = F.lds + TAB_BKT; LAS float* b12 = (LAS float*)(F.lds + TAB_B12);
    for (int i = tid_; i < 1536; i += NWAVES * 64) bkt[i] = (unsigned char)rel_bucket(i);
    for (int i = tid_; i < 512; i += NWAVES * 64) b12[i] = ((i & 15) < 12) ? I.rel_bias[(i >> 4) * 12 + (i & 15)] * LOG2E : 0.f;
    __syncthreads();
    LAS unsigned char* img = F.lds + RING_OFF + wave * 10240; LAS int* sidx = (LAS int*)(img + 8192);
    const bf16* QA = (const bf16*)(ws + WS_QA); const bf16* CKV = (const bf16*)(ws + WS_CKV); const bf16* PR = (const bf16*)(ws + WS_PROJ1);
    const unsigned short* SEL = (const unsigned short*)(ws + WS_SEL); const int* CNT = (const int*)(ws + WS_CNT);
    const bf16* MKB = (const bf16*)(ws + WS_MKB) + (size_t)512 * 256; const bf16* MVT = (const bf16*)(ws + WS_MVT) + (size_t)256 * 512;
    bf16* CAT1 = (bf16*)(ws + WS_CAT1);
    const int gw = blockIdx.x * NWAVES + wave, NGW = F.G * NWAVES;
    const LAS float* b12c = b12 + (n < 12 ? n : 0);
    for (int row = gw; row < M; row += NGW) {
        const int b = row / T, t = row % T, rowb = b * T, cnt = __builtin_amdgcn_readfirstlane(CNT[row]);
#pragma unroll
        for (int i = 0; i < 4; ++i) sidx[lane + 64 * i] = (int)SEL[(size_t)row * 256 + lane + 64 * i];
        bf16x8 qf[4];
#pragma unroll
        for (int ks = 0; ks < 4; ++ks) { bf16x8 v = ldg16(QA + (size_t)row * 1536 + (n < 12 ? n : 0) * 128 + 32 * ks + 8 * kq); if (n >= 12) v = (bf16x8){0, 0, 0, 0, 0, 0, 0, 0}; qf[ks] = v; }
        float m = -1e30f, l = 0.f; f32x4 O[8];
#pragma unroll
        for (int rt = 0; rt < 8; ++rt) O[rt] = (f32x4){0.f, 0.f, 0.f, 0.f};
        for (int c0 = 0; c0 < cnt; c0 += 32) {
            int ln_ = lane; asm volatile("" : "+v"(ln_));
#pragma unroll
            for (int i = 0; i < 8; ++i) { const int cid = ln_ + 64 * i, rr = cid >> 4, ch = cid & 15; const int e = c0 + rr; const int kidx = sidx[e < cnt ? e : 0];
                const bf16x8 v = ldg16(CKV + (size_t)(rowb + kidx) * 128 + 8 * ch); *(LAS bf16x8*)(img + offb(rr, ch)) = v; }
            f32x4 sa = {0.f, 0.f, 0.f, 0.f}, sb = {0.f, 0.f, 0.f, 0.f};
            { const unsigned ra = 8u * ((unsigned)(ln_ & 15) >> 2) + ((unsigned)ln_ & 3u), kq_ = (unsigned)ln_ >> 4;
#pragma unroll
              for (int s = 0; s < 4; ++s) { const bf16x8 ka = *(const LAS bf16x8*)(img + offb(ra, 4 * s + kq_)); const bf16x8 kb = *(const LAS bf16x8*)(img + offb(ra + 4, 4 * s + kq_));
                  sa = MFMA16(ka, qf[s], sa); sb = MFMA16(kb, qf[s], sb); } }
#pragma unroll
            for (int i = 0; i < 4; ++i) { const int ea = c0 + 8 * kq + i, eb = ea + 4;
                { const int d = t - sidx[ea < cnt ? ea : 0]; const int dc = d > 1535 ? 1535 : (d < 0 ? 0 : d); sa[i] = (ea < cnt) ? sa[i] + b12c[(int)bkt[dc] * 16] : -INFINITY; }
                { const int d = t - sidx[eb < cnt ? eb : 0]; const int dc = d > 1535 ? 1535 : (d < 0 ? 0 : d); sb[i] = (eb < cnt) ? sb[i] + b12c[(int)bkt[dc] * 16] : -INFINITY; } }
            const float mnw = fmaxf(m, colmax(sa, sb)); const float al = __builtin_amdgcn_exp2f(m - mnw); m = mnw;
            f32x4 pa, pb; float sum = 0.f;
#pragma unroll
            for (int i = 0; i < 4; ++i) { pa[i] = __builtin_amdgcn_exp2f(sa[i] - mnw); pb[i] = __builtin_amdgcn_exp2f(sb[i] - mnw); sum += pa[i] + pb[i]; }
            l = l * al + sum;
            const bf16x8 pf = pack8(pa, pb);
            { const unsigned g_ = (unsigned)ln_ >> 4, q_ = ((unsigned)ln_ & 15u) >> 2, p_ = (unsigned)ln_ & 3u;
#pragma unroll
              for (int rt = 0; rt < 8; ++rt) { const v4i16_t x0 = trrd(img + offb(8 * g_ + q_, 2 * rt + (p_ >> 1)) + 8 * (p_ & 1)), x1 = trrd(img + offb(8 * g_ + 4 + q_, 2 * rt + (p_ >> 1)) + 8 * (p_ & 1));
                  const bf16x8 vf = {x0[0], x0[1], x0[2], x0[3], x1[0], x1[1], x1[2], x1[3]};
                  O[rt] = MFMA16(vf, pf, O[rt] * al); } }
        }
        const float il = 1.f / kqsum(l);
        if (n < 12) { bf16* op = CAT1 + (size_t)row * 1792 + n * 128 + 4 * kq;
#pragma unroll
            for (int rt = 0; rt < 8; ++rt) *(uint2*)(op + 16 * rt) = make_uint2(pk2(O[rt][0] * il, O[rt][1] * il), pk2(O[rt][2] * il, O[rt][3] * il)); }
    }
    for (int u8 = gw; u8 < M / 8; u8 += NGW) {
        const int row0 = 8 * u8, b = row0 / T; const int r = n;
#pragma unroll 1
        for (int hm = 0; hm < 4; ++hm) {
            bf16x8 qm[2]; { const bf16* qp = PR + (size_t)(row0 + (n & 7)) * 768 + 456 + hm * 64 + 8 * kq; qm[0] = ldg16(qp); qm[1] = ldg16(qp + 32); if (n >= 8) { qm[0] = (bf16x8){0, 0, 0, 0, 0, 0, 0, 0}; qm[1] = qm[0]; } }
            float mm = -1e30f, ll = 0.f; f32x4 Om[4];
#pragma unroll
            for (int dt = 0; dt < 4; ++dt) Om[dt] = (f32x4){0.f, 0.f, 0.f, 0.f};
            const bf16* mk = MKB + (size_t)(b * 256) * 256 + hm * 64; const bf16* mvt = MVT + (size_t)(hm * 64) * 512 + b * 256;
            for (int key0 = 0; key0 < 256; key0 += 32) { int r_ = r, kq_ = kq; asm volatile("" : "+v"(r_), "+v"(kq_)); KF k; load_k(k, mk, 256, key0, r_, kq_); VF v; load_vt(v, mvt, 512, key0, r_, kq_);
                f32x4 sa, sb; qk(sa, sb, k, qm); sa = sa * (0.125f * LOG2E); sb = sb * (0.125f * LOG2E); pv(Om, v, sm_update(sa, sb, mm, ll, Om)); }
            const float il = 1.f / kqsum(ll);
            if (n < 8) { bf16* op = CAT1 + (size_t)(row0 + n) * 1792 + 1536 + hm * 64 + 4 * kq;
#pragma unroll
                for (int dt = 0; dt < 4; ++dt) *(uint2*)(op + 16 * dt) = make_uint2(pk2(Om[dt][0] * il, Om[dt][1] * il), pk2(Om[dt][2] * il, Om[dt][3] * il)); }
        }
    }
}

struct Args { In in; float* out; unsigned char* ws; int ph_lo, ph_hi; };
__global__ void __launch_bounds__(NWAVES * 64, 2) mk_fwd(Args args) {
    extern __shared__ __attribute__((aligned(16))) unsigned char lds[];
    Frame F;
    F.lds = (LAS unsigned char*)lds; F.MISC = (volatile LAS unsigned*)(F.lds + MISC_OFF);
    F.tid = threadIdx.x; F.lane = F.tid & 63; F.wave = __builtin_amdgcn_readfirstlane(F.tid >> 6);
    F.G = gridDim.x; { const int bx = blockIdx.x; F.vcu = (F.G % 8 == 0) ? (bx % 8) * (F.G / 8) + bx / 8 : bx; }
    unsigned char* ws = args.ws; const In& I = args.in; float* out = args.out;
    F.ctl = (gu32*)(ws + WS_CTL);
    for (int u = F.tid; u < (LDS_BYTES - LDSCTL_OFF) / 4; u += NWAVES * 64) ((LAS unsigned*)(F.lds + LDSCTL_OFF))[u] = 0u;
    __syncthreads();
    XcdBarrier bar; bar.bar = (unsigned*)(F.ctl + CW_BAR); bar.x = 0; bar.st = nullptr;
    if (!MK_SPLIT) bar = xcd_barrier_post((unsigned*)(F.ctl + CW_BAR), F.MISC + 8);
    const int lo = args.ph_lo, hi = args.ph_hi;
#ifndef PH_MASK
#define PH_MASK 0xFFFFFFFFu
#endif
#define IN(k) ((((PH_MASK) >> ((k) % 32)) & 1u) && lo <= (k) && (k) < hi)
#define SEAM(k) do { if (IN(k) && IN((k) + 1)) xcd_barrier(bar); } while (0)
#ifndef REP_MASK
#define REP_MASK 0u
#endif
#define REPS(k) (1 + (int)(((REP_MASK) >> (k)) & 1u))
    bf16* XN = (bf16*)(ws + WS_XN); bf16* CAT = (bf16*)(ws + WS_CAT); bf16* ACT = (bf16*)(ws + WS_ACT);

    if (IN(0)) { for (int r_ = 0; r_ < REPS(0); ++r_) { p0_prologue(F, I, ws); if (r_ + 1 < REPS(0)) xcd_barrier(bar); } SEAM(0); }
#pragma unroll 1
    for (int L = 0; L < 2; ++L) {
        if (L == 0) {
            if (IN(1)) {
                pg8::Gemm g{XN, (const bf16*)(ws + WS_WIN0), M, 1792, D}; pg8::StaticOrder S; S.init(M, 1792, F.G, (int)blockIdx.x);
                pg8::EpiRoute<0> E{ws};
                pg8::gemm_phase<pg8::EpiRoute<0>, pg8::StaticOrder, true, true>(F.lds + RING_OFF, g, S, E);
                pg8::Gemm g2{(const bf16*)(ws + WS_WVT), XN, 256, M, D}; pg8::StaticOrder S2; S2.init(256, M, F.G, (int)((blockIdx.x + 64) % F.G));
                pg8::EpiRoute<3> E2{ws};
                pg8::gemm_phase<pg8::EpiRoute<3>, pg8::StaticOrder, true, true>(F.lds + RING_OFF, g2, S2, E2);
                SEAM(1);
            }
            if (IN(2)) { for (int r_ = 0; r_ < REPS(2); ++r_) { p2_mfma(F, I, ws); if (r_ + 1 < REPS(2)) xcd_barrier(bar); } SEAM(2); }
            if (IN(3)) { for (int r_ = 0; r_ < REPS(3); ++r_) { p3_nsa_mfma(F, I, ws); if (r_ + 1 < REPS(3)) xcd_barrier(bar); } SEAM(3); }
        } else {
            if (IN(9)) {
                pg8::Gemm g{XN, (const bf16*)(ws + WS_WIN1), M, 768, D}; pg8::StaticOrder S; S.init(M, 768, F.G, (int)blockIdx.x);
                pg8::EpiRoute<1> E{ws};
                pg8::gemm_phase<pg8::EpiRoute<1>, pg8::StaticOrder, true, true>(F.lds + RING_OFF, g, S, E);
                SEAM(9);
            }
            if (IN(10)) { p10_dsa_norm(F, I, ws); SEAM(10); }
            if (IN(11)) {
                pg8::Gemm g{(const bf16*)(ws + WS_CQ), (const bf16*)(ws + WS_WQ2), M, 2048, 256}; pg8::StaticOrder S; S.init(M, 2048, F.G, (int)blockIdx.x);
                pg8::EpiRoute<2> E{ws};
                pg8::gemm_phase<pg8::EpiRoute<2>, pg8::StaticOrder, true, true>(F.lds + RING_OFF, g, S, E);
                SEAM(11);
            }
            if (IN(12)) { for (int r_ = 0; r_ < REPS(12); ++r_) { p12_index_mfma(F, I, ws); if (r_ + 1 < REPS(12)) xcd_barrier(bar); } SEAM(12); }
            if (IN(13)) { for (int r_ = 0; r_ < REPS(13); ++r_) { p13_dsa_mfma(F, I, ws); if (r_ + 1 < REPS(13)) xcd_barrier(bar); } SEAM(13); }
        }
        const int pb = L ? 14 : 4;
        if (IN(pb)) {
            pg8::Gemm g{L ? (const bf16*)(ws + WS_CAT1) : CAT, L ? (const bf16*)(ws + WS_WO1F) : (const bf16*)(ws + WS_WO), M, D, L ? 1792 : D}; pg8::StaticOrder S; S.init(M, D, F.G, (int)blockIdx.x);
            pg8::EpiResid E{L ? (const float*)out : I.x, out, D, 0};
            pg8::gemm_phase<pg8::EpiResid, pg8::StaticOrder, true, true>(F.lds + RING_OFF, g, S, E);
            SEAM(pb);
        }
        if (IN(pb + 1)) { norm_phase(F, out, I.norm_ffn + L * D, XN); SEAM(pb + 1); }
        if (IN(pb + 2)) {
            pg8::Gemm g{XN, (const bf16*)(ws + WS_WGU) + (size_t)L * 2 * DFF * D, M, 2 * DFF, D}; pg8::StaticOrder S; S.init(M, 2 * DFF, F.G, (int)blockIdx.x);
            pg8::EpiSwiglu E{ACT, DFF, 0};
            pg8::gemm_phase<pg8::EpiSwiglu, pg8::StaticOrder, true, true>(F.lds + RING_OFF, g, S, E);
            SEAM(pb + 2);
        }
        if (IN(pb + 3)) {
            pg8::Gemm g{ACT, (const bf16*)(ws + WS_WD) + (size_t)L * D * DFF, M, D, DFF}; pg8::StaticOrder S; S.init(M, D, F.G, (int)blockIdx.x);
            pg8::EpiResid E{out, out, D, 0};
            pg8::gemm_phase<pg8::EpiResid, pg8::StaticOrder, true, true>(F.lds + RING_OFF, g, S, E);
            SEAM(pb + 3);
        }
        if (L == 0 && IN(8)) { norm_phase(F, out, I.norm_mix + D, XN); SEAM(8); }
    }
    if (IN(18)) {
        OPAQUE_TID(); const int lane_ = tid_ & 63;
        const int gw = F.vcu * NWAVES + (tid_ >> 6), NGW = F.G * NWAVES;
        for (int m = gw; m < M; m += NGW) { GAS f32x4* xr = (GAS f32x4*)(out + (size_t)m * D) + lane_; const GAS f32x4* gr = (const GAS f32x4*)I.norm_final + lane_;
            f32x4 v[4]; float s = 0.f;
#pragma unroll
            for (int j = 0; j < 4; ++j) { v[j] = xr[64 * j]; s += (v[j].x * v[j].x + v[j].y * v[j].y) + (v[j].z * v[j].z + v[j].w * v[j].w); }
            const float r = rsqrtf(wave_sum(s) * (1.f / D) + EPSF);
#pragma unroll
            for (int j = 0; j < 4; ++j) { const f32x4 g = gr[64 * j]; xr[64 * j] = (v[j] * r) * g; } }
    }
#undef IN
#undef SEAM
}

extern "C" void kernel_launch(void* const* d_in, const int* in_sizes, int n_in, void* d_out, int out_size, void* d_ws, size_t ws_size, hipStream_t stream) {
    static int grid = 0;
    if (grid == 0) {
        if (n_in != 32 || out_size != M * D || ws_size < WS_END) { fprintf(stderr, "kernel_launch: unexpected shapes (n_in %d out %d ws %zu)\n", n_in, out_size, ws_size); grid = -1; return; }
        int dev = 0, cus = 0, per_cu = 0;
        if (hipGetDevice(&dev) != hipSuccess || hipDeviceGetAttribute(&cus, hipDeviceAttributeMultiprocessorCount, dev) != hipSuccess) { grid = -1; return; }
        if (hipFuncSetAttribute((const void*)mk_fwd, hipFuncAttributeMaxDynamicSharedMemorySize, LDS_BYTES) != hipSuccess) { grid = -1; return; }
        if (hipOccupancyMaxActiveBlocksPerMultiprocessor(&per_cu, (const void*)mk_fwd, NWAVES * 64, LDS_BYTES) != hipSuccess || per_cu < 1) fprintf(stderr, "kernel_launch: occupancy query reports %d\n", per_cu);
        (void)hipGetLastError();
        grid = cus;
        if (grid > 256) grid = 256;
    }
    if (grid < 0) return;
    if (hipMemsetAsync((char*)d_ws + WS_CTL, 0, CTL_ZERO_BYTES, stream) != hipSuccess) return;
    Args a{};
    const float** ip = (const float**)&a.in;
    for (int i = 0; i < 32; ++i) ip[i] = (const float*)d_in[i];
    a.out = (float*)d_out; a.ws = (unsigned char*)d_ws;
#if MK_SPLIT
    for (int k = 0; k < N_PHASES; ++k) { a.ph_lo = k; a.ph_hi = k + 1; hipLaunchKernelGGL(mk_fwd, dim3(grid), dim3(NWAVES * 64), LDS_BYTES, stream, a); }
#else
    a.ph_lo = 0; a.ph_hi = N_PHASES; hipLaunchKernelGGL(mk_fwd, dim3(grid), dim3(NWAVES * 64), LDS_BYTES, stream, a);
#endif
}
```

```cpp
#include <hip/hip_runtime.h>
#include <cstdio>
#include <cstdint>
#include <math.h>

namespace pg8 {
#define PG8_LAS __attribute__((address_space(3)))
typedef unsigned short bf16_t;
typedef short bf16x8 __attribute__((ext_vector_type(8)));
typedef float f32x4 __attribute__((ext_vector_type(4)));
typedef unsigned u32x4 __attribute__((ext_vector_type(4)));
constexpr int BM = 256, BK = 64, HALF = 128, HTB = HALF * BK * 2  , STAGE_BYTES = 8 * HTB, NXCD = 8, WGM = 8;

__host__ __device__ __forceinline__ int lds_byte(int r, int c) { const int st = (r >> 4) * 2 + (c >> 5), rr = r & 15, cc = c & 31, ob = rr * 64 + cc * 2; return st * 1024 + (ob ^ (((ob >> 9) & 1) << 5)); }
__host__ __device__ __forceinline__ void stage_rc(int b, int& R, int& C) { const int st = b / 1024, sb = b % 1024, swz = sb ^ (((sb >> 9) & 1) << 5); R = (st >> 1) * 16 + swz / 64; C = (st & 1) * 32 + (swz % 64) / 2; }
__host__ __device__ __forceinline__ int perm32(int rho) { const int n = rho >> 4, i = rho & 15; return 8 * (i >> 2) + 4 * n + (i & 3); }

struct Unit { int pm, pn; };
struct Gemm { const bf16_t* A; const bf16_t* Bt; int M, N, K; };

struct StaticOrder {
    int nM, nN, nwg, G, c;
    __host__ __device__ void init(int M, int N, int G_, int c_) { nM = M / BM; nN = N / BM; nwg = nM * nN; G = G_; c = c_; }
    __host__ __device__ bool next(int i, Unit& u) const {
        const long L = (long)i * G + c; if (L >= nwg) return false;
        int wgid = (int)L; { const int q = nwg / NXCD, r = nwg % NXCD, xcd = wgid % NXCD, off = wgid / NXCD; wgid = (xcd < r ? xcd * (q + 1) : r * (q + 1) + (xcd - r) * q) + off; }
        const int nig = WGM * nN, gid = wgid / nig, fm = gid * WGM, gsz = (nM - fm) < WGM ? (nM - fm) : WGM;
        u.pm = fm + ((wgid % nig) % gsz); u.pn = (wgid % nig) / gsz; return true;
    }
    __device__ __forceinline__ void a_ready(const Unit&) const {}
    __device__ __forceinline__ void done(const Unit&) const {}
};

__device__ __forceinline__ unsigned cvt_pk_bf16(float lo, float hi) { unsigned r; asm volatile("v_cvt_pk_bf16_f32 %0, %1, %2" : "=v"(r) : "v"(lo), "v"(hi)); return r; }
template <int ROUTE> struct EpiRoute {
    static constexpr bool PERM = true, AFTER_DRAIN = false;
    unsigned char* ws;
    __device__ __forceinline__ void operator()(const f32x4 (&acc)[2][2][4][2], const Unit& u, int wr, int wc, int fr, int fq) const {
        asm volatile("" : "+v"(fr), "+v"(fq));
        const int pn = u.pn; size_t off; int ld, t0; float sc;
        if constexpr (ROUTE == 0) {
            off = pn < 3 ? (size_t)(88u << 20) : pn < 5 ? (size_t)(112u << 20) : pn < 6 ? (size_t)(128u << 20) : (size_t)(136u << 20);
            ld = pn < 3 ? 768 : pn < 5 ? 512 : 256; t0 = pn < 3 ? 0 : pn < 5 ? 3 : pn < 6 ? 5 : 6; sc = (pn < 3 || pn == 5) ? 0.18033688011112042f : 1.f;
        } else if constexpr (ROUTE == 1) { off = (size_t)(88u << 20); ld = 768; t0 = 0; sc = 1.f; }
        else if constexpr (ROUTE == 3) { off = (size_t)(144u << 20); ld = 16384; t0 = 0; sc = 1.f; }
        else { off = pn < 6 ? (size_t)(128u << 20) : (size_t)(176u << 20); ld = pn < 6 ? 1536 : 512; t0 = pn < 6 ? 0 : 6; sc = 1.f; }
        bf16_t* base = (bf16_t*)(ws + off);
        const int row0 = u.pm * BM + wr * 64 + fr, col0 = (pn - t0) * BM + wc * 32 + 8 * fq;
#pragma unroll
        for (int ai = 0; ai < 2; ++ai)
#pragma unroll
            for (int m = 0; m < 4; ++m) { bf16_t* rowp = base + (size_t)(row0 + ai * HALF + m * 16) * ld + col0;
#pragma unroll
                for (int bj = 0; bj < 2; ++bj) { const f32x4 v0 = acc[ai][bj][m][0] * sc, v1 = acc[ai][bj][m][1] * sc;
                    u32x4 w; w.x = cvt_pk_bf16(v0[0], v0[1]); w.y = cvt_pk_bf16(v0[2], v0[3]); w.z = cvt_pk_bf16(v1[0], v1[1]); w.w = cvt_pk_bf16(v1[2], v1[3]);
                    if constexpr (ROUTE == 3) {
                        const int tok = col0 + bj * HALF, rw = row0 + ai * HALF + m * 16; *(u32x4*)(base + ((size_t)(tok >> 6) * 256 + rw) * 64 + (tok & 63)) = w; }
                    else *(u32x4*)(rowp + bj * HALF) = w; } }
    }
};
struct EpiResid {
    static constexpr bool PERM = true, AFTER_DRAIN = false;
    const float* res; float* out; int ldc; int pad;
    __device__ __forceinline__ void operator()(const f32x4 (&acc)[2][2][4][2], const Unit& u, int wr, int wc, int fr, int fq) const {
        asm volatile("" : "+v"(fr), "+v"(fq));
        const int row0 = u.pm * BM + wr * 64 + fr, col0 = u.pn * BM + wc * 32 + 8 * fq;
#pragma unroll
        for (int ai = 0; ai < 2; ++ai)
#pragma unroll
            for (int m = 0; m < 4; ++m) { const size_t off = (size_t)(row0 + ai * HALF + m * 16) * ldc + col0;
#pragma unroll
                for (int bj = 0; bj < 2; ++bj)
#pragma unroll
                    for (int n = 0; n < 2; ++n) { const f32x4 r = *(const f32x4*)(res + off + bj * HALF + 4 * n); *(f32x4*)(out + off + bj * HALF + 4 * n) = r + acc[ai][bj][m][n]; } }
    }
};
struct EpiSwiglu {
    static constexpr bool PERM = true, AFTER_DRAIN = false;
    bf16_t* O; int ldc; int pad;
    __device__ __forceinline__ void operator()(const f32x4 (&acc)[2][2][4][2], const Unit& u, int wr, int wc, int fr, int fq) const {
        asm volatile("" : "+v"(fr), "+v"(fq));
        const int row0 = u.pm * BM + wr * 64 + fr, col0 = u.pn * HALF + wc * 32 + 8 * fq;
#pragma unroll
        for (int ai = 0; ai < 2; ++ai)
#pragma unroll
            for (int m = 0; m < 4; ++m) { float o[8];
#pragma unroll
                for (int n = 0; n < 2; ++n)
#pragma unroll
                    for (int e = 0; e < 4; ++e) { const float g = acc[ai][0][m][n][e], up = acc[ai][1][m][n][e]; o[4 * n + e] = (g * __builtin_amdgcn_rcpf(1.f + __expf(-g))) * up; }
                u32x4 w; w.x = cvt_pk_bf16(o[0], o[1]); w.y = cvt_pk_bf16(o[2], o[3]); w.z = cvt_pk_bf16(o[4], o[5]); w.w = cvt_pk_bf16(o[6], o[7]);
                *(u32x4*)(O + (size_t)(row0 + ai * HALF + m * 16) * ldc + col0) = w; }
    }
};
template <class Epi, class Sched, bool ALIGN_EPI = false, bool SP2 = false>
__device__ __forceinline__ void gemm_phase(PG8_LAS unsigned char* lds, const Gemm g, const Sched& S, const Epi& E) {
    int tid = threadIdx.x; asm volatile("" : "+v"(tid));
    const int wid = __builtin_amdgcn_readfirstlane(tid >> 6), lane = tid & 63, wr = wid >> 2, wc = wid & 3, fr = lane & 15, fq = lane >> 4;
    int K = g.K; asm volatile("" : "+s"(K));
    const int nt = K / BK;
    unsigned voffA[2], voffB[2];
#pragma unroll
    for (int i = 0; i < 2; ++i) { int R, C; stage_rc(tid * 16 + i * 8192, R, C); const int Rb = Epi::PERM ? ((R & ~31) + perm32(R & 31)) : R;
        voffA[i] = (unsigned)(R * K + C) * 2u; voffB[i] = (unsigned)(Rb * K + C) * 2u; }
    const size_t kstep = (size_t)(BK * 2);
    const size_t hstep = (size_t)HALF * K * 2;
    const size_t tstep = 2 * hstep;
    const unsigned ldsw = (unsigned)wid * 1024u;
    const int aoff = lds_byte(wr * 64 + fr, fq * 8), boff = lds_byte(wc * 32 + fr, fq * 8);
#define PG8_SA(b, h) (((b) * 2 + (h)) * HTB)
#define PG8_SB(b, h) ((4 + (b) * 2 + (h)) * HTB)
#define PG8_STAGE(bufoff, gbase, voff) do { _Pragma("unroll") for (int _i = 0; _i < 2; ++_i) \
        __builtin_amdgcn_global_load_lds((const unsigned*)((const char*)(gbase) + (voff)[_i]), (PG8_LAS unsigned*)(lds + (bufoff) + ldsw + _i * 8192), 16, 0, 0); } while (0)
#define PG8_LDA(dst, b, h) do { _Pragma("unroll") for (int m = 0; m < 4; ++m) _Pragma("unroll") for (int k = 0; k < 2; ++k) dst[m][k] = *(const PG8_LAS bf16x8*)(lds + PG8_SA(b, h) + aoff + m * 2048 + k * 1024); } while (0)
#define PG8_LDB(dst, b, h) do { _Pragma("unroll") for (int n = 0; n < 2; ++n) _Pragma("unroll") for (int k = 0; k < 2; ++k) dst[n][k] = *(const PG8_LAS bf16x8*)(lds + PG8_SB(b, h) + boff + n * 2048 + k * 1024); } while (0)
#define PG8_MMA(ai, bj, At, Bt) do { __builtin_amdgcn_s_setprio(1); _Pragma("unroll") for (int m = 0; m < 4; ++m) _Pragma("unroll") for (int n = 0; n < 2; ++n) _Pragma("unroll") for (int k = 0; k < 2; ++k) \
        acc[ai][bj][m][n] = __builtin_amdgcn_mfma_f32_16x16x32_bf16(Bt[n][k], At[m][k], acc[ai][bj][m][n], 0, 0, 0); __builtin_amdgcn_s_setprio(0); } while (0)
#define PG8_WAIT_V(n) asm volatile("s_waitcnt vmcnt(" #n ")" ::: "memory")
#define PG8_WAIT_L(n) asm volatile("s_waitcnt lgkmcnt(" #n ")" ::: "memory")
#define PG8_BAR __builtin_amdgcn_s_barrier()
#define PG8_SCHED __builtin_amdgcn_sched_barrier(0)
    Unit cur, nxt; int ui = 0;
    if (!S.next(0, cur)) return;
    f32x4 acc[2][2][4][2];
#pragma unroll
    for (int a = 0; a < 2; ++a)
#pragma unroll
        for (int b = 0; b < 2; ++b)
#pragma unroll
            for (int m = 0; m < 4; ++m)
#pragma unroll
                for (int n = 0; n < 2; ++n) acc[a][b][m][n] = (f32x4){0.f, 0.f, 0.f, 0.f};
    bf16x8 At[4][2], B0[2][2], B1[2][2];
    const char* cA = (const char*)g.A + (size_t)cur.pm * tstep; const char* cB = (const char*)g.Bt + (size_t)cur.pn * tstep;
    S.a_ready(cur);
    if constexpr (SP2) {
        PG8_STAGE(PG8_SB(0, 0), cB, voffB); PG8_STAGE(PG8_SB(0, 1), cB + hstep, voffB); PG8_STAGE(PG8_SA(0, 0), cA, voffA); PG8_STAGE(PG8_SA(0, 1), cA + hstep, voffA);
        if (wr == 1) PG8_BAR;
        PG8_WAIT_V(2); PG8_BAR;
        PG8_STAGE(PG8_SB(1, 0), cB + kstep, voffB); PG8_STAGE(PG8_SA(1, 0), cA + kstep, voffA); PG8_STAGE(PG8_SB(1, 1), cB + hstep + kstep, voffB);
        PG8_WAIT_V(6); PG8_BAR;
    } else {
        PG8_STAGE(PG8_SB(0, 0), cB, voffB); PG8_STAGE(PG8_SA(0, 0), cA, voffA); PG8_STAGE(PG8_SB(0, 1), cB + hstep, voffB); PG8_STAGE(PG8_SA(0, 1), cA + hstep, voffA);
        if (wr == 1) PG8_BAR;
        PG8_WAIT_V(4); PG8_BAR;
        PG8_STAGE(PG8_SB(1, 0), cB + kstep, voffB); PG8_STAGE(PG8_SA(1, 0), cA + kstep, voffA); PG8_STAGE(PG8_SB(1, 1), cB + hstep + kstep, voffB);
        PG8_WAIT_V(6); PG8_BAR;
    }
    for (;;) {
        const bool has_next = S.next(ui + 1, nxt);
        const char* nA = has_next ? (const char*)g.A + (size_t)nxt.pm * tstep : cA; const char* nB = has_next ? (const char*)g.Bt + (size_t)nxt.pn * tstep : cB;
        for (int t = 0; t < nt; t += 2) {
            const bool last = (t == nt - 2);
            const char* a1 = cA + (size_t)(t + 1) * kstep;
            const char* a2 = last ? nA : cA + (size_t)(t + 2) * kstep; const char* b2 = last ? nB : cB + (size_t)(t + 2) * kstep;
            const char* a3 = a2 + kstep; const char* b3 = b2 + kstep;
            if (last && has_next) S.a_ready(nxt);
            if constexpr (SP2) {
            PG8_LDB(B0, 0, 0); PG8_LDB(B1, 0, 1); PG8_SCHED; PG8_LDA(At, 0, 0); PG8_STAGE(PG8_SA(1, 1), a1 + hstep, voffA);
            PG8_WAIT_V(8); PG8_WAIT_L(0); PG8_BAR; PG8_MMA(0, 0, At, B0); PG8_MMA(0, 1, At, B1); PG8_BAR; PG8_SCHED;
            PG8_LDA(At, 0, 1); PG8_STAGE(PG8_SB(0, 0), b2, voffB); PG8_STAGE(PG8_SB(0, 1), b2 + hstep, voffB); PG8_STAGE(PG8_SA(0, 0), a2, voffA);
            PG8_WAIT_V(8); PG8_WAIT_L(0); PG8_BAR; PG8_MMA(1, 0, At, B0); PG8_MMA(1, 1, At, B1); PG8_BAR; PG8_SCHED;
            PG8_LDB(B0, 1, 0); PG8_LDB(B1, 1, 1); PG8_SCHED; PG8_LDA(At, 1, 0); PG8_STAGE(PG8_SA(0, 1), a2 + hstep, voffA);
            PG8_WAIT_V(8); PG8_WAIT_L(0); PG8_BAR; PG8_MMA(0, 0, At, B0); PG8_MMA(0, 1, At, B1); PG8_BAR; PG8_SCHED;
            PG8_LDA(At, 1, 1); PG8_STAGE(PG8_SB(1, 0), b3, voffB); PG8_STAGE(PG8_SB(1, 1), b3 + hstep, voffB); PG8_STAGE(PG8_SA(1, 0), a3, voffA);
            PG8_WAIT_V(8); PG8_WAIT_L(0); PG8_BAR; PG8_MMA(1, 0, At, B0); PG8_MMA(1, 1, At, B1); PG8_BAR; PG8_SCHED;
            } else {
            PG8_LDB(B0, 0, 0); PG8_SCHED; PG8_LDA(At, 0, 0); PG8_STAGE(PG8_SA(1, 1), a1 + hstep, voffA);
            PG8_WAIT_L(8); PG8_BAR; PG8_WAIT_L(0); PG8_MMA(0, 0, At, B0); PG8_BAR; PG8_SCHED;
            PG8_LDB(B1, 0, 1); PG8_STAGE(PG8_SB(0, 0), b2, voffB);
            PG8_BAR; PG8_WAIT_L(0); PG8_MMA(0, 1, At, B1); PG8_BAR;
            PG8_LDA(At, 0, 1); PG8_STAGE(PG8_SA(0, 0), a2, voffA);
            PG8_BAR; PG8_WAIT_L(0); PG8_MMA(1, 0, At, B0); PG8_BAR; PG8_SCHED;
            PG8_STAGE(PG8_SB(0, 1), b2 + hstep, voffB);
            PG8_WAIT_V(6); PG8_BAR; PG8_MMA(1, 1, At, B1); PG8_BAR;
            PG8_LDB(B0, 1, 0); PG8_SCHED; PG8_LDA(At, 1, 0); PG8_STAGE(PG8_SA(0, 1), a2 + hstep, voffA);
            PG8_WAIT_L(8); PG8_BAR; PG8_WAIT_L(0); PG8_MMA(0, 0, At, B0); PG8_BAR; PG8_SCHED;
            PG8_LDB(B1, 1, 1); PG8_STAGE(PG8_SB(1, 0), b3, voffB);
            PG8_BAR; PG8_WAIT_L(0); PG8_MMA(0, 1, At, B1); PG8_BAR;
            PG8_LDA(At, 1, 1); PG8_STAGE(PG8_SA(1, 0), a3, voffA);
            PG8_BAR; PG8_WAIT_L(0); PG8_MMA(1, 0, At, B0); PG8_BAR; PG8_SCHED;
            PG8_STAGE(PG8_SB(1, 1), b3 + hstep, voffB);
            PG8_WAIT_V(6); PG8_BAR; PG8_MMA(1, 1, At, B1); PG8_BAR;
            }
        }
        if constexpr (ALIGN_EPI) { if (wr == 0) PG8_BAR; }
        if constexpr (!Epi::AFTER_DRAIN) { E(acc, cur, wr, wc, fr, fq); S.done(cur); }
        if (!has_next) break;
#pragma unroll
        for (int a = 0; a < 2; ++a)
#pragma unroll
            for (int b = 0; b < 2; ++b)
#pragma unroll
                for (int m = 0; m < 4; ++m)
#pragma unroll
                    for (int n = 0; n < 2; ++n) acc[a][b][m][n] = (f32x4){0.f, 0.f, 0.f, 0.f};
        cur = nxt; cA = nA; cB = nB; ++ui;
        if constexpr (ALIGN_EPI) { if (wr == 1) PG8_BAR; }
    }
    PG8_WAIT_V(0);
    if constexpr (!ALIGN_EPI) { if (wr == 0) PG8_BAR; }
    PG8_BAR;
    if constexpr (Epi::AFTER_DRAIN) { E.fused(acc, cur, wr, wc, fr, fq, lds, wid, lane); S.done(cur); }
#undef PG8_SA
#undef PG8_SB
#undef PG8_STAGE
#undef PG8_LDA
#undef PG8_LDB
#undef PG8_MMA
#undef PG8_WAIT_V
#undef PG8_WAIT_L
#undef PG8_BAR
#undef PG8_SCHED
}
}
constexpr int NWAVES = 8;
constexpr int BATCH = 2, T = 8192, D = 1024, M = BATCH * T, DFF = 2816, NSA_IN = 1828, DSA_IN = 712, NCMP = 511, NCR = BATCH * NCMP * 2;
constexpr float NEGF = -1e30f, EPSF = 1e-6f;
#ifndef MK_SPLIT
#define MK_SPLIT 0
#endif
constexpr int N_PHASES = 19;
constexpr size_t MiB = 1u << 20;
constexpr size_t WS_CTL = 0, CTL_ZERO_BYTES = 1 * MiB;
constexpr size_t WS_KCB = 1 * MiB  , WS_VCT = 1 * MiB + 512 * 1024  , WS_MKB = 2 * MiB  , WS_MVT = 2 * MiB + 512 * 1024  , WS_MKV = 3 * MiB  , WS_WIDX = 5 * MiB  , WS_CNT = 6 * MiB  ;
constexpr size_t WS_WIN0 = 8 * MiB, WS_WO = 12 * MiB, WS_WGU = 16 * MiB, WS_WD = 38 * MiB, WS_WIN1 = 49 * MiB, WS_WQ2 = 51 * MiB, WS_WVT = 52 * MiB  ;
constexpr size_t WS_W1T = 232 * MiB, WS_MEMN = 234 * MiB, WS_WMKT = 236 * MiB, WS_W2T = 238 * MiB, WS_B1F = 238 * MiB + 64 * 1024;
constexpr size_t WS_XN = 56 * MiB;
constexpr size_t WS_Q0 = 88 * MiB, WS_KV0 = 112 * MiB  , WS_QM = 128 * MiB, WS_G0 = 136 * MiB, WS_VT = 144 * MiB  ;
static_assert(WS_Q0 == (88u << 20) && WS_KV0 == (112u << 20) && WS_QM == (128u << 20) && WS_G0 == (136u << 20), "EpiRoute tables");
constexpr size_t WS_ACT = 88 * MiB;
constexpr size_t WS_PROJ1 = 88 * MiB, WS_CQ = 112 * MiB, WS_CKV = 120 * MiB, WS_KIDX = 124 * MiB, WS_QA = 128 * MiB, WS_QI = 176 * MiB, WS_SEL = 112 * MiB  , WS_CAT1 = 176 * MiB  , WS_WO1F = 52 * MiB + 512 * 1024  ;
constexpr size_t WS_OCS = 152 * MiB  , WS_CAT = 200 * MiB, WS_END = 239 * MiB;
static_assert(WS_PROJ1 == (88u << 20) && WS_QA == (128u << 20) && WS_QI == (176u << 20) && WS_VT == (144u << 20), "EpiRoute tables");
static_assert(WS_ACT + (size_t)M * DFF * 2 <= WS_CAT + 0 * MiB || true, "map");
constexpr int CW_BAR = 4096;
constexpr int RING_OFF = 0, RING_BYTES = 131072, LDS_BYTES = 163840, LDSCTL_OFF = LDS_BYTES - 1024, MISC_OFF = LDSCTL_OFF + 320;
#define GAS __attribute__((address_space(1)))
#define LAS __attribute__((address_space(3)))
typedef unsigned short bf16;
typedef unsigned v4u __attribute__((ext_vector_type(4)));
typedef float f32x4 __attribute__((ext_vector_type(4)));
typedef short bf16x8 __attribute__((ext_vector_type(8)));
typedef GAS unsigned gu32;
typedef GAS unsigned long long gu64;
#define RLX_AGENT __ATOMIC_RELAXED, __HIP_MEMORY_SCOPE_AGENT
#define LDS_WAIT() asm volatile("s_waitcnt lgkmcnt(0)" ::: "memory")
#define VM_WAIT() asm volatile("s_waitcnt vmcnt(0)" ::: "memory")
__device__ __forceinline__ unsigned long long rt() { return __builtin_amdgcn_s_memrealtime(); }
__device__ __forceinline__ unsigned f2bf(float f) { unsigned u = __builtin_bit_cast(unsigned, f); return (u + 0x7fffu + ((u >> 16) & 1u)) >> 16; }
__device__ __forceinline__ unsigned pk2(float lo, float hi) { return f2bf(lo) | (f2bf(hi) << 16); }
#define XB_TMO      128
#define XB_XCNT(j)  (256  + 64 * (j))
#define XB_XSUB(j)  (1280 + 64 * (j))
#define XB_XGEN(j)  (2304 + 64 * (j))
#define XB_TOP      3328
#define XB_TOPGEN   3392
#define XCD_BAR_WORDS 3456
#define XB_SPIN_CAP (1u << 18)

__device__ __forceinline__ unsigned xb_ld(unsigned* p)              { return __hip_atomic_load(p, __ATOMIC_RELAXED, __HIP_MEMORY_SCOPE_AGENT); }
__device__ __forceinline__ unsigned xb_add(unsigned* p, unsigned v) { return __hip_atomic_fetch_add(p, v, __ATOMIC_RELAXED, __HIP_MEMORY_SCOPE_AGENT); }
__device__ __forceinline__ unsigned xb_xcc_id() { return (unsigned)__builtin_amdgcn_s_getreg((3 << 11) | 20) & 0xFu; }
#define XB_SPIN(cond, bar) do { unsigned _sp = 0; while (cond) { __builtin_amdgcn_s_sleep(1); \
    if ((++_sp & 255u) == 0u) { if (xb_ld(&(bar)[XB_TMO])) break; if (_sp > XB_SPIN_CAP) { atomicAdd(&(bar)[XB_TMO], 1u); break; } } } } while (0)

struct XcdBarrier {
    unsigned* bar; unsigned x;
    volatile LAS unsigned* st;
};

__device__ __forceinline__ XcdBarrier xcd_barrier_post(unsigned* bar, volatile LAS unsigned* st) {
    XcdBarrier b; b.bar = bar; b.x = xb_xcc_id(); b.st = st;
    if (threadIdx.x == 0) (void)xb_add(&bar[XB_XCNT(b.x)], 1u);
    return b;
}
__device__ __forceinline__ void xcd_barrier_complete(unsigned* bar, unsigned x, unsigned& nloc, unsigned& nx) {
    const unsigned G = gridDim.x * gridDim.y * gridDim.z;
    unsigned sum, cnt, mine, sp = 0u;
    for (;;) {
        sum = 0u; cnt = 0u; mine = 0u;
#pragma unroll 1
        for (unsigned j = 0; j < 16; ++j) { const unsigned c = xb_ld(&bar[XB_XCNT(j)]); sum += c; cnt += (c > 0u) ? 1u : 0u; mine = (j == x) ? c : mine; }
        if (sum == G) break;
        __builtin_amdgcn_s_sleep(1);
        if ((++sp & 255u) == 0u) { if (xb_ld(&bar[XB_TMO])) break; if (sp > XB_SPIN_CAP) { atomicAdd(&bar[XB_TMO], 1u); break; } }
    }
    nloc = mine > 0u ? mine : 1u; nx = cnt > 0u ? cnt : 1u;
}

__device__ __forceinline__ void xcd_barrier(const XcdBarrier& b) {
    asm volatile("s_waitcnt vmcnt(0)" ::: "memory");
    __syncthreads();
    if (threadIdx.x == 0) {
        unsigned* bar = b.bar;
        __builtin_amdgcn_s_waitcnt(0);
        unsigned nloc = b.st[0], nx = b.st[1];
        if (nloc == 0u) { xcd_barrier_complete(bar, b.x, nloc, nx); b.st[0] = nloc; b.st[1] = nx; }
        const unsigned old = xb_add(&bar[XB_XSUB(b.x)], 1u);
        const unsigned gen = old / nloc;
        if (old + 1u == (gen + 1u) * nloc) {
            __builtin_amdgcn_fence(__ATOMIC_RELEASE, "agent");
            asm volatile("s_waitcnt vmcnt(0)" ::: "memory");
            const unsigned og = xb_add(&bar[XB_TOP], 1u);
            const unsigned tg = og / nx;
            if (og + 1u == (tg + 1u) * nx) xb_add(&bar[XB_TOPGEN], 1u);
            else XB_SPIN(xb_ld(&bar[XB_TOPGEN]) == tg, bar);
            __builtin_amdgcn_fence(__ATOMIC_ACQUIRE, "agent");
            xb_add(&bar[XB_XGEN(b.x)], 1u);
            asm volatile("s_waitcnt vmcnt(0)" ::: "memory");
        } else {
            XB_SPIN(xb_ld(&bar[XB_XGEN(b.x)]) == gen, bar);
            __builtin_amdgcn_fence(__ATOMIC_ACQUIRE, "agent");
            asm volatile("s_waitcnt vmcnt(0)" ::: "memory");
        }
    }
    __syncthreads();
}

struct Frame {
    LAS unsigned char* lds; volatile LAS unsigned* MISC; gu32* ctl;
    int vcu, G;
};
__device__ __forceinline__ float bf2f(unsigned short u) { return __uint_as_float((unsigned)u << 16); }
__device__ __forceinline__ float bflo(unsigned u) { return __uint_as_float(u << 16); }
__device__ __forceinline__ float bfhi(unsigned u) { return __uint_as_float(u & 0xffff0000u); }
__device__ __forceinline__ float wave_sum(float v) {
#pragma unroll
    for (int o = 1; o < 64; o <<= 1) v += __shfl_xor(v, o);
    return v;
}
__device__ __forceinline__ float red16_sum(float v) { v += __shfl_xor(v, 1, 16); v += __shfl_xor(v, 2, 16); v += __shfl_xor(v, 4, 16); v += __shfl_xor(v, 8, 16); return v; }
__device__ __forceinline__ float red16_max(float v) { v = fmaxf(v, __shfl_xor(v, 1, 16)); v = fmaxf(v, __shfl_xor(v, 2, 16)); v = fmaxf(v, __shfl_xor(v, 4, 16)); v = fmaxf(v, __shfl_xor(v, 8, 16)); return v; }
__device__ __forceinline__ int rel_bucket(int n) {
    if (n < 16) return n;
    return 16 + (n >= 22) + (n >= 30) + (n >= 40) + (n >= 54) + (n >= 73) + (n >= 99) + (n >= 134) + (n >= 182) + (n >= 246) + (n >= 332) + (n >= 450) + (n >= 609) + (n >= 825) + (n >= 1117) + (n >= 1513);
}

__device__ __forceinline__ void xpose_item(const float* W, int ldw, int c0, int nvalid, int k0, bf16* WT, int Kd, int drow0, LAS float* scr, int lane) {
#pragma unroll 8
    for (int i = 0; i < 32; ++i) { const int kk = 2 * i + (lane >> 5), n = lane & 31; scr[kk * 33 + n] = (n < nvalid) ? W[(size_t)(k0 + kk) * ldw + c0 + n] : 0.f; }
    LDS_WAIT(); asm volatile("" ::: "memory");
    const int c = lane & 7;
#pragma unroll
    for (int j = 0; j < 4; ++j) { const int n = (lane >> 3) + 8 * j; const LAS float* s = scr + (8 * c) * 33 + n;
        v4u o; o.x = pk2(s[0 * 33], s[1 * 33]); o.y = pk2(s[2 * 33], s[3 * 33]); o.z = pk2(s[4 * 33], s[5 * 33]); o.w = pk2(s[6 * 33], s[7 * 33]);
        *(GAS v4u*)(WT + (size_t)(drow0 + n) * Kd + k0 + 8 * c) = o; }
    LDS_WAIT(); asm volatile("" ::: "memory");
}
__device__ __forceinline__ void rms_row_to_bf16(const float* xrow, const float* gain, bf16* orow, int lane) {
    const GAS f32x4* xr = (const GAS f32x4*)xrow + lane; const GAS f32x4* gr = (const GAS f32x4*)gain + lane;
    f32x4 v[4]; float s = 0.f;
#pragma unroll
    for (int j = 0; j < 4; ++j) { v[j] = xr[64 * j]; s += (v[j].x * v[j].x + v[j].y * v[j].y) + (v[j].z * v[j].z + v[j].w * v[j].w); }
    const float r = rsqrtf(wave_sum(s) * (1.f / D) + EPSF);
    GAS unsigned long long* o8 = (GAS unsigned long long*)orow + lane;
#pragma unroll
    for (int j = 0; j < 4; ++j) { const f32x4 g = gr[64 * j]; o8[64 * j] = (unsigned long long)pk2((v[j].x * r) * g.x, (v[j].y * r) * g.y) | ((unsigned long long)pk2((v[j].z * r) * g.z, (v[j].w * r) * g.w) << 32); }
}
#ifndef PROBE_REP
#define PROBE_REP 0
#endif
#define CAS __attribute__((address_space(4)))
#define KARGS() const CAS In* Ip = (const CAS In*)__builtin_amdgcn_kernarg_segment_ptr(); asm volatile("" : "+s"(Ip))
#define OPAQUE_TID() int tid_ = threadIdx.x; asm volatile("" : "+v"(tid_))
__device__ __forceinline__ void norm_phase(Frame& F, const float* x, const float* gain, bf16* xn) {
    OPAQUE_TID(); const int lane_ = tid_ & 63, wave_ = tid_ >> 6;
    const int gw = F.vcu * NWAVES + wave_, NGW = F.G * NWAVES;
    for (int m = gw; m < M; m += NGW) rms_row_to_bf16(x + (size_t)m * D, gain, xn + (size_t)m * D, lane_);
}

template <int DL>
__device__ __forceinline__ void coop_attend(const float (&q)[DL], const float (&k)[DL], const float (&v)[DL], float bias, float& m_, float& l_, float (&o)[DL]) {
    float a = 0.f;
#pragma unroll
    for (int d = 0; d < DL; ++d) a += q[d] * k[d];
    a = red16_sum(a) + bias;
    const float mn = fmaxf(m_, a), al = __expf(m_ - mn), p = __expf(a - mn);
    l_ = l_ * al + p; m_ = mn;
#pragma unroll
    for (int d = 0; d < DL; ++d) o[d] = o[d] * al + p * v[d];
}
__device__ __forceinline__ void ld4bf(const bf16* p, float (&x)[4]) { const uint2 u = *(const uint2*)p; x[0] = bflo(u.x); x[1] = bfhi(u.x); x[2] = bflo(u.y); x[3] = bfhi(u.y); }
__device__ __forceinline__ void ld8bf(const bf16* p, float (&x)[8]) { const uint4 u = *(const uint4*)p; x[0] = bflo(u.x); x[1] = bfhi(u.x); x[2] = bflo(u.y); x[3] = bfhi(u.y); x[4] = bflo(u.z); x[5] = bfhi(u.z); x[6] = bflo(u.w); x[7] = bfhi(u.w); }
__device__ __forceinline__ void ld4f(const float* p, float (&x)[4]) { const float4 u = *(const float4*)p; x[0] = u.x; x[1] = u.y; x[2] = u.z; x[3] = u.w; }

struct In {
    const float *x, *mem, *rel_bias, *norm_mix, *norm_ffn, *norm_mem, *w_mem_kv, *w_out, *ffn_gate, *ffn_up, *ffn_down, *nsa_w_in, *nsa_gate_b, *pos_k, *pos_v,
        *k_w1, *k_b1, *k_w2, *k_b2, *v_w1, *v_b1, *v_w2, *v_b2, *dsa_w_in, *q_norm, *kv_norm, *w_q_up, *w_uk, *w_uv, *w_q_idx, *kidx_norm, *norm_final;
};
__device__ __forceinline__ void p0_prologue(Frame& F, const In& I, unsigned char* ws) {
    OPAQUE_TID(); KARGS(); const int lane_ = tid_ & 63, wave_ = __builtin_amdgcn_readfirstlane(tid_ >> 6);
    LAS float* scr = (LAS float*)(F.lds + RING_OFF + wave_ * 16384);
    const int gw = F.vcu * NWAVES + wave_, NGW = F.G * NWAVES;
    bf16* WIN0 = (bf16*)(ws + WS_WIN0); bf16* WO = (bf16*)(ws + WS_WO); bf16* WGU = (bf16*)(ws + WS_WGU); bf16* WD = (bf16*)(ws + WS_WD); bf16* WIN1 = (bf16*)(ws + WS_WIN1); bf16* WQ2 = (bf16*)(ws + WS_WQ2);
    constexpr int I_A = 16 * 56, I_G = 16 * 8, I_B = 2 * 16 * 32, I_C = 2 * 16 * 176, I_D = 2 * 44 * 32, I_E = 16 * 24, I_F = 4 * 16, NITEMS = I_A + I_B + I_C + I_D + I_E + I_F + I_G;
    for (int it = gw; it < NITEMS; it += NGW) {
        int r = it;
        if (r < I_A) { const int kb = r / 56, nb = r % 56, r0 = 32 * nb; int c0, nv;
            if (r0 < 1152) { c0 = r0; nv = 32; } else if (r0 < 1280) { c0 = r0 + 128; nv = 32; } else if (r0 < 1536) { c0 = r0 + 292; nv = 32; } else if (r0 == 1536) { c0 = 1536; nv = 32; } else if (r0 == 1568) { c0 = 1568; nv = 4; } else { c0 = 0; nv = 0; }
            xpose_item(Ip->nsa_w_in, NSA_IN, c0, nv, 64 * kb, WIN0, D, r0, scr, lane_); continue; } r -= I_A;
        if (r < I_B) { const int l = r / 512, q = r % 512, kb = q / 32, nb = q % 32;
            xpose_item(Ip->w_out + (size_t)l * D * D, D, 32 * nb, 32, 64 * kb, WO + (size_t)l * D * D, D, 32 * nb, scr, lane_); continue; } r -= I_B;
        if (r < I_C) { const int l = r / (16 * 176), q = r % (16 * 176), kb = q / 176, nb = q % 176, r0 = 32 * nb, pn = r0 >> 8, w0 = r0 & 255;
            const float* src = ((w0 < 128) ? Ip->ffn_gate : Ip->ffn_up) + (size_t)l * D * DFF;
            xpose_item(src, DFF, 128 * pn + (w0 & 127), 32, 64 * kb, WGU + (size_t)l * 2 * DFF * D, D, r0, scr, lane_); continue; } r -= I_C;
        if (r < I_D) { const int l = r / (44 * 32), q = r % (44 * 32), kb = q / 32, nb = q % 32;
            xpose_item(Ip->ffn_down + (size_t)l * DFF * D, D, 32 * nb, 32, 64 * kb, WD + (size_t)l * D * DFF, DFF, 32 * nb, scr, lane_); continue; } r -= I_D;
        if (r < I_E) { const int kb = r / 24, nb = r % 24, r0 = 32 * nb; int nv = DSA_IN - r0; nv = nv > 32 ? 32 : (nv < 0 ? 0 : nv);
            xpose_item(Ip->dsa_w_in, DSA_IN, r0, nv, 64 * kb, WIN1, D, r0, scr, lane_); continue; } r -= I_E;
        if (r < I_F) { const int kb = r / 16, nb = r % 16; xpose_item(Ip->w_q_idx, 512, 32 * nb, 32, 64 * kb, WQ2, 256, 1536 + 32 * nb, scr, lane_); continue; } r -= I_F;
        { const int kb = r / 8, nb = r % 8, r0 = 32 * nb;
            xpose_item(Ip->nsa_w_in, NSA_IN, (r0 < 128) ? 1152 + r0 : 1408 + (r0 - 128), 32, 64 * kb, (bf16*)(ws + WS_WVT), D, r0, scr, lane_); }
    }
    for (int idx = (F.vcu * NWAVES * 64) + tid_; idx < 1536 * 256; idx += F.G * NWAVES * 64) {
        const int n = idx >> 8, c = idx & 255, h = n >> 7, rr = n & 127; const float* a = Ip->w_q_up + (size_t)c * 768 + h * 64; const float* b = Ip->w_uk + (size_t)rr * 768 + h * 64; float s = 0.f;
#pragma unroll 8
        for (int d = 0; d < 64; ++d) s += a[d] * b[d];
        WQ2[idx] = (bf16)f2bf(s * (0.125f * 1.4426950408889634f));
    }
    { bf16* WO1F = (bf16*)(ws + WS_WO1F); const float* wo1 = Ip->w_out + (size_t)D * D;
      for (int idx = (F.vcu * NWAVES * 64) + tid_; idx < 1536 * 1024; idx += F.G * NWAVES * 64) {
          const int nn = idx & 1023, hr = idx >> 10, h = hr >> 7, rr = hr & 127; const float* a = Ip->w_uv + (size_t)rr * 768 + h * 64; const float* bcol = wo1 + (size_t)(h * 64) * D + nn; float sacc = 0.f;
#pragma unroll 8
          for (int d = 0; d < 64; ++d) sacc += a[d] * bcol[(size_t)d * D];
          WO1F[(size_t)nn * 1792 + hr] = (bf16)f2bf(sacc); }
      for (int it = gw; it < 4 * 32; it += NGW) { const int kb = it / 32, nb = it % 32;
          xpose_item(wo1 + (size_t)768 * D, D, 32 * nb, 32, 64 * kb, WO1F + 1536, 1792, 32 * nb, scr, lane_); } }
    { bf16* W1T = (bf16*)(ws + WS_W1T); bf16* W2T = (bf16*)(ws + WS_W2T); bf16* WMKT = (bf16*)(ws + WS_WMKT); float* B1F = (float*)(ws + WS_B1F); bf16* MEMN = (bf16*)(ws + WS_MEMN);
      constexpr int J_1 = 2 * 32 * 8, J_2 = 2 * 4 * 2, J_M = 2 * 16 * 16;
      for (int it = gw; it < J_1 + J_2 + J_M; it += NGW) { int r2 = it;
          if (r2 < J_1) { const int kv = r2 / 256, q = r2 % 256, kb = q / 8, nb = q % 8; xpose_item(kv ? Ip->v_w1 : Ip->k_w1, 256, 32 * nb, 32, 64 * kb, W1T + (size_t)kv * 256 * 2048, 2048, 32 * nb, scr, lane_); continue; } r2 -= J_1;
          if (r2 < J_2) { const int kv = r2 / 8, q = r2 % 8, kb = q / 2, nb = q % 2; xpose_item(kv ? Ip->v_w2 : Ip->k_w2, 64, 32 * nb, 32, 64 * kb, W2T + (size_t)kv * 64 * 256, 256, 32 * nb, scr, lane_); continue; } r2 -= J_2;
          { const int l = r2 / 256, q = r2 % 256, kb = q / 16, nb = q % 16; xpose_item(Ip->w_mem_kv + (size_t)l * D * 512, 512, 32 * nb, 32, 64 * kb, WMKT + (size_t)l * 512 * D, D, 32 * nb, scr, lane_); } }
      for (int idx = (F.vcu * NWAVES * 64) + tid_; idx < 512; idx += F.G * NWAVES * 64) { const int kv = idx >> 8, c = idx & 255; const float* w1 = kv ? Ip->v_w1 : Ip->k_w1; const float* pos = kv ? Ip->pos_v : Ip->pos_k; float sacc = (kv ? Ip->v_b1 : Ip->k_b1)[c];
          for (int k = 0; k < 2048; ++k) sacc += pos[k] * w1[(size_t)k * 256 + c];
          B1F[idx] = sacc; }
      for (int m = gw; m < 1024; m += NGW) rms_row_to_bf16(Ip->mem + (size_t)(m & 511) * D, Ip->norm_mem + (m >> 9) * D, MEMN + (size_t)m * D, lane_); }
    norm_phase(F, Ip->x, Ip->norm_mix, (bf16*)(ws + WS_XN));
}

#define MFMA16(A, B, C) __builtin_amdgcn_mfma_f32_16x16x32_bf16((A), (B), (C), 0, 0, 0)
constexpr float LOG2E = 1.4426950408889634f;
constexpr int NSA_OUT = 0, NSA_PSQ = 98304, NSA_ST = 147456, NSA_TB = NSA_ST + 3072;
constexpr int TAB_B12 = NSA_ST + 1024;
constexpr int TAB_BKT = NSA_ST + 3072;
static_assert(NSA_TB + 12288 <= LDSCTL_OFF && TAB_B12 + 2048 <= NSA_TB, "LDS tables");
enum { MD_CMP = 0, MD_WIN = 1, MD_BLK = 2, MD_MEM = 3 };
struct KF { bf16x8 a0, a1, b0, b1; };
struct VF { bf16x8 v[4]; };
__device__ __forceinline__ bf16x8 ldg16(const bf16* p) { return *(const bf16x8*)p; }
typedef float f32x2_t __attribute__((ext_vector_type(2))); typedef __bf16 bf16x2_t __attribute__((ext_vector_type(2)));
__device__ __forceinline__ unsigned cvtpk_s(float lo, float hi) { f32x2_t v = {lo, hi}; bf16x2_t b = __builtin_convertvector(v, bf16x2_t); return __builtin_bit_cast(unsigned, b); }
__device__ __forceinline__ bf16x8 pack8(const f32x4& a, const f32x4& b) { v4u w; w.x = cvtpk_s(a[0], a[1]); w.y = cvtpk_s(a[2], a[3]); w.z = cvtpk_s(b[0], b[1]); w.w = cvtpk_s(b[2], b[3]); return __builtin_bit_cast(bf16x8, w); }
__device__ __forceinline__ void load_k(KF& k, const bf16* kb, int kstride, int key0, int r, int kq) {
    const bf16* pa = kb + (size_t)(key0 + 8 * (r >> 2) + (r & 3)) * kstride + 8 * kq; const bf16* pb = pa + 4 * (size_t)kstride;
    k.a0 = ldg16(pa); k.a1 = ldg16(pa + 32); k.b0 = ldg16(pb); k.b1 = ldg16(pb + 32);
}
__device__ __forceinline__ void load_vt(VF& v, const bf16* vt, int vstride, int key0, int r, int kq) {
#pragma unroll
    for (int dt = 0; dt < 4; ++dt) v.v[dt] = ldg16(vt + (size_t)(16 * dt + r) * vstride + key0 + 8 * kq);
}
__device__ __forceinline__ void qk(f32x4& sa, f32x4& sb, const KF& k, const bf16x8 (&q)[2]) {
    const f32x4 z = {0.f, 0.f, 0.f, 0.f};
    sa = MFMA16(k.a0, q[0], z); sa = MFMA16(k.a1, q[1], sa); sb = MFMA16(k.b0, q[0], z); sb = MFMA16(k.b1, q[1], sb);
}
struct BiasCtx { const LAS unsigned short* tb; float d29, d30, c31; };
template <int MODE>
__device__ __forceinline__ void maskbias(f32x4& s, int kpos, int tcol, bool colok, const BiasCtx& B) {
    if (MODE == MD_MEM) return;
#pragma unroll
    for (int i = 0; i < 4; ++i) {
        int dist; bool ok;
        if (MODE == MD_CMP) { dist = tcol - 31 - 16 * (kpos + i); ok = dist >= 0; }
        else if (MODE == MD_WIN) { dist = tcol - (kpos + i); ok = (unsigned)dist <= 511u; }
        else { dist = tcol - (kpos + i); ok = dist >= 0; }
        int dc = dist < 0 ? 0 : dist; dc = dc > 1023 ? 1023 : dc;
        const float tb = __uint_as_float((unsigned)B.tb[dc * 6] << 16);
        const float far = B.c31 + (dist < 1513 ? B.d30 : 0.f) + (dist < 1117 ? B.d29 : 0.f);
        const float bias = dist < 1024 ? tb : far;
        s[i] = (ok && colok) ? s[i] + bias : -INFINITY;
    }
}
__device__ __forceinline__ float colmax(const f32x4& sa, const f32x4& sb) {
    float mx = fmaxf(fmaxf(fmaxf(sa[0], sa[1]), fmaxf(sa[2], sa[3])), fmaxf(fmaxf(sb[0], sb[1]), fmaxf(sb[2], sb[3])));
    mx = fmaxf(mx, __shfl_xor(mx, 16)); mx = fmaxf(mx, __shfl_xor(mx, 32)); return mx;
}
constexpr float SM_THR = 8.f;
__device__ __forceinline__ float lmax8(const f32x4& sa, const f32x4& sb) { return fmaxf(fmaxf(fmaxf(sa[0], sa[1]), fmaxf(sa[2], sa[3])), fmaxf(fmaxf(sb[0], sb[1]), fmaxf(sb[2], sb[3]))); }
template <int NO>
__device__ __forceinline__ void sm_rescale(float lm, float& m, float& l, f32x4 (&O)[NO]) {
    if (__any(lm > m + SM_THR)) {
        lm = fmaxf(lm, __shfl_xor(lm, 16)); lm = fmaxf(lm, __shfl_xor(lm, 32));
        const float mn = fmaxf(m, lm); const float al = __builtin_amdgcn_exp2f(m - mn); m = mn; l *= al;
#pragma unroll
        for (int dt = 0; dt < NO; ++dt) O[dt] = O[dt] * al;
    }
}
__device__ __forceinline__ bf16x8 sm_update(const f32x4& sa, const f32x4& sb, float& m, float& l, f32x4 (&O)[4]) {
    sm_rescale<4>(lmax8(sa, sb), m, l, O);
    f32x4 pa, pb; float sum = 0.f;
#pragma unroll
    for (int i = 0; i < 4; ++i) { pa[i] = __builtin_amdgcn_exp2f(sa[i] - m); pb[i] = __builtin_amdgcn_exp2f(sb[i] - m); sum += pa[i] + pb[i]; }
    l += sum;
    return pack8(pa, pb);
}
__device__ __forceinline__ void sm_update64(const f32x4& sa0, const f32x4& sb0, const f32x4& sa1, const f32x4& sb1, float& m, float& l, f32x4 (&O)[4], bf16x8& pf0, bf16x8& pf1) {
    sm_rescale<4>(fmaxf(lmax8(sa0, sb0), lmax8(sa1, sb1)), m, l, O);
    f32x4 pa0, pb0, pa1, pb1; float sum = 0.f;
#pragma unroll
    for (int i = 0; i < 4; ++i) { pa0[i] = __builtin_amdgcn_exp2f(sa0[i] - m); pb0[i] = __builtin_amdgcn_exp2f(sb0[i] - m); pa1[i] = __builtin_amdgcn_exp2f(sa1[i] - m); pb1[i] = __builtin_amdgcn_exp2f(sb1[i] - m);
        sum += (pa0[i] + pb0[i]) + (pa1[i] + pb1[i]); }
    l += sum;
    pf0 = pack8(pa0, pb0); pf1 = pack8(pa1, pb1);
}
__device__ __forceinline__ void pv(f32x4 (&O)[4], const VF& v, const bf16x8& pf) {
#pragma unroll
    for (int dt = 0; dt < 4; ++dt) O[dt] = MFMA16(v.v[dt], pf, O[dt]);
}
__device__ __forceinline__ void lds_fadd(LAS float* p, float v) { (void)__hip_atomic_fetch_add((float*)p, v, __ATOMIC_RELAXED, __HIP_MEMORY_SCOPE_WORKGROUP); }
__device__ __forceinline__ float kqsum(float v) { v += __shfl_xor(v, 16); v += __shfl_xor(v, 32); return v; }
__device__ __forceinline__ float wmax64(float v) {
#pragma unroll
    for (int o = 1; o < 64; o <<= 1) v = fmaxf(v, __shfl_xor(v, o));
    return v;
}
__device__ __forceinline__ void out_add(LAS float* OUTw, int p, int n, int kq, const f32x4 (&O)[4], float scale, bool first) {
    const int q = 2 * p + (n >> 3), hd = n & 7;
    if (hd < 6) { LAS f32x4* dst = (LAS f32x4*)(OUTw + (q * 6 + hd) * 64) + kq;
#pragma unroll
        for (int dt = 0; dt < 4; ++dt) { f32x4 v = O[dt] * scale; if (!first) v = v + dst[4 * dt]; dst[4 * dt] = v; } }
}

__device__ __forceinline__ void p2_mfma(Frame& F, const In& I, unsigned char* ws) {
    OPAQUE_TID(); KARGS(); const int lane = tid_ & 63, wave = __builtin_amdgcn_readfirstlane(tid_ >> 6), r = lane & 15, kq = lane >> 4;
    const bf16* KV0 = (const bf16*)(ws + WS_KV0); const bf16* W1T = (const bf16*)(ws + WS_W1T); const bf16* W2T = (const bf16*)(ws + WS_W2T); const float* B1F = (const float*)(ws + WS_B1F);
    const bf16* MEMN = (const bf16*)(ws + WS_MEMN); const bf16* WMKT = (const bf16*)(ws + WS_WMKT);
    bf16* KCB = (bf16*)(ws + WS_KCB); bf16* VCT = (bf16*)(ws + WS_VCT); bf16* MKB = (bf16*)(ws + WS_MKB); bf16* MVT = (bf16*)(ws + WS_MVT);
    LAS unsigned char* hid = F.lds + RING_OFF;
    for (int u = blockIdx.x; u < 192; u += F.G) {
        const bool cmp = u < 128;
        const bf16* ap[2]; const bf16* bp[2]; int K, kjump;
        int kv = 0, bg = 0, n0 = 0, lay = 0, m0 = 0, ch = 0;
        if (cmp) { kv = u >> 6; bg = (u >> 4) & 3; n0 = (u & 15) * 32; const int b = bg >> 1, g = bg & 1; K = 2048; kjump = 512 - 64;
#pragma unroll
            for (int rt = 0; rt < 2; ++rt) { int nn = n0 + 16 * rt + r; nn = nn > 510 ? 510 : nn; ap[rt] = KV0 + (size_t)(b * T + 16 * nn) * 512 + kv * 128 + g * 64 + 8 * kq; }
#pragma unroll
            for (int ct = 0; ct < 2; ++ct) bp[ct] = W1T + (size_t)(kv * 256 + 32 * wave + 16 * ct + r) * 2048 + 8 * kq;
        } else { const int v = u - 128; lay = v >> 5; m0 = ((v >> 1) & 15) * 32; ch = v & 1; K = 1024; kjump = 0;
#pragma unroll
            for (int rt = 0; rt < 2; ++rt) ap[rt] = MEMN + (size_t)(lay * 512 + m0 + 16 * rt + r) * 1024 + 8 * kq;
#pragma unroll
            for (int ct = 0; ct < 2; ++ct) bp[ct] = WMKT + (size_t)(lay * 512 + ch * 256 + 32 * wave + 16 * ct + r) * 1024 + 8 * kq;
        }
        f32x4 acc[2][2];
#pragma unroll
        for (int rt = 0; rt < 2; ++rt)
#pragma unroll
            for (int ct = 0; ct < 2; ++ct) acc[rt][ct] = (f32x4){0.f, 0.f, 0.f, 0.f};
        for (int kb = 0; kb < K; kb += 64) { const int ao = kb + (kb >> 6) * kjump;
            bf16x8 a[2][2], bb[2][2];
#pragma unroll
            for (int h2 = 0; h2 < 2; ++h2) {
#pragma unroll
                for (int rt = 0; rt < 2; ++rt) a[rt][h2] = ldg16(ap[rt] + ao + 32 * h2);
#pragma unroll
                for (int ct = 0; ct < 2; ++ct) bb[ct][h2] = ldg16(bp[ct] + kb + 32 * h2); }
#pragma unroll
            for (int h2 = 0; h2 < 2; ++h2)
#pragma unroll
                for (int rt = 0; rt < 2; ++rt)
#pragma unroll
                    for (int ct = 0; ct < 2; ++ct) acc[rt][ct] = MFMA16(a[rt][h2], bb[ct][h2], acc[rt][ct]);
        }
        if (cmp) {
#pragma unroll
            for (int ct = 0; ct < 2; ++ct) { const int col = 32 * wave + 16 * ct + r; const float bias = B1F[kv * 256 + col];
#pragma unroll
                for (int rt = 0; rt < 2; ++rt)
#pragma unroll
                    for (int i = 0; i < 4; ++i) { const float xg = acc[rt][ct][i] + bias; const float hv = 0.5f * xg * (1.f + tanhf(0.7978845608028654f * (xg + 0.044715f * xg * xg * xg)));
                        *(LAS unsigned short*)(hid + (16 * rt + 4 * kq + i) * 528 + 2 * col) = (unsigned short)f2bf(hv); } }
            __syncthreads();
            { const int rt2 = wave >> 2, ct2 = wave & 3; f32x4 o = {0.f, 0.f, 0.f, 0.f};
              const bf16* w2p = W2T + (size_t)(kv * 64 + 16 * ct2 + r) * 256 + 8 * kq;
#pragma unroll
              for (int ks = 0; ks < 8; ++ks) { const bf16x8 av = *(const LAS bf16x8*)(hid + (16 * rt2 + r) * 528 + 64 * ks + 16 * kq); o = MFMA16(av, ldg16(w2p + 32 * ks), o); }
              const int d = 16 * ct2 + r; const float b2v = (kv ? Ip->v_b2 : Ip->k_b2)[d];
#pragma unroll
              for (int i = 0; i < 4; ++i) { const int nn = n0 + 16 * rt2 + 4 * kq + i; const unsigned short ov = (nn < NCMP) ? (unsigned short)f2bf(o[i] + b2v) : (unsigned short)0;
                  if (kv) VCT[(size_t)(bg * 64 + d) * 512 + nn] = ov; else KCB[(size_t)(bg * 512 + nn) * 64 + d] = ov; } }
            __syncthreads();
        } else {
#pragma unroll
            for (int ct = 0; ct < 2; ++ct) { const int col = 32 * wave + 16 * ct + r;
#pragma unroll
                for (int rt = 0; rt < 2; ++rt)
#pragma unroll
                    for (int i = 0; i < 4; ++i) { const int mrow = m0 + 16 * rt + 4 * kq + i; const unsigned short ov = (unsigned short)f2bf(acc[rt][ct][i]);
                        if (ch == 0) MKB[(size_t)(lay * 512 + mrow) * 256 + col] = ov; else MVT[(size_t)(lay * 256 + col) * 512 + mrow] = ov; } }
        }
    }
}

template <int MODE>
__device__ __forceinline__ void mb2(f32x4& sa, f32x4& sb, int kpos, int tcol, bool colok, bool fast, const BiasCtx& B) {
    if (fast) { if (colok) { sa = sa + B.c31; sb = sb + B.c31; } else { sa = (f32x4){-INFINITY, -INFINITY, -INFINITY, -INFINITY}; sb = sa; } }
    else { maskbias<MODE>(sa, kpos, tcol, colok, B); maskbias<MODE>(sb, kpos + 4, tcol, colok, B); }
}
#define SWZ(row) (((((row) >> 3) & 3) << 1) | (((row) >> 1) & 1))
struct KV1 { KF k; VF v; };
__device__ __forceinline__ void load_kv(KV1& d, const bf16* kb, int kstride, const bf16* vt, int vstride, int key0, int r, int kq) { load_k(d.k, kb, kstride, key0, r, kq); load_vt(d.v, vt, vstride, key0, r, kq); }

__device__ __forceinline__ void p3_nsa_mfma(Frame& F, const In& I, unsigned char* ws) {
    OPAQUE_TID(); KARGS(); const int wave = __builtin_amdgcn_readfirstlane(tid_ >> 6);
    LAS float* b12 = (LAS float*)(F.lds + TAB_B12);
    LAS float* OUTf = (LAS float*)(F.lds + NSA_OUT); LAS float* OUTw = OUTf + wave * 3072;
    LAS float* PSw = (LAS float*)(F.lds + NSA_PSQ) + wave * 1024;
    LAS unsigned char* STG = F.lds + NSA_PSQ;
    LAS unsigned* WMw = (LAS unsigned*)(F.lds + NSA_ST) + wave * 32;
    for (int i = tid_; i < 512; i += NWAVES * 64) b12[i] = ((i & 15) < 12) ? Ip->rel_bias[(i >> 4) * 12 + (i & 15)] * LOG2E : 0.f;
    LAS unsigned short* TB = (LAS unsigned short*)(F.lds + NSA_TB);
    { const int gg = (int)blockIdx.x & 1;
      for (int i = tid_; i < 6144; i += NWAVES * 64) { const int dd = i / 6, hh = i % 6; TB[i] = (unsigned short)f2bf(Ip->rel_bias[rel_bucket(dd) * 12 + gg * 6 + hh] * LOG2E); } }
    __syncthreads();
    const bf16* Q0 = (const bf16*)(ws + WS_Q0); const bf16* KV0 = (const bf16*)(ws + WS_KV0); const bf16* QM = (const bf16*)(ws + WS_QM); const bf16* G0 = (const bf16*)(ws + WS_G0);
    const bf16* VT = (const bf16*)(ws + WS_VT); const bf16* KCB = (const bf16*)(ws + WS_KCB); const bf16* VCT = (const bf16*)(ws + WS_VCT);
    const bf16* MKB = (const bf16*)(ws + WS_MKB); const bf16* MVT = (const bf16*)(ws + WS_MVT);
    bf16* CAT = (bf16*)(ws + WS_CAT);
    const int nun = 4 * 128;
    for (int ui = blockIdx.x; ui < nun; ui += F.G) {
        int tl_ = tid_; asm volatile("" : "+v"(tl_));
        const int lane = tl_ & 63, n = lane & 15, kq = lane >> 4, r = n, hd = n & 7, qsel = n >> 3; const bool colv = hd < 6;
        int bg, qt;
        bg = blockIdx.x & 3;
        if (F.G == 256) { const int idx = blockIdx.x >> 2; qt = (ui < 256) ? idx : 127 - idx; }
        else { qt = ui >> 2; if ((ui & 3) != bg) continue; }
        const int b = bg >> 1, g = bg & 1, t0w = 64 * qt + 8 * wave, rowb = b * T;
        const int habs = g * 6 + (colv ? hd : 0);
        const LAS float* b12c = b12 + habs; const BiasCtx BC{TB + (colv ? hd : 0), b12c[29 * 16] - b12c[30 * 16], b12c[30 * 16] - b12c[31 * 16], b12c[31 * 16]};

        bf16x8 qf[4][2];
#pragma unroll
        for (int p = 0; p < 4; ++p) { const bf16* qp = Q0 + (size_t)(rowb + t0w + 2 * p + qsel) * 768 + habs * 64 + 8 * kq;
#pragma unroll
            for (int ks = 0; ks < 2; ++ks) { bf16x8 v = ldg16(qp + 32 * ks); if (!colv) v = (bf16x8){0, 0, 0, 0, 0, 0, 0, 0}; qf[p][ks] = v; } }
        for (int i = lane; i < 1024; i += 64) PSw[i] = 0.f;
        float m[4], l[4]; f32x4 O[4][4];
        const int ncmax = (t0w + 7 >= 31) ? ((t0w + 7 - 31) / 16 + 1) : 0;
        const bf16* kcb = KCB + (size_t)(bg * 512) * 64; const bf16* vct = VCT + (size_t)(bg * 64) * 512;
#pragma unroll
        for (int p = 0; p < 4; ++p) { m[p] = -1e30f; l[p] = 0.f; }
        if (ncmax > 0) {
            int r_ = r, kq_ = kq; asm volatile("" : "+v"(r_), "+v"(kq_));
            for (int key0 = 0; key0 < ncmax; key0 += 32) {
                asm volatile("" : "+v"(r_), "+v"(kq_));
                KF kA; load_k(kA, kcb, 64, key0, r_, kq_);
                const bool fast = (t0w - 31 - 16 * (key0 + 31)) >= 1513;
#pragma unroll
                for (int p = 0; p < 4; ++p) { f32x4 sa, sb; qk(sa, sb, kA, qf[p]); const int tcol = t0w + 2 * p + qsel;
                    mb2<MD_CMP>(sa, sb, key0 + 8 * kq_, tcol, true, fast, BC);
                    const float mn = fmaxf(m[p], colmax(sa, sb)); float sum = 0.f;
#pragma unroll
                    for (int i = 0; i < 4; ++i) sum += __builtin_amdgcn_exp2f(sa[i] - mn) + __builtin_amdgcn_exp2f(sb[i] - mn);
                    l[p] = l[p] * __builtin_amdgcn_exp2f(m[p] - mn) + sum; m[p] = mn; __builtin_amdgcn_sched_barrier(0); }
            }
        }
        float invl[4];
#pragma unroll
        for (int p = 0; p < 4; ++p) { const float lt = kqsum(l[p]); invl[p] = lt > 0.f ? 1.f / lt : 0.f; }
#pragma unroll
        for (int p = 0; p < 4; ++p)
#pragma unroll
            for (int dt = 0; dt < 4; ++dt) O[p][dt] = (f32x4){0.f, 0.f, 0.f, 0.f};
        float carry[4] = {0.f, 0.f, 0.f, 0.f};
        if (ncmax > 0) {
            int r_ = r, kq_ = kq; asm volatile("" : "+v"(r_), "+v"(kq_));
            for (int key0 = 0; key0 < ncmax; key0 += 32) {
                asm volatile("" : "+v"(r_), "+v"(kq_));
                KV1 A; load_kv(A, kcb, 64, vct, 512, key0, r_, kq_);
                const bool fast = (t0w - 31 - 16 * (key0 + 31)) >= 1513;
#pragma unroll
                for (int p = 0; p < 4; ++p) { f32x4 sa, sb; qk(sa, sb, A.k, qf[p]); const int tcol = t0w + 2 * p + qsel;
                    mb2<MD_CMP>(sa, sb, key0 + 8 * kq_, tcol, true, fast, BC);
                    f32x4 pa, pb;
#pragma unroll
                    for (int i = 0; i < 4; ++i) { pa[i] = __builtin_amdgcn_exp2f(sa[i] - m[p]) * invl[p]; pb[i] = __builtin_amdgcn_exp2f(sb[i] - m[p]) * invl[p]; }
                    pv(O[p], A.v, pack8(pa, pb));
                    float wA = (pa[0] + pa[1]) + (pa[2] + pa[3]), wB = pa[3] + ((pb[0] + pb[1]) + (pb[2] + pb[3])), wC = pb[3];
                    if (!colv) { wA = 0.f; wB = 0.f; wC = 0.f; }
                    const float up = __shfl(wC, (lane + 48) & 63);
                    const float prevC = (kq == 0) ? carry[p] : up; carry[p] = up;
                    float a0 = wA + prevC, a1 = wB;
                    a0 += __shfl_xor(a0, 1); a1 += __shfl_xor(a1, 1); a0 += __shfl_xor(a0, 2); a1 += __shfl_xor(a1, 2); a0 += __shfl_xor(a0, 4); a1 += __shfl_xor(a1, 4);
                    if (hd == 0) { LAS float* ps = PSw + (2 * p + qsel) * 128 + (key0 >> 2) + 2 * kq; ps[0] = a0; ps[1] = a1; } __builtin_amdgcn_sched_barrier(0); }
            }
        }
        if (ncmax > 0 && ncmax <= 480) {
            const int jn = ((ncmax + 31) >> 5) * 8;
#pragma unroll
            for (int p = 0; p < 4; ++p) { float a0 = carry[p]; a0 += __shfl_xor(a0, 1); a0 += __shfl_xor(a0, 2); a0 += __shfl_xor(a0, 4); if (hd == 0 && kq == 0) PSw[(2 * p + qsel) * 128 + jn] = a0; }
        }
        {
#pragma unroll
            for (int p = 0; p < 4; ++p) { const size_t row = (size_t)(rowb + t0w + 2 * p + qsel);
                const float gz = bf2f(G0[row * 256 + habs * 3 + 0]) + Ip->nsa_gate_b[habs * 3 + 0]; out_add(OUTw, p, n, kq, O[p], 1.f / (1.f + __expf(-gz)), true); }
        }
        for (int i = lane; i < 32; i += 64) WMw[i] = (qt < 16) ? 0xffffffffu : 0u;
        if (qt >= 16) {
            if (lane < 3) { const int j = lane == 0 ? 0 : qt - 2 + lane; atomicOr((unsigned*)&WMw[j >> 2], 0xffu << (8 * (j & 3))); }
            for (int q = 0; q < 8; ++q) {
                float v0 = PSw[q * 128 + lane], v1 = PSw[q * 128 + 64 + lane];
                if (lane < 1 || lane > qt - 2) v0 = -1.f; if (lane + 64 > qt - 2) v1 = -1.f;
                for (int s = 0; s < 13; ++s) { const float mx = wmax64(fmaxf(v0, v1));
                    const unsigned long long b0 = __ballot(v0 == mx); int j;
                    if (b0) { j = __builtin_ctzll(b0); if (lane == j) v0 = -1.f; } else { const unsigned long long b1 = __ballot(v1 == mx); j = __builtin_ctzll(b1); if (lane == j) v1 = -1.f; j += 64; }
                    if (lane == 0) atomicOr((unsigned*)&WMw[j >> 2], 1u << (8 * (j & 3) + q)); }
            }
        }
        const bf16* ksb = KV0 + (size_t)rowb * 512 + 256 + g * 64; const bf16* vst = VT + ((size_t)(rowb >> 6) * 256 + g * 64) * 64;
        __syncthreads();
#pragma unroll 1
        for (int rep_ = 0; rep_ < (PROBE_REP == 1 ? 2 : 1); ++rep_) {
#pragma unroll
            for (int p = 0; p < 4; ++p) { m[p] = -1e30f; l[p] = 0.f;
#pragma unroll
                for (int dt = 0; dt < 4; ++dt) O[p][dt] = (f32x4){0.f, 0.f, 0.f, 0.f}; }
            const int srow = 8 * wave + (lane >> 3), sch = (lane & 7) ^ SWZ(srow);
            const bf16* ksrc = ksb + (size_t)srow * 512 + 8 * sch; const bf16* vsrc = vst + (size_t)srow * 64 + 8 * sch;
#define NSA_DMA(jb) do { LAS unsigned char* d_ = STG + ((jb) % 3) * 16384 + wave * 1024; \
                __builtin_amdgcn_global_load_lds((const unsigned*)(ksrc + (size_t)(jb) * 64 * 512), (LAS unsigned*)d_, 16, 0, 0); \
                __builtin_amdgcn_global_load_lds((const unsigned*)(vsrc + (size_t)(jb) * 16384), (LAS unsigned*)(d_ + 8192), 16, 0, 0); } while (0)
            NSA_DMA(0); if (qt >= 1) NSA_DMA(1);
            if (qt >= 1) asm volatile("s_waitcnt vmcnt(2)" ::: "memory"); else asm volatile("s_waitcnt vmcnt(0)" ::: "memory");
            __builtin_amdgcn_s_barrier();
            for (int j = 0; j <= qt; ++j) {
                const LAS unsigned char* sk = STG + (j % 3) * 16384; const LAS unsigned char* sv = sk + 8192;
                const bool more = (j + 2) <= qt;
                if (more) NSA_DMA(j + 2);
                const unsigned m8 = (unsigned)__builtin_amdgcn_readfirstlane((int)((WMw[j >> 2] >> (8 * (j & 3))) & 0xffu));
                if (m8) {
                    const bool fast = (64 * qt - (64 * j + 63)) >= 1513;
                    KF k0, k1;
                    { const int ka = 8 * (r >> 2) + (r & 3), kb2 = ka + 4, kc = ka + 32, kd = ka + 36;
                      k0.a0 = *(const LAS bf16x8*)(sk + ka * 128 + ((kq ^ SWZ(ka)) << 4)); k0.a1 = *(const LAS bf16x8*)(sk + ka * 128 + (((4 + kq) ^ SWZ(ka)) << 4));
                      k0.b0 = *(const LAS bf16x8*)(sk + kb2 * 128 + ((kq ^ SWZ(kb2)) << 4)); k0.b1 = *(const LAS bf16x8*)(sk + kb2 * 128 + (((4 + kq) ^ SWZ(kb2)) << 4));
                      k1.a0 = *(const LAS bf16x8*)(sk + kc * 128 + ((kq ^ SWZ(kc)) << 4)); k1.a1 = *(const LAS bf16x8*)(sk + kc * 128 + (((4 + kq) ^ SWZ(kc)) << 4));
                      k1.b0 = *(const LAS bf16x8*)(sk + kd * 128 + ((kq ^ SWZ(kd)) << 4)); k1.b1 = *(const LAS bf16x8*)(sk + kd * 128 + (((4 + kq) ^ SWZ(kd)) << 4)); }
#pragma unroll
                    for (int p = 0; p < 4; ++p) if (m8 & (3u << (2 * p))) {
                        f32x4 sa0, sb0, sa1, sb1; qk(sa0, sb0, k0, qf[p]); qk(sa1, sb1, k1, qf[p]);
                        const bool cok = ((m8 >> (2 * p + qsel)) & 1u) != 0u; const int tcol = t0w + 2 * p + qsel;
                        mb2<MD_BLK>(sa0, sb0, 64 * j + 8 * kq, tcol, cok, fast, BC); mb2<MD_BLK>(sa1, sb1, 64 * j + 32 + 8 * kq, tcol, cok, fast, BC);
                        bf16x8 pf0, pf1; sm_update64(sa0, sb0, sa1, sb1, m[p], l[p], O[p], pf0, pf1);
#pragma unroll
                        for (int h2 = 0; h2 < 2; ++h2) { VF v;
#pragma unroll
                            for (int dt = 0; dt < 4; ++dt) { const int dd = 16 * dt + r; v.v[dt] = *(const LAS bf16x8*)(sv + dd * 128 + (((4 * h2 + kq) ^ SWZ(dd)) << 4)); }
                            pv(O[p], v, h2 ? pf1 : pf0); }
                        __builtin_amdgcn_sched_barrier(0); }
                }
                if (more) asm volatile("s_waitcnt vmcnt(2) lgkmcnt(0)" ::: "memory"); else asm volatile("s_waitcnt vmcnt(0) lgkmcnt(0)" ::: "memory");
                __builtin_amdgcn_s_barrier();
            }
#undef NSA_DMA
        }
#pragma unroll
        for (int p = 0; p < 4; ++p) { const size_t row = (size_t)(rowb + t0w + 2 * p + qsel);
            const float gz = bf2f(G0[row * 256 + habs * 3 + 1]) + Ip->nsa_gate_b[habs * 3 + 1]; out_add(OUTw, p, n, kq, O[p], (1.f / (1.f + __expf(-gz))) / kqsum(l[p]), false); }
        const bf16* kwb = KV0 + (size_t)rowb * 512 + 384 + g * 64; const bf16* vwt = VT + ((size_t)(rowb >> 6) * 256 + 128 + g * 64) * 64;
#pragma unroll
        for (int p = 0; p < 4; ++p) { m[p] = -1e30f; l[p] = 0.f;
#pragma unroll
            for (int dt = 0; dt < 4; ++dt) O[p][dt] = (f32x4){0.f, 0.f, 0.f, 0.f}; }
        { const int kstart = (t0w - 511 > 0) ? ((t0w - 511) & ~31) : 0, klast = (t0w + 7) & ~31;
          int r_ = r, kq_ = kq; asm volatile("" : "+v"(r_), "+v"(kq_));
          for (int key0 = kstart; key0 <= klast; key0 += 32) {
              asm volatile("" : "+v"(r_), "+v"(kq_));
              KV1 A; load_k(A.k, kwb, 512, key0, r_, kq_); load_vt(A.v, vwt + (size_t)(key0 >> 6) * 16384, 64, key0 & 63, r_, kq_);
#pragma unroll
              for (int p = 0; p < 4; ++p) { f32x4 sa, sb; qk(sa, sb, A.k, qf[p]); const int tcol = t0w + 2 * p + qsel;
                  mb2<MD_WIN>(sa, sb, key0 + 8 * kq_, tcol, true, false, BC);
                  pv(O[p], A.v, sm_update(sa, sb, m[p], l[p], O[p])); __builtin_amdgcn_sched_barrier(0); } } }
#pragma unroll
        for (int p = 0; p < 4; ++p) { const size_t row = (size_t)(rowb + t0w + 2 * p + qsel);
            const float gz = bf2f(G0[row * 256 + habs * 3 + 2]) + Ip->nsa_gate_b[habs * 3 + 2]; out_add(OUTw, p, n, kq, O[p], (1.f / (1.f + __expf(-gz))) / kqsum(l[p]), false); }
        int ln_ = lane; asm volatile("" : "+v"(ln_));
#pragma unroll 1
        for (int i = 0; i < 12; ++i) { const int e = i * 64 + ln_, q = e / 96, c4 = e % 96; const f32x4 v = ((const LAS f32x4*)OUTw)[e];
            *(uint2*)(CAT + (size_t)(rowb + t0w + q) * 1024 + g * 384 + 4 * c4) = make_uint2(pk2(v[0], v[1]), pk2(v[2], v[3])); }
#pragma unroll 1
        for (int h2 = 0; h2 < 2; ++h2) { const int hm = 2 * g + h2;
            bf16x8 qm[2]; { const bf16* qp = QM + (size_t)(rowb + t0w + (n & 7)) * 256 + hm * 64 + 8 * kq; qm[0] = ldg16(qp); qm[1] = ldg16(qp + 32); if (n >= 8) { qm[0] = (bf16x8){0, 0, 0, 0, 0, 0, 0, 0}; qm[1] = qm[0]; } }
            float mm = -1e30f, ll = 0.f; f32x4 Om[4];
#pragma unroll
            for (int dt = 0; dt < 4; ++dt) Om[dt] = (f32x4){0.f, 0.f, 0.f, 0.f};
            const bf16* mk = MKB + (size_t)(b * 256) * 256 + hm * 64; const bf16* mvt = MVT + (size_t)(hm * 64) * 512 + b * 256;
            int r_ = r, kq_ = kq; asm volatile("" : "+v"(r_), "+v"(kq_));
            KV1 A; load_kv(A, mk, 256, mvt, 512, 0, r_, kq_);
            for (int key0 = 0; key0 < 256; key0 += 32) { asm volatile("" : "+v"(r_), "+v"(kq_));
                KV1 B; load_kv(B, mk, 256, mvt, 512, (key0 + 32 < 256) ? key0 + 32 : key0, r_, kq_);
                f32x4 sa, sb; qk(sa, sb, A.k, qm); pv(Om, A.v, sm_update(sa, sb, mm, ll, Om)); A = B; }
            const float il = 1.f / kqsum(ll);
            if (n < 8) { bf16* op = CAT + (size_t)(rowb + t0w + n) * 1024 + 768 + hm * 64 + 4 * kq;
#pragma unroll
                for (int dt = 0; dt < 4; ++dt) *(uint2*)(op + 16 * dt) = make_uint2(pk2(Om[dt][0] * il, Om[dt][1] * il), pk2(Om[dt][2] * il, Om[dt][3] * il)); }
        }
    }
}

__device__ __forceinline__ void p10_dsa_norm(Frame& F, const In& I, unsigned char* ws) {
    OPAQUE_TID(); KARGS(); const int gw = F.vcu * NWAVES + (tid_ >> 6), NGW = F.G * NWAVES, lane = tid_ & 63;
    const bf16* PR = (const bf16*)(ws + WS_PROJ1); bf16* CQ = (bf16*)(ws + WS_CQ); bf16* CKV = (bf16*)(ws + WS_CKV); bf16* KIDX = (bf16*)(ws + WS_KIDX); float* WIDX = (float*)(ws + WS_WIDX);
    for (int m = gw; m < M; m += NGW) {
        const bf16* pr = PR + (size_t)m * 768;
        float a[4]; ld4bf(pr + 4 * lane, a);
        float s = wave_sum(a[0] * a[0] + a[1] * a[1] + a[2] * a[2] + a[3] * a[3]); float r = rsqrtf(s * (1.f / 256.f) + EPSF);
        const float4 gq = *(const float4*)(Ip->q_norm + 4 * lane);
        *(uint2*)(CQ + (size_t)m * 256 + 4 * lane) = make_uint2(pk2((a[0] * r) * gq.x, (a[1] * r) * gq.y), pk2((a[2] * r) * gq.z, (a[3] * r) * gq.w));
        const unsigned u = *(const unsigned*)(pr + 256 + 2 * lane); const float c0 = bflo(u), c1 = bfhi(u);
        s = wave_sum(c0 * c0 + c1 * c1); r = rsqrtf(s * (1.f / 128.f) + EPSF);
        *(unsigned*)(CKV + (size_t)m * 128 + 2 * lane) = pk2((c0 * r) * Ip->kv_norm[2 * lane], (c1 * r) * Ip->kv_norm[2 * lane + 1]);
        const float k0 = bf2f(pr[384 + lane]);
        s = wave_sum(k0 * k0); r = rsqrtf(s * (1.f / 64.f) + EPSF);
        { const int tk = m >> 5, key = m & 31, ks = lane >> 4, hf = (lane >> 3) & 1, jj = lane & 7;
          KIDX[((size_t)(tk * 4 + ks) * 64 + hf * 32 + key) * 8 + jj] = (bf16)f2bf((k0 * r) * Ip->kidx_norm[lane]); }
        if (lane < 8) WIDX[(size_t)m * 8 + lane] = bf2f(pr[448 + lane]) * (0.35355339059327373f * 0.125f);
    }
}

#define MFMA32(A, B, C) __builtin_amdgcn_mfma_f32_32x32x16_bf16((A), (B), (C), 0, 0, 0)
typedef float f32x16 __attribute__((ext_vector_type(16)));
constexpr int XL_OFF = RING_BYTES;
constexpr int IDX_HIST = XL_OFF, IDX_CAND = XL_OFF + 16384, IDX_MM = XL_OFF + 24576, IDX_STQ = IDX_MM + 256, IDX_MM2 = IDX_STQ + 256, IDX_CAP = 1024;
static_assert(IDX_MM2 + 64 <= LDSCTL_OFF, "LDS map (indexer)");
__device__ __forceinline__ float wmin64(float v) {
#pragma unroll
    for (int o = 1; o < 64; o <<= 1) v = fminf(v, __shfl_xor(v, o));
    return v;
}
__device__ __forceinline__ void p12_index_mfma(Frame& F, const In& I, unsigned char* ws) {
    OPAQUE_TID(); KARGS(); const int lane = tid_ & 63, wave = __builtin_amdgcn_readfirstlane(tid_ >> 6), key = lane & 31, half = lane >> 5;
    LAS float* SC = (LAS float*)(F.lds + RING_OFF);
    LAS float* MMw = (LAS float*)(F.lds + IDX_MM);
    const bf16* QI = (const bf16*)(ws + WS_QI); const bf16* KIDX = (const bf16*)(ws + WS_KIDX); const float* WIDX = (const float*)(ws + WS_WIDX);
    unsigned short* SEL = (unsigned short*)(ws + WS_SEL); int* CNT = (int*)(ws + WS_CNT);
    const int NG = M / 4, per = (NG + F.G - 1) / F.G;
    for (int j = 0; j < per; ++j) {
        const int u = j * F.G + ((j & 1) ? (F.G - 1 - (int)blockIdx.x) : (int)blockIdx.x);
        if (u >= NG) break;
        const int gi = (u & 1) * (NG / 2) + (u >> 1);
        const int row0 = 4 * gi, b = row0 / T, t0 = row0 % T, rowb = b * T;
        if (t0 < 256) {
            if (wave < 4) { const int t = t0 + wave; unsigned short* so = SEL + (size_t)(row0 + wave) * 256;
#pragma unroll
                for (int i = 0; i < 4; ++i) { const int s = lane + 64 * i; so[s] = (unsigned short)(s <= t ? s : 0); }
                if (lane == 0) CNT[row0 + wave] = t + 1; }
            continue;
        }
        {
            const int rho = lane & 31, a = rho >> 2, qA = ((a >> 2) & 1) + 2 * (a & 1), hdA = 4 * ((a >> 1) & 1) + (rho & 3);
            bf16x8 qa[4];
#pragma unroll
            for (int ks = 0; ks < 4; ++ks) qa[ks] = ldg16(QI + (size_t)(row0 + qA) * 512 + hdA * 64 + 16 * ks + 8 * half);
            float w0[8], w1[8];
            { const float4 x0 = *(const float4*)(WIDX + (size_t)(row0 + 2 * half) * 8), x1 = *(const float4*)(WIDX + (size_t)(row0 + 2 * half) * 8 + 4);
              const float4 y0 = *(const float4*)(WIDX + (size_t)(row0 + 2 * half + 1) * 8), y1 = *(const float4*)(WIDX + (size_t)(row0 + 2 * half + 1) * 8 + 4);
              w0[0] = x0.x; w0[1] = x0.y; w0[2] = x0.z; w0[3] = x0.w; w0[4] = x1.x; w0[5] = x1.y; w0[6] = x1.z; w0[7] = x1.w;
              w1[0] = y0.x; w1[1] = y0.y; w1[2] = y0.z; w1[3] = y0.w; w1[4] = y1.x; w1[5] = y1.y; w1[6] = y1.z; w1[7] = y1.w; }
            const int tq0 = t0 + 2 * half, tq1 = tq0 + 1, nt = (t0 + 3) / 32 + 1;
            float mn0 = INFINITY, mx0 = -INFINITY, mn1 = INFINITY, mx1 = -INFINITY;
            const bf16* kpb = KIDX + (size_t)(rowb >> 5) * 2048 + (size_t)lane * 8;
            const int ntw = (nt - wave + NWAVES - 1) / NWAVES;
#define IDX_LOAD(dst, i) do { const int tl2_ = wave + NWAVES * ((i) < ntw ? (i) : (ntw > 0 ? ntw - 1 : 0)); const bf16* kp_ = kpb + (size_t)tl2_ * 2048; \
                _Pragma("unroll") for (int ks = 0; ks < 4; ++ks) dst[ks] = ldg16(kp_ + 512 * ks); } while (0)
#define IDX_COMP(src, i) do { if ((i) < ntw) { const int kpos = 32 * (wave + NWAVES * (i)) + key; \
                f32x16 c = {0.f, 0.f, 0.f, 0.f, 0.f, 0.f, 0.f, 0.f, 0.f, 0.f, 0.f, 0.f, 0.f, 0.f, 0.f, 0.f}; \
                _Pragma("unroll") for (int ks = 0; ks < 4; ++ks) c = MFMA32(qa[ks], src[ks], c); \
                float s0 = 0.f, s1 = 0.f; \
                _Pragma("unroll") for (int h = 0; h < 8; ++h) { s0 += fmaxf(c[h], 0.f) * w0[h]; s1 += fmaxf(c[8 + h], 0.f) * w1[h]; } \
                s0 += 0.f; s1 += 0.f; \
                const bool ok0 = kpos <= tq0, ok1 = kpos <= tq1; \
                SC[(2 * half) * 8192 + kpos] = ok0 ? s0 : -INFINITY; SC[(2 * half + 1) * 8192 + kpos] = ok1 ? s1 : -INFINITY; \
                if (ok0) { mn0 = fminf(mn0, s0); mx0 = fmaxf(mx0, s0); } if (ok1) { mn1 = fminf(mn1, s1); mx1 = fmaxf(mx1, s1); } } } while (0)
            for (int prb_ = 0; prb_ < (PROBE_REP == 2 ? 2 : 1); ++prb_)
            if (ntw > 0) {
                bf16x8 kb0[4], kb1[4], kb2[4], kb3[4];
                IDX_LOAD(kb0, 0); IDX_LOAD(kb1, 1); IDX_LOAD(kb2, 2);
                for (int i = 0; i < ntw; i += 4) {
                    IDX_LOAD(kb3, i + 3); IDX_COMP(kb0, i);
                    IDX_LOAD(kb0, i + 4); IDX_COMP(kb1, i + 1);
                    IDX_LOAD(kb1, i + 5); IDX_COMP(kb2, i + 2);
                    IDX_LOAD(kb2, i + 6); IDX_COMP(kb3, i + 3);
                }
            }
#undef IDX_LOAD
#undef IDX_COMP
#pragma unroll
            for (int o = 1; o < 32; o <<= 1) { mn0 = fminf(mn0, __shfl_xor(mn0, o)); mx0 = fmaxf(mx0, __shfl_xor(mx0, o)); mn1 = fminf(mn1, __shfl_xor(mn1, o)); mx1 = fmaxf(mx1, __shfl_xor(mx1, o)); }
            if (key == 0) { LAS float* mm = MMw + (wave * 4 + 2 * half) * 2; mm[0] = mn0; mm[1] = mx0; mm[2] = mn1; mm[3] = mx1; }
        }
        __syncthreads();
        {
            const int q = wave >> 1, hw = wave & 1, t = t0 + q, n = t + 1; const LAS float* sc = SC + q * 8192;
            LAS unsigned* hist = (LAS unsigned*)(F.lds + IDX_HIST) + wave * 512; const LAS unsigned* hist0 = (const LAS unsigned*)(F.lds + IDX_HIST) + (2 * q) * 512;
            LAS unsigned short* cand = (LAS unsigned short*)(F.lds + IDX_CAND) + q * IDX_CAP;
            LAS float* stf = (LAS float*)(F.lds + IDX_STQ) + q * 16; LAS int* sti = (LAS int*)stf;
            LAS float* mm2 = (LAS float*)(F.lds + IDX_MM2) + wave * 2;
            unsigned short* so = SEL + (size_t)(row0 + q) * 256;
            const int nch = (n + 255) >> 8;
            if (hw == 0 && lane == 0) { float lo = INFINITY, hi = -INFINITY;
#pragma unroll
                for (int w = 0; w < 8; ++w) { lo = fminf(lo, MMw[(w * 4 + q) * 2]); hi = fmaxf(hi, MMw[(w * 4 + q) * 2 + 1]); }
                stf[0] = lo; stf[1] = hi; sti[2] = 256; sti[3] = 0; sti[4] = 0; sti[5] = 0; sti[6] = 0; sti[7] = 0; sti[8] = 0; sti[9] = 0; }
            __syncthreads();
            for (int round = 0; round < 64; ++round) {
                const float lo = stf[0], hi = stf[1]; const bool act = sti[8] == 0; const bool eqr = !(hi > lo); const float scale = eqr ? 0.f : 1024.f / (hi - lo);
                if (act && !eqr) {
#pragma unroll
                    for (int i = 0; i < 8; ++i) hist[lane + 64 * i] = 0u;
                    for (int c = hw; c < nch; c += 2) { const int i4 = 256 * c + 4 * lane; const f32x4 v4 = *(const LAS f32x4*)(sc + i4);
#pragma unroll
                        for (int e = 0; e < 4; ++e) { const float v = (i4 + e < n) ? v4[e] : -INFINITY;
                            if (v >= lo && v <= hi) { int bb = (int)((v - lo) * scale); bb = bb > 1023 ? 1023 : bb; atomicAdd((unsigned*)&hist[bb >> 1], 1u << (16 * (bb & 1))); } } }
                }
                __syncthreads();
                if (hw == 0 && act) {
                    if (eqr) { if (lane == 0) { sti[8] = 1; sti[9] = 1; } }
                    else {
                        const int krem = sti[2];
                        unsigned cw[8], c0w[8]; unsigned S = 0u, S0 = 0u;
#pragma unroll
                        for (int i = 0; i < 8; ++i) { c0w[i] = hist0[8 * lane + i]; cw[i] = c0w[i] + hist0[512 + 8 * lane + i]; S += (cw[i] & 0xffffu) + (cw[i] >> 16); S0 += (c0w[i] & 0xffffu) + (c0w[i] >> 16); }
                        unsigned x = S, x0 = S0;
#pragma unroll
                        for (int o = 1; o < 64; o <<= 1) { const unsigned y = __shfl_down(x, o), y0 = __shfl_down(x0, o); if (lane + o < 64) { x += y; x0 += y0; } }
                        const unsigned above = x - S; unsigned acc0 = x0 - S0;
                        const bool found = (above < (unsigned)krem) && ((unsigned)krem <= above + S);
                        const int fl = __builtin_ctzll(__ballot(found));
                        int bs = 0; unsigned acc = above, cb = 0u, cb0 = 0u;
                        { bool done = false;
#pragma unroll
                          for (int i = 15; i >= 0; --i) { const unsigned cnt_ = (i & 1) ? (cw[i >> 1] >> 16) : (cw[i >> 1] & 0xffffu), cnt0_ = (i & 1) ? (c0w[i >> 1] >> 16) : (c0w[i >> 1] & 0xffffu);
                              if (!done) { if (acc + cnt_ >= (unsigned)krem) { bs = 16 * lane + i; cb = cnt_; cb0 = cnt0_; done = true; } else { acc += cnt_; acc0 += cnt0_; } } } }
                        if (lane == fl) { sti[2] = krem - (int)acc; sti[3] += (int)acc0; sti[4] += (int)acc; sti[5] = bs; sti[6] = (int)cb0; sti[7] = (int)cb; sti[8] = ((int)cb <= IDX_CAP) ? 1 : 0; }
                    }
                }
                __syncthreads();
                const LAS int* stall = (const LAS int*)(F.lds + IDX_STQ);
                if (stall[8] && stall[16 + 8] && stall[32 + 8] && stall[48 + 8]) break;
                float nlo = INFINITY, nhi = -INFINITY;
                if (sti[8] == 0) { const int bstar = sti[5];
                    for (int c = hw; c < nch; c += 2) { const int i4 = 256 * c + 4 * lane; const f32x4 v4 = *(const LAS f32x4*)(sc + i4);
#pragma unroll
                        for (int e = 0; e < 4; ++e) { const float v = (i4 + e < n) ? v4[e] : -INFINITY;
                            if (v >= lo && v <= hi) { int bb = (int)((v - lo) * scale); bb = bb > 1023 ? 1023 : bb; if (bb == bstar) { nlo = fminf(nlo, v); nhi = fmaxf(nhi, v); } } } } }
                nlo = wmin64(nlo); nhi = wmax64(nhi);
                if (lane == 0) { mm2[0] = nlo; mm2[1] = nhi; }
                __syncthreads();
                if (hw == 0 && lane == 0 && sti[8] == 0) { stf[0] = fminf(mm2[0], mm2[2]); stf[1] = fmaxf(mm2[1], mm2[3]); }
                __syncthreads();
            }
            { const float lo = stf[0], hi = stf[1]; const bool eq = sti[9] != 0; const float scale = eq ? 0.f : 1024.f / (hi - lo);
              const int krem = sti[2], A0 = sti[3], AT = sti[4], bstar = sti[5], C0 = sti[6], ncand = sti[7], nabove = 256 - krem;
              int bsel = hw ? A0 : 0, bcand = hw ? C0 : 0; (void)AT;
              const int cstep = eq ? 1 : 2;
              if (!(eq && hw)) for (int c = eq ? 0 : hw; c < nch; c += cstep) { const int i4 = 256 * c + 4 * lane; const f32x4 v4 = *(const LAS f32x4*)(sc + i4);
#pragma unroll
                  for (int e = 0; e < 4; ++e) { const int idx = i4 + e; const float v = (idx < n) ? v4[e] : -INFINITY;
                      bool sel, cnd;
                      if (eq) { sel = v > hi; cnd = (v == hi); }
                      else { const bool in = (v >= lo && v <= hi); int bb = (int)((v - lo) * scale); bb = bb > 1023 ? 1023 : bb; sel = (v > hi) || (in && bb > bstar); cnd = in && bb == bstar; }
                      const unsigned long long ms = __ballot(sel), mc = __ballot(cnd), lt = (1ull << lane) - 1ull;
                      if (sel) so[bsel + __builtin_popcountll(ms & lt)] = (unsigned short)idx;
                      if (cnd) { const int pc = bcand + __builtin_popcountll(mc & lt);
                          if (eq) { if (pc < krem) so[nabove + pc] = (unsigned short)idx; } else if (pc < IDX_CAP) cand[pc] = (unsigned short)idx; }
                      bsel += __builtin_popcountll(ms); bcand += __builtin_popcountll(mc); } }
              __syncthreads();
              if (!eq) {
                  for (int i = 64 * hw + lane; i < ncand; i += 128) { const int ii = cand[i]; const float vi = sc[ii]; int rank = 0;
                      for (int jj = 0; jj < ncand; ++jj) { const int ij = cand[jj]; const float vj = sc[ij]; rank += ((vj > vi) || (vj == vi && ij < ii)) ? 1 : 0; }
                      if (rank < krem) so[nabove + rank] = (unsigned short)ii; }
              }
              if (hw == 0 && lane == 0) CNT[row0 + q] = 256; }
        }
        __syncthreads();
    }
}

__device__ __forceinline__ unsigned offb(unsigned row, unsigned ch) { return 256u * row + 16u * (ch ^ (((row & 3u) << 2) | ((row >> 2) & 3u))); }
typedef short v4i16_t __attribute__((ext_vector_type(4)));
__device__ __forceinline__ v4i16_t trrd(const LAS unsigned char* p) { return __builtin_amdgcn_ds_read_tr16_b64_v4i16((LAS v4i16_t*)p); }
__device__ __forceinline__ void p13_dsa_mfma(Frame& F, const In& I, unsigned char* ws) {
    OPAQUE_TID(); KARGS(); const int lane = tid_ & 63, wave = __builtin_amdgcn_readfirstlane(tid_ >> 6), n = lane & 15, kq = lane >> 4;
    LAS unsigned char* bkt = F.lds + TAB_BKT; LAS float* b12 = (LAS float*)(F.lds + TAB_B12);
    for (int i = tid_; i < 1536; i += NWAVES * 64) bkt[i] = (unsigned char)rel_bucket(i);
    for (int i = tid_; i < 512; i += NWAVES * 64) b12[i] = ((i & 15) < 12) ? Ip->rel_bias[(i >> 4) * 12 + (i & 15)] * LOG2E : 0.f;
    __syncthreads();
    LAS unsigned char* imgb = F.lds + RING_OFF + wave * 17408; LAS int* sidx = (LAS int*)(imgb + 16384);
    const bf16* QA = (const bf16*)(ws + WS_QA); const bf16* CKV = (const bf16*)(ws + WS_CKV); const bf16* PR = (const bf16*)(ws + WS_PROJ1);
    const unsigned short* SEL = (const unsigned short*)(ws + WS_SEL); const int* CNT = (const int*)(ws + WS_CNT);
    const bf16* MKB = (const bf16*)(ws + WS_MKB) + (size_t)512 * 256; const bf16* MVT = (const bf16*)(ws + WS_MVT) + (size_t)256 * 512;
    bf16* CAT1 = (bf16*)(ws + WS_CAT1);
    const int gw = blockIdx.x * NWAVES + wave, NGW = F.G * NWAVES;
    const LAS float* b12c = b12 + (n < 12 ? n : 0);
    for (int row = gw; row < M; row += NGW) {
        const int b = row / T, t = row % T, rowb = b * T, cnt = __builtin_amdgcn_readfirstlane(CNT[row]);
        asm volatile("s_waitcnt lgkmcnt(0)" ::: "memory");
#pragma unroll
        for (int i = 0; i < 4; ++i) sidx[lane + 64 * i] = (int)SEL[(size_t)row * 256 + lane + 64 * i];
        bf16x8 qf[4];
#pragma unroll
        for (int ks = 0; ks < 4; ++ks) { bf16x8 v = ldg16(QA + (size_t)row * 1536 + (n < 12 ? n : 0) * 128 + 32 * ks + 8 * kq); if (n >= 12) v = (bf16x8){0, 0, 0, 0, 0, 0, 0, 0}; qf[ks] = v; }
        float m = -1e30f, l = 0.f; f32x4 O[8];
#pragma unroll
        for (int rt = 0; rt < 8; ++rt) O[rt] = (f32x4){0.f, 0.f, 0.f, 0.f};
#define DSA_GATHER(c0_, buf_) do { int ln2_ = lane; asm volatile("" : "+v"(ln2_)); \
            _Pragma("unroll") for (int i = 0; i < 8; ++i) { const int rr = 4 * i + (ln2_ >> 4), pos = ln2_ & 15, e = (c0_) + rr; const int kidx = sidx[e < cnt ? e : 0]; \
                const unsigned chs = (unsigned)pos ^ ((((unsigned)rr & 3u) << 2) | (((unsigned)rr >> 2) & 3u)); \
                __builtin_amdgcn_global_load_lds((const unsigned*)(CKV + (size_t)(rowb + kidx) * 128 + 8 * chs), (LAS unsigned*)(imgb + (buf_) * 8192 + i * 1024), 16, 0, 0); } } while (0)
        asm volatile("s_waitcnt lgkmcnt(0)" ::: "memory");
        DSA_GATHER(0, 0);
        for (int c0 = 0; c0 < cnt; c0 += 32) {
            const int cb = (c0 >> 5) & 1; LAS unsigned char* img = imgb + cb * 8192;
            if (c0 + 32 < cnt) { DSA_GATHER(c0 + 32, cb ^ 1); asm volatile("s_waitcnt vmcnt(8)" ::: "memory"); } else asm volatile("s_waitcnt vmcnt(0)" ::: "memory");
            int ln_ = lane; asm volatile("" : "+v"(ln_));
            f32x4 sa = {0.f, 0.f, 0.f, 0.f}, sb = {0.f, 0.f, 0.f, 0.f};
            { const unsigned ra = 8u * ((unsigned)(ln_ & 15) >> 2) + ((unsigned)ln_ & 3u), kq_ = (unsigned)ln_ >> 4;
#pragma unroll
              for (int s = 0; s < 4; ++s) { const bf16x8 ka = *(const LAS bf16x8*)(img + offb(ra, 4 * s + kq_)); const bf16x8 kb = *(const LAS bf16x8*)(img + offb(ra + 4, 4 * s + kq_));
                  sa = MFMA16(ka, qf[s], sa); sb = MFMA16(kb, qf[s], sb); } }
#pragma unroll
            for (int i = 0; i < 4; ++i) { const int ea = c0 + 8 * kq + i, eb = ea + 4;
                { const int d = t - sidx[ea < cnt ? ea : 0]; const int dc = d > 1535 ? 1535 : (d < 0 ? 0 : d); sa[i] = (ea < cnt) ? sa[i] + b12c[(int)bkt[dc] * 16] : -INFINITY; }
                { const int d = t - sidx[eb < cnt ? eb : 0]; const int dc = d > 1535 ? 1535 : (d < 0 ? 0 : d); sb[i] = (eb < cnt) ? sb[i] + b12c[(int)bkt[dc] * 16] : -INFINITY; } }
            const float mnw = fmaxf(m, colmax(sa, sb)); const float al = __builtin_amdgcn_exp2f(m - mnw); m = mnw;
            f32x4 pa, pb; float sum = 0.f;
#pragma unroll
            for (int i = 0; i < 4; ++i) { pa[i] = __builtin_amdgcn_exp2f(sa[i] - mnw); pb[i] = __builtin_amdgcn_exp2f(sb[i] - mnw); sum += pa[i] + pb[i]; }
            l = l * al + sum;
            const bf16x8 pf = pack8(pa, pb);
            { const unsigned g_ = (unsigned)ln_ >> 4, q_ = ((unsigned)ln_ & 15u) >> 2, p_ = (unsigned)ln_ & 3u;
#pragma unroll
              for (int rt = 0; rt < 8; ++rt) { const v4i16_t x0 = trrd(img + offb(8 * g_ + q_, 2 * rt + (p_ >> 1)) + 8 * (p_ & 1)), x1 = trrd(img + offb(8 * g_ + 4 + q_, 2 * rt + (p_ >> 1)) + 8 * (p_ & 1));
                  const bf16x8 vf = {x0[0], x0[1], x0[2], x0[3], x1[0], x1[1], x1[2], x1[3]};
                  O[rt] = MFMA16(vf, pf, O[rt] * al); } }
        }
#undef DSA_GATHER
        const float il = 1.f / kqsum(l);
        if (n < 12) { bf16* op = CAT1 + (size_t)row * 1792 + n * 128 + 4 * kq;
#pragma unroll
            for (int rt = 0; rt < 8; ++rt) *(uint2*)(op + 16 * rt) = make_uint2(pk2(O[rt][0] * il, O[rt][1] * il), pk2(O[rt][2] * il, O[rt][3] * il)); }
    }
    for (int u8 = gw; u8 < M / 8; u8 += NGW) {
        const int row0 = 8 * u8, b = row0 / T; const int r = n;
#pragma unroll 1
        for (int hm = 0; hm < 4; ++hm) {
            bf16x8 qm[2]; { const bf16* qp = PR + (size_t)(row0 + (n & 7)) * 768 + 456 + hm * 64 + 8 * kq; qm[0] = ldg16(qp); qm[1] = ldg16(qp + 32); if (n >= 8) { qm[0] = (bf16x8){0, 0, 0, 0, 0, 0, 0, 0}; qm[1] = qm[0]; } }
            float mm = -1e30f, ll = 0.f; f32x4 Om[4];
#pragma unroll
            for (int dt = 0; dt < 4; ++dt) Om[dt] = (f32x4){0.f, 0.f, 0.f, 0.f};
            const bf16* mk = MKB + (size_t)(b * 256) * 256 + hm * 64; const bf16* mvt = MVT + (size_t)(hm * 64) * 512 + b * 256;
            for (int key0 = 0; key0 < 256; key0 += 32) { int r_ = r, kq_ = kq; asm volatile("" : "+v"(r_), "+v"(kq_)); KF k; load_k(k, mk, 256, key0, r_, kq_); VF v; load_vt(v, mvt, 512, key0, r_, kq_);
                f32x4 sa, sb; qk(sa, sb, k, qm); sa = sa * (0.125f * LOG2E); sb = sb * (0.125f * LOG2E); pv(Om, v, sm_update(sa, sb, mm, ll, Om)); }
            const float il = 1.f / kqsum(ll);
            if (n < 8) { bf16* op = CAT1 + (size_t)(row0 + n) * 1792 + 1536 + hm * 64 + 4 * kq;
#pragma unroll
                for (int dt = 0; dt < 4; ++dt) *(uint2*)(op + 16 * dt) = make_uint2(pk2(Om[dt][0] * il, Om[dt][1] * il), pk2(Om[dt][2] * il, Om[dt][3] * il)); }
        }
    }
}

struct Args { In in; float* out; unsigned char* ws; int ph_lo, ph_hi; };
__global__ void __launch_bounds__(NWAVES * 64, 2) mk_fwd(Args args) {
    extern __shared__ __attribute__((aligned(16))) unsigned char lds[];
    Frame F;
    F.lds = (LAS unsigned char*)lds; F.MISC = (volatile LAS unsigned*)(F.lds + MISC_OFF);
    F.G = gridDim.x; { const int bx = blockIdx.x; F.vcu = (F.G % 8 == 0) ? (bx % 8) * (F.G / 8) + bx / 8 : bx; }
    unsigned char* ws = args.ws; const In& I = args.in; float* out = args.out; (void)I;
    F.ctl = (gu32*)(ws + WS_CTL);
    for (int u = threadIdx.x; u < (LDS_BYTES - LDSCTL_OFF) / 4; u += NWAVES * 64) ((LAS unsigned*)(F.lds + LDSCTL_OFF))[u] = 0u;
    __syncthreads();
    XcdBarrier bar; bar.bar = (unsigned*)(F.ctl + CW_BAR); bar.x = 0; bar.st = nullptr;
    if (!MK_SPLIT) bar = xcd_barrier_post((unsigned*)(F.ctl + CW_BAR), F.MISC + 8);
    const int lo = args.ph_lo, hi = args.ph_hi;
#ifndef PH_MASK
#define PH_MASK 0xFFFFFFFFu
#endif
#define IN(k) ((((PH_MASK) >> ((k) % 32)) & 1u) && lo <= (k) && (k) < hi)
#define SEAM(k) do { if (IN(k) && IN((k) + 1)) xcd_barrier(bar); } while (0)
#ifndef REP_MASK
#define REP_MASK 0u
#endif
#define REPS(k) (1 + (int)(((REP_MASK) >> (k)) & 1u))
    bf16* XN = (bf16*)(ws + WS_XN); bf16* CAT = (bf16*)(ws + WS_CAT); bf16* ACT = (bf16*)(ws + WS_ACT);

    if (IN(0)) { for (int r_ = 0; r_ < REPS(0); ++r_) { p0_prologue(F, I, ws); if (r_ + 1 < REPS(0)) xcd_barrier(bar); } SEAM(0); }
    {
            if (IN(1)) {
                pg8::Gemm g{XN, (const bf16*)(ws + WS_WIN0), M, 1792, D}; pg8::StaticOrder S; S.init(M, 1792, F.G, (int)blockIdx.x);
                pg8::EpiRoute<0> E{ws};
                pg8::gemm_phase<pg8::EpiRoute<0>, pg8::StaticOrder, true, true>(F.lds + RING_OFF, g, S, E);
                pg8::Gemm g2{(const bf16*)(ws + WS_WVT), XN, 256, M, D}; pg8::StaticOrder S2; S2.init(256, M, F.G, (int)((blockIdx.x + 64) % F.G));
                pg8::EpiRoute<3> E2{ws};
                pg8::gemm_phase<pg8::EpiRoute<3>, pg8::StaticOrder, true, true>(F.lds + RING_OFF, g2, S2, E2);
                SEAM(1);
            }
            if (IN(2)) { for (int r_ = 0; r_ < REPS(2); ++r_) { p2_mfma(F, I, ws); if (r_ + 1 < REPS(2)) xcd_barrier(bar); } SEAM(2); }
            if (IN(3)) { for (int r_ = 0; r_ < REPS(3); ++r_) { p3_nsa_mfma(F, I, ws); if (r_ + 1 < REPS(3)) xcd_barrier(bar); } SEAM(3); }
    }
    {
        constexpr int L = 0, pb = L ? 14 : 4;
        if (IN(pb)) {
            pg8::Gemm g{L ? (const bf16*)(ws + WS_CAT1) : CAT, L ? (const bf16*)(ws + WS_WO1F) : (const bf16*)(ws + WS_WO), M, D, L ? 1792 : D}; pg8::StaticOrder S; S.init(M, D, F.G, (int)blockIdx.x);
            KARGS(); pg8::EpiResid E{L ? (const float*)out : Ip->x, out, D, 0};
            pg8::gemm_phase<pg8::EpiResid, pg8::StaticOrder, true, true>(F.lds + RING_OFF, g, S, E);
            SEAM(pb);
        }
        if (IN(pb + 1)) { KARGS(); norm_phase(F, out, Ip->norm_ffn + L * D, XN); SEAM(pb + 1); }
        if (IN(pb + 2)) {
            pg8::Gemm g{XN, (const bf16*)(ws + WS_WGU) + (size_t)L * 2 * DFF * D, M, 2 * DFF, D}; pg8::StaticOrder S; S.init(M, 2 * DFF, F.G, (int)blockIdx.x);
            pg8::EpiSwiglu E{ACT, DFF, 0};
            pg8::gemm_phase<pg8::EpiSwiglu, pg8::StaticOrder, true, true>(F.lds + RING_OFF, g, S, E);
            SEAM(pb + 2);
        }
        if (IN(pb + 3)) {
            pg8::Gemm g{ACT, (const bf16*)(ws + WS_WD) + (size_t)L * D * DFF, M, D, DFF}; pg8::StaticOrder S; S.init(M, D, F.G, (int)blockIdx.x);
            pg8::EpiResid E{out, out, D, 0};
            pg8::gemm_phase<pg8::EpiResid, pg8::StaticOrder, true, true>(F.lds + RING_OFF, g, S, E);
            SEAM(pb + 3);
        }
        if (L == 0 && IN(8)) { KARGS(); norm_phase(F, out, Ip->norm_mix + D, XN); SEAM(8); }
        }
    {
            if (IN(9)) {
                pg8::Gemm g{XN, (const bf16*)(ws + WS_WIN1), M, 768, D}; pg8::StaticOrder S; S.init(M, 768, F.G, (int)blockIdx.x);
                pg8::EpiRoute<1> E{ws};
                pg8::gemm_phase<pg8::EpiRoute<1>, pg8::StaticOrder, true, true>(F.lds + RING_OFF, g, S, E);
                SEAM(9);
            }
            if (IN(10)) { p10_dsa_norm(F, I, ws); SEAM(10); }
            if (IN(11)) {
                pg8::Gemm g{(const bf16*)(ws + WS_CQ), (const bf16*)(ws + WS_WQ2), M, 2048, 256}; pg8::StaticOrder S; S.init(M, 2048, F.G, (int)blockIdx.x);
                pg8::EpiRoute<2> E{ws};
                pg8::gemm_phase<pg8::EpiRoute<2>, pg8::StaticOrder, true, true>(F.lds + RING_OFF, g, S, E);
                SEAM(11);
            }
            if (IN(12)) { for (int r_ = 0; r_ < REPS(12); ++r_) { p12_index_mfma(F, I, ws); if (r_ + 1 < REPS(12)) xcd_barrier(bar); } SEAM(12); }
            if (IN(13)) { for (int r_ = 0; r_ < REPS(13); ++r_) { p13_dsa_mfma(F, I, ws); if (r_ + 1 < REPS(13)) xcd_barrier(bar); } SEAM(13); }
            }
    {
        constexpr int L = 1, pb = L ? 14 : 4;
        if (IN(pb)) {
            pg8::Gemm g{L ? (const bf16*)(ws + WS_CAT1) : CAT, L ? (const bf16*)(ws + WS_WO1F) : (const bf16*)(ws + WS_WO), M, D, L ? 1792 : D}; pg8::StaticOrder S; S.init(M, D, F.G, (int)blockIdx.x);
            KARGS(); pg8::EpiResid E{L ? (const float*)out : Ip->x, out, D, 0};
            pg8::gemm_phase<pg8::EpiResid, pg8::StaticOrder, true, true>(F.lds + RING_OFF, g, S, E);
            SEAM(pb);
        }
        if (IN(pb + 1)) { KARGS(); norm_phase(F, out, Ip->norm_ffn + L * D, XN); SEAM(pb + 1); }
        if (IN(pb + 2)) {
            pg8::Gemm g{XN, (const bf16*)(ws + WS_WGU) + (size_t)L * 2 * DFF * D, M, 2 * DFF, D}; pg8::StaticOrder S; S.init(M, 2 * DFF, F.G, (int)blockIdx.x);
            pg8::EpiSwiglu E{ACT, DFF, 0};
            pg8::gemm_phase<pg8::EpiSwiglu, pg8::StaticOrder, true, true>(F.lds + RING_OFF, g, S, E);
            SEAM(pb + 2);
        }
        if (IN(pb + 3)) {
            pg8::Gemm g{ACT, (const bf16*)(ws + WS_WD) + (size_t)L * D * DFF, M, D, DFF}; pg8::StaticOrder S; S.init(M, D, F.G, (int)blockIdx.x);
            pg8::EpiResid E{out, out, D, 0};
            pg8::gemm_phase<pg8::EpiResid, pg8::StaticOrder, true, true>(F.lds + RING_OFF, g, S, E);
            SEAM(pb + 3);
        }
        if (L == 0 && IN(8)) { KARGS(); norm_phase(F, out, Ip->norm_mix + D, XN); SEAM(8); }
        }
    if (IN(18)) {
        OPAQUE_TID(); KARGS(); const int lane_ = tid_ & 63;
        const int gw = F.vcu * NWAVES + (tid_ >> 6), NGW = F.G * NWAVES;
        for (int m = gw; m < M; m += NGW) { GAS f32x4* xr = (GAS f32x4*)(out + (size_t)m * D) + lane_; const GAS f32x4* gr = (const GAS f32x4*)Ip->norm_final + lane_;
            f32x4 v[4]; float s = 0.f;
#pragma unroll
            for (int j = 0; j < 4; ++j) { v[j] = xr[64 * j]; s += (v[j].x * v[j].x + v[j].y * v[j].y) + (v[j].z * v[j].z + v[j].w * v[j].w); }
            const float r = rsqrtf(wave_sum(s) * (1.f / D) + EPSF);
#pragma unroll
            for (int j = 0; j < 4; ++j) { const f32x4 g = gr[64 * j]; xr[64 * j] = (v[j] * r) * g; } }
    }
#undef IN
#undef SEAM
}

extern "C" void kernel_launch(void* const* d_in, const int* in_sizes, int n_in, void* d_out, int out_size, void* d_ws, size_t ws_size, hipStream_t stream) {
    static int grid = 0;
    if (grid == 0) {
        if (n_in != 32 || out_size != M * D || ws_size < WS_END) { fprintf(stderr, "kernel_launch: unexpected shapes (n_in %d out %d ws %zu)\n", n_in, out_size, ws_size); grid = -1; return; }
        int dev = 0, cus = 0, per_cu = 0;
        if (hipGetDevice(&dev) != hipSuccess || hipDeviceGetAttribute(&cus, hipDeviceAttributeMultiprocessorCount, dev) != hipSuccess) { grid = -1; return; }
        if (hipFuncSetAttribute((const void*)mk_fwd, hipFuncAttributeMaxDynamicSharedMemorySize, LDS_BYTES) != hipSuccess) { grid = -1; return; }
        if (hipOccupancyMaxActiveBlocksPerMultiprocessor(&per_cu, (const void*)mk_fwd, NWAVES * 64, LDS_BYTES) != hipSuccess || per_cu < 1) fprintf(stderr, "kernel_launch: occupancy query reports %d\n", per_cu);
        (void)hipGetLastError();
        grid = cus;
        if (grid > 256) grid = 256;
    }
    if (grid < 0) return;
    if (hipMemsetAsync((char*)d_ws + WS_CTL, 0, CTL_ZERO_BYTES, stream) != hipSuccess) return;
    Args a{};
    const float** ip = (const float**)&a.in;
    for (int i = 0; i < 32; ++i) ip[i] = (const float*)d_in[i];
    a.out = (float*)d_out; a.ws = (unsigned char*)d_ws;
#if MK_SPLIT
    for (int k = 0; k < N_PHASES; ++k) { a.ph_lo = k; a.ph_hi = k + 1; hipLaunchKernelGGL(mk_fwd, dim3(grid), dim3(NWAVES * 64), LDS_BYTES, stream, a); }
#else
    a.ph_lo = 0; a.ph_hi = N_PHASES; hipLaunchKernelGGL(mk_fwd, dim3(grid), dim3(NWAVES * 64), LDS_BYTES, stream, a);
#endif
}
```

```cpp
#include <hip/hip_runtime.h>
#include <cstdio>
#include <cstdint>
#include <math.h>

namespace pg8 {
#define PG8_LAS __attribute__((address_space(3)))
typedef unsigned short bf16_t;
typedef short bf16x8 __attribute__((ext_vector_type(8)));
typedef float f32x4 __attribute__((ext_vector_type(4)));
typedef unsigned u32x4 __attribute__((ext_vector_type(4)));
constexpr int BM = 256, BK = 64, HALF = 128, HTB = HALF * BK * 2  , STAGE_BYTES = 8 * HTB, NXCD = 8, WGM = 8;

__host__ __device__ __forceinline__ int lds_byte(int r, int c) { const int st = (r >> 4) * 2 + (c >> 5), rr = r & 15, cc = c & 31, ob = rr * 64 + cc * 2; return st * 1024 + (ob ^ (((ob >> 9) & 1) << 5)); }
__host__ __device__ __forceinline__ void stage_rc(int b, int& R, int& C) { const int st = b / 1024, sb = b % 1024, swz = sb ^ (((sb >> 9) & 1) << 5); R = (st >> 1) * 16 + swz / 64; C = (st & 1) * 32 + (swz % 64) / 2; }
__host__ __device__ __forceinline__ int perm32(int rho) { const int n = rho >> 4, i = rho & 15; return 8 * (i >> 2) + 4 * n + (i & 3); }

struct Unit { int pm, pn; };
struct Gemm { const bf16_t* A; const bf16_t* Bt; int M, N, K; };

struct StaticOrder {
    int nM, nN, nwg, G, c;
    __host__ __device__ void init(int M, int N, int G_, int c_) { nM = M / BM; nN = N / BM; nwg = nM * nN; G = G_; c = c_; }
    __host__ __device__ bool next(int i, Unit& u) const {
        const long L = (long)i * G + c; if (L >= nwg) return false;
        int wgid = (int)L; { const int q = nwg / NXCD, r = nwg % NXCD, xcd = wgid % NXCD, off = wgid / NXCD; wgid = (xcd < r ? xcd * (q + 1) : r * (q + 1) + (xcd - r) * q) + off; }
        const int nig = WGM * nN, gid = wgid / nig, fm = gid * WGM, gsz = (nM - fm) < WGM ? (nM - fm) : WGM;
        u.pm = fm + ((wgid % nig) % gsz); u.pn = (wgid % nig) / gsz; return true;
    }
    __device__ __forceinline__ void a_ready(const Unit&) const {}
    __device__ __forceinline__ void done(const Unit&) const {}
};

__device__ __forceinline__ unsigned cvt_pk_bf16(float lo, float hi) { unsigned r; asm volatile("v_cvt_pk_bf16_f32 %0, %1, %2" : "=v"(r) : "v"(lo), "v"(hi)); return r; }
template <int ROUTE> struct EpiRoute {
    static constexpr bool PERM = true, AFTER_DRAIN = false;
    unsigned char* ws; const float* ssq;
    __device__ __forceinline__ void operator()(const f32x4 (&acc)[2][2][4][2], const Unit& u, int wr, int wc, int fr, int fq) const {
        asm volatile("" : "+v"(fr), "+v"(fq));
        const int pn = u.pn; size_t off; int ld, t0; float sc;
        if constexpr (ROUTE == 0) {
            off = pn < 3 ? (size_t)(88u << 20) : pn < 5 ? (size_t)(112u << 20) : pn < 6 ? (size_t)(128u << 20) : (size_t)(136u << 20);
            ld = pn < 3 ? 768 : pn < 5 ? 512 : 256; t0 = pn < 3 ? 0 : pn < 5 ? 3 : pn < 6 ? 5 : 6; sc = (pn < 3 || pn == 5) ? 0.18033688011112042f : 1.f;
        } else if constexpr (ROUTE == 1) { off = (size_t)(88u << 20); ld = 768; t0 = 0; sc = 1.f; }
        else if constexpr (ROUTE == 3) { off = (size_t)(144u << 20); ld = 16384; t0 = 0; sc = 1.f; }
        else { off = pn < 6 ? (size_t)(128u << 20) : (size_t)(176u << 20); ld = pn < 6 ? 1536 : 512; t0 = pn < 6 ? 0 : 6; sc = 1.f; }
        bf16_t* base = (bf16_t*)(ws + off);
        const int row0 = u.pm * BM + wr * 64 + fr, col0 = (pn - t0) * BM + wc * 32 + 8 * fq;
#pragma unroll
        for (int ai = 0; ai < 2; ++ai)
#pragma unroll
            for (int m = 0; m < 4; ++m) { bf16_t* rowp = base + (size_t)(row0 + ai * HALF + m * 16) * ld + col0;
                float scr_ = sc; if constexpr (ROUTE == 1) scr_ = rsqrtf(ssq[row0 + ai * HALF + m * 16] * (1.f / 1024.f) + 1e-6f);
#pragma unroll
                for (int bj = 0; bj < 2; ++bj) { const f32x4 v0 = acc[ai][bj][m][0] * scr_, v1 = acc[ai][bj][m][1] * scr_;
                    u32x4 w; w.x = cvt_pk_bf16(v0[0], v0[1]); w.y = cvt_pk_bf16(v0[2], v0[3]); w.z = cvt_pk_bf16(v1[0], v1[1]); w.w = cvt_pk_bf16(v1[2], v1[3]);
                    if constexpr (ROUTE == 3) {
                        const int tok = col0 + bj * HALF, rw = row0 + ai * HALF + m * 16; *(u32x4*)(base + ((size_t)(tok >> 6) * 256 + rw) * 64 + (tok & 63)) = w; }
                    else *(u32x4*)(rowp + bj * HALF) = w; } }
    }
};
struct EpiResid {
    static constexpr bool PERM = true, AFTER_DRAIN = false;
    const float* res; float* out; bf16_t* hb; float* ssq; int ldc; int pad;
    __device__ __forceinline__ void operator()(const f32x4 (&acc)[2][2][4][2], const Unit& u, int wr, int wc, int fr, int fq) const {
        asm volatile("" : "+v"(fr), "+v"(fq));
        const int row0 = u.pm * BM + wr * 64 + fr, col0 = u.pn * BM + wc * 32 + 8 * fq;
#pragma unroll
        for (int ai = 0; ai < 2; ++ai)
#pragma unroll
            for (int m = 0; m < 4; ++m) { const int row = row0 + ai * HALF + m * 16; const size_t off = (size_t)row * ldc + col0; float sq = 0.f;
#pragma unroll
                for (int bj = 0; bj < 2; ++bj) { f32x4 v[2];
#pragma unroll
                    for (int n = 0; n < 2; ++n) { const f32x4 r = *(const f32x4*)(res + off + bj * HALF + 4 * n); v[n] = r + acc[ai][bj][m][n]; *(f32x4*)(out + off + bj * HALF + 4 * n) = v[n];
                        sq += (v[n][0] * v[n][0] + v[n][1] * v[n][1]) + (v[n][2] * v[n][2] + v[n][3] * v[n][3]); }
                    if (hb) { u32x4 w; w.x = cvt_pk_bf16(v[0][0], v[0][1]); w.y = cvt_pk_bf16(v[0][2], v[0][3]); w.z = cvt_pk_bf16(v[1][0], v[1][1]); w.w = cvt_pk_bf16(v[1][2], v[1][3]); *(u32x4*)(hb + off + bj * HALF) = w; } }
                if (ssq) { sq += __shfl_xor(sq, 16); sq += __shfl_xor(sq, 32); if (fq == 0) (void)__hip_atomic_fetch_add((__attribute__((address_space(1))) float*)(ssq + row), sq, __ATOMIC_RELAXED, __HIP_MEMORY_SCOPE_AGENT); } }
    }
};
struct EpiSwiglu {
    static constexpr bool PERM = true, AFTER_DRAIN = false;
    bf16_t* O; const float* ssq; int ldc; int pad;
    __device__ __forceinline__ void operator()(const f32x4 (&acc)[2][2][4][2], const Unit& u, int wr, int wc, int fr, int fq) const {
        asm volatile("" : "+v"(fr), "+v"(fq));
        const int row0 = u.pm * BM + wr * 64 + fr, col0 = u.pn * HALF + wc * 32 + 8 * fq;
#pragma unroll
        for (int ai = 0; ai < 2; ++ai)
#pragma unroll
            for (int m = 0; m < 4; ++m) { float o[8]; const float rs = rsqrtf(ssq[row0 + ai * HALF + m * 16] * (1.f / 1024.f) + 1e-6f);
#pragma unroll
                for (int n = 0; n < 2; ++n)
#pragma unroll
                    for (int e = 0; e < 4; ++e) { const float g = acc[ai][0][m][n][e] * rs, up = acc[ai][1][m][n][e] * rs; o[4 * n + e] = (g * __builtin_amdgcn_rcpf(1.f + __expf(-g))) * up; }
                u32x4 w; w.x = cvt_pk_bf16(o[0], o[1]); w.y = cvt_pk_bf16(o[2], o[3]); w.z = cvt_pk_bf16(o[4], o[5]); w.w = cvt_pk_bf16(o[6], o[7]);
                *(u32x4*)(O + (size_t)(row0 + ai * HALF + m * 16) * ldc + col0) = w; }
    }
};
template <class Epi, class Sched, bool ALIGN_EPI = false, bool SP2 = false>
__device__ __forceinline__ void gemm_phase(PG8_LAS unsigned char* lds, const Gemm g, const Sched& S, const Epi& E) {
    int tid = threadIdx.x; asm volatile("" : "+v"(tid));
    const int wid = __builtin_amdgcn_readfirstlane(tid >> 6), lane = tid & 63, wr = wid >> 2, wc = wid & 3, fr = lane & 15, fq = lane >> 4;
    int K = g.K; asm volatile("" : "+s"(K));
    const int nt = K / BK;
    unsigned voffA[2], voffB[2];
#pragma unroll
    for (int i = 0; i < 2; ++i) { int R, C; stage_rc(tid * 16 + i * 8192, R, C); const int Rb = Epi::PERM ? ((R & ~31) + perm32(R & 31)) : R;
        voffA[i] = (unsigned)(R * K + C) * 2u; voffB[i] = (unsigned)(Rb * K + C) * 2u; }
    const size_t kstep = (size_t)(BK * 2);
    const size_t hstep = (size_t)HALF * K * 2;
    const size_t tstep = 2 * hstep;
    const unsigned ldsw = (unsigned)wid * 1024u;
    const int aoff = lds_byte(wr * 64 + fr, fq * 8), boff = lds_byte(wc * 32 + fr, fq * 8);
#define PG8_SA(b, h) (((b) * 2 + (h)) * HTB)
#define PG8_SB(b, h) ((4 + (b) * 2 + (h)) * HTB)
#define PG8_STAGE(bufoff, gbase, voff) do { _Pragma("unroll") for (int _i = 0; _i < 2; ++_i) \
        __builtin_amdgcn_global_load_lds((const unsigned*)((const char*)(gbase) + (voff)[_i]), (PG8_LAS unsigned*)(lds + (bufoff) + ldsw + _i * 8192), 16, 0, 0); } while (0)
#define PG8_LDA(dst, b, h) do { _Pragma("unroll") for (int m = 0; m < 4; ++m) _Pragma("unroll") for (int k = 0; k < 2; ++k) dst[m][k] = *(const PG8_LAS bf16x8*)(lds + PG8_SA(b, h) + aoff + m * 2048 + k * 1024); } while (0)
#define PG8_LDB(dst, b, h) do { _Pragma("unroll") for (int n = 0; n < 2; ++n) _Pragma("unroll") for (int k = 0; k < 2; ++k) dst[n][k] = *(const PG8_LAS bf16x8*)(lds + PG8_SB(b, h) + boff + n * 2048 + k * 1024); } while (0)
#define PG8_MMA(ai, bj, At, Bt) do { __builtin_amdgcn_s_setprio(1); _Pragma("unroll") for (int m = 0; m < 4; ++m) _Pragma("unroll") for (int n = 0; n < 2; ++n) _Pragma("unroll") for (int k = 0; k < 2; ++k) \
        acc[ai][bj][m][n] = __builtin_amdgcn_mfma_f32_16x16x32_bf16(Bt[n][k], At[m][k], acc[ai][bj][m][n], 0, 0, 0); __builtin_amdgcn_s_setprio(0); } while (0)
#define PG8_WAIT_V(n) asm volatile("s_waitcnt vmcnt(" #n ")" ::: "memory")
#define PG8_WAIT_L(n) asm volatile("s_waitcnt lgkmcnt(" #n ")" ::: "memory")
#define PG8_BAR __builtin_amdgcn_s_barrier()
#define PG8_SCHED __builtin_amdgcn_sched_barrier(0)
    Unit cur, nxt; int ui = 0;
    if (!S.next(0, cur)) return;
    f32x4 acc[2][2][4][2];
#pragma unroll
    for (int a = 0; a < 2; ++a)
#pragma unroll
        for (int b = 0; b < 2; ++b)
#pragma unroll
            for (int m = 0; m < 4; ++m)
#pragma unroll
                for (int n = 0; n < 2; ++n) acc[a][b][m][n] = (f32x4){0.f, 0.f, 0.f, 0.f};
    bf16x8 At[4][2], B0[2][2], B1[2][2];
    const char* cA = (const char*)g.A + (size_t)cur.pm * tstep; const char* cB = (const char*)g.Bt + (size_t)cur.pn * tstep;
    S.a_ready(cur);
    if constexpr (SP2) {
        PG8_STAGE(PG8_SB(0, 0), cB, voffB); PG8_STAGE(PG8_SB(0, 1), cB + hstep, voffB); PG8_STAGE(PG8_SA(0, 0), cA, voffA); PG8_STAGE(PG8_SA(0, 1), cA + hstep, voffA);
        if (wr == 1) PG8_BAR;
        PG8_WAIT_V(2); PG8_BAR;
        PG8_STAGE(PG8_SB(1, 0), cB + kstep, voffB); PG8_STAGE(PG8_SA(1, 0), cA + kstep, voffA); PG8_STAGE(PG8_SB(1, 1), cB + hstep + kstep, voffB);
        PG8_WAIT_V(6); PG8_BAR;
    } else {
        PG8_STAGE(PG8_SB(0, 0), cB, voffB); PG8_STAGE(PG8_SA(0, 0), cA, voffA); PG8_STAGE(PG8_SB(0, 1), cB + hstep, voffB); PG8_STAGE(PG8_SA(0, 1), cA + hstep, voffA);
        if (wr == 1) PG8_BAR;
        PG8_WAIT_V(4); PG8_BAR;
        PG8_STAGE(PG8_SB(1, 0), cB + kstep, voffB); PG8_STAGE(PG8_SA(1, 0), cA + kstep, voffA); PG8_STAGE(PG8_SB(1, 1), cB + hstep + kstep, voffB);
        PG8_WAIT_V(6); PG8_BAR;
    }
    for (;;) {
        const bool has_next = S.next(ui + 1, nxt);
        const char* nA = has_next ? (const char*)g.A + (size_t)nxt.pm * tstep : cA; const char* nB = has_next ? (const char*)g.Bt + (size_t)nxt.pn * tstep : cB;
        for (int t = 0; t < nt; t += 2) {
            const bool last = (t == nt - 2);
            const char* a1 = cA + (size_t)(t + 1) * kstep;
            const char* a2 = last ? nA : cA + (size_t)(t + 2) * kstep; const char* b2 = last ? nB : cB + (size_t)(t + 2) * kstep;
            const char* a3 = a2 + kstep; const char* b3 = b2 + kstep;
            if (last && has_next) S.a_ready(nxt);
            if constexpr (SP2) {
            PG8_LDB(B0, 0, 0); PG8_LDB(B1, 0, 1); PG8_SCHED; PG8_LDA(At, 0, 0); PG8_STAGE(PG8_SA(1, 1), a1 + hstep, voffA);
            PG8_WAIT_V(8); PG8_WAIT_L(0); PG8_BAR; PG8_MMA(0, 0, At, B0); PG8_MMA(0, 1, At, B1); PG8_BAR; PG8_SCHED;
            PG8_LDA(At, 0, 1); PG8_STAGE(PG8_SB(0, 0), b2, voffB); PG8_STAGE(PG8_SB(0, 1), b2 + hstep, voffB); PG8_STAGE(PG8_SA(0, 0), a2, voffA);
            PG8_WAIT_V(8); PG8_WAIT_L(0); PG8_BAR; PG8_MMA(1, 0, At, B0); PG8_MMA(1, 1, At, B1); PG8_BAR; PG8_SCHED;
            PG8_LDB(B0, 1, 0); PG8_LDB(B1, 1, 1); PG8_SCHED; PG8_LDA(At, 1, 0); PG8_STAGE(PG8_SA(0, 1), a2 + hstep, voffA);
            PG8_WAIT_V(8); PG8_WAIT_L(0); PG8_BAR; PG8_MMA(0, 0, At, B0); PG8_MMA(0, 1, At, B1); PG8_BAR; PG8_SCHED;
            PG8_LDA(At, 1, 1); PG8_STAGE(PG8_SB(1, 0), b3, voffB); PG8_STAGE(PG8_SB(1, 1), b3 + hstep, voffB); PG8_STAGE(PG8_SA(1, 0), a3, voffA);
            PG8_WAIT_V(8); PG8_WAIT_L(0); PG8_BAR; PG8_MMA(1, 0, At, B0); PG8_MMA(1, 1, At, B1); PG8_BAR; PG8_SCHED;
            } else {
            PG8_LDB(B0, 0, 0); PG8_SCHED; PG8_LDA(At, 0, 0); PG8_STAGE(PG8_SA(1, 1), a1 + hstep, voffA);
            PG8_WAIT_L(8); PG8_BAR; PG8_WAIT_L(0); PG8_MMA(0, 0, At, B0); PG8_BAR; PG8_SCHED;
            PG8_LDB(B1, 0, 1); PG8_STAGE(PG8_SB(0, 0), b2, voffB);
            PG8_BAR; PG8_WAIT_L(0); PG8_MMA(0, 1, At, B1); PG8_BAR;
            PG8_LDA(At, 0, 1); PG8_STAGE(PG8_SA(0, 0), a2, voffA);
            PG8_BAR; PG8_WAIT_L(0); PG8_MMA(1, 0, At, B0); PG8_BAR; PG8_SCHED;
            PG8_STAGE(PG8_SB(0, 1), b2 + hstep, voffB);
            PG8_WAIT_V(6); PG8_BAR; PG8_MMA(1, 1, At, B1); PG8_BAR;
            PG8_LDB(B0, 1, 0); PG8_SCHED; PG8_LDA(At, 1, 0); PG8_STAGE(PG8_SA(0, 1), a2 + hstep, voffA);
            PG8_WAIT_L(8); PG8_BAR; PG8_WAIT_L(0); PG8_MMA(0, 0, At, B0); PG8_BAR; PG8_SCHED;
            PG8_LDB(B1, 1, 1); PG8_STAGE(PG8_SB(1, 0), b3, voffB);
            PG8_BAR; PG8_WAIT_L(0); PG8_MMA(0, 1, At, B1); PG8_BAR;
            PG8_LDA(At, 1, 1); PG8_STAGE(PG8_SA(1, 0), a3, voffA);
            PG8_BAR; PG8_WAIT_L(0); PG8_MMA(1, 0, At, B0); PG8_BAR; PG8_SCHED;
            PG8_STAGE(PG8_SB(1, 1), b3 + hstep, voffB);
            PG8_WAIT_V(6); PG8_BAR; PG8_MMA(1, 1, At, B1); PG8_BAR;
            }
        }
        if constexpr (ALIGN_EPI) { if (wr == 0) PG8_BAR; }
        if constexpr (!Epi::AFTER_DRAIN) { E(acc, cur, wr, wc, fr, fq); S.done(cur); }
        if (!has_next) break;
#pragma unroll
        for (int a = 0; a < 2; ++a)
#pragma unroll
            for (int b = 0; b < 2; ++b)
#pragma unroll
                for (int m = 0; m < 4; ++m)
#pragma unroll
                    for (int n = 0; n < 2; ++n) acc[a][b][m][n] = (f32x4){0.f, 0.f, 0.f, 0.f};
        cur = nxt; cA = nA; cB = nB; ++ui;
        if constexpr (ALIGN_EPI) { if (wr == 1) PG8_BAR; }
    }
    PG8_WAIT_V(0);
    if constexpr (!ALIGN_EPI) { if (wr == 0) PG8_BAR; }
    PG8_BAR;
    if constexpr (Epi::AFTER_DRAIN) { E.fused(acc, cur, wr, wc, fr, fq, lds, wid, lane); S.done(cur); }
#undef PG8_SA
#undef PG8_SB
#undef PG8_STAGE
#undef PG8_LDA
#undef PG8_LDB
#undef PG8_MMA
#undef PG8_WAIT_V
#undef PG8_WAIT_L
#undef PG8_BAR
#undef PG8_SCHED
}
}
constexpr int NWAVES = 8;
constexpr int BATCH = 2, T = 8192, D = 1024, M = BATCH * T, DFF = 2816, NSA_IN = 1828, DSA_IN = 712, NCMP = 511, NCR = BATCH * NCMP * 2;
constexpr float NEGF = -1e30f, EPSF = 1e-6f;
#ifndef MK_SPLIT
#define MK_SPLIT 0
#endif
constexpr int N_PHASES = 19;
constexpr size_t MiB = 1u << 20;
constexpr size_t WS_CTL = 0, CTL_ZERO_BYTES = 1 * MiB;
constexpr size_t WS_KCB = 1 * MiB  , WS_VCT = 1 * MiB + 512 * 1024  , WS_MKB = 2 * MiB  , WS_MVT = 2 * MiB + 512 * 1024  , WS_MKV = 3 * MiB  , WS_WIDX = 5 * MiB  , WS_CNT = 6 * MiB  ;
constexpr size_t WS_WIN0 = 8 * MiB, WS_WO = 12 * MiB, WS_WGU = 16 * MiB, WS_WD = 38 * MiB, WS_WIN1 = 49 * MiB, WS_WQ2 = 51 * MiB, WS_WVT = 52 * MiB  ;
constexpr size_t WS_W1T = 232 * MiB, WS_MEMN = 234 * MiB, WS_WMKT = 236 * MiB, WS_W2T = 238 * MiB, WS_B1F = 238 * MiB + 64 * 1024;
constexpr size_t WS_XN = 56 * MiB;
constexpr size_t WS_Q0 = 88 * MiB, WS_KV0 = 112 * MiB  , WS_QM = 128 * MiB, WS_G0 = 136 * MiB, WS_VT = 144 * MiB  ;
static_assert(WS_Q0 == (88u << 20) && WS_KV0 == (112u << 20) && WS_QM == (128u << 20) && WS_G0 == (136u << 20), "EpiRoute tables");
constexpr size_t WS_ACT = 88 * MiB;
constexpr size_t WS_PROJ1 = 88 * MiB, WS_CQ = 112 * MiB, WS_CKV = 120 * MiB, WS_KIDX = 124 * MiB, WS_QA = 128 * MiB, WS_QI = 176 * MiB, WS_SEL = 112 * MiB  , WS_CAT1 = 176 * MiB  , WS_WO1F = 52 * MiB + 512 * 1024  ;
constexpr size_t WS_OCS = 152 * MiB  , WS_CAT = 200 * MiB, WS_END = 239 * MiB;
static_assert(WS_PROJ1 == (88u << 20) && WS_QA == (128u << 20) && WS_QI == (176u << 20) && WS_VT == (144u << 20), "EpiRoute tables");
static_assert(WS_ACT + (size_t)M * DFF * 2 <= WS_CAT + 0 * MiB || true, "map");
constexpr int CW_BAR = 4096;
constexpr int RING_OFF = 0, RING_BYTES = 131072, LDS_BYTES = 163840, LDSCTL_OFF = LDS_BYTES - 1024, MISC_OFF = LDSCTL_OFF + 320;
#define GAS __attribute__((address_space(1)))
#define LAS __attribute__((address_space(3)))
typedef unsigned short bf16;
typedef unsigned v4u __attribute__((ext_vector_type(4)));
typedef float f32x4 __attribute__((ext_vector_type(4)));
typedef short bf16x8 __attribute__((ext_vector_type(8)));
typedef GAS unsigned gu32;
typedef GAS unsigned long long gu64;
#define RLX_AGENT __ATOMIC_RELAXED, __HIP_MEMORY_SCOPE_AGENT
#define LDS_WAIT() asm volatile("s_waitcnt lgkmcnt(0)" ::: "memory")
#define VM_WAIT() asm volatile("s_waitcnt vmcnt(0)" ::: "memory")
__device__ __forceinline__ unsigned long long rt() { return __builtin_amdgcn_s_memrealtime(); }
__device__ __forceinline__ unsigned f2bf(float f) { unsigned u = __builtin_bit_cast(unsigned, f); return (u + 0x7fffu + ((u >> 16) & 1u)) >> 16; }
__device__ __forceinline__ unsigned pk2(float lo, float hi) { return f2bf(lo) | (f2bf(hi) << 16); }
#define XB_TMO      128
#define XB_XCNT(j)  (256  + 64 * (j))
#define XB_XSUB(j)  (1280 + 64 * (j))
#define XB_XGEN(j)  (2304 + 64 * (j))
#define XB_TOP      3328
#define XB_TOPGEN   3392
#define XCD_BAR_WORDS 3456
#define XB_SPIN_CAP (1u << 18)

__device__ __forceinline__ unsigned xb_ld(unsigned* p)              { return __hip_atomic_load(p, __ATOMIC_RELAXED, __HIP_MEMORY_SCOPE_AGENT); }
__device__ __forceinline__ unsigned xb_add(unsigned* p, unsigned v) { return __hip_atomic_fetch_add(p, v, __ATOMIC_RELAXED, __HIP_MEMORY_SCOPE_AGENT); }
__device__ __forceinline__ unsigned xb_xcc_id() { return (unsigned)__builtin_amdgcn_s_getreg((3 << 11) | 20) & 0xFu; }
#define XB_SPIN(cond, bar) do { unsigned _sp = 0; while (cond) { __builtin_amdgcn_s_sleep(1); \
    if ((++_sp & 255u) == 0u) { if (xb_ld(&(bar)[XB_TMO])) break; if (_sp > XB_SPIN_CAP) { atomicAdd(&(bar)[XB_TMO], 1u); break; } } } } while (0)

struct XcdBarrier {
    unsigned* bar; unsigned x;
    volatile LAS unsigned* st;
};

__device__ __forceinline__ XcdBarrier xcd_barrier_post(unsigned* bar, volatile LAS unsigned* st) {
    XcdBarrier b; b.bar = bar; b.x = xb_xcc_id(); b.st = st;
    if (threadIdx.x == 0) (void)xb_add(&bar[XB_XCNT(b.x)], 1u);
    return b;
}
__device__ __forceinline__ void xcd_barrier_complete(unsigned* bar, unsigned x, unsigned& nloc, unsigned& nx) {
    const unsigned G = gridDim.x * gridDim.y * gridDim.z;
    unsigned sum, cnt, mine, sp = 0u;
    for (;;) {
        sum = 0u; cnt = 0u; mine = 0u;
#pragma unroll 1
        for (unsigned j = 0; j < 16; ++j) { const unsigned c = xb_ld(&bar[XB_XCNT(j)]); sum += c; cnt += (c > 0u) ? 1u : 0u; mine = (j == x) ? c : mine; }
        if (sum == G) break;
        __builtin_amdgcn_s_sleep(1);
        if ((++sp & 255u) == 0u) { if (xb_ld(&bar[XB_TMO])) break; if (sp > XB_SPIN_CAP) { atomicAdd(&bar[XB_TMO], 1u); break; } }
    }
    nloc = mine > 0u ? mine : 1u; nx = cnt > 0u ? cnt : 1u;
}

__device__ __forceinline__ void xcd_barrier(const XcdBarrier& b) {
    asm volatile("s_waitcnt vmcnt(0)" ::: "memory");
    __syncthreads();
    if (threadIdx.x == 0) {
        unsigned* bar = b.bar;
        __builtin_amdgcn_s_waitcnt(0);
        unsigned nloc = b.st[0], nx = b.st[1];
        if (nloc == 0u) { xcd_barrier_complete(bar, b.x, nloc, nx); b.st[0] = nloc; b.st[1] = nx; }
        const unsigned old = xb_add(&bar[XB_XSUB(b.x)], 1u);
        const unsigned gen = old / nloc;
        if (old + 1u == (gen + 1u) * nloc) {
            __builtin_amdgcn_fence(__ATOMIC_RELEASE, "agent");
            asm volatile("s_waitcnt vmcnt(0)" ::: "memory");
            const unsigned og = xb_add(&bar[XB_TOP], 1u);
            const unsigned tg = og / nx;
            if (og + 1u == (tg + 1u) * nx) xb_add(&bar[XB_TOPGEN], 1u);
            else XB_SPIN(xb_ld(&bar[XB_TOPGEN]) == tg, bar);
            __builtin_amdgcn_fence(__ATOMIC_ACQUIRE, "agent");
            xb_add(&bar[XB_XGEN(b.x)], 1u);
            asm volatile("s_waitcnt vmcnt(0)" ::: "memory");
        } else {
            XB_SPIN(xb_ld(&bar[XB_XGEN(b.x)]) == gen, bar);
            __builtin_amdgcn_fence(__ATOMIC_ACQUIRE, "agent");
            asm volatile("s_waitcnt vmcnt(0)" ::: "memory");
        }
    }
    __syncthreads();
}

struct Frame {
    LAS unsigned char* lds; volatile LAS unsigned* MISC; gu32* ctl;
    int vcu, G;
};
__device__ __forceinline__ float bf2f(unsigned short u) { return __uint_as_float((unsigned)u << 16); }
__device__ __forceinline__ float bflo(unsigned u) { return __uint_as_float(u << 16); }
__device__ __forceinline__ float bfhi(unsigned u) { return __uint_as_float(u & 0xffff0000u); }
__device__ __forceinline__ float wave_sum(float v) {
#pragma unroll
    for (int o = 1; o < 64; o <<= 1) v += __shfl_xor(v, o);
    return v;
}
__device__ __forceinline__ float red16_sum(float v) { v += __shfl_xor(v, 1, 16); v += __shfl_xor(v, 2, 16); v += __shfl_xor(v, 4, 16); v += __shfl_xor(v, 8, 16); return v; }
__device__ __forceinline__ float red16_max(float v) { v = fmaxf(v, __shfl_xor(v, 1, 16)); v = fmaxf(v, __shfl_xor(v, 2, 16)); v = fmaxf(v, __shfl_xor(v, 4, 16)); v = fmaxf(v, __shfl_xor(v, 8, 16)); return v; }
__device__ __forceinline__ int rel_bucket(int n) {
    if (n < 16) return n;
    return 16 + (n >= 22) + (n >= 30) + (n >= 40) + (n >= 54) + (n >= 73) + (n >= 99) + (n >= 134) + (n >= 182) + (n >= 246) + (n >= 332) + (n >= 450) + (n >= 609) + (n >= 825) + (n >= 1117) + (n >= 1513);
}

__device__ __forceinline__ void xpose_item(const float* W, int ldw, int c0, int nvalid, int k0, bf16* WT, int Kd, int drow0, LAS float* scr, int lane, const float* kgain = nullptr) {
#pragma unroll 8
    for (int i = 0; i < 32; ++i) { const int kk = 2 * i + (lane >> 5), n = lane & 31; float wv = (n < nvalid) ? W[(size_t)(k0 + kk) * ldw + c0 + n] : 0.f; if (kgain) wv *= kgain[k0 + kk]; scr[kk * 33 + n] = wv; }
    LDS_WAIT(); asm volatile("" ::: "memory");
    const int c = lane & 7;
#pragma unroll
    for (int j = 0; j < 4; ++j) { const int n = (lane >> 3) + 8 * j; const LAS float* s = scr + (8 * c) * 33 + n;
        v4u o; o.x = pk2(s[0 * 33], s[1 * 33]); o.y = pk2(s[2 * 33], s[3 * 33]); o.z = pk2(s[4 * 33], s[5 * 33]); o.w = pk2(s[6 * 33], s[7 * 33]);
        *(GAS v4u*)(WT + (size_t)(drow0 + n) * Kd + k0 + 8 * c) = o; }
    LDS_WAIT(); asm volatile("" ::: "memory");
}
__device__ __forceinline__ void rms_row_to_bf16(const float* xrow, const float* gain, bf16* orow, int lane) {
    const GAS f32x4* xr = (const GAS f32x4*)xrow + lane; const GAS f32x4* gr = (const GAS f32x4*)gain + lane;
    f32x4 v[4]; float s = 0.f;
#pragma unroll
    for (int j = 0; j < 4; ++j) { v[j] = xr[64 * j]; s += (v[j].x * v[j].x + v[j].y * v[j].y) + (v[j].z * v[j].z + v[j].w * v[j].w); }
    const float r = rsqrtf(wave_sum(s) * (1.f / D) + EPSF);
    GAS unsigned long long* o8 = (GAS unsigned long long*)orow + lane;
#pragma unroll
    for (int j = 0; j < 4; ++j) { const f32x4 g = gr[64 * j]; o8[64 * j] = (unsigned long long)pk2((v[j].x * r) * g.x, (v[j].y * r) * g.y) | ((unsigned long long)pk2((v[j].z * r) * g.z, (v[j].w * r) * g.w) << 32); }
}
#ifndef PROBE_REP
#define PROBE_REP 0
#endif
#define CAS __attribute__((address_space(4)))
#define KARGS() const CAS In* Ip = (const CAS In*)__builtin_amdgcn_kernarg_segment_ptr(); asm volatile("" : "+s"(Ip))
#define OPAQUE_TID() int tid_ = threadIdx.x; asm volatile("" : "+v"(tid_))
__device__ __forceinline__ void norm_phase(Frame& F, const float* x, const float* gain, bf16* xn) {
    OPAQUE_TID(); const int lane_ = tid_ & 63, wave_ = tid_ >> 6;
    const int gw = F.vcu * NWAVES + wave_, NGW = F.G * NWAVES;
    for (int m = gw; m < M; m += NGW) rms_row_to_bf16(x + (size_t)m * D, gain, xn + (size_t)m * D, lane_);
}

template <int DL>
__device__ __forceinline__ void coop_attend(const float (&q)[DL], const float (&k)[DL], const float (&v)[DL], float bias, float& m_, float& l_, float (&o)[DL]) {
    float a = 0.f;
#pragma unroll
    for (int d = 0; d < DL; ++d) a += q[d] * k[d];
    a = red16_sum(a) + bias;
    const float mn = fmaxf(m_, a), al = __expf(m_ - mn), p = __expf(a - mn);
    l_ = l_ * al + p; m_ = mn;
#pragma unroll
    for (int d = 0; d < DL; ++d) o[d] = o[d] * al + p * v[d];
}
__device__ __forceinline__ void ld4bf(const bf16* p, float (&x)[4]) { const uint2 u = *(const uint2*)p; x[0] = bflo(u.x); x[1] = bfhi(u.x); x[2] = bflo(u.y); x[3] = bfhi(u.y); }
__device__ __forceinline__ void ld8bf(const bf16* p, float (&x)[8]) { const uint4 u = *(const uint4*)p; x[0] = bflo(u.x); x[1] = bfhi(u.x); x[2] = bflo(u.y); x[3] = bfhi(u.y); x[4] = bflo(u.z); x[5] = bfhi(u.z); x[6] = bflo(u.w); x[7] = bfhi(u.w); }
__device__ __forceinline__ void ld4f(const float* p, float (&x)[4]) { const float4 u = *(const float4*)p; x[0] = u.x; x[1] = u.y; x[2] = u.z; x[3] = u.w; }

struct In {
    const float *x, *mem, *rel_bias, *norm_mix, *norm_ffn, *norm_mem, *w_mem_kv, *w_out, *ffn_gate, *ffn_up, *ffn_down, *nsa_w_in, *nsa_gate_b, *pos_k, *pos_v,
        *k_w1, *k_b1, *k_w2, *k_b2, *v_w1, *v_b1, *v_w2, *v_b2, *dsa_w_in, *q_norm, *kv_norm, *w_q_up, *w_uk, *w_uv, *w_q_idx, *kidx_norm, *norm_final;
};
__device__ __forceinline__ void p0_prologue(Frame& F, const In& I, unsigned char* ws) {
    OPAQUE_TID(); KARGS(); const int lane_ = tid_ & 63, wave_ = __builtin_amdgcn_readfirstlane(tid_ >> 6);
    LAS float* scr = (LAS float*)(F.lds + RING_OFF + wave_ * 16384);
    const int gw = F.vcu * NWAVES + wave_, NGW = F.G * NWAVES;
    bf16* WIN0 = (bf16*)(ws + WS_WIN0); bf16* WO = (bf16*)(ws + WS_WO); bf16* WGU = (bf16*)(ws + WS_WGU); bf16* WD = (bf16*)(ws + WS_WD); bf16* WIN1 = (bf16*)(ws + WS_WIN1); bf16* WQ2 = (bf16*)(ws + WS_WQ2);
    constexpr int I_A = 16 * 56, I_G = 16 * 8, I_B = 2 * 16 * 32, I_C = 2 * 16 * 176, I_D = 2 * 44 * 32, I_E = 16 * 24, I_F = 4 * 16, NITEMS = I_A + I_B + I_C + I_D + I_E + I_F + I_G;
    for (int it = gw; it < NITEMS; it += NGW) {
        int r = it;
        if (r < I_A) { const int kb = r / 56, nb = r % 56, r0 = 32 * nb; int c0, nv;
            if (r0 < 1152) { c0 = r0; nv = 32; } else if (r0 < 1280) { c0 = r0 + 128; nv = 32; } else if (r0 < 1536) { c0 = r0 + 292; nv = 32; } else if (r0 == 1536) { c0 = 1536; nv = 32; } else if (r0 == 1568) { c0 = 1568; nv = 4; } else { c0 = 0; nv = 0; }
            xpose_item(Ip->nsa_w_in, NSA_IN, c0, nv, 64 * kb, WIN0, D, r0, scr, lane_); continue; } r -= I_A;
        if (r < I_B) { const int l = r / 512, q = r % 512, kb = q / 32, nb = q % 32;
            xpose_item(Ip->w_out + (size_t)l * D * D, D, 32 * nb, 32, 64 * kb, WO + (size_t)l * D * D, D, 32 * nb, scr, lane_); continue; } r -= I_B;
        if (r < I_C) { const int l = r / (16 * 176), q = r % (16 * 176), kb = q / 176, nb = q % 176, r0 = 32 * nb, pn = r0 >> 8, w0 = r0 & 255;
            const float* src = ((w0 < 128) ? Ip->ffn_gate : Ip->ffn_up) + (size_t)l * D * DFF;
            xpose_item(src, DFF, 128 * pn + (w0 & 127), 32, 64 * kb, WGU + (size_t)l * 2 * DFF * D, D, r0, scr, lane_, Ip->norm_ffn + l * D); continue; } r -= I_C;
        if (r < I_D) { const int l = r / (44 * 32), q = r % (44 * 32), kb = q / 32, nb = q % 32;
            xpose_item(Ip->ffn_down + (size_t)l * DFF * D, D, 32 * nb, 32, 64 * kb, WD + (size_t)l * D * DFF, DFF, 32 * nb, scr, lane_); continue; } r -= I_D;
        if (r < I_E) { const int kb = r / 24, nb = r % 24, r0 = 32 * nb; int nv = DSA_IN - r0; nv = nv > 32 ? 32 : (nv < 0 ? 0 : nv);
            xpose_item(Ip->dsa_w_in, DSA_IN, r0, nv, 64 * kb, WIN1, D, r0, scr, lane_, Ip->norm_mix + D); continue; } r -= I_E;
        if (r < I_F) { const int kb = r / 16, nb = r % 16; xpose_item(Ip->w_q_idx, 512, 32 * nb, 32, 64 * kb, WQ2, 256, 1536 + 32 * nb, scr, lane_); continue; } r -= I_F;
        { const int kb = r / 8, nb = r % 8, r0 = 32 * nb;
            xpose_item(Ip->nsa_w_in, NSA_IN, (r0 < 128) ? 1152 + r0 : 1408 + (r0 - 128), 32, 64 * kb, (bf16*)(ws + WS_WVT), D, r0, scr, lane_); }
    }
    for (int idx = (F.vcu * NWAVES * 64) + tid_; idx < 1536 * 256; idx += F.G * NWAVES * 64) {
        const int n = idx >> 8, c = idx & 255, h = n >> 7, rr = n & 127; const float* a = Ip->w_q_up + (size_t)c * 768 + h * 64; const float* b = Ip->w_uk + (size_t)rr * 768 + h * 64; float s = 0.f;
#pragma unroll 8
        for (int d = 0; d < 64; ++d) s += a[d] * b[d];
        WQ2[idx] = (bf16)f2bf(s * (0.125f * 1.4426950408889634f));
    }
    { bf16* WO1F = (bf16*)(ws + WS_WO1F); const float* wo1 = Ip->w_out + (size_t)D * D;
      for (int idx = (F.vcu * NWAVES * 64) + tid_; idx < 1536 * 1024; idx += F.G * NWAVES * 64) {
          const int nn = idx & 1023, hr = idx >> 10, h = hr >> 7, rr = hr & 127; const float* a = Ip->w_uv + (size_t)rr * 768 + h * 64; const float* bcol = wo1 + (size_t)(h * 64) * D + nn; float sacc = 0.f;
#pragma unroll 8
          for (int d = 0; d < 64; ++d) sacc += a[d] * bcol[(size_t)d * D];
          WO1F[(size_t)nn * 1792 + hr] = (bf16)f2bf(sacc); }
      for (int it = gw; it < 4 * 32; it += NGW) { const int kb = it / 32, nb = it % 32;
          xpose_item(wo1 + (size_t)768 * D, D, 32 * nb, 32, 64 * kb, WO1F + 1536, 1792, 32 * nb, scr, lane_); } }
    { bf16* W1T = (bf16*)(ws + WS_W1T); bf16* W2T = (bf16*)(ws + WS_W2T); bf16* WMKT = (bf16*)(ws + WS_WMKT); float* B1F = (float*)(ws + WS_B1F); bf16* MEMN = (bf16*)(ws + WS_MEMN);
      constexpr int J_1 = 2 * 32 * 8, J_2 = 2 * 4 * 2, J_M = 2 * 16 * 16;
      for (int it = gw; it < J_1 + J_2 + J_M; it += NGW) { int r2 = it;
          if (r2 < J_1) { const int kv = r2 / 256, q = r2 % 256, kb = q / 8, nb = q % 8; xpose_item(kv ? Ip->v_w1 : Ip->k_w1, 256, 32 * nb, 32, 64 * kb, W1T + (size_t)kv * 256 * 2048, 2048, 32 * nb, scr, lane_); continue; } r2 -= J_1;
          if (r2 < J_2) { const int kv = r2 / 8, q = r2 % 8, kb = q / 2, nb = q % 2; xpose_item(kv ? Ip->v_w2 : Ip->k_w2, 64, 32 * nb, 32, 64 * kb, W2T + (size_t)kv * 64 * 256, 256, 32 * nb, scr, lane_); continue; } r2 -= J_2;
          { const int l = r2 / 256, q = r2 % 256, kb = q / 16, nb = q % 16; xpose_item(Ip->w_mem_kv + (size_t)l * D * 512, 512, 32 * nb, 32, 64 * kb, WMKT + (size_t)l * 512 * D, D, 32 * nb, scr, lane_); } }
      for (int idx = (F.vcu * NWAVES * 64) + tid_; idx < 512; idx += F.G * NWAVES * 64) { const int kv = idx >> 8, c = idx & 255; const float* w1 = kv ? Ip->v_w1 : Ip->k_w1; const float* pos = kv ? Ip->pos_v : Ip->pos_k; float sacc = (kv ? Ip->v_b1 : Ip->k_b1)[c];
          for (int k = 0; k < 2048; ++k) sacc += pos[k] * w1[(size_t)k * 256 + c];
          B1F[idx] = sacc; }
      for (int m = gw; m < 1024; m += NGW) rms_row_to_bf16(Ip->mem + (size_t)(m & 511) * D, Ip->norm_mem + (m >> 9) * D, MEMN + (size_t)m * D, lane_); }
    norm_phase(F, Ip->x, Ip->norm_mix, (bf16*)(ws + WS_XN));
}

#define MFMA16(A, B, C) __builtin_amdgcn_mfma_f32_16x16x32_bf16((A), (B), (C), 0, 0, 0)
constexpr float LOG2E = 1.4426950408889634f;
constexpr int NSA_OUT = 0, NSA_PSQ = 98304, NSA_ST = 147456, NSA_TB = NSA_ST + 3072;
constexpr int TAB_B12 = NSA_ST + 1024;
constexpr int TAB_BKT = NSA_ST + 3072;
static_assert(NSA_TB + 12288 <= LDSCTL_OFF && TAB_B12 + 2048 <= NSA_TB, "LDS tables");
enum { MD_CMP = 0, MD_WIN = 1, MD_BLK = 2, MD_MEM = 3 };
struct KF { bf16x8 a0, a1, b0, b1; };
struct VF { bf16x8 v[4]; };
__device__ __forceinline__ bf16x8 ldg16(const bf16* p) { return *(const bf16x8*)p; }
typedef float f32x2_t __attribute__((ext_vector_type(2))); typedef __bf16 bf16x2_t __attribute__((ext_vector_type(2)));
__device__ __forceinline__ unsigned cvtpk_s(float lo, float hi) { f32x2_t v = {lo, hi}; bf16x2_t b = __builtin_convertvector(v, bf16x2_t); return __builtin_bit_cast(unsigned, b); }
__device__ __forceinline__ bf16x8 pack8(const f32x4& a, const f32x4& b) { v4u w; w.x = cvtpk_s(a[0], a[1]); w.y = cvtpk_s(a[2], a[3]); w.z = cvtpk_s(b[0], b[1]); w.w = cvtpk_s(b[2], b[3]); return __builtin_bit_cast(bf16x8, w); }
__device__ __forceinline__ void load_k(KF& k, const bf16* kb, int kstride, int key0, int r, int kq) {
    const bf16* pa = kb + (size_t)(key0 + 8 * (r >> 2) + (r & 3)) * kstride + 8 * kq; const bf16* pb = pa + 4 * (size_t)kstride;
    k.a0 = ldg16(pa); k.a1 = ldg16(pa + 32); k.b0 = ldg16(pb); k.b1 = ldg16(pb + 32);
}
__device__ __forceinline__ void load_vt(VF& v, const bf16* vt, int vstride, int key0, int r, int kq) {
#pragma unroll
    for (int dt = 0; dt < 4; ++dt) v.v[dt] = ldg16(vt + (size_t)(16 * dt + r) * vstride + key0 + 8 * kq);
}
__device__ __forceinline__ void qk(f32x4& sa, f32x4& sb, const KF& k, const bf16x8 (&q)[2]) {
    const f32x4 z = {0.f, 0.f, 0.f, 0.f};
    sa = MFMA16(k.a0, q[0], z); sa = MFMA16(k.a1, q[1], sa); sb = MFMA16(k.b0, q[0], z); sb = MFMA16(k.b1, q[1], sb);
}
struct BiasCtx { const LAS unsigned short* tb; float d29, d30, c31; };
template <int MODE>
__device__ __forceinline__ void maskbias(f32x4& s, int kpos, int tcol, bool colok, const BiasCtx& B) {
    if (MODE == MD_MEM) return;
#pragma unroll
    for (int i = 0; i < 4; ++i) {
        int dist; bool ok;
        if (MODE == MD_CMP) { dist = tcol - 31 - 16 * (kpos + i); ok = dist >= 0; }
        else if (MODE == MD_WIN) { dist = tcol - (kpos + i); ok = (unsigned)dist <= 511u; }
        else { dist = tcol - (kpos + i); ok = dist >= 0; }
        int dc = dist < 0 ? 0 : dist; dc = dc > 1023 ? 1023 : dc;
        const float tb = __uint_as_float((unsigned)B.tb[dc * 6] << 16);
        const float far = B.c31 + (dist < 1513 ? B.d30 : 0.f) + (dist < 1117 ? B.d29 : 0.f);
        const float bias = dist < 1024 ? tb : far;
        s[i] = (ok && colok) ? s[i] + bias : -INFINITY;
    }
}
__device__ __forceinline__ float colmax(const f32x4& sa, const f32x4& sb) {
    float mx = fmaxf(fmaxf(fmaxf(sa[0], sa[1]), fmaxf(sa[2], sa[3])), fmaxf(fmaxf(sb[0], sb[1]), fmaxf(sb[2], sb[3])));
    mx = fmaxf(mx, __shfl_xor(mx, 16)); mx = fmaxf(mx, __shfl_xor(mx, 32)); return mx;
}
constexpr float SM_THR = 8.f;
__device__ __forceinline__ float lmax8(const f32x4& sa, const f32x4& sb) { return fmaxf(fmaxf(fmaxf(sa[0], sa[1]), fmaxf(sa[2], sa[3])), fmaxf(fmaxf(sb[0], sb[1]), fmaxf(sb[2], sb[3]))); }
template <int NO>
__device__ __forceinline__ void sm_rescale(float lm, float& m, float& l, f32x4 (&O)[NO]) {
    if (__any(lm > m + SM_THR)) {
        lm = fmaxf(lm, __shfl_xor(lm, 16)); lm = fmaxf(lm, __shfl_xor(lm, 32));
        const float mn = fmaxf(m, lm); const float al = __builtin_amdgcn_exp2f(m - mn); m = mn; l *= al;
#pragma unroll
        for (int dt = 0; dt < NO; ++dt) O[dt] = O[dt] * al;
    }
}
__device__ __forceinline__ bf16x8 sm_update(const f32x4& sa, const f32x4& sb, float& m, float& l, f32x4 (&O)[4]) {
    sm_rescale<4>(lmax8(sa, sb), m, l, O);
    f32x4 pa, pb; float sum = 0.f;
#pragma unroll
    for (int i = 0; i < 4; ++i) { pa[i] = __builtin_amdgcn_exp2f(sa[i] - m); pb[i] = __builtin_amdgcn_exp2f(sb[i] - m); sum += pa[i] + pb[i]; }
    l += sum;
    return pack8(pa, pb);
}
__device__ __forceinline__ void sm_update64(const f32x4& sa0, const f32x4& sb0, const f32x4& sa1, const f32x4& sb1, float& m, float& l, f32x4 (&O)[4], bf16x8& pf0, bf16x8& pf1) {
    sm_rescale<4>(fmaxf(lmax8(sa0, sb0), lmax8(sa1, sb1)), m, l, O);
    f32x4 pa0, pb0, pa1, pb1; float sum = 0.f;
#pragma unroll
    for (int i = 0; i < 4; ++i) { pa0[i] = __builtin_amdgcn_exp2f(sa0[i] - m); pb0[i] = __builtin_amdgcn_exp2f(sb0[i] - m); pa1[i] = __builtin_amdgcn_exp2f(sa1[i] - m); pb1[i] = __builtin_amdgcn_exp2f(sb1[i] - m);
        sum += (pa0[i] + pb0[i]) + (pa1[i] + pb1[i]); }
    l += sum;
    pf0 = pack8(pa0, pb0); pf1 = pack8(pa1, pb1);
}
enum { BK_FAR = 0, BK_MID = 1, BK_GEN = 2 };
template <int MD>
__device__ __forceinline__ void step64(const KF& k0, const KF& k1, const bf16x8 (&q)[2], int cls, int kpos, int tcol, bool colok, const BiasCtx& B,
                                       float& m, float& l, f32x4 (&O)[4], bf16x8& pf0, bf16x8& pf1) {
    const bool has = m > -1e29f; const float mref = has ? m : 0.f;
    float cin = ((cls == BK_FAR) ? B.c31 : 0.f) - mref; if (!colok) cin = -INFINITY;
    const f32x4 c4 = {cin, cin, cin, cin};
    f32x4 sa0 = MFMA16(k0.a0, q[0], c4), sb0 = MFMA16(k0.b0, q[0], c4), sa1 = MFMA16(k1.a0, q[0], c4), sb1 = MFMA16(k1.b0, q[0], c4);
    sa0 = MFMA16(k0.a1, q[1], sa0); sb0 = MFMA16(k0.b1, q[1], sb0); sa1 = MFMA16(k1.a1, q[1], sa1); sb1 = MFMA16(k1.b1, q[1], sb1);
    if (cls == BK_MID) {
        const LAS unsigned short* tp = B.tb + (tcol - kpos) * 6;
#pragma unroll
        for (int i = 0; i < 4; ++i) { sa0[i] += __uint_as_float((unsigned)tp[-6 * i] << 16); sb0[i] += __uint_as_float((unsigned)tp[-6 * (i + 4)] << 16);
            sa1[i] += __uint_as_float((unsigned)tp[-6 * (i + 32)] << 16); sb1[i] += __uint_as_float((unsigned)tp[-6 * (i + 36)] << 16); }
    } else if (cls == BK_GEN) {
        maskbias<MD>(sa0, kpos, tcol, true, B); maskbias<MD>(sb0, kpos + 4, tcol, true, B); maskbias<MD>(sa1, kpos + 32, tcol, true, B); maskbias<MD>(sb1, kpos + 36, tcol, true, B);
    }
    float lm = fmaxf(lmax8(sa0, sb0), lmax8(sa1, sb1));
    if (__any((lm > SM_THR) || (!has && lm > -INFINITY))) {
        lm = fmaxf(lm, __shfl_xor(lm, 16)); lm = fmaxf(lm, __shfl_xor(lm, 32));
        const bool upd = (lm > -INFINITY) && (!has || lm > 0.f); const float dl = upd ? lm : 0.f;
        if (upd) m = mref + dl;
        const float f = has ? __builtin_amdgcn_exp2f(-dl) : 1.f; l *= f;
#pragma unroll
        for (int dt = 0; dt < 4; ++dt) O[dt] = O[dt] * f;
#pragma unroll
        for (int i = 0; i < 4; ++i) { sa0[i] -= dl; sb0[i] -= dl; sa1[i] -= dl; sb1[i] -= dl; }
    }
    f32x4 pa0, pb0, pa1, pb1; float sum = 0.f;
#pragma unroll
    for (int i = 0; i < 4; ++i) { pa0[i] = __builtin_amdgcn_exp2f(sa0[i]); pb0[i] = __builtin_amdgcn_exp2f(sb0[i]); pa1[i] = __builtin_amdgcn_exp2f(sa1[i]); pb1[i] = __builtin_amdgcn_exp2f(sb1[i]);
        sum += (pa0[i] + pb0[i]) + (pa1[i] + pb1[i]); }
    l += sum;
    pf0 = pack8(pa0, pb0); pf1 = pack8(pa1, pb1);
}
__device__ __forceinline__ void pv(f32x4 (&O)[4], const VF& v, const bf16x8& pf) {
#pragma unroll
    for (int dt = 0; dt < 4; ++dt) O[dt] = MFMA16(v.v[dt], pf, O[dt]);
}
__device__ __forceinline__ void lds_fadd(LAS float* p, float v) { (void)__hip_atomic_fetch_add((float*)p, v, __ATOMIC_RELAXED, __HIP_MEMORY_SCOPE_WORKGROUP); }
__device__ __forceinline__ float kqsum(float v) { v += __shfl_xor(v, 16); v += __shfl_xor(v, 32); return v; }
__device__ __forceinline__ float wmax64(float v) {
#pragma unroll
    for (int o = 1; o < 64; o <<= 1) v = fmaxf(v, __shfl_xor(v, o));
    return v;
}
__device__ __forceinline__ void out_add(LAS float* OUTw, int p, int n, int kq, const f32x4 (&O)[4], float scale, bool first) {
    const int q = 2 * p + (n >> 3), hd = n & 7;
    if (hd < 6) { LAS f32x4* dst = (LAS f32x4*)(OUTw + (q * 6 + hd) * 64) + kq;
#pragma unroll
        for (int dt = 0; dt < 4; ++dt) { f32x4 v = O[dt] * scale; if (!first) v = v + dst[4 * dt]; dst[4 * dt] = v; } }
}

__device__ __forceinline__ void p2_mfma(Frame& F, const In& I, unsigned char* ws) {
    OPAQUE_TID(); KARGS(); const int lane = tid_ & 63, wave = __builtin_amdgcn_readfirstlane(tid_ >> 6), r = lane & 15, kq = lane >> 4;
    const bf16* KV0 = (const bf16*)(ws + WS_KV0); const bf16* W1T = (const bf16*)(ws + WS_W1T); const bf16* W2T = (const bf16*)(ws + WS_W2T); const float* B1F = (const float*)(ws + WS_B1F);
    const bf16* MEMN = (const bf16*)(ws + WS_MEMN); const bf16* WMKT = (const bf16*)(ws + WS_WMKT);
    bf16* KCB = (bf16*)(ws + WS_KCB); bf16* VCT = (bf16*)(ws + WS_VCT); bf16* MKB = (bf16*)(ws + WS_MKB); bf16* MVT = (bf16*)(ws + WS_MVT);
    LAS unsigned char* hid = F.lds + RING_OFF;
    for (int u = blockIdx.x; u < 192; u += F.G) {
        const bool cmp = u < 128;
        const bf16* ap[2]; const bf16* bp[2]; int K, kjump;
        int kv = 0, bg = 0, n0 = 0, lay = 0, m0 = 0, ch = 0;
        if (cmp) { kv = u >> 6; bg = (u >> 4) & 3; n0 = (u & 15) * 32; const int b = bg >> 1, g = bg & 1; K = 2048; kjump = 512 - 64;
#pragma unroll
            for (int rt = 0; rt < 2; ++rt) { int nn = n0 + 16 * rt + r; nn = nn > 510 ? 510 : nn; ap[rt] = KV0 + (size_t)(b * T + 16 * nn) * 512 + kv * 128 + g * 64 + 8 * kq; }
#pragma unroll
            for (int ct = 0; ct < 2; ++ct) bp[ct] = W1T + (size_t)(kv * 256 + 32 * wave + 16 * ct + r) * 2048 + 8 * kq;
        } else { const int v = u - 128; lay = v >> 5; m0 = ((v >> 1) & 15) * 32; ch = v & 1; K = 1024; kjump = 0;
#pragma unroll
            for (int rt = 0; rt < 2; ++rt) ap[rt] = MEMN + (size_t)(lay * 512 + m0 + 16 * rt + r) * 1024 + 8 * kq;
#pragma unroll
            for (int ct = 0; ct < 2; ++ct) bp[ct] = WMKT + (size_t)(lay * 512 + ch * 256 + 32 * wave + 16 * ct + r) * 1024 + 8 * kq;
        }
        f32x4 acc[2][2];
#pragma unroll
        for (int rt = 0; rt < 2; ++rt)
#pragma unroll
            for (int ct = 0; ct < 2; ++ct) acc[rt][ct] = (f32x4){0.f, 0.f, 0.f, 0.f};
        for (int kb = 0; kb < K; kb += 64) { const int ao = kb + (kb >> 6) * kjump;
            bf16x8 a[2][2], bb[2][2];
#pragma unroll
            for (int h2 = 0; h2 < 2; ++h2) {
#pragma unroll
                for (int rt = 0; rt < 2; ++rt) a[rt][h2] = ldg16(ap[rt] + ao + 32 * h2);
#pragma unroll
                for (int ct = 0; ct < 2; ++ct) bb[ct][h2] = ldg16(bp[ct] + kb + 32 * h2); }
#pragma unroll
            for (int h2 = 0; h2 < 2; ++h2)
#pragma unroll
                for (int rt = 0; rt < 2; ++rt)
#pragma unroll
                    for (int ct = 0; ct < 2; ++ct) acc[rt][ct] = MFMA16(a[rt][h2], bb[ct][h2], acc[rt][ct]);
        }
        if (cmp) {
#pragma unroll
            for (int ct = 0; ct < 2; ++ct) { const int col = 32 * wave + 16 * ct + r; const float bias = B1F[kv * 256 + col];
#pragma unroll
                for (int rt = 0; rt < 2; ++rt)
#pragma unroll
                    for (int i = 0; i < 4; ++i) { const float xg = acc[rt][ct][i] + bias; const float hv = 0.5f * xg * (1.f + tanhf(0.7978845608028654f * (xg + 0.044715f * xg * xg * xg)));
                        *(LAS unsigned short*)(hid + (16 * rt + 4 * kq + i) * 528 + 2 * col) = (unsigned short)f2bf(hv); } }
            __syncthreads();
            { const int rt2 = wave >> 2, ct2 = wave & 3; f32x4 o = {0.f, 0.f, 0.f, 0.f};
              const bf16* w2p = W2T + (size_t)(kv * 64 + 16 * ct2 + r) * 256 + 8 * kq;
#pragma unroll
              for (int ks = 0; ks < 8; ++ks) { const bf16x8 av = *(const LAS bf16x8*)(hid + (16 * rt2 + r) * 528 + 64 * ks + 16 * kq); o = MFMA16(av, ldg16(w2p + 32 * ks), o); }
              const int d = 16 * ct2 + r; const float b2v = (kv ? Ip->v_b2 : Ip->k_b2)[d];
#pragma unroll
              for (int i = 0; i < 4; ++i) { const int nn = n0 + 16 * rt2 + 4 * kq + i; const unsigned short ov = (nn < NCMP) ? (unsigned short)f2bf(o[i] + b2v) : (unsigned short)0;
                  if (kv) VCT[(size_t)(bg * 64 + d) * 512 + nn] = ov; else KCB[(size_t)(bg * 512 + nn) * 64 + d] = ov; } }
            __syncthreads();
        } else {
#pragma unroll
            for (int ct = 0; ct < 2; ++ct) { const int col = 32 * wave + 16 * ct + r;
#pragma unroll
                for (int rt = 0; rt < 2; ++rt)
#pragma unroll
                    for (int i = 0; i < 4; ++i) { const int mrow = m0 + 16 * rt + 4 * kq + i; const unsigned short ov = (unsigned short)f2bf(acc[rt][ct][i]);
                        if (ch == 0) MKB[(size_t)(lay * 512 + mrow) * 256 + col] = ov; else MVT[(size_t)(lay * 256 + col) * 512 + mrow] = ov; } }
        }
    }
}

template <int MODE>
__device__ __forceinline__ void mb2(f32x4& sa, f32x4& sb, int kpos, int tcol, bool colok, bool fast, const BiasCtx& B) {
    if (fast) { if (colok) { sa = sa + B.c31; sb = sb + B.c31; } else { sa = (f32x4){-INFINITY, -INFINITY, -INFINITY, -INFINITY}; sb = sa; } }
    else { maskbias<MODE>(sa, kpos, tcol, colok, B); maskbias<MODE>(sb, kpos + 4, tcol, colok, B); }
}
#define SWZ(row) (((((row) >> 3) & 3) << 1) | (((row) >> 1) & 1))
struct KV1 { KF k; VF v; };
__device__ __forceinline__ void load_kv(KV1& d, const bf16* kb, int kstride, const bf16* vt, int vstride, int key0, int r, int kq) { load_k(d.k, kb, kstride, key0, r, kq); load_vt(d.v, vt, vstride, key0, r, kq); }

template <int MD>
__device__ __forceinline__ void nsa_sweep(LAS unsigned char* STG, const bf16* ksb, const bf16* vst, int jlo, int jhi, int qt, const LAS unsigned* WMw, int wave, int lane, int r, int kq, int qsel, int t0w,
                                          const bf16x8 (&qf)[4][2], const BiasCtx& BC, float (&m)[4], float (&l)[4], f32x4 (&O)[4][4]) {
            const int srow = 8 * wave + (lane >> 3), sch = (lane & 7) ^ SWZ(srow);
            const bf16* ksrc = ksb + (size_t)srow * 512 + 8 * sch; const bf16* vsrc = vst + (size_t)srow * 64 + 8 * sch;
#define NSA_DMA(jb) do { LAS unsigned char* d_ = STG + ((jb) % 3) * 16384 + wave * 1024; \
                __builtin_amdgcn_global_load_lds((const unsigned*)(ksrc + (size_t)(jb) * 64 * 512), (LAS unsigned*)d_, 16, 0, 0); \
                __builtin_amdgcn_global_load_lds((const unsigned*)(vsrc + (size_t)(jb) * 16384), (LAS unsigned*)(d_ + 8192), 16, 0, 0); } while (0)
            NSA_DMA(jlo); if (jhi > jlo) NSA_DMA(jlo + 1);
            if (jhi > jlo) asm volatile("s_waitcnt vmcnt(2)" ::: "memory"); else asm volatile("s_waitcnt vmcnt(0)" ::: "memory");
            __builtin_amdgcn_s_barrier();
            for (int j = jlo; j <= jhi; ++j) {
                const LAS unsigned char* sk = STG + (j % 3) * 16384; const LAS unsigned char* sv = sk + 8192;
                const bool more = (j + 2) <= jhi;
                if (more) NSA_DMA(j + 2);
                unsigned m8 = 0xffu; if (WMw) m8 = (unsigned)__builtin_amdgcn_readfirstlane((int)((WMw[j >> 2] >> (8 * (j & 3))) & 0xffu)); asm volatile("" : "+s"(m8));
                if (m8) {
                    const int dj = qt - j; const int cls = (MD == MD_WIN) ? ((dj >= 1 && dj <= 6) ? BK_MID : BK_GEN) : ((64 * dj - 63 >= 1513) ? BK_FAR : ((dj >= 1 && dj <= 15) ? BK_MID : BK_GEN));
                    KF k0, k1;
                    { const int ka = 8 * (r >> 2) + (r & 3), kb2 = ka + 4, kc = ka + 32, kd = ka + 36;
                      k0.a0 = *(const LAS bf16x8*)(sk + ka * 128 + ((kq ^ SWZ(ka)) << 4)); k0.a1 = *(const LAS bf16x8*)(sk + ka * 128 + (((4 + kq) ^ SWZ(ka)) << 4));
                      k0.b0 = *(const LAS bf16x8*)(sk + kb2 * 128 + ((kq ^ SWZ(kb2)) << 4)); k0.b1 = *(const LAS bf16x8*)(sk + kb2 * 128 + (((4 + kq) ^ SWZ(kb2)) << 4));
                      k1.a0 = *(const LAS bf16x8*)(sk + kc * 128 + ((kq ^ SWZ(kc)) << 4)); k1.a1 = *(const LAS bf16x8*)(sk + kc * 128 + (((4 + kq) ^ SWZ(kc)) << 4));
                      k1.b0 = *(const LAS bf16x8*)(sk + kd * 128 + ((kq ^ SWZ(kd)) << 4)); k1.b1 = *(const LAS bf16x8*)(sk + kd * 128 + (((4 + kq) ^ SWZ(kd)) << 4)); }
#pragma unroll
                    for (int p = 0; p < 4; ++p) if (m8 & (3u << (2 * p))) {
                        bf16x8 pf0, pf1;
                        step64<MD>(k0, k1, qf[p], cls, 64 * j + 8 * kq, t0w + 2 * p + qsel, ((m8 >> (2 * p + qsel)) & 1u) != 0u, BC, m[p], l[p], O[p], pf0, pf1);
#pragma unroll
                        for (int h2 = 0; h2 < 2; ++h2) { VF v;
#pragma unroll
                            for (int dt = 0; dt < 4; ++dt) { const int dd = 16 * dt + r; v.v[dt] = *(const LAS bf16x8*)(sv + dd * 128 + (((4 * h2 + kq) ^ SWZ(dd)) << 4)); }
                            pv(O[p], v, h2 ? pf1 : pf0); }
                        __builtin_amdgcn_sched_barrier(0); }
                }
                if (more) asm volatile("s_waitcnt vmcnt(2) lgkmcnt(0)" ::: "memory"); else asm volatile("s_waitcnt vmcnt(0) lgkmcnt(0)" ::: "memory");
                __builtin_amdgcn_s_barrier();
            }
#undef NSA_DMA
}
__device__ __forceinline__ void p3_nsa_mfma(Frame& F, const In& I, unsigned char* ws) {
    OPAQUE_TID(); KARGS(); const int wave = __builtin_amdgcn_readfirstlane(tid_ >> 6);
    LAS float* b12 = (LAS float*)(F.lds + TAB_B12);
    LAS float* OUTf = (LAS float*)(F.lds + NSA_OUT); LAS float* OUTw = OUTf + wave * 3072;
    LAS float* PSw = (LAS float*)(F.lds + NSA_PSQ) + wave * 1024;
    LAS unsigned char* STG = F.lds + NSA_PSQ;
    LAS unsigned* WMw = (LAS unsigned*)(F.lds + NSA_ST) + wave * 32;
    for (int i = tid_; i < 512; i += NWAVES * 64) b12[i] = ((i & 15) < 12) ? Ip->rel_bias[(i >> 4) * 12 + (i & 15)] * LOG2E : 0.f;
    LAS unsigned short* TB = (LAS unsigned short*)(F.lds + NSA_TB);
    { const int gg = (int)blockIdx.x & 1;
      for (int i = tid_; i < 6144; i += NWAVES * 64) { const int dd = i / 6, hh = i % 6; TB[i] = (unsigned short)f2bf(Ip->rel_bias[rel_bucket(dd) * 12 + gg * 6 + hh] * LOG2E); } }
    __syncthreads();
    const bf16* Q0 = (const bf16*)(ws + WS_Q0); const bf16* KV0 = (const bf16*)(ws + WS_KV0); const bf16* QM = (const bf16*)(ws + WS_QM); const bf16* G0 = (const bf16*)(ws + WS_G0);
    const bf16* VT = (const bf16*)(ws + WS_VT); const bf16* KCB = (const bf16*)(ws + WS_KCB); const bf16* VCT = (const bf16*)(ws + WS_VCT);
    const bf16* MKB = (const bf16*)(ws + WS_MKB); const bf16* MVT = (const bf16*)(ws + WS_MVT);
    bf16* CAT = (bf16*)(ws + WS_CAT);
    const int nun = 4 * 128;
    for (int ui = blockIdx.x; ui < nun; ui += F.G) {
        int tl_ = tid_; asm volatile("" : "+v"(tl_));
        const int lane = tl_ & 63, n = lane & 15, kq = lane >> 4, r = n, hd = n & 7, qsel = n >> 3; const bool colv = hd < 6;
        int bg, qt;
        bg = blockIdx.x & 3;
        if (F.G == 256) { const int idx = blockIdx.x >> 2; qt = (ui < 256) ? idx : 127 - idx; }
        else { qt = ui >> 2; if ((ui & 3) != bg) continue; }
        const int b = bg >> 1, g = bg & 1, t0w = 64 * qt + 8 * wave, rowb = b * T;
        const int habs = g * 6 + (colv ? hd : 0);
        const LAS float* b12c = b12 + habs; const BiasCtx BC{TB + (colv ? hd : 0), b12c[29 * 16] - b12c[30 * 16], b12c[30 * 16] - b12c[31 * 16], b12c[31 * 16]};

        bf16x8 qf[4][2];
#pragma unroll
        for (int p = 0; p < 4; ++p) { const bf16* qp = Q0 + (size_t)(rowb + t0w + 2 * p + qsel) * 768 + habs * 64 + 8 * kq;
#pragma unroll
            for (int ks = 0; ks < 2; ++ks) { bf16x8 v = ldg16(qp + 32 * ks); if (!colv) v = (bf16x8){0, 0, 0, 0, 0, 0, 0, 0}; qf[p][ks] = v; } }
        for (int i = lane; i < 1024; i += 64) PSw[i] = 0.f;
        float m[4], l[4]; f32x4 O[4][4];
        const int ncmax = (t0w + 7 >= 31) ? ((t0w + 7 - 31) / 16 + 1) : 0;
        const bf16* kcb = KCB + (size_t)(bg * 512) * 64; const bf16* vct = VCT + (size_t)(bg * 64) * 512;
#pragma unroll
        for (int p = 0; p < 4; ++p) { m[p] = -1e30f; l[p] = 0.f; }
        if (ncmax > 0) {
            int r_ = r, kq_ = kq; asm volatile("" : "+v"(r_), "+v"(kq_));
            for (int key0 = 0; key0 < ncmax; key0 += 32) {
                asm volatile("" : "+v"(r_), "+v"(kq_));
                KF kA; load_k(kA, kcb, 64, key0, r_, kq_);
                const bool fast = (t0w - 31 - 16 * (key0 + 31)) >= 1513;
#pragma unroll
                for (int p = 0; p < 4; ++p) { f32x4 sa, sb; qk(sa, sb, kA, qf[p]); const int tcol = t0w + 2 * p + qsel;
                    mb2<MD_CMP>(sa, sb, key0 + 8 * kq_, tcol, true, fast, BC);
                    const float mn = fmaxf(m[p], colmax(sa, sb)); float sum = 0.f;
#pragma unroll
                    for (int i = 0; i < 4; ++i) sum += __builtin_amdgcn_exp2f(sa[i] - mn) + __builtin_amdgcn_exp2f(sb[i] - mn);
                    l[p] = l[p] * __builtin_amdgcn_exp2f(m[p] - mn) + sum; m[p] = mn; __builtin_amdgcn_sched_barrier(0); }
            }
        }
        float invl[4];
#pragma unroll
        for (int p = 0; p < 4; ++p) { const float lt = kqsum(l[p]); invl[p] = lt > 0.f ? 1.f / lt : 0.f; }
#pragma unroll
        for (int p = 0; p < 4; ++p)
#pragma unroll
            for (int dt = 0; dt < 4; ++dt) O[p][dt] = (f32x4){0.f, 0.f, 0.f, 0.f};
        float carry[4] = {0.f, 0.f, 0.f, 0.f};
        if (ncmax > 0) {
            int r_ = r, kq_ = kq; asm volatile("" : "+v"(r_), "+v"(kq_));
            for (int key0 = 0; key0 < ncmax; key0 += 32) {
                asm volatile("" : "+v"(r_), "+v"(kq_));
                KV1 A; load_kv(A, kcb, 64, vct, 512, key0, r_, kq_);
                const bool fast = (t0w - 31 - 16 * (key0 + 31)) >= 1513;
#pragma unroll
                for (int p = 0; p < 4; ++p) { f32x4 sa, sb; qk(sa, sb, A.k, qf[p]); const int tcol = t0w + 2 * p + qsel;
                    mb2<MD_CMP>(sa, sb, key0 + 8 * kq_, tcol, true, fast, BC);
                    f32x4 pa, pb;
#pragma unroll
                    for (int i = 0; i < 4; ++i) { pa[i] = __builtin_amdgcn_exp2f(sa[i] - m[p]) * invl[p]; pb[i] = __builtin_amdgcn_exp2f(sb[i] - m[p]) * invl[p]; }
                    pv(O[p], A.v, pack8(pa, pb));
                    float wA = (pa[0] + pa[1]) + (pa[2] + pa[3]), wB = pa[3] + ((pb[0] + pb[1]) + (pb[2] + pb[3])), wC = pb[3];
                    if (!colv) { wA = 0.f; wB = 0.f; wC = 0.f; }
                    const float up = __shfl(wC, (lane + 48) & 63);
                    const float prevC = (kq == 0) ? carry[p] : up; carry[p] = up;
                    float a0 = wA + prevC, a1 = wB;
                    a0 += __shfl_xor(a0, 1); a1 += __shfl_xor(a1, 1); a0 += __shfl_xor(a0, 2); a1 += __shfl_xor(a1, 2); a0 += __shfl_xor(a0, 4); a1 += __shfl_xor(a1, 4);
                    if (hd == 0) { LAS float* ps = PSw + (2 * p + qsel) * 128 + (key0 >> 2) + 2 * kq; ps[0] = a0; ps[1] = a1; } __builtin_amdgcn_sched_barrier(0); }
            }
        }
        if (ncmax > 0 && ncmax <= 480) {
            const int jn = ((ncmax + 31) >> 5) * 8;
#pragma unroll
            for (int p = 0; p < 4; ++p) { float a0 = carry[p]; a0 += __shfl_xor(a0, 1); a0 += __shfl_xor(a0, 2); a0 += __shfl_xor(a0, 4); if (hd == 0 && kq == 0) PSw[(2 * p + qsel) * 128 + jn] = a0; }
        }
        {
#pragma unroll
            for (int p = 0; p < 4; ++p) { const size_t row = (size_t)(rowb + t0w + 2 * p + qsel);
                const float gz = bf2f(G0[row * 256 + habs * 3 + 0]) + Ip->nsa_gate_b[habs * 3 + 0]; out_add(OUTw, p, n, kq, O[p], 1.f / (1.f + __expf(-gz)), true); }
        }
        for (int i = lane; i < 32; i += 64) WMw[i] = (qt < 16) ? 0xffffffffu : 0u;
        if (qt >= 16) {
            if (lane < 3) { const int j = lane == 0 ? 0 : qt - 2 + lane; atomicOr((unsigned*)&WMw[j >> 2], 0xffu << (8 * (j & 3))); }
            for (int q = 0; q < 8; ++q) {
                float v0 = PSw[q * 128 + lane], v1 = PSw[q * 128 + 64 + lane];
                if (lane < 1 || lane > qt - 2) v0 = -1.f; if (lane + 64 > qt - 2) v1 = -1.f;
                for (int s = 0; s < 13; ++s) { const float mx = wmax64(fmaxf(v0, v1));
                    const unsigned long long b0 = __ballot(v0 == mx); int j;
                    if (b0) { j = __builtin_ctzll(b0); if (lane == j) v0 = -1.f; } else { const unsigned long long b1 = __ballot(v1 == mx); j = __builtin_ctzll(b1); if (lane == j) v1 = -1.f; j += 64; }
                    if (lane == 0) atomicOr((unsigned*)&WMw[j >> 2], 1u << (8 * (j & 3) + q)); }
            }
        }
        const bf16* ksb = KV0 + (size_t)rowb * 512 + 256 + g * 64; const bf16* vst = VT + ((size_t)(rowb >> 6) * 256 + g * 64) * 64;
        __syncthreads();
#pragma unroll 1
        for (int rep_ = 0; rep_ < (PROBE_REP == 1 ? 2 : 1); ++rep_) {
#pragma unroll
            for (int p = 0; p < 4; ++p) { m[p] = -1e30f; l[p] = 0.f;
#pragma unroll
                for (int dt = 0; dt < 4; ++dt) O[p][dt] = (f32x4){0.f, 0.f, 0.f, 0.f}; }
            nsa_sweep<MD_BLK>(STG, ksb, vst, 0, qt, qt, WMw, wave, lane, r, kq, qsel, t0w, qf, BC, m, l, O);
        }
        { int qs2_ = qsel; asm volatile("" : "+v"(qs2_));
#pragma unroll
        for (int p = 0; p < 4; ++p) { const size_t row = (size_t)(rowb + t0w + 2 * p + qs2_);
            const float gz = bf2f(G0[row * 256 + habs * 3 + 1]) + Ip->nsa_gate_b[habs * 3 + 1]; out_add(OUTw, p, n, kq, O[p], (1.f / (1.f + __expf(-gz))) / kqsum(l[p]), false); } }
        const bf16* kwb = KV0 + (size_t)rowb * 512 + 384 + g * 64; const bf16* vwt = VT + ((size_t)(rowb >> 6) * 256 + 128 + g * 64) * 64;
#pragma unroll
        for (int p = 0; p < 4; ++p) { m[p] = -1e30f; l[p] = 0.f;
#pragma unroll
            for (int dt = 0; dt < 4; ++dt) O[p][dt] = (f32x4){0.f, 0.f, 0.f, 0.f}; }
        __syncthreads();
        nsa_sweep<MD_WIN>(STG, kwb, vwt, (qt >= 8) ? qt - 8 : 0, qt, qt, nullptr, wave, lane, r, kq, qsel, t0w, qf, BC, m, l, O);
        if (PROBE_REP == 4) {
#pragma unroll
            for (int p = 0; p < 4; ++p) { m[p] = -1e30f; l[p] = 0.f;
#pragma unroll
                for (int dt = 0; dt < 4; ++dt) O[p][dt] = (f32x4){0.f, 0.f, 0.f, 0.f}; }
            nsa_sweep<MD_WIN>(STG, kwb, vwt, (qt >= 8) ? qt - 8 : 0, qt, qt, nullptr, wave, lane, r, kq, qsel, t0w, qf, BC, m, l, O); }
        { int qs3_ = qsel; asm volatile("" : "+v"(qs3_));
#pragma unroll
        for (int p = 0; p < 4; ++p) { const size_t row = (size_t)(rowb + t0w + 2 * p + qs3_);
            const float gz = bf2f(G0[row * 256 + habs * 3 + 2]) + Ip->nsa_gate_b[habs * 3 + 2]; out_add(OUTw, p, n, kq, O[p], (1.f / (1.f + __expf(-gz))) / kqsum(l[p]), false); } }
        int ln_ = lane; asm volatile("" : "+v"(ln_));
#pragma unroll 1
        for (int i = 0; i < 12; ++i) { const int e = i * 64 + ln_, q = e / 96, c4 = e % 96; const f32x4 v = ((const LAS f32x4*)OUTw)[e];
            *(uint2*)(CAT + (size_t)(rowb + t0w + q) * 1024 + g * 384 + 4 * c4) = make_uint2(pk2(v[0], v[1]), pk2(v[2], v[3])); }
#pragma unroll 1
        for (int h2 = 0; h2 < 2; ++h2) { const int hm = 2 * g + h2;
            bf16x8 qm[2]; { const bf16* qp = QM + (size_t)(rowb + t0w + (n & 7)) * 256 + hm * 64 + 8 * kq; qm[0] = ldg16(qp); qm[1] = ldg16(qp + 32); if (n >= 8) { qm[0] = (bf16x8){0, 0, 0, 0, 0, 0, 0, 0}; qm[1] = qm[0]; } }
            float mm = -1e30f, ll = 0.f; f32x4 Om[4];
#pragma unroll
            for (int dt = 0; dt < 4; ++dt) Om[dt] = (f32x4){0.f, 0.f, 0.f, 0.f};
            const bf16* mk = MKB + (size_t)(b * 256) * 256 + hm * 64; const bf16* mvt = MVT + (size_t)(hm * 64) * 512 + b * 256;
            int r_ = r, kq_ = kq; asm volatile("" : "+v"(r_), "+v"(kq_));
            KV1 A; load_kv(A, mk, 256, mvt, 512, 0, r_, kq_);
            for (int key0 = 0; key0 < 256; key0 += 32) { asm volatile("" : "+v"(r_), "+v"(kq_));
                KV1 B; load_kv(B, mk, 256, mvt, 512, (key0 + 32 < 256) ? key0 + 32 : key0, r_, kq_);
                f32x4 sa, sb; qk(sa, sb, A.k, qm); pv(Om, A.v, sm_update(sa, sb, mm, ll, Om)); A = B; }
            const float il = 1.f / kqsum(ll);
            if (n < 8) { bf16* op = CAT + (size_t)(rowb + t0w + n) * 1024 + 768 + hm * 64 + 4 * kq;
#pragma unroll
                for (int dt = 0; dt < 4; ++dt) *(uint2*)(op + 16 * dt) = make_uint2(pk2(Om[dt][0] * il, Om[dt][1] * il), pk2(Om[dt][2] * il, Om[dt][3] * il)); }
        }
    }
}

__device__ __forceinline__ void p10_dsa_norm(Frame& F, const In& I, unsigned char* ws) {
    OPAQUE_TID(); KARGS(); const int gw = F.vcu * NWAVES + (tid_ >> 6), NGW = F.G * NWAVES, lane = tid_ & 63;
    const bf16* PR = (const bf16*)(ws + WS_PROJ1); bf16* CQ = (bf16*)(ws + WS_CQ); bf16* CKV = (bf16*)(ws + WS_CKV); bf16* KIDX = (bf16*)(ws + WS_KIDX); float* WIDX = (float*)(ws + WS_WIDX);
    for (int m = gw; m < M; m += NGW) {
        const bf16* pr = PR + (size_t)m * 768;
        float a[4]; ld4bf(pr + 4 * lane, a);
        float s = wave_sum(a[0] * a[0] + a[1] * a[1] + a[2] * a[2] + a[3] * a[3]); float r = rsqrtf(s * (1.f / 256.f) + EPSF);
        const float4 gq = *(const float4*)(Ip->q_norm + 4 * lane);
        *(uint2*)(CQ + (size_t)m * 256 + 4 * lane) = make_uint2(pk2((a[0] * r) * gq.x, (a[1] * r) * gq.y), pk2((a[2] * r) * gq.z, (a[3] * r) * gq.w));
        const unsigned u = *(const unsigned*)(pr + 256 + 2 * lane); const float c0 = bflo(u), c1 = bfhi(u);
        s = wave_sum(c0 * c0 + c1 * c1); r = rsqrtf(s * (1.f / 128.f) + EPSF);
        *(unsigned*)(CKV + (size_t)m * 128 + 2 * lane) = pk2((c0 * r) * Ip->kv_norm[2 * lane], (c1 * r) * Ip->kv_norm[2 * lane + 1]);
        const float k0 = bf2f(pr[384 + lane]);
        s = wave_sum(k0 * k0); r = rsqrtf(s * (1.f / 64.f) + EPSF);
        { const int tk = m >> 5, key = m & 31, ks = lane >> 4, hf = (lane >> 3) & 1, jj = lane & 7;
          KIDX[((size_t)(tk * 4 + ks) * 64 + hf * 32 + key) * 8 + jj] = (bf16)f2bf((k0 * r) * Ip->kidx_norm[lane]); }
        if (lane < 8) WIDX[(size_t)m * 8 + lane] = bf2f(pr[448 + lane]) * (0.35355339059327373f * 0.125f);
    }
}

#define MFMA32(A, B, C) __builtin_amdgcn_mfma_f32_32x32x16_bf16((A), (B), (C), 0, 0, 0)
typedef float f32x16 __attribute__((ext_vector_type(16)));
constexpr int XL_OFF = RING_BYTES;
constexpr int IDX_HIST = XL_OFF, IDX_CAND = XL_OFF + 16384, IDX_MM = XL_OFF + 24576, IDX_STQ = IDX_MM + 256, IDX_MM2 = IDX_STQ + 256, IDX_CAP = 1024;
static_assert(IDX_MM2 + 64 <= LDSCTL_OFF, "LDS map (indexer)");
__device__ __forceinline__ float wmin64(float v) {
#pragma unroll
    for (int o = 1; o < 64; o <<= 1) v = fminf(v, __shfl_xor(v, o));
    return v;
}
__device__ __forceinline__ void p12_index_mfma(Frame& F, const In& I, unsigned char* ws) {
    OPAQUE_TID(); KARGS(); const int lane = tid_ & 63, wave = __builtin_amdgcn_readfirstlane(tid_ >> 6), key = lane & 31, half = lane >> 5;
    LAS float* SC = (LAS float*)(F.lds + RING_OFF);
    LAS float* MMw = (LAS float*)(F.lds + IDX_MM);
    const bf16* QI = (const bf16*)(ws + WS_QI); const bf16* KIDX = (const bf16*)(ws + WS_KIDX); const float* WIDX = (const float*)(ws + WS_WIDX);
    unsigned short* SEL = (unsigned short*)(ws + WS_SEL); int* CNT = (int*)(ws + WS_CNT);
    const int NG = M / 4, per = (NG + F.G - 1) / F.G;
    for (int j = 0; j < per; ++j) {
        const int u = j * F.G + ((j & 1) ? (F.G - 1 - (int)blockIdx.x) : (int)blockIdx.x);
        if (u >= NG) break;
        const int gi = (u & 1) * (NG / 2) + (u >> 1);
        const int row0 = 4 * gi, b = row0 / T, t0 = row0 % T, rowb = b * T;
        if (t0 < 256) {
            if (wave < 4) { const int t = t0 + wave; unsigned short* so = SEL + (size_t)(row0 + wave) * 256;
#pragma unroll
                for (int i = 0; i < 4; ++i) { const int s = lane + 64 * i; so[s] = (unsigned short)(s <= t ? s : 0); }
                if (lane == 0) CNT[row0 + wave] = t + 1; }
            continue;
        }
        {
            const int rho = lane & 31, a = rho >> 2, qA = ((a >> 2) & 1) + 2 * (a & 1), hdA = 4 * ((a >> 1) & 1) + (rho & 3);
            bf16x8 qa[4];
#pragma unroll
            for (int ks = 0; ks < 4; ++ks) qa[ks] = ldg16(QI + (size_t)(row0 + qA) * 512 + hdA * 64 + 16 * ks + 8 * half);
            float w0[8], w1[8];
            { const float4 x0 = *(const float4*)(WIDX + (size_t)(row0 + 2 * half) * 8), x1 = *(const float4*)(WIDX + (size_t)(row0 + 2 * half) * 8 + 4);
              const float4 y0 = *(const float4*)(WIDX + (size_t)(row0 + 2 * half + 1) * 8), y1 = *(const float4*)(WIDX + (size_t)(row0 + 2 * half + 1) * 8 + 4);
              w0[0] = x0.x; w0[1] = x0.y; w0[2] = x0.z; w0[3] = x0.w; w0[4] = x1.x; w0[5] = x1.y; w0[6] = x1.z; w0[7] = x1.w;
              w1[0] = y0.x; w1[1] = y0.y; w1[2] = y0.z; w1[3] = y0.w; w1[4] = y1.x; w1[5] = y1.y; w1[6] = y1.z; w1[7] = y1.w; }
            const int tq0 = t0 + 2 * half, tq1 = tq0 + 1, nt = (t0 + 3) / 32 + 1;
            float mn0 = INFINITY, mx0 = -INFINITY, mn1 = INFINITY, mx1 = -INFINITY;
            const bf16* kpb = KIDX + (size_t)(rowb >> 5) * 2048 + (size_t)lane * 8;
            const int ntw = (nt - wave + NWAVES - 1) / NWAVES;
#define IDX_LOAD(dst, i) do { const int tl2_ = wave + NWAVES * ((i) < ntw ? (i) : (ntw > 0 ? ntw - 1 : 0)); const bf16* kp_ = kpb + (size_t)tl2_ * 2048; \
                _Pragma("unroll") for (int ks = 0; ks < 4; ++ks) dst[ks] = ldg16(kp_ + 512 * ks); } while (0)
#define IDX_COMP(src, i) do { if ((i) < ntw) { const int kpos = 32 * (wave + NWAVES * (i)) + key; \
                f32x16 c = {0.f, 0.f, 0.f, 0.f, 0.f, 0.f, 0.f, 0.f, 0.f, 0.f, 0.f, 0.f, 0.f, 0.f, 0.f, 0.f}; \
                _Pragma("unroll") for (int ks = 0; ks < 4; ++ks) c = MFMA32(qa[ks], src[ks], c); \
                float s0 = 0.f, s1 = 0.f; \
                _Pragma("unroll") for (int h = 0; h < 8; ++h) { s0 += fmaxf(c[h], 0.f) * w0[h]; s1 += fmaxf(c[8 + h], 0.f) * w1[h]; } \
                s0 += 0.f; s1 += 0.f; \
                const bool ok0 = kpos <= tq0, ok1 = kpos <= tq1; \
                SC[(2 * half) * 8192 + kpos] = ok0 ? s0 : -INFINITY; SC[(2 * half + 1) * 8192 + kpos] = ok1 ? s1 : -INFINITY; \
                if (ok0) { mn0 = fminf(mn0, s0); mx0 = fmaxf(mx0, s0); } if (ok1) { mn1 = fminf(mn1, s1); mx1 = fmaxf(mx1, s1); } } } while (0)
            for (int prb_ = 0; prb_ < (PROBE_REP == 2 ? 2 : 1); ++prb_)
            if (ntw > 0) {
                bf16x8 kb0[4], kb1[4], kb2[4], kb3[4];
                IDX_LOAD(kb0, 0); IDX_LOAD(kb1, 1); IDX_LOAD(kb2, 2);
                for (int i = 0; i < ntw; i += 4) {
                    IDX_LOAD(kb3, i + 3); IDX_COMP(kb0, i);
                    IDX_LOAD(kb0, i + 4); IDX_COMP(kb1, i + 1);
                    IDX_LOAD(kb1, i + 5); IDX_COMP(kb2, i + 2);
                    IDX_LOAD(kb2, i + 6); IDX_COMP(kb3, i + 3);
                }
            }
#undef IDX_LOAD
#undef IDX_COMP
#pragma unroll
            for (int o = 1; o < 32; o <<= 1) { mn0 = fminf(mn0, __shfl_xor(mn0, o)); mx0 = fmaxf(mx0, __shfl_xor(mx0, o)); mn1 = fminf(mn1, __shfl_xor(mn1, o)); mx1 = fmaxf(mx1, __shfl_xor(mx1, o)); }
            if (key == 0) { LAS float* mm = MMw + (wave * 4 + 2 * half) * 2; mm[0] = mn0; mm[1] = mx0; mm[2] = mn1; mm[3] = mx1; }
        }
        __syncthreads();
        {
            const int q = wave >> 1, hw = wave & 1, t = t0 + q, n = t + 1; const LAS float* sc = SC + q * 8192;
            LAS unsigned* hist = (LAS unsigned*)(F.lds + IDX_HIST) + wave * 512; const LAS unsigned* hist0 = (const LAS unsigned*)(F.lds + IDX_HIST) + (2 * q) * 512;
            LAS unsigned short* cand = (LAS unsigned short*)(F.lds + IDX_CAND) + q * IDX_CAP;
            LAS float* stf = (LAS float*)(F.lds + IDX_STQ) + q * 16; LAS int* sti = (LAS int*)stf;
            LAS float* mm2 = (LAS float*)(F.lds + IDX_MM2) + wave * 2;
            unsigned short* so = SEL + (size_t)(row0 + q) * 256;
            const int nch = (n + 255) >> 8;
            if (hw == 0 && lane == 0) { float lo = INFINITY, hi = -INFINITY;
#pragma unroll
                for (int w = 0; w < 8; ++w) { lo = fminf(lo, MMw[(w * 4 + q) * 2]); hi = fmaxf(hi, MMw[(w * 4 + q) * 2 + 1]); }
                stf[0] = lo; stf[1] = hi; sti[2] = 256; sti[3] = 0; sti[4] = 0; sti[5] = 0; sti[6] = 0; sti[7] = 0; sti[8] = 0; sti[9] = 0; }
            __syncthreads();
            for (int round = 0; round < 64; ++round) {
                const float lo = stf[0], hi = stf[1]; const bool act = sti[8] == 0; const bool eqr = !(hi > lo); const float scale = eqr ? 0.f : 1024.f / (hi - lo);
                if (act && !eqr) {
#pragma unroll
                    for (int i = 0; i < 8; ++i) hist[lane + 64 * i] = 0u;
                    for (int c = hw; c < nch; c += 2) { const int i4 = 256 * c + 4 * lane; const f32x4 v4 = *(const LAS f32x4*)(sc + i4);
#pragma unroll
                        for (int e = 0; e < 4; ++e) { const float v = (i4 + e < n) ? v4[e] : -INFINITY;
                            if (v >= lo && v <= hi) { int bb = (int)((v - lo) * scale); bb = bb > 1023 ? 1023 : bb; atomicAdd((unsigned*)&hist[bb >> 1], 1u << (16 * (bb & 1))); } } }
                }
                __syncthreads();
                if (hw == 0 && act) {
                    if (eqr) { if (lane == 0) { sti[8] = 1; sti[9] = 1; } }
                    else {
                        const int krem = sti[2];
                        unsigned cw[8], c0w[8]; unsigned S = 0u, S0 = 0u;
#pragma unroll
                        for (int i = 0; i < 8; ++i) { c0w[i] = hist0[8 * lane + i]; cw[i] = c0w[i] + hist0[512 + 8 * lane + i]; S += (cw[i] & 0xffffu) + (cw[i] >> 16); S0 += (c0w[i] & 0xffffu) + (c0w[i] >> 16); }
                        unsigned x = S, x0 = S0;
#pragma unroll
                        for (int o = 1; o < 64; o <<= 1) { const unsigned y = __shfl_down(x, o), y0 = __shfl_down(x0, o); if (lane + o < 64) { x += y; x0 += y0; } }
                        const unsigned above = x - S; unsigned acc0 = x0 - S0;
                        const bool found = (above < (unsigned)krem) && ((unsigned)krem <= above + S);
                        const int fl = __builtin_ctzll(__ballot(found));
                        int bs = 0; unsigned acc = above, cb = 0u, cb0 = 0u;
                        { bool done = false;
#pragma unroll
                          for (int i = 15; i >= 0; --i) { const unsigned cnt_ = (i & 1) ? (cw[i >> 1] >> 16) : (cw[i >> 1] & 0xffffu), cnt0_ = (i & 1) ? (c0w[i >> 1] >> 16) : (c0w[i >> 1] & 0xffffu);
                              if (!done) { if (acc + cnt_ >= (unsigned)krem) { bs = 16 * lane + i; cb = cnt_; cb0 = cnt0_; done = true; } else { acc += cnt_; acc0 += cnt0_; } } } }
                        if (lane == fl) { sti[2] = krem - (int)acc; sti[3] += (int)acc0; sti[4] += (int)acc; sti[5] = bs; sti[6] = (int)cb0; sti[7] = (int)cb; sti[8] = ((int)cb <= IDX_CAP) ? 1 : 0; }
                    }
                }
                __syncthreads();
                const LAS int* stall = (const LAS int*)(F.lds + IDX_STQ);
                if (stall[8] && stall[16 + 8] && stall[32 + 8] && stall[48 + 8]) break;
                float nlo = INFINITY, nhi = -INFINITY;
                if (sti[8] == 0) { const int bstar = sti[5];
                    for (int c = hw; c < nch; c += 2) { const int i4 = 256 * c + 4 * lane; const f32x4 v4 = *(const LAS f32x4*)(sc + i4);
#pragma unroll
                        for (int e = 0; e < 4; ++e) { const float v = (i4 + e < n) ? v4[e] : -INFINITY;
                            if (v >= lo && v <= hi) { int bb = (int)((v - lo) * scale); bb = bb > 1023 ? 1023 : bb; if (bb == bstar) { nlo = fminf(nlo, v); nhi = fmaxf(nhi, v); } } } } }
                nlo = wmin64(nlo); nhi = wmax64(nhi);
                if (lane == 0) { mm2[0] = nlo; mm2[1] = nhi; }
                __syncthreads();
                if (hw == 0 && lane == 0 && sti[8] == 0) { stf[0] = fminf(mm2[0], mm2[2]); stf[1] = fmaxf(mm2[1], mm2[3]); }
                __syncthreads();
            }
            { const float lo = stf[0], hi = stf[1]; const bool eq = sti[9] != 0; const float scale = eq ? 0.f : 1024.f / (hi - lo);
              const int krem = sti[2], A0 = sti[3], AT = sti[4], bstar = sti[5], C0 = sti[6], ncand = sti[7], nabove = 256 - krem;
              int bsel = hw ? A0 : 0, bcand = hw ? C0 : 0; (void)AT;
              const int cstep = eq ? 1 : 2;
              if (!(eq && hw)) for (int c = eq ? 0 : hw; c < nch; c += cstep) { const int i4 = 256 * c + 4 * lane; const f32x4 v4 = *(const LAS f32x4*)(sc + i4);
#pragma unroll
                  for (int e = 0; e < 4; ++e) { const int idx = i4 + e; const float v = (idx < n) ? v4[e] : -INFINITY;
                      bool sel, cnd;
                      if (eq) { sel = v > hi; cnd = (v == hi); }
                      else { const bool in = (v >= lo && v <= hi); int bb = (int)((v - lo) * scale); bb = bb > 1023 ? 1023 : bb; sel = (v > hi) || (in && bb > bstar); cnd = in && bb == bstar; }
                      const unsigned long long ms = __ballot(sel), mc = __ballot(cnd), lt = (1ull << lane) - 1ull;
                      if (sel) so[bsel + __builtin_popcountll(ms & lt)] = (unsigned short)idx;
                      if (cnd) { const int pc = bcand + __builtin_popcountll(mc & lt);
                          if (eq) { if (pc < krem) so[nabove + pc] = (unsigned short)idx; } else if (pc < IDX_CAP) cand[pc] = (unsigned short)idx; }
                      bsel += __builtin_popcountll(ms); bcand += __builtin_popcountll(mc); } }
              __syncthreads();
              if (!eq) {
                  for (int i = 64 * hw + lane; i < ncand; i += 128) { const int ii = cand[i]; const float vi = sc[ii]; int rank = 0;
                      for (int jj = 0; jj < ncand; ++jj) { const int ij = cand[jj]; const float vj = sc[ij]; rank += ((vj > vi) || (vj == vi && ij < ii)) ? 1 : 0; }
                      if (rank < krem) so[nabove + rank] = (unsigned short)ii; }
              }
              if (hw == 0 && lane == 0) CNT[row0 + q] = 256; }
        }
        __syncthreads();
    }
}

__device__ __forceinline__ unsigned offb(unsigned row, unsigned ch) { return 256u * row + 16u * (ch ^ (((row & 3u) << 2) | ((row >> 2) & 3u))); }
typedef short v4i16_t __attribute__((ext_vector_type(4)));
__device__ __forceinline__ v4i16_t trrd(const LAS unsigned char* p) { return __builtin_amdgcn_ds_read_tr16_b64_v4i16((LAS v4i16_t*)p); }
__device__ __forceinline__ void p13_dsa_mfma(Frame& F, const In& I, unsigned char* ws) {
    OPAQUE_TID(); KARGS(); const int lane = tid_ & 63, wave = __builtin_amdgcn_readfirstlane(tid_ >> 6), n = lane & 15, kq = lane >> 4;
    LAS unsigned char* bkt = F.lds + TAB_BKT; LAS float* b12 = (LAS float*)(F.lds + TAB_B12);
    for (int i = tid_; i < 1536; i += NWAVES * 64) bkt[i] = (unsigned char)rel_bucket(i);
    for (int i = tid_; i < 512; i += NWAVES * 64) b12[i] = ((i & 15) < 12) ? Ip->rel_bias[(i >> 4) * 12 + (i & 15)] * LOG2E : 0.f;
    __syncthreads();
    LAS unsigned char* imgb = F.lds + RING_OFF + wave * 17408; LAS int* sidx = (LAS int*)(imgb + 16384);
    const bf16* QA = (const bf16*)(ws + WS_QA); const bf16* CKV = (const bf16*)(ws + WS_CKV); const bf16* PR = (const bf16*)(ws + WS_PROJ1);
    const unsigned short* SEL = (const unsigned short*)(ws + WS_SEL); const int* CNT = (const int*)(ws + WS_CNT);
    const bf16* MKB = (const bf16*)(ws + WS_MKB) + (size_t)512 * 256; const bf16* MVT = (const bf16*)(ws + WS_MVT) + (size_t)256 * 512;
    bf16* CAT1 = (bf16*)(ws + WS_CAT1);
    const int gw = blockIdx.x * NWAVES + wave, NGW = F.G * NWAVES;
    const LAS float* b12c = b12 + (n < 12 ? n : 0);
    for (int row = gw; row < M; row += NGW) {
        const int b = row / T, t = row % T, rowb = b * T, cnt = __builtin_amdgcn_readfirstlane(CNT[row]);
        asm volatile("s_waitcnt lgkmcnt(0)" ::: "memory");
#pragma unroll
        for (int i = 0; i < 4; ++i) sidx[lane + 64 * i] = (int)SEL[(size_t)row * 256 + lane + 64 * i];
        bf16x8 qf[4];
#pragma unroll
        for (int ks = 0; ks < 4; ++ks) { bf16x8 v = ldg16(QA + (size_t)row * 1536 + (n < 12 ? n : 0) * 128 + 32 * ks + 8 * kq); if (n >= 12) v = (bf16x8){0, 0, 0, 0, 0, 0, 0, 0}; qf[ks] = v; }
        float m = -1e30f, l = 0.f; f32x4 O[8];
#pragma unroll
        for (int rt = 0; rt < 8; ++rt) O[rt] = (f32x4){0.f, 0.f, 0.f, 0.f};
#define DSA_GATHER(c0_, buf_) do { int ln2_ = lane; asm volatile("" : "+v"(ln2_)); \
            _Pragma("unroll") for (int i = 0; i < 8; ++i) { const int rr = 4 * i + (ln2_ >> 4), pos = ln2_ & 15, e = (c0_) + rr; const int kidx = sidx[e < cnt ? e : 0]; \
                const unsigned chs = (unsigned)pos ^ ((((unsigned)rr & 3u) << 2) | (((unsigned)rr >> 2) & 3u)); \
                __builtin_amdgcn_global_load_lds((const unsigned*)(CKV + (size_t)(rowb + kidx) * 128 + 8 * chs), (LAS unsigned*)(imgb + (buf_) * 8192 + i * 1024), 16, 0, 0); } } while (0)
        asm volatile("s_waitcnt lgkmcnt(0)" ::: "memory");
        DSA_GATHER(0, 0);
        for (int c0 = 0; c0 < cnt; c0 += 32) {
            const int cb = (c0 >> 5) & 1; LAS unsigned char* img = imgb + cb * 8192;
            if (c0 + 32 < cnt) { DSA_GATHER(c0 + 32, cb ^ 1); asm volatile("s_waitcnt vmcnt(8)" ::: "memory"); } else asm volatile("s_waitcnt vmcnt(0)" ::: "memory");
            int ln_ = lane; asm volatile("" : "+v"(ln_));
            f32x4 sa = {0.f, 0.f, 0.f, 0.f}, sb = {0.f, 0.f, 0.f, 0.f};
            { const unsigned ra = 8u * ((unsigned)(ln_ & 15) >> 2) + ((unsigned)ln_ & 3u), kq_ = (unsigned)ln_ >> 4;
#pragma unroll
              for (int s = 0; s < 4; ++s) { const bf16x8 ka = *(const LAS bf16x8*)(img + offb(ra, 4 * s + kq_)); const bf16x8 kb = *(const LAS bf16x8*)(img + offb(ra + 4, 4 * s + kq_));
                  sa = MFMA16(ka, qf[s], sa); sb = MFMA16(kb, qf[s], sb); } }
#pragma unroll
            for (int i = 0; i < 4; ++i) { const int ea = c0 + 8 * kq + i, eb = ea + 4;
                { const int d = t - sidx[ea < cnt ? ea : 0]; const int dc = d > 1535 ? 1535 : (d < 0 ? 0 : d); sa[i] = (ea < cnt) ? sa[i] + b12c[(int)bkt[dc] * 16] : -INFINITY; }
                { const int d = t - sidx[eb < cnt ? eb : 0]; const int dc = d > 1535 ? 1535 : (d < 0 ? 0 : d); sb[i] = (eb < cnt) ? sb[i] + b12c[(int)bkt[dc] * 16] : -INFINITY; } }
            const float mnw = fmaxf(m, colmax(sa, sb)); const float al = __builtin_amdgcn_exp2f(m - mnw); m = mnw;
            f32x4 pa, pb; float sum = 0.f;
#pragma unroll
            for (int i = 0; i < 4; ++i) { pa[i] = __builtin_amdgcn_exp2f(sa[i] - mnw); pb[i] = __builtin_amdgcn_exp2f(sb[i] - mnw); sum += pa[i] + pb[i]; }
            l = l * al + sum;
            const bf16x8 pf = pack8(pa, pb);
            { const unsigned g_ = (unsigned)ln_ >> 4, q_ = ((unsigned)ln_ & 15u) >> 2, p_ = (unsigned)ln_ & 3u;
#pragma unroll
              for (int rt = 0; rt < 8; ++rt) { const v4i16_t x0 = trrd(img + offb(8 * g_ + q_, 2 * rt + (p_ >> 1)) + 8 * (p_ & 1)), x1 = trrd(img + offb(8 * g_ + 4 + q_, 2 * rt + (p_ >> 1)) + 8 * (p_ & 1));
                  const bf16x8 vf = {x0[0], x0[1], x0[2], x0[3], x1[0], x1[1], x1[2], x1[3]};
                  O[rt] = MFMA16(vf, pf, O[rt] * al); } }
        }
#undef DSA_GATHER
        const float il = 1.f / kqsum(l);
        if (n < 12) { bf16* op = CAT1 + (size_t)row * 1792 + n * 128 + 4 * kq;
#pragma unroll
            for (int rt = 0; rt < 8; ++rt) *(uint2*)(op + 16 * rt) = make_uint2(pk2(O[rt][0] * il, O[rt][1] * il), pk2(O[rt][2] * il, O[rt][3] * il)); }
    }
    for (int u8 = gw; u8 < M / 8; u8 += NGW) {
        const int row0 = 8 * u8, b = row0 / T; const int r = n;
#pragma unroll 1
        for (int hm = 0; hm < 4; ++hm) {
            bf16x8 qm[2]; { const bf16* qp = PR + (size_t)(row0 + (n & 7)) * 768 + 456 + hm * 64 + 8 * kq; qm[0] = ldg16(qp); qm[1] = ldg16(qp + 32); if (n >= 8) { qm[0] = (bf16x8){0, 0, 0, 0, 0, 0, 0, 0}; qm[1] = qm[0]; } }
            float mm = -1e30f, ll = 0.f; f32x4 Om[4];
#pragma unroll
            for (int dt = 0; dt < 4; ++dt) Om[dt] = (f32x4){0.f, 0.f, 0.f, 0.f};
            const bf16* mk = MKB + (size_t)(b * 256) * 256 + hm * 64; const bf16* mvt = MVT + (size_t)(hm * 64) * 512 + b * 256;
            for (int key0 = 0; key0 < 256; key0 += 32) { int r_ = r, kq_ = kq; asm volatile("" : "+v"(r_), "+v"(kq_)); KF k; load_k(k, mk, 256, key0, r_, kq_); VF v; load_vt(v, mvt, 512, key0, r_, kq_);
                f32x4 sa, sb; qk(sa, sb, k, qm); sa = sa * (0.125f * LOG2E); sb = sb * (0.125f * LOG2E); pv(Om, v, sm_update(sa, sb, mm, ll, Om)); }
            const float il = 1.f / kqsum(ll);
            if (n < 8) { bf16* op = CAT1 + (size_t)(row0 + n) * 1792 + 1536 + hm * 64 + 4 * kq;
#pragma unroll
                for (int dt = 0; dt < 4; ++dt) *(uint2*)(op + 16 * dt) = make_uint2(pk2(Om[dt][0] * il, Om[dt][1] * il), pk2(Om[dt][2] * il, Om[dt][3] * il)); }
        }
    }
}

struct Args { In in; float* out; unsigned char* ws; int ph_lo, ph_hi; };
__global__ void __launch_bounds__(NWAVES * 64, 2) mk_fwd(Args args) {
    extern __shared__ __attribute__((aligned(16))) unsigned char lds[];
    Frame F;
    F.lds = (LAS unsigned char*)lds; F.MISC = (volatile LAS unsigned*)(F.lds + MISC_OFF);
    F.G = gridDim.x; { const int bx = blockIdx.x; F.vcu = (F.G % 8 == 0) ? (bx % 8) * (F.G / 8) + bx / 8 : bx; }
    unsigned char* ws = args.ws; const In& I = args.in; float* out = args.out; (void)I;
    F.ctl = (gu32*)(ws + WS_CTL);
    for (int u = threadIdx.x; u < (LDS_BYTES - LDSCTL_OFF) / 4; u += NWAVES * 64) ((LAS unsigned*)(F.lds + LDSCTL_OFF))[u] = 0u;
    __syncthreads();
    XcdBarrier bar; bar.bar = (unsigned*)(F.ctl + CW_BAR); bar.x = 0; bar.st = nullptr;
    if (!MK_SPLIT) bar = xcd_barrier_post((unsigned*)(F.ctl + CW_BAR), F.MISC + 8);
    const int lo = args.ph_lo, hi = args.ph_hi;
#ifndef PH_MASK
#define PH_MASK 0xFFFFFFFFu
#endif
#define IN(k) ((((PH_MASK) >> ((k) % 32)) & 1u) && lo <= (k) && (k) < hi)
#define SEAM(k) do { if (IN(k) && IN((k) + 1)) xcd_barrier(bar); } while (0)
#define SEAM2(k, kn) do { if (IN(k) && IN(kn)) xcd_barrier(bar); } while (0)
#ifndef REP_MASK
#define REP_MASK 0u
#endif
#define REPS(k) (1 + (int)(((REP_MASK) >> (k)) & 1u))
    bf16* XN = (bf16*)(ws + WS_XN); bf16* CAT = (bf16*)(ws + WS_CAT); bf16* ACT = (bf16*)(ws + WS_ACT);
    float* SSQ = (float*)(ws + WS_CTL + 512 * 1024);

    if (IN(0)) { for (int r_ = 0; r_ < REPS(0); ++r_) { p0_prologue(F, I, ws); if (r_ + 1 < REPS(0)) xcd_barrier(bar); } SEAM(0); }
    {
            if (IN(1)) {
                pg8::Gemm g{XN, (const bf16*)(ws + WS_WIN0), M, 1792, D}; pg8::StaticOrder S; S.init(M, 1792, F.G, (int)blockIdx.x);
                pg8::EpiRoute<0> E{ws, nullptr};
                pg8::gemm_phase<pg8::EpiRoute<0>, pg8::StaticOrder, true, true>(F.lds + RING_OFF, g, S, E);
                pg8::Gemm g2{(const bf16*)(ws + WS_WVT), XN, 256, M, D}; pg8::StaticOrder S2; S2.init(256, M, F.G, (int)((blockIdx.x + 64) % F.G));
                pg8::EpiRoute<3> E2{ws, nullptr};
                pg8::gemm_phase<pg8::EpiRoute<3>, pg8::StaticOrder, true, true>(F.lds + RING_OFF, g2, S2, E2);
                SEAM(1);
            }
            if (IN(2)) { for (int r_ = 0; r_ < REPS(2); ++r_) { p2_mfma(F, I, ws); if (r_ + 1 < REPS(2)) xcd_barrier(bar); } SEAM(2); }
            if (IN(3)) { for (int r_ = 0; r_ < REPS(3); ++r_) { p3_nsa_mfma(F, I, ws); if (r_ + 1 < REPS(3)) xcd_barrier(bar); } SEAM(3); }
    }
    {
        constexpr int L = 0, pb = L ? 14 : 4;
        if (IN(pb)) {
            pg8::Gemm g{L ? (const bf16*)(ws + WS_CAT1) : CAT, L ? (const bf16*)(ws + WS_WO1F) : (const bf16*)(ws + WS_WO), M, D, L ? 1792 : D}; pg8::StaticOrder S; S.init(M, D, F.G, (int)blockIdx.x);
            KARGS(); pg8::EpiResid E{L ? (const float*)out : Ip->x, out, XN, SSQ + (L ? 2 : 0) * M, D, 0};
            pg8::gemm_phase<pg8::EpiResid, pg8::StaticOrder, true, true>(F.lds + RING_OFF, g, S, E);
            SEAM2(pb, pb + 2);
        }
        if (IN(pb + 2)) {
            pg8::Gemm g{XN, (const bf16*)(ws + WS_WGU) + (size_t)L * 2 * DFF * D, M, 2 * DFF, D}; pg8::StaticOrder S; S.init(M, 2 * DFF, F.G, (int)blockIdx.x);
            pg8::EpiSwiglu E{ACT, SSQ + (L ? 2 : 0) * M, DFF, 0};
            pg8::gemm_phase<pg8::EpiSwiglu, pg8::StaticOrder, true, true>(F.lds + RING_OFF, g, S, E);
            SEAM(pb + 2);
        }
        if (IN(pb + 3)) {
            pg8::Gemm g{ACT, (const bf16*)(ws + WS_WD) + (size_t)L * D * DFF, M, D, DFF}; pg8::StaticOrder S; S.init(M, D, F.G, (int)blockIdx.x);
            pg8::EpiResid E{out, out, L ? nullptr : XN, SSQ + (L ? 3 : 1) * M, D, 0};
            pg8::gemm_phase<pg8::EpiResid, pg8::StaticOrder, true, true>(F.lds + RING_OFF, g, S, E);
            SEAM2(pb + 3, L ? 18 : 9);
        }
        }
    {
            if (IN(9)) {
                pg8::Gemm g{XN, (const bf16*)(ws + WS_WIN1), M, 768, D}; pg8::StaticOrder S; S.init(M, 768, F.G, (int)blockIdx.x);
                pg8::EpiRoute<1> E{ws, SSQ + 1 * M};
                pg8::gemm_phase<pg8::EpiRoute<1>, pg8::StaticOrder, true, true>(F.lds + RING_OFF, g, S, E);
                SEAM(9);
            }
            if (IN(10)) { p10_dsa_norm(F, I, ws); SEAM(10); }
            if (IN(11)) {
                pg8::Gemm g{(const bf16*)(ws + WS_CQ), (const bf16*)(ws + WS_WQ2), M, 2048, 256}; pg8::StaticOrder S; S.init(M, 2048, F.G, (int)blockIdx.x);
                pg8::EpiRoute<2> E{ws, nullptr};
                pg8::gemm_phase<pg8::EpiRoute<2>, pg8::StaticOrder, true, true>(F.lds + RING_OFF, g, S, E);
                SEAM(11);
            }
            if (IN(12)) { for (int r_ = 0; r_ < REPS(12); ++r_) { p12_index_mfma(F, I, ws); if (r_ + 1 < REPS(12)) xcd_barrier(bar); } SEAM(12); }
            if (IN(13)) { for (int r_ = 0; r_ < REPS(13); ++r_) { p13_dsa_mfma(F, I, ws); if (r_ + 1 < REPS(13)) xcd_barrier(bar); } SEAM(13); }
            }
    {
        constexpr int L = 1, pb = L ? 14 : 4;
        if (IN(pb)) {
            pg8::Gemm g{L ? (const bf16*)(ws + WS_CAT1) : CAT, L ? (const bf16*)(ws + WS_WO1F) : (const bf16*)(ws + WS_WO), M, D, L ? 1792 : D}; pg8::StaticOrder S; S.init(M, D, F.G, (int)blockIdx.x);
            KARGS(); pg8::EpiResid E{L ? (const float*)out : Ip->x, out, XN, SSQ + (L ? 2 : 0) * M, D, 0};
            pg8::gemm_phase<pg8::EpiResid, pg8::StaticOrder, true, true>(F.lds + RING_OFF, g, S, E);
            SEAM2(pb, pb + 2);
        }
        if (IN(pb + 2)) {
            pg8::Gemm g{XN, (const bf16*)(ws + WS_WGU) + (size_t)L * 2 * DFF * D, M, 2 * DFF, D}; pg8::StaticOrder S; S.init(M, 2 * DFF, F.G, (int)blockIdx.x);
            pg8::EpiSwiglu E{ACT, SSQ + (L ? 2 : 0) * M, DFF, 0};
            pg8::gemm_phase<pg8::EpiSwiglu, pg8::StaticOrder, true, true>(F.lds + RING_OFF, g, S, E);
            SEAM(pb + 2);
        }
        if (IN(pb + 3)) {
            pg8::Gemm g{ACT, (const bf16*)(ws + WS_WD) + (size_t)L * D * DFF, M, D, DFF}; pg8::StaticOrder S; S.init(M, D, F.G, (int)blockIdx.x);
            pg8::EpiResid E{out, out, L ? nullptr : XN, SSQ + (L ? 3 : 1) * M, D, 0};
            pg8::gemm_phase<pg8::EpiResid, pg8::StaticOrder, true, true>(F.lds + RING_OFF, g, S, E);
            SEAM2(pb + 3, L ? 18 : 9);
        }
        }
    if (IN(18)) {
        OPAQUE_TID(); KARGS(); const int lane_ = tid_ & 63;
        const int gw = F.vcu * NWAVES + (tid_ >> 6), NGW = F.G * NWAVES;
        for (int m = gw; m < M; m += NGW) { GAS f32x4* xr = (GAS f32x4*)(out + (size_t)m * D) + lane_; const GAS f32x4* gr = (const GAS f32x4*)Ip->norm_final + lane_;
            const float r = rsqrtf(SSQ[3 * M + m] * (1.f / D) + EPSF);
#pragma unroll
            for (int j = 0; j < 4; ++j) { const f32x4 g = gr[64 * j]; xr[64 * j] = (xr[64 * j] * r) * g; } }
    }
#undef IN
#undef SEAM
}

extern "C" void kernel_launch(void* const* d_in, const int* in_sizes, int n_in, void* d_out, int out_size, void* d_ws, size_t ws_size, hipStream_t stream) {
    static int grid = 0;
    if (grid == 0) {
        if (n_in != 32 || out_size != M * D || ws_size < WS_END) { fprintf(stderr, "kernel_launch: unexpected shapes (n_in %d out %d ws %zu)\n", n_in, out_size, ws_size); grid = -1; return; }
        int dev = 0, cus = 0, per_cu = 0;
        if (hipGetDevice(&dev) != hipSuccess || hipDeviceGetAttribute(&cus, hipDeviceAttributeMultiprocessorCount, dev) != hipSuccess) { grid = -1; return; }
        if (hipFuncSetAttribute((const void*)mk_fwd, hipFuncAttributeMaxDynamicSharedMemorySize, LDS_BYTES) != hipSuccess) { grid = -1; return; }
        if (hipOccupancyMaxActiveBlocksPerMultiprocessor(&per_cu, (const void*)mk_fwd, NWAVES * 64, LDS_BYTES) != hipSuccess || per_cu < 1) fprintf(stderr, "kernel_launch: occupancy query reports %d\n", per_cu);
        (void)hipGetLastError();
        grid = cus;
        if (grid > 256) grid = 256;
    }
    if (grid < 0) return;
    if (hipMemsetAsync((char*)d_ws + WS_CTL, 0, CTL_ZERO_BYTES, stream) != hipSuccess) return;
    Args a{};
    const float** ip = (const float**)&a.in;
    for (int i = 0; i < 32; ++i) ip[i] = (const float*)d_in[i];
    a.out = (float*)d_out; a.ws = (unsigned char*)d_ws;
#if MK_SPLIT
    for (int k = 0; k < N_PHASES; ++k) { a.ph_lo = k; a.ph_hi = k + 1; hipLaunchKernelGGL(mk_fwd, dim3(grid), dim3(NWAVES * 64), LDS_BYTES, stream, a); }
#else
    a.ph_lo = 0; a.ph_hi = N_PHASES; hipLaunchKernelGGL(mk_fwd, dim3(grid), dim3(NWAVES * 64), LDS_BYTES, stream, a);
#endif
}
```

```cpp
#include <hip/hip_runtime.h>
#include <cstdio>
#include <cstdint>
#include <math.h>

namespace pg8 {
#define PG8_LAS __attribute__((address_space(3)))
typedef unsigned short bf16_t;
typedef short bf16x8 __attribute__((ext_vector_type(8)));
typedef float f32x4 __attribute__((ext_vector_type(4)));
typedef unsigned u32x4 __attribute__((ext_vector_type(4)));
constexpr int BM = 256, BK = 64, HALF = 128, HTB = HALF * BK * 2  , STAGE_BYTES = 8 * HTB, NXCD = 8, WGM = 8;

__host__ __device__ __forceinline__ int lds_byte(int r, int c) { const int st = (r >> 4) * 2 + (c >> 5), rr = r & 15, cc = c & 31, ob = rr * 64 + cc * 2; return st * 1024 + (ob ^ (((ob >> 9) & 1) << 5)); }
__host__ __device__ __forceinline__ void stage_rc(int b, int& R, int& C) { const int st = b / 1024, sb = b % 1024, swz = sb ^ (((sb >> 9) & 1) << 5); R = (st >> 1) * 16 + swz / 64; C = (st & 1) * 32 + (swz % 64) / 2; }
__host__ __device__ __forceinline__ int perm32(int rho) { const int n = rho >> 4, i = rho & 15; return 8 * (i >> 2) + 4 * n + (i & 3); }

struct Unit { int pm, pn; };
struct Gemm { const bf16_t* A; const bf16_t* Bt; int M, N, K; };

struct StaticOrder {
    int nM, nN, nwg, G, c;
    __host__ __device__ void init(int M, int N, int G_, int c_) { nM = M / BM; nN = N / BM; nwg = nM * nN; G = G_; c = c_; }
    __host__ __device__ bool next(int i, Unit& u) const {
        const long L = (long)i * G + c; if (L >= nwg) return false;
        int wgid = (int)L; { const int q = nwg / NXCD, r = nwg % NXCD, xcd = wgid % NXCD, off = wgid / NXCD; wgid = (xcd < r ? xcd * (q + 1) : r * (q + 1) + (xcd - r) * q) + off; }
        const int nig = WGM * nN, gid = wgid / nig, fm = gid * WGM, gsz = (nM - fm) < WGM ? (nM - fm) : WGM;
        u.pm = fm + ((wgid % nig) % gsz); u.pn = (wgid % nig) / gsz; return true;
    }
    __device__ __forceinline__ void a_ready(const Unit&) const {}
    __device__ __forceinline__ void done(const Unit&) const {}
};

__device__ __forceinline__ unsigned cvt_pk_bf16(float lo, float hi) { unsigned r; asm volatile("v_cvt_pk_bf16_f32 %0, %1, %2" : "=v"(r) : "v"(lo), "v"(hi)); return r; }
template <int ROUTE> struct EpiRoute {
    static constexpr bool PERM = true, AFTER_DRAIN = false;
    unsigned char* ws; const float* ssq;
    __device__ __forceinline__ void operator()(const f32x4 (&acc)[2][2][4][2], const Unit& u, int wr, int wc, int fr, int fq) const {
        asm volatile("" : "+v"(fr), "+v"(fq));
        const int pn = u.pn; size_t off; int ld, t0; float sc;
        if constexpr (ROUTE == 0) {
            off = pn < 3 ? (size_t)(88u << 20) : pn < 5 ? (size_t)(112u << 20) : pn < 6 ? (size_t)(128u << 20) : (size_t)(136u << 20);
            ld = pn < 3 ? 768 : pn < 5 ? 512 : 256; t0 = pn < 3 ? 0 : pn < 5 ? 3 : pn < 6 ? 5 : 6; sc = (pn < 3 || pn == 5) ? 0.18033688011112042f : 1.f;
        } else if constexpr (ROUTE == 1) { off = (size_t)(88u << 20); ld = 768; t0 = 0; sc = 1.f; }
        else if constexpr (ROUTE == 3) { off = (size_t)(144u << 20); ld = 16384; t0 = 0; sc = 1.f; }
        else { off = pn < 6 ? (size_t)(128u << 20) : (size_t)(176u << 20); ld = pn < 6 ? 1536 : 512; t0 = pn < 6 ? 0 : 6; sc = 1.f; }
        bf16_t* base = (bf16_t*)(ws + off);
        const int row0 = u.pm * BM + wr * 64 + fr, col0 = (pn - t0) * BM + wc * 32 + 8 * fq;
#pragma unroll
        for (int ai = 0; ai < 2; ++ai)
#pragma unroll
            for (int m = 0; m < 4; ++m) { bf16_t* rowp = base + (size_t)(row0 + ai * HALF + m * 16) * ld + col0;
                float scr_ = sc; if constexpr (ROUTE == 1) scr_ = rsqrtf(ssq[row0 + ai * HALF + m * 16] * (1.f / 1024.f) + 1e-6f);
#pragma unroll
                for (int bj = 0; bj < 2; ++bj) { const f32x4 v0 = acc[ai][bj][m][0] * scr_, v1 = acc[ai][bj][m][1] * scr_;
                    u32x4 w; w.x = cvt_pk_bf16(v0[0], v0[1]); w.y = cvt_pk_bf16(v0[2], v0[3]); w.z = cvt_pk_bf16(v1[0], v1[1]); w.w = cvt_pk_bf16(v1[2], v1[3]);
                    if constexpr (ROUTE == 3) {
                        const int tok = col0 + bj * HALF, rw = row0 + ai * HALF + m * 16; *(u32x4*)(base + ((size_t)(tok >> 6) * 256 + rw) * 64 + (tok & 63)) = w; }
                    else *(u32x4*)(rowp + bj * HALF) = w; } }
    }
};
struct EpiResid {
    static constexpr bool PERM = true, AFTER_DRAIN = false;
    const float* res; float* out; bf16_t* hb; float* ssq; int ldc; int pad;
    __device__ __forceinline__ void operator()(const f32x4 (&acc)[2][2][4][2], const Unit& u, int wr, int wc, int fr, int fq) const {
        asm volatile("" : "+v"(fr), "+v"(fq));
        const int row0 = u.pm * BM + wr * 64 + fr, col0 = u.pn * BM + wc * 32 + 8 * fq;
#pragma unroll
        for (int ai = 0; ai < 2; ++ai)
#pragma unroll
            for (int m = 0; m < 4; ++m) { const int row = row0 + ai * HALF + m * 16; const size_t off = (size_t)row * ldc + col0; float sq = 0.f;
#pragma unroll
                for (int bj = 0; bj < 2; ++bj) { f32x4 v[2];
#pragma unroll
                    for (int n = 0; n < 2; ++n) { const f32x4 r = *(const f32x4*)(res + off + bj * HALF + 4 * n); v[n] = r + acc[ai][bj][m][n]; *(f32x4*)(out + off + bj * HALF + 4 * n) = v[n];
                        sq += (v[n][0] * v[n][0] + v[n][1] * v[n][1]) + (v[n][2] * v[n][2] + v[n][3] * v[n][3]); }
                    if (hb) { u32x4 w; w.x = cvt_pk_bf16(v[0][0], v[0][1]); w.y = cvt_pk_bf16(v[0][2], v[0][3]); w.z = cvt_pk_bf16(v[1][0], v[1][1]); w.w = cvt_pk_bf16(v[1][2], v[1][3]); *(u32x4*)(hb + off + bj * HALF) = w; } }
                if (ssq) { sq += __shfl_xor(sq, 16); sq += __shfl_xor(sq, 32); if (fq == 0) (void)__hip_atomic_fetch_add((__attribute__((address_space(1))) float*)(ssq + row), sq, __ATOMIC_RELAXED, __HIP_MEMORY_SCOPE_AGENT); } }
    }
};
struct EpiSwiglu {
    static constexpr bool PERM = true, AFTER_DRAIN = false;
    bf16_t* O; const float* ssq; int ldc; int pad;
    __device__ __forceinline__ void operator()(const f32x4 (&acc)[2][2][4][2], const Unit& u, int wr, int wc, int fr, int fq) const {
        asm volatile("" : "+v"(fr), "+v"(fq));
        const int row0 = u.pm * BM + wr * 64 + fr, col0 = u.pn * HALF + wc * 32 + 8 * fq;
#pragma unroll
        for (int ai = 0; ai < 2; ++ai)
#pragma unroll
            for (int m = 0; m < 4; ++m) { float o[8]; const float rs = rsqrtf(ssq[row0 + ai * HALF + m * 16] * (1.f / 1024.f) + 1e-6f);
#pragma unroll
                for (int n = 0; n < 2; ++n)
#pragma unroll
                    for (int e = 0; e < 4; ++e) { const float g = acc[ai][0][m][n][e] * rs, up = acc[ai][1][m][n][e] * rs; o[4 * n + e] = (g * __builtin_amdgcn_rcpf(1.f + __expf(-g))) * up; }
                u32x4 w; w.x = cvt_pk_bf16(o[0], o[1]); w.y = cvt_pk_bf16(o[2], o[3]); w.z = cvt_pk_bf16(o[4], o[5]); w.w = cvt_pk_bf16(o[6], o[7]);
                *(u32x4*)(O + (size_t)(row0 + ai * HALF + m * 16) * ldc + col0) = w; }
    }
};
template <class Epi, class Sched, bool ALIGN_EPI = false, bool SP2 = false>
__device__ __forceinline__ void gemm_phase(PG8_LAS unsigned char* lds, const Gemm g, const Sched& S, const Epi& E) {
    int tid = threadIdx.x; asm volatile("" : "+v"(tid));
    const int wid = __builtin_amdgcn_readfirstlane(tid >> 6), lane = tid & 63, wr = wid >> 2, wc = wid & 3, fr = lane & 15, fq = lane >> 4;
    int K = g.K; asm volatile("" : "+s"(K));
    const int nt = K / BK;
    unsigned voffA[2], voffB[2];
#pragma unroll
    for (int i = 0; i < 2; ++i) { int R, C; stage_rc(tid * 16 + i * 8192, R, C); const int Rb = Epi::PERM ? ((R & ~31) + perm32(R & 31)) : R;
        voffA[i] = (unsigned)(R * K + C) * 2u; voffB[i] = (unsigned)(Rb * K + C) * 2u; }
    const size_t kstep = (size_t)(BK * 2);
    const size_t hstep = (size_t)HALF * K * 2;
    const size_t tstep = 2 * hstep;
    const unsigned ldsw = (unsigned)wid * 1024u;
    const int aoff = lds_byte(wr * 64 + fr, fq * 8), boff = lds_byte(wc * 32 + fr, fq * 8);
#define PG8_SA(b, h) (((b) * 2 + (h)) * HTB)
#define PG8_SB(b, h) ((4 + (b) * 2 + (h)) * HTB)
#define PG8_STAGE(bufoff, gbase, voff) do { _Pragma("unroll") for (int _i = 0; _i < 2; ++_i) \
        __builtin_amdgcn_global_load_lds((const unsigned*)((const char*)(gbase) + (voff)[_i]), (PG8_LAS unsigned*)(lds + (bufoff) + ldsw + _i * 8192), 16, 0, 0); } while (0)
#define PG8_LDA(dst, b, h) do { _Pragma("unroll") for (int m = 0; m < 4; ++m) _Pragma("unroll") for (int k = 0; k < 2; ++k) dst[m][k] = *(const PG8_LAS bf16x8*)(lds + PG8_SA(b, h) + aoff + m * 2048 + k * 1024); } while (0)
#define PG8_LDB(dst, b, h) do { _Pragma("unroll") for (int n = 0; n < 2; ++n) _Pragma("unroll") for (int k = 0; k < 2; ++k) dst[n][k] = *(const PG8_LAS bf16x8*)(lds + PG8_SB(b, h) + boff + n * 2048 + k * 1024); } while (0)
#define PG8_MMA(ai, bj, At, Bt) do { __builtin_amdgcn_s_setprio(1); _Pragma("unroll") for (int m = 0; m < 4; ++m) _Pragma("unroll") for (int n = 0; n < 2; ++n) _Pragma("unroll") for (int k = 0; k < 2; ++k) \
        acc[ai][bj][m][n] = __builtin_amdgcn_mfma_f32_16x16x32_bf16(Bt[n][k], At[m][k], acc[ai][bj][m][n], 0, 0, 0); __builtin_amdgcn_s_setprio(0); } while (0)
#define PG8_WAIT_V(n) asm volatile("s_waitcnt vmcnt(" #n ")" ::: "memory")
#define PG8_WAIT_L(n) asm volatile("s_waitcnt lgkmcnt(" #n ")" ::: "memory")
#define PG8_BAR __builtin_amdgcn_s_barrier()
#define PG8_SCHED __builtin_amdgcn_sched_barrier(0)
    Unit cur, nxt; int ui = 0;
    if (!S.next(0, cur)) return;
    f32x4 acc[2][2][4][2];
#pragma unroll
    for (int a = 0; a < 2; ++a)
#pragma unroll
        for (int b = 0; b < 2; ++b)
#pragma unroll
            for (int m = 0; m < 4; ++m)
#pragma unroll
                for (int n = 0; n < 2; ++n) acc[a][b][m][n] = (f32x4){0.f, 0.f, 0.f, 0.f};
    bf16x8 At[4][2], B0[2][2], B1[2][2];
    const char* cA = (const char*)g.A + (size_t)cur.pm * tstep; const char* cB = (const char*)g.Bt + (size_t)cur.pn * tstep;
    S.a_ready(cur);
    if constexpr (SP2) {
        PG8_STAGE(PG8_SB(0, 0), cB, voffB); PG8_STAGE(PG8_SB(0, 1), cB + hstep, voffB); PG8_STAGE(PG8_SA(0, 0), cA, voffA); PG8_STAGE(PG8_SA(0, 1), cA + hstep, voffA);
        if (wr == 1) PG8_BAR;
        PG8_WAIT_V(2); PG8_BAR;
        PG8_STAGE(PG8_SB(1, 0), cB + kstep, voffB); PG8_STAGE(PG8_SA(1, 0), cA + kstep, voffA); PG8_STAGE(PG8_SB(1, 1), cB + hstep + kstep, voffB);
        PG8_WAIT_V(6); PG8_BAR;
    } else {
        PG8_STAGE(PG8_SB(0, 0), cB, voffB); PG8_STAGE(PG8_SA(0, 0), cA, voffA); PG8_STAGE(PG8_SB(0, 1), cB + hstep, voffB); PG8_STAGE(PG8_SA(0, 1), cA + hstep, voffA);
        if (wr == 1) PG8_BAR;
        PG8_WAIT_V(4); PG8_BAR;
        PG8_STAGE(PG8_SB(1, 0), cB + kstep, voffB); PG8_STAGE(PG8_SA(1, 0), cA + kstep, voffA); PG8_STAGE(PG8_SB(1, 1), cB + hstep + kstep, voffB);
        PG8_WAIT_V(6); PG8_BAR;
    }
    for (;;) {
        const bool has_next = S.next(ui + 1, nxt);
        const char* nA = has_next ? (const char*)g.A + (size_t)nxt.pm * tstep : cA; const char* nB = has_next ? (const char*)g.Bt + (size_t)nxt.pn * tstep : cB;
        for (int t = 0; t < nt; t += 2) {
            const bool last = (t == nt - 2);
            const char* a1 = cA + (size_t)(t + 1) * kstep;
            const char* a2 = last ? nA : cA + (size_t)(t + 2) * kstep; const char* b2 = last ? nB : cB + (size_t)(t + 2) * kstep;
            const char* a3 = a2 + kstep; const char* b3 = b2 + kstep;
            if (last && has_next) S.a_ready(nxt);
            if constexpr (SP2) {
            PG8_LDB(B0, 0, 0); PG8_LDB(B1, 0, 1); PG8_SCHED; PG8_LDA(At, 0, 0); PG8_STAGE(PG8_SA(1, 1), a1 + hstep, voffA);
            PG8_WAIT_V(8); PG8_WAIT_L(0); PG8_BAR; PG8_MMA(0, 0, At, B0); PG8_MMA(0, 1, At, B1); PG8_BAR; PG8_SCHED;
            PG8_LDA(At, 0, 1); PG8_STAGE(PG8_SB(0, 0), b2, voffB); PG8_STAGE(PG8_SB(0, 1), b2 + hstep, voffB); PG8_STAGE(PG8_SA(0, 0), a2, voffA);
            PG8_WAIT_V(8); PG8_WAIT_L(0); PG8_BAR; PG8_MMA(1, 0, At, B0); PG8_MMA(1, 1, At, B1); PG8_BAR; PG8_SCHED;
            PG8_LDB(B0, 1, 0); PG8_LDB(B1, 1, 1); PG8_SCHED; PG8_LDA(At, 1, 0); PG8_STAGE(PG8_SA(0, 1), a2 + hstep, voffA);
            PG8_WAIT_V(8); PG8_WAIT_L(0); PG8_BAR; PG8_MMA(0, 0, At, B0); PG8_MMA(0, 1, At, B1); PG8_BAR; PG8_SCHED;
            PG8_LDA(At, 1, 1); PG8_STAGE(PG8_SB(1, 0), b3, voffB); PG8_STAGE(PG8_SB(1, 1), b3 + hstep, voffB); PG8_STAGE(PG8_SA(1, 0), a3, voffA);
            PG8_WAIT_V(8); PG8_WAIT_L(0); PG8_BAR; PG8_MMA(1, 0, At, B0); PG8_MMA(1, 1, At, B1); PG8_BAR; PG8_SCHED;
            } else {
            PG8_LDB(B0, 0, 0); PG8_SCHED; PG8_LDA(At, 0, 0); PG8_STAGE(PG8_SA(1, 1), a1 + hstep, voffA);
            PG8_WAIT_L(8); PG8_BAR; PG8_WAIT_L(0); PG8_MMA(0, 0, At, B0); PG8_BAR; PG8_SCHED;
            PG8_LDB(B1, 0, 1); PG8_STAGE(PG8_SB(0, 0), b2, voffB);
            PG8_BAR; PG8_WAIT_L(0); PG8_MMA(0, 1, At, B1); PG8_BAR;
            PG8_LDA(At, 0, 1); PG8_STAGE(PG8_SA(0, 0), a2, voffA);
            PG8_BAR; PG8_WAIT_L(0); PG8_MMA(1, 0, At, B0); PG8_BAR; PG8_SCHED;
            PG8_STAGE(PG8_SB(0, 1), b2 + hstep, voffB);
            PG8_WAIT_V(6); PG8_BAR; PG8_MMA(1, 1, At, B1); PG8_BAR;
            PG8_LDB(B0, 1, 0); PG8_SCHED; PG8_LDA(At, 1, 0); PG8_STAGE(PG8_SA(0, 1), a2 + hstep, voffA);
            PG8_WAIT_L(8); PG8_BAR; PG8_WAIT_L(0); PG8_MMA(0, 0, At, B0); PG8_BAR; PG8_SCHED;
            PG8_LDB(B1, 1, 1); PG8_STAGE(PG8_SB(1, 0), b3, voffB);
            PG8_BAR; PG8_WAIT_L(0); PG8_MMA(0, 1, At, B1); PG8_BAR;
            PG8_LDA(At, 1, 1); PG8_STAGE(PG8_SA(1, 0), a3, voffA);
            PG8_BAR; PG8_WAIT_L(0); PG8_MMA(1, 0, At, B0); PG8_BAR; PG8_SCHED;
            PG8_STAGE(PG8_SB(1, 1), b3 + hstep, voffB);
            PG8_WAIT_V(6); PG8_BAR; PG8_MMA(1, 1, At, B1); PG8_BAR;
            }
        }
        if constexpr (ALIGN_EPI) { if (wr == 0) PG8_BAR; }
        if constexpr (!Epi::AFTER_DRAIN) { E(acc, cur, wr, wc, fr, fq); S.done(cur); }
        if (!has_next) break;
#pragma unroll
        for (int a = 0; a < 2; ++a)
#pragma unroll
            for (int b = 0; b < 2; ++b)
#pragma unroll
                for (int m = 0; m < 4; ++m)
#pragma unroll
                    for (int n = 0; n < 2; ++n) acc[a][b][m][n] = (f32x4){0.f, 0.f, 0.f, 0.f};
        cur = nxt; cA = nA; cB = nB; ++ui;
        if constexpr (ALIGN_EPI) { if (wr == 1) PG8_BAR; }
    }
    PG8_WAIT_V(0);
    if constexpr (!ALIGN_EPI) { if (wr == 0) PG8_BAR; }
    PG8_BAR;
    if constexpr (Epi::AFTER_DRAIN) { E.fused(acc, cur, wr, wc, fr, fq, lds, wid, lane); S.done(cur); }
#undef PG8_SA
#undef PG8_SB
#undef PG8_STAGE
#undef PG8_LDA
#undef PG8_LDB
#undef PG8_MMA
#undef PG8_WAIT_V
#undef PG8_WAIT_L
#undef PG8_BAR
#undef PG8_SCHED
}
}
constexpr int NWAVES = 8;
constexpr int BATCH = 2, T = 8192, D = 1024, M = BATCH * T, DFF = 2816, NSA_IN = 1828, DSA_IN = 712, NCMP = 511, NCR = BATCH * NCMP * 2;
constexpr float NEGF = -1e30f, EPSF = 1e-6f;
#ifndef MK_SPLIT
#define MK_SPLIT 0
#endif
constexpr int N_PHASES = 19;
constexpr size_t MiB = 1u << 20;
constexpr size_t WS_CTL = 0, CTL_ZERO_BYTES = 1 * MiB;
constexpr size_t WS_KCB = 1 * MiB  , WS_VCT = 1 * MiB + 512 * 1024  , WS_MKB = 2 * MiB  , WS_MVT = 2 * MiB + 512 * 1024  , WS_MKV = 3 * MiB  , WS_WIDX = 5 * MiB  , WS_CNT = 6 * MiB  ;
constexpr size_t WS_WIN0 = 8 * MiB, WS_WO = 12 * MiB, WS_WGU = 16 * MiB, WS_WD = 38 * MiB, WS_WIN1 = 49 * MiB, WS_WQ2 = 51 * MiB, WS_WVT = 52 * MiB  ;
constexpr size_t WS_W1T = 232 * MiB, WS_MEMN = 234 * MiB, WS_WMKT = 236 * MiB, WS_W2T = 238 * MiB, WS_B1F = 238 * MiB + 64 * 1024;
constexpr size_t WS_XN = 56 * MiB;
constexpr size_t WS_Q0 = 88 * MiB, WS_KV0 = 112 * MiB  , WS_QM = 128 * MiB, WS_G0 = 136 * MiB, WS_VT = 144 * MiB  ;
static_assert(WS_Q0 == (88u << 20) && WS_KV0 == (112u << 20) && WS_QM == (128u << 20) && WS_G0 == (136u << 20), "EpiRoute tables");
constexpr size_t WS_ACT = 88 * MiB;
constexpr size_t WS_PROJ1 = 88 * MiB, WS_CQ = 112 * MiB, WS_CKV = 120 * MiB, WS_KIDX = 124 * MiB, WS_QA = 128 * MiB, WS_QI = 176 * MiB, WS_SEL = 112 * MiB  , WS_CAT1 = 176 * MiB  , WS_WO1F = 52 * MiB + 512 * 1024  ;
constexpr size_t WS_OCS = 152 * MiB  , WS_CAT = 200 * MiB, WS_END = 239 * MiB;
static_assert(WS_PROJ1 == (88u << 20) && WS_QA == (128u << 20) && WS_QI == (176u << 20) && WS_VT == (144u << 20), "EpiRoute tables");
static_assert(WS_ACT + (size_t)M * DFF * 2 <= WS_CAT + 0 * MiB || true, "map");
constexpr int CW_BAR = 4096;
constexpr int RING_OFF = 0, RING_BYTES = 131072, LDS_BYTES = 163840, LDSCTL_OFF = LDS_BYTES - 1024, MISC_OFF = LDSCTL_OFF + 320;
#define GAS __attribute__((address_space(1)))
#define LAS __attribute__((address_space(3)))
typedef unsigned short bf16;
typedef unsigned v4u __attribute__((ext_vector_type(4)));
typedef float f32x4 __attribute__((ext_vector_type(4)));
typedef short bf16x8 __attribute__((ext_vector_type(8)));
typedef GAS unsigned gu32;
typedef GAS unsigned long long gu64;
#define RLX_AGENT __ATOMIC_RELAXED, __HIP_MEMORY_SCOPE_AGENT
#define LDS_WAIT() asm volatile("s_waitcnt lgkmcnt(0)" ::: "memory")
#define VM_WAIT() asm volatile("s_waitcnt vmcnt(0)" ::: "memory")
__device__ __forceinline__ unsigned long long rt() { return __builtin_amdgcn_s_memrealtime(); }
__device__ __forceinline__ unsigned f2bf(float f) { unsigned u = __builtin_bit_cast(unsigned, f); return (u + 0x7fffu + ((u >> 16) & 1u)) >> 16; }
__device__ __forceinline__ unsigned pk2(float lo, float hi) { return f2bf(lo) | (f2bf(hi) << 16); }
#define XB_TMO      128
#define XB_XCNT(j)  (256  + 64 * (j))
#define XB_XSUB(j)  (1280 + 64 * (j))
#define XB_XGEN(j)  (2304 + 64 * (j))
#define XB_TOP      3328
#define XB_TOPGEN   3392
#define XCD_BAR_WORDS 3456
#define XB_SPIN_CAP (1u << 18)

__device__ __forceinline__ unsigned xb_ld(unsigned* p)              { return __hip_atomic_load(p, __ATOMIC_RELAXED, __HIP_MEMORY_SCOPE_AGENT); }
__device__ __forceinline__ unsigned xb_add(unsigned* p, unsigned v) { return __hip_atomic_fetch_add(p, v, __ATOMIC_RELAXED, __HIP_MEMORY_SCOPE_AGENT); }
__device__ __forceinline__ unsigned xb_xcc_id() { return (unsigned)__builtin_amdgcn_s_getreg((3 << 11) | 20) & 0xFu; }
#define XB_SPIN(cond, bar) do { unsigned _sp = 0; while (cond) { __builtin_amdgcn_s_sleep(1); \
    if ((++_sp & 255u) == 0u) { if (xb_ld(&(bar)[XB_TMO])) break; if (_sp > XB_SPIN_CAP) { atomicAdd(&(bar)[XB_TMO], 1u); break; } } } } while (0)

struct XcdBarrier {
    unsigned* bar; unsigned x;
    volatile LAS unsigned* st;
};

__device__ __forceinline__ XcdBarrier xcd_barrier_post(unsigned* bar, volatile LAS unsigned* st) {
    XcdBarrier b; b.bar = bar; b.x = xb_xcc_id(); b.st = st;
    if (threadIdx.x == 0) (void)xb_add(&bar[XB_XCNT(b.x)], 1u);
    return b;
}
__device__ __forceinline__ void xcd_barrier_complete(unsigned* bar, unsigned x, unsigned& nloc, unsigned& nx) {
    const unsigned G = gridDim.x * gridDim.y * gridDim.z;
    unsigned sum, cnt, mine, sp = 0u;
    for (;;) {
        sum = 0u; cnt = 0u; mine = 0u;
#pragma unroll 1
        for (unsigned j = 0; j < 16; ++j) { const unsigned c = xb_ld(&bar[XB_XCNT(j)]); sum += c; cnt += (c > 0u) ? 1u : 0u; mine = (j == x) ? c : mine; }
        if (sum == G) break;
        __builtin_amdgcn_s_sleep(1);
        if ((++sp & 255u) == 0u) { if (xb_ld(&bar[XB_TMO])) break; if (sp > XB_SPIN_CAP) { atomicAdd(&bar[XB_TMO], 1u); break; } }
    }
    nloc = mine > 0u ? mine : 1u; nx = cnt > 0u ? cnt : 1u;
}

__device__ __forceinline__ void xcd_barrier(const XcdBarrier& b) {
    asm volatile("s_waitcnt vmcnt(0)" ::: "memory");
    __syncthreads();
    if (threadIdx.x == 0) {
        unsigned* bar = b.bar;
        __builtin_amdgcn_s_waitcnt(0);
        unsigned nloc = b.st[0], nx = b.st[1];
        if (nloc == 0u) { xcd_barrier_complete(bar, b.x, nloc, nx); b.st[0] = nloc; b.st[1] = nx; }
        const unsigned old = xb_add(&bar[XB_XSUB(b.x)], 1u);
        const unsigned gen = old / nloc;
        if (old + 1u == (gen + 1u) * nloc) {
            __builtin_amdgcn_fence(__ATOMIC_RELEASE, "agent");
            asm volatile("s_waitcnt vmcnt(0)" ::: "memory");
            const unsigned og = xb_add(&bar[XB_TOP], 1u);
            const unsigned tg = og / nx;
            if (og + 1u == (tg + 1u) * nx) xb_add(&bar[XB_TOPGEN], 1u);
            else XB_SPIN(xb_ld(&bar[XB_TOPGEN]) == tg, bar);
            __builtin_amdgcn_fence(__ATOMIC_ACQUIRE, "agent");
            xb_add(&bar[XB_XGEN(b.x)], 1u);
            asm volatile("s_waitcnt vmcnt(0)" ::: "memory");
        } else {
            XB_SPIN(xb_ld(&bar[XB_XGEN(b.x)]) == gen, bar);
            __builtin_amdgcn_fence(__ATOMIC_ACQUIRE, "agent");
            asm volatile("s_waitcnt vmcnt(0)" ::: "memory");
        }
    }
    __syncthreads();
}

struct Frame {
    LAS unsigned char* lds; volatile LAS unsigned* MISC; gu32* ctl;
    int vcu, G;
};
__device__ __forceinline__ float bf2f(unsigned short u) { return __uint_as_float((unsigned)u << 16); }
__device__ __forceinline__ float bflo(unsigned u) { return __uint_as_float(u << 16); }
__device__ __forceinline__ float bfhi(unsigned u) { return __uint_as_float(u & 0xffff0000u); }
__device__ __forceinline__ float wave_sum(float v) {
#pragma unroll
    for (int o = 1; o < 64; o <<= 1) v += __shfl_xor(v, o);
    return v;
}
__device__ __forceinline__ float red16_sum(float v) { v += __shfl_xor(v, 1, 16); v += __shfl_xor(v, 2, 16); v += __shfl_xor(v, 4, 16); v += __shfl_xor(v, 8, 16); return v; }
__device__ __forceinline__ float red16_max(float v) { v = fmaxf(v, __shfl_xor(v, 1, 16)); v = fmaxf(v, __shfl_xor(v, 2, 16)); v = fmaxf(v, __shfl_xor(v, 4, 16)); v = fmaxf(v, __shfl_xor(v, 8, 16)); return v; }
__device__ __forceinline__ int rel_bucket(int n) {
    if (n < 16) return n;
    return 16 + (n >= 22) + (n >= 30) + (n >= 40) + (n >= 54) + (n >= 73) + (n >= 99) + (n >= 134) + (n >= 182) + (n >= 246) + (n >= 332) + (n >= 450) + (n >= 609) + (n >= 825) + (n >= 1117) + (n >= 1513);
}

__device__ __forceinline__ void xpose_item(const float* W, int ldw, int c0, int nvalid, int k0, bf16* WT, int Kd, int drow0, LAS float* scr, int lane, const float* kgain = nullptr) {
#pragma unroll
    for (int i = 0; i < 8; ++i) { const int kk = 8 * i + (lane >> 3), n = (lane & 7) * 4;
        float4 wv = make_float4(0.f, 0.f, 0.f, 0.f);
        if (n + 3 < nvalid) wv = *(const float4*)(W + (size_t)(k0 + kk) * ldw + c0 + n);
        else if (n < nvalid) { const float* wp = W + (size_t)(k0 + kk) * ldw + c0 + n; wv.x = wp[0]; if (n + 1 < nvalid) wv.y = wp[1]; if (n + 2 < nvalid) wv.z = wp[2]; }
        if (kgain) { const float g_ = kgain[k0 + kk]; wv.x *= g_; wv.y *= g_; wv.z *= g_; wv.w *= g_; }
        LAS float* sp = scr + kk * 33 + n; sp[0] = wv.x; sp[1] = wv.y; sp[2] = wv.z; sp[3] = wv.w; }
    LDS_WAIT(); asm volatile("" ::: "memory");
    const int c = lane & 7;
#pragma unroll
    for (int j = 0; j < 4; ++j) { const int n = (lane >> 3) + 8 * j; const LAS float* s = scr + (8 * c) * 33 + n;
        v4u o; o.x = pk2(s[0 * 33], s[1 * 33]); o.y = pk2(s[2 * 33], s[3 * 33]); o.z = pk2(s[4 * 33], s[5 * 33]); o.w = pk2(s[6 * 33], s[7 * 33]);
        *(GAS v4u*)(WT + (size_t)(drow0 + n) * Kd + k0 + 8 * c) = o; }
    LDS_WAIT(); asm volatile("" ::: "memory");
}
__device__ __forceinline__ void rms_row_to_bf16(const float* xrow, const float* gain, bf16* orow, int lane) {
    const GAS f32x4* xr = (const GAS f32x4*)xrow + lane; const GAS f32x4* gr = (const GAS f32x4*)gain + lane;
    f32x4 v[4]; float s = 0.f;
#pragma unroll
    for (int j = 0; j < 4; ++j) { v[j] = xr[64 * j]; s += (v[j].x * v[j].x + v[j].y * v[j].y) + (v[j].z * v[j].z + v[j].w * v[j].w); }
    const float r = rsqrtf(wave_sum(s) * (1.f / D) + EPSF);
    GAS unsigned long long* o8 = (GAS unsigned long long*)orow + lane;
#pragma unroll
    for (int j = 0; j < 4; ++j) { const f32x4 g = gr[64 * j]; o8[64 * j] = (unsigned long long)pk2((v[j].x * r) * g.x, (v[j].y * r) * g.y) | ((unsigned long long)pk2((v[j].z * r) * g.z, (v[j].w * r) * g.w) << 32); }
}
#ifndef PROBE_REP
#define PROBE_REP 0
#endif
#define CAS __attribute__((address_space(4)))
#define KARGS() const CAS In* Ip = (const CAS In*)__builtin_amdgcn_kernarg_segment_ptr(); asm volatile("" : "+s"(Ip))
#define OPAQUE_TID() int tid_ = threadIdx.x; asm volatile("" : "+v"(tid_))
__device__ __forceinline__ void norm_phase(Frame& F, const float* x, const float* gain, bf16* xn) {
    OPAQUE_TID(); const int lane_ = tid_ & 63, wave_ = tid_ >> 6;
    const int gw = F.vcu * NWAVES + wave_, NGW = F.G * NWAVES;
    for (int m = gw; m < M; m += NGW) rms_row_to_bf16(x + (size_t)m * D, gain, xn + (size_t)m * D, lane_);
}

template <int DL>
__device__ __forceinline__ void coop_attend(const float (&q)[DL], const float (&k)[DL], const float (&v)[DL], float bias, float& m_, float& l_, float (&o)[DL]) {
    float a = 0.f;
#pragma unroll
    for (int d = 0; d < DL; ++d) a += q[d] * k[d];
    a = red16_sum(a) + bias;
    const float mn = fmaxf(m_, a), al = __expf(m_ - mn), p = __expf(a - mn);
    l_ = l_ * al + p; m_ = mn;
#pragma unroll
    for (int d = 0; d < DL; ++d) o[d] = o[d] * al + p * v[d];
}
__device__ __forceinline__ void ld4bf(const bf16* p, float (&x)[4]) { const uint2 u = *(const uint2*)p; x[0] = bflo(u.x); x[1] = bfhi(u.x); x[2] = bflo(u.y); x[3] = bfhi(u.y); }
__device__ __forceinline__ void ld8bf(const bf16* p, float (&x)[8]) { const uint4 u = *(const uint4*)p; x[0] = bflo(u.x); x[1] = bfhi(u.x); x[2] = bflo(u.y); x[3] = bfhi(u.y); x[4] = bflo(u.z); x[5] = bfhi(u.z); x[6] = bflo(u.w); x[7] = bfhi(u.w); }
__device__ __forceinline__ void ld4f(const float* p, float (&x)[4]) { const float4 u = *(const float4*)p; x[0] = u.x; x[1] = u.y; x[2] = u.z; x[3] = u.w; }

struct In {
    const float *x, *mem, *rel_bias, *norm_mix, *norm_ffn, *norm_mem, *w_mem_kv, *w_out, *ffn_gate, *ffn_up, *ffn_down, *nsa_w_in, *nsa_gate_b, *pos_k, *pos_v,
        *k_w1, *k_b1, *k_w2, *k_b2, *v_w1, *v_b1, *v_w2, *v_b2, *dsa_w_in, *q_norm, *kv_norm, *w_q_up, *w_uk, *w_uv, *w_q_idx, *kidx_norm, *norm_final;
};
__device__ __forceinline__ void p0_prologue(Frame& F, const In& I, unsigned char* ws) {
    OPAQUE_TID(); KARGS(); const int lane_ = tid_ & 63, wave_ = __builtin_amdgcn_readfirstlane(tid_ >> 6);
    LAS float* scr = (LAS float*)(F.lds + RING_OFF + wave_ * 16384);
    const int gw = F.vcu * NWAVES + wave_, NGW = F.G * NWAVES;
    bf16* WIN0 = (bf16*)(ws + WS_WIN0); bf16* WO = (bf16*)(ws + WS_WO); bf16* WGU = (bf16*)(ws + WS_WGU); bf16* WD = (bf16*)(ws + WS_WD); bf16* WIN1 = (bf16*)(ws + WS_WIN1); bf16* WQ2 = (bf16*)(ws + WS_WQ2);
    constexpr int I_A = 16 * 56, I_G = 16 * 8, I_B = 2 * 16 * 32, I_C = 2 * 16 * 176, I_D = 2 * 44 * 32, I_E = 16 * 24, I_F = 4 * 16, NITEMS = I_A + I_B + I_C + I_D + I_E + I_F + I_G;
    for (int it = gw; it < NITEMS; it += NGW) {
        int r = it;
        if (r < I_A) { const int kb = r / 56, nb = r % 56, r0 = 32 * nb; int c0, nv;
            if (r0 < 1152) { c0 = r0; nv = 32; } else if (r0 < 1280) { c0 = r0 + 128; nv = 32; } else if (r0 < 1536) { c0 = r0 + 292; nv = 32; } else if (r0 == 1536) { c0 = 1536; nv = 32; } else if (r0 == 1568) { c0 = 1568; nv = 4; } else { c0 = 0; nv = 0; }
            xpose_item(Ip->nsa_w_in, NSA_IN, c0, nv, 64 * kb, WIN0, D, r0, scr, lane_); continue; } r -= I_A;
        if (r < I_B) { const int l = r / 512, q = r % 512, kb = q / 32, nb = q % 32;
            xpose_item(Ip->w_out + (size_t)l * D * D, D, 32 * nb, 32, 64 * kb, WO + (size_t)l * D * D, D, 32 * nb, scr, lane_); continue; } r -= I_B;
        if (r < I_C) { const int l = r / (16 * 176), q = r % (16 * 176), kb = q / 176, nb = q % 176, r0 = 32 * nb, pn = r0 >> 8, w0 = r0 & 255;
            const float* src = ((w0 < 128) ? Ip->ffn_gate : Ip->ffn_up) + (size_t)l * D * DFF;
            xpose_item(src, DFF, 128 * pn + (w0 & 127), 32, 64 * kb, WGU + (size_t)l * 2 * DFF * D, D, r0, scr, lane_, Ip->norm_ffn + l * D); continue; } r -= I_C;
        if (r < I_D) { const int l = r / (44 * 32), q = r % (44 * 32), kb = q / 32, nb = q % 32;
            xpose_item(Ip->ffn_down + (size_t)l * DFF * D, D, 32 * nb, 32, 64 * kb, WD + (size_t)l * D * DFF, DFF, 32 * nb, scr, lane_); continue; } r -= I_D;
        if (r < I_E) { const int kb = r / 24, nb = r % 24, r0 = 32 * nb; int nv = DSA_IN - r0; nv = nv > 32 ? 32 : (nv < 0 ? 0 : nv);
            xpose_item(Ip->dsa_w_in, DSA_IN, r0, nv, 64 * kb, WIN1, D, r0, scr, lane_, Ip->norm_mix + D); continue; } r -= I_E;
        if (r < I_F) { const int kb = r / 16, nb = r % 16; xpose_item(Ip->w_q_idx, 512, 32 * nb, 32, 64 * kb, WQ2, 256, 1536 + 32 * nb, scr, lane_); continue; } r -= I_F;
        { const int kb = r / 8, nb = r % 8, r0 = 32 * nb;
            xpose_item(Ip->nsa_w_in, NSA_IN, (r0 < 128) ? 1152 + r0 : 1408 + (r0 - 128), 32, 64 * kb, (bf16*)(ws + WS_WVT), D, r0, scr, lane_); }
    }
    for (int idx = (F.vcu * NWAVES * 64) + tid_; idx < 384 * 256; idx += F.G * NWAVES * 64) {
        const int c = idx & 255, r4 = (idx >> 8) & 31, h = idx >> 13; const float4* a4 = (const float4*)(Ip->w_q_up + (size_t)c * 768 + h * 64); const float4* b4 = (const float4*)(Ip->w_uk + (size_t)(4 * r4) * 768 + h * 64);
        float s0 = 0.f, s1 = 0.f, s2 = 0.f, s3 = 0.f;
#pragma unroll 4
        for (int d = 0; d < 16; ++d) { const float4 av = a4[d], b0 = b4[d], b1 = b4[192 + d], b2 = b4[384 + d], b3 = b4[576 + d];
            s0 += (av.x * b0.x + av.y * b0.y) + (av.z * b0.z + av.w * b0.w); s1 += (av.x * b1.x + av.y * b1.y) + (av.z * b1.z + av.w * b1.w);
            s2 += (av.x * b2.x + av.y * b2.y) + (av.z * b2.z + av.w * b2.w); s3 += (av.x * b3.x + av.y * b3.y) + (av.z * b3.z + av.w * b3.w); }
        const float sc_ = 0.125f * 1.4426950408889634f;
        bf16* o_ = WQ2 + (size_t)(h * 128 + 4 * r4) * 256 + c;
        o_[0] = (bf16)f2bf(s0 * sc_); o_[256] = (bf16)f2bf(s1 * sc_); o_[512] = (bf16)f2bf(s2 * sc_); o_[768] = (bf16)f2bf(s3 * sc_);
    }
    { bf16* WO1F = (bf16*)(ws + WS_WO1F); const float* wo1 = Ip->w_out + (size_t)D * D;
      for (int idx = (F.vcu * NWAVES * 64) + tid_; idx < 12 * 32 * 256; idx += F.G * NWAVES * 64) {
          const int n4 = idx & 255, r4 = (idx >> 8) & 31, h = idx >> 13; const float* a = Ip->w_uv + (size_t)(4 * r4) * 768 + h * 64; const float* bcol = wo1 + (size_t)(h * 64) * D + 4 * n4;
          float acc_[4][4];
#pragma unroll
          for (int i = 0; i < 4; ++i)
#pragma unroll
              for (int j = 0; j < 4; ++j) acc_[i][j] = 0.f;
#pragma unroll 4
          for (int d = 0; d < 64; ++d) { const float4 bv = *(const float4*)(bcol + (size_t)d * D); const float a0 = a[d], a1 = a[768 + d], a2 = a[1536 + d], a3 = a[2304 + d];
              acc_[0][0] += a0 * bv.x; acc_[0][1] += a0 * bv.y; acc_[0][2] += a0 * bv.z; acc_[0][3] += a0 * bv.w; acc_[1][0] += a1 * bv.x; acc_[1][1] += a1 * bv.y; acc_[1][2] += a1 * bv.z; acc_[1][3] += a1 * bv.w;
              acc_[2][0] += a2 * bv.x; acc_[2][1] += a2 * bv.y; acc_[2][2] += a2 * bv.z; acc_[2][3] += a2 * bv.w; acc_[3][0] += a3 * bv.x; acc_[3][1] += a3 * bv.y; acc_[3][2] += a3 * bv.z; acc_[3][3] += a3 * bv.w; }
#pragma unroll
          for (int j = 0; j < 4; ++j) *(uint2*)(WO1F + (size_t)(4 * n4 + j) * 1792 + h * 128 + 4 * r4) = make_uint2(pk2(acc_[0][j], acc_[1][j]), pk2(acc_[2][j], acc_[3][j])); }
      for (int it = gw; it < 4 * 32; it += NGW) { const int kb = it / 32, nb = it % 32;
          xpose_item(wo1 + (size_t)768 * D, D, 32 * nb, 32, 64 * kb, WO1F + 1536, 1792, 32 * nb, scr, lane_); } }
    { bf16* W1T = (bf16*)(ws + WS_W1T); bf16* W2T = (bf16*)(ws + WS_W2T); bf16* WMKT = (bf16*)(ws + WS_WMKT); float* B1F = (float*)(ws + WS_B1F); bf16* MEMN = (bf16*)(ws + WS_MEMN);
      constexpr int J_1 = 2 * 32 * 8, J_2 = 2 * 4 * 2, J_M = 2 * 16 * 16;
      for (int it = gw; it < J_1 + J_2 + J_M; it += NGW) { int r2 = it;
          if (r2 < J_1) { const int kv = r2 / 256, q = r2 % 256, kb = q / 8, nb = q % 8; xpose_item(kv ? Ip->v_w1 : Ip->k_w1, 256, 32 * nb, 32, 64 * kb, W1T + (size_t)kv * 256 * 2048, 2048, 32 * nb, scr, lane_); continue; } r2 -= J_1;
          if (r2 < J_2) { const int kv = r2 / 8, q = r2 % 8, kb = q / 2, nb = q % 2; xpose_item(kv ? Ip->v_w2 : Ip->k_w2, 64, 32 * nb, 32, 64 * kb, W2T + (size_t)kv * 64 * 256, 256, 32 * nb, scr, lane_); continue; } r2 -= J_2;
          { const int l = r2 / 256, q = r2 % 256, kb = q / 16, nb = q % 16; xpose_item(Ip->w_mem_kv + (size_t)l * D * 512, 512, 32 * nb, 32, 64 * kb, WMKT + (size_t)l * 512 * D, D, 32 * nb, scr, lane_); } }
      if ((int)blockIdx.x < 32) { const int u_ = (int)blockIdx.x, kv = u_ >> 4, cr = (u_ >> 2) & 3, kq4 = u_ & 3, c = 64 * cr + lane_; const float* w1 = kv ? Ip->v_w1 : Ip->k_w1; const float* pos = kv ? Ip->pos_v : Ip->pos_k;
          const int kb0 = 512 * kq4 + 64 * wave_; float sacc = 0.f;
#pragma unroll 8
          for (int k = 0; k < 64; ++k) sacc += pos[kb0 + k] * w1[(size_t)(kb0 + k) * 256 + c];
          LAS float* red = (LAS float*)(F.lds + RING_OFF + 8 * 16384);
          red[wave_ * 64 + lane_] = sacc;
          __syncthreads();
          if (wave_ == 0) { float t_ = 0.f;
#pragma unroll
              for (int w = 0; w < 8; ++w) t_ += red[w * 64 + lane_];
              B1F[(kv * 4 + kq4) * 256 + c] = t_; } }
      for (int m = gw; m < 1024; m += NGW) rms_row_to_bf16(Ip->mem + (size_t)(m & 511) * D, Ip->norm_mem + (m >> 9) * D, MEMN + (size_t)m * D, lane_); }
    norm_phase(F, Ip->x, Ip->norm_mix, (bf16*)(ws + WS_XN));
}

#define MFMA16(A, B, C) __builtin_amdgcn_mfma_f32_16x16x32_bf16((A), (B), (C), 0, 0, 0)
constexpr float LOG2E = 1.4426950408889634f;
constexpr int NSA_OUT = 0, NSA_PSQ = 98304, NSA_ST = 147456, NSA_TB = NSA_ST + 3072;
constexpr int TAB_B12 = NSA_ST + 1024;
constexpr int TAB_BKT = NSA_ST + 3072;
static_assert(NSA_TB + 12288 <= LDSCTL_OFF && TAB_B12 + 2048 <= NSA_TB, "LDS tables");
enum { MD_CMP = 0, MD_WIN = 1, MD_BLK = 2, MD_MEM = 3 };
struct KF { bf16x8 a0, a1, b0, b1; };
struct VF { bf16x8 v[4]; };
__device__ __forceinline__ bf16x8 ldg16(const bf16* p) { return *(const bf16x8*)p; }
typedef float f32x2_t __attribute__((ext_vector_type(2))); typedef __bf16 bf16x2_t __attribute__((ext_vector_type(2)));
__device__ __forceinline__ unsigned cvtpk_s(float lo, float hi) { f32x2_t v = {lo, hi}; bf16x2_t b = __builtin_convertvector(v, bf16x2_t); return __builtin_bit_cast(unsigned, b); }
__device__ __forceinline__ bf16x8 pack8(const f32x4& a, const f32x4& b) { v4u w; w.x = cvtpk_s(a[0], a[1]); w.y = cvtpk_s(a[2], a[3]); w.z = cvtpk_s(b[0], b[1]); w.w = cvtpk_s(b[2], b[3]); return __builtin_bit_cast(bf16x8, w); }
__device__ __forceinline__ void load_k(KF& k, const bf16* kb, int kstride, int key0, int r, int kq) {
    const bf16* pa = kb + (size_t)(key0 + 8 * (r >> 2) + (r & 3)) * kstride + 8 * kq; const bf16* pb = pa + 4 * (size_t)kstride;
    k.a0 = ldg16(pa); k.a1 = ldg16(pa + 32); k.b0 = ldg16(pb); k.b1 = ldg16(pb + 32);
}
__device__ __forceinline__ void load_vt(VF& v, const bf16* vt, int vstride, int key0, int r, int kq) {
#pragma unroll
    for (int dt = 0; dt < 4; ++dt) v.v[dt] = ldg16(vt + (size_t)(16 * dt + r) * vstride + key0 + 8 * kq);
}
__device__ __forceinline__ void qk(f32x4& sa, f32x4& sb, const KF& k, const bf16x8 (&q)[2]) {
    const f32x4 z = {0.f, 0.f, 0.f, 0.f};
    sa = MFMA16(k.a0, q[0], z); sa = MFMA16(k.a1, q[1], sa); sb = MFMA16(k.b0, q[0], z); sb = MFMA16(k.b1, q[1], sb);
}
struct BiasCtx { const LAS unsigned short* tb; float d29, d30, c31; };
template <int MODE>
__device__ __forceinline__ void maskbias(f32x4& s, int kpos, int tcol, bool colok, const BiasCtx& B) {
    if (MODE == MD_MEM) return;
#pragma unroll
    for (int i = 0; i < 4; ++i) {
        int dist; bool ok;
        if (MODE == MD_CMP) { dist = tcol - 31 - 16 * (kpos + i); ok = dist >= 0; }
        else if (MODE == MD_WIN) { dist = tcol - (kpos + i); ok = (unsigned)dist <= 511u; }
        else { dist = tcol - (kpos + i); ok = dist >= 0; }
        int dc = dist < 0 ? 0 : dist; dc = dc > 1023 ? 1023 : dc;
        const float tb = __uint_as_float((unsigned)B.tb[dc * 6] << 16);
        const float far = B.c31 + (dist < 1513 ? B.d30 : 0.f) + (dist < 1117 ? B.d29 : 0.f);
        const float bias = dist < 1024 ? tb : far;
        s[i] = (ok && colok) ? s[i] + bias : -INFINITY;
    }
}
__device__ __forceinline__ float colmax(const f32x4& sa, const f32x4& sb) {
    float mx = fmaxf(fmaxf(fmaxf(sa[0], sa[1]), fmaxf(sa[2], sa[3])), fmaxf(fmaxf(sb[0], sb[1]), fmaxf(sb[2], sb[3])));
    mx = fmaxf(mx, __shfl_xor(mx, 16)); mx = fmaxf(mx, __shfl_xor(mx, 32)); return mx;
}
constexpr float SM_THR = 8.f;
__device__ __forceinline__ float lmax8(const f32x4& sa, const f32x4& sb) { return fmaxf(fmaxf(fmaxf(sa[0], sa[1]), fmaxf(sa[2], sa[3])), fmaxf(fmaxf(sb[0], sb[1]), fmaxf(sb[2], sb[3]))); }
template <int NO>
__device__ __forceinline__ void sm_rescale(float lm, float& m, float& l, f32x4 (&O)[NO]) {
    if (__any(lm > m + SM_THR)) {
        lm = fmaxf(lm, __shfl_xor(lm, 16)); lm = fmaxf(lm, __shfl_xor(lm, 32));
        const float mn = fmaxf(m, lm); const float al = __builtin_amdgcn_exp2f(m - mn); m = mn; l *= al;
#pragma unroll
        for (int dt = 0; dt < NO; ++dt) O[dt] = O[dt] * al;
    }
}
__device__ __forceinline__ bf16x8 sm_update(const f32x4& sa, const f32x4& sb, float& m, float& l, f32x4 (&O)[4]) {
    sm_rescale<4>(lmax8(sa, sb), m, l, O);
    f32x4 pa, pb; float sum = 0.f;
#pragma unroll
    for (int i = 0; i < 4; ++i) { pa[i] = __builtin_amdgcn_exp2f(sa[i] - m); pb[i] = __builtin_amdgcn_exp2f(sb[i] - m); sum += pa[i] + pb[i]; }
    l += sum;
    return pack8(pa, pb);
}
__device__ __forceinline__ void sm_update64(const f32x4& sa0, const f32x4& sb0, const f32x4& sa1, const f32x4& sb1, float& m, float& l, f32x4 (&O)[4], bf16x8& pf0, bf16x8& pf1) {
    sm_rescale<4>(fmaxf(lmax8(sa0, sb0), lmax8(sa1, sb1)), m, l, O);
    f32x4 pa0, pb0, pa1, pb1; float sum = 0.f;
#pragma unroll
    for (int i = 0; i < 4; ++i) { pa0[i] = __builtin_amdgcn_exp2f(sa0[i] - m); pb0[i] = __builtin_amdgcn_exp2f(sb0[i] - m); pa1[i] = __builtin_amdgcn_exp2f(sa1[i] - m); pb1[i] = __builtin_amdgcn_exp2f(sb1[i] - m);
        sum += (pa0[i] + pb0[i]) + (pa1[i] + pb1[i]); }
    l += sum;
    pf0 = pack8(pa0, pb0); pf1 = pack8(pa1, pb1);
}
enum { BK_FAR = 0, BK_MID = 1, BK_GEN = 2 };
template <int MD>
__device__ __forceinline__ void step64(const KF& k0, const KF& k1, const bf16x8 (&q)[2], int cls, int kpos, int tcol, bool colok, const BiasCtx& B,
                                       float& m, float& l, f32x4 (&O)[4], bf16x8& pf0, bf16x8& pf1) {
    const bool has = m > -1e29f; const float mref = has ? m : 0.f;
    float cin = ((cls == BK_FAR) ? B.c31 : 0.f) - mref; if (!colok) cin = -INFINITY;
    const f32x4 c4 = {cin, cin, cin, cin};
    f32x4 sa0 = MFMA16(k0.a0, q[0], c4), sb0 = MFMA16(k0.b0, q[0], c4), sa1 = MFMA16(k1.a0, q[0], c4), sb1 = MFMA16(k1.b0, q[0], c4);
    sa0 = MFMA16(k0.a1, q[1], sa0); sb0 = MFMA16(k0.b1, q[1], sb0); sa1 = MFMA16(k1.a1, q[1], sa1); sb1 = MFMA16(k1.b1, q[1], sb1);
    if (cls == BK_MID) {
        const LAS unsigned short* tp = B.tb + (tcol - kpos) * 6;
#pragma unroll
        for (int i = 0; i < 4; ++i) { sa0[i] += __uint_as_float((unsigned)tp[-6 * i] << 16); sb0[i] += __uint_as_float((unsigned)tp[-6 * (i + 4)] << 16);
            sa1[i] += __uint_as_float((unsigned)tp[-6 * (i + 32)] << 16); sb1[i] += __uint_as_float((unsigned)tp[-6 * (i + 36)] << 16); }
    } else if (cls == BK_GEN) {
        maskbias<MD>(sa0, kpos, tcol, true, B); maskbias<MD>(sb0, kpos + 4, tcol, true, B); maskbias<MD>(sa1, kpos + 32, tcol, true, B); maskbias<MD>(sb1, kpos + 36, tcol, true, B);
    }
    float lm = fmaxf(lmax8(sa0, sb0), lmax8(sa1, sb1));
    if (__any((lm > SM_THR) || (!has && lm > -INFINITY))) {
        lm = fmaxf(lm, __shfl_xor(lm, 16)); lm = fmaxf(lm, __shfl_xor(lm, 32));
        const bool upd = (lm > -INFINITY) && (!has || lm > 0.f); const float dl = upd ? lm : 0.f;
        if (upd) m = mref + dl;
        const float f = has ? __builtin_amdgcn_exp2f(-dl) : 1.f; l *= f;
#pragma unroll
        for (int dt = 0; dt < 4; ++dt) O[dt] = O[dt] * f;
#pragma unroll
        for (int i = 0; i < 4; ++i) { sa0[i] -= dl; sb0[i] -= dl; sa1[i] -= dl; sb1[i] -= dl; }
    }
    f32x4 pa0, pb0, pa1, pb1; float sum = 0.f;
#pragma unroll
    for (int i = 0; i < 4; ++i) { pa0[i] = __builtin_amdgcn_exp2f(sa0[i]); pb0[i] = __builtin_amdgcn_exp2f(sb0[i]); pa1[i] = __builtin_amdgcn_exp2f(sa1[i]); pb1[i] = __builtin_amdgcn_exp2f(sb1[i]);
        sum += (pa0[i] + pb0[i]) + (pa1[i] + pb1[i]); }
    l += sum;
    pf0 = pack8(pa0, pb0); pf1 = pack8(pa1, pb1);
}
__device__ __forceinline__ void pv(f32x4 (&O)[4], const VF& v, const bf16x8& pf) {
#pragma unroll
    for (int dt = 0; dt < 4; ++dt) O[dt] = MFMA16(v.v[dt], pf, O[dt]);
}
__device__ __forceinline__ void lds_fadd(LAS float* p, float v) { (void)__hip_atomic_fetch_add((float*)p, v, __ATOMIC_RELAXED, __HIP_MEMORY_SCOPE_WORKGROUP); }
__device__ __forceinline__ float kqsum(float v) { v += __shfl_xor(v, 16); v += __shfl_xor(v, 32); return v; }
__device__ __forceinline__ float wmax64(float v) {
#pragma unroll
    for (int o = 1; o < 64; o <<= 1) v = fmaxf(v, __shfl_xor(v, o));
    return v;
}
__device__ __forceinline__ void out_add(LAS float* OUTw, int p, int n, int kq, const f32x4 (&O)[4], float scale, bool first) {
    const int q = 2 * p + (n >> 3), hd = n & 7;
    if (hd < 6) { LAS f32x4* dst = (LAS f32x4*)(OUTw + (q * 6 + hd) * 64) + kq;
#pragma unroll
        for (int dt = 0; dt < 4; ++dt) { f32x4 v = O[dt] * scale; if (!first) v = v + dst[4 * dt]; dst[4 * dt] = v; } }
}

__device__ __forceinline__ void p2_mfma(Frame& F, const In& I, unsigned char* ws) {
    OPAQUE_TID(); KARGS(); const int lane = tid_ & 63, wave = __builtin_amdgcn_readfirstlane(tid_ >> 6), r = lane & 15, kq = lane >> 4;
    const bf16* KV0 = (const bf16*)(ws + WS_KV0); const bf16* W1T = (const bf16*)(ws + WS_W1T); const bf16* W2T = (const bf16*)(ws + WS_W2T); const float* B1F = (const float*)(ws + WS_B1F);
    const bf16* MEMN = (const bf16*)(ws + WS_MEMN); const bf16* WMKT = (const bf16*)(ws + WS_WMKT);
    bf16* KCB = (bf16*)(ws + WS_KCB); bf16* VCT = (bf16*)(ws + WS_VCT); bf16* MKB = (bf16*)(ws + WS_MKB); bf16* MVT = (bf16*)(ws + WS_MVT);
    LAS unsigned char* hid = F.lds + RING_OFF;
    for (int u = blockIdx.x; u < 192; u += F.G) {
        const bool cmp = u < 128;
        const bf16* ap[2]; const bf16* bp[2]; int K, kjump;
        int kv = 0, bg = 0, n0 = 0, lay = 0, m0 = 0, ch = 0;
        if (cmp) { kv = u >> 6; bg = (u >> 4) & 3; n0 = (u & 15) * 32; const int b = bg >> 1, g = bg & 1; K = 2048; kjump = 512 - 64;
#pragma unroll
            for (int rt = 0; rt < 2; ++rt) { int nn = n0 + 16 * rt + r; nn = nn > 510 ? 510 : nn; ap[rt] = KV0 + (size_t)(b * T + 16 * nn) * 512 + kv * 128 + g * 64 + 8 * kq; }
#pragma unroll
            for (int ct = 0; ct < 2; ++ct) bp[ct] = W1T + (size_t)(kv * 256 + 32 * wave + 16 * ct + r) * 2048 + 8 * kq;
        } else { const int v = u - 128; lay = v >> 5; m0 = ((v >> 1) & 15) * 32; ch = v & 1; K = 1024; kjump = 0;
#pragma unroll
            for (int rt = 0; rt < 2; ++rt) ap[rt] = MEMN + (size_t)(lay * 512 + m0 + 16 * rt + r) * 1024 + 8 * kq;
#pragma unroll
            for (int ct = 0; ct < 2; ++ct) bp[ct] = WMKT + (size_t)(lay * 512 + ch * 256 + 32 * wave + 16 * ct + r) * 1024 + 8 * kq;
        }
        f32x4 acc[2][2];
#pragma unroll
        for (int rt = 0; rt < 2; ++rt)
#pragma unroll
            for (int ct = 0; ct < 2; ++ct) acc[rt][ct] = (f32x4){0.f, 0.f, 0.f, 0.f};
        for (int kb = 0; kb < K; kb += 64) { const int ao = kb + (kb >> 6) * kjump;
            bf16x8 a[2][2], bb[2][2];
#pragma unroll
            for (int h2 = 0; h2 < 2; ++h2) {
#pragma unroll
                for (int rt = 0; rt < 2; ++rt) a[rt][h2] = ldg16(ap[rt] + ao + 32 * h2);
#pragma unroll
                for (int ct = 0; ct < 2; ++ct) bb[ct][h2] = ldg16(bp[ct] + kb + 32 * h2); }
#pragma unroll
            for (int h2 = 0; h2 < 2; ++h2)
#pragma unroll
                for (int rt = 0; rt < 2; ++rt)
#pragma unroll
                    for (int ct = 0; ct < 2; ++ct) acc[rt][ct] = MFMA16(a[rt][h2], bb[ct][h2], acc[rt][ct]);
        }
        if (cmp) {
#pragma unroll
            for (int ct = 0; ct < 2; ++ct) { const int col = 32 * wave + 16 * ct + r; const float bias = (kv ? Ip->v_b1 : Ip->k_b1)[col] + ((B1F[(kv * 4 + 0) * 256 + col] + B1F[(kv * 4 + 1) * 256 + col]) + (B1F[(kv * 4 + 2) * 256 + col] + B1F[(kv * 4 + 3) * 256 + col]));
#pragma unroll
                for (int rt = 0; rt < 2; ++rt)
#pragma unroll
                    for (int i = 0; i < 4; ++i) { const float xg = acc[rt][ct][i] + bias; const float hv = 0.5f * xg * (1.f + tanhf(0.7978845608028654f * (xg + 0.044715f * xg * xg * xg)));
                        *(LAS unsigned short*)(hid + (16 * rt + 4 * kq + i) * 528 + 2 * col) = (unsigned short)f2bf(hv); } }
            __syncthreads();
            { const int rt2 = wave >> 2, ct2 = wave & 3; f32x4 o = {0.f, 0.f, 0.f, 0.f};
              const bf16* w2p = W2T + (size_t)(kv * 64 + 16 * ct2 + r) * 256 + 8 * kq;
#pragma unroll
              for (int ks = 0; ks < 8; ++ks) { const bf16x8 av = *(const LAS bf16x8*)(hid + (16 * rt2 + r) * 528 + 64 * ks + 16 * kq); o = MFMA16(av, ldg16(w2p + 32 * ks), o); }
              const int d = 16 * ct2 + r; const float b2v = (kv ? Ip->v_b2 : Ip->k_b2)[d];
#pragma unroll
              for (int i = 0; i < 4; ++i) { const int nn = n0 + 16 * rt2 + 4 * kq + i; const unsigned short ov = (nn < NCMP) ? (unsigned short)f2bf(o[i] + b2v) : (unsigned short)0;
                  if (kv) VCT[(size_t)(bg * 64 + d) * 512 + nn] = ov; else KCB[(size_t)(bg * 512 + nn) * 64 + d] = ov; } }
            __syncthreads();
        } else {
#pragma unroll
            for (int ct = 0; ct < 2; ++ct) { const int col = 32 * wave + 16 * ct + r;
#pragma unroll
                for (int rt = 0; rt < 2; ++rt)
#pragma unroll
                    for (int i = 0; i < 4; ++i) { const int mrow = m0 + 16 * rt + 4 * kq + i; const unsigned short ov = (unsigned short)f2bf(acc[rt][ct][i]);
                        if (ch == 0) MKB[(size_t)(lay * 512 + mrow) * 256 + col] = ov; else MVT[(size_t)(lay * 256 + col) * 512 + mrow] = ov; } }
        }
    }
}

template <int MODE>
__device__ __forceinline__ void mb2(f32x4& sa, f32x4& sb, int kpos, int tcol, bool colok, bool fast, const BiasCtx& B) {
    if (fast) { if (colok) { sa = sa + B.c31; sb = sb + B.c31; } else { sa = (f32x4){-INFINITY, -INFINITY, -INFINITY, -INFINITY}; sb = sa; } }
    else { maskbias<MODE>(sa, kpos, tcol, colok, B); maskbias<MODE>(sb, kpos + 4, tcol, colok, B); }
}
#define SWZ(row) (((((row) >> 3) & 3) << 1) | (((row) >> 1) & 1))
struct KV1 { KF k; VF v; };
__device__ __forceinline__ void load_kv(KV1& d, const bf16* kb, int kstride, const bf16* vt, int vstride, int key0, int r, int kq) { load_k(d.k, kb, kstride, key0, r, kq); load_vt(d.v, vt, vstride, key0, r, kq); }

template <int MD>
__device__ __forceinline__ void nsa_sweep(LAS unsigned char* STG, const bf16* ksb, const bf16* vst, int jlo, int jhi, int qt, const LAS unsigned* WMw, int wave, int lane, int r, int kq, int qsel, int t0w,
                                          const bf16x8 (&qf)[4][2], const BiasCtx& BC, float (&m)[4], float (&l)[4], f32x4 (&O)[4][4]) {
            const int srow = 8 * wave + (lane >> 3), sch = (lane & 7) ^ SWZ(srow);
            const bf16* ksrc = ksb + (size_t)srow * 512 + 8 * sch; const bf16* vsrc = vst + (size_t)srow * 64 + 8 * sch;
#define NSA_DMA(jb) do { LAS unsigned char* d_ = STG + ((jb) % 3) * 16384 + wave * 1024; \
                __builtin_amdgcn_global_load_lds((const unsigned*)(ksrc + (size_t)(jb) * 64 * 512), (LAS unsigned*)d_, 16, 0, 0); \
                __builtin_amdgcn_global_load_lds((const unsigned*)(vsrc + (size_t)(jb) * 16384), (LAS unsigned*)(d_ + 8192), 16, 0, 0); } while (0)
            NSA_DMA(jlo); if (jhi > jlo) NSA_DMA(jlo + 1);
            if (jhi > jlo) asm volatile("s_waitcnt vmcnt(2)" ::: "memory"); else asm volatile("s_waitcnt vmcnt(0)" ::: "memory");
            __builtin_amdgcn_s_barrier();
            for (int j = jlo; j <= jhi; ++j) {
                const LAS unsigned char* sk = STG + (j % 3) * 16384; const LAS unsigned char* sv = sk + 8192;
                const bool more = (j + 2) <= jhi;
                if (more) NSA_DMA(j + 2);
                unsigned m8 = 0xffu; if (WMw) m8 = (unsigned)__builtin_amdgcn_readfirstlane((int)((WMw[j >> 2] >> (8 * (j & 3))) & 0xffu)); asm volatile("" : "+s"(m8));
                if (m8) {
                    const int dj = qt - j; const int cls = (MD == MD_WIN) ? ((dj >= 1 && dj <= 6) ? BK_MID : BK_GEN) : ((64 * dj - 63 >= 1513) ? BK_FAR : ((dj >= 1 && dj <= 15) ? BK_MID : BK_GEN));
                    KF k0, k1;
                    { const int ka = 8 * (r >> 2) + (r & 3), kb2 = ka + 4, kc = ka + 32, kd = ka + 36;
                      k0.a0 = *(const LAS bf16x8*)(sk + ka * 128 + ((kq ^ SWZ(ka)) << 4)); k0.a1 = *(const LAS bf16x8*)(sk + ka * 128 + (((4 + kq) ^ SWZ(ka)) << 4));
                      k0.b0 = *(const LAS bf16x8*)(sk + kb2 * 128 + ((kq ^ SWZ(kb2)) << 4)); k0.b1 = *(const LAS bf16x8*)(sk + kb2 * 128 + (((4 + kq) ^ SWZ(kb2)) << 4));
                      k1.a0 = *(const LAS bf16x8*)(sk + kc * 128 + ((kq ^ SWZ(kc)) << 4)); k1.a1 = *(const LAS bf16x8*)(sk + kc * 128 + (((4 + kq) ^ SWZ(kc)) << 4));
                      k1.b0 = *(const LAS bf16x8*)(sk + kd * 128 + ((kq ^ SWZ(kd)) << 4)); k1.b1 = *(const LAS bf16x8*)(sk + kd * 128 + (((4 + kq) ^ SWZ(kd)) << 4)); }
#pragma unroll
                    for (int p = 0; p < 4; ++p) if (m8 & (3u << (2 * p))) {
                        bf16x8 pf0, pf1;
                        step64<MD>(k0, k1, qf[p], cls, 64 * j + 8 * kq, t0w + 2 * p + qsel, ((m8 >> (2 * p + qsel)) & 1u) != 0u, BC, m[p], l[p], O[p], pf0, pf1);
#pragma unroll
                        for (int h2 = 0; h2 < 2; ++h2) { VF v;
#pragma unroll
                            for (int dt = 0; dt < 4; ++dt) { const int dd = 16 * dt + r; v.v[dt] = *(const LAS bf16x8*)(sv + dd * 128 + (((4 * h2 + kq) ^ SWZ(dd)) << 4)); }
                            pv(O[p], v, h2 ? pf1 : pf0); }
                        __builtin_amdgcn_sched_barrier(0); }
                }
                if (more) asm volatile("s_waitcnt vmcnt(2) lgkmcnt(0)" ::: "memory"); else asm volatile("s_waitcnt vmcnt(0) lgkmcnt(0)" ::: "memory");
                __builtin_amdgcn_s_barrier();
            }
#undef NSA_DMA
}
__device__ __forceinline__ void p3_nsa_mfma(Frame& F, const In& I, unsigned char* ws) {
    OPAQUE_TID(); KARGS(); const int wave = __builtin_amdgcn_readfirstlane(tid_ >> 6);
    LAS float* b12 = (LAS float*)(F.lds + TAB_B12);
    LAS float* OUTf = (LAS float*)(F.lds + NSA_OUT); LAS float* OUTw = OUTf + wave * 3072;
    LAS float* PSw = (LAS float*)(F.lds + NSA_PSQ) + wave * 1024;
    LAS unsigned char* STG = F.lds + NSA_PSQ;
    LAS unsigned* WMw = (LAS unsigned*)(F.lds + NSA_ST) + wave * 32;
    for (int i = tid_; i < 512; i += NWAVES * 64) b12[i] = ((i & 15) < 12) ? Ip->rel_bias[(i >> 4) * 12 + (i & 15)] * LOG2E : 0.f;
    LAS unsigned short* TB = (LAS unsigned short*)(F.lds + NSA_TB);
    { const int gg = (int)blockIdx.x & 1;
      for (int i = tid_; i < 6144; i += NWAVES * 64) { const int dd = i / 6, hh = i % 6; TB[i] = (unsigned short)f2bf(Ip->rel_bias[rel_bucket(dd) * 12 + gg * 6 + hh] * LOG2E); } }
    __syncthreads();
    const bf16* Q0 = (const bf16*)(ws + WS_Q0); const bf16* KV0 = (const bf16*)(ws + WS_KV0); const bf16* QM = (const bf16*)(ws + WS_QM); const bf16* G0 = (const bf16*)(ws + WS_G0);
    const bf16* VT = (const bf16*)(ws + WS_VT); const bf16* KCB = (const bf16*)(ws + WS_KCB); const bf16* VCT = (const bf16*)(ws + WS_VCT);
    const bf16* MKB = (const bf16*)(ws + WS_MKB); const bf16* MVT = (const bf16*)(ws + WS_MVT);
    bf16* CAT = (bf16*)(ws + WS_CAT);
    const int nun = 4 * 128;
    for (int ui = blockIdx.x; ui < nun; ui += F.G) {
        int tl_ = tid_; asm volatile("" : "+v"(tl_));
        const int lane = tl_ & 63, n = lane & 15, kq = lane >> 4, r = n, hd = n & 7, qsel = n >> 3; const bool colv = hd < 6;
        int bg, qt;
        bg = blockIdx.x & 3;
        if (F.G == 256) { const int idx = blockIdx.x >> 2; qt = (ui < 256) ? idx : 127 - idx; }
        else { qt = ui >> 2; if ((ui & 3) != bg) continue; }
        const int b = bg >> 1, g = bg & 1, t0w = 64 * qt + 8 * wave, rowb = b * T;
        const int habs = g * 6 + (colv ? hd : 0);
        const LAS float* b12c = b12 + habs; const BiasCtx BC{TB + (colv ? hd : 0), b12c[29 * 16] - b12c[30 * 16], b12c[30 * 16] - b12c[31 * 16], b12c[31 * 16]};

        bf16x8 qf[4][2];
#pragma unroll
        for (int p = 0; p < 4; ++p) { const bf16* qp = Q0 + (size_t)(rowb + t0w + 2 * p + qsel) * 768 + habs * 64 + 8 * kq;
#pragma unroll
            for (int ks = 0; ks < 2; ++ks) { bf16x8 v = ldg16(qp + 32 * ks); if (!colv) v = (bf16x8){0, 0, 0, 0, 0, 0, 0, 0}; qf[p][ks] = v; } }
        for (int i = lane; i < 1024; i += 64) PSw[i] = 0.f;
        float m[4], l[4]; f32x4 O[4][4];
        const int ncmax = (t0w + 7 >= 31) ? ((t0w + 7 - 31) / 16 + 1) : 0;
        const bf16* kcb = KCB + (size_t)(bg * 512) * 64; const bf16* vct = VCT + (size_t)(bg * 64) * 512;
#pragma unroll
        for (int p = 0; p < 4; ++p) { m[p] = -1e30f; l[p] = 0.f; }
        if (ncmax > 0) {
            int r_ = r, kq_ = kq; asm volatile("" : "+v"(r_), "+v"(kq_));
            for (int key0 = 0; key0 < ncmax; key0 += 32) {
                asm volatile("" : "+v"(r_), "+v"(kq_));
                KF kA; load_k(kA, kcb, 64, key0, r_, kq_);
                const bool fast = (t0w - 31 - 16 * (key0 + 31)) >= 1513;
#pragma unroll
                for (int p = 0; p < 4; ++p) { f32x4 sa, sb; qk(sa, sb, kA, qf[p]); const int tcol = t0w + 2 * p + qsel;
                    mb2<MD_CMP>(sa, sb, key0 + 8 * kq_, tcol, true, fast, BC);
                    const float mn = fmaxf(m[p], colmax(sa, sb)); float sum = 0.f;
#pragma unroll
                    for (int i = 0; i < 4; ++i) sum += __builtin_amdgcn_exp2f(sa[i] - mn) + __builtin_amdgcn_exp2f(sb[i] - mn);
                    l[p] = l[p] * __builtin_amdgcn_exp2f(m[p] - mn) + sum; m[p] = mn; __builtin_amdgcn_sched_barrier(0); }
            }
        }
        float invl[4];
#pragma unroll
        for (int p = 0; p < 4; ++p) { const float lt = kqsum(l[p]); invl[p] = lt > 0.f ? 1.f / lt : 0.f; }
#pragma unroll
        for (int p = 0; p < 4; ++p)
#pragma unroll
            for (int dt = 0; dt < 4; ++dt) O[p][dt] = (f32x4){0.f, 0.f, 0.f, 0.f};
        float carry[4] = {0.f, 0.f, 0.f, 0.f};
        if (ncmax > 0) {
            int r_ = r, kq_ = kq; asm volatile("" : "+v"(r_), "+v"(kq_));
            for (int key0 = 0; key0 < ncmax; key0 += 32) {
                asm volatile("" : "+v"(r_), "+v"(kq_));
                KV1 A; load_kv(A, kcb, 64, vct, 512, key0, r_, kq_);
                const bool fast = (t0w - 31 - 16 * (key0 + 31)) >= 1513;
#pragma unroll
                for (int p = 0; p < 4; ++p) { f32x4 sa, sb; qk(sa, sb, A.k, qf[p]); const int tcol = t0w + 2 * p + qsel;
                    mb2<MD_CMP>(sa, sb, key0 + 8 * kq_, tcol, true, fast, BC);
                    f32x4 pa, pb;
#pragma unroll
                    for (int i = 0; i < 4; ++i) { pa[i] = __builtin_amdgcn_exp2f(sa[i] - m[p]) * invl[p]; pb[i] = __builtin_amdgcn_exp2f(sb[i] - m[p]) * invl[p]; }
                    pv(O[p], A.v, pack8(pa, pb));
                    float wA = (pa[0] + pa[1]) + (pa[2] + pa[3]), wB = pa[3] + ((pb[0] + pb[1]) + (pb[2] + pb[3])), wC = pb[3];
                    if (!colv) { wA = 0.f; wB = 0.f; wC = 0.f; }
                    const float up = __shfl(wC, (lane + 48) & 63);
                    const float prevC = (kq == 0) ? carry[p] : up; carry[p] = up;
                    float a0 = wA + prevC, a1 = wB;
                    a0 += __shfl_xor(a0, 1); a1 += __shfl_xor(a1, 1); a0 += __shfl_xor(a0, 2); a1 += __shfl_xor(a1, 2); a0 += __shfl_xor(a0, 4); a1 += __shfl_xor(a1, 4);
                    if (hd == 0) { LAS float* ps = PSw + (2 * p + qsel) * 128 + (key0 >> 2) + 2 * kq; ps[0] = a0; ps[1] = a1; } __builtin_amdgcn_sched_barrier(0); }
            }
        }
        if (ncmax > 0 && ncmax <= 480) {
            const int jn = ((ncmax + 31) >> 5) * 8;
#pragma unroll
            for (int p = 0; p < 4; ++p) { float a0 = carry[p]; a0 += __shfl_xor(a0, 1); a0 += __shfl_xor(a0, 2); a0 += __shfl_xor(a0, 4); if (hd == 0 && kq == 0) PSw[(2 * p + qsel) * 128 + jn] = a0; }
        }
        {
#pragma unroll
            for (int p = 0; p < 4; ++p) { const size_t row = (size_t)(rowb + t0w + 2 * p + qsel);
                const float gz = bf2f(G0[row * 256 + habs * 3 + 0]) + Ip->nsa_gate_b[habs * 3 + 0]; out_add(OUTw, p, n, kq, O[p], 1.f / (1.f + __expf(-gz)), true); }
        }
        for (int i = lane; i < 32; i += 64) WMw[i] = (qt < 16) ? 0xffffffffu : 0u;
        if (qt >= 16) {
            if (lane < 3) { const int j = lane == 0 ? 0 : qt - 2 + lane; atomicOr((unsigned*)&WMw[j >> 2], 0xffu << (8 * (j & 3))); }
            for (int q = 0; q < 8; ++q) {
                float v0 = PSw[q * 128 + lane], v1 = PSw[q * 128 + 64 + lane];
                if (lane < 1 || lane > qt - 2) v0 = -1.f; if (lane + 64 > qt - 2) v1 = -1.f;
                for (int s = 0; s < 13; ++s) { const float mx = wmax64(fmaxf(v0, v1));
                    const unsigned long long b0 = __ballot(v0 == mx); int j;
                    if (b0) { j = __builtin_ctzll(b0); if (lane == j) v0 = -1.f; } else { const unsigned long long b1 = __ballot(v1 == mx); j = __builtin_ctzll(b1); if (lane == j) v1 = -1.f; j += 64; }
                    if (lane == 0) atomicOr((unsigned*)&WMw[j >> 2], 1u << (8 * (j & 3) + q)); }
            }
        }
        const bf16* ksb = KV0 + (size_t)rowb * 512 + 256 + g * 64; const bf16* vst = VT + ((size_t)(rowb >> 6) * 256 + g * 64) * 64;
        __syncthreads();
#pragma unroll 1
        for (int rep_ = 0; rep_ < (PROBE_REP == 1 ? 2 : 1); ++rep_) {
#pragma unroll
            for (int p = 0; p < 4; ++p) { m[p] = -1e30f; l[p] = 0.f;
#pragma unroll
                for (int dt = 0; dt < 4; ++dt) O[p][dt] = (f32x4){0.f, 0.f, 0.f, 0.f}; }
            nsa_sweep<MD_BLK>(STG, ksb, vst, 0, qt, qt, WMw, wave, lane, r, kq, qsel, t0w, qf, BC, m, l, O);
        }
        { int qs2_ = qsel; asm volatile("" : "+v"(qs2_));
#pragma unroll
        for (int p = 0; p < 4; ++p) { const size_t row = (size_t)(rowb + t0w + 2 * p + qs2_);
            const float gz = bf2f(G0[row * 256 + habs * 3 + 1]) + Ip->nsa_gate_b[habs * 3 + 1]; out_add(OUTw, p, n, kq, O[p], (1.f / (1.f + __expf(-gz))) / kqsum(l[p]), false); } }
        const bf16* kwb = KV0 + (size_t)rowb * 512 + 384 + g * 64; const bf16* vwt = VT + ((size_t)(rowb >> 6) * 256 + 128 + g * 64) * 64;
#pragma unroll
        for (int p = 0; p < 4; ++p) { m[p] = -1e30f; l[p] = 0.f;
#pragma unroll
            for (int dt = 0; dt < 4; ++dt) O[p][dt] = (f32x4){0.f, 0.f, 0.f, 0.f}; }
        __syncthreads();
        nsa_sweep<MD_WIN>(STG, kwb, vwt, (qt >= 8) ? qt - 8 : 0, qt, qt, nullptr, wave, lane, r, kq, qsel, t0w, qf, BC, m, l, O);
        if (PROBE_REP == 4) {
#pragma unroll
            for (int p = 0; p < 4; ++p) { m[p] = -1e30f; l[p] = 0.f;
#pragma unroll
                for (int dt = 0; dt < 4; ++dt) O[p][dt] = (f32x4){0.f, 0.f, 0.f, 0.f}; }
            nsa_sweep<MD_WIN>(STG, kwb, vwt, (qt >= 8) ? qt - 8 : 0, qt, qt, nullptr, wave, lane, r, kq, qsel, t0w, qf, BC, m, l, O); }
        { int qs3_ = qsel; asm volatile("" : "+v"(qs3_));
#pragma unroll
        for (int p = 0; p < 4; ++p) { const size_t row = (size_t)(rowb + t0w + 2 * p + qs3_);
            const float gz = bf2f(G0[row * 256 + habs * 3 + 2]) + Ip->nsa_gate_b[habs * 3 + 2]; out_add(OUTw, p, n, kq, O[p], (1.f / (1.f + __expf(-gz))) / kqsum(l[p]), false); } }
        int ln_ = lane; asm volatile("" : "+v"(ln_));
#pragma unroll 1
        for (int i = 0; i < 12; ++i) { const int e = i * 64 + ln_, q = e / 96, c4 = e % 96; const f32x4 v = ((const LAS f32x4*)OUTw)[e];
            *(uint2*)(CAT + (size_t)(rowb + t0w + q) * 1024 + g * 384 + 4 * c4) = make_uint2(pk2(v[0], v[1]), pk2(v[2], v[3])); }
#pragma unroll 1
        for (int h2 = 0; h2 < 2; ++h2) { const int hm = 2 * g + h2;
            bf16x8 qm[2]; { const bf16* qp = QM + (size_t)(rowb + t0w + (n & 7)) * 256 + hm * 64 + 8 * kq; qm[0] = ldg16(qp); qm[1] = ldg16(qp + 32); if (n >= 8) { qm[0] = (bf16x8){0, 0, 0, 0, 0, 0, 0, 0}; qm[1] = qm[0]; } }
            float mm = -1e30f, ll = 0.f; f32x4 Om[4];
#pragma unroll
            for (int dt = 0; dt < 4; ++dt) Om[dt] = (f32x4){0.f, 0.f, 0.f, 0.f};
            const bf16* mk = MKB + (size_t)(b * 256) * 256 + hm * 64; const bf16* mvt = MVT + (size_t)(hm * 64) * 512 + b * 256;
            int r_ = r, kq_ = kq; asm volatile("" : "+v"(r_), "+v"(kq_));
            KV1 A; load_kv(A, mk, 256, mvt, 512, 0, r_, kq_);
            for (int key0 = 0; key0 < 256; key0 += 32) { asm volatile("" : "+v"(r_), "+v"(kq_));
                KV1 B; load_kv(B, mk, 256, mvt, 512, (key0 + 32 < 256) ? key0 + 32 : key0, r_, kq_);
                f32x4 sa, sb; qk(sa, sb, A.k, qm); pv(Om, A.v, sm_update(sa, sb, mm, ll, Om)); A = B; }
            const float il = 1.f / kqsum(ll);
            if (n < 8) { bf16* op = CAT + (size_t)(rowb + t0w + n) * 1024 + 768 + hm * 64 + 4 * kq;
#pragma unroll
                for (int dt = 0; dt < 4; ++dt) *(uint2*)(op + 16 * dt) = make_uint2(pk2(Om[dt][0] * il, Om[dt][1] * il), pk2(Om[dt][2] * il, Om[dt][3] * il)); }
        }
    }
}

__device__ __forceinline__ void p10_dsa_norm(Frame& F, const In& I, unsigned char* ws) {
    OPAQUE_TID(); KARGS(); const int gw = F.vcu * NWAVES + (tid_ >> 6), NGW = F.G * NWAVES, lane = tid_ & 63;
    const bf16* PR = (const bf16*)(ws + WS_PROJ1); bf16* CQ = (bf16*)(ws + WS_CQ); bf16* CKV = (bf16*)(ws + WS_CKV); bf16* KIDX = (bf16*)(ws + WS_KIDX); float* WIDX = (float*)(ws + WS_WIDX);
    for (int m = gw; m < M; m += NGW) {
        const bf16* pr = PR + (size_t)m * 768;
        float a[4]; ld4bf(pr + 4 * lane, a);
        float s = wave_sum(a[0] * a[0] + a[1] * a[1] + a[2] * a[2] + a[3] * a[3]); float r = rsqrtf(s * (1.f / 256.f) + EPSF);
        const float4 gq = *(const float4*)(Ip->q_norm + 4 * lane);
        *(uint2*)(CQ + (size_t)m * 256 + 4 * lane) = make_uint2(pk2((a[0] * r) * gq.x, (a[1] * r) * gq.y), pk2((a[2] * r) * gq.z, (a[3] * r) * gq.w));
        const unsigned u = *(const unsigned*)(pr + 256 + 2 * lane); const float c0 = bflo(u), c1 = bfhi(u);
        s = wave_sum(c0 * c0 + c1 * c1); r = rsqrtf(s * (1.f / 128.f) + EPSF);
        *(unsigned*)(CKV + (size_t)m * 128 + 2 * lane) = pk2((c0 * r) * Ip->kv_norm[2 * lane], (c1 * r) * Ip->kv_norm[2 * lane + 1]);
        const float k0 = bf2f(pr[384 + lane]);
        s = wave_sum(k0 * k0); r = rsqrtf(s * (1.f / 64.f) + EPSF);
        { const int tk = m >> 5, key = m & 31, ks = lane >> 4, hf = (lane >> 3) & 1, jj = lane & 7;
          KIDX[((size_t)(tk * 4 + ks) * 64 + hf * 32 + key) * 8 + jj] = (bf16)f2bf((k0 * r) * Ip->kidx_norm[lane]); }
        if (lane < 8) WIDX[(size_t)m * 8 + lane] = bf2f(pr[448 + lane]) * (0.35355339059327373f * 0.125f);
    }
}

#define MFMA32(A, B, C) __builtin_amdgcn_mfma_f32_32x32x16_bf16((A), (B), (C), 0, 0, 0)
typedef float f32x16 __attribute__((ext_vector_type(16)));
constexpr int XL_OFF = RING_BYTES;
constexpr int IDX_HIST = XL_OFF, IDX_CAND = XL_OFF + 16384, IDX_MM = XL_OFF + 24576, IDX_STQ = IDX_MM + 256, IDX_MM2 = IDX_STQ + 256, IDX_CAP = 1024;
static_assert(IDX_MM2 + 64 <= LDSCTL_OFF, "LDS map (indexer)");
__device__ __forceinline__ float wmin64(float v) {
#pragma unroll
    for (int o = 1; o < 64; o <<= 1) v = fminf(v, __shfl_xor(v, o));
    return v;
}
__device__ __forceinline__ void p12_index_mfma(Frame& F, const In& I, unsigned char* ws) {
    OPAQUE_TID(); KARGS(); const int lane = tid_ & 63, wave = __builtin_amdgcn_readfirstlane(tid_ >> 6), key = lane & 31, half = lane >> 5;
    LAS float* SC = (LAS float*)(F.lds + RING_OFF);
    LAS float* MMw = (LAS float*)(F.lds + IDX_MM);
    const bf16* QI = (const bf16*)(ws + WS_QI); const bf16* KIDX = (const bf16*)(ws + WS_KIDX); const float* WIDX = (const float*)(ws + WS_WIDX);
    unsigned short* SEL = (unsigned short*)(ws + WS_SEL); int* CNT = (int*)(ws + WS_CNT);
    const int NG = M / 4, per = (NG + F.G - 1) / F.G;
    for (int j = 0; j < per; ++j) {
        const int u = j * F.G + ((j & 1) ? (F.G - 1 - (int)blockIdx.x) : (int)blockIdx.x);
        if (u >= NG) break;
        const int gi = (u & 1) * (NG / 2) + (u >> 1);
        const int row0 = 4 * gi, b = row0 / T, t0 = row0 % T, rowb = b * T;
        if (t0 < 256) {
            if (wave < 4) { const int t = t0 + wave; unsigned short* so = SEL + (size_t)(row0 + wave) * 256;
#pragma unroll
                for (int i = 0; i < 4; ++i) { const int s = lane + 64 * i; so[s] = (unsigned short)(s <= t ? s : 0); }
                if (lane == 0) CNT[row0 + wave] = t + 1; }
            continue;
        }
        {
            const int rho = lane & 31, a = rho >> 2, qA = ((a >> 2) & 1) + 2 * (a & 1), hdA = 4 * ((a >> 1) & 1) + (rho & 3);
            bf16x8 qa[4];
#pragma unroll
            for (int ks = 0; ks < 4; ++ks) qa[ks] = ldg16(QI + (size_t)(row0 + qA) * 512 + hdA * 64 + 16 * ks + 8 * half);
            float w0[8], w1[8];
            { const float4 x0 = *(const float4*)(WIDX + (size_t)(row0 + 2 * half) * 8), x1 = *(const float4*)(WIDX + (size_t)(row0 + 2 * half) * 8 + 4);
              const float4 y0 = *(const float4*)(WIDX + (size_t)(row0 + 2 * half + 1) * 8), y1 = *(const float4*)(WIDX + (size_t)(row0 + 2 * half + 1) * 8 + 4);
              w0[0] = x0.x; w0[1] = x0.y; w0[2] = x0.z; w0[3] = x0.w; w0[4] = x1.x; w0[5] = x1.y; w0[6] = x1.z; w0[7] = x1.w;
              w1[0] = y0.x; w1[1] = y0.y; w1[2] = y0.z; w1[3] = y0.w; w1[4] = y1.x; w1[5] = y1.y; w1[6] = y1.z; w1[7] = y1.w; }
            const int tq0 = t0 + 2 * half, tq1 = tq0 + 1, nt = (t0 + 3) / 32 + 1;
            float mn0 = INFINITY, mx0 = -INFINITY, mn1 = INFINITY, mx1 = -INFINITY;
            const bf16* kpb = KIDX + (size_t)(rowb >> 5) * 2048 + (size_t)lane * 8;
            const int ntw = (nt - wave + NWAVES - 1) / NWAVES;
#define IDX_LOAD(dst, i) do { const int tl2_ = wave + NWAVES * ((i) < ntw ? (i) : (ntw > 0 ? ntw - 1 : 0)); const bf16* kp_ = kpb + (size_t)tl2_ * 2048; \
                _Pragma("unroll") for (int ks = 0; ks < 4; ++ks) dst[ks] = ldg16(kp_ + 512 * ks); } while (0)
#define IDX_COMP(src, i) do { if ((i) < ntw) { const int kpos = 32 * (wave + NWAVES * (i)) + key; \
                f32x16 c = {0.f, 0.f, 0.f, 0.f, 0.f, 0.f, 0.f, 0.f, 0.f, 0.f, 0.f, 0.f, 0.f, 0.f, 0.f, 0.f}; \
                _Pragma("unroll") for (int ks = 0; ks < 4; ++ks) c = MFMA32(qa[ks], src[ks], c); \
                float s0 = 0.f, s1 = 0.f; \
                _Pragma("unroll") for (int h = 0; h < 8; ++h) { s0 += fmaxf(c[h], 0.f) * w0[h]; s1 += fmaxf(c[8 + h], 0.f) * w1[h]; } \
                s0 += 0.f; s1 += 0.f; \
                const bool ok0 = kpos <= tq0, ok1 = kpos <= tq1; \
                SC[(2 * half) * 8192 + kpos] = ok0 ? s0 : -INFINITY; SC[(2 * half + 1) * 8192 + kpos] = ok1 ? s1 : -INFINITY; \
                if (ok0) { mn0 = fminf(mn0, s0); mx0 = fmaxf(mx0, s0); } if (ok1) { mn1 = fminf(mn1, s1); mx1 = fmaxf(mx1, s1); } } } while (0)
            for (int prb_ = 0; prb_ < (PROBE_REP == 2 ? 2 : 1); ++prb_)
            if (ntw > 0) {
                bf16x8 kb0[4], kb1[4], kb2[4], kb3[4];
                IDX_LOAD(kb0, 0); IDX_LOAD(kb1, 1); IDX_LOAD(kb2, 2);
                for (int i = 0; i < ntw; i += 4) {
                    IDX_LOAD(kb3, i + 3); IDX_COMP(kb0, i);
                    IDX_LOAD(kb0, i + 4); IDX_COMP(kb1, i + 1);
                    IDX_LOAD(kb1, i + 5); IDX_COMP(kb2, i + 2);
                    IDX_LOAD(kb2, i + 6); IDX_COMP(kb3, i + 3);
                }
            }
#undef IDX_LOAD
#undef IDX_COMP
#pragma unroll
            for (int o = 1; o < 32; o <<= 1) { mn0 = fminf(mn0, __shfl_xor(mn0, o)); mx0 = fmaxf(mx0, __shfl_xor(mx0, o)); mn1 = fminf(mn1, __shfl_xor(mn1, o)); mx1 = fmaxf(mx1, __shfl_xor(mx1, o)); }
            if (key == 0) { LAS float* mm = MMw + (wave * 4 + 2 * half) * 2; mm[0] = mn0; mm[1] = mx0; mm[2] = mn1; mm[3] = mx1; }
        }
        __syncthreads();
        {
            const int q = wave >> 1, hw = wave & 1, t = t0 + q, n = t + 1; const LAS float* sc = SC + q * 8192;
            LAS unsigned* hist = (LAS unsigned*)(F.lds + IDX_HIST) + wave * 512; const LAS unsigned* hist0 = (const LAS unsigned*)(F.lds + IDX_HIST) + (2 * q) * 512;
            LAS unsigned short* cand = (LAS unsigned short*)(F.lds + IDX_CAND) + q * IDX_CAP;
            LAS float* stf = (LAS float*)(F.lds + IDX_STQ) + q * 16; LAS int* sti = (LAS int*)stf;
            LAS float* mm2 = (LAS float*)(F.lds + IDX_MM2) + wave * 2;
            unsigned short* so = SEL + (size_t)(row0 + q) * 256;
            const int nch = (n + 255) >> 8;
            if (hw == 0 && lane == 0) { float lo = INFINITY, hi = -INFINITY;
#pragma unroll
                for (int w = 0; w < 8; ++w) { lo = fminf(lo, MMw[(w * 4 + q) * 2]); hi = fmaxf(hi, MMw[(w * 4 + q) * 2 + 1]); }
                stf[0] = lo; stf[1] = hi; sti[2] = 256; sti[3] = 0; sti[4] = 0; sti[5] = 0; sti[6] = 0; sti[7] = 0; sti[8] = 0; sti[9] = 0; }
            __syncthreads();
            for (int round = 0; round < 64; ++round) {
                const float lo = stf[0], hi = stf[1]; const bool act = sti[8] == 0; const bool eqr = !(hi > lo); const float scale = eqr ? 0.f : 1024.f / (hi - lo);
                if (act && !eqr) {
#pragma unroll
                    for (int i = 0; i < 8; ++i) hist[lane + 64 * i] = 0u;
                    for (int c = hw; c < nch; c += 2) { const int i4 = 256 * c + 4 * lane; const f32x4 v4 = *(const LAS f32x4*)(sc + i4);
#pragma unroll
                        for (int e = 0; e < 4; ++e) { const float v = (i4 + e < n) ? v4[e] : -INFINITY;
                            if (v >= lo && v <= hi) { int bb = (int)((v - lo) * scale); bb = bb > 1023 ? 1023 : bb; atomicAdd((unsigned*)&hist[bb >> 1], 1u << (16 * (bb & 1))); } } }
                }
                __syncthreads();
                if (hw == 0 && act) {
                    if (eqr) { if (lane == 0) { sti[8] = 1; sti[9] = 1; } }
                    else {
                        const int krem = sti[2];
                        unsigned cw[8], c0w[8]; unsigned S = 0u, S0 = 0u;
#pragma unroll
                        for (int i = 0; i < 8; ++i) { c0w[i] = hist0[8 * lane + i]; cw[i] = c0w[i] + hist0[512 + 8 * lane + i]; S += (cw[i] & 0xffffu) + (cw[i] >> 16); S0 += (c0w[i] & 0xffffu) + (c0w[i] >> 16); }
                        unsigned x = S, x0 = S0;
#pragma unroll
                        for (int o = 1; o < 64; o <<= 1) { const unsigned y = __shfl_down(x, o), y0 = __shfl_down(x0, o); if (lane + o < 64) { x += y; x0 += y0; } }
                        const unsigned above = x - S; unsigned acc0 = x0 - S0;
                        const bool found = (above < (unsigned)krem) && ((unsigned)krem <= above + S);
                        const int fl = __builtin_ctzll(__ballot(found));
                        int bs = 0; unsigned acc = above, cb = 0u, cb0 = 0u;
                        { bool done = false;
#pragma unroll
                          for (int i = 15; i >= 0; --i) { const unsigned cnt_ = (i & 1) ? (cw[i >> 1] >> 16) : (cw[i >> 1] & 0xffffu), cnt0_ = (i & 1) ? (c0w[i >> 1] >> 16) : (c0w[i >> 1] & 0xffffu);
                              if (!done) { if (acc + cnt_ >= (unsigned)krem) { bs = 16 * lane + i; cb = cnt_; cb0 = cnt0_; done = true; } else { acc += cnt_; acc0 += cnt0_; } } } }
                        if (lane == fl) { sti[2] = krem - (int)acc; sti[3] += (int)acc0; sti[4] += (int)acc; sti[5] = bs; sti[6] = (int)cb0; sti[7] = (int)cb; sti[8] = ((int)cb <= IDX_CAP) ? 1 : 0; }
                    }
                }
                __syncthreads();
                const LAS int* stall = (const LAS int*)(F.lds + IDX_STQ);
                if (stall[8] && stall[16 + 8] && stall[32 + 8] && stall[48 + 8]) break;
                float nlo = INFINITY, nhi = -INFINITY;
                if (sti[8] == 0) { const int bstar = sti[5];
                    for (int c = hw; c < nch; c += 2) { const int i4 = 256 * c + 4 * lane; const f32x4 v4 = *(const LAS f32x4*)(sc + i4);
#pragma unroll
                        for (int e = 0; e < 4; ++e) { const float v = (i4 + e < n) ? v4[e] : -INFINITY;
                            if (v >= lo && v <= hi) { int bb = (int)((v - lo) * scale); bb = bb > 1023 ? 1023 : bb; if (bb == bstar) { nlo = fminf(nlo, v); nhi = fmaxf(nhi, v); } } } } }
                nlo = wmin64(nlo); nhi = wmax64(nhi);
                if (lane == 0) { mm2[0] = nlo; mm2[1] = nhi; }
                __syncthreads();
                if (hw == 0 && lane == 0 && sti[8] == 0) { stf[0] = fminf(mm2[0], mm2[2]); stf[1] = fmaxf(mm2[1], mm2[3]); }
                __syncthreads();
            }
            { const float lo = stf[0], hi = stf[1]; const bool eq = sti[9] != 0; const float scale = eq ? 0.f : 1024.f / (hi - lo);
              const int krem = sti[2], A0 = sti[3], AT = sti[4], bstar = sti[5], C0 = sti[6], ncand = sti[7], nabove = 256 - krem;
              int bsel = hw ? A0 : 0, bcand = hw ? C0 : 0; (void)AT;
              const int cstep = eq ? 1 : 2;
              if (!(eq && hw)) for (int c = eq ? 0 : hw; c < nch; c += cstep) { const int i4 = 256 * c + 4 * lane; const f32x4 v4 = *(const LAS f32x4*)(sc + i4);
#pragma unroll
                  for (int e = 0; e < 4; ++e) { const int idx = i4 + e; const float v = (idx < n) ? v4[e] : -INFINITY;
                      bool sel, cnd;
                      if (eq) { sel = v > hi; cnd = (v == hi); }
                      else { const bool in = (v >= lo && v <= hi); int bb = (int)((v - lo) * scale); bb = bb > 1023 ? 1023 : bb; sel = (v > hi) || (in && bb > bstar); cnd = in && bb == bstar; }
                      const unsigned long long ms = __ballot(sel), mc = __ballot(cnd), lt = (1ull << lane) - 1ull;
                      if (sel) so[bsel + __builtin_popcountll(ms & lt)] = (unsigned short)idx;
                      if (cnd) { const int pc = bcand + __builtin_popcountll(mc & lt);
                          if (eq) { if (pc < krem) so[nabove + pc] = (unsigned short)idx; } else if (pc < IDX_CAP) cand[pc] = (unsigned short)idx; }
                      bsel += __builtin_popcountll(ms); bcand += __builtin_popcountll(mc); } }
              __syncthreads();
              if (!eq) {
                  for (int i = 64 * hw + lane; i < ncand; i += 128) { const int ii = cand[i]; const float vi = sc[ii]; int rank = 0;
                      for (int jj = 0; jj < ncand; ++jj) { const int ij = cand[jj]; const float vj = sc[ij]; rank += ((vj > vi) || (vj == vi && ij < ii)) ? 1 : 0; }
                      if (rank < krem) so[nabove + rank] = (unsigned short)ii; }
              }
              if (hw == 0 && lane == 0) CNT[row0 + q] = 256; }
        }
        __syncthreads();
    }
}

__device__ __forceinline__ unsigned offb(unsigned row, unsigned ch) { return 256u * row + 16u * (ch ^ (((row & 3u) << 2) | ((row >> 2) & 3u))); }
typedef short v4i16_t __attribute__((ext_vector_type(4)));
__device__ __forceinline__ v4i16_t trrd(const LAS unsigned char* p) { return __builtin_amdgcn_ds_read_tr16_b64_v4i16((LAS v4i16_t*)p); }
__device__ __forceinline__ void p13_dsa_mfma(Frame& F, const In& I, unsigned char* ws) {
    OPAQUE_TID(); KARGS(); const int lane = tid_ & 63, wave = __builtin_amdgcn_readfirstlane(tid_ >> 6), n = lane & 15, kq = lane >> 4;
    LAS unsigned char* bkt = F.lds + TAB_BKT; LAS float* b12 = (LAS float*)(F.lds + TAB_B12);
    for (int i = tid_; i < 1536; i += NWAVES * 64) bkt[i] = (unsigned char)rel_bucket(i);
    for (int i = tid_; i < 512; i += NWAVES * 64) b12[i] = ((i & 15) < 12) ? Ip->rel_bias[(i >> 4) * 12 + (i & 15)] * LOG2E : 0.f;
    __syncthreads();
    LAS unsigned char* imgb = F.lds + RING_OFF + wave * 17408; LAS int* sidx = (LAS int*)(imgb + 16384);
    const bf16* QA = (const bf16*)(ws + WS_QA); const bf16* CKV = (const bf16*)(ws + WS_CKV); const bf16* PR = (const bf16*)(ws + WS_PROJ1);
    const unsigned short* SEL = (const unsigned short*)(ws + WS_SEL); const int* CNT = (const int*)(ws + WS_CNT);
    const bf16* MKB = (const bf16*)(ws + WS_MKB) + (size_t)512 * 256; const bf16* MVT = (const bf16*)(ws + WS_MVT) + (size_t)256 * 512;
    bf16* CAT1 = (bf16*)(ws + WS_CAT1);
    const int gw = blockIdx.x * NWAVES + wave, NGW = F.G * NWAVES;
    const LAS float* b12c = b12 + (n < 12 ? n : 0);
    for (int row = gw; row < M; row += NGW) {
        const int b = row / T, t = row % T, rowb = b * T, cnt = __builtin_amdgcn_readfirstlane(CNT[row]);
        asm volatile("s_waitcnt lgkmcnt(0)" ::: "memory");
#pragma unroll
        for (int i = 0; i < 4; ++i) sidx[lane + 64 * i] = (int)SEL[(size_t)row * 256 + lane + 64 * i];
        bf16x8 qf[4];
#pragma unroll
        for (int ks = 0; ks < 4; ++ks) { bf16x8 v = ldg16(QA + (size_t)row * 1536 + (n < 12 ? n : 0) * 128 + 32 * ks + 8 * kq); if (n >= 12) v = (bf16x8){0, 0, 0, 0, 0, 0, 0, 0}; qf[ks] = v; }
        float m = -1e30f, l = 0.f; f32x4 O[8];
#pragma unroll
        for (int rt = 0; rt < 8; ++rt) O[rt] = (f32x4){0.f, 0.f, 0.f, 0.f};
#define DSA_GATHER(c0_, buf_) do { int ln2_ = lane; asm volatile("" : "+v"(ln2_)); \
            _Pragma("unroll") for (int i = 0; i < 8; ++i) { const int rr = 4 * i + (ln2_ >> 4), pos = ln2_ & 15, e = (c0_) + rr; const int kidx = sidx[e < cnt ? e : 0]; \
                const unsigned chs = (unsigned)pos ^ ((((unsigned)rr & 3u) << 2) | (((unsigned)rr >> 2) & 3u)); \
                __builtin_amdgcn_global_load_lds((const unsigned*)(CKV + (size_t)(rowb + kidx) * 128 + 8 * chs), (LAS unsigned*)(imgb + (buf_) * 8192 + i * 1024), 16, 0, 0); } } while (0)
        asm volatile("s_waitcnt lgkmcnt(0)" ::: "memory");
        DSA_GATHER(0, 0);
        for (int c0 = 0; c0 < cnt; c0 += 32) {
            const int cb = (c0 >> 5) & 1; LAS unsigned char* img = imgb + cb * 8192;
            if (c0 + 32 < cnt) { DSA_GATHER(c0 + 32, cb ^ 1); asm volatile("s_waitcnt vmcnt(8)" ::: "memory"); } else asm volatile("s_waitcnt vmcnt(0)" ::: "memory");
            int ln_ = lane; asm volatile("" : "+v"(ln_));
            const bool has = m > -1e29f; const float mref = has ? m : 0.f; const float cinv = -mref;
            f32x4 sa = {cinv, cinv, cinv, cinv}, sb = sa;
            { const unsigned ra = 8u * ((unsigned)(ln_ & 15) >> 2) + ((unsigned)ln_ & 3u), kq_ = (unsigned)ln_ >> 4;
#pragma unroll
              for (int s = 0; s < 4; ++s) { const bf16x8 ka = *(const LAS bf16x8*)(img + offb(ra, 4 * s + kq_)); const bf16x8 kb = *(const LAS bf16x8*)(img + offb(ra + 4, 4 * s + kq_));
                  sa = MFMA16(ka, qf[s], sa); sb = MFMA16(kb, qf[s], sb); } }
#pragma unroll
            for (int i = 0; i < 4; ++i) { const int ea = c0 + 8 * kq + i, eb = ea + 4;
                { const int d = t - sidx[ea < cnt ? ea : 0]; const int dc = d > 1535 ? 1535 : (d < 0 ? 0 : d); sa[i] = (ea < cnt) ? sa[i] + b12c[(int)bkt[dc] * 16] : -INFINITY; }
                { const int d = t - sidx[eb < cnt ? eb : 0]; const int dc = d > 1535 ? 1535 : (d < 0 ? 0 : d); sb[i] = (eb < cnt) ? sb[i] + b12c[(int)bkt[dc] * 16] : -INFINITY; } }
            float lm = lmax8(sa, sb); float fsc = 1.f;
            if (__any((lm > SM_THR) || (!has && lm > -INFINITY))) {
                lm = fmaxf(lm, __shfl_xor(lm, 16)); lm = fmaxf(lm, __shfl_xor(lm, 32));
                const bool upd = (lm > -INFINITY) && (!has || lm > 0.f); const float dl = upd ? lm : 0.f;
                if (upd) m = mref + dl;
                fsc = has ? __builtin_amdgcn_exp2f(-dl) : 1.f; l *= fsc;
#pragma unroll
                for (int i = 0; i < 4; ++i) { sa[i] -= dl; sb[i] -= dl; }
#pragma unroll
                for (int rt = 0; rt < 8; ++rt) O[rt] = O[rt] * fsc;
            }
            f32x4 pa, pb; float sum = 0.f;
#pragma unroll
            for (int i = 0; i < 4; ++i) { pa[i] = __builtin_amdgcn_exp2f(sa[i]); pb[i] = __builtin_amdgcn_exp2f(sb[i]); sum += pa[i] + pb[i]; }
            l += sum;
            const bf16x8 pf = pack8(pa, pb);
            { const unsigned g_ = (unsigned)ln_ >> 4, q_ = ((unsigned)ln_ & 15u) >> 2, p_ = (unsigned)ln_ & 3u;
#pragma unroll
              for (int rt = 0; rt < 8; ++rt) { const v4i16_t x0 = trrd(img + offb(8 * g_ + q_, 2 * rt + (p_ >> 1)) + 8 * (p_ & 1)), x1 = trrd(img + offb(8 * g_ + 4 + q_, 2 * rt + (p_ >> 1)) + 8 * (p_ & 1));
                  const bf16x8 vf = {x0[0], x0[1], x0[2], x0[3], x1[0], x1[1], x1[2], x1[3]};
                  O[rt] = MFMA16(vf, pf, O[rt]); } }
        }
#undef DSA_GATHER
        const float il = 1.f / kqsum(l);
        if (n < 12) { bf16* op = CAT1 + (size_t)row * 1792 + n * 128 + 4 * kq;
#pragma unroll
            for (int rt = 0; rt < 8; ++rt) *(uint2*)(op + 16 * rt) = make_uint2(pk2(O[rt][0] * il, O[rt][1] * il), pk2(O[rt][2] * il, O[rt][3] * il)); }
    }
    for (int u8 = gw; u8 < M / 8; u8 += NGW) {
        const int row0 = 8 * u8, b = row0 / T; const int r = n;
#pragma unroll 1
        for (int hm = 0; hm < 4; ++hm) {
            bf16x8 qm[2]; { const bf16* qp = PR + (size_t)(row0 + (n & 7)) * 768 + 456 + hm * 64 + 8 * kq; qm[0] = ldg16(qp); qm[1] = ldg16(qp + 32); if (n >= 8) { qm[0] = (bf16x8){0, 0, 0, 0, 0, 0, 0, 0}; qm[1] = qm[0]; } }
            float mm = -1e30f, ll = 0.f; f32x4 Om[4];
#pragma unroll
            for (int dt = 0; dt < 4; ++dt) Om[dt] = (f32x4){0.f, 0.f, 0.f, 0.f};
            const bf16* mk = MKB + (size_t)(b * 256) * 256 + hm * 64; const bf16* mvt = MVT + (size_t)(hm * 64) * 512 + b * 256;
            for (int key0 = 0; key0 < 256; key0 += 32) { int r_ = r, kq_ = kq; asm volatile("" : "+v"(r_), "+v"(kq_)); KF k; load_k(k, mk, 256, key0, r_, kq_); VF v; load_vt(v, mvt, 512, key0, r_, kq_);
                f32x4 sa, sb; qk(sa, sb, k, qm); sa = sa * (0.125f * LOG2E); sb = sb * (0.125f * LOG2E); pv(Om, v, sm_update(sa, sb, mm, ll, Om)); }
            const float il = 1.f / kqsum(ll);
            if (n < 8) { bf16* op = CAT1 + (size_t)(row0 + n) * 1792 + 1536 + hm * 64 + 4 * kq;
#pragma unroll
                for (int dt = 0; dt < 4; ++dt) *(uint2*)(op + 16 * dt) = make_uint2(pk2(Om[dt][0] * il, Om[dt][1] * il), pk2(Om[dt][2] * il, Om[dt][3] * il)); }
        }
    }
}

struct Args { In in; float* out; unsigned char* ws; int ph_lo, ph_hi; };
__global__ void __launch_bounds__(NWAVES * 64, 2) mk_fwd(Args args) {
    extern __shared__ __attribute__((aligned(16))) unsigned char lds[];
    Frame F;
    F.lds = (LAS unsigned char*)lds; F.MISC = (volatile LAS unsigned*)(F.lds + MISC_OFF);
    F.G = gridDim.x; { const int bx = blockIdx.x; F.vcu = (F.G % 8 == 0) ? (bx % 8) * (F.G / 8) + bx / 8 : bx; }
    unsigned char* ws = args.ws; const In& I = args.in; float* out = args.out; (void)I;
    F.ctl = (gu32*)(ws + WS_CTL);
    for (int u = threadIdx.x; u < (LDS_BYTES - LDSCTL_OFF) / 4; u += NWAVES * 64) ((LAS unsigned*)(F.lds + LDSCTL_OFF))[u] = 0u;
    __syncthreads();
    XcdBarrier bar; bar.bar = (unsigned*)(F.ctl + CW_BAR); bar.x = 0; bar.st = nullptr;
    if (!MK_SPLIT) bar = xcd_barrier_post((unsigned*)(F.ctl + CW_BAR), F.MISC + 8);
    const int lo = args.ph_lo, hi = args.ph_hi;
#ifndef PH_MASK
#define PH_MASK 0xFFFFFFFFu
#endif
#define IN(k) ((((PH_MASK) >> ((k) % 32)) & 1u) && lo <= (k) && (k) < hi)
#define SEAM(k) do { if (IN(k) && IN((k) + 1)) xcd_barrier(bar); } while (0)
#define SEAM2(k, kn) do { if (IN(k) && IN(kn)) xcd_barrier(bar); } while (0)
#ifndef REP_MASK
#define REP_MASK 0u
#endif
#define REPS(k) (1 + (int)(((REP_MASK) >> (k)) & 1u))
    bf16* XN = (bf16*)(ws + WS_XN); bf16* CAT = (bf16*)(ws + WS_CAT); bf16* ACT = (bf16*)(ws + WS_ACT);
    float* SSQ = (float*)(ws + WS_CTL + 512 * 1024);

    if (IN(0)) { for (int r_ = 0; r_ < REPS(0); ++r_) { p0_prologue(F, I, ws); if (r_ + 1 < REPS(0)) xcd_barrier(bar); } SEAM(0); }
    {
            if (IN(1)) {
                pg8::Gemm g{XN, (const bf16*)(ws + WS_WIN0), M, 1792, D}; pg8::StaticOrder S; S.init(M, 1792, F.G, (int)blockIdx.x);
                pg8::EpiRoute<0> E{ws, nullptr};
                for (int r_ = 0; r_ < REPS(1); ++r_) { if (r_) xcd_barrier(bar);
                pg8::gemm_phase<pg8::EpiRoute<0>, pg8::StaticOrder, true, true>(F.lds + RING_OFF, g, S, E); }
                pg8::Gemm g2{(const bf16*)(ws + WS_WVT), XN, 256, M, D}; pg8::StaticOrder S2; S2.init(256, M, F.G, (int)((blockIdx.x + 64) % F.G));
                pg8::EpiRoute<3> E2{ws, nullptr};
                pg8::gemm_phase<pg8::EpiRoute<3>, pg8::StaticOrder, true, true>(F.lds + RING_OFF, g2, S2, E2);
                SEAM(1);
            }
            if (IN(2)) { for (int r_ = 0; r_ < REPS(2); ++r_) { p2_mfma(F, I, ws); if (r_ + 1 < REPS(2)) xcd_barrier(bar); } SEAM(2); }
            if (IN(3)) { for (int r_ = 0; r_ < REPS(3); ++r_) { p3_nsa_mfma(F, I, ws); if (r_ + 1 < REPS(3)) xcd_barrier(bar); } SEAM(3); }
    }
    {
        constexpr int L = 0, pb = L ? 14 : 4;
        if (IN(pb)) {
            pg8::Gemm g{L ? (const bf16*)(ws + WS_CAT1) : CAT, L ? (const bf16*)(ws + WS_WO1F) : (const bf16*)(ws + WS_WO), M, D, L ? 1792 : D}; pg8::StaticOrder S; S.init(M, D, F.G, (int)blockIdx.x);
            KARGS(); pg8::EpiResid E{L ? (const float*)out : Ip->x, out, XN, SSQ + (L ? 2 : 0) * M, D, 0};
            pg8::gemm_phase<pg8::EpiResid, pg8::StaticOrder, true, true>(F.lds + RING_OFF, g, S, E);
            SEAM2(pb, pb + 2);
        }
        if (IN(pb + 2)) {
            pg8::Gemm g{XN, (const bf16*)(ws + WS_WGU) + (size_t)L * 2 * DFF * D, M, 2 * DFF, D}; pg8::StaticOrder S; S.init(M, 2 * DFF, F.G, (int)blockIdx.x);
            pg8::EpiSwiglu E{ACT, SSQ + (L ? 2 : 0) * M, DFF, 0};
            for (int r_ = 0; r_ < REPS(pb + 2); ++r_) { if (r_) xcd_barrier(bar);
            pg8::gemm_phase<pg8::EpiSwiglu, pg8::StaticOrder, true, true>(F.lds + RING_OFF, g, S, E); }
            SEAM(pb + 2);
        }
        if (IN(pb + 3)) {
            pg8::Gemm g{ACT, (const bf16*)(ws + WS_WD) + (size_t)L * D * DFF, M, D, DFF}; pg8::StaticOrder S; S.init(M, D, F.G, (int)blockIdx.x);
            pg8::EpiResid E{out, out, L ? nullptr : XN, SSQ + (L ? 3 : 1) * M, D, 0};
            pg8::gemm_phase<pg8::EpiResid, pg8::StaticOrder, true, true>(F.lds + RING_OFF, g, S, E);
            SEAM2(pb + 3, L ? 18 : 9);
        }
        }
    {
            if (IN(9)) {
                pg8::Gemm g{XN, (const bf16*)(ws + WS_WIN1), M, 768, D}; pg8::StaticOrder S; S.init(M, 768, F.G, (int)blockIdx.x);
                pg8::EpiRoute<1> E{ws, SSQ + 1 * M};
                for (int r_ = 0; r_ < REPS(9); ++r_) { if (r_) xcd_barrier(bar);
                pg8::gemm_phase<pg8::EpiRoute<1>, pg8::StaticOrder, true, true>(F.lds + RING_OFF, g, S, E); }
                SEAM(9);
            }
            if (IN(10)) { p10_dsa_norm(F, I, ws); SEAM(10); }
            if (IN(11)) {
                pg8::Gemm g{(const bf16*)(ws + WS_CQ), (const bf16*)(ws + WS_WQ2), M, 2048, 256}; pg8::StaticOrder S; S.init(M, 2048, F.G, (int)blockIdx.x);
                pg8::EpiRoute<2> E{ws, nullptr};
                for (int r_ = 0; r_ < REPS(11); ++r_) { if (r_) xcd_barrier(bar);
                pg8::gemm_phase<pg8::EpiRoute<2>, pg8::StaticOrder, true, true>(F.lds + RING_OFF, g, S, E); }
                SEAM(11);
            }
            if (IN(12)) { for (int r_ = 0; r_ < REPS(12); ++r_) { p12_index_mfma(F, I, ws); if (r_ + 1 < REPS(12)) xcd_barrier(bar); } SEAM(12); }
            if (IN(13)) { for (int r_ = 0; r_ < REPS(13); ++r_) { p13_dsa_mfma(F, I, ws); if (r_ + 1 < REPS(13)) xcd_barrier(bar); } SEAM(13); }
            }
    {
        constexpr int L = 1, pb = L ? 14 : 4;
        if (IN(pb)) {
            pg8::Gemm g{L ? (const bf16*)(ws + WS_CAT1) : CAT, L ? (const bf16*)(ws + WS_WO1F) : (const bf16*)(ws + WS_WO), M, D, L ? 1792 : D}; pg8::StaticOrder S; S.init(M, D, F.G, (int)blockIdx.x);
            KARGS(); pg8::EpiResid E{L ? (const float*)out : Ip->x, out, XN, SSQ + (L ? 2 : 0) * M, D, 0};
            pg8::gemm_phase<pg8::EpiResid, pg8::StaticOrder, true, true>(F.lds + RING_OFF, g, S, E);
            SEAM2(pb, pb + 2);
        }
        if (IN(pb + 2)) {
            pg8::Gemm g{XN, (const bf16*)(ws + WS_WGU) + (size_t)L * 2 * DFF * D, M, 2 * DFF, D}; pg8::StaticOrder S; S.init(M, 2 * DFF, F.G, (int)blockIdx.x);
            pg8::EpiSwiglu E{ACT, SSQ + (L ? 2 : 0) * M, DFF, 0};
            for (int r_ = 0; r_ < REPS(pb + 2); ++r_) { if (r_) xcd_barrier(bar);
            pg8::gemm_phase<pg8::EpiSwiglu, pg8::StaticOrder, true, true>(F.lds + RING_OFF, g, S, E); }
            SEAM(pb + 2);
        }
        if (IN(pb + 3)) {
            pg8::Gemm g{ACT, (const bf16*)(ws + WS_WD) + (size_t)L * D * DFF, M, D, DFF}; pg8::StaticOrder S; S.init(M, D, F.G, (int)blockIdx.x);
            pg8::EpiResid E{out, out, L ? nullptr : XN, SSQ + (L ? 3 : 1) * M, D, 0};
            pg8::gemm_phase<pg8::EpiResid, pg8::StaticOrder, true, true>(F.lds + RING_OFF, g, S, E);
            SEAM2(pb + 3, L ? 18 : 9);
        }
        }
    if (IN(18)) {
        OPAQUE_TID(); KARGS(); const int lane_ = tid_ & 63;
        const int gw = F.vcu * NWAVES + (tid_ >> 6), NGW = F.G * NWAVES;
        for (int m = gw; m < M; m += NGW) { GAS f32x4* xr = (GAS f32x4*)(out + (size_t)m * D) + lane_; const GAS f32x4* gr = (const GAS f32x4*)Ip->norm_final + lane_;
            const float r = rsqrtf(SSQ[3 * M + m] * (1.f / D) + EPSF);
#pragma unroll
            for (int j = 0; j < 4; ++j) { const f32x4 g = gr[64 * j]; xr[64 * j] = (xr[64 * j] * r) * g; } }
    }
#undef IN
#undef SEAM
}

extern "C" void kernel_launch(void* const* d_in, const int* in_sizes, int n_in, void* d_out, int out_size, void* d_ws, size_t ws_size, hipStream_t stream) {
    static int grid = 0;
    if (grid == 0) {
        if (n_in != 32 || out_size != M * D || ws_size < WS_END) { fprintf(stderr, "kernel_launch: unexpected shapes (n_in %d out %d ws %zu)\n", n_in, out_size, ws_size); grid = -1; return; }
        int dev = 0, cus = 0, per_cu = 0;
        if (hipGetDevice(&dev) != hipSuccess || hipDeviceGetAttribute(&cus, hipDeviceAttributeMultiprocessorCount, dev) != hipSuccess) { grid = -1; return; }
        if (hipFuncSetAttribute((const void*)mk_fwd, hipFuncAttributeMaxDynamicSharedMemorySize, LDS_BYTES) != hipSuccess) { grid = -1; return; }
        if (hipOccupancyMaxActiveBlocksPerMultiprocessor(&per_cu, (const void*)mk_fwd, NWAVES * 64, LDS_BYTES) != hipSuccess || per_cu < 1) fprintf(stderr, "kernel_launch: occupancy query reports %d\n", per_cu);
        (void)hipGetLastError();
        grid = cus;
        if (grid > 256) grid = 256;
    }
    if (grid < 0) return;
    if (hipMemsetAsync((char*)d_ws + WS_CTL, 0, CTL_ZERO_BYTES, stream) != hipSuccess) return;
    Args a{};
    const float** ip = (const float**)&a.in;
    for (int i = 0; i < 32; ++i) ip[i] = (const float*)d_in[i];
    a.out = (float*)d_out; a.ws = (unsigned char*)d_ws;
#if MK_SPLIT
    for (int k = 0; k < N_PHASES; ++k) { a.ph_lo = k; a.ph_hi = k + 1; hipLaunchKernelGGL(mk_fwd, dim3(grid), dim3(NWAVES * 64), LDS_BYTES, stream, a); }
#else
    a.ph_lo = 0; a.ph_hi = N_PHASES; hipLaunchKernelGGL(mk_fwd, dim3(grid), dim3(NWAVES * 64), LDS_BYTES, stream, a);
#endif
}
```

```cpp
#include <hip/hip_runtime.h>
#include <cstdio>
#include <cstdint>
#include <math.h>

namespace pg8 {
#define PG8_LAS __attribute__((address_space(3)))
typedef unsigned short bf16_t;
typedef short bf16x8 __attribute__((ext_vector_type(8)));
typedef float f32x4 __attribute__((ext_vector_type(4)));
typedef unsigned u32x4 __attribute__((ext_vector_type(4)));
constexpr int BM = 256, BK = 64, HALF = 128, HTB = HALF * BK * 2  , STAGE_BYTES = 8 * HTB, NXCD = 8, WGM = 8;

__host__ __device__ __forceinline__ int lds_byte(int r, int c) { const int st = (r >> 4) * 2 + (c >> 5), rr = r & 15, cc = c & 31, ob = rr * 64 + cc * 2; return st * 1024 + (ob ^ (((ob >> 9) & 1) << 5)); }
__host__ __device__ __forceinline__ void stage_rc(int b, int& R, int& C) { const int st = b / 1024, sb = b % 1024, swz = sb ^ (((sb >> 9) & 1) << 5); R = (st >> 1) * 16 + swz / 64; C = (st & 1) * 32 + (swz % 64) / 2; }
__host__ __device__ __forceinline__ int perm32(int rho) { const int n = rho >> 4, i = rho & 15; return 8 * (i >> 2) + 4 * n + (i & 3); }

struct Unit { int pm, pn; };
struct Gemm { const bf16_t* A; const bf16_t* Bt; int M, N, K; };

struct StaticOrder {
    int nM, nN, nwg, G, c;
    __host__ __device__ void init(int M, int N, int G_, int c_) { nM = M / BM; nN = N / BM; nwg = nM * nN; G = G_; c = c_; }
    __host__ __device__ bool next(int i, Unit& u) const {
        const long L = (long)i * G + c; if (L >= nwg) return false;
        int wgid = (int)L; { const int q = nwg / NXCD, r = nwg % NXCD, xcd = wgid % NXCD, off = wgid / NXCD; wgid = (xcd < r ? xcd * (q + 1) : r * (q + 1) + (xcd - r) * q) + off; }
        const int nig = WGM * nN, gid = wgid / nig, fm = gid * WGM, gsz = (nM - fm) < WGM ? (nM - fm) : WGM;
        u.pm = fm + ((wgid % nig) % gsz); u.pn = (wgid % nig) / gsz; return true;
    }
    __device__ __forceinline__ void a_ready(const Unit&) const {}
    __device__ __forceinline__ void done(const Unit&) const {}
};

__device__ __forceinline__ unsigned cvt_pk_bf16(float lo, float hi) { unsigned r; asm volatile("v_cvt_pk_bf16_f32 %0, %1, %2" : "=v"(r) : "v"(lo), "v"(hi)); return r; }
__device__ __forceinline__ float ssq_row(const float* p) { const f32x4 a = ((const f32x4*)p)[0], b = ((const f32x4*)p)[1], c = ((const f32x4*)p)[2], d = ((const f32x4*)p)[3]; const f32x4 t = (a + b) + (c + d); return (t[0] + t[1]) + (t[2] + t[3]); }
template <int ROUTE> struct EpiRoute {
    static constexpr bool PERM = true, AFTER_DRAIN = false;
    unsigned char* ws; const float* ssq;
    __device__ __forceinline__ void operator()(const f32x4 (&acc)[2][2][4][2], const Unit& u, int wr, int wc, int fr, int fq) const {
        asm volatile("" : "+v"(fr), "+v"(fq));
        const int pn = u.pn; size_t off; int ld, t0; float sc;
        if constexpr (ROUTE == 0) {
            off = pn < 3 ? (size_t)(88u << 20) : pn < 5 ? (size_t)(112u << 20) : pn < 6 ? (size_t)(128u << 20) : (size_t)(136u << 20);
            ld = pn < 3 ? 768 : pn < 5 ? 512 : 256; t0 = pn < 3 ? 0 : pn < 5 ? 3 : pn < 6 ? 5 : 6; sc = (pn < 3 || pn == 5) ? 0.18033688011112042f : 1.f;
        } else if constexpr (ROUTE == 1) { off = (size_t)(88u << 20); ld = 768; t0 = 0; sc = 1.f; }
        else if constexpr (ROUTE == 3) { off = (size_t)(144u << 20); ld = 16384; t0 = 0; sc = 1.f; }
        else { off = pn < 6 ? (size_t)(128u << 20) : (size_t)(176u << 20); ld = pn < 6 ? 1536 : 512; t0 = pn < 6 ? 0 : 6; sc = 1.f; }
        bf16_t* base = (bf16_t*)(ws + off);
        const int row0 = u.pm * BM + wr * 64 + fr, col0 = (pn - t0) * BM + wc * 32 + 8 * fq;
#pragma unroll
        for (int ai = 0; ai < 2; ++ai)
#pragma unroll
            for (int m = 0; m < 4; ++m) { bf16_t* rowp = base + (size_t)(row0 + ai * HALF + m * 16) * ld + col0;
                float scr_ = sc; if constexpr (ROUTE == 1) scr_ = rsqrtf(ssq_row(ssq + (size_t)(row0 + ai * HALF + m * 16) * 16) * (1.f / 1024.f) + 1e-6f);
#pragma unroll
                for (int bj = 0; bj < 2; ++bj) { const f32x4 v0 = acc[ai][bj][m][0] * scr_, v1 = acc[ai][bj][m][1] * scr_;
                    u32x4 w; w.x = cvt_pk_bf16(v0[0], v0[1]); w.y = cvt_pk_bf16(v0[2], v0[3]); w.z = cvt_pk_bf16(v1[0], v1[1]); w.w = cvt_pk_bf16(v1[2], v1[3]);
                    if constexpr (ROUTE == 3) {
                        const int tok = col0 + bj * HALF, rw = row0 + ai * HALF + m * 16; *(u32x4*)(base + ((size_t)(tok >> 6) * 256 + rw) * 64 + (tok & 63)) = w; }
                    else *(u32x4*)(rowp + bj * HALF) = w; } }
    }
};
template <bool RES_F32>
struct EpiResid {
    static constexpr bool PERM = true, AFTER_DRAIN = false;
    const void* res; bf16_t* hb; float* ssq; int ldc; int pad;
    __device__ __forceinline__ void operator()(const f32x4 (&acc)[2][2][4][2], const Unit& u, int wr, int wc, int fr, int fq) const {
        asm volatile("" : "+v"(fr), "+v"(fq));
        const int row0 = u.pm * BM + wr * 64 + fr, col0 = u.pn * BM + wc * 32 + 8 * fq;
#pragma unroll
        for (int ai = 0; ai < 2; ++ai)
#pragma unroll
            for (int m = 0; m < 4; ++m) { const int row = row0 + ai * HALF + m * 16; const size_t off = (size_t)row * ldc + col0; float sq = 0.f;
#pragma unroll
                for (int bj = 0; bj < 2; ++bj) { f32x4 v[2];
                    if constexpr (RES_F32) {
#pragma unroll
                        for (int n = 0; n < 2; ++n) v[n] = *(const f32x4*)((const float*)res + off + bj * HALF + 4 * n) + acc[ai][bj][m][n];
                    } else { const u32x4 rw = *(const u32x4*)((const bf16_t*)res + off + bj * HALF);
                        f32x4 r0, r1; r0[0] = __uint_as_float(rw.x << 16); r0[1] = __uint_as_float(rw.x & 0xffff0000u); r0[2] = __uint_as_float(rw.y << 16); r0[3] = __uint_as_float(rw.y & 0xffff0000u);
                        r1[0] = __uint_as_float(rw.z << 16); r1[1] = __uint_as_float(rw.z & 0xffff0000u); r1[2] = __uint_as_float(rw.w << 16); r1[3] = __uint_as_float(rw.w & 0xffff0000u);
                        v[0] = r0 + acc[ai][bj][m][0]; v[1] = r1 + acc[ai][bj][m][1]; }
#pragma unroll
                    for (int n = 0; n < 2; ++n) sq += (v[n][0] * v[n][0] + v[n][1] * v[n][1]) + (v[n][2] * v[n][2] + v[n][3] * v[n][3]);
                    u32x4 w; w.x = cvt_pk_bf16(v[0][0], v[0][1]); w.y = cvt_pk_bf16(v[0][2], v[0][3]); w.z = cvt_pk_bf16(v[1][0], v[1][1]); w.w = cvt_pk_bf16(v[1][2], v[1][3]); *(u32x4*)(hb + off + bj * HALF) = w; }
                sq += __shfl_xor(sq, 16); sq += __shfl_xor(sq, 32); if (fq == 0) ssq[(size_t)row * 16 + u.pn * 4 + wc] = sq; }
    }
};
struct EpiSwiglu {
    static constexpr bool PERM = true, AFTER_DRAIN = false;
    bf16_t* O; const float* ssq; int ldc; int pad;
    __device__ __forceinline__ void operator()(const f32x4 (&acc)[2][2][4][2], const Unit& u, int wr, int wc, int fr, int fq) const {
        asm volatile("" : "+v"(fr), "+v"(fq));
        const int row0 = u.pm * BM + wr * 64 + fr, col0 = u.pn * HALF + wc * 32 + 8 * fq;
#pragma unroll
        for (int ai = 0; ai < 2; ++ai)
#pragma unroll
            for (int m = 0; m < 4; ++m) { float o[8]; const float rs = rsqrtf(ssq_row(ssq + (size_t)(row0 + ai * HALF + m * 16) * 16) * (1.f / 1024.f) + 1e-6f);
#pragma unroll
                for (int n = 0; n < 2; ++n)
#pragma unroll
                    for (int e = 0; e < 4; ++e) { const float g = acc[ai][0][m][n][e] * rs, up = acc[ai][1][m][n][e] * rs; o[4 * n + e] = (g * __builtin_amdgcn_rcpf(1.f + __expf(-g))) * up; }
                u32x4 w; w.x = cvt_pk_bf16(o[0], o[1]); w.y = cvt_pk_bf16(o[2], o[3]); w.z = cvt_pk_bf16(o[4], o[5]); w.w = cvt_pk_bf16(o[6], o[7]);
                *(u32x4*)(O + (size_t)(row0 + ai * HALF + m * 16) * ldc + col0) = w; }
    }
};
template <class Epi, class Sched, bool ALIGN_EPI = false, bool SP2 = false>
__device__ __forceinline__ void gemm_phase(PG8_LAS unsigned char* lds, const Gemm g, const Sched& S, const Epi& E) {
    int tid = threadIdx.x; asm volatile("" : "+v"(tid));
    const int wid = __builtin_amdgcn_readfirstlane(tid >> 6), lane = tid & 63, wr = wid >> 2, wc = wid & 3, fr = lane & 15, fq = lane >> 4;
    int K = g.K; asm volatile("" : "+s"(K));
    const int nt = K / BK;
    unsigned voffA[2], voffB[2];
#pragma unroll
    for (int i = 0; i < 2; ++i) { int R, C; stage_rc(tid * 16 + i * 8192, R, C); const int Rb = Epi::PERM ? ((R & ~31) + perm32(R & 31)) : R;
        voffA[i] = (unsigned)(R * K + C) * 2u; voffB[i] = (unsigned)(Rb * K + C) * 2u; }
    const size_t kstep = (size_t)(BK * 2);
    const size_t hstep = (size_t)HALF * K * 2;
    const size_t tstep = 2 * hstep;
    const unsigned ldsw = (unsigned)wid * 1024u;
    const int aoff = lds_byte(wr * 64 + fr, fq * 8), boff = lds_byte(wc * 32 + fr, fq * 8);
#define PG8_SA(b, h) (((b) * 2 + (h)) * HTB)
#define PG8_SB(b, h) ((4 + (b) * 2 + (h)) * HTB)
#define PG8_STAGE(bufoff, gbase, voff) do { _Pragma("unroll") for (int _i = 0; _i < 2; ++_i) \
        __builtin_amdgcn_global_load_lds((const unsigned*)((const char*)(gbase) + (voff)[_i]), (PG8_LAS unsigned*)(lds + (bufoff) + ldsw + _i * 8192), 16, 0, 0); } while (0)
#define PG8_LDA(dst, b, h) do { _Pragma("unroll") for (int m = 0; m < 4; ++m) _Pragma("unroll") for (int k = 0; k < 2; ++k) dst[m][k] = *(const PG8_LAS bf16x8*)(lds + PG8_SA(b, h) + aoff + m * 2048 + k * 1024); } while (0)
#define PG8_LDB(dst, b, h) do { _Pragma("unroll") for (int n = 0; n < 2; ++n) _Pragma("unroll") for (int k = 0; k < 2; ++k) dst[n][k] = *(const PG8_LAS bf16x8*)(lds + PG8_SB(b, h) + boff + n * 2048 + k * 1024); } while (0)
#define PG8_MMA(ai, bj, At, Bt) do { __builtin_amdgcn_s_setprio(1); _Pragma("unroll") for (int m = 0; m < 4; ++m) _Pragma("unroll") for (int n = 0; n < 2; ++n) _Pragma("unroll") for (int k = 0; k < 2; ++k) \
        acc[ai][bj][m][n] = __builtin_amdgcn_mfma_f32_16x16x32_bf16(Bt[n][k], At[m][k], acc[ai][bj][m][n], 0, 0, 0); __builtin_amdgcn_s_setprio(0); } while (0)
#define PG8_WAIT_V(n) asm volatile("s_waitcnt vmcnt(" #n ")" ::: "memory")
#define PG8_WAIT_L(n) asm volatile("s_waitcnt lgkmcnt(" #n ")" ::: "memory")
#define PG8_BAR __builtin_amdgcn_s_barrier()
#define PG8_SCHED __builtin_amdgcn_sched_barrier(0)
    Unit cur, nxt; int ui = 0;
    if (!S.next(0, cur)) return;
    f32x4 acc[2][2][4][2];
#pragma unroll
    for (int a = 0; a < 2; ++a)
#pragma unroll
        for (int b = 0; b < 2; ++b)
#pragma unroll
            for (int m = 0; m < 4; ++m)
#pragma unroll
                for (int n = 0; n < 2; ++n) acc[a][b][m][n] = (f32x4){0.f, 0.f, 0.f, 0.f};
    bf16x8 At[4][2], B0[2][2], B1[2][2];
    const char* cA = (const char*)g.A + (size_t)cur.pm * tstep; const char* cB = (const char*)g.Bt + (size_t)cur.pn * tstep;
    S.a_ready(cur);
    if constexpr (SP2) {
        PG8_STAGE(PG8_SB(0, 0), cB, voffB); PG8_STAGE(PG8_SB(0, 1), cB + hstep, voffB); PG8_STAGE(PG8_SA(0, 0), cA, voffA); PG8_STAGE(PG8_SA(0, 1), cA + hstep, voffA);
        if (wr == 1) PG8_BAR;
        PG8_WAIT_V(2); PG8_BAR;
        PG8_STAGE(PG8_SB(1, 0), cB + kstep, voffB); PG8_STAGE(PG8_SA(1, 0), cA + kstep, voffA); PG8_STAGE(PG8_SB(1, 1), cB + hstep + kstep, voffB);
        PG8_WAIT_V(6); PG8_BAR;
    } else {
        PG8_STAGE(PG8_SB(0, 0), cB, voffB); PG8_STAGE(PG8_SA(0, 0), cA, voffA); PG8_STAGE(PG8_SB(0, 1), cB + hstep, voffB); PG8_STAGE(PG8_SA(0, 1), cA + hstep, voffA);
        if (wr == 1) PG8_BAR;
        PG8_WAIT_V(4); PG8_BAR;
        PG8_STAGE(PG8_SB(1, 0), cB + kstep, voffB); PG8_STAGE(PG8_SA(1, 0), cA + kstep, voffA); PG8_STAGE(PG8_SB(1, 1), cB + hstep + kstep, voffB);
        PG8_WAIT_V(6); PG8_BAR;
    }
    for (;;) {
        const bool has_next = S.next(ui + 1, nxt);
        const char* nA = has_next ? (const char*)g.A + (size_t)nxt.pm * tstep : cA; const char* nB = has_next ? (const char*)g.Bt + (size_t)nxt.pn * tstep : cB;
        for (int t = 0; t < nt; t += 2) {
            const bool last = (t == nt - 2);
            const char* a1 = cA + (size_t)(t + 1) * kstep;
            const char* a2 = last ? nA : cA + (size_t)(t + 2) * kstep; const char* b2 = last ? nB : cB + (size_t)(t + 2) * kstep;
            const char* a3 = a2 + kstep; const char* b3 = b2 + kstep;
            if (last && has_next) S.a_ready(nxt);
            if constexpr (SP2) {
            PG8_LDB(B0, 0, 0); PG8_LDB(B1, 0, 1); PG8_SCHED; PG8_LDA(At, 0, 0); PG8_STAGE(PG8_SA(1, 1), a1 + hstep, voffA);
            PG8_WAIT_V(8); PG8_WAIT_L(0); PG8_BAR; PG8_MMA(0, 0, At, B0); PG8_MMA(0, 1, At, B1); PG8_BAR; PG8_SCHED;
            PG8_LDA(At, 0, 1); PG8_STAGE(PG8_SB(0, 0), b2, voffB); PG8_STAGE(PG8_SB(0, 1), b2 + hstep, voffB); PG8_STAGE(PG8_SA(0, 0), a2, voffA);
            PG8_WAIT_V(8); PG8_WAIT_L(0); PG8_BAR; PG8_MMA(1, 0, At, B0); PG8_MMA(1, 1, At, B1); PG8_BAR; PG8_SCHED;
            PG8_LDB(B0, 1, 0); PG8_LDB(B1, 1, 1); PG8_SCHED; PG8_LDA(At, 1, 0); PG8_STAGE(PG8_SA(0, 1), a2 + hstep, voffA);
            PG8_WAIT_V(8); PG8_WAIT_L(0); PG8_BAR; PG8_MMA(0, 0, At, B0); PG8_MMA(0, 1, At, B1); PG8_BAR; PG8_SCHED;
            PG8_LDA(At, 1, 1); PG8_STAGE(PG8_SB(1, 0), b3, voffB); PG8_STAGE(PG8_SB(1, 1), b3 + hstep, voffB); PG8_STAGE(PG8_SA(1, 0), a3, voffA);
            PG8_WAIT_V(8); PG8_WAIT_L(0); PG8_BAR; PG8_MMA(1, 0, At, B0); PG8_MMA(1, 1, At, B1); PG8_BAR; PG8_SCHED;
            } else {
            PG8_LDB(B0, 0, 0); PG8_SCHED; PG8_LDA(At, 0, 0); PG8_STAGE(PG8_SA(1, 1), a1 + hstep, voffA);
            PG8_WAIT_L(8); PG8_BAR; PG8_WAIT_L(0); PG8_MMA(0, 0, At, B0); PG8_BAR; PG8_SCHED;
            PG8_LDB(B1, 0, 1); PG8_STAGE(PG8_SB(0, 0), b2, voffB);
            PG8_BAR; PG8_WAIT_L(0); PG8_MMA(0, 1, At, B1); PG8_BAR;
            PG8_LDA(At, 0, 1); PG8_STAGE(PG8_SA(0, 0), a2, voffA);
            PG8_BAR; PG8_WAIT_L(0); PG8_MMA(1, 0, At, B0); PG8_BAR; PG8_SCHED;
            PG8_STAGE(PG8_SB(0, 1), b2 + hstep, voffB);
            PG8_WAIT_V(6); PG8_BAR; PG8_MMA(1, 1, At, B1); PG8_BAR;
            PG8_LDB(B0, 1, 0); PG8_SCHED; PG8_LDA(At, 1, 0); PG8_STAGE(PG8_SA(0, 1), a2 + hstep, voffA);
            PG8_WAIT_L(8); PG8_BAR; PG8_WAIT_L(0); PG8_MMA(0, 0, At, B0); PG8_BAR; PG8_SCHED;
            PG8_LDB(B1, 1, 1); PG8_STAGE(PG8_SB(1, 0), b3, voffB);
            PG8_BAR; PG8_WAIT_L(0); PG8_MMA(0, 1, At, B1); PG8_BAR;
            PG8_LDA(At, 1, 1); PG8_STAGE(PG8_SA(1, 0), a3, voffA);
            PG8_BAR; PG8_WAIT_L(0); PG8_MMA(1, 0, At, B0); PG8_BAR; PG8_SCHED;
            PG8_STAGE(PG8_SB(1, 1), b3 + hstep, voffB);
            PG8_WAIT_V(6); PG8_BAR; PG8_MMA(1, 1, At, B1); PG8_BAR;
            }
        }
        if constexpr (ALIGN_EPI) { if (wr == 0) PG8_BAR; }
        if constexpr (!Epi::AFTER_DRAIN) { E(acc, cur, wr, wc, fr, fq); S.done(cur); }
        if (!has_next) break;
#pragma unroll
        for (int a = 0; a < 2; ++a)
#pragma unroll
            for (int b = 0; b < 2; ++b)
#pragma unroll
                for (int m = 0; m < 4; ++m)
#pragma unroll
                    for (int n = 0; n < 2; ++n) acc[a][b][m][n] = (f32x4){0.f, 0.f, 0.f, 0.f};
        cur = nxt; cA = nA; cB = nB; ++ui;
        if constexpr (ALIGN_EPI) { if (wr == 1) PG8_BAR; }
    }
    PG8_WAIT_V(0);
    if constexpr (!ALIGN_EPI) { if (wr == 0) PG8_BAR; }
    PG8_BAR;
    if constexpr (Epi::AFTER_DRAIN) { E.fused(acc, cur, wr, wc, fr, fq, lds, wid, lane); S.done(cur); }
#undef PG8_SA
#undef PG8_SB
#undef PG8_STAGE
#undef PG8_LDA
#undef PG8_LDB
#undef PG8_MMA
#undef PG8_WAIT_V
#undef PG8_WAIT_L
#undef PG8_BAR
#undef PG8_SCHED
}
}
constexpr int NWAVES = 8;
constexpr int BATCH = 2, T = 8192, D = 1024, M = BATCH * T, DFF = 2816, NSA_IN = 1828, DSA_IN = 712, NCMP = 511, NCR = BATCH * NCMP * 2;
constexpr float NEGF = -1e30f, EPSF = 1e-6f;
#ifndef MK_SPLIT
#define MK_SPLIT 0
#endif
constexpr int N_PHASES = 19;
constexpr size_t MiB = 1u << 20;
constexpr size_t WS_CTL = 0, CTL_ZERO_BYTES = 1 * MiB;
constexpr size_t WS_KCB = 1 * MiB  , WS_VCT = 1 * MiB + 512 * 1024  , WS_MKB = 2 * MiB  , WS_MVT = 2 * MiB + 512 * 1024  , WS_MKV = 3 * MiB  , WS_WIDX = 5 * MiB  , WS_CNT = 6 * MiB  ;
constexpr size_t WS_WIN0 = 8 * MiB, WS_WO = 12 * MiB, WS_WGU = 16 * MiB, WS_WD = 38 * MiB, WS_WIN1 = 49 * MiB, WS_WQ2 = 51 * MiB, WS_WVT = 52 * MiB  ;
constexpr size_t WS_W1T = 232 * MiB, WS_MEMN = 234 * MiB, WS_WMKT = 236 * MiB, WS_W2T = 238 * MiB, WS_B1F = 238 * MiB + 64 * 1024;
constexpr size_t WS_XN = 56 * MiB;
constexpr size_t WS_Q0 = 88 * MiB, WS_KV0 = 112 * MiB  , WS_QM = 128 * MiB, WS_G0 = 136 * MiB, WS_VT = 144 * MiB  ;
static_assert(WS_Q0 == (88u << 20) && WS_KV0 == (112u << 20) && WS_QM == (128u << 20) && WS_G0 == (136u << 20), "EpiRoute tables");
constexpr size_t WS_ACT = 88 * MiB;
constexpr size_t WS_PROJ1 = 88 * MiB, WS_CQ = 112 * MiB, WS_CKV = 120 * MiB, WS_KIDX = 124 * MiB, WS_QA = 128 * MiB, WS_QI = 176 * MiB, WS_SEL = 112 * MiB  , WS_CAT1 = 176 * MiB  , WS_WO1F = 52 * MiB + 512 * 1024  ;
constexpr size_t WS_OCS = 152 * MiB  , WS_CAT = 200 * MiB, WS_SSQ = 239 * MiB  , WS_END = 243 * MiB;
static_assert(WS_PROJ1 == (88u << 20) && WS_QA == (128u << 20) && WS_QI == (176u << 20) && WS_VT == (144u << 20), "EpiRoute tables");
static_assert(WS_ACT + (size_t)M * DFF * 2 <= WS_CAT + 0 * MiB || true, "map");
constexpr int CW_BAR = 4096;
constexpr int RING_OFF = 0, RING_BYTES = 131072, LDS_BYTES = 163840, LDSCTL_OFF = LDS_BYTES - 1024, MISC_OFF = LDSCTL_OFF + 320;
#define GAS __attribute__((address_space(1)))
#define LAS __attribute__((address_space(3)))
typedef unsigned short bf16;
typedef unsigned v4u __attribute__((ext_vector_type(4)));
typedef float f32x4 __attribute__((ext_vector_type(4)));
typedef short bf16x8 __attribute__((ext_vector_type(8)));
typedef GAS unsigned gu32;
typedef GAS unsigned long long gu64;
#define RLX_AGENT __ATOMIC_RELAXED, __HIP_MEMORY_SCOPE_AGENT
#define LDS_WAIT() asm volatile("s_waitcnt lgkmcnt(0)" ::: "memory")
#define VM_WAIT() asm volatile("s_waitcnt vmcnt(0)" ::: "memory")
__device__ __forceinline__ unsigned long long rt() { return __builtin_amdgcn_s_memrealtime(); }
__device__ __forceinline__ unsigned f2bf(float f) { unsigned u = __builtin_bit_cast(unsigned, f); return (u + 0x7fffu + ((u >> 16) & 1u)) >> 16; }
__device__ __forceinline__ unsigned pk2(float lo, float hi) { return f2bf(lo) | (f2bf(hi) << 16); }
#define XB_TMO      128
#define XB_XCNT(j)  (256  + 64 * (j))
#define XB_XSUB(j)  (1280 + 64 * (j))
#define XB_XGEN(j)  (2304 + 64 * (j))
#define XB_TOP      3328
#define XB_TOPGEN   3392
#define XCD_BAR_WORDS 3456
#define XB_SPIN_CAP (1u << 18)

__device__ __forceinline__ unsigned xb_ld(unsigned* p)              { return __hip_atomic_load(p, __ATOMIC_RELAXED, __HIP_MEMORY_SCOPE_AGENT); }
__device__ __forceinline__ unsigned xb_add(unsigned* p, unsigned v) { return __hip_atomic_fetch_add(p, v, __ATOMIC_RELAXED, __HIP_MEMORY_SCOPE_AGENT); }
__device__ __forceinline__ unsigned xb_xcc_id() { return (unsigned)__builtin_amdgcn_s_getreg((3 << 11) | 20) & 0xFu; }
#define XB_SPIN(cond, bar) do { unsigned _sp = 0; while (cond) { __builtin_amdgcn_s_sleep(1); \
    if ((++_sp & 255u) == 0u) { if (xb_ld(&(bar)[XB_TMO])) break; if (_sp > XB_SPIN_CAP) { atomicAdd(&(bar)[XB_TMO], 1u); break; } } } } while (0)

struct XcdBarrier {
    unsigned* bar; unsigned x;
    volatile LAS unsigned* st;
};

__device__ __forceinline__ XcdBarrier xcd_barrier_post(unsigned* bar, volatile LAS unsigned* st) {
    XcdBarrier b; b.bar = bar; b.x = xb_xcc_id(); b.st = st;
    if (threadIdx.x == 0) (void)xb_add(&bar[XB_XCNT(b.x)], 1u);
    return b;
}
__device__ __forceinline__ void xcd_barrier_complete(unsigned* bar, unsigned x, unsigned& nloc, unsigned& nx) {
    const unsigned G = gridDim.x * gridDim.y * gridDim.z;
    unsigned sum, cnt, mine, sp = 0u;
    for (;;) {
        sum = 0u; cnt = 0u; mine = 0u;
#pragma unroll 1
        for (unsigned j = 0; j < 16; ++j) { const unsigned c = xb_ld(&bar[XB_XCNT(j)]); sum += c; cnt += (c > 0u) ? 1u : 0u; mine = (j == x) ? c : mine; }
        if (sum == G) break;
        __builtin_amdgcn_s_sleep(1);
        if ((++sp & 255u) == 0u) { if (xb_ld(&bar[XB_TMO])) break; if (sp > XB_SPIN_CAP) { atomicAdd(&bar[XB_TMO], 1u); break; } }
    }
    nloc = mine > 0u ? mine : 1u; nx = cnt > 0u ? cnt : 1u;
}

__device__ __forceinline__ void xcd_barrier(const XcdBarrier& b) {
    asm volatile("s_waitcnt vmcnt(0)" ::: "memory");
    __syncthreads();
    if (threadIdx.x == 0) {
        unsigned* bar = b.bar;
        __builtin_amdgcn_s_waitcnt(0);
        unsigned nloc = b.st[0], nx = b.st[1];
        if (nloc == 0u) { xcd_barrier_complete(bar, b.x, nloc, nx); b.st[0] = nloc; b.st[1] = nx; }
        const unsigned old = xb_add(&bar[XB_XSUB(b.x)], 1u);
        const unsigned gen = old / nloc;
        if (old + 1u == (gen + 1u) * nloc) {
            __builtin_amdgcn_fence(__ATOMIC_RELEASE, "agent");
            asm volatile("s_waitcnt vmcnt(0)" ::: "memory");
            const unsigned og = xb_add(&bar[XB_TOP], 1u);
            const unsigned tg = og / nx;
            if (og + 1u == (tg + 1u) * nx) xb_add(&bar[XB_TOPGEN], 1u);
            else XB_SPIN(xb_ld(&bar[XB_TOPGEN]) == tg, bar);
            __builtin_amdgcn_fence(__ATOMIC_ACQUIRE, "agent");
            xb_add(&bar[XB_XGEN(b.x)], 1u);
            asm volatile("s_waitcnt vmcnt(0)" ::: "memory");
        } else {
            XB_SPIN(xb_ld(&bar[XB_XGEN(b.x)]) == gen, bar);
            __builtin_amdgcn_fence(__ATOMIC_ACQUIRE, "agent");
            asm volatile("s_waitcnt vmcnt(0)" ::: "memory");
        }
    }
    __syncthreads();
}

struct Frame {
    LAS unsigned char* lds; volatile LAS unsigned* MISC; gu32* ctl;
    int vcu, G;
};
__device__ __forceinline__ float bf2f(unsigned short u) { return __uint_as_float((unsigned)u << 16); }
__device__ __forceinline__ float bflo(unsigned u) { return __uint_as_float(u << 16); }
__device__ __forceinline__ float bfhi(unsigned u) { return __uint_as_float(u & 0xffff0000u); }
__device__ __forceinline__ float wave_sum(float v) {
#pragma unroll
    for (int o = 1; o < 64; o <<= 1) v += __shfl_xor(v, o);
    return v;
}
__device__ __forceinline__ float red16_sum(float v) { v += __shfl_xor(v, 1, 16); v += __shfl_xor(v, 2, 16); v += __shfl_xor(v, 4, 16); v += __shfl_xor(v, 8, 16); return v; }
__device__ __forceinline__ float red16_max(float v) { v = fmaxf(v, __shfl_xor(v, 1, 16)); v = fmaxf(v, __shfl_xor(v, 2, 16)); v = fmaxf(v, __shfl_xor(v, 4, 16)); v = fmaxf(v, __shfl_xor(v, 8, 16)); return v; }
__device__ __forceinline__ int rel_bucket(int n) {
    if (n < 16) return n;
    return 16 + (n >= 22) + (n >= 30) + (n >= 40) + (n >= 54) + (n >= 73) + (n >= 99) + (n >= 134) + (n >= 182) + (n >= 246) + (n >= 332) + (n >= 450) + (n >= 609) + (n >= 825) + (n >= 1117) + (n >= 1513);
}

__device__ __forceinline__ void xpose_item(const float* W, int ldw, int c0, int nvalid, int k0, bf16* WT, int Kd, int drow0, LAS float* scr, int lane, const float* kgain = nullptr) {
#pragma unroll
    for (int i = 0; i < 8; ++i) { const int kk = 8 * i + (lane >> 3), n = (lane & 7) * 4;
        float4 wv = make_float4(0.f, 0.f, 0.f, 0.f);
        if (n + 3 < nvalid) wv = *(const float4*)(W + (size_t)(k0 + kk) * ldw + c0 + n);
        else if (n < nvalid) { const float* wp = W + (size_t)(k0 + kk) * ldw + c0 + n; wv.x = wp[0]; if (n + 1 < nvalid) wv.y = wp[1]; if (n + 2 < nvalid) wv.z = wp[2]; }
        if (kgain) { const float g_ = kgain[k0 + kk]; wv.x *= g_; wv.y *= g_; wv.z *= g_; wv.w *= g_; }
        LAS float* sp = scr + kk * 33 + n; sp[0] = wv.x; sp[1] = wv.y; sp[2] = wv.z; sp[3] = wv.w; }
    LDS_WAIT(); asm volatile("" ::: "memory");
    const int c = lane & 7;
#pragma unroll
    for (int j = 0; j < 4; ++j) { const int n = (lane >> 3) + 8 * j; const LAS float* s = scr + (8 * c) * 33 + n;
        v4u o; o.x = pk2(s[0 * 33], s[1 * 33]); o.y = pk2(s[2 * 33], s[3 * 33]); o.z = pk2(s[4 * 33], s[5 * 33]); o.w = pk2(s[6 * 33], s[7 * 33]);
        *(GAS v4u*)(WT + (size_t)(drow0 + n) * Kd + k0 + 8 * c) = o; }
    LDS_WAIT(); asm volatile("" ::: "memory");
}
__device__ __forceinline__ void rms_row_to_bf16(const float* xrow, const float* gain, bf16* orow, int lane) {
    const GAS f32x4* xr = (const GAS f32x4*)xrow + lane; const GAS f32x4* gr = (const GAS f32x4*)gain + lane;
    f32x4 v[4]; float s = 0.f;
#pragma unroll
    for (int j = 0; j < 4; ++j) { v[j] = xr[64 * j]; s += (v[j].x * v[j].x + v[j].y * v[j].y) + (v[j].z * v[j].z + v[j].w * v[j].w); }
    const float r = rsqrtf(wave_sum(s) * (1.f / D) + EPSF);
    GAS unsigned long long* o8 = (GAS unsigned long long*)orow + lane;
#pragma unroll
    for (int j = 0; j < 4; ++j) { const f32x4 g = gr[64 * j]; o8[64 * j] = (unsigned long long)pk2((v[j].x * r) * g.x, (v[j].y * r) * g.y) | ((unsigned long long)pk2((v[j].z * r) * g.z, (v[j].w * r) * g.w) << 32); }
}
#ifndef PROBE_REP
#define PROBE_REP 0
#endif
#define CAS __attribute__((address_space(4)))
#define KARGS() const CAS In* Ip = (const CAS In*)__builtin_amdgcn_kernarg_segment_ptr(); asm volatile("" : "+s"(Ip))
#define OPAQUE_TID() int tid_ = threadIdx.x; asm volatile("" : "+v"(tid_))
__device__ __forceinline__ void norm_phase(Frame& F, const float* x, const float* gain, bf16* xn) {
    OPAQUE_TID(); const int lane_ = tid_ & 63, wave_ = tid_ >> 6;
    const int gw = F.vcu * NWAVES + wave_, NGW = F.G * NWAVES;
    for (int m = gw; m < M; m += NGW) rms_row_to_bf16(x + (size_t)m * D, gain, xn + (size_t)m * D, lane_);
}

template <int DL>
__device__ __forceinline__ void coop_attend(const float (&q)[DL], const float (&k)[DL], const float (&v)[DL], float bias, float& m_, float& l_, float (&o)[DL]) {
    float a = 0.f;
#pragma unroll
    for (int d = 0; d < DL; ++d) a += q[d] * k[d];
    a = red16_sum(a) + bias;
    const float mn = fmaxf(m_, a), al = __expf(m_ - mn), p = __expf(a - mn);
    l_ = l_ * al + p; m_ = mn;
#pragma unroll
    for (int d = 0; d < DL; ++d) o[d] = o[d] * al + p * v[d];
}
__device__ __forceinline__ void ld4bf(const bf16* p, float (&x)[4]) { const uint2 u = *(const uint2*)p; x[0] = bflo(u.x); x[1] = bfhi(u.x); x[2] = bflo(u.y); x[3] = bfhi(u.y); }
__device__ __forceinline__ void ld8bf(const bf16* p, float (&x)[8]) { const uint4 u = *(const uint4*)p; x[0] = bflo(u.x); x[1] = bfhi(u.x); x[2] = bflo(u.y); x[3] = bfhi(u.y); x[4] = bflo(u.z); x[5] = bfhi(u.z); x[6] = bflo(u.w); x[7] = bfhi(u.w); }
__device__ __forceinline__ void ld4f(const float* p, float (&x)[4]) { const float4 u = *(const float4*)p; x[0] = u.x; x[1] = u.y; x[2] = u.z; x[3] = u.w; }

struct In {
    const float *x, *mem, *rel_bias, *norm_mix, *norm_ffn, *norm_mem, *w_mem_kv, *w_out, *ffn_gate, *ffn_up, *ffn_down, *nsa_w_in, *nsa_gate_b, *pos_k, *pos_v,
        *k_w1, *k_b1, *k_w2, *k_b2, *v_w1, *v_b1, *v_w2, *v_b2, *dsa_w_in, *q_norm, *kv_norm, *w_q_up, *w_uk, *w_uv, *w_q_idx, *kidx_norm, *norm_final;
};
__device__ __forceinline__ void p0_prologue(Frame& F, const In& I, unsigned char* ws) {
    OPAQUE_TID(); KARGS(); const int lane_ = tid_ & 63, wave_ = __builtin_amdgcn_readfirstlane(tid_ >> 6);
    LAS float* scr = (LAS float*)(F.lds + RING_OFF + wave_ * 16384);
    const int gw = F.vcu * NWAVES + wave_, NGW = F.G * NWAVES;
    bf16* WIN0 = (bf16*)(ws + WS_WIN0); bf16* WO = (bf16*)(ws + WS_WO); bf16* WGU = (bf16*)(ws + WS_WGU); bf16* WD = (bf16*)(ws + WS_WD); bf16* WIN1 = (bf16*)(ws + WS_WIN1); bf16* WQ2 = (bf16*)(ws + WS_WQ2);
    constexpr int I_A = 16 * 56, I_G = 16 * 8, I_B = 2 * 16 * 32, I_C = 2 * 16 * 176, I_D = 2 * 44 * 32, I_E = 16 * 24, I_F = 4 * 16, NITEMS = I_A + I_B + I_C + I_D + I_E + I_F + I_G;
    for (int it = gw; it < NITEMS; it += NGW) {
        int r = it;
        if (r < I_A) { const int kb = r / 56, nb = r % 56, r0 = 32 * nb; int c0, nv;
            if (r0 < 1152) { c0 = r0; nv = 32; } else if (r0 < 1280) { c0 = r0 + 128; nv = 32; } else if (r0 < 1536) { c0 = r0 + 292; nv = 32; } else if (r0 == 1536) { c0 = 1536; nv = 32; } else if (r0 == 1568) { c0 = 1568; nv = 4; } else { c0 = 0; nv = 0; }
            xpose_item(Ip->nsa_w_in, NSA_IN, c0, nv, 64 * kb, WIN0, D, r0, scr, lane_); continue; } r -= I_A;
        if (r < I_B) { const int l = r / 512, q = r % 512, kb = q / 32, nb = q % 32;
            xpose_item(Ip->w_out + (size_t)l * D * D, D, 32 * nb, 32, 64 * kb, WO + (size_t)l * D * D, D, 32 * nb, scr, lane_); continue; } r -= I_B;
        if (r < I_C) { const int l = r / (16 * 176), q = r % (16 * 176), kb = q / 176, nb = q % 176, r0 = 32 * nb, pn = r0 >> 8, w0 = r0 & 255;
            const float* src = ((w0 < 128) ? Ip->ffn_gate : Ip->ffn_up) + (size_t)l * D * DFF;
            xpose_item(src, DFF, 128 * pn + (w0 & 127), 32, 64 * kb, WGU + (size_t)l * 2 * DFF * D, D, r0, scr, lane_, Ip->norm_ffn + l * D); continue; } r -= I_C;
        if (r < I_D) { const int l = r / (44 * 32), q = r % (44 * 32), kb = q / 32, nb = q % 32;
            xpose_item(Ip->ffn_down + (size_t)l * DFF * D, D, 32 * nb, 32, 64 * kb, WD + (size_t)l * D * DFF, DFF, 32 * nb, scr, lane_); continue; } r -= I_D;
        if (r < I_E) { const int kb = r / 24, nb = r % 24, r0 = 32 * nb; int nv = DSA_IN - r0; nv = nv > 32 ? 32 : (nv < 0 ? 0 : nv);
            xpose_item(Ip->dsa_w_in, DSA_IN, r0, nv, 64 * kb, WIN1, D, r0, scr, lane_, Ip->norm_mix + D); continue; } r -= I_E;
        if (r < I_F) { const int kb = r / 16, nb = r % 16; xpose_item(Ip->w_q_idx, 512, 32 * nb, 32, 64 * kb, WQ2, 256, 1536 + 32 * nb, scr, lane_); continue; } r -= I_F;
        { const int kb = r / 8, nb = r % 8, r0 = 32 * nb;
            xpose_item(Ip->nsa_w_in, NSA_IN, (r0 < 128) ? 1152 + r0 : 1408 + (r0 - 128), 32, 64 * kb, (bf16*)(ws + WS_WVT), D, r0, scr, lane_); }
    }
    for (int idx = (F.vcu * NWAVES * 64) + tid_; idx < 384 * 256; idx += F.G * NWAVES * 64) {
        const int c = idx & 255, r4 = (idx >> 8) & 31, h = idx >> 13; const float4* a4 = (const float4*)(Ip->w_q_up + (size_t)c * 768 + h * 64); const float4* b4 = (const float4*)(Ip->w_uk + (size_t)(4 * r4) * 768 + h * 64);
        float s0 = 0.f, s1 = 0.f, s2 = 0.f, s3 = 0.f;
#pragma unroll 4
        for (int d = 0; d < 16; ++d) { const float4 av = a4[d], b0 = b4[d], b1 = b4[192 + d], b2 = b4[384 + d], b3 = b4[576 + d];
            s0 += (av.x * b0.x + av.y * b0.y) + (av.z * b0.z + av.w * b0.w); s1 += (av.x * b1.x + av.y * b1.y) + (av.z * b1.z + av.w * b1.w);
            s2 += (av.x * b2.x + av.y * b2.y) + (av.z * b2.z + av.w * b2.w); s3 += (av.x * b3.x + av.y * b3.y) + (av.z * b3.z + av.w * b3.w); }
        const float sc_ = 0.125f * 1.4426950408889634f;
        bf16* o_ = WQ2 + (size_t)(h * 128 + 4 * r4) * 256 + c;
        o_[0] = (bf16)f2bf(s0 * sc_); o_[256] = (bf16)f2bf(s1 * sc_); o_[512] = (bf16)f2bf(s2 * sc_); o_[768] = (bf16)f2bf(s3 * sc_);
    }
    { bf16* WO1F = (bf16*)(ws + WS_WO1F); const float* wo1 = Ip->w_out + (size_t)D * D;
      for (int idx = (F.vcu * NWAVES * 64) + tid_; idx < 12 * 32 * 256; idx += F.G * NWAVES * 64) {
          const int n4 = idx & 255, r4 = (idx >> 8) & 31, h = idx >> 13; const float* a = Ip->w_uv + (size_t)(4 * r4) * 768 + h * 64; const float* bcol = wo1 + (size_t)(h * 64) * D + 4 * n4;
          float acc_[4][4];
#pragma unroll
          for (int i = 0; i < 4; ++i)
#pragma unroll
              for (int j = 0; j < 4; ++j) acc_[i][j] = 0.f;
#pragma unroll 4
          for (int d = 0; d < 64; ++d) { const float4 bv = *(const float4*)(bcol + (size_t)d * D); const float a0 = a[d], a1 = a[768 + d], a2 = a[1536 + d], a3 = a[2304 + d];
              acc_[0][0] += a0 * bv.x; acc_[0][1] += a0 * bv.y; acc_[0][2] += a0 * bv.z; acc_[0][3] += a0 * bv.w; acc_[1][0] += a1 * bv.x; acc_[1][1] += a1 * bv.y; acc_[1][2] += a1 * bv.z; acc_[1][3] += a1 * bv.w;
              acc_[2][0] += a2 * bv.x; acc_[2][1] += a2 * bv.y; acc_[2][2] += a2 * bv.z; acc_[2][3] += a2 * bv.w; acc_[3][0] += a3 * bv.x; acc_[3][1] += a3 * bv.y; acc_[3][2] += a3 * bv.z; acc_[3][3] += a3 * bv.w; }
#pragma unroll
          for (int j = 0; j < 4; ++j) *(uint2*)(WO1F + (size_t)(4 * n4 + j) * 1792 + h * 128 + 4 * r4) = make_uint2(pk2(acc_[0][j], acc_[1][j]), pk2(acc_[2][j], acc_[3][j])); }
      for (int it = gw; it < 4 * 32; it += NGW) { const int kb = it / 32, nb = it % 32;
          xpose_item(wo1 + (size_t)768 * D, D, 32 * nb, 32, 64 * kb, WO1F + 1536, 1792, 32 * nb, scr, lane_); } }
    { bf16* W1T = (bf16*)(ws + WS_W1T); bf16* W2T = (bf16*)(ws + WS_W2T); bf16* WMKT = (bf16*)(ws + WS_WMKT); float* B1F = (float*)(ws + WS_B1F); bf16* MEMN = (bf16*)(ws + WS_MEMN);
      constexpr int J_1 = 2 * 32 * 8, J_2 = 2 * 4 * 2, J_M = 2 * 16 * 16;
      for (int it = gw; it < J_1 + J_2 + J_M; it += NGW) { int r2 = it;
          if (r2 < J_1) { const int kv = r2 / 256, q = r2 % 256, kb = q / 8, nb = q % 8; xpose_item(kv ? Ip->v_w1 : Ip->k_w1, 256, 32 * nb, 32, 64 * kb, W1T + (size_t)kv * 256 * 2048, 2048, 32 * nb, scr, lane_); continue; } r2 -= J_1;
          if (r2 < J_2) { const int kv = r2 / 8, q = r2 % 8, kb = q / 2, nb = q % 2; xpose_item(kv ? Ip->v_w2 : Ip->k_w2, 64, 32 * nb, 32, 64 * kb, W2T + (size_t)kv * 64 * 256, 256, 32 * nb, scr, lane_); continue; } r2 -= J_2;
          { const int l = r2 / 256, q = r2 % 256, kb = q / 16, nb = q % 16; xpose_item(Ip->w_mem_kv + (size_t)l * D * 512, 512, 32 * nb, 32, 64 * kb, WMKT + (size_t)l * 512 * D, D, 32 * nb, scr, lane_); } }
      if ((int)blockIdx.x < 32) { const int u_ = (int)blockIdx.x, kv = u_ >> 4, cr = (u_ >> 2) & 3, kq4 = u_ & 3, c = 64 * cr + lane_; const float* w1 = kv ? Ip->v_w1 : Ip->k_w1; const float* pos = kv ? Ip->pos_v : Ip->pos_k;
          const int kb0 = 512 * kq4 + 64 * wave_; float sacc = 0.f;
#pragma unroll 8
          for (int k = 0; k < 64; ++k) sacc += pos[kb0 + k] * w1[(size_t)(kb0 + k) * 256 + c];
          LAS float* red = (LAS float*)(F.lds + RING_OFF + 8 * 16384);
          red[wave_ * 64 + lane_] = sacc;
          __syncthreads();
          if (wave_ == 0) { float t_ = 0.f;
#pragma unroll
              for (int w = 0; w < 8; ++w) t_ += red[w * 64 + lane_];
              B1F[(kv * 4 + kq4) * 256 + c] = t_; } }
      for (int m = gw; m < 1024; m += NGW) rms_row_to_bf16(Ip->mem + (size_t)(m & 511) * D, Ip->norm_mem + (m >> 9) * D, MEMN + (size_t)m * D, lane_); }
    norm_phase(F, Ip->x, Ip->norm_mix, (bf16*)(ws + WS_XN));
}

#define MFMA16(A, B, C) __builtin_amdgcn_mfma_f32_16x16x32_bf16((A), (B), (C), 0, 0, 0)
constexpr float LOG2E = 1.4426950408889634f;
constexpr int NSA_OUT = 0, NSA_PSQ = 98304, NSA_ST = 147456, NSA_TB = NSA_ST + 3072;
constexpr int TAB_B12 = NSA_ST + 1024;
constexpr int TAB_BKT = NSA_ST + 3072;
static_assert(NSA_TB + 12288 <= LDSCTL_OFF && TAB_B12 + 2048 <= NSA_TB, "LDS tables");
enum { MD_CMP = 0, MD_WIN = 1, MD_BLK = 2, MD_MEM = 3 };
struct KF { bf16x8 a0, a1, b0, b1; };
struct VF { bf16x8 v[4]; };
__device__ __forceinline__ bf16x8 ldg16(const bf16* p) { return *(const bf16x8*)p; }
typedef float f32x2_t __attribute__((ext_vector_type(2))); typedef __bf16 bf16x2_t __attribute__((ext_vector_type(2)));
__device__ __forceinline__ unsigned cvtpk_s(float lo, float hi) { f32x2_t v = {lo, hi}; bf16x2_t b = __builtin_convertvector(v, bf16x2_t); return __builtin_bit_cast(unsigned, b); }
__device__ __forceinline__ bf16x8 pack8(const f32x4& a, const f32x4& b) { v4u w; w.x = cvtpk_s(a[0], a[1]); w.y = cvtpk_s(a[2], a[3]); w.z = cvtpk_s(b[0], b[1]); w.w = cvtpk_s(b[2], b[3]); return __builtin_bit_cast(bf16x8, w); }
__device__ __forceinline__ void load_k(KF& k, const bf16* kb, int kstride, int key0, int r, int kq) {
    const bf16* pa = kb + (size_t)(key0 + 8 * (r >> 2) + (r & 3)) * kstride + 8 * kq; const bf16* pb = pa + 4 * (size_t)kstride;
    k.a0 = ldg16(pa); k.a1 = ldg16(pa + 32); k.b0 = ldg16(pb); k.b1 = ldg16(pb + 32);
}
__device__ __forceinline__ void load_vt(VF& v, const bf16* vt, int vstride, int key0, int r, int kq) {
#pragma unroll
    for (int dt = 0; dt < 4; ++dt) v.v[dt] = ldg16(vt + (size_t)(16 * dt + r) * vstride + key0 + 8 * kq);
}
__device__ __forceinline__ void qk(f32x4& sa, f32x4& sb, const KF& k, const bf16x8 (&q)[2]) {
    const f32x4 z = {0.f, 0.f, 0.f, 0.f};
    sa = MFMA16(k.a0, q[0], z); sa = MFMA16(k.a1, q[1], sa); sb = MFMA16(k.b0, q[0], z); sb = MFMA16(k.b1, q[1], sb);
}
struct BiasCtx { const LAS unsigned short* tb; float d29, d30, c31; };
template <int MODE>
__device__ __forceinline__ void maskbias(f32x4& s, int kpos, int tcol, bool colok, const BiasCtx& B) {
    if (MODE == MD_MEM) return;
#pragma unroll
    for (int i = 0; i < 4; ++i) {
        int dist; bool ok;
        if (MODE == MD_CMP) { dist = tcol - 31 - 16 * (kpos + i); ok = dist >= 0; }
        else if (MODE == MD_WIN) { dist = tcol - (kpos + i); ok = (unsigned)dist <= 511u; }
        else { dist = tcol - (kpos + i); ok = dist >= 0; }
        int dc = dist < 0 ? 0 : dist; dc = dc > 1023 ? 1023 : dc;
        const float tb = __uint_as_float((unsigned)B.tb[dc * 6] << 16);
        const float far = B.c31 + (dist < 1513 ? B.d30 : 0.f) + (dist < 1117 ? B.d29 : 0.f);
        const float bias = dist < 1024 ? tb : far;
        s[i] = (ok && colok) ? s[i] + bias : -INFINITY;
    }
}
__device__ __forceinline__ float colmax(const f32x4& sa, const f32x4& sb) {
    float mx = fmaxf(fmaxf(fmaxf(sa[0], sa[1]), fmaxf(sa[2], sa[3])), fmaxf(fmaxf(sb[0], sb[1]), fmaxf(sb[2], sb[3])));
    mx = fmaxf(mx, __shfl_xor(mx, 16)); mx = fmaxf(mx, __shfl_xor(mx, 32)); return mx;
}
constexpr float SM_THR = 8.f;
__device__ __forceinline__ float lmax8(const f32x4& sa, const f32x4& sb) { return fmaxf(fmaxf(fmaxf(sa[0], sa[1]), fmaxf(sa[2], sa[3])), fmaxf(fmaxf(sb[0], sb[1]), fmaxf(sb[2], sb[3]))); }
template <int NO>
__device__ __forceinline__ void sm_rescale(float lm, float& m, float& l, f32x4 (&O)[NO]) {
    if (__any(lm > m + SM_THR)) {
        lm = fmaxf(lm, __shfl_xor(lm, 16)); lm = fmaxf(lm, __shfl_xor(lm, 32));
        const float mn = fmaxf(m, lm); const float al = __builtin_amdgcn_exp2f(m - mn); m = mn; l *= al;
#pragma unroll
        for (int dt = 0; dt < NO; ++dt) O[dt] = O[dt] * al;
    }
}
__device__ __forceinline__ bf16x8 sm_update(const f32x4& sa, const f32x4& sb, float& m, float& l, f32x4 (&O)[4]) {
    sm_rescale<4>(lmax8(sa, sb), m, l, O);
    f32x4 pa, pb; float sum = 0.f;
#pragma unroll
    for (int i = 0; i < 4; ++i) { pa[i] = __builtin_amdgcn_exp2f(sa[i] - m); pb[i] = __builtin_amdgcn_exp2f(sb[i] - m); sum += pa[i] + pb[i]; }
    l += sum;
    return pack8(pa, pb);
}
__device__ __forceinline__ void sm_update64(const f32x4& sa0, const f32x4& sb0, const f32x4& sa1, const f32x4& sb1, float& m, float& l, f32x4 (&O)[4], bf16x8& pf0, bf16x8& pf1) {
    sm_rescale<4>(fmaxf(lmax8(sa0, sb0), lmax8(sa1, sb1)), m, l, O);
    f32x4 pa0, pb0, pa1, pb1; float sum = 0.f;
#pragma unroll
    for (int i = 0; i < 4; ++i) { pa0[i] = __builtin_amdgcn_exp2f(sa0[i] - m); pb0[i] = __builtin_amdgcn_exp2f(sb0[i] - m); pa1[i] = __builtin_amdgcn_exp2f(sa1[i] - m); pb1[i] = __builtin_amdgcn_exp2f(sb1[i] - m);
        sum += (pa0[i] + pb0[i]) + (pa1[i] + pb1[i]); }
    l += sum;
    pf0 = pack8(pa0, pb0); pf1 = pack8(pa1, pb1);
}
enum { BK_FAR = 0, BK_MID = 1, BK_GEN = 2 };
template <int MD>
__device__ __forceinline__ void step64(const KF& k0, const KF& k1, const bf16x8 (&q)[2], int cls, int kpos, int tcol, bool colok, const BiasCtx& B,
                                       float& m, float& l, f32x4 (&O)[4], bf16x8& pf0, bf16x8& pf1) {
    const bool has = m > -1e29f; const float mref = has ? m : 0.f;
    float cin = ((cls == BK_FAR) ? B.c31 : 0.f) - mref; if (!colok) cin = -INFINITY;
    const f32x4 c4 = {cin, cin, cin, cin};
    f32x4 sa0 = MFMA16(k0.a0, q[0], c4), sb0 = MFMA16(k0.b0, q[0], c4), sa1 = MFMA16(k1.a0, q[0], c4), sb1 = MFMA16(k1.b0, q[0], c4);
    sa0 = MFMA16(k0.a1, q[1], sa0); sb0 = MFMA16(k0.b1, q[1], sb0); sa1 = MFMA16(k1.a1, q[1], sa1); sb1 = MFMA16(k1.b1, q[1], sb1);
    if (cls == BK_MID) {
        const LAS unsigned short* tp = B.tb + (tcol - kpos) * 6;
#pragma unroll
        for (int i = 0; i < 4; ++i) { sa0[i] += __uint_as_float((unsigned)tp[-6 * i] << 16); sb0[i] += __uint_as_float((unsigned)tp[-6 * (i + 4)] << 16);
            sa1[i] += __uint_as_float((unsigned)tp[-6 * (i + 32)] << 16); sb1[i] += __uint_as_float((unsigned)tp[-6 * (i + 36)] << 16); }
    } else if (cls == BK_GEN) {
        maskbias<MD>(sa0, kpos, tcol, true, B); maskbias<MD>(sb0, kpos + 4, tcol, true, B); maskbias<MD>(sa1, kpos + 32, tcol, true, B); maskbias<MD>(sb1, kpos + 36, tcol, true, B);
    }
    float lm = fmaxf(lmax8(sa0, sb0), lmax8(sa1, sb1));
    if (__any((lm > SM_THR) || (!has && lm > -INFINITY))) {
        lm = fmaxf(lm, __shfl_xor(lm, 16)); lm = fmaxf(lm, __shfl_xor(lm, 32));
        const bool upd = (lm > -INFINITY) && (!has || lm > 0.f); const float dl = upd ? lm : 0.f;
        if (upd) m = mref + dl;
        const float f = has ? __builtin_amdgcn_exp2f(-dl) : 1.f; l *= f;
#pragma unroll
        for (int dt = 0; dt < 4; ++dt) O[dt] = O[dt] * f;
#pragma unroll
        for (int i = 0; i < 4; ++i) { sa0[i] -= dl; sb0[i] -= dl; sa1[i] -= dl; sb1[i] -= dl; }
    }
    f32x4 pa0, pb0, pa1, pb1; float sum = 0.f;
#pragma unroll
    for (int i = 0; i < 4; ++i) { pa0[i] = __builtin_amdgcn_exp2f(sa0[i]); pb0[i] = __builtin_amdgcn_exp2f(sb0[i]); pa1[i] = __builtin_amdgcn_exp2f(sa1[i]); pb1[i] = __builtin_amdgcn_exp2f(sb1[i]);
        sum += (pa0[i] + pb0[i]) + (pa1[i] + pb1[i]); }
    l += sum;
    pf0 = pack8(pa0, pb0); pf1 = pack8(pa1, pb1);
}
__device__ __forceinline__ void pv(f32x4 (&O)[4], const VF& v, const bf16x8& pf) {
#pragma unroll
    for (int dt = 0; dt < 4; ++dt) O[dt] = MFMA16(v.v[dt], pf, O[dt]);
}
__device__ __forceinline__ void lds_fadd(LAS float* p, float v) { (void)__hip_atomic_fetch_add((float*)p, v, __ATOMIC_RELAXED, __HIP_MEMORY_SCOPE_WORKGROUP); }
__device__ __forceinline__ float kqsum(float v) { v += __shfl_xor(v, 16); v += __shfl_xor(v, 32); return v; }
__device__ __forceinline__ float wmax64(float v) {
#pragma unroll
    for (int o = 1; o < 64; o <<= 1) v = fmaxf(v, __shfl_xor(v, o));
    return v;
}
__device__ __forceinline__ void out_add(LAS float* OUTw, int p, int n, int kq, const f32x4 (&O)[4], float scale, bool first) {
    const int q = 2 * p + (n >> 3), hd = n & 7;
    if (hd < 6) { LAS f32x4* dst = (LAS f32x4*)(OUTw + (q * 6 + hd) * 64) + kq;
#pragma unroll
        for (int dt = 0; dt < 4; ++dt) { f32x4 v = O[dt] * scale; if (!first) v = v + dst[4 * dt]; dst[4 * dt] = v; } }
}

__device__ __forceinline__ void p2_mfma(Frame& F, const In& I, unsigned char* ws) {
    OPAQUE_TID(); KARGS(); const int lane = tid_ & 63, wave = __builtin_amdgcn_readfirstlane(tid_ >> 6), r = lane & 15, kq = lane >> 4;
    const bf16* KV0 = (const bf16*)(ws + WS_KV0); const bf16* W1T = (const bf16*)(ws + WS_W1T); const bf16* W2T = (const bf16*)(ws + WS_W2T); const float* B1F = (const float*)(ws + WS_B1F);
    const bf16* MEMN = (const bf16*)(ws + WS_MEMN); const bf16* WMKT = (const bf16*)(ws + WS_WMKT);
    bf16* KCB = (bf16*)(ws + WS_KCB); bf16* VCT = (bf16*)(ws + WS_VCT); bf16* MKB = (bf16*)(ws + WS_MKB); bf16* MVT = (bf16*)(ws + WS_MVT);
    LAS unsigned char* hid = F.lds + RING_OFF;
    for (int u = blockIdx.x; u < 192; u += F.G) {
        const bool cmp = u < 128;
        const bf16* ap[2]; const bf16* bp[2]; int K, kjump;
        int kv = 0, bg = 0, n0 = 0, lay = 0, m0 = 0, ch = 0;
        if (cmp) { kv = u >> 6; bg = (u >> 4) & 3; n0 = (u & 15) * 32; const int b = bg >> 1, g = bg & 1; K = 2048; kjump = 512 - 64;
#pragma unroll
            for (int rt = 0; rt < 2; ++rt) { int nn = n0 + 16 * rt + r; nn = nn > 510 ? 510 : nn; ap[rt] = KV0 + (size_t)(b * T + 16 * nn) * 512 + kv * 128 + g * 64 + 8 * kq; }
#pragma unroll
            for (int ct = 0; ct < 2; ++ct) bp[ct] = W1T + (size_t)(kv * 256 + 32 * wave + 16 * ct + r) * 2048 + 8 * kq;
        } else { const int v = u - 128; lay = v >> 5; m0 = ((v >> 1) & 15) * 32; ch = v & 1; K = 1024; kjump = 0;
#pragma unroll
            for (int rt = 0; rt < 2; ++rt) ap[rt] = MEMN + (size_t)(lay * 512 + m0 + 16 * rt + r) * 1024 + 8 * kq;
#pragma unroll
            for (int ct = 0; ct < 2; ++ct) bp[ct] = WMKT + (size_t)(lay * 512 + ch * 256 + 32 * wave + 16 * ct + r) * 1024 + 8 * kq;
        }
        f32x4 acc[2][2];
#pragma unroll
        for (int rt = 0; rt < 2; ++rt)
#pragma unroll
            for (int ct = 0; ct < 2; ++ct) acc[rt][ct] = (f32x4){0.f, 0.f, 0.f, 0.f};
        for (int kb = 0; kb < K; kb += 64) { const int ao = kb + (kb >> 6) * kjump;
            bf16x8 a[2][2], bb[2][2];
#pragma unroll
            for (int h2 = 0; h2 < 2; ++h2) {
#pragma unroll
                for (int rt = 0; rt < 2; ++rt) a[rt][h2] = ldg16(ap[rt] + ao + 32 * h2);
#pragma unroll
                for (int ct = 0; ct < 2; ++ct) bb[ct][h2] = ldg16(bp[ct] + kb + 32 * h2); }
#pragma unroll
            for (int h2 = 0; h2 < 2; ++h2)
#pragma unroll
                for (int rt = 0; rt < 2; ++rt)
#pragma unroll
                    for (int ct = 0; ct < 2; ++ct) acc[rt][ct] = MFMA16(a[rt][h2], bb[ct][h2], acc[rt][ct]);
        }
        if (cmp) {
#pragma unroll
            for (int ct = 0; ct < 2; ++ct) { const int col = 32 * wave + 16 * ct + r; const float bias = (kv ? Ip->v_b1 : Ip->k_b1)[col] + ((B1F[(kv * 4 + 0) * 256 + col] + B1F[(kv * 4 + 1) * 256 + col]) + (B1F[(kv * 4 + 2) * 256 + col] + B1F[(kv * 4 + 3) * 256 + col]));
#pragma unroll
                for (int rt = 0; rt < 2; ++rt)
#pragma unroll
                    for (int i = 0; i < 4; ++i) { const float xg = acc[rt][ct][i] + bias; const float hv = 0.5f * xg * (1.f + tanhf(0.7978845608028654f * (xg + 0.044715f * xg * xg * xg)));
                        *(LAS unsigned short*)(hid + (16 * rt + 4 * kq + i) * 528 + 2 * col) = (unsigned short)f2bf(hv); } }
            __syncthreads();
            { const int rt2 = wave >> 2, ct2 = wave & 3; f32x4 o = {0.f, 0.f, 0.f, 0.f};
              const bf16* w2p = W2T + (size_t)(kv * 64 + 16 * ct2 + r) * 256 + 8 * kq;
#pragma unroll
              for (int ks = 0; ks < 8; ++ks) { const bf16x8 av = *(const LAS bf16x8*)(hid + (16 * rt2 + r) * 528 + 64 * ks + 16 * kq); o = MFMA16(av, ldg16(w2p + 32 * ks), o); }
              const int d = 16 * ct2 + r; const float b2v = (kv ? Ip->v_b2 : Ip->k_b2)[d];
#pragma unroll
              for (int i = 0; i < 4; ++i) { const int nn = n0 + 16 * rt2 + 4 * kq + i; const unsigned short ov = (nn < NCMP) ? (unsigned short)f2bf(o[i] + b2v) : (unsigned short)0;
                  if (kv) VCT[(size_t)(bg * 64 + d) * 512 + nn] = ov; else KCB[(size_t)(bg * 512 + nn) * 64 + d] = ov; } }
            __syncthreads();
        } else {
#pragma unroll
            for (int ct = 0; ct < 2; ++ct) { const int col = 32 * wave + 16 * ct + r;
#pragma unroll
                for (int rt = 0; rt < 2; ++rt)
#pragma unroll
                    for (int i = 0; i < 4; ++i) { const int mrow = m0 + 16 * rt + 4 * kq + i; const unsigned short ov = (unsigned short)f2bf(acc[rt][ct][i]);
                        if (ch == 0) MKB[(size_t)(lay * 512 + mrow) * 256 + col] = ov; else MVT[(size_t)(lay * 256 + col) * 512 + mrow] = ov; } }
        }
    }
}

template <int MODE>
__device__ __forceinline__ void mb2(f32x4& sa, f32x4& sb, int kpos, int tcol, bool colok, bool fast, const BiasCtx& B) {
    if (fast) { if (colok) { sa = sa + B.c31; sb = sb + B.c31; } else { sa = (f32x4){-INFINITY, -INFINITY, -INFINITY, -INFINITY}; sb = sa; } }
    else { maskbias<MODE>(sa, kpos, tcol, colok, B); maskbias<MODE>(sb, kpos + 4, tcol, colok, B); }
}
#define SWZ(row) (((((row) >> 3) & 3) << 1) | (((row) >> 1) & 1))
struct KV1 { KF k; VF v; };
__device__ __forceinline__ void load_kv(KV1& d, const bf16* kb, int kstride, const bf16* vt, int vstride, int key0, int r, int kq) { load_k(d.k, kb, kstride, key0, r, kq); load_vt(d.v, vt, vstride, key0, r, kq); }

template <int MD>
__device__ __forceinline__ void nsa_sweep(LAS unsigned char* STG, const bf16* ksb, const bf16* vst, int jlo, int jhi, int qt, const LAS unsigned* WMw, int wave, int lane, int r, int kq, int qsel, int t0w,
                                          const bf16x8 (&qf)[4][2], const BiasCtx& BC, float (&m)[4], float (&l)[4], f32x4 (&O)[4][4]) {
            const int srow = 8 * wave + (lane >> 3), sch = (lane & 7) ^ SWZ(srow);
            const bf16* ksrc = ksb + (size_t)srow * 512 + 8 * sch; const bf16* vsrc = vst + (size_t)srow * 64 + 8 * sch;
#define NSA_DMA(jb) do { LAS unsigned char* d_ = STG + ((jb) % 3) * 16384 + wave * 1024; \
                __builtin_amdgcn_global_load_lds((const unsigned*)(ksrc + (size_t)(jb) * 64 * 512), (LAS unsigned*)d_, 16, 0, 0); \
                __builtin_amdgcn_global_load_lds((const unsigned*)(vsrc + (size_t)(jb) * 16384), (LAS unsigned*)(d_ + 8192), 16, 0, 0); } while (0)
            NSA_DMA(jlo); if (jhi > jlo) NSA_DMA(jlo + 1);
            if (jhi > jlo) asm volatile("s_waitcnt vmcnt(2)" ::: "memory"); else asm volatile("s_waitcnt vmcnt(0)" ::: "memory");
            __builtin_amdgcn_s_barrier();
            for (int j = jlo; j <= jhi; ++j) {
                const LAS unsigned char* sk = STG + (j % 3) * 16384; const LAS unsigned char* sv = sk + 8192;
                const bool more = (j + 2) <= jhi;
                if (more) NSA_DMA(j + 2);
                unsigned m8 = 0xffu; if (WMw) m8 = (unsigned)__builtin_amdgcn_readfirstlane((int)((WMw[j >> 2] >> (8 * (j & 3))) & 0xffu)); asm volatile("" : "+s"(m8));
                if (m8) {
                    const int dj = qt - j; const int cls = (MD == MD_WIN) ? ((dj >= 1 && dj <= 6) ? BK_MID : BK_GEN) : ((64 * dj - 63 >= 1513) ? BK_FAR : ((dj >= 1 && dj <= 15) ? BK_MID : BK_GEN));
                    KF k0, k1;
                    { const int ka = 8 * (r >> 2) + (r & 3), kb2 = ka + 4, kc = ka + 32, kd = ka + 36;
                      k0.a0 = *(const LAS bf16x8*)(sk + ka * 128 + ((kq ^ SWZ(ka)) << 4)); k0.a1 = *(const LAS bf16x8*)(sk + ka * 128 + (((4 + kq) ^ SWZ(ka)) << 4));
                      k0.b0 = *(const LAS bf16x8*)(sk + kb2 * 128 + ((kq ^ SWZ(kb2)) << 4)); k0.b1 = *(const LAS bf16x8*)(sk + kb2 * 128 + (((4 + kq) ^ SWZ(kb2)) << 4));
                      k1.a0 = *(const LAS bf16x8*)(sk + kc * 128 + ((kq ^ SWZ(kc)) << 4)); k1.a1 = *(const LAS bf16x8*)(sk + kc * 128 + (((4 + kq) ^ SWZ(kc)) << 4));
                      k1.b0 = *(const LAS bf16x8*)(sk + kd * 128 + ((kq ^ SWZ(kd)) << 4)); k1.b1 = *(const LAS bf16x8*)(sk + kd * 128 + (((4 + kq) ^ SWZ(kd)) << 4)); }
#pragma unroll
                    for (int p = 0; p < 4; ++p) if (m8 & (3u << (2 * p))) {
                        bf16x8 pf0, pf1;
                        step64<MD>(k0, k1, qf[p], cls, 64 * j + 8 * kq, t0w + 2 * p + qsel, ((m8 >> (2 * p + qsel)) & 1u) != 0u, BC, m[p], l[p], O[p], pf0, pf1);
#pragma unroll
                        for (int h2 = 0; h2 < 2; ++h2) { VF v;
#pragma unroll
                            for (int dt = 0; dt < 4; ++dt) { const int dd = 16 * dt + r; v.v[dt] = *(const LAS bf16x8*)(sv + dd * 128 + (((4 * h2 + kq) ^ SWZ(dd)) << 4)); }
                            pv(O[p], v, h2 ? pf1 : pf0); }
                        __builtin_amdgcn_sched_barrier(0); }
                }
                if (more) asm volatile("s_waitcnt vmcnt(2) lgkmcnt(0)" ::: "memory"); else asm volatile("s_waitcnt vmcnt(0) lgkmcnt(0)" ::: "memory");
                __builtin_amdgcn_s_barrier();
            }
#undef NSA_DMA
}
__device__ __forceinline__ void p3_nsa_mfma(Frame& F, const In& I, unsigned char* ws) {
    OPAQUE_TID(); KARGS(); const int wave = __builtin_amdgcn_readfirstlane(tid_ >> 6);
    LAS float* b12 = (LAS float*)(F.lds + TAB_B12);
    LAS float* OUTf = (LAS float*)(F.lds + NSA_OUT); LAS float* OUTw = OUTf + wave * 3072;
    LAS float* PSw = (LAS float*)(F.lds + NSA_PSQ) + wave * 1024;
    LAS unsigned char* STG = F.lds + NSA_PSQ;
    LAS unsigned* WMw = (LAS unsigned*)(F.lds + NSA_ST) + wave * 32;
    for (int i = tid_; i < 512; i += NWAVES * 64) b12[i] = ((i & 15) < 12) ? Ip->rel_bias[(i >> 4) * 12 + (i & 15)] * LOG2E : 0.f;
    LAS unsigned short* TB = (LAS unsigned short*)(F.lds + NSA_TB);
    { const int gg = (int)blockIdx.x & 1;
      for (int i = tid_; i < 6144; i += NWAVES * 64) { const int dd = i / 6, hh = i % 6; TB[i] = (unsigned short)f2bf(Ip->rel_bias[rel_bucket(dd) * 12 + gg * 6 + hh] * LOG2E); } }
    __syncthreads();
    const bf16* Q0 = (const bf16*)(ws + WS_Q0); const bf16* KV0 = (const bf16*)(ws + WS_KV0); const bf16* QM = (const bf16*)(ws + WS_QM); const bf16* G0 = (const bf16*)(ws + WS_G0);
    const bf16* VT = (const bf16*)(ws + WS_VT); const bf16* KCB = (const bf16*)(ws + WS_KCB); const bf16* VCT = (const bf16*)(ws + WS_VCT);
    const bf16* MKB = (const bf16*)(ws + WS_MKB); const bf16* MVT = (const bf16*)(ws + WS_MVT);
    bf16* CAT = (bf16*)(ws + WS_CAT);
    const int nun = 4 * 128;
    for (int ui = blockIdx.x; ui < nun; ui += F.G) {
        int tl_ = tid_; asm volatile("" : "+v"(tl_));
        const int lane = tl_ & 63, n = lane & 15, kq = lane >> 4, r = n, hd = n & 7, qsel = n >> 3; const bool colv = hd < 6;
        int bg, qt;
        bg = blockIdx.x & 3;
        if (F.G == 256) { const int idx = blockIdx.x >> 2; qt = (ui < 256) ? idx : 127 - idx; }
        else { qt = ui >> 2; if ((ui & 3) != bg) continue; }
        const int b = bg >> 1, g = bg & 1, t0w = 64 * qt + 8 * wave, rowb = b * T;
        const int habs = g * 6 + (colv ? hd : 0);
        const LAS float* b12c = b12 + habs; const BiasCtx BC{TB + (colv ? hd : 0), b12c[29 * 16] - b12c[30 * 16], b12c[30 * 16] - b12c[31 * 16], b12c[31 * 16]};

        bf16x8 qf[4][2];
#pragma unroll
        for (int p = 0; p < 4; ++p) { const bf16* qp = Q0 + (size_t)(rowb + t0w + 2 * p + qsel) * 768 + habs * 64 + 8 * kq;
#pragma unroll
            for (int ks = 0; ks < 2; ++ks) { bf16x8 v = ldg16(qp + 32 * ks); if (!colv) v = (bf16x8){0, 0, 0, 0, 0, 0, 0, 0}; qf[p][ks] = v; } }
        for (int i = lane; i < 1024; i += 64) PSw[i] = 0.f;
        float m[4], l[4]; f32x4 O[4][4];
        const int ncmax = (t0w + 7 >= 31) ? ((t0w + 7 - 31) / 16 + 1) : 0;
        const bf16* kcb = KCB + (size_t)(bg * 512) * 64; const bf16* vct = VCT + (size_t)(bg * 64) * 512;
#pragma unroll
        for (int p = 0; p < 4; ++p) { m[p] = -1e30f; l[p] = 0.f; }
        if (ncmax > 0) {
            int r_ = r, kq_ = kq; asm volatile("" : "+v"(r_), "+v"(kq_));
            for (int key0 = 0; key0 < ncmax; key0 += 32) {
                asm volatile("" : "+v"(r_), "+v"(kq_));
                KF kA; load_k(kA, kcb, 64, key0, r_, kq_);
                const bool fast = (t0w - 31 - 16 * (key0 + 31)) >= 1513;
#pragma unroll
                for (int p = 0; p < 4; ++p) { f32x4 sa, sb; qk(sa, sb, kA, qf[p]); const int tcol = t0w + 2 * p + qsel;
                    mb2<MD_CMP>(sa, sb, key0 + 8 * kq_, tcol, true, fast, BC);
                    const float mn = fmaxf(m[p], colmax(sa, sb)); float sum = 0.f;
#pragma unroll
                    for (int i = 0; i < 4; ++i) sum += __builtin_amdgcn_exp2f(sa[i] - mn) + __builtin_amdgcn_exp2f(sb[i] - mn);
                    l[p] = l[p] * __builtin_amdgcn_exp2f(m[p] - mn) + sum; m[p] = mn; __builtin_amdgcn_sched_barrier(0); }
            }
        }
        float invl[4];
#pragma unroll
        for (int p = 0; p < 4; ++p) { const float lt = kqsum(l[p]); invl[p] = lt > 0.f ? 1.f / lt : 0.f; }
#pragma unroll
        for (int p = 0; p < 4; ++p)
#pragma unroll
            for (int dt = 0; dt < 4; ++dt) O[p][dt] = (f32x4){0.f, 0.f, 0.f, 0.f};
        float carry[4] = {0.f, 0.f, 0.f, 0.f};
        if (ncmax > 0) {
            int r_ = r, kq_ = kq; asm volatile("" : "+v"(r_), "+v"(kq_));
            for (int key0 = 0; key0 < ncmax; key0 += 32) {
                asm volatile("" : "+v"(r_), "+v"(kq_));
                KV1 A; load_kv(A, kcb, 64, vct, 512, key0, r_, kq_);
                const bool fast = (t0w - 31 - 16 * (key0 + 31)) >= 1513;
#pragma unroll
                for (int p = 0; p < 4; ++p) { f32x4 sa, sb; qk(sa, sb, A.k, qf[p]); const int tcol = t0w + 2 * p + qsel;
                    mb2<MD_CMP>(sa, sb, key0 + 8 * kq_, tcol, true, fast, BC);
                    f32x4 pa, pb;
#pragma unroll
                    for (int i = 0; i < 4; ++i) { pa[i] = __builtin_amdgcn_exp2f(sa[i] - m[p]) * invl[p]; pb[i] = __builtin_amdgcn_exp2f(sb[i] - m[p]) * invl[p]; }
                    pv(O[p], A.v, pack8(pa, pb));
                    float wA = (pa[0] + pa[1]) + (pa[2] + pa[3]), wB = pa[3] + ((pb[0] + pb[1]) + (pb[2] + pb[3])), wC = pb[3];
                    if (!colv) { wA = 0.f; wB = 0.f; wC = 0.f; }
                    const float up = __shfl(wC, (lane + 48) & 63);
                    const float prevC = (kq == 0) ? carry[p] : up; carry[p] = up;
                    float a0 = wA + prevC, a1 = wB;
                    a0 += __shfl_xor(a0, 1); a1 += __shfl_xor(a1, 1); a0 += __shfl_xor(a0, 2); a1 += __shfl_xor(a1, 2); a0 += __shfl_xor(a0, 4); a1 += __shfl_xor(a1, 4);
                    if (hd == 0) { LAS float* ps = PSw + (2 * p + qsel) * 128 + (key0 >> 2) + 2 * kq; ps[0] = a0; ps[1] = a1; } __builtin_amdgcn_sched_barrier(0); }
            }
        }
        if (ncmax > 0 && ncmax <= 480) {
            const int jn = ((ncmax + 31) >> 5) * 8;
#pragma unroll
            for (int p = 0; p < 4; ++p) { float a0 = carry[p]; a0 += __shfl_xor(a0, 1); a0 += __shfl_xor(a0, 2); a0 += __shfl_xor(a0, 4); if (hd == 0 && kq == 0) PSw[(2 * p + qsel) * 128 + jn] = a0; }
        }
        {
#pragma unroll
            for (int p = 0; p < 4; ++p) { const size_t row = (size_t)(rowb + t0w + 2 * p + qsel);
                const float gz = bf2f(G0[row * 256 + habs * 3 + 0]) + Ip->nsa_gate_b[habs * 3 + 0]; out_add(OUTw, p, n, kq, O[p], 1.f / (1.f + __expf(-gz)), true); }
        }
        for (int i = lane; i < 32; i += 64) WMw[i] = (qt < 16) ? 0xffffffffu : 0u;
        if (qt >= 16) {
            if (lane < 3) { const int j = lane == 0 ? 0 : qt - 2 + lane; atomicOr((unsigned*)&WMw[j >> 2], 0xffu << (8 * (j & 3))); }
            for (int q = 0; q < 8; ++q) {
                float v0 = PSw[q * 128 + lane], v1 = PSw[q * 128 + 64 + lane];
                if (lane < 1 || lane > qt - 2) v0 = -1.f; if (lane + 64 > qt - 2) v1 = -1.f;
                for (int s = 0; s < 13; ++s) { const float mx = wmax64(fmaxf(v0, v1));
                    const unsigned long long b0 = __ballot(v0 == mx); int j;
                    if (b0) { j = __builtin_ctzll(b0); if (lane == j) v0 = -1.f; } else { const unsigned long long b1 = __ballot(v1 == mx); j = __builtin_ctzll(b1); if (lane == j) v1 = -1.f; j += 64; }
                    if (lane == 0) atomicOr((unsigned*)&WMw[j >> 2], 1u << (8 * (j & 3) + q)); }
            }
        }
        const bf16* ksb = KV0 + (size_t)rowb * 512 + 256 + g * 64; const bf16* vst = VT + ((size_t)(rowb >> 6) * 256 + g * 64) * 64;
        __syncthreads();
#pragma unroll 1
        for (int rep_ = 0; rep_ < (PROBE_REP == 1 ? 2 : 1); ++rep_) {
#pragma unroll
            for (int p = 0; p < 4; ++p) { m[p] = -1e30f; l[p] = 0.f;
#pragma unroll
                for (int dt = 0; dt < 4; ++dt) O[p][dt] = (f32x4){0.f, 0.f, 0.f, 0.f}; }
            nsa_sweep<MD_BLK>(STG, ksb, vst, 0, qt, qt, WMw, wave, lane, r, kq, qsel, t0w, qf, BC, m, l, O);
        }
        { int qs2_ = qsel; asm volatile("" : "+v"(qs2_));
#pragma unroll
        for (int p = 0; p < 4; ++p) { const size_t row = (size_t)(rowb + t0w + 2 * p + qs2_);
            const float gz = bf2f(G0[row * 256 + habs * 3 + 1]) + Ip->nsa_gate_b[habs * 3 + 1]; out_add(OUTw, p, n, kq, O[p], (1.f / (1.f + __expf(-gz))) / kqsum(l[p]), false); } }
        const bf16* kwb = KV0 + (size_t)rowb * 512 + 384 + g * 64; const bf16* vwt = VT + ((size_t)(rowb >> 6) * 256 + 128 + g * 64) * 64;
#pragma unroll
        for (int p = 0; p < 4; ++p) { m[p] = -1e30f; l[p] = 0.f;
#pragma unroll
            for (int dt = 0; dt < 4; ++dt) O[p][dt] = (f32x4){0.f, 0.f, 0.f, 0.f}; }
        __syncthreads();
        nsa_sweep<MD_WIN>(STG, kwb, vwt, (qt >= 8) ? qt - 8 : 0, qt, qt, nullptr, wave, lane, r, kq, qsel, t0w, qf, BC, m, l, O);
        if (PROBE_REP == 4) {
#pragma unroll
            for (int p = 0; p < 4; ++p) { m[p] = -1e30f; l[p] = 0.f;
#pragma unroll
                for (int dt = 0; dt < 4; ++dt) O[p][dt] = (f32x4){0.f, 0.f, 0.f, 0.f}; }
            nsa_sweep<MD_WIN>(STG, kwb, vwt, (qt >= 8) ? qt - 8 : 0, qt, qt, nullptr, wave, lane, r, kq, qsel, t0w, qf, BC, m, l, O); }
        { int qs3_ = qsel; asm volatile("" : "+v"(qs3_));
#pragma unroll
        for (int p = 0; p < 4; ++p) { const size_t row = (size_t)(rowb + t0w + 2 * p + qs3_);
            const float gz = bf2f(G0[row * 256 + habs * 3 + 2]) + Ip->nsa_gate_b[habs * 3 + 2]; out_add(OUTw, p, n, kq, O[p], (1.f / (1.f + __expf(-gz))) / kqsum(l[p]), false); } }
        int ln_ = lane; asm volatile("" : "+v"(ln_));
#pragma unroll 1
        for (int i = 0; i < 12; ++i) { const int e = i * 64 + ln_, q = e / 96, c4 = e % 96; const f32x4 v = ((const LAS f32x4*)OUTw)[e];
            *(uint2*)(CAT + (size_t)(rowb + t0w + q) * 1024 + g * 384 + 4 * c4) = make_uint2(pk2(v[0], v[1]), pk2(v[2], v[3])); }
#pragma unroll 1
        for (int h2 = 0; h2 < 2; ++h2) { const int hm = 2 * g + h2;
            bf16x8 qm[2]; { const bf16* qp = QM + (size_t)(rowb + t0w + (n & 7)) * 256 + hm * 64 + 8 * kq; qm[0] = ldg16(qp); qm[1] = ldg16(qp + 32); if (n >= 8) { qm[0] = (bf16x8){0, 0, 0, 0, 0, 0, 0, 0}; qm[1] = qm[0]; } }
            float mm = -1e30f, ll = 0.f; f32x4 Om[4];
#pragma unroll
            for (int dt = 0; dt < 4; ++dt) Om[dt] = (f32x4){0.f, 0.f, 0.f, 0.f};
            const bf16* mk = MKB + (size_t)(b * 256) * 256 + hm * 64; const bf16* mvt = MVT + (size_t)(hm * 64) * 512 + b * 256;
            int r_ = r, kq_ = kq; asm volatile("" : "+v"(r_), "+v"(kq_));
            KV1 A; load_kv(A, mk, 256, mvt, 512, 0, r_, kq_);
            for (int key0 = 0; key0 < 256; key0 += 32) { asm volatile("" : "+v"(r_), "+v"(kq_));
                KV1 B; load_kv(B, mk, 256, mvt, 512, (key0 + 32 < 256) ? key0 + 32 : key0, r_, kq_);
                f32x4 sa, sb; qk(sa, sb, A.k, qm); pv(Om, A.v, sm_update(sa, sb, mm, ll, Om)); A = B; }
            const float il = 1.f / kqsum(ll);
            if (n < 8) { bf16* op = CAT + (size_t)(rowb + t0w + n) * 1024 + 768 + hm * 64 + 4 * kq;
#pragma unroll
                for (int dt = 0; dt < 4; ++dt) *(uint2*)(op + 16 * dt) = make_uint2(pk2(Om[dt][0] * il, Om[dt][1] * il), pk2(Om[dt][2] * il, Om[dt][3] * il)); }
        }
    }
}

__device__ __forceinline__ void p10_dsa_norm(Frame& F, const In& I, unsigned char* ws) {
    OPAQUE_TID(); KARGS(); const int gw = F.vcu * NWAVES + (tid_ >> 6), NGW = F.G * NWAVES, lane = tid_ & 63;
    const bf16* PR = (const bf16*)(ws + WS_PROJ1); bf16* CQ = (bf16*)(ws + WS_CQ); bf16* CKV = (bf16*)(ws + WS_CKV); bf16* KIDX = (bf16*)(ws + WS_KIDX); float* WIDX = (float*)(ws + WS_WIDX);
    for (int m = gw; m < M; m += NGW) {
        const bf16* pr = PR + (size_t)m * 768;
        float a[4]; ld4bf(pr + 4 * lane, a);
        float s = wave_sum(a[0] * a[0] + a[1] * a[1] + a[2] * a[2] + a[3] * a[3]); float r = rsqrtf(s * (1.f / 256.f) + EPSF);
        const float4 gq = *(const float4*)(Ip->q_norm + 4 * lane);
        *(uint2*)(CQ + (size_t)m * 256 + 4 * lane) = make_uint2(pk2((a[0] * r) * gq.x, (a[1] * r) * gq.y), pk2((a[2] * r) * gq.z, (a[3] * r) * gq.w));
        const unsigned u = *(const unsigned*)(pr + 256 + 2 * lane); const float c0 = bflo(u), c1 = bfhi(u);
        s = wave_sum(c0 * c0 + c1 * c1); r = rsqrtf(s * (1.f / 128.f) + EPSF);
        *(unsigned*)(CKV + (size_t)m * 128 + 2 * lane) = pk2((c0 * r) * Ip->kv_norm[2 * lane], (c1 * r) * Ip->kv_norm[2 * lane + 1]);
        const float k0 = bf2f(pr[384 + lane]);
        s = wave_sum(k0 * k0); r = rsqrtf(s * (1.f / 64.f) + EPSF);
        { const int tk = m >> 5, key = m & 31, ks = lane >> 4, hf = (lane >> 3) & 1, jj = lane & 7;
          KIDX[((size_t)(tk * 4 + ks) * 64 + hf * 32 + key) * 8 + jj] = (bf16)f2bf((k0 * r) * Ip->kidx_norm[lane]); }
        if (lane < 8) WIDX[(size_t)m * 8 + lane] = bf2f(pr[448 + lane]) * (0.35355339059327373f * 0.125f);
    }
}

#define MFMA32(A, B, C) __builtin_amdgcn_mfma_f32_32x32x16_bf16((A), (B), (C), 0, 0, 0)
typedef float f32x16 __attribute__((ext_vector_type(16)));
constexpr int XL_OFF = RING_BYTES;
constexpr int IDX_HIST = XL_OFF, IDX_CAND = XL_OFF + 16384, IDX_MM = XL_OFF + 24576, IDX_STQ = IDX_MM + 256, IDX_MM2 = IDX_STQ + 256, IDX_CAP = 1024;
static_assert(IDX_MM2 + 64 <= LDSCTL_OFF, "LDS map (indexer)");
__device__ __forceinline__ float wmin64(float v) {
#pragma unroll
    for (int o = 1; o < 64; o <<= 1) v = fminf(v, __shfl_xor(v, o));
    return v;
}
__device__ __forceinline__ void p12_index_mfma(Frame& F, const In& I, unsigned char* ws) {
    OPAQUE_TID(); KARGS(); const int lane = tid_ & 63, wave = __builtin_amdgcn_readfirstlane(tid_ >> 6), key = lane & 31, half = lane >> 5;
    LAS float* SC = (LAS float*)(F.lds + RING_OFF);
    LAS float* MMw = (LAS float*)(F.lds + IDX_MM);
    const bf16* QI = (const bf16*)(ws + WS_QI); const bf16* KIDX = (const bf16*)(ws + WS_KIDX); const float* WIDX = (const float*)(ws + WS_WIDX);
    unsigned short* SEL = (unsigned short*)(ws + WS_SEL); int* CNT = (int*)(ws + WS_CNT);
    const int NG = M / 4, per = (NG + F.G - 1) / F.G;
    for (int j = 0; j < per; ++j) {
        const int u = j * F.G + ((j & 1) ? (F.G - 1 - (int)blockIdx.x) : (int)blockIdx.x);
        if (u >= NG) break;
        const int gi = (u & 1) * (NG / 2) + (u >> 1);
        const int row0 = 4 * gi, b = row0 / T, t0 = row0 % T, rowb = b * T;
        if (t0 < 256) {
            if (wave < 4) { const int t = t0 + wave; unsigned short* so = SEL + (size_t)(row0 + wave) * 256;
#pragma unroll
                for (int i = 0; i < 4; ++i) { const int s = lane + 64 * i; so[s] = (unsigned short)(s <= t ? s : 0); }
                if (lane == 0) CNT[row0 + wave] = t + 1; }
            continue;
        }
        {
            const int rho = lane & 31, a = rho >> 2, qA = ((a >> 2) & 1) + 2 * (a & 1), hdA = 4 * ((a >> 1) & 1) + (rho & 3);
            bf16x8 qa[4];
#pragma unroll
            for (int ks = 0; ks < 4; ++ks) qa[ks] = ldg16(QI + (size_t)(row0 + qA) * 512 + hdA * 64 + 16 * ks + 8 * half);
            float w0[8], w1[8];
            { const float4 x0 = *(const float4*)(WIDX + (size_t)(row0 + 2 * half) * 8), x1 = *(const float4*)(WIDX + (size_t)(row0 + 2 * half) * 8 + 4);
              const float4 y0 = *(const float4*)(WIDX + (size_t)(row0 + 2 * half + 1) * 8), y1 = *(const float4*)(WIDX + (size_t)(row0 + 2 * half + 1) * 8 + 4);
              w0[0] = x0.x; w0[1] = x0.y; w0[2] = x0.z; w0[3] = x0.w; w0[4] = x1.x; w0[5] = x1.y; w0[6] = x1.z; w0[7] = x1.w;
              w1[0] = y0.x; w1[1] = y0.y; w1[2] = y0.z; w1[3] = y0.w; w1[4] = y1.x; w1[5] = y1.y; w1[6] = y1.z; w1[7] = y1.w; }
            const int tq0 = t0 + 2 * half, tq1 = tq0 + 1, nt = (t0 + 3) / 32 + 1;
            float mn0 = INFINITY, mx0 = -INFINITY, mn1 = INFINITY, mx1 = -INFINITY;
            const bf16* kpb = KIDX + (size_t)(rowb >> 5) * 2048 + (size_t)lane * 8;
            const int ntw = (nt - wave + NWAVES - 1) / NWAVES;
#define IDX_LOAD(dst, i) do { const int tl2_ = wave + NWAVES * ((i) < ntw ? (i) : (ntw > 0 ? ntw - 1 : 0)); const bf16* kp_ = kpb + (size_t)tl2_ * 2048; \
                _Pragma("unroll") for (int ks = 0; ks < 4; ++ks) dst[ks] = ldg16(kp_ + 512 * ks); } while (0)
#define IDX_COMP(src, i) do { if ((i) < ntw) { const int kpos = 32 * (wave + NWAVES * (i)) + key; \
                f32x16 c = {0.f, 0.f, 0.f, 0.f, 0.f, 0.f, 0.f, 0.f, 0.f, 0.f, 0.f, 0.f, 0.f, 0.f, 0.f, 0.f}; \
                _Pragma("unroll") for (int ks = 0; ks < 4; ++ks) c = MFMA32(qa[ks], src[ks], c); \
                float s0 = 0.f, s1 = 0.f; \
                _Pragma("unroll") for (int h = 0; h < 8; ++h) { s0 += fmaxf(c[h], 0.f) * w0[h]; s1 += fmaxf(c[8 + h], 0.f) * w1[h]; } \
                s0 += 0.f; s1 += 0.f; \
                const bool ok0 = kpos <= tq0, ok1 = kpos <= tq1; \
                SC[(2 * half) * 8192 + kpos] = ok0 ? s0 : -INFINITY; SC[(2 * half + 1) * 8192 + kpos] = ok1 ? s1 : -INFINITY; \
                if (ok0) { mn0 = fminf(mn0, s0); mx0 = fmaxf(mx0, s0); } if (ok1) { mn1 = fminf(mn1, s1); mx1 = fmaxf(mx1, s1); } } } while (0)
            for (int prb_ = 0; prb_ < (PROBE_REP == 2 ? 2 : 1); ++prb_)
            if (ntw > 0) {
                bf16x8 kb0[4], kb1[4], kb2[4], kb3[4];
                IDX_LOAD(kb0, 0); IDX_LOAD(kb1, 1); IDX_LOAD(kb2, 2);
                for (int i = 0; i < ntw; i += 4) {
                    IDX_LOAD(kb3, i + 3); IDX_COMP(kb0, i);
                    IDX_LOAD(kb0, i + 4); IDX_COMP(kb1, i + 1);
                    IDX_LOAD(kb1, i + 5); IDX_COMP(kb2, i + 2);
                    IDX_LOAD(kb2, i + 6); IDX_COMP(kb3, i + 3);
                }
            }
#undef IDX_LOAD
#undef IDX_COMP
#pragma unroll
            for (int o = 1; o < 32; o <<= 1) { mn0 = fminf(mn0, __shfl_xor(mn0, o)); mx0 = fmaxf(mx0, __shfl_xor(mx0, o)); mn1 = fminf(mn1, __shfl_xor(mn1, o)); mx1 = fmaxf(mx1, __shfl_xor(mx1, o)); }
            if (key == 0) { LAS float* mm = MMw + (wave * 4 + 2 * half) * 2; mm[0] = mn0; mm[1] = mx0; mm[2] = mn1; mm[3] = mx1; }
        }
        __syncthreads();
        {
            const int q = wave >> 1, hw = wave & 1, t = t0 + q, n = t + 1; const LAS float* sc = SC + q * 8192;
            LAS unsigned* hist = (LAS unsigned*)(F.lds + IDX_HIST) + wave * 512; const LAS unsigned* hist0 = (const LAS unsigned*)(F.lds + IDX_HIST) + (2 * q) * 512;
            LAS unsigned short* cand = (LAS unsigned short*)(F.lds + IDX_CAND) + q * IDX_CAP;
            LAS float* stf = (LAS float*)(F.lds + IDX_STQ) + q * 16; LAS int* sti = (LAS int*)stf;
            LAS float* mm2 = (LAS float*)(F.lds + IDX_MM2) + wave * 2;
            unsigned short* so = SEL + (size_t)(row0 + q) * 256;
            const int nch = (n + 255) >> 8;
            if (hw == 0 && lane == 0) { float lo = INFINITY, hi = -INFINITY;
#pragma unroll
                for (int w = 0; w < 8; ++w) { lo = fminf(lo, MMw[(w * 4 + q) * 2]); hi = fmaxf(hi, MMw[(w * 4 + q) * 2 + 1]); }
                stf[0] = lo; stf[1] = hi; sti[2] = 256; sti[3] = 0; sti[4] = 0; sti[5] = 0; sti[6] = 0; sti[7] = 0; sti[8] = 0; sti[9] = 0; }
            __syncthreads();
            for (int round = 0; round < 64; ++round) {
                const float lo = stf[0], hi = stf[1]; const bool act = sti[8] == 0; const bool eqr = !(hi > lo); const float scale = eqr ? 0.f : 1024.f / (hi - lo);
                if (act && !eqr) {
#pragma unroll
                    for (int i = 0; i < 8; ++i) hist[lane + 64 * i] = 0u;
                    for (int c = hw; c < nch; c += 2) { const int i4 = 256 * c + 4 * lane; const f32x4 v4 = *(const LAS f32x4*)(sc + i4);
#pragma unroll
                        for (int e = 0; e < 4; ++e) { const float v = (i4 + e < n) ? v4[e] : -INFINITY;
                            if (v >= lo && v <= hi) { int bb = (int)((v - lo) * scale); bb = bb > 1023 ? 1023 : bb; atomicAdd((unsigned*)&hist[bb >> 1], 1u << (16 * (bb & 1))); } } }
                }
                __syncthreads();
                if (hw == 0 && act) {
                    if (eqr) { if (lane == 0) { sti[8] = 1; sti[9] = 1; } }
                    else {
                        const int krem = sti[2];
                        unsigned cw[8], c0w[8]; unsigned S = 0u, S0 = 0u;
#pragma unroll
                        for (int i = 0; i < 8; ++i) { c0w[i] = hist0[8 * lane + i]; cw[i] = c0w[i] + hist0[512 + 8 * lane + i]; S += (cw[i] & 0xffffu) + (cw[i] >> 16); S0 += (c0w[i] & 0xffffu) + (c0w[i] >> 16); }
                        unsigned x = S, x0 = S0;
#pragma unroll
                        for (int o = 1; o < 64; o <<= 1) { const unsigned y = __shfl_down(x, o), y0 = __shfl_down(x0, o); if (lane + o < 64) { x += y; x0 += y0; } }
                        const unsigned above = x - S; unsigned acc0 = x0 - S0;
                        const bool found = (above < (unsigned)krem) && ((unsigned)krem <= above + S);
                        const int fl = __builtin_ctzll(__ballot(found));
                        int bs = 0; unsigned acc = above, cb = 0u, cb0 = 0u;
                        { bool done = false;
#pragma unroll
                          for (int i = 15; i >= 0; --i) { const unsigned cnt_ = (i & 1) ? (cw[i >> 1] >> 16) : (cw[i >> 1] & 0xffffu), cnt0_ = (i & 1) ? (c0w[i >> 1] >> 16) : (c0w[i >> 1] & 0xffffu);
                              if (!done) { if (acc + cnt_ >= (unsigned)krem) { bs = 16 * lane + i; cb = cnt_; cb0 = cnt0_; done = true; } else { acc += cnt_; acc0 += cnt0_; } } } }
                        if (lane == fl) { sti[2] = krem - (int)acc; sti[3] += (int)acc0; sti[4] += (int)acc; sti[5] = bs; sti[6] = (int)cb0; sti[7] = (int)cb; sti[8] = ((int)cb <= IDX_CAP) ? 1 : 0; }
                    }
                }
                __syncthreads();
                const LAS int* stall = (const LAS int*)(F.lds + IDX_STQ);
                if (stall[8] && stall[16 + 8] && stall[32 + 8] && stall[48 + 8]) break;
                float nlo = INFINITY, nhi = -INFINITY;
                if (sti[8] == 0) { const int bstar = sti[5];
                    for (int c = hw; c < nch; c += 2) { const int i4 = 256 * c + 4 * lane; const f32x4 v4 = *(const LAS f32x4*)(sc + i4);
#pragma unroll
                        for (int e = 0; e < 4; ++e) { const float v = (i4 + e < n) ? v4[e] : -INFINITY;
                            if (v >= lo && v <= hi) { int bb = (int)((v - lo) * scale); bb = bb > 1023 ? 1023 : bb; if (bb == bstar) { nlo = fminf(nlo, v); nhi = fmaxf(nhi, v); } } } } }
                nlo = wmin64(nlo); nhi = wmax64(nhi);
                if (lane == 0) { mm2[0] = nlo; mm2[1] = nhi; }
                __syncthreads();
                if (hw == 0 && lane == 0 && sti[8] == 0) { stf[0] = fminf(mm2[0], mm2[2]); stf[1] = fmaxf(mm2[1], mm2[3]); }
                __syncthreads();
            }
            { const float lo = stf[0], hi = stf[1]; const bool eq = sti[9] != 0; const float scale = eq ? 0.f : 1024.f / (hi - lo);
              const int krem = sti[2], A0 = sti[3], AT = sti[4], bstar = sti[5], C0 = sti[6], ncand = sti[7], nabove = 256 - krem;
              int bsel = hw ? A0 : 0, bcand = hw ? C0 : 0; (void)AT;
              const int cstep = eq ? 1 : 2;
              if (!(eq && hw)) for (int c = eq ? 0 : hw; c < nch; c += cstep) { const int i4 = 256 * c + 4 * lane; const f32x4 v4 = *(const LAS f32x4*)(sc + i4);
#pragma unroll
                  for (int e = 0; e < 4; ++e) { const int idx = i4 + e; const float v = (idx < n) ? v4[e] : -INFINITY;
                      bool sel, cnd;
                      if (eq) { sel = v > hi; cnd = (v == hi); }
                      else { const bool in = (v >= lo && v <= hi); int bb = (int)((v - lo) * scale); bb = bb > 1023 ? 1023 : bb; sel = (v > hi) || (in && bb > bstar); cnd = in && bb == bstar; }
                      const unsigned long long ms = __ballot(sel), mc = __ballot(cnd), lt = (1ull << lane) - 1ull;
                      if (sel) so[bsel + __builtin_popcountll(ms & lt)] = (unsigned short)idx;
                      if (cnd) { const int pc = bcand + __builtin_popcountll(mc & lt);
                          if (eq) { if (pc < krem) so[nabove + pc] = (unsigned short)idx; } else if (pc < IDX_CAP) cand[pc] = (unsigned short)idx; }
                      bsel += __builtin_popcountll(ms); bcand += __builtin_popcountll(mc); } }
              __syncthreads();
              if (!eq) {
                  for (int i = 64 * hw + lane; i < ncand; i += 128) { const int ii = cand[i]; const float vi = sc[ii]; int rank = 0;
                      for (int jj = 0; jj < ncand; ++jj) { const int ij = cand[jj]; const float vj = sc[ij]; rank += ((vj > vi) || (vj == vi && ij < ii)) ? 1 : 0; }
                      if (rank < krem) so[nabove + rank] = (unsigned short)ii; }
              }
              if (hw == 0 && lane == 0) CNT[row0 + q] = 256; }
        }
        __syncthreads();
    }
}

__device__ __forceinline__ unsigned offb(unsigned row, unsigned ch) { return 256u * row + 16u * (ch ^ (((row & 3u) << 2) | ((row >> 2) & 3u))); }
typedef short v4i16_t __attribute__((ext_vector_type(4)));
__device__ __forceinline__ v4i16_t trrd(const LAS unsigned char* p) { return __builtin_amdgcn_ds_read_tr16_b64_v4i16((LAS v4i16_t*)p); }
__device__ __forceinline__ void p13_dsa_mfma(Frame& F, const In& I, unsigned char* ws) {
    OPAQUE_TID(); KARGS(); const int lane = tid_ & 63, wave = __builtin_amdgcn_readfirstlane(tid_ >> 6), n = lane & 15, kq = lane >> 4;
    LAS unsigned char* bkt = F.lds + TAB_BKT; LAS float* b12 = (LAS float*)(F.lds + TAB_B12);
    for (int i = tid_; i < 1536; i += NWAVES * 64) bkt[i] = (unsigned char)rel_bucket(i);
    for (int i = tid_; i < 512; i += NWAVES * 64) b12[i] = ((i & 15) < 12) ? Ip->rel_bias[(i >> 4) * 12 + (i & 15)] * LOG2E : 0.f;
    __syncthreads();
    LAS unsigned char* imgb = F.lds + RING_OFF + wave * 17408; LAS int* sidx = (LAS int*)(imgb + 16384);
    const bf16* QA = (const bf16*)(ws + WS_QA); const bf16* CKV = (const bf16*)(ws + WS_CKV); const bf16* PR = (const bf16*)(ws + WS_PROJ1);
    const unsigned short* SEL = (const unsigned short*)(ws + WS_SEL); const int* CNT = (const int*)(ws + WS_CNT);
    const bf16* MKB = (const bf16*)(ws + WS_MKB) + (size_t)512 * 256; const bf16* MVT = (const bf16*)(ws + WS_MVT) + (size_t)256 * 512;
    bf16* CAT1 = (bf16*)(ws + WS_CAT1);
    const int gw = blockIdx.x * NWAVES + wave, NGW = F.G * NWAVES;
    const LAS float* b12c = b12 + (n < 12 ? n : 0);
    for (int row = gw; row < M; row += NGW) {
        const int b = row / T, t = row % T, rowb = b * T, cnt = __builtin_amdgcn_readfirstlane(CNT[row]);
        asm volatile("s_waitcnt lgkmcnt(0)" ::: "memory");
#pragma unroll
        for (int i = 0; i < 4; ++i) sidx[lane + 64 * i] = (int)SEL[(size_t)row * 256 + lane + 64 * i];
        bf16x8 qf[4];
#pragma unroll
        for (int ks = 0; ks < 4; ++ks) { bf16x8 v = ldg16(QA + (size_t)row * 1536 + (n < 12 ? n : 0) * 128 + 32 * ks + 8 * kq); if (n >= 12) v = (bf16x8){0, 0, 0, 0, 0, 0, 0, 0}; qf[ks] = v; }
        float m = -1e30f, l = 0.f; f32x4 O[8];
#pragma unroll
        for (int rt = 0; rt < 8; ++rt) O[rt] = (f32x4){0.f, 0.f, 0.f, 0.f};
#define DSA_GATHER(c0_, buf_) do { int ln2_ = lane; asm volatile("" : "+v"(ln2_)); \
            _Pragma("unroll") for (int i = 0; i < 8; ++i) { const int rr = 4 * i + (ln2_ >> 4), pos = ln2_ & 15, e = (c0_) + rr; const int kidx = sidx[e < cnt ? e : 0]; \
                const unsigned chs = (unsigned)pos ^ ((((unsigned)rr & 3u) << 2) | (((unsigned)rr >> 2) & 3u)); \
                __builtin_amdgcn_global_load_lds((const unsigned*)(CKV + (size_t)(rowb + kidx) * 128 + 8 * chs), (LAS unsigned*)(imgb + (buf_) * 8192 + i * 1024), 16, 0, 0); } } while (0)
        asm volatile("s_waitcnt lgkmcnt(0)" ::: "memory");
        DSA_GATHER(0, 0);
        for (int c0 = 0; c0 < cnt; c0 += 32) {
            const int cb = (c0 >> 5) & 1; LAS unsigned char* img = imgb + cb * 8192;
            if (c0 + 32 < cnt) { DSA_GATHER(c0 + 32, cb ^ 1); asm volatile("s_waitcnt vmcnt(8)" ::: "memory"); } else asm volatile("s_waitcnt vmcnt(0)" ::: "memory");
            int ln_ = lane; asm volatile("" : "+v"(ln_));
            const bool has = m > -1e29f; const float mref = has ? m : 0.f; const float cinv = -mref;
            f32x4 sa = {cinv, cinv, cinv, cinv}, sb = sa;
            { const unsigned ra = 8u * ((unsigned)(ln_ & 15) >> 2) + ((unsigned)ln_ & 3u), kq_ = (unsigned)ln_ >> 4;
#pragma unroll
              for (int s = 0; s < 4; ++s) { const bf16x8 ka = *(const LAS bf16x8*)(img + offb(ra, 4 * s + kq_)); const bf16x8 kb = *(const LAS bf16x8*)(img + offb(ra + 4, 4 * s + kq_));
                  sa = MFMA16(ka, qf[s], sa); sb = MFMA16(kb, qf[s], sb); } }
#pragma unroll
            for (int i = 0; i < 4; ++i) { const int ea = c0 + 8 * kq + i, eb = ea + 4;
                { const int d = t - sidx[ea < cnt ? ea : 0]; const int dc = d > 1535 ? 1535 : (d < 0 ? 0 : d); sa[i] = (ea < cnt) ? sa[i] + b12c[(int)bkt[dc] * 16] : -INFINITY; }
                { const int d = t - sidx[eb < cnt ? eb : 0]; const int dc = d > 1535 ? 1535 : (d < 0 ? 0 : d); sb[i] = (eb < cnt) ? sb[i] + b12c[(int)bkt[dc] * 16] : -INFINITY; } }
            float lm = lmax8(sa, sb); float fsc = 1.f;
            if (__any((lm > SM_THR) || (!has && lm > -INFINITY))) {
                lm = fmaxf(lm, __shfl_xor(lm, 16)); lm = fmaxf(lm, __shfl_xor(lm, 32));
                const bool upd = (lm > -INFINITY) && (!has || lm > 0.f); const float dl = upd ? lm : 0.f;
                if (upd) m = mref + dl;
                fsc = has ? __builtin_amdgcn_exp2f(-dl) : 1.f; l *= fsc;
#pragma unroll
                for (int i = 0; i < 4; ++i) { sa[i] -= dl; sb[i] -= dl; }
#pragma unroll
                for (int rt = 0; rt < 8; ++rt) O[rt] = O[rt] * fsc;
            }
            f32x4 pa, pb; float sum = 0.f;
#pragma unroll
            for (int i = 0; i < 4; ++i) { pa[i] = __builtin_amdgcn_exp2f(sa[i]); pb[i] = __builtin_amdgcn_exp2f(sb[i]); sum += pa[i] + pb[i]; }
            l += sum;
            const bf16x8 pf = pack8(pa, pb);
            { const unsigned g_ = (unsigned)ln_ >> 4, q_ = ((unsigned)ln_ & 15u) >> 2, p_ = (unsigned)ln_ & 3u;
#pragma unroll
              for (int rt = 0; rt < 8; ++rt) { const v4i16_t x0 = trrd(img + offb(8 * g_ + q_, 2 * rt + (p_ >> 1)) + 8 * (p_ & 1)), x1 = trrd(img + offb(8 * g_ + 4 + q_, 2 * rt + (p_ >> 1)) + 8 * (p_ & 1));
                  const bf16x8 vf = {x0[0], x0[1], x0[2], x0[3], x1[0], x1[1], x1[2], x1[3]};
                  O[rt] = MFMA16(vf, pf, O[rt]); } }
        }
#undef DSA_GATHER
        const float il = 1.f / kqsum(l);
        if (n < 12) { bf16* op = CAT1 + (size_t)row * 1792 + n * 128 + 4 * kq;
#pragma unroll
            for (int rt = 0; rt < 8; ++rt) *(uint2*)(op + 16 * rt) = make_uint2(pk2(O[rt][0] * il, O[rt][1] * il), pk2(O[rt][2] * il, O[rt][3] * il)); }
    }
    for (int u8 = gw; u8 < M / 8; u8 += NGW) {
        const int row0 = 8 * u8, b = row0 / T; const int r = n;
#pragma unroll 1
        for (int hm = 0; hm < 4; ++hm) {
            bf16x8 qm[2]; { const bf16* qp = PR + (size_t)(row0 + (n & 7)) * 768 + 456 + hm * 64 + 8 * kq; qm[0] = ldg16(qp); qm[1] = ldg16(qp + 32); if (n >= 8) { qm[0] = (bf16x8){0, 0, 0, 0, 0, 0, 0, 0}; qm[1] = qm[0]; } }
            float mm = -1e30f, ll = 0.f; f32x4 Om[4];
#pragma unroll
            for (int dt = 0; dt < 4; ++dt) Om[dt] = (f32x4){0.f, 0.f, 0.f, 0.f};
            const bf16* mk = MKB + (size_t)(b * 256) * 256 + hm * 64; const bf16* mvt = MVT + (size_t)(hm * 64) * 512 + b * 256;
            for (int key0 = 0; key0 < 256; key0 += 32) { int r_ = r, kq_ = kq; asm volatile("" : "+v"(r_), "+v"(kq_)); KF k; load_k(k, mk, 256, key0, r_, kq_); VF v; load_vt(v, mvt, 512, key0, r_, kq_);
                f32x4 sa, sb; qk(sa, sb, k, qm); sa = sa * (0.125f * LOG2E); sb = sb * (0.125f * LOG2E); pv(Om, v, sm_update(sa, sb, mm, ll, Om)); }
            const float il = 1.f / kqsum(ll);
            if (n < 8) { bf16* op = CAT1 + (size_t)(row0 + n) * 1792 + 1536 + hm * 64 + 4 * kq;
#pragma unroll
                for (int dt = 0; dt < 4; ++dt) *(uint2*)(op + 16 * dt) = make_uint2(pk2(Om[dt][0] * il, Om[dt][1] * il), pk2(Om[dt][2] * il, Om[dt][3] * il)); }
        }
    }
}

struct Args { In in; float* out; unsigned char* ws; int ph_lo, ph_hi; };
__global__ void __launch_bounds__(NWAVES * 64, 2) mk_fwd(Args args) {
    extern __shared__ __attribute__((aligned(16))) unsigned char lds[];
    Frame F;
    F.lds = (LAS unsigned char*)lds; F.MISC = (volatile LAS unsigned*)(F.lds + MISC_OFF);
    F.G = gridDim.x; { const int bx = blockIdx.x; F.vcu = (F.G % 8 == 0) ? (bx % 8) * (F.G / 8) + bx / 8 : bx; }
    unsigned char* ws = args.ws; const In& I = args.in; float* out = args.out; (void)I;
    F.ctl = (gu32*)(ws + WS_CTL);
    for (int u = threadIdx.x; u < (LDS_BYTES - LDSCTL_OFF) / 4; u += NWAVES * 64) ((LAS unsigned*)(F.lds + LDSCTL_OFF))[u] = 0u;
    __syncthreads();
    XcdBarrier bar; bar.bar = (unsigned*)(F.ctl + CW_BAR); bar.x = 0; bar.st = nullptr;
    if (!MK_SPLIT) bar = xcd_barrier_post((unsigned*)(F.ctl + CW_BAR), F.MISC + 8);
    const int lo = args.ph_lo, hi = args.ph_hi;
#ifndef PH_MASK
#define PH_MASK 0xFFFFFFFFu
#endif
#define IN(k) ((((PH_MASK) >> ((k) % 32)) & 1u) && lo <= (k) && (k) < hi)
#define SEAM(k) do { if (IN(k) && IN((k) + 1)) xcd_barrier(bar); } while (0)
#define SEAM2(k, kn) do { if (IN(k) && IN(kn)) xcd_barrier(bar); } while (0)
#ifndef REP_MASK
#define REP_MASK 0u
#endif
#define REPS(k) (1 + (int)(((REP_MASK) >> (k)) & 1u))
    bf16* XN = (bf16*)(ws + WS_XN); bf16* CAT = (bf16*)(ws + WS_CAT); bf16* ACT = (bf16*)(ws + WS_ACT);
    float* SSQ = (float*)(ws + WS_SSQ);

    if (IN(0)) { for (int r_ = 0; r_ < REPS(0); ++r_) { p0_prologue(F, I, ws); if (r_ + 1 < REPS(0)) xcd_barrier(bar); } SEAM(0); }
    {
            if (IN(1)) {
                pg8::Gemm g{XN, (const bf16*)(ws + WS_WIN0), M, 1792, D}; pg8::StaticOrder S; S.init(M, 1792, F.G, (int)blockIdx.x);
                pg8::EpiRoute<0> E{ws, nullptr};
                for (int r_ = 0; r_ < REPS(1); ++r_) { if (r_) xcd_barrier(bar);
                pg8::gemm_phase<pg8::EpiRoute<0>, pg8::StaticOrder, true, true>(F.lds + RING_OFF, g, S, E); }
                pg8::Gemm g2{(const bf16*)(ws + WS_WVT), XN, 256, M, D}; pg8::StaticOrder S2; S2.init(256, M, F.G, (int)((blockIdx.x + 64) % F.G));
                pg8::EpiRoute<3> E2{ws, nullptr};
                pg8::gemm_phase<pg8::EpiRoute<3>, pg8::StaticOrder, true, true>(F.lds + RING_OFF, g2, S2, E2);
                SEAM(1);
            }
            if (IN(2)) { for (int r_ = 0; r_ < REPS(2); ++r_) { p2_mfma(F, I, ws); if (r_ + 1 < REPS(2)) xcd_barrier(bar); } SEAM(2); }
            if (IN(3)) { for (int r_ = 0; r_ < REPS(3); ++r_) { p3_nsa_mfma(F, I, ws); if (r_ + 1 < REPS(3)) xcd_barrier(bar); } SEAM(3); }
    }
    {
        constexpr int L = 0, pb = L ? 14 : 4;
        if (IN(pb)) {
            pg8::Gemm g{L ? (const bf16*)(ws + WS_CAT1) : CAT, L ? (const bf16*)(ws + WS_WO1F) : (const bf16*)(ws + WS_WO), M, D, L ? 1792 : D}; pg8::StaticOrder S; S.init(M, D, F.G, (int)blockIdx.x);
            KARGS(); pg8::EpiResid<L == 0> E{L ? (const void*)XN : (const void*)Ip->x, XN, SSQ + (size_t)(L ? 2 : 0) * M * 16, D, 0};
            pg8::gemm_phase<pg8::EpiResid<L == 0>, pg8::StaticOrder, true, true>(F.lds + RING_OFF, g, S, E);
            SEAM2(pb, pb + 2);
        }
        if (IN(pb + 2)) {
            pg8::Gemm g{XN, (const bf16*)(ws + WS_WGU) + (size_t)L * 2 * DFF * D, M, 2 * DFF, D}; pg8::StaticOrder S; S.init(M, 2 * DFF, F.G, (int)blockIdx.x);
            pg8::EpiSwiglu E{ACT, SSQ + (size_t)(L ? 2 : 0) * M * 16, DFF, 0};
            for (int r_ = 0; r_ < REPS(pb + 2); ++r_) { if (r_) xcd_barrier(bar);
            pg8::gemm_phase<pg8::EpiSwiglu, pg8::StaticOrder, true, true>(F.lds + RING_OFF, g, S, E); }
            SEAM(pb + 2);
        }
        if (IN(pb + 3)) {
            pg8::Gemm g{ACT, (const bf16*)(ws + WS_WD) + (size_t)L * D * DFF, M, D, DFF}; pg8::StaticOrder S; S.init(M, D, F.G, (int)blockIdx.x);
            pg8::EpiResid<false> E{XN, XN, SSQ + (size_t)(L ? 3 : 1) * M * 16, D, 0};
            pg8::gemm_phase<pg8::EpiResid<false>, pg8::StaticOrder, true, true>(F.lds + RING_OFF, g, S, E);
            SEAM2(pb + 3, L ? 18 : 9);
        }
        }
    {
            if (IN(9)) {
                pg8::Gemm g{XN, (const bf16*)(ws + WS_WIN1), M, 768, D}; pg8::StaticOrder S; S.init(M, 768, F.G, (int)blockIdx.x);
                pg8::EpiRoute<1> E{ws, SSQ + (size_t)1 * M * 16};
                for (int r_ = 0; r_ < REPS(9); ++r_) { if (r_) xcd_barrier(bar);
                pg8::gemm_phase<pg8::EpiRoute<1>, pg8::StaticOrder, true, true>(F.lds + RING_OFF, g, S, E); }
                SEAM(9);
            }
            if (IN(10)) { p10_dsa_norm(F, I, ws); SEAM(10); }
            if (IN(11)) {
                pg8::Gemm g{(const bf16*)(ws + WS_CQ), (const bf16*)(ws + WS_WQ2), M, 2048, 256}; pg8::StaticOrder S; S.init(M, 2048, F.G, (int)blockIdx.x);
                pg8::EpiRoute<2> E{ws, nullptr};
                for (int r_ = 0; r_ < REPS(11); ++r_) { if (r_) xcd_barrier(bar);
                pg8::gemm_phase<pg8::EpiRoute<2>, pg8::StaticOrder, true, true>(F.lds + RING_OFF, g, S, E); }
                SEAM(11);
            }
            if (IN(12)) { for (int r_ = 0; r_ < REPS(12); ++r_) { p12_index_mfma(F, I, ws); if (r_ + 1 < REPS(12)) xcd_barrier(bar); } SEAM(12); }
            if (IN(13)) { for (int r_ = 0; r_ < REPS(13); ++r_) { p13_dsa_mfma(F, I, ws); if (r_ + 1 < REPS(13)) xcd_barrier(bar); } SEAM(13); }
            }
    {
        constexpr int L = 1, pb = L ? 14 : 4;
        if (IN(pb)) {
            pg8::Gemm g{L ? (const bf16*)(ws + WS_CAT1) : CAT, L ? (const bf16*)(ws + WS_WO1F) : (const bf16*)(ws + WS_WO), M, D, L ? 1792 : D}; pg8::StaticOrder S; S.init(M, D, F.G, (int)blockIdx.x);
            KARGS(); pg8::EpiResid<L == 0> E{L ? (const void*)XN : (const void*)Ip->x, XN, SSQ + (size_t)(L ? 2 : 0) * M * 16, D, 0};
            pg8::gemm_phase<pg8::EpiResid<L == 0>, pg8::StaticOrder, true, true>(F.lds + RING_OFF, g, S, E);
            SEAM2(pb, pb + 2);
        }
        if (IN(pb + 2)) {
            pg8::Gemm g{XN, (const bf16*)(ws + WS_WGU) + (size_t)L * 2 * DFF * D, M, 2 * DFF, D}; pg8::StaticOrder S; S.init(M, 2 * DFF, F.G, (int)blockIdx.x);
            pg8::EpiSwiglu E{ACT, SSQ + (size_t)(L ? 2 : 0) * M * 16, DFF, 0};
            for (int r_ = 0; r_ < REPS(pb + 2); ++r_) { if (r_) xcd_barrier(bar);
            pg8::gemm_phase<pg8::EpiSwiglu, pg8::StaticOrder, true, true>(F.lds + RING_OFF, g, S, E); }
            SEAM(pb + 2);
        }
        if (IN(pb + 3)) {
            pg8::Gemm g{ACT, (const bf16*)(ws + WS_WD) + (size_t)L * D * DFF, M, D, DFF}; pg8::StaticOrder S; S.init(M, D, F.G, (int)blockIdx.x);
            pg8::EpiResid<false> E{XN, XN, SSQ + (size_t)(L ? 3 : 1) * M * 16, D, 0};
            pg8::gemm_phase<pg8::EpiResid<false>, pg8::StaticOrder, true, true>(F.lds + RING_OFF, g, S, E);
            SEAM2(pb + 3, L ? 18 : 9);
        }
        }
    if (IN(18)) {
        OPAQUE_TID(); KARGS(); const int lane_ = tid_ & 63;
        const int gw = F.vcu * NWAVES + (tid_ >> 6), NGW = F.G * NWAVES;
        for (int m = gw; m < M; m += NGW) { const float r = rsqrtf(pg8::ssq_row(SSQ + ((size_t)3 * M + m) * 16) * (1.f / D) + EPSF);
#pragma unroll
            for (int j = 0; j < 2; ++j) { const int c = (j * 64 + lane_) * 8; const pg8::u32x4 rw = *(const GAS pg8::u32x4*)(XN + (size_t)m * D + c);
                const GAS f32x4* gr = (const GAS f32x4*)(Ip->norm_final + c); GAS f32x4* orow = (GAS f32x4*)(out + (size_t)m * D + c);
                f32x4 r0, r1; r0[0] = __uint_as_float(rw.x << 16); r0[1] = __uint_as_float(rw.x & 0xffff0000u); r0[2] = __uint_as_float(rw.y << 16); r0[3] = __uint_as_float(rw.y & 0xffff0000u);
                r1[0] = __uint_as_float(rw.z << 16); r1[1] = __uint_as_float(rw.z & 0xffff0000u); r1[2] = __uint_as_float(rw.w << 16); r1[3] = __uint_as_float(rw.w & 0xffff0000u);
                orow[0] = (r0 * r) * gr[0]; orow[1] = (r1 * r) * gr[1]; } }
    }
#undef IN
#undef SEAM
}

extern "C" void kernel_launch(void* const* d_in, const int* in_sizes, int n_in, void* d_out, int out_size, void* d_ws, size_t ws_size, hipStream_t stream) {
    static int grid = 0;
    if (grid == 0) {
        if (n_in != 32 || out_size != M * D || ws_size < WS_END) { fprintf(stderr, "kernel_launch: unexpected shapes (n_in %d out %d ws %zu)\n", n_in, out_size, ws_size); grid = -1; return; }
        int dev = 0, cus = 0, per_cu = 0;
        if (hipGetDevice(&dev) != hipSuccess || hipDeviceGetAttribute(&cus, hipDeviceAttributeMultiprocessorCount, dev) != hipSuccess) { grid = -1; return; }
        if (hipFuncSetAttribute((const void*)mk_fwd, hipFuncAttributeMaxDynamicSharedMemorySize, LDS_BYTES) != hipSuccess) { grid = -1; return; }
        if (hipOccupancyMaxActiveBlocksPerMultiprocessor(&per_cu, (const void*)mk_fwd, NWAVES * 64, LDS_BYTES) != hipSuccess || per_cu < 1) fprintf(stderr, "kernel_launch: occupancy query reports %d\n", per_cu);
        (void)hipGetLastError();
        grid = cus;
        if (grid > 256) grid = 256;
    }
    if (grid < 0) return;
    if (hipMemsetAsync((char*)d_ws + WS_CTL, 0, CTL_ZERO_BYTES, stream) != hipSuccess) return;
    Args a{};
    const float** ip = (const float**)&a.in;
    for (int i = 0; i < 32; ++i) ip[i] = (const float*)d_in[i];
    a.out = (float*)d_out; a.ws = (unsigned char*)d_ws;
#if MK_SPLIT
    for (int k = 0; k < N_PHASES; ++k) { a.ph_lo = k; a.ph_hi = k + 1; hipLaunchKernelGGL(mk_fwd, dim3(grid), dim3(NWAVES * 64), LDS_BYTES, stream, a); }
#else
    a.ph_lo = 0; a.ph_hi = N_PHASES; hipLaunchKernelGGL(mk_fwd, dim3(grid), dim3(NWAVES * 64), LDS_BYTES, stream, a);
#endif
}
```

```cpp
#include <hip/hip_runtime.h>
#include <cstdio>
#include <cstdint>
#include <type_traits>
#include <math.h>

namespace pg8 {
#define PG8_LAS __attribute__((address_space(3)))
typedef unsigned short bf16_t;
typedef short bf16x8 __attribute__((ext_vector_type(8)));
typedef float f32x4 __attribute__((ext_vector_type(4)));
typedef unsigned u32x4 __attribute__((ext_vector_type(4)));
constexpr int BM = 256, BK = 64, HALF = 128, HTB = HALF * BK * 2  , STAGE_BYTES = 8 * HTB, NXCD = 8, WGM = 8;

__host__ __device__ __forceinline__ int lds_byte(int r, int c) { const int st = (r >> 4) * 2 + (c >> 5), rr = r & 15, cc = c & 31, ob = rr * 64 + cc * 2; return st * 1024 + (ob ^ (((ob >> 9) & 1) << 5)); }
__host__ __device__ __forceinline__ void stage_rc(int b, int& R, int& C) { const int st = b / 1024, sb = b % 1024, swz = sb ^ (((sb >> 9) & 1) << 5); R = (st >> 1) * 16 + swz / 64; C = (st & 1) * 32 + (swz % 64) / 2; }
__host__ __device__ __forceinline__ int perm32(int rho) { const int n = rho >> 4, i = rho & 15; return 8 * (i >> 2) + 4 * n + (i & 3); }

struct Unit { int pm, pn; };
struct Gemm { const bf16_t* A; const bf16_t* Bt; int M, N, K; };

struct StaticOrder {
    int nM, nN, nwg, G, c;
    __host__ __device__ void init(int M, int N, int G_, int c_) { nM = M / BM; nN = N / BM; nwg = nM * nN; G = G_; c = c_; }
    __host__ __device__ bool next(int i, Unit& u) const {
        const long L = (long)i * G + c; if (L >= nwg) return false;
        int wgid = (int)L; { const int q = nwg / NXCD, r = nwg % NXCD, xcd = wgid % NXCD, off = wgid / NXCD; wgid = (xcd < r ? xcd * (q + 1) : r * (q + 1) + (xcd - r) * q) + off; }
        const int nig = WGM * nN, gid = wgid / nig, fm = gid * WGM, gsz = (nM - fm) < WGM ? (nM - fm) : WGM;
        u.pm = fm + ((wgid % nig) % gsz); u.pn = (wgid % nig) / gsz; return true;
    }
    __device__ __forceinline__ void a_ready(const Unit&) const {}
    __device__ __forceinline__ void done(const Unit&) const {}
};

__device__ __forceinline__ unsigned cvt_pk_bf16(float lo, float hi) { unsigned r; asm volatile("v_cvt_pk_bf16_f32 %0, %1, %2" : "=v"(r) : "v"(lo), "v"(hi)); return r; }
__device__ __forceinline__ float ssq_row(const float* p) { const f32x4 a = ((const f32x4*)p)[0], b = ((const f32x4*)p)[1], c = ((const f32x4*)p)[2], d = ((const f32x4*)p)[3]; const f32x4 t = (a + b) + (c + d); return (t[0] + t[1]) + (t[2] + t[3]); }
template <int ROUTE> struct EpiRoute {
    static constexpr bool PERM = true, AFTER_DRAIN = false;
    unsigned char* ws; const float* ssq;
    __device__ __forceinline__ void operator()(const f32x4 (&acc)[2][2][4][2], const Unit& u, int wr, int wc, int fr, int fq) const {
        asm volatile("" : "+v"(fr), "+v"(fq));
        const int pn = u.pn; size_t off; int ld, t0; float sc;
        if constexpr (ROUTE == 0) {
            off = pn < 3 ? (size_t)(88u << 20) : pn < 5 ? (size_t)(112u << 20) : pn < 6 ? (size_t)(128u << 20) : (size_t)(136u << 20);
            ld = pn < 3 ? 768 : pn < 5 ? 512 : 256; t0 = pn < 3 ? 0 : pn < 5 ? 3 : pn < 6 ? 5 : 6; sc = (pn < 3 || pn == 5) ? 0.18033688011112042f : 1.f;
        } else if constexpr (ROUTE == 1) { off = (size_t)(88u << 20); ld = 768; t0 = 0; sc = 1.f; }
        else if constexpr (ROUTE == 3) { off = (size_t)(144u << 20); ld = 16384; t0 = 0; sc = 1.f; }
        else { off = pn < 6 ? (size_t)(128u << 20) : (size_t)(176u << 20); ld = pn < 6 ? 1536 : 512; t0 = pn < 6 ? 0 : 6; sc = 1.f; }
        bf16_t* base = (bf16_t*)(ws + off);
        const int row0 = u.pm * BM + wr * 64 + fr, col0 = (pn - t0) * BM + wc * 32 + 8 * fq;
#pragma unroll
        for (int ai = 0; ai < 2; ++ai)
#pragma unroll
            for (int m = 0; m < 4; ++m) { bf16_t* rowp = base + (size_t)(row0 + ai * HALF + m * 16) * ld + col0;
                float scr_ = sc; if constexpr (ROUTE == 1) scr_ = rsqrtf(ssq_row(ssq + (size_t)(row0 + ai * HALF + m * 16) * 16) * (1.f / 1024.f) + 1e-6f);
#pragma unroll
                for (int bj = 0; bj < 2; ++bj) { const f32x4 v0 = acc[ai][bj][m][0] * scr_, v1 = acc[ai][bj][m][1] * scr_;
                    u32x4 w; w.x = cvt_pk_bf16(v0[0], v0[1]); w.y = cvt_pk_bf16(v0[2], v0[3]); w.z = cvt_pk_bf16(v1[0], v1[1]); w.w = cvt_pk_bf16(v1[2], v1[3]);
                    if constexpr (ROUTE == 3) {
                        const int tok = col0 + bj * HALF, rw = row0 + ai * HALF + m * 16; *(u32x4*)(base + ((size_t)(tok >> 6) * 256 + rw) * 64 + (tok & 63)) = w; }
                    else *(u32x4*)(rowp + bj * HALF) = w; } }
    }
};
template <bool RES_F32>
struct EpiResid {
    static constexpr bool PERM = true, AFTER_DRAIN = false;
    const void* res; bf16_t* hb; float* ssq; int ldc; int pad;
    __device__ __forceinline__ void operator()(const f32x4 (&acc)[2][2][4][2], const Unit& u, int wr, int wc, int fr, int fq) const {
        asm volatile("" : "+v"(fr), "+v"(fq));
        const int row0 = u.pm * BM + wr * 64 + fr, col0 = u.pn * BM + wc * 32 + 8 * fq;
#pragma unroll
        for (int ai = 0; ai < 2; ++ai)
#pragma unroll
            for (int m = 0; m < 4; ++m) { const int row = row0 + ai * HALF + m * 16; const size_t off = (size_t)row * ldc + col0; float sq = 0.f;
#pragma unroll
                for (int bj = 0; bj < 2; ++bj) { f32x4 v[2];
                    if constexpr (RES_F32) {
#pragma unroll
                        for (int n = 0; n < 2; ++n) v[n] = *(const f32x4*)((const float*)res + off + bj * HALF + 4 * n) + acc[ai][bj][m][n];
                    } else { const u32x4 rw = *(const u32x4*)((const bf16_t*)res + off + bj * HALF);
                        f32x4 r0, r1; r0[0] = __uint_as_float(rw.x << 16); r0[1] = __uint_as_float(rw.x & 0xffff0000u); r0[2] = __uint_as_float(rw.y << 16); r0[3] = __uint_as_float(rw.y & 0xffff0000u);
                        r1[0] = __uint_as_float(rw.z << 16); r1[1] = __uint_as_float(rw.z & 0xffff0000u); r1[2] = __uint_as_float(rw.w << 16); r1[3] = __uint_as_float(rw.w & 0xffff0000u);
                        v[0] = r0 + acc[ai][bj][m][0]; v[1] = r1 + acc[ai][bj][m][1]; }
#pragma unroll
                    for (int n = 0; n < 2; ++n) sq += (v[n][0] * v[n][0] + v[n][1] * v[n][1]) + (v[n][2] * v[n][2] + v[n][3] * v[n][3]);
                    u32x4 w; w.x = cvt_pk_bf16(v[0][0], v[0][1]); w.y = cvt_pk_bf16(v[0][2], v[0][3]); w.z = cvt_pk_bf16(v[1][0], v[1][1]); w.w = cvt_pk_bf16(v[1][2], v[1][3]); *(u32x4*)(hb + off + bj * HALF) = w; }
                sq += __shfl_xor(sq, 16); sq += __shfl_xor(sq, 32); if (fq == 0) ssq[(size_t)row * 16 + u.pn * 4 + wc] = sq; }
    }
};
struct EpiSwiglu {
    static constexpr bool PERM = true, AFTER_DRAIN = false;
    bf16_t* O; const float* ssq; int ldc; int pad;
    __device__ __forceinline__ void operator()(const f32x4 (&acc)[2][2][4][2], const Unit& u, int wr, int wc, int fr, int fq) const {
        asm volatile("" : "+v"(fr), "+v"(fq));
        const int row0 = u.pm * BM + wr * 64 + fr, col0 = u.pn * HALF + wc * 32 + 8 * fq;
#pragma unroll
        for (int ai = 0; ai < 2; ++ai)
#pragma unroll
            for (int m = 0; m < 4; ++m) { float o[8]; const float rs = rsqrtf(ssq_row(ssq + (size_t)(row0 + ai * HALF + m * 16) * 16) * (1.f / 1024.f) + 1e-6f);
#pragma unroll
                for (int n = 0; n < 2; ++n)
#pragma unroll
                    for (int e = 0; e < 4; ++e) { const float g = acc[ai][0][m][n][e] * rs, up = acc[ai][1][m][n][e] * rs; o[4 * n + e] = (g * __builtin_amdgcn_rcpf(1.f + __expf(-g))) * up; }
                u32x4 w; w.x = cvt_pk_bf16(o[0], o[1]); w.y = cvt_pk_bf16(o[2], o[3]); w.z = cvt_pk_bf16(o[4], o[5]); w.w = cvt_pk_bf16(o[6], o[7]);
                *(u32x4*)(O + (size_t)(row0 + ai * HALF + m * 16) * ldc + col0) = w; }
    }
};
template <class Epi, class Sched, bool ALIGN_EPI = false, bool SP2 = false>
__device__ __forceinline__ void gemm_phase(PG8_LAS unsigned char* lds, const Gemm g, const Sched& S, const Epi& E) {
    int tid = threadIdx.x; asm volatile("" : "+v"(tid));
    const int wid = __builtin_amdgcn_readfirstlane(tid >> 6), lane = tid & 63, wr = wid >> 2, wc = wid & 3, fr = lane & 15, fq = lane >> 4;
    int K = g.K; asm volatile("" : "+s"(K));
    const int nt = K / BK;
    unsigned voffA[2], voffB[2];
#pragma unroll
    for (int i = 0; i < 2; ++i) { int R, C; stage_rc(tid * 16 + i * 8192, R, C); const int Rb = Epi::PERM ? ((R & ~31) + perm32(R & 31)) : R;
        voffA[i] = (unsigned)(R * K + C) * 2u; voffB[i] = (unsigned)(Rb * K + C) * 2u; }
    const size_t kstep = (size_t)(BK * 2);
    const size_t hstep = (size_t)HALF * K * 2;
    const size_t tstep = 2 * hstep;
    const unsigned ldsw = (unsigned)wid * 1024u;
    const int aoff = lds_byte(wr * 64 + fr, fq * 8), boff = lds_byte(wc * 32 + fr, fq * 8);
#define PG8_SA(b, h) (((b) * 2 + (h)) * HTB)
#define PG8_SB(b, h) ((4 + (b) * 2 + (h)) * HTB)
#define PG8_STAGE(bufoff, gbase, voff) do { _Pragma("unroll") for (int _i = 0; _i < 2; ++_i) \
        __builtin_amdgcn_global_load_lds((const unsigned*)((const char*)(gbase) + (voff)[_i]), (PG8_LAS unsigned*)(lds + (bufoff) + ldsw + _i * 8192), 16, 0, 0); } while (0)
#define PG8_LDA(dst, b, h) do { _Pragma("unroll") for (int m = 0; m < 4; ++m) _Pragma("unroll") for (int k = 0; k < 2; ++k) dst[m][k] = *(const PG8_LAS bf16x8*)(lds + PG8_SA(b, h) + aoff + m * 2048 + k * 1024); } while (0)
#define PG8_LDB(dst, b, h) do { _Pragma("unroll") for (int n = 0; n < 2; ++n) _Pragma("unroll") for (int k = 0; k < 2; ++k) dst[n][k] = *(const PG8_LAS bf16x8*)(lds + PG8_SB(b, h) + boff + n * 2048 + k * 1024); } while (0)
#define PG8_MMA(ai, bj, At, Bt) do { __builtin_amdgcn_s_setprio(1); _Pragma("unroll") for (int m = 0; m < 4; ++m) _Pragma("unroll") for (int n = 0; n < 2; ++n) _Pragma("unroll") for (int k = 0; k < 2; ++k) \
        acc[ai][bj][m][n] = __builtin_amdgcn_mfma_f32_16x16x32_bf16(Bt[n][k], At[m][k], acc[ai][bj][m][n], 0, 0, 0); __builtin_amdgcn_s_setprio(0); } while (0)
#define PG8_WAIT_V(n) asm volatile("s_waitcnt vmcnt(" #n ")" ::: "memory")
#define PG8_WAIT_L(n) asm volatile("s_waitcnt lgkmcnt(" #n ")" ::: "memory")
#define PG8_BAR __builtin_amdgcn_s_barrier()
#define PG8_SCHED __builtin_amdgcn_sched_barrier(0)
    Unit cur, nxt; int ui = 0;
    if (!S.next(0, cur)) return;
    f32x4 acc[2][2][4][2];
#pragma unroll
    for (int a = 0; a < 2; ++a)
#pragma unroll
        for (int b = 0; b < 2; ++b)
#pragma unroll
            for (int m = 0; m < 4; ++m)
#pragma unroll
                for (int n = 0; n < 2; ++n) acc[a][b][m][n] = (f32x4){0.f, 0.f, 0.f, 0.f};
    bf16x8 At[4][2], B0[2][2], B1[2][2];
    const char* cA = (const char*)g.A + (size_t)cur.pm * tstep; const char* cB = (const char*)g.Bt + (size_t)cur.pn * tstep;
    S.a_ready(cur);
    if constexpr (SP2) {
        PG8_STAGE(PG8_SB(0, 0), cB, voffB); PG8_STAGE(PG8_SB(0, 1), cB + hstep, voffB); PG8_STAGE(PG8_SA(0, 0), cA, voffA); PG8_STAGE(PG8_SA(0, 1), cA + hstep, voffA);
        if (wr == 1) PG8_BAR;
        PG8_WAIT_V(2); PG8_BAR;
        PG8_STAGE(PG8_SB(1, 0), cB + kstep, voffB); PG8_STAGE(PG8_SA(1, 0), cA + kstep, voffA); PG8_STAGE(PG8_SB(1, 1), cB + hstep + kstep, voffB);
        PG8_WAIT_V(6); PG8_BAR;
    } else {
        PG8_STAGE(PG8_SB(0, 0), cB, voffB); PG8_STAGE(PG8_SA(0, 0), cA, voffA); PG8_STAGE(PG8_SB(0, 1), cB + hstep, voffB); PG8_STAGE(PG8_SA(0, 1), cA + hstep, voffA);
        if (wr == 1) PG8_BAR;
        PG8_WAIT_V(4); PG8_BAR;
        PG8_STAGE(PG8_SB(1, 0), cB + kstep, voffB); PG8_STAGE(PG8_SA(1, 0), cA + kstep, voffA); PG8_STAGE(PG8_SB(1, 1), cB + hstep + kstep, voffB);
        PG8_WAIT_V(6); PG8_BAR;
    }
    for (;;) {
        const bool has_next = S.next(ui + 1, nxt);
        const char* nA = has_next ? (const char*)g.A + (size_t)nxt.pm * tstep : cA; const char* nB = has_next ? (const char*)g.Bt + (size_t)nxt.pn * tstep : cB;
        for (int t = 0; t < nt; t += 2) {
            const bool last = (t == nt - 2);
            const char* a1 = cA + (size_t)(t + 1) * kstep;
            const char* a2 = last ? nA : cA + (size_t)(t + 2) * kstep; const char* b2 = last ? nB : cB + (size_t)(t + 2) * kstep;
            const char* a3 = a2 + kstep; const char* b3 = b2 + kstep;
            if (last && has_next) S.a_ready(nxt);
            if constexpr (SP2) {
            PG8_LDB(B0, 0, 0); PG8_LDB(B1, 0, 1); PG8_SCHED; PG8_LDA(At, 0, 0); PG8_STAGE(PG8_SA(1, 1), a1 + hstep, voffA);
            PG8_WAIT_V(8); PG8_WAIT_L(0); PG8_BAR; PG8_MMA(0, 0, At, B0); PG8_MMA(0, 1, At, B1); PG8_BAR; PG8_SCHED;
            PG8_LDA(At, 0, 1); PG8_STAGE(PG8_SB(0, 0), b2, voffB); PG8_STAGE(PG8_SB(0, 1), b2 + hstep, voffB); PG8_STAGE(PG8_SA(0, 0), a2, voffA);
            PG8_WAIT_V(8); PG8_WAIT_L(0); PG8_BAR; PG8_MMA(1, 0, At, B0); PG8_MMA(1, 1, At, B1); PG8_BAR; PG8_SCHED;
            PG8_LDB(B0, 1, 0); PG8_LDB(B1, 1, 1); PG8_SCHED; PG8_LDA(At, 1, 0); PG8_STAGE(PG8_SA(0, 1), a2 + hstep, voffA);
            PG8_WAIT_V(8); PG8_WAIT_L(0); PG8_BAR; PG8_MMA(0, 0, At, B0); PG8_MMA(0, 1, At, B1); PG8_BAR; PG8_SCHED;
            PG8_LDA(At, 1, 1); PG8_STAGE(PG8_SB(1, 0), b3, voffB); PG8_STAGE(PG8_SB(1, 1), b3 + hstep, voffB); PG8_STAGE(PG8_SA(1, 0), a3, voffA);
            PG8_WAIT_V(8); PG8_WAIT_L(0); PG8_BAR; PG8_MMA(1, 0, At, B0); PG8_MMA(1, 1, At, B1); PG8_BAR; PG8_SCHED;
            } else {
            PG8_LDB(B0, 0, 0); PG8_SCHED; PG8_LDA(At, 0, 0); PG8_STAGE(PG8_SA(1, 1), a1 + hstep, voffA);
            PG8_WAIT_L(8); PG8_BAR; PG8_WAIT_L(0); PG8_MMA(0, 0, At, B0); PG8_BAR; PG8_SCHED;
            PG8_LDB(B1, 0, 1); PG8_STAGE(PG8_SB(0, 0), b2, voffB);
            PG8_BAR; PG8_WAIT_L(0); PG8_MMA(0, 1, At, B1); PG8_BAR;
            PG8_LDA(At, 0, 1); PG8_STAGE(PG8_SA(0, 0), a2, voffA);
            PG8_BAR; PG8_WAIT_L(0); PG8_MMA(1, 0, At, B0); PG8_BAR; PG8_SCHED;
            PG8_STAGE(PG8_SB(0, 1), b2 + hstep, voffB);
            PG8_WAIT_V(6); PG8_BAR; PG8_MMA(1, 1, At, B1); PG8_BAR;
            PG8_LDB(B0, 1, 0); PG8_SCHED; PG8_LDA(At, 1, 0); PG8_STAGE(PG8_SA(0, 1), a2 + hstep, voffA);
            PG8_WAIT_L(8); PG8_BAR; PG8_WAIT_L(0); PG8_MMA(0, 0, At, B0); PG8_BAR; PG8_SCHED;
            PG8_LDB(B1, 1, 1); PG8_STAGE(PG8_SB(1, 0), b3, voffB);
            PG8_BAR; PG8_WAIT_L(0); PG8_MMA(0, 1, At, B1); PG8_BAR;
            PG8_LDA(At, 1, 1); PG8_STAGE(PG8_SA(1, 0), a3, voffA);
            PG8_BAR; PG8_WAIT_L(0); PG8_MMA(1, 0, At, B0); PG8_BAR; PG8_SCHED;
            PG8_STAGE(PG8_SB(1, 1), b3 + hstep, voffB);
            PG8_WAIT_V(6); PG8_BAR; PG8_MMA(1, 1, At, B1); PG8_BAR;
            }
        }
        if constexpr (ALIGN_EPI) { if (wr == 0) PG8_BAR; }
        if constexpr (!Epi::AFTER_DRAIN) { E(acc, cur, wr, wc, fr, fq); S.done(cur); }
        if (!has_next) break;
#pragma unroll
        for (int a = 0; a < 2; ++a)
#pragma unroll
            for (int b = 0; b < 2; ++b)
#pragma unroll
                for (int m = 0; m < 4; ++m)
#pragma unroll
                    for (int n = 0; n < 2; ++n) acc[a][b][m][n] = (f32x4){0.f, 0.f, 0.f, 0.f};
        cur = nxt; cA = nA; cB = nB; ++ui;
        if constexpr (ALIGN_EPI) { if (wr == 1) PG8_BAR; }
    }
    PG8_WAIT_V(0);
    if constexpr (!ALIGN_EPI) { if (wr == 0) PG8_BAR; }
    PG8_BAR;
    if constexpr (Epi::AFTER_DRAIN) { E.fused(acc, cur, wr, wc, fr, fq, lds, wid, lane); S.done(cur); }
#undef PG8_SA
#undef PG8_SB
#undef PG8_STAGE
#undef PG8_LDA
#undef PG8_LDB
#undef PG8_MMA
#undef PG8_WAIT_V
#undef PG8_WAIT_L
#undef PG8_BAR
#undef PG8_SCHED
}
}
constexpr int NWAVES = 8;
constexpr int BATCH = 2, T = 8192, D = 1024, M = BATCH * T, DFF = 2816, NSA_IN = 1828, DSA_IN = 712, NCMP = 511, NCR = BATCH * NCMP * 2;
constexpr float NEGF = -1e30f, EPSF = 1e-6f;
#ifndef MK_SPLIT
#define MK_SPLIT 0
#endif
constexpr int N_PHASES = 19;
constexpr size_t MiB = 1u << 20;
constexpr size_t WS_CTL = 0, CTL_ZERO_BYTES = 1 * MiB;
constexpr size_t WS_KCB = 1 * MiB  , WS_VCT = 1 * MiB + 512 * 1024  , WS_MKB = 2 * MiB  , WS_MVT = 2 * MiB + 512 * 1024  , WS_MKV = 3 * MiB  , WS_WIDX = 5 * MiB  , WS_CNT = 6 * MiB  ;
constexpr size_t WS_WIN0 = 8 * MiB, WS_WO = 12 * MiB, WS_WGU = 16 * MiB, WS_WD = 38 * MiB, WS_WIN1 = 49 * MiB, WS_WQ2 = 51 * MiB, WS_WVT = 52 * MiB  ;
constexpr size_t WS_W1T = 232 * MiB, WS_MEMN = 234 * MiB, WS_WMKT = 236 * MiB, WS_W2T = 238 * MiB, WS_B1F = 238 * MiB + 64 * 1024;
constexpr size_t WS_XN = 56 * MiB;
constexpr size_t WS_Q0 = 88 * MiB, WS_KV0 = 112 * MiB  , WS_QM = 128 * MiB, WS_G0 = 136 * MiB, WS_VT = 144 * MiB  ;
static_assert(WS_Q0 == (88u << 20) && WS_KV0 == (112u << 20) && WS_QM == (128u << 20) && WS_G0 == (136u << 20), "EpiRoute tables");
constexpr size_t WS_ACT = 88 * MiB;
constexpr size_t WS_PROJ1 = 88 * MiB, WS_CQ = 112 * MiB, WS_CKV = 120 * MiB, WS_KIDX = 124 * MiB, WS_QA = 128 * MiB, WS_QI = 176 * MiB, WS_SEL = 112 * MiB  , WS_CAT1 = 176 * MiB  , WS_WO1F = 52 * MiB + 512 * 1024  ;
constexpr size_t WS_OCS = 152 * MiB  , WS_CAT = 200 * MiB, WS_SSQ = 239 * MiB  , WS_END = 243 * MiB;
static_assert(WS_PROJ1 == (88u << 20) && WS_QA == (128u << 20) && WS_QI == (176u << 20) && WS_VT == (144u << 20), "EpiRoute tables");
static_assert(WS_ACT + (size_t)M * DFF * 2 <= WS_CAT + 0 * MiB || true, "map");
constexpr int CW_BAR = 4096;
constexpr int RING_OFF = 0, RING_BYTES = 131072, LDS_BYTES = 163840, LDSCTL_OFF = LDS_BYTES - 1024, MISC_OFF = LDSCTL_OFF + 320;
#define GAS __attribute__((address_space(1)))
#define LAS __attribute__((address_space(3)))
typedef unsigned short bf16;
typedef unsigned v4u __attribute__((ext_vector_type(4)));
typedef float f32x4 __attribute__((ext_vector_type(4)));
typedef short bf16x8 __attribute__((ext_vector_type(8)));
typedef GAS unsigned gu32;
typedef GAS unsigned long long gu64;
#define RLX_AGENT __ATOMIC_RELAXED, __HIP_MEMORY_SCOPE_AGENT
#define LDS_WAIT() asm volatile("s_waitcnt lgkmcnt(0)" ::: "memory")
#define VM_WAIT() asm volatile("s_waitcnt vmcnt(0)" ::: "memory")
__device__ __forceinline__ unsigned long long rt() { return __builtin_amdgcn_s_memrealtime(); }
__device__ __forceinline__ unsigned f2bf(float f) { unsigned u = __builtin_bit_cast(unsigned, f); return (u + 0x7fffu + ((u >> 16) & 1u)) >> 16; }
__device__ __forceinline__ unsigned pk2(float lo, float hi) { return f2bf(lo) | (f2bf(hi) << 16); }
#define XB_TMO      128
#define XB_XCNT(j)  (256  + 64 * (j))
#define XB_XSUB(j)  (1280 + 64 * (j))
#define XB_XGEN(j)  (2304 + 64 * (j))
#define XB_TOP      3328
#define XB_TOPGEN   3392
#define XCD_BAR_WORDS 3456
#define XB_SPIN_CAP (1u << 18)

__device__ __forceinline__ unsigned xb_ld(unsigned* p)              { return __hip_atomic_load(p, __ATOMIC_RELAXED, __HIP_MEMORY_SCOPE_AGENT); }
__device__ __forceinline__ unsigned xb_add(unsigned* p, unsigned v) { return __hip_atomic_fetch_add(p, v, __ATOMIC_RELAXED, __HIP_MEMORY_SCOPE_AGENT); }
__device__ __forceinline__ unsigned xb_xcc_id() { return (unsigned)__builtin_amdgcn_s_getreg((3 << 11) | 20) & 0xFu; }
#define XB_SPIN(cond, bar) do { unsigned _sp = 0; while (cond) { __builtin_amdgcn_s_sleep(1); \
    if ((++_sp & 255u) == 0u) { if (xb_ld(&(bar)[XB_TMO])) break; if (_sp > XB_SPIN_CAP) { atomicAdd(&(bar)[XB_TMO], 1u); break; } } } } while (0)

struct XcdBarrier {
    unsigned* bar; unsigned x;
    volatile LAS unsigned* st;
};

__device__ __forceinline__ XcdBarrier xcd_barrier_post(unsigned* bar, volatile LAS unsigned* st) {
    XcdBarrier b; b.bar = bar; b.x = xb_xcc_id(); b.st = st;
    if (threadIdx.x == 0) (void)xb_add(&bar[XB_XCNT(b.x)], 1u);
    return b;
}
__device__ __forceinline__ void xcd_barrier_complete(unsigned* bar, unsigned x, unsigned& nloc, unsigned& nx) {
    const unsigned G = gridDim.x * gridDim.y * gridDim.z;
    unsigned sum, cnt, mine, sp = 0u;
    for (;;) {
        sum = 0u; cnt = 0u; mine = 0u;
#pragma unroll 1
        for (unsigned j = 0; j < 16; ++j) { const unsigned c = xb_ld(&bar[XB_XCNT(j)]); sum += c; cnt += (c > 0u) ? 1u : 0u; mine = (j == x) ? c : mine; }
        if (sum == G) break;
        __builtin_amdgcn_s_sleep(1);
        if ((++sp & 255u) == 0u) { if (xb_ld(&bar[XB_TMO])) break; if (sp > XB_SPIN_CAP) { atomicAdd(&bar[XB_TMO], 1u); break; } }
    }
    nloc = mine > 0u ? mine : 1u; nx = cnt > 0u ? cnt : 1u;
}

__device__ __forceinline__ void xcd_barrier(const XcdBarrier& b) {
    asm volatile("s_waitcnt vmcnt(0)" ::: "memory");
    __syncthreads();
    if (threadIdx.x == 0) {
        unsigned* bar = b.bar;
        __builtin_amdgcn_s_waitcnt(0);
        unsigned nloc = b.st[0], nx = b.st[1];
        if (nloc == 0u) { xcd_barrier_complete(bar, b.x, nloc, nx); b.st[0] = nloc; b.st[1] = nx; }
        const unsigned old = xb_add(&bar[XB_XSUB(b.x)], 1u);
        const unsigned gen = old / nloc;
        if (old + 1u == (gen + 1u) * nloc) {
            __builtin_amdgcn_fence(__ATOMIC_RELEASE, "agent");
            asm volatile("s_waitcnt vmcnt(0)" ::: "memory");
            const unsigned og = xb_add(&bar[XB_TOP], 1u);
            const unsigned tg = og / nx;
            if (og + 1u == (tg + 1u) * nx) xb_add(&bar[XB_TOPGEN], 1u);
            else XB_SPIN(xb_ld(&bar[XB_TOPGEN]) == tg, bar);
            __builtin_amdgcn_fence(__ATOMIC_ACQUIRE, "agent");
            xb_add(&bar[XB_XGEN(b.x)], 1u);
            asm volatile("s_waitcnt vmcnt(0)" ::: "memory");
        } else {
            XB_SPIN(xb_ld(&bar[XB_XGEN(b.x)]) == gen, bar);
            __builtin_amdgcn_fence(__ATOMIC_ACQUIRE, "agent");
            asm volatile("s_waitcnt vmcnt(0)" ::: "memory");
        }
    }
    __syncthreads();
}

struct Frame {
    LAS unsigned char* lds; volatile LAS unsigned* MISC; gu32* ctl;
    int vcu, G;
};
__device__ __forceinline__ float bf2f(unsigned short u) { return __uint_as_float((unsigned)u << 16); }
__device__ __forceinline__ float bflo(unsigned u) { return __uint_as_float(u << 16); }
__device__ __forceinline__ float bfhi(unsigned u) { return __uint_as_float(u & 0xffff0000u); }
__device__ __forceinline__ float wave_sum(float v) {
#pragma unroll
    for (int o = 1; o < 64; o <<= 1) v += __shfl_xor(v, o);
    return v;
}
__device__ __forceinline__ float red16_sum(float v) { v += __shfl_xor(v, 1, 16); v += __shfl_xor(v, 2, 16); v += __shfl_xor(v, 4, 16); v += __shfl_xor(v, 8, 16); return v; }
__device__ __forceinline__ float red16_max(float v) { v = fmaxf(v, __shfl_xor(v, 1, 16)); v = fmaxf(v, __shfl_xor(v, 2, 16)); v = fmaxf(v, __shfl_xor(v, 4, 16)); v = fmaxf(v, __shfl_xor(v, 8, 16)); return v; }
__device__ __forceinline__ int rel_bucket(int n) {
    if (n < 16) return n;
    return 16 + (n >= 22) + (n >= 30) + (n >= 40) + (n >= 54) + (n >= 73) + (n >= 99) + (n >= 134) + (n >= 182) + (n >= 246) + (n >= 332) + (n >= 450) + (n >= 609) + (n >= 825) + (n >= 1117) + (n >= 1513);
}

__device__ __forceinline__ void xpose_item(const float* W, int ldw, int c0, int nvalid, int k0, bf16* WT, int Kd, int drow0, LAS float* scr, int lane, const float* kgain = nullptr) {
#pragma unroll
    for (int i = 0; i < 8; ++i) { const int kk = 8 * i + (lane >> 3), n = (lane & 7) * 4;
        float4 wv = make_float4(0.f, 0.f, 0.f, 0.f);
        if (n + 3 < nvalid) wv = *(const float4*)(W + (size_t)(k0 + kk) * ldw + c0 + n);
        else if (n < nvalid) { const float* wp = W + (size_t)(k0 + kk) * ldw + c0 + n; wv.x = wp[0]; if (n + 1 < nvalid) wv.y = wp[1]; if (n + 2 < nvalid) wv.z = wp[2]; }
        if (kgain) { const float g_ = kgain[k0 + kk]; wv.x *= g_; wv.y *= g_; wv.z *= g_; wv.w *= g_; }
        LAS float* sp = scr + kk * 33 + n; sp[0] = wv.x; sp[1] = wv.y; sp[2] = wv.z; sp[3] = wv.w; }
    LDS_WAIT(); asm volatile("" ::: "memory");
    const int c = lane & 7;
#pragma unroll
    for (int j = 0; j < 4; ++j) { const int n = (lane >> 3) + 8 * j; const LAS float* s = scr + (8 * c) * 33 + n;
        v4u o; o.x = pk2(s[0 * 33], s[1 * 33]); o.y = pk2(s[2 * 33], s[3 * 33]); o.z = pk2(s[4 * 33], s[5 * 33]); o.w = pk2(s[6 * 33], s[7 * 33]);
        *(GAS v4u*)(WT + (size_t)(drow0 + n) * Kd + k0 + 8 * c) = o; }
    LDS_WAIT(); asm volatile("" ::: "memory");
}
__device__ __forceinline__ void rms_row_to_bf16(const float* xrow, const float* gain, bf16* orow, int lane) {
    const GAS f32x4* xr = (const GAS f32x4*)xrow + lane; const GAS f32x4* gr = (const GAS f32x4*)gain + lane;
    f32x4 v[4]; float s = 0.f;
#pragma unroll
    for (int j = 0; j < 4; ++j) { v[j] = xr[64 * j]; s += (v[j].x * v[j].x + v[j].y * v[j].y) + (v[j].z * v[j].z + v[j].w * v[j].w); }
    const float r = rsqrtf(wave_sum(s) * (1.f / D) + EPSF);
    GAS unsigned long long* o8 = (GAS unsigned long long*)orow + lane;
#pragma unroll
    for (int j = 0; j < 4; ++j) { const f32x4 g = gr[64 * j]; o8[64 * j] = (unsigned long long)pk2((v[j].x * r) * g.x, (v[j].y * r) * g.y) | ((unsigned long long)pk2((v[j].z * r) * g.z, (v[j].w * r) * g.w) << 32); }
}
#ifndef PROBE_REP
#define PROBE_REP 0
#endif
#define CAS __attribute__((address_space(4)))
#define KARGS() const CAS In* Ip = (const CAS In*)__builtin_amdgcn_kernarg_segment_ptr(); asm volatile("" : "+s"(Ip))
#define OPAQUE_TID() int tid_ = threadIdx.x; asm volatile("" : "+v"(tid_))
__device__ __forceinline__ void norm_phase(Frame& F, const float* x, const float* gain, bf16* xn) {
    OPAQUE_TID(); const int lane_ = tid_ & 63, wave_ = tid_ >> 6;
    const int gw = F.vcu * NWAVES + wave_, NGW = F.G * NWAVES;
    for (int m = gw; m < M; m += NGW) rms_row_to_bf16(x + (size_t)m * D, gain, xn + (size_t)m * D, lane_);
}

template <int DL>
__device__ __forceinline__ void coop_attend(const float (&q)[DL], const float (&k)[DL], const float (&v)[DL], float bias, float& m_, float& l_, float (&o)[DL]) {
    float a = 0.f;
#pragma unroll
    for (int d = 0; d < DL; ++d) a += q[d] * k[d];
    a = red16_sum(a) + bias;
    const float mn = fmaxf(m_, a), al = __expf(m_ - mn), p = __expf(a - mn);
    l_ = l_ * al + p; m_ = mn;
#pragma unroll
    for (int d = 0; d < DL; ++d) o[d] = o[d] * al + p * v[d];
}
__device__ __forceinline__ void ld4bf(const bf16* p, float (&x)[4]) { const uint2 u = *(const uint2*)p; x[0] = bflo(u.x); x[1] = bfhi(u.x); x[2] = bflo(u.y); x[3] = bfhi(u.y); }
__device__ __forceinline__ void ld8bf(const bf16* p, float (&x)[8]) { const uint4 u = *(const uint4*)p; x[0] = bflo(u.x); x[1] = bfhi(u.x); x[2] = bflo(u.y); x[3] = bfhi(u.y); x[4] = bflo(u.z); x[5] = bfhi(u.z); x[6] = bflo(u.w); x[7] = bfhi(u.w); }
__device__ __forceinline__ void ld4f(const float* p, float (&x)[4]) { const float4 u = *(const float4*)p; x[0] = u.x; x[1] = u.y; x[2] = u.z; x[3] = u.w; }

struct In {
    const float *x, *mem, *rel_bias, *norm_mix, *norm_ffn, *norm_mem, *w_mem_kv, *w_out, *ffn_gate, *ffn_up, *ffn_down, *nsa_w_in, *nsa_gate_b, *pos_k, *pos_v,
        *k_w1, *k_b1, *k_w2, *k_b2, *v_w1, *v_b1, *v_w2, *v_b2, *dsa_w_in, *q_norm, *kv_norm, *w_q_up, *w_uk, *w_uv, *w_q_idx, *kidx_norm, *norm_final;
};
__device__ __forceinline__ void p0_prologue(Frame& F, const In& I, unsigned char* ws) {
    OPAQUE_TID(); KARGS(); const int lane_ = tid_ & 63, wave_ = __builtin_amdgcn_readfirstlane(tid_ >> 6);
    LAS float* scr = (LAS float*)(F.lds + RING_OFF + wave_ * 16384);
    const int gw = F.vcu * NWAVES + wave_, NGW = F.G * NWAVES;
    bf16* WIN0 = (bf16*)(ws + WS_WIN0); bf16* WO = (bf16*)(ws + WS_WO); bf16* WGU = (bf16*)(ws + WS_WGU); bf16* WD = (bf16*)(ws + WS_WD); bf16* WIN1 = (bf16*)(ws + WS_WIN1); bf16* WQ2 = (bf16*)(ws + WS_WQ2);
    constexpr int I_A = 16 * 56, I_G = 16 * 8, I_B = 2 * 16 * 32, I_C = 2 * 16 * 176, I_D = 2 * 44 * 32, I_E = 16 * 24, I_F = 4 * 16, NITEMS = I_A + I_B + I_C + I_D + I_E + I_F + I_G;
    for (int it = gw; it < NITEMS; it += NGW) {
        int r = it;
        if (r < I_A) { const int kb = r / 56, nb = r % 56, r0 = 32 * nb; int c0, nv;
            if (r0 < 1152) { c0 = r0; nv = 32; } else if (r0 < 1280) { c0 = r0 + 128; nv = 32; } else if (r0 < 1536) { c0 = r0 + 292; nv = 32; } else if (r0 == 1536) { c0 = 1536; nv = 32; } else if (r0 == 1568) { c0 = 1568; nv = 4; } else { c0 = 0; nv = 0; }
            xpose_item(Ip->nsa_w_in, NSA_IN, c0, nv, 64 * kb, WIN0, D, r0, scr, lane_); continue; } r -= I_A;
        if (r < I_B) { const int l = r / 512, q = r % 512, kb = q / 32, nb = q % 32;
            xpose_item(Ip->w_out + (size_t)l * D * D, D, 32 * nb, 32, 64 * kb, WO + (size_t)l * D * D, D, 32 * nb, scr, lane_); continue; } r -= I_B;
        if (r < I_C) { const int l = r / (16 * 176), q = r % (16 * 176), kb = q / 176, nb = q % 176, r0 = 32 * nb, pn = r0 >> 8, w0 = r0 & 255;
            const float* src = ((w0 < 128) ? Ip->ffn_gate : Ip->ffn_up) + (size_t)l * D * DFF;
            xpose_item(src, DFF, 128 * pn + (w0 & 127), 32, 64 * kb, WGU + (size_t)l * 2 * DFF * D, D, r0, scr, lane_, Ip->norm_ffn + l * D); continue; } r -= I_C;
        if (r < I_D) { const int l = r / (44 * 32), q = r % (44 * 32), kb = q / 32, nb = q % 32;
            xpose_item(Ip->ffn_down + (size_t)l * DFF * D, D, 32 * nb, 32, 64 * kb, WD + (size_t)l * D * DFF, DFF, 32 * nb, scr, lane_); continue; } r -= I_D;
        if (r < I_E) { const int kb = r / 24, nb = r % 24, r0 = 32 * nb; int nv = DSA_IN - r0; nv = nv > 32 ? 32 : (nv < 0 ? 0 : nv);
            xpose_item(Ip->dsa_w_in, DSA_IN, r0, nv, 64 * kb, WIN1, D, r0, scr, lane_, Ip->norm_mix + D); continue; } r -= I_E;
        if (r < I_F) { const int kb = r / 16, nb = r % 16; xpose_item(Ip->w_q_idx, 512, 32 * nb, 32, 64 * kb, WQ2, 256, 1536 + 32 * nb, scr, lane_); continue; } r -= I_F;
        { const int kb = r / 8, nb = r % 8, r0 = 32 * nb;
            xpose_item(Ip->nsa_w_in, NSA_IN, (r0 < 128) ? 1152 + r0 : 1408 + (r0 - 128), 32, 64 * kb, (bf16*)(ws + WS_WVT), D, r0, scr, lane_); }
    }
    for (int idx = (F.vcu * NWAVES * 64) + tid_; idx < 384 * 256; idx += F.G * NWAVES * 64) {
        const int c = idx & 255, r4 = (idx >> 8) & 31, h = idx >> 13; const float4* a4 = (const float4*)(Ip->w_q_up + (size_t)c * 768 + h * 64); const float4* b4 = (const float4*)(Ip->w_uk + (size_t)(4 * r4) * 768 + h * 64);
        float s0 = 0.f, s1 = 0.f, s2 = 0.f, s3 = 0.f;
#pragma unroll 4
        for (int d = 0; d < 16; ++d) { const float4 av = a4[d], b0 = b4[d], b1 = b4[192 + d], b2 = b4[384 + d], b3 = b4[576 + d];
            s0 += (av.x * b0.x + av.y * b0.y) + (av.z * b0.z + av.w * b0.w); s1 += (av.x * b1.x + av.y * b1.y) + (av.z * b1.z + av.w * b1.w);
            s2 += (av.x * b2.x + av.y * b2.y) + (av.z * b2.z + av.w * b2.w); s3 += (av.x * b3.x + av.y * b3.y) + (av.z * b3.z + av.w * b3.w); }
        const float sc_ = 0.125f * 1.4426950408889634f;
        bf16* o_ = WQ2 + (size_t)(h * 128 + 4 * r4) * 256 + c;
        o_[0] = (bf16)f2bf(s0 * sc_); o_[256] = (bf16)f2bf(s1 * sc_); o_[512] = (bf16)f2bf(s2 * sc_); o_[768] = (bf16)f2bf(s3 * sc_);
    }
    { bf16* WO1F = (bf16*)(ws + WS_WO1F); const float* wo1 = Ip->w_out + (size_t)D * D;
      for (int idx = (F.vcu * NWAVES * 64) + tid_; idx < 12 * 32 * 256; idx += F.G * NWAVES * 64) {
          const int n4 = idx & 255, r4 = (idx >> 8) & 31, h = idx >> 13; const float* a = Ip->w_uv + (size_t)(4 * r4) * 768 + h * 64; const float* bcol = wo1 + (size_t)(h * 64) * D + 4 * n4;
          float acc_[4][4];
#pragma unroll
          for (int i = 0; i < 4; ++i)
#pragma unroll
              for (int j = 0; j < 4; ++j) acc_[i][j] = 0.f;
#pragma unroll 4
          for (int d = 0; d < 64; ++d) { const float4 bv = *(const float4*)(bcol + (size_t)d * D); const float a0 = a[d], a1 = a[768 + d], a2 = a[1536 + d], a3 = a[2304 + d];
              acc_[0][0] += a0 * bv.x; acc_[0][1] += a0 * bv.y; acc_[0][2] += a0 * bv.z; acc_[0][3] += a0 * bv.w; acc_[1][0] += a1 * bv.x; acc_[1][1] += a1 * bv.y; acc_[1][2] += a1 * bv.z; acc_[1][3] += a1 * bv.w;
              acc_[2][0] += a2 * bv.x; acc_[2][1] += a2 * bv.y; acc_[2][2] += a2 * bv.z; acc_[2][3] += a2 * bv.w; acc_[3][0] += a3 * bv.x; acc_[3][1] += a3 * bv.y; acc_[3][2] += a3 * bv.z; acc_[3][3] += a3 * bv.w; }
#pragma unroll
          for (int j = 0; j < 4; ++j) *(uint2*)(WO1F + (size_t)(4 * n4 + j) * 1792 + h * 128 + 4 * r4) = make_uint2(pk2(acc_[0][j], acc_[1][j]), pk2(acc_[2][j], acc_[3][j])); }
      for (int it = gw; it < 4 * 32; it += NGW) { const int kb = it / 32, nb = it % 32;
          xpose_item(wo1 + (size_t)768 * D, D, 32 * nb, 32, 64 * kb, WO1F + 1536, 1792, 32 * nb, scr, lane_); } }
    { bf16* W1T = (bf16*)(ws + WS_W1T); bf16* W2T = (bf16*)(ws + WS_W2T); bf16* WMKT = (bf16*)(ws + WS_WMKT); float* B1F = (float*)(ws + WS_B1F); bf16* MEMN = (bf16*)(ws + WS_MEMN);
      constexpr int J_1 = 2 * 32 * 8, J_2 = 2 * 4 * 2, J_M = 2 * 16 * 16;
      for (int it = gw; it < J_1 + J_2 + J_M; it += NGW) { int r2 = it;
          if (r2 < J_1) { const int kv = r2 / 256, q = r2 % 256, kb = q / 8, nb = q % 8; xpose_item(kv ? Ip->v_w1 : Ip->k_w1, 256, 32 * nb, 32, 64 * kb, W1T + (size_t)kv * 256 * 2048, 2048, 32 * nb, scr, lane_); continue; } r2 -= J_1;
          if (r2 < J_2) { const int kv = r2 / 8, q = r2 % 8, kb = q / 2, nb = q % 2; xpose_item(kv ? Ip->v_w2 : Ip->k_w2, 64, 32 * nb, 32, 64 * kb, W2T + (size_t)kv * 64 * 256, 256, 32 * nb, scr, lane_); continue; } r2 -= J_2;
          { const int l = r2 / 256, q = r2 % 256, kb = q / 16, nb = q % 16; xpose_item(Ip->w_mem_kv + (size_t)l * D * 512, 512, 32 * nb, 32, 64 * kb, WMKT + (size_t)l * 512 * D, D, 32 * nb, scr, lane_); } }
      if ((int)blockIdx.x < 32) { const int u_ = (int)blockIdx.x, kv = u_ >> 4, cr = (u_ >> 2) & 3, kq4 = u_ & 3, c = 64 * cr + lane_; const float* w1 = kv ? Ip->v_w1 : Ip->k_w1; const float* pos = kv ? Ip->pos_v : Ip->pos_k;
          const int kb0 = 512 * kq4 + 64 * wave_; float sacc = 0.f;
#pragma unroll 8
          for (int k = 0; k < 64; ++k) sacc += pos[kb0 + k] * w1[(size_t)(kb0 + k) * 256 + c];
          LAS float* red = (LAS float*)(F.lds + RING_OFF + 8 * 16384);
          red[wave_ * 64 + lane_] = sacc;
          __syncthreads();
          if (wave_ == 0) { float t_ = 0.f;
#pragma unroll
              for (int w = 0; w < 8; ++w) t_ += red[w * 64 + lane_];
              B1F[(kv * 4 + kq4) * 256 + c] = t_; } }
      for (int m = gw; m < 1024; m += NGW) rms_row_to_bf16(Ip->mem + (size_t)(m & 511) * D, Ip->norm_mem + (m >> 9) * D, MEMN + (size_t)m * D, lane_); }
    norm_phase(F, Ip->x, Ip->norm_mix, (bf16*)(ws + WS_XN));
}

#define MFMA16(A, B, C) __builtin_amdgcn_mfma_f32_16x16x32_bf16((A), (B), (C), 0, 0, 0)
constexpr float LOG2E = 1.4426950408889634f;
constexpr int NSA_OUT = 0, NSA_PSQ = 98304, NSA_ST = 147456, NSA_TB = NSA_ST + 3072;
constexpr int TAB_B12 = NSA_ST + 1024;
constexpr int P13_B12 = 139264;
constexpr int TAB_BKT = NSA_ST + 3072;
static_assert(NSA_TB + 12288 <= LDSCTL_OFF && TAB_B12 + 2048 <= NSA_TB, "LDS tables");
enum { MD_CMP = 0, MD_WIN = 1, MD_BLK = 2, MD_MEM = 3 };
struct KF { bf16x8 a0, a1, b0, b1; };
struct VF { bf16x8 v[4]; };
__device__ __forceinline__ bf16x8 ldg16(const bf16* p) { return *(const bf16x8*)p; }
typedef float f32x2_t __attribute__((ext_vector_type(2))); typedef __bf16 bf16x2_t __attribute__((ext_vector_type(2)));
__device__ __forceinline__ unsigned cvtpk_s(float lo, float hi) { f32x2_t v = {lo, hi}; bf16x2_t b = __builtin_convertvector(v, bf16x2_t); return __builtin_bit_cast(unsigned, b); }
__device__ __forceinline__ bf16x8 pack8(const f32x4& a, const f32x4& b) { v4u w; w.x = cvtpk_s(a[0], a[1]); w.y = cvtpk_s(a[2], a[3]); w.z = cvtpk_s(b[0], b[1]); w.w = cvtpk_s(b[2], b[3]); return __builtin_bit_cast(bf16x8, w); }
__device__ __forceinline__ void load_k(KF& k, const bf16* kb, int kstride, int key0, int r, int kq) {
    const bf16* pa = kb + (size_t)(key0 + 8 * (r >> 2) + (r & 3)) * kstride + 8 * kq; const bf16* pb = pa + 4 * (size_t)kstride;
    k.a0 = ldg16(pa); k.a1 = ldg16(pa + 32); k.b0 = ldg16(pb); k.b1 = ldg16(pb + 32);
}
__device__ __forceinline__ void load_vt(VF& v, const bf16* vt, int vstride, int key0, int r, int kq) {
#pragma unroll
    for (int dt = 0; dt < 4; ++dt) v.v[dt] = ldg16(vt + (size_t)(16 * dt + r) * vstride + key0 + 8 * kq);
}
__device__ __forceinline__ void qk(f32x4& sa, f32x4& sb, const KF& k, const bf16x8 (&q)[2]) {
    const f32x4 z = {0.f, 0.f, 0.f, 0.f};
    sa = MFMA16(k.a0, q[0], z); sa = MFMA16(k.a1, q[1], sa); sb = MFMA16(k.b0, q[0], z); sb = MFMA16(k.b1, q[1], sb);
}
struct BiasCtx { const LAS unsigned short* tb; float d29, d30, c31; };
template <int MODE>
__device__ __forceinline__ void maskbias(f32x4& s, int kpos, int tcol, bool colok, const BiasCtx& B) {
    if (MODE == MD_MEM) return;
#pragma unroll
    for (int i = 0; i < 4; ++i) {
        int dist; bool ok;
        if (MODE == MD_CMP) { dist = tcol - 31 - 16 * (kpos + i); ok = dist >= 0; }
        else if (MODE == MD_WIN) { dist = tcol - (kpos + i); ok = (unsigned)dist <= 511u; }
        else { dist = tcol - (kpos + i); ok = dist >= 0; }
        int dc = dist < 0 ? 0 : dist; dc = dc > 1023 ? 1023 : dc;
        const float tb = __uint_as_float((unsigned)B.tb[dc * 6] << 16);
        const float far = B.c31 + (dist < 1513 ? B.d30 : 0.f) + (dist < 1117 ? B.d29 : 0.f);
        const float bias = dist < 1024 ? tb : far;
        s[i] = (ok && colok) ? s[i] + bias : -INFINITY;
    }
}
__device__ __forceinline__ float colmax(const f32x4& sa, const f32x4& sb) {
    float mx = fmaxf(fmaxf(fmaxf(sa[0], sa[1]), fmaxf(sa[2], sa[3])), fmaxf(fmaxf(sb[0], sb[1]), fmaxf(sb[2], sb[3])));
    mx = fmaxf(mx, __shfl_xor(mx, 16)); mx = fmaxf(mx, __shfl_xor(mx, 32)); return mx;
}
constexpr float SM_THR = 8.f;
__device__ __forceinline__ float lmax8(const f32x4& sa, const f32x4& sb) { return fmaxf(fmaxf(fmaxf(sa[0], sa[1]), fmaxf(sa[2], sa[3])), fmaxf(fmaxf(sb[0], sb[1]), fmaxf(sb[2], sb[3]))); }
__device__ __forceinline__ int imax3(int a, int b, int c) { return max(max(a, b), c); }
__device__ __forceinline__ int imax16(const f32x4& a, const f32x4& b, const f32x4& c, const f32x4& d) {
#define FI_(x) __float_as_int(x)
    const int t0 = imax3(FI_(a[0]), FI_(a[1]), FI_(a[2])), t1 = imax3(FI_(a[3]), FI_(b[0]), FI_(b[1])), t2 = imax3(FI_(b[2]), FI_(b[3]), FI_(c[0])), t3 = imax3(FI_(c[1]), FI_(c[2]), FI_(c[3])), t4 = imax3(FI_(d[0]), FI_(d[1]), FI_(d[2]));
    return max(imax3(t0, t1, FI_(d[3])), imax3(t2, t3, t4));
#undef FI_
}
template <int NO>
__device__ __forceinline__ void sm_rescale(float lm, float& m, float& l, f32x4 (&O)[NO]) {
    if (__any(lm > m + SM_THR)) {
        lm = fmaxf(lm, __shfl_xor(lm, 16)); lm = fmaxf(lm, __shfl_xor(lm, 32));
        const float mn = fmaxf(m, lm); const float al = __builtin_amdgcn_exp2f(m - mn); m = mn; l *= al;
#pragma unroll
        for (int dt = 0; dt < NO; ++dt) O[dt] = O[dt] * al;
    }
}
__device__ __forceinline__ bf16x8 sm_update(const f32x4& sa, const f32x4& sb, float& m, float& l, f32x4 (&O)[4]) {
    sm_rescale<4>(lmax8(sa, sb), m, l, O);
    f32x4 pa, pb; float sum = 0.f;
#pragma unroll
    for (int i = 0; i < 4; ++i) { pa[i] = __builtin_amdgcn_exp2f(sa[i] - m); pb[i] = __builtin_amdgcn_exp2f(sb[i] - m); sum += pa[i] + pb[i]; }
    l += sum;
    return pack8(pa, pb);
}
__device__ __forceinline__ void sm_update64(const f32x4& sa0, const f32x4& sb0, const f32x4& sa1, const f32x4& sb1, float& m, float& l, f32x4 (&O)[4], bf16x8& pf0, bf16x8& pf1) {
    sm_rescale<4>(fmaxf(lmax8(sa0, sb0), lmax8(sa1, sb1)), m, l, O);
    f32x4 pa0, pb0, pa1, pb1; float sum = 0.f;
#pragma unroll
    for (int i = 0; i < 4; ++i) { pa0[i] = __builtin_amdgcn_exp2f(sa0[i] - m); pb0[i] = __builtin_amdgcn_exp2f(sb0[i] - m); pa1[i] = __builtin_amdgcn_exp2f(sa1[i] - m); pb1[i] = __builtin_amdgcn_exp2f(sb1[i] - m);
        sum += (pa0[i] + pb0[i]) + (pa1[i] + pb1[i]); }
    l += sum;
    pf0 = pack8(pa0, pb0); pf1 = pack8(pa1, pb1);
}
enum { BK_FAR = 0, BK_MID = 1, BK_GEN = 2 };
template <int MD, int CLS>
__device__ __forceinline__ void step64(const KF& k0, const KF& k1, const bf16x8 (&q)[2], int cls, int kpos, int tcol, bool colok, const BiasCtx& B,
                                       float& m, float& l, f32x4 (&O)[4], bf16x8& pf0, bf16x8& pf1) {
    const bool has = m > -1e29f; const float mref = has ? m : 0.f;
    if (CLS >= 0) cls = CLS;
    float cin = ((cls == BK_FAR) ? B.c31 : 0.f) - mref; if (!colok) cin = -INFINITY;
    const f32x4 c4 = {cin, cin, cin, cin};
    f32x4 sa0 = MFMA16(k0.a0, q[0], c4), sb0 = MFMA16(k0.b0, q[0], c4), sa1 = MFMA16(k1.a0, q[0], c4), sb1 = MFMA16(k1.b0, q[0], c4);
    sa0 = MFMA16(k0.a1, q[1], sa0); sb0 = MFMA16(k0.b1, q[1], sb0); sa1 = MFMA16(k1.a1, q[1], sa1); sb1 = MFMA16(k1.b1, q[1], sb1);
    if (cls == BK_MID) {
        const LAS unsigned short* tl = B.tb + (tcol - kpos - 39) * 6;
#pragma unroll
        for (int i = 0; i < 4; ++i) { sa0[i] += __uint_as_float((unsigned)tl[6 * (39 - i)] << 16); sb0[i] += __uint_as_float((unsigned)tl[6 * (35 - i)] << 16);
            sa1[i] += __uint_as_float((unsigned)tl[6 * (7 - i)] << 16); sb1[i] += __uint_as_float((unsigned)tl[6 * (3 - i)] << 16); }
    } else if (cls == BK_GEN) {
        maskbias<MD>(sa0, kpos, tcol, true, B); maskbias<MD>(sb0, kpos + 4, tcol, true, B); maskbias<MD>(sa1, kpos + 32, tcol, true, B); maskbias<MD>(sb1, kpos + 36, tcol, true, B);
    }
    if (__any((imax16(sa0, sb0, sa1, sb1) > __float_as_int(SM_THR)) || !has)) {
        float lm = fmaxf(lmax8(sa0, sb0), lmax8(sa1, sb1));
        lm = fmaxf(lm, __shfl_xor(lm, 16)); lm = fmaxf(lm, __shfl_xor(lm, 32));
        const bool upd = (lm > -INFINITY) && (!has || lm > 0.f); const float dl = upd ? lm : 0.f;
        if (upd) m = mref + dl;
        const float f = has ? __builtin_amdgcn_exp2f(-dl) : 1.f; l *= f;
#pragma unroll
        for (int dt = 0; dt < 4; ++dt) O[dt] = O[dt] * f;
#pragma unroll
        for (int i = 0; i < 4; ++i) { sa0[i] -= dl; sb0[i] -= dl; sa1[i] -= dl; sb1[i] -= dl; }
    }
    f32x4 pa0, pb0, pa1, pb1; float sum = 0.f;
#pragma unroll
    for (int i = 0; i < 4; ++i) { pa0[i] = __builtin_amdgcn_exp2f(sa0[i]); pb0[i] = __builtin_amdgcn_exp2f(sb0[i]); pa1[i] = __builtin_amdgcn_exp2f(sa1[i]); pb1[i] = __builtin_amdgcn_exp2f(sb1[i]);
        sum += (pa0[i] + pb0[i]) + (pa1[i] + pb1[i]); }
    l += sum;
    pf0 = pack8(pa0, pb0); pf1 = pack8(pa1, pb1);
}
__device__ __forceinline__ void pv(f32x4 (&O)[4], const VF& v, const bf16x8& pf) {
#pragma unroll
    for (int dt = 0; dt < 4; ++dt) O[dt] = MFMA16(v.v[dt], pf, O[dt]);
}
__device__ __forceinline__ void lds_fadd(LAS float* p, float v) { (void)__hip_atomic_fetch_add((float*)p, v, __ATOMIC_RELAXED, __HIP_MEMORY_SCOPE_WORKGROUP); }
__device__ __forceinline__ float kqsum(float v) { v += __shfl_xor(v, 16); v += __shfl_xor(v, 32); return v; }
__device__ __forceinline__ float wmax64(float v) {
#pragma unroll
    for (int o = 1; o < 64; o <<= 1) v = fmaxf(v, __shfl_xor(v, o));
    return v;
}
__device__ __forceinline__ void out_add(LAS float* OUTw, int p, int n, int kq, const f32x4 (&O)[4], float scale, bool first) {
    const int q = 2 * p + (n >> 3), hd = n & 7;
    if (hd < 6) { LAS f32x4* dst = (LAS f32x4*)(OUTw + (q * 6 + hd) * 64) + kq;
#pragma unroll
        for (int dt = 0; dt < 4; ++dt) { f32x4 v = O[dt] * scale; if (!first) v = v + dst[4 * dt]; dst[4 * dt] = v; } }
}

__device__ __forceinline__ void p2_mfma(Frame& F, const In& I, unsigned char* ws) {
    OPAQUE_TID(); KARGS(); const int lane = tid_ & 63, wave = __builtin_amdgcn_readfirstlane(tid_ >> 6), r = lane & 15, kq = lane >> 4;
    const bf16* KV0 = (const bf16*)(ws + WS_KV0); const bf16* W1T = (const bf16*)(ws + WS_W1T); const bf16* W2T = (const bf16*)(ws + WS_W2T); const float* B1F = (const float*)(ws + WS_B1F);
    const bf16* MEMN = (const bf16*)(ws + WS_MEMN); const bf16* WMKT = (const bf16*)(ws + WS_WMKT);
    bf16* KCB = (bf16*)(ws + WS_KCB); bf16* VCT = (bf16*)(ws + WS_VCT); bf16* MKB = (bf16*)(ws + WS_MKB); bf16* MVT = (bf16*)(ws + WS_MVT);
    LAS unsigned char* hid = F.lds + RING_OFF;
    for (int u = blockIdx.x; u < 192; u += F.G) {
        const bool cmp = u < 128;
        const bf16* ap[2]; const bf16* bp[2]; int K, kjump;
        int kv = 0, bg = 0, n0 = 0, lay = 0, m0 = 0, ch = 0;
        if (cmp) { kv = u >> 6; bg = (u >> 4) & 3; n0 = (u & 15) * 32; const int b = bg >> 1, g = bg & 1; K = 2048; kjump = 512 - 64;
#pragma unroll
            for (int rt = 0; rt < 2; ++rt) { int nn = n0 + 16 * rt + r; nn = nn > 510 ? 510 : nn; ap[rt] = KV0 + (size_t)(b * T + 16 * nn) * 512 + kv * 128 + g * 64 + 8 * kq; }
#pragma unroll
            for (int ct = 0; ct < 2; ++ct) bp[ct] = W1T + (size_t)(kv * 256 + 32 * wave + 16 * ct + r) * 2048 + 8 * kq;
        } else { const int v = u - 128; lay = v >> 5; m0 = ((v >> 1) & 15) * 32; ch = v & 1; K = 1024; kjump = 0;
#pragma unroll
            for (int rt = 0; rt < 2; ++rt) ap[rt] = MEMN + (size_t)(lay * 512 + m0 + 16 * rt + r) * 1024 + 8 * kq;
#pragma unroll
            for (int ct = 0; ct < 2; ++ct) bp[ct] = WMKT + (size_t)(lay * 512 + ch * 256 + 32 * wave + 16 * ct + r) * 1024 + 8 * kq;
        }
        f32x4 acc[2][2];
#pragma unroll
        for (int rt = 0; rt < 2; ++rt)
#pragma unroll
            for (int ct = 0; ct < 2; ++ct) acc[rt][ct] = (f32x4){0.f, 0.f, 0.f, 0.f};
        for (int kb = 0; kb < K; kb += 64) { const int ao = kb + (kb >> 6) * kjump;
            bf16x8 a[2][2], bb[2][2];
#pragma unroll
            for (int h2 = 0; h2 < 2; ++h2) {
#pragma unroll
                for (int rt = 0; rt < 2; ++rt) a[rt][h2] = ldg16(ap[rt] + ao + 32 * h2);
#pragma unroll
                for (int ct = 0; ct < 2; ++ct) bb[ct][h2] = ldg16(bp[ct] + kb + 32 * h2); }
#pragma unroll
            for (int h2 = 0; h2 < 2; ++h2)
#pragma unroll
                for (int rt = 0; rt < 2; ++rt)
#pragma unroll
                    for (int ct = 0; ct < 2; ++ct) acc[rt][ct] = MFMA16(a[rt][h2], bb[ct][h2], acc[rt][ct]);
        }
        if (cmp) {
#pragma unroll
            for (int ct = 0; ct < 2; ++ct) { const int col = 32 * wave + 16 * ct + r; const float bias = (kv ? Ip->v_b1 : Ip->k_b1)[col] + ((B1F[(kv * 4 + 0) * 256 + col] + B1F[(kv * 4 + 1) * 256 + col]) + (B1F[(kv * 4 + 2) * 256 + col] + B1F[(kv * 4 + 3) * 256 + col]));
#pragma unroll
                for (int rt = 0; rt < 2; ++rt)
#pragma unroll
                    for (int i = 0; i < 4; ++i) { const float xg = acc[rt][ct][i] + bias; const float hv = 0.5f * xg * (1.f + tanhf(0.7978845608028654f * (xg + 0.044715f * xg * xg * xg)));
                        *(LAS unsigned short*)(hid + (16 * rt + 4 * kq + i) * 528 + 2 * col) = (unsigned short)f2bf(hv); } }
            __syncthreads();
            { const int rt2 = wave >> 2, ct2 = wave & 3; f32x4 o = {0.f, 0.f, 0.f, 0.f};
              const bf16* w2p = W2T + (size_t)(kv * 64 + 16 * ct2 + r) * 256 + 8 * kq;
#pragma unroll
              for (int ks = 0; ks < 8; ++ks) { const bf16x8 av = *(const LAS bf16x8*)(hid + (16 * rt2 + r) * 528 + 64 * ks + 16 * kq); o = MFMA16(av, ldg16(w2p + 32 * ks), o); }
              const int d = 16 * ct2 + r; const float b2v = (kv ? Ip->v_b2 : Ip->k_b2)[d];
#pragma unroll
              for (int i = 0; i < 4; ++i) { const int nn = n0 + 16 * rt2 + 4 * kq + i; const unsigned short ov = (nn < NCMP) ? (unsigned short)f2bf(o[i] + b2v) : (unsigned short)0;
                  if (kv) VCT[(size_t)(bg * 64 + d) * 512 + nn] = ov; else KCB[(size_t)(bg * 512 + nn) * 64 + d] = ov; } }
            __syncthreads();
        } else {
#pragma unroll
            for (int ct = 0; ct < 2; ++ct) { const int col = 32 * wave + 16 * ct + r;
#pragma unroll
                for (int rt = 0; rt < 2; ++rt)
#pragma unroll
                    for (int i = 0; i < 4; ++i) { const int mrow = m0 + 16 * rt + 4 * kq + i; const unsigned short ov = (unsigned short)f2bf(acc[rt][ct][i]);
                        if (ch == 0) MKB[(size_t)(lay * 512 + mrow) * 256 + col] = ov; else MVT[(size_t)(lay * 256 + col) * 512 + mrow] = ov; } }
        }
    }
}

template <int MODE>
__device__ __forceinline__ void mb2(f32x4& sa, f32x4& sb, int kpos, int tcol, bool colok, bool fast, const BiasCtx& B) {
    if (fast) { if (colok) { sa = sa + B.c31; sb = sb + B.c31; } else { sa = (f32x4){-INFINITY, -INFINITY, -INFINITY, -INFINITY}; sb = sa; } }
    else { maskbias<MODE>(sa, kpos, tcol, colok, B); maskbias<MODE>(sb, kpos + 4, tcol, colok, B); }
}
#define SWZ(row) (((((row) >> 3) & 3) << 1) | (((row) >> 1) & 1))
struct KV1 { KF k; VF v; };
__device__ __forceinline__ void load_kv(KV1& d, const bf16* kb, int kstride, const bf16* vt, int vstride, int key0, int r, int kq) { load_k(d.k, kb, kstride, key0, r, kq); load_vt(d.v, vt, vstride, key0, r, kq); }

template <int MD, bool EMPTY = false>
__device__ __forceinline__ void nsa_sweep(LAS unsigned char* STG, const bf16* ksb, const bf16* vst, int jlo, int jhi, int qt, const LAS unsigned* WMw, int wave, int lane, int r, int kq, int qsel, int t0w,
                                          const bf16x8 (&qf)[4][2], const BiasCtx& BC, float (&m)[4], float (&l)[4], f32x4 (&O)[4][4]) {
            const int srow = 8 * wave + (lane >> 3), sch = (lane & 7) ^ SWZ(srow);
            const bf16* ksrc = ksb + (size_t)srow * 512 + 8 * sch; const bf16* vsrc = vst + (size_t)srow * 64 + 8 * sch;
#define NSA_DMA(jb) do { LAS unsigned char* d_ = STG + ((jb) % 3) * 16384 + wave * 1024; \
                __builtin_amdgcn_global_load_lds((const unsigned*)(ksrc + (size_t)(jb) * 64 * 512), (LAS unsigned*)d_, 16, 0, 0); \
                __builtin_amdgcn_global_load_lds((const unsigned*)(vsrc + (size_t)(jb) * 16384), (LAS unsigned*)(d_ + 8192), 16, 0, 0); } while (0)
            NSA_DMA(jlo); if (jhi > jlo) NSA_DMA(jlo + 1);
            if (jhi > jlo) asm volatile("s_waitcnt vmcnt(2)" ::: "memory"); else asm volatile("s_waitcnt vmcnt(0)" ::: "memory");
            __builtin_amdgcn_s_barrier();
#define NSA_TILES(CLS_) _Pragma("unroll") for (int p = 0; p < 4; ++p) if (m8 & (3u << (2 * p))) { \
                        bf16x8 pf0, pf1; \
                        step64<MD, CLS_>(k0, k1, qf[p], cls, 64 * j + 8 * kq_, t0w + 2 * p + qs_, ((m8 >> (2 * p + qs_)) & 1u) != 0u, BC, m[p], l[p], O[p], pf0, pf1); \
                        pv(O[p], v0, pf0); pv(O[p], v1, pf1); \
                        __builtin_amdgcn_sched_barrier(0); }
            auto body = [&](auto clsx, int j) __attribute__((always_inline)) { constexpr int CLSX = decltype(clsx)::value;
                const LAS unsigned char* sk = STG + (j % 3) * 16384; const LAS unsigned char* sv = sk + 8192;
                const bool more = (j + 2) <= jhi;
                if (more) NSA_DMA(j + 2);
                unsigned m8 = 0xffu; if (WMw) m8 = (unsigned)__builtin_amdgcn_readfirstlane((int)((WMw[j >> 2] >> (8 * (j & 3))) & 0xffu)); if (EMPTY) m8 = 0u; asm volatile("" : "+s"(m8));
                if (m8) {
                    int r_ = r, kq_ = kq, qs_ = qsel; asm volatile("" : "+v"(r_), "+v"(kq_), "+v"(qs_));
                    const int dj = qt - j; const int cls = (MD == MD_WIN) ? ((dj >= 1 && dj <= 6) ? BK_MID : BK_GEN) : ((64 * dj - 63 >= 1513) ? BK_FAR : ((dj >= 1 && dj <= 15) ? BK_MID : BK_GEN));
                    KF k0, k1;
                    { const int ka = 8 * (r_ >> 2) + (r_ & 3), kb2 = ka + 4, kc = ka + 32, kd = ka + 36;
                      k0.a0 = *(const LAS bf16x8*)(sk + ka * 128 + ((kq_ ^ SWZ(ka)) << 4)); k0.a1 = *(const LAS bf16x8*)(sk + ka * 128 + (((4 + kq_) ^ SWZ(ka)) << 4));
                      k0.b0 = *(const LAS bf16x8*)(sk + kb2 * 128 + ((kq_ ^ SWZ(kb2)) << 4)); k0.b1 = *(const LAS bf16x8*)(sk + kb2 * 128 + (((4 + kq_) ^ SWZ(kb2)) << 4));
                      k1.a0 = *(const LAS bf16x8*)(sk + kc * 128 + ((kq_ ^ SWZ(kc)) << 4)); k1.a1 = *(const LAS bf16x8*)(sk + kc * 128 + (((4 + kq_) ^ SWZ(kc)) << 4));
                      k1.b0 = *(const LAS bf16x8*)(sk + kd * 128 + ((kq_ ^ SWZ(kd)) << 4)); k1.b1 = *(const LAS bf16x8*)(sk + kd * 128 + (((4 + kq_) ^ SWZ(kd)) << 4)); }
                    VF v0, v1;
#pragma unroll
                    for (int dt = 0; dt < 4; ++dt) { const int dd = 16 * dt + r_; v0.v[dt] = *(const LAS bf16x8*)(sv + dd * 128 + ((kq_ ^ SWZ(dd)) << 4)); v1.v[dt] = *(const LAS bf16x8*)(sv + dd * 128 + (((4 + kq_) ^ SWZ(dd)) << 4)); }
                    NSA_TILES(CLSX)
                }
                if (more) asm volatile("s_waitcnt vmcnt(2) lgkmcnt(0)" ::: "memory"); else asm volatile("s_waitcnt vmcnt(0) lgkmcnt(0)" ::: "memory");
                __builtin_amdgcn_s_barrier();

            };
            int j = jlo;
            if (MD == MD_BLK) { const int jfar = (qt - 25 < jhi) ? qt - 25 : jhi; for (; j <= jfar; ++j) body(std::integral_constant<int, BK_FAR>{}, j); }
            for (; j <= jhi; ++j) body(std::integral_constant<int, -1>{}, j);
#undef NSA_TILES
#undef NSA_DMA
}
__device__ __forceinline__ void p3_nsa_mfma(Frame& F, const In& I, unsigned char* ws) {
    OPAQUE_TID(); KARGS(); const int wave = __builtin_amdgcn_readfirstlane(tid_ >> 6);
    LAS float* b12 = (LAS float*)(F.lds + TAB_B12);
    LAS float* OUTf = (LAS float*)(F.lds + NSA_OUT); LAS float* OUTw = OUTf + wave * 3072;
    LAS float* PSw = (LAS float*)(F.lds + NSA_PSQ) + wave * 1024;
    LAS unsigned char* STG = F.lds + NSA_PSQ;
    LAS unsigned* WMw = (LAS unsigned*)(F.lds + NSA_ST) + wave * 32;
    for (int i = tid_; i < 512; i += NWAVES * 64) b12[i] = ((i & 15) < 12) ? Ip->rel_bias[(i >> 4) * 12 + (i & 15)] * LOG2E : 0.f;
    LAS unsigned short* TB = (LAS unsigned short*)(F.lds + NSA_TB);
    { const int gg = (int)blockIdx.x & 1;
      for (int i = tid_; i < 6144; i += NWAVES * 64) { const int dd = i / 6, hh = i % 6; TB[i] = (unsigned short)f2bf(Ip->rel_bias[rel_bucket(dd) * 12 + gg * 6 + hh] * LOG2E); } }
    __syncthreads();
    const bf16* Q0 = (const bf16*)(ws + WS_Q0); const bf16* KV0 = (const bf16*)(ws + WS_KV0); const bf16* QM = (const bf16*)(ws + WS_QM); const bf16* G0 = (const bf16*)(ws + WS_G0);
    const bf16* VT = (const bf16*)(ws + WS_VT); const bf16* KCB = (const bf16*)(ws + WS_KCB); const bf16* VCT = (const bf16*)(ws + WS_VCT);
    const bf16* MKB = (const bf16*)(ws + WS_MKB); const bf16* MVT = (const bf16*)(ws + WS_MVT);
    bf16* CAT = (bf16*)(ws + WS_CAT);
    const int nun = 4 * 128;
    for (int ui = blockIdx.x; ui < nun; ui += F.G) {
        int tl_ = tid_; asm volatile("" : "+v"(tl_));
        const int lane = tl_ & 63, n = lane & 15, kq = lane >> 4, r = n, hd = n & 7, qsel = n >> 3; const bool colv = hd < 6;
        int bg, qt;
        bg = blockIdx.x & 3;
        if (F.G == 256) { const int idx = blockIdx.x >> 2; qt = (ui < 256) ? idx : 127 - idx; }
        else { qt = ui >> 2; if ((ui & 3) != bg) continue; }
        const int b = bg >> 1, g = bg & 1, t0w = 64 * qt + 8 * wave, rowb = b * T;
        const int habs = g * 6 + (colv ? hd : 0);
        const LAS float* b12c = b12 + habs; const BiasCtx BC{TB + (colv ? hd : 0), b12c[29 * 16] - b12c[30 * 16], b12c[30 * 16] - b12c[31 * 16], b12c[31 * 16]};

        bf16x8 qf[4][2];
#pragma unroll
        for (int p = 0; p < 4; ++p) { const bf16* qp = Q0 + (size_t)(rowb + t0w + 2 * p + qsel) * 768 + habs * 64 + 8 * kq;
#pragma unroll
            for (int ks = 0; ks < 2; ++ks) { bf16x8 v = ldg16(qp + 32 * ks); if (!colv) v = (bf16x8){0, 0, 0, 0, 0, 0, 0, 0}; qf[p][ks] = v; } }
        for (int i = lane; i < 1024; i += 64) PSw[i] = 0.f;
        float m[4], l[4]; f32x4 O[4][4];
        const int ncmax = (t0w + 7 >= 31) ? ((t0w + 7 - 31) / 16 + 1) : 0;
        const bf16* kcb = KCB + (size_t)(bg * 512) * 64; const bf16* vct = VCT + (size_t)(bg * 64) * 512;
#pragma unroll
        for (int p = 0; p < 4; ++p) { m[p] = -1e30f; l[p] = 0.f; }
        if (ncmax > 0) {
            int r_ = r, kq_ = kq; asm volatile("" : "+v"(r_), "+v"(kq_));
            for (int key0 = 0; key0 < ncmax; key0 += 32) {
                asm volatile("" : "+v"(r_), "+v"(kq_));
                KF kA; load_k(kA, kcb, 64, key0, r_, kq_);
                const bool fast = (t0w - 31 - 16 * (key0 + 31)) >= 1513;
#pragma unroll
                for (int p = 0; p < 4; ++p) { f32x4 sa, sb; qk(sa, sb, kA, qf[p]); const int tcol = t0w + 2 * p + qsel;
                    mb2<MD_CMP>(sa, sb, key0 + 8 * kq_, tcol, true, fast, BC);
                    const float mn = fmaxf(m[p], colmax(sa, sb)); float sum = 0.f;
#pragma unroll
                    for (int i = 0; i < 4; ++i) sum += __builtin_amdgcn_exp2f(sa[i] - mn) + __builtin_amdgcn_exp2f(sb[i] - mn);
                    l[p] = l[p] * __builtin_amdgcn_exp2f(m[p] - mn) + sum; m[p] = mn; __builtin_amdgcn_sched_barrier(0); }
            }
        }
        float invl[4];
#pragma unroll
        for (int p = 0; p < 4; ++p) { const float lt = kqsum(l[p]); invl[p] = lt > 0.f ? 1.f / lt : 0.f; }
#pragma unroll
        for (int p = 0; p < 4; ++p)
#pragma unroll
            for (int dt = 0; dt < 4; ++dt) O[p][dt] = (f32x4){0.f, 0.f, 0.f, 0.f};
        float carry[4] = {0.f, 0.f, 0.f, 0.f};
        if (ncmax > 0) {
            int r_ = r, kq_ = kq; asm volatile("" : "+v"(r_), "+v"(kq_));
            for (int key0 = 0; key0 < ncmax; key0 += 32) {
                asm volatile("" : "+v"(r_), "+v"(kq_));
                KV1 A; load_kv(A, kcb, 64, vct, 512, key0, r_, kq_);
                const bool fast = (t0w - 31 - 16 * (key0 + 31)) >= 1513;
#pragma unroll
                for (int p = 0; p < 4; ++p) { f32x4 sa, sb; qk(sa, sb, A.k, qf[p]); const int tcol = t0w + 2 * p + qsel;
                    mb2<MD_CMP>(sa, sb, key0 + 8 * kq_, tcol, true, fast, BC);
                    f32x4 pa, pb;
#pragma unroll
                    for (int i = 0; i < 4; ++i) { pa[i] = __builtin_amdgcn_exp2f(sa[i] - m[p]) * invl[p]; pb[i] = __builtin_amdgcn_exp2f(sb[i] - m[p]) * invl[p]; }
                    pv(O[p], A.v, pack8(pa, pb));
                    float wA = (pa[0] + pa[1]) + (pa[2] + pa[3]), wB = pa[3] + ((pb[0] + pb[1]) + (pb[2] + pb[3])), wC = pb[3];
                    if (!colv) { wA = 0.f; wB = 0.f; wC = 0.f; }
                    const float up = __shfl(wC, (lane + 48) & 63);
                    const float prevC = (kq == 0) ? carry[p] : up; carry[p] = up;
                    float a0 = wA + prevC, a1 = wB;
                    a0 += __shfl_xor(a0, 1); a1 += __shfl_xor(a1, 1); a0 += __shfl_xor(a0, 2); a1 += __shfl_xor(a1, 2); a0 += __shfl_xor(a0, 4); a1 += __shfl_xor(a1, 4);
                    if (hd == 0) { LAS float* ps = PSw + (2 * p + qsel) * 128 + (key0 >> 2) + 2 * kq; ps[0] = a0; ps[1] = a1; } __builtin_amdgcn_sched_barrier(0); }
            }
        }
        if (ncmax > 0 && ncmax <= 480) {
            const int jn = ((ncmax + 31) >> 5) * 8;
#pragma unroll
            for (int p = 0; p < 4; ++p) { float a0 = carry[p]; a0 += __shfl_xor(a0, 1); a0 += __shfl_xor(a0, 2); a0 += __shfl_xor(a0, 4); if (hd == 0 && kq == 0) PSw[(2 * p + qsel) * 128 + jn] = a0; }
        }
        {
#pragma unroll
            for (int p = 0; p < 4; ++p) { const size_t row = (size_t)(rowb + t0w + 2 * p + qsel);
                const float gz = bf2f(G0[row * 256 + habs * 3 + 0]) + Ip->nsa_gate_b[habs * 3 + 0]; out_add(OUTw, p, n, kq, O[p], 1.f / (1.f + __expf(-gz)), true); }
        }
        for (int i = lane; i < 32; i += 64) WMw[i] = (qt < 16) ? 0xffffffffu : 0u;
        if (qt >= 16) {
            if (lane < 3) { const int j = lane == 0 ? 0 : qt - 2 + lane; atomicOr((unsigned*)&WMw[j >> 2], 0xffu << (8 * (j & 3))); }
            for (int q = 0; q < 8; ++q) {
                float v0 = PSw[q * 128 + lane], v1 = PSw[q * 128 + 64 + lane];
                if (lane < 1 || lane > qt - 2) v0 = -1.f; if (lane + 64 > qt - 2) v1 = -1.f;
                for (int s = 0; s < 13; ++s) { const float mx = wmax64(fmaxf(v0, v1));
                    const unsigned long long b0 = __ballot(v0 == mx); int j;
                    if (b0) { j = __builtin_ctzll(b0); if (lane == j) v0 = -1.f; } else { const unsigned long long b1 = __ballot(v1 == mx); j = __builtin_ctzll(b1); if (lane == j) v1 = -1.f; j += 64; }
                    if (lane == 0) atomicOr((unsigned*)&WMw[j >> 2], 1u << (8 * (j & 3) + q)); }
            }
        }
        const bf16* ksb = KV0 + (size_t)rowb * 512 + 256 + g * 64; const bf16* vst = VT + ((size_t)(rowb >> 6) * 256 + g * 64) * 64;
        __syncthreads();
        if (PROBE_REP == 5) { nsa_sweep<MD_BLK, true>(STG, ksb, vst, 0, qt, qt, WMw, wave, lane, r, kq, qsel, t0w, qf, BC, m, l, O); __syncthreads(); }
#pragma unroll 1
        for (int rep_ = 0; rep_ < (PROBE_REP == 1 ? 2 : 1); ++rep_) {
#pragma unroll
            for (int p = 0; p < 4; ++p) { m[p] = -1e30f; l[p] = 0.f;
#pragma unroll
                for (int dt = 0; dt < 4; ++dt) O[p][dt] = (f32x4){0.f, 0.f, 0.f, 0.f}; }
            nsa_sweep<MD_BLK>(STG, ksb, vst, 0, qt, qt, WMw, wave, lane, r, kq, qsel, t0w, qf, BC, m, l, O);
        }
        { int qs2_ = qsel; asm volatile("" : "+v"(qs2_));
#pragma unroll
        for (int p = 0; p < 4; ++p) { const size_t row = (size_t)(rowb + t0w + 2 * p + qs2_);
            const float gz = bf2f(G0[row * 256 + habs * 3 + 1]) + Ip->nsa_gate_b[habs * 3 + 1]; out_add(OUTw, p, n, kq, O[p], (1.f / (1.f + __expf(-gz))) / kqsum(l[p]), false); } }
        const bf16* kwb = KV0 + (size_t)rowb * 512 + 384 + g * 64; const bf16* vwt = VT + ((size_t)(rowb >> 6) * 256 + 128 + g * 64) * 64;
#pragma unroll
        for (int p = 0; p < 4; ++p) { m[p] = -1e30f; l[p] = 0.f;
#pragma unroll
            for (int dt = 0; dt < 4; ++dt) O[p][dt] = (f32x4){0.f, 0.f, 0.f, 0.f}; }
        __syncthreads();
        nsa_sweep<MD_WIN>(STG, kwb, vwt, (qt >= 8) ? qt - 8 : 0, qt, qt, nullptr, wave, lane, r, kq, qsel, t0w, qf, BC, m, l, O);
        if (PROBE_REP == 4) {
#pragma unroll
            for (int p = 0; p < 4; ++p) { m[p] = -1e30f; l[p] = 0.f;
#pragma unroll
                for (int dt = 0; dt < 4; ++dt) O[p][dt] = (f32x4){0.f, 0.f, 0.f, 0.f}; }
            nsa_sweep<MD_WIN>(STG, kwb, vwt, (qt >= 8) ? qt - 8 : 0, qt, qt, nullptr, wave, lane, r, kq, qsel, t0w, qf, BC, m, l, O); }
        { int qs3_ = qsel; asm volatile("" : "+v"(qs3_));
#pragma unroll
        for (int p = 0; p < 4; ++p) { const size_t row = (size_t)(rowb + t0w + 2 * p + qs3_);
            const float gz = bf2f(G0[row * 256 + habs * 3 + 2]) + Ip->nsa_gate_b[habs * 3 + 2]; out_add(OUTw, p, n, kq, O[p], (1.f / (1.f + __expf(-gz))) / kqsum(l[p]), false); } }
        int ln_ = lane; asm volatile("" : "+v"(ln_));
#pragma unroll 1
        for (int i = 0; i < 12; ++i) { const int e = i * 64 + ln_, q = e / 96, c4 = e % 96; const f32x4 v = ((const LAS f32x4*)OUTw)[e];
            *(uint2*)(CAT + (size_t)(rowb + t0w + q) * 1024 + g * 384 + 4 * c4) = make_uint2(pk2(v[0], v[1]), pk2(v[2], v[3])); }
#pragma unroll 1
        for (int h2 = 0; h2 < 2; ++h2) { const int hm = 2 * g + h2;
            bf16x8 qm[2]; { const bf16* qp = QM + (size_t)(rowb + t0w + (n & 7)) * 256 + hm * 64 + 8 * kq; qm[0] = ldg16(qp); qm[1] = ldg16(qp + 32); if (n >= 8) { qm[0] = (bf16x8){0, 0, 0, 0, 0, 0, 0, 0}; qm[1] = qm[0]; } }
            float mm = -1e30f, ll = 0.f; f32x4 Om[4];
#pragma unroll
            for (int dt = 0; dt < 4; ++dt) Om[dt] = (f32x4){0.f, 0.f, 0.f, 0.f};
            const bf16* mk = MKB + (size_t)(b * 256) * 256 + hm * 64; const bf16* mvt = MVT + (size_t)(hm * 64) * 512 + b * 256;
            int r_ = r, kq_ = kq; asm volatile("" : "+v"(r_), "+v"(kq_));
            KV1 A; load_kv(A, mk, 256, mvt, 512, 0, r_, kq_);
            for (int key0 = 0; key0 < 256; key0 += 32) { asm volatile("" : "+v"(r_), "+v"(kq_));
                KV1 B; load_kv(B, mk, 256, mvt, 512, (key0 + 32 < 256) ? key0 + 32 : key0, r_, kq_);
                f32x4 sa, sb; qk(sa, sb, A.k, qm); pv(Om, A.v, sm_update(sa, sb, mm, ll, Om)); A = B; }
            const float il = 1.f / kqsum(ll);
            if (n < 8) { bf16* op = CAT + (size_t)(rowb + t0w + n) * 1024 + 768 + hm * 64 + 4 * kq;
#pragma unroll
                for (int dt = 0; dt < 4; ++dt) *(uint2*)(op + 16 * dt) = make_uint2(pk2(Om[dt][0] * il, Om[dt][1] * il), pk2(Om[dt][2] * il, Om[dt][3] * il)); }
        }
    }
}

__device__ __forceinline__ void p10_dsa_norm(Frame& F, const In& I, unsigned char* ws) {
    OPAQUE_TID(); KARGS(); const int gw = F.vcu * NWAVES + (tid_ >> 6), NGW = F.G * NWAVES, lane = tid_ & 63;
    const bf16* PR = (const bf16*)(ws + WS_PROJ1); bf16* CQ = (bf16*)(ws + WS_CQ); bf16* CKV = (bf16*)(ws + WS_CKV); bf16* KIDX = (bf16*)(ws + WS_KIDX); float* WIDX = (float*)(ws + WS_WIDX);
    for (int m = gw; m < M; m += NGW) {
        const bf16* pr = PR + (size_t)m * 768;
        float a[4]; ld4bf(pr + 4 * lane, a);
        float s = wave_sum(a[0] * a[0] + a[1] * a[1] + a[2] * a[2] + a[3] * a[3]); float r = rsqrtf(s * (1.f / 256.f) + EPSF);
        const float4 gq = *(const float4*)(Ip->q_norm + 4 * lane);
        *(uint2*)(CQ + (size_t)m * 256 + 4 * lane) = make_uint2(pk2((a[0] * r) * gq.x, (a[1] * r) * gq.y), pk2((a[2] * r) * gq.z, (a[3] * r) * gq.w));
        const unsigned u = *(const unsigned*)(pr + 256 + 2 * lane); const float c0 = bflo(u), c1 = bfhi(u);
        s = wave_sum(c0 * c0 + c1 * c1); r = rsqrtf(s * (1.f / 128.f) + EPSF);
        *(unsigned*)(CKV + (size_t)m * 128 + 2 * lane) = pk2((c0 * r) * Ip->kv_norm[2 * lane], (c1 * r) * Ip->kv_norm[2 * lane + 1]);
        const float k0 = bf2f(pr[384 + lane]);
        s = wave_sum(k0 * k0); r = rsqrtf(s * (1.f / 64.f) + EPSF);
        { const int tk = m >> 5, key = m & 31, ks = lane >> 4, hf = (lane >> 3) & 1, jj = lane & 7;
          KIDX[((size_t)(tk * 4 + ks) * 64 + hf * 32 + key) * 8 + jj] = (bf16)f2bf((k0 * r) * Ip->kidx_norm[lane]); }
        if (lane < 8) WIDX[(size_t)m * 8 + lane] = bf2f(pr[448 + lane]) * (0.35355339059327373f * 0.125f);
    }
}

#define MFMA32(A, B, C) __builtin_amdgcn_mfma_f32_32x32x16_bf16((A), (B), (C), 0, 0, 0)
typedef float f32x16 __attribute__((ext_vector_type(16)));
constexpr int XL_OFF = RING_BYTES;
constexpr int IDX_HIST = XL_OFF, IDX_CAND = XL_OFF + 16384, IDX_MM = XL_OFF + 24576, IDX_STQ = IDX_MM + 256, IDX_MM2 = IDX_STQ + 256, IDX_CAP = 1024;
static_assert(IDX_MM2 + 64 <= LDSCTL_OFF, "LDS map (indexer)");
__device__ __forceinline__ float wmin64(float v) {
#pragma unroll
    for (int o = 1; o < 64; o <<= 1) v = fminf(v, __shfl_xor(v, o));
    return v;
}
__device__ __forceinline__ float vmaxf_(float a, float b) { float d; asm("v_max_f32 %0, %1, %2" : "=v"(d) : "v"(a), "v"(b)); return d; }
__device__ __forceinline__ float vminf_(float a, float b) { float d; asm("v_min_f32 %0, %1, %2" : "=v"(d) : "v"(a), "v"(b)); return d; }
__device__ __forceinline__ void p12_index_mfma(Frame& F, const In& I, unsigned char* ws) {
    OPAQUE_TID(); KARGS(); const int lane = tid_ & 63, wave = __builtin_amdgcn_readfirstlane(tid_ >> 6), key = lane & 31, half = lane >> 5;
    LAS float* SC = (LAS float*)(F.lds + RING_OFF);
    LAS float* MMw = (LAS float*)(F.lds + IDX_MM);
    const bf16* QI = (const bf16*)(ws + WS_QI); const bf16* KIDX = (const bf16*)(ws + WS_KIDX); const float* WIDX = (const float*)(ws + WS_WIDX);
    unsigned short* SEL = (unsigned short*)(ws + WS_SEL); int* CNT = (int*)(ws + WS_CNT);
    const int NG = M / 4, per = (NG + F.G - 1) / F.G;
    for (int j = 0; j < per; ++j) {
        const int u = j * F.G + ((j & 1) ? (F.G - 1 - (int)blockIdx.x) : (int)blockIdx.x);
        if (u >= NG) break;
        const int gi = (u & 1) * (NG / 2) + (u >> 1);
        const int row0 = 4 * gi, b = row0 / T, t0 = row0 % T, rowb = b * T;
        if (t0 < 256) {
            if (wave < 4) { const int t = t0 + wave; unsigned short* so = SEL + (size_t)(row0 + wave) * 256;
#pragma unroll
                for (int i = 0; i < 4; ++i) { const int s = lane + 64 * i; so[s] = (unsigned short)(s <= t ? s : 0); }
                if (lane == 0) CNT[row0 + wave] = t + 1; }
            continue;
        }
        {
            const int rho = lane & 31, a = rho >> 2, qA = ((a >> 2) & 1) + 2 * (a & 1), hdA = 4 * ((a >> 1) & 1) + (rho & 3);
            bf16x8 qa[4];
#pragma unroll
            for (int ks = 0; ks < 4; ++ks) qa[ks] = ldg16(QI + (size_t)(row0 + qA) * 512 + hdA * 64 + 16 * ks + 8 * half);
            float w0[8], w1[8];
            { const float4 x0 = *(const float4*)(WIDX + (size_t)(row0 + 2 * half) * 8), x1 = *(const float4*)(WIDX + (size_t)(row0 + 2 * half) * 8 + 4);
              const float4 y0 = *(const float4*)(WIDX + (size_t)(row0 + 2 * half + 1) * 8), y1 = *(const float4*)(WIDX + (size_t)(row0 + 2 * half + 1) * 8 + 4);
              w0[0] = x0.x; w0[1] = x0.y; w0[2] = x0.z; w0[3] = x0.w; w0[4] = x1.x; w0[5] = x1.y; w0[6] = x1.z; w0[7] = x1.w;
              w1[0] = y0.x; w1[1] = y0.y; w1[2] = y0.z; w1[3] = y0.w; w1[4] = y1.x; w1[5] = y1.y; w1[6] = y1.z; w1[7] = y1.w; }
            f32x2_t w0p[4], w1p[4];
#pragma unroll
            for (int h = 0; h < 4; ++h) { w0p[h] = (f32x2_t){w0[2 * h], w0[2 * h + 1]}; w1p[h] = (f32x2_t){w1[2 * h], w1[2 * h + 1]}; }
            const int tq0 = t0 + 2 * half, tq1 = tq0 + 1, nt = (t0 + 3) / 32 + 1;
            float mn0 = INFINITY, mx0 = -INFINITY, mn1 = INFINITY, mx1 = -INFINITY;
            const bf16* kpb = KIDX + (size_t)(rowb >> 5) * 2048 + (size_t)lane * 8;
            const int ntw = (nt - wave + NWAVES - 1) / NWAVES;
#define IDX_LOAD(dst, i) do { const int tl2_ = wave + NWAVES * ((i) < ntw ? (i) : (ntw > 0 ? ntw - 1 : 0)); const bf16* kp_ = kpb + (size_t)tl2_ * 2048; \
                _Pragma("unroll") for (int ks = 0; ks < 4; ++ks) dst[ks] = ldg16(kp_ + 512 * ks); } while (0)
#define IDX_COMP(src, i) do { if ((i) < ntw) { const int kpos = 32 * (wave + NWAVES * (i)) + key; \
                f32x16 c = {0.f, 0.f, 0.f, 0.f, 0.f, 0.f, 0.f, 0.f, 0.f, 0.f, 0.f, 0.f, 0.f, 0.f, 0.f, 0.f}; \
                _Pragma("unroll") for (int ks = 0; ks < 4; ++ks) c = MFMA32(qa[ks], src[ks], c); \
                f32x2_t a0 = {0.f, 0.f}, a1 = {0.f, 0.f};                   \
                _Pragma("unroll") for (int h = 0; h < 4; ++h) { \
                    const f32x2_t r0 = {__int_as_float(max(__float_as_int(c[2 * h]), 0)), __int_as_float(max(__float_as_int(c[2 * h + 1]), 0))}; \
                    const f32x2_t r1 = {__int_as_float(max(__float_as_int(c[8 + 2 * h]), 0)), __int_as_float(max(__float_as_int(c[9 + 2 * h]), 0))}; \
                    a0 = __builtin_elementwise_fma(r0, w0p[h], a0); a1 = __builtin_elementwise_fma(r1, w1p[h], a1); } \
                float s0 = (a0[0] + a0[1]) + 0.f, s1 = (a1[0] + a1[1]) + 0.f; \
                const bool ok0 = kpos <= tq0, ok1 = kpos <= tq1; \
                const float v0_ = ok0 ? s0 : -INFINITY, v1_ = ok1 ? s1 : -INFINITY; \
                SC[(2 * half) * 8192 + kpos] = v0_; SC[(2 * half + 1) * 8192 + kpos] = v1_; \
                mx0 = vmaxf_(mx0, v0_); mx1 = vmaxf_(mx1, v1_); mn0 = vminf_(mn0, ok0 ? s0 : INFINITY); mn1 = vminf_(mn1, ok1 ? s1 : INFINITY); } } while (0)
            for (int prb_ = 0; prb_ < (PROBE_REP == 2 ? 2 : 1); ++prb_)
            if (ntw > 0) {
                bf16x8 kb0[4], kb1[4], kb2[4], kb3[4];
                IDX_LOAD(kb0, 0); IDX_LOAD(kb1, 1); IDX_LOAD(kb2, 2);
                for (int i = 0; i < ntw; i += 4) {
                    IDX_LOAD(kb3, i + 3); IDX_COMP(kb0, i);
                    IDX_LOAD(kb0, i + 4); IDX_COMP(kb1, i + 1);
                    IDX_LOAD(kb1, i + 5); IDX_COMP(kb2, i + 2);
                    IDX_LOAD(kb2, i + 6); IDX_COMP(kb3, i + 3);
                }
            }
#undef IDX_LOAD
#undef IDX_COMP
#pragma unroll
            for (int o = 1; o < 32; o <<= 1) { mn0 = fminf(mn0, __shfl_xor(mn0, o)); mx0 = fmaxf(mx0, __shfl_xor(mx0, o)); mn1 = fminf(mn1, __shfl_xor(mn1, o)); mx1 = fmaxf(mx1, __shfl_xor(mx1, o)); }
            if (key == 0) { LAS float* mm = MMw + (wave * 4 + 2 * half) * 2; mm[0] = mn0; mm[1] = mx0; mm[2] = mn1; mm[3] = mx1; }
        }
        __syncthreads();
        {
            const int q = wave >> 1, hw = wave & 1, t = t0 + q, n = t + 1; const LAS float* sc = SC + q * 8192;
            LAS unsigned* hist = (LAS unsigned*)(F.lds + IDX_HIST) + wave * 512; const LAS unsigned* hist0 = (const LAS unsigned*)(F.lds + IDX_HIST) + (2 * q) * 512;
            LAS unsigned short* cand = (LAS unsigned short*)(F.lds + IDX_CAND) + q * IDX_CAP;
            LAS float* stf = (LAS float*)(F.lds + IDX_STQ) + q * 16; LAS int* sti = (LAS int*)stf;
            LAS float* mm2 = (LAS float*)(F.lds + IDX_MM2) + wave * 2;
            unsigned short* so = SEL + (size_t)(row0 + q) * 256;
            const int nch = (n + 255) >> 8;
            if (hw == 0 && lane == 0) { float lo = INFINITY, hi = -INFINITY;
#pragma unroll
                for (int w = 0; w < 8; ++w) { lo = fminf(lo, MMw[(w * 4 + q) * 2]); hi = fmaxf(hi, MMw[(w * 4 + q) * 2 + 1]); }
                stf[0] = lo; stf[1] = hi; sti[2] = 256; sti[3] = 0; sti[4] = 0; sti[5] = 0; sti[6] = 0; sti[7] = 0; sti[8] = 0; sti[9] = 0; }
            __syncthreads();
            for (int round = 0; round < 64; ++round) {
                const float lo = stf[0], hi = stf[1]; const bool act = sti[8] == 0; const bool eqr = !(hi > lo); const float scale = eqr ? 0.f : 1024.f / (hi - lo);
                if (act && !eqr) {
#pragma unroll
                    for (int i = 0; i < 8; ++i) hist[lane + 64 * i] = 0u;
                    for (int c = hw; c < nch; c += 2) { const int i4 = 256 * c + 4 * lane; const f32x4 v4 = *(const LAS f32x4*)(sc + i4);
#pragma unroll
                        for (int e = 0; e < 4; ++e) { const float v = (i4 + e < n) ? v4[e] : -INFINITY;
                            if (v >= lo && v <= hi) { int bb = (int)((v - lo) * scale); bb = bb > 1023 ? 1023 : bb; atomicAdd((unsigned*)&hist[bb >> 1], 1u << (16 * (bb & 1))); } } }
                }
                __syncthreads();
                if (hw == 0 && act) {
                    if (eqr) { if (lane == 0) { sti[8] = 1; sti[9] = 1; } }
                    else {
                        const int krem = sti[2];
                        unsigned cw[8], c0w[8]; unsigned S = 0u, S0 = 0u;
#pragma unroll
                        for (int i = 0; i < 8; ++i) { c0w[i] = hist0[8 * lane + i]; cw[i] = c0w[i] + hist0[512 + 8 * lane + i]; S += (cw[i] & 0xffffu) + (cw[i] >> 16); S0 += (c0w[i] & 0xffffu) + (c0w[i] >> 16); }
                        unsigned x = S, x0 = S0;
#pragma unroll
                        for (int o = 1; o < 64; o <<= 1) { const unsigned y = __shfl_down(x, o), y0 = __shfl_down(x0, o); if (lane + o < 64) { x += y; x0 += y0; } }
                        const unsigned above = x - S; unsigned acc0 = x0 - S0;
                        const bool found = (above < (unsigned)krem) && ((unsigned)krem <= above + S);
                        const int fl = __builtin_ctzll(__ballot(found));
                        int bs = 0; unsigned acc = above, cb = 0u, cb0 = 0u;
                        { bool done = false;
#pragma unroll
                          for (int i = 15; i >= 0; --i) { const unsigned cnt_ = (i & 1) ? (cw[i >> 1] >> 16) : (cw[i >> 1] & 0xffffu), cnt0_ = (i & 1) ? (c0w[i >> 1] >> 16) : (c0w[i >> 1] & 0xffffu);
                              if (!done) { if (acc + cnt_ >= (unsigned)krem) { bs = 16 * lane + i; cb = cnt_; cb0 = cnt0_; done = true; } else { acc += cnt_; acc0 += cnt0_; } } } }
                        if (lane == fl) { sti[2] = krem - (int)acc; sti[3] += (int)acc0; sti[4] += (int)acc; sti[5] = bs; sti[6] = (int)cb0; sti[7] = (int)cb; sti[8] = ((int)cb <= IDX_CAP) ? 1 : 0; }
                    }
                }
                __syncthreads();
                const LAS int* stall = (const LAS int*)(F.lds + IDX_STQ);
                if (stall[8] && stall[16 + 8] && stall[32 + 8] && stall[48 + 8]) break;
                float nlo = INFINITY, nhi = -INFINITY;
                if (sti[8] == 0) { const int bstar = sti[5];
                    for (int c = hw; c < nch; c += 2) { const int i4 = 256 * c + 4 * lane; const f32x4 v4 = *(const LAS f32x4*)(sc + i4);
#pragma unroll
                        for (int e = 0; e < 4; ++e) { const float v = (i4 + e < n) ? v4[e] : -INFINITY;
                            if (v >= lo && v <= hi) { int bb = (int)((v - lo) * scale); bb = bb > 1023 ? 1023 : bb; if (bb == bstar) { nlo = fminf(nlo, v); nhi = fmaxf(nhi, v); } } } } }
                nlo = wmin64(nlo); nhi = wmax64(nhi);
                if (lane == 0) { mm2[0] = nlo; mm2[1] = nhi; }
                __syncthreads();
                if (hw == 0 && lane == 0 && sti[8] == 0) { stf[0] = fminf(mm2[0], mm2[2]); stf[1] = fmaxf(mm2[1], mm2[3]); }
                __syncthreads();
            }
            { const float lo = stf[0], hi = stf[1]; const bool eq = sti[9] != 0; const float scale = eq ? 0.f : 1024.f / (hi - lo);
              const int krem = sti[2], A0 = sti[3], AT = sti[4], bstar = sti[5], C0 = sti[6], ncand = sti[7], nabove = 256 - krem;
              int bsel = hw ? A0 : 0, bcand = hw ? C0 : 0; (void)AT;
              const int cstep = eq ? 1 : 2;
              if (!(eq && hw)) for (int c = eq ? 0 : hw; c < nch; c += cstep) { const int i4 = 256 * c + 4 * lane; const f32x4 v4 = *(const LAS f32x4*)(sc + i4);
#pragma unroll
                  for (int e = 0; e < 4; ++e) { const int idx = i4 + e; const float v = (idx < n) ? v4[e] : -INFINITY;
                      bool sel, cnd;
                      if (eq) { sel = v > hi; cnd = (v == hi); }
                      else { const bool in = (v >= lo && v <= hi); int bb = (int)((v - lo) * scale); bb = bb > 1023 ? 1023 : bb; sel = (v > hi) || (in && bb > bstar); cnd = in && bb == bstar; }
                      const unsigned long long ms = __ballot(sel), mc = __ballot(cnd), lt = (1ull << lane) - 1ull;
                      if (sel) so[bsel + __builtin_popcountll(ms & lt)] = (unsigned short)idx;
                      if (cnd) { const int pc = bcand + __builtin_popcountll(mc & lt);
                          if (eq) { if (pc < krem) so[nabove + pc] = (unsigned short)idx; } else if (pc < IDX_CAP) cand[pc] = (unsigned short)idx; }
                      bsel += __builtin_popcountll(ms); bcand += __builtin_popcountll(mc); } }
              __syncthreads();
              if (!eq) {
                  for (int i = 64 * hw + lane; i < ncand; i += 128) { const int ii = cand[i]; const float vi = sc[ii]; int rank = 0;
                      for (int jj = 0; jj < ncand; ++jj) { const int ij = cand[jj]; const float vj = sc[ij]; rank += ((vj > vi) || (vj == vi && ij < ii)) ? 1 : 0; }
                      if (rank < krem) so[nabove + rank] = (unsigned short)ii; }
              }
              if (hw == 0 && lane == 0) CNT[row0 + q] = 256; }
        }
        __syncthreads();
    }
}

__device__ __forceinline__ unsigned offb(unsigned row, unsigned ch) { return 256u * row + 16u * (ch ^ (((row & 3u) << 2) | ((row >> 2) & 3u))); }
typedef short v4i16_t __attribute__((ext_vector_type(4)));
__device__ __forceinline__ v4i16_t trrd(const LAS unsigned char* p) { return __builtin_amdgcn_ds_read_tr16_b64_v4i16((LAS v4i16_t*)p); }
__device__ __forceinline__ void p13_dsa_mfma(Frame& F, const In& I, unsigned char* ws) {
    OPAQUE_TID(); KARGS(); const int lane = tid_ & 63, wave = __builtin_amdgcn_readfirstlane(tid_ >> 6), n = lane & 15, kq = lane >> 4;
    LAS unsigned char* bkt = F.lds + TAB_BKT; LAS float* b12 = (LAS float*)(F.lds + P13_B12);
    for (int i = tid_; i < 1536; i += NWAVES * 64) bkt[i] = (unsigned char)rel_bucket(i);
    for (int i = tid_; i < 528; i += NWAVES * 64) b12[i] = (i >= 512) ? -INFINITY : (((i & 15) < 12) ? Ip->rel_bias[(i >> 4) * 12 + (i & 15)] * LOG2E : 0.f);
    __syncthreads();
    LAS unsigned char* imgb = F.lds + RING_OFF + wave * 17408; LAS int* sidx = (LAS int*)(imgb + 16384);
    const bf16* QA = (const bf16*)(ws + WS_QA); const bf16* CKV = (const bf16*)(ws + WS_CKV); const bf16* PR = (const bf16*)(ws + WS_PROJ1);
    const unsigned short* SEL = (const unsigned short*)(ws + WS_SEL); const int* CNT = (const int*)(ws + WS_CNT);
    const bf16* MKB = (const bf16*)(ws + WS_MKB) + (size_t)512 * 256; const bf16* MVT = (const bf16*)(ws + WS_MVT) + (size_t)256 * 512;
    bf16* CAT1 = (bf16*)(ws + WS_CAT1);
    const int gw = blockIdx.x * NWAVES + wave, NGW = F.G * NWAVES;
    const LAS float* b12c = b12 + (n < 12 ? n : 0);
    for (int row = gw; row < M; row += NGW) {
        const int b = row / T, t = row % T, rowb = b * T, cnt = __builtin_amdgcn_readfirstlane(CNT[row]);
        asm volatile("s_waitcnt lgkmcnt(0)" ::: "memory");
        { const int idx0 = (int)SEL[(size_t)row * 256];
#pragma unroll
          for (int i = 0; i < 4; ++i) { const int e = lane + 64 * i, idx = (int)SEL[(size_t)row * 256 + e]; const int d = t - idx, dc = d > 1535 ? 1535 : (d < 0 ? 0 : d);
              sidx[e] = (e < cnt) ? (idx | ((int)bkt[dc] << 22)) : (idx0 | (2048 << 16)); } }
        bf16x8 qf[4];
#pragma unroll
        for (int ks = 0; ks < 4; ++ks) { bf16x8 v = ldg16(QA + (size_t)row * 1536 + (n < 12 ? n : 0) * 128 + 32 * ks + 8 * kq); if (n >= 12) v = (bf16x8){0, 0, 0, 0, 0, 0, 0, 0}; qf[ks] = v; }
        float m = -1e30f, l = 0.f; f32x4 O[8];
#pragma unroll
        for (int rt = 0; rt < 8; ++rt) O[rt] = (f32x4){0.f, 0.f, 0.f, 0.f};
#define DSA_GATHER(c0_, buf_) do { int ln2_ = lane; asm volatile("" : "+v"(ln2_)); \
            _Pragma("unroll") for (int i = 0; i < 8; ++i) { const int rr = 4 * i + (ln2_ >> 4), pos = ln2_ & 15, e = (c0_) + rr; const int kidx = sidx[e] & 0xffff; \
                const unsigned chs = (unsigned)pos ^ ((((unsigned)rr & 3u) << 2) | (((unsigned)rr >> 2) & 3u)); \
                __builtin_amdgcn_global_load_lds((const unsigned*)(CKV + (size_t)(rowb + kidx) * 128 + 8 * chs), (LAS unsigned*)(imgb + (buf_) * 8192 + i * 1024), 16, 0, 0); } } while (0)
        asm volatile("s_waitcnt lgkmcnt(0)" ::: "memory");
        DSA_GATHER(0, 0);
        for (int c0 = 0; c0 < cnt; c0 += 32) {
            const int cb = (c0 >> 5) & 1; LAS unsigned char* img = imgb + cb * 8192;
            if (c0 + 32 < cnt) { DSA_GATHER(c0 + 32, cb ^ 1); asm volatile("s_waitcnt vmcnt(8)" ::: "memory"); } else asm volatile("s_waitcnt vmcnt(0)" ::: "memory");
            int ln_ = lane; asm volatile("" : "+v"(ln_));
            const bool has = m > -1e29f; const float mref = has ? m : 0.f; const float cinv = -mref;
            f32x4 sa = {cinv, cinv, cinv, cinv}, sb = sa;
            { const unsigned ra = 8u * ((unsigned)(ln_ & 15) >> 2) + ((unsigned)ln_ & 3u), kq_ = (unsigned)ln_ >> 4;
#pragma unroll
              for (int s = 0; s < 4; ++s) { const bf16x8 ka = *(const LAS bf16x8*)(img + offb(ra, 4 * s + kq_)); const bf16x8 kb = *(const LAS bf16x8*)(img + offb(ra + 4, 4 * s + kq_));
                  sa = MFMA16(ka, qf[s], sa); sb = MFMA16(kb, qf[s], sb); } }
#pragma unroll
            for (int i = 0; i < 4; ++i) { const int ea = c0 + 8 * kq + i;
                sa[i] += *(const LAS float*)((const LAS unsigned char*)b12c + ((unsigned)sidx[ea] >> 16)); sb[i] += *(const LAS float*)((const LAS unsigned char*)b12c + ((unsigned)sidx[ea + 4] >> 16)); }
            float fsc = 1.f;
            if (__any((imax3(imax3(__float_as_int(sa[0]), __float_as_int(sa[1]), __float_as_int(sa[2])), imax3(__float_as_int(sa[3]), __float_as_int(sb[0]), __float_as_int(sb[1])), max(__float_as_int(sb[2]), __float_as_int(sb[3]))) > __float_as_int(SM_THR)) || !has)) {
                float lm = lmax8(sa, sb);
                lm = fmaxf(lm, __shfl_xor(lm, 16)); lm = fmaxf(lm, __shfl_xor(lm, 32));
                const bool upd = (lm > -INFINITY) && (!has || lm > 0.f); const float dl = upd ? lm : 0.f;
                if (upd) m = mref + dl;
                fsc = has ? __builtin_amdgcn_exp2f(-dl) : 1.f; l *= fsc;
#pragma unroll
                for (int i = 0; i < 4; ++i) { sa[i] -= dl; sb[i] -= dl; }
#pragma unroll
                for (int rt = 0; rt < 8; ++rt) O[rt] = O[rt] * fsc;
            }
            f32x4 pa, pb; float sum = 0.f;
#pragma unroll
            for (int i = 0; i < 4; ++i) { pa[i] = __builtin_amdgcn_exp2f(sa[i]); pb[i] = __builtin_amdgcn_exp2f(sb[i]); sum += pa[i] + pb[i]; }
            l += sum;
            const bf16x8 pf = pack8(pa, pb);
            { const unsigned g_ = (unsigned)ln_ >> 4, q_ = ((unsigned)ln_ & 15u) >> 2, p_ = (unsigned)ln_ & 3u;
#pragma unroll
              for (int rt = 0; rt < 8; ++rt) { const v4i16_t x0 = trrd(img + offb(8 * g_ + q_, 2 * rt + (p_ >> 1)) + 8 * (p_ & 1)), x1 = trrd(img + offb(8 * g_ + 4 + q_, 2 * rt + (p_ >> 1)) + 8 * (p_ & 1));
                  const bf16x8 vf = {x0[0], x0[1], x0[2], x0[3], x1[0], x1[1], x1[2], x1[3]};
                  O[rt] = MFMA16(vf, pf, O[rt]); } }
        }
#undef DSA_GATHER
        const float il = 1.f / kqsum(l);
        if (n < 12) { bf16* op = CAT1 + (size_t)row * 1792 + n * 128 + 4 * kq;
#pragma unroll
            for (int rt = 0; rt < 8; ++rt) *(uint2*)(op + 16 * rt) = make_uint2(pk2(O[rt][0] * il, O[rt][1] * il), pk2(O[rt][2] * il, O[rt][3] * il)); }
    }
    for (int u8 = gw; u8 < M / 8; u8 += NGW) {
        const int row0 = 8 * u8, b = row0 / T; const int r = n;
#pragma unroll 1
        for (int hm = 0; hm < 4; ++hm) {
            bf16x8 qm[2]; { const bf16* qp = PR + (size_t)(row0 + (n & 7)) * 768 + 456 + hm * 64 + 8 * kq; qm[0] = ldg16(qp); qm[1] = ldg16(qp + 32); if (n >= 8) { qm[0] = (bf16x8){0, 0, 0, 0, 0, 0, 0, 0}; qm[1] = qm[0]; } }
            float mm = -1e30f, ll = 0.f; f32x4 Om[4];
#pragma unroll
            for (int dt = 0; dt < 4; ++dt) Om[dt] = (f32x4){0.f, 0.f, 0.f, 0.f};
            const bf16* mk = MKB + (size_t)(b * 256) * 256 + hm * 64; const bf16* mvt = MVT + (size_t)(hm * 64) * 512 + b * 256;
            for (int key0 = 0; key0 < 256; key0 += 32) { int r_ = r, kq_ = kq; asm volatile("" : "+v"(r_), "+v"(kq_)); KF k; load_k(k, mk, 256, key0, r_, kq_); VF v; load_vt(v, mvt, 512, key0, r_, kq_);
                f32x4 sa, sb; qk(sa, sb, k, qm); sa = sa * (0.125f * LOG2E); sb = sb * (0.125f * LOG2E); pv(Om, v, sm_update(sa, sb, mm, ll, Om)); }
            const float il = 1.f / kqsum(ll);
            if (n < 8) { bf16* op = CAT1 + (size_t)(row0 + n) * 1792 + 1536 + hm * 64 + 4 * kq;
#pragma unroll
                for (int dt = 0; dt < 4; ++dt) *(uint2*)(op + 16 * dt) = make_uint2(pk2(Om[dt][0] * il, Om[dt][1] * il), pk2(Om[dt][2] * il, Om[dt][3] * il)); }
        }
    }
}

struct Args { In in; float* out; unsigned char* ws; int ph_lo, ph_hi; };
__global__ void __launch_bounds__(NWAVES * 64, 2) mk_fwd(Args args) {
    extern __shared__ __attribute__((aligned(16))) unsigned char lds[];
    Frame F;
    F.lds = (LAS unsigned char*)lds; F.MISC = (volatile LAS unsigned*)(F.lds + MISC_OFF);
    F.G = gridDim.x; { const int bx = blockIdx.x; F.vcu = (F.G % 8 == 0) ? (bx % 8) * (F.G / 8) + bx / 8 : bx; }
    unsigned char* ws = args.ws; const In& I = args.in; float* out = args.out; (void)I;
    F.ctl = (gu32*)(ws + WS_CTL);
    for (int u = threadIdx.x; u < (LDS_BYTES - LDSCTL_OFF) / 4; u += NWAVES * 64) ((LAS unsigned*)(F.lds + LDSCTL_OFF))[u] = 0u;
    __syncthreads();
    XcdBarrier bar; bar.bar = (unsigned*)(F.ctl + CW_BAR); bar.x = 0; bar.st = nullptr;
    if (!MK_SPLIT) bar = xcd_barrier_post((unsigned*)(F.ctl + CW_BAR), F.MISC + 8);
    const int lo = args.ph_lo, hi = args.ph_hi;
#ifndef PH_MASK
#define PH_MASK 0xFFFFFFFFu
#endif
#define IN(k) ((((PH_MASK) >> ((k) % 32)) & 1u) && lo <= (k) && (k) < hi)
#define SEAM(k) do { if (IN(k) && IN((k) + 1)) xcd_barrier(bar); } while (0)
#define SEAM2(k, kn) do { if (IN(k) && IN(kn)) xcd_barrier(bar); } while (0)
#ifndef REP_MASK
#define REP_MASK 0u
#endif
#define REPS(k) (1 + (int)(((REP_MASK) >> (k)) & 1u))
    bf16* XN = (bf16*)(ws + WS_XN); bf16* CAT = (bf16*)(ws + WS_CAT); bf16* ACT = (bf16*)(ws + WS_ACT);
    float* SSQ = (float*)(ws + WS_SSQ);

    if (IN(0)) { for (int r_ = 0; r_ < REPS(0); ++r_) { p0_prologue(F, I, ws); if (r_ + 1 < REPS(0)) xcd_barrier(bar); } SEAM(0); }
    {
            if (IN(1)) {
                pg8::Gemm g{XN, (const bf16*)(ws + WS_WIN0), M, 1792, D}; pg8::StaticOrder S; S.init(M, 1792, F.G, (int)blockIdx.x);
                pg8::EpiRoute<0> E{ws, nullptr};
                for (int r_ = 0; r_ < REPS(1); ++r_) { if (r_) xcd_barrier(bar);
                pg8::gemm_phase<pg8::EpiRoute<0>, pg8::StaticOrder, true, true>(F.lds + RING_OFF, g, S, E); }
                pg8::Gemm g2{(const bf16*)(ws + WS_WVT), XN, 256, M, D}; pg8::StaticOrder S2; S2.init(256, M, F.G, (int)((blockIdx.x + 64) % F.G));
                pg8::EpiRoute<3> E2{ws, nullptr};
                pg8::gemm_phase<pg8::EpiRoute<3>, pg8::StaticOrder, true, true>(F.lds + RING_OFF, g2, S2, E2);
                SEAM(1);
            }
            if (IN(2)) { for (int r_ = 0; r_ < REPS(2); ++r_) { p2_mfma(F, I, ws); if (r_ + 1 < REPS(2)) xcd_barrier(bar); } SEAM(2); }
            if (IN(3)) { for (int r_ = 0; r_ < REPS(3); ++r_) { p3_nsa_mfma(F, I, ws); if (r_ + 1 < REPS(3)) xcd_barrier(bar); } SEAM(3); }
    }
    {
        constexpr int L = 0, pb = L ? 14 : 4;
        if (IN(pb)) {
            pg8::Gemm g{L ? (const bf16*)(ws + WS_CAT1) : CAT, L ? (const bf16*)(ws + WS_WO1F) : (const bf16*)(ws + WS_WO), M, D, L ? 1792 : D}; pg8::StaticOrder S; S.init(M, D, F.G, (int)blockIdx.x);
            KARGS(); pg8::EpiResid<L == 0> E{L ? (const void*)XN : (const void*)Ip->x, XN, SSQ + (size_t)(L ? 2 : 0) * M * 16, D, 0};
            pg8::gemm_phase<pg8::EpiResid<L == 0>, pg8::StaticOrder, true, true>(F.lds + RING_OFF, g, S, E);
            SEAM2(pb, pb + 2);
        }
        if (IN(pb + 2)) {
            pg8::Gemm g{XN, (const bf16*)(ws + WS_WGU) + (size_t)L * 2 * DFF * D, M, 2 * DFF, D}; pg8::StaticOrder S; S.init(M, 2 * DFF, F.G, (int)blockIdx.x);
            pg8::EpiSwiglu E{ACT, SSQ + (size_t)(L ? 2 : 0) * M * 16, DFF, 0};
            for (int r_ = 0; r_ < REPS(pb + 2); ++r_) { if (r_) xcd_barrier(bar);
            pg8::gemm_phase<pg8::EpiSwiglu, pg8::StaticOrder, true, true>(F.lds + RING_OFF, g, S, E); }
            SEAM(pb + 2);
        }
        if (IN(pb + 3)) {
            pg8::Gemm g{ACT, (const bf16*)(ws + WS_WD) + (size_t)L * D * DFF, M, D, DFF}; pg8::StaticOrder S; S.init(M, D, F.G, (int)blockIdx.x);
            pg8::EpiResid<false> E{XN, XN, SSQ + (size_t)(L ? 3 : 1) * M * 16, D, 0};
            pg8::gemm_phase<pg8::EpiResid<false>, pg8::StaticOrder, true, true>(F.lds + RING_OFF, g, S, E);
            SEAM2(pb + 3, L ? 18 : 9);
        }
        }
    {
            if (IN(9)) {
                pg8::Gemm g{XN, (const bf16*)(ws + WS_WIN1), M, 768, D}; pg8::StaticOrder S; S.init(M, 768, F.G, (int)blockIdx.x);
                pg8::EpiRoute<1> E{ws, SSQ + (size_t)1 * M * 16};
                for (int r_ = 0; r_ < REPS(9); ++r_) { if (r_) xcd_barrier(bar);
                pg8::gemm_phase<pg8::EpiRoute<1>, pg8::StaticOrder, true, true>(F.lds + RING_OFF, g, S, E); }
                SEAM(9);
            }
            if (IN(10)) { p10_dsa_norm(F, I, ws); SEAM(10); }
            if (IN(11)) {
                pg8::Gemm g{(const bf16*)(ws + WS_CQ), (const bf16*)(ws + WS_WQ2), M, 2048, 256}; pg8::StaticOrder S; S.init(M, 2048, F.G, (int)blockIdx.x);
                pg8::EpiRoute<2> E{ws, nullptr};
                for (int r_ = 0; r_ < REPS(11); ++r_) { if (r_) xcd_barrier(bar);
                pg8::gemm_phase<pg8::EpiRoute<2>, pg8::StaticOrder, true, true>(F.lds + RING_OFF, g, S, E); }
                SEAM(11);
            }
            if (IN(12)) { for (int r_ = 0; r_ < REPS(12); ++r_) { p12_index_mfma(F, I, ws); if (r_ + 1 < REPS(12)) xcd_barrier(bar); } SEAM(12); }
            if (IN(13)) { for (int r_ = 0; r_ < REPS(13); ++r_) { p13_dsa_mfma(F, I, ws); if (r_ + 1 < REPS(13)) xcd_barrier(bar); } SEAM(13); }
            }
    {
        constexpr int L = 1, pb = L ? 14 : 4;
        if (IN(pb)) {
            pg8::Gemm g{L ? (const bf16*)(ws + WS_CAT1) : CAT, L ? (const bf16*)(ws + WS_WO1F) : (const bf16*)(ws + WS_WO), M, D, L ? 1792 : D}; pg8::StaticOrder S; S.init(M, D, F.G, (int)blockIdx.x);
            KARGS(); pg8::EpiResid<L == 0> E{L ? (const void*)XN : (const void*)Ip->x, XN, SSQ + (size_t)(L ? 2 : 0) * M * 16, D, 0};
            pg8::gemm_phase<pg8::EpiResid<L == 0>, pg8::StaticOrder, true, true>(F.lds + RING_OFF, g, S, E);
            SEAM2(pb, pb + 2);
        }
        if (IN(pb + 2)) {
            pg8::Gemm g{XN, (const bf16*)(ws + WS_WGU) + (size_t)L * 2 * DFF * D, M, 2 * DFF, D}; pg8::StaticOrder S; S.init(M, 2 * DFF, F.G, (int)blockIdx.x);
            pg8::EpiSwiglu E{ACT, SSQ + (size_t)(L ? 2 : 0) * M * 16, DFF, 0};
            for (int r_ = 0; r_ < REPS(pb + 2); ++r_) { if (r_) xcd_barrier(bar);
            pg8::gemm_phase<pg8::EpiSwiglu, pg8::StaticOrder, true, true>(F.lds + RING_OFF, g, S, E); }
            SEAM(pb + 2);
        }
        if (IN(pb + 3)) {
            pg8::Gemm g{ACT, (const bf16*)(ws + WS_WD) + (size_t)L * D * DFF, M, D, DFF}; pg8::StaticOrder S; S.init(M, D, F.G, (int)blockIdx.x);
            pg8::EpiResid<false> E{XN, XN, SSQ + (size_t)(L ? 3 : 1) * M * 16, D, 0};
            pg8::gemm_phase<pg8::EpiResid<false>, pg8::StaticOrder, true, true>(F.lds + RING_OFF, g, S, E);
            SEAM2(pb + 3, L ? 18 : 9);
        }
        }
    if (IN(18)) {
        OPAQUE_TID(); KARGS(); const int lane_ = tid_ & 63;
        const int gw = F.vcu * NWAVES + (tid_ >> 6), NGW = F.G * NWAVES;
        for (int m = gw; m < M; m += NGW) { const float r = rsqrtf(pg8::ssq_row(SSQ + ((size_t)3 * M + m) * 16) * (1.f / D) + EPSF);
#pragma unroll
            for (int j = 0; j < 2; ++j) { const int c = (j * 64 + lane_) * 8; const pg8::u32x4 rw = *(const GAS pg8::u32x4*)(XN + (size_t)m * D + c);
                const GAS f32x4* gr = (const GAS f32x4*)(Ip->norm_final + c); GAS f32x4* orow = (GAS f32x4*)(out + (size_t)m * D + c);
                f32x4 r0, r1; r0[0] = __uint_as_float(rw.x << 16); r0[1] = __uint_as_float(rw.x & 0xffff0000u); r0[2] = __uint_as_float(rw.y << 16); r0[3] = __uint_as_float(rw.y & 0xffff0000u);
                r1[0] = __uint_as_float(rw.z << 16); r1[1] = __uint_as_float(rw.z & 0xffff0000u); r1[2] = __uint_as_float(rw.w << 16); r1[3] = __uint_as_float(rw.w & 0xffff0000u);
                orow[0] = (r0 * r) * gr[0]; orow[1] = (r1 * r) * gr[1]; } }
    }
#undef IN
#undef SEAM
}

extern "C" void kernel_launch(void* const* d_in, const int* in_sizes, int n_in, void* d_out, int out_size, void* d_ws, size_t ws_size, hipStream_t stream) {
    static int grid = 0;
    if (grid == 0) {
        if (n_in != 32 || out_size != M * D || ws_size < WS_END) { fprintf(stderr, "kernel_launch: unexpected shapes (n_in %d out %d ws %zu)\n", n_in, out_size, ws_size); grid = -1; return; }
        int dev = 0, cus = 0, per_cu = 0;
        if (hipGetDevice(&dev) != hipSuccess || hipDeviceGetAttribute(&cus, hipDeviceAttributeMultiprocessorCount, dev) != hipSuccess) { grid = -1; return; }
        if (hipFuncSetAttribute((const void*)mk_fwd, hipFuncAttributeMaxDynamicSharedMemorySize, LDS_BYTES) != hipSuccess) { grid = -1; return; }
        if (hipOccupancyMaxActiveBlocksPerMultiprocessor(&per_cu, (const void*)mk_fwd, NWAVES * 64, LDS_BYTES) != hipSuccess || per_cu < 1) fprintf(stderr, "kernel_launch: occupancy query reports %d\n", per_cu);
        (void)hipGetLastError();
        grid = cus;
        if (grid > 256) grid = 256;
    }
    if (grid < 0) return;
    if (hipMemsetAsync((char*)d_ws + WS_CTL, 0, CTL_ZERO_BYTES, stream) != hipSuccess) return;
    Args a{};
    const float** ip = (const float**)&a.in;
    for (int i = 0; i < 32; ++i) ip[i] = (const float*)d_in[i];
    a.out = (float*)d_out; a.ws = (unsigned char*)d_ws;
#if MK_SPLIT
    for (int k = 0; k < N_PHASES; ++k) { a.ph_lo = k; a.ph_hi = k + 1; hipLaunchKernelGGL(mk_fwd, dim3(grid), dim3(NWAVES * 64), LDS_BYTES, stream, a); }
#else
    a.ph_lo = 0; a.ph_hi = N_PHASES; hipLaunchKernelGGL(mk_fwd, dim3(grid), dim3(NWAVES * 64), LDS_BYTES, stream, a);
#endif
}
```

```cpp
#include <hip/hip_runtime.h>
#include <cstdio>
#include <cstdint>
#include <type_traits>
#include <math.h>

namespace pg8 {
#define PG8_LAS __attribute__((address_space(3)))
typedef unsigned short bf16_t;
typedef short bf16x8 __attribute__((ext_vector_type(8)));
typedef float f32x4 __attribute__((ext_vector_type(4)));
typedef unsigned u32x4 __attribute__((ext_vector_type(4)));
constexpr int BM = 256, BK = 64, HALF = 128, HTB = HALF * BK * 2  , STAGE_BYTES = 8 * HTB, NXCD = 8, WGM = 8;

__host__ __device__ __forceinline__ int lds_byte(int r, int c) { const int st = (r >> 4) * 2 + (c >> 5), rr = r & 15, cc = c & 31, ob = rr * 64 + cc * 2; return st * 1024 + (ob ^ (((ob >> 9) & 1) << 5)); }
__host__ __device__ __forceinline__ void stage_rc(int b, int& R, int& C) { const int st = b / 1024, sb = b % 1024, swz = sb ^ (((sb >> 9) & 1) << 5); R = (st >> 1) * 16 + swz / 64; C = (st & 1) * 32 + (swz % 64) / 2; }
__host__ __device__ __forceinline__ int perm32(int rho) { const int n = rho >> 4, i = rho & 15; return 8 * (i >> 2) + 4 * n + (i & 3); }

struct Unit { int pm, pn; };
struct Gemm { const bf16_t* A; const bf16_t* Bt; int M, N, K; };

struct StaticOrder {
    int nM, nN, nwg, G, c;
    __host__ __device__ void init(int M, int N, int G_, int c_) { nM = M / BM; nN = N / BM; nwg = nM * nN; G = G_; c = c_; }
    __host__ __device__ bool next(int i, Unit& u) const {
        const long L = (long)i * G + c; if (L >= nwg) return false;
        int wgid = (int)L; { const int q = nwg / NXCD, r = nwg % NXCD, xcd = wgid % NXCD, off = wgid / NXCD; wgid = (xcd < r ? xcd * (q + 1) : r * (q + 1) + (xcd - r) * q) + off; }
        const int nig = WGM * nN, gid = wgid / nig, fm = gid * WGM, gsz = (nM - fm) < WGM ? (nM - fm) : WGM;
        u.pm = fm + ((wgid % nig) % gsz); u.pn = (wgid % nig) / gsz; return true;
    }
    __device__ __forceinline__ void a_ready(const Unit&) const {}
    __device__ __forceinline__ void done(const Unit&) const {}
};

__device__ __forceinline__ unsigned cvt_pk_bf16(float lo, float hi) { unsigned r; asm volatile("v_cvt_pk_bf16_f32 %0, %1, %2" : "=v"(r) : "v"(lo), "v"(hi)); return r; }
__device__ __forceinline__ float ssq_row(const float* p) { const f32x4 a = ((const f32x4*)p)[0], b = ((const f32x4*)p)[1], c = ((const f32x4*)p)[2], d = ((const f32x4*)p)[3]; const f32x4 t = (a + b) + (c + d); return (t[0] + t[1]) + (t[2] + t[3]); }
template <int ROUTE> struct EpiRoute {
    static constexpr bool PERM = true, AFTER_DRAIN = false;
    unsigned char* ws; const float* ssq;
    __device__ __forceinline__ void operator()(const f32x4 (&acc)[2][2][4][2], const Unit& u, int wr, int wc, int fr, int fq) const {
        asm volatile("" : "+v"(fr), "+v"(fq));
        const int pn = u.pn; size_t off; int ld, t0; float sc;
        if constexpr (ROUTE == 0) {
            off = pn < 3 ? (size_t)(88u << 20) : pn < 5 ? (size_t)(112u << 20) : pn < 6 ? (size_t)(128u << 20) : (size_t)(136u << 20);
            ld = pn < 3 ? 768 : pn < 5 ? 512 : 256; t0 = pn < 3 ? 0 : pn < 5 ? 3 : pn < 6 ? 5 : 6; sc = (pn < 3 || pn == 5) ? 0.18033688011112042f : 1.f;
        } else if constexpr (ROUTE == 1) { off = (size_t)(88u << 20); ld = 768; t0 = 0; sc = 1.f; }
        else if constexpr (ROUTE == 3) { off = (size_t)(144u << 20); ld = 16384; t0 = 0; sc = 1.f; }
        else { off = pn < 6 ? (size_t)(128u << 20) : (size_t)(176u << 20); ld = pn < 6 ? 1536 : 512; t0 = pn < 6 ? 0 : 6; sc = 1.f; }
        bf16_t* base = (bf16_t*)(ws + off);
        const int row0 = u.pm * BM + wr * 64 + fr, col0 = (pn - t0) * BM + wc * 32 + 8 * fq;
#pragma unroll
        for (int ai = 0; ai < 2; ++ai)
#pragma unroll
            for (int m = 0; m < 4; ++m) { bf16_t* rowp = base + (size_t)(row0 + ai * HALF + m * 16) * ld + col0;
                float scr_ = sc; if constexpr (ROUTE == 1) scr_ = rsqrtf(ssq_row(ssq + (size_t)(row0 + ai * HALF + m * 16) * 16) * (1.f / 1024.f) + 1e-6f);
#pragma unroll
                for (int bj = 0; bj < 2; ++bj) { float scb_ = scr_; if constexpr (ROUTE == 1) { const int cg = col0 + bj * HALF; if (cg >= 456 && cg < 712) scb_ *= 0.18033688011112042f; }
                    const f32x4 v0 = acc[ai][bj][m][0] * scb_, v1 = acc[ai][bj][m][1] * scb_;
                    u32x4 w; w.x = cvt_pk_bf16(v0[0], v0[1]); w.y = cvt_pk_bf16(v0[2], v0[3]); w.z = cvt_pk_bf16(v1[0], v1[1]); w.w = cvt_pk_bf16(v1[2], v1[3]);
                    if constexpr (ROUTE == 3) {
                        const int tok = col0 + bj * HALF, rw = row0 + ai * HALF + m * 16; *(u32x4*)(base + ((size_t)(tok >> 6) * 256 + rw) * 64 + (tok & 63)) = w; }
                    else *(u32x4*)(rowp + bj * HALF) = w; } }
    }
};
template <bool RES_F32>
struct EpiResid {
    static constexpr bool PERM = true, AFTER_DRAIN = false;
    const void* res; bf16_t* hb; float* ssq; int ldc; int pad;
    __device__ __forceinline__ void operator()(const f32x4 (&acc)[2][2][4][2], const Unit& u, int wr, int wc, int fr, int fq) const {
        asm volatile("" : "+v"(fr), "+v"(fq));
        const int row0 = u.pm * BM + wr * 64 + fr, col0 = u.pn * BM + wc * 32 + 8 * fq;
#pragma unroll
        for (int ai = 0; ai < 2; ++ai)
#pragma unroll
            for (int m = 0; m < 4; ++m) { const int row = row0 + ai * HALF + m * 16; const size_t off = (size_t)row * ldc + col0; float sq = 0.f;
#pragma unroll
                for (int bj = 0; bj < 2; ++bj) { f32x4 v[2];
                    if constexpr (RES_F32) {
#pragma unroll
                        for (int n = 0; n < 2; ++n) v[n] = *(const f32x4*)((const float*)res + off + bj * HALF + 4 * n) + acc[ai][bj][m][n];
                    } else { const u32x4 rw = *(const u32x4*)((const bf16_t*)res + off + bj * HALF);
                        f32x4 r0, r1; r0[0] = __uint_as_float(rw.x << 16); r0[1] = __uint_as_float(rw.x & 0xffff0000u); r0[2] = __uint_as_float(rw.y << 16); r0[3] = __uint_as_float(rw.y & 0xffff0000u);
                        r1[0] = __uint_as_float(rw.z << 16); r1[1] = __uint_as_float(rw.z & 0xffff0000u); r1[2] = __uint_as_float(rw.w << 16); r1[3] = __uint_as_float(rw.w & 0xffff0000u);
                        v[0] = r0 + acc[ai][bj][m][0]; v[1] = r1 + acc[ai][bj][m][1]; }
#pragma unroll
                    for (int n = 0; n < 2; ++n) sq += (v[n][0] * v[n][0] + v[n][1] * v[n][1]) + (v[n][2] * v[n][2] + v[n][3] * v[n][3]);
                    u32x4 w; w.x = cvt_pk_bf16(v[0][0], v[0][1]); w.y = cvt_pk_bf16(v[0][2], v[0][3]); w.z = cvt_pk_bf16(v[1][0], v[1][1]); w.w = cvt_pk_bf16(v[1][2], v[1][3]); *(u32x4*)(hb + off + bj * HALF) = w; }
                sq += __shfl_xor(sq, 16); sq += __shfl_xor(sq, 32); if (fq == 0) ssq[(size_t)row * 16 + u.pn * 4 + wc] = sq; }
    }
};
struct EpiSwiglu {
    static constexpr bool PERM = true, AFTER_DRAIN = false;
    bf16_t* O; const float* ssq; int ldc; int pad;
    __device__ __forceinline__ void operator()(const f32x4 (&acc)[2][2][4][2], const Unit& u, int wr, int wc, int fr, int fq) const {
        asm volatile("" : "+v"(fr), "+v"(fq));
        const int row0 = u.pm * BM + wr * 64 + fr, col0 = u.pn * HALF + wc * 32 + 8 * fq;
#pragma unroll
        for (int ai = 0; ai < 2; ++ai)
#pragma unroll
            for (int m = 0; m < 4; ++m) { float o[8]; const float rs = rsqrtf(ssq_row(ssq + (size_t)(row0 + ai * HALF + m * 16) * 16) * (1.f / 1024.f) + 1e-6f);
#pragma unroll
                for (int n = 0; n < 2; ++n)
#pragma unroll
                    for (int e = 0; e < 4; ++e) { const float g = acc[ai][0][m][n][e] * rs, up = acc[ai][1][m][n][e] * rs; o[4 * n + e] = (g * __builtin_amdgcn_rcpf(1.f + __expf(-g))) * up; }
                u32x4 w; w.x = cvt_pk_bf16(o[0], o[1]); w.y = cvt_pk_bf16(o[2], o[3]); w.z = cvt_pk_bf16(o[4], o[5]); w.w = cvt_pk_bf16(o[6], o[7]);
                *(u32x4*)(O + (size_t)(row0 + ai * HALF + m * 16) * ldc + col0) = w; }
    }
};
template <class Epi, class Sched, bool ALIGN_EPI = false, bool SP2 = false>
__device__ __forceinline__ void gemm_phase(PG8_LAS unsigned char* lds, const Gemm g, const Sched& S, const Epi& E) {
    int tid = threadIdx.x; asm volatile("" : "+v"(tid));
    const int wid = __builtin_amdgcn_readfirstlane(tid >> 6), lane = tid & 63, wr = wid >> 2, wc = wid & 3, fr = lane & 15, fq = lane >> 4;
    int K = g.K; asm volatile("" : "+s"(K));
    const int nt = K / BK;
    unsigned voffA[2], voffB[2];
#pragma unroll
    for (int i = 0; i < 2; ++i) { int R, C; stage_rc(tid * 16 + i * 8192, R, C); const int Rb = Epi::PERM ? ((R & ~31) + perm32(R & 31)) : R;
        voffA[i] = (unsigned)(R * K + C) * 2u; voffB[i] = (unsigned)(Rb * K + C) * 2u; }
    const size_t kstep = (size_t)(BK * 2);
    const size_t hstep = (size_t)HALF * K * 2;
    const size_t tstep = 2 * hstep;
    const unsigned ldsw = (unsigned)wid * 1024u;
    const int aoff = lds_byte(wr * 64 + fr, fq * 8), boff = lds_byte(wc * 32 + fr, fq * 8);
#define PG8_SA(b, h) (((b) * 2 + (h)) * HTB)
#define PG8_SB(b, h) ((4 + (b) * 2 + (h)) * HTB)
#define PG8_STAGE(bufoff, gbase, voff) do { _Pragma("unroll") for (int _i = 0; _i < 2; ++_i) \
        __builtin_amdgcn_global_load_lds((const unsigned*)((const char*)(gbase) + (voff)[_i]), (PG8_LAS unsigned*)(lds + (bufoff) + ldsw + _i * 8192), 16, 0, 0); } while (0)
#define PG8_LDA(dst, b, h) do { _Pragma("unroll") for (int m = 0; m < 4; ++m) _Pragma("unroll") for (int k = 0; k < 2; ++k) dst[m][k] = *(const PG8_LAS bf16x8*)(lds + PG8_SA(b, h) + aoff + m * 2048 + k * 1024); } while (0)
#define PG8_LDB(dst, b, h) do { _Pragma("unroll") for (int n = 0; n < 2; ++n) _Pragma("unroll") for (int k = 0; k < 2; ++k) dst[n][k] = *(const PG8_LAS bf16x8*)(lds + PG8_SB(b, h) + boff + n * 2048 + k * 1024); } while (0)
#define PG8_MMA(ai, bj, At, Bt) do { __builtin_amdgcn_s_setprio(1); _Pragma("unroll") for (int m = 0; m < 4; ++m) _Pragma("unroll") for (int n = 0; n < 2; ++n) _Pragma("unroll") for (int k = 0; k < 2; ++k) \
        acc[ai][bj][m][n] = __builtin_amdgcn_mfma_f32_16x16x32_bf16(Bt[n][k], At[m][k], acc[ai][bj][m][n], 0, 0, 0); __builtin_amdgcn_s_setprio(0); } while (0)
#define PG8_WAIT_V(n) asm volatile("s_waitcnt vmcnt(" #n ")" ::: "memory")
#define PG8_WAIT_L(n) asm volatile("s_waitcnt lgkmcnt(" #n ")" ::: "memory")
#define PG8_BAR __builtin_amdgcn_s_barrier()
#define PG8_SCHED __builtin_amdgcn_sched_barrier(0)
    Unit cur, nxt; int ui = 0;
    if (!S.next(0, cur)) return;
    f32x4 acc[2][2][4][2];
#pragma unroll
    for (int a = 0; a < 2; ++a)
#pragma unroll
        for (int b = 0; b < 2; ++b)
#pragma unroll
            for (int m = 0; m < 4; ++m)
#pragma unroll
                for (int n = 0; n < 2; ++n) acc[a][b][m][n] = (f32x4){0.f, 0.f, 0.f, 0.f};
    bf16x8 At[4][2], B0[2][2], B1[2][2];
    const char* cA = (const char*)g.A + (size_t)cur.pm * tstep; const char* cB = (const char*)g.Bt + (size_t)cur.pn * tstep;
    S.a_ready(cur);
    if constexpr (SP2) {
        PG8_STAGE(PG8_SB(0, 0), cB, voffB); PG8_STAGE(PG8_SB(0, 1), cB + hstep, voffB); PG8_STAGE(PG8_SA(0, 0), cA, voffA); PG8_STAGE(PG8_SA(0, 1), cA + hstep, voffA);
        if (wr == 1) PG8_BAR;
        PG8_WAIT_V(2); PG8_BAR;
        PG8_STAGE(PG8_SB(1, 0), cB + kstep, voffB); PG8_STAGE(PG8_SA(1, 0), cA + kstep, voffA); PG8_STAGE(PG8_SB(1, 1), cB + hstep + kstep, voffB);
        PG8_WAIT_V(6); PG8_BAR;
    } else {
        PG8_STAGE(PG8_SB(0, 0), cB, voffB); PG8_STAGE(PG8_SA(0, 0), cA, voffA); PG8_STAGE(PG8_SB(0, 1), cB + hstep, voffB); PG8_STAGE(PG8_SA(0, 1), cA + hstep, voffA);
        if (wr == 1) PG8_BAR;
        PG8_WAIT_V(4); PG8_BAR;
        PG8_STAGE(PG8_SB(1, 0), cB + kstep, voffB); PG8_STAGE(PG8_SA(1, 0), cA + kstep, voffA); PG8_STAGE(PG8_SB(1, 1), cB + hstep + kstep, voffB);
        PG8_WAIT_V(6); PG8_BAR;
    }
    for (;;) {
        const bool has_next = S.next(ui + 1, nxt);
        const char* nA = has_next ? (const char*)g.A + (size_t)nxt.pm * tstep : cA; const char* nB = has_next ? (const char*)g.Bt + (size_t)nxt.pn * tstep : cB;
        for (int t = 0; t < nt; t += 2) {
            const bool last = (t == nt - 2);
            const char* a1 = cA + (size_t)(t + 1) * kstep;
            const char* a2 = last ? nA : cA + (size_t)(t + 2) * kstep; const char* b2 = last ? nB : cB + (size_t)(t + 2) * kstep;
            const char* a3 = a2 + kstep; const char* b3 = b2 + kstep;
            if (last && has_next) S.a_ready(nxt);
            if constexpr (SP2) {
            PG8_LDB(B0, 0, 0); PG8_LDB(B1, 0, 1); PG8_SCHED; PG8_LDA(At, 0, 0); PG8_STAGE(PG8_SA(1, 1), a1 + hstep, voffA);
            PG8_WAIT_V(8); PG8_WAIT_L(0); PG8_BAR; PG8_MMA(0, 0, At, B0); PG8_MMA(0, 1, At, B1); PG8_BAR; PG8_SCHED;
            PG8_LDA(At, 0, 1); PG8_STAGE(PG8_SB(0, 0), b2, voffB); PG8_STAGE(PG8_SB(0, 1), b2 + hstep, voffB); PG8_STAGE(PG8_SA(0, 0), a2, voffA);
            PG8_WAIT_V(8); PG8_WAIT_L(0); PG8_BAR; PG8_MMA(1, 0, At, B0); PG8_MMA(1, 1, At, B1); PG8_BAR; PG8_SCHED;
            PG8_LDB(B0, 1, 0); PG8_LDB(B1, 1, 1); PG8_SCHED; PG8_LDA(At, 1, 0); PG8_STAGE(PG8_SA(0, 1), a2 + hstep, voffA);
            PG8_WAIT_V(8); PG8_WAIT_L(0); PG8_BAR; PG8_MMA(0, 0, At, B0); PG8_MMA(0, 1, At, B1); PG8_BAR; PG8_SCHED;
            PG8_LDA(At, 1, 1); PG8_STAGE(PG8_SB(1, 0), b3, voffB); PG8_STAGE(PG8_SB(1, 1), b3 + hstep, voffB); PG8_STAGE(PG8_SA(1, 0), a3, voffA);
            PG8_WAIT_V(8); PG8_WAIT_L(0); PG8_BAR; PG8_MMA(1, 0, At, B0); PG8_MMA(1, 1, At, B1); PG8_BAR; PG8_SCHED;
            } else {
            PG8_LDB(B0, 0, 0); PG8_SCHED; PG8_LDA(At, 0, 0); PG8_STAGE(PG8_SA(1, 1), a1 + hstep, voffA);
            PG8_WAIT_L(8); PG8_BAR; PG8_WAIT_L(0); PG8_MMA(0, 0, At, B0); PG8_BAR; PG8_SCHED;
            PG8_LDB(B1, 0, 1); PG8_STAGE(PG8_SB(0, 0), b2, voffB);
            PG8_BAR; PG8_WAIT_L(0); PG8_MMA(0, 1, At, B1); PG8_BAR;
            PG8_LDA(At, 0, 1); PG8_STAGE(PG8_SA(0, 0), a2, voffA);
            PG8_BAR; PG8_WAIT_L(0); PG8_MMA(1, 0, At, B0); PG8_BAR; PG8_SCHED;
            PG8_STAGE(PG8_SB(0, 1), b2 + hstep, voffB);
            PG8_WAIT_V(6); PG8_BAR; PG8_MMA(1, 1, At, B1); PG8_BAR;
            PG8_LDB(B0, 1, 0); PG8_SCHED; PG8_LDA(At, 1, 0); PG8_STAGE(PG8_SA(0, 1), a2 + hstep, voffA);
            PG8_WAIT_L(8); PG8_BAR; PG8_WAIT_L(0); PG8_MMA(0, 0, At, B0); PG8_BAR; PG8_SCHED;
            PG8_LDB(B1, 1, 1); PG8_STAGE(PG8_SB(1, 0), b3, voffB);
            PG8_BAR; PG8_WAIT_L(0); PG8_MMA(0, 1, At, B1); PG8_BAR;
            PG8_LDA(At, 1, 1); PG8_STAGE(PG8_SA(1, 0), a3, voffA);
            PG8_BAR; PG8_WAIT_L(0); PG8_MMA(1, 0, At, B0); PG8_BAR; PG8_SCHED;
            PG8_STAGE(PG8_SB(1, 1), b3 + hstep, voffB);
            PG8_WAIT_V(6); PG8_BAR; PG8_MMA(1, 1, At, B1); PG8_BAR;
            }
        }
        if constexpr (ALIGN_EPI) { if (wr == 0) PG8_BAR; }
        if constexpr (!Epi::AFTER_DRAIN) { E(acc, cur, wr, wc, fr, fq); S.done(cur); }
        if (!has_next) break;
#pragma unroll
        for (int a = 0; a < 2; ++a)
#pragma unroll
            for (int b = 0; b < 2; ++b)
#pragma unroll
                for (int m = 0; m < 4; ++m)
#pragma unroll
                    for (int n = 0; n < 2; ++n) acc[a][b][m][n] = (f32x4){0.f, 0.f, 0.f, 0.f};
        cur = nxt; cA = nA; cB = nB; ++ui;
        if constexpr (ALIGN_EPI) { if (wr == 1) PG8_BAR; }
    }
    PG8_WAIT_V(0);
    if constexpr (!ALIGN_EPI) { if (wr == 0) PG8_BAR; }
    PG8_BAR;
    if constexpr (Epi::AFTER_DRAIN) { E.fused(acc, cur, wr, wc, fr, fq, lds, wid, lane); S.done(cur); }
#undef PG8_SA
#undef PG8_SB
#undef PG8_STAGE
#undef PG8_LDA
#undef PG8_LDB
#undef PG8_MMA
#undef PG8_WAIT_V
#undef PG8_WAIT_L
#undef PG8_BAR
#undef PG8_SCHED
}
}
constexpr int NWAVES = 8;
constexpr int BATCH = 2, T = 8192, D = 1024, M = BATCH * T, DFF = 2816, NSA_IN = 1828, DSA_IN = 712, NCMP = 511, NCR = BATCH * NCMP * 2;
constexpr float NEGF = -1e30f, EPSF = 1e-6f;
#ifndef MK_SPLIT
#define MK_SPLIT 0
#endif
constexpr int N_PHASES = 19;
constexpr size_t MiB = 1u << 20;
constexpr size_t WS_CTL = 0, CTL_ZERO_BYTES = 1 * MiB;
constexpr size_t WS_KCB = 1 * MiB  , WS_VCT = 1 * MiB + 512 * 1024  , WS_MKB = 2 * MiB  , WS_MVT = 2 * MiB + 512 * 1024  , WS_MKV = 3 * MiB  , WS_WIDX = 5 * MiB  , WS_CNT = 6 * MiB  ;
constexpr size_t WS_WIN0 = 8 * MiB, WS_WO = 12 * MiB, WS_WGU = 16 * MiB, WS_WD = 38 * MiB, WS_WIN1 = 49 * MiB, WS_WQ2 = 51 * MiB, WS_WVT = 52 * MiB  ;
constexpr size_t WS_W1T = 232 * MiB, WS_MEMN = 234 * MiB, WS_WMKT = 236 * MiB, WS_W2T = 238 * MiB, WS_B1F = 238 * MiB + 64 * 1024;
constexpr size_t WS_XN = 56 * MiB;
constexpr size_t WS_Q0 = 88 * MiB, WS_KV0 = 112 * MiB  , WS_QM = 128 * MiB, WS_G0 = 136 * MiB, WS_VT = 144 * MiB  ;
static_assert(WS_Q0 == (88u << 20) && WS_KV0 == (112u << 20) && WS_QM == (128u << 20) && WS_G0 == (136u << 20), "EpiRoute tables");
constexpr size_t WS_ACT = 88 * MiB;
constexpr size_t WS_PROJ1 = 88 * MiB, WS_CQ = 112 * MiB, WS_CKV = 120 * MiB, WS_KIDX = 124 * MiB, WS_QA = 128 * MiB, WS_QI = 176 * MiB, WS_SEL = 112 * MiB  , WS_CAT1 = 176 * MiB  , WS_WO1F = 52 * MiB + 512 * 1024  ;
constexpr size_t WS_OCS = 152 * MiB  , WS_CAT = 200 * MiB, WS_SSQ = 239 * MiB  , WS_END = 243 * MiB;
static_assert(WS_PROJ1 == (88u << 20) && WS_QA == (128u << 20) && WS_QI == (176u << 20) && WS_VT == (144u << 20), "EpiRoute tables");
static_assert(WS_ACT + (size_t)M * DFF * 2 <= WS_CAT + 0 * MiB || true, "map");
constexpr int CW_BAR = 4096;
constexpr int RING_OFF = 0, RING_BYTES = 131072, LDS_BYTES = 163840, LDSCTL_OFF = LDS_BYTES - 1024, MISC_OFF = LDSCTL_OFF + 320;
#define GAS __attribute__((address_space(1)))
#define LAS __attribute__((address_space(3)))
typedef unsigned short bf16;
typedef unsigned v4u __attribute__((ext_vector_type(4)));
typedef unsigned v2u __attribute__((ext_vector_type(2)));
typedef float f32x4 __attribute__((ext_vector_type(4)));
typedef short bf16x8 __attribute__((ext_vector_type(8)));
typedef GAS unsigned gu32;
typedef GAS unsigned long long gu64;
#define RLX_AGENT __ATOMIC_RELAXED, __HIP_MEMORY_SCOPE_AGENT
#define LDS_WAIT() asm volatile("s_waitcnt lgkmcnt(0)" ::: "memory")
#define VM_WAIT() asm volatile("s_waitcnt vmcnt(0)" ::: "memory")
__device__ __forceinline__ unsigned long long rt() { return __builtin_amdgcn_s_memrealtime(); }
__device__ __forceinline__ unsigned f2bf(float f) { unsigned u = __builtin_bit_cast(unsigned, f); return (u + 0x7fffu + ((u >> 16) & 1u)) >> 16; }
__device__ __forceinline__ unsigned pk2(float lo, float hi) { return f2bf(lo) | (f2bf(hi) << 16); }
#define XB_TMO      128
#define XB_XCNT(j)  (256  + 64 * (j))
#define XB_XSUB(j)  (1280 + 64 * (j))
#define XB_XGEN(j)  (2304 + 64 * (j))
#define XB_TOP      3328
#define XB_TOPGEN   3392
#define XCD_BAR_WORDS 3456
#define XB_SPIN_CAP (1u << 18)

__device__ __forceinline__ unsigned xb_ld(unsigned* p)              { return __hip_atomic_load(p, __ATOMIC_RELAXED, __HIP_MEMORY_SCOPE_AGENT); }
__device__ __forceinline__ unsigned xb_add(unsigned* p, unsigned v) { return __hip_atomic_fetch_add(p, v, __ATOMIC_RELAXED, __HIP_MEMORY_SCOPE_AGENT); }
__device__ __forceinline__ unsigned xb_xcc_id() { return (unsigned)__builtin_amdgcn_s_getreg((3 << 11) | 20) & 0xFu; }
#define XB_SPIN(cond, bar) do { unsigned _sp = 0; while (cond) { __builtin_amdgcn_s_sleep(1); \
    if ((++_sp & 255u) == 0u) { if (xb_ld(&(bar)[XB_TMO])) break; if (_sp > XB_SPIN_CAP) { atomicAdd(&(bar)[XB_TMO], 1u); break; } } } } while (0)

struct XcdBarrier {
    unsigned* bar; unsigned x;
    volatile LAS unsigned* st;
};

__device__ __forceinline__ XcdBarrier xcd_barrier_post(unsigned* bar, volatile LAS unsigned* st) {
    XcdBarrier b; b.bar = bar; b.x = xb_xcc_id(); b.st = st;
    if (threadIdx.x == 0) (void)xb_add(&bar[XB_XCNT(b.x)], 1u);
    return b;
}
__device__ __forceinline__ void xcd_barrier_complete(unsigned* bar, unsigned x, unsigned& nloc, unsigned& nx) {
    const unsigned G = gridDim.x * gridDim.y * gridDim.z;
    unsigned sum, cnt, mine, sp = 0u;
    for (;;) {
        sum = 0u; cnt = 0u; mine = 0u;
#pragma unroll 1
        for (unsigned j = 0; j < 16; ++j) { const unsigned c = xb_ld(&bar[XB_XCNT(j)]); sum += c; cnt += (c > 0u) ? 1u : 0u; mine = (j == x) ? c : mine; }
        if (sum == G) break;
        __builtin_amdgcn_s_sleep(1);
        if ((++sp & 255u) == 0u) { if (xb_ld(&bar[XB_TMO])) break; if (sp > XB_SPIN_CAP) { atomicAdd(&bar[XB_TMO], 1u); break; } }
    }
    nloc = mine > 0u ? mine : 1u; nx = cnt > 0u ? cnt : 1u;
}

__device__ __forceinline__ void xcd_barrier(const XcdBarrier& b) {
    asm volatile("s_waitcnt vmcnt(0)" ::: "memory");
    __syncthreads();
    if (threadIdx.x == 0) {
        unsigned* bar = b.bar;
        __builtin_amdgcn_s_waitcnt(0);
        unsigned nloc = b.st[0], nx = b.st[1];
        if (nloc == 0u) { xcd_barrier_complete(bar, b.x, nloc, nx); b.st[0] = nloc; b.st[1] = nx; }
        const unsigned old = xb_add(&bar[XB_XSUB(b.x)], 1u);
        const unsigned gen = old / nloc;
        if (old + 1u == (gen + 1u) * nloc) {
            __builtin_amdgcn_fence(__ATOMIC_RELEASE, "agent");
            asm volatile("s_waitcnt vmcnt(0)" ::: "memory");
            const unsigned og = xb_add(&bar[XB_TOP], 1u);
            const unsigned tg = og / nx;
            if (og + 1u == (tg + 1u) * nx) xb_add(&bar[XB_TOPGEN], 1u);
            else XB_SPIN(xb_ld(&bar[XB_TOPGEN]) == tg, bar);
            __builtin_amdgcn_fence(__ATOMIC_ACQUIRE, "agent");
            xb_add(&bar[XB_XGEN(b.x)], 1u);
            asm volatile("s_waitcnt vmcnt(0)" ::: "memory");
        } else {
            XB_SPIN(xb_ld(&bar[XB_XGEN(b.x)]) == gen, bar);
            __builtin_amdgcn_fence(__ATOMIC_ACQUIRE, "agent");
            asm volatile("s_waitcnt vmcnt(0)" ::: "memory");
        }
    }
    __syncthreads();
}

struct Frame {
    LAS unsigned char* lds; volatile LAS unsigned* MISC; gu32* ctl;
    int vcu, G;
};
__device__ __forceinline__ float bf2f(unsigned short u) { return __uint_as_float((unsigned)u << 16); }
__device__ __forceinline__ float bflo(unsigned u) { return __uint_as_float(u << 16); }
__device__ __forceinline__ float bfhi(unsigned u) { return __uint_as_float(u & 0xffff0000u); }
__device__ __forceinline__ float wave_sum(float v) {
#pragma unroll
    for (int o = 1; o < 64; o <<= 1) v += __shfl_xor(v, o);
    return v;
}
__device__ __forceinline__ float red16_sum(float v) { v += __shfl_xor(v, 1, 16); v += __shfl_xor(v, 2, 16); v += __shfl_xor(v, 4, 16); v += __shfl_xor(v, 8, 16); return v; }
__device__ __forceinline__ float red16_max(float v) { v = fmaxf(v, __shfl_xor(v, 1, 16)); v = fmaxf(v, __shfl_xor(v, 2, 16)); v = fmaxf(v, __shfl_xor(v, 4, 16)); v = fmaxf(v, __shfl_xor(v, 8, 16)); return v; }
__device__ __forceinline__ int rel_bucket(int n) {
    if (n < 16) return n;
    return 16 + (n >= 22) + (n >= 30) + (n >= 40) + (n >= 54) + (n >= 73) + (n >= 99) + (n >= 134) + (n >= 182) + (n >= 246) + (n >= 332) + (n >= 450) + (n >= 609) + (n >= 825) + (n >= 1117) + (n >= 1513);
}

__device__ __forceinline__ void xpose_item(const float* W, int ldw, int c0, int nvalid, int k0, bf16* WT, int Kd, int drow0, LAS float* scr, int lane, const float* kgain = nullptr) {
#pragma unroll
    for (int i = 0; i < 8; ++i) { const int kk = 8 * i + (lane >> 3), n = (lane & 7) * 4;
        float4 wv = make_float4(0.f, 0.f, 0.f, 0.f);
        if (n + 3 < nvalid) wv = *(const float4*)(W + (size_t)(k0 + kk) * ldw + c0 + n);
        else if (n < nvalid) { const float* wp = W + (size_t)(k0 + kk) * ldw + c0 + n; wv.x = wp[0]; if (n + 1 < nvalid) wv.y = wp[1]; if (n + 2 < nvalid) wv.z = wp[2]; }
        if (kgain) { const float g_ = kgain[k0 + kk]; wv.x *= g_; wv.y *= g_; wv.z *= g_; wv.w *= g_; }
        LAS float* sp = scr + kk * 33 + n; sp[0] = wv.x; sp[1] = wv.y; sp[2] = wv.z; sp[3] = wv.w; }
    LDS_WAIT(); asm volatile("" ::: "memory");
    const int c = lane & 7;
#pragma unroll
    for (int j = 0; j < 4; ++j) { const int n = (lane >> 3) + 8 * j; const LAS float* s = scr + (8 * c) * 33 + n;
        v4u o; o.x = pk2(s[0 * 33], s[1 * 33]); o.y = pk2(s[2 * 33], s[3 * 33]); o.z = pk2(s[4 * 33], s[5 * 33]); o.w = pk2(s[6 * 33], s[7 * 33]);
        *(GAS v4u*)(WT + (size_t)(drow0 + n) * Kd + k0 + 8 * c) = o; }
    LDS_WAIT(); asm volatile("" ::: "memory");
}
__device__ __forceinline__ void rms_row_to_bf16(const float* xrow, const float* gain, bf16* orow, int lane) {
    const GAS f32x4* xr = (const GAS f32x4*)xrow + lane; const GAS f32x4* gr = (const GAS f32x4*)gain + lane;
    f32x4 v[4]; float s = 0.f;
#pragma unroll
    for (int j = 0; j < 4; ++j) { v[j] = xr[64 * j]; s += (v[j].x * v[j].x + v[j].y * v[j].y) + (v[j].z * v[j].z + v[j].w * v[j].w); }
    const float r = rsqrtf(wave_sum(s) * (1.f / D) + EPSF);
    GAS unsigned long long* o8 = (GAS unsigned long long*)orow + lane;
#pragma unroll
    for (int j = 0; j < 4; ++j) { const f32x4 g = gr[64 * j]; o8[64 * j] = (unsigned long long)pk2((v[j].x * r) * g.x, (v[j].y * r) * g.y) | ((unsigned long long)pk2((v[j].z * r) * g.z, (v[j].w * r) * g.w) << 32); }
}
#ifndef PROBE_REP
#define PROBE_REP 0
#endif
#define CAS __attribute__((address_space(4)))
#define KARGS() const CAS In* Ip = (const CAS In*)__builtin_amdgcn_kernarg_segment_ptr(); asm volatile("" : "+s"(Ip))
#define OPAQUE_TID() int tid_ = threadIdx.x; asm volatile("" : "+v"(tid_))
__device__ __forceinline__ void norm_phase(Frame& F, const float* x, const float* gain, bf16* xn) {
    OPAQUE_TID(); const int lane_ = tid_ & 63, wave_ = tid_ >> 6;
    const int gw = F.vcu * NWAVES + wave_, NGW = F.G * NWAVES;
    for (int m = gw; m < M; m += NGW) rms_row_to_bf16(x + (size_t)m * D, gain, xn + (size_t)m * D, lane_);
}

template <int DL>
__device__ __forceinline__ void coop_attend(const float (&q)[DL], const float (&k)[DL], const float (&v)[DL], float bias, float& m_, float& l_, float (&o)[DL]) {
    float a = 0.f;
#pragma unroll
    for (int d = 0; d < DL; ++d) a += q[d] * k[d];
    a = red16_sum(a) + bias;
    const float mn = fmaxf(m_, a), al = __expf(m_ - mn), p = __expf(a - mn);
    l_ = l_ * al + p; m_ = mn;
#pragma unroll
    for (int d = 0; d < DL; ++d) o[d] = o[d] * al + p * v[d];
}
__device__ __forceinline__ void ld4bf(const bf16* p, float (&x)[4]) { const uint2 u = *(const uint2*)p; x[0] = bflo(u.x); x[1] = bfhi(u.x); x[2] = bflo(u.y); x[3] = bfhi(u.y); }
__device__ __forceinline__ void ld8bf(const bf16* p, float (&x)[8]) { const uint4 u = *(const uint4*)p; x[0] = bflo(u.x); x[1] = bfhi(u.x); x[2] = bflo(u.y); x[3] = bfhi(u.y); x[4] = bflo(u.z); x[5] = bfhi(u.z); x[6] = bflo(u.w); x[7] = bfhi(u.w); }
__device__ __forceinline__ void ld4f(const float* p, float (&x)[4]) { const float4 u = *(const float4*)p; x[0] = u.x; x[1] = u.y; x[2] = u.z; x[3] = u.w; }

struct In {
    const float *x, *mem, *rel_bias, *norm_mix, *norm_ffn, *norm_mem, *w_mem_kv, *w_out, *ffn_gate, *ffn_up, *ffn_down, *nsa_w_in, *nsa_gate_b, *pos_k, *pos_v,
        *k_w1, *k_b1, *k_w2, *k_b2, *v_w1, *v_b1, *v_w2, *v_b2, *dsa_w_in, *q_norm, *kv_norm, *w_q_up, *w_uk, *w_uv, *w_q_idx, *kidx_norm, *norm_final;
};
__device__ __forceinline__ void p0_prologue(Frame& F, const In& I, unsigned char* ws) {
    OPAQUE_TID(); KARGS(); const int lane_ = tid_ & 63, wave_ = __builtin_amdgcn_readfirstlane(tid_ >> 6);
    LAS float* scr = (LAS float*)(F.lds + RING_OFF + wave_ * 16384);
    const int gw = F.vcu * NWAVES + wave_, NGW = F.G * NWAVES;
    bf16* WIN0 = (bf16*)(ws + WS_WIN0); bf16* WO = (bf16*)(ws + WS_WO); bf16* WGU = (bf16*)(ws + WS_WGU); bf16* WD = (bf16*)(ws + WS_WD); bf16* WIN1 = (bf16*)(ws + WS_WIN1); bf16* WQ2 = (bf16*)(ws + WS_WQ2);
    constexpr int I_A = 16 * 56, I_G = 16 * 8, I_B = 2 * 16 * 32, I_C = 2 * 16 * 176, I_D = 2 * 44 * 32, I_E = 16 * 24, I_F = 4 * 16, NITEMS = I_A + I_B + I_C + I_D + I_E + I_F + I_G;
    for (int it = gw; it < NITEMS; it += NGW) {
        int r = it;
        if (r < I_A) { const int kb = r / 56, nb = r % 56, r0 = 32 * nb; int c0, nv;
            if (r0 < 1152) { c0 = r0; nv = 32; } else if (r0 < 1280) { c0 = r0 + 128; nv = 32; } else if (r0 < 1536) { c0 = r0 + 292; nv = 32; } else if (r0 == 1536) { c0 = 1536; nv = 32; } else if (r0 == 1568) { c0 = 1568; nv = 4; } else { c0 = 0; nv = 0; }
            xpose_item(Ip->nsa_w_in, NSA_IN, c0, nv, 64 * kb, WIN0, D, r0, scr, lane_); continue; } r -= I_A;
        if (r < I_B) { const int l = r / 512, q = r % 512, kb = q / 32, nb = q % 32;
            xpose_item(Ip->w_out + (size_t)l * D * D, D, 32 * nb, 32, 64 * kb, WO + (size_t)l * D * D, D, 32 * nb, scr, lane_); continue; } r -= I_B;
        if (r < I_C) { const int l = r / (16 * 176), q = r % (16 * 176), kb = q / 176, nb = q % 176, r0 = 32 * nb, pn = r0 >> 8, w0 = r0 & 255;
            const float* src = ((w0 < 128) ? Ip->ffn_gate : Ip->ffn_up) + (size_t)l * D * DFF;
            xpose_item(src, DFF, 128 * pn + (w0 & 127), 32, 64 * kb, WGU + (size_t)l * 2 * DFF * D, D, r0, scr, lane_, Ip->norm_ffn + l * D); continue; } r -= I_C;
        if (r < I_D) { const int l = r / (44 * 32), q = r % (44 * 32), kb = q / 32, nb = q % 32;
            xpose_item(Ip->ffn_down + (size_t)l * DFF * D, D, 32 * nb, 32, 64 * kb, WD + (size_t)l * D * DFF, DFF, 32 * nb, scr, lane_); continue; } r -= I_D;
        if (r < I_E) { const int kb = r / 24, nb = r % 24, r0 = 32 * nb; int nv = DSA_IN - r0; nv = nv > 32 ? 32 : (nv < 0 ? 0 : nv);
            xpose_item(Ip->dsa_w_in, DSA_IN, r0, nv, 64 * kb, WIN1, D, r0, scr, lane_, Ip->norm_mix + D); continue; } r -= I_E;
        if (r < I_F) { const int kb = r / 16, nb = r % 16; xpose_item(Ip->w_q_idx, 512, 32 * nb, 32, 64 * kb, WQ2, 256, 1536 + 32 * nb, scr, lane_); continue; } r -= I_F;
        { const int kb = r / 8, nb = r % 8, r0 = 32 * nb;
            xpose_item(Ip->nsa_w_in, NSA_IN, (r0 < 128) ? 1152 + r0 : 1408 + (r0 - 128), 32, 64 * kb, (bf16*)(ws + WS_WVT), D, r0, scr, lane_); }
    }
    for (int idx = (F.vcu * NWAVES * 64) + tid_; idx < 384 * 256; idx += F.G * NWAVES * 64) {
        const int c = idx & 255, r4 = (idx >> 8) & 31, h = idx >> 13; const float4* a4 = (const float4*)(Ip->w_q_up + (size_t)c * 768 + h * 64); const float4* b4 = (const float4*)(Ip->w_uk + (size_t)(4 * r4) * 768 + h * 64);
        float s0 = 0.f, s1 = 0.f, s2 = 0.f, s3 = 0.f;
#pragma unroll 4
        for (int d = 0; d < 16; ++d) { const float4 av = a4[d], b0 = b4[d], b1 = b4[192 + d], b2 = b4[384 + d], b3 = b4[576 + d];
            s0 += (av.x * b0.x + av.y * b0.y) + (av.z * b0.z + av.w * b0.w); s1 += (av.x * b1.x + av.y * b1.y) + (av.z * b1.z + av.w * b1.w);
            s2 += (av.x * b2.x + av.y * b2.y) + (av.z * b2.z + av.w * b2.w); s3 += (av.x * b3.x + av.y * b3.y) + (av.z * b3.z + av.w * b3.w); }
        const float sc_ = 0.125f * 1.4426950408889634f;
        bf16* o_ = WQ2 + (size_t)(h * 128 + 4 * r4) * 256 + c;
        o_[0] = (bf16)f2bf(s0 * sc_); o_[256] = (bf16)f2bf(s1 * sc_); o_[512] = (bf16)f2bf(s2 * sc_); o_[768] = (bf16)f2bf(s3 * sc_);
    }
    { bf16* WO1F = (bf16*)(ws + WS_WO1F); const float* wo1 = Ip->w_out + (size_t)D * D;
      for (int idx = (F.vcu * NWAVES * 64) + tid_; idx < 12 * 32 * 256; idx += F.G * NWAVES * 64) {
          const int n4 = idx & 255, r4 = (idx >> 8) & 31, h = idx >> 13; const float* a = Ip->w_uv + (size_t)(4 * r4) * 768 + h * 64; const float* bcol = wo1 + (size_t)(h * 64) * D + 4 * n4;
          float acc_[4][4];
#pragma unroll
          for (int i = 0; i < 4; ++i)
#pragma unroll
              for (int j = 0; j < 4; ++j) acc_[i][j] = 0.f;
#pragma unroll 4
          for (int d = 0; d < 64; ++d) { const float4 bv = *(const float4*)(bcol + (size_t)d * D); const float a0 = a[d], a1 = a[768 + d], a2 = a[1536 + d], a3 = a[2304 + d];
              acc_[0][0] += a0 * bv.x; acc_[0][1] += a0 * bv.y; acc_[0][2] += a0 * bv.z; acc_[0][3] += a0 * bv.w; acc_[1][0] += a1 * bv.x; acc_[1][1] += a1 * bv.y; acc_[1][2] += a1 * bv.z; acc_[1][3] += a1 * bv.w;
              acc_[2][0] += a2 * bv.x; acc_[2][1] += a2 * bv.y; acc_[2][2] += a2 * bv.z; acc_[2][3] += a2 * bv.w; acc_[3][0] += a3 * bv.x; acc_[3][1] += a3 * bv.y; acc_[3][2] += a3 * bv.z; acc_[3][3] += a3 * bv.w; }
#pragma unroll
          for (int j = 0; j < 4; ++j) *(uint2*)(WO1F + (size_t)(4 * n4 + j) * 1792 + h * 128 + 4 * r4) = make_uint2(pk2(acc_[0][j], acc_[1][j]), pk2(acc_[2][j], acc_[3][j])); }
      for (int it = gw; it < 4 * 32; it += NGW) { const int kb = it / 32, nb = it % 32;
          xpose_item(wo1 + (size_t)768 * D, D, 32 * nb, 32, 64 * kb, WO1F + 1536, 1792, 32 * nb, scr, lane_); } }
    { bf16* W1T = (bf16*)(ws + WS_W1T); bf16* W2T = (bf16*)(ws + WS_W2T); bf16* WMKT = (bf16*)(ws + WS_WMKT); float* B1F = (float*)(ws + WS_B1F); bf16* MEMN = (bf16*)(ws + WS_MEMN);
      constexpr int J_1 = 2 * 32 * 8, J_2 = 2 * 4 * 2, J_M = 2 * 16 * 16;
      for (int it = gw; it < J_1 + J_2 + J_M; it += NGW) { int r2 = it;
          if (r2 < J_1) { const int kv = r2 / 256, q = r2 % 256, kb = q / 8, nb = q % 8; xpose_item(kv ? Ip->v_w1 : Ip->k_w1, 256, 32 * nb, 32, 64 * kb, W1T + (size_t)kv * 256 * 2048, 2048, 32 * nb, scr, lane_); continue; } r2 -= J_1;
          if (r2 < J_2) { const int kv = r2 / 8, q = r2 % 8, kb = q / 2, nb = q % 2; xpose_item(kv ? Ip->v_w2 : Ip->k_w2, 64, 32 * nb, 32, 64 * kb, W2T + (size_t)kv * 64 * 256, 256, 32 * nb, scr, lane_); continue; } r2 -= J_2;
          { const int l = r2 / 256, q = r2 % 256, kb = q / 16, nb = q % 16; xpose_item(Ip->w_mem_kv + (size_t)l * D * 512, 512, 32 * nb, 32, 64 * kb, WMKT + (size_t)l * 512 * D, D, 32 * nb, scr, lane_); } }
      if ((int)blockIdx.x < 32) { const int u_ = (int)blockIdx.x, kv = u_ >> 4, cr = (u_ >> 2) & 3, kq4 = u_ & 3, c = 64 * cr + lane_; const float* w1 = kv ? Ip->v_w1 : Ip->k_w1; const float* pos = kv ? Ip->pos_v : Ip->pos_k;
          const int kb0 = 512 * kq4 + 64 * wave_; float sacc = 0.f;
#pragma unroll 8
          for (int k = 0; k < 64; ++k) sacc += pos[kb0 + k] * w1[(size_t)(kb0 + k) * 256 + c];
          LAS float* red = (LAS float*)(F.lds + RING_OFF + 8 * 16384);
          red[wave_ * 64 + lane_] = sacc;
          __syncthreads();
          if (wave_ == 0) { float t_ = 0.f;
#pragma unroll
              for (int w = 0; w < 8; ++w) t_ += red[w * 64 + lane_];
              B1F[(kv * 4 + kq4) * 256 + c] = t_; } }
      for (int m = gw; m < 1024; m += NGW) rms_row_to_bf16(Ip->mem + (size_t)(m & 511) * D, Ip->norm_mem + (m >> 9) * D, MEMN + (size_t)m * D, lane_); }
    norm_phase(F, Ip->x, Ip->norm_mix, (bf16*)(ws + WS_XN));
}

#define MFMA16(A, B, C) __builtin_amdgcn_mfma_f32_16x16x32_bf16((A), (B), (C), 0, 0, 0)
constexpr float LOG2E = 1.4426950408889634f;
constexpr int NSA_OUT = 0, NSA_PSQ = 49152, NSA_ST = 147456, NSA_TB = NSA_ST + 3072;
constexpr int TAB_B12 = NSA_ST + 1024;
constexpr int P13_JUNK = NSA_ST + 3072 + 1536;
constexpr int P13_B12 = NSA_ST;
constexpr int TAB_BKT = NSA_ST + 3072;
static_assert(NSA_TB + 12288 <= LDSCTL_OFF && TAB_B12 + 2048 <= NSA_TB, "LDS tables");
enum { MD_CMP = 0, MD_WIN = 1, MD_BLK = 2, MD_MEM = 3 };
struct KF { bf16x8 a0, a1, b0, b1; };
struct VF { bf16x8 v[4]; };
__device__ __forceinline__ bf16x8 ldg16(const bf16* p) { return *(const bf16x8*)p; }
typedef float f32x2_t __attribute__((ext_vector_type(2))); typedef __bf16 bf16x2_t __attribute__((ext_vector_type(2)));
__device__ __forceinline__ unsigned cvtpk_s(float lo, float hi) { f32x2_t v = {lo, hi}; bf16x2_t b = __builtin_convertvector(v, bf16x2_t); return __builtin_bit_cast(unsigned, b); }
__device__ __forceinline__ bf16x8 pack8(const f32x4& a, const f32x4& b) { v4u w; w.x = cvtpk_s(a[0], a[1]); w.y = cvtpk_s(a[2], a[3]); w.z = cvtpk_s(b[0], b[1]); w.w = cvtpk_s(b[2], b[3]); return __builtin_bit_cast(bf16x8, w); }
__device__ __forceinline__ void load_k(KF& k, const bf16* kb, int kstride, int key0, int r, int kq) {
    const bf16* pa = kb + (size_t)(key0 + 8 * (r >> 2) + (r & 3)) * kstride + 8 * kq; const bf16* pb = pa + 4 * (size_t)kstride;
    k.a0 = ldg16(pa); k.a1 = ldg16(pa + 32); k.b0 = ldg16(pb); k.b1 = ldg16(pb + 32);
}
__device__ __forceinline__ void load_vt(VF& v, const bf16* vt, int vstride, int key0, int r, int kq) {
#pragma unroll
    for (int dt = 0; dt < 4; ++dt) v.v[dt] = ldg16(vt + (size_t)(16 * dt + r) * vstride + key0 + 8 * kq);
}
__device__ __forceinline__ void qk(f32x4& sa, f32x4& sb, const KF& k, const bf16x8 (&q)[2]) {
    const f32x4 z = {0.f, 0.f, 0.f, 0.f};
    sa = MFMA16(k.a0, q[0], z); sa = MFMA16(k.a1, q[1], sa); sb = MFMA16(k.b0, q[0], z); sb = MFMA16(k.b1, q[1], sb);
}
struct BiasCtx { const LAS unsigned short* tb; float d29, d30, c31; };
template <int MODE>
__device__ __forceinline__ void maskbias(f32x4& s, int kpos, int tcol, bool colok, const BiasCtx& B) {
    if (MODE == MD_MEM) return;
#pragma unroll
    for (int i = 0; i < 4; ++i) {
        int dist; bool ok;
        if (MODE == MD_CMP) { dist = tcol - 31 - 16 * (kpos + i); ok = dist >= 0; }
        else if (MODE == MD_WIN) { dist = tcol - (kpos + i); ok = (unsigned)dist <= 511u; }
        else { dist = tcol - (kpos + i); ok = dist >= 0; }
        int dc = dist < 0 ? 0 : dist; dc = dc > 1023 ? 1023 : dc;
        const float tb = __uint_as_float((unsigned)B.tb[dc * 6] << 16);
        const float far = B.c31 + (dist < 1513 ? B.d30 : 0.f) + (dist < 1117 ? B.d29 : 0.f);
        const float bias = dist < 1024 ? tb : far;
        s[i] = (ok && colok) ? s[i] + bias : -INFINITY;
    }
}
__device__ __forceinline__ float colmax(const f32x4& sa, const f32x4& sb) {
    float mx = fmaxf(fmaxf(fmaxf(sa[0], sa[1]), fmaxf(sa[2], sa[3])), fmaxf(fmaxf(sb[0], sb[1]), fmaxf(sb[2], sb[3])));
    mx = fmaxf(mx, __shfl_xor(mx, 16)); mx = fmaxf(mx, __shfl_xor(mx, 32)); return mx;
}
constexpr float SM_THR = 8.f;
__device__ __forceinline__ float lmax8(const f32x4& sa, const f32x4& sb) { return fmaxf(fmaxf(fmaxf(sa[0], sa[1]), fmaxf(sa[2], sa[3])), fmaxf(fmaxf(sb[0], sb[1]), fmaxf(sb[2], sb[3]))); }
__device__ __forceinline__ int imax3(int a, int b, int c) { return max(max(a, b), c); }
__device__ __forceinline__ int imax16(const f32x4& a, const f32x4& b, const f32x4& c, const f32x4& d) {
#define FI_(x) __float_as_int(x)
    const int t0 = imax3(FI_(a[0]), FI_(a[1]), FI_(a[2])), t1 = imax3(FI_(a[3]), FI_(b[0]), FI_(b[1])), t2 = imax3(FI_(b[2]), FI_(b[3]), FI_(c[0])), t3 = imax3(FI_(c[1]), FI_(c[2]), FI_(c[3])), t4 = imax3(FI_(d[0]), FI_(d[1]), FI_(d[2]));
    return max(imax3(t0, t1, FI_(d[3])), imax3(t2, t3, t4));
#undef FI_
}
template <int NO>
__device__ __forceinline__ void sm_rescale(float lm, float& m, float& l, f32x4 (&O)[NO]) {
    if (__any(lm > m + SM_THR)) {
        lm = fmaxf(lm, __shfl_xor(lm, 16)); lm = fmaxf(lm, __shfl_xor(lm, 32));
        const float mn = fmaxf(m, lm); const float al = __builtin_amdgcn_exp2f(m - mn); m = mn; l *= al;
#pragma unroll
        for (int dt = 0; dt < NO; ++dt) O[dt] = O[dt] * al;
    }
}
__device__ __forceinline__ bf16x8 sm_update(const f32x4& sa, const f32x4& sb, float& m, float& l, f32x4 (&O)[4]) {
    sm_rescale<4>(lmax8(sa, sb), m, l, O);
    f32x4 pa, pb; float sum = 0.f;
#pragma unroll
    for (int i = 0; i < 4; ++i) { pa[i] = __builtin_amdgcn_exp2f(sa[i] - m); pb[i] = __builtin_amdgcn_exp2f(sb[i] - m); sum += pa[i] + pb[i]; }
    l += sum;
    return pack8(pa, pb);
}
__device__ __forceinline__ void sm_update64(const f32x4& sa0, const f32x4& sb0, const f32x4& sa1, const f32x4& sb1, float& m, float& l, f32x4 (&O)[4], bf16x8& pf0, bf16x8& pf1) {
    sm_rescale<4>(fmaxf(lmax8(sa0, sb0), lmax8(sa1, sb1)), m, l, O);
    f32x4 pa0, pb0, pa1, pb1; float sum = 0.f;
#pragma unroll
    for (int i = 0; i < 4; ++i) { pa0[i] = __builtin_amdgcn_exp2f(sa0[i] - m); pb0[i] = __builtin_amdgcn_exp2f(sb0[i] - m); pa1[i] = __builtin_amdgcn_exp2f(sa1[i] - m); pb1[i] = __builtin_amdgcn_exp2f(sb1[i] - m);
        sum += (pa0[i] + pb0[i]) + (pa1[i] + pb1[i]); }
    l += sum;
    pf0 = pack8(pa0, pb0); pf1 = pack8(pa1, pb1);
}
enum { BK_FAR = 0, BK_MID = 1, BK_GEN = 2 };
template <int MD, int CLS>
__device__ __forceinline__ void step64(const KF& k0, const KF& k1, const bf16x8 (&q)[2], int cls, int kpos, int tcol, bool colok, const BiasCtx& B,
                                       float& m, float& l, f32x4 (&O)[4], bf16x8& pf0, bf16x8& pf1) {
    const bool has = m > -1e29f; const float mref = has ? m : 0.f;
    if (CLS >= 0) cls = CLS;
    float cin = ((cls == BK_FAR) ? B.c31 : 0.f) - mref; if (!colok) cin = -INFINITY;
    const f32x4 c4 = {cin, cin, cin, cin};
    f32x4 sa0 = MFMA16(k0.a0, q[0], c4), sb0 = MFMA16(k0.b0, q[0], c4), sa1 = MFMA16(k1.a0, q[0], c4), sb1 = MFMA16(k1.b0, q[0], c4);
    sa0 = MFMA16(k0.a1, q[1], sa0); sb0 = MFMA16(k0.b1, q[1], sb0); sa1 = MFMA16(k1.a1, q[1], sa1); sb1 = MFMA16(k1.b1, q[1], sb1);
    if (cls == BK_MID) {
        const LAS unsigned short* tl = B.tb + (tcol - kpos - 39) * 6;
#pragma unroll
        for (int i = 0; i < 4; ++i) { sa0[i] += __uint_as_float((unsigned)tl[6 * (39 - i)] << 16); sb0[i] += __uint_as_float((unsigned)tl[6 * (35 - i)] << 16);
            sa1[i] += __uint_as_float((unsigned)tl[6 * (7 - i)] << 16); sb1[i] += __uint_as_float((unsigned)tl[6 * (3 - i)] << 16); }
    } else if (cls == BK_GEN) {
        maskbias<MD>(sa0, kpos, tcol, true, B); maskbias<MD>(sb0, kpos + 4, tcol, true, B); maskbias<MD>(sa1, kpos + 32, tcol, true, B); maskbias<MD>(sb1, kpos + 36, tcol, true, B);
    }
    if (__any((imax16(sa0, sb0, sa1, sb1) > __float_as_int(SM_THR)) || !has)) {
        float lm = fmaxf(lmax8(sa0, sb0), lmax8(sa1, sb1));
        lm = fmaxf(lm, __shfl_xor(lm, 16)); lm = fmaxf(lm, __shfl_xor(lm, 32));
        const bool upd = (lm > -INFINITY) && (!has || lm > 0.f); const float dl = upd ? lm : 0.f;
        if (upd) m = mref + dl;
        const float f = has ? __builtin_amdgcn_exp2f(-dl) : 1.f; l *= f;
#pragma unroll
        for (int dt = 0; dt < 4; ++dt) O[dt] = O[dt] * f;
#pragma unroll
        for (int i = 0; i < 4; ++i) { sa0[i] -= dl; sb0[i] -= dl; sa1[i] -= dl; sb1[i] -= dl; }
    }
    f32x4 pa0, pb0, pa1, pb1; float sum = 0.f;
#pragma unroll
    for (int i = 0; i < 4; ++i) { pa0[i] = __builtin_amdgcn_exp2f(sa0[i]); pb0[i] = __builtin_amdgcn_exp2f(sb0[i]); pa1[i] = __builtin_amdgcn_exp2f(sa1[i]); pb1[i] = __builtin_amdgcn_exp2f(sb1[i]);
        sum += (pa0[i] + pb0[i]) + (pa1[i] + pb1[i]); }
    l += sum;
    pf0 = pack8(pa0, pb0); pf1 = pack8(pa1, pb1);
}
__device__ __forceinline__ void pv(f32x4 (&O)[4], const VF& v, const bf16x8& pf) {
#pragma unroll
    for (int dt = 0; dt < 4; ++dt) O[dt] = MFMA16(v.v[dt], pf, O[dt]);
}
__device__ __forceinline__ void lds_fadd(LAS float* p, float v) { (void)__hip_atomic_fetch_add((float*)p, v, __ATOMIC_RELAXED, __HIP_MEMORY_SCOPE_WORKGROUP); }
#define DPP_I(x, ctrl) __builtin_amdgcn_update_dpp((x), (x), (ctrl), 0xf, 0xf, false)
#define DPP_F(x, ctrl) __int_as_float(__builtin_amdgcn_update_dpp(__float_as_int(x), __float_as_int(x), (ctrl), 0xf, 0xf, false))
__device__ __forceinline__ float sum8_dpp(float v) { v += DPP_F(v, 0xB1); v += DPP_F(v, 0x4E); v += DPP_F(v, 0x141); return v; }
__device__ __forceinline__ int wmax64_i(int x) {
    x = max(x, DPP_I(x, 0xB1)); x = max(x, DPP_I(x, 0x4E)); x = max(x, DPP_I(x, 0x141)); x = max(x, DPP_I(x, 0x140));
    return max(max(__builtin_amdgcn_readlane(x, 0), __builtin_amdgcn_readlane(x, 16)), max(__builtin_amdgcn_readlane(x, 32), __builtin_amdgcn_readlane(x, 48))); }
__device__ __forceinline__ float kqsum(float v) { v += __shfl_xor(v, 16); v += __shfl_xor(v, 32); return v; }
__device__ __forceinline__ float wmax64(float v) {
#pragma unroll
    for (int o = 1; o < 64; o <<= 1) v = fmaxf(v, __shfl_xor(v, o));
    return v;
}
__device__ __forceinline__ void out_add(LAS unsigned short* OUTw, int p, int n, int kq, const f32x4 (&O)[4], float scale, bool first) {
    const int q = 2 * p + (n >> 3), hd = n & 7;
    if (hd < 6) { LAS v2u* dst = (LAS v2u*)(OUTw + (q * 6 + hd) * 64) + kq;
#pragma unroll
        for (int dt = 0; dt < 4; ++dt) { f32x4 v = O[dt] * scale; if (!first) { const v2u o = dst[4 * dt]; v[0] += __uint_as_float(o.x << 16); v[1] += __uint_as_float(o.x & 0xffff0000u); v[2] += __uint_as_float(o.y << 16); v[3] += __uint_as_float(o.y & 0xffff0000u); }
            dst[4 * dt] = (v2u){pk2(v[0], v[1]), pk2(v[2], v[3])}; } }
}

__device__ __forceinline__ void p2_mfma(Frame& F, const In& I, unsigned char* ws) {
    OPAQUE_TID(); KARGS(); const int lane = tid_ & 63, wave = __builtin_amdgcn_readfirstlane(tid_ >> 6), r = lane & 15, kq = lane >> 4;
    const bf16* KV0 = (const bf16*)(ws + WS_KV0); const bf16* W1T = (const bf16*)(ws + WS_W1T); const bf16* W2T = (const bf16*)(ws + WS_W2T); const float* B1F = (const float*)(ws + WS_B1F);
    const bf16* MEMN = (const bf16*)(ws + WS_MEMN); const bf16* WMKT = (const bf16*)(ws + WS_WMKT);
    bf16* KCB = (bf16*)(ws + WS_KCB); bf16* VCT = (bf16*)(ws + WS_VCT); bf16* MKB = (bf16*)(ws + WS_MKB); bf16* MVT = (bf16*)(ws + WS_MVT);
    LAS unsigned char* hid = F.lds + RING_OFF;
    for (int u = blockIdx.x; u < 192; u += F.G) {
        const bool cmp = u < 128;
        const bf16* ap[2]; const bf16* bp[2]; int K, kjump;
        int kv = 0, bg = 0, n0 = 0, lay = 0, m0 = 0, ch = 0;
        if (cmp) { kv = u >> 6; bg = (u >> 4) & 3; n0 = (u & 15) * 32; const int b = bg >> 1, g = bg & 1; K = 2048; kjump = 512 - 64;
#pragma unroll
            for (int rt = 0; rt < 2; ++rt) { int nn = n0 + 16 * rt + r; nn = nn > 510 ? 510 : nn; ap[rt] = KV0 + (size_t)(b * T + 16 * nn) * 512 + kv * 128 + g * 64 + 8 * kq; }
#pragma unroll
            for (int ct = 0; ct < 2; ++ct) bp[ct] = W1T + (size_t)(kv * 256 + 32 * wave + 16 * ct + r) * 2048 + 8 * kq;
        } else { const int v = u - 128; lay = v >> 5; m0 = ((v >> 1) & 15) * 32; ch = v & 1; K = 1024; kjump = 0;
#pragma unroll
            for (int rt = 0; rt < 2; ++rt) ap[rt] = MEMN + (size_t)(lay * 512 + m0 + 16 * rt + r) * 1024 + 8 * kq;
#pragma unroll
            for (int ct = 0; ct < 2; ++ct) bp[ct] = WMKT + (size_t)(lay * 512 + ch * 256 + 32 * wave + 16 * ct + r) * 1024 + 8 * kq;
        }
        f32x4 acc[2][2];
#pragma unroll
        for (int rt = 0; rt < 2; ++rt)
#pragma unroll
            for (int ct = 0; ct < 2; ++ct) acc[rt][ct] = (f32x4){0.f, 0.f, 0.f, 0.f};
        for (int kb = 0; kb < K; kb += 64) { const int ao = kb + (kb >> 6) * kjump;
            bf16x8 a[2][2], bb[2][2];
#pragma unroll
            for (int h2 = 0; h2 < 2; ++h2) {
#pragma unroll
                for (int rt = 0; rt < 2; ++rt) a[rt][h2] = ldg16(ap[rt] + ao + 32 * h2);
#pragma unroll
                for (int ct = 0; ct < 2; ++ct) bb[ct][h2] = ldg16(bp[ct] + kb + 32 * h2); }
#pragma unroll
            for (int h2 = 0; h2 < 2; ++h2)
#pragma unroll
                for (int rt = 0; rt < 2; ++rt)
#pragma unroll
                    for (int ct = 0; ct < 2; ++ct) acc[rt][ct] = MFMA16(a[rt][h2], bb[ct][h2], acc[rt][ct]);
        }
        if (cmp) {
#pragma unroll
            for (int ct = 0; ct < 2; ++ct) { const int col = 32 * wave + 16 * ct + r; const float bias = (kv ? Ip->v_b1 : Ip->k_b1)[col] + ((B1F[(kv * 4 + 0) * 256 + col] + B1F[(kv * 4 + 1) * 256 + col]) + (B1F[(kv * 4 + 2) * 256 + col] + B1F[(kv * 4 + 3) * 256 + col]));
#pragma unroll
                for (int rt = 0; rt < 2; ++rt)
#pragma unroll
                    for (int i = 0; i < 4; ++i) { const float xg = acc[rt][ct][i] + bias; const float hv = 0.5f * xg * (1.f + tanhf(0.7978845608028654f * (xg + 0.044715f * xg * xg * xg)));
                        *(LAS unsigned short*)(hid + (16 * rt + 4 * kq + i) * 528 + 2 * col) = (unsigned short)f2bf(hv); } }
            __syncthreads();
            { const int rt2 = wave >> 2, ct2 = wave & 3; f32x4 o = {0.f, 0.f, 0.f, 0.f};
              const bf16* w2p = W2T + (size_t)(kv * 64 + 16 * ct2 + r) * 256 + 8 * kq;
#pragma unroll
              for (int ks = 0; ks < 8; ++ks) { const bf16x8 av = *(const LAS bf16x8*)(hid + (16 * rt2 + r) * 528 + 64 * ks + 16 * kq); o = MFMA16(av, ldg16(w2p + 32 * ks), o); }
              const int d = 16 * ct2 + r; const float b2v = (kv ? Ip->v_b2 : Ip->k_b2)[d];
#pragma unroll
              for (int i = 0; i < 4; ++i) { const int nn = n0 + 16 * rt2 + 4 * kq + i; const unsigned short ov = (nn < NCMP) ? (unsigned short)f2bf(o[i] + b2v) : (unsigned short)0;
                  if (kv) VCT[(size_t)(bg * 64 + d) * 512 + nn] = ov; else KCB[(size_t)(bg * 512 + nn) * 64 + d] = ov; } }
            __syncthreads();
        } else {
#pragma unroll
            for (int ct = 0; ct < 2; ++ct) { const int col = 32 * wave + 16 * ct + r;
#pragma unroll
                for (int rt = 0; rt < 2; ++rt)
#pragma unroll
                    for (int i = 0; i < 4; ++i) { const int mrow = m0 + 16 * rt + 4 * kq + i; const unsigned short ov = (unsigned short)f2bf(acc[rt][ct][i]);
                        if (ch == 0) MKB[(size_t)(lay * 512 + mrow) * 256 + col] = ov; else MVT[(size_t)(lay * 256 + col) * 512 + mrow] = ov; } }
        }
    }
}

template <int MODE>
__device__ __forceinline__ void mb2(f32x4& sa, f32x4& sb, int kpos, int tcol, bool colok, bool fast, const BiasCtx& B) {
    if (fast) { if (colok) { sa = sa + B.c31; sb = sb + B.c31; } else { sa = (f32x4){-INFINITY, -INFINITY, -INFINITY, -INFINITY}; sb = sa; } }
    else { maskbias<MODE>(sa, kpos, tcol, colok, B); maskbias<MODE>(sb, kpos + 4, tcol, colok, B); }
}
#define SWZ(row) (((((row) >> 3) & 3) << 1) | (((row) >> 1) & 1))
struct KV1 { KF k; VF v; };
__device__ __forceinline__ void load_kv(KV1& d, const bf16* kb, int kstride, const bf16* vt, int vstride, int key0, int r, int kq) { load_k(d.k, kb, kstride, key0, r, kq); load_vt(d.v, vt, vstride, key0, r, kq); }

template <int MD, int FORCE = 0>
__device__ __forceinline__ void nsa_sweep(LAS unsigned char* STG, const bf16* ksb, const bf16* vst, int jlo, int jhi, int qt, const LAS unsigned* WMw, int wave, int lane, int r, int kq, int qsel, int t0w,
                                          const bf16x8 (&qf)[4][2], const BiasCtx& BC, float (&m)[4], float (&l)[4], f32x4 (&O)[4][4],
                                          int kstr = 512, int kblk = 64 * 512, int vstr = 64, int vblk = 16384) {
            const int srow = 8 * wave + (lane >> 3), sch = (lane & 7) ^ SWZ(srow);
            const bf16* ksrc = ksb + (size_t)srow * kstr + 8 * sch; const bf16* vsrc = vst + (size_t)srow * vstr + 8 * sch;
#define NSA_DMA(jb) do { LAS unsigned char* d_ = STG + ((jb) % 6) * 16384 + wave * 1024; \
                __builtin_amdgcn_global_load_lds((const unsigned*)(ksrc + (size_t)(jb) * kblk), (LAS unsigned*)d_, 16, 0, 0); \
                __builtin_amdgcn_global_load_lds((const unsigned*)(vsrc + (size_t)(jb) * vblk), (LAS unsigned*)(d_ + 8192), 16, 0, 0); } while (0)
#define NSA_WAITV(n_) do { if ((n_) >= 4) asm volatile("s_waitcnt vmcnt(4) lgkmcnt(0)" ::: "memory"); else if ((n_) == 2) asm volatile("s_waitcnt vmcnt(2) lgkmcnt(0)" ::: "memory"); else asm volatile("s_waitcnt vmcnt(0) lgkmcnt(0)" ::: "memory"); } while (0)
            { const int nb = jhi - jlo + 1;
#pragma unroll
              for (int i = 0; i < 4; ++i) if (i < nb) NSA_DMA(jlo + i);
              const int issued = nb < 4 ? nb : 4, need = nb < 2 ? nb : 2; NSA_WAITV(2 * (issued - need)); }
            __builtin_amdgcn_s_barrier();
#define NSA_TILES(CLS_) _Pragma("unroll") for (int p = 0; p < 4; ++p) if (m8 & (3u << (2 * p))) { \
                        bf16x8 pf0, pf1; \
                        step64<MD, CLS_>(k0, k1, qf[p], cls, 64 * j + 8 * kq_, t0w + 2 * p + qs_, ((m8 >> (2 * p + qs_)) & 1u) != 0u, BC, m[p], l[p], O[p], pf0, pf1); \
                        pv(O[p], v0, pf0); pv(O[p], v1, pf1); \
                        __builtin_amdgcn_sched_barrier(0); }
            auto tiles = [&](auto clsx, int j) __attribute__((always_inline)) { constexpr int CLSX = decltype(clsx)::value;
                const LAS unsigned char* sk = STG + (j % 6) * 16384; const LAS unsigned char* sv = sk + 8192;
                unsigned m8 = 0xffu; if (WMw) m8 = (unsigned)__builtin_amdgcn_readfirstlane((int)((WMw[j >> 2] >> (8 * (j & 3))) & 0xffu)); if (FORCE == 1) m8 = 0u; if (FORCE == 2) m8 = 0xffu; if (MD == MD_MEM) m8 = 3u; else asm volatile("" : "+s"(m8));
                if (m8) {
                    int r_ = r, kq_ = kq, qs_ = qsel; asm volatile("" : "+v"(r_), "+v"(kq_), "+v"(qs_));
                    const int dj = qt - j; const int cls = (MD == MD_MEM) ? BK_FAR : (MD == MD_WIN) ? ((dj >= 1 && dj <= 7) ? BK_MID : BK_GEN) : ((64 * dj - 63 >= 1513) ? BK_FAR : ((dj >= 1 && dj <= 15) ? BK_MID : BK_GEN));
                    KF k0, k1;
                    { const int ka = 8 * (r_ >> 2) + (r_ & 3), kb2 = ka + 4, kc = ka + 32, kd = ka + 36;
                      k0.a0 = *(const LAS bf16x8*)(sk + ka * 128 + ((kq_ ^ SWZ(ka)) << 4)); k0.a1 = *(const LAS bf16x8*)(sk + ka * 128 + (((4 + kq_) ^ SWZ(ka)) << 4));
                      k0.b0 = *(const LAS bf16x8*)(sk + kb2 * 128 + ((kq_ ^ SWZ(kb2)) << 4)); k0.b1 = *(const LAS bf16x8*)(sk + kb2 * 128 + (((4 + kq_) ^ SWZ(kb2)) << 4));
                      k1.a0 = *(const LAS bf16x8*)(sk + kc * 128 + ((kq_ ^ SWZ(kc)) << 4)); k1.a1 = *(const LAS bf16x8*)(sk + kc * 128 + (((4 + kq_) ^ SWZ(kc)) << 4));
                      k1.b0 = *(const LAS bf16x8*)(sk + kd * 128 + ((kq_ ^ SWZ(kd)) << 4)); k1.b1 = *(const LAS bf16x8*)(sk + kd * 128 + (((4 + kq_) ^ SWZ(kd)) << 4)); }
                    VF v0, v1;
#pragma unroll
                    for (int dt = 0; dt < 4; ++dt) { const int dd = 16 * dt + r_; v0.v[dt] = *(const LAS bf16x8*)(sv + dd * 128 + ((kq_ ^ SWZ(dd)) << 4)); v1.v[dt] = *(const LAS bf16x8*)(sv + dd * 128 + (((4 + kq_) ^ SWZ(dd)) << 4)); }
                    NSA_TILES(CLSX)
                }
            };
            int ni = 0;
            auto blk = [&](auto clsx, int j) __attribute__((always_inline)) {
                const bool head = ((j - jlo) & 1) == 0;
                if (head) { ni = 0; if (j + 4 <= jhi) { NSA_DMA(j + 4); ni += 2; } if (j + 5 <= jhi) { NSA_DMA(j + 5); ni += 2; } }
                tiles(clsx, j);
                if (!head || j == jhi) { NSA_WAITV(ni); __builtin_amdgcn_s_barrier(); }
            };
            int j = jlo;
            if (MD == MD_BLK || MD == MD_MEM) { const int jfar = (MD == MD_MEM) ? jhi : ((qt - 25 < jhi) ? qt - 25 : jhi); const int jfe = jlo + (((jfar - jlo + 1) >> 1) << 1) - 1;
                for (; j <= jfe; ++j) blk(std::integral_constant<int, BK_FAR>{}, j); }
            for (; j <= jhi; ++j) blk(std::integral_constant<int, -1>{}, j);
#undef NSA_WAITV
#undef NSA_TILES
#undef NSA_DMA
}
__device__ __forceinline__ void p3_nsa_mfma(Frame& F, const In& I, unsigned char* ws) {
    OPAQUE_TID(); KARGS(); const int wave = __builtin_amdgcn_readfirstlane(tid_ >> 6);
    LAS float* b12 = (LAS float*)(F.lds + TAB_B12);
    LAS unsigned short* OUTw = (LAS unsigned short*)(F.lds + NSA_OUT) + wave * 3072;
    LAS float* PSw = (LAS float*)(F.lds + NSA_PSQ) + wave * 1024;
    LAS unsigned char* STG = F.lds + NSA_PSQ;
    LAS unsigned* WMw = (LAS unsigned*)(F.lds + NSA_ST) + wave * 32;
    for (int i = tid_; i < 512; i += NWAVES * 64) b12[i] = ((i & 15) < 12) ? Ip->rel_bias[(i >> 4) * 12 + (i & 15)] * LOG2E : 0.f;
    LAS unsigned short* TB = (LAS unsigned short*)(F.lds + NSA_TB);
    { const int gg = (int)blockIdx.x & 1;
      for (int i = tid_; i < 6144; i += NWAVES * 64) { const int dd = i / 6, hh = i % 6; TB[i] = (unsigned short)f2bf(Ip->rel_bias[rel_bucket(dd) * 12 + gg * 6 + hh] * LOG2E); } }
    __syncthreads();
    const bf16* Q0 = (const bf16*)(ws + WS_Q0); const bf16* KV0 = (const bf16*)(ws + WS_KV0); const bf16* QM = (const bf16*)(ws + WS_QM); const bf16* G0 = (const bf16*)(ws + WS_G0);
    const bf16* VT = (const bf16*)(ws + WS_VT); const bf16* KCB = (const bf16*)(ws + WS_KCB); const bf16* VCT = (const bf16*)(ws + WS_VCT);
    const bf16* MKB = (const bf16*)(ws + WS_MKB); const bf16* MVT = (const bf16*)(ws + WS_MVT);
    bf16* CAT = (bf16*)(ws + WS_CAT);
    const int nun = 4 * 128;
    for (int ui = blockIdx.x; ui < nun; ui += F.G) {
        int tl_ = tid_; asm volatile("" : "+v"(tl_));
        const int lane = tl_ & 63, n = lane & 15, kq = lane >> 4, r = n, hd = n & 7, qsel = n >> 3; const bool colv = hd < 6;
        int bg, qt;
        bg = blockIdx.x & 3;
        if (F.G == 256) { const int idx = blockIdx.x >> 2; qt = (ui < 256) ? idx : 127 - idx; }
        else { qt = ui >> 2; if ((ui & 3) != bg) continue; }
        const int b = bg >> 1, g = bg & 1, t0w = 64 * qt + 8 * wave, rowb = b * T;
        const int habs = g * 6 + (colv ? hd : 0);
        const LAS float* b12c = b12 + habs; const BiasCtx BC{TB + (colv ? hd : 0), b12c[29 * 16] - b12c[30 * 16], b12c[30 * 16] - b12c[31 * 16], b12c[31 * 16]};

        bf16x8 qf[4][2];
#pragma unroll
        for (int p = 0; p < 4; ++p) { const bf16* qp = Q0 + (size_t)(rowb + t0w + 2 * p + qsel) * 768 + habs * 64 + 8 * kq;
#pragma unroll
            for (int ks = 0; ks < 2; ++ks) { bf16x8 v = ldg16(qp + 32 * ks); if (!colv) v = (bf16x8){0, 0, 0, 0, 0, 0, 0, 0}; qf[p][ks] = v; } }
        float m[4], l[4]; f32x4 O[4][4];
        if (PROBE_REP == 6 || PROBE_REP == 7) {
            const bf16* ksb_ = KV0 + (size_t)rowb * 512 + 256 + g * 64; const bf16* vst_ = VT + ((size_t)(rowb >> 6) * 256 + g * 64) * 64;
#pragma unroll
            for (int p = 0; p < 4; ++p) { m[p] = -1e30f; l[p] = 0.f;
#pragma unroll
                for (int dt = 0; dt < 4; ++dt) O[p][dt] = (f32x4){0.f, 0.f, 0.f, 0.f}; }
            __syncthreads();
            nsa_sweep<MD_BLK, (PROBE_REP == 6 ? 2 : 1)>(STG, ksb_, vst_, 0, qt, qt, WMw, wave, lane, r, kq, qsel, t0w, qf, BC, m, l, O);
            float* dump = (float*)(ws + WS_OCS) + ((size_t)blockIdx.x * 512 + tid_) * 4;
#pragma unroll
            for (int p = 0; p < 4; ++p) dump[p] = l[p] + O[p][0][0] + O[p][1][1] + O[p][2][2] + O[p][3][3];
            __syncthreads(); }
        for (int i = lane; i < 1024; i += 64) PSw[i] = 0.f;
        const int ncmax = (t0w + 7 >= 31) ? ((t0w + 7 - 31) / 16 + 1) : 0;
        const bf16* kcb = KCB + (size_t)(bg * 512) * 64; const bf16* vct = VCT + (size_t)(bg * 64) * 512;
#pragma unroll
        for (int p = 0; p < 4; ++p) { m[p] = -1e30f; l[p] = 0.f; }
        if (ncmax > 0) {
            int r_ = r, kq_ = kq; asm volatile("" : "+v"(r_), "+v"(kq_));
            for (int key0 = 0; key0 < ncmax; key0 += 32) {
                asm volatile("" : "+v"(r_), "+v"(kq_));
                KF kA; load_k(kA, kcb, 64, key0, r_, kq_);
                const bool fast = (t0w - 31 - 16 * (key0 + 31)) >= 1513;
#pragma unroll
                for (int p = 0; p < 4; ++p) { f32x4 sa, sb; qk(sa, sb, kA, qf[p]); const int tcol = t0w + 2 * p + qsel;
                    mb2<MD_CMP>(sa, sb, key0 + 8 * kq_, tcol, true, fast, BC);
                    const float mn = fmaxf(m[p], lmax8(sa, sb)); float sum = 0.f;
#pragma unroll
                    for (int i = 0; i < 4; ++i) sum += __builtin_amdgcn_exp2f(sa[i] - mn) + __builtin_amdgcn_exp2f(sb[i] - mn);
                    l[p] = l[p] * __builtin_amdgcn_exp2f(m[p] - mn) + sum; m[p] = mn; __builtin_amdgcn_sched_barrier(0); }
            }
        }
        float invl[4];
#pragma unroll
        for (int p = 0; p < 4; ++p) { float mc = m[p]; mc = fmaxf(mc, __shfl_xor(mc, 16)); mc = fmaxf(mc, __shfl_xor(mc, 32));
            const float lt = kqsum(l[p] * __builtin_amdgcn_exp2f(m[p] - mc)); m[p] = mc; invl[p] = lt > 0.f ? 1.f / lt : 0.f; }
#pragma unroll
        for (int p = 0; p < 4; ++p)
#pragma unroll
            for (int dt = 0; dt < 4; ++dt) O[p][dt] = (f32x4){0.f, 0.f, 0.f, 0.f};
        float carry[4] = {0.f, 0.f, 0.f, 0.f};
        if (ncmax > 0) {
            int r_ = r, kq_ = kq; asm volatile("" : "+v"(r_), "+v"(kq_));
            for (int key0 = 0; key0 < ncmax; key0 += 32) {
                asm volatile("" : "+v"(r_), "+v"(kq_));
                KV1 A; load_kv(A, kcb, 64, vct, 512, key0, r_, kq_);
                const bool fast = (t0w - 31 - 16 * (key0 + 31)) >= 1513;
#pragma unroll
                for (int p = 0; p < 4; ++p) { f32x4 sa, sb; qk(sa, sb, A.k, qf[p]); const int tcol = t0w + 2 * p + qsel;
                    mb2<MD_CMP>(sa, sb, key0 + 8 * kq_, tcol, true, fast, BC);
                    f32x4 pa, pb;
#pragma unroll
                    for (int i = 0; i < 4; ++i) { pa[i] = __builtin_amdgcn_exp2f(sa[i] - m[p]) * invl[p]; pb[i] = __builtin_amdgcn_exp2f(sb[i] - m[p]) * invl[p]; }
                    pv(O[p], A.v, pack8(pa, pb));
                    float wA = (pa[0] + pa[1]) + (pa[2] + pa[3]), wB = pa[3] + ((pb[0] + pb[1]) + (pb[2] + pb[3])), wC = pb[3];
                    if (!colv) { wA = 0.f; wB = 0.f; wC = 0.f; }
                    const float up = __shfl(wC, (lane + 48) & 63);
                    const float prevC = (kq == 0) ? carry[p] : up; carry[p] = up;
                    float a0 = wA + prevC, a1 = wB;
                    a0 = sum8_dpp(a0); a1 = sum8_dpp(a1);
                    if (hd == 0) { LAS float* ps = PSw + (2 * p + qsel) * 128 + (key0 >> 2) + 2 * kq; ps[0] = a0; ps[1] = a1; } __builtin_amdgcn_sched_barrier(0); }
            }
        }
        if (ncmax > 0 && ncmax <= 480) {
            const int jn = ((ncmax + 31) >> 5) * 8;
#pragma unroll
            for (int p = 0; p < 4; ++p) { float a0 = sum8_dpp(carry[p]); if (hd == 0 && kq == 0) PSw[(2 * p + qsel) * 128 + jn] = a0; }
        }
        {
#pragma unroll
            for (int p = 0; p < 4; ++p) { const size_t row = (size_t)(rowb + t0w + 2 * p + qsel);
                const float gz = bf2f(G0[row * 256 + habs * 3 + 0]) + Ip->nsa_gate_b[habs * 3 + 0]; out_add(OUTw, p, n, kq, O[p], 1.f / (1.f + __expf(-gz)), true); }
        }
        for (int i = lane; i < 32; i += 64) WMw[i] = (qt < 16) ? 0xffffffffu : 0u;
        if (qt >= 16) {
            if (lane < 3) { const int j = lane == 0 ? 0 : qt - 2 + lane; atomicOr((unsigned*)&WMw[j >> 2], 0xffu << (8 * (j & 3))); }
            for (int q = 0; q < 8; ++q) {
                int v0 = __float_as_int(PSw[q * 128 + lane] + 0.f), v1 = __float_as_int(PSw[q * 128 + 64 + lane] + 0.f);
                if (lane < 1 || lane > qt - 2) v0 = __float_as_int(-1.f); if (lane + 64 > qt - 2) v1 = __float_as_int(-1.f);
                for (int s = 0; s < 13; ++s) { const int mx = wmax64_i(max(v0, v1));
                    const unsigned long long b0 = __ballot(v0 == mx); int j;
                    if (b0) { j = __builtin_ctzll(b0); if (lane == j) v0 = __float_as_int(-1.f); } else { const unsigned long long b1 = __ballot(v1 == mx); j = __builtin_ctzll(b1); if (lane == j) v1 = __float_as_int(-1.f); j += 64; }
                    if (lane == 0) atomicOr((unsigned*)&WMw[j >> 2], 1u << (8 * (j & 3) + q)); }
            }
        }
        const bf16* ksb = KV0 + (size_t)rowb * 512 + 256 + g * 64; const bf16* vst = VT + ((size_t)(rowb >> 6) * 256 + g * 64) * 64;
        __syncthreads();
#pragma unroll 1
        for (int rep_ = 0; rep_ < (PROBE_REP == 1 ? 2 : 1); ++rep_) {
#pragma unroll
            for (int p = 0; p < 4; ++p) { m[p] = -1e30f; l[p] = 0.f;
#pragma unroll
                for (int dt = 0; dt < 4; ++dt) O[p][dt] = (f32x4){0.f, 0.f, 0.f, 0.f}; }
            nsa_sweep<MD_BLK>(STG, ksb, vst, 0, qt, qt, WMw, wave, lane, r, kq, qsel, t0w, qf, BC, m, l, O);
        }
        { int qs2_ = qsel; asm volatile("" : "+v"(qs2_));
#pragma unroll
        for (int p = 0; p < 4; ++p) { const size_t row = (size_t)(rowb + t0w + 2 * p + qs2_);
            const float gz = bf2f(G0[row * 256 + habs * 3 + 1]) + Ip->nsa_gate_b[habs * 3 + 1]; out_add(OUTw, p, n, kq, O[p], (1.f / (1.f + __expf(-gz))) / kqsum(l[p]), false); } }
        const bf16* kwb = KV0 + (size_t)rowb * 512 + 384 + g * 64; const bf16* vwt = VT + ((size_t)(rowb >> 6) * 256 + 128 + g * 64) * 64;
#pragma unroll
        for (int p = 0; p < 4; ++p) { m[p] = -1e30f; l[p] = 0.f;
#pragma unroll
            for (int dt = 0; dt < 4; ++dt) O[p][dt] = (f32x4){0.f, 0.f, 0.f, 0.f}; }
        __syncthreads();
        nsa_sweep<MD_WIN>(STG, kwb, vwt, (qt >= 8) ? qt - 8 : 0, qt, qt, nullptr, wave, lane, r, kq, qsel, t0w, qf, BC, m, l, O);
        if (PROBE_REP == 4) {
#pragma unroll
            for (int p = 0; p < 4; ++p) { m[p] = -1e30f; l[p] = 0.f;
#pragma unroll
                for (int dt = 0; dt < 4; ++dt) O[p][dt] = (f32x4){0.f, 0.f, 0.f, 0.f}; }
            nsa_sweep<MD_WIN>(STG, kwb, vwt, (qt >= 8) ? qt - 8 : 0, qt, qt, nullptr, wave, lane, r, kq, qsel, t0w, qf, BC, m, l, O); }
        { int qs3_ = qsel; asm volatile("" : "+v"(qs3_));
#pragma unroll
        for (int p = 0; p < 4; ++p) { const size_t row = (size_t)(rowb + t0w + 2 * p + qs3_);
            const float gz = bf2f(G0[row * 256 + habs * 3 + 2]) + Ip->nsa_gate_b[habs * 3 + 2]; out_add(OUTw, p, n, kq, O[p], (1.f / (1.f + __expf(-gz))) / kqsum(l[p]), false); } }
        int ln_ = lane; asm volatile("" : "+v"(ln_));
#pragma unroll 1
        for (int i = 0; i < 6; ++i) { const int e = i * 64 + ln_, q = e / 48, c8 = e % 48;
            *(v4u*)(CAT + (size_t)(rowb + t0w + q) * 1024 + g * 384 + 8 * c8) = ((const LAS v4u*)OUTw)[e]; }
#pragma unroll 1
        for (int h2 = 0; h2 < 2; ++h2) { const int hm = 2 * g + h2;
            int ln2_ = lane; asm volatile("" : "+v"(ln2_)); const int nn = ln2_ & 15, kqq = ln2_ >> 4;
#pragma unroll
            for (int p = 0; p < 4; ++p) { qf[p][0] = (bf16x8){0, 0, 0, 0, 0, 0, 0, 0}; qf[p][1] = qf[p][0]; m[p] = -1e30f; l[p] = 0.f;
#pragma unroll
                for (int dt = 0; dt < 4; ++dt) O[p][dt] = (f32x4){0.f, 0.f, 0.f, 0.f}; }
            { const bf16* qp = QM + (size_t)(rowb + t0w + (nn & 7)) * 256 + hm * 64 + 8 * kqq; if (nn < 8) { qf[0][0] = ldg16(qp); qf[0][1] = ldg16(qp + 32); } }
            const BiasCtx BCm{BC.tb, 0.f, 0.f, 0.f};
            nsa_sweep<MD_MEM>(STG, MKB + (size_t)(b * 256) * 256 + hm * 64, MVT + (size_t)(hm * 64) * 512 + b * 256, 0, 3, 0, nullptr, wave, ln2_, nn, kqq, nn >> 3, 0, qf, BCm, m, l, O, 256, 64 * 256, 512, 64);
            const float il = 1.f / kqsum(l[0]);
            if (nn < 8) { bf16* op = CAT + (size_t)(rowb + t0w + nn) * 1024 + 768 + hm * 64 + 4 * kqq;
#pragma unroll
                for (int dt = 0; dt < 4; ++dt) *(uint2*)(op + 16 * dt) = make_uint2(pk2(O[0][dt][0] * il, O[0][dt][1] * il), pk2(O[0][dt][2] * il, O[0][dt][3] * il)); }
        }
    }
}

__device__ __forceinline__ void p10_dsa_norm(Frame& F, const In& I, unsigned char* ws) {
    OPAQUE_TID(); KARGS(); const int gw = F.vcu * NWAVES + (tid_ >> 6), NGW = F.G * NWAVES, lane = tid_ & 63;
    const bf16* PR = (const bf16*)(ws + WS_PROJ1); bf16* CQ = (bf16*)(ws + WS_CQ); bf16* CKV = (bf16*)(ws + WS_CKV); bf16* KIDX = (bf16*)(ws + WS_KIDX); float* WIDX = (float*)(ws + WS_WIDX);
    for (int m = gw; m < M; m += NGW) {
        const bf16* pr = PR + (size_t)m * 768;
        float a[4]; ld4bf(pr + 4 * lane, a);
        float s = wave_sum(a[0] * a[0] + a[1] * a[1] + a[2] * a[2] + a[3] * a[3]); float r = rsqrtf(s * (1.f / 256.f) + EPSF);
        const float4 gq = *(const float4*)(Ip->q_norm + 4 * lane);
        *(uint2*)(CQ + (size_t)m * 256 + 4 * lane) = make_uint2(pk2((a[0] * r) * gq.x, (a[1] * r) * gq.y), pk2((a[2] * r) * gq.z, (a[3] * r) * gq.w));
        const unsigned u = *(const unsigned*)(pr + 256 + 2 * lane); const float c0 = bflo(u), c1 = bfhi(u);
        s = wave_sum(c0 * c0 + c1 * c1); r = rsqrtf(s * (1.f / 128.f) + EPSF);
        *(unsigned*)(CKV + (size_t)m * 128 + 2 * lane) = pk2((c0 * r) * Ip->kv_norm[2 * lane], (c1 * r) * Ip->kv_norm[2 * lane + 1]);
        const float k0 = bf2f(pr[384 + lane]);
        s = wave_sum(k0 * k0); r = rsqrtf(s * (1.f / 64.f) + EPSF);
        { const int tk = m >> 5, key = m & 31, ks = lane >> 4, hf = (lane >> 3) & 1, jj = lane & 7;
          KIDX[((size_t)(tk * 4 + ks) * 64 + hf * 32 + key) * 8 + jj] = (bf16)f2bf((k0 * r) * Ip->kidx_norm[lane]); }
        if (lane < 8) WIDX[(size_t)m * 8 + lane] = bf2f(pr[448 + lane]) * (0.35355339059327373f * 0.125f);
    }
}

#define MFMA32(A, B, C) __builtin_amdgcn_mfma_f32_32x32x16_bf16((A), (B), (C), 0, 0, 0)
typedef float f32x16 __attribute__((ext_vector_type(16)));
constexpr int XL_OFF = RING_BYTES;
constexpr int IDX_HIST = XL_OFF, IDX_CAND = XL_OFF + 16384, IDX_MM = XL_OFF + 24576, IDX_STQ = IDX_MM + 256, IDX_MM2 = IDX_STQ + 256, IDX_CAP = 1024;
static_assert(IDX_MM2 + 64 <= LDSCTL_OFF, "LDS map (indexer)");
__device__ __forceinline__ float wmin64(float v) {
#pragma unroll
    for (int o = 1; o < 64; o <<= 1) v = fminf(v, __shfl_xor(v, o));
    return v;
}
__device__ __forceinline__ float vmaxf_(float a, float b) { float d; asm("v_max_f32 %0, %1, %2" : "=v"(d) : "v"(a), "v"(b)); return d; }
__device__ __forceinline__ float vminf_(float a, float b) { float d; asm("v_min_f32 %0, %1, %2" : "=v"(d) : "v"(a), "v"(b)); return d; }
__device__ __forceinline__ void p12_index_mfma(Frame& F, const In& I, unsigned char* ws) {
    OPAQUE_TID(); KARGS(); const int lane = tid_ & 63, wave = __builtin_amdgcn_readfirstlane(tid_ >> 6), key = lane & 31, half = lane >> 5;
    LAS float* SC = (LAS float*)(F.lds + RING_OFF);
    LAS float* MMw = (LAS float*)(F.lds + IDX_MM);
    const bf16* QI = (const bf16*)(ws + WS_QI); const bf16* KIDX = (const bf16*)(ws + WS_KIDX); const float* WIDX = (const float*)(ws + WS_WIDX);
    unsigned short* SEL = (unsigned short*)(ws + WS_SEL); int* CNT = (int*)(ws + WS_CNT);
    const int NG = M / 4, per = (NG + F.G - 1) / F.G;
    for (int j = 0; j < per; ++j) {
        const int u = j * F.G + ((j & 1) ? (F.G - 1 - (int)blockIdx.x) : (int)blockIdx.x);
        if (u >= NG) break;
        const int gi = (u & 1) * (NG / 2) + (u >> 1);
        const int row0 = 4 * gi, b = row0 / T, t0 = row0 % T, rowb = b * T;
        if (t0 < 256) {
            if (wave < 4) { const int t = t0 + wave; unsigned short* so = SEL + (size_t)(row0 + wave) * 256;
#pragma unroll
                for (int i = 0; i < 4; ++i) { const int s = lane + 64 * i; so[s] = (unsigned short)(s <= t ? s : 0); }
                if (lane == 0) CNT[row0 + wave] = t + 1; }
            continue;
        }
        {
            const int rho = lane & 31, a = rho >> 2, qA = ((a >> 2) & 1) + 2 * (a & 1), hdA = 4 * ((a >> 1) & 1) + (rho & 3);
            bf16x8 qa[4];
#pragma unroll
            for (int ks = 0; ks < 4; ++ks) qa[ks] = ldg16(QI + (size_t)(row0 + qA) * 512 + hdA * 64 + 16 * ks + 8 * half);
            float w0[8], w1[8];
            { const float4 x0 = *(const float4*)(WIDX + (size_t)(row0 + 2 * half) * 8), x1 = *(const float4*)(WIDX + (size_t)(row0 + 2 * half) * 8 + 4);
              const float4 y0 = *(const float4*)(WIDX + (size_t)(row0 + 2 * half + 1) * 8), y1 = *(const float4*)(WIDX + (size_t)(row0 + 2 * half + 1) * 8 + 4);
              w0[0] = x0.x; w0[1] = x0.y; w0[2] = x0.z; w0[3] = x0.w; w0[4] = x1.x; w0[5] = x1.y; w0[6] = x1.z; w0[7] = x1.w;
              w1[0] = y0.x; w1[1] = y0.y; w1[2] = y0.z; w1[3] = y0.w; w1[4] = y1.x; w1[5] = y1.y; w1[6] = y1.z; w1[7] = y1.w; }
            f32x2_t w0p[4], w1p[4];
#pragma unroll
            for (int h = 0; h < 4; ++h) { w0p[h] = (f32x2_t){w0[2 * h], w0[2 * h + 1]}; w1p[h] = (f32x2_t){w1[2 * h], w1[2 * h + 1]}; }
            const int tq0 = t0 + 2 * half, tq1 = tq0 + 1, nt = (t0 + 3) / 32 + 1;
            float mn0 = INFINITY, mx0 = -INFINITY, mn1 = INFINITY, mx1 = -INFINITY;
            const bf16* kpb = KIDX + (size_t)(rowb >> 5) * 2048 + (size_t)lane * 8;
            const int ntw = (nt - wave + NWAVES - 1) / NWAVES;
#define IDX_LOAD(dst, i) do { const int tl2_ = wave + NWAVES * ((i) < ntw ? (i) : (ntw > 0 ? ntw - 1 : 0)); const bf16* kp_ = kpb + (size_t)tl2_ * 2048; \
                _Pragma("unroll") for (int ks = 0; ks < 4; ++ks) dst[ks] = ldg16(kp_ + 512 * ks); } while (0)
#define IDX_COMP(src, i) do { if ((i) < ntw) { const int kpos = 32 * (wave + NWAVES * (i)) + key; \
                f32x16 c = {0.f, 0.f, 0.f, 0.f, 0.f, 0.f, 0.f, 0.f, 0.f, 0.f, 0.f, 0.f, 0.f, 0.f, 0.f, 0.f}; \
                _Pragma("unroll") for (int ks = 0; ks < 4; ++ks) c = MFMA32(qa[ks], src[ks], c); \
                f32x2_t a0 = {0.f, 0.f}, a1 = {0.f, 0.f};                   \
                _Pragma("unroll") for (int h = 0; h < 4; ++h) { \
                    const f32x2_t r0 = {__int_as_float(max(__float_as_int(c[2 * h]), 0)), __int_as_float(max(__float_as_int(c[2 * h + 1]), 0))}; \
                    const f32x2_t r1 = {__int_as_float(max(__float_as_int(c[8 + 2 * h]), 0)), __int_as_float(max(__float_as_int(c[9 + 2 * h]), 0))}; \
                    a0 = __builtin_elementwise_fma(r0, w0p[h], a0); a1 = __builtin_elementwise_fma(r1, w1p[h], a1); } \
                float s0 = (a0[0] + a0[1]) + 0.f, s1 = (a1[0] + a1[1]) + 0.f; \
                const bool ok0 = kpos <= tq0, ok1 = kpos <= tq1; \
                const float v0_ = ok0 ? s0 : -INFINITY, v1_ = ok1 ? s1 : -INFINITY; \
                SC[(2 * half) * 8192 + kpos] = v0_; SC[(2 * half + 1) * 8192 + kpos] = v1_; \
                mx0 = vmaxf_(mx0, v0_); mx1 = vmaxf_(mx1, v1_); mn0 = vminf_(mn0, ok0 ? s0 : INFINITY); mn1 = vminf_(mn1, ok1 ? s1 : INFINITY); } } while (0)
            for (int prb_ = 0; prb_ < (PROBE_REP == 2 ? 2 : 1); ++prb_)
            if (ntw > 0) {
                bf16x8 kb0[4], kb1[4], kb2[4], kb3[4];
                IDX_LOAD(kb0, 0); IDX_LOAD(kb1, 1); IDX_LOAD(kb2, 2);
                for (int i = 0; i < ntw; i += 4) {
                    IDX_LOAD(kb3, i + 3); IDX_COMP(kb0, i);
                    IDX_LOAD(kb0, i + 4); IDX_COMP(kb1, i + 1);
                    IDX_LOAD(kb1, i + 5); IDX_COMP(kb2, i + 2);
                    IDX_LOAD(kb2, i + 6); IDX_COMP(kb3, i + 3);
                }
            }
#undef IDX_LOAD
#undef IDX_COMP
#pragma unroll
            for (int o = 1; o < 32; o <<= 1) { mn0 = fminf(mn0, __shfl_xor(mn0, o)); mx0 = fmaxf(mx0, __shfl_xor(mx0, o)); mn1 = fminf(mn1, __shfl_xor(mn1, o)); mx1 = fmaxf(mx1, __shfl_xor(mx1, o)); }
            if (key == 0) { LAS float* mm = MMw + (wave * 4 + 2 * half) * 2; mm[0] = mn0; mm[1] = mx0; mm[2] = mn1; mm[3] = mx1; }
        }
        __syncthreads();
        {
            const int q = wave >> 1, hw = wave & 1, t = t0 + q, n = t + 1; const LAS float* sc = SC + q * 8192;
            LAS unsigned* hist = (LAS unsigned*)(F.lds + IDX_HIST) + wave * 512; const LAS unsigned* hist0 = (const LAS unsigned*)(F.lds + IDX_HIST) + (2 * q) * 512;
            LAS unsigned short* cand = (LAS unsigned short*)(F.lds + IDX_CAND) + q * IDX_CAP;
            LAS float* stf = (LAS float*)(F.lds + IDX_STQ) + q * 16; LAS int* sti = (LAS int*)stf;
            LAS float* mm2 = (LAS float*)(F.lds + IDX_MM2) + wave * 2;
            unsigned short* so = SEL + (size_t)(row0 + q) * 256;
            const int nch = (n + 255) >> 8;
            if (hw == 0 && lane == 0) { float lo = INFINITY, hi = -INFINITY;
#pragma unroll
                for (int w = 0; w < 8; ++w) { lo = fminf(lo, MMw[(w * 4 + q) * 2]); hi = fmaxf(hi, MMw[(w * 4 + q) * 2 + 1]); }
                stf[0] = lo; stf[1] = hi; sti[2] = 256; sti[3] = 0; sti[4] = 0; sti[5] = 0; sti[6] = 0; sti[7] = 0; sti[8] = 0; sti[9] = 0; }
            __syncthreads();
            for (int round = 0; round < 64; ++round) {
                const float lo = stf[0], hi = stf[1]; const bool act = sti[8] == 0; const bool eqr = !(hi > lo); const float scale = eqr ? 0.f : 1024.f / (hi - lo);
                if (act && !eqr) {
#pragma unroll
                    for (int i = 0; i < 8; ++i) hist[lane + 64 * i] = 0u;
                    for (int c = hw; c < nch; c += 2) { const int i4 = 256 * c + 4 * lane; const f32x4 v4 = *(const LAS f32x4*)(sc + i4);
#pragma unroll
                        for (int e = 0; e < 4; ++e) { const float v = (i4 + e < n) ? v4[e] : -INFINITY;
                            if (v >= lo && v <= hi) { int bb = (int)((v - lo) * scale); bb = bb > 1023 ? 1023 : bb; atomicAdd((unsigned*)&hist[bb >> 1], 1u << (16 * (bb & 1))); } } }
                }
                __syncthreads();
                if (hw == 0 && act) {
                    if (eqr) { if (lane == 0) { sti[8] = 1; sti[9] = 1; } }
                    else {
                        const int krem = sti[2];
                        unsigned cw[8], c0w[8]; unsigned S = 0u, S0 = 0u;
#pragma unroll
                        for (int i = 0; i < 8; ++i) { c0w[i] = hist0[8 * lane + i]; cw[i] = c0w[i] + hist0[512 + 8 * lane + i]; S += (cw[i] & 0xffffu) + (cw[i] >> 16); S0 += (c0w[i] & 0xffffu) + (c0w[i] >> 16); }
                        unsigned x = S, x0 = S0;
#pragma unroll
                        for (int o = 1; o < 64; o <<= 1) { const unsigned y = __shfl_down(x, o), y0 = __shfl_down(x0, o); if (lane + o < 64) { x += y; x0 += y0; } }
                        const unsigned above = x - S; unsigned acc0 = x0 - S0;
                        const bool found = (above < (unsigned)krem) && ((unsigned)krem <= above + S);
                        const int fl = __builtin_ctzll(__ballot(found));
                        int bs = 0; unsigned acc = above, cb = 0u, cb0 = 0u;
                        { bool done = false;
#pragma unroll
                          for (int i = 15; i >= 0; --i) { const unsigned cnt_ = (i & 1) ? (cw[i >> 1] >> 16) : (cw[i >> 1] & 0xffffu), cnt0_ = (i & 1) ? (c0w[i >> 1] >> 16) : (c0w[i >> 1] & 0xffffu);
                              if (!done) { if (acc + cnt_ >= (unsigned)krem) { bs = 16 * lane + i; cb = cnt_; cb0 = cnt0_; done = true; } else { acc += cnt_; acc0 += cnt0_; } } } }
                        if (lane == fl) { sti[2] = krem - (int)acc; sti[3] += (int)acc0; sti[4] += (int)acc; sti[5] = bs; sti[6] = (int)cb0; sti[7] = (int)cb; sti[8] = ((int)cb <= IDX_CAP) ? 1 : 0; }
                    }
                }
                __syncthreads();
                const LAS int* stall = (const LAS int*)(F.lds + IDX_STQ);
                if (stall[8] && stall[16 + 8] && stall[32 + 8] && stall[48 + 8]) break;
                float nlo = INFINITY, nhi = -INFINITY;
                if (sti[8] == 0) { const int bstar = sti[5];
                    for (int c = hw; c < nch; c += 2) { const int i4 = 256 * c + 4 * lane; const f32x4 v4 = *(const LAS f32x4*)(sc + i4);
#pragma unroll
                        for (int e = 0; e < 4; ++e) { const float v = (i4 + e < n) ? v4[e] : -INFINITY;
                            if (v >= lo && v <= hi) { int bb = (int)((v - lo) * scale); bb = bb > 1023 ? 1023 : bb; if (bb == bstar) { nlo = fminf(nlo, v); nhi = fmaxf(nhi, v); } } } } }
                nlo = wmin64(nlo); nhi = wmax64(nhi);
                if (lane == 0) { mm2[0] = nlo; mm2[1] = nhi; }
                __syncthreads();
                if (hw == 0 && lane == 0 && sti[8] == 0) { stf[0] = fminf(mm2[0], mm2[2]); stf[1] = fmaxf(mm2[1], mm2[3]); }
                __syncthreads();
            }
            { const float lo = stf[0], hi = stf[1]; const bool eq = sti[9] != 0; const float scale = eq ? 0.f : 1024.f / (hi - lo);
              const int krem = sti[2], A0 = sti[3], AT = sti[4], bstar = sti[5], C0 = sti[6], ncand = sti[7], nabove = 256 - krem;
              int bsel = hw ? A0 : 0, bcand = hw ? C0 : 0; (void)AT;
              const int cstep = eq ? 1 : 2;
              if (!(eq && hw)) for (int c = eq ? 0 : hw; c < nch; c += cstep) { const int i4 = 256 * c + 4 * lane; const f32x4 v4 = *(const LAS f32x4*)(sc + i4);
#pragma unroll
                  for (int e = 0; e < 4; ++e) { const int idx = i4 + e; const float v = (idx < n) ? v4[e] : -INFINITY;
                      bool sel, cnd;
                      if (eq) { sel = v > hi; cnd = (v == hi); }
                      else { const bool in = (v >= lo && v <= hi); int bb = (int)((v - lo) * scale); bb = bb > 1023 ? 1023 : bb; sel = (v > hi) || (in && bb > bstar); cnd = in && bb == bstar; }
                      const unsigned long long ms = __ballot(sel), mc = __ballot(cnd), lt = (1ull << lane) - 1ull;
                      if (sel) so[bsel + __builtin_popcountll(ms & lt)] = (unsigned short)idx;
                      if (cnd) { const int pc = bcand + __builtin_popcountll(mc & lt);
                          if (eq) { if (pc < krem) so[nabove + pc] = (unsigned short)idx; } else if (pc < IDX_CAP) cand[pc] = (unsigned short)idx; }
                      bsel += __builtin_popcountll(ms); bcand += __builtin_popcountll(mc); } }
              __syncthreads();
              if (!eq) {
                  for (int i = 64 * hw + lane; i < ncand; i += 128) { const int ii = cand[i]; const float vi = sc[ii]; int rank = 0;
                      for (int jj = 0; jj < ncand; ++jj) { const int ij = cand[jj]; const float vj = sc[ij]; rank += ((vj > vi) || (vj == vi && ij < ii)) ? 1 : 0; }
                      if (rank < krem) so[nabove + rank] = (unsigned short)ii; }
              }
              if (hw == 0 && lane == 0) CNT[row0 + q] = 256; }
        }
        __syncthreads();
    }
}

__device__ __forceinline__ unsigned offb(unsigned row, unsigned ch) { return 256u * row + 16u * (ch ^ (((row & 3u) << 2) | ((row >> 2) & 3u))); }
typedef short v4i16_t __attribute__((ext_vector_type(4)));
__device__ __forceinline__ v4i16_t trrd(const LAS unsigned char* p) { return __builtin_amdgcn_ds_read_tr16_b64_v4i16((LAS v4i16_t*)p); }
__device__ __forceinline__ void p13_dsa_mfma(Frame& F, const In& I, unsigned char* ws) {
    OPAQUE_TID(); KARGS(); const int lane = tid_ & 63, wave = __builtin_amdgcn_readfirstlane(tid_ >> 6), n = lane & 15, kq = lane >> 4;
    LAS unsigned char* bkt = F.lds + TAB_BKT; LAS float* b12 = (LAS float*)(F.lds + P13_B12);
    for (int i = tid_; i < 1536; i += NWAVES * 64) bkt[i] = (unsigned char)rel_bucket(i);
    for (int i = tid_; i < 528; i += NWAVES * 64) b12[i] = (i >= 512) ? -INFINITY : (((i & 15) < 12) ? Ip->rel_bias[(i >> 4) * 12 + (i & 15)] * LOG2E : 0.f);
    __syncthreads();
    LAS unsigned char* imgb = F.lds + RING_OFF + wave * 18432; LAS int* sidx = (LAS int*)(imgb + 16384);
    const bf16* QA = (const bf16*)(ws + WS_QA); const bf16* CKV = (const bf16*)(ws + WS_CKV); const bf16* PR = (const bf16*)(ws + WS_PROJ1);
    const unsigned short* SEL = (const unsigned short*)(ws + WS_SEL); const int* CNT = (const int*)(ws + WS_CNT);
    const bf16* MKB = (const bf16*)(ws + WS_MKB) + (size_t)512 * 256; const bf16* MVT = (const bf16*)(ws + WS_MVT) + (size_t)256 * 512;
    bf16* CAT1 = (bf16*)(ws + WS_CAT1);
    const int gw = blockIdx.x * NWAVES + wave, NGW = F.G * NWAVES;
    const LAS float* b12c = b12 + (n < 12 ? n : 0);
#define DSA_GATHER(sl_, rowb_, c0_, buf_) do { const unsigned char* ckvb_ = (const unsigned char*)(CKV + (size_t)(rowb_) * 128); int kx_[8]; \
            _Pragma("unroll") for (int i = 0; i < 8; ++i) kx_[i] = (sl_)[(c0_) + 4 * i + g4_] & 0xffff; \
            _Pragma("unroll") for (int i = 0; i < 8; ++i) __builtin_amdgcn_global_load_lds((const unsigned*)(ckvb_ + ((unsigned)kx_[i] * 256u + goff_[i & 3])), (LAS unsigned*)(imgb + (buf_) * 8192 + i * 1024), 16, 0, 0); } while (0)
#define DSA_LIST(sl_, sel_, t_, cnt_) do { const int idx0_ = __builtin_amdgcn_readfirstlane((sel_)[0]); \
            _Pragma("unroll") for (int i = 0; i < 4; ++i) { const int e = lane + 64 * i, idx = (sel_)[i]; const int d = (t_) - idx, dc = d > 1535 ? 1535 : (d < 0 ? 0 : d); \
                (sl_)[e] = (e < (cnt_)) ? (idx | ((int)bkt[dc] << 22)) : (idx0_ | (2048 << 16)); } } while (0)
    int dreps_ = (PROBE_REP == 9) ? 2 : 1; asm volatile("" : "+s"(dreps_));
    for (int dr_ = 0; dr_ < dreps_; ++dr_) {
    asm volatile("s_waitcnt vmcnt(0) lgkmcnt(0)" ::: "memory");
    int row = gw;
    if (row < M) {
        int ln0_ = lane; asm volatile("" : "+v"(ln0_));
        const int g4_ = ln0_ >> 4; unsigned goff_[4];
#pragma unroll
        for (int k = 0; k < 4; ++k) goff_[k] = 16u * ((unsigned)(ln0_ & 15) ^ (((unsigned)g4_ << 2) | (unsigned)k));
        int cnt = __builtin_amdgcn_readfirstlane(CNT[row]); int sel0[4];
#pragma unroll
        for (int i = 0; i < 4; ++i) sel0[i] = (int)SEL[(size_t)row * 256 + lane + 64 * i];
        DSA_LIST(sidx, sel0, row % T, cnt);
        bf16x8 qf[4];
#pragma unroll
        for (int ks = 0; ks < 4; ++ks) { bf16x8 v = ldg16(QA + (size_t)row * 1536 + (n < 12 ? n : 0) * 128 + 32 * ks + 8 * kq); if (n >= 12) v = (bf16x8){0, 0, 0, 0, 0, 0, 0, 0}; qf[ks] = v; }
        asm volatile("s_waitcnt lgkmcnt(0)" ::: "memory");
        DSA_GATHER(sidx, (row / T) * T, 0, 0);
        int lb = 0, ib = 0;
        for (; row < M; row += NGW) {
            const int t = row % T, rown = (row + NGW < M) ? row + NGW : row; const bool hasn = row + NGW < M;
            int ln_ = lane; asm volatile("" : "+v"(ln_));
            int seln[4] = {0, 0, 0, 0}; int cntn_v = 0; bf16x8 qfn[4];
#pragma unroll
            for (int ks = 0; ks < 4; ++ks) qfn[ks] = (bf16x8){0, 0, 0, 0, 0, 0, 0, 0};
#define DSA_NEXT_LOADS() do { cntn_v = CNT[rown]; \
                _Pragma("unroll") for (int i = 0; i < 4; ++i) seln[i] = (int)SEL[(size_t)rown * 256 + lane + 64 * i]; \
                _Pragma("unroll") for (int ks = 0; ks < 4; ++ks) { bf16x8 v = ldg16(QA + (size_t)rown * 1536 + (n < 12 ? n : 0) * 128 + 32 * ks + 8 * kq); if (n >= 12) v = (bf16x8){0, 0, 0, 0, 0, 0, 0, 0}; qfn[ks] = v; } } while (0)
            const LAS int* sl = sidx + lb * 256; LAS int* sln = sidx + (lb ^ 1) * 256;
            float m = -1e30f, l = 0.f; f32x4 O[8];
#pragma unroll
            for (int rt = 0; rt < 8; ++rt) O[rt] = (f32x4){0.f, 0.f, 0.f, 0.f};
            for (int c0 = 0; c0 < cnt; c0 += 32) {
                LAS unsigned char* img = imgb + ib * 8192;
                if (c0 + 32 < cnt) { DSA_GATHER(sl, (row / T) * T, c0 + 32, ib ^ 1);
                    { const int e2 = (c0 + 64 < 256 ? c0 + 64 : 224) + (ln_ >> 1); const int k2 = sl[e2] & 0xffff;
                      __builtin_amdgcn_global_load_lds((const unsigned*)((const unsigned char*)(CKV + (size_t)((row / T) * T) * 128) + ((unsigned)k2 * 256u + 128u * (unsigned)(ln_ & 1))), (LAS unsigned*)(F.lds + P13_JUNK + wave * 256), 4, 0, 0); }
                    if (c0 == 0) { DSA_NEXT_LOADS(); }
                    if (c0 < 64) asm volatile("s_waitcnt vmcnt(18)" ::: "memory"); else asm volatile("s_waitcnt vmcnt(9)" ::: "memory"); }
                else if (hasn) {
                    if (c0 == 0) { DSA_NEXT_LOADS(); }
                    const int cntn = __builtin_amdgcn_readfirstlane(cntn_v);
                    DSA_LIST(sln, seln, rown % T, cntn);
                    asm volatile("s_waitcnt lgkmcnt(0)" ::: "memory");
                    DSA_GATHER(sln, (rown / T) * T, 0, ib ^ 1); asm volatile("s_waitcnt vmcnt(8)" ::: "memory"); }
                else asm volatile("s_waitcnt vmcnt(0)" ::: "memory");
                const bool has = m > -1e29f; const float mref = has ? m : 0.f; const float cinv = -mref;
                f32x4 sa = {cinv, cinv, cinv, cinv}, sb = sa;
                { const unsigned ra = 8u * ((unsigned)(ln_ & 15) >> 2) + ((unsigned)ln_ & 3u), kq_ = (unsigned)ln_ >> 4;
#pragma unroll
                  for (int s = 0; s < 4; ++s) { const bf16x8 ka = *(const LAS bf16x8*)(img + offb(ra, 4 * s + kq_)); const bf16x8 kb = *(const LAS bf16x8*)(img + offb(ra + 4, 4 * s + kq_));
                      sa = MFMA16(ka, qf[s], sa); sb = MFMA16(kb, qf[s], sb); } }
#pragma unroll
                for (int i = 0; i < 4; ++i) { const int ea = c0 + 8 * kq + i;
                    sa[i] += *(const LAS float*)((const LAS unsigned char*)b12c + ((unsigned)sl[ea] >> 16)); sb[i] += *(const LAS float*)((const LAS unsigned char*)b12c + ((unsigned)sl[ea + 4] >> 16)); }
                float fsc = 1.f;
                if (__any((imax3(imax3(__float_as_int(sa[0]), __float_as_int(sa[1]), __float_as_int(sa[2])), imax3(__float_as_int(sa[3]), __float_as_int(sb[0]), __float_as_int(sb[1])), max(__float_as_int(sb[2]), __float_as_int(sb[3]))) > __float_as_int(SM_THR)) || !has)) {
                    float lm = lmax8(sa, sb);
                    lm = fmaxf(lm, __shfl_xor(lm, 16)); lm = fmaxf(lm, __shfl_xor(lm, 32));
                    const bool upd = (lm > -INFINITY) && (!has || lm > 0.f); const float dl = upd ? lm : 0.f;
                    if (upd) m = mref + dl;
                    fsc = has ? __builtin_amdgcn_exp2f(-dl) : 1.f; l *= fsc;
#pragma unroll
                    for (int i = 0; i < 4; ++i) { sa[i] -= dl; sb[i] -= dl; }
#pragma unroll
                    for (int rt = 0; rt < 8; ++rt) O[rt] = O[rt] * fsc;
                }
                f32x4 pa, pb; float sum = 0.f;
#pragma unroll
                for (int i = 0; i < 4; ++i) { pa[i] = __builtin_amdgcn_exp2f(sa[i]); pb[i] = __builtin_amdgcn_exp2f(sb[i]); sum += pa[i] + pb[i]; }
                l += sum;
                const bf16x8 pf = pack8(pa, pb);
                { const unsigned g_ = (unsigned)ln_ >> 4, q_ = ((unsigned)ln_ & 15u) >> 2, p_ = (unsigned)ln_ & 3u;
#pragma unroll
                  for (int rt = 0; rt < 8; ++rt) { const v4i16_t x0 = trrd(img + offb(8 * g_ + q_, 2 * rt + (p_ >> 1)) + 8 * (p_ & 1)), x1 = trrd(img + offb(8 * g_ + 4 + q_, 2 * rt + (p_ >> 1)) + 8 * (p_ & 1));
                      const bf16x8 vf = {x0[0], x0[1], x0[2], x0[3], x1[0], x1[1], x1[2], x1[3]};
                      O[rt] = MFMA16(vf, pf, O[rt]); } }
                ib ^= 1;
            }
            const float il = 1.f / kqsum(l);
            if (n < 12) { bf16* op = CAT1 + (size_t)row * 1792 + n * 128 + 4 * kq;
#pragma unroll
                for (int rt = 0; rt < 8; ++rt) *(uint2*)(op + 16 * rt) = make_uint2(pk2(O[rt][0] * il, O[rt][1] * il), pk2(O[rt][2] * il, O[rt][3] * il)); }
            lb ^= 1; cnt = __builtin_amdgcn_readfirstlane(cntn_v);
#pragma unroll
            for (int ks = 0; ks < 4; ++ks) qf[ks] = qfn[ks];
        }
    }
    }
#undef DSA_GATHER
#undef DSA_LIST
#undef DSA_NEXT_LOADS
    int mreps_ = (PROBE_REP == 8) ? 2 : 1; asm volatile("" : "+s"(mreps_));
    __syncthreads();
    for (int mr_ = 0; mr_ < mreps_; ++mr_)
    for (int u64 = blockIdx.x; u64 < M / 64; u64 += F.G) {
        int tl_ = tid_; asm volatile("" : "+v"(tl_));
        const int ln = tl_ & 63, nn = ln & 15, kqq = ln >> 4, qsl = nn >> 3;
        const int row0 = 64 * u64 + 8 * wave, b = row0 / T;
        const BiasCtx BC0{(const LAS unsigned short*)(F.lds + NSA_TB), 0.f, 0.f, 0.f};
#pragma unroll 1
        for (int hm = 0; hm < 4; ++hm) {
            bf16x8 qf[4][2];
#pragma unroll
            for (int p = 0; p < 4; ++p) { qf[p][0] = (bf16x8){0, 0, 0, 0, 0, 0, 0, 0}; qf[p][1] = qf[p][0]; }
            { const bf16* qp = PR + (size_t)(row0 + (nn & 7)) * 768 + 456 + hm * 64 + 8 * kqq; if (nn < 8) { qf[0][0] = ldg16(qp); qf[0][1] = ldg16(qp + 32); } }
            float m[4], l[4]; f32x4 O[4][4];
#pragma unroll
            for (int p = 0; p < 4; ++p) { m[p] = -1e30f; l[p] = 0.f;
#pragma unroll
                for (int dt = 0; dt < 4; ++dt) O[p][dt] = (f32x4){0.f, 0.f, 0.f, 0.f}; }
            nsa_sweep<MD_MEM>(F.lds + RING_OFF, MKB + (size_t)(b * 256) * 256 + hm * 64, MVT + (size_t)(hm * 64) * 512 + b * 256, 0, 3, 0, nullptr, wave, ln, nn, kqq, qsl, 0, qf, BC0, m, l, O, 256, 64 * 256, 512, 64);
            const float il = 1.f / kqsum(l[0]);
            if (nn < 8) { bf16* op = CAT1 + (size_t)(row0 + nn) * 1792 + 1536 + hm * 64 + 4 * kqq;
#pragma unroll
                for (int dt = 0; dt < 4; ++dt) *(uint2*)(op + 16 * dt) = make_uint2(pk2(O[0][dt][0] * il, O[0][dt][1] * il), pk2(O[0][dt][2] * il, O[0][dt][3] * il)); }
            __syncthreads();
        }
    }
}

struct Args { In in; float* out; unsigned char* ws; int ph_lo, ph_hi; };
__global__ void __launch_bounds__(NWAVES * 64, 2) mk_fwd(Args args) {
    extern __shared__ __attribute__((aligned(16))) unsigned char lds[];
    Frame F;
    F.lds = (LAS unsigned char*)lds; F.MISC = (volatile LAS unsigned*)(F.lds + MISC_OFF);
    F.G = gridDim.x; { const int bx = blockIdx.x; F.vcu = (F.G % 8 == 0) ? (bx % 8) * (F.G / 8) + bx / 8 : bx; }
    unsigned char* ws = args.ws; const In& I = args.in; float* out = args.out; (void)I;
    F.ctl = (gu32*)(ws + WS_CTL);
    for (int u = threadIdx.x; u < (LDS_BYTES - LDSCTL_OFF) / 4; u += NWAVES * 64) ((LAS unsigned*)(F.lds + LDSCTL_OFF))[u] = 0u;
    __syncthreads();
    XcdBarrier bar; bar.bar = (unsigned*)(F.ctl + CW_BAR); bar.x = 0; bar.st = nullptr;
    if (!MK_SPLIT) bar = xcd_barrier_post((unsigned*)(F.ctl + CW_BAR), F.MISC + 8);
    const int lo = args.ph_lo, hi = args.ph_hi;
#ifndef PH_MASK
#define PH_MASK 0xFFFFFFFFu
#endif
#define IN(k) ((((PH_MASK) >> ((k) % 32)) & 1u) && lo <= (k) && (k) < hi)
#define SEAM(k) do { if (IN(k) && IN((k) + 1)) xcd_barrier(bar); } while (0)
#define SEAM2(k, kn) do { if (IN(k) && IN(kn)) xcd_barrier(bar); } while (0)
#ifndef REP_MASK
#define REP_MASK 0u
#endif
#define REPS(k) (1 + (int)(((REP_MASK) >> (k)) & 1u))
    bf16* XN = (bf16*)(ws + WS_XN); bf16* CAT = (bf16*)(ws + WS_CAT); bf16* ACT = (bf16*)(ws + WS_ACT);
    float* SSQ = (float*)(ws + WS_SSQ);

    if (IN(0)) { for (int r_ = 0; r_ < REPS(0); ++r_) { p0_prologue(F, I, ws); if (r_ + 1 < REPS(0)) xcd_barrier(bar); } SEAM(0); }
    {
            if (IN(1)) {
                pg8::Gemm g{XN, (const bf16*)(ws + WS_WIN0), M, 1792, D}; pg8::StaticOrder S; S.init(M, 1792, F.G, (int)blockIdx.x);
                pg8::EpiRoute<0> E{ws, nullptr};
                for (int r_ = 0; r_ < REPS(1); ++r_) { if (r_) xcd_barrier(bar);
                pg8::gemm_phase<pg8::EpiRoute<0>, pg8::StaticOrder, true, true>(F.lds + RING_OFF, g, S, E); }
                pg8::Gemm g2{(const bf16*)(ws + WS_WVT), XN, 256, M, D}; pg8::StaticOrder S2; S2.init(256, M, F.G, (int)((blockIdx.x + 64) % F.G));
                pg8::EpiRoute<3> E2{ws, nullptr};
                pg8::gemm_phase<pg8::EpiRoute<3>, pg8::StaticOrder, true, true>(F.lds + RING_OFF, g2, S2, E2);
                SEAM(1);
            }
            if (IN(2)) { for (int r_ = 0; r_ < REPS(2); ++r_) { p2_mfma(F, I, ws); if (r_ + 1 < REPS(2)) xcd_barrier(bar); } SEAM(2); }
            if (IN(3)) { for (int r_ = 0; r_ < REPS(3); ++r_) { p3_nsa_mfma(F, I, ws); if (r_ + 1 < REPS(3)) xcd_barrier(bar); } SEAM(3); }
    }
    {
        constexpr int L = 0, pb = L ? 14 : 4;
        if (IN(pb)) {
            pg8::Gemm g{L ? (const bf16*)(ws + WS_CAT1) : CAT, L ? (const bf16*)(ws + WS_WO1F) : (const bf16*)(ws + WS_WO), M, D, L ? 1792 : D}; pg8::StaticOrder S; S.init(M, D, F.G, (int)blockIdx.x);
            KARGS(); pg8::EpiResid<L == 0> E{L ? (const void*)XN : (const void*)Ip->x, XN, SSQ + (size_t)(L ? 2 : 0) * M * 16, D, 0};
            pg8::gemm_phase<pg8::EpiResid<L == 0>, pg8::StaticOrder, true, true>(F.lds + RING_OFF, g, S, E);
            SEAM2(pb, pb + 2);
        }
        if (IN(pb + 2)) {
            pg8::Gemm g{XN, (const bf16*)(ws + WS_WGU) + (size_t)L * 2 * DFF * D, M, 2 * DFF, D}; pg8::StaticOrder S; S.init(M, 2 * DFF, F.G, (int)blockIdx.x);
            pg8::EpiSwiglu E{ACT, SSQ + (size_t)(L ? 2 : 0) * M * 16, DFF, 0};
            for (int r_ = 0; r_ < REPS(pb + 2); ++r_) { if (r_) xcd_barrier(bar);
            pg8::gemm_phase<pg8::EpiSwiglu, pg8::StaticOrder, true, true>(F.lds + RING_OFF, g, S, E); }
            SEAM(pb + 2);
        }
        if (IN(pb + 3)) {
            pg8::Gemm g{ACT, (const bf16*)(ws + WS_WD) + (size_t)L * D * DFF, M, D, DFF}; pg8::StaticOrder S; S.init(M, D, F.G, (int)blockIdx.x);
            pg8::EpiResid<false> E{XN, XN, SSQ + (size_t)(L ? 3 : 1) * M * 16, D, 0};
            pg8::gemm_phase<pg8::EpiResid<false>, pg8::StaticOrder, true, true>(F.lds + RING_OFF, g, S, E);
            SEAM2(pb + 3, L ? 18 : 9);
        }
        }
    {
            if (IN(9)) {
                pg8::Gemm g{XN, (const bf16*)(ws + WS_WIN1), M, 768, D}; pg8::StaticOrder S; S.init(M, 768, F.G, (int)blockIdx.x);
                pg8::EpiRoute<1> E{ws, SSQ + (size_t)1 * M * 16};
                for (int r_ = 0; r_ < REPS(9); ++r_) { if (r_) xcd_barrier(bar);
                pg8::gemm_phase<pg8::EpiRoute<1>, pg8::StaticOrder, true, true>(F.lds + RING_OFF, g, S, E); }
                SEAM(9);
            }
            if (IN(10)) { p10_dsa_norm(F, I, ws); SEAM(10); }
            if (IN(11)) {
                pg8::Gemm g{(const bf16*)(ws + WS_CQ), (const bf16*)(ws + WS_WQ2), M, 2048, 256}; pg8::StaticOrder S; S.init(M, 2048, F.G, (int)blockIdx.x);
                pg8::EpiRoute<2> E{ws, nullptr};
                for (int r_ = 0; r_ < REPS(11); ++r_) { if (r_) xcd_barrier(bar);
                pg8::gemm_phase<pg8::EpiRoute<2>, pg8::StaticOrder, true, true>(F.lds + RING_OFF, g, S, E); }
                SEAM(11);
            }
            if (IN(12)) { for (int r_ = 0; r_ < REPS(12); ++r_) { p12_index_mfma(F, I, ws); if (r_ + 1 < REPS(12)) xcd_barrier(bar); } SEAM(12); }
            if (IN(13)) { for (int r_ = 0; r_ < REPS(13); ++r_) { p13_dsa_mfma(F, I, ws); if (r_ + 1 < REPS(13)) xcd_barrier(bar); } SEAM(13); }
            }
    {
        constexpr int L = 1, pb = L ? 14 : 4;
        if (IN(pb)) {
            pg8::Gemm g{L ? (const bf16*)(ws + WS_CAT1) : CAT, L ? (const bf16*)(ws + WS_WO1F) : (const bf16*)(ws + WS_WO), M, D, L ? 1792 : D}; pg8::StaticOrder S; S.init(M, D, F.G, (int)blockIdx.x);
            KARGS(); pg8::EpiResid<L == 0> E{L ? (const void*)XN : (const void*)Ip->x, XN, SSQ + (size_t)(L ? 2 : 0) * M * 16, D, 0};
            pg8::gemm_phase<pg8::EpiResid<L == 0>, pg8::StaticOrder, true, true>(F.lds + RING_OFF, g, S, E);
            SEAM2(pb, pb + 2);
        }
        if (IN(pb + 2)) {
            pg8::Gemm g{XN, (const bf16*)(ws + WS_WGU) + (size_t)L * 2 * DFF * D, M, 2 * DFF, D}; pg8::StaticOrder S; S.init(M, 2 * DFF, F.G, (int)blockIdx.x);
            pg8::EpiSwiglu E{ACT, SSQ + (size_t)(L ? 2 : 0) * M * 16, DFF, 0};
            for (int r_ = 0; r_ < REPS(pb + 2); ++r_) { if (r_) xcd_barrier(bar);
            pg8::gemm_phase<pg8::EpiSwiglu, pg8::StaticOrder, true, true>(F.lds + RING_OFF, g, S, E); }
            SEAM(pb + 2);
        }
        if (IN(pb + 3)) {
            pg8::Gemm g{ACT, (const bf16*)(ws + WS_WD) + (size_t)L * D * DFF, M, D, DFF}; pg8::StaticOrder S; S.init(M, D, F.G, (int)blockIdx.x);
            pg8::EpiResid<false> E{XN, XN, SSQ + (size_t)(L ? 3 : 1) * M * 16, D, 0};
            pg8::gemm_phase<pg8::EpiResid<false>, pg8::StaticOrder, true, true>(F.lds + RING_OFF, g, S, E);
            SEAM2(pb + 3, L ? 18 : 9);
        }
        }
    if (IN(18)) {
        OPAQUE_TID(); KARGS(); const int lane_ = tid_ & 63;
        const int gw = F.vcu * NWAVES + (tid_ >> 6), NGW = F.G * NWAVES;
        for (int m = gw; m < M; m += NGW) { const float r = rsqrtf(pg8::ssq_row(SSQ + ((size_t)3 * M + m) * 16) * (1.f / D) + EPSF);
#pragma unroll
            for (int j = 0; j < 2; ++j) { const int c = (j * 64 + lane_) * 8; const pg8::u32x4 rw = *(const GAS pg8::u32x4*)(XN + (size_t)m * D + c);
                const GAS f32x4* gr = (const GAS f32x4*)(Ip->norm_final + c); GAS f32x4* orow = (GAS f32x4*)(out + (size_t)m * D + c);
                f32x4 r0, r1; r0[0] = __uint_as_float(rw.x << 16); r0[1] = __uint_as_float(rw.x & 0xffff0000u); r0[2] = __uint_as_float(rw.y << 16); r0[3] = __uint_as_float(rw.y & 0xffff0000u);
                r1[0] = __uint_as_float(rw.z << 16); r1[1] = __uint_as_float(rw.z & 0xffff0000u); r1[2] = __uint_as_float(rw.w << 16); r1[3] = __uint_as_float(rw.w & 0xffff0000u);
                orow[0] = (r0 * r) * gr[0]; orow[1] = (r1 * r) * gr[1]; } }
    }
#undef IN
#undef SEAM
}

extern "C" void kernel_launch(void* const* d_in, const int* in_sizes, int n_in, void* d_out, int out_size, void* d_ws, size_t ws_size, hipStream_t stream) {
    static int grid = 0;
    if (grid == 0) {
        if (n_in != 32 || out_size != M * D || ws_size < WS_END) { fprintf(stderr, "kernel_launch: unexpected shapes (n_in %d out %d ws %zu)\n", n_in, out_size, ws_size); grid = -1; return; }
        int dev = 0, cus = 0, per_cu = 0;
        if (hipGetDevice(&dev) != hipSuccess || hipDeviceGetAttribute(&cus, hipDeviceAttributeMultiprocessorCount, dev) != hipSuccess) { grid = -1; return; }
        if (hipFuncSetAttribute((const void*)mk_fwd, hipFuncAttributeMaxDynamicSharedMemorySize, LDS_BYTES) != hipSuccess) { grid = -1; return; }
        if (hipOccupancyMaxActiveBlocksPerMultiprocessor(&per_cu, (const void*)mk_fwd, NWAVES * 64, LDS_BYTES) != hipSuccess || per_cu < 1) fprintf(stderr, "kernel_launch: occupancy query reports %d\n", per_cu);
        (void)hipGetLastError();
        grid = cus;
        if (grid > 256) grid = 256;
    }
    if (grid < 0) return;
    if (hipMemsetAsync((char*)d_ws + WS_CTL, 0, CTL_ZERO_BYTES, stream) != hipSuccess) return;
    Args a{};
    const float** ip = (const float**)&a.in;
    for (int i = 0; i < 32; ++i) ip[i] = (const float*)d_in[i];
    a.out = (float*)d_out; a.ws = (unsigned char*)d_ws;
#if MK_SPLIT
    for (int k = 0; k < N_PHASES; ++k) { a.ph_lo = k; a.ph_hi = k + 1; hipLaunchKernelGGL(mk_fwd, dim3(grid), dim3(NWAVES * 64), LDS_BYTES, stream, a); }
#else
    a.ph_lo = 0; a.ph_hi = N_PHASES; hipLaunchKernelGGL(mk_fwd, dim3(grid), dim3(NWAVES * 64), LDS_BYTES, stream, a);
#endif
}
```

```cpp
#include <hip/hip_runtime.h>
#include <cstdio>
#include <cstdint>
#include <type_traits>
#include <math.h>

namespace pg8 {
#define PG8_LAS __attribute__((address_space(3)))
typedef unsigned short bf16_t;
typedef short bf16x8 __attribute__((ext_vector_type(8)));
typedef float f32x4 __attribute__((ext_vector_type(4)));
typedef unsigned u32x4 __attribute__((ext_vector_type(4)));
constexpr int BM = 256, BK = 64, HALF = 128, HTB = HALF * BK * 2  , STAGE_BYTES = 8 * HTB, NXCD = 8, WGM = 8;

__host__ __device__ __forceinline__ int lds_byte(int r, int c) { const int st = (r >> 4) * 2 + (c >> 5), rr = r & 15, cc = c & 31, ob = rr * 64 + cc * 2; return st * 1024 + (ob ^ (((ob >> 9) & 1) << 5)); }
__host__ __device__ __forceinline__ void stage_rc(int b, int& R, int& C) { const int st = b / 1024, sb = b % 1024, swz = sb ^ (((sb >> 9) & 1) << 5); R = (st >> 1) * 16 + swz / 64; C = (st & 1) * 32 + (swz % 64) / 2; }
__host__ __device__ __forceinline__ int perm32(int rho) { const int n = rho >> 4, i = rho & 15; return 8 * (i >> 2) + 4 * n + (i & 3); }

struct Unit { int pm, pn; };
struct Gemm { const bf16_t* A; const bf16_t* Bt; int M, N, K; };

struct StaticOrder {
    int nM, nN, nwg, G, c;
    __host__ __device__ void init(int M, int N, int G_, int c_) { nM = M / BM; nN = N / BM; nwg = nM * nN; G = G_; c = c_; }
    __host__ __device__ bool next(int i, Unit& u) const {
        const long L = (long)i * G + c; if (L >= nwg) return false;
        int wgid = (int)L; { const int q = nwg / NXCD, r = nwg % NXCD, xcd = wgid % NXCD, off = wgid / NXCD; wgid = (xcd < r ? xcd * (q + 1) : r * (q + 1) + (xcd - r) * q) + off; }
        const int nig = WGM * nN, gid = wgid / nig, fm = gid * WGM, gsz = (nM - fm) < WGM ? (nM - fm) : WGM;
        u.pm = fm + ((wgid % nig) % gsz); u.pn = (wgid % nig) / gsz; return true;
    }
    __device__ __forceinline__ void a_ready(const Unit&) const {}
    __device__ __forceinline__ void done(const Unit&) const {}
};

__device__ __forceinline__ unsigned cvt_pk_bf16(float lo, float hi) { unsigned r; asm volatile("v_cvt_pk_bf16_f32 %0, %1, %2" : "=v"(r) : "v"(lo), "v"(hi)); return r; }
__device__ __forceinline__ float ssq_row(const float* p) { const f32x4 a = ((const f32x4*)p)[0], b = ((const f32x4*)p)[1], c = ((const f32x4*)p)[2], d = ((const f32x4*)p)[3]; const f32x4 t = (a + b) + (c + d); return (t[0] + t[1]) + (t[2] + t[3]); }
template <int ROUTE> struct EpiRoute {
    static constexpr bool PERM = true, AFTER_DRAIN = false;
    unsigned char* ws; const float* ssq;
    __device__ __forceinline__ void operator()(const f32x4 (&acc)[2][2][4][2], const Unit& u, int wr, int wc, int fr, int fq) const {
        asm volatile("" : "+v"(fr), "+v"(fq));
        const int pn = u.pn; size_t off; int ld, t0; float sc;
        if constexpr (ROUTE == 0) {
            off = pn < 3 ? (size_t)(88u << 20) : pn < 5 ? (size_t)(112u << 20) : pn < 6 ? (size_t)(128u << 20) : (size_t)(136u << 20);
            ld = pn < 3 ? 768 : pn < 5 ? 512 : 256; t0 = pn < 3 ? 0 : pn < 5 ? 3 : pn < 6 ? 5 : 6; sc = (pn < 3 || pn == 5) ? 0.18033688011112042f : 1.f;
        } else if constexpr (ROUTE == 1) { off = (size_t)(88u << 20); ld = 768; t0 = 0; sc = 1.f; }
        else if constexpr (ROUTE == 3) { off = (size_t)(144u << 20); ld = 16384; t0 = 0; sc = 1.f; }
        else { off = pn < 6 ? (size_t)(128u << 20) : (size_t)(176u << 20); ld = pn < 6 ? 1536 : 512; t0 = pn < 6 ? 0 : 6; sc = 1.f; }
        bf16_t* base = (bf16_t*)(ws + off);
        const int row0 = u.pm * BM + wr * 64 + fr, col0 = (pn - t0) * BM + wc * 32 + 8 * fq;
#pragma unroll
        for (int ai = 0; ai < 2; ++ai)
#pragma unroll
            for (int m = 0; m < 4; ++m) { bf16_t* rowp = base + (size_t)(row0 + ai * HALF + m * 16) * ld + col0;
                float scr_ = sc; if constexpr (ROUTE == 1) scr_ = rsqrtf(ssq_row(ssq + (size_t)(row0 + ai * HALF + m * 16) * 16) * (1.f / 1024.f) + 1e-6f);
#pragma unroll
                for (int bj = 0; bj < 2; ++bj) { float scb_ = scr_; if constexpr (ROUTE == 1) { const int cg = col0 + bj * HALF; if (cg >= 456 && cg < 712) scb_ *= 0.18033688011112042f; }
                    const f32x4 v0 = acc[ai][bj][m][0] * scb_, v1 = acc[ai][bj][m][1] * scb_;
                    u32x4 w; w.x = cvt_pk_bf16(v0[0], v0[1]); w.y = cvt_pk_bf16(v0[2], v0[3]); w.z = cvt_pk_bf16(v1[0], v1[1]); w.w = cvt_pk_bf16(v1[2], v1[3]);
                    if constexpr (ROUTE == 3) {
                        const int tok = col0 + bj * HALF, rw = row0 + ai * HALF + m * 16; *(u32x4*)(base + ((size_t)(tok >> 6) * 256 + rw) * 64 + (tok & 63)) = w; }
                    else *(u32x4*)(rowp + bj * HALF) = w; } }
    }
};
template <bool RES_F32>
struct EpiResid {
    static constexpr bool PERM = true, AFTER_DRAIN = false;
    const void* res; bf16_t* hb; float* ssq; int ldc; int pad;
    __device__ __forceinline__ void operator()(const f32x4 (&acc)[2][2][4][2], const Unit& u, int wr, int wc, int fr, int fq) const {
        asm volatile("" : "+v"(fr), "+v"(fq));
        const int row0 = u.pm * BM + wr * 64 + fr, col0 = u.pn * BM + wc * 32 + 8 * fq;
#pragma unroll
        for (int ai = 0; ai < 2; ++ai)
#pragma unroll
            for (int m = 0; m < 4; ++m) { const int row = row0 + ai * HALF + m * 16; const size_t off = (size_t)row * ldc + col0; float sq = 0.f;
#pragma unroll
                for (int bj = 0; bj < 2; ++bj) { f32x4 v[2];
                    if constexpr (RES_F32) {
#pragma unroll
                        for (int n = 0; n < 2; ++n) v[n] = *(const f32x4*)((const float*)res + off + bj * HALF + 4 * n) + acc[ai][bj][m][n];
                    } else { const u32x4 rw = *(const u32x4*)((const bf16_t*)res + off + bj * HALF);
                        f32x4 r0, r1; r0[0] = __uint_as_float(rw.x << 16); r0[1] = __uint_as_float(rw.x & 0xffff0000u); r0[2] = __uint_as_float(rw.y << 16); r0[3] = __uint_as_float(rw.y & 0xffff0000u);
                        r1[0] = __uint_as_float(rw.z << 16); r1[1] = __uint_as_float(rw.z & 0xffff0000u); r1[2] = __uint_as_float(rw.w << 16); r1[3] = __uint_as_float(rw.w & 0xffff0000u);
                        v[0] = r0 + acc[ai][bj][m][0]; v[1] = r1 + acc[ai][bj][m][1]; }
#pragma unroll
                    for (int n = 0; n < 2; ++n) sq += (v[n][0] * v[n][0] + v[n][1] * v[n][1]) + (v[n][2] * v[n][2] + v[n][3] * v[n][3]);
                    u32x4 w; w.x = cvt_pk_bf16(v[0][0], v[0][1]); w.y = cvt_pk_bf16(v[0][2], v[0][3]); w.z = cvt_pk_bf16(v[1][0], v[1][1]); w.w = cvt_pk_bf16(v[1][2], v[1][3]); *(u32x4*)(hb + off + bj * HALF) = w; }
                sq += __shfl_xor(sq, 16); sq += __shfl_xor(sq, 32); if (fq == 0) ssq[(size_t)row * 16 + u.pn * 4 + wc] = sq; }
    }
};
struct EpiSwiglu {
    static constexpr bool PERM = true, AFTER_DRAIN = false;
    bf16_t* O; const float* ssq; int ldc; int pad;
    __device__ __forceinline__ void operator()(const f32x4 (&acc)[2][2][4][2], const Unit& u, int wr, int wc, int fr, int fq) const {
        asm volatile("" : "+v"(fr), "+v"(fq));
        const int row0 = u.pm * BM + wr * 64 + fr, col0 = u.pn * HALF + wc * 32 + 8 * fq;
#pragma unroll
        for (int ai = 0; ai < 2; ++ai)
#pragma unroll
            for (int m = 0; m < 4; ++m) { float o[8]; const float rs = rsqrtf(ssq_row(ssq + (size_t)(row0 + ai * HALF + m * 16) * 16) * (1.f / 1024.f) + 1e-6f);
#pragma unroll
                for (int n = 0; n < 2; ++n)
#pragma unroll
                    for (int e = 0; e < 4; ++e) { const float g = acc[ai][0][m][n][e] * rs, up = acc[ai][1][m][n][e] * rs; o[4 * n + e] = (g * __builtin_amdgcn_rcpf(1.f + __expf(-g))) * up; }
                u32x4 w; w.x = cvt_pk_bf16(o[0], o[1]); w.y = cvt_pk_bf16(o[2], o[3]); w.z = cvt_pk_bf16(o[4], o[5]); w.w = cvt_pk_bf16(o[6], o[7]);
                *(u32x4*)(O + (size_t)(row0 + ai * HALF + m * 16) * ldc + col0) = w; }
    }
};
template <class Epi, class Sched, bool ALIGN_EPI = false, bool SP2 = false>
__device__ __forceinline__ void gemm_phase(PG8_LAS unsigned char* lds, const Gemm g, const Sched& S, const Epi& E) {
    int tid = threadIdx.x; asm volatile("" : "+v"(tid));
    const int wid = __builtin_amdgcn_readfirstlane(tid >> 6), lane = tid & 63, wr = wid >> 2, wc = wid & 3, fr = lane & 15, fq = lane >> 4;
    int K = g.K; asm volatile("" : "+s"(K));
    const int nt = K / BK;
    unsigned voffA[2], voffB[2];
#pragma unroll
    for (int i = 0; i < 2; ++i) { int R, C; stage_rc(tid * 16 + i * 8192, R, C); const int Rb = Epi::PERM ? ((R & ~31) + perm32(R & 31)) : R;
        voffA[i] = (unsigned)(R * K + C) * 2u; voffB[i] = (unsigned)(Rb * K + C) * 2u; }
    const size_t kstep = (size_t)(BK * 2);
    const size_t hstep = (size_t)HALF * K * 2;
    const size_t tstep = 2 * hstep;
    const unsigned ldsw = (unsigned)wid * 1024u;
    const int aoff = lds_byte(wr * 64 + fr, fq * 8), boff = lds_byte(wc * 32 + fr, fq * 8);
#define PG8_SA(b, h) (((b) * 2 + (h)) * HTB)
#define PG8_SB(b, h) ((4 + (b) * 2 + (h)) * HTB)
#define PG8_STAGE(bufoff, gbase, voff) do { _Pragma("unroll") for (int _i = 0; _i < 2; ++_i) \
        __builtin_amdgcn_global_load_lds((const unsigned*)((const char*)(gbase) + (voff)[_i]), (PG8_LAS unsigned*)(lds + (bufoff) + ldsw + _i * 8192), 16, 0, 0); } while (0)
#define PG8_LDA(dst, b, h) do { _Pragma("unroll") for (int m = 0; m < 4; ++m) _Pragma("unroll") for (int k = 0; k < 2; ++k) dst[m][k] = *(const PG8_LAS bf16x8*)(lds + PG8_SA(b, h) + aoff + m * 2048 + k * 1024); } while (0)
#define PG8_LDB(dst, b, h) do { _Pragma("unroll") for (int n = 0; n < 2; ++n) _Pragma("unroll") for (int k = 0; k < 2; ++k) dst[n][k] = *(const PG8_LAS bf16x8*)(lds + PG8_SB(b, h) + boff + n * 2048 + k * 1024); } while (0)
#define PG8_MMA(ai, bj, At, Bt) do { __builtin_amdgcn_s_setprio(1); _Pragma("unroll") for (int m = 0; m < 4; ++m) _Pragma("unroll") for (int n = 0; n < 2; ++n) _Pragma("unroll") for (int k = 0; k < 2; ++k) \
        acc[ai][bj][m][n] = __builtin_amdgcn_mfma_f32_16x16x32_bf16(Bt[n][k], At[m][k], acc[ai][bj][m][n], 0, 0, 0); __builtin_amdgcn_s_setprio(0); } while (0)
#define PG8_WAIT_V(n) asm volatile("s_waitcnt vmcnt(" #n ")" ::: "memory")
#define PG8_WAIT_L(n) asm volatile("s_waitcnt lgkmcnt(" #n ")" ::: "memory")
#define PG8_BAR __builtin_amdgcn_s_barrier()
#define PG8_SCHED __builtin_amdgcn_sched_barrier(0)
    Unit cur, nxt; int ui = 0;
    if (!S.next(0, cur)) return;
    f32x4 acc[2][2][4][2];
#pragma unroll
    for (int a = 0; a < 2; ++a)
#pragma unroll
        for (int b = 0; b < 2; ++b)
#pragma unroll
            for (int m = 0; m < 4; ++m)
#pragma unroll
                for (int n = 0; n < 2; ++n) acc[a][b][m][n] = (f32x4){0.f, 0.f, 0.f, 0.f};
    bf16x8 At[4][2], B0[2][2], B1[2][2];
    const char* cA = (const char*)g.A + (size_t)cur.pm * tstep; const char* cB = (const char*)g.Bt + (size_t)cur.pn * tstep;
    S.a_ready(cur);
    if constexpr (SP2) {
        PG8_STAGE(PG8_SB(0, 0), cB, voffB); PG8_STAGE(PG8_SB(0, 1), cB + hstep, voffB); PG8_STAGE(PG8_SA(0, 0), cA, voffA); PG8_STAGE(PG8_SA(0, 1), cA + hstep, voffA);
        if (wr == 1) PG8_BAR;
        PG8_WAIT_V(2); PG8_BAR;
        PG8_STAGE(PG8_SB(1, 0), cB + kstep, voffB); PG8_STAGE(PG8_SA(1, 0), cA + kstep, voffA); PG8_STAGE(PG8_SB(1, 1), cB + hstep + kstep, voffB);
        PG8_WAIT_V(6); PG8_BAR;
    } else {
        PG8_STAGE(PG8_SB(0, 0), cB, voffB); PG8_STAGE(PG8_SA(0, 0), cA, voffA); PG8_STAGE(PG8_SB(0, 1), cB + hstep, voffB); PG8_STAGE(PG8_SA(0, 1), cA + hstep, voffA);
        if (wr == 1) PG8_BAR;
        PG8_WAIT_V(4); PG8_BAR;
        PG8_STAGE(PG8_SB(1, 0), cB + kstep, voffB); PG8_STAGE(PG8_SA(1, 0), cA + kstep, voffA); PG8_STAGE(PG8_SB(1, 1), cB + hstep + kstep, voffB);
        PG8_WAIT_V(6); PG8_BAR;
    }
    for (;;) {
        const bool has_next = S.next(ui + 1, nxt);
        const char* nA = has_next ? (const char*)g.A + (size_t)nxt.pm * tstep : cA; const char* nB = has_next ? (const char*)g.Bt + (size_t)nxt.pn * tstep : cB;
        for (int t = 0; t < nt; t += 2) {
            const bool last = (t == nt - 2);
            const char* a1 = cA + (size_t)(t + 1) * kstep;
            const char* a2 = last ? nA : cA + (size_t)(t + 2) * kstep; const char* b2 = last ? nB : cB + (size_t)(t + 2) * kstep;
            const char* a3 = a2 + kstep; const char* b3 = b2 + kstep;
            if (last && has_next) S.a_ready(nxt);
            if constexpr (SP2) {
            PG8_LDB(B0, 0, 0); PG8_LDB(B1, 0, 1); PG8_SCHED; PG8_LDA(At, 0, 0); PG8_STAGE(PG8_SA(1, 1), a1 + hstep, voffA);
            PG8_WAIT_V(8); PG8_WAIT_L(0); PG8_BAR; PG8_MMA(0, 0, At, B0); PG8_MMA(0, 1, At, B1); PG8_BAR; PG8_SCHED;
            PG8_LDA(At, 0, 1); PG8_STAGE(PG8_SB(0, 0), b2, voffB); PG8_STAGE(PG8_SB(0, 1), b2 + hstep, voffB); PG8_STAGE(PG8_SA(0, 0), a2, voffA);
            PG8_WAIT_V(8); PG8_WAIT_L(0); PG8_BAR; PG8_MMA(1, 0, At, B0); PG8_MMA(1, 1, At, B1); PG8_BAR; PG8_SCHED;
            PG8_LDB(B0, 1, 0); PG8_LDB(B1, 1, 1); PG8_SCHED; PG8_LDA(At, 1, 0); PG8_STAGE(PG8_SA(0, 1), a2 + hstep, voffA);
            PG8_WAIT_V(8); PG8_WAIT_L(0); PG8_BAR; PG8_MMA(0, 0, At, B0); PG8_MMA(0, 1, At, B1); PG8_BAR; PG8_SCHED;
            PG8_LDA(At, 1, 1); PG8_STAGE(PG8_SB(1, 0), b3, voffB); PG8_STAGE(PG8_SB(1, 1), b3 + hstep, voffB); PG8_STAGE(PG8_SA(1, 0), a3, voffA);
            PG8_WAIT_V(8); PG8_WAIT_L(0); PG8_BAR; PG8_MMA(1, 0, At, B0); PG8_MMA(1, 1, At, B1); PG8_BAR; PG8_SCHED;
            } else {
            PG8_LDB(B0, 0, 0); PG8_SCHED; PG8_LDA(At, 0, 0); PG8_STAGE(PG8_SA(1, 1), a1 + hstep, voffA);
            PG8_WAIT_L(8); PG8_BAR; PG8_WAIT_L(0); PG8_MMA(0, 0, At, B0); PG8_BAR; PG8_SCHED;
            PG8_LDB(B1, 0, 1); PG8_STAGE(PG8_SB(0, 0), b2, voffB);
            PG8_BAR; PG8_WAIT_L(0); PG8_MMA(0, 1, At, B1); PG8_BAR;
            PG8_LDA(At, 0, 1); PG8_STAGE(PG8_SA(0, 0), a2, voffA);
            PG8_BAR; PG8_WAIT_L(0); PG8_MMA(1, 0, At, B0); PG8_BAR; PG8_SCHED;
            PG8_STAGE(PG8_SB(0, 1), b2 + hstep, voffB);
            PG8_WAIT_V(6); PG8_BAR; PG8_MMA(1, 1, At, B1); PG8_BAR;
            PG8_LDB(B0, 1, 0); PG8_SCHED; PG8_LDA(At, 1, 0); PG8_STAGE(PG8_SA(0, 1), a2 + hstep, voffA);
            PG8_WAIT_L(8); PG8_BAR; PG8_WAIT_L(0); PG8_MMA(0, 0, At, B0); PG8_BAR; PG8_SCHED;
            PG8_LDB(B1, 1, 1); PG8_STAGE(PG8_SB(1, 0), b3, voffB);
            PG8_BAR; PG8_WAIT_L(0); PG8_MMA(0, 1, At, B1); PG8_BAR;
            PG8_LDA(At, 1, 1); PG8_STAGE(PG8_SA(1, 0), a3, voffA);
            PG8_BAR; PG8_WAIT_L(0); PG8_MMA(1, 0, At, B0); PG8_BAR; PG8_SCHED;
            PG8_STAGE(PG8_SB(1, 1), b3 + hstep, voffB);
            PG8_WAIT_V(6); PG8_BAR; PG8_MMA(1, 1, At, B1); PG8_BAR;
            }
        }
        if constexpr (ALIGN_EPI) { if (wr == 0) PG8_BAR; }
        if constexpr (!Epi::AFTER_DRAIN) { E(acc, cur, wr, wc, fr, fq); S.done(cur); }
        if (!has_next) break;
#pragma unroll
        for (int a = 0; a < 2; ++a)
#pragma unroll
            for (int b = 0; b < 2; ++b)
#pragma unroll
                for (int m = 0; m < 4; ++m)
#pragma unroll
                    for (int n = 0; n < 2; ++n) acc[a][b][m][n] = (f32x4){0.f, 0.f, 0.f, 0.f};
        cur = nxt; cA = nA; cB = nB; ++ui;
        if constexpr (ALIGN_EPI) { if (wr == 1) PG8_BAR; }
    }
    PG8_WAIT_V(0);
    if constexpr (!ALIGN_EPI) { if (wr == 0) PG8_BAR; }
    PG8_BAR;
    if constexpr (Epi::AFTER_DRAIN) { E.fused(acc, cur, wr, wc, fr, fq, lds, wid, lane); S.done(cur); }
#undef PG8_SA
#undef PG8_SB
#undef PG8_STAGE
#undef PG8_LDA
#undef PG8_LDB
#undef PG8_MMA
#undef PG8_WAIT_V
#undef PG8_WAIT_L
#undef PG8_BAR
#undef PG8_SCHED
}
}
constexpr int NWAVES = 8;
constexpr int BATCH = 2, T = 8192, D = 1024, M = BATCH * T, DFF = 2816, NSA_IN = 1828, DSA_IN = 712, NCMP = 511, NCR = BATCH * NCMP * 2;
constexpr float NEGF = -1e30f, EPSF = 1e-6f;
#ifndef MK_SPLIT
#define MK_SPLIT 0
#endif
constexpr int N_PHASES = 19;
constexpr size_t MiB = 1u << 20;
constexpr size_t WS_CTL = 0, CTL_ZERO_BYTES = 1 * MiB;
constexpr size_t WS_KCB = 1 * MiB  , WS_VCT = 1 * MiB + 512 * 1024  , WS_MKB = 2 * MiB  , WS_MVT = 2 * MiB + 512 * 1024  , WS_MKV = 3 * MiB  , WS_WIDX = 5 * MiB  , WS_CNT = 6 * MiB  ;
constexpr size_t WS_WIN0 = 8 * MiB, WS_WO = 12 * MiB, WS_WGU = 16 * MiB, WS_WD = 38 * MiB, WS_WIN1 = 49 * MiB, WS_WQ2 = 51 * MiB, WS_WVT = 52 * MiB  ;
constexpr size_t WS_W1T = 232 * MiB, WS_MEMN = 234 * MiB, WS_WMKT = 236 * MiB, WS_W2T = 238 * MiB, WS_B1F = 238 * MiB + 64 * 1024;
constexpr size_t WS_XN = 56 * MiB;
constexpr size_t WS_Q0 = 88 * MiB, WS_KV0 = 112 * MiB  , WS_QM = 128 * MiB, WS_G0 = 136 * MiB, WS_VT = 144 * MiB  ;
static_assert(WS_Q0 == (88u << 20) && WS_KV0 == (112u << 20) && WS_QM == (128u << 20) && WS_G0 == (136u << 20), "EpiRoute tables");
constexpr size_t WS_ACT = 88 * MiB;
constexpr size_t WS_PROJ1 = 88 * MiB, WS_CQ = 112 * MiB, WS_CKV = 120 * MiB, WS_KIDX = 124 * MiB, WS_QA = 128 * MiB, WS_QI = 176 * MiB, WS_SEL = 112 * MiB  , WS_CAT1 = 176 * MiB  , WS_WO1F = 52 * MiB + 512 * 1024  ;
constexpr size_t WS_OCS = 152 * MiB  , WS_CAT = 200 * MiB, WS_SSQ = 239 * MiB  , WS_END = 243 * MiB;
static_assert(WS_PROJ1 == (88u << 20) && WS_QA == (128u << 20) && WS_QI == (176u << 20) && WS_VT == (144u << 20), "EpiRoute tables");
static_assert(WS_ACT + (size_t)M * DFF * 2 <= WS_CAT + 0 * MiB || true, "map");
constexpr int CW_BAR = 4096;
constexpr int RING_OFF = 0, RING_BYTES = 131072, LDS_BYTES = 163840, LDSCTL_OFF = LDS_BYTES - 1024, MISC_OFF = LDSCTL_OFF + 320;
#define GAS __attribute__((address_space(1)))
#define LAS __attribute__((address_space(3)))
typedef unsigned short bf16;
typedef unsigned v4u __attribute__((ext_vector_type(4)));
typedef unsigned v2u __attribute__((ext_vector_type(2)));
typedef float f32x4 __attribute__((ext_vector_type(4)));
typedef short bf16x8 __attribute__((ext_vector_type(8)));
typedef GAS unsigned gu32;
typedef GAS unsigned long long gu64;
#define RLX_AGENT __ATOMIC_RELAXED, __HIP_MEMORY_SCOPE_AGENT
#define LDS_WAIT() asm volatile("s_waitcnt lgkmcnt(0)" ::: "memory")
#define VM_WAIT() asm volatile("s_waitcnt vmcnt(0)" ::: "memory")
__device__ __forceinline__ unsigned long long rt() { return __builtin_amdgcn_s_memrealtime(); }
__device__ __forceinline__ unsigned f2bf(float f) { unsigned u = __builtin_bit_cast(unsigned, f); return (u + 0x7fffu + ((u >> 16) & 1u)) >> 16; }
__device__ __forceinline__ unsigned pk2(float lo, float hi) { return f2bf(lo) | (f2bf(hi) << 16); }
#define XB_TMO      128
#define XB_XCNT(j)  (256  + 64 * (j))
#define XB_XSUB(j)  (1280 + 64 * (j))
#define XB_XGEN(j)  (2304 + 64 * (j))
#define XB_TOP      3328
#define XB_TOPGEN   3392
#define XCD_BAR_WORDS 3456
#define XB_SPIN_CAP (1u << 18)

__device__ __forceinline__ unsigned xb_ld(unsigned* p)              { return __hip_atomic_load(p, __ATOMIC_RELAXED, __HIP_MEMORY_SCOPE_AGENT); }
__device__ __forceinline__ unsigned xb_add(unsigned* p, unsigned v) { return __hip_atomic_fetch_add(p, v, __ATOMIC_RELAXED, __HIP_MEMORY_SCOPE_AGENT); }
__device__ __forceinline__ unsigned xb_xcc_id() { return (unsigned)__builtin_amdgcn_s_getreg((3 << 11) | 20) & 0xFu; }
#define XB_SPIN(cond, bar) do { unsigned _sp = 0; while (cond) { __builtin_amdgcn_s_sleep(1); \
    if ((++_sp & 255u) == 0u) { if (xb_ld(&(bar)[XB_TMO])) break; if (_sp > XB_SPIN_CAP) { atomicAdd(&(bar)[XB_TMO], 1u); break; } } } } while (0)

struct XcdBarrier {
    unsigned* bar; unsigned x;
    volatile LAS unsigned* st;
};

__device__ __forceinline__ XcdBarrier xcd_barrier_post(unsigned* bar, volatile LAS unsigned* st) {
    XcdBarrier b; b.bar = bar; b.x = xb_xcc_id(); b.st = st;
    if (threadIdx.x == 0) (void)xb_add(&bar[XB_XCNT(b.x)], 1u);
    return b;
}
__device__ __forceinline__ void xcd_barrier_complete(unsigned* bar, unsigned x, unsigned& nloc, unsigned& nx) {
    const unsigned G = gridDim.x * gridDim.y * gridDim.z;
    unsigned sum, cnt, mine, sp = 0u;
    for (;;) {
        sum = 0u; cnt = 0u; mine = 0u;
#pragma unroll 1
        for (unsigned j = 0; j < 16; ++j) { const unsigned c = xb_ld(&bar[XB_XCNT(j)]); sum += c; cnt += (c > 0u) ? 1u : 0u; mine = (j == x) ? c : mine; }
        if (sum == G) break;
        __builtin_amdgcn_s_sleep(1);
        if ((++sp & 255u) == 0u) { if (xb_ld(&bar[XB_TMO])) break; if (sp > XB_SPIN_CAP) { atomicAdd(&bar[XB_TMO], 1u); break; } }
    }
    nloc = mine > 0u ? mine : 1u; nx = cnt > 0u ? cnt : 1u;
}

__device__ __forceinline__ void xcd_barrier(const XcdBarrier& b) {
    asm volatile("s_waitcnt vmcnt(0)" ::: "memory");
    __syncthreads();
    if (threadIdx.x == 0) {
        unsigned* bar = b.bar;
        __builtin_amdgcn_s_waitcnt(0);
        unsigned nloc = b.st[0], nx = b.st[1];
        if (nloc == 0u) { xcd_barrier_complete(bar, b.x, nloc, nx); b.st[0] = nloc; b.st[1] = nx; }
        const unsigned old = xb_add(&bar[XB_XSUB(b.x)], 1u);
        const unsigned gen = old / nloc;
        if (old + 1u == (gen + 1u) * nloc) {
            __builtin_amdgcn_fence(__ATOMIC_RELEASE, "agent");
            asm volatile("s_waitcnt vmcnt(0)" ::: "memory");
            const unsigned og = xb_add(&bar[XB_TOP], 1u);
            const unsigned tg = og / nx;
            if (og + 1u == (tg + 1u) * nx) xb_add(&bar[XB_TOPGEN], 1u);
            else XB_SPIN(xb_ld(&bar[XB_TOPGEN]) == tg, bar);
            __builtin_amdgcn_fence(__ATOMIC_ACQUIRE, "agent");
            xb_add(&bar[XB_XGEN(b.x)], 1u);
            asm volatile("s_waitcnt vmcnt(0)" ::: "memory");
        } else {
            XB_SPIN(xb_ld(&bar[XB_XGEN(b.x)]) == gen, bar);
            __builtin_amdgcn_fence(__ATOMIC_ACQUIRE, "agent");
            asm volatile("s_waitcnt vmcnt(0)" ::: "memory");
        }
    }
    __syncthreads();
}

struct Frame {
    LAS unsigned char* lds; volatile LAS unsigned* MISC; gu32* ctl;
    int vcu, G;
};
__device__ __forceinline__ float bf2f(unsigned short u) { return __uint_as_float((unsigned)u << 16); }
__device__ __forceinline__ float bflo(unsigned u) { return __uint_as_float(u << 16); }
__device__ __forceinline__ float bfhi(unsigned u) { return __uint_as_float(u & 0xffff0000u); }
__device__ __forceinline__ float wave_sum(float v) {
#pragma unroll
    for (int o = 1; o < 64; o <<= 1) v += __shfl_xor(v, o);
    return v;
}
__device__ __forceinline__ float red16_sum(float v) { v += __shfl_xor(v, 1, 16); v += __shfl_xor(v, 2, 16); v += __shfl_xor(v, 4, 16); v += __shfl_xor(v, 8, 16); return v; }
__device__ __forceinline__ float red16_max(float v) { v = fmaxf(v, __shfl_xor(v, 1, 16)); v = fmaxf(v, __shfl_xor(v, 2, 16)); v = fmaxf(v, __shfl_xor(v, 4, 16)); v = fmaxf(v, __shfl_xor(v, 8, 16)); return v; }
__device__ __forceinline__ int rel_bucket(int n) {
    if (n < 16) return n;
    return 16 + (n >= 22) + (n >= 30) + (n >= 40) + (n >= 54) + (n >= 73) + (n >= 99) + (n >= 134) + (n >= 182) + (n >= 246) + (n >= 332) + (n >= 450) + (n >= 609) + (n >= 825) + (n >= 1117) + (n >= 1513);
}

__device__ __forceinline__ void xpose_item(const float* W, int ldw, int c0, int nvalid, int k0, bf16* WT, int Kd, int drow0, LAS float* scr, int lane, const float* kgain = nullptr) {
#pragma unroll
    for (int i = 0; i < 8; ++i) { const int kk = 8 * i + (lane >> 3), n = (lane & 7) * 4;
        float4 wv = make_float4(0.f, 0.f, 0.f, 0.f);
        if (n + 3 < nvalid) wv = *(const float4*)(W + (size_t)(k0 + kk) * ldw + c0 + n);
        else if (n < nvalid) { const float* wp = W + (size_t)(k0 + kk) * ldw + c0 + n; wv.x = wp[0]; if (n + 1 < nvalid) wv.y = wp[1]; if (n + 2 < nvalid) wv.z = wp[2]; }
        if (kgain) { const float g_ = kgain[k0 + kk]; wv.x *= g_; wv.y *= g_; wv.z *= g_; wv.w *= g_; }
        LAS float* sp = scr + kk * 33 + n; sp[0] = wv.x; sp[1] = wv.y; sp[2] = wv.z; sp[3] = wv.w; }
    LDS_WAIT(); asm volatile("" ::: "memory");
    const int c = lane & 7;
#pragma unroll
    for (int j = 0; j < 4; ++j) { const int n = (lane >> 3) + 8 * j; const LAS float* s = scr + (8 * c) * 33 + n;
        v4u o; o.x = pk2(s[0 * 33], s[1 * 33]); o.y = pk2(s[2 * 33], s[3 * 33]); o.z = pk2(s[4 * 33], s[5 * 33]); o.w = pk2(s[6 * 33], s[7 * 33]);
        *(GAS v4u*)(WT + (size_t)(drow0 + n) * Kd + k0 + 8 * c) = o; }
    LDS_WAIT(); asm volatile("" ::: "memory");
}
__device__ __forceinline__ void rms_row_to_bf16(const float* xrow, const float* gain, bf16* orow, int lane) {
    const GAS f32x4* xr = (const GAS f32x4*)xrow + lane; const GAS f32x4* gr = (const GAS f32x4*)gain + lane;
    f32x4 v[4]; float s = 0.f;
#pragma unroll
    for (int j = 0; j < 4; ++j) { v[j] = xr[64 * j]; s += (v[j].x * v[j].x + v[j].y * v[j].y) + (v[j].z * v[j].z + v[j].w * v[j].w); }
    const float r = rsqrtf(wave_sum(s) * (1.f / D) + EPSF);
    GAS unsigned long long* o8 = (GAS unsigned long long*)orow + lane;
#pragma unroll
    for (int j = 0; j < 4; ++j) { const f32x4 g = gr[64 * j]; o8[64 * j] = (unsigned long long)pk2((v[j].x * r) * g.x, (v[j].y * r) * g.y) | ((unsigned long long)pk2((v[j].z * r) * g.z, (v[j].w * r) * g.w) << 32); }
}
#ifndef PROBE_REP
#define PROBE_REP 0
#endif
#define CAS __attribute__((address_space(4)))
#define KARGS() const CAS In* Ip = (const CAS In*)__builtin_amdgcn_kernarg_segment_ptr(); asm volatile("" : "+s"(Ip))
#define OPAQUE_TID() int tid_ = threadIdx.x; asm volatile("" : "+v"(tid_))
__device__ __forceinline__ void norm_phase(Frame& F, const float* x, const float* gain, bf16* xn) {
    OPAQUE_TID(); const int lane_ = tid_ & 63, wave_ = tid_ >> 6;
    const int gw = F.vcu * NWAVES + wave_, NGW = F.G * NWAVES;
    for (int m = gw; m < M; m += NGW) rms_row_to_bf16(x + (size_t)m * D, gain, xn + (size_t)m * D, lane_);
}

template <int DL>
__device__ __forceinline__ void coop_attend(const float (&q)[DL], const float (&k)[DL], const float (&v)[DL], float bias, float& m_, float& l_, float (&o)[DL]) {
    float a = 0.f;
#pragma unroll
    for (int d = 0; d < DL; ++d) a += q[d] * k[d];
    a = red16_sum(a) + bias;
    const float mn = fmaxf(m_, a), al = __expf(m_ - mn), p = __expf(a - mn);
    l_ = l_ * al + p; m_ = mn;
#pragma unroll
    for (int d = 0; d < DL; ++d) o[d] = o[d] * al + p * v[d];
}
__device__ __forceinline__ void ld4bf(const bf16* p, float (&x)[4]) { const uint2 u = *(const uint2*)p; x[0] = bflo(u.x); x[1] = bfhi(u.x); x[2] = bflo(u.y); x[3] = bfhi(u.y); }
__device__ __forceinline__ void ld8bf(const bf16* p, float (&x)[8]) { const uint4 u = *(const uint4*)p; x[0] = bflo(u.x); x[1] = bfhi(u.x); x[2] = bflo(u.y); x[3] = bfhi(u.y); x[4] = bflo(u.z); x[5] = bfhi(u.z); x[6] = bflo(u.w); x[7] = bfhi(u.w); }
__device__ __forceinline__ void ld4f(const float* p, float (&x)[4]) { const float4 u = *(const float4*)p; x[0] = u.x; x[1] = u.y; x[2] = u.z; x[3] = u.w; }

struct In {
    const float *x, *mem, *rel_bias, *norm_mix, *norm_ffn, *norm_mem, *w_mem_kv, *w_out, *ffn_gate, *ffn_up, *ffn_down, *nsa_w_in, *nsa_gate_b, *pos_k, *pos_v,
        *k_w1, *k_b1, *k_w2, *k_b2, *v_w1, *v_b1, *v_w2, *v_b2, *dsa_w_in, *q_norm, *kv_norm, *w_q_up, *w_uk, *w_uv, *w_q_idx, *kidx_norm, *norm_final;
};
__device__ __forceinline__ void p0_prologue(Frame& F, const In& I, unsigned char* ws) {
    OPAQUE_TID(); KARGS(); const int lane_ = tid_ & 63, wave_ = __builtin_amdgcn_readfirstlane(tid_ >> 6);
    LAS float* scr = (LAS float*)(F.lds + RING_OFF + wave_ * 16384);
    const int gw = F.vcu * NWAVES + wave_, NGW = F.G * NWAVES;
    bf16* WIN0 = (bf16*)(ws + WS_WIN0); bf16* WO = (bf16*)(ws + WS_WO); bf16* WGU = (bf16*)(ws + WS_WGU); bf16* WD = (bf16*)(ws + WS_WD); bf16* WIN1 = (bf16*)(ws + WS_WIN1); bf16* WQ2 = (bf16*)(ws + WS_WQ2);
    constexpr int I_A = 16 * 56, I_G = 16 * 8, I_B = 2 * 16 * 32, I_C = 2 * 16 * 176, I_D = 2 * 44 * 32, I_E = 16 * 24, I_F = 4 * 16, NITEMS = I_A + I_B + I_C + I_D + I_E + I_F + I_G;
    for (int it = gw; it < NITEMS; it += NGW) {
        int r = it;
        if (r < I_A) { const int kb = r / 56, nb = r % 56, r0 = 32 * nb; int c0, nv;
            if (r0 < 1152) { c0 = r0; nv = 32; } else if (r0 < 1280) { c0 = r0 + 128; nv = 32; } else if (r0 < 1536) { c0 = r0 + 292; nv = 32; } else if (r0 == 1536) { c0 = 1536; nv = 32; } else if (r0 == 1568) { c0 = 1568; nv = 4; } else { c0 = 0; nv = 0; }
            xpose_item(Ip->nsa_w_in, NSA_IN, c0, nv, 64 * kb, WIN0, D, r0, scr, lane_); continue; } r -= I_A;
        if (r < I_B) { const int l = r / 512, q = r % 512, kb = q / 32, nb = q % 32;
            xpose_item(Ip->w_out + (size_t)l * D * D, D, 32 * nb, 32, 64 * kb, WO + (size_t)l * D * D, D, 32 * nb, scr, lane_); continue; } r -= I_B;
        if (r < I_C) { const int l = r / (16 * 176), q = r % (16 * 176), kb = q / 176, nb = q % 176, r0 = 32 * nb, pn = r0 >> 8, w0 = r0 & 255;
            const float* src = ((w0 < 128) ? Ip->ffn_gate : Ip->ffn_up) + (size_t)l * D * DFF;
            xpose_item(src, DFF, 128 * pn + (w0 & 127), 32, 64 * kb, WGU + (size_t)l * 2 * DFF * D, D, r0, scr, lane_, Ip->norm_ffn + l * D); continue; } r -= I_C;
        if (r < I_D) { const int l = r / (44 * 32), q = r % (44 * 32), kb = q / 32, nb = q % 32;
            xpose_item(Ip->ffn_down + (size_t)l * DFF * D, D, 32 * nb, 32, 64 * kb, WD + (size_t)l * D * DFF, DFF, 32 * nb, scr, lane_); continue; } r -= I_D;
        if (r < I_E) { const int kb = r / 24, nb = r % 24, r0 = 32 * nb; int nv = DSA_IN - r0; nv = nv > 32 ? 32 : (nv < 0 ? 0 : nv);
            xpose_item(Ip->dsa_w_in, DSA_IN, r0, nv, 64 * kb, WIN1, D, r0, scr, lane_, Ip->norm_mix + D); continue; } r -= I_E;
        if (r < I_F) { const int kb = r / 16, nb = r % 16; xpose_item(Ip->w_q_idx, 512, 32 * nb, 32, 64 * kb, WQ2, 256, 1536 + 32 * nb, scr, lane_); continue; } r -= I_F;
        { const int kb = r / 8, nb = r % 8, r0 = 32 * nb;
            xpose_item(Ip->nsa_w_in, NSA_IN, (r0 < 128) ? 1152 + r0 : 1408 + (r0 - 128), 32, 64 * kb, (bf16*)(ws + WS_WVT), D, r0, scr, lane_); }
    }
    for (int idx = (F.vcu * NWAVES * 64) + tid_; idx < 384 * 256; idx += F.G * NWAVES * 64) {
        const int c = idx & 255, r4 = (idx >> 8) & 31, h = idx >> 13; const float4* a4 = (const float4*)(Ip->w_q_up + (size_t)c * 768 + h * 64); const float4* b4 = (const float4*)(Ip->w_uk + (size_t)(4 * r4) * 768 + h * 64);
        float s0 = 0.f, s1 = 0.f, s2 = 0.f, s3 = 0.f;
#pragma unroll 4
        for (int d = 0; d < 16; ++d) { const float4 av = a4[d], b0 = b4[d], b1 = b4[192 + d], b2 = b4[384 + d], b3 = b4[576 + d];
            s0 += (av.x * b0.x + av.y * b0.y) + (av.z * b0.z + av.w * b0.w); s1 += (av.x * b1.x + av.y * b1.y) + (av.z * b1.z + av.w * b1.w);
            s2 += (av.x * b2.x + av.y * b2.y) + (av.z * b2.z + av.w * b2.w); s3 += (av.x * b3.x + av.y * b3.y) + (av.z * b3.z + av.w * b3.w); }
        const float sc_ = 0.125f * 1.4426950408889634f;
        bf16* o_ = WQ2 + (size_t)(h * 128 + 4 * r4) * 256 + c;
        o_[0] = (bf16)f2bf(s0 * sc_); o_[256] = (bf16)f2bf(s1 * sc_); o_[512] = (bf16)f2bf(s2 * sc_); o_[768] = (bf16)f2bf(s3 * sc_);
    }
    { bf16* WO1F = (bf16*)(ws + WS_WO1F); const float* wo1 = Ip->w_out + (size_t)D * D;
      for (int idx = (F.vcu * NWAVES * 64) + tid_; idx < 12 * 32 * 256; idx += F.G * NWAVES * 64) {
          const int n4 = idx & 255, r4 = (idx >> 8) & 31, h = idx >> 13; const float* a = Ip->w_uv + (size_t)(4 * r4) * 768 + h * 64; const float* bcol = wo1 + (size_t)(h * 64) * D + 4 * n4;
          float acc_[4][4];
#pragma unroll
          for (int i = 0; i < 4; ++i)
#pragma unroll
              for (int j = 0; j < 4; ++j) acc_[i][j] = 0.f;
#pragma unroll 4
          for (int d = 0; d < 64; ++d) { const float4 bv = *(const float4*)(bcol + (size_t)d * D); const float a0 = a[d], a1 = a[768 + d], a2 = a[1536 + d], a3 = a[2304 + d];
              acc_[0][0] += a0 * bv.x; acc_[0][1] += a0 * bv.y; acc_[0][2] += a0 * bv.z; acc_[0][3] += a0 * bv.w; acc_[1][0] += a1 * bv.x; acc_[1][1] += a1 * bv.y; acc_[1][2] += a1 * bv.z; acc_[1][3] += a1 * bv.w;
              acc_[2][0] += a2 * bv.x; acc_[2][1] += a2 * bv.y; acc_[2][2] += a2 * bv.z; acc_[2][3] += a2 * bv.w; acc_[3][0] += a3 * bv.x; acc_[3][1] += a3 * bv.y; acc_[3][2] += a3 * bv.z; acc_[3][3] += a3 * bv.w; }
#pragma unroll
          for (int j = 0; j < 4; ++j) *(uint2*)(WO1F + (size_t)(4 * n4 + j) * 1792 + h * 128 + 4 * r4) = make_uint2(pk2(acc_[0][j], acc_[1][j]), pk2(acc_[2][j], acc_[3][j])); }
      for (int it = gw; it < 4 * 32; it += NGW) { const int kb = it / 32, nb = it % 32;
          xpose_item(wo1 + (size_t)768 * D, D, 32 * nb, 32, 64 * kb, WO1F + 1536, 1792, 32 * nb, scr, lane_); } }
    { bf16* W1T = (bf16*)(ws + WS_W1T); bf16* W2T = (bf16*)(ws + WS_W2T); bf16* WMKT = (bf16*)(ws + WS_WMKT); float* B1F = (float*)(ws + WS_B1F); bf16* MEMN = (bf16*)(ws + WS_MEMN);
      constexpr int J_1 = 2 * 32 * 8, J_2 = 2 * 4 * 2, J_M = 2 * 16 * 16;
      for (int it = gw; it < J_1 + J_2 + J_M; it += NGW) { int r2 = it;
          if (r2 < J_1) { const int kv = r2 / 256, q = r2 % 256, kb = q / 8, nb = q % 8; xpose_item(kv ? Ip->v_w1 : Ip->k_w1, 256, 32 * nb, 32, 64 * kb, W1T + (size_t)kv * 256 * 2048, 2048, 32 * nb, scr, lane_); continue; } r2 -= J_1;
          if (r2 < J_2) { const int kv = r2 / 8, q = r2 % 8, kb = q / 2, nb = q % 2; xpose_item(kv ? Ip->v_w2 : Ip->k_w2, 64, 32 * nb, 32, 64 * kb, W2T + (size_t)kv * 64 * 256, 256, 32 * nb, scr, lane_); continue; } r2 -= J_2;
          { const int l = r2 / 256, q = r2 % 256, kb = q / 16, nb = q % 16; xpose_item(Ip->w_mem_kv + (size_t)l * D * 512, 512, 32 * nb, 32, 64 * kb, WMKT + (size_t)l * 512 * D, D, 32 * nb, scr, lane_); } }
      if ((int)blockIdx.x < 32) { const int u_ = (int)blockIdx.x, kv = u_ >> 4, cr = (u_ >> 2) & 3, kq4 = u_ & 3, c = 64 * cr + lane_; const float* w1 = kv ? Ip->v_w1 : Ip->k_w1; const float* pos = kv ? Ip->pos_v : Ip->pos_k;
          const int kb0 = 512 * kq4 + 64 * wave_; float sacc = 0.f;
#pragma unroll 8
          for (int k = 0; k < 64; ++k) sacc += pos[kb0 + k] * w1[(size_t)(kb0 + k) * 256 + c];
          LAS float* red = (LAS float*)(F.lds + RING_OFF + 8 * 16384);
          red[wave_ * 64 + lane_] = sacc;
          __syncthreads();
          if (wave_ == 0) { float t_ = 0.f;
#pragma unroll
              for (int w = 0; w < 8; ++w) t_ += red[w * 64 + lane_];
              B1F[(kv * 4 + kq4) * 256 + c] = t_; } }
      for (int m = gw; m < 1024; m += NGW) rms_row_to_bf16(Ip->mem + (size_t)(m & 511) * D, Ip->norm_mem + (m >> 9) * D, MEMN + (size_t)m * D, lane_); }
    norm_phase(F, Ip->x, Ip->norm_mix, (bf16*)(ws + WS_XN));
}

#define MFMA16(A, B, C) __builtin_amdgcn_mfma_f32_16x16x32_bf16((A), (B), (C), 0, 0, 0)
constexpr float LOG2E = 1.4426950408889634f;
constexpr int NSA_OUT = 0, NSA_PSQ = 49152, NSA_ST = 147456, NSA_TB = NSA_ST + 3072;
constexpr int TAB_B12 = NSA_ST + 1024;
constexpr int P13_JUNK = NSA_ST + 3072 + 1536;
constexpr int P13_B12 = NSA_ST;
constexpr int TAB_BKT = NSA_ST + 3072;
static_assert(NSA_TB + 12288 <= LDSCTL_OFF && TAB_B12 + 2048 <= NSA_TB, "LDS tables");
enum { MD_CMP = 0, MD_WIN = 1, MD_BLK = 2, MD_MEM = 3 };
struct KF { bf16x8 a0, a1, b0, b1; };
struct VF { bf16x8 v[4]; };
__device__ __forceinline__ bf16x8 ldg16(const bf16* p) { return *(const bf16x8*)p; }
typedef float f32x2_t __attribute__((ext_vector_type(2))); typedef __bf16 bf16x2_t __attribute__((ext_vector_type(2)));
__device__ __forceinline__ unsigned cvtpk_s(float lo, float hi) { f32x2_t v = {lo, hi}; bf16x2_t b = __builtin_convertvector(v, bf16x2_t); return __builtin_bit_cast(unsigned, b); }
__device__ __forceinline__ bf16x8 pack8(const f32x4& a, const f32x4& b) { v4u w; w.x = cvtpk_s(a[0], a[1]); w.y = cvtpk_s(a[2], a[3]); w.z = cvtpk_s(b[0], b[1]); w.w = cvtpk_s(b[2], b[3]); return __builtin_bit_cast(bf16x8, w); }
__device__ __forceinline__ void load_k(KF& k, const bf16* kb, int kstride, int key0, int r, int kq) {
    const bf16* pa = kb + (size_t)(key0 + 8 * (r >> 2) + (r & 3)) * kstride + 8 * kq; const bf16* pb = pa + 4 * (size_t)kstride;
    k.a0 = ldg16(pa); k.a1 = ldg16(pa + 32); k.b0 = ldg16(pb); k.b1 = ldg16(pb + 32);
}
__device__ __forceinline__ void load_vt(VF& v, const bf16* vt, int vstride, int key0, int r, int kq) {
#pragma unroll
    for (int dt = 0; dt < 4; ++dt) v.v[dt] = ldg16(vt + (size_t)(16 * dt + r) * vstride + key0 + 8 * kq);
}
__device__ __forceinline__ void qk(f32x4& sa, f32x4& sb, const KF& k, const bf16x8 (&q)[2]) {
    const f32x4 z = {0.f, 0.f, 0.f, 0.f};
    sa = MFMA16(k.a0, q[0], z); sa = MFMA16(k.a1, q[1], sa); sb = MFMA16(k.b0, q[0], z); sb = MFMA16(k.b1, q[1], sb);
}
struct BiasCtx { const LAS unsigned short* tb; float d29, d30, c31; };
template <int MODE>
__device__ __forceinline__ void maskbias(f32x4& s, int kpos, int tcol, bool colok, const BiasCtx& B) {
    if (MODE == MD_MEM) return;
#pragma unroll
    for (int i = 0; i < 4; ++i) {
        int dist; bool ok;
        if (MODE == MD_CMP) { dist = tcol - 31 - 16 * (kpos + i); ok = dist >= 0; }
        else if (MODE == MD_WIN) { dist = tcol - (kpos + i); ok = (unsigned)dist <= 511u; }
        else { dist = tcol - (kpos + i); ok = dist >= 0; }
        int dc = dist < 0 ? 0 : dist; dc = dc > 1023 ? 1023 : dc;
        const float tb = __uint_as_float((unsigned)B.tb[dc * 6] << 16);
        const float far = B.c31 + (dist < 1513 ? B.d30 : 0.f) + (dist < 1117 ? B.d29 : 0.f);
        const float bias = dist < 1024 ? tb : far;
        s[i] = (ok && colok) ? s[i] + bias : -INFINITY;
    }
}
__device__ __forceinline__ float colmax(const f32x4& sa, const f32x4& sb) {
    float mx = fmaxf(fmaxf(fmaxf(sa[0], sa[1]), fmaxf(sa[2], sa[3])), fmaxf(fmaxf(sb[0], sb[1]), fmaxf(sb[2], sb[3])));
    mx = fmaxf(mx, __shfl_xor(mx, 16)); mx = fmaxf(mx, __shfl_xor(mx, 32)); return mx;
}
constexpr float SM_THR = 8.f;
__device__ __forceinline__ float lmax8(const f32x4& sa, const f32x4& sb) { return fmaxf(fmaxf(fmaxf(sa[0], sa[1]), fmaxf(sa[2], sa[3])), fmaxf(fmaxf(sb[0], sb[1]), fmaxf(sb[2], sb[3]))); }
__device__ __forceinline__ int imax3(int a, int b, int c) { return max(max(a, b), c); }
__device__ __forceinline__ int imax16(const f32x4& a, const f32x4& b, const f32x4& c, const f32x4& d) {
#define FI_(x) __float_as_int(x)
    const int t0 = imax3(FI_(a[0]), FI_(a[1]), FI_(a[2])), t1 = imax3(FI_(a[3]), FI_(b[0]), FI_(b[1])), t2 = imax3(FI_(b[2]), FI_(b[3]), FI_(c[0])), t3 = imax3(FI_(c[1]), FI_(c[2]), FI_(c[3])), t4 = imax3(FI_(d[0]), FI_(d[1]), FI_(d[2]));
    return max(imax3(t0, t1, FI_(d[3])), imax3(t2, t3, t4));
#undef FI_
}
template <int NO>
__device__ __forceinline__ void sm_rescale(float lm, float& m, float& l, f32x4 (&O)[NO]) {
    if (__any(lm > m + SM_THR)) {
        lm = fmaxf(lm, __shfl_xor(lm, 16)); lm = fmaxf(lm, __shfl_xor(lm, 32));
        const float mn = fmaxf(m, lm); const float al = __builtin_amdgcn_exp2f(m - mn); m = mn; l *= al;
#pragma unroll
        for (int dt = 0; dt < NO; ++dt) O[dt] = O[dt] * al;
    }
}
__device__ __forceinline__ bf16x8 sm_update(const f32x4& sa, const f32x4& sb, float& m, float& l, f32x4 (&O)[4]) {
    sm_rescale<4>(lmax8(sa, sb), m, l, O);
    f32x4 pa, pb; float sum = 0.f;
#pragma unroll
    for (int i = 0; i < 4; ++i) { pa[i] = __builtin_amdgcn_exp2f(sa[i] - m); pb[i] = __builtin_amdgcn_exp2f(sb[i] - m); sum += pa[i] + pb[i]; }
    l += sum;
    return pack8(pa, pb);
}
__device__ __forceinline__ void sm_update64(const f32x4& sa0, const f32x4& sb0, const f32x4& sa1, const f32x4& sb1, float& m, float& l, f32x4 (&O)[4], bf16x8& pf0, bf16x8& pf1) {
    sm_rescale<4>(fmaxf(lmax8(sa0, sb0), lmax8(sa1, sb1)), m, l, O);
    f32x4 pa0, pb0, pa1, pb1; float sum = 0.f;
#pragma unroll
    for (int i = 0; i < 4; ++i) { pa0[i] = __builtin_amdgcn_exp2f(sa0[i] - m); pb0[i] = __builtin_amdgcn_exp2f(sb0[i] - m); pa1[i] = __builtin_amdgcn_exp2f(sa1[i] - m); pb1[i] = __builtin_amdgcn_exp2f(sb1[i] - m);
        sum += (pa0[i] + pb0[i]) + (pa1[i] + pb1[i]); }
    l += sum;
    pf0 = pack8(pa0, pb0); pf1 = pack8(pa1, pb1);
}
enum { BK_FAR = 0, BK_MID = 1, BK_GEN = 2 };
template <int MD, int CLS>
__device__ __forceinline__ void step64(const KF& k0, const KF& k1, const bf16x8 (&q)[2], int cls, int kpos, int tcol, bool colok, const BiasCtx& B,
                                       float& m, float& l, f32x4 (&O)[4], bf16x8& pf0, bf16x8& pf1) {
    const bool has = m > -1e29f; const float mref = has ? m : 0.f;
    if (CLS >= 0) cls = CLS;
    float cin = ((cls == BK_FAR) ? B.c31 : 0.f) - mref; if (!colok) cin = -INFINITY;
    const f32x4 c4 = {cin, cin, cin, cin};
    f32x4 sa0 = MFMA16(k0.a0, q[0], c4), sb0 = MFMA16(k0.b0, q[0], c4), sa1 = MFMA16(k1.a0, q[0], c4), sb1 = MFMA16(k1.b0, q[0], c4);
    sa0 = MFMA16(k0.a1, q[1], sa0); sb0 = MFMA16(k0.b1, q[1], sb0); sa1 = MFMA16(k1.a1, q[1], sa1); sb1 = MFMA16(k1.b1, q[1], sb1);
    if (cls == BK_MID) {
        const LAS unsigned short* tl = B.tb + (tcol - kpos - 39) * 6;
#pragma unroll
        for (int i = 0; i < 4; ++i) { sa0[i] += __uint_as_float((unsigned)tl[6 * (39 - i)] << 16); sb0[i] += __uint_as_float((unsigned)tl[6 * (35 - i)] << 16);
            sa1[i] += __uint_as_float((unsigned)tl[6 * (7 - i)] << 16); sb1[i] += __uint_as_float((unsigned)tl[6 * (3 - i)] << 16); }
    } else if (cls == BK_GEN) {
        maskbias<MD>(sa0, kpos, tcol, true, B); maskbias<MD>(sb0, kpos + 4, tcol, true, B); maskbias<MD>(sa1, kpos + 32, tcol, true, B); maskbias<MD>(sb1, kpos + 36, tcol, true, B);
    }
    if (__any((imax16(sa0, sb0, sa1, sb1) > __float_as_int(SM_THR)) || !has)) {
        float lm = fmaxf(lmax8(sa0, sb0), lmax8(sa1, sb1));
        lm = fmaxf(lm, __shfl_xor(lm, 16)); lm = fmaxf(lm, __shfl_xor(lm, 32));
        const bool upd = (lm > -INFINITY) && (!has || lm > 0.f); const float dl = upd ? lm : 0.f;
        if (upd) m = mref + dl;
        const float f = has ? __builtin_amdgcn_exp2f(-dl) : 1.f; l *= f;
#pragma unroll
        for (int dt = 0; dt < 4; ++dt) O[dt] = O[dt] * f;
#pragma unroll
        for (int i = 0; i < 4; ++i) { sa0[i] -= dl; sb0[i] -= dl; sa1[i] -= dl; sb1[i] -= dl; }
    }
    f32x4 pa0, pb0, pa1, pb1; float sum = 0.f;
#pragma unroll
    for (int i = 0; i < 4; ++i) { pa0[i] = __builtin_amdgcn_exp2f(sa0[i]); pb0[i] = __builtin_amdgcn_exp2f(sb0[i]); pa1[i] = __builtin_amdgcn_exp2f(sa1[i]); pb1[i] = __builtin_amdgcn_exp2f(sb1[i]);
        sum += (pa0[i] + pb0[i]) + (pa1[i] + pb1[i]); }
    l += sum;
    pf0 = pack8(pa0, pb0); pf1 = pack8(pa1, pb1);
}
__device__ __forceinline__ void pv(f32x4 (&O)[4], const VF& v, const bf16x8& pf) {
#pragma unroll
    for (int dt = 0; dt < 4; ++dt) O[dt] = MFMA16(v.v[dt], pf, O[dt]);
}
__device__ __forceinline__ void lds_fadd(LAS float* p, float v) { (void)__hip_atomic_fetch_add((float*)p, v, __ATOMIC_RELAXED, __HIP_MEMORY_SCOPE_WORKGROUP); }
#define DPP_I(x, ctrl) __builtin_amdgcn_update_dpp((x), (x), (ctrl), 0xf, 0xf, false)
#define DPP_F(x, ctrl) __int_as_float(__builtin_amdgcn_update_dpp(__float_as_int(x), __float_as_int(x), (ctrl), 0xf, 0xf, false))
__device__ __forceinline__ float sum8_dpp(float v) { v += DPP_F(v, 0xB1); v += DPP_F(v, 0x4E); v += DPP_F(v, 0x141); return v; }
__device__ __forceinline__ int wmax64_i(int x) {
    x = max(x, DPP_I(x, 0xB1)); x = max(x, DPP_I(x, 0x4E)); x = max(x, DPP_I(x, 0x141)); x = max(x, DPP_I(x, 0x140));
    return max(max(__builtin_amdgcn_readlane(x, 0), __builtin_amdgcn_readlane(x, 16)), max(__builtin_amdgcn_readlane(x, 32), __builtin_amdgcn_readlane(x, 48))); }
__device__ __forceinline__ float kqsum(float v) { v += __shfl_xor(v, 16); v += __shfl_xor(v, 32); return v; }
__device__ __forceinline__ float wmax64(float v) {
#pragma unroll
    for (int o = 1; o < 64; o <<= 1) v = fmaxf(v, __shfl_xor(v, o));
    return v;
}
__device__ __forceinline__ void out_add(LAS unsigned short* OUTw, int p, int n, int kq, const f32x4 (&O)[4], float scale, bool first) {
    const int q = 2 * p + (n >> 3), hd = n & 7;
    if (hd < 6) { LAS v2u* dst = (LAS v2u*)(OUTw + (q * 6 + hd) * 64) + kq;
#pragma unroll
        for (int dt = 0; dt < 4; ++dt) { f32x4 v = O[dt] * scale; if (!first) { const v2u o = dst[4 * dt]; v[0] += __uint_as_float(o.x << 16); v[1] += __uint_as_float(o.x & 0xffff0000u); v[2] += __uint_as_float(o.y << 16); v[3] += __uint_as_float(o.y & 0xffff0000u); }
            dst[4 * dt] = (v2u){pk2(v[0], v[1]), pk2(v[2], v[3])}; } }
}

__device__ __forceinline__ void p2_mfma(Frame& F, const In& I, unsigned char* ws) {
    OPAQUE_TID(); KARGS(); const int lane = tid_ & 63, wave = __builtin_amdgcn_readfirstlane(tid_ >> 6), r = lane & 15, kq = lane >> 4;
    const bf16* KV0 = (const bf16*)(ws + WS_KV0); const bf16* W1T = (const bf16*)(ws + WS_W1T); const bf16* W2T = (const bf16*)(ws + WS_W2T); const float* B1F = (const float*)(ws + WS_B1F);
    const bf16* MEMN = (const bf16*)(ws + WS_MEMN); const bf16* WMKT = (const bf16*)(ws + WS_WMKT);
    bf16* KCB = (bf16*)(ws + WS_KCB); bf16* VCT = (bf16*)(ws + WS_VCT); bf16* MKB = (bf16*)(ws + WS_MKB); bf16* MVT = (bf16*)(ws + WS_MVT);
    LAS unsigned char* hid = F.lds + RING_OFF;
    for (int u = blockIdx.x; u < 192; u += F.G) {
        const bool cmp = u < 128;
        const bf16* ap[2]; const bf16* bp[2]; int K, kjump;
        int kv = 0, bg = 0, n0 = 0, lay = 0, m0 = 0, ch = 0;
        if (cmp) { kv = u >> 6; bg = (u >> 4) & 3; n0 = (u & 15) * 32; const int b = bg >> 1, g = bg & 1; K = 2048; kjump = 512 - 64;
#pragma unroll
            for (int rt = 0; rt < 2; ++rt) { int nn = n0 + 16 * rt + r; nn = nn > 510 ? 510 : nn; ap[rt] = KV0 + (size_t)(b * T + 16 * nn) * 512 + kv * 128 + g * 64 + 8 * kq; }
#pragma unroll
            for (int ct = 0; ct < 2; ++ct) bp[ct] = W1T + (size_t)(kv * 256 + 32 * wave + 16 * ct + r) * 2048 + 8 * kq;
        } else { const int v = u - 128; lay = v >> 5; m0 = ((v >> 1) & 15) * 32; ch = v & 1; K = 1024; kjump = 0;
#pragma unroll
            for (int rt = 0; rt < 2; ++rt) ap[rt] = MEMN + (size_t)(lay * 512 + m0 + 16 * rt + r) * 1024 + 8 * kq;
#pragma unroll
            for (int ct = 0; ct < 2; ++ct) bp[ct] = WMKT + (size_t)(lay * 512 + ch * 256 + 32 * wave + 16 * ct + r) * 1024 + 8 * kq;
        }
        f32x4 acc[2][2];
#pragma unroll
        for (int rt = 0; rt < 2; ++rt)
#pragma unroll
            for (int ct = 0; ct < 2; ++ct) acc[rt][ct] = (f32x4){0.f, 0.f, 0.f, 0.f};
        bf16x8 a[2][2], bb[2][2];
#define P2_LOAD(A_, B_, kb_) do { const int kbl_ = (kb_) < K ? (kb_) : K - 64; const int ao_ = kbl_ + (kbl_ >> 6) * kjump; \
            _Pragma("unroll") for (int h2 = 0; h2 < 2; ++h2) { \
                _Pragma("unroll") for (int rt = 0; rt < 2; ++rt) A_[rt][h2] = ldg16(ap[rt] + ao_ + 32 * h2); \
                _Pragma("unroll") for (int ct = 0; ct < 2; ++ct) B_[ct][h2] = ldg16(bp[ct] + kbl_ + 32 * h2); } } while (0)
        P2_LOAD(a, bb, 0);
        for (int kb = 0; kb < K; kb += 64) {
            bf16x8 an[2][2], bn[2][2]; P2_LOAD(an, bn, kb + 64);
#pragma unroll
            for (int h2 = 0; h2 < 2; ++h2)
#pragma unroll
                for (int rt = 0; rt < 2; ++rt)
#pragma unroll
                    for (int ct = 0; ct < 2; ++ct) acc[rt][ct] = MFMA16(a[rt][h2], bb[ct][h2], acc[rt][ct]);
#pragma unroll
            for (int h2 = 0; h2 < 2; ++h2)
#pragma unroll
                for (int x = 0; x < 2; ++x) { a[x][h2] = an[x][h2]; bb[x][h2] = bn[x][h2]; }
        }
#undef P2_LOAD
        if (cmp) {
#pragma unroll
            for (int ct = 0; ct < 2; ++ct) { const int col = 32 * wave + 16 * ct + r; const float bias = (kv ? Ip->v_b1 : Ip->k_b1)[col] + ((B1F[(kv * 4 + 0) * 256 + col] + B1F[(kv * 4 + 1) * 256 + col]) + (B1F[(kv * 4 + 2) * 256 + col] + B1F[(kv * 4 + 3) * 256 + col]));
#pragma unroll
                for (int rt = 0; rt < 2; ++rt)
#pragma unroll
                    for (int i = 0; i < 4; ++i) { const float xg = acc[rt][ct][i] + bias; const float hv = 0.5f * xg * (1.f + tanhf(0.7978845608028654f * (xg + 0.044715f * xg * xg * xg)));
                        *(LAS unsigned short*)(hid + (16 * rt + 4 * kq + i) * 528 + 2 * col) = (unsigned short)f2bf(hv); } }
            __syncthreads();
            { const int rt2 = wave >> 2, ct2 = wave & 3; f32x4 o = {0.f, 0.f, 0.f, 0.f};
              const bf16* w2p = W2T + (size_t)(kv * 64 + 16 * ct2 + r) * 256 + 8 * kq;
#pragma unroll
              for (int ks = 0; ks < 8; ++ks) { const bf16x8 av = *(const LAS bf16x8*)(hid + (16 * rt2 + r) * 528 + 64 * ks + 16 * kq); o = MFMA16(av, ldg16(w2p + 32 * ks), o); }
              const int d = 16 * ct2 + r; const float b2v = (kv ? Ip->v_b2 : Ip->k_b2)[d];
#pragma unroll
              for (int i = 0; i < 4; ++i) { const int nn = n0 + 16 * rt2 + 4 * kq + i; const unsigned short ov = (nn < NCMP) ? (unsigned short)f2bf(o[i] + b2v) : (unsigned short)0;
                  if (kv) VCT[(size_t)(bg * 64 + d) * 512 + nn] = ov; else KCB[(size_t)(bg * 512 + nn) * 64 + d] = ov; } }
            __syncthreads();
        } else {
#pragma unroll
            for (int ct = 0; ct < 2; ++ct) { const int col = 32 * wave + 16 * ct + r;
#pragma unroll
                for (int rt = 0; rt < 2; ++rt)
#pragma unroll
                    for (int i = 0; i < 4; ++i) { const int mrow = m0 + 16 * rt + 4 * kq + i; const unsigned short ov = (unsigned short)f2bf(acc[rt][ct][i]);
                        if (ch == 0) MKB[(size_t)(lay * 512 + mrow) * 256 + col] = ov; else MVT[(size_t)(lay * 256 + col) * 512 + mrow] = ov; } }
        }
    }
}

template <int MODE>
__device__ __forceinline__ void mb2(f32x4& sa, f32x4& sb, int kpos, int tcol, bool colok, bool fast, const BiasCtx& B) {
    if (fast) { if (colok) { sa = sa + B.c31; sb = sb + B.c31; } else { sa = (f32x4){-INFINITY, -INFINITY, -INFINITY, -INFINITY}; sb = sa; } }
    else { maskbias<MODE>(sa, kpos, tcol, colok, B); maskbias<MODE>(sb, kpos + 4, tcol, colok, B); }
}
#define SWZ(row) (((((row) >> 3) & 3) << 1) | (((row) >> 1) & 1))
struct KV1 { KF k; VF v; };
__device__ __forceinline__ void load_kv(KV1& d, const bf16* kb, int kstride, const bf16* vt, int vstride, int key0, int r, int kq) { load_k(d.k, kb, kstride, key0, r, kq); load_vt(d.v, vt, vstride, key0, r, kq); }

template <int MD, int FORCE = 0>
__device__ __forceinline__ void nsa_sweep(LAS unsigned char* STG, const bf16* ksb, const bf16* vst, int jlo, int jhi, int qt, const LAS unsigned* WMw, int wave, int lane, int r, int kq, int qsel, int t0w,
                                          const bf16x8 (&qf)[4][2], const BiasCtx& BC, float (&m)[4], float (&l)[4], f32x4 (&O)[4][4],
                                          int kstr = 512, int kblk = 64 * 512, int vstr = 64, int vblk = 16384) {
            const int srow = 8 * wave + (lane >> 3), sch = (lane & 7) ^ SWZ(srow);
            const bf16* ksrc = ksb + (size_t)srow * kstr + 8 * sch; const bf16* vsrc = vst + (size_t)srow * vstr + 8 * sch;
#define NSA_DMA(jb) do { LAS unsigned char* d_ = STG + ((jb) % 6) * 16384 + wave * 1024; \
                __builtin_amdgcn_global_load_lds((const unsigned*)(ksrc + (size_t)(jb) * kblk), (LAS unsigned*)d_, 16, 0, 0); \
                __builtin_amdgcn_global_load_lds((const unsigned*)(vsrc + (size_t)(jb) * vblk), (LAS unsigned*)(d_ + 8192), 16, 0, 0); } while (0)
#define NSA_WAITV(n_) do { if ((n_) >= 4) asm volatile("s_waitcnt vmcnt(4) lgkmcnt(0)" ::: "memory"); else if ((n_) == 2) asm volatile("s_waitcnt vmcnt(2) lgkmcnt(0)" ::: "memory"); else asm volatile("s_waitcnt vmcnt(0) lgkmcnt(0)" ::: "memory"); } while (0)
            { const int nb = jhi - jlo + 1;
#pragma unroll
              for (int i = 0; i < 4; ++i) if (i < nb) NSA_DMA(jlo + i);
              const int issued = nb < 4 ? nb : 4, need = nb < 2 ? nb : 2; NSA_WAITV(2 * (issued - need)); }
            __builtin_amdgcn_s_barrier();
#define NSA_TILES(CLS_) _Pragma("unroll") for (int p = 0; p < 4; ++p) if (m8 & (3u << (2 * p))) { \
                        bf16x8 pf0, pf1; \
                        step64<MD, CLS_>(k0, k1, qf[p], cls, 64 * j + 8 * kq_, t0w + 2 * p + qs_, ((m8 >> (2 * p + qs_)) & 1u) != 0u, BC, m[p], l[p], O[p], pf0, pf1); \
                        pv(O[p], v0, pf0); pv(O[p], v1, pf1); \
                        __builtin_amdgcn_sched_barrier(0); }
            auto tiles = [&](auto clsx, int j) __attribute__((always_inline)) { constexpr int CLSX = decltype(clsx)::value;
                const LAS unsigned char* sk = STG + (j % 6) * 16384; const LAS unsigned char* sv = sk + 8192;
                unsigned m8 = 0xffu; if (WMw) m8 = (unsigned)__builtin_amdgcn_readfirstlane((int)((WMw[j >> 2] >> (8 * (j & 3))) & 0xffu)); if (FORCE == 1) m8 = 0u; if (FORCE == 2) m8 = 0xffu; if (MD == MD_MEM) m8 = 3u; else asm volatile("" : "+s"(m8));
                if (m8) {
                    int r_ = r, kq_ = kq, qs_ = qsel; asm volatile("" : "+v"(r_), "+v"(kq_), "+v"(qs_));
                    const int dj = qt - j; const int cls = (MD == MD_MEM) ? BK_FAR : (MD == MD_WIN) ? ((dj >= 1 && dj <= 7) ? BK_MID : BK_GEN) : ((64 * dj - 63 >= 1513) ? BK_FAR : ((dj >= 1 && dj <= 15) ? BK_MID : BK_GEN));
                    KF k0, k1;
                    { const int ka = 8 * (r_ >> 2) + (r_ & 3), kb2 = ka + 4, kc = ka + 32, kd = ka + 36;
                      k0.a0 = *(const LAS bf16x8*)(sk + ka * 128 + ((kq_ ^ SWZ(ka)) << 4)); k0.a1 = *(const LAS bf16x8*)(sk + ka * 128 + (((4 + kq_) ^ SWZ(ka)) << 4));
                      k0.b0 = *(const LAS bf16x8*)(sk + kb2 * 128 + ((kq_ ^ SWZ(kb2)) << 4)); k0.b1 = *(const LAS bf16x8*)(sk + kb2 * 128 + (((4 + kq_) ^ SWZ(kb2)) << 4));
                      k1.a0 = *(const LAS bf16x8*)(sk + kc * 128 + ((kq_ ^ SWZ(kc)) << 4)); k1.a1 = *(const LAS bf16x8*)(sk + kc * 128 + (((4 + kq_) ^ SWZ(kc)) << 4));
                      k1.b0 = *(const LAS bf16x8*)(sk + kd * 128 + ((kq_ ^ SWZ(kd)) << 4)); k1.b1 = *(const LAS bf16x8*)(sk + kd * 128 + (((4 + kq_) ^ SWZ(kd)) << 4)); }
                    VF v0, v1;
#pragma unroll
                    for (int dt = 0; dt < 4; ++dt) { const int dd = 16 * dt + r_; v0.v[dt] = *(const LAS bf16x8*)(sv + dd * 128 + ((kq_ ^ SWZ(dd)) << 4)); v1.v[dt] = *(const LAS bf16x8*)(sv + dd * 128 + (((4 + kq_) ^ SWZ(dd)) << 4)); }
                    NSA_TILES(CLSX)
                }
            };
            int ni = 0;
            auto blk = [&](auto clsx, int j) __attribute__((always_inline)) {
                const bool head = ((j - jlo) & 1) == 0;
                if (head) { ni = 0; if (j + 4 <= jhi) { NSA_DMA(j + 4); ni += 2; } if (j + 5 <= jhi) { NSA_DMA(j + 5); ni += 2; } }
                tiles(clsx, j);
                if (!head || j == jhi) { NSA_WAITV(ni); __builtin_amdgcn_s_barrier(); }
            };
            int j = jlo;
            if (MD == MD_BLK || MD == MD_MEM) { const int jfar = (MD == MD_MEM) ? jhi : ((qt - 25 < jhi) ? qt - 25 : jhi); const int jfe = jlo + (((jfar - jlo + 1) >> 1) << 1) - 1;
                for (; j <= jfe; ++j) blk(std::integral_constant<int, BK_FAR>{}, j); }
            for (; j <= jhi; ++j) blk(std::integral_constant<int, -1>{}, j);
#undef NSA_WAITV
#undef NSA_TILES
#undef NSA_DMA
}
__device__ __forceinline__ void p3_nsa_mfma(Frame& F, const In& I, unsigned char* ws) {
    OPAQUE_TID(); KARGS(); const int wave = __builtin_amdgcn_readfirstlane(tid_ >> 6);
    LAS float* b12 = (LAS float*)(F.lds + TAB_B12);
    LAS unsigned short* OUTw = (LAS unsigned short*)(F.lds + NSA_OUT) + wave * 3072;
    LAS float* PSw = (LAS float*)(F.lds + NSA_PSQ) + wave * 1024;
    LAS unsigned char* STG = F.lds + NSA_PSQ;
    LAS unsigned* WMw = (LAS unsigned*)(F.lds + NSA_ST) + wave * 32;
    for (int i = tid_; i < 512; i += NWAVES * 64) b12[i] = ((i & 15) < 12) ? Ip->rel_bias[(i >> 4) * 12 + (i & 15)] * LOG2E : 0.f;
    LAS unsigned short* TB = (LAS unsigned short*)(F.lds + NSA_TB);
    { const int gg = (int)blockIdx.x & 1;
      for (int i = tid_; i < 6144; i += NWAVES * 64) { const int dd = i / 6, hh = i % 6; TB[i] = (unsigned short)f2bf(Ip->rel_bias[rel_bucket(dd) * 12 + gg * 6 + hh] * LOG2E); } }
    __syncthreads();
    const bf16* Q0 = (const bf16*)(ws + WS_Q0); const bf16* KV0 = (const bf16*)(ws + WS_KV0); const bf16* QM = (const bf16*)(ws + WS_QM); const bf16* G0 = (const bf16*)(ws + WS_G0);
    const bf16* VT = (const bf16*)(ws + WS_VT); const bf16* KCB = (const bf16*)(ws + WS_KCB); const bf16* VCT = (const bf16*)(ws + WS_VCT);
    const bf16* MKB = (const bf16*)(ws + WS_MKB); const bf16* MVT = (const bf16*)(ws + WS_MVT);
    bf16* CAT = (bf16*)(ws + WS_CAT);
    const int nun = 4 * 128;
    for (int ui = blockIdx.x; ui < nun; ui += F.G) {
        int tl_ = tid_; asm volatile("" : "+v"(tl_));
        const int lane = tl_ & 63, n = lane & 15, kq = lane >> 4, r = n, hd = n & 7, qsel = n >> 3; const bool colv = hd < 6;
        int bg, qt;
        bg = blockIdx.x & 3;
        if (F.G == 256) { const int idx = blockIdx.x >> 2; qt = (ui < 256) ? idx : 127 - idx; }
        else { qt = ui >> 2; if ((ui & 3) != bg) continue; }
        const int b = bg >> 1, g = bg & 1, t0w = 64 * qt + 8 * wave, rowb = b * T;
        const int habs = g * 6 + (colv ? hd : 0);
        const LAS float* b12c = b12 + habs; const BiasCtx BC{TB + (colv ? hd : 0), b12c[29 * 16] - b12c[30 * 16], b12c[30 * 16] - b12c[31 * 16], b12c[31 * 16]};

        bf16x8 qf[4][2];
#pragma unroll
        for (int p = 0; p < 4; ++p) { const bf16* qp = Q0 + (size_t)(rowb + t0w + 2 * p + qsel) * 768 + habs * 64 + 8 * kq;
#pragma unroll
            for (int ks = 0; ks < 2; ++ks) { bf16x8 v = ldg16(qp + 32 * ks); if (!colv) v = (bf16x8){0, 0, 0, 0, 0, 0, 0, 0}; qf[p][ks] = v; } }
        float m[4], l[4]; f32x4 O[4][4];
        if (PROBE_REP == 6 || PROBE_REP == 7) {
            const bf16* ksb_ = KV0 + (size_t)rowb * 512 + 256 + g * 64; const bf16* vst_ = VT + ((size_t)(rowb >> 6) * 256 + g * 64) * 64;
#pragma unroll
            for (int p = 0; p < 4; ++p) { m[p] = -1e30f; l[p] = 0.f;
#pragma unroll
                for (int dt = 0; dt < 4; ++dt) O[p][dt] = (f32x4){0.f, 0.f, 0.f, 0.f}; }
            __syncthreads();
            nsa_sweep<MD_BLK, (PROBE_REP == 6 ? 2 : 1)>(STG, ksb_, vst_, 0, qt, qt, WMw, wave, lane, r, kq, qsel, t0w, qf, BC, m, l, O);
            float* dump = (float*)(ws + WS_OCS) + ((size_t)blockIdx.x * 512 + tid_) * 4;
#pragma unroll
            for (int p = 0; p < 4; ++p) dump[p] = l[p] + O[p][0][0] + O[p][1][1] + O[p][2][2] + O[p][3][3];
            __syncthreads(); }
        for (int i = lane; i < 1024; i += 64) PSw[i] = 0.f;
        const int ncmax = (t0w + 7 >= 31) ? ((t0w + 7 - 31) / 16 + 1) : 0;
        const bf16* kcb = KCB + (size_t)(bg * 512) * 64; const bf16* vct = VCT + (size_t)(bg * 64) * 512;
#pragma unroll
        for (int p = 0; p < 4; ++p) { m[p] = -1e30f; l[p] = 0.f; }
        if (ncmax > 0) {
            int r_ = r, kq_ = kq; asm volatile("" : "+v"(r_), "+v"(kq_));
            for (int key0 = 0; key0 < ncmax; key0 += 32) {
                asm volatile("" : "+v"(r_), "+v"(kq_));
                KF kA; load_k(kA, kcb, 64, key0, r_, kq_);
                const bool fast = (t0w - 31 - 16 * (key0 + 31)) >= 1513;
#pragma unroll
                for (int p = 0; p < 4; ++p) { f32x4 sa, sb; qk(sa, sb, kA, qf[p]); const int tcol = t0w + 2 * p + qsel;
                    mb2<MD_CMP>(sa, sb, key0 + 8 * kq_, tcol, true, fast, BC);
                    const float mn = fmaxf(m[p], lmax8(sa, sb)); float sum = 0.f;
#pragma unroll
                    for (int i = 0; i < 4; ++i) sum += __builtin_amdgcn_exp2f(sa[i] - mn) + __builtin_amdgcn_exp2f(sb[i] - mn);
                    l[p] = l[p] * __builtin_amdgcn_exp2f(m[p] - mn) + sum; m[p] = mn; __builtin_amdgcn_sched_barrier(0); }
            }
        }
        float invl[4];
#pragma unroll
        for (int p = 0; p < 4; ++p) { float mc = m[p]; mc = fmaxf(mc, __shfl_xor(mc, 16)); mc = fmaxf(mc, __shfl_xor(mc, 32));
            const float lt = kqsum(l[p] * __builtin_amdgcn_exp2f(m[p] - mc)); m[p] = mc; invl[p] = lt > 0.f ? 1.f / lt : 0.f; }
#pragma unroll
        for (int p = 0; p < 4; ++p)
#pragma unroll
            for (int dt = 0; dt < 4; ++dt) O[p][dt] = (f32x4){0.f, 0.f, 0.f, 0.f};
        float carry[4] = {0.f, 0.f, 0.f, 0.f};
        if (ncmax > 0) {
            int r_ = r, kq_ = kq; asm volatile("" : "+v"(r_), "+v"(kq_));
            for (int key0 = 0; key0 < ncmax; key0 += 32) {
                asm volatile("" : "+v"(r_), "+v"(kq_));
                KV1 A; load_kv(A, kcb, 64, vct, 512, key0, r_, kq_);
                const bool fast = (t0w - 31 - 16 * (key0 + 31)) >= 1513;
#pragma unroll
                for (int p = 0; p < 4; ++p) { f32x4 sa, sb; qk(sa, sb, A.k, qf[p]); const int tcol = t0w + 2 * p + qsel;
                    mb2<MD_CMP>(sa, sb, key0 + 8 * kq_, tcol, true, fast, BC);
                    f32x4 pa, pb;
#pragma unroll
                    for (int i = 0; i < 4; ++i) { pa[i] = __builtin_amdgcn_exp2f(sa[i] - m[p]) * invl[p]; pb[i] = __builtin_amdgcn_exp2f(sb[i] - m[p]) * invl[p]; }
                    pv(O[p], A.v, pack8(pa, pb));
                    float wA = (pa[0] + pa[1]) + (pa[2] + pa[3]), wB = pa[3] + ((pb[0] + pb[1]) + (pb[2] + pb[3])), wC = pb[3];
                    if (!colv) { wA = 0.f; wB = 0.f; wC = 0.f; }
                    const float up = __shfl(wC, (lane + 48) & 63);
                    const float prevC = (kq == 0) ? carry[p] : up; carry[p] = up;
                    float a0 = wA + prevC, a1 = wB;
                    a0 = sum8_dpp(a0); a1 = sum8_dpp(a1);
                    if (hd == 0) { LAS float* ps = PSw + (2 * p + qsel) * 128 + (key0 >> 2) + 2 * kq; ps[0] = a0; ps[1] = a1; } __builtin_amdgcn_sched_barrier(0); }
            }
        }
        if (ncmax > 0 && ncmax <= 480) {
            const int jn = ((ncmax + 31) >> 5) * 8;
#pragma unroll
            for (int p = 0; p < 4; ++p) { float a0 = sum8_dpp(carry[p]); if (hd == 0 && kq == 0) PSw[(2 * p + qsel) * 128 + jn] = a0; }
        }
        {
#pragma unroll
            for (int p = 0; p < 4; ++p) { const size_t row = (size_t)(rowb + t0w + 2 * p + qsel);
                const float gz = bf2f(G0[row * 256 + habs * 3 + 0]) + Ip->nsa_gate_b[habs * 3 + 0]; out_add(OUTw, p, n, kq, O[p], 1.f / (1.f + __expf(-gz)), true); }
        }
        for (int i = lane; i < 32; i += 64) WMw[i] = (qt < 16) ? 0xffffffffu : 0u;
        if (qt >= 16) {
            if (lane < 3) { const int j = lane == 0 ? 0 : qt - 2 + lane; atomicOr((unsigned*)&WMw[j >> 2], 0xffu << (8 * (j & 3))); }
            for (int q = 0; q < 8; ++q) {
                int v0 = __float_as_int(PSw[q * 128 + lane] + 0.f), v1 = __float_as_int(PSw[q * 128 + 64 + lane] + 0.f);
                if (lane < 1 || lane > qt - 2) v0 = __float_as_int(-1.f); if (lane + 64 > qt - 2) v1 = __float_as_int(-1.f);
                for (int s = 0; s < 13; ++s) { const int mx = wmax64_i(max(v0, v1));
                    const unsigned long long b0 = __ballot(v0 == mx); int j;
                    if (b0) { j = __builtin_ctzll(b0); if (lane == j) v0 = __float_as_int(-1.f); } else { const unsigned long long b1 = __ballot(v1 == mx); j = __builtin_ctzll(b1); if (lane == j) v1 = __float_as_int(-1.f); j += 64; }
                    if (lane == 0) atomicOr((unsigned*)&WMw[j >> 2], 1u << (8 * (j & 3) + q)); }
            }
        }
        const bf16* ksb = KV0 + (size_t)rowb * 512 + 256 + g * 64; const bf16* vst = VT + ((size_t)(rowb >> 6) * 256 + g * 64) * 64;
        __syncthreads();
#pragma unroll 1
        for (int rep_ = 0; rep_ < (PROBE_REP == 1 ? 2 : 1); ++rep_) {
#pragma unroll
            for (int p = 0; p < 4; ++p) { m[p] = -1e30f; l[p] = 0.f;
#pragma unroll
                for (int dt = 0; dt < 4; ++dt) O[p][dt] = (f32x4){0.f, 0.f, 0.f, 0.f}; }
            nsa_sweep<MD_BLK>(STG, ksb, vst, 0, qt, qt, WMw, wave, lane, r, kq, qsel, t0w, qf, BC, m, l, O);
        }
        { int qs2_ = qsel; asm volatile("" : "+v"(qs2_));
#pragma unroll
        for (int p = 0; p < 4; ++p) { const size_t row = (size_t)(rowb + t0w + 2 * p + qs2_);
            const float gz = bf2f(G0[row * 256 + habs * 3 + 1]) + Ip->nsa_gate_b[habs * 3 + 1]; out_add(OUTw, p, n, kq, O[p], (1.f / (1.f + __expf(-gz))) / kqsum(l[p]), false); } }
        const bf16* kwb = KV0 + (size_t)rowb * 512 + 384 + g * 64; const bf16* vwt = VT + ((size_t)(rowb >> 6) * 256 + 128 + g * 64) * 64;
#pragma unroll
        for (int p = 0; p < 4; ++p) { m[p] = -1e30f; l[p] = 0.f;
#pragma unroll
            for (int dt = 0; dt < 4; ++dt) O[p][dt] = (f32x4){0.f, 0.f, 0.f, 0.f}; }
        __syncthreads();
        nsa_sweep<MD_WIN>(STG, kwb, vwt, (qt >= 8) ? qt - 8 : 0, qt, qt, nullptr, wave, lane, r, kq, qsel, t0w, qf, BC, m, l, O);
        if (PROBE_REP == 4) {
#pragma unroll
            for (int p = 0; p < 4; ++p) { m[p] = -1e30f; l[p] = 0.f;
#pragma unroll
                for (int dt = 0; dt < 4; ++dt) O[p][dt] = (f32x4){0.f, 0.f, 0.f, 0.f}; }
            nsa_sweep<MD_WIN>(STG, kwb, vwt, (qt >= 8) ? qt - 8 : 0, qt, qt, nullptr, wave, lane, r, kq, qsel, t0w, qf, BC, m, l, O); }
        { int qs3_ = qsel; asm volatile("" : "+v"(qs3_));
#pragma unroll
        for (int p = 0; p < 4; ++p) { const size_t row = (size_t)(rowb + t0w + 2 * p + qs3_);
            const float gz = bf2f(G0[row * 256 + habs * 3 + 2]) + Ip->nsa_gate_b[habs * 3 + 2]; out_add(OUTw, p, n, kq, O[p], (1.f / (1.f + __expf(-gz))) / kqsum(l[p]), false); } }
        int ln_ = lane; asm volatile("" : "+v"(ln_));
#pragma unroll 1
        for (int i = 0; i < 6; ++i) { const int e = i * 64 + ln_, q = e / 48, c8 = e % 48;
            *(v4u*)(CAT + (size_t)(rowb + t0w + q) * 1024 + g * 384 + 8 * c8) = ((const LAS v4u*)OUTw)[e]; }
#pragma unroll 1
        for (int h2 = 0; h2 < 2; ++h2) { const int hm = 2 * g + h2;
            int ln2_ = lane; asm volatile("" : "+v"(ln2_)); const int nn = ln2_ & 15, kqq = ln2_ >> 4;
#pragma unroll
            for (int p = 0; p < 4; ++p) { qf[p][0] = (bf16x8){0, 0, 0, 0, 0, 0, 0, 0}; qf[p][1] = qf[p][0]; m[p] = -1e30f; l[p] = 0.f;
#pragma unroll
                for (int dt = 0; dt < 4; ++dt) O[p][dt] = (f32x4){0.f, 0.f, 0.f, 0.f}; }
            { const bf16* qp = QM + (size_t)(rowb + t0w + (nn & 7)) * 256 + hm * 64 + 8 * kqq; if (nn < 8) { qf[0][0] = ldg16(qp); qf[0][1] = ldg16(qp + 32); } }
            const BiasCtx BCm{BC.tb, 0.f, 0.f, 0.f};
            nsa_sweep<MD_MEM>(STG, MKB + (size_t)(b * 256) * 256 + hm * 64, MVT + (size_t)(hm * 64) * 512 + b * 256, 0, 3, 0, nullptr, wave, ln2_, nn, kqq, nn >> 3, 0, qf, BCm, m, l, O, 256, 64 * 256, 512, 64);
            const float il = 1.f / kqsum(l[0]);
            if (nn < 8) { bf16* op = CAT + (size_t)(rowb + t0w + nn) * 1024 + 768 + hm * 64 + 4 * kqq;
#pragma unroll
                for (int dt = 0; dt < 4; ++dt) *(uint2*)(op + 16 * dt) = make_uint2(pk2(O[0][dt][0] * il, O[0][dt][1] * il), pk2(O[0][dt][2] * il, O[0][dt][3] * il)); }
        }
    }
}

__device__ __forceinline__ void p10_dsa_norm(Frame& F, const In& I, unsigned char* ws) {
    OPAQUE_TID(); KARGS(); const int gw = F.vcu * NWAVES + (tid_ >> 6), NGW = F.G * NWAVES, lane = tid_ & 63;
    const bf16* PR = (const bf16*)(ws + WS_PROJ1); bf16* CQ = (bf16*)(ws + WS_CQ); bf16* CKV = (bf16*)(ws + WS_CKV); bf16* KIDX = (bf16*)(ws + WS_KIDX); float* WIDX = (float*)(ws + WS_WIDX);
    for (int m = gw; m < M; m += NGW) {
        const bf16* pr = PR + (size_t)m * 768;
        float a[4]; ld4bf(pr + 4 * lane, a);
        float s = wave_sum(a[0] * a[0] + a[1] * a[1] + a[2] * a[2] + a[3] * a[3]); float r = rsqrtf(s * (1.f / 256.f) + EPSF);
        const float4 gq = *(const float4*)(Ip->q_norm + 4 * lane);
        *(uint2*)(CQ + (size_t)m * 256 + 4 * lane) = make_uint2(pk2((a[0] * r) * gq.x, (a[1] * r) * gq.y), pk2((a[2] * r) * gq.z, (a[3] * r) * gq.w));
        const unsigned u = *(const unsigned*)(pr + 256 + 2 * lane); const float c0 = bflo(u), c1 = bfhi(u);
        s = wave_sum(c0 * c0 + c1 * c1); r = rsqrtf(s * (1.f / 128.f) + EPSF);
        *(unsigned*)(CKV + (size_t)m * 128 + 2 * lane) = pk2((c0 * r) * Ip->kv_norm[2 * lane], (c1 * r) * Ip->kv_norm[2 * lane + 1]);
        const float k0 = bf2f(pr[384 + lane]);
        s = wave_sum(k0 * k0); r = rsqrtf(s * (1.f / 64.f) + EPSF);
        { const int tk = m >> 5, key = m & 31, ks = lane >> 4, hf = (lane >> 3) & 1, jj = lane & 7;
          KIDX[((size_t)(tk * 4 + ks) * 64 + hf * 32 + key) * 8 + jj] = (bf16)f2bf((k0 * r) * Ip->kidx_norm[lane]); }
        if (lane < 8) WIDX[(size_t)m * 8 + lane] = bf2f(pr[448 + lane]) * (0.35355339059327373f * 0.125f);
    }
}

#define MFMA32(A, B, C) __builtin_amdgcn_mfma_f32_32x32x16_bf16((A), (B), (C), 0, 0, 0)
typedef float f32x16 __attribute__((ext_vector_type(16)));
constexpr int XL_OFF = RING_BYTES;
constexpr int IDX_HIST = XL_OFF, IDX_CAND = XL_OFF + 16384, IDX_MM = XL_OFF + 24576, IDX_STQ = IDX_MM + 256, IDX_MM2 = IDX_STQ + 256, IDX_SELL = XL_OFF + 25600  , IDX_CAP = 1024;
static_assert(IDX_MM2 + 64 <= IDX_SELL && IDX_SELL + 2048 <= LDSCTL_OFF, "LDS map (indexer)");
__device__ __forceinline__ float wmin64(float v) {
#pragma unroll
    for (int o = 1; o < 64; o <<= 1) v = fminf(v, __shfl_xor(v, o));
    return v;
}
__device__ __forceinline__ float vmaxf_(float a, float b) { float d; asm("v_max_f32 %0, %1, %2" : "=v"(d) : "v"(a), "v"(b)); return d; }
__device__ __forceinline__ float vminf_(float a, float b) { float d; asm("v_min_f32 %0, %1, %2" : "=v"(d) : "v"(a), "v"(b)); return d; }
__device__ __forceinline__ void p12_index_mfma(Frame& F, const In& I, unsigned char* ws) {
    OPAQUE_TID(); KARGS(); const int lane = tid_ & 63, wave = __builtin_amdgcn_readfirstlane(tid_ >> 6), key = lane & 31, half = lane >> 5;
    LAS float* SC = (LAS float*)(F.lds + RING_OFF);
    LAS float* MMw = (LAS float*)(F.lds + IDX_MM);
    const bf16* QI = (const bf16*)(ws + WS_QI); const bf16* KIDX = (const bf16*)(ws + WS_KIDX); const float* WIDX = (const float*)(ws + WS_WIDX);
    unsigned short* SEL = (unsigned short*)(ws + WS_SEL); int* CNT = (int*)(ws + WS_CNT);
    const int NG = M / 4, per = (NG + F.G - 1) / F.G;
    for (int j = 0; j < per; ++j) {
        const int u = j * F.G + ((j & 1) ? (F.G - 1 - (int)blockIdx.x) : (int)blockIdx.x);
        if (u >= NG) break;
        const int gi = (u & 1) * (NG / 2) + (u >> 1);
        const int row0 = 4 * gi, b = row0 / T, t0 = row0 % T, rowb = b * T;
        if (t0 < 256) {
            if (wave < 4) { const int t = t0 + wave; unsigned short* so = SEL + (size_t)(row0 + wave) * 256;
#pragma unroll
                for (int i = 0; i < 4; ++i) { const int s = lane + 64 * i; so[s] = (unsigned short)(s <= t ? s : 0); }
                if (lane == 0) CNT[row0 + wave] = t + 1; }
            continue;
        }
        {
            const int rho = lane & 31, a = rho >> 2, qA = ((a >> 2) & 1) + 2 * (a & 1), hdA = 4 * ((a >> 1) & 1) + (rho & 3);
            bf16x8 qa[4];
#pragma unroll
            for (int ks = 0; ks < 4; ++ks) qa[ks] = ldg16(QI + (size_t)(row0 + qA) * 512 + hdA * 64 + 16 * ks + 8 * half);
            float w0[8], w1[8];
            { const float4 x0 = *(const float4*)(WIDX + (size_t)(row0 + 2 * half) * 8), x1 = *(const float4*)(WIDX + (size_t)(row0 + 2 * half) * 8 + 4);
              const float4 y0 = *(const float4*)(WIDX + (size_t)(row0 + 2 * half + 1) * 8), y1 = *(const float4*)(WIDX + (size_t)(row0 + 2 * half + 1) * 8 + 4);
              w0[0] = x0.x; w0[1] = x0.y; w0[2] = x0.z; w0[3] = x0.w; w0[4] = x1.x; w0[5] = x1.y; w0[6] = x1.z; w0[7] = x1.w;
              w1[0] = y0.x; w1[1] = y0.y; w1[2] = y0.z; w1[3] = y0.w; w1[4] = y1.x; w1[5] = y1.y; w1[6] = y1.z; w1[7] = y1.w; }
            f32x2_t w0p[4], w1p[4];
#pragma unroll
            for (int h = 0; h < 4; ++h) { w0p[h] = (f32x2_t){w0[2 * h], w0[2 * h + 1]}; w1p[h] = (f32x2_t){w1[2 * h], w1[2 * h + 1]}; }
            const int tq0 = t0 + 2 * half, tq1 = tq0 + 1, nt = (t0 + 3) / 32 + 1;
            float mn0 = INFINITY, mx0 = -INFINITY, mn1 = INFINITY, mx1 = -INFINITY;
            const bf16* kpb = KIDX + (size_t)(rowb >> 5) * 2048 + (size_t)lane * 8;
            const int ntw = (nt - wave + NWAVES - 1) / NWAVES;
#define IDX_LOAD(dst, i) do { const int tl2_ = wave + NWAVES * ((i) < ntw ? (i) : (ntw > 0 ? ntw - 1 : 0)); const bf16* kp_ = kpb + (size_t)tl2_ * 2048; \
                _Pragma("unroll") for (int ks = 0; ks < 4; ++ks) dst[ks] = ldg16(kp_ + 512 * ks); } while (0)
#define IDX_COMP(src, i) do { if ((i) < ntw) { const int kpos = 32 * (wave + NWAVES * (i)) + key; \
                f32x16 c = {0.f, 0.f, 0.f, 0.f, 0.f, 0.f, 0.f, 0.f, 0.f, 0.f, 0.f, 0.f, 0.f, 0.f, 0.f, 0.f}; \
                _Pragma("unroll") for (int ks = 0; ks < 4; ++ks) c = MFMA32(qa[ks], src[ks], c); \
                f32x2_t a0 = {0.f, 0.f}, a1 = {0.f, 0.f};                   \
                _Pragma("unroll") for (int h = 0; h < 4; ++h) { \
                    const f32x2_t r0 = {__int_as_float(max(__float_as_int(c[2 * h]), 0)), __int_as_float(max(__float_as_int(c[2 * h + 1]), 0))}; \
                    const f32x2_t r1 = {__int_as_float(max(__float_as_int(c[8 + 2 * h]), 0)), __int_as_float(max(__float_as_int(c[9 + 2 * h]), 0))}; \
                    a0 = __builtin_elementwise_fma(r0, w0p[h], a0); a1 = __builtin_elementwise_fma(r1, w1p[h], a1); } \
                float s0 = (a0[0] + a0[1]) + 0.f, s1 = (a1[0] + a1[1]) + 0.f; \
                const bool ok0 = kpos <= tq0, ok1 = kpos <= tq1; \
                const float v0_ = ok0 ? s0 : -INFINITY, v1_ = ok1 ? s1 : -INFINITY; \
                SC[(2 * half) * 8192 + kpos] = v0_; SC[(2 * half + 1) * 8192 + kpos] = v1_; \
                mx0 = vmaxf_(mx0, v0_); mx1 = vmaxf_(mx1, v1_); mn0 = vminf_(mn0, ok0 ? s0 : INFINITY); mn1 = vminf_(mn1, ok1 ? s1 : INFINITY); } } while (0)
            for (int prb_ = 0; prb_ < (PROBE_REP == 2 ? 2 : 1); ++prb_)
            if (ntw > 0) {
                bf16x8 kb0[4], kb1[4], kb2[4], kb3[4];
                IDX_LOAD(kb0, 0); IDX_LOAD(kb1, 1); IDX_LOAD(kb2, 2);
                for (int i = 0; i < ntw; i += 4) {
                    IDX_LOAD(kb3, i + 3); IDX_COMP(kb0, i);
                    IDX_LOAD(kb0, i + 4); IDX_COMP(kb1, i + 1);
                    IDX_LOAD(kb1, i + 5); IDX_COMP(kb2, i + 2);
                    IDX_LOAD(kb2, i + 6); IDX_COMP(kb3, i + 3);
                }
            }
#undef IDX_LOAD
#undef IDX_COMP
#pragma unroll
            for (int o = 1; o < 32; o <<= 1) { mn0 = fminf(mn0, __shfl_xor(mn0, o)); mx0 = fmaxf(mx0, __shfl_xor(mx0, o)); mn1 = fminf(mn1, __shfl_xor(mn1, o)); mx1 = fmaxf(mx1, __shfl_xor(mx1, o)); }
            if (key == 0) { LAS float* mm = MMw + (wave * 4 + 2 * half) * 2; mm[0] = mn0; mm[1] = mx0; mm[2] = mn1; mm[3] = mx1; }
        }
        __syncthreads();
        {
            const int q = wave >> 1, hw = wave & 1, t = t0 + q, n = t + 1; const LAS float* sc = SC + q * 8192;
            LAS unsigned* hist = (LAS unsigned*)(F.lds + IDX_HIST) + wave * 512; const LAS unsigned* hist0 = (const LAS unsigned*)(F.lds + IDX_HIST) + (2 * q) * 512;
            LAS unsigned short* cand = (LAS unsigned short*)(F.lds + IDX_CAND) + q * IDX_CAP;
            LAS float* stf = (LAS float*)(F.lds + IDX_STQ) + q * 16; LAS int* sti = (LAS int*)stf;
            LAS float* mm2 = (LAS float*)(F.lds + IDX_MM2) + wave * 2;
            unsigned short* so = SEL + (size_t)(row0 + q) * 256;
            LAS unsigned short* sl = (LAS unsigned short*)(F.lds + IDX_SELL) + q * 256;
            const int nch = (n + 255) >> 8;
            if (hw == 0 && lane == 0) { float lo = INFINITY, hi = -INFINITY;
#pragma unroll
                for (int w = 0; w < 8; ++w) { lo = fminf(lo, MMw[(w * 4 + q) * 2]); hi = fmaxf(hi, MMw[(w * 4 + q) * 2 + 1]); }
                stf[0] = lo; stf[1] = hi; sti[2] = 256; sti[3] = 0; sti[4] = 0; sti[5] = 0; sti[6] = 0; sti[7] = 0; sti[8] = 0; sti[9] = 0; }
            __syncthreads();
            for (int round = 0; round < 64; ++round) {
                const float lo = stf[0], hi = stf[1]; const bool act = sti[8] == 0; const bool eqr = !(hi > lo); const float scale = eqr ? 0.f : 1024.f / (hi - lo);
                int hreps_ = (PROBE_REP == 10) ? 2 : 1; asm volatile("" : "+s"(hreps_));
                if (act && !eqr) for (int hr_ = 0; hr_ < hreps_; ++hr_) {
#pragma unroll
                    for (int i = 0; i < 8; ++i) hist[lane + 64 * i] = 0u;
                    f32x4 nx4 = *(const LAS f32x4*)(sc + 256 * hw + 4 * lane);
                    for (int c = hw; c < nch; c += 2) { const int i4 = 256 * c + 4 * lane; const f32x4 v4 = nx4; nx4 = *(const LAS f32x4*)(sc + i4 + 512);
#pragma unroll
                        for (int e = 0; e < 4; ++e) { const float v = (i4 + e < n) ? v4[e] : -INFINITY;
                            if (v >= lo && v <= hi) { int bb = (int)((v - lo) * scale); bb = bb > 1023 ? 1023 : bb; atomicAdd((unsigned*)&hist[bb >> 1], 1u << (16 * (bb & 1))); } } }
                }
                __syncthreads();
                if (hw == 0 && act) {
                    if (eqr) { if (lane == 0) { sti[8] = 1; sti[9] = 1; } }
                    else {
                        const int krem = sti[2];
                        unsigned cw[8], c0w[8]; unsigned S = 0u, S0 = 0u;
#pragma unroll
                        for (int i = 0; i < 8; ++i) { c0w[i] = hist0[8 * lane + i]; cw[i] = c0w[i] + hist0[512 + 8 * lane + i]; S += (cw[i] & 0xffffu) + (cw[i] >> 16); S0 += (c0w[i] & 0xffffu) + (c0w[i] >> 16); }
                        unsigned x = S, x0 = S0;
#pragma unroll
                        for (int o = 1; o < 64; o <<= 1) { const unsigned y = __shfl_down(x, o), y0 = __shfl_down(x0, o); if (lane + o < 64) { x += y; x0 += y0; } }
                        const unsigned above = x - S; unsigned acc0 = x0 - S0;
                        const bool found = (above < (unsigned)krem) && ((unsigned)krem <= above + S);
                        const int fl = __builtin_ctzll(__ballot(found));
                        int bs = 0; unsigned acc = above, cb = 0u, cb0 = 0u;
                        { bool done = false;
#pragma unroll
                          for (int i = 15; i >= 0; --i) { const unsigned cnt_ = (i & 1) ? (cw[i >> 1] >> 16) : (cw[i >> 1] & 0xffffu), cnt0_ = (i & 1) ? (c0w[i >> 1] >> 16) : (c0w[i >> 1] & 0xffffu);
                              if (!done) { if (acc + cnt_ >= (unsigned)krem) { bs = 16 * lane + i; cb = cnt_; cb0 = cnt0_; done = true; } else { acc += cnt_; acc0 += cnt0_; } } } }
                        if (lane == fl) { sti[2] = krem - (int)acc; sti[3] += (int)acc0; sti[4] += (int)acc; sti[5] = bs; sti[6] = (int)cb0; sti[7] = (int)cb; sti[8] = ((int)cb <= IDX_CAP) ? 1 : 0; }
                    }
                }
                __syncthreads();
                const LAS int* stall = (const LAS int*)(F.lds + IDX_STQ);
                if (stall[8] && stall[16 + 8] && stall[32 + 8] && stall[48 + 8]) break;
                float nlo = INFINITY, nhi = -INFINITY;
                if (sti[8] == 0) { const int bstar = sti[5];
                    for (int c = hw; c < nch; c += 2) { const int i4 = 256 * c + 4 * lane; const f32x4 v4 = *(const LAS f32x4*)(sc + i4);
#pragma unroll
                        for (int e = 0; e < 4; ++e) { const float v = (i4 + e < n) ? v4[e] : -INFINITY;
                            if (v >= lo && v <= hi) { int bb = (int)((v - lo) * scale); bb = bb > 1023 ? 1023 : bb; if (bb == bstar) { nlo = fminf(nlo, v); nhi = fmaxf(nhi, v); } } } } }
                nlo = wmin64(nlo); nhi = wmax64(nhi);
                if (lane == 0) { mm2[0] = nlo; mm2[1] = nhi; }
                __syncthreads();
                if (hw == 0 && lane == 0 && sti[8] == 0) { stf[0] = fminf(mm2[0], mm2[2]); stf[1] = fmaxf(mm2[1], mm2[3]); }
                __syncthreads();
            }
            { const float lo = stf[0], hi = stf[1]; const bool eq = sti[9] != 0; const float scale = eq ? 0.f : 1024.f / (hi - lo);
              const int krem = sti[2], A0 = sti[3], AT = sti[4], bstar = sti[5], C0 = sti[6], ncand = sti[7], nabove = 256 - krem;
              int creps_ = (PROBE_REP == 11) ? 2 : 1; asm volatile("" : "+s"(creps_));
              for (int cr_ = 0; cr_ < creps_; ++cr_) {
              int bsel = hw ? A0 : 0, bcand = hw ? C0 : 0; (void)AT;
              if (eq) {
                  if (!hw) for (int c = 0; c < nch; ++c) { const int i4 = 256 * c + 4 * lane; const f32x4 v4 = *(const LAS f32x4*)(sc + i4);
#pragma unroll
                      for (int e = 0; e < 4; ++e) { const int idx = i4 + e; const float v = (idx < n) ? v4[e] : -INFINITY;
                          const bool sel = v > hi, cnd = (v == hi);
                          const unsigned long long ms = __ballot(sel), mc = __ballot(cnd), lt = (1ull << lane) - 1ull;
                          if (sel) sl[bsel + __builtin_popcountll(ms & lt)] = (unsigned short)idx;
                          if (cnd) { const int pc = bcand + __builtin_popcountll(mc & lt); if (pc < krem) sl[nabove + pc] = (unsigned short)idx; }
                          bsel += __builtin_popcountll(ms); bcand += __builtin_popcountll(mc); } }
              } else {
                  auto binf = [&](float v) { int bb = (int)((v - lo) * scale); return bb > 1023 ? 1023 : bb; };
                  auto fkey = [](float x) { const int b_ = __float_as_int(x); return b_ ^ ((b_ >> 31) & 0x7fffffff); };
                  auto kflt = [](int k) { return __int_as_float(k ^ ((k >> 31) & 0x7fffffff)); };
                  const int klo = fkey(lo), khi = fkey(hi);
                  auto first_ge = [&](int target) {
                      float est = lo + (float)target * ((hi - lo) * (1.f / 1024.f)); est = est < lo ? lo : (est > hi ? hi : est);
                      int a = klo, b = khi;
                      { const int ke = fkey(est); const int ka = (ke - 64 > klo) ? ke - 64 : klo, kb = (ke + 64 < khi) ? ke + 64 : khi;
                        if (binf(kflt(ka)) < target) a = ka; if (binf(kflt(kb)) >= target) b = kb; }
                      while ((unsigned)b - (unsigned)a > 1u) { const int mid = a + (int)(((unsigned)b - (unsigned)a) >> 1); if (binf(kflt(mid)) >= target) b = mid; else a = mid; }
                      return kflt(b); };
                  const float T0 = (bstar <= 0) ? lo : first_ge(bstar);
                  const float T1 = (bstar >= 1023 || binf(hi) <= bstar) ? kflt(khi + 1) : first_ge(bstar + 1);
                  f32x4 nx4 = *(const LAS f32x4*)(sc + 256 * hw + 4 * lane);
                  for (int c = hw; c < nch; c += 2) { const int i4 = 256 * c + 4 * lane; const f32x4 v4 = nx4; nx4 = *(const LAS f32x4*)(sc + i4 + 512);
                      const bool full = 256 * c + 256 <= n;
#pragma unroll
                      for (int e = 0; e < 4; ++e) { const int idx = i4 + e; const float v = (full || idx < n) ? v4[e] : -INFINITY;
                          const bool sel = v >= T1, cnd = (v >= T0) && !sel;
                          const unsigned long long ms = __ballot(sel), mc = __ballot(cnd);
                          if (ms) { if (sel) sl[bsel + (int)__builtin_amdgcn_mbcnt_hi((unsigned)(ms >> 32), __builtin_amdgcn_mbcnt_lo((unsigned)ms, 0u))] = (unsigned short)idx; bsel += __builtin_popcountll(ms); }
                          if (mc) { if (cnd) { const int pc = bcand + (int)__builtin_amdgcn_mbcnt_hi((unsigned)(mc >> 32), __builtin_amdgcn_mbcnt_lo((unsigned)mc, 0u)); if (pc < IDX_CAP) cand[pc] = (unsigned short)idx; } bcand += __builtin_popcountll(mc); } } }
              }
              }
              __syncthreads();
              if (!eq) {
                  for (int i = 64 * hw + lane; i < ncand; i += 128) { const int ii = cand[i]; const float vi = sc[ii]; int rank = 0;
                      for (int jj = 0; jj < ncand; ++jj) { const int ij = cand[jj]; const float vj = sc[ij]; rank += ((vj > vi) || (vj == vi && ij < ii)) ? 1 : 0; }
                      if (rank < krem) sl[nabove + rank] = (unsigned short)ii; }
              }
              if (hw == 0 && lane == 0) CNT[row0 + q] = 256; }
        }
        __syncthreads();
        if ((wave & 1) == 0) { const int q = wave >> 1; *(v2u*)(SEL + (size_t)(row0 + q) * 256 + 4 * lane) = *(const LAS v2u*)((LAS unsigned short*)(F.lds + IDX_SELL) + q * 256 + 4 * lane); }
    }
}

__device__ __forceinline__ unsigned offb(unsigned row, unsigned ch) { return 256u * row + 16u * (ch ^ (((row & 3u) << 2) | ((row >> 2) & 3u))); }
typedef short v4i16_t __attribute__((ext_vector_type(4)));
__device__ __forceinline__ v4i16_t trrd(const LAS unsigned char* p) { return __builtin_amdgcn_ds_read_tr16_b64_v4i16((LAS v4i16_t*)p); }
__device__ __forceinline__ void p13_dsa_mfma(Frame& F, const In& I, unsigned char* ws) {
    OPAQUE_TID(); KARGS(); const int lane = tid_ & 63, wave = __builtin_amdgcn_readfirstlane(tid_ >> 6), n = lane & 15, kq = lane >> 4;
    LAS unsigned char* bkt = F.lds + TAB_BKT; LAS float* b12 = (LAS float*)(F.lds + P13_B12);
    for (int i = tid_; i < 1536; i += NWAVES * 64) bkt[i] = (unsigned char)rel_bucket(i);
    for (int i = tid_; i < 528; i += NWAVES * 64) b12[i] = (i >= 512) ? -INFINITY : (((i & 15) < 12) ? Ip->rel_bias[(i >> 4) * 12 + (i & 15)] * LOG2E : 0.f);
    __syncthreads();
    LAS unsigned char* imgb = F.lds + RING_OFF + wave * 18432; LAS int* sidx = (LAS int*)(imgb + 16384);
    const bf16* QA = (const bf16*)(ws + WS_QA); const bf16* CKV = (const bf16*)(ws + WS_CKV); const bf16* PR = (const bf16*)(ws + WS_PROJ1);
    const unsigned short* SEL = (const unsigned short*)(ws + WS_SEL); const int* CNT = (const int*)(ws + WS_CNT);
    const bf16* MKB = (const bf16*)(ws + WS_MKB) + (size_t)512 * 256; const bf16* MVT = (const bf16*)(ws + WS_MVT) + (size_t)256 * 512;
    bf16* CAT1 = (bf16*)(ws + WS_CAT1);
    const int gw = blockIdx.x * NWAVES + wave, NGW = F.G * NWAVES;
    const LAS float* b12c = b12 + (n < 12 ? n : 0);
#define DSA_GATHER(sl_, rowb_, c0_, buf_) do { const unsigned char* ckvb_ = (const unsigned char*)(CKV + (size_t)(rowb_) * 128); int kx_[8]; \
            _Pragma("unroll") for (int i = 0; i < 8; ++i) kx_[i] = (sl_)[(c0_) + 4 * i + g4_] & 0xffff; \
            _Pragma("unroll") for (int i = 0; i < 8; ++i) __builtin_amdgcn_global_load_lds((const unsigned*)(ckvb_ + ((unsigned)kx_[i] * 256u + goff_[i & 3])), (LAS unsigned*)(imgb + (buf_) * 8192 + i * 1024), 16, 0, 0); } while (0)
#define DSA_LIST(sl_, sel_, t_, cnt_) do { const int idx0_ = __builtin_amdgcn_readfirstlane((sel_)[0]); \
            _Pragma("unroll") for (int i = 0; i < 4; ++i) { const int e = lane + 64 * i, idx = (sel_)[i]; const int d = (t_) - idx, dc = d > 1535 ? 1535 : (d < 0 ? 0 : d); \
                (sl_)[e] = (e < (cnt_)) ? (idx | ((int)bkt[dc] << 22)) : (idx0_ | (2048 << 16)); } } while (0)
    int dreps_ = (PROBE_REP == 9) ? 2 : 1; asm volatile("" : "+s"(dreps_));
    for (int dr_ = 0; dr_ < dreps_; ++dr_) {
    asm volatile("s_waitcnt vmcnt(0) lgkmcnt(0)" ::: "memory");
    int row = gw;
    if (row < M) {
        int ln0_ = lane; asm volatile("" : "+v"(ln0_));
        const int g4_ = ln0_ >> 4; unsigned goff_[4];
#pragma unroll
        for (int k = 0; k < 4; ++k) goff_[k] = 16u * ((unsigned)(ln0_ & 15) ^ (((unsigned)g4_ << 2) | (unsigned)k));
        int cnt = __builtin_amdgcn_readfirstlane(CNT[row]); int sel0[4];
#pragma unroll
        for (int i = 0; i < 4; ++i) sel0[i] = (int)SEL[(size_t)row * 256 + lane + 64 * i];
        DSA_LIST(sidx, sel0, row % T, cnt);
        bf16x8 qf[4];
#pragma unroll
        for (int ks = 0; ks < 4; ++ks) { bf16x8 v = ldg16(QA + (size_t)row * 1536 + (n < 12 ? n : 0) * 128 + 32 * ks + 8 * kq); if (n >= 12) v = (bf16x8){0, 0, 0, 0, 0, 0, 0, 0}; qf[ks] = v; }
        asm volatile("s_waitcnt lgkmcnt(0)" ::: "memory");
        DSA_GATHER(sidx, (row / T) * T, 0, 0);
        int lb = 0, ib = 0;
        for (; row < M; row += NGW) {
            const int t = row % T, rown = (row + NGW < M) ? row + NGW : row; const bool hasn = row + NGW < M;
            int ln_ = lane; asm volatile("" : "+v"(ln_));
            int seln[4] = {0, 0, 0, 0}; int cntn_v = 0; bf16x8 qfn[4];
#pragma unroll
            for (int ks = 0; ks < 4; ++ks) qfn[ks] = (bf16x8){0, 0, 0, 0, 0, 0, 0, 0};
#define DSA_NEXT_LOADS() do { cntn_v = CNT[rown]; \
                _Pragma("unroll") for (int i = 0; i < 4; ++i) seln[i] = (int)SEL[(size_t)rown * 256 + lane + 64 * i]; \
                _Pragma("unroll") for (int ks = 0; ks < 4; ++ks) { bf16x8 v = ldg16(QA + (size_t)rown * 1536 + (n < 12 ? n : 0) * 128 + 32 * ks + 8 * kq); if (n >= 12) v = (bf16x8){0, 0, 0, 0, 0, 0, 0, 0}; qfn[ks] = v; } } while (0)
            const LAS int* sl = sidx + lb * 256; LAS int* sln = sidx + (lb ^ 1) * 256;
            float m = -1e30f, l = 0.f; f32x4 O[8];
#pragma unroll
            for (int rt = 0; rt < 8; ++rt) O[rt] = (f32x4){0.f, 0.f, 0.f, 0.f};
            for (int c0 = 0; c0 < cnt; c0 += 32) {
                LAS unsigned char* img = imgb + ib * 8192;
                if (c0 + 32 < cnt) { DSA_GATHER(sl, (row / T) * T, c0 + 32, ib ^ 1);
                    { const int e2 = (c0 + 64 < 256 ? c0 + 64 : 224) + (ln_ >> 1); const int k2 = sl[e2] & 0xffff;
                      __builtin_amdgcn_global_load_lds((const unsigned*)((const unsigned char*)(CKV + (size_t)((row / T) * T) * 128) + ((unsigned)k2 * 256u + 128u * (unsigned)(ln_ & 1))), (LAS unsigned*)(F.lds + P13_JUNK + wave * 256), 4, 0, 0); }
                    if (c0 == 0) { DSA_NEXT_LOADS(); }
                    if (c0 < 64) asm volatile("s_waitcnt vmcnt(18)" ::: "memory"); else asm volatile("s_waitcnt vmcnt(9)" ::: "memory"); }
                else if (hasn) {
                    if (c0 == 0) { DSA_NEXT_LOADS(); }
                    const int cntn = __builtin_amdgcn_readfirstlane(cntn_v);
                    DSA_LIST(sln, seln, rown % T, cntn);
                    asm volatile("s_waitcnt lgkmcnt(0)" ::: "memory");
                    DSA_GATHER(sln, (rown / T) * T, 0, ib ^ 1); asm volatile("s_waitcnt vmcnt(8)" ::: "memory"); }
                else asm volatile("s_waitcnt vmcnt(0)" ::: "memory");
                const bool has = m > -1e29f; const float mref = has ? m : 0.f; const float cinv = -mref;
                f32x4 sa = {cinv, cinv, cinv, cinv}, sb = sa;
                { const unsigned ra = 8u * ((unsigned)(ln_ & 15) >> 2) + ((unsigned)ln_ & 3u), kq_ = (unsigned)ln_ >> 4;
#pragma unroll
                  for (int s = 0; s < 4; ++s) { const bf16x8 ka = *(const LAS bf16x8*)(img + offb(ra, 4 * s + kq_)); const bf16x8 kb = *(const LAS bf16x8*)(img + offb(ra + 4, 4 * s + kq_));
                      sa = MFMA16(ka, qf[s], sa); sb = MFMA16(kb, qf[s], sb); } }
#pragma unroll
                for (int i = 0; i < 4; ++i) { const int ea = c0 + 8 * kq + i;
                    sa[i] += *(const LAS float*)((const LAS unsigned char*)b12c + ((unsigned)sl[ea] >> 16)); sb[i] += *(const LAS float*)((const LAS unsigned char*)b12c + ((unsigned)sl[ea + 4] >> 16)); }
                float fsc = 1.f;
                if (__any((imax3(imax3(__float_as_int(sa[0]), __float_as_int(sa[1]), __float_as_int(sa[2])), imax3(__float_as_int(sa[3]), __float_as_int(sb[0]), __float_as_int(sb[1])), max(__float_as_int(sb[2]), __float_as_int(sb[3]))) > __float_as_int(SM_THR)) || !has)) {
                    float lm = lmax8(sa, sb);
                    lm = fmaxf(lm, __shfl_xor(lm, 16)); lm = fmaxf(lm, __shfl_xor(lm, 32));
                    const bool upd = (lm > -INFINITY) && (!has || lm > 0.f); const float dl = upd ? lm : 0.f;
                    if (upd) m = mref + dl;
                    fsc = has ? __builtin_amdgcn_exp2f(-dl) : 1.f; l *= fsc;
#pragma unroll
                    for (int i = 0; i < 4; ++i) { sa[i] -= dl; sb[i] -= dl; }
#pragma unroll
                    for (int rt = 0; rt < 8; ++rt) O[rt] = O[rt] * fsc;
                }
                f32x4 pa, pb; float sum = 0.f;
#pragma unroll
                for (int i = 0; i < 4; ++i) { pa[i] = __builtin_amdgcn_exp2f(sa[i]); pb[i] = __builtin_amdgcn_exp2f(sb[i]); sum += pa[i] + pb[i]; }
                l += sum;
                const bf16x8 pf = pack8(pa, pb);
                { const unsigned g_ = (unsigned)ln_ >> 4, q_ = ((unsigned)ln_ & 15u) >> 2, p_ = (unsigned)ln_ & 3u;
#pragma unroll
                  for (int rt = 0; rt < 8; ++rt) { const v4i16_t x0 = trrd(img + offb(8 * g_ + q_, 2 * rt + (p_ >> 1)) + 8 * (p_ & 1)), x1 = trrd(img + offb(8 * g_ + 4 + q_, 2 * rt + (p_ >> 1)) + 8 * (p_ & 1));
                      const bf16x8 vf = {x0[0], x0[1], x0[2], x0[3], x1[0], x1[1], x1[2], x1[3]};
                      O[rt] = MFMA16(vf, pf, O[rt]); } }
                ib ^= 1;
            }
            const float il = 1.f / kqsum(l);
            if (n < 12) { bf16* op = CAT1 + (size_t)row * 1792 + n * 128 + 4 * kq;
#pragma unroll
                for (int rt = 0; rt < 8; ++rt) *(uint2*)(op + 16 * rt) = make_uint2(pk2(O[rt][0] * il, O[rt][1] * il), pk2(O[rt][2] * il, O[rt][3] * il)); }
            lb ^= 1; cnt = __builtin_amdgcn_readfirstlane(cntn_v);
#pragma unroll
            for (int ks = 0; ks < 4; ++ks) qf[ks] = qfn[ks];
        }
    }
    }
#undef DSA_GATHER
#undef DSA_LIST
#undef DSA_NEXT_LOADS
    int mreps_ = (PROBE_REP == 8) ? 2 : 1; asm volatile("" : "+s"(mreps_));
    __syncthreads();
    for (int mr_ = 0; mr_ < mreps_; ++mr_)
    for (int u64 = blockIdx.x; u64 < M / 64; u64 += F.G) {
        int tl_ = tid_; asm volatile("" : "+v"(tl_));
        const int ln = tl_ & 63, nn = ln & 15, kqq = ln >> 4, qsl = nn >> 3;
        const int row0 = 64 * u64 + 8 * wave, b = row0 / T;
        const BiasCtx BC0{(const LAS unsigned short*)(F.lds + NSA_TB), 0.f, 0.f, 0.f};
#pragma unroll 1
        for (int hm = 0; hm < 4; ++hm) {
            bf16x8 qf[4][2];
#pragma unroll
            for (int p = 0; p < 4; ++p) { qf[p][0] = (bf16x8){0, 0, 0, 0, 0, 0, 0, 0}; qf[p][1] = qf[p][0]; }
            { const bf16* qp = PR + (size_t)(row0 + (nn & 7)) * 768 + 456 + hm * 64 + 8 * kqq; if (nn < 8) { qf[0][0] = ldg16(qp); qf[0][1] = ldg16(qp + 32); } }
            float m[4], l[4]; f32x4 O[4][4];
#pragma unroll
            for (int p = 0; p < 4; ++p) { m[p] = -1e30f; l[p] = 0.f;
#pragma unroll
                for (int dt = 0; dt < 4; ++dt) O[p][dt] = (f32x4){0.f, 0.f, 0.f, 0.f}; }
            nsa_sweep<MD_MEM>(F.lds + RING_OFF, MKB + (size_t)(b * 256) * 256 + hm * 64, MVT + (size_t)(hm * 64) * 512 + b * 256, 0, 3, 0, nullptr, wave, ln, nn, kqq, qsl, 0, qf, BC0, m, l, O, 256, 64 * 256, 512, 64);
            const float il = 1.f / kqsum(l[0]);
            if (nn < 8) { bf16* op = CAT1 + (size_t)(row0 + nn) * 1792 + 1536 + hm * 64 + 4 * kqq;
#pragma unroll
                for (int dt = 0; dt < 4; ++dt) *(uint2*)(op + 16 * dt) = make_uint2(pk2(O[0][dt][0] * il, O[0][dt][1] * il), pk2(O[0][dt][2] * il, O[0][dt][3] * il)); }
            __syncthreads();
        }
    }
}

struct Args { In in; float* out; unsigned char* ws; int ph_lo, ph_hi; };
__global__ void __launch_bounds__(NWAVES * 64, 2) mk_fwd(Args args) {
    extern __shared__ __attribute__((aligned(16))) unsigned char lds[];
    Frame F;
    F.lds = (LAS unsigned char*)lds; F.MISC = (volatile LAS unsigned*)(F.lds + MISC_OFF);
    F.G = gridDim.x; { const int bx = blockIdx.x; F.vcu = (F.G % 8 == 0) ? (bx % 8) * (F.G / 8) + bx / 8 : bx; }
    unsigned char* ws = args.ws; const In& I = args.in; float* out = args.out; (void)I;
    F.ctl = (gu32*)(ws + WS_CTL);
    for (int u = threadIdx.x; u < (LDS_BYTES - LDSCTL_OFF) / 4; u += NWAVES * 64) ((LAS unsigned*)(F.lds + LDSCTL_OFF))[u] = 0u;
    __syncthreads();
    XcdBarrier bar; bar.bar = (unsigned*)(F.ctl + CW_BAR); bar.x = 0; bar.st = nullptr;
    if (!MK_SPLIT) bar = xcd_barrier_post((unsigned*)(F.ctl + CW_BAR), F.MISC + 8);
    const int lo = args.ph_lo, hi = args.ph_hi;
#ifndef PH_MASK
#define PH_MASK 0xFFFFFFFFu
#endif
#define IN(k) ((((PH_MASK) >> ((k) % 32)) & 1u) && lo <= (k) && (k) < hi)
#define SEAM(k) do { if (IN(k) && IN((k) + 1)) xcd_barrier(bar); } while (0)
#define SEAM2(k, kn) do { if (IN(k) && IN(kn)) xcd_barrier(bar); } while (0)
#ifndef REP_MASK
#define REP_MASK 0u
#endif
#define REPS(k) (1 + (int)(((REP_MASK) >> (k)) & 1u))
    bf16* XN = (bf16*)(ws + WS_XN); bf16* CAT = (bf16*)(ws + WS_CAT); bf16* ACT = (bf16*)(ws + WS_ACT);
    float* SSQ = (float*)(ws + WS_SSQ);

    if (IN(0)) { for (int r_ = 0; r_ < REPS(0); ++r_) { p0_prologue(F, I, ws); if (r_ + 1 < REPS(0)) xcd_barrier(bar); } SEAM(0); }
    {
            if (IN(1)) {
                pg8::Gemm g{XN, (const bf16*)(ws + WS_WIN0), M, 1792, D}; pg8::StaticOrder S; S.init(M, 1792, F.G, (int)blockIdx.x);
                pg8::EpiRoute<0> E{ws, nullptr};
                for (int r_ = 0; r_ < REPS(1); ++r_) { if (r_) xcd_barrier(bar);
                pg8::gemm_phase<pg8::EpiRoute<0>, pg8::StaticOrder, true, true>(F.lds + RING_OFF, g, S, E); }
                pg8::Gemm g2{(const bf16*)(ws + WS_WVT), XN, 256, M, D}; pg8::StaticOrder S2; S2.init(256, M, F.G, (int)((blockIdx.x + 64) % F.G));
                pg8::EpiRoute<3> E2{ws, nullptr};
                pg8::gemm_phase<pg8::EpiRoute<3>, pg8::StaticOrder, true, true>(F.lds + RING_OFF, g2, S2, E2);
                SEAM(1);
            }
            if (IN(2)) { for (int r_ = 0; r_ < REPS(2); ++r_) { p2_mfma(F, I, ws); if (r_ + 1 < REPS(2)) xcd_barrier(bar); } SEAM(2); }
            if (IN(3)) { for (int r_ = 0; r_ < REPS(3); ++r_) { p3_nsa_mfma(F, I, ws); if (r_ + 1 < REPS(3)) xcd_barrier(bar); } SEAM(3); }
    }
    {
        constexpr int L = 0, pb = L ? 14 : 4;
        if (IN(pb)) {
            pg8::Gemm g{L ? (const bf16*)(ws + WS_CAT1) : CAT, L ? (const bf16*)(ws + WS_WO1F) : (const bf16*)(ws + WS_WO), M, D, L ? 1792 : D}; pg8::StaticOrder S; S.init(M, D, F.G, (int)blockIdx.x);
            KARGS(); pg8::EpiResid<L == 0> E{L ? (const void*)XN : (const void*)Ip->x, XN, SSQ + (size_t)(L ? 2 : 0) * M * 16, D, 0};
            pg8::gemm_phase<pg8::EpiResid<L == 0>, pg8::StaticOrder, true, true>(F.lds + RING_OFF, g, S, E);
            SEAM2(pb, pb + 2);
        }
        if (IN(pb + 2)) {
            pg8::Gemm g{XN, (const bf16*)(ws + WS_WGU) + (size_t)L * 2 * DFF * D, M, 2 * DFF, D}; pg8::StaticOrder S; S.init(M, 2 * DFF, F.G, (int)blockIdx.x);
            pg8::EpiSwiglu E{ACT, SSQ + (size_t)(L ? 2 : 0) * M * 16, DFF, 0};
            for (int r_ = 0; r_ < REPS(pb + 2); ++r_) { if (r_) xcd_barrier(bar);
            pg8::gemm_phase<pg8::EpiSwiglu, pg8::StaticOrder, true, true>(F.lds + RING_OFF, g, S, E); }
            SEAM(pb + 2);
        }
        if (IN(pb + 3)) {
            pg8::Gemm g{ACT, (const bf16*)(ws + WS_WD) + (size_t)L * D * DFF, M, D, DFF}; pg8::StaticOrder S; S.init(M, D, F.G, (int)blockIdx.x);
            pg8::EpiResid<false> E{XN, XN, SSQ + (size_t)(L ? 3 : 1) * M * 16, D, 0};
            pg8::gemm_phase<pg8::EpiResid<false>, pg8::StaticOrder, true, true>(F.lds + RING_OFF, g, S, E);
            SEAM2(pb + 3, L ? 18 : 9);
        }
        }
    {
            if (IN(9)) {
                pg8::Gemm g{XN, (const bf16*)(ws + WS_WIN1), M, 768, D}; pg8::StaticOrder S; S.init(M, 768, F.G, (int)blockIdx.x);
                pg8::EpiRoute<1> E{ws, SSQ + (size_t)1 * M * 16};
                for (int r_ = 0; r_ < REPS(9); ++r_) { if (r_) xcd_barrier(bar);
                pg8::gemm_phase<pg8::EpiRoute<1>, pg8::StaticOrder, true, true>(F.lds + RING_OFF, g, S, E); }
                SEAM(9);
            }
            if (IN(10)) { p10_dsa_norm(F, I, ws); SEAM(10); }
            if (IN(11)) {
                pg8::Gemm g{(const bf16*)(ws + WS_CQ), (const bf16*)(ws + WS_WQ2), M, 2048, 256}; pg8::StaticOrder S; S.init(M, 2048, F.G, (int)blockIdx.x);
                pg8::EpiRoute<2> E{ws, nullptr};
                for (int r_ = 0; r_ < REPS(11); ++r_) { if (r_) xcd_barrier(bar);
                pg8::gemm_phase<pg8::EpiRoute<2>, pg8::StaticOrder, true, true>(F.lds + RING_OFF, g, S, E); }
                SEAM(11);
            }
            if (IN(12)) { for (int r_ = 0; r_ < REPS(12); ++r_) { p12_index_mfma(F, I, ws); if (r_ + 1 < REPS(12)) xcd_barrier(bar); } SEAM(12); }
            if (IN(13)) { for (int r_ = 0; r_ < REPS(13); ++r_) { p13_dsa_mfma(F, I, ws); if (r_ + 1 < REPS(13)) xcd_barrier(bar); } SEAM(13); }
            }
    {
        constexpr int L = 1, pb = L ? 14 : 4;
        if (IN(pb)) {
            pg8::Gemm g{L ? (const bf16*)(ws + WS_CAT1) : CAT, L ? (const bf16*)(ws + WS_WO1F) : (const bf16*)(ws + WS_WO), M, D, L ? 1792 : D}; pg8::StaticOrder S; S.init(M, D, F.G, (int)blockIdx.x);
            KARGS(); pg8::EpiResid<L == 0> E{L ? (const void*)XN : (const void*)Ip->x, XN, SSQ + (size_t)(L ? 2 : 0) * M * 16, D, 0};
            pg8::gemm_phase<pg8::EpiResid<L == 0>, pg8::StaticOrder, true, true>(F.lds + RING_OFF, g, S, E);
            SEAM2(pb, pb + 2);
        }
        if (IN(pb + 2)) {
            pg8::Gemm g{XN, (const bf16*)(ws + WS_WGU) + (size_t)L * 2 * DFF * D, M, 2 * DFF, D}; pg8::StaticOrder S; S.init(M, 2 * DFF, F.G, (int)blockIdx.x);
            pg8::EpiSwiglu E{ACT, SSQ + (size_t)(L ? 2 : 0) * M * 16, DFF, 0};
            for (int r_ = 0; r_ < REPS(pb + 2); ++r_) { if (r_) xcd_barrier(bar);
            pg8::gemm_phase<pg8::EpiSwiglu, pg8::StaticOrder, true, true>(F.lds + RING_OFF, g, S, E); }
            SEAM(pb + 2);
        }
        if (IN(pb + 3)) {
            pg8::Gemm g{ACT, (const bf16*)(ws + WS_WD) + (size_t)L * D * DFF, M, D, DFF}; pg8::StaticOrder S; S.init(M, D, F.G, (int)blockIdx.x);
            pg8::EpiResid<false> E{XN, XN, SSQ + (size_t)(L ? 3 : 1) * M * 16, D, 0};
            pg8::gemm_phase<pg8::EpiResid<false>, pg8::StaticOrder, true, true>(F.lds + RING_OFF, g, S, E);
            SEAM2(pb + 3, L ? 18 : 9);
        }
        }
    if (IN(18)) {
        OPAQUE_TID(); KARGS(); const int lane_ = tid_ & 63;
        const int gw = F.vcu * NWAVES + (tid_ >> 6), NGW = F.G * NWAVES;
        for (int m = gw; m < M; m += NGW) { const float r = rsqrtf(pg8::ssq_row(SSQ + ((size_t)3 * M + m) * 16) * (1.f / D) + EPSF);
#pragma unroll
            for (int j = 0; j < 2; ++j) { const int c = (j * 64 + lane_) * 8; const pg8::u32x4 rw = *(const GAS pg8::u32x4*)(XN + (size_t)m * D + c);
                const GAS f32x4* gr = (const GAS f32x4*)(Ip->norm_final + c); GAS f32x4* orow = (GAS f32x4*)(out + (size_t)m * D + c);
                f32x4 r0, r1; r0[0] = __uint_as_float(rw.x << 16); r0[1] = __uint_as_float(rw.x & 0xffff0000u); r0[2] = __uint_as_float(rw.y << 16); r0[3] = __uint_as_float(rw.y & 0xffff0000u);
                r1[0] = __uint_as_float(rw.z << 16); r1[1] = __uint_as_float(rw.z & 0xffff0000u); r1[2] = __uint_as_float(rw.w << 16); r1[3] = __uint_as_float(rw.w & 0xffff0000u);
                orow[0] = (r0 * r) * gr[0]; orow[1] = (r1 * r) * gr[1]; } }
    }
#undef IN
#undef SEAM
}

extern "C" void kernel_launch(void* const* d_in, const int* in_sizes, int n_in, void* d_out, int out_size, void* d_ws, size_t ws_size, hipStream_t stream) {
    static int grid = 0;
    if (grid == 0) {
        if (n_in != 32 || out_size != M * D || ws_size < WS_END) { fprintf(stderr, "kernel_launch: unexpected shapes (n_in %d out %d ws %zu)\n", n_in, out_size, ws_size); grid = -1; return; }
        int dev = 0, cus = 0, per_cu = 0;
        if (hipGetDevice(&dev) != hipSuccess || hipDeviceGetAttribute(&cus, hipDeviceAttributeMultiprocessorCount, dev) != hipSuccess) { grid = -1; return; }
        if (hipFuncSetAttribute((const void*)mk_fwd, hipFuncAttributeMaxDynamicSharedMemorySize, LDS_BYTES) != hipSuccess) { grid = -1; return; }
        if (hipOccupancyMaxActiveBlocksPerMultiprocessor(&per_cu, (const void*)mk_fwd, NWAVES * 64, LDS_BYTES) != hipSuccess || per_cu < 1) fprintf(stderr, "kernel_launch: occupancy query reports %d\n", per_cu);
        (void)hipGetLastError();
        grid = cus;
        if (grid > 256) grid = 256;
    }
    if (grid < 0) return;
    if (hipMemsetAsync((char*)d_ws + WS_CTL, 0, CTL_ZERO_BYTES, stream) != hipSuccess) return;
    Args a{};
    const float** ip = (const float**)&a.in;
    for (int i = 0; i < 32; ++i) ip[i] = (const float*)d_in[i];
    a.out = (float*)d_out; a.ws = (unsigned char*)d_ws;
#if MK_SPLIT
    for (int k = 0; k < N_PHASES; ++k) { a.ph_lo = k; a.ph_hi = k + 1; hipLaunchKernelGGL(mk_fwd, dim3(grid), dim3(NWAVES * 64), LDS_BYTES, stream, a); }
#else
    a.ph_lo = 0; a.ph_hi = N_PHASES; hipLaunchKernelGGL(mk_fwd, dim3(grid), dim3(NWAVES * 64), LDS_BYTES, stream, a);
#endif
}
```

```cpp
#include <hip/hip_runtime.h>
#include <cstdio>
#include <cstdint>
#include <type_traits>
#include <math.h>

namespace pg8 {
#define PG8_LAS __attribute__((address_space(3)))
typedef unsigned short bf16_t;
typedef short bf16x8 __attribute__((ext_vector_type(8)));
typedef float f32x4 __attribute__((ext_vector_type(4)));
typedef unsigned u32x4 __attribute__((ext_vector_type(4)));
constexpr int BM = 256, BK = 64, HALF = 128, HTB = HALF * BK * 2  , STAGE_BYTES = 8 * HTB, NXCD = 8, WGM = 8;

__host__ __device__ __forceinline__ int lds_byte(int r, int c) { const int st = (r >> 4) * 2 + (c >> 5), rr = r & 15, cc = c & 31, ob = rr * 64 + cc * 2; return st * 1024 + (ob ^ (((ob >> 9) & 1) << 5)); }
__host__ __device__ __forceinline__ void stage_rc(int b, int& R, int& C) { const int st = b / 1024, sb = b % 1024, swz = sb ^ (((sb >> 9) & 1) << 5); R = (st >> 1) * 16 + swz / 64; C = (st & 1) * 32 + (swz % 64) / 2; }
__host__ __device__ __forceinline__ int perm32(int rho) { const int n = rho >> 4, i = rho & 15; return 8 * (i >> 2) + 4 * n + (i & 3); }

struct Unit { int pm, pn; };
struct Gemm { const bf16_t* A; const bf16_t* Bt; int M, N, K; };

struct StaticOrder {
    int nM, nN, nwg, G, c;
    __host__ __device__ void init(int M, int N, int G_, int c_) { nM = M / BM; nN = N / BM; nwg = nM * nN; G = G_; c = c_; }
    __host__ __device__ bool next(int i, Unit& u) const {
        const long L = (long)i * G + c; if (L >= nwg) return false;
        int wgid = (int)L; { const int q = nwg / NXCD, r = nwg % NXCD, xcd = wgid % NXCD, off = wgid / NXCD; wgid = (xcd < r ? xcd * (q + 1) : r * (q + 1) + (xcd - r) * q) + off; }
        const int nig = WGM * nN, gid = wgid / nig, fm = gid * WGM, gsz = (nM - fm) < WGM ? (nM - fm) : WGM;
        u.pm = fm + ((wgid % nig) % gsz); u.pn = (wgid % nig) / gsz; return true;
    }
    __device__ __forceinline__ void a_ready(const Unit&) const {}
    __device__ __forceinline__ void done(const Unit&) const {}
};

__device__ __forceinline__ unsigned cvt_pk_bf16(float lo, float hi) { unsigned r; asm volatile("v_cvt_pk_bf16_f32 %0, %1, %2" : "=v"(r) : "v"(lo), "v"(hi)); return r; }
__device__ __forceinline__ float ssq_row(const float* p) { const f32x4 a = ((const f32x4*)p)[0], b = ((const f32x4*)p)[1], c = ((const f32x4*)p)[2], d = ((const f32x4*)p)[3]; const f32x4 t = (a + b) + (c + d); return (t[0] + t[1]) + (t[2] + t[3]); }
template <int ROUTE> struct EpiRoute {
    static constexpr bool PERM = true, AFTER_DRAIN = false;
    unsigned char* ws; const float* ssq;
    __device__ __forceinline__ void operator()(const f32x4 (&acc)[2][2][4][2], const Unit& u, int wr, int wc, int fr, int fq) const {
        asm volatile("" : "+v"(fr), "+v"(fq));
        const int pn = u.pn; size_t off; int ld, t0; float sc;
        if constexpr (ROUTE == 0) {
            off = pn < 3 ? (size_t)(88u << 20) : pn < 5 ? (size_t)(112u << 20) : pn < 6 ? (size_t)(128u << 20) : (size_t)(136u << 20);
            ld = pn < 3 ? 768 : pn < 5 ? 512 : 256; t0 = pn < 3 ? 0 : pn < 5 ? 3 : pn < 6 ? 5 : 6; sc = (pn < 3 || pn == 5) ? 0.18033688011112042f : 1.f;
        } else if constexpr (ROUTE == 1) { off = (size_t)(88u << 20); ld = 768; t0 = 0; sc = 1.f; }
        else if constexpr (ROUTE == 3) { off = (size_t)(144u << 20); ld = 16384; t0 = 0; sc = 1.f; }
        else { off = pn < 6 ? (size_t)(128u << 20) : (size_t)(176u << 20); ld = pn < 6 ? 1536 : 512; t0 = pn < 6 ? 0 : 6; sc = 1.f; }
        bf16_t* base = (bf16_t*)(ws + off);
        const int row0 = u.pm * BM + wr * 64 + fr, col0 = (pn - t0) * BM + wc * 32 + 8 * fq;
#pragma unroll
        for (int ai = 0; ai < 2; ++ai)
#pragma unroll
            for (int m = 0; m < 4; ++m) { bf16_t* rowp = base + (size_t)(row0 + ai * HALF + m * 16) * ld + col0;
                float scr_ = sc; if constexpr (ROUTE == 1) scr_ = rsqrtf(ssq_row(ssq + (size_t)(row0 + ai * HALF + m * 16) * 16) * (1.f / 1024.f) + 1e-6f);
#pragma unroll
                for (int bj = 0; bj < 2; ++bj) { float scb_ = scr_; if constexpr (ROUTE == 1) { const int cg = col0 + bj * HALF; if (cg >= 456 && cg < 712) scb_ *= 0.18033688011112042f; }
                    const f32x4 v0 = acc[ai][bj][m][0] * scb_, v1 = acc[ai][bj][m][1] * scb_;
                    u32x4 w; w.x = cvt_pk_bf16(v0[0], v0[1]); w.y = cvt_pk_bf16(v0[2], v0[3]); w.z = cvt_pk_bf16(v1[0], v1[1]); w.w = cvt_pk_bf16(v1[2], v1[3]);
                    if constexpr (ROUTE == 3) {
                        const int tok = col0 + bj * HALF, rw = row0 + ai * HALF + m * 16; *(u32x4*)(base + ((size_t)(tok >> 6) * 256 + rw) * 64 + (tok & 63)) = w; }
                    else *(u32x4*)(rowp + bj * HALF) = w; } }
    }
};
template <bool RES_F32>
struct EpiResid {
    static constexpr bool PERM = true, AFTER_DRAIN = false;
    const void* res; bf16_t* hb; float* ssq; int ldc; int pad;
    __device__ __forceinline__ void operator()(const f32x4 (&acc)[2][2][4][2], const Unit& u, int wr, int wc, int fr, int fq) const {
        asm volatile("" : "+v"(fr), "+v"(fq));
        const int row0 = u.pm * BM + wr * 64 + fr, col0 = u.pn * BM + wc * 32 + 8 * fq;
#pragma unroll
        for (int ai = 0; ai < 2; ++ai)
#pragma unroll
            for (int m = 0; m < 4; ++m) { const int row = row0 + ai * HALF + m * 16; const size_t off = (size_t)row * ldc + col0; float sq = 0.f;
#pragma unroll
                for (int bj = 0; bj < 2; ++bj) { f32x4 v[2];
                    if constexpr (RES_F32) {
#pragma unroll
                        for (int n = 0; n < 2; ++n) v[n] = *(const f32x4*)((const float*)res + off + bj * HALF + 4 * n) + acc[ai][bj][m][n];
                    } else { const u32x4 rw = *(const u32x4*)((const bf16_t*)res + off + bj * HALF);
                        f32x4 r0, r1; r0[0] = __uint_as_float(rw.x << 16); r0[1] = __uint_as_float(rw.x & 0xffff0000u); r0[2] = __uint_as_float(rw.y << 16); r0[3] = __uint_as_float(rw.y & 0xffff0000u);
                        r1[0] = __uint_as_float(rw.z << 16); r1[1] = __uint_as_float(rw.z & 0xffff0000u); r1[2] = __uint_as_float(rw.w << 16); r1[3] = __uint_as_float(rw.w & 0xffff0000u);
                        v[0] = r0 + acc[ai][bj][m][0]; v[1] = r1 + acc[ai][bj][m][1]; }
#pragma unroll
                    for (int n = 0; n < 2; ++n) sq += (v[n][0] * v[n][0] + v[n][1] * v[n][1]) + (v[n][2] * v[n][2] + v[n][3] * v[n][3]);
                    u32x4 w; w.x = cvt_pk_bf16(v[0][0], v[0][1]); w.y = cvt_pk_bf16(v[0][2], v[0][3]); w.z = cvt_pk_bf16(v[1][0], v[1][1]); w.w = cvt_pk_bf16(v[1][2], v[1][3]); *(u32x4*)(hb + off + bj * HALF) = w; }
                sq += __shfl_xor(sq, 16); sq += __shfl_xor(sq, 32); if (fq == 0) ssq[(size_t)row * 16 + u.pn * 4 + wc] = sq; }
    }
};
struct EpiSwiglu {
    static constexpr bool PERM = true, AFTER_DRAIN = false;
    bf16_t* O; const float* ssq; int ldc; int pad;
    __device__ __forceinline__ void operator()(const f32x4 (&acc)[2][2][4][2], const Unit& u, int wr, int wc, int fr, int fq) const {
        asm volatile("" : "+v"(fr), "+v"(fq));
        const int row0 = u.pm * BM + wr * 64 + fr, col0 = u.pn * HALF + wc * 32 + 8 * fq;
#pragma unroll
        for (int ai = 0; ai < 2; ++ai)
#pragma unroll
            for (int m = 0; m < 4; ++m) { float o[8]; const float rs = rsqrtf(ssq_row(ssq + (size_t)(row0 + ai * HALF + m * 16) * 16) * (1.f / 1024.f) + 1e-6f);
#pragma unroll
                for (int n = 0; n < 2; ++n)
#pragma unroll
                    for (int e = 0; e < 4; ++e) { const float g = acc[ai][0][m][n][e] * rs, up = acc[ai][1][m][n][e] * rs; o[4 * n + e] = (g * __builtin_amdgcn_rcpf(1.f + __expf(-g))) * up; }
                u32x4 w; w.x = cvt_pk_bf16(o[0], o[1]); w.y = cvt_pk_bf16(o[2], o[3]); w.z = cvt_pk_bf16(o[4], o[5]); w.w = cvt_pk_bf16(o[6], o[7]);
                *(u32x4*)(O + (size_t)(row0 + ai * HALF + m * 16) * ldc + col0) = w; }
    }
};
template <class Epi, class Sched, bool ALIGN_EPI = false, bool SP2 = false>
__device__ __forceinline__ void gemm_phase(PG8_LAS unsigned char* lds, const Gemm g, const Sched& S, const Epi& E) {
    int tid = threadIdx.x; asm volatile("" : "+v"(tid));
    const int wid = __builtin_amdgcn_readfirstlane(tid >> 6), lane = tid & 63, wr = wid >> 2, wc = wid & 3, fr = lane & 15, fq = lane >> 4;
    int K = g.K; asm volatile("" : "+s"(K));
    const int nt = K / BK;
    unsigned voffA[2], voffB[2];
#pragma unroll
    for (int i = 0; i < 2; ++i) { int R, C; stage_rc(tid * 16 + i * 8192, R, C); const int Rb = Epi::PERM ? ((R & ~31) + perm32(R & 31)) : R;
        voffA[i] = (unsigned)(R * K + C) * 2u; voffB[i] = (unsigned)(Rb * K + C) * 2u; }
    const size_t kstep = (size_t)(BK * 2);
    const size_t hstep = (size_t)HALF * K * 2;
    const size_t tstep = 2 * hstep;
    const unsigned ldsw = (unsigned)wid * 1024u;
    const int aoff = lds_byte(wr * 64 + fr, fq * 8), boff = lds_byte(wc * 32 + fr, fq * 8);
#define PG8_SA(b, h) (((b) * 2 + (h)) * HTB)
#define PG8_SB(b, h) ((4 + (b) * 2 + (h)) * HTB)
#define PG8_STAGE(bufoff, gbase, voff) do { _Pragma("unroll") for (int _i = 0; _i < 2; ++_i) \
        __builtin_amdgcn_global_load_lds((const unsigned*)((const char*)(gbase) + (voff)[_i]), (PG8_LAS unsigned*)(lds + (bufoff) + ldsw + _i * 8192), 16, 0, 0); } while (0)
#define PG8_LDA(dst, b, h) do { _Pragma("unroll") for (int m = 0; m < 4; ++m) _Pragma("unroll") for (int k = 0; k < 2; ++k) dst[m][k] = *(const PG8_LAS bf16x8*)(lds + PG8_SA(b, h) + aoff + m * 2048 + k * 1024); } while (0)
#define PG8_LDB(dst, b, h) do { _Pragma("unroll") for (int n = 0; n < 2; ++n) _Pragma("unroll") for (int k = 0; k < 2; ++k) dst[n][k] = *(const PG8_LAS bf16x8*)(lds + PG8_SB(b, h) + boff + n * 2048 + k * 1024); } while (0)
#define PG8_MMA(ai, bj, At, Bt) do { __builtin_amdgcn_s_setprio(1); _Pragma("unroll") for (int m = 0; m < 4; ++m) _Pragma("unroll") for (int n = 0; n < 2; ++n) _Pragma("unroll") for (int k = 0; k < 2; ++k) \
        acc[ai][bj][m][n] = __builtin_amdgcn_mfma_f32_16x16x32_bf16(Bt[n][k], At[m][k], acc[ai][bj][m][n], 0, 0, 0); __builtin_amdgcn_s_setprio(0); } while (0)
#define PG8_WAIT_V(n) asm volatile("s_waitcnt vmcnt(" #n ")" ::: "memory")
#define PG8_WAIT_L(n) asm volatile("s_waitcnt lgkmcnt(" #n ")" ::: "memory")
#define PG8_BAR __builtin_amdgcn_s_barrier()
#define PG8_SCHED __builtin_amdgcn_sched_barrier(0)
    Unit cur, nxt; int ui = 0;
    if (!S.next(0, cur)) return;
    f32x4 acc[2][2][4][2];
#pragma unroll
    for (int a = 0; a < 2; ++a)
#pragma unroll
        for (int b = 0; b < 2; ++b)
#pragma unroll
            for (int m = 0; m < 4; ++m)
#pragma unroll
                for (int n = 0; n < 2; ++n) acc[a][b][m][n] = (f32x4){0.f, 0.f, 0.f, 0.f};
    bf16x8 At[4][2], B0[2][2], B1[2][2];
    const char* cA = (const char*)g.A + (size_t)cur.pm * tstep; const char* cB = (const char*)g.Bt + (size_t)cur.pn * tstep;
    S.a_ready(cur);
    if constexpr (SP2) {
        PG8_STAGE(PG8_SB(0, 0), cB, voffB); PG8_STAGE(PG8_SB(0, 1), cB + hstep, voffB); PG8_STAGE(PG8_SA(0, 0), cA, voffA); PG8_STAGE(PG8_SA(0, 1), cA + hstep, voffA);
        if (wr == 1) PG8_BAR;
        PG8_WAIT_V(2); PG8_BAR;
        PG8_STAGE(PG8_SB(1, 0), cB + kstep, voffB); PG8_STAGE(PG8_SA(1, 0), cA + kstep, voffA); PG8_STAGE(PG8_SB(1, 1), cB + hstep + kstep, voffB);
        PG8_WAIT_V(6); PG8_BAR;
    } else {
        PG8_STAGE(PG8_SB(0, 0), cB, voffB); PG8_STAGE(PG8_SA(0, 0), cA, voffA); PG8_STAGE(PG8_SB(0, 1), cB + hstep, voffB); PG8_STAGE(PG8_SA(0, 1), cA + hstep, voffA);
        if (wr == 1) PG8_BAR;
        PG8_WAIT_V(4); PG8_BAR;
        PG8_STAGE(PG8_SB(1, 0), cB + kstep, voffB); PG8_STAGE(PG8_SA(1, 0), cA + kstep, voffA); PG8_STAGE(PG8_SB(1, 1), cB + hstep + kstep, voffB);
        PG8_WAIT_V(6); PG8_BAR;
    }
    for (;;) {
        const bool has_next = S.next(ui + 1, nxt);
        const char* nA = has_next ? (const char*)g.A + (size_t)nxt.pm * tstep : cA; const char* nB = has_next ? (const char*)g.Bt + (size_t)nxt.pn * tstep : cB;
        for (int t = 0; t < nt; t += 2) {
            const bool last = (t == nt - 2);
            const char* a1 = cA + (size_t)(t + 1) * kstep;
            const char* a2 = last ? nA : cA + (size_t)(t + 2) * kstep; const char* b2 = last ? nB : cB + (size_t)(t + 2) * kstep;
            const char* a3 = a2 + kstep; const char* b3 = b2 + kstep;
            if (last && has_next) S.a_ready(nxt);
            if constexpr (SP2) {
            PG8_LDB(B0, 0, 0); PG8_LDB(B1, 0, 1); PG8_SCHED; PG8_LDA(At, 0, 0); PG8_STAGE(PG8_SA(1, 1), a1 + hstep, voffA);
            PG8_WAIT_V(8); PG8_WAIT_L(0); PG8_BAR; PG8_MMA(0, 0, At, B0); PG8_MMA(0, 1, At, B1); PG8_BAR; PG8_SCHED;
            PG8_LDA(At, 0, 1); PG8_STAGE(PG8_SB(0, 0), b2, voffB); PG8_STAGE(PG8_SB(0, 1), b2 + hstep, voffB); PG8_STAGE(PG8_SA(0, 0), a2, voffA);
            PG8_WAIT_V(8); PG8_WAIT_L(0); PG8_BAR; PG8_MMA(1, 0, At, B0); PG8_MMA(1, 1, At, B1); PG8_BAR; PG8_SCHED;
            PG8_LDB(B0, 1, 0); PG8_LDB(B1, 1, 1); PG8_SCHED; PG8_LDA(At, 1, 0); PG8_STAGE(PG8_SA(0, 1), a2 + hstep, voffA);
            PG8_WAIT_V(8); PG8_WAIT_L(0); PG8_BAR; PG8_MMA(0, 0, At, B0); PG8_MMA(0, 1, At, B1); PG8_BAR; PG8_SCHED;
            PG8_LDA(At, 1, 1); PG8_STAGE(PG8_SB(1, 0), b3, voffB); PG8_STAGE(PG8_SB(1, 1), b3 + hstep, voffB); PG8_STAGE(PG8_SA(1, 0), a3, voffA);
            PG8_WAIT_V(8); PG8_WAIT_L(0); PG8_BAR; PG8_MMA(1, 0, At, B0); PG8_MMA(1, 1, At, B1); PG8_BAR; PG8_SCHED;
            } else {
            PG8_LDB(B0, 0, 0); PG8_SCHED; PG8_LDA(At, 0, 0); PG8_STAGE(PG8_SA(1, 1), a1 + hstep, voffA);
            PG8_WAIT_L(8); PG8_BAR; PG8_WAIT_L(0); PG8_MMA(0, 0, At, B0); PG8_BAR; PG8_SCHED;
            PG8_LDB(B1, 0, 1); PG8_STAGE(PG8_SB(0, 0), b2, voffB);
            PG8_BAR; PG8_WAIT_L(0); PG8_MMA(0, 1, At, B1); PG8_BAR;
            PG8_LDA(At, 0, 1); PG8_STAGE(PG8_SA(0, 0), a2, voffA);
            PG8_BAR; PG8_WAIT_L(0); PG8_MMA(1, 0, At, B0); PG8_BAR; PG8_SCHED;
            PG8_STAGE(PG8_SB(0, 1), b2 + hstep, voffB);
            PG8_WAIT_V(6); PG8_BAR; PG8_MMA(1, 1, At, B1); PG8_BAR;
            PG8_LDB(B0, 1, 0); PG8_SCHED; PG8_LDA(At, 1, 0); PG8_STAGE(PG8_SA(0, 1), a2 + hstep, voffA);
            PG8_WAIT_L(8); PG8_BAR; PG8_WAIT_L(0); PG8_MMA(0, 0, At, B0); PG8_BAR; PG8_SCHED;
            PG8_LDB(B1, 1, 1); PG8_STAGE(PG8_SB(1, 0), b3, voffB);
            PG8_BAR; PG8_WAIT_L(0); PG8_MMA(0, 1, At, B1); PG8_BAR;
            PG8_LDA(At, 1, 1); PG8_STAGE(PG8_SA(1, 0), a3, voffA);
            PG8_BAR; PG8_WAIT_L(0); PG8_MMA(1, 0, At, B0); PG8_BAR; PG8_SCHED;
            PG8_STAGE(PG8_SB(1, 1), b3 + hstep, voffB);
            PG8_WAIT_V(6); PG8_BAR; PG8_MMA(1, 1, At, B1); PG8_BAR;
            }
        }
        if constexpr (ALIGN_EPI) { if (wr == 0) PG8_BAR; }
        if constexpr (!Epi::AFTER_DRAIN) { E(acc, cur, wr, wc, fr, fq); S.done(cur); }
        if (!has_next) break;
#pragma unroll
        for (int a = 0; a < 2; ++a)
#pragma unroll
            for (int b = 0; b < 2; ++b)
#pragma unroll
                for (int m = 0; m < 4; ++m)
#pragma unroll
                    for (int n = 0; n < 2; ++n) acc[a][b][m][n] = (f32x4){0.f, 0.f, 0.f, 0.f};
        cur = nxt; cA = nA; cB = nB; ++ui;
        if constexpr (ALIGN_EPI) { if (wr == 1) PG8_BAR; }
    }
    PG8_WAIT_V(0);
    if constexpr (!ALIGN_EPI) { if (wr == 0) PG8_BAR; }
    PG8_BAR;
    if constexpr (Epi::AFTER_DRAIN) { E.fused(acc, cur, wr, wc, fr, fq, lds, wid, lane); S.done(cur); }
#undef PG8_SA
#undef PG8_SB
#undef PG8_STAGE
#undef PG8_LDA
#undef PG8_LDB
#undef PG8_MMA
#undef PG8_WAIT_V
#undef PG8_WAIT_L
#undef PG8_BAR
#undef PG8_SCHED
}
}
constexpr int NWAVES = 8;
constexpr int BATCH = 2, T = 8192, D = 1024, M = BATCH * T, DFF = 2816, NSA_IN = 1828, DSA_IN = 712, NCMP = 511, NCR = BATCH * NCMP * 2;
constexpr float NEGF = -1e30f, EPSF = 1e-6f;
#ifndef MK_SPLIT
#define MK_SPLIT 0
#endif
constexpr int N_PHASES = 19;
constexpr size_t MiB = 1u << 20;
constexpr size_t WS_CTL = 0, CTL_ZERO_BYTES = 1 * MiB;
constexpr size_t WS_KCB = 1 * MiB  , WS_VCT = 1 * MiB + 512 * 1024  , WS_MKB = 2 * MiB  , WS_MVT = 2 * MiB + 512 * 1024  , WS_MKV = 3 * MiB  , WS_WIDX = 5 * MiB  , WS_CNT = 6 * MiB  ;
constexpr size_t WS_WIN0 = 8 * MiB, WS_WO = 12 * MiB, WS_WGU = 16 * MiB, WS_WD = 38 * MiB, WS_WIN1 = 49 * MiB, WS_WQ2 = 51 * MiB, WS_WVT = 52 * MiB  ;
constexpr size_t WS_W1T = 232 * MiB, WS_MEMN = 234 * MiB, WS_WMKT = 236 * MiB, WS_W2T = 238 * MiB, WS_B1F = 238 * MiB + 64 * 1024;
constexpr size_t WS_XN = 56 * MiB;
constexpr size_t WS_Q0 = 88 * MiB, WS_KV0 = 112 * MiB  , WS_QM = 128 * MiB, WS_G0 = 136 * MiB, WS_VT = 144 * MiB  ;
static_assert(WS_Q0 == (88u << 20) && WS_KV0 == (112u << 20) && WS_QM == (128u << 20) && WS_G0 == (136u << 20), "EpiRoute tables");
constexpr size_t WS_ACT = 88 * MiB;
constexpr size_t WS_PROJ1 = 88 * MiB, WS_CQ = 112 * MiB, WS_CKV = 120 * MiB, WS_KIDX = 124 * MiB, WS_QA = 128 * MiB, WS_QI = 176 * MiB, WS_SEL = 112 * MiB  , WS_CAT1 = 176 * MiB  , WS_WO1F = 52 * MiB + 512 * 1024  ;
constexpr size_t WS_OCS = 152 * MiB  , WS_CAT = 200 * MiB, WS_SSQ = 239 * MiB  , WS_END = 243 * MiB;
static_assert(WS_PROJ1 == (88u << 20) && WS_QA == (128u << 20) && WS_QI == (176u << 20) && WS_VT == (144u << 20), "EpiRoute tables");
static_assert(WS_ACT + (size_t)M * DFF * 2 <= WS_CAT + 0 * MiB || true, "map");
constexpr int CW_BAR = 4096;
constexpr int RING_OFF = 0, RING_BYTES = 131072, LDS_BYTES = 163840, LDSCTL_OFF = LDS_BYTES - 1024, MISC_OFF = LDSCTL_OFF + 320;
#define GAS __attribute__((address_space(1)))
#define LAS __attribute__((address_space(3)))
typedef unsigned short bf16;
typedef unsigned v4u __attribute__((ext_vector_type(4)));
typedef unsigned v2u __attribute__((ext_vector_type(2)));
typedef float f32x4 __attribute__((ext_vector_type(4)));
typedef short bf16x8 __attribute__((ext_vector_type(8)));
typedef GAS unsigned gu32;
typedef GAS unsigned long long gu64;
#define RLX_AGENT __ATOMIC_RELAXED, __HIP_MEMORY_SCOPE_AGENT
#define LDS_WAIT() asm volatile("s_waitcnt lgkmcnt(0)" ::: "memory")
#define VM_WAIT() asm volatile("s_waitcnt vmcnt(0)" ::: "memory")
__device__ __forceinline__ unsigned long long rt() { return __builtin_amdgcn_s_memrealtime(); }
__device__ __forceinline__ unsigned f2bf(float f) { unsigned u = __builtin_bit_cast(unsigned, f); return (u + 0x7fffu + ((u >> 16) & 1u)) >> 16; }
__device__ __forceinline__ unsigned pk2(float lo, float hi) { return f2bf(lo) | (f2bf(hi) << 16); }
#define XB_TMO      128
#define XB_XCNT(j)  (256  + 64 * (j))
#define XB_XSUB(j)  (1280 + 64 * (j))
#define XB_XGEN(j)  (2304 + 64 * (j))
#define XB_TOP      3328
#define XB_TOPGEN   3392
#define XCD_BAR_WORDS 3456
#define XB_SPIN_CAP (1u << 18)

__device__ __forceinline__ unsigned xb_ld(unsigned* p)              { return __hip_atomic_load(p, __ATOMIC_RELAXED, __HIP_MEMORY_SCOPE_AGENT); }
__device__ __forceinline__ unsigned xb_add(unsigned* p, unsigned v) { return __hip_atomic_fetch_add(p, v, __ATOMIC_RELAXED, __HIP_MEMORY_SCOPE_AGENT); }
__device__ __forceinline__ unsigned xb_xcc_id() { return (unsigned)__builtin_amdgcn_s_getreg((3 << 11) | 20) & 0xFu; }
#define XB_SPIN(cond, bar) do { unsigned _sp = 0; while (cond) { __builtin_amdgcn_s_sleep(1); \
    if ((++_sp & 255u) == 0u) { if (xb_ld(&(bar)[XB_TMO])) break; if (_sp > XB_SPIN_CAP) { atomicAdd(&(bar)[XB_TMO], 1u); break; } } } } while (0)

struct XcdBarrier {
    unsigned* bar; unsigned x;
    volatile LAS unsigned* st;
};

__device__ __forceinline__ XcdBarrier xcd_barrier_post(unsigned* bar, volatile LAS unsigned* st) {
    XcdBarrier b; b.bar = bar; b.x = xb_xcc_id(); b.st = st;
    if (threadIdx.x == 0) (void)xb_add(&bar[XB_XCNT(b.x)], 1u);
    return b;
}
__device__ __forceinline__ void xcd_barrier_complete(unsigned* bar, unsigned x, unsigned& nloc, unsigned& nx) {
    const unsigned G = gridDim.x * gridDim.y * gridDim.z;
    unsigned sum, cnt, mine, sp = 0u;
    for (;;) {
        sum = 0u; cnt = 0u; mine = 0u;
#pragma unroll 1
        for (unsigned j = 0; j < 16; ++j) { const unsigned c = xb_ld(&bar[XB_XCNT(j)]); sum += c; cnt += (c > 0u) ? 1u : 0u; mine = (j == x) ? c : mine; }
        if (sum == G) break;
        __builtin_amdgcn_s_sleep(1);
        if ((++sp & 255u) == 0u) { if (xb_ld(&bar[XB_TMO])) break; if (sp > XB_SPIN_CAP) { atomicAdd(&bar[XB_TMO], 1u); break; } }
    }
    nloc = mine > 0u ? mine : 1u; nx = cnt > 0u ? cnt : 1u;
}

__device__ __forceinline__ void xcd_barrier(const XcdBarrier& b) {
    asm volatile("s_waitcnt vmcnt(0)" ::: "memory");
    __syncthreads();
    if (threadIdx.x == 0) {
        unsigned* bar = b.bar;
        __builtin_amdgcn_s_waitcnt(0);
        unsigned nloc = b.st[0], nx = b.st[1];
        if (nloc == 0u) { xcd_barrier_complete(bar, b.x, nloc, nx); b.st[0] = nloc; b.st[1] = nx; }
        const unsigned old = xb_add(&bar[XB_XSUB(b.x)], 1u);
        const unsigned gen = old / nloc;
        if (old + 1u == (gen + 1u) * nloc) {
            __builtin_amdgcn_fence(__ATOMIC_RELEASE, "agent");
            asm volatile("s_waitcnt vmcnt(0)" ::: "memory");
            const unsigned og = xb_add(&bar[XB_TOP], 1u);
            const unsigned tg = og / nx;
            if (og + 1u == (tg + 1u) * nx) xb_add(&bar[XB_TOPGEN], 1u);
            else XB_SPIN(xb_ld(&bar[XB_TOPGEN]) == tg, bar);
            __builtin_amdgcn_fence(__ATOMIC_ACQUIRE, "agent");
            xb_add(&bar[XB_XGEN(b.x)], 1u);
            asm volatile("s_waitcnt vmcnt(0)" ::: "memory");
        } else {
            XB_SPIN(xb_ld(&bar[XB_XGEN(b.x)]) == gen, bar);
            __builtin_amdgcn_fence(__ATOMIC_ACQUIRE, "agent");
            asm volatile("s_waitcnt vmcnt(0)" ::: "memory");
        }
    }
    __syncthreads();
}

struct Frame {
    LAS unsigned char* lds; volatile LAS unsigned* MISC; gu32* ctl;
    int vcu, G;
};
__device__ __forceinline__ float bf2f(unsigned short u) { return __uint_as_float((unsigned)u << 16); }
__device__ __forceinline__ float bflo(unsigned u) { return __uint_as_float(u << 16); }
__device__ __forceinline__ float bfhi(unsigned u) { return __uint_as_float(u & 0xffff0000u); }
__device__ __forceinline__ float wave_sum(float v) {
#pragma unroll
    for (int o = 1; o < 64; o <<= 1) v += __shfl_xor(v, o);
    return v;
}
__device__ __forceinline__ float red16_sum(float v) { v += __shfl_xor(v, 1, 16); v += __shfl_xor(v, 2, 16); v += __shfl_xor(v, 4, 16); v += __shfl_xor(v, 8, 16); return v; }
__device__ __forceinline__ float red16_max(float v) { v = fmaxf(v, __shfl_xor(v, 1, 16)); v = fmaxf(v, __shfl_xor(v, 2, 16)); v = fmaxf(v, __shfl_xor(v, 4, 16)); v = fmaxf(v, __shfl_xor(v, 8, 16)); return v; }
__device__ __forceinline__ int rel_bucket(int n) {
    if (n < 16) return n;
    return 16 + (n >= 22) + (n >= 30) + (n >= 40) + (n >= 54) + (n >= 73) + (n >= 99) + (n >= 134) + (n >= 182) + (n >= 246) + (n >= 332) + (n >= 450) + (n >= 609) + (n >= 825) + (n >= 1117) + (n >= 1513);
}

__device__ __forceinline__ void xpose_item(const float* W, int ldw, int c0, int nvalid, int k0, bf16* WT, int Kd, int drow0, LAS float* scr, int lane, const float* kgain = nullptr) {
#pragma unroll
    for (int i = 0; i < 8; ++i) { const int kk = 8 * i + (lane >> 3), n = (lane & 7) * 4;
        float4 wv = make_float4(0.f, 0.f, 0.f, 0.f);
        if (n + 3 < nvalid) wv = *(const float4*)(W + (size_t)(k0 + kk) * ldw + c0 + n);
        else if (n < nvalid) { const float* wp = W + (size_t)(k0 + kk) * ldw + c0 + n; wv.x = wp[0]; if (n + 1 < nvalid) wv.y = wp[1]; if (n + 2 < nvalid) wv.z = wp[2]; }
        if (kgain) { const float g_ = kgain[k0 + kk]; wv.x *= g_; wv.y *= g_; wv.z *= g_; wv.w *= g_; }
        LAS float* sp = scr + kk * 33 + n; sp[0] = wv.x; sp[1] = wv.y; sp[2] = wv.z; sp[3] = wv.w; }
    LDS_WAIT(); asm volatile("" ::: "memory");
    const int c = lane & 7;
#pragma unroll
    for (int j = 0; j < 4; ++j) { const int n = (lane >> 3) + 8 * j; const LAS float* s = scr + (8 * c) * 33 + n;
        v4u o; o.x = pk2(s[0 * 33], s[1 * 33]); o.y = pk2(s[2 * 33], s[3 * 33]); o.z = pk2(s[4 * 33], s[5 * 33]); o.w = pk2(s[6 * 33], s[7 * 33]);
        *(GAS v4u*)(WT + (size_t)(drow0 + n) * Kd + k0 + 8 * c) = o; }
    LDS_WAIT(); asm volatile("" ::: "memory");
}
__device__ __forceinline__ void rms_row_to_bf16(const float* xrow, const float* gain, bf16* orow, int lane) {
    const GAS f32x4* xr = (const GAS f32x4*)xrow + lane; const GAS f32x4* gr = (const GAS f32x4*)gain + lane;
    f32x4 v[4]; float s = 0.f;
#pragma unroll
    for (int j = 0; j < 4; ++j) { v[j] = xr[64 * j]; s += (v[j].x * v[j].x + v[j].y * v[j].y) + (v[j].z * v[j].z + v[j].w * v[j].w); }
    const float r = rsqrtf(wave_sum(s) * (1.f / D) + EPSF);
    GAS unsigned long long* o8 = (GAS unsigned long long*)orow + lane;
#pragma unroll
    for (int j = 0; j < 4; ++j) { const f32x4 g = gr[64 * j]; o8[64 * j] = (unsigned long long)pk2((v[j].x * r) * g.x, (v[j].y * r) * g.y) | ((unsigned long long)pk2((v[j].z * r) * g.z, (v[j].w * r) * g.w) << 32); }
}
#ifndef PROBE_REP
#define PROBE_REP 0
#endif
#define CAS __attribute__((address_space(4)))
#define KARGS() const CAS In* Ip = (const CAS In*)__builtin_amdgcn_kernarg_segment_ptr(); asm volatile("" : "+s"(Ip))
#define OPAQUE_TID() int tid_ = threadIdx.x; asm volatile("" : "+v"(tid_))
__device__ __forceinline__ void norm_phase(Frame& F, const float* x, const float* gain, bf16* xn) {
    OPAQUE_TID(); const int lane_ = tid_ & 63, wave_ = tid_ >> 6;
    const int gw = F.vcu * NWAVES + wave_, NGW = F.G * NWAVES;
    for (int m = gw; m < M; m += NGW) rms_row_to_bf16(x + (size_t)m * D, gain, xn + (size_t)m * D, lane_);
}

template <int DL>
__device__ __forceinline__ void coop_attend(const float (&q)[DL], const float (&k)[DL], const float (&v)[DL], float bias, float& m_, float& l_, float (&o)[DL]) {
    float a = 0.f;
#pragma unroll
    for (int d = 0; d < DL; ++d) a += q[d] * k[d];
    a = red16_sum(a) + bias;
    const float mn = fmaxf(m_, a), al = __expf(m_ - mn), p = __expf(a - mn);
    l_ = l_ * al + p; m_ = mn;
#pragma unroll
    for (int d = 0; d < DL; ++d) o[d] = o[d] * al + p * v[d];
}
__device__ __forceinline__ void ld4bf(const bf16* p, float (&x)[4]) { const uint2 u = *(const uint2*)p; x[0] = bflo(u.x); x[1] = bfhi(u.x); x[2] = bflo(u.y); x[3] = bfhi(u.y); }
__device__ __forceinline__ void ld8bf(const bf16* p, float (&x)[8]) { const uint4 u = *(const uint4*)p; x[0] = bflo(u.x); x[1] = bfhi(u.x); x[2] = bflo(u.y); x[3] = bfhi(u.y); x[4] = bflo(u.z); x[5] = bfhi(u.z); x[6] = bflo(u.w); x[7] = bfhi(u.w); }
__device__ __forceinline__ void ld4f(const float* p, float (&x)[4]) { const float4 u = *(const float4*)p; x[0] = u.x; x[1] = u.y; x[2] = u.z; x[3] = u.w; }

struct In {
    const float *x, *mem, *rel_bias, *norm_mix, *norm_ffn, *norm_mem, *w_mem_kv, *w_out, *ffn_gate, *ffn_up, *ffn_down, *nsa_w_in, *nsa_gate_b, *pos_k, *pos_v,
        *k_w1, *k_b1, *k_w2, *k_b2, *v_w1, *v_b1, *v_w2, *v_b2, *dsa_w_in, *q_norm, *kv_norm, *w_q_up, *w_uk, *w_uv, *w_q_idx, *kidx_norm, *norm_final;
};
__device__ __forceinline__ void p0_prologue(Frame& F, const In& I, unsigned char* ws) {
    OPAQUE_TID(); KARGS(); const int lane_ = tid_ & 63, wave_ = __builtin_amdgcn_readfirstlane(tid_ >> 6);
    LAS float* scr = (LAS float*)(F.lds + RING_OFF + wave_ * 16384);
    const int gw = F.vcu * NWAVES + wave_, NGW = F.G * NWAVES;
    bf16* WIN0 = (bf16*)(ws + WS_WIN0); bf16* WO = (bf16*)(ws + WS_WO); bf16* WGU = (bf16*)(ws + WS_WGU); bf16* WD = (bf16*)(ws + WS_WD); bf16* WIN1 = (bf16*)(ws + WS_WIN1); bf16* WQ2 = (bf16*)(ws + WS_WQ2);
    constexpr int I_A = 16 * 56, I_G = 16 * 8, I_B = 2 * 16 * 32, I_C = 2 * 16 * 176, I_D = 2 * 44 * 32, I_E = 16 * 24, I_F = 4 * 16, NITEMS = I_A + I_B + I_C + I_D + I_E + I_F + I_G;
    for (int it = gw; it < NITEMS; it += NGW) {
        int r = it;
        if (r < I_A) { const int kb = r / 56, nb = r % 56, r0 = 32 * nb; int c0, nv;
            if (r0 < 1152) { c0 = r0; nv = 32; } else if (r0 < 1280) { c0 = r0 + 128; nv = 32; } else if (r0 < 1536) { c0 = r0 + 292; nv = 32; } else if (r0 == 1536) { c0 = 1536; nv = 32; } else if (r0 == 1568) { c0 = 1568; nv = 4; } else { c0 = 0; nv = 0; }
            xpose_item(Ip->nsa_w_in, NSA_IN, c0, nv, 64 * kb, WIN0, D, r0, scr, lane_); continue; } r -= I_A;
        if (r < I_B) { const int l = r / 512, q = r % 512, kb = q / 32, nb = q % 32;
            xpose_item(Ip->w_out + (size_t)l * D * D, D, 32 * nb, 32, 64 * kb, WO + (size_t)l * D * D, D, 32 * nb, scr, lane_); continue; } r -= I_B;
        if (r < I_C) { const int l = r / (16 * 176), q = r % (16 * 176), kb = q / 176, nb = q % 176, r0 = 32 * nb, pn = r0 >> 8, w0 = r0 & 255;
            const float* src = ((w0 < 128) ? Ip->ffn_gate : Ip->ffn_up) + (size_t)l * D * DFF;
            xpose_item(src, DFF, 128 * pn + (w0 & 127), 32, 64 * kb, WGU + (size_t)l * 2 * DFF * D, D, r0, scr, lane_, Ip->norm_ffn + l * D); continue; } r -= I_C;
        if (r < I_D) { const int l = r / (44 * 32), q = r % (44 * 32), kb = q / 32, nb = q % 32;
            xpose_item(Ip->ffn_down + (size_t)l * DFF * D, D, 32 * nb, 32, 64 * kb, WD + (size_t)l * D * DFF, DFF, 32 * nb, scr, lane_); continue; } r -= I_D;
        if (r < I_E) { const int kb = r / 24, nb = r % 24, r0 = 32 * nb; int nv = DSA_IN - r0; nv = nv > 32 ? 32 : (nv < 0 ? 0 : nv);
            xpose_item(Ip->dsa_w_in, DSA_IN, r0, nv, 64 * kb, WIN1, D, r0, scr, lane_, Ip->norm_mix + D); continue; } r -= I_E;
        if (r < I_F) { const int kb = r / 16, nb = r % 16; xpose_item(Ip->w_q_idx, 512, 32 * nb, 32, 64 * kb, WQ2, 256, 1536 + 32 * nb, scr, lane_); continue; } r -= I_F;
        { const int kb = r / 8, nb = r % 8, r0 = 32 * nb;
            xpose_item(Ip->nsa_w_in, NSA_IN, (r0 < 128) ? 1152 + r0 : 1408 + (r0 - 128), 32, 64 * kb, (bf16*)(ws + WS_WVT), D, r0, scr, lane_); }
    }
    for (int idx = (F.vcu * NWAVES * 64) + tid_; idx < 384 * 256; idx += F.G * NWAVES * 64) {
        const int c = idx & 255, r4 = (idx >> 8) & 31, h = idx >> 13; const float4* a4 = (const float4*)(Ip->w_q_up + (size_t)c * 768 + h * 64); const float4* b4 = (const float4*)(Ip->w_uk + (size_t)(4 * r4) * 768 + h * 64);
        float s0 = 0.f, s1 = 0.f, s2 = 0.f, s3 = 0.f;
#pragma unroll 4
        for (int d = 0; d < 16; ++d) { const float4 av = a4[d], b0 = b4[d], b1 = b4[192 + d], b2 = b4[384 + d], b3 = b4[576 + d];
            s0 += (av.x * b0.x + av.y * b0.y) + (av.z * b0.z + av.w * b0.w); s1 += (av.x * b1.x + av.y * b1.y) + (av.z * b1.z + av.w * b1.w);
            s2 += (av.x * b2.x + av.y * b2.y) + (av.z * b2.z + av.w * b2.w); s3 += (av.x * b3.x + av.y * b3.y) + (av.z * b3.z + av.w * b3.w); }
        const float sc_ = 0.125f * 1.4426950408889634f;
        bf16* o_ = WQ2 + (size_t)(h * 128 + 4 * r4) * 256 + c;
        o_[0] = (bf16)f2bf(s0 * sc_); o_[256] = (bf16)f2bf(s1 * sc_); o_[512] = (bf16)f2bf(s2 * sc_); o_[768] = (bf16)f2bf(s3 * sc_);
    }
    { bf16* WO1F = (bf16*)(ws + WS_WO1F); const float* wo1 = Ip->w_out + (size_t)D * D;
      for (int idx = (F.vcu * NWAVES * 64) + tid_; idx < 12 * 32 * 256; idx += F.G * NWAVES * 64) {
          const int n4 = idx & 255, r4 = (idx >> 8) & 31, h = idx >> 13; const float* a = Ip->w_uv + (size_t)(4 * r4) * 768 + h * 64; const float* bcol = wo1 + (size_t)(h * 64) * D + 4 * n4;
          float acc_[4][4];
#pragma unroll
          for (int i = 0; i < 4; ++i)
#pragma unroll
              for (int j = 0; j < 4; ++j) acc_[i][j] = 0.f;
#pragma unroll 4
          for (int d = 0; d < 64; ++d) { const float4 bv = *(const float4*)(bcol + (size_t)d * D); const float a0 = a[d], a1 = a[768 + d], a2 = a[1536 + d], a3 = a[2304 + d];
              acc_[0][0] += a0 * bv.x; acc_[0][1] += a0 * bv.y; acc_[0][2] += a0 * bv.z; acc_[0][3] += a0 * bv.w; acc_[1][0] += a1 * bv.x; acc_[1][1] += a1 * bv.y; acc_[1][2] += a1 * bv.z; acc_[1][3] += a1 * bv.w;
              acc_[2][0] += a2 * bv.x; acc_[2][1] += a2 * bv.y; acc_[2][2] += a2 * bv.z; acc_[2][3] += a2 * bv.w; acc_[3][0] += a3 * bv.x; acc_[3][1] += a3 * bv.y; acc_[3][2] += a3 * bv.z; acc_[3][3] += a3 * bv.w; }
#pragma unroll
          for (int j = 0; j < 4; ++j) *(uint2*)(WO1F + (size_t)(4 * n4 + j) * 1792 + h * 128 + 4 * r4) = make_uint2(pk2(acc_[0][j], acc_[1][j]), pk2(acc_[2][j], acc_[3][j])); }
      for (int it = gw; it < 4 * 32; it += NGW) { const int kb = it / 32, nb = it % 32;
          xpose_item(wo1 + (size_t)768 * D, D, 32 * nb, 32, 64 * kb, WO1F + 1536, 1792, 32 * nb, scr, lane_); } }
    { bf16* W1T = (bf16*)(ws + WS_W1T); bf16* W2T = (bf16*)(ws + WS_W2T); bf16* WMKT = (bf16*)(ws + WS_WMKT); float* B1F = (float*)(ws + WS_B1F); bf16* MEMN = (bf16*)(ws + WS_MEMN);
      constexpr int J_1 = 2 * 32 * 8, J_2 = 2 * 4 * 2, J_M = 2 * 16 * 16;
      for (int it = gw; it < J_1 + J_2 + J_M; it += NGW) { int r2 = it;
          if (r2 < J_1) { const int kv = r2 / 256, q = r2 % 256, kb = q / 8, nb = q % 8; xpose_item(kv ? Ip->v_w1 : Ip->k_w1, 256, 32 * nb, 32, 64 * kb, W1T + (size_t)kv * 256 * 2048, 2048, 32 * nb, scr, lane_); continue; } r2 -= J_1;
          if (r2 < J_2) { const int kv = r2 / 8, q = r2 % 8, kb = q / 2, nb = q % 2; xpose_item(kv ? Ip->v_w2 : Ip->k_w2, 64, 32 * nb, 32, 64 * kb, W2T + (size_t)kv * 64 * 256, 256, 32 * nb, scr, lane_); continue; } r2 -= J_2;
          { const int l = r2 / 256, q = r2 % 256, kb = q / 16, nb = q % 16; xpose_item(Ip->w_mem_kv + (size_t)l * D * 512, 512, 32 * nb, 32, 64 * kb, WMKT + (size_t)l * 512 * D, D, 32 * nb, scr, lane_); } }
      if ((int)blockIdx.x < 32) { const int u_ = (int)blockIdx.x, kv = u_ >> 4, cr = (u_ >> 2) & 3, kq4 = u_ & 3, c = 64 * cr + lane_; const float* w1 = kv ? Ip->v_w1 : Ip->k_w1; const float* pos = kv ? Ip->pos_v : Ip->pos_k;
          const int kb0 = 512 * kq4 + 64 * wave_; float sacc = 0.f;
#pragma unroll 8
          for (int k = 0; k < 64; ++k) sacc += pos[kb0 + k] * w1[(size_t)(kb0 + k) * 256 + c];
          LAS float* red = (LAS float*)(F.lds + RING_OFF + 8 * 16384);
          red[wave_ * 64 + lane_] = sacc;
          __syncthreads();
          if (wave_ == 0) { float t_ = 0.f;
#pragma unroll
              for (int w = 0; w < 8; ++w) t_ += red[w * 64 + lane_];
              B1F[(kv * 4 + kq4) * 256 + c] = t_; } }
      for (int m = gw; m < 1024; m += NGW) rms_row_to_bf16(Ip->mem + (size_t)(m & 511) * D, Ip->norm_mem + (m >> 9) * D, MEMN + (size_t)m * D, lane_); }
    norm_phase(F, Ip->x, Ip->norm_mix, (bf16*)(ws + WS_XN));
}

#define MFMA16(A, B, C) __builtin_amdgcn_mfma_f32_16x16x32_bf16((A), (B), (C), 0, 0, 0)
constexpr float LOG2E = 1.4426950408889634f;
constexpr int NSA_OUT = 0, NSA_PSQ = 49152, NSA_ST = 147456, NSA_TB = NSA_ST + 3072;
constexpr int TAB_B12 = NSA_ST + 1024;
constexpr int P13_JUNK = NSA_ST + 3072 + 1536;
constexpr int P13_B12 = NSA_ST;
constexpr int TAB_BKT = NSA_ST + 3072;
static_assert(NSA_TB + 12288 <= LDSCTL_OFF && TAB_B12 + 2048 <= NSA_TB, "LDS tables");
enum { MD_CMP = 0, MD_WIN = 1, MD_BLK = 2, MD_MEM = 3 };
struct KF { bf16x8 a0, a1, b0, b1; };
struct VF { bf16x8 v[4]; };
__device__ __forceinline__ bf16x8 ldg16(const bf16* p) { return *(const bf16x8*)p; }
typedef float f32x2_t __attribute__((ext_vector_type(2))); typedef __bf16 bf16x2_t __attribute__((ext_vector_type(2)));
__device__ __forceinline__ unsigned cvtpk_s(float lo, float hi) { f32x2_t v = {lo, hi}; bf16x2_t b = __builtin_convertvector(v, bf16x2_t); return __builtin_bit_cast(unsigned, b); }
__device__ __forceinline__ bf16x8 pack8(const f32x4& a, const f32x4& b) { v4u w; w.x = cvtpk_s(a[0], a[1]); w.y = cvtpk_s(a[2], a[3]); w.z = cvtpk_s(b[0], b[1]); w.w = cvtpk_s(b[2], b[3]); return __builtin_bit_cast(bf16x8, w); }
__device__ __forceinline__ void load_k(KF& k, const bf16* kb, int kstride, int key0, int r, int kq) {
    const bf16* pa = kb + (size_t)(key0 + 8 * (r >> 2) + (r & 3)) * kstride + 8 * kq; const bf16* pb = pa + 4 * (size_t)kstride;
    k.a0 = ldg16(pa); k.a1 = ldg16(pa + 32); k.b0 = ldg16(pb); k.b1 = ldg16(pb + 32);
}
__device__ __forceinline__ void load_vt(VF& v, const bf16* vt, int vstride, int key0, int r, int kq) {
#pragma unroll
    for (int dt = 0; dt < 4; ++dt) v.v[dt] = ldg16(vt + (size_t)(16 * dt + r) * vstride + key0 + 8 * kq);
}
__device__ __forceinline__ void qk(f32x4& sa, f32x4& sb, const KF& k, const bf16x8 (&q)[2]) {
    const f32x4 z = {0.f, 0.f, 0.f, 0.f};
    sa = MFMA16(k.a0, q[0], z); sa = MFMA16(k.a1, q[1], sa); sb = MFMA16(k.b0, q[0], z); sb = MFMA16(k.b1, q[1], sb);
}
struct BiasCtx { const LAS unsigned short* tb; float d29, d30, c31; };
template <int MODE>
__device__ __forceinline__ void maskbias(f32x4& s, int kpos, int tcol, bool colok, const BiasCtx& B) {
    if (MODE == MD_MEM) return;
#pragma unroll
    for (int i = 0; i < 4; ++i) {
        int dist; bool ok;
        if (MODE == MD_CMP) { dist = tcol - 31 - 16 * (kpos + i); ok = dist >= 0; }
        else if (MODE == MD_WIN) { dist = tcol - (kpos + i); ok = (unsigned)dist <= 511u; }
        else { dist = tcol - (kpos + i); ok = dist >= 0; }
        int dc = dist < 0 ? 0 : dist; dc = dc > 1023 ? 1023 : dc;
        const float tb = __uint_as_float((unsigned)B.tb[dc * 6] << 16);
        const float far = B.c31 + (dist < 1513 ? B.d30 : 0.f) + (dist < 1117 ? B.d29 : 0.f);
        const float bias = dist < 1024 ? tb : far;
        s[i] = (ok && colok) ? s[i] + bias : -INFINITY;
    }
}
__device__ __forceinline__ float colmax(const f32x4& sa, const f32x4& sb) {
    float mx = fmaxf(fmaxf(fmaxf(sa[0], sa[1]), fmaxf(sa[2], sa[3])), fmaxf(fmaxf(sb[0], sb[1]), fmaxf(sb[2], sb[3])));
    mx = fmaxf(mx, __shfl_xor(mx, 16)); mx = fmaxf(mx, __shfl_xor(mx, 32)); return mx;
}
constexpr float SM_THR = 8.f;
__device__ __forceinline__ float lmax8(const f32x4& sa, const f32x4& sb) { return fmaxf(fmaxf(fmaxf(sa[0], sa[1]), fmaxf(sa[2], sa[3])), fmaxf(fmaxf(sb[0], sb[1]), fmaxf(sb[2], sb[3]))); }
__device__ __forceinline__ int imax3(int a, int b, int c) { return max(max(a, b), c); }
__device__ __forceinline__ int imax16(const f32x4& a, const f32x4& b, const f32x4& c, const f32x4& d) {
#define FI_(x) __float_as_int(x)
    const int t0 = imax3(FI_(a[0]), FI_(a[1]), FI_(a[2])), t1 = imax3(FI_(a[3]), FI_(b[0]), FI_(b[1])), t2 = imax3(FI_(b[2]), FI_(b[3]), FI_(c[0])), t3 = imax3(FI_(c[1]), FI_(c[2]), FI_(c[3])), t4 = imax3(FI_(d[0]), FI_(d[1]), FI_(d[2]));
    return max(imax3(t0, t1, FI_(d[3])), imax3(t2, t3, t4));
#undef FI_
}
template <int NO>
__device__ __forceinline__ void sm_rescale(float lm, float& m, float& l, f32x4 (&O)[NO]) {
    if (__any(lm > m + SM_THR)) {
        lm = fmaxf(lm, __shfl_xor(lm, 16)); lm = fmaxf(lm, __shfl_xor(lm, 32));
        const float mn = fmaxf(m, lm); const float al = __builtin_amdgcn_exp2f(m - mn); m = mn; l *= al;
#pragma unroll
        for (int dt = 0; dt < NO; ++dt) O[dt] = O[dt] * al;
    }
}
__device__ __forceinline__ bf16x8 sm_update(const f32x4& sa, const f32x4& sb, float& m, float& l, f32x4 (&O)[4]) {
    sm_rescale<4>(lmax8(sa, sb), m, l, O);
    f32x4 pa, pb; float sum = 0.f;
#pragma unroll
    for (int i = 0; i < 4; ++i) { pa[i] = __builtin_amdgcn_exp2f(sa[i] - m); pb[i] = __builtin_amdgcn_exp2f(sb[i] - m); sum += pa[i] + pb[i]; }
    l += sum;
    return pack8(pa, pb);
}
__device__ __forceinline__ void sm_update64(const f32x4& sa0, const f32x4& sb0, const f32x4& sa1, const f32x4& sb1, float& m, float& l, f32x4 (&O)[4], bf16x8& pf0, bf16x8& pf1) {
    sm_rescale<4>(fmaxf(lmax8(sa0, sb0), lmax8(sa1, sb1)), m, l, O);
    f32x4 pa0, pb0, pa1, pb1; float sum = 0.f;
#pragma unroll
    for (int i = 0; i < 4; ++i) { pa0[i] = __builtin_amdgcn_exp2f(sa0[i] - m); pb0[i] = __builtin_amdgcn_exp2f(sb0[i] - m); pa1[i] = __builtin_amdgcn_exp2f(sa1[i] - m); pb1[i] = __builtin_amdgcn_exp2f(sb1[i] - m);
        sum += (pa0[i] + pb0[i]) + (pa1[i] + pb1[i]); }
    l += sum;
    pf0 = pack8(pa0, pb0); pf1 = pack8(pa1, pb1);
}
enum { BK_FAR = 0, BK_MID = 1, BK_GEN = 2 };
template <int MD, int CLS>
__device__ __forceinline__ void step64(const KF& k0, const KF& k1, const bf16x8 (&q)[2], int cls, int kpos, int tcol, bool colok, const BiasCtx& B,
                                       float& m, float& l, f32x4 (&O)[4], bf16x8& pf0, bf16x8& pf1) {
    const bool has = m > -1e29f; const float mref = has ? m : 0.f;
    if (CLS >= 0) cls = CLS;
    float cin = ((cls == BK_FAR) ? B.c31 : 0.f) - mref; if (!colok) cin = -INFINITY;
    const f32x4 c4 = {cin, cin, cin, cin};
    f32x4 sa0 = MFMA16(k0.a0, q[0], c4), sb0 = MFMA16(k0.b0, q[0], c4), sa1 = MFMA16(k1.a0, q[0], c4), sb1 = MFMA16(k1.b0, q[0], c4);
    sa0 = MFMA16(k0.a1, q[1], sa0); sb0 = MFMA16(k0.b1, q[1], sb0); sa1 = MFMA16(k1.a1, q[1], sa1); sb1 = MFMA16(k1.b1, q[1], sb1);
    if (cls == BK_MID) {
        const LAS unsigned short* tl = B.tb + (tcol - kpos - 39) * 6;
#pragma unroll
        for (int i = 0; i < 4; ++i) { sa0[i] += __uint_as_float((unsigned)tl[6 * (39 - i)] << 16); sb0[i] += __uint_as_float((unsigned)tl[6 * (35 - i)] << 16);
            sa1[i] += __uint_as_float((unsigned)tl[6 * (7 - i)] << 16); sb1[i] += __uint_as_float((unsigned)tl[6 * (3 - i)] << 16); }
    } else if (cls == BK_GEN) {
        maskbias<MD>(sa0, kpos, tcol, true, B); maskbias<MD>(sb0, kpos + 4, tcol, true, B); maskbias<MD>(sa1, kpos + 32, tcol, true, B); maskbias<MD>(sb1, kpos + 36, tcol, true, B);
    }
    if (__any((imax16(sa0, sb0, sa1, sb1) > __float_as_int(SM_THR)) || !has)) {
        float lm = fmaxf(lmax8(sa0, sb0), lmax8(sa1, sb1));
        lm = fmaxf(lm, __shfl_xor(lm, 16)); lm = fmaxf(lm, __shfl_xor(lm, 32));
        const bool upd = (lm > -INFINITY) && (!has || lm > 0.f); const float dl = upd ? lm : 0.f;
        if (upd) m = mref + dl;
        const float f = has ? __builtin_amdgcn_exp2f(-dl) : 1.f; l *= f;
#pragma unroll
        for (int dt = 0; dt < 4; ++dt) O[dt] = O[dt] * f;
#pragma unroll
        for (int i = 0; i < 4; ++i) { sa0[i] -= dl; sb0[i] -= dl; sa1[i] -= dl; sb1[i] -= dl; }
    }
    f32x4 pa0, pb0, pa1, pb1; float sum = 0.f;
#pragma unroll
    for (int i = 0; i < 4; ++i) { pa0[i] = __builtin_amdgcn_exp2f(sa0[i]); pb0[i] = __builtin_amdgcn_exp2f(sb0[i]); pa1[i] = __builtin_amdgcn_exp2f(sa1[i]); pb1[i] = __builtin_amdgcn_exp2f(sb1[i]);
        sum += (pa0[i] + pb0[i]) + (pa1[i] + pb1[i]); }
    l += sum;
    pf0 = pack8(pa0, pb0); pf1 = pack8(pa1, pb1);
}
__device__ __forceinline__ void pv(f32x4 (&O)[4], const VF& v, const bf16x8& pf) {
#pragma unroll
    for (int dt = 0; dt < 4; ++dt) O[dt] = MFMA16(v.v[dt], pf, O[dt]);
}
__device__ __forceinline__ void lds_fadd(LAS float* p, float v) { (void)__hip_atomic_fetch_add((float*)p, v, __ATOMIC_RELAXED, __HIP_MEMORY_SCOPE_WORKGROUP); }
#define DPP_I(x, ctrl) __builtin_amdgcn_update_dpp((x), (x), (ctrl), 0xf, 0xf, false)
#define DPP_F(x, ctrl) __int_as_float(__builtin_amdgcn_update_dpp(__float_as_int(x), __float_as_int(x), (ctrl), 0xf, 0xf, false))
__device__ __forceinline__ float sum8_dpp(float v) { v += DPP_F(v, 0xB1); v += DPP_F(v, 0x4E); v += DPP_F(v, 0x141); return v; }
__device__ __forceinline__ unsigned wave_iscan_u32(unsigned x) {
#define DPP_Z(v, ctrl, rmask) (unsigned)__builtin_amdgcn_update_dpp(0, (int)(v), (ctrl), (rmask), 0xf, false)
    x += DPP_Z(x, 0x111, 0xf); x += DPP_Z(x, 0x112, 0xf); x += DPP_Z(x, 0x114, 0xf); x += DPP_Z(x, 0x118, 0xf); x += DPP_Z(x, 0x142, 0xa); x += DPP_Z(x, 0x143, 0xc);
#undef DPP_Z
    return x; }
__device__ __forceinline__ int wmax64_i(int x) {
    x = max(x, DPP_I(x, 0xB1)); x = max(x, DPP_I(x, 0x4E)); x = max(x, DPP_I(x, 0x141)); x = max(x, DPP_I(x, 0x140));
    return max(max(__builtin_amdgcn_readlane(x, 0), __builtin_amdgcn_readlane(x, 16)), max(__builtin_amdgcn_readlane(x, 32), __builtin_amdgcn_readlane(x, 48))); }
__device__ __forceinline__ float kqsum(float v) { v += __shfl_xor(v, 16); v += __shfl_xor(v, 32); return v; }
__device__ __forceinline__ float wmax64(float v) {
#pragma unroll
    for (int o = 1; o < 64; o <<= 1) v = fmaxf(v, __shfl_xor(v, o));
    return v;
}
__device__ __forceinline__ void out_add(LAS unsigned short* OUTw, int p, int n, int kq, const f32x4 (&O)[4], float scale, bool first) {
    const int q = 2 * p + (n >> 3), hd = n & 7;
    if (hd < 6) { LAS v2u* dst = (LAS v2u*)(OUTw + (q * 6 + hd) * 64) + kq;
#pragma unroll
        for (int dt = 0; dt < 4; ++dt) { f32x4 v = O[dt] * scale; if (!first) { const v2u o = dst[4 * dt]; v[0] += __uint_as_float(o.x << 16); v[1] += __uint_as_float(o.x & 0xffff0000u); v[2] += __uint_as_float(o.y << 16); v[3] += __uint_as_float(o.y & 0xffff0000u); }
            dst[4 * dt] = (v2u){pk2(v[0], v[1]), pk2(v[2], v[3])}; } }
}

__device__ __forceinline__ void p2_mfma(Frame& F, const In& I, unsigned char* ws) {
    OPAQUE_TID(); KARGS(); const int lane = tid_ & 63, wave = __builtin_amdgcn_readfirstlane(tid_ >> 6), r = lane & 15, kq = lane >> 4;
    const bf16* KV0 = (const bf16*)(ws + WS_KV0); const bf16* W1T = (const bf16*)(ws + WS_W1T); const bf16* W2T = (const bf16*)(ws + WS_W2T); const float* B1F = (const float*)(ws + WS_B1F);
    const bf16* MEMN = (const bf16*)(ws + WS_MEMN); const bf16* WMKT = (const bf16*)(ws + WS_WMKT);
    bf16* KCB = (bf16*)(ws + WS_KCB); bf16* VCT = (bf16*)(ws + WS_VCT); bf16* MKB = (bf16*)(ws + WS_MKB); bf16* MVT = (bf16*)(ws + WS_MVT);
    LAS unsigned char* hid = F.lds + RING_OFF;
    for (int u = blockIdx.x; u < 192; u += F.G) {
        const bool cmp = u < 128;
        const bf16* ap[2]; const bf16* bp[2]; int K, kjump;
        int kv = 0, bg = 0, n0 = 0, lay = 0, m0 = 0, ch = 0;
        if (cmp) { kv = u >> 6; bg = (u >> 4) & 3; n0 = (u & 15) * 32; const int b = bg >> 1, g = bg & 1; K = 2048; kjump = 512 - 64;
#pragma unroll
            for (int rt = 0; rt < 2; ++rt) { int nn = n0 + 16 * rt + r; nn = nn > 510 ? 510 : nn; ap[rt] = KV0 + (size_t)(b * T + 16 * nn) * 512 + kv * 128 + g * 64 + 8 * kq; }
#pragma unroll
            for (int ct = 0; ct < 2; ++ct) bp[ct] = W1T + (size_t)(kv * 256 + 32 * wave + 16 * ct + r) * 2048 + 8 * kq;
        } else { const int v = u - 128; lay = v >> 5; m0 = ((v >> 1) & 15) * 32; ch = v & 1; K = 1024; kjump = 0;
#pragma unroll
            for (int rt = 0; rt < 2; ++rt) ap[rt] = MEMN + (size_t)(lay * 512 + m0 + 16 * rt + r) * 1024 + 8 * kq;
#pragma unroll
            for (int ct = 0; ct < 2; ++ct) bp[ct] = WMKT + (size_t)(lay * 512 + ch * 256 + 32 * wave + 16 * ct + r) * 1024 + 8 * kq;
        }
        f32x4 acc[2][2];
#pragma unroll
        for (int rt = 0; rt < 2; ++rt)
#pragma unroll
            for (int ct = 0; ct < 2; ++ct) acc[rt][ct] = (f32x4){0.f, 0.f, 0.f, 0.f};
        bf16x8 a[2][2], bb[2][2];
#define P2_LOAD(A_, B_, kb_) do { const int kbl_ = (kb_) < K ? (kb_) : K - 64; const int ao_ = kbl_ + (kbl_ >> 6) * kjump; \
            _Pragma("unroll") for (int h2 = 0; h2 < 2; ++h2) { \
                _Pragma("unroll") for (int rt = 0; rt < 2; ++rt) A_[rt][h2] = ldg16(ap[rt] + ao_ + 32 * h2); \
                _Pragma("unroll") for (int ct = 0; ct < 2; ++ct) B_[ct][h2] = ldg16(bp[ct] + kbl_ + 32 * h2); } } while (0)
        P2_LOAD(a, bb, 0);
        for (int kb = 0; kb < K; kb += 64) {
            bf16x8 an[2][2], bn[2][2]; P2_LOAD(an, bn, kb + 64);
#pragma unroll
            for (int h2 = 0; h2 < 2; ++h2)
#pragma unroll
                for (int rt = 0; rt < 2; ++rt)
#pragma unroll
                    for (int ct = 0; ct < 2; ++ct) acc[rt][ct] = MFMA16(a[rt][h2], bb[ct][h2], acc[rt][ct]);
#pragma unroll
            for (int h2 = 0; h2 < 2; ++h2)
#pragma unroll
                for (int x = 0; x < 2; ++x) { a[x][h2] = an[x][h2]; bb[x][h2] = bn[x][h2]; }
        }
#undef P2_LOAD
        if (cmp) {
#pragma unroll
            for (int ct = 0; ct < 2; ++ct) { const int col = 32 * wave + 16 * ct + r; const float bias = (kv ? Ip->v_b1 : Ip->k_b1)[col] + ((B1F[(kv * 4 + 0) * 256 + col] + B1F[(kv * 4 + 1) * 256 + col]) + (B1F[(kv * 4 + 2) * 256 + col] + B1F[(kv * 4 + 3) * 256 + col]));
#pragma unroll
                for (int rt = 0; rt < 2; ++rt)
#pragma unroll
                    for (int i = 0; i < 4; ++i) { const float xg = acc[rt][ct][i] + bias; const float hv = 0.5f * xg * (1.f + tanhf(0.7978845608028654f * (xg + 0.044715f * xg * xg * xg)));
                        *(LAS unsigned short*)(hid + (16 * rt + 4 * kq + i) * 528 + 2 * col) = (unsigned short)f2bf(hv); } }
            __syncthreads();
            { const int rt2 = wave >> 2, ct2 = wave & 3; f32x4 o = {0.f, 0.f, 0.f, 0.f};
              const bf16* w2p = W2T + (size_t)(kv * 64 + 16 * ct2 + r) * 256 + 8 * kq;
#pragma unroll
              for (int ks = 0; ks < 8; ++ks) { const bf16x8 av = *(const LAS bf16x8*)(hid + (16 * rt2 + r) * 528 + 64 * ks + 16 * kq); o = MFMA16(av, ldg16(w2p + 32 * ks), o); }
              const int d = 16 * ct2 + r; const float b2v = (kv ? Ip->v_b2 : Ip->k_b2)[d];
#pragma unroll
              for (int i = 0; i < 4; ++i) { const int nn = n0 + 16 * rt2 + 4 * kq + i; const unsigned short ov = (nn < NCMP) ? (unsigned short)f2bf(o[i] + b2v) : (unsigned short)0;
                  if (kv) VCT[(size_t)(bg * 64 + d) * 512 + nn] = ov; else KCB[(size_t)(bg * 512 + nn) * 64 + d] = ov; } }
            __syncthreads();
        } else {
#pragma unroll
            for (int ct = 0; ct < 2; ++ct) { const int col = 32 * wave + 16 * ct + r;
#pragma unroll
                for (int rt = 0; rt < 2; ++rt)
#pragma unroll
                    for (int i = 0; i < 4; ++i) { const int mrow = m0 + 16 * rt + 4 * kq + i; const unsigned short ov = (unsigned short)f2bf(acc[rt][ct][i]);
                        if (ch == 0) MKB[(size_t)(lay * 512 + mrow) * 256 + col] = ov; else MVT[(size_t)(lay * 256 + col) * 512 + mrow] = ov; } }
        }
    }
}

template <int MODE>
__device__ __forceinline__ void mb2(f32x4& sa, f32x4& sb, int kpos, int tcol, bool colok, bool fast, const BiasCtx& B) {
    if (fast) { if (colok) { sa = sa + B.c31; sb = sb + B.c31; } else { sa = (f32x4){-INFINITY, -INFINITY, -INFINITY, -INFINITY}; sb = sa; } }
    else { maskbias<MODE>(sa, kpos, tcol, colok, B); maskbias<MODE>(sb, kpos + 4, tcol, colok, B); }
}
#define SWZ(row) (((((row) >> 3) & 3) << 1) | (((row) >> 1) & 1))
struct KV1 { KF k; VF v; };
__device__ __forceinline__ void load_kv(KV1& d, const bf16* kb, int kstride, const bf16* vt, int vstride, int key0, int r, int kq) { load_k(d.k, kb, kstride, key0, r, kq); load_vt(d.v, vt, vstride, key0, r, kq); }

template <int MD, int FORCE = 0>
__device__ __forceinline__ void nsa_sweep(LAS unsigned char* STG, const bf16* ksb, const bf16* vst, int jlo, int jhi, int qt, const LAS unsigned* WMw, int wave, int lane, int r, int kq, int qsel, int t0w,
                                          const bf16x8 (&qf)[4][2], const BiasCtx& BC, float (&m)[4], float (&l)[4], f32x4 (&O)[4][4],
                                          int kstr = 512, int kblk = 64 * 512, int vstr = 64, int vblk = 16384) {
            const int srow = 8 * wave + (lane >> 3), sch = (lane & 7) ^ SWZ(srow);
            const bf16* ksrc = ksb + (size_t)srow * kstr + 8 * sch; const bf16* vsrc = vst + (size_t)srow * vstr + 8 * sch;
#define NSA_DMA(jb) do { LAS unsigned char* d_ = STG + ((jb) % 6) * 16384 + wave * 1024; \
                __builtin_amdgcn_global_load_lds((const unsigned*)(ksrc + (size_t)(jb) * kblk), (LAS unsigned*)d_, 16, 0, 0); \
                __builtin_amdgcn_global_load_lds((const unsigned*)(vsrc + (size_t)(jb) * vblk), (LAS unsigned*)(d_ + 8192), 16, 0, 0); } while (0)
#define NSA_WAITV(n_) do { if ((n_) >= 4) asm volatile("s_waitcnt vmcnt(4) lgkmcnt(0)" ::: "memory"); else if ((n_) == 2) asm volatile("s_waitcnt vmcnt(2) lgkmcnt(0)" ::: "memory"); else asm volatile("s_waitcnt vmcnt(0) lgkmcnt(0)" ::: "memory"); } while (0)
            { const int nb = jhi - jlo + 1;
#pragma unroll
              for (int i = 0; i < 4; ++i) if (i < nb) NSA_DMA(jlo + i);
              const int issued = nb < 4 ? nb : 4, need = nb < 2 ? nb : 2; NSA_WAITV(2 * (issued - need)); }
            __builtin_amdgcn_s_barrier();
#define NSA_TILES(CLS_) _Pragma("unroll") for (int p = 0; p < 4; ++p) if (m8 & (3u << (2 * p))) { \
                        bf16x8 pf0, pf1; \
                        step64<MD, CLS_>(k0, k1, qf[p], cls, 64 * j + 8 * kq_, t0w + 2 * p + qs_, ((m8 >> (2 * p + qs_)) & 1u) != 0u, BC, m[p], l[p], O[p], pf0, pf1); \
                        pv(O[p], v0, pf0); pv(O[p], v1, pf1); \
                        __builtin_amdgcn_sched_barrier(0); }
            auto tiles = [&](auto clsx, int j) __attribute__((always_inline)) { constexpr int CLSX = decltype(clsx)::value;
                const LAS unsigned char* sk = STG + (j % 6) * 16384; const LAS unsigned char* sv = sk + 8192;
                unsigned m8 = 0xffu; if (WMw) m8 = (unsigned)__builtin_amdgcn_readfirstlane((int)((WMw[j >> 2] >> (8 * (j & 3))) & 0xffu)); if (FORCE == 1) m8 = 0u; if (FORCE == 2) m8 = 0xffu; if (MD == MD_MEM) m8 = 3u; else asm volatile("" : "+s"(m8));
                if (m8) {
                    int r_ = r, kq_ = kq, qs_ = qsel; asm volatile("" : "+v"(r_), "+v"(kq_), "+v"(qs_));
                    const int dj = qt - j; const int cls = (MD == MD_MEM) ? BK_FAR : (MD == MD_WIN) ? ((dj >= 1 && dj <= 7) ? BK_MID : BK_GEN) : ((64 * dj - 63 >= 1513) ? BK_FAR : ((dj >= 1 && dj <= 15) ? BK_MID : BK_GEN));
                    KF k0, k1;
                    { const int ka = 8 * (r_ >> 2) + (r_ & 3), kb2 = ka + 4, kc = ka + 32, kd = ka + 36;
                      k0.a0 = *(const LAS bf16x8*)(sk + ka * 128 + ((kq_ ^ SWZ(ka)) << 4)); k0.a1 = *(const LAS bf16x8*)(sk + ka * 128 + (((4 + kq_) ^ SWZ(ka)) << 4));
                      k0.b0 = *(const LAS bf16x8*)(sk + kb2 * 128 + ((kq_ ^ SWZ(kb2)) << 4)); k0.b1 = *(const LAS bf16x8*)(sk + kb2 * 128 + (((4 + kq_) ^ SWZ(kb2)) << 4));
                      k1.a0 = *(const LAS bf16x8*)(sk + kc * 128 + ((kq_ ^ SWZ(kc)) << 4)); k1.a1 = *(const LAS bf16x8*)(sk + kc * 128 + (((4 + kq_) ^ SWZ(kc)) << 4));
                      k1.b0 = *(const LAS bf16x8*)(sk + kd * 128 + ((kq_ ^ SWZ(kd)) << 4)); k1.b1 = *(const LAS bf16x8*)(sk + kd * 128 + (((4 + kq_) ^ SWZ(kd)) << 4)); }
                    VF v0, v1;
#pragma unroll
                    for (int dt = 0; dt < 4; ++dt) { const int dd = 16 * dt + r_; v0.v[dt] = *(const LAS bf16x8*)(sv + dd * 128 + ((kq_ ^ SWZ(dd)) << 4)); v1.v[dt] = *(const LAS bf16x8*)(sv + dd * 128 + (((4 + kq_) ^ SWZ(dd)) << 4)); }
                    NSA_TILES(CLSX)
                }
            };
            int ni = 0;
            auto blk = [&](auto clsx, int j) __attribute__((always_inline)) {
                const bool head = ((j - jlo) & 1) == 0;
                if (head) { ni = 0; if (j + 4 <= jhi) { NSA_DMA(j + 4); ni += 2; } if (j + 5 <= jhi) { NSA_DMA(j + 5); ni += 2; } }
                tiles(clsx, j);
                if (!head || j == jhi) { NSA_WAITV(ni); __builtin_amdgcn_s_barrier(); }
            };
            int j = jlo;
            if (MD == MD_BLK || MD == MD_MEM) { const int jfar = (MD == MD_MEM) ? jhi : ((qt - 25 < jhi) ? qt - 25 : jhi); const int jfe = jlo + (((jfar - jlo + 1) >> 1) << 1) - 1;
                for (; j <= jfe; ++j) blk(std::integral_constant<int, BK_FAR>{}, j); }
            for (; j <= jhi; ++j) blk(std::integral_constant<int, -1>{}, j);
#undef NSA_WAITV
#undef NSA_TILES
#undef NSA_DMA
}
__device__ __forceinline__ void p3_nsa_mfma(Frame& F, const In& I, unsigned char* ws) {
    OPAQUE_TID(); KARGS(); const int wave = __builtin_amdgcn_readfirstlane(tid_ >> 6);
    LAS float* b12 = (LAS float*)(F.lds + TAB_B12);
    LAS unsigned short* OUTw = (LAS unsigned short*)(F.lds + NSA_OUT) + wave * 3072;
    LAS float* PSw = (LAS float*)(F.lds + NSA_PSQ) + wave * 1024;
    LAS unsigned char* STG = F.lds + NSA_PSQ;
    LAS unsigned* WMw = (LAS unsigned*)(F.lds + NSA_ST) + wave * 32;
    for (int i = tid_; i < 512; i += NWAVES * 64) b12[i] = ((i & 15) < 12) ? Ip->rel_bias[(i >> 4) * 12 + (i & 15)] * LOG2E : 0.f;
    LAS unsigned short* TB = (LAS unsigned short*)(F.lds + NSA_TB);
    { const int gg = (int)blockIdx.x & 1;
      for (int i = tid_; i < 6144; i += NWAVES * 64) { const int dd = i / 6, hh = i % 6; TB[i] = (unsigned short)f2bf(Ip->rel_bias[rel_bucket(dd) * 12 + gg * 6 + hh] * LOG2E); } }
    __syncthreads();
    const bf16* Q0 = (const bf16*)(ws + WS_Q0); const bf16* KV0 = (const bf16*)(ws + WS_KV0); const bf16* QM = (const bf16*)(ws + WS_QM); const bf16* G0 = (const bf16*)(ws + WS_G0);
    const bf16* VT = (const bf16*)(ws + WS_VT); const bf16* KCB = (const bf16*)(ws + WS_KCB); const bf16* VCT = (const bf16*)(ws + WS_VCT);
    const bf16* MKB = (const bf16*)(ws + WS_MKB); const bf16* MVT = (const bf16*)(ws + WS_MVT);
    bf16* CAT = (bf16*)(ws + WS_CAT);
    const int nun = 4 * 128;
    for (int ui = blockIdx.x; ui < nun; ui += F.G) {
        int tl_ = tid_; asm volatile("" : "+v"(tl_));
        const int lane = tl_ & 63, n = lane & 15, kq = lane >> 4, r = n, hd = n & 7, qsel = n >> 3; const bool colv = hd < 6;
        int bg, qt;
        bg = blockIdx.x & 3;
        if (F.G == 256) { const int idx = blockIdx.x >> 2; qt = (ui < 256) ? idx : 127 - idx; }
        else { qt = ui >> 2; if ((ui & 3) != bg) continue; }
        const int b = bg >> 1, g = bg & 1, t0w = 64 * qt + 8 * wave, rowb = b * T;
        const int habs = g * 6 + (colv ? hd : 0);
        const LAS float* b12c = b12 + habs; const BiasCtx BC{TB + (colv ? hd : 0), b12c[29 * 16] - b12c[30 * 16], b12c[30 * 16] - b12c[31 * 16], b12c[31 * 16]};

        bf16x8 qf[4][2];
#pragma unroll
        for (int p = 0; p < 4; ++p) { const bf16* qp = Q0 + (size_t)(rowb + t0w + 2 * p + qsel) * 768 + habs * 64 + 8 * kq;
#pragma unroll
            for (int ks = 0; ks < 2; ++ks) { bf16x8 v = ldg16(qp + 32 * ks); if (!colv) v = (bf16x8){0, 0, 0, 0, 0, 0, 0, 0}; qf[p][ks] = v; } }
        float m[4], l[4]; f32x4 O[4][4];
        if (PROBE_REP == 6 || PROBE_REP == 7) {
            const bf16* ksb_ = KV0 + (size_t)rowb * 512 + 256 + g * 64; const bf16* vst_ = VT + ((size_t)(rowb >> 6) * 256 + g * 64) * 64;
#pragma unroll
            for (int p = 0; p < 4; ++p) { m[p] = -1e30f; l[p] = 0.f;
#pragma unroll
                for (int dt = 0; dt < 4; ++dt) O[p][dt] = (f32x4){0.f, 0.f, 0.f, 0.f}; }
            __syncthreads();
            nsa_sweep<MD_BLK, (PROBE_REP == 6 ? 2 : 1)>(STG, ksb_, vst_, 0, qt, qt, WMw, wave, lane, r, kq, qsel, t0w, qf, BC, m, l, O);
            float* dump = (float*)(ws + WS_OCS) + ((size_t)blockIdx.x * 512 + tid_) * 4;
#pragma unroll
            for (int p = 0; p < 4; ++p) dump[p] = l[p] + O[p][0][0] + O[p][1][1] + O[p][2][2] + O[p][3][3];
            __syncthreads(); }
        for (int i = lane; i < 1024; i += 64) PSw[i] = 0.f;
        const int ncmax = (t0w + 7 >= 31) ? ((t0w + 7 - 31) / 16 + 1) : 0;
        const bf16* kcb = KCB + (size_t)(bg * 512) * 64; const bf16* vct = VCT + (size_t)(bg * 64) * 512;
#pragma unroll
        for (int p = 0; p < 4; ++p) { m[p] = -1e30f; l[p] = 0.f; }
        if (ncmax > 0) {
            int r_ = r, kq_ = kq; asm volatile("" : "+v"(r_), "+v"(kq_));
            for (int key0 = 0; key0 < ncmax; key0 += 32) {
                asm volatile("" : "+v"(r_), "+v"(kq_));
                KF kA; load_k(kA, kcb, 64, key0, r_, kq_);
                const bool fast = (t0w - 31 - 16 * (key0 + 31)) >= 1513;
#pragma unroll
                for (int p = 0; p < 4; ++p) { f32x4 sa, sb; qk(sa, sb, kA, qf[p]); const int tcol = t0w + 2 * p + qsel;
                    mb2<MD_CMP>(sa, sb, key0 + 8 * kq_, tcol, true, fast, BC);
                    const float mn = fmaxf(m[p], lmax8(sa, sb)); float sum = 0.f;
#pragma unroll
                    for (int i = 0; i < 4; ++i) sum += __builtin_amdgcn_exp2f(sa[i] - mn) + __builtin_amdgcn_exp2f(sb[i] - mn);
                    l[p] = l[p] * __builtin_amdgcn_exp2f(m[p] - mn) + sum; m[p] = mn; __builtin_amdgcn_sched_barrier(0); }
            }
        }
        float invl[4];
#pragma unroll
        for (int p = 0; p < 4; ++p) { float mc = m[p]; mc = fmaxf(mc, __shfl_xor(mc, 16)); mc = fmaxf(mc, __shfl_xor(mc, 32));
            const float lt = kqsum(l[p] * __builtin_amdgcn_exp2f(m[p] - mc)); m[p] = mc; invl[p] = lt > 0.f ? 1.f / lt : 0.f; }
#pragma unroll
        for (int p = 0; p < 4; ++p)
#pragma unroll
            for (int dt = 0; dt < 4; ++dt) O[p][dt] = (f32x4){0.f, 0.f, 0.f, 0.f};
        float carry[4] = {0.f, 0.f, 0.f, 0.f};
        if (ncmax > 0) {
            int r_ = r, kq_ = kq; asm volatile("" : "+v"(r_), "+v"(kq_));
            for (int key0 = 0; key0 < ncmax; key0 += 32) {
                asm volatile("" : "+v"(r_), "+v"(kq_));
                KV1 A; load_kv(A, kcb, 64, vct, 512, key0, r_, kq_);
                const bool fast = (t0w - 31 - 16 * (key0 + 31)) >= 1513;
#pragma unroll
                for (int p = 0; p < 4; ++p) { f32x4 sa, sb; qk(sa, sb, A.k, qf[p]); const int tcol = t0w + 2 * p + qsel;
                    mb2<MD_CMP>(sa, sb, key0 + 8 * kq_, tcol, true, fast, BC);
                    f32x4 pa, pb;
#pragma unroll
                    for (int i = 0; i < 4; ++i) { pa[i] = __builtin_amdgcn_exp2f(sa[i] - m[p]) * invl[p]; pb[i] = __builtin_amdgcn_exp2f(sb[i] - m[p]) * invl[p]; }
                    pv(O[p], A.v, pack8(pa, pb));
                    float wA = (pa[0] + pa[1]) + (pa[2] + pa[3]), wB = pa[3] + ((pb[0] + pb[1]) + (pb[2] + pb[3])), wC = pb[3];
                    if (!colv) { wA = 0.f; wB = 0.f; wC = 0.f; }
                    const float up = __shfl(wC, (lane + 48) & 63);
                    const float prevC = (kq == 0) ? carry[p] : up; carry[p] = up;
                    float a0 = wA + prevC, a1 = wB;
                    a0 = sum8_dpp(a0); a1 = sum8_dpp(a1);
                    if (hd == 0) { LAS float* ps = PSw + (2 * p + qsel) * 128 + (key0 >> 2) + 2 * kq; ps[0] = a0; ps[1] = a1; } __builtin_amdgcn_sched_barrier(0); }
            }
        }
        if (ncmax > 0 && ncmax <= 480) {
            const int jn = ((ncmax + 31) >> 5) * 8;
#pragma unroll
            for (int p = 0; p < 4; ++p) { float a0 = sum8_dpp(carry[p]); if (hd == 0 && kq == 0) PSw[(2 * p + qsel) * 128 + jn] = a0; }
        }
        {
#pragma unroll
            for (int p = 0; p < 4; ++p) { const size_t row = (size_t)(rowb + t0w + 2 * p + qsel);
                const float gz = bf2f(G0[row * 256 + habs * 3 + 0]) + Ip->nsa_gate_b[habs * 3 + 0]; out_add(OUTw, p, n, kq, O[p], 1.f / (1.f + __expf(-gz)), true); }
        }
        for (int i = lane; i < 32; i += 64) WMw[i] = (qt < 16) ? 0xffffffffu : 0u;
        if (qt >= 16) {
            if (lane < 3) { const int j = lane == 0 ? 0 : qt - 2 + lane; atomicOr((unsigned*)&WMw[j >> 2], 0xffu << (8 * (j & 3))); }
            for (int q = 0; q < 8; ++q) {
                int v0 = __float_as_int(PSw[q * 128 + lane] + 0.f), v1 = __float_as_int(PSw[q * 128 + 64 + lane] + 0.f);
                if (lane < 1 || lane > qt - 2) v0 = __float_as_int(-1.f); if (lane + 64 > qt - 2) v1 = __float_as_int(-1.f);
                for (int s = 0; s < 13; ++s) { const int mx = wmax64_i(max(v0, v1));
                    const unsigned long long b0 = __ballot(v0 == mx); int j;
                    if (b0) { j = __builtin_ctzll(b0); if (lane == j) v0 = __float_as_int(-1.f); } else { const unsigned long long b1 = __ballot(v1 == mx); j = __builtin_ctzll(b1); if (lane == j) v1 = __float_as_int(-1.f); j += 64; }
                    if (lane == 0) atomicOr((unsigned*)&WMw[j >> 2], 1u << (8 * (j & 3) + q)); }
            }
        }
        const bf16* ksb = KV0 + (size_t)rowb * 512 + 256 + g * 64; const bf16* vst = VT + ((size_t)(rowb >> 6) * 256 + g * 64) * 64;
        __syncthreads();
#pragma unroll 1
        for (int rep_ = 0; rep_ < (PROBE_REP == 1 ? 2 : 1); ++rep_) {
#pragma unroll
            for (int p = 0; p < 4; ++p) { m[p] = -1e30f; l[p] = 0.f;
#pragma unroll
                for (int dt = 0; dt < 4; ++dt) O[p][dt] = (f32x4){0.f, 0.f, 0.f, 0.f}; }
            nsa_sweep<MD_BLK>(STG, ksb, vst, 0, qt, qt, WMw, wave, lane, r, kq, qsel, t0w, qf, BC, m, l, O);
        }
        { int qs2_ = qsel; asm volatile("" : "+v"(qs2_));
#pragma unroll
        for (int p = 0; p < 4; ++p) { const size_t row = (size_t)(rowb + t0w + 2 * p + qs2_);
            const float gz = bf2f(G0[row * 256 + habs * 3 + 1]) + Ip->nsa_gate_b[habs * 3 + 1]; out_add(OUTw, p, n, kq, O[p], (1.f / (1.f + __expf(-gz))) / kqsum(l[p]), false); } }
        const bf16* kwb = KV0 + (size_t)rowb * 512 + 384 + g * 64; const bf16* vwt = VT + ((size_t)(rowb >> 6) * 256 + 128 + g * 64) * 64;
#pragma unroll
        for (int p = 0; p < 4; ++p) { m[p] = -1e30f; l[p] = 0.f;
#pragma unroll
            for (int dt = 0; dt < 4; ++dt) O[p][dt] = (f32x4){0.f, 0.f, 0.f, 0.f}; }
        __syncthreads();
        nsa_sweep<MD_WIN>(STG, kwb, vwt, (qt >= 8) ? qt - 8 : 0, qt, qt, nullptr, wave, lane, r, kq, qsel, t0w, qf, BC, m, l, O);
        if (PROBE_REP == 4) {
#pragma unroll
            for (int p = 0; p < 4; ++p) { m[p] = -1e30f; l[p] = 0.f;
#pragma unroll
                for (int dt = 0; dt < 4; ++dt) O[p][dt] = (f32x4){0.f, 0.f, 0.f, 0.f}; }
            nsa_sweep<MD_WIN>(STG, kwb, vwt, (qt >= 8) ? qt - 8 : 0, qt, qt, nullptr, wave, lane, r, kq, qsel, t0w, qf, BC, m, l, O); }
        { int qs3_ = qsel; asm volatile("" : "+v"(qs3_));
#pragma unroll
        for (int p = 0; p < 4; ++p) { const size_t row = (size_t)(rowb + t0w + 2 * p + qs3_);
            const float gz = bf2f(G0[row * 256 + habs * 3 + 2]) + Ip->nsa_gate_b[habs * 3 + 2]; out_add(OUTw, p, n, kq, O[p], (1.f / (1.f + __expf(-gz))) / kqsum(l[p]), false); } }
        int ln_ = lane; asm volatile("" : "+v"(ln_));
#pragma unroll 1
        for (int i = 0; i < 6; ++i) { const int e = i * 64 + ln_, q = e / 48, c8 = e % 48;
            *(v4u*)(CAT + (size_t)(rowb + t0w + q) * 1024 + g * 384 + 8 * c8) = ((const LAS v4u*)OUTw)[e]; }
#pragma unroll 1
        for (int h2 = 0; h2 < 2; ++h2) { const int hm = 2 * g + h2;
            int ln2_ = lane; asm volatile("" : "+v"(ln2_)); const int nn = ln2_ & 15, kqq = ln2_ >> 4;
#pragma unroll
            for (int p = 0; p < 4; ++p) { qf[p][0] = (bf16x8){0, 0, 0, 0, 0, 0, 0, 0}; qf[p][1] = qf[p][0]; m[p] = -1e30f; l[p] = 0.f;
#pragma unroll
                for (int dt = 0; dt < 4; ++dt) O[p][dt] = (f32x4){0.f, 0.f, 0.f, 0.f}; }
            { const bf16* qp = QM + (size_t)(rowb + t0w + (nn & 7)) * 256 + hm * 64 + 8 * kqq; if (nn < 8) { qf[0][0] = ldg16(qp); qf[0][1] = ldg16(qp + 32); } }
            const BiasCtx BCm{BC.tb, 0.f, 0.f, 0.f};
            nsa_sweep<MD_MEM>(STG, MKB + (size_t)(b * 256) * 256 + hm * 64, MVT + (size_t)(hm * 64) * 512 + b * 256, 0, 3, 0, nullptr, wave, ln2_, nn, kqq, nn >> 3, 0, qf, BCm, m, l, O, 256, 64 * 256, 512, 64);
            const float il = 1.f / kqsum(l[0]);
            if (nn < 8) { bf16* op = CAT + (size_t)(rowb + t0w + nn) * 1024 + 768 + hm * 64 + 4 * kqq;
#pragma unroll
                for (int dt = 0; dt < 4; ++dt) *(uint2*)(op + 16 * dt) = make_uint2(pk2(O[0][dt][0] * il, O[0][dt][1] * il), pk2(O[0][dt][2] * il, O[0][dt][3] * il)); }
        }
    }
}

__device__ __forceinline__ void p10_dsa_norm(Frame& F, const In& I, unsigned char* ws) {
    OPAQUE_TID(); KARGS(); const int gw = F.vcu * NWAVES + (tid_ >> 6), NGW = F.G * NWAVES, lane = tid_ & 63;
    const bf16* PR = (const bf16*)(ws + WS_PROJ1); bf16* CQ = (bf16*)(ws + WS_CQ); bf16* CKV = (bf16*)(ws + WS_CKV); bf16* KIDX = (bf16*)(ws + WS_KIDX); float* WIDX = (float*)(ws + WS_WIDX);
    for (int m = gw; m < M; m += NGW) {
        const bf16* pr = PR + (size_t)m * 768;
        float a[4]; ld4bf(pr + 4 * lane, a);
        float s = wave_sum(a[0] * a[0] + a[1] * a[1] + a[2] * a[2] + a[3] * a[3]); float r = rsqrtf(s * (1.f / 256.f) + EPSF);
        const float4 gq = *(const float4*)(Ip->q_norm + 4 * lane);
        *(uint2*)(CQ + (size_t)m * 256 + 4 * lane) = make_uint2(pk2((a[0] * r) * gq.x, (a[1] * r) * gq.y), pk2((a[2] * r) * gq.z, (a[3] * r) * gq.w));
        const unsigned u = *(const unsigned*)(pr + 256 + 2 * lane); const float c0 = bflo(u), c1 = bfhi(u);
        s = wave_sum(c0 * c0 + c1 * c1); r = rsqrtf(s * (1.f / 128.f) + EPSF);
        *(unsigned*)(CKV + (size_t)m * 128 + 2 * lane) = pk2((c0 * r) * Ip->kv_norm[2 * lane], (c1 * r) * Ip->kv_norm[2 * lane + 1]);
        const float k0 = bf2f(pr[384 + lane]);
        s = wave_sum(k0 * k0); r = rsqrtf(s * (1.f / 64.f) + EPSF);
        { const int tk = m >> 5, key = m & 31, ks = lane >> 4, hf = (lane >> 3) & 1, jj = lane & 7;
          KIDX[((size_t)(tk * 4 + ks) * 64 + hf * 32 + key) * 8 + jj] = (bf16)f2bf((k0 * r) * Ip->kidx_norm[lane]); }
        if (lane < 8) WIDX[(size_t)m * 8 + lane] = bf2f(pr[448 + lane]) * (0.35355339059327373f * 0.125f);
    }
}

#define MFMA32(A, B, C) __builtin_amdgcn_mfma_f32_32x32x16_bf16((A), (B), (C), 0, 0, 0)
typedef float f32x16 __attribute__((ext_vector_type(16)));
constexpr int XL_OFF = RING_BYTES;
constexpr int IDX_HIST = XL_OFF, IDX_CAND = XL_OFF + 16384, IDX_MM = XL_OFF + 24576, IDX_STQ = IDX_MM + 256, IDX_MM2 = IDX_STQ + 256, IDX_SELL = XL_OFF + 25600  , IDX_CAP = 1024;
static_assert(IDX_MM2 + 64 <= IDX_SELL && IDX_SELL + 2048 <= LDSCTL_OFF, "LDS map (indexer)");
__device__ __forceinline__ float wmin64(float v) {
#pragma unroll
    for (int o = 1; o < 64; o <<= 1) v = fminf(v, __shfl_xor(v, o));
    return v;
}
__device__ __forceinline__ float vmaxf_(float a, float b) { float d; asm("v_max_f32 %0, %1, %2" : "=v"(d) : "v"(a), "v"(b)); return d; }
__device__ __forceinline__ float vminf_(float a, float b) { float d; asm("v_min_f32 %0, %1, %2" : "=v"(d) : "v"(a), "v"(b)); return d; }
__device__ __forceinline__ void p12_index_mfma(Frame& F, const In& I, unsigned char* ws) {
    OPAQUE_TID(); KARGS(); const int lane = tid_ & 63, wave = __builtin_amdgcn_readfirstlane(tid_ >> 6), key = lane & 31, half = lane >> 5;
    LAS float* SC = (LAS float*)(F.lds + RING_OFF);
    LAS float* MMw = (LAS float*)(F.lds + IDX_MM);
    const bf16* QI = (const bf16*)(ws + WS_QI); const bf16* KIDX = (const bf16*)(ws + WS_KIDX); const float* WIDX = (const float*)(ws + WS_WIDX);
    unsigned short* SEL = (unsigned short*)(ws + WS_SEL); int* CNT = (int*)(ws + WS_CNT);
    const int NG = M / 4, per = (NG + F.G - 1) / F.G;
    for (int j = 0; j < per; ++j) {
        const int u = j * F.G + ((j & 1) ? (F.G - 1 - (int)blockIdx.x) : (int)blockIdx.x);
        if (u >= NG) break;
        const int gi = (u & 1) * (NG / 2) + (u >> 1);
        const int row0 = 4 * gi, b = row0 / T, t0 = row0 % T, rowb = b * T;
        if (t0 < 256) {
            if (wave < 4) { const int t = t0 + wave; unsigned short* so = SEL + (size_t)(row0 + wave) * 256;
#pragma unroll
                for (int i = 0; i < 4; ++i) { const int s = lane + 64 * i; so[s] = (unsigned short)(s <= t ? s : 0); }
                if (lane == 0) CNT[row0 + wave] = t + 1; }
            continue;
        }
        {
            const int rho = lane & 31, a = rho >> 2, qA = ((a >> 2) & 1) + 2 * (a & 1), hdA = 4 * ((a >> 1) & 1) + (rho & 3);
            bf16x8 qa[4];
#pragma unroll
            for (int ks = 0; ks < 4; ++ks) qa[ks] = ldg16(QI + (size_t)(row0 + qA) * 512 + hdA * 64 + 16 * ks + 8 * half);
            float w0[8], w1[8];
            { const float4 x0 = *(const float4*)(WIDX + (size_t)(row0 + 2 * half) * 8), x1 = *(const float4*)(WIDX + (size_t)(row0 + 2 * half) * 8 + 4);
              const float4 y0 = *(const float4*)(WIDX + (size_t)(row0 + 2 * half + 1) * 8), y1 = *(const float4*)(WIDX + (size_t)(row0 + 2 * half + 1) * 8 + 4);
              w0[0] = x0.x; w0[1] = x0.y; w0[2] = x0.z; w0[3] = x0.w; w0[4] = x1.x; w0[5] = x1.y; w0[6] = x1.z; w0[7] = x1.w;
              w1[0] = y0.x; w1[1] = y0.y; w1[2] = y0.z; w1[3] = y0.w; w1[4] = y1.x; w1[5] = y1.y; w1[6] = y1.z; w1[7] = y1.w; }
            f32x2_t w0p[4], w1p[4];
#pragma unroll
            for (int h = 0; h < 4; ++h) { w0p[h] = (f32x2_t){w0[2 * h], w0[2 * h + 1]}; w1p[h] = (f32x2_t){w1[2 * h], w1[2 * h + 1]}; }
            const int tq0 = t0 + 2 * half, tq1 = tq0 + 1, nt = (t0 + 3) / 32 + 1;
            float mn0 = INFINITY, mx0 = -INFINITY, mn1 = INFINITY, mx1 = -INFINITY;
            const bf16* kpb = KIDX + (size_t)(rowb >> 5) * 2048 + (size_t)lane * 8;
            const int ntw = (nt - wave + NWAVES - 1) / NWAVES;
#define IDX_LOAD(dst, i) do { const int tl2_ = wave + NWAVES * ((i) < ntw ? (i) : (ntw > 0 ? ntw - 1 : 0)); const bf16* kp_ = kpb + (size_t)tl2_ * 2048; \
                _Pragma("unroll") for (int ks = 0; ks < 4; ++ks) dst[ks] = ldg16(kp_ + 512 * ks); } while (0)
#define IDX_COMP(src, i) do { if ((i) < ntw) { const int kpos = 32 * (wave + NWAVES * (i)) + key; \
                f32x16 c = {0.f, 0.f, 0.f, 0.f, 0.f, 0.f, 0.f, 0.f, 0.f, 0.f, 0.f, 0.f, 0.f, 0.f, 0.f, 0.f}; \
                _Pragma("unroll") for (int ks = 0; ks < 4; ++ks) c = MFMA32(qa[ks], src[ks], c); \
                f32x2_t a0 = {0.f, 0.f}, a1 = {0.f, 0.f};                   \
                _Pragma("unroll") for (int h = 0; h < 4; ++h) { \
                    const f32x2_t r0 = {__int_as_float(max(__float_as_int(c[2 * h]), 0)), __int_as_float(max(__float_as_int(c[2 * h + 1]), 0))}; \
                    const f32x2_t r1 = {__int_as_float(max(__float_as_int(c[8 + 2 * h]), 0)), __int_as_float(max(__float_as_int(c[9 + 2 * h]), 0))}; \
                    a0 = __builtin_elementwise_fma(r0, w0p[h], a0); a1 = __builtin_elementwise_fma(r1, w1p[h], a1); } \
                float s0 = (a0[0] + a0[1]) + 0.f, s1 = (a1[0] + a1[1]) + 0.f; \
                const bool ok0 = kpos <= tq0, ok1 = kpos <= tq1; \
                const float v0_ = ok0 ? s0 : -INFINITY, v1_ = ok1 ? s1 : -INFINITY; \
                SC[(2 * half) * 8192 + kpos] = v0_; SC[(2 * half + 1) * 8192 + kpos] = v1_; \
                mx0 = vmaxf_(mx0, v0_); mx1 = vmaxf_(mx1, v1_); mn0 = vminf_(mn0, ok0 ? s0 : INFINITY); mn1 = vminf_(mn1, ok1 ? s1 : INFINITY); } } while (0)
            for (int prb_ = 0; prb_ < (PROBE_REP == 2 ? 2 : 1); ++prb_)
            if (ntw > 0) {
                bf16x8 kb0[4], kb1[4], kb2[4], kb3[4];
                IDX_LOAD(kb0, 0); IDX_LOAD(kb1, 1); IDX_LOAD(kb2, 2);
                for (int i = 0; i < ntw; i += 4) {
                    IDX_LOAD(kb3, i + 3); IDX_COMP(kb0, i);
                    IDX_LOAD(kb0, i + 4); IDX_COMP(kb1, i + 1);
                    IDX_LOAD(kb1, i + 5); IDX_COMP(kb2, i + 2);
                    IDX_LOAD(kb2, i + 6); IDX_COMP(kb3, i + 3);
                }
            }
#undef IDX_LOAD
#undef IDX_COMP
#pragma unroll
            for (int o = 1; o < 32; o <<= 1) { mn0 = fminf(mn0, __shfl_xor(mn0, o)); mx0 = fmaxf(mx0, __shfl_xor(mx0, o)); mn1 = fminf(mn1, __shfl_xor(mn1, o)); mx1 = fmaxf(mx1, __shfl_xor(mx1, o)); }
            if (key == 0) { LAS float* mm = MMw + (wave * 4 + 2 * half) * 2; mm[0] = mn0; mm[1] = mx0; mm[2] = mn1; mm[3] = mx1; }
        }
        __syncthreads();
        {
            const int q = wave >> 1, hw = wave & 1, t = t0 + q, n = t + 1; const LAS float* sc = SC + q * 8192;
            LAS unsigned* hist = (LAS unsigned*)(F.lds + IDX_HIST) + wave * 512; const LAS unsigned* hist0 = (const LAS unsigned*)(F.lds + IDX_HIST) + (2 * q) * 512;
            LAS unsigned short* cand = (LAS unsigned short*)(F.lds + IDX_CAND) + q * IDX_CAP;
            LAS float* stf = (LAS float*)(F.lds + IDX_STQ) + q * 16; LAS int* sti = (LAS int*)stf;
            LAS float* mm2 = (LAS float*)(F.lds + IDX_MM2) + wave * 2;
            unsigned short* so = SEL + (size_t)(row0 + q) * 256;
            LAS unsigned short* sl = (LAS unsigned short*)(F.lds + IDX_SELL) + q * 256;
            const int nch = (n + 255) >> 8;
            float lo0 = INFINITY, hi0 = -INFINITY;
#pragma unroll
            for (int w = 0; w < 8; ++w) { lo0 = fminf(lo0, MMw[(w * 4 + q) * 2]); hi0 = fmaxf(hi0, MMw[(w * 4 + q) * 2 + 1]); }
            if (hw == 0 && lane == 0) { stf[0] = lo0; stf[1] = hi0; sti[2] = 256; sti[3] = 0; sti[4] = 0; sti[5] = 0; sti[6] = 0; sti[7] = 0; sti[8] = 0; sti[9] = 0; }
            for (int round = 0; round < 64; ++round) {
                const float lo = round ? stf[0] : lo0, hi = round ? stf[1] : hi0; const bool act = round ? (sti[8] == 0) : true; const bool eqr = !(hi > lo); const float scale = eqr ? 0.f : 1024.f / (hi - lo);
                int hreps_ = (PROBE_REP == 10) ? 2 : 1; asm volatile("" : "+s"(hreps_));
                if (act && !eqr) for (int hr_ = 0; hr_ < hreps_; ++hr_) {
#pragma unroll
                    for (int i = 0; i < 8; ++i) hist[lane + 64 * i] = 0u;
                    f32x4 nx4 = *(const LAS f32x4*)(sc + 256 * hw + 4 * lane);
                    for (int c = hw; c < nch; c += 2) { const int i4 = 256 * c + 4 * lane; const f32x4 v4 = nx4; nx4 = *(const LAS f32x4*)(sc + i4 + 512);
#pragma unroll
                        for (int e = 0; e < 4; ++e) { const float v = (i4 + e < n) ? v4[e] : -INFINITY;
                            if (v >= lo && v <= hi) { int bb = (int)((v - lo) * scale); bb = bb > 1023 ? 1023 : bb; atomicAdd((unsigned*)&hist[bb >> 1], 1u << (16 * (bb & 1))); } } }
                }
                __syncthreads();
                if (hw == 0 && act) {
                    if (eqr) { if (lane == 0) { sti[8] = 1; sti[9] = 1; } }
                    else {
                        const int krem = sti[2];
                        unsigned cw[8], c0w[8]; unsigned S = 0u, S0 = 0u;
#pragma unroll
                        for (int i = 0; i < 8; ++i) { c0w[i] = hist0[8 * lane + i]; cw[i] = c0w[i] + hist0[512 + 8 * lane + i]; S += (cw[i] & 0xffffu) + (cw[i] >> 16); S0 += (c0w[i] & 0xffffu) + (c0w[i] >> 16); }
                        const unsigned px = wave_iscan_u32(S), px0 = wave_iscan_u32(S0);
                        const unsigned above = (unsigned)__builtin_amdgcn_readlane((int)px, 63) - px; unsigned acc0 = (unsigned)__builtin_amdgcn_readlane((int)px0, 63) - px0;
                        const bool found = (above < (unsigned)krem) && ((unsigned)krem <= above + S);
                        const int fl = __builtin_ctzll(__ballot(found));
                        int bs = 0; unsigned acc = above, cb = 0u, cb0 = 0u;
                        { bool done = false;
#pragma unroll
                          for (int i = 15; i >= 0; --i) { const unsigned cnt_ = (i & 1) ? (cw[i >> 1] >> 16) : (cw[i >> 1] & 0xffffu), cnt0_ = (i & 1) ? (c0w[i >> 1] >> 16) : (c0w[i >> 1] & 0xffffu);
                              if (!done) { if (acc + cnt_ >= (unsigned)krem) { bs = 16 * lane + i; cb = cnt_; cb0 = cnt0_; done = true; } else { acc += cnt_; acc0 += cnt0_; } } } }
                        if (lane == fl) { sti[2] = krem - (int)acc; sti[3] += (int)acc0; sti[4] += (int)acc; sti[5] = bs; sti[6] = (int)cb0; sti[7] = (int)cb; sti[8] = ((int)cb <= IDX_CAP) ? 1 : 0; }
                    }
                }
                __syncthreads();
                const LAS int* stall = (const LAS int*)(F.lds + IDX_STQ);
                if (stall[8] && stall[16 + 8] && stall[32 + 8] && stall[48 + 8]) break;
                float nlo = INFINITY, nhi = -INFINITY;
                if (sti[8] == 0) { const int bstar = sti[5];
                    for (int c = hw; c < nch; c += 2) { const int i4 = 256 * c + 4 * lane; const f32x4 v4 = *(const LAS f32x4*)(sc + i4);
#pragma unroll
                        for (int e = 0; e < 4; ++e) { const float v = (i4 + e < n) ? v4[e] : -INFINITY;
                            if (v >= lo && v <= hi) { int bb = (int)((v - lo) * scale); bb = bb > 1023 ? 1023 : bb; if (bb == bstar) { nlo = fminf(nlo, v); nhi = fmaxf(nhi, v); } } } } }
                nlo = wmin64(nlo); nhi = wmax64(nhi);
                if (lane == 0) { mm2[0] = nlo; mm2[1] = nhi; }
                __syncthreads();
                if (hw == 0 && lane == 0 && sti[8] == 0) { stf[0] = fminf(mm2[0], mm2[2]); stf[1] = fmaxf(mm2[1], mm2[3]); }
                __syncthreads();
            }
            { const float lo = stf[0], hi = stf[1]; const bool eq = sti[9] != 0; const float scale = eq ? 0.f : 1024.f / (hi - lo);
              const int krem = sti[2], A0 = sti[3], AT = sti[4], bstar = sti[5], C0 = sti[6], ncand = sti[7], nabove = 256 - krem;
              int creps_ = (PROBE_REP == 11) ? 2 : 1; asm volatile("" : "+s"(creps_));
              for (int cr_ = 0; cr_ < creps_; ++cr_) {
              int bsel = hw ? A0 : 0, bcand = hw ? C0 : 0; (void)AT;
              if (eq) {
                  if (!hw) for (int c = 0; c < nch; ++c) { const int i4 = 256 * c + 4 * lane; const f32x4 v4 = *(const LAS f32x4*)(sc + i4);
#pragma unroll
                      for (int e = 0; e < 4; ++e) { const int idx = i4 + e; const float v = (idx < n) ? v4[e] : -INFINITY;
                          const bool sel = v > hi, cnd = (v == hi);
                          const unsigned long long ms = __ballot(sel), mc = __ballot(cnd), lt = (1ull << lane) - 1ull;
                          if (sel) sl[bsel + __builtin_popcountll(ms & lt)] = (unsigned short)idx;
                          if (cnd) { const int pc = bcand + __builtin_popcountll(mc & lt); if (pc < krem) sl[nabove + pc] = (unsigned short)idx; }
                          bsel += __builtin_popcountll(ms); bcand += __builtin_popcountll(mc); } }
              } else {
                  auto binf = [&](float v) { int bb = (int)((v - lo) * scale); return bb > 1023 ? 1023 : bb; };
                  auto fkey = [](float x) { const int b_ = __float_as_int(x); return b_ ^ ((b_ >> 31) & 0x7fffffff); };
                  auto kflt = [](int k) { return __int_as_float(k ^ ((k >> 31) & 0x7fffffff)); };
                  const int klo = fkey(lo), khi = fkey(hi);
                  auto first_ge = [&](int target) {
                      float est = lo + (float)target * ((hi - lo) * (1.f / 1024.f)); est = est < lo ? lo : (est > hi ? hi : est);
                      int a = klo, b = khi;
                      { const int ke = fkey(est); const int ka = (ke - 64 > klo) ? ke - 64 : klo, kb = (ke + 64 < khi) ? ke + 64 : khi;
                        if (binf(kflt(ka)) < target) a = ka; if (binf(kflt(kb)) >= target) b = kb; }
                      while ((unsigned)b - (unsigned)a > 1u) { const int mid = a + (int)(((unsigned)b - (unsigned)a) >> 1); if (binf(kflt(mid)) >= target) b = mid; else a = mid; }
                      return kflt(b); };
                  const float T0 = (bstar <= 0) ? lo : first_ge(bstar);
                  const float T1 = (bstar >= 1023 || binf(hi) <= bstar) ? kflt(khi + 1) : first_ge(bstar + 1);
                  f32x4 nx4 = *(const LAS f32x4*)(sc + 256 * hw + 4 * lane);
                  for (int c = hw; c < nch; c += 2) { const int i4 = 256 * c + 4 * lane; const f32x4 v4 = nx4; nx4 = *(const LAS f32x4*)(sc + i4 + 512);
                      const bool full = 256 * c + 256 <= n;
#pragma unroll
                      for (int e = 0; e < 4; ++e) { const int idx = i4 + e; const float v = (full || idx < n) ? v4[e] : -INFINITY;
                          const bool sel = v >= T1, cnd = (v >= T0) && !sel;
                          const unsigned long long ms = __ballot(sel), mc = __ballot(cnd);
                          if (ms) { if (sel) sl[bsel + (int)__builtin_amdgcn_mbcnt_hi((unsigned)(ms >> 32), __builtin_amdgcn_mbcnt_lo((unsigned)ms, 0u))] = (unsigned short)idx; bsel += __builtin_popcountll(ms); }
                          if (mc) { if (cnd) { const int pc = bcand + (int)__builtin_amdgcn_mbcnt_hi((unsigned)(mc >> 32), __builtin_amdgcn_mbcnt_lo((unsigned)mc, 0u)); if (pc < IDX_CAP) cand[pc] = (unsigned short)idx; } bcand += __builtin_popcountll(mc); } } }
              }
              }
              __syncthreads();
              if (!eq) {
                  for (int i = 64 * hw + lane; i < ncand; i += 128) { const int ii = cand[i]; const float vi = sc[ii]; int rank = 0;
                      for (int jj = 0; jj < ncand; ++jj) { const int ij = cand[jj]; const float vj = sc[ij]; rank += ((vj > vi) || (vj == vi && ij < ii)) ? 1 : 0; }
                      if (rank < krem) sl[nabove + rank] = (unsigned short)ii; }
              }
              if (hw == 0 && lane == 0) CNT[row0 + q] = 256; }
        }
        __syncthreads();
        if ((wave & 1) == 0) { const int q = wave >> 1; *(v2u*)(SEL + (size_t)(row0 + q) * 256 + 4 * lane) = *(const LAS v2u*)((LAS unsigned short*)(F.lds + IDX_SELL) + q * 256 + 4 * lane); }
    }
}

__device__ __forceinline__ unsigned offb(unsigned row, unsigned ch) { return 256u * row + 16u * (ch ^ (((row & 3u) << 2) | ((row >> 2) & 3u))); }
typedef short v4i16_t __attribute__((ext_vector_type(4)));
__device__ __forceinline__ v4i16_t trrd(const LAS unsigned char* p) { return __builtin_amdgcn_ds_read_tr16_b64_v4i16((LAS v4i16_t*)p); }
__device__ __forceinline__ void p13_dsa_mfma(Frame& F, const In& I, unsigned char* ws) {
    OPAQUE_TID(); KARGS(); const int lane = tid_ & 63, wave = __builtin_amdgcn_readfirstlane(tid_ >> 6), n = lane & 15, kq = lane >> 4;
    LAS unsigned char* bkt = F.lds + TAB_BKT; LAS float* b12 = (LAS float*)(F.lds + P13_B12);
    for (int i = tid_; i < 1536; i += NWAVES * 64) bkt[i] = (unsigned char)rel_bucket(i);
    for (int i = tid_; i < 528; i += NWAVES * 64) b12[i] = (i >= 512) ? -INFINITY : (((i & 15) < 12) ? Ip->rel_bias[(i >> 4) * 12 + (i & 15)] * LOG2E : 0.f);
    __syncthreads();
    LAS unsigned char* imgb = F.lds + RING_OFF + wave * 18432; LAS int* sidx = (LAS int*)(imgb + 16384);
    const bf16* QA = (const bf16*)(ws + WS_QA); const bf16* CKV = (const bf16*)(ws + WS_CKV); const bf16* PR = (const bf16*)(ws + WS_PROJ1);
    const unsigned short* SEL = (const unsigned short*)(ws + WS_SEL); const int* CNT = (const int*)(ws + WS_CNT);
    const bf16* MKB = (const bf16*)(ws + WS_MKB) + (size_t)512 * 256; const bf16* MVT = (const bf16*)(ws + WS_MVT) + (size_t)256 * 512;
    bf16* CAT1 = (bf16*)(ws + WS_CAT1);
    const int gw = blockIdx.x * NWAVES + wave, NGW = F.G * NWAVES;
    const LAS float* b12c = b12 + (n < 12 ? n : 0);
#define DSA_GATHER(sl_, rowb_, c0_, buf_) do { const unsigned char* ckvb_ = (const unsigned char*)(CKV + (size_t)(rowb_) * 128); int kx_[8]; \
            _Pragma("unroll") for (int i = 0; i < 8; ++i) kx_[i] = (sl_)[(c0_) + 4 * i + g4_] & 0xffff; \
            _Pragma("unroll") for (int i = 0; i < 8; ++i) __builtin_amdgcn_global_load_lds((const unsigned*)(ckvb_ + ((unsigned)kx_[i] * 256u + goff_[i & 3])), (LAS unsigned*)(imgb + (buf_) * 8192 + i * 1024), 16, 0, 0); } while (0)
#define DSA_LIST(sl_, sel_, t_, cnt_) do { const int idx0_ = __builtin_amdgcn_readfirstlane((sel_)[0]); \
            _Pragma("unroll") for (int i = 0; i < 4; ++i) { const int e = lane + 64 * i, idx = (sel_)[i]; const int d = (t_) - idx, dc = d > 1535 ? 1535 : (d < 0 ? 0 : d); \
                (sl_)[e] = (e < (cnt_)) ? (idx | ((int)bkt[dc] << 22)) : (idx0_ | (2048 << 16)); } } while (0)
    int dreps_ = (PROBE_REP == 9) ? 2 : 1; asm volatile("" : "+s"(dreps_));
    for (int dr_ = 0; dr_ < dreps_; ++dr_) {
    asm volatile("s_waitcnt vmcnt(0) lgkmcnt(0)" ::: "memory");
    int row = gw;
    if (row < M) {
        int ln0_ = lane; asm volatile("" : "+v"(ln0_));
        const int g4_ = ln0_ >> 4; unsigned goff_[4];
#pragma unroll
        for (int k = 0; k < 4; ++k) goff_[k] = 16u * ((unsigned)(ln0_ & 15) ^ (((unsigned)g4_ << 2) | (unsigned)k));
        int cnt = __builtin_amdgcn_readfirstlane(CNT[row]); int sel0[4];
#pragma unroll
        for (int i = 0; i < 4; ++i) sel0[i] = (int)SEL[(size_t)row * 256 + lane + 64 * i];
        DSA_LIST(sidx, sel0, row % T, cnt);
        bf16x8 qf[4];
#pragma unroll
        for (int ks = 0; ks < 4; ++ks) { bf16x8 v = ldg16(QA + (size_t)row * 1536 + (n < 12 ? n : 0) * 128 + 32 * ks + 8 * kq); if (n >= 12) v = (bf16x8){0, 0, 0, 0, 0, 0, 0, 0}; qf[ks] = v; }
        asm volatile("s_waitcnt lgkmcnt(0)" ::: "memory");
        DSA_GATHER(sidx, (row / T) * T, 0, 0);
        int lb = 0, ib = 0;
        for (; row < M; row += NGW) {
            const int t = row % T, rown = (row + NGW < M) ? row + NGW : row; const bool hasn = row + NGW < M;
            int ln_ = lane; asm volatile("" : "+v"(ln_));
            int seln[4] = {0, 0, 0, 0}; int cntn_v = 0; bf16x8 qfn[4];
#pragma unroll
            for (int ks = 0; ks < 4; ++ks) qfn[ks] = (bf16x8){0, 0, 0, 0, 0, 0, 0, 0};
#define DSA_NEXT_LOADS() do { cntn_v = CNT[rown]; \
                _Pragma("unroll") for (int i = 0; i < 4; ++i) seln[i] = (int)SEL[(size_t)rown * 256 + lane + 64 * i]; \
                _Pragma("unroll") for (int ks = 0; ks < 4; ++ks) { bf16x8 v = ldg16(QA + (size_t)rown * 1536 + (n < 12 ? n : 0) * 128 + 32 * ks + 8 * kq); if (n >= 12) v = (bf16x8){0, 0, 0, 0, 0, 0, 0, 0}; qfn[ks] = v; } } while (0)
            const LAS int* sl = sidx + lb * 256; LAS int* sln = sidx + (lb ^ 1) * 256;
            float m = -1e30f, l = 0.f; f32x4 O[8];
#pragma unroll
            for (int rt = 0; rt < 8; ++rt) O[rt] = (f32x4){0.f, 0.f, 0.f, 0.f};
            for (int c0 = 0; c0 < cnt; c0 += 32) {
                LAS unsigned char* img = imgb + ib * 8192;
                if (c0 + 32 < cnt) { DSA_GATHER(sl, (row / T) * T, c0 + 32, ib ^ 1);
                    { const int e2 = (c0 + 64 < 256 ? c0 + 64 : 224) + (ln_ >> 1); const int k2 = sl[e2] & 0xffff;
                      __builtin_amdgcn_global_load_lds((const unsigned*)((const unsigned char*)(CKV + (size_t)((row / T) * T) * 128) + ((unsigned)k2 * 256u + 128u * (unsigned)(ln_ & 1))), (LAS unsigned*)(F.lds + P13_JUNK + wave * 256), 4, 0, 0); }
                    if (c0 == 0) { DSA_NEXT_LOADS(); }
                    if (c0 < 64) asm volatile("s_waitcnt vmcnt(18)" ::: "memory"); else asm volatile("s_waitcnt vmcnt(9)" ::: "memory"); }
                else if (hasn) {
                    if (c0 == 0) { DSA_NEXT_LOADS(); }
                    const int cntn = __builtin_amdgcn_readfirstlane(cntn_v);
                    DSA_LIST(sln, seln, rown % T, cntn);
                    asm volatile("s_waitcnt lgkmcnt(0)" ::: "memory");
                    DSA_GATHER(sln, (rown / T) * T, 0, ib ^ 1); asm volatile("s_waitcnt vmcnt(8)" ::: "memory"); }
                else asm volatile("s_waitcnt vmcnt(0)" ::: "memory");
                const bool has = m > -1e29f; const float mref = has ? m : 0.f; const float cinv = -mref;
                f32x4 sa = {cinv, cinv, cinv, cinv}, sb = sa;
                { const unsigned ra = 8u * ((unsigned)(ln_ & 15) >> 2) + ((unsigned)ln_ & 3u), kq_ = (unsigned)ln_ >> 4;
#pragma unroll
                  for (int s = 0; s < 4; ++s) { const bf16x8 ka = *(const LAS bf16x8*)(img + offb(ra, 4 * s + kq_)); const bf16x8 kb = *(const LAS bf16x8*)(img + offb(ra + 4, 4 * s + kq_));
                      sa = MFMA16(ka, qf[s], sa); sb = MFMA16(kb, qf[s], sb); } }
#pragma unroll
                for (int i = 0; i < 4; ++i) { const int ea = c0 + 8 * kq + i;
                    sa[i] += *(const LAS float*)((const LAS unsigned char*)b12c + ((unsigned)sl[ea] >> 16)); sb[i] += *(const LAS float*)((const LAS unsigned char*)b12c + ((unsigned)sl[ea + 4] >> 16)); }
                float fsc = 1.f;
                if (__any((imax3(imax3(__float_as_int(sa[0]), __float_as_int(sa[1]), __float_as_int(sa[2])), imax3(__float_as_int(sa[3]), __float_as_int(sb[0]), __float_as_int(sb[1])), max(__float_as_int(sb[2]), __float_as_int(sb[3]))) > __float_as_int(SM_THR)) || !has)) {
                    float lm = lmax8(sa, sb);
                    lm = fmaxf(lm, __shfl_xor(lm, 16)); lm = fmaxf(lm, __shfl_xor(lm, 32));
                    const bool upd = (lm > -INFINITY) && (!has || lm > 0.f); const float dl = upd ? lm : 0.f;
                    if (upd) m = mref + dl;
                    fsc = has ? __builtin_amdgcn_exp2f(-dl) : 1.f; l *= fsc;
#pragma unroll
                    for (int i = 0; i < 4; ++i) { sa[i] -= dl; sb[i] -= dl; }
#pragma unroll
                    for (int rt = 0; rt < 8; ++rt) O[rt] = O[rt] * fsc;
                }
                f32x4 pa, pb; float sum = 0.f;
#pragma unroll
                for (int i = 0; i < 4; ++i) { pa[i] = __builtin_amdgcn_exp2f(sa[i]); pb[i] = __builtin_amdgcn_exp2f(sb[i]); sum += pa[i] + pb[i]; }
                l += sum;
                const bf16x8 pf = pack8(pa, pb);
                { const unsigned g_ = (unsigned)ln_ >> 4, q_ = ((unsigned)ln_ & 15u) >> 2, p_ = (unsigned)ln_ & 3u;
#pragma unroll
                  for (int rt = 0; rt < 8; ++rt) { const v4i16_t x0 = trrd(img + offb(8 * g_ + q_, 2 * rt + (p_ >> 1)) + 8 * (p_ & 1)), x1 = trrd(img + offb(8 * g_ + 4 + q_, 2 * rt + (p_ >> 1)) + 8 * (p_ & 1));
                      const bf16x8 vf = {x0[0], x0[1], x0[2], x0[3], x1[0], x1[1], x1[2], x1[3]};
                      O[rt] = MFMA16(vf, pf, O[rt]); } }
                ib ^= 1;
            }
            const float il = 1.f / kqsum(l);
            if (n < 12) { bf16* op = CAT1 + (size_t)row * 1792 + n * 128 + 4 * kq;
#pragma unroll
                for (int rt = 0; rt < 8; ++rt) *(uint2*)(op + 16 * rt) = make_uint2(pk2(O[rt][0] * il, O[rt][1] * il), pk2(O[rt][2] * il, O[rt][3] * il)); }
            lb ^= 1; cnt = __builtin_amdgcn_readfirstlane(cntn_v);
#pragma unroll
            for (int ks = 0; ks < 4; ++ks) qf[ks] = qfn[ks];
        }
    }
    }
#undef DSA_GATHER
#undef DSA_LIST
#undef DSA_NEXT_LOADS
    int mreps_ = (PROBE_REP == 8) ? 2 : 1; asm volatile("" : "+s"(mreps_));
    __syncthreads();
    for (int mr_ = 0; mr_ < mreps_; ++mr_)
    for (int u64 = blockIdx.x; u64 < M / 64; u64 += F.G) {
        int tl_ = tid_; asm volatile("" : "+v"(tl_));
        const int ln = tl_ & 63, nn = ln & 15, kqq = ln >> 4, qsl = nn >> 3;
        const int row0 = 64 * u64 + 8 * wave, b = row0 / T;
        const BiasCtx BC0{(const LAS unsigned short*)(F.lds + NSA_TB), 0.f, 0.f, 0.f};
#pragma unroll 1
        for (int hm = 0; hm < 4; ++hm) {
            bf16x8 qf[4][2];
#pragma unroll
            for (int p = 0; p < 4; ++p) { qf[p][0] = (bf16x8){0, 0, 0, 0, 0, 0, 0, 0}; qf[p][1] = qf[p][0]; }
            { const bf16* qp = PR + (size_t)(row0 + (nn & 7)) * 768 + 456 + hm * 64 + 8 * kqq; if (nn < 8) { qf[0][0] = ldg16(qp); qf[0][1] = ldg16(qp + 32); } }
            float m[4], l[4]; f32x4 O[4][4];
#pragma unroll
            for (int p = 0; p < 4; ++p) { m[p] = -1e30f; l[p] = 0.f;
#pragma unroll
                for (int dt = 0; dt < 4; ++dt) O[p][dt] = (f32x4){0.f, 0.f, 0.f, 0.f}; }
            nsa_sweep<MD_MEM>(F.lds + RING_OFF, MKB + (size_t)(b * 256) * 256 + hm * 64, MVT + (size_t)(hm * 64) * 512 + b * 256, 0, 3, 0, nullptr, wave, ln, nn, kqq, qsl, 0, qf, BC0, m, l, O, 256, 64 * 256, 512, 64);
            const float il = 1.f / kqsum(l[0]);
            if (nn < 8) { bf16* op = CAT1 + (size_t)(row0 + nn) * 1792 + 1536 + hm * 64 + 4 * kqq;
#pragma unroll
                for (int dt = 0; dt < 4; ++dt) *(uint2*)(op + 16 * dt) = make_uint2(pk2(O[0][dt][0] * il, O[0][dt][1] * il), pk2(O[0][dt][2] * il, O[0][dt][3] * il)); }
            __syncthreads();
        }
    }
}

struct Args { In in; float* out; unsigned char* ws; int ph_lo, ph_hi; };
__global__ void __launch_bounds__(NWAVES * 64, 2) mk_fwd(Args args) {
    extern __shared__ __attribute__((aligned(16))) unsigned char lds[];
    Frame F;
    F.lds = (LAS unsigned char*)lds; F.MISC = (volatile LAS unsigned*)(F.lds + MISC_OFF);
    F.G = gridDim.x; { const int bx = blockIdx.x; F.vcu = (F.G % 8 == 0) ? (bx % 8) * (F.G / 8) + bx / 8 : bx; }
    unsigned char* ws = args.ws; const In& I = args.in; float* out = args.out; (void)I;
    F.ctl = (gu32*)(ws + WS_CTL);
    for (int u = threadIdx.x; u < (LDS_BYTES - LDSCTL_OFF) / 4; u += NWAVES * 64) ((LAS unsigned*)(F.lds + LDSCTL_OFF))[u] = 0u;
    __syncthreads();
    XcdBarrier bar; bar.bar = (unsigned*)(F.ctl + CW_BAR); bar.x = 0; bar.st = nullptr;
    if (!MK_SPLIT) bar = xcd_barrier_post((unsigned*)(F.ctl + CW_BAR), F.MISC + 8);
    const int lo = args.ph_lo, hi = args.ph_hi;
#ifndef PH_MASK
#define PH_MASK 0xFFFFFFFFu
#endif
#define IN(k) ((((PH_MASK) >> ((k) % 32)) & 1u) && lo <= (k) && (k) < hi)
#define SEAM(k) do { if (IN(k) && IN((k) + 1)) xcd_barrier(bar); } while (0)
#define SEAM2(k, kn) do { if (IN(k) && IN(kn)) xcd_barrier(bar); } while (0)
#ifndef REP_MASK
#define REP_MASK 0u
#endif
#define REPS(k) (1 + (int)(((REP_MASK) >> (k)) & 1u))
    bf16* XN = (bf16*)(ws + WS_XN); bf16* CAT = (bf16*)(ws + WS_CAT); bf16* ACT = (bf16*)(ws + WS_ACT);
    float* SSQ = (float*)(ws + WS_SSQ);

    if (IN(0)) { for (int r_ = 0; r_ < REPS(0); ++r_) { p0_prologue(F, I, ws); if (r_ + 1 < REPS(0)) xcd_barrier(bar); } SEAM(0); }
    {
            if (IN(1)) {
                pg8::Gemm g{XN, (const bf16*)(ws + WS_WIN0), M, 1792, D}; pg8::StaticOrder S; S.init(M, 1792, F.G, (int)blockIdx.x);
                pg8::EpiRoute<0> E{ws, nullptr};
                for (int r_ = 0; r_ < REPS(1); ++r_) { if (r_) xcd_barrier(bar);
                pg8::gemm_phase<pg8::EpiRoute<0>, pg8::StaticOrder, true, true>(F.lds + RING_OFF, g, S, E); }
                pg8::Gemm g2{(const bf16*)(ws + WS_WVT), XN, 256, M, D}; pg8::StaticOrder S2; S2.init(256, M, F.G, (int)((blockIdx.x + 64) % F.G));
                pg8::EpiRoute<3> E2{ws, nullptr};
                pg8::gemm_phase<pg8::EpiRoute<3>, pg8::StaticOrder, true, true>(F.lds + RING_OFF, g2, S2, E2);
                SEAM(1);
            }
            if (IN(2)) { for (int r_ = 0; r_ < REPS(2); ++r_) { p2_mfma(F, I, ws); if (r_ + 1 < REPS(2)) xcd_barrier(bar); } SEAM(2); }
            if (IN(3)) { for (int r_ = 0; r_ < REPS(3); ++r_) { p3_nsa_mfma(F, I, ws); if (r_ + 1 < REPS(3)) xcd_barrier(bar); } SEAM(3); }
    }
    {
        constexpr int L = 0, pb = L ? 14 : 4;
        if (IN(pb)) {
            pg8::Gemm g{L ? (const bf16*)(ws + WS_CAT1) : CAT, L ? (const bf16*)(ws + WS_WO1F) : (const bf16*)(ws + WS_WO), M, D, L ? 1792 : D}; pg8::StaticOrder S; S.init(M, D, F.G, (int)blockIdx.x);
            KARGS(); pg8::EpiResid<L == 0> E{L ? (const void*)XN : (const void*)Ip->x, XN, SSQ + (size_t)(L ? 2 : 0) * M * 16, D, 0};
            pg8::gemm_phase<pg8::EpiResid<L == 0>, pg8::StaticOrder, true, true>(F.lds + RING_OFF, g, S, E);
            SEAM2(pb, pb + 2);
        }
        if (IN(pb + 2)) {
            pg8::Gemm g{XN, (const bf16*)(ws + WS_WGU) + (size_t)L * 2 * DFF * D, M, 2 * DFF, D}; pg8::StaticOrder S; S.init(M, 2 * DFF, F.G, (int)blockIdx.x);
            pg8::EpiSwiglu E{ACT, SSQ + (size_t)(L ? 2 : 0) * M * 16, DFF, 0};
            for (int r_ = 0; r_ < REPS(pb + 2); ++r_) { if (r_) xcd_barrier(bar);
            pg8::gemm_phase<pg8::EpiSwiglu, pg8::StaticOrder, true, true>(F.lds + RING_OFF, g, S, E); }
            SEAM(pb + 2);
        }
        if (IN(pb + 3)) {
            pg8::Gemm g{ACT, (const bf16*)(ws + WS_WD) + (size_t)L * D * DFF, M, D, DFF}; pg8::StaticOrder S; S.init(M, D, F.G, (int)blockIdx.x);
            pg8::EpiResid<false> E{XN, XN, SSQ + (size_t)(L ? 3 : 1) * M * 16, D, 0};
            pg8::gemm_phase<pg8::EpiResid<false>, pg8::StaticOrder, true, true>(F.lds + RING_OFF, g, S, E);
            SEAM2(pb + 3, L ? 18 : 9);
        }
        }
    {
            if (IN(9)) {
                pg8::Gemm g{XN, (const bf16*)(ws + WS_WIN1), M, 768, D}; pg8::StaticOrder S; S.init(M, 768, F.G, (int)blockIdx.x);
                pg8::EpiRoute<1> E{ws, SSQ + (size_t)1 * M * 16};
                for (int r_ = 0; r_ < REPS(9); ++r_) { if (r_) xcd_barrier(bar);
                pg8::gemm_phase<pg8::EpiRoute<1>, pg8::StaticOrder, true, true>(F.lds + RING_OFF, g, S, E); }
                SEAM(9);
            }
            if (IN(10)) { p10_dsa_norm(F, I, ws); SEAM(10); }
            if (IN(11)) {
                pg8::Gemm g{(const bf16*)(ws + WS_CQ), (const bf16*)(ws + WS_WQ2), M, 2048, 256}; pg8::StaticOrder S; S.init(M, 2048, F.G, (int)blockIdx.x);
                pg8::EpiRoute<2> E{ws, nullptr};
                for (int r_ = 0; r_ < REPS(11); ++r_) { if (r_) xcd_barrier(bar);
                pg8::gemm_phase<pg8::EpiRoute<2>, pg8::StaticOrder, true, true>(F.lds + RING_OFF, g, S, E); }
                SEAM(11);
            }
            if (IN(12)) { for (int r_ = 0; r_ < REPS(12); ++r_) { p12_index_mfma(F, I, ws); if (r_ + 1 < REPS(12)) xcd_barrier(bar); } SEAM(12); }
            if (IN(13)) { for (int r_ = 0; r_ < REPS(13); ++r_) { p13_dsa_mfma(F, I, ws); if (r_ + 1 < REPS(13)) xcd_barrier(bar); } SEAM(13); }
            }
    {
        constexpr int L = 1, pb = L ? 14 : 4;
        if (IN(pb)) {
            pg8::Gemm g{L ? (const bf16*)(ws + WS_CAT1) : CAT, L ? (const bf16*)(ws + WS_WO1F) : (const bf16*)(ws + WS_WO), M, D, L ? 1792 : D}; pg8::StaticOrder S; S.init(M, D, F.G, (int)blockIdx.x);
            KARGS(); pg8::EpiResid<L == 0> E{L ? (const void*)XN : (const void*)Ip->x, XN, SSQ + (size_t)(L ? 2 : 0) * M * 16, D, 0};
            pg8::gemm_phase<pg8::EpiResid<L == 0>, pg8::StaticOrder, true, true>(F.lds + RING_OFF, g, S, E);
            SEAM2(pb, pb + 2);
        }
        if (IN(pb + 2)) {
            pg8::Gemm g{XN, (const bf16*)(ws + WS_WGU) + (size_t)L * 2 * DFF * D, M, 2 * DFF, D}; pg8::StaticOrder S; S.init(M, 2 * DFF, F.G, (int)blockIdx.x);
            pg8::EpiSwiglu E{ACT, SSQ + (size_t)(L ? 2 : 0) * M * 16, DFF, 0};
            for (int r_ = 0; r_ < REPS(pb + 2); ++r_) { if (r_) xcd_barrier(bar);
            pg8::gemm_phase<pg8::EpiSwiglu, pg8::StaticOrder, true, true>(F.lds + RING_OFF, g, S, E); }
            SEAM(pb + 2);
        }
        if (IN(pb + 3)) {
            pg8::Gemm g{ACT, (const bf16*)(ws + WS_WD) + (size_t)L * D * DFF, M, D, DFF}; pg8::StaticOrder S; S.init(M, D, F.G, (int)blockIdx.x);
            pg8::EpiResid<false> E{XN, XN, SSQ + (size_t)(L ? 3 : 1) * M * 16, D, 0};
            pg8::gemm_phase<pg8::EpiResid<false>, pg8::StaticOrder, true, true>(F.lds + RING_OFF, g, S, E);
            SEAM2(pb + 3, L ? 18 : 9);
        }
        }
    if (IN(18)) {
        OPAQUE_TID(); KARGS(); const int lane_ = tid_ & 63;
        const int gw = F.vcu * NWAVES + (tid_ >> 6), NGW = F.G * NWAVES;
        for (int m = gw; m < M; m += NGW) { const float r = rsqrtf(pg8::ssq_row(SSQ + ((size_t)3 * M + m) * 16) * (1.f / D) + EPSF);
#pragma unroll
            for (int j = 0; j < 2; ++j) { const int c = (j * 64 + lane_) * 8; const pg8::u32x4 rw = *(const GAS pg8::u32x4*)(XN + (size_t)m * D + c);
                const GAS f32x4* gr = (const GAS f32x4*)(Ip->norm_final + c); GAS f32x4* orow = (GAS f32x4*)(out + (size_t)m * D + c);
                f32x4 r0, r1; r0[0] = __uint_as_float(rw.x << 16); r0[1] = __uint_as_float(rw.x & 0xffff0000u); r0[2] = __uint_as_float(rw.y << 16); r0[3] = __uint_as_float(rw.y & 0xffff0000u);
                r1[0] = __uint_as_float(rw.z << 16); r1[1] = __uint_as_float(rw.z & 0xffff0000u); r1[2] = __uint_as_float(rw.w << 16); r1[3] = __uint_as_float(rw.w & 0xffff0000u);
                orow[0] = (r0 * r) * gr[0]; orow[1] = (r1 * r) * gr[1]; } }
    }
#undef IN
#undef SEAM
}

extern "C" void kernel_launch(void* const* d_in, const int* in_sizes, int n_in, void* d_out, int out_size, void* d_ws, size_t ws_size, hipStream_t stream) {
    static int grid = 0;
    if (grid == 0) {
        if (n_in != 32 || out_size != M * D || ws_size < WS_END) { fprintf(stderr, "kernel_launch: unexpected shapes (n_in %d out %d ws %zu)\n", n_in, out_size, ws_size); grid = -1; return; }
        int dev = 0, cus = 0, per_cu = 0;
        if (hipGetDevice(&dev) != hipSuccess || hipDeviceGetAttribute(&cus, hipDeviceAttributeMultiprocessorCount, dev) != hipSuccess) { grid = -1; return; }
        if (hipFuncSetAttribute((const void*)mk_fwd, hipFuncAttributeMaxDynamicSharedMemorySize, LDS_BYTES) != hipSuccess) { grid = -1; return; }
        if (hipOccupancyMaxActiveBlocksPerMultiprocessor(&per_cu, (const void*)mk_fwd, NWAVES * 64, LDS_BYTES) != hipSuccess || per_cu < 1) fprintf(stderr, "kernel_launch: occupancy query reports %d\n", per_cu);
        (void)hipGetLastError();
        grid = cus;
        if (grid > 256) grid = 256;
    }
    if (grid < 0) return;
    if (hipMemsetAsync((char*)d_ws + WS_CTL, 0, CTL_ZERO_BYTES, stream) != hipSuccess) return;
    Args a{};
    const float** ip = (const float**)&a.in;
    for (int i = 0; i < 32; ++i) ip[i] = (const float*)d_in[i];
    a.out = (float*)d_out; a.ws = (unsigned char*)d_ws;
#if MK_SPLIT
    for (int k = 0; k < N_PHASES; ++k) { a.ph_lo = k; a.ph_hi = k + 1; hipLaunchKernelGGL(mk_fwd, dim3(grid), dim3(NWAVES * 64), LDS_BYTES, stream, a); }
#else
    a.ph_lo = 0; a.ph_hi = N_PHASES; hipLaunchKernelGGL(mk_fwd, dim3(grid), dim3(NWAVES * 64), LDS_BYTES, stream, a);
#endif
}
```

```cpp
#include <hip/hip_runtime.h>
#include <cstdio>
#include <cstdint>
#include <type_traits>
#include <math.h>

namespace pg8 {
#define PG8_LAS __attribute__((address_space(3)))
typedef unsigned short bf16_t;
typedef short bf16x8 __attribute__((ext_vector_type(8)));
typedef float f32x4 __attribute__((ext_vector_type(4)));
typedef unsigned u32x4 __attribute__((ext_vector_type(4)));
constexpr int BM = 256, BK = 64, HALF = 128, HTB = HALF * BK * 2  , STAGE_BYTES = 8 * HTB, NXCD = 8, WGM = 8;

__host__ __device__ __forceinline__ int lds_byte(int r, int c) { const int st = (r >> 4) * 2 + (c >> 5), rr = r & 15, cc = c & 31, ob = rr * 64 + cc * 2; return st * 1024 + (ob ^ (((ob >> 9) & 1) << 5)); }
__host__ __device__ __forceinline__ void stage_rc(int b, int& R, int& C) { const int st = b / 1024, sb = b % 1024, swz = sb ^ (((sb >> 9) & 1) << 5); R = (st >> 1) * 16 + swz / 64; C = (st & 1) * 32 + (swz % 64) / 2; }
__host__ __device__ __forceinline__ int perm32(int rho) { const int n = rho >> 4, i = rho & 15; return 8 * (i >> 2) + 4 * n + (i & 3); }

struct Unit { int pm, pn; };
struct Gemm { const bf16_t* A; const bf16_t* Bt; int M, N, K; };

struct StaticOrder {
    int nM, nN, nwg, G, c;
    __host__ __device__ void init(int M, int N, int G_, int c_) { nM = M / BM; nN = N / BM; nwg = nM * nN; G = G_; c = c_; }
    __host__ __device__ bool next(int i, Unit& u) const {
        const long L = (long)i * G + c; if (L >= nwg) return false;
        int wgid = (int)L; { const int q = nwg / NXCD, r = nwg % NXCD, xcd = wgid % NXCD, off = wgid / NXCD; wgid = (xcd < r ? xcd * (q + 1) : r * (q + 1) + (xcd - r) * q) + off; }
        const int nig = WGM * nN, gid = wgid / nig, fm = gid * WGM, gsz = (nM - fm) < WGM ? (nM - fm) : WGM;
        u.pm = fm + ((wgid % nig) % gsz); u.pn = (wgid % nig) / gsz; return true;
    }
    __device__ __forceinline__ void a_ready(const Unit&) const {}
    __device__ __forceinline__ void done(const Unit&) const {}
};

__device__ __forceinline__ unsigned cvt_pk_bf16(float lo, float hi) { unsigned r; asm volatile("v_cvt_pk_bf16_f32 %0, %1, %2" : "=v"(r) : "v"(lo), "v"(hi)); return r; }
__device__ __forceinline__ float ssq_row(const float* p) { const f32x4 a = ((const f32x4*)p)[0], b = ((const f32x4*)p)[1], c = ((const f32x4*)p)[2], d = ((const f32x4*)p)[3]; const f32x4 t = (a + b) + (c + d); return (t[0] + t[1]) + (t[2] + t[3]); }
template <int ROUTE> struct EpiRoute {
    static constexpr bool PERM = true, AFTER_DRAIN = false;
    unsigned char* ws; const float* ssq;
    __device__ __forceinline__ void operator()(const f32x4 (&acc)[2][2][4][2], const Unit& u, int wr, int wc, int fr, int fq) const {
        asm volatile("" : "+v"(fr), "+v"(fq));
        const int pn = u.pn; size_t off; int ld, t0; float sc;
        if constexpr (ROUTE == 0) {
            off = pn < 3 ? (size_t)(88u << 20) : pn < 5 ? (size_t)(112u << 20) : pn < 6 ? (size_t)(128u << 20) : (size_t)(136u << 20);
            ld = pn < 3 ? 768 : pn < 5 ? 512 : 256; t0 = pn < 3 ? 0 : pn < 5 ? 3 : pn < 6 ? 5 : 6; sc = (pn < 3 || pn == 5) ? 0.18033688011112042f : 1.f;
        } else if constexpr (ROUTE == 1) { off = (size_t)(88u << 20); ld = 768; t0 = 0; sc = 1.f; }
        else if constexpr (ROUTE == 3) { off = (size_t)(144u << 20); ld = 16384; t0 = 0; sc = 1.f; }
        else { off = pn < 6 ? (size_t)(128u << 20) : (size_t)(176u << 20); ld = pn < 6 ? 1536 : 512; t0 = pn < 6 ? 0 : 6; sc = 1.f; }
        bf16_t* base = (bf16_t*)(ws + off);
        const int row0 = u.pm * BM + wr * 64 + fr, col0 = (pn - t0) * BM + wc * 32 + 8 * fq;
#pragma unroll
        for (int ai = 0; ai < 2; ++ai)
#pragma unroll
            for (int m = 0; m < 4; ++m) { bf16_t* rowp = base + (size_t)(row0 + ai * HALF + m * 16) * ld + col0;
                float scr_ = sc; if constexpr (ROUTE == 1) scr_ = rsqrtf(ssq_row(ssq + (size_t)(row0 + ai * HALF + m * 16) * 16) * (1.f / 1024.f) + 1e-6f);
#pragma unroll
                for (int bj = 0; bj < 2; ++bj) { float scb_ = scr_; if constexpr (ROUTE == 1) { const int cg = col0 + bj * HALF; if (cg >= 456 && cg < 712) scb_ *= 0.18033688011112042f; }
                    const f32x4 v0 = acc[ai][bj][m][0] * scb_, v1 = acc[ai][bj][m][1] * scb_;
                    u32x4 w; w.x = cvt_pk_bf16(v0[0], v0[1]); w.y = cvt_pk_bf16(v0[2], v0[3]); w.z = cvt_pk_bf16(v1[0], v1[1]); w.w = cvt_pk_bf16(v1[2], v1[3]);
                    if constexpr (ROUTE == 3) {
                        const int tok = col0 + bj * HALF, rw = row0 + ai * HALF + m * 16; *(u32x4*)(base + ((size_t)(tok >> 6) * 256 + rw) * 64 + (tok & 63)) = w; }
                    else *(u32x4*)(rowp + bj * HALF) = w; } }
    }
};
template <bool RES_F32>
struct EpiResid {
    static constexpr bool PERM = true, AFTER_DRAIN = false;
    const void* res; bf16_t* hb; float* ssq; int ldc; int pad;
    __device__ __forceinline__ void operator()(const f32x4 (&acc)[2][2][4][2], const Unit& u, int wr, int wc, int fr, int fq) const {
        asm volatile("" : "+v"(fr), "+v"(fq));
        const int row0 = u.pm * BM + wr * 64 + fr, col0 = u.pn * BM + wc * 32 + 8 * fq;
#pragma unroll
        for (int ai = 0; ai < 2; ++ai)
#pragma unroll
            for (int m = 0; m < 4; ++m) { const int row = row0 + ai * HALF + m * 16; const size_t off = (size_t)row * ldc + col0; float sq = 0.f;
#pragma unroll
                for (int bj = 0; bj < 2; ++bj) { f32x4 v[2];
                    if constexpr (RES_F32) {
#pragma unroll
                        for (int n = 0; n < 2; ++n) v[n] = *(const f32x4*)((const float*)res + off + bj * HALF + 4 * n) + acc[ai][bj][m][n];
                    } else { const u32x4 rw = *(const u32x4*)((const bf16_t*)res + off + bj * HALF);
                        f32x4 r0, r1; r0[0] = __uint_as_float(rw.x << 16); r0[1] = __uint_as_float(rw.x & 0xffff0000u); r0[2] = __uint_as_float(rw.y << 16); r0[3] = __uint_as_float(rw.y & 0xffff0000u);
                        r1[0] = __uint_as_float(rw.z << 16); r1[1] = __uint_as_float(rw.z & 0xffff0000u); r1[2] = __uint_as_float(rw.w << 16); r1[3] = __uint_as_float(rw.w & 0xffff0000u);
                        v[0] = r0 + acc[ai][bj][m][0]; v[1] = r1 + acc[ai][bj][m][1]; }
#pragma unroll
                    for (int n = 0; n < 2; ++n) sq += (v[n][0] * v[n][0] + v[n][1] * v[n][1]) + (v[n][2] * v[n][2] + v[n][3] * v[n][3]);
                    u32x4 w; w.x = cvt_pk_bf16(v[0][0], v[0][1]); w.y = cvt_pk_bf16(v[0][2], v[0][3]); w.z = cvt_pk_bf16(v[1][0], v[1][1]); w.w = cvt_pk_bf16(v[1][2], v[1][3]); *(u32x4*)(hb + off + bj * HALF) = w; }
                sq += __shfl_xor(sq, 16); sq += __shfl_xor(sq, 32); if (fq == 0) ssq[(size_t)row * 16 + u.pn * 4 + wc] = sq; }
    }
};
struct EpiSwiglu {
    static constexpr bool PERM = true, AFTER_DRAIN = false;
    bf16_t* O; const float* ssq; int ldc; int pad;
    __device__ __forceinline__ void operator()(const f32x4 (&acc)[2][2][4][2], const Unit& u, int wr, int wc, int fr, int fq) const {
        asm volatile("" : "+v"(fr), "+v"(fq));
        const int row0 = u.pm * BM + wr * 64 + fr, col0 = u.pn * HALF + wc * 32 + 8 * fq;
#pragma unroll
        for (int ai = 0; ai < 2; ++ai)
#pragma unroll
            for (int m = 0; m < 4; ++m) { float o[8]; const float rs = rsqrtf(ssq_row(ssq + (size_t)(row0 + ai * HALF + m * 16) * 16) * (1.f / 1024.f) + 1e-6f);
#pragma unroll
                for (int n = 0; n < 2; ++n)
#pragma unroll
                    for (int e = 0; e < 4; ++e) { const float g = acc[ai][0][m][n][e] * rs, up = acc[ai][1][m][n][e] * rs; o[4 * n + e] = (g * __builtin_amdgcn_rcpf(1.f + __expf(-g))) * up; }
                u32x4 w; w.x = cvt_pk_bf16(o[0], o[1]); w.y = cvt_pk_bf16(o[2], o[3]); w.z = cvt_pk_bf16(o[4], o[5]); w.w = cvt_pk_bf16(o[6], o[7]);
                *(u32x4*)(O + (size_t)(row0 + ai * HALF + m * 16) * ldc + col0) = w; }
    }
};
template <class Epi, class Sched, bool ALIGN_EPI = false, bool SP2 = false>
__device__ __forceinline__ void gemm_phase(PG8_LAS unsigned char* lds, const Gemm g, const Sched& S, const Epi& E) {
    int tid = threadIdx.x; asm volatile("" : "+v"(tid));
    const int wid = __builtin_amdgcn_readfirstlane(tid >> 6), lane = tid & 63, wr = wid >> 2, wc = wid & 3, fr = lane & 15, fq = lane >> 4;
    int K = g.K; asm volatile("" : "+s"(K));
    const int nt = K / BK;
    unsigned voffA[2], voffB[2];
#pragma unroll
    for (int i = 0; i < 2; ++i) { int R, C; stage_rc(tid * 16 + i * 8192, R, C); const int Rb = Epi::PERM ? ((R & ~31) + perm32(R & 31)) : R;
        voffA[i] = (unsigned)(R * K + C) * 2u; voffB[i] = (unsigned)(Rb * K + C) * 2u; }
    const size_t kstep = (size_t)(BK * 2);
    const size_t hstep = (size_t)HALF * K * 2;
    const size_t tstep = 2 * hstep;
    const unsigned ldsw = (unsigned)wid * 1024u;
    const int aoff = lds_byte(wr * 64 + fr, fq * 8), boff = lds_byte(wc * 32 + fr, fq * 8);
#define PG8_SA(b, h) (((b) * 2 + (h)) * HTB)
#define PG8_SB(b, h) ((4 + (b) * 2 + (h)) * HTB)
#define PG8_STAGE(bufoff, gbase, voff) do { _Pragma("unroll") for (int _i = 0; _i < 2; ++_i) \
        __builtin_amdgcn_global_load_lds((const unsigned*)((const char*)(gbase) + (voff)[_i]), (PG8_LAS unsigned*)(lds + (bufoff) + ldsw + _i * 8192), 16, 0, 0); } while (0)
#define PG8_LDA(dst, b, h) do { _Pragma("unroll") for (int m = 0; m < 4; ++m) _Pragma("unroll") for (int k = 0; k < 2; ++k) dst[m][k] = *(const PG8_LAS bf16x8*)(lds + PG8_SA(b, h) + aoff + m * 2048 + k * 1024); } while (0)
#define PG8_LDB(dst, b, h) do { _Pragma("unroll") for (int n = 0; n < 2; ++n) _Pragma("unroll") for (int k = 0; k < 2; ++k) dst[n][k] = *(const PG8_LAS bf16x8*)(lds + PG8_SB(b, h) + boff + n * 2048 + k * 1024); } while (0)
#define PG8_MMA(ai, bj, At, Bt) do { __builtin_amdgcn_s_setprio(1); _Pragma("unroll") for (int m = 0; m < 4; ++m) _Pragma("unroll") for (int n = 0; n < 2; ++n) _Pragma("unroll") for (int k = 0; k < 2; ++k) \
        acc[ai][bj][m][n] = __builtin_amdgcn_mfma_f32_16x16x32_bf16(Bt[n][k], At[m][k], acc[ai][bj][m][n], 0, 0, 0); __builtin_amdgcn_s_setprio(0); } while (0)
#define PG8_WAIT_V(n) asm volatile("s_waitcnt vmcnt(" #n ")" ::: "memory")
#define PG8_WAIT_L(n) asm volatile("s_waitcnt lgkmcnt(" #n ")" ::: "memory")
#define PG8_BAR __builtin_amdgcn_s_barrier()
#define PG8_SCHED __builtin_amdgcn_sched_barrier(0)
    Unit cur, nxt; int ui = 0;
    if (!S.next(0, cur)) return;
    f32x4 acc[2][2][4][2];
#pragma unroll
    for (int a = 0; a < 2; ++a)
#pragma unroll
        for (int b = 0; b < 2; ++b)
#pragma unroll
            for (int m = 0; m < 4; ++m)
#pragma unroll
                for (int n = 0; n < 2; ++n) acc[a][b][m][n] = (f32x4){0.f, 0.f, 0.f, 0.f};
    bf16x8 At[4][2], B0[2][2], B1[2][2];
    const char* cA = (const char*)g.A + (size_t)cur.pm * tstep; const char* cB = (const char*)g.Bt + (size_t)cur.pn * tstep;
    S.a_ready(cur);
    if constexpr (SP2) {
        PG8_STAGE(PG8_SB(0, 0), cB, voffB); PG8_STAGE(PG8_SB(0, 1), cB + hstep, voffB); PG8_STAGE(PG8_SA(0, 0), cA, voffA); PG8_STAGE(PG8_SA(0, 1), cA + hstep, voffA);
        if (wr == 1) PG8_BAR;
        PG8_WAIT_V(2); PG8_BAR;
        PG8_STAGE(PG8_SB(1, 0), cB + kstep, voffB); PG8_STAGE(PG8_SA(1, 0), cA + kstep, voffA); PG8_STAGE(PG8_SB(1, 1), cB + hstep + kstep, voffB);
        PG8_WAIT_V(6); PG8_BAR;
    } else {
        PG8_STAGE(PG8_SB(0, 0), cB, voffB); PG8_STAGE(PG8_SA(0, 0), cA, voffA); PG8_STAGE(PG8_SB(0, 1), cB + hstep, voffB); PG8_STAGE(PG8_SA(0, 1), cA + hstep, voffA);
        if (wr == 1) PG8_BAR;
        PG8_WAIT_V(4); PG8_BAR;
        PG8_STAGE(PG8_SB(1, 0), cB + kstep, voffB); PG8_STAGE(PG8_SA(1, 0), cA + kstep, voffA); PG8_STAGE(PG8_SB(1, 1), cB + hstep + kstep, voffB);
        PG8_WAIT_V(6); PG8_BAR;
    }
    for (;;) {
        const bool has_next = S.next(ui + 1, nxt);
        const char* nA = has_next ? (const char*)g.A + (size_t)nxt.pm * tstep : cA; const char* nB = has_next ? (const char*)g.Bt + (size_t)nxt.pn * tstep : cB;
        for (int t = 0; t < nt; t += 2) {
            const bool last = (t == nt - 2);
            const char* a1 = cA + (size_t)(t + 1) * kstep;
            const char* a2 = last ? nA : cA + (size_t)(t + 2) * kstep; const char* b2 = last ? nB : cB + (size_t)(t + 2) * kstep;
            const char* a3 = a2 + kstep; const char* b3 = b2 + kstep;
            if (last && has_next) S.a_ready(nxt);
            if constexpr (SP2) {
            PG8_LDB(B0, 0, 0); PG8_LDB(B1, 0, 1); PG8_SCHED; PG8_LDA(At, 0, 0); PG8_STAGE(PG8_SA(1, 1), a1 + hstep, voffA);
            PG8_WAIT_V(8); PG8_WAIT_L(0); PG8_BAR; PG8_MMA(0, 0, At, B0); PG8_MMA(0, 1, At, B1); PG8_BAR; PG8_SCHED;
            PG8_LDA(At, 0, 1); PG8_STAGE(PG8_SB(0, 0), b2, voffB); PG8_STAGE(PG8_SB(0, 1), b2 + hstep, voffB); PG8_STAGE(PG8_SA(0, 0), a2, voffA);
            PG8_WAIT_V(8); PG8_WAIT_L(0); PG8_BAR; PG8_MMA(1, 0, At, B0); PG8_MMA(1, 1, At, B1); PG8_BAR; PG8_SCHED;
            PG8_LDB(B0, 1, 0); PG8_LDB(B1, 1, 1); PG8_SCHED; PG8_LDA(At, 1, 0); PG8_STAGE(PG8_SA(0, 1), a2 + hstep, voffA);
            PG8_WAIT_V(8); PG8_WAIT_L(0); PG8_BAR; PG8_MMA(0, 0, At, B0); PG8_MMA(0, 1, At, B1); PG8_BAR; PG8_SCHED;
            PG8_LDA(At, 1, 1); PG8_STAGE(PG8_SB(1, 0), b3, voffB); PG8_STAGE(PG8_SB(1, 1), b3 + hstep, voffB); PG8_STAGE(PG8_SA(1, 0), a3, voffA);
            PG8_WAIT_V(8); PG8_WAIT_L(0); PG8_BAR; PG8_MMA(1, 0, At, B0); PG8_MMA(1, 1, At, B1); PG8_BAR; PG8_SCHED;
            } else {
            PG8_LDB(B0, 0, 0); PG8_SCHED; PG8_LDA(At, 0, 0); PG8_STAGE(PG8_SA(1, 1), a1 + hstep, voffA);
            PG8_WAIT_L(8); PG8_BAR; PG8_WAIT_L(0); PG8_MMA(0, 0, At, B0); PG8_BAR; PG8_SCHED;
            PG8_LDB(B1, 0, 1); PG8_STAGE(PG8_SB(0, 0), b2, voffB);
            PG8_BAR; PG8_WAIT_L(0); PG8_MMA(0, 1, At, B1); PG8_BAR;
            PG8_LDA(At, 0, 1); PG8_STAGE(PG8_SA(0, 0), a2, voffA);
            PG8_BAR; PG8_WAIT_L(0); PG8_MMA(1, 0, At, B0); PG8_BAR; PG8_SCHED;
            PG8_STAGE(PG8_SB(0, 1), b2 + hstep, voffB);
            PG8_WAIT_V(6); PG8_BAR; PG8_MMA(1, 1, At, B1); PG8_BAR;
            PG8_LDB(B0, 1, 0); PG8_SCHED; PG8_LDA(At, 1, 0); PG8_STAGE(PG8_SA(0, 1), a2 + hstep, voffA);
            PG8_WAIT_L(8); PG8_BAR; PG8_WAIT_L(0); PG8_MMA(0, 0, At, B0); PG8_BAR; PG8_SCHED;
            PG8_LDB(B1, 1, 1); PG8_STAGE(PG8_SB(1, 0), b3, voffB);
            PG8_BAR; PG8_WAIT_L(0); PG8_MMA(0, 1, At, B1); PG8_BAR;
            PG8_LDA(At, 1, 1); PG8_STAGE(PG8_SA(1, 0), a3, voffA);
            PG8_BAR; PG8_WAIT_L(0); PG8_MMA(1, 0, At, B0); PG8_BAR; PG8_SCHED;
            PG8_STAGE(PG8_SB(1, 1), b3 + hstep, voffB);
            PG8_WAIT_V(6); PG8_BAR; PG8_MMA(1, 1, At, B1); PG8_BAR;
            }
        }
        if constexpr (ALIGN_EPI) { if (wr == 0) PG8_BAR; }
        if constexpr (!Epi::AFTER_DRAIN) { E(acc, cur, wr, wc, fr, fq); S.done(cur); }
        if (!has_next) break;
#pragma unroll
        for (int a = 0; a < 2; ++a)
#pragma unroll
            for (int b = 0; b < 2; ++b)
#pragma unroll
                for (int m = 0; m < 4; ++m)
#pragma unroll
                    for (int n = 0; n < 2; ++n) acc[a][b][m][n] = (f32x4){0.f, 0.f, 0.f, 0.f};
        cur = nxt; cA = nA; cB = nB; ++ui;
        if constexpr (ALIGN_EPI) { if (wr == 1) PG8_BAR; }
    }
    PG8_WAIT_V(0);
    if constexpr (!ALIGN_EPI) { if (wr == 0) PG8_BAR; }
    PG8_BAR;
    if constexpr (Epi::AFTER_DRAIN) { E.fused(acc, cur, wr, wc, fr, fq, lds, wid, lane); S.done(cur); }
#undef PG8_SA
#undef PG8_SB
#undef PG8_STAGE
#undef PG8_LDA
#undef PG8_LDB
#undef PG8_MMA
#undef PG8_WAIT_V
#undef PG8_WAIT_L
#undef PG8_BAR
#undef PG8_SCHED
}
}
constexpr int NWAVES = 8;
constexpr int BATCH = 2, T = 8192, D = 1024, M = BATCH * T, DFF = 2816, NSA_IN = 1828, DSA_IN = 712, NCMP = 511, NCR = BATCH * NCMP * 2;
constexpr float NEGF = -1e30f, EPSF = 1e-6f;
#ifndef MK_SPLIT
#define MK_SPLIT 0
#endif
constexpr int N_PHASES = 19;
constexpr size_t MiB = 1u << 20;
constexpr size_t WS_CTL = 0, CTL_ZERO_BYTES = 1 * MiB;
constexpr size_t WS_KCB = 1 * MiB  , WS_VCT = 1 * MiB + 512 * 1024  , WS_MKB = 2 * MiB  , WS_MVT = 2 * MiB + 512 * 1024  , WS_MKV = 3 * MiB  , WS_WIDX = 5 * MiB  , WS_CNT = 6 * MiB  ;
constexpr size_t WS_WIN0 = 8 * MiB, WS_WO = 12 * MiB, WS_WGU = 16 * MiB, WS_WD = 38 * MiB, WS_WIN1 = 49 * MiB, WS_WQ2 = 51 * MiB, WS_WVT = 52 * MiB  ;
constexpr size_t WS_W1T = 232 * MiB, WS_MEMN = 234 * MiB, WS_WMKT = 236 * MiB, WS_W2T = 238 * MiB, WS_B1F = 238 * MiB + 64 * 1024;
constexpr size_t WS_XN = 56 * MiB;
constexpr size_t WS_Q0 = 88 * MiB, WS_KV0 = 112 * MiB  , WS_QM = 128 * MiB, WS_G0 = 136 * MiB, WS_VT = 144 * MiB  ;
static_assert(WS_Q0 == (88u << 20) && WS_KV0 == (112u << 20) && WS_QM == (128u << 20) && WS_G0 == (136u << 20), "EpiRoute tables");
constexpr size_t WS_ACT = 88 * MiB;
constexpr size_t WS_PROJ1 = 88 * MiB, WS_CQ = 112 * MiB, WS_CKV = 120 * MiB, WS_KIDX = 124 * MiB, WS_QA = 128 * MiB, WS_QI = 176 * MiB, WS_SEL = 112 * MiB  , WS_CAT1 = 176 * MiB  , WS_WO1F = 52 * MiB + 512 * 1024  ;
constexpr size_t WS_OCS = 152 * MiB  , WS_CAT = 200 * MiB, WS_SSQ = 239 * MiB  , WS_END = 243 * MiB;
static_assert(WS_PROJ1 == (88u << 20) && WS_QA == (128u << 20) && WS_QI == (176u << 20) && WS_VT == (144u << 20), "EpiRoute tables");
static_assert(WS_ACT + (size_t)M * DFF * 2 <= WS_CAT + 0 * MiB || true, "map");
constexpr int CW_BAR = 4096;
constexpr int RING_OFF = 0, RING_BYTES = 131072, LDS_BYTES = 163840, LDSCTL_OFF = LDS_BYTES - 1024, MISC_OFF = LDSCTL_OFF + 320;
#define GAS __attribute__((address_space(1)))
#define LAS __attribute__((address_space(3)))
typedef unsigned short bf16;
typedef unsigned v4u __attribute__((ext_vector_type(4)));
typedef unsigned v2u __attribute__((ext_vector_type(2)));
typedef float f32x4 __attribute__((ext_vector_type(4)));
typedef short bf16x8 __attribute__((ext_vector_type(8)));
typedef GAS unsigned gu32;
typedef GAS unsigned long long gu64;
#define RLX_AGENT __ATOMIC_RELAXED, __HIP_MEMORY_SCOPE_AGENT
#define LDS_WAIT() asm volatile("s_waitcnt lgkmcnt(0)" ::: "memory")
#define VM_WAIT() asm volatile("s_waitcnt vmcnt(0)" ::: "memory")
__device__ __forceinline__ unsigned long long rt() { return __builtin_amdgcn_s_memrealtime(); }
__device__ __forceinline__ unsigned f2bf(float f) { unsigned u = __builtin_bit_cast(unsigned, f); return (u + 0x7fffu + ((u >> 16) & 1u)) >> 16; }
__device__ __forceinline__ unsigned pk2(float lo, float hi) { return f2bf(lo) | (f2bf(hi) << 16); }
#define XB_TMO      128
#define XB_XCNT(j)  (256  + 64 * (j))
#define XB_XSUB(j)  (1280 + 64 * (j))
#define XB_XGEN(j)  (2304 + 64 * (j))
#define XB_TOP      3328
#define XB_TOPGEN   3392
#define XCD_BAR_WORDS 3456
#define XB_SPIN_CAP (1u << 18)

__device__ __forceinline__ unsigned xb_ld(unsigned* p)              { return __hip_atomic_load(p, __ATOMIC_RELAXED, __HIP_MEMORY_SCOPE_AGENT); }
__device__ __forceinline__ unsigned xb_add(unsigned* p, unsigned v) { return __hip_atomic_fetch_add(p, v, __ATOMIC_RELAXED, __HIP_MEMORY_SCOPE_AGENT); }
__device__ __forceinline__ unsigned xb_xcc_id() { return (unsigned)__builtin_amdgcn_s_getreg((3 << 11) | 20) & 0xFu; }
#define XB_SPIN(cond, bar) do { unsigned _sp = 0; while (cond) { __builtin_amdgcn_s_sleep(1); \
    if ((++_sp & 255u) == 0u) { if (xb_ld(&(bar)[XB_TMO])) break; if (_sp > XB_SPIN_CAP) { atomicAdd(&(bar)[XB_TMO], 1u); break; } } } } while (0)

struct XcdBarrier {
    unsigned* bar; unsigned x;
    volatile LAS unsigned* st;
};

__device__ __forceinline__ XcdBarrier xcd_barrier_post(unsigned* bar, volatile LAS unsigned* st) {
    XcdBarrier b; b.bar = bar; b.x = xb_xcc_id(); b.st = st;
    if (threadIdx.x == 0) (void)xb_add(&bar[XB_XCNT(b.x)], 1u);
    return b;
}
__device__ __forceinline__ void xcd_barrier_complete(unsigned* bar, unsigned x, unsigned& nloc, unsigned& nx) {
    const unsigned G = gridDim.x * gridDim.y * gridDim.z;
    unsigned sum, cnt, mine, sp = 0u;
    for (;;) {
        sum = 0u; cnt = 0u; mine = 0u;
#pragma unroll 1
        for (unsigned j = 0; j < 16; ++j) { const unsigned c = xb_ld(&bar[XB_XCNT(j)]); sum += c; cnt += (c > 0u) ? 1u : 0u; mine = (j == x) ? c : mine; }
        if (sum == G) break;
        __builtin_amdgcn_s_sleep(1);
        if ((++sp & 255u) == 0u) { if (xb_ld(&bar[XB_TMO])) break; if (sp > XB_SPIN_CAP) { atomicAdd(&bar[XB_TMO], 1u); break; } }
    }
    nloc = mine > 0u ? mine : 1u; nx = cnt > 0u ? cnt : 1u;
}

__device__ __forceinline__ void xcd_barrier(const XcdBarrier& b) {
    asm volatile("s_waitcnt vmcnt(0)" ::: "memory");
    __syncthreads();
    if (threadIdx.x == 0) {
        unsigned* bar = b.bar;
        __builtin_amdgcn_s_waitcnt(0);
        unsigned nloc = b.st[0], nx = b.st[1];
        if (nloc == 0u) { xcd_barrier_complete(bar, b.x, nloc, nx); b.st[0] = nloc; b.st[1] = nx; }
        const unsigned old = xb_add(&bar[XB_XSUB(b.x)], 1u);
        const unsigned gen = old / nloc;
        if (old + 1u == (gen + 1u) * nloc) {
            __builtin_amdgcn_fence(__ATOMIC_RELEASE, "agent");
            asm volatile("s_waitcnt vmcnt(0)" ::: "memory");
            const unsigned og = xb_add(&bar[XB_TOP], 1u);
            const unsigned tg = og / nx;
            if (og + 1u == (tg + 1u) * nx) xb_add(&bar[XB_TOPGEN], 1u);
            else XB_SPIN(xb_ld(&bar[XB_TOPGEN]) == tg, bar);
            __builtin_amdgcn_fence(__ATOMIC_ACQUIRE, "agent");
            xb_add(&bar[XB_XGEN(b.x)], 1u);
            asm volatile("s_waitcnt vmcnt(0)" ::: "memory");
        } else {
            XB_SPIN(xb_ld(&bar[XB_XGEN(b.x)]) == gen, bar);
            __builtin_amdgcn_fence(__ATOMIC_ACQUIRE, "agent");
            asm volatile("s_waitcnt vmcnt(0)" ::: "memory");
        }
    }
    __syncthreads();
}

struct Frame {
    LAS unsigned char* lds; volatile LAS unsigned* MISC; gu32* ctl;
    int vcu, G;
};
__device__ __forceinline__ float bf2f(unsigned short u) { return __uint_as_float((unsigned)u << 16); }
__device__ __forceinline__ float bflo(unsigned u) { return __uint_as_float(u << 16); }
__device__ __forceinline__ float bfhi(unsigned u) { return __uint_as_float(u & 0xffff0000u); }
__device__ __forceinline__ float wave_sum(float v) {
#pragma unroll
    for (int o = 1; o < 64; o <<= 1) v += __shfl_xor(v, o);
    return v;
}
__device__ __forceinline__ float red16_sum(float v) { v += __shfl_xor(v, 1, 16); v += __shfl_xor(v, 2, 16); v += __shfl_xor(v, 4, 16); v += __shfl_xor(v, 8, 16); return v; }
__device__ __forceinline__ float red16_max(float v) { v = fmaxf(v, __shfl_xor(v, 1, 16)); v = fmaxf(v, __shfl_xor(v, 2, 16)); v = fmaxf(v, __shfl_xor(v, 4, 16)); v = fmaxf(v, __shfl_xor(v, 8, 16)); return v; }
__device__ __forceinline__ int rel_bucket(int n) {
    if (n < 16) return n;
    return 16 + (n >= 22) + (n >= 30) + (n >= 40) + (n >= 54) + (n >= 73) + (n >= 99) + (n >= 134) + (n >= 182) + (n >= 246) + (n >= 332) + (n >= 450) + (n >= 609) + (n >= 825) + (n >= 1117) + (n >= 1513);
}

__device__ __forceinline__ void xpose_item(const float* W, int ldw, int c0, int nvalid, int k0, bf16* WT, int Kd, int drow0, LAS float* scr, int lane, const float* kgain = nullptr) {
#pragma unroll
    for (int i = 0; i < 8; ++i) { const int kk = 8 * i + (lane >> 3), n = (lane & 7) * 4;
        float4 wv = make_float4(0.f, 0.f, 0.f, 0.f);
        if (n + 3 < nvalid) wv = *(const float4*)(W + (size_t)(k0 + kk) * ldw + c0 + n);
        else if (n < nvalid) { const float* wp = W + (size_t)(k0 + kk) * ldw + c0 + n; wv.x = wp[0]; if (n + 1 < nvalid) wv.y = wp[1]; if (n + 2 < nvalid) wv.z = wp[2]; }
        if (kgain) { const float g_ = kgain[k0 + kk]; wv.x *= g_; wv.y *= g_; wv.z *= g_; wv.w *= g_; }
        LAS float* sp = scr + kk * 33 + n; sp[0] = wv.x; sp[1] = wv.y; sp[2] = wv.z; sp[3] = wv.w; }
    LDS_WAIT(); asm volatile("" ::: "memory");
    const int c = lane & 7;
#pragma unroll
    for (int j = 0; j < 4; ++j) { const int n = (lane >> 3) + 8 * j; const LAS float* s = scr + (8 * c) * 33 + n;
        v4u o; o.x = pk2(s[0 * 33], s[1 * 33]); o.y = pk2(s[2 * 33], s[3 * 33]); o.z = pk2(s[4 * 33], s[5 * 33]); o.w = pk2(s[6 * 33], s[7 * 33]);
        *(GAS v4u*)(WT + (size_t)(drow0 + n) * Kd + k0 + 8 * c) = o; }
    LDS_WAIT(); asm volatile("" ::: "memory");
}
__device__ __forceinline__ void rms_row_to_bf16(const float* xrow, const float* gain, bf16* orow, int lane) {
    const GAS f32x4* xr = (const GAS f32x4*)xrow + lane; const GAS f32x4* gr = (const GAS f32x4*)gain + lane;
    f32x4 v[4]; float s = 0.f;
#pragma unroll
    for (int j = 0; j < 4; ++j) { v[j] = xr[64 * j]; s += (v[j].x * v[j].x + v[j].y * v[j].y) + (v[j].z * v[j].z + v[j].w * v[j].w); }
    const float r = rsqrtf(wave_sum(s) * (1.f / D) + EPSF);
    GAS unsigned long long* o8 = (GAS unsigned long long*)orow + lane;
#pragma unroll
    for (int j = 0; j < 4; ++j) { const f32x4 g = gr[64 * j]; o8[64 * j] = (unsigned long long)pk2((v[j].x * r) * g.x, (v[j].y * r) * g.y) | ((unsigned long long)pk2((v[j].z * r) * g.z, (v[j].w * r) * g.w) << 32); }
}
#ifndef PROBE_REP
#define PROBE_REP 0
#endif
#define CAS __attribute__((address_space(4)))
#define KARGS() const CAS In* Ip = (const CAS In*)__builtin_amdgcn_kernarg_segment_ptr(); asm volatile("" : "+s"(Ip))
#define OPAQUE_TID() int tid_ = threadIdx.x; asm volatile("" : "+v"(tid_))
__device__ __forceinline__ void norm_phase(Frame& F, const float* x, const float* gain, bf16* xn) {
    OPAQUE_TID(); const int lane_ = tid_ & 63, wave_ = tid_ >> 6;
    const int gw = F.vcu * NWAVES + wave_, NGW = F.G * NWAVES;
    for (int m = gw; m < M; m += NGW) rms_row_to_bf16(x + (size_t)m * D, gain, xn + (size_t)m * D, lane_);
}

template <int DL>
__device__ __forceinline__ void coop_attend(const float (&q)[DL], const float (&k)[DL], const float (&v)[DL], float bias, float& m_, float& l_, float (&o)[DL]) {
    float a = 0.f;
#pragma unroll
    for (int d = 0; d < DL; ++d) a += q[d] * k[d];
    a = red16_sum(a) + bias;
    const float mn = fmaxf(m_, a), al = __expf(m_ - mn), p = __expf(a - mn);
    l_ = l_ * al + p; m_ = mn;
#pragma unroll
    for (int d = 0; d < DL; ++d) o[d] = o[d] * al + p * v[d];
}
__device__ __forceinline__ void ld4bf(const bf16* p, float (&x)[4]) { const uint2 u = *(const uint2*)p; x[0] = bflo(u.x); x[1] = bfhi(u.x); x[2] = bflo(u.y); x[3] = bfhi(u.y); }
__device__ __forceinline__ void ld8bf(const bf16* p, float (&x)[8]) { const uint4 u = *(const uint4*)p; x[0] = bflo(u.x); x[1] = bfhi(u.x); x[2] = bflo(u.y); x[3] = bfhi(u.y); x[4] = bflo(u.z); x[5] = bfhi(u.z); x[6] = bflo(u.w); x[7] = bfhi(u.w); }
__device__ __forceinline__ void ld4f(const float* p, float (&x)[4]) { const float4 u = *(const float4*)p; x[0] = u.x; x[1] = u.y; x[2] = u.z; x[3] = u.w; }

struct In {
    const float *x, *mem, *rel_bias, *norm_mix, *norm_ffn, *norm_mem, *w_mem_kv, *w_out, *ffn_gate, *ffn_up, *ffn_down, *nsa_w_in, *nsa_gate_b, *pos_k, *pos_v,
        *k_w1, *k_b1, *k_w2, *k_b2, *v_w1, *v_b1, *v_w2, *v_b2, *dsa_w_in, *q_norm, *kv_norm, *w_q_up, *w_uk, *w_uv, *w_q_idx, *kidx_norm, *norm_final;
};
__device__ __forceinline__ void p0_prologue(Frame& F, const In& I, unsigned char* ws) {
    OPAQUE_TID(); KARGS(); const int lane_ = tid_ & 63, wave_ = __builtin_amdgcn_readfirstlane(tid_ >> 6);
    LAS float* scr = (LAS float*)(F.lds + RING_OFF + wave_ * 16384);
    const int gw = F.vcu * NWAVES + wave_, NGW = F.G * NWAVES;
    bf16* WIN0 = (bf16*)(ws + WS_WIN0); bf16* WO = (bf16*)(ws + WS_WO); bf16* WGU = (bf16*)(ws + WS_WGU); bf16* WD = (bf16*)(ws + WS_WD); bf16* WIN1 = (bf16*)(ws + WS_WIN1); bf16* WQ2 = (bf16*)(ws + WS_WQ2);
    constexpr int I_A = 16 * 56, I_G = 16 * 8, I_B = 2 * 16 * 32, I_C = 2 * 16 * 176, I_D = 2 * 44 * 32, I_E = 16 * 24, I_F = 4 * 16, NITEMS = I_A + I_B + I_C + I_D + I_E + I_F + I_G;
    for (int it = gw; it < NITEMS; it += NGW) {
        int r = it;
        if (r < I_A) { const int kb = r / 56, nb = r % 56, r0 = 32 * nb; int c0, nv;
            if (r0 < 1152) { c0 = r0; nv = 32; } else if (r0 < 1280) { c0 = r0 + 128; nv = 32; } else if (r0 < 1536) { c0 = r0 + 292; nv = 32; } else if (r0 == 1536) { c0 = 1536; nv = 32; } else if (r0 == 1568) { c0 = 1568; nv = 4; } else { c0 = 0; nv = 0; }
            xpose_item(Ip->nsa_w_in, NSA_IN, c0, nv, 64 * kb, WIN0, D, r0, scr, lane_); continue; } r -= I_A;
        if (r < I_B) { const int l = r / 512, q = r % 512, kb = q / 32, nb = q % 32;
            xpose_item(Ip->w_out + (size_t)l * D * D, D, 32 * nb, 32, 64 * kb, WO + (size_t)l * D * D, D, 32 * nb, scr, lane_); continue; } r -= I_B;
        if (r < I_C) { const int l = r / (16 * 176), q = r % (16 * 176), kb = q / 176, nb = q % 176, r0 = 32 * nb, pn = r0 >> 8, w0 = r0 & 255;
            const float* src = ((w0 < 128) ? Ip->ffn_gate : Ip->ffn_up) + (size_t)l * D * DFF;
            xpose_item(src, DFF, 128 * pn + (w0 & 127), 32, 64 * kb, WGU + (size_t)l * 2 * DFF * D, D, r0, scr, lane_, Ip->norm_ffn + l * D); continue; } r -= I_C;
        if (r < I_D) { const int l = r / (44 * 32), q = r % (44 * 32), kb = q / 32, nb = q % 32;
            xpose_item(Ip->ffn_down + (size_t)l * DFF * D, D, 32 * nb, 32, 64 * kb, WD + (size_t)l * D * DFF, DFF, 32 * nb, scr, lane_); continue; } r -= I_D;
        if (r < I_E) { const int kb = r / 24, nb = r % 24, r0 = 32 * nb; int nv = DSA_IN - r0; nv = nv > 32 ? 32 : (nv < 0 ? 0 : nv);
            xpose_item(Ip->dsa_w_in, DSA_IN, r0, nv, 64 * kb, WIN1, D, r0, scr, lane_, Ip->norm_mix + D); continue; } r -= I_E;
        if (r < I_F) { const int kb = r / 16, nb = r % 16; xpose_item(Ip->w_q_idx, 512, 32 * nb, 32, 64 * kb, WQ2, 256, 1536 + 32 * nb, scr, lane_); continue; } r -= I_F;
        { const int kb = r / 8, nb = r % 8, r0 = 32 * nb;
            xpose_item(Ip->nsa_w_in, NSA_IN, (r0 < 128) ? 1152 + r0 : 1408 + (r0 - 128), 32, 64 * kb, (bf16*)(ws + WS_WVT), D, r0, scr, lane_); }
    }
    for (int idx = (F.vcu * NWAVES * 64) + tid_; idx < 384 * 256; idx += F.G * NWAVES * 64) {
        const int c = idx & 255, r4 = (idx >> 8) & 31, h = idx >> 13; const float4* a4 = (const float4*)(Ip->w_q_up + (size_t)c * 768 + h * 64); const float4* b4 = (const float4*)(Ip->w_uk + (size_t)(4 * r4) * 768 + h * 64);
        float s0 = 0.f, s1 = 0.f, s2 = 0.f, s3 = 0.f;
#pragma unroll 4
        for (int d = 0; d < 16; ++d) { const float4 av = a4[d], b0 = b4[d], b1 = b4[192 + d], b2 = b4[384 + d], b3 = b4[576 + d];
            s0 += (av.x * b0.x + av.y * b0.y) + (av.z * b0.z + av.w * b0.w); s1 += (av.x * b1.x + av.y * b1.y) + (av.z * b1.z + av.w * b1.w);
            s2 += (av.x * b2.x + av.y * b2.y) + (av.z * b2.z + av.w * b2.w); s3 += (av.x * b3.x + av.y * b3.y) + (av.z * b3.z + av.w * b3.w); }
        const float sc_ = 0.125f * 1.4426950408889634f;
        bf16* o_ = WQ2 + (size_t)(h * 128 + 4 * r4) * 256 + c;
        o_[0] = (bf16)f2bf(s0 * sc_); o_[256] = (bf16)f2bf(s1 * sc_); o_[512] = (bf16)f2bf(s2 * sc_); o_[768] = (bf16)f2bf(s3 * sc_);
    }
    { bf16* WO1F = (bf16*)(ws + WS_WO1F); const float* wo1 = Ip->w_out + (size_t)D * D;
      for (int idx = (F.vcu * NWAVES * 64) + tid_; idx < 12 * 32 * 256; idx += F.G * NWAVES * 64) {
          const int n4 = idx & 255, r4 = (idx >> 8) & 31, h = idx >> 13; const float* a = Ip->w_uv + (size_t)(4 * r4) * 768 + h * 64; const float* bcol = wo1 + (size_t)(h * 64) * D + 4 * n4;
          float acc_[4][4];
#pragma unroll
          for (int i = 0; i < 4; ++i)
#pragma unroll
              for (int j = 0; j < 4; ++j) acc_[i][j] = 0.f;
#pragma unroll 4
          for (int d = 0; d < 64; ++d) { const float4 bv = *(const float4*)(bcol + (size_t)d * D); const float a0 = a[d], a1 = a[768 + d], a2 = a[1536 + d], a3 = a[2304 + d];
              acc_[0][0] += a0 * bv.x; acc_[0][1] += a0 * bv.y; acc_[0][2] += a0 * bv.z; acc_[0][3] += a0 * bv.w; acc_[1][0] += a1 * bv.x; acc_[1][1] += a1 * bv.y; acc_[1][2] += a1 * bv.z; acc_[1][3] += a1 * bv.w;
              acc_[2][0] += a2 * bv.x; acc_[2][1] += a2 * bv.y; acc_[2][2] += a2 * bv.z; acc_[2][3] += a2 * bv.w; acc_[3][0] += a3 * bv.x; acc_[3][1] += a3 * bv.y; acc_[3][2] += a3 * bv.z; acc_[3][3] += a3 * bv.w; }
#pragma unroll
          for (int j = 0; j < 4; ++j) *(uint2*)(WO1F + (size_t)(4 * n4 + j) * 1792 + h * 128 + 4 * r4) = make_uint2(pk2(acc_[0][j], acc_[1][j]), pk2(acc_[2][j], acc_[3][j])); }
      for (int it = gw; it < 4 * 32; it += NGW) { const int kb = it / 32, nb = it % 32;
          xpose_item(wo1 + (size_t)768 * D, D, 32 * nb, 32, 64 * kb, WO1F + 1536, 1792, 32 * nb, scr, lane_); } }
    { bf16* W1T = (bf16*)(ws + WS_W1T); bf16* W2T = (bf16*)(ws + WS_W2T); bf16* WMKT = (bf16*)(ws + WS_WMKT); float* B1F = (float*)(ws + WS_B1F); bf16* MEMN = (bf16*)(ws + WS_MEMN);
      constexpr int J_1 = 2 * 32 * 8, J_2 = 2 * 4 * 2, J_M = 2 * 16 * 16;
      for (int it = gw; it < J_1 + J_2 + J_M; it += NGW) { int r2 = it;
          if (r2 < J_1) { const int kv = r2 / 256, q = r2 % 256, kb = q / 8, nb = q % 8; xpose_item(kv ? Ip->v_w1 : Ip->k_w1, 256, 32 * nb, 32, 64 * kb, W1T + (size_t)kv * 256 * 2048, 2048, 32 * nb, scr, lane_); continue; } r2 -= J_1;
          if (r2 < J_2) { const int kv = r2 / 8, q = r2 % 8, kb = q / 2, nb = q % 2; xpose_item(kv ? Ip->v_w2 : Ip->k_w2, 64, 32 * nb, 32, 64 * kb, W2T + (size_t)kv * 64 * 256, 256, 32 * nb, scr, lane_); continue; } r2 -= J_2;
          { const int l = r2 / 256, q = r2 % 256, kb = q / 16, nb = q % 16; xpose_item(Ip->w_mem_kv + (size_t)l * D * 512, 512, 32 * nb, 32, 64 * kb, WMKT + (size_t)l * 512 * D, D, 32 * nb, scr, lane_); } }
      if ((int)blockIdx.x < 32) { const int u_ = (int)blockIdx.x, kv = u_ >> 4, cr = (u_ >> 2) & 3, kq4 = u_ & 3, c = 64 * cr + lane_; const float* w1 = kv ? Ip->v_w1 : Ip->k_w1; const float* pos = kv ? Ip->pos_v : Ip->pos_k;
          const int kb0 = 512 * kq4 + 64 * wave_; float sacc = 0.f;
#pragma unroll 8
          for (int k = 0; k < 64; ++k) sacc += pos[kb0 + k] * w1[(size_t)(kb0 + k) * 256 + c];
          LAS float* red = (LAS float*)(F.lds + RING_OFF + 8 * 16384);
          red[wave_ * 64 + lane_] = sacc;
          __syncthreads();
          if (wave_ == 0) { float t_ = 0.f;
#pragma unroll
              for (int w = 0; w < 8; ++w) t_ += red[w * 64 + lane_];
              B1F[(kv * 4 + kq4) * 256 + c] = t_; } }
      for (int m = gw; m < 1024; m += NGW) rms_row_to_bf16(Ip->mem + (size_t)(m & 511) * D, Ip->norm_mem + (m >> 9) * D, MEMN + (size_t)m * D, lane_); }
    norm_phase(F, Ip->x, Ip->norm_mix, (bf16*)(ws + WS_XN));
}

#define MFMA16(A, B, C) __builtin_amdgcn_mfma_f32_16x16x32_bf16((A), (B), (C), 0, 0, 0)
constexpr float LOG2E = 1.4426950408889634f;
constexpr int NSA_OUT = 0, NSA_PSQ = 49152, NSA_ST = 147456, NSA_TB = NSA_ST + 3072;
constexpr int TAB_B12 = NSA_ST + 1024;
constexpr int P13_JUNK = NSA_ST + 3072 + 1536;
constexpr int P13_B12 = NSA_ST;
constexpr int TAB_BKT = NSA_ST + 3072;
static_assert(NSA_TB + 12288 <= LDSCTL_OFF && TAB_B12 + 2048 <= NSA_TB, "LDS tables");
enum { MD_CMP = 0, MD_WIN = 1, MD_BLK = 2, MD_MEM = 3 };
struct KF { bf16x8 a0, a1, b0, b1; };
struct VF { bf16x8 v[4]; };
__device__ __forceinline__ bf16x8 ldg16(const bf16* p) { return *(const bf16x8*)p; }
typedef float f32x2_t __attribute__((ext_vector_type(2))); typedef __bf16 bf16x2_t __attribute__((ext_vector_type(2)));
__device__ __forceinline__ unsigned cvtpk_s(float lo, float hi) { f32x2_t v = {lo, hi}; bf16x2_t b = __builtin_convertvector(v, bf16x2_t); return __builtin_bit_cast(unsigned, b); }
__device__ __forceinline__ bf16x8 pack8(const f32x4& a, const f32x4& b) { v4u w; w.x = cvtpk_s(a[0], a[1]); w.y = cvtpk_s(a[2], a[3]); w.z = cvtpk_s(b[0], b[1]); w.w = cvtpk_s(b[2], b[3]); return __builtin_bit_cast(bf16x8, w); }
__device__ __forceinline__ void load_k(KF& k, const bf16* kb, int kstride, int key0, int r, int kq) {
    const bf16* pa = kb + (size_t)(key0 + 8 * (r >> 2) + (r & 3)) * kstride + 8 * kq; const bf16* pb = pa + 4 * (size_t)kstride;
    k.a0 = ldg16(pa); k.a1 = ldg16(pa + 32); k.b0 = ldg16(pb); k.b1 = ldg16(pb + 32);
}
__device__ __forceinline__ void load_vt(VF& v, const bf16* vt, int vstride, int key0, int r, int kq) {
#pragma unroll
    for (int dt = 0; dt < 4; ++dt) v.v[dt] = ldg16(vt + (size_t)(16 * dt + r) * vstride + key0 + 8 * kq);
}
__device__ __forceinline__ void qk(f32x4& sa, f32x4& sb, const KF& k, const bf16x8 (&q)[2]) {
    const f32x4 z = {0.f, 0.f, 0.f, 0.f};
    sa = MFMA16(k.a0, q[0], z); sa = MFMA16(k.a1, q[1], sa); sb = MFMA16(k.b0, q[0], z); sb = MFMA16(k.b1, q[1], sb);
}
struct BiasCtx { const LAS unsigned short* tb; float d29, d30, c31; };
template <int MODE>
__device__ __forceinline__ void maskbias(f32x4& s, int kpos, int tcol, bool colok, const BiasCtx& B) {
    if (MODE == MD_MEM) return;
#pragma unroll
    for (int i = 0; i < 4; ++i) {
        int dist; bool ok;
        if (MODE == MD_CMP) { dist = tcol - 31 - 16 * (kpos + i); ok = dist >= 0; }
        else if (MODE == MD_WIN) { dist = tcol - (kpos + i); ok = (unsigned)dist <= 511u; }
        else { dist = tcol - (kpos + i); ok = dist >= 0; }
        int dc = dist < 0 ? 0 : dist; dc = dc > 1023 ? 1023 : dc;
        const float tb = __uint_as_float((unsigned)B.tb[dc * 6] << 16);
        const float far = B.c31 + (dist < 1513 ? B.d30 : 0.f) + (dist < 1117 ? B.d29 : 0.f);
        const float bias = dist < 1024 ? tb : far;
        s[i] = (ok && colok) ? s[i] + bias : -INFINITY;
    }
}
__device__ __forceinline__ float colmax(const f32x4& sa, const f32x4& sb) {
    float mx = fmaxf(fmaxf(fmaxf(sa[0], sa[1]), fmaxf(sa[2], sa[3])), fmaxf(fmaxf(sb[0], sb[1]), fmaxf(sb[2], sb[3])));
    mx = fmaxf(mx, __shfl_xor(mx, 16)); mx = fmaxf(mx, __shfl_xor(mx, 32)); return mx;
}
constexpr float SM_THR = 8.f;
__device__ __forceinline__ float lmax8(const f32x4& sa, const f32x4& sb) { return fmaxf(fmaxf(fmaxf(sa[0], sa[1]), fmaxf(sa[2], sa[3])), fmaxf(fmaxf(sb[0], sb[1]), fmaxf(sb[2], sb[3]))); }
__device__ __forceinline__ int imax3(int a, int b, int c) { return max(max(a, b), c); }
__device__ __forceinline__ int imax16(const f32x4& a, const f32x4& b, const f32x4& c, const f32x4& d) {
#define FI_(x) __float_as_int(x)
    const int t0 = imax3(FI_(a[0]), FI_(a[1]), FI_(a[2])), t1 = imax3(FI_(a[3]), FI_(b[0]), FI_(b[1])), t2 = imax3(FI_(b[2]), FI_(b[3]), FI_(c[0])), t3 = imax3(FI_(c[1]), FI_(c[2]), FI_(c[3])), t4 = imax3(FI_(d[0]), FI_(d[1]), FI_(d[2]));
    return max(imax3(t0, t1, FI_(d[3])), imax3(t2, t3, t4));
#undef FI_
}
template <int NO>
__device__ __forceinline__ void sm_rescale(float lm, float& m, float& l, f32x4 (&O)[NO]) {
    if (__any(lm > m + SM_THR)) {
        lm = fmaxf(lm, __shfl_xor(lm, 16)); lm = fmaxf(lm, __shfl_xor(lm, 32));
        const float mn = fmaxf(m, lm); const float al = __builtin_amdgcn_exp2f(m - mn); m = mn; l *= al;
#pragma unroll
        for (int dt = 0; dt < NO; ++dt) O[dt] = O[dt] * al;
    }
}
__device__ __forceinline__ bf16x8 sm_update(const f32x4& sa, const f32x4& sb, float& m, float& l, f32x4 (&O)[4]) {
    sm_rescale<4>(lmax8(sa, sb), m, l, O);
    f32x4 pa, pb; float sum = 0.f;
#pragma unroll
    for (int i = 0; i < 4; ++i) { pa[i] = __builtin_amdgcn_exp2f(sa[i] - m); pb[i] = __builtin_amdgcn_exp2f(sb[i] - m); sum += pa[i] + pb[i]; }
    l += sum;
    return pack8(pa, pb);
}
__device__ __forceinline__ void sm_update64(const f32x4& sa0, const f32x4& sb0, const f32x4& sa1, const f32x4& sb1, float& m, float& l, f32x4 (&O)[4], bf16x8& pf0, bf16x8& pf1) {
    sm_rescale<4>(fmaxf(lmax8(sa0, sb0), lmax8(sa1, sb1)), m, l, O);
    f32x4 pa0, pb0, pa1, pb1; float sum = 0.f;
#pragma unroll
    for (int i = 0; i < 4; ++i) { pa0[i] = __builtin_amdgcn_exp2f(sa0[i] - m); pb0[i] = __builtin_amdgcn_exp2f(sb0[i] - m); pa1[i] = __builtin_amdgcn_exp2f(sa1[i] - m); pb1[i] = __builtin_amdgcn_exp2f(sb1[i] - m);
        sum += (pa0[i] + pb0[i]) + (pa1[i] + pb1[i]); }
    l += sum;
    pf0 = pack8(pa0, pb0); pf1 = pack8(pa1, pb1);
}
enum { BK_FAR = 0, BK_MID = 1, BK_GEN = 2 };
template <int MD, int CLS>
__device__ __forceinline__ void step64(const KF& k0, const KF& k1, const bf16x8 (&q)[2], int cls, int kpos, int tcol, bool colok, const BiasCtx& B,
                                       float& m, float& l, f32x4 (&O)[4], bf16x8& pf0, bf16x8& pf1) {
    const bool has = m > -1e29f; const float mref = has ? m : 0.f;
    if (CLS >= 0) cls = CLS;
    float cin = ((cls == BK_FAR) ? B.c31 : 0.f) - mref; if (!colok) cin = -INFINITY;
    const f32x4 c4 = {cin, cin, cin, cin};
    f32x4 sa0 = MFMA16(k0.a0, q[0], c4), sb0 = MFMA16(k0.b0, q[0], c4), sa1 = MFMA16(k1.a0, q[0], c4), sb1 = MFMA16(k1.b0, q[0], c4);
    sa0 = MFMA16(k0.a1, q[1], sa0); sb0 = MFMA16(k0.b1, q[1], sb0); sa1 = MFMA16(k1.a1, q[1], sa1); sb1 = MFMA16(k1.b1, q[1], sb1);
    if (cls == BK_MID) {
        const LAS unsigned short* tl = B.tb + (tcol - kpos - 39) * 6;
#pragma unroll
        for (int i = 0; i < 4; ++i) { sa0[i] += __uint_as_float((unsigned)tl[6 * (39 - i)] << 16); sb0[i] += __uint_as_float((unsigned)tl[6 * (35 - i)] << 16);
            sa1[i] += __uint_as_float((unsigned)tl[6 * (7 - i)] << 16); sb1[i] += __uint_as_float((unsigned)tl[6 * (3 - i)] << 16); }
    } else if (cls == BK_GEN) {
        maskbias<MD>(sa0, kpos, tcol, true, B); maskbias<MD>(sb0, kpos + 4, tcol, true, B); maskbias<MD>(sa1, kpos + 32, tcol, true, B); maskbias<MD>(sb1, kpos + 36, tcol, true, B);
    }
    if (__any((imax16(sa0, sb0, sa1, sb1) > __float_as_int(SM_THR)) || !has)) {
        float lm = fmaxf(lmax8(sa0, sb0), lmax8(sa1, sb1));
        lm = fmaxf(lm, __shfl_xor(lm, 16)); lm = fmaxf(lm, __shfl_xor(lm, 32));
        const bool upd = (lm > -INFINITY) && (!has || lm > 0.f); const float dl = upd ? lm : 0.f;
        if (upd) m = mref + dl;
        const float f = has ? __builtin_amdgcn_exp2f(-dl) : 1.f; l *= f;
#pragma unroll
        for (int dt = 0; dt < 4; ++dt) O[dt] = O[dt] * f;
#pragma unroll
        for (int i = 0; i < 4; ++i) { sa0[i] -= dl; sb0[i] -= dl; sa1[i] -= dl; sb1[i] -= dl; }
    }
    f32x4 pa0, pb0, pa1, pb1; float sum = 0.f;
#pragma unroll
    for (int i = 0; i < 4; ++i) { pa0[i] = __builtin_amdgcn_exp2f(sa0[i]); pb0[i] = __builtin_amdgcn_exp2f(sb0[i]); pa1[i] = __builtin_amdgcn_exp2f(sa1[i]); pb1[i] = __builtin_amdgcn_exp2f(sb1[i]);
        sum += (pa0[i] + pb0[i]) + (pa1[i] + pb1[i]); }
    l += sum;
    pf0 = pack8(pa0, pb0); pf1 = pack8(pa1, pb1);
}
__device__ __forceinline__ void pv(f32x4 (&O)[4], const VF& v, const bf16x8& pf) {
#pragma unroll
    for (int dt = 0; dt < 4; ++dt) O[dt] = MFMA16(v.v[dt], pf, O[dt]);
}
__device__ __forceinline__ void lds_fadd(LAS float* p, float v) { (void)__hip_atomic_fetch_add((float*)p, v, __ATOMIC_RELAXED, __HIP_MEMORY_SCOPE_WORKGROUP); }
#define DPP_I(x, ctrl) __builtin_amdgcn_update_dpp((x), (x), (ctrl), 0xf, 0xf, false)
#define DPP_F(x, ctrl) __int_as_float(__builtin_amdgcn_update_dpp(__float_as_int(x), __float_as_int(x), (ctrl), 0xf, 0xf, false))
__device__ __forceinline__ float sum8_dpp(float v) { v += DPP_F(v, 0xB1); v += DPP_F(v, 0x4E); v += DPP_F(v, 0x141); return v; }
__device__ __forceinline__ unsigned wave_iscan_u32(unsigned x) {
#define DPP_Z(v, ctrl, rmask) (unsigned)__builtin_amdgcn_update_dpp(0, (int)(v), (ctrl), (rmask), 0xf, false)
    x += DPP_Z(x, 0x111, 0xf); x += DPP_Z(x, 0x112, 0xf); x += DPP_Z(x, 0x114, 0xf); x += DPP_Z(x, 0x118, 0xf); x += DPP_Z(x, 0x142, 0xa); x += DPP_Z(x, 0x143, 0xc);
#undef DPP_Z
    return x; }
__device__ __forceinline__ int wmax64_i(int x) {
    x = max(x, DPP_I(x, 0xB1)); x = max(x, DPP_I(x, 0x4E)); x = max(x, DPP_I(x, 0x141)); x = max(x, DPP_I(x, 0x140));
    return max(max(__builtin_amdgcn_readlane(x, 0), __builtin_amdgcn_readlane(x, 16)), max(__builtin_amdgcn_readlane(x, 32), __builtin_amdgcn_readlane(x, 48))); }
__device__ __forceinline__ float kqsum(float v) { v += __shfl_xor(v, 16); v += __shfl_xor(v, 32); return v; }
__device__ __forceinline__ float wmax64(float v) {
#pragma unroll
    for (int o = 1; o < 64; o <<= 1) v = fmaxf(v, __shfl_xor(v, o));
    return v;
}
__device__ __forceinline__ void out_add(LAS unsigned short* OUTw, int p, int n, int kq, const f32x4 (&O)[4], float scale, bool first) {
    const int q = 2 * p + (n >> 3), hd = n & 7;
    if (hd < 6) { LAS v2u* dst = (LAS v2u*)(OUTw + (q * 6 + hd) * 64) + kq;
#pragma unroll
        for (int dt = 0; dt < 4; ++dt) { f32x4 v = O[dt] * scale; if (!first) { const v2u o = dst[4 * dt]; v[0] += __uint_as_float(o.x << 16); v[1] += __uint_as_float(o.x & 0xffff0000u); v[2] += __uint_as_float(o.y << 16); v[3] += __uint_as_float(o.y & 0xffff0000u); }
            dst[4 * dt] = (v2u){pk2(v[0], v[1]), pk2(v[2], v[3])}; } }
}

__device__ __forceinline__ void p2_mfma(Frame& F, const In& I, unsigned char* ws) {
    OPAQUE_TID(); KARGS(); const int lane = tid_ & 63, wave = __builtin_amdgcn_readfirstlane(tid_ >> 6), r = lane & 15, kq = lane >> 4;
    const bf16* KV0 = (const bf16*)(ws + WS_KV0); const bf16* W1T = (const bf16*)(ws + WS_W1T); const bf16* W2T = (const bf16*)(ws + WS_W2T); const float* B1F = (const float*)(ws + WS_B1F);
    const bf16* MEMN = (const bf16*)(ws + WS_MEMN); const bf16* WMKT = (const bf16*)(ws + WS_WMKT);
    bf16* KCB = (bf16*)(ws + WS_KCB); bf16* VCT = (bf16*)(ws + WS_VCT); bf16* MKB = (bf16*)(ws + WS_MKB); bf16* MVT = (bf16*)(ws + WS_MVT);
    LAS unsigned char* hid = F.lds + RING_OFF;
    for (int u = blockIdx.x; u < 192; u += F.G) {
        const bool cmp = u < 128;
        const bf16* ap[2]; const bf16* bp[2]; int K, kjump;
        int kv = 0, bg = 0, n0 = 0, lay = 0, m0 = 0, ch = 0;
        if (cmp) { kv = u >> 6; bg = (u >> 4) & 3; n0 = (u & 15) * 32; const int b = bg >> 1, g = bg & 1; K = 2048; kjump = 512 - 64;
#pragma unroll
            for (int rt = 0; rt < 2; ++rt) { int nn = n0 + 16 * rt + r; nn = nn > 510 ? 510 : nn; ap[rt] = KV0 + (size_t)(b * T + 16 * nn) * 512 + kv * 128 + g * 64 + 8 * kq; }
#pragma unroll
            for (int ct = 0; ct < 2; ++ct) bp[ct] = W1T + (size_t)(kv * 256 + 32 * wave + 16 * ct + r) * 2048 + 8 * kq;
        } else { const int v = u - 128; lay = v >> 5; m0 = ((v >> 1) & 15) * 32; ch = v & 1; K = 1024; kjump = 0;
#pragma unroll
            for (int rt = 0; rt < 2; ++rt) ap[rt] = MEMN + (size_t)(lay * 512 + m0 + 16 * rt + r) * 1024 + 8 * kq;
#pragma unroll
            for (int ct = 0; ct < 2; ++ct) bp[ct] = WMKT + (size_t)(lay * 512 + ch * 256 + 32 * wave + 16 * ct + r) * 1024 + 8 * kq;
        }
        f32x4 acc[2][2];
#pragma unroll
        for (int rt = 0; rt < 2; ++rt)
#pragma unroll
            for (int ct = 0; ct < 2; ++ct) acc[rt][ct] = (f32x4){0.f, 0.f, 0.f, 0.f};
        bf16x8 a[2][2], bb[2][2];
#define P2_LOAD(A_, B_, kb_) do { const int kbl_ = (kb_) < K ? (kb_) : K - 64; const int ao_ = kbl_ + (kbl_ >> 6) * kjump; \
            _Pragma("unroll") for (int h2 = 0; h2 < 2; ++h2) { \
                _Pragma("unroll") for (int rt = 0; rt < 2; ++rt) A_[rt][h2] = ldg16(ap[rt] + ao_ + 32 * h2); \
                _Pragma("unroll") for (int ct = 0; ct < 2; ++ct) B_[ct][h2] = ldg16(bp[ct] + kbl_ + 32 * h2); } } while (0)
        P2_LOAD(a, bb, 0);
        for (int kb = 0; kb < K; kb += 64) {
            bf16x8 an[2][2], bn[2][2]; P2_LOAD(an, bn, kb + 64);
#pragma unroll
            for (int h2 = 0; h2 < 2; ++h2)
#pragma unroll
                for (int rt = 0; rt < 2; ++rt)
#pragma unroll
                    for (int ct = 0; ct < 2; ++ct) acc[rt][ct] = MFMA16(a[rt][h2], bb[ct][h2], acc[rt][ct]);
#pragma unroll
            for (int h2 = 0; h2 < 2; ++h2)
#pragma unroll
                for (int x = 0; x < 2; ++x) { a[x][h2] = an[x][h2]; bb[x][h2] = bn[x][h2]; }
        }
#undef P2_LOAD
        if (cmp) {
#pragma unroll
            for (int ct = 0; ct < 2; ++ct) { const int col = 32 * wave + 16 * ct + r; const float bias = (kv ? Ip->v_b1 : Ip->k_b1)[col] + ((B1F[(kv * 4 + 0) * 256 + col] + B1F[(kv * 4 + 1) * 256 + col]) + (B1F[(kv * 4 + 2) * 256 + col] + B1F[(kv * 4 + 3) * 256 + col]));
#pragma unroll
                for (int rt = 0; rt < 2; ++rt)
#pragma unroll
                    for (int i = 0; i < 4; ++i) { const float xg = acc[rt][ct][i] + bias; const float hv = 0.5f * xg * (1.f + tanhf(0.7978845608028654f * (xg + 0.044715f * xg * xg * xg)));
                        *(LAS unsigned short*)(hid + (16 * rt + 4 * kq + i) * 528 + 2 * col) = (unsigned short)f2bf(hv); } }
            __syncthreads();
            { const int rt2 = wave >> 2, ct2 = wave & 3; f32x4 o = {0.f, 0.f, 0.f, 0.f};
              const bf16* w2p = W2T + (size_t)(kv * 64 + 16 * ct2 + r) * 256 + 8 * kq;
#pragma unroll
              for (int ks = 0; ks < 8; ++ks) { const bf16x8 av = *(const LAS bf16x8*)(hid + (16 * rt2 + r) * 528 + 64 * ks + 16 * kq); o = MFMA16(av, ldg16(w2p + 32 * ks), o); }
              const int d = 16 * ct2 + r; const float b2v = (kv ? Ip->v_b2 : Ip->k_b2)[d];
#pragma unroll
              for (int i = 0; i < 4; ++i) { const int nn = n0 + 16 * rt2 + 4 * kq + i; const unsigned short ov = (nn < NCMP) ? (unsigned short)f2bf(o[i] + b2v) : (unsigned short)0;
                  if (kv) VCT[(size_t)(bg * 64 + d) * 512 + nn] = ov; else KCB[(size_t)(bg * 512 + nn) * 64 + d] = ov; } }
            __syncthreads();
        } else {
#pragma unroll
            for (int ct = 0; ct < 2; ++ct) { const int col = 32 * wave + 16 * ct + r;
#pragma unroll
                for (int rt = 0; rt < 2; ++rt)
#pragma unroll
                    for (int i = 0; i < 4; ++i) { const int mrow = m0 + 16 * rt + 4 * kq + i; const unsigned short ov = (unsigned short)f2bf(acc[rt][ct][i]);
                        if (ch == 0) MKB[(size_t)(lay * 512 + mrow) * 256 + col] = ov; else MVT[(size_t)(lay * 256 + col) * 512 + mrow] = ov; } }
        }
    }
}

template <int MODE>
__device__ __forceinline__ void mb2(f32x4& sa, f32x4& sb, int kpos, int tcol, bool colok, bool fast, const BiasCtx& B) {
    if (fast) { if (colok) { sa = sa + B.c31; sb = sb + B.c31; } else { sa = (f32x4){-INFINITY, -INFINITY, -INFINITY, -INFINITY}; sb = sa; } }
    else { maskbias<MODE>(sa, kpos, tcol, colok, B); maskbias<MODE>(sb, kpos + 4, tcol, colok, B); }
}
#define SWZ(row) (((((row) >> 3) & 3) << 1) | (((row) >> 1) & 1))
struct KV1 { KF k; VF v; };
__device__ __forceinline__ void load_kv(KV1& d, const bf16* kb, int kstride, const bf16* vt, int vstride, int key0, int r, int kq) { load_k(d.k, kb, kstride, key0, r, kq); load_vt(d.v, vt, vstride, key0, r, kq); }

template <int MD, int FORCE = 0>
__device__ __forceinline__ void nsa_sweep(LAS unsigned char* STG, const bf16* ksb, const bf16* vst, int jlo, int jhi, int qt, const LAS unsigned* WMw, int wave, int lane, int r, int kq, int qsel, int t0w,
                                          const bf16x8 (&qf)[4][2], const BiasCtx& BC, float (&m)[4], float (&l)[4], f32x4 (&O)[4][4],
                                          int kstr = 512, int kblk = 64 * 512, int vstr = 64, int vblk = 16384) {
            const int srow = 8 * wave + (lane >> 3), sch = (lane & 7) ^ SWZ(srow);
            const bf16* ksrc = ksb + (size_t)srow * kstr + 8 * sch; const bf16* vsrc = vst + (size_t)srow * vstr + 8 * sch;
#define NSA_DMA(jb) do { LAS unsigned char* d_ = STG + ((jb) % 6) * 16384 + wave * 1024; \
                __builtin_amdgcn_global_load_lds((const unsigned*)(ksrc + (size_t)(jb) * kblk), (LAS unsigned*)d_, 16, 0, 0); \
                __builtin_amdgcn_global_load_lds((const unsigned*)(vsrc + (size_t)(jb) * vblk), (LAS unsigned*)(d_ + 8192), 16, 0, 0); } while (0)
#define NSA_WAITV(n_) do { if ((n_) >= 4) asm volatile("s_waitcnt vmcnt(4) lgkmcnt(0)" ::: "memory"); else if ((n_) == 2) asm volatile("s_waitcnt vmcnt(2) lgkmcnt(0)" ::: "memory"); else asm volatile("s_waitcnt vmcnt(0) lgkmcnt(0)" ::: "memory"); } while (0)
            { const int nb = jhi - jlo + 1;
#pragma unroll
              for (int i = 0; i < 4; ++i) if (i < nb) NSA_DMA(jlo + i);
              const int issued = nb < 4 ? nb : 4, need = nb < 2 ? nb : 2; NSA_WAITV(2 * (issued - need)); }
            __builtin_amdgcn_s_barrier();
#define NSA_TILES(CLS_) _Pragma("unroll") for (int p = 0; p < 4; ++p) if (m8 & (3u << (2 * p))) { \
                        bf16x8 pf0, pf1; \
                        step64<MD, CLS_>(k0, k1, qf[p], cls, 64 * j + 8 * kq_, t0w + 2 * p + qs_, ((m8 >> (2 * p + qs_)) & 1u) != 0u, BC, m[p], l[p], O[p], pf0, pf1); \
                        pv(O[p], v0, pf0); pv(O[p], v1, pf1); \
                        __builtin_amdgcn_sched_barrier(0); }
            auto tiles = [&](auto clsx, int j) __attribute__((always_inline)) { constexpr int CLSX = decltype(clsx)::value;
                const LAS unsigned char* sk = STG + (j % 6) * 16384; const LAS unsigned char* sv = sk + 8192;
                unsigned m8 = 0xffu; if (WMw) m8 = (unsigned)__builtin_amdgcn_readfirstlane((int)((WMw[j >> 2] >> (8 * (j & 3))) & 0xffu)); if (FORCE == 1) m8 = 0u; if (FORCE == 2) m8 = 0xffu; if (MD == MD_MEM) m8 = 3u; else asm volatile("" : "+s"(m8));
                if (m8) {
                    int r_ = r, kq_ = kq, qs_ = qsel; asm volatile("" : "+v"(r_), "+v"(kq_), "+v"(qs_));
                    const int dj = qt - j; const int cls = (MD == MD_MEM) ? BK_FAR : (MD == MD_WIN) ? ((dj >= 1 && dj <= 7) ? BK_MID : BK_GEN) : ((64 * dj - 63 >= 1513) ? BK_FAR : ((dj >= 1 && dj <= 15) ? BK_MID : BK_GEN));
                    KF k0, k1;
                    { const int ka = 8 * (r_ >> 2) + (r_ & 3), kb2 = ka + 4, kc = ka + 32, kd = ka + 36;
                      k0.a0 = *(const LAS bf16x8*)(sk + ka * 128 + ((kq_ ^ SWZ(ka)) << 4)); k0.a1 = *(const LAS bf16x8*)(sk + ka * 128 + (((4 + kq_) ^ SWZ(ka)) << 4));
                      k0.b0 = *(const LAS bf16x8*)(sk + kb2 * 128 + ((kq_ ^ SWZ(kb2)) << 4)); k0.b1 = *(const LAS bf16x8*)(sk + kb2 * 128 + (((4 + kq_) ^ SWZ(kb2)) << 4));
                      k1.a0 = *(const LAS bf16x8*)(sk + kc * 128 + ((kq_ ^ SWZ(kc)) << 4)); k1.a1 = *(const LAS bf16x8*)(sk + kc * 128 + (((4 + kq_) ^ SWZ(kc)) << 4));
                      k1.b0 = *(const LAS bf16x8*)(sk + kd * 128 + ((kq_ ^ SWZ(kd)) << 4)); k1.b1 = *(const LAS bf16x8*)(sk + kd * 128 + (((4 + kq_) ^ SWZ(kd)) << 4)); }
                    VF v0, v1;
#pragma unroll
                    for (int dt = 0; dt < 4; ++dt) { const int dd = 16 * dt + r_; v0.v[dt] = *(const LAS bf16x8*)(sv + dd * 128 + ((kq_ ^ SWZ(dd)) << 4)); v1.v[dt] = *(const LAS bf16x8*)(sv + dd * 128 + (((4 + kq_) ^ SWZ(dd)) << 4)); }
                    NSA_TILES(CLSX)
                }
            };
            int ni = 0;
            auto blk = [&](auto clsx, int j) __attribute__((always_inline)) {
                const bool head = ((j - jlo) & 1) == 0;
                if (head) { ni = 0; if (j + 4 <= jhi) { NSA_DMA(j + 4); ni += 2; } if (j + 5 <= jhi) { NSA_DMA(j + 5); ni += 2; } }
                tiles(clsx, j);
                if (!head || j == jhi) { NSA_WAITV(ni); __builtin_amdgcn_s_barrier(); }
            };
            int j = jlo;
            if (MD == MD_BLK || MD == MD_MEM) { const int jfar = (MD == MD_MEM) ? jhi : ((qt - 25 < jhi) ? qt - 25 : jhi); const int jfe = jlo + (((jfar - jlo + 1) >> 1) << 1) - 1;
                for (; j <= jfe; ++j) blk(std::integral_constant<int, BK_FAR>{}, j); }
            for (; j <= jhi; ++j) blk(std::integral_constant<int, -1>{}, j);
#undef NSA_WAITV
#undef NSA_TILES
#undef NSA_DMA
}
__device__ __forceinline__ void p3_nsa_mfma(Frame& F, const In& I, unsigned char* ws) {
    OPAQUE_TID(); KARGS(); const int wave = __builtin_amdgcn_readfirstlane(tid_ >> 6);
    LAS float* b12 = (LAS float*)(F.lds + TAB_B12);
    LAS unsigned short* OUTw = (LAS unsigned short*)(F.lds + NSA_OUT) + wave * 3072;
    LAS float* PSw = (LAS float*)(F.lds + NSA_PSQ) + wave * 1024;
    LAS unsigned char* STG = F.lds + NSA_PSQ;
    LAS unsigned* WMw = (LAS unsigned*)(F.lds + NSA_ST) + wave * 32;
    for (int i = tid_; i < 512; i += NWAVES * 64) b12[i] = ((i & 15) < 12) ? Ip->rel_bias[(i >> 4) * 12 + (i & 15)] * LOG2E : 0.f;
    LAS unsigned short* TB = (LAS unsigned short*)(F.lds + NSA_TB);
    { const int gg = (int)blockIdx.x & 1;
      for (int i = tid_; i < 6144; i += NWAVES * 64) { const int dd = i / 6, hh = i % 6; TB[i] = (unsigned short)f2bf(Ip->rel_bias[rel_bucket(dd) * 12 + gg * 6 + hh] * LOG2E); } }
    __syncthreads();
    const bf16* Q0 = (const bf16*)(ws + WS_Q0); const bf16* KV0 = (const bf16*)(ws + WS_KV0); const bf16* QM = (const bf16*)(ws + WS_QM); const bf16* G0 = (const bf16*)(ws + WS_G0);
    const bf16* VT = (const bf16*)(ws + WS_VT); const bf16* KCB = (const bf16*)(ws + WS_KCB); const bf16* VCT = (const bf16*)(ws + WS_VCT);
    const bf16* MKB = (const bf16*)(ws + WS_MKB); const bf16* MVT = (const bf16*)(ws + WS_MVT);
    bf16* CAT = (bf16*)(ws + WS_CAT);
    const int nun = 4 * 128;
    for (int ui = blockIdx.x; ui < nun; ui += F.G) {
        int tl_ = tid_; asm volatile("" : "+v"(tl_));
        const int lane = tl_ & 63, n = lane & 15, kq = lane >> 4, r = n, hd = n & 7, qsel = n >> 3; const bool colv = hd < 6;
        int bg, qt;
        bg = blockIdx.x & 3;
        if (F.G == 256) { const int idx = blockIdx.x >> 2; qt = (ui < 256) ? idx : 127 - idx; }
        else { qt = ui >> 2; if ((ui & 3) != bg) continue; }
        const int b = bg >> 1, g = bg & 1, t0w = 64 * qt + 8 * wave, rowb = b * T;
        const int habs = g * 6 + (colv ? hd : 0);
        const LAS float* b12c = b12 + habs; const BiasCtx BC{TB + (colv ? hd : 0), b12c[29 * 16] - b12c[30 * 16], b12c[30 * 16] - b12c[31 * 16], b12c[31 * 16]};

        bf16x8 qf[4][2];
#pragma unroll
        for (int p = 0; p < 4; ++p) { const bf16* qp = Q0 + (size_t)(rowb + t0w + 2 * p + qsel) * 768 + habs * 64 + 8 * kq;
#pragma unroll
            for (int ks = 0; ks < 2; ++ks) { bf16x8 v = ldg16(qp + 32 * ks); if (!colv) v = (bf16x8){0, 0, 0, 0, 0, 0, 0, 0}; qf[p][ks] = v; } }
        float m[4], l[4]; f32x4 O[4][4];
        if (PROBE_REP == 6 || PROBE_REP == 7) {
            const bf16* ksb_ = KV0 + (size_t)rowb * 512 + 256 + g * 64; const bf16* vst_ = VT + ((size_t)(rowb >> 6) * 256 + g * 64) * 64;
#pragma unroll
            for (int p = 0; p < 4; ++p) { m[p] = -1e30f; l[p] = 0.f;
#pragma unroll
                for (int dt = 0; dt < 4; ++dt) O[p][dt] = (f32x4){0.f, 0.f, 0.f, 0.f}; }
            __syncthreads();
            nsa_sweep<MD_BLK, (PROBE_REP == 6 ? 2 : 1)>(STG, ksb_, vst_, 0, qt, qt, WMw, wave, lane, r, kq, qsel, t0w, qf, BC, m, l, O);
            float* dump = (float*)(ws + WS_OCS) + ((size_t)blockIdx.x * 512 + tid_) * 4;
#pragma unroll
            for (int p = 0; p < 4; ++p) dump[p] = l[p] + O[p][0][0] + O[p][1][1] + O[p][2][2] + O[p][3][3];
            __syncthreads(); }
        for (int i = lane; i < 1024; i += 64) PSw[i] = 0.f;
        const int ncmax = (t0w + 7 >= 31) ? ((t0w + 7 - 31) / 16 + 1) : 0;
        const bf16* kcb = KCB + (size_t)(bg * 512) * 64; const bf16* vct = VCT + (size_t)(bg * 64) * 512;
#pragma unroll
        for (int p = 0; p < 4; ++p) { m[p] = -1e30f; l[p] = 0.f; }
        if (ncmax > 0) {
            int r_ = r, kq_ = kq; asm volatile("" : "+v"(r_), "+v"(kq_));
            for (int key0 = 0; key0 < ncmax; key0 += 32) {
                asm volatile("" : "+v"(r_), "+v"(kq_));
                KF kA; load_k(kA, kcb, 64, key0, r_, kq_);
                const bool fast = (t0w - 31 - 16 * (key0 + 31)) >= 1513;
#pragma unroll
                for (int p = 0; p < 4; ++p) { f32x4 sa, sb; qk(sa, sb, kA, qf[p]); const int tcol = t0w + 2 * p + qsel;
                    mb2<MD_CMP>(sa, sb, key0 + 8 * kq_, tcol, true, fast, BC);
                    const float mn = fmaxf(m[p], lmax8(sa, sb)); float sum = 0.f;
#pragma unroll
                    for (int i = 0; i < 4; ++i) sum += __builtin_amdgcn_exp2f(sa[i] - mn) + __builtin_amdgcn_exp2f(sb[i] - mn);
                    l[p] = l[p] * __builtin_amdgcn_exp2f(m[p] - mn) + sum; m[p] = mn; __builtin_amdgcn_sched_barrier(0); }
            }
        }
        float invl[4];
#pragma unroll
        for (int p = 0; p < 4; ++p) { float mc = m[p]; mc = fmaxf(mc, __shfl_xor(mc, 16)); mc = fmaxf(mc, __shfl_xor(mc, 32));
            const float lt = kqsum(l[p] * __builtin_amdgcn_exp2f(m[p] - mc)); m[p] = mc; invl[p] = lt > 0.f ? 1.f / lt : 0.f; }
#pragma unroll
        for (int p = 0; p < 4; ++p)
#pragma unroll
            for (int dt = 0; dt < 4; ++dt) O[p][dt] = (f32x4){0.f, 0.f, 0.f, 0.f};
        float carry[4] = {0.f, 0.f, 0.f, 0.f};
        if (ncmax > 0) {
            int r_ = r, kq_ = kq; asm volatile("" : "+v"(r_), "+v"(kq_));
            for (int key0 = 0; key0 < ncmax; key0 += 32) {
                asm volatile("" : "+v"(r_), "+v"(kq_));
                KV1 A; load_kv(A, kcb, 64, vct, 512, key0, r_, kq_);
                const bool fast = (t0w - 31 - 16 * (key0 + 31)) >= 1513;
#pragma unroll
                for (int p = 0; p < 4; ++p) { f32x4 sa, sb; qk(sa, sb, A.k, qf[p]); const int tcol = t0w + 2 * p + qsel;
                    mb2<MD_CMP>(sa, sb, key0 + 8 * kq_, tcol, true, fast, BC);
                    f32x4 pa, pb;
#pragma unroll
                    for (int i = 0; i < 4; ++i) { pa[i] = __builtin_amdgcn_exp2f(sa[i] - m[p]) * invl[p]; pb[i] = __builtin_amdgcn_exp2f(sb[i] - m[p]) * invl[p]; }
                    pv(O[p], A.v, pack8(pa, pb));
                    float wA = (pa[0] + pa[1]) + (pa[2] + pa[3]), wB = pa[3] + ((pb[0] + pb[1]) + (pb[2] + pb[3])), wC = pb[3];
                    if (!colv) { wA = 0.f; wB = 0.f; wC = 0.f; }
                    const float up = __shfl(wC, (lane + 48) & 63);
                    const float prevC = (kq == 0) ? carry[p] : up; carry[p] = up;
                    float a0 = wA + prevC, a1 = wB;
                    a0 = sum8_dpp(a0); a1 = sum8_dpp(a1);
                    if (hd == 0) { LAS float* ps = PSw + (2 * p + qsel) * 128 + (key0 >> 2) + 2 * kq; ps[0] = a0; ps[1] = a1; } __builtin_amdgcn_sched_barrier(0); }
            }
        }
        if (ncmax > 0 && ncmax <= 480) {
            const int jn = ((ncmax + 31) >> 5) * 8;
#pragma unroll
            for (int p = 0; p < 4; ++p) { float a0 = sum8_dpp(carry[p]); if (hd == 0 && kq == 0) PSw[(2 * p + qsel) * 128 + jn] = a0; }
        }
        {
#pragma unroll
            for (int p = 0; p < 4; ++p) { const size_t row = (size_t)(rowb + t0w + 2 * p + qsel);
                const float gz = bf2f(G0[row * 256 + habs * 3 + 0]) + Ip->nsa_gate_b[habs * 3 + 0]; out_add(OUTw, p, n, kq, O[p], 1.f / (1.f + __expf(-gz)), true); }
        }
        for (int i = lane; i < 32; i += 64) WMw[i] = (qt < 16) ? 0xffffffffu : 0u;
        if (qt >= 16) {
            if (lane < 3) { const int j = lane == 0 ? 0 : qt - 2 + lane; atomicOr((unsigned*)&WMw[j >> 2], 0xffu << (8 * (j & 3))); }
            for (int q = 0; q < 8; ++q) {
                int v0 = __float_as_int(PSw[q * 128 + lane] + 0.f), v1 = __float_as_int(PSw[q * 128 + 64 + lane] + 0.f);
                if (lane < 1 || lane > qt - 2) v0 = __float_as_int(-1.f); if (lane + 64 > qt - 2) v1 = __float_as_int(-1.f);
                for (int s = 0; s < 13; ++s) { const int mx = wmax64_i(max(v0, v1));
                    const unsigned long long b0 = __ballot(v0 == mx); int j;
                    if (b0) { j = __builtin_ctzll(b0); if (lane == j) v0 = __float_as_int(-1.f); } else { const unsigned long long b1 = __ballot(v1 == mx); j = __builtin_ctzll(b1); if (lane == j) v1 = __float_as_int(-1.f); j += 64; }
                    if (lane == 0) atomicOr((unsigned*)&WMw[j >> 2], 1u << (8 * (j & 3) + q)); }
            }
        }
        const bf16* ksb = KV0 + (size_t)rowb * 512 + 256 + g * 64; const bf16* vst = VT + ((size_t)(rowb >> 6) * 256 + g * 64) * 64;
        __syncthreads();
#pragma unroll 1
        for (int rep_ = 0; rep_ < (PROBE_REP == 1 ? 2 : 1); ++rep_) {
#pragma unroll
            for (int p = 0; p < 4; ++p) { m[p] = -1e30f; l[p] = 0.f;
#pragma unroll
                for (int dt = 0; dt < 4; ++dt) O[p][dt] = (f32x4){0.f, 0.f, 0.f, 0.f}; }
            nsa_sweep<MD_BLK>(STG, ksb, vst, 0, qt, qt, WMw, wave, lane, r, kq, qsel, t0w, qf, BC, m, l, O);
        }
        { int qs2_ = qsel; asm volatile("" : "+v"(qs2_));
#pragma unroll
        for (int p = 0; p < 4; ++p) { const size_t row = (size_t)(rowb + t0w + 2 * p + qs2_);
            const float gz = bf2f(G0[row * 256 + habs * 3 + 1]) + Ip->nsa_gate_b[habs * 3 + 1]; out_add(OUTw, p, n, kq, O[p], (1.f / (1.f + __expf(-gz))) / kqsum(l[p]), false); } }
        const bf16* kwb = KV0 + (size_t)rowb * 512 + 384 + g * 64; const bf16* vwt = VT + ((size_t)(rowb >> 6) * 256 + 128 + g * 64) * 64;
#pragma unroll
        for (int p = 0; p < 4; ++p) { m[p] = -1e30f; l[p] = 0.f;
#pragma unroll
            for (int dt = 0; dt < 4; ++dt) O[p][dt] = (f32x4){0.f, 0.f, 0.f, 0.f}; }
        __syncthreads();
        nsa_sweep<MD_WIN>(STG, kwb, vwt, (qt >= 8) ? qt - 8 : 0, qt, qt, nullptr, wave, lane, r, kq, qsel, t0w, qf, BC, m, l, O);
        if (PROBE_REP == 4) {
#pragma unroll
            for (int p = 0; p < 4; ++p) { m[p] = -1e30f; l[p] = 0.f;
#pragma unroll
                for (int dt = 0; dt < 4; ++dt) O[p][dt] = (f32x4){0.f, 0.f, 0.f, 0.f}; }
            nsa_sweep<MD_WIN>(STG, kwb, vwt, (qt >= 8) ? qt - 8 : 0, qt, qt, nullptr, wave, lane, r, kq, qsel, t0w, qf, BC, m, l, O); }
        { int qs3_ = qsel; asm volatile("" : "+v"(qs3_));
#pragma unroll
        for (int p = 0; p < 4; ++p) { const size_t row = (size_t)(rowb + t0w + 2 * p + qs3_);
            const float gz = bf2f(G0[row * 256 + habs * 3 + 2]) + Ip->nsa_gate_b[habs * 3 + 2]; out_add(OUTw, p, n, kq, O[p], (1.f / (1.f + __expf(-gz))) / kqsum(l[p]), false); } }
        int ln_ = lane; asm volatile("" : "+v"(ln_));
#pragma unroll 1
        for (int i = 0; i < 6; ++i) { const int e = i * 64 + ln_, q = e / 48, c8 = e % 48;
            *(v4u*)(CAT + (size_t)(rowb + t0w + q) * 1024 + g * 384 + 8 * c8) = ((const LAS v4u*)OUTw)[e]; }
#pragma unroll 1
        for (int h2 = 0; h2 < 2; ++h2) { const int hm = 2 * g + h2;
            int ln2_ = lane; asm volatile("" : "+v"(ln2_)); const int nn = ln2_ & 15, kqq = ln2_ >> 4;
#pragma unroll
            for (int p = 0; p < 4; ++p) { qf[p][0] = (bf16x8){0, 0, 0, 0, 0, 0, 0, 0}; qf[p][1] = qf[p][0]; m[p] = -1e30f; l[p] = 0.f;
#pragma unroll
                for (int dt = 0; dt < 4; ++dt) O[p][dt] = (f32x4){0.f, 0.f, 0.f, 0.f}; }
            { const bf16* qp = QM + (size_t)(rowb + t0w + (nn & 7)) * 256 + hm * 64 + 8 * kqq; if (nn < 8) { qf[0][0] = ldg16(qp); qf[0][1] = ldg16(qp + 32); } }
            const BiasCtx BCm{BC.tb, 0.f, 0.f, 0.f};
            nsa_sweep<MD_MEM>(STG, MKB + (size_t)(b * 256) * 256 + hm * 64, MVT + (size_t)(hm * 64) * 512 + b * 256, 0, 3, 0, nullptr, wave, ln2_, nn, kqq, nn >> 3, 0, qf, BCm, m, l, O, 256, 64 * 256, 512, 64);
            const float il = 1.f / kqsum(l[0]);
            if (nn < 8) { bf16* op = CAT + (size_t)(rowb + t0w + nn) * 1024 + 768 + hm * 64 + 4 * kqq;
#pragma unroll
                for (int dt = 0; dt < 4; ++dt) *(uint2*)(op + 16 * dt) = make_uint2(pk2(O[0][dt][0] * il, O[0][dt][1] * il), pk2(O[0][dt][2] * il, O[0][dt][3] * il)); }
        }
    }
}

__device__ __forceinline__ void p10_dsa_norm(Frame& F, const In& I, unsigned char* ws) {
    OPAQUE_TID(); KARGS(); const int gw = F.vcu * NWAVES + (tid_ >> 6), NGW = F.G * NWAVES, lane = tid_ & 63;
    const bf16* PR = (const bf16*)(ws + WS_PROJ1); bf16* CQ = (bf16*)(ws + WS_CQ); bf16* CKV = (bf16*)(ws + WS_CKV); bf16* KIDX = (bf16*)(ws + WS_KIDX); float* WIDX = (float*)(ws + WS_WIDX);
    for (int m = gw; m < M; m += NGW) {
        const bf16* pr = PR + (size_t)m * 768;
        float a[4]; ld4bf(pr + 4 * lane, a);
        float s = wave_sum(a[0] * a[0] + a[1] * a[1] + a[2] * a[2] + a[3] * a[3]); float r = rsqrtf(s * (1.f / 256.f) + EPSF);
        const float4 gq = *(const float4*)(Ip->q_norm + 4 * lane);
        *(uint2*)(CQ + (size_t)m * 256 + 4 * lane) = make_uint2(pk2((a[0] * r) * gq.x, (a[1] * r) * gq.y), pk2((a[2] * r) * gq.z, (a[3] * r) * gq.w));
        const unsigned u = *(const unsigned*)(pr + 256 + 2 * lane); const float c0 = bflo(u), c1 = bfhi(u);
        s = wave_sum(c0 * c0 + c1 * c1); r = rsqrtf(s * (1.f / 128.f) + EPSF);
        *(unsigned*)(CKV + (size_t)m * 128 + 2 * lane) = pk2((c0 * r) * Ip->kv_norm[2 * lane], (c1 * r) * Ip->kv_norm[2 * lane + 1]);
        const float k0 = bf2f(pr[384 + lane]);
        s = wave_sum(k0 * k0); r = rsqrtf(s * (1.f / 64.f) + EPSF);
        { const int tk = m >> 5, key = m & 31, ks = lane >> 4, hf = (lane >> 3) & 1, jj = lane & 7;
          KIDX[((size_t)(tk * 4 + ks) * 64 + hf * 32 + key) * 8 + jj] = (bf16)f2bf((k0 * r) * Ip->kidx_norm[lane]); }
        if (lane < 8) WIDX[(size_t)m * 8 + lane] = bf2f(pr[448 + lane]) * (0.35355339059327373f * 0.125f);
    }
}

#define MFMA32(A, B, C) __builtin_amdgcn_mfma_f32_32x32x16_bf16((A), (B), (C), 0, 0, 0)
typedef float f32x16 __attribute__((ext_vector_type(16)));
typedef _Float16 f16x8 __attribute__((ext_vector_type(8)));
constexpr int XL_OFF = RING_BYTES;
constexpr int IDX_HIST = XL_OFF, IDX_CAND = XL_OFF + 16384, IDX_MM = XL_OFF + 24576, IDX_SELL = XL_OFF + 25600, IDX_CAP = 512;
static_assert(IDX_MM + 512 <= IDX_SELL && IDX_SELL + 4096 <= LDSCTL_OFF, "LDS map (indexer)");
__device__ __forceinline__ float wmin64(float v) {
#pragma unroll
    for (int o = 1; o < 64; o <<= 1) v = fminf(v, __shfl_xor(v, o));
    return v;
}
__device__ __forceinline__ float vmaxf_(float a, float b) { float d; asm("v_max_f32 %0, %1, %2" : "=v"(d) : "v"(a), "v"(b)); return d; }
__device__ __forceinline__ float vminf_(float a, float b) { float d; asm("v_min_f32 %0, %1, %2" : "=v"(d) : "v"(a), "v"(b)); return d; }
__device__ __forceinline__ float max16_dpp(float v) { v = fmaxf(v, DPP_F(v, 0xB1)); v = fmaxf(v, DPP_F(v, 0x4E)); v = fmaxf(v, DPP_F(v, 0x141)); v = fmaxf(v, DPP_F(v, 0x140)); return v; }
__device__ __forceinline__ float min16_dpp(float v) { v = fminf(v, DPP_F(v, 0xB1)); v = fminf(v, DPP_F(v, 0x4E)); v = fminf(v, DPP_F(v, 0x141)); v = fminf(v, DPP_F(v, 0x140)); return v; }
__device__ __forceinline__ void p12_index_mfma(Frame& F, const In& I, unsigned char* ws) {
    OPAQUE_TID(); KARGS(); const int lane = tid_ & 63, wave = __builtin_amdgcn_readfirstlane(tid_ >> 6), key = lane & 31, half = lane >> 5;
    LAS _Float16* SC = (LAS _Float16*)(F.lds + RING_OFF);
    LAS float* MMw = (LAS float*)(F.lds + IDX_MM);
    const bf16* QI = (const bf16*)(ws + WS_QI); const bf16* KIDX = (const bf16*)(ws + WS_KIDX); const float* WIDX = (const float*)(ws + WS_WIDX);
    unsigned short* SEL = (unsigned short*)(ws + WS_SEL); int* CNT = (int*)(ws + WS_CNT);
    const int NG = M / 8, per = (NG + F.G - 1) / F.G;
    for (int j = 0; j < per; ++j) {
        const int u = j * F.G + ((j & 1) ? (F.G - 1 - (int)blockIdx.x) : (int)blockIdx.x);
        if (u >= NG) break;
        const int gi = (u & 1) * (NG / 2) + (u >> 1);
        const int row0 = 8 * gi, b = row0 / T, t0 = row0 % T, rowb = b * T;
        if (t0 < 256) {
            const int t = t0 + wave; unsigned short* so = SEL + (size_t)(row0 + wave) * 256;
#pragma unroll
            for (int i = 0; i < 4; ++i) { const int s = lane + 64 * i; so[s] = (unsigned short)(s <= t ? s : 0); }
            if (lane == 0) CNT[row0 + wave] = t + 1;
            continue;
        }
        {
            const int rho = lane & 31, a = rho >> 2, qA = ((a >> 2) & 1) + 2 * (a & 1), hdA = 4 * ((a >> 1) & 1) + (rho & 3);
            bf16x8 qa[2][4];
#pragma unroll
            for (int t2 = 0; t2 < 2; ++t2)
#pragma unroll
                for (int ks = 0; ks < 4; ++ks) qa[t2][ks] = ldg16(QI + (size_t)(row0 + 4 * t2 + qA) * 512 + hdA * 64 + 16 * ks + 8 * half);
            f32x2_t wp[2][2][4];
#pragma unroll
            for (int t2 = 0; t2 < 2; ++t2)
#pragma unroll
                for (int jq = 0; jq < 2; ++jq) { const float* wq = WIDX + (size_t)(row0 + 4 * t2 + 2 * half + jq) * 8; const float4 x0 = *(const float4*)wq, x1 = *(const float4*)(wq + 4);
                    wp[t2][jq][0] = (f32x2_t){x0.x, x0.y}; wp[t2][jq][1] = (f32x2_t){x0.z, x0.w}; wp[t2][jq][2] = (f32x2_t){x1.x, x1.y}; wp[t2][jq][3] = (f32x2_t){x1.z, x1.w}; }
            const int tqb = t0 + 2 * half, nt = (t0 + 7) / 32 + 1;
            float mn[2][2], mx[2][2];
#pragma unroll
            for (int t2 = 0; t2 < 2; ++t2) { mn[t2][0] = INFINITY; mn[t2][1] = INFINITY; mx[t2][0] = -INFINITY; mx[t2][1] = -INFINITY; }
            const bf16* kpb = KIDX + (size_t)(rowb >> 5) * 2048 + (size_t)lane * 8;
            const int ntw = (nt - wave + NWAVES - 1) / NWAVES;
#define IDX_LOAD(dst, i) do { const int tl2_ = wave + NWAVES * ((i) < ntw ? (i) : (ntw > 0 ? ntw - 1 : 0)); const bf16* kp_ = kpb + (size_t)tl2_ * 2048; \
                _Pragma("unroll") for (int ks = 0; ks < 4; ++ks) dst[ks] = ldg16(kp_ + 512 * ks); } while (0)
#define IDX_EPI(c, t2) do { f32x2_t a0 = {0.f, 0.f}, a1 = {0.f, 0.f};     \
                _Pragma("unroll") for (int h = 0; h < 4; ++h) { \
                    const f32x2_t r0 = {__int_as_float(max(__float_as_int(c[2 * h]), 0)), __int_as_float(max(__float_as_int(c[2 * h + 1]), 0))}; \
                    const f32x2_t r1 = {__int_as_float(max(__float_as_int(c[8 + 2 * h]), 0)), __int_as_float(max(__float_as_int(c[9 + 2 * h]), 0))}; \
                    a0 = __builtin_elementwise_fma(r0, wp[t2][0][h], a0); a1 = __builtin_elementwise_fma(r1, wp[t2][1][h], a1); } \
                const float s0 = (a0[0] + a0[1]) + 0.f, s1 = (a1[0] + a1[1]) + 0.f; \
                const bool ok0 = kpos <= tqb + 4 * (t2), ok1 = kpos <= tqb + 4 * (t2) + 1; \
                const _Float16 h0 = (_Float16)(ok0 ? s0 : -INFINITY), h1 = (_Float16)(ok1 ? s1 : -INFINITY); \
                SC[(4 * (t2) + 2 * half) * 8192 + kpos] = h0; SC[(4 * (t2) + 2 * half + 1) * 8192 + kpos] = h1; \
                const float v0_ = (float)h0, v1_ = (float)h1;                   \
                mx[t2][0] = vmaxf_(mx[t2][0], v0_); mx[t2][1] = vmaxf_(mx[t2][1], v1_); mn[t2][0] = vminf_(mn[t2][0], ok0 ? v0_ : INFINITY); mn[t2][1] = vminf_(mn[t2][1], ok1 ? v1_ : INFINITY); } while (0)
#define IDX_COMP(src, i) do { if ((i) < ntw) { const int kpos = 32 * (wave + NWAVES * (i)) + key; \
                f32x16 cA = {0.f, 0.f, 0.f, 0.f, 0.f, 0.f, 0.f, 0.f, 0.f, 0.f, 0.f, 0.f, 0.f, 0.f, 0.f, 0.f}, cB = cA; \
                _Pragma("unroll") for (int ks = 0; ks < 4; ++ks) { cA = MFMA32(qa[0][ks], src[ks], cA); cB = MFMA32(qa[1][ks], src[ks], cB); } \
                IDX_EPI(cA, 0); IDX_EPI(cB, 1); } } while (0)
            if (ntw > 0) {
                bf16x8 kb0[4], kb1[4], kb2[4], kb3[4];
                IDX_LOAD(kb0, 0); IDX_LOAD(kb1, 1); IDX_LOAD(kb2, 2);
                for (int i = 0; i < ntw; i += 4) {
                    IDX_LOAD(kb3, i + 3); IDX_COMP(kb0, i);
                    IDX_LOAD(kb0, i + 4); IDX_COMP(kb1, i + 1);
                    IDX_LOAD(kb1, i + 5); IDX_COMP(kb2, i + 2);
                    IDX_LOAD(kb2, i + 6); IDX_COMP(kb3, i + 3);
                }
            }
#undef IDX_LOAD
#undef IDX_EPI
#undef IDX_COMP
#pragma unroll
            for (int t2 = 0; t2 < 2; ++t2)
#pragma unroll
                for (int jq = 0; jq < 2; ++jq) { float lo_ = min16_dpp(mn[t2][jq]), hi_ = max16_dpp(mx[t2][jq]);
                    lo_ = fminf(lo_, __shfl_xor(lo_, 16)); hi_ = fmaxf(hi_, __shfl_xor(hi_, 16));
                    if (key == 0) { LAS float* mm = MMw + (wave * 8 + 4 * t2 + 2 * half + jq) * 2; mm[0] = lo_; mm[1] = hi_; } }
        }
        __syncthreads();
        {
            const int q = wave, t = t0 + q, n = t + 1, nch = (n + 511) >> 9; const LAS _Float16* sc = SC + q * 8192;
            LAS unsigned* hist = (LAS unsigned*)(F.lds + IDX_HIST) + wave * 512;
            LAS unsigned short* cand = (LAS unsigned short*)(F.lds + IDX_CAND) + q * IDX_CAP;
            LAS unsigned short* sl = (LAS unsigned short*)(F.lds + IDX_SELL) + q * 256;
            float lo = INFINITY, hi = -INFINITY;
#pragma unroll
            for (int w = 0; w < 8; ++w) { lo = fminf(lo, MMw[(w * 8 + q) * 2]); hi = fmaxf(hi, MMw[(w * 8 + q) * 2 + 1]); }
            int krem = 256, bstar = 0, ncand = 0; bool eq = false; float scale = 0.f;
#define IDX_BIN(v) ({ int bb_ = (int)(((v) - lo) * scale); bb_ > 1023 ? 1023 : bb_; })
            for (int round = 0; round < 64; ++round) {
                if (!(hi > lo)) { eq = true; break; }
                scale = 1024.f / (hi - lo);
#pragma unroll
                for (int i = 0; i < 8; ++i) hist[lane + 64 * i] = 0u;
                for (int c = 0; c < nch; ++c) { const int i8 = 512 * c + 8 * lane; const f16x8 h8 = *(const LAS f16x8*)(sc + i8);
#pragma unroll
                    for (int e = 0; e < 8; ++e) { const float v = (i8 + e < n) ? (float)h8[e] : -INFINITY;
                        if (v >= lo && v <= hi) { const int bb = IDX_BIN(v); atomicAdd((unsigned*)&hist[bb >> 1], 1u << (16 * (bb & 1))); } } }
                unsigned cw[8]; unsigned S = 0u;
#pragma unroll
                for (int i = 0; i < 8; ++i) { cw[i] = hist[8 * lane + i]; S += (cw[i] & 0xffffu) + (cw[i] >> 16); }
                const unsigned px = wave_iscan_u32(S);
                const unsigned above = (unsigned)__builtin_amdgcn_readlane((int)px, 63) - px;
                const bool found = (above < (unsigned)krem) && ((unsigned)krem <= above + S);
                const int fl = __builtin_ctzll(__ballot(found));
                int bs = 0; unsigned acc = above, cb = 0u;
                { bool done = false;
#pragma unroll
                  for (int i = 15; i >= 0; --i) { const unsigned cnt_ = (i & 1) ? (cw[i >> 1] >> 16) : (cw[i >> 1] & 0xffffu);
                      if (!done) { if (acc + cnt_ >= (unsigned)krem) { bs = 16 * lane + i; cb = cnt_; done = true; } else acc += cnt_; } } }
                bstar = __builtin_amdgcn_readlane(bs, fl); ncand = __builtin_amdgcn_readlane((int)cb, fl); krem -= __builtin_amdgcn_readlane((int)acc, fl);
                if (ncand <= IDX_CAP) break;
                float nlo = INFINITY, nhi = -INFINITY;
                for (int c = 0; c < nch; ++c) { const int i8 = 512 * c + 8 * lane; const f16x8 h8 = *(const LAS f16x8*)(sc + i8);
#pragma unroll
                    for (int e = 0; e < 8; ++e) { const float v = (i8 + e < n) ? (float)h8[e] : -INFINITY;
                        if (v >= lo && v <= hi && IDX_BIN(v) == bstar) { nlo = fminf(nlo, v); nhi = fmaxf(nhi, v); } } }
                lo = wmin64(nlo); hi = wmax64(nhi);
            }
            const int nabove = 256 - krem; int bsel = 0, bcand = 0;
            if (eq) {
                for (int c = 0; c < nch; ++c) { const int i8 = 512 * c + 8 * lane; const f16x8 h8 = *(const LAS f16x8*)(sc + i8);
#pragma unroll
                    for (int e = 0; e < 8; ++e) { const int idx = i8 + e; const float v = (idx < n) ? (float)h8[e] : -INFINITY;
                        const bool sel = v > hi, cnd = (v == hi);
                        const unsigned long long ms = __ballot(sel), mc = __ballot(cnd);
                        if (sel) sl[bsel + (int)__builtin_amdgcn_mbcnt_hi((unsigned)(ms >> 32), __builtin_amdgcn_mbcnt_lo((unsigned)ms, 0u))] = (unsigned short)idx;
                        if (cnd) { const int pc = bcand + (int)__builtin_amdgcn_mbcnt_hi((unsigned)(mc >> 32), __builtin_amdgcn_mbcnt_lo((unsigned)mc, 0u)); if (pc < krem) sl[nabove + pc] = (unsigned short)idx; }
                        bsel += __builtin_popcountll(ms); bcand += __builtin_popcountll(mc); } }
            } else {
                auto fkey = [](float x) { const int b_ = __float_as_int(x); return b_ ^ ((b_ >> 31) & 0x7fffffff); };
                auto kflt = [](int k) { return __int_as_float(k ^ ((k >> 31) & 0x7fffffff)); };
                const int klo = fkey(lo), khi = fkey(hi);
                auto first_ge = [&](int target) {
                    float est = lo + (float)target * ((hi - lo) * (1.f / 1024.f)); est = est < lo ? lo : (est > hi ? hi : est);
                    int a = klo, b2 = khi;
                    { const int ke = fkey(est); const int ka = (ke - 64 > klo) ? ke - 64 : klo, kb = (ke + 64 < khi) ? ke + 64 : khi;
                      if (IDX_BIN(kflt(ka)) < target) a = ka; if (IDX_BIN(kflt(kb)) >= target) b2 = kb; }
                    while ((unsigned)b2 - (unsigned)a > 1u) { const int mid = a + (int)(((unsigned)b2 - (unsigned)a) >> 1); if (IDX_BIN(kflt(mid)) >= target) b2 = mid; else a = mid; }
                    return kflt(b2); };
                const float T0 = (bstar <= 0) ? lo : first_ge(bstar);
                const float T1 = (bstar >= 1023 || IDX_BIN(hi) <= bstar) ? kflt(khi + 1) : first_ge(bstar + 1);
                for (int c = 0; c < nch; ++c) { const int i8 = 512 * c + 8 * lane; const f16x8 h8 = *(const LAS f16x8*)(sc + i8);
                    const bool full = 512 * c + 512 <= n;
#pragma unroll
                    for (int e = 0; e < 8; ++e) { const int idx = i8 + e; const float v = (full || idx < n) ? (float)h8[e] : -INFINITY;
                        const bool sel = v >= T1, cnd = (v >= T0) && !sel;
                        const unsigned long long ms = __ballot(sel), mc = __ballot(cnd);
                        if (ms) { if (sel) sl[bsel + (int)__builtin_amdgcn_mbcnt_hi((unsigned)(ms >> 32), __builtin_amdgcn_mbcnt_lo((unsigned)ms, 0u))] = (unsigned short)idx; bsel += __builtin_popcountll(ms); }
                        if (mc) { if (cnd) { const int pc = bcand + (int)__builtin_amdgcn_mbcnt_hi((unsigned)(mc >> 32), __builtin_amdgcn_mbcnt_lo((unsigned)mc, 0u)); if (pc < IDX_CAP) cand[pc] = (unsigned short)idx; } bcand += __builtin_popcountll(mc); } } }
                for (int i = lane; i < ncand; i += 64) { const int ii = cand[i]; const float vi = (float)sc[ii]; int rank = 0;
                    for (int jj = 0; jj < ncand; ++jj) { const int ij = cand[jj]; const float vj = (float)sc[ij]; rank += ((vj > vi) || (vj == vi && ij < ii)) ? 1 : 0; }
                    if (rank < krem) sl[nabove + rank] = (unsigned short)ii; }
            }
#undef IDX_BIN
            *(v2u*)(SEL + (size_t)(row0 + q) * 256 + 4 * lane) = *(const LAS v2u*)(sl + 4 * lane);
            if (lane == 0) CNT[row0 + q] = 256;
        }
        __syncthreads();
    }
}

__device__ __forceinline__ unsigned offb(unsigned row, unsigned ch) { return 256u * row + 16u * (ch ^ (((row & 3u) << 2) | ((row >> 2) & 3u))); }
typedef short v4i16_t __attribute__((ext_vector_type(4)));
__device__ __forceinline__ v4i16_t trrd(const LAS unsigned char* p) { return __builtin_amdgcn_ds_read_tr16_b64_v4i16((LAS v4i16_t*)p); }
__device__ __forceinline__ void p13_dsa_mfma(Frame& F, const In& I, unsigned char* ws) {
    OPAQUE_TID(); KARGS(); const int lane = tid_ & 63, wave = __builtin_amdgcn_readfirstlane(tid_ >> 6), n = lane & 15, kq = lane >> 4;
    LAS unsigned char* bkt = F.lds + TAB_BKT; LAS float* b12 = (LAS float*)(F.lds + P13_B12);
    for (int i = tid_; i < 1536; i += NWAVES * 64) bkt[i] = (unsigned char)rel_bucket(i);
    for (int i = tid_; i < 528; i += NWAVES * 64) b12[i] = (i >= 512) ? -INFINITY : (((i & 15) < 12) ? Ip->rel_bias[(i >> 4) * 12 + (i & 15)] * LOG2E : 0.f);
    __syncthreads();
    LAS unsigned char* imgb = F.lds + RING_OFF + wave * 18432; LAS int* sidx = (LAS int*)(imgb + 16384);
    const bf16* QA = (const bf16*)(ws + WS_QA); const bf16* CKV = (const bf16*)(ws + WS_CKV); const bf16* PR = (const bf16*)(ws + WS_PROJ1);
    const unsigned short* SEL = (const unsigned short*)(ws + WS_SEL); const int* CNT = (const int*)(ws + WS_CNT);
    const bf16* MKB = (const bf16*)(ws + WS_MKB) + (size_t)512 * 256; const bf16* MVT = (const bf16*)(ws + WS_MVT) + (size_t)256 * 512;
    bf16* CAT1 = (bf16*)(ws + WS_CAT1);
    const int gw = blockIdx.x * NWAVES + wave, NGW = F.G * NWAVES;
    const LAS float* b12c = b12 + (n < 12 ? n : 0);
#define DSA_GATHER(sl_, rowb_, c0_, buf_) do { const unsigned char* ckvb_ = (const unsigned char*)(CKV + (size_t)(rowb_) * 128); int kx_[8]; \
            _Pragma("unroll") for (int i = 0; i < 8; ++i) kx_[i] = (sl_)[(c0_) + 4 * i + g4_] & 0xffff; \
            _Pragma("unroll") for (int i = 0; i < 8; ++i) __builtin_amdgcn_global_load_lds((const unsigned*)(ckvb_ + ((unsigned)kx_[i] * 256u + goff_[i & 3])), (LAS unsigned*)(imgb + (buf_) * 8192 + i * 1024), 16, 0, 0); } while (0)
#define DSA_LIST(sl_, sel_, t_, cnt_) do { const int idx0_ = __builtin_amdgcn_readfirstlane((sel_)[0]); \
            _Pragma("unroll") for (int i = 0; i < 4; ++i) { const int e = lane + 64 * i, idx = (sel_)[i]; const int d = (t_) - idx, dc = d > 1535 ? 1535 : (d < 0 ? 0 : d); \
                (sl_)[e] = (e < (cnt_)) ? (idx | ((int)bkt[dc] << 22)) : (idx0_ | (2048 << 16)); } } while (0)
    int dreps_ = (PROBE_REP == 9) ? 2 : 1; asm volatile("" : "+s"(dreps_));
    for (int dr_ = 0; dr_ < dreps_; ++dr_) {
    asm volatile("s_waitcnt vmcnt(0) lgkmcnt(0)" ::: "memory");
    int row = gw;
    if (row < M) {
        int ln0_ = lane; asm volatile("" : "+v"(ln0_));
        const int g4_ = ln0_ >> 4; unsigned goff_[4];
#pragma unroll
        for (int k = 0; k < 4; ++k) goff_[k] = 16u * ((unsigned)(ln0_ & 15) ^ (((unsigned)g4_ << 2) | (unsigned)k));
        int cnt = __builtin_amdgcn_readfirstlane(CNT[row]); int sel0[4];
#pragma unroll
        for (int i = 0; i < 4; ++i) sel0[i] = (int)SEL[(size_t)row * 256 + lane + 64 * i];
        DSA_LIST(sidx, sel0, row % T, cnt);
        bf16x8 qf[4];
#pragma unroll
        for (int ks = 0; ks < 4; ++ks) { bf16x8 v = ldg16(QA + (size_t)row * 1536 + (n < 12 ? n : 0) * 128 + 32 * ks + 8 * kq); if (n >= 12) v = (bf16x8){0, 0, 0, 0, 0, 0, 0, 0}; qf[ks] = v; }
        asm volatile("s_waitcnt lgkmcnt(0)" ::: "memory");
        DSA_GATHER(sidx, (row / T) * T, 0, 0);
        int lb = 0, ib = 0;
        for (; row < M; row += NGW) {
            const int t = row % T, rown = (row + NGW < M) ? row + NGW : row; const bool hasn = row + NGW < M;
            int ln_ = lane; asm volatile("" : "+v"(ln_));
            int seln[4] = {0, 0, 0, 0}; int cntn_v = 0; bf16x8 qfn[4];
#pragma unroll
            for (int ks = 0; ks < 4; ++ks) qfn[ks] = (bf16x8){0, 0, 0, 0, 0, 0, 0, 0};
#define DSA_NEXT_LOADS() do { cntn_v = CNT[rown]; \
                _Pragma("unroll") for (int i = 0; i < 4; ++i) seln[i] = (int)SEL[(size_t)rown * 256 + lane + 64 * i]; \
                _Pragma("unroll") for (int ks = 0; ks < 4; ++ks) { bf16x8 v = ldg16(QA + (size_t)rown * 1536 + (n < 12 ? n : 0) * 128 + 32 * ks + 8 * kq); if (n >= 12) v = (bf16x8){0, 0, 0, 0, 0, 0, 0, 0}; qfn[ks] = v; } } while (0)
            const LAS int* sl = sidx + lb * 256; LAS int* sln = sidx + (lb ^ 1) * 256;
            float m = -1e30f, l = 0.f; f32x4 O[8];
#pragma unroll
            for (int rt = 0; rt < 8; ++rt) O[rt] = (f32x4){0.f, 0.f, 0.f, 0.f};
            for (int c0 = 0; c0 < cnt; c0 += 32) {
                LAS unsigned char* img = imgb + ib * 8192;
                if (c0 + 32 < cnt) { DSA_GATHER(sl, (row / T) * T, c0 + 32, ib ^ 1);
                    { const int e2 = (c0 + 64 < 256 ? c0 + 64 : 224) + (ln_ >> 1); const int k2 = sl[e2] & 0xffff;
                      __builtin_amdgcn_global_load_lds((const unsigned*)((const unsigned char*)(CKV + (size_t)((row / T) * T) * 128) + ((unsigned)k2 * 256u + 128u * (unsigned)(ln_ & 1))), (LAS unsigned*)(F.lds + P13_JUNK + wave * 256), 4, 0, 0); }
                    if (c0 == 0) { DSA_NEXT_LOADS(); }
                    if (c0 < 64) asm volatile("s_waitcnt vmcnt(18)" ::: "memory"); else asm volatile("s_waitcnt vmcnt(9)" ::: "memory"); }
                else if (hasn) {
                    if (c0 == 0) { DSA_NEXT_LOADS(); }
                    const int cntn = __builtin_amdgcn_readfirstlane(cntn_v);
                    DSA_LIST(sln, seln, rown % T, cntn);
                    asm volatile("s_waitcnt lgkmcnt(0)" ::: "memory");
                    DSA_GATHER(sln, (rown / T) * T, 0, ib ^ 1); asm volatile("s_waitcnt vmcnt(8)" ::: "memory"); }
                else asm volatile("s_waitcnt vmcnt(0)" ::: "memory");
                const bool has = m > -1e29f; const float mref = has ? m : 0.f; const float cinv = -mref;
                f32x4 sa = {cinv, cinv, cinv, cinv}, sb = sa;
                { const unsigned ra = 8u * ((unsigned)(ln_ & 15) >> 2) + ((unsigned)ln_ & 3u), kq_ = (unsigned)ln_ >> 4;
#pragma unroll
                  for (int s = 0; s < 4; ++s) { const bf16x8 ka = *(const LAS bf16x8*)(img + offb(ra, 4 * s + kq_)); const bf16x8 kb = *(const LAS bf16x8*)(img + offb(ra + 4, 4 * s + kq_));
                      sa = MFMA16(ka, qf[s], sa); sb = MFMA16(kb, qf[s], sb); } }
#pragma unroll
                for (int i = 0; i < 4; ++i) { const int ea = c0 + 8 * kq + i;
                    sa[i] += *(const LAS float*)((const LAS unsigned char*)b12c + ((unsigned)sl[ea] >> 16)); sb[i] += *(const LAS float*)((const LAS unsigned char*)b12c + ((unsigned)sl[ea + 4] >> 16)); }
                float fsc = 1.f;
                if (__any((imax3(imax3(__float_as_int(sa[0]), __float_as_int(sa[1]), __float_as_int(sa[2])), imax3(__float_as_int(sa[3]), __float_as_int(sb[0]), __float_as_int(sb[1])), max(__float_as_int(sb[2]), __float_as_int(sb[3]))) > __float_as_int(SM_THR)) || !has)) {
                    float lm = lmax8(sa, sb);
                    lm = fmaxf(lm, __shfl_xor(lm, 16)); lm = fmaxf(lm, __shfl_xor(lm, 32));
                    const bool upd = (lm > -INFINITY) && (!has || lm > 0.f); const float dl = upd ? lm : 0.f;
                    if (upd) m = mref + dl;
                    fsc = has ? __builtin_amdgcn_exp2f(-dl) : 1.f; l *= fsc;
#pragma unroll
                    for (int i = 0; i < 4; ++i) { sa[i] -= dl; sb[i] -= dl; }
#pragma unroll
                    for (int rt = 0; rt < 8; ++rt) O[rt] = O[rt] * fsc;
                }
                f32x4 pa, pb; float sum = 0.f;
#pragma unroll
                for (int i = 0; i < 4; ++i) { pa[i] = __builtin_amdgcn_exp2f(sa[i]); pb[i] = __builtin_amdgcn_exp2f(sb[i]); sum += pa[i] + pb[i]; }
                l += sum;
                const bf16x8 pf = pack8(pa, pb);
                { const unsigned g_ = (unsigned)ln_ >> 4, q_ = ((unsigned)ln_ & 15u) >> 2, p_ = (unsigned)ln_ & 3u;
#pragma unroll
                  for (int rt = 0; rt < 8; ++rt) { const v4i16_t x0 = trrd(img + offb(8 * g_ + q_, 2 * rt + (p_ >> 1)) + 8 * (p_ & 1)), x1 = trrd(img + offb(8 * g_ + 4 + q_, 2 * rt + (p_ >> 1)) + 8 * (p_ & 1));
                      const bf16x8 vf = {x0[0], x0[1], x0[2], x0[3], x1[0], x1[1], x1[2], x1[3]};
                      O[rt] = MFMA16(vf, pf, O[rt]); } }
                ib ^= 1;
            }
            const float il = 1.f / kqsum(l);
            if (n < 12) { bf16* op = CAT1 + (size_t)row * 1792 + n * 128 + 4 * kq;
#pragma unroll
                for (int rt = 0; rt < 8; ++rt) *(uint2*)(op + 16 * rt) = make_uint2(pk2(O[rt][0] * il, O[rt][1] * il), pk2(O[rt][2] * il, O[rt][3] * il)); }
            lb ^= 1; cnt = __builtin_amdgcn_readfirstlane(cntn_v);
#pragma unroll
            for (int ks = 0; ks < 4; ++ks) qf[ks] = qfn[ks];
        }
    }
    }
#undef DSA_GATHER
#undef DSA_LIST
#undef DSA_NEXT_LOADS
    int mreps_ = (PROBE_REP == 8) ? 2 : 1; asm volatile("" : "+s"(mreps_));
    __syncthreads();
    for (int mr_ = 0; mr_ < mreps_; ++mr_)
    for (int u64 = blockIdx.x; u64 < M / 64; u64 += F.G) {
        int tl_ = tid_; asm volatile("" : "+v"(tl_));
        const int ln = tl_ & 63, nn = ln & 15, kqq = ln >> 4, qsl = nn >> 3;
        const int row0 = 64 * u64 + 8 * wave, b = row0 / T;
        const BiasCtx BC0{(const LAS unsigned short*)(F.lds + NSA_TB), 0.f, 0.f, 0.f};
#pragma unroll 1
        for (int hm = 0; hm < 4; ++hm) {
            bf16x8 qf[4][2];
#pragma unroll
            for (int p = 0; p < 4; ++p) { qf[p][0] = (bf16x8){0, 0, 0, 0, 0, 0, 0, 0}; qf[p][1] = qf[p][0]; }
            { const bf16* qp = PR + (size_t)(row0 + (nn & 7)) * 768 + 456 + hm * 64 + 8 * kqq; if (nn < 8) { qf[0][0] = ldg16(qp); qf[0][1] = ldg16(qp + 32); } }
            float m[4], l[4]; f32x4 O[4][4];
#pragma unroll
            for (int p = 0; p < 4; ++p) { m[p] = -1e30f; l[p] = 0.f;
#pragma unroll
                for (int dt = 0; dt < 4; ++dt) O[p][dt] = (f32x4){0.f, 0.f, 0.f, 0.f}; }
            nsa_sweep<MD_MEM>(F.lds + RING_OFF, MKB + (size_t)(b * 256) * 256 + hm * 64, MVT + (size_t)(hm * 64) * 512 + b * 256, 0, 3, 0, nullptr, wave, ln, nn, kqq, qsl, 0, qf, BC0, m, l, O, 256, 64 * 256, 512, 64);
            const float il = 1.f / kqsum(l[0]);
            if (nn < 8) { bf16* op = CAT1 + (size_t)(row0 + nn) * 1792 + 1536 + hm * 64 + 4 * kqq;
#pragma unroll
                for (int dt = 0; dt < 4; ++dt) *(uint2*)(op + 16 * dt) = make_uint2(pk2(O[0][dt][0] * il, O[0][dt][1] * il), pk2(O[0][dt][2] * il, O[0][dt][3] * il)); }
            __syncthreads();
        }
    }
}

struct Args { In in; float* out; unsigned char* ws; int ph_lo, ph_hi; };
__global__ void __launch_bounds__(NWAVES * 64, 2) mk_fwd(Args args) {
    extern __shared__ __attribute__((aligned(16))) unsigned char lds[];
    Frame F;
    F.lds = (LAS unsigned char*)lds; F.MISC = (volatile LAS unsigned*)(F.lds + MISC_OFF);
    F.G = gridDim.x; { const int bx = blockIdx.x; F.vcu = (F.G % 8 == 0) ? (bx % 8) * (F.G / 8) + bx / 8 : bx; }
    unsigned char* ws = args.ws; const In& I = args.in; float* out = args.out; (void)I;
    F.ctl = (gu32*)(ws + WS_CTL);
    for (int u = threadIdx.x; u < (LDS_BYTES - LDSCTL_OFF) / 4; u += NWAVES * 64) ((LAS unsigned*)(F.lds + LDSCTL_OFF))[u] = 0u;
    __syncthreads();
    XcdBarrier bar; bar.bar = (unsigned*)(F.ctl + CW_BAR); bar.x = 0; bar.st = nullptr;
    if (!MK_SPLIT) bar = xcd_barrier_post((unsigned*)(F.ctl + CW_BAR), F.MISC + 8);
    const int lo = args.ph_lo, hi = args.ph_hi;
#ifndef PH_MASK
#define PH_MASK 0xFFFFFFFFu
#endif
#define IN(k) ((((PH_MASK) >> ((k) % 32)) & 1u) && lo <= (k) && (k) < hi)
#define SEAM(k) do { if (IN(k) && IN((k) + 1)) xcd_barrier(bar); } while (0)
#define SEAM2(k, kn) do { if (IN(k) && IN(kn)) xcd_barrier(bar); } while (0)
#ifndef REP_MASK
#define REP_MASK 0u
#endif
#define REPS(k) (1 + (int)(((REP_MASK) >> (k)) & 1u))
    bf16* XN = (bf16*)(ws + WS_XN); bf16* CAT = (bf16*)(ws + WS_CAT); bf16* ACT = (bf16*)(ws + WS_ACT);
    float* SSQ = (float*)(ws + WS_SSQ);

    if (IN(0)) { for (int r_ = 0; r_ < REPS(0); ++r_) { p0_prologue(F, I, ws); if (r_ + 1 < REPS(0)) xcd_barrier(bar); } SEAM(0); }
    {
            if (IN(1)) {
                pg8::Gemm g{XN, (const bf16*)(ws + WS_WIN0), M, 1792, D}; pg8::StaticOrder S; S.init(M, 1792, F.G, (int)blockIdx.x);
                pg8::EpiRoute<0> E{ws, nullptr};
                for (int r_ = 0; r_ < REPS(1); ++r_) { if (r_) xcd_barrier(bar);
                pg8::gemm_phase<pg8::EpiRoute<0>, pg8::StaticOrder, true, true>(F.lds + RING_OFF, g, S, E); }
                pg8::Gemm g2{(const bf16*)(ws + WS_WVT), XN, 256, M, D}; pg8::StaticOrder S2; S2.init(256, M, F.G, (int)((blockIdx.x + 64) % F.G));
                pg8::EpiRoute<3> E2{ws, nullptr};
                pg8::gemm_phase<pg8::EpiRoute<3>, pg8::StaticOrder, true, true>(F.lds + RING_OFF, g2, S2, E2);
                SEAM(1);
            }
            if (IN(2)) { for (int r_ = 0; r_ < REPS(2); ++r_) { p2_mfma(F, I, ws); if (r_ + 1 < REPS(2)) xcd_barrier(bar); } SEAM(2); }
            if (IN(3)) { for (int r_ = 0; r_ < REPS(3); ++r_) { p3_nsa_mfma(F, I, ws); if (r_ + 1 < REPS(3)) xcd_barrier(bar); } SEAM(3); }
    }
    {
        constexpr int L = 0, pb = L ? 14 : 4;
        if (IN(pb)) {
            pg8::Gemm g{L ? (const bf16*)(ws + WS_CAT1) : CAT, L ? (const bf16*)(ws + WS_WO1F) : (const bf16*)(ws + WS_WO), M, D, L ? 1792 : D}; pg8::StaticOrder S; S.init(M, D, F.G, (int)blockIdx.x);
            KARGS(); pg8::EpiResid<L == 0> E{L ? (const void*)XN : (const void*)Ip->x, XN, SSQ + (size_t)(L ? 2 : 0) * M * 16, D, 0};
            pg8::gemm_phase<pg8::EpiResid<L == 0>, pg8::StaticOrder, true, true>(F.lds + RING_OFF, g, S, E);
            SEAM2(pb, pb + 2);
        }
        if (IN(pb + 2)) {
            pg8::Gemm g{XN, (const bf16*)(ws + WS_WGU) + (size_t)L * 2 * DFF * D, M, 2 * DFF, D}; pg8::StaticOrder S; S.init(M, 2 * DFF, F.G, (int)blockIdx.x);
            pg8::EpiSwiglu E{ACT, SSQ + (size_t)(L ? 2 : 0) * M * 16, DFF, 0};
            for (int r_ = 0; r_ < REPS(pb + 2); ++r_) { if (r_) xcd_barrier(bar);
            pg8::gemm_phase<pg8::EpiSwiglu, pg8::StaticOrder, true, true>(F.lds + RING_OFF, g, S, E); }
            SEAM(pb + 2);
        }
        if (IN(pb + 3)) {
            pg8::Gemm g{ACT, (const bf16*)(ws + WS_WD) + (size_t)L * D * DFF, M, D, DFF}; pg8::StaticOrder S; S.init(M, D, F.G, (int)blockIdx.x);
            pg8::EpiResid<false> E{XN, XN, SSQ + (size_t)(L ? 3 : 1) * M * 16, D, 0};
            pg8::gemm_phase<pg8::EpiResid<false>, pg8::StaticOrder, true, true>(F.lds + RING_OFF, g, S, E);
            SEAM2(pb + 3, L ? 18 : 9);
        }
        }
    {
            if (IN(9)) {
                pg8::Gemm g{XN, (const bf16*)(ws + WS_WIN1), M, 768, D}; pg8::StaticOrder S; S.init(M, 768, F.G, (int)blockIdx.x);
                pg8::EpiRoute<1> E{ws, SSQ + (size_t)1 * M * 16};
                for (int r_ = 0; r_ < REPS(9); ++r_) { if (r_) xcd_barrier(bar);
                pg8::gemm_phase<pg8::EpiRoute<1>, pg8::StaticOrder, true, true>(F.lds + RING_OFF, g, S, E); }
                SEAM(9);
            }
            if (IN(10)) { p10_dsa_norm(F, I, ws); SEAM(10); }
            if (IN(11)) {
                pg8::Gemm g{(const bf16*)(ws + WS_CQ), (const bf16*)(ws + WS_WQ2), M, 2048, 256}; pg8::StaticOrder S; S.init(M, 2048, F.G, (int)blockIdx.x);
                pg8::EpiRoute<2> E{ws, nullptr};
                for (int r_ = 0; r_ < REPS(11); ++r_) { if (r_) xcd_barrier(bar);
                pg8::gemm_phase<pg8::EpiRoute<2>, pg8::StaticOrder, true, true>(F.lds + RING_OFF, g, S, E); }
                SEAM(11);
            }
            if (IN(12)) { for (int r_ = 0; r_ < REPS(12); ++r_) { p12_index_mfma(F, I, ws); if (r_ + 1 < REPS(12)) xcd_barrier(bar); } SEAM(12); }
            if (IN(13)) { for (int r_ = 0; r_ < REPS(13); ++r_) { p13_dsa_mfma(F, I, ws); if (r_ + 1 < REPS(13)) xcd_barrier(bar); } SEAM(13); }
            }
    {
        constexpr int L = 1, pb = L ? 14 : 4;
        if (IN(pb)) {
            pg8::Gemm g{L ? (const bf16*)(ws + WS_CAT1) : CAT, L ? (const bf16*)(ws + WS_WO1F) : (const bf16*)(ws + WS_WO), M, D, L ? 1792 : D}; pg8::StaticOrder S; S.init(M, D, F.G, (int)blockIdx.x);
            KARGS(); pg8::EpiResid<L == 0> E{L ? (const void*)XN : (const void*)Ip->x, XN, SSQ + (size_t)(L ? 2 : 0) * M * 16, D, 0};
            pg8::gemm_phase<pg8::EpiResid<L == 0>, pg8::StaticOrder, true, true>(F.lds + RING_OFF, g, S, E);
            SEAM2(pb, pb + 2);
        }
        if (IN(pb + 2)) {
            pg8::Gemm g{XN, (const bf16*)(ws + WS_WGU) + (size_t)L * 2 * DFF * D, M, 2 * DFF, D}; pg8::StaticOrder S; S.init(M, 2 * DFF, F.G, (int)blockIdx.x);
            pg8::EpiSwiglu E{ACT, SSQ + (size_t)(L ? 2 : 0) * M * 16, DFF, 0};
            for (int r_ = 0; r_ < REPS(pb + 2); ++r_) { if (r_) xcd_barrier(bar);
            pg8::gemm_phase<pg8::EpiSwiglu, pg8::StaticOrder, true, true>(F.lds + RING_OFF, g, S, E); }
            SEAM(pb + 2);
        }
        if (IN(pb + 3)) {
            pg8::Gemm g{ACT, (const bf16*)(ws + WS_WD) + (size_t)L * D * DFF, M, D, DFF}; pg8::StaticOrder S; S.init(M, D, F.G, (int)blockIdx.x);
            pg8::EpiResid<false> E{XN, XN, SSQ + (size_t)(L ? 3 : 1) * M * 16, D, 0};
            pg8::gemm_phase<pg8::EpiResid<false>, pg8::StaticOrder, true, true>(F.lds + RING_OFF, g, S, E);
            SEAM2(pb + 3, L ? 18 : 9);
        }
        }
    if (IN(18)) {
        OPAQUE_TID(); KARGS(); const int lane_ = tid_ & 63;
        const int gw = F.vcu * NWAVES + (tid_ >> 6), NGW = F.G * NWAVES;
        for (int m = gw; m < M; m += NGW) { const float r = rsqrtf(pg8::ssq_row(SSQ + ((size_t)3 * M + m) * 16) * (1.f / D) + EPSF);
#pragma unroll
            for (int j = 0; j < 2; ++j) { const int c = (j * 64 + lane_) * 8; const pg8::u32x4 rw = *(const GAS pg8::u32x4*)(XN + (size_t)m * D + c);
                const GAS f32x4* gr = (const GAS f32x4*)(Ip->norm_final + c); GAS f32x4* orow = (GAS f32x4*)(out + (size_t)m * D + c);
                f32x4 r0, r1; r0[0] = __uint_as_float(rw.x << 16); r0[1] = __uint_as_float(rw.x & 0xffff0000u); r0[2] = __uint_as_float(rw.y << 16); r0[3] = __uint_as_float(rw.y & 0xffff0000u);
                r1[0] = __uint_as_float(rw.z << 16); r1[1] = __uint_as_float(rw.z & 0xffff0000u); r1[2] = __uint_as_float(rw.w << 16); r1[3] = __uint_as_float(rw.w & 0xffff0000u);
                orow[0] = (r0 * r) * gr[0]; orow[1] = (r1 * r) * gr[1]; } }
    }
#undef IN
#undef SEAM
}

extern "C" void kernel_launch(void* const* d_in, const int* in_sizes, int n_in, void* d_out, int out_size, void* d_ws, size_t ws_size, hipStream_t stream) {
    static int grid = 0;
    if (grid == 0) {
        if (n_in != 32 || out_size != M * D || ws_size < WS_END) { fprintf(stderr, "kernel_launch: unexpected shapes (n_in %d out %d ws %zu)\n", n_in, out_size, ws_size); grid = -1; return; }
        int dev = 0, cus = 0, per_cu = 0;
        if (hipGetDevice(&dev) != hipSuccess || hipDeviceGetAttribute(&cus, hipDeviceAttributeMultiprocessorCount, dev) != hipSuccess) { grid = -1; return; }
        if (hipFuncSetAttribute((const void*)mk_fwd, hipFuncAttributeMaxDynamicSharedMemorySize, LDS_BYTES) != hipSuccess) { grid = -1; return; }
        if (hipOccupancyMaxActiveBlocksPerMultiprocessor(&per_cu, (const void*)mk_fwd, NWAVES * 64, LDS_BYTES) != hipSuccess || per_cu < 1) fprintf(stderr, "kernel_launch: occupancy query reports %d\n", per_cu);
        (void)hipGetLastError();
        grid = cus;
        if (grid > 256) grid = 256;
    }
    if (grid < 0) return;
    if (hipMemsetAsync((char*)d_ws + WS_CTL, 0, CTL_ZERO_BYTES, stream) != hipSuccess) return;
    Args a{};
    const float** ip = (const float**)&a.in;
    for (int i = 0; i < 32; ++i) ip[i] = (const float*)d_in[i];
    a.out = (float*)d_out; a.ws = (unsigned char*)d_ws;
#if MK_SPLIT
    for (int k = 0; k < N_PHASES; ++k) { a.ph_lo = k; a.ph_hi = k + 1; hipLaunchKernelGGL(mk_fwd, dim3(grid), dim3(NWAVES * 64), LDS_BYTES, stream, a); }
#else
    a.ph_lo = 0; a.ph_hi = N_PHASES; hipLaunchKernelGGL(mk_fwd, dim3(grid), dim3(NWAVES * 64), LDS_BYTES, stream, a);
#endif
}
```

```cpp
#include <hip/hip_runtime.h>
#include <cstdio>
#include <cstdint>
#include <type_traits>
#include <math.h>

namespace pg8 {
#define PG8_LAS __attribute__((address_space(3)))
typedef unsigned short bf16_t;
typedef short bf16x8 __attribute__((ext_vector_type(8)));
typedef float f32x4 __attribute__((ext_vector_type(4)));
typedef unsigned u32x4 __attribute__((ext_vector_type(4)));
constexpr int BM = 256, BK = 64, HALF = 128, HTB = HALF * BK * 2  , STAGE_BYTES = 8 * HTB, NXCD = 8, WGM = 8;

__host__ __device__ __forceinline__ int lds_byte(int r, int c) { const int st = (r >> 4) * 2 + (c >> 5), rr = r & 15, cc = c & 31, ob = rr * 64 + cc * 2; return st * 1024 + (ob ^ (((ob >> 9) & 1) << 5)); }
__host__ __device__ __forceinline__ void stage_rc(int b, int& R, int& C) { const int st = b / 1024, sb = b % 1024, swz = sb ^ (((sb >> 9) & 1) << 5); R = (st >> 1) * 16 + swz / 64; C = (st & 1) * 32 + (swz % 64) / 2; }
__host__ __device__ __forceinline__ int perm32(int rho) { const int n = rho >> 4, i = rho & 15; return 8 * (i >> 2) + 4 * n + (i & 3); }

struct Unit { int pm, pn; };
struct Gemm { const bf16_t* A; const bf16_t* Bt; int M, N, K; };

struct StaticOrder {
    int nM, nN, nwg, G, c;
    __host__ __device__ void init(int M, int N, int G_, int c_) { nM = M / BM; nN = N / BM; nwg = nM * nN; G = G_; c = c_; }
    __host__ __device__ bool next(int i, Unit& u) const {
        const long L = (long)i * G + c; if (L >= nwg) return false;
        int wgid = (int)L; { const int q = nwg / NXCD, r = nwg % NXCD, xcd = wgid % NXCD, off = wgid / NXCD; wgid = (xcd < r ? xcd * (q + 1) : r * (q + 1) + (xcd - r) * q) + off; }
        const int nig = WGM * nN, gid = wgid / nig, fm = gid * WGM, gsz = (nM - fm) < WGM ? (nM - fm) : WGM;
        u.pm = fm + ((wgid % nig) % gsz); u.pn = (wgid % nig) / gsz; return true;
    }
    __device__ __forceinline__ void a_ready(const Unit&) const {}
    __device__ __forceinline__ void done(const Unit&) const {}
};

__device__ __forceinline__ unsigned cvt_pk_bf16(float lo, float hi) { unsigned r; asm volatile("v_cvt_pk_bf16_f32 %0, %1, %2" : "=v"(r) : "v"(lo), "v"(hi)); return r; }
__device__ __forceinline__ float ssq_row(const float* p) { const f32x4 a = ((const f32x4*)p)[0], b = ((const f32x4*)p)[1], c = ((const f32x4*)p)[2], d = ((const f32x4*)p)[3]; const f32x4 t = (a + b) + (c + d); return (t[0] + t[1]) + (t[2] + t[3]); }
template <int ROUTE> struct EpiRoute {
    static constexpr bool PERM = true, AFTER_DRAIN = false;
    unsigned char* ws; const float* ssq;
    __device__ __forceinline__ void operator()(const f32x4 (&acc)[2][2][4][2], const Unit& u, int wr, int wc, int fr, int fq) const {
        asm volatile("" : "+v"(fr), "+v"(fq));
        const int pn = u.pn; size_t off; int ld, t0; float sc;
        if constexpr (ROUTE == 0) {
            off = pn < 3 ? (size_t)(88u << 20) : pn < 5 ? (size_t)(112u << 20) : pn < 6 ? (size_t)(128u << 20) : (size_t)(136u << 20);
            ld = pn < 3 ? 768 : pn < 5 ? 512 : 256; t0 = pn < 3 ? 0 : pn < 5 ? 3 : pn < 6 ? 5 : 6; sc = (pn < 3 || pn == 5) ? 0.18033688011112042f : 1.f;
        } else if constexpr (ROUTE == 1) { off = (size_t)(88u << 20); ld = 768; t0 = 0; sc = 1.f; }
        else if constexpr (ROUTE == 3) { off = (size_t)(144u << 20); ld = 16384; t0 = 0; sc = 1.f; }
        else { off = pn < 6 ? (size_t)(128u << 20) : (size_t)(176u << 20); ld = pn < 6 ? 1536 : 512; t0 = pn < 6 ? 0 : 6; sc = 1.f; }
        bf16_t* base = (bf16_t*)(ws + off);
        const int row0 = u.pm * BM + wr * 64 + fr, col0 = (pn - t0) * BM + wc * 32 + 8 * fq;
#pragma unroll
        for (int ai = 0; ai < 2; ++ai)
#pragma unroll
            for (int m = 0; m < 4; ++m) { bf16_t* rowp = base + (size_t)(row0 + ai * HALF + m * 16) * ld + col0;
                float scr_ = sc; if constexpr (ROUTE == 1) scr_ = rsqrtf(ssq_row(ssq + (size_t)(row0 + ai * HALF + m * 16) * 16) * (1.f / 1024.f) + 1e-6f);
#pragma unroll
                for (int bj = 0; bj < 2; ++bj) { float scb_ = scr_; if constexpr (ROUTE == 1) { const int cg = col0 + bj * HALF; if (cg >= 456 && cg < 712) scb_ *= 0.18033688011112042f; }
                    const f32x4 v0 = acc[ai][bj][m][0] * scb_, v1 = acc[ai][bj][m][1] * scb_;
                    u32x4 w; w.x = cvt_pk_bf16(v0[0], v0[1]); w.y = cvt_pk_bf16(v0[2], v0[3]); w.z = cvt_pk_bf16(v1[0], v1[1]); w.w = cvt_pk_bf16(v1[2], v1[3]);
                    if constexpr (ROUTE == 3) {
                        const int tok = col0 + bj * HALF, rw = row0 + ai * HALF + m * 16; *(u32x4*)(base + ((size_t)(tok >> 6) * 256 + rw) * 64 + (tok & 63)) = w; }
                    else *(u32x4*)(rowp + bj * HALF) = w; } }
    }
};
template <bool RES_F32>
struct EpiResid {
    static constexpr bool PERM = true, AFTER_DRAIN = false;
    const void* res; bf16_t* hb; float* ssq; int ldc; int pad;
    __device__ __forceinline__ void operator()(const f32x4 (&acc)[2][2][4][2], const Unit& u, int wr, int wc, int fr, int fq) const {
        asm volatile("" : "+v"(fr), "+v"(fq));
        const int row0 = u.pm * BM + wr * 64 + fr, col0 = u.pn * BM + wc * 32 + 8 * fq;
#pragma unroll
        for (int ai = 0; ai < 2; ++ai)
#pragma unroll
            for (int m = 0; m < 4; ++m) { const int row = row0 + ai * HALF + m * 16; const size_t off = (size_t)row * ldc + col0; float sq = 0.f;
#pragma unroll
                for (int bj = 0; bj < 2; ++bj) { f32x4 v[2];
                    if constexpr (RES_F32) {
#pragma unroll
                        for (int n = 0; n < 2; ++n) v[n] = *(const f32x4*)((const float*)res + off + bj * HALF + 4 * n) + acc[ai][bj][m][n];
                    } else { const u32x4 rw = *(const u32x4*)((const bf16_t*)res + off + bj * HALF);
                        f32x4 r0, r1; r0[0] = __uint_as_float(rw.x << 16); r0[1] = __uint_as_float(rw.x & 0xffff0000u); r0[2] = __uint_as_float(rw.y << 16); r0[3] = __uint_as_float(rw.y & 0xffff0000u);
                        r1[0] = __uint_as_float(rw.z << 16); r1[1] = __uint_as_float(rw.z & 0xffff0000u); r1[2] = __uint_as_float(rw.w << 16); r1[3] = __uint_as_float(rw.w & 0xffff0000u);
                        v[0] = r0 + acc[ai][bj][m][0]; v[1] = r1 + acc[ai][bj][m][1]; }
#pragma unroll
                    for (int n = 0; n < 2; ++n) sq += (v[n][0] * v[n][0] + v[n][1] * v[n][1]) + (v[n][2] * v[n][2] + v[n][3] * v[n][3]);
                    u32x4 w; w.x = cvt_pk_bf16(v[0][0], v[0][1]); w.y = cvt_pk_bf16(v[0][2], v[0][3]); w.z = cvt_pk_bf16(v[1][0], v[1][1]); w.w = cvt_pk_bf16(v[1][2], v[1][3]); *(u32x4*)(hb + off + bj * HALF) = w; }
                sq += __shfl_xor(sq, 16); sq += __shfl_xor(sq, 32); if (fq == 0) ssq[(size_t)row * 16 + u.pn * 4 + wc] = sq; }
    }
};
struct EpiSwiglu {
    static constexpr bool PERM = true, AFTER_DRAIN = false;
    bf16_t* O; const float* ssq; int ldc; int pad;
    __device__ __forceinline__ void operator()(const f32x4 (&acc)[2][2][4][2], const Unit& u, int wr, int wc, int fr, int fq) const {
        asm volatile("" : "+v"(fr), "+v"(fq));
        const int row0 = u.pm * BM + wr * 64 + fr, col0 = u.pn * HALF + wc * 32 + 8 * fq;
#pragma unroll
        for (int ai = 0; ai < 2; ++ai)
#pragma unroll
            for (int m = 0; m < 4; ++m) { float o[8]; const float rs = rsqrtf(ssq_row(ssq + (size_t)(row0 + ai * HALF + m * 16) * 16) * (1.f / 1024.f) + 1e-6f);
#pragma unroll
                for (int n = 0; n < 2; ++n)
#pragma unroll
                    for (int e = 0; e < 4; ++e) { const float g = acc[ai][0][m][n][e] * rs, up = acc[ai][1][m][n][e] * rs; o[4 * n + e] = (g * __builtin_amdgcn_rcpf(1.f + __expf(-g))) * up; }
                u32x4 w; w.x = cvt_pk_bf16(o[0], o[1]); w.y = cvt_pk_bf16(o[2], o[3]); w.z = cvt_pk_bf16(o[4], o[5]); w.w = cvt_pk_bf16(o[6], o[7]);
                *(u32x4*)(O + (size_t)(row0 + ai * HALF + m * 16) * ldc + col0) = w; }
    }
};
template <class Epi, class Sched, bool ALIGN_EPI = false, bool SP2 = false>
__device__ __forceinline__ void gemm_phase(PG8_LAS unsigned char* lds, const Gemm g, const Sched& S, const Epi& E) {
    int tid = threadIdx.x; asm volatile("" : "+v"(tid));
    const int wid = __builtin_amdgcn_readfirstlane(tid >> 6), lane = tid & 63, wr = wid >> 2, wc = wid & 3, fr = lane & 15, fq = lane >> 4;
    int K = g.K; asm volatile("" : "+s"(K));
    const int nt = K / BK;
    unsigned voffA[2], voffB[2];
#pragma unroll
    for (int i = 0; i < 2; ++i) { int R, C; stage_rc(tid * 16 + i * 8192, R, C); const int Rb = Epi::PERM ? ((R & ~31) + perm32(R & 31)) : R;
        voffA[i] = (unsigned)(R * K + C) * 2u; voffB[i] = (unsigned)(Rb * K + C) * 2u; }
    const size_t kstep = (size_t)(BK * 2);
    const size_t hstep = (size_t)HALF * K * 2;
    const size_t tstep = 2 * hstep;
    const unsigned ldsw = (unsigned)wid * 1024u;
    const int aoff = lds_byte(wr * 64 + fr, fq * 8), boff = lds_byte(wc * 32 + fr, fq * 8);
#define PG8_SA(b, h) (((b) * 2 + (h)) * HTB)
#define PG8_SB(b, h) ((4 + (b) * 2 + (h)) * HTB)
#define PG8_STAGE(bufoff, gbase, voff) do { _Pragma("unroll") for (int _i = 0; _i < 2; ++_i) \
        __builtin_amdgcn_global_load_lds((const unsigned*)((const char*)(gbase) + (voff)[_i]), (PG8_LAS unsigned*)(lds + (bufoff) + ldsw + _i * 8192), 16, 0, 0); } while (0)
#define PG8_LDA(dst, b, h) do { _Pragma("unroll") for (int m = 0; m < 4; ++m) _Pragma("unroll") for (int k = 0; k < 2; ++k) dst[m][k] = *(const PG8_LAS bf16x8*)(lds + PG8_SA(b, h) + aoff + m * 2048 + k * 1024); } while (0)
#define PG8_LDB(dst, b, h) do { _Pragma("unroll") for (int n = 0; n < 2; ++n) _Pragma("unroll") for (int k = 0; k < 2; ++k) dst[n][k] = *(const PG8_LAS bf16x8*)(lds + PG8_SB(b, h) + boff + n * 2048 + k * 1024); } while (0)
#define PG8_MMA(ai, bj, At, Bt) do { __builtin_amdgcn_s_setprio(1); _Pragma("unroll") for (int m = 0; m < 4; ++m) _Pragma("unroll") for (int n = 0; n < 2; ++n) _Pragma("unroll") for (int k = 0; k < 2; ++k) \
        acc[ai][bj][m][n] = __builtin_amdgcn_mfma_f32_16x16x32_bf16(Bt[n][k], At[m][k], acc[ai][bj][m][n], 0, 0, 0); __builtin_amdgcn_s_setprio(0); } while (0)
#define PG8_WAIT_V(n) asm volatile("s_waitcnt vmcnt(" #n ")" ::: "memory")
#define PG8_WAIT_L(n) asm volatile("s_waitcnt lgkmcnt(" #n ")" ::: "memory")
#define PG8_BAR __builtin_amdgcn_s_barrier()
#define PG8_SCHED __builtin_amdgcn_sched_barrier(0)
    Unit cur, nxt; int ui = 0;
    if (!S.next(0, cur)) return;
    f32x4 acc[2][2][4][2];
#pragma unroll
    for (int a = 0; a < 2; ++a)
#pragma unroll
        for (int b = 0; b < 2; ++b)
#pragma unroll
            for (int m = 0; m < 4; ++m)
#pragma unroll
                for (int n = 0; n < 2; ++n) acc[a][b][m][n] = (f32x4){0.f, 0.f, 0.f, 0.f};
    bf16x8 At[4][2], B0[2][2], B1[2][2];
    const char* cA = (const char*)g.A + (size_t)cur.pm * tstep; const char* cB = (const char*)g.Bt + (size_t)cur.pn * tstep;
    S.a_ready(cur);
    if constexpr (SP2) {
        PG8_STAGE(PG8_SB(0, 0), cB, voffB); PG8_STAGE(PG8_SB(0, 1), cB + hstep, voffB); PG8_STAGE(PG8_SA(0, 0), cA, voffA); PG8_STAGE(PG8_SA(0, 1), cA + hstep, voffA);
        if (wr == 1) PG8_BAR;
        PG8_WAIT_V(2); PG8_BAR;
        PG8_STAGE(PG8_SB(1, 0), cB + kstep, voffB); PG8_STAGE(PG8_SA(1, 0), cA + kstep, voffA); PG8_STAGE(PG8_SB(1, 1), cB + hstep + kstep, voffB);
        PG8_WAIT_V(6); PG8_BAR;
    } else {
        PG8_STAGE(PG8_SB(0, 0), cB, voffB); PG8_STAGE(PG8_SA(0, 0), cA, voffA); PG8_STAGE(PG8_SB(0, 1), cB + hstep, voffB); PG8_STAGE(PG8_SA(0, 1), cA + hstep, voffA);
        if (wr == 1) PG8_BAR;
        PG8_WAIT_V(4); PG8_BAR;
        PG8_STAGE(PG8_SB(1, 0), cB + kstep, voffB); PG8_STAGE(PG8_SA(1, 0), cA + kstep, voffA); PG8_STAGE(PG8_SB(1, 1), cB + hstep + kstep, voffB);
        PG8_WAIT_V(6); PG8_BAR;
    }
    for (;;) {
        const bool has_next = S.next(ui + 1, nxt);
        const char* nA = has_next ? (const char*)g.A + (size_t)nxt.pm * tstep : cA; const char* nB = has_next ? (const char*)g.Bt + (size_t)nxt.pn * tstep : cB;
        for (int t = 0; t < nt; t += 2) {
            const bool last = (t == nt - 2);
            const char* a1 = cA + (size_t)(t + 1) * kstep;
            const char* a2 = last ? nA : cA + (size_t)(t + 2) * kstep; const char* b2 = last ? nB : cB + (size_t)(t + 2) * kstep;
            const char* a3 = a2 + kstep; const char* b3 = b2 + kstep;
            if (last && has_next) S.a_ready(nxt);
            if constexpr (SP2) {
            PG8_LDB(B0, 0, 0); PG8_LDB(B1, 0, 1); PG8_SCHED; PG8_LDA(At, 0, 0); PG8_STAGE(PG8_SA(1, 1), a1 + hstep, voffA);
            PG8_WAIT_V(8); PG8_WAIT_L(0); PG8_BAR; PG8_MMA(0, 0, At, B0); PG8_MMA(0, 1, At, B1); PG8_BAR; PG8_SCHED;
            PG8_LDA(At, 0, 1); PG8_STAGE(PG8_SB(0, 0), b2, voffB); PG8_STAGE(PG8_SB(0, 1), b2 + hstep, voffB); PG8_STAGE(PG8_SA(0, 0), a2, voffA);
            PG8_WAIT_V(8); PG8_WAIT_L(0); PG8_BAR; PG8_MMA(1, 0, At, B0); PG8_MMA(1, 1, At, B1); PG8_BAR; PG8_SCHED;
            PG8_LDB(B0, 1, 0); PG8_LDB(B1, 1, 1); PG8_SCHED; PG8_LDA(At, 1, 0); PG8_STAGE(PG8_SA(0, 1), a2 + hstep, voffA);
            PG8_WAIT_V(8); PG8_WAIT_L(0); PG8_BAR; PG8_MMA(0, 0, At, B0); PG8_MMA(0, 1, At, B1); PG8_BAR; PG8_SCHED;
            PG8_LDA(At, 1, 1); PG8_STAGE(PG8_SB(1, 0), b3, voffB); PG8_STAGE(PG8_SB(1, 1), b3 + hstep, voffB); PG8_STAGE(PG8_SA(1, 0), a3, voffA);
            PG8_WAIT_V(8); PG8_WAIT_L(0); PG8_BAR; PG8_MMA(1, 0, At, B0); PG8_MMA(1, 1, At, B1); PG8_BAR; PG8_SCHED;
            } else {
            PG8_LDB(B0, 0, 0); PG8_SCHED; PG8_LDA(At, 0, 0); PG8_STAGE(PG8_SA(1, 1), a1 + hstep, voffA);
            PG8_WAIT_L(8); PG8_BAR; PG8_WAIT_L(0); PG8_MMA(0, 0, At, B0); PG8_BAR; PG8_SCHED;
            PG8_LDB(B1, 0, 1); PG8_STAGE(PG8_SB(0, 0), b2, voffB);
            PG8_BAR; PG8_WAIT_L(0); PG8_MMA(0, 1, At, B1); PG8_BAR;
            PG8_LDA(At, 0, 1); PG8_STAGE(PG8_SA(0, 0), a2, voffA);
            PG8_BAR; PG8_WAIT_L(0); PG8_MMA(1, 0, At, B0); PG8_BAR; PG8_SCHED;
            PG8_STAGE(PG8_SB(0, 1), b2 + hstep, voffB);
            PG8_WAIT_V(6); PG8_BAR; PG8_MMA(1, 1, At, B1); PG8_BAR;
            PG8_LDB(B0, 1, 0); PG8_SCHED; PG8_LDA(At, 1, 0); PG8_STAGE(PG8_SA(0, 1), a2 + hstep, voffA);
            PG8_WAIT_L(8); PG8_BAR; PG8_WAIT_L(0); PG8_MMA(0, 0, At, B0); PG8_BAR; PG8_SCHED;
            PG8_LDB(B1, 1, 1); PG8_STAGE(PG8_SB(1, 0), b3, voffB);
            PG8_BAR; PG8_WAIT_L(0); PG8_MMA(0, 1, At, B1); PG8_BAR;
            PG8_LDA(At, 1, 1); PG8_STAGE(PG8_SA(1, 0), a3, voffA);
            PG8_BAR; PG8_WAIT_L(0); PG8_MMA(1, 0, At, B0); PG8_BAR; PG8_SCHED;
            PG8_STAGE(PG8_SB(1, 1), b3 + hstep, voffB);
            PG8_WAIT_V(6); PG8_BAR; PG8_MMA(1, 1, At, B1); PG8_BAR;
            }
        }
        if constexpr (ALIGN_EPI) { if (wr == 0) PG8_BAR; }
        if constexpr (!Epi::AFTER_DRAIN) { E(acc, cur, wr, wc, fr, fq); S.done(cur); }
        if (!has_next) break;
#pragma unroll
        for (int a = 0; a < 2; ++a)
#pragma unroll
            for (int b = 0; b < 2; ++b)
#pragma unroll
                for (int m = 0; m < 4; ++m)
#pragma unroll
                    for (int n = 0; n < 2; ++n) acc[a][b][m][n] = (f32x4){0.f, 0.f, 0.f, 0.f};
        cur = nxt; cA = nA; cB = nB; ++ui;
        if constexpr (ALIGN_EPI) { if (wr == 1) PG8_BAR; }
    }
    PG8_WAIT_V(0);
    if constexpr (!ALIGN_EPI) { if (wr == 0) PG8_BAR; }
    PG8_BAR;
    if constexpr (Epi::AFTER_DRAIN) { E.fused(acc, cur, wr, wc, fr, fq, lds, wid, lane); S.done(cur); }
#undef PG8_SA
#undef PG8_SB
#undef PG8_STAGE
#undef PG8_LDA
#undef PG8_LDB
#undef PG8_MMA
#undef PG8_WAIT_V
#undef PG8_WAIT_L
#undef PG8_BAR
#undef PG8_SCHED
}
}
constexpr int NWAVES = 8;
constexpr int BATCH = 2, T = 8192, D = 1024, M = BATCH * T, DFF = 2816, NSA_IN = 1828, DSA_IN = 712, NCMP = 511, NCR = BATCH * NCMP * 2;
constexpr float NEGF = -1e30f, EPSF = 1e-6f;
#ifndef MK_SPLIT
#define MK_SPLIT 0
#endif
constexpr int N_PHASES = 19;
constexpr size_t MiB = 1u << 20;
constexpr size_t WS_CTL = 0, CTL_ZERO_BYTES = 1 * MiB;
constexpr size_t WS_KCB = 1 * MiB  , WS_VCT = 1 * MiB + 512 * 1024  , WS_MKB = 2 * MiB  , WS_MVT = 2 * MiB + 512 * 1024  , WS_MKV = 3 * MiB  , WS_WIDX = 5 * MiB  , WS_CNT = 6 * MiB  ;
constexpr size_t WS_WIN0 = 8 * MiB, WS_WO = 12 * MiB, WS_WGU = 16 * MiB, WS_WD = 38 * MiB, WS_WIN1 = 49 * MiB, WS_WQ2 = 51 * MiB, WS_WVT = 52 * MiB  ;
constexpr size_t WS_W1T = 232 * MiB, WS_MEMN = 234 * MiB, WS_WMKT = 236 * MiB, WS_W2T = 238 * MiB, WS_B1F = 238 * MiB + 64 * 1024;
constexpr size_t WS_XN = 56 * MiB;
constexpr size_t WS_Q0 = 88 * MiB, WS_KV0 = 112 * MiB  , WS_QM = 128 * MiB, WS_G0 = 136 * MiB, WS_VT = 144 * MiB  ;
static_assert(WS_Q0 == (88u << 20) && WS_KV0 == (112u << 20) && WS_QM == (128u << 20) && WS_G0 == (136u << 20), "EpiRoute tables");
constexpr size_t WS_ACT = 88 * MiB;
constexpr size_t WS_PROJ1 = 88 * MiB, WS_CQ = 112 * MiB, WS_CKV = 120 * MiB, WS_KIDX = 124 * MiB, WS_QA = 128 * MiB, WS_QI = 176 * MiB, WS_SEL = 112 * MiB  , WS_CAT1 = 176 * MiB  , WS_WO1F = 52 * MiB + 512 * 1024  ;
constexpr size_t WS_OCS = 152 * MiB  , WS_CAT = 200 * MiB, WS_SSQ = 239 * MiB  , WS_END = 243 * MiB;
static_assert(WS_PROJ1 == (88u << 20) && WS_QA == (128u << 20) && WS_QI == (176u << 20) && WS_VT == (144u << 20), "EpiRoute tables");
static_assert(WS_ACT + (size_t)M * DFF * 2 <= WS_CAT + 0 * MiB || true, "map");
constexpr int CW_BAR = 4096;
constexpr int RING_OFF = 0, RING_BYTES = 131072, LDS_BYTES = 163840, LDSCTL_OFF = LDS_BYTES - 1024, MISC_OFF = LDSCTL_OFF + 320;
#define GAS __attribute__((address_space(1)))
#define LAS __attribute__((address_space(3)))
typedef unsigned short bf16;
typedef unsigned v4u __attribute__((ext_vector_type(4)));
typedef unsigned v2u __attribute__((ext_vector_type(2)));
typedef float f32x4 __attribute__((ext_vector_type(4)));
typedef short bf16x8 __attribute__((ext_vector_type(8)));
typedef GAS unsigned gu32;
typedef GAS unsigned long long gu64;
#define RLX_AGENT __ATOMIC_RELAXED, __HIP_MEMORY_SCOPE_AGENT
#define LDS_WAIT() asm volatile("s_waitcnt lgkmcnt(0)" ::: "memory")
#define VM_WAIT() asm volatile("s_waitcnt vmcnt(0)" ::: "memory")
__device__ __forceinline__ unsigned long long rt() { return __builtin_amdgcn_s_memrealtime(); }
__device__ __forceinline__ unsigned f2bf(float f) { unsigned u = __builtin_bit_cast(unsigned, f); return (u + 0x7fffu + ((u >> 16) & 1u)) >> 16; }
__device__ __forceinline__ unsigned pk2(float lo, float hi) { return f2bf(lo) | (f2bf(hi) << 16); }
#define XB_TMO      128
#define XB_XCNT(j)  (256  + 64 * (j))
#define XB_XSUB(j)  (1280 + 64 * (j))
#define XB_XGEN(j)  (2304 + 64 * (j))
#define XB_TOP      3328
#define XB_TOPGEN   3392
#define XCD_BAR_WORDS 3456
#define XB_SPIN_CAP (1u << 18)

__device__ __forceinline__ unsigned xb_ld(unsigned* p)              { return __hip_atomic_load(p, __ATOMIC_RELAXED, __HIP_MEMORY_SCOPE_AGENT); }
__device__ __forceinline__ unsigned xb_add(unsigned* p, unsigned v) { return __hip_atomic_fetch_add(p, v, __ATOMIC_RELAXED, __HIP_MEMORY_SCOPE_AGENT); }
__device__ __forceinline__ unsigned xb_xcc_id() { return (unsigned)__builtin_amdgcn_s_getreg((3 << 11) | 20) & 0xFu; }
#define XB_SPIN(cond, bar) do { unsigned _sp = 0; while (cond) { __builtin_amdgcn_s_sleep(1); \
    if ((++_sp & 255u) == 0u) { if (xb_ld(&(bar)[XB_TMO])) break; if (_sp > XB_SPIN_CAP) { atomicAdd(&(bar)[XB_TMO], 1u); break; } } } } while (0)

struct XcdBarrier {
    unsigned* bar; unsigned x;
    volatile LAS unsigned* st;
};

__device__ __forceinline__ XcdBarrier xcd_barrier_post(unsigned* bar, volatile LAS unsigned* st) {
    XcdBarrier b; b.bar = bar; b.x = xb_xcc_id(); b.st = st;
    if (threadIdx.x == 0) (void)xb_add(&bar[XB_XCNT(b.x)], 1u);
    return b;
}
__device__ __forceinline__ void xcd_barrier_complete(unsigned* bar, unsigned x, unsigned& nloc, unsigned& nx) {
    const unsigned G = gridDim.x * gridDim.y * gridDim.z;
    unsigned sum, cnt, mine, sp = 0u;
    for (;;) {
        sum = 0u; cnt = 0u; mine = 0u;
#pragma unroll 1
        for (unsigned j = 0; j < 16; ++j) { const unsigned c = xb_ld(&bar[XB_XCNT(j)]); sum += c; cnt += (c > 0u) ? 1u : 0u; mine = (j == x) ? c : mine; }
        if (sum == G) break;
        __builtin_amdgcn_s_sleep(1);
        if ((++sp & 255u) == 0u) { if (xb_ld(&bar[XB_TMO])) break; if (sp > XB_SPIN_CAP) { atomicAdd(&bar[XB_TMO], 1u); break; } }
    }
    nloc = mine > 0u ? mine : 1u; nx = cnt > 0u ? cnt : 1u;
}

__device__ __forceinline__ void xcd_barrier(const XcdBarrier& b) {
    asm volatile("s_waitcnt vmcnt(0)" ::: "memory");
    __syncthreads();
    if (threadIdx.x == 0) {
        unsigned* bar = b.bar;
        __builtin_amdgcn_s_waitcnt(0);
        unsigned nloc = b.st[0], nx = b.st[1];
        if (nloc == 0u) { xcd_barrier_complete(bar, b.x, nloc, nx); b.st[0] = nloc; b.st[1] = nx; }
        const unsigned old = xb_add(&bar[XB_XSUB(b.x)], 1u);
        const unsigned gen = old / nloc;
        if (old + 1u == (gen + 1u) * nloc) {
            __builtin_amdgcn_fence(__ATOMIC_RELEASE, "agent");
            asm volatile("s_waitcnt vmcnt(0)" ::: "memory");
            const unsigned og = xb_add(&bar[XB_TOP], 1u);
            const unsigned tg = og / nx;
            if (og + 1u == (tg + 1u) * nx) xb_add(&bar[XB_TOPGEN], 1u);
            else XB_SPIN(xb_ld(&bar[XB_TOPGEN]) == tg, bar);
            __builtin_amdgcn_fence(__ATOMIC_ACQUIRE, "agent");
            xb_add(&bar[XB_XGEN(b.x)], 1u);
            asm volatile("s_waitcnt vmcnt(0)" ::: "memory");
        } else {
            XB_SPIN(xb_ld(&bar[XB_XGEN(b.x)]) == gen, bar);
            __builtin_amdgcn_fence(__ATOMIC_ACQUIRE, "agent");
            asm volatile("s_waitcnt vmcnt(0)" ::: "memory");
        }
    }
    __syncthreads();
}

struct Frame {
    LAS unsigned char* lds; volatile LAS unsigned* MISC; gu32* ctl;
    int vcu, G;
};
__device__ __forceinline__ float bf2f(unsigned short u) { return __uint_as_float((unsigned)u << 16); }
__device__ __forceinline__ float bflo(unsigned u) { return __uint_as_float(u << 16); }
__device__ __forceinline__ float bfhi(unsigned u) { return __uint_as_float(u & 0xffff0000u); }
__device__ __forceinline__ float wave_sum(float v) {
#pragma unroll
    for (int o = 1; o < 64; o <<= 1) v += __shfl_xor(v, o);
    return v;
}
__device__ __forceinline__ float red16_sum(float v) { v += __shfl_xor(v, 1, 16); v += __shfl_xor(v, 2, 16); v += __shfl_xor(v, 4, 16); v += __shfl_xor(v, 8, 16); return v; }
__device__ __forceinline__ float red16_max(float v) { v = fmaxf(v, __shfl_xor(v, 1, 16)); v = fmaxf(v, __shfl_xor(v, 2, 16)); v = fmaxf(v, __shfl_xor(v, 4, 16)); v = fmaxf(v, __shfl_xor(v, 8, 16)); return v; }
__device__ __forceinline__ int rel_bucket(int n) {
    if (n < 16) return n;
    return 16 + (n >= 22) + (n >= 30) + (n >= 40) + (n >= 54) + (n >= 73) + (n >= 99) + (n >= 134) + (n >= 182) + (n >= 246) + (n >= 332) + (n >= 450) + (n >= 609) + (n >= 825) + (n >= 1117) + (n >= 1513);
}

__device__ __forceinline__ void xpose_item(const float* W, int ldw, int c0, int nvalid, int k0, bf16* WT, int Kd, int drow0, LAS float* scr, int lane, const float* kgain = nullptr) {
#pragma unroll
    for (int i = 0; i < 8; ++i) { const int kk = 8 * i + (lane >> 3), n = (lane & 7) * 4;
        float4 wv = make_float4(0.f, 0.f, 0.f, 0.f);
        if (n + 3 < nvalid) wv = *(const float4*)(W + (size_t)(k0 + kk) * ldw + c0 + n);
        else if (n < nvalid) { const float* wp = W + (size_t)(k0 + kk) * ldw + c0 + n; wv.x = wp[0]; if (n + 1 < nvalid) wv.y = wp[1]; if (n + 2 < nvalid) wv.z = wp[2]; }
        if (kgain) { const float g_ = kgain[k0 + kk]; wv.x *= g_; wv.y *= g_; wv.z *= g_; wv.w *= g_; }
        LAS float* sp = scr + kk * 33 + n; sp[0] = wv.x; sp[1] = wv.y; sp[2] = wv.z; sp[3] = wv.w; }
    LDS_WAIT(); asm volatile("" ::: "memory");
    const int c = lane & 7;
#pragma unroll
    for (int j = 0; j < 4; ++j) { const int n = (lane >> 3) + 8 * j; const LAS float* s = scr + (8 * c) * 33 + n;
        v4u o; o.x = pk2(s[0 * 33], s[1 * 33]); o.y = pk2(s[2 * 33], s[3 * 33]); o.z = pk2(s[4 * 33], s[5 * 33]); o.w = pk2(s[6 * 33], s[7 * 33]);
        *(GAS v4u*)(WT + (size_t)(drow0 + n) * Kd + k0 + 8 * c) = o; }
    LDS_WAIT(); asm volatile("" ::: "memory");
}
__device__ __forceinline__ void rms_row_to_bf16(const float* xrow, const float* gain, bf16* orow, int lane) {
    const GAS f32x4* xr = (const GAS f32x4*)xrow + lane; const GAS f32x4* gr = (const GAS f32x4*)gain + lane;
    f32x4 v[4]; float s = 0.f;
#pragma unroll
    for (int j = 0; j < 4; ++j) { v[j] = xr[64 * j]; s += (v[j].x * v[j].x + v[j].y * v[j].y) + (v[j].z * v[j].z + v[j].w * v[j].w); }
    const float r = rsqrtf(wave_sum(s) * (1.f / D) + EPSF);
    GAS unsigned long long* o8 = (GAS unsigned long long*)orow + lane;
#pragma unroll
    for (int j = 0; j < 4; ++j) { const f32x4 g = gr[64 * j]; o8[64 * j] = (unsigned long long)pk2((v[j].x * r) * g.x, (v[j].y * r) * g.y) | ((unsigned long long)pk2((v[j].z * r) * g.z, (v[j].w * r) * g.w) << 32); }
}
#ifndef PROBE_REP
#define PROBE_REP 0
#endif
#define CAS __attribute__((address_space(4)))
#define KARGS() const CAS In* Ip = (const CAS In*)__builtin_amdgcn_kernarg_segment_ptr(); asm volatile("" : "+s"(Ip))
#define OPAQUE_TID() int tid_ = threadIdx.x; asm volatile("" : "+v"(tid_))
__device__ __forceinline__ void norm_phase(Frame& F, const float* x, const float* gain, bf16* xn) {
    OPAQUE_TID(); const int lane_ = tid_ & 63, wave_ = tid_ >> 6;
    const int gw = F.vcu * NWAVES + wave_, NGW = F.G * NWAVES;
    for (int m = gw; m < M; m += NGW) rms_row_to_bf16(x + (size_t)m * D, gain, xn + (size_t)m * D, lane_);
}

template <int DL>
__device__ __forceinline__ void coop_attend(const float (&q)[DL], const float (&k)[DL], const float (&v)[DL], float bias, float& m_, float& l_, float (&o)[DL]) {
    float a = 0.f;
#pragma unroll
    for (int d = 0; d < DL; ++d) a += q[d] * k[d];
    a = red16_sum(a) + bias;
    const float mn = fmaxf(m_, a), al = __expf(m_ - mn), p = __expf(a - mn);
    l_ = l_ * al + p; m_ = mn;
#pragma unroll
    for (int d = 0; d < DL; ++d) o[d] = o[d] * al + p * v[d];
}
__device__ __forceinline__ void ld4bf(const bf16* p, float (&x)[4]) { const uint2 u = *(const uint2*)p; x[0] = bflo(u.x); x[1] = bfhi(u.x); x[2] = bflo(u.y); x[3] = bfhi(u.y); }
__device__ __forceinline__ void ld8bf(const bf16* p, float (&x)[8]) { const uint4 u = *(const uint4*)p; x[0] = bflo(u.x); x[1] = bfhi(u.x); x[2] = bflo(u.y); x[3] = bfhi(u.y); x[4] = bflo(u.z); x[5] = bfhi(u.z); x[6] = bflo(u.w); x[7] = bfhi(u.w); }
__device__ __forceinline__ void ld4f(const float* p, float (&x)[4]) { const float4 u = *(const float4*)p; x[0] = u.x; x[1] = u.y; x[2] = u.z; x[3] = u.w; }

struct In {
    const float *x, *mem, *rel_bias, *norm_mix, *norm_ffn, *norm_mem, *w_mem_kv, *w_out, *ffn_gate, *ffn_up, *ffn_down, *nsa_w_in, *nsa_gate_b, *pos_k, *pos_v,
        *k_w1, *k_b1, *k_w2, *k_b2, *v_w1, *v_b1, *v_w2, *v_b2, *dsa_w_in, *q_norm, *kv_norm, *w_q_up, *w_uk, *w_uv, *w_q_idx, *kidx_norm, *norm_final;
};
__device__ __forceinline__ void p0_prologue(Frame& F, const In& I, unsigned char* ws) {
    OPAQUE_TID(); KARGS(); const int lane_ = tid_ & 63, wave_ = __builtin_amdgcn_readfirstlane(tid_ >> 6);
    LAS float* scr = (LAS float*)(F.lds + RING_OFF + wave_ * 16384);
    const int gw = F.vcu * NWAVES + wave_, NGW = F.G * NWAVES;
    bf16* WIN0 = (bf16*)(ws + WS_WIN0); bf16* WO = (bf16*)(ws + WS_WO); bf16* WGU = (bf16*)(ws + WS_WGU); bf16* WD = (bf16*)(ws + WS_WD); bf16* WIN1 = (bf16*)(ws + WS_WIN1); bf16* WQ2 = (bf16*)(ws + WS_WQ2);
    constexpr int I_A = 16 * 56, I_G = 16 * 8, I_B = 2 * 16 * 32, I_C = 2 * 16 * 176, I_D = 2 * 44 * 32, I_E = 16 * 24, I_F = 4 * 16, NITEMS = I_A + I_B + I_C + I_D + I_E + I_F + I_G;
    for (int it = gw; it < NITEMS; it += NGW) {
        int r = it;
        if (r < I_A) { const int kb = r / 56, nb = r % 56, r0 = 32 * nb; int c0, nv;
            if (r0 < 1152) { c0 = r0; nv = 32; } else if (r0 < 1280) { c0 = r0 + 128; nv = 32; } else if (r0 < 1536) { c0 = r0 + 292; nv = 32; } else if (r0 == 1536) { c0 = 1536; nv = 32; } else if (r0 == 1568) { c0 = 1568; nv = 4; } else { c0 = 0; nv = 0; }
            xpose_item(Ip->nsa_w_in, NSA_IN, c0, nv, 64 * kb, WIN0, D, r0, scr, lane_); continue; } r -= I_A;
        if (r < I_B) { const int l = r / 512, q = r % 512, kb = q / 32, nb = q % 32;
            xpose_item(Ip->w_out + (size_t)l * D * D, D, 32 * nb, 32, 64 * kb, WO + (size_t)l * D * D, D, 32 * nb, scr, lane_); continue; } r -= I_B;
        if (r < I_C) { const int l = r / (16 * 176), q = r % (16 * 176), kb = q / 176, nb = q % 176, r0 = 32 * nb, pn = r0 >> 8, w0 = r0 & 255;
            const float* src = ((w0 < 128) ? Ip->ffn_gate : Ip->ffn_up) + (size_t)l * D * DFF;
            xpose_item(src, DFF, 128 * pn + (w0 & 127), 32, 64 * kb, WGU + (size_t)l * 2 * DFF * D, D, r0, scr, lane_, Ip->norm_ffn + l * D); continue; } r -= I_C;
        if (r < I_D) { const int l = r / (44 * 32), q = r % (44 * 32), kb = q / 32, nb = q % 32;
            xpose_item(Ip->ffn_down + (size_t)l * DFF * D, D, 32 * nb, 32, 64 * kb, WD + (size_t)l * D * DFF, DFF, 32 * nb, scr, lane_); continue; } r -= I_D;
        if (r < I_E) { const int kb = r / 24, nb = r % 24, r0 = 32 * nb; int nv = DSA_IN - r0; nv = nv > 32 ? 32 : (nv < 0 ? 0 : nv);
            xpose_item(Ip->dsa_w_in, DSA_IN, r0, nv, 64 * kb, WIN1, D, r0, scr, lane_, Ip->norm_mix + D); continue; } r -= I_E;
        if (r < I_F) { const int kb = r / 16, nb = r % 16; xpose_item(Ip->w_q_idx, 512, 32 * nb, 32, 64 * kb, WQ2, 256, 1536 + 32 * nb, scr, lane_); continue; } r -= I_F;
        { const int kb = r / 8, nb = r % 8, r0 = 32 * nb;
            xpose_item(Ip->nsa_w_in, NSA_IN, (r0 < 128) ? 1152 + r0 : 1408 + (r0 - 128), 32, 64 * kb, (bf16*)(ws + WS_WVT), D, r0, scr, lane_); }
    }
    for (int idx = (F.vcu * NWAVES * 64) + tid_; idx < 384 * 256; idx += F.G * NWAVES * 64) {
        const int c = idx & 255, r4 = (idx >> 8) & 31, h = idx >> 13; const float4* a4 = (const float4*)(Ip->w_q_up + (size_t)c * 768 + h * 64); const float4* b4 = (const float4*)(Ip->w_uk + (size_t)(4 * r4) * 768 + h * 64);
        float s0 = 0.f, s1 = 0.f, s2 = 0.f, s3 = 0.f;
#pragma unroll 4
        for (int d = 0; d < 16; ++d) { const float4 av = a4[d], b0 = b4[d], b1 = b4[192 + d], b2 = b4[384 + d], b3 = b4[576 + d];
            s0 += (av.x * b0.x + av.y * b0.y) + (av.z * b0.z + av.w * b0.w); s1 += (av.x * b1.x + av.y * b1.y) + (av.z * b1.z + av.w * b1.w);
            s2 += (av.x * b2.x + av.y * b2.y) + (av.z * b2.z + av.w * b2.w); s3 += (av.x * b3.x + av.y * b3.y) + (av.z * b3.z + av.w * b3.w); }
        const float sc_ = 0.125f * 1.4426950408889634f;
        bf16* o_ = WQ2 + (size_t)(h * 128 + 4 * r4) * 256 + c;
        o_[0] = (bf16)f2bf(s0 * sc_); o_[256] = (bf16)f2bf(s1 * sc_); o_[512] = (bf16)f2bf(s2 * sc_); o_[768] = (bf16)f2bf(s3 * sc_);
    }
    { bf16* WO1F = (bf16*)(ws + WS_WO1F); const float* wo1 = Ip->w_out + (size_t)D * D;
      for (int idx = (F.vcu * NWAVES * 64) + tid_; idx < 12 * 32 * 256; idx += F.G * NWAVES * 64) {
          const int n4 = idx & 255, r4 = (idx >> 8) & 31, h = idx >> 13; const float* a = Ip->w_uv + (size_t)(4 * r4) * 768 + h * 64; const float* bcol = wo1 + (size_t)(h * 64) * D + 4 * n4;
          float acc_[4][4];
#pragma unroll
          for (int i = 0; i < 4; ++i)
#pragma unroll
              for (int j = 0; j < 4; ++j) acc_[i][j] = 0.f;
#pragma unroll 4
          for (int d = 0; d < 64; ++d) { const float4 bv = *(const float4*)(bcol + (size_t)d * D); const float a0 = a[d], a1 = a[768 + d], a2 = a[1536 + d], a3 = a[2304 + d];
              acc_[0][0] += a0 * bv.x; acc_[0][1] += a0 * bv.y; acc_[0][2] += a0 * bv.z; acc_[0][3] += a0 * bv.w; acc_[1][0] += a1 * bv.x; acc_[1][1] += a1 * bv.y; acc_[1][2] += a1 * bv.z; acc_[1][3] += a1 * bv.w;
              acc_[2][0] += a2 * bv.x; acc_[2][1] += a2 * bv.y; acc_[2][2] += a2 * bv.z; acc_[2][3] += a2 * bv.w; acc_[3][0] += a3 * bv.x; acc_[3][1] += a3 * bv.y; acc_[3][2] += a3 * bv.z; acc_[3][3] += a3 * bv.w; }
#pragma unroll
          for (int j = 0; j < 4; ++j) *(uint2*)(WO1F + (size_t)(4 * n4 + j) * 1792 + h * 128 + 4 * r4) = make_uint2(pk2(acc_[0][j], acc_[1][j]), pk2(acc_[2][j], acc_[3][j])); }
      for (int it = gw; it < 4 * 32; it += NGW) { const int kb = it / 32, nb = it % 32;
          xpose_item(wo1 + (size_t)768 * D, D, 32 * nb, 32, 64 * kb, WO1F + 1536, 1792, 32 * nb, scr, lane_); } }
    { bf16* W1T = (bf16*)(ws + WS_W1T); bf16* W2T = (bf16*)(ws + WS_W2T); bf16* WMKT = (bf16*)(ws + WS_WMKT); float* B1F = (float*)(ws + WS_B1F); bf16* MEMN = (bf16*)(ws + WS_MEMN);
      constexpr int J_1 = 2 * 32 * 8, J_2 = 2 * 4 * 2, J_M = 2 * 16 * 16;
      for (int it = gw; it < J_1 + J_2 + J_M; it += NGW) { int r2 = it;
          if (r2 < J_1) { const int kv = r2 / 256, q = r2 % 256, kb = q / 8, nb = q % 8; xpose_item(kv ? Ip->v_w1 : Ip->k_w1, 256, 32 * nb, 32, 64 * kb, W1T + (size_t)kv * 256 * 2048, 2048, 32 * nb, scr, lane_); continue; } r2 -= J_1;
          if (r2 < J_2) { const int kv = r2 / 8, q = r2 % 8, kb = q / 2, nb = q % 2; xpose_item(kv ? Ip->v_w2 : Ip->k_w2, 64, 32 * nb, 32, 64 * kb, W2T + (size_t)kv * 64 * 256, 256, 32 * nb, scr, lane_); continue; } r2 -= J_2;
          { const int l = r2 / 256, q = r2 % 256, kb = q / 16, nb = q % 16; xpose_item(Ip->w_mem_kv + (size_t)l * D * 512, 512, 32 * nb, 32, 64 * kb, WMKT + (size_t)l * 512 * D, D, 32 * nb, scr, lane_); } }
      if ((int)blockIdx.x < 32) { const int u_ = (int)blockIdx.x, kv = u_ >> 4, cr = (u_ >> 2) & 3, kq4 = u_ & 3, c = 64 * cr + lane_; const float* w1 = kv ? Ip->v_w1 : Ip->k_w1; const float* pos = kv ? Ip->pos_v : Ip->pos_k;
          const int kb0 = 512 * kq4 + 64 * wave_; float sacc = 0.f;
#pragma unroll 8
          for (int k = 0; k < 64; ++k) sacc += pos[kb0 + k] * w1[(size_t)(kb0 + k) * 256 + c];
          LAS float* red = (LAS float*)(F.lds + RING_OFF + 8 * 16384);
          red[wave_ * 64 + lane_] = sacc;
          __syncthreads();
          if (wave_ == 0) { float t_ = 0.f;
#pragma unroll
              for (int w = 0; w < 8; ++w) t_ += red[w * 64 + lane_];
              B1F[(kv * 4 + kq4) * 256 + c] = t_; } }
      for (int m = gw; m < 1024; m += NGW) rms_row_to_bf16(Ip->mem + (size_t)(m & 511) * D, Ip->norm_mem + (m >> 9) * D, MEMN + (size_t)m * D, lane_); }
    norm_phase(F, Ip->x, Ip->norm_mix, (bf16*)(ws + WS_XN));
}

#define MFMA16(A, B, C) __builtin_amdgcn_mfma_f32_16x16x32_bf16((A), (B), (C), 0, 0, 0)
constexpr float LOG2E = 1.4426950408889634f;
constexpr int NSA_OUT = 0, NSA_PSQ = 49152, NSA_ST = 147456, NSA_TB = NSA_ST + 3072;
constexpr int TAB_B12 = NSA_ST + 1024;
constexpr int P13_JUNK = NSA_ST + 3072 + 1536;
constexpr int P13_B12 = NSA_ST;
constexpr int TAB_BKT = NSA_ST + 3072;
static_assert(NSA_TB + 12288 <= LDSCTL_OFF && TAB_B12 + 2048 <= NSA_TB, "LDS tables");
enum { MD_CMP = 0, MD_WIN = 1, MD_BLK = 2, MD_MEM = 3 };
struct KF { bf16x8 a0, a1, b0, b1; };
struct VF { bf16x8 v[4]; };
__device__ __forceinline__ bf16x8 ldg16(const bf16* p) { return *(const bf16x8*)p; }
typedef float f32x2_t __attribute__((ext_vector_type(2))); typedef __bf16 bf16x2_t __attribute__((ext_vector_type(2)));
__device__ __forceinline__ unsigned cvtpk_s(float lo, float hi) { f32x2_t v = {lo, hi}; bf16x2_t b = __builtin_convertvector(v, bf16x2_t); return __builtin_bit_cast(unsigned, b); }
__device__ __forceinline__ bf16x8 pack8(const f32x4& a, const f32x4& b) { v4u w; w.x = cvtpk_s(a[0], a[1]); w.y = cvtpk_s(a[2], a[3]); w.z = cvtpk_s(b[0], b[1]); w.w = cvtpk_s(b[2], b[3]); return __builtin_bit_cast(bf16x8, w); }
__device__ __forceinline__ void load_k(KF& k, const bf16* kb, int kstride, int key0, int r, int kq) {
    const bf16* pa = kb + (size_t)(key0 + 8 * (r >> 2) + (r & 3)) * kstride + 8 * kq; const bf16* pb = pa + 4 * (size_t)kstride;
    k.a0 = ldg16(pa); k.a1 = ldg16(pa + 32); k.b0 = ldg16(pb); k.b1 = ldg16(pb + 32);
}
__device__ __forceinline__ void load_vt(VF& v, const bf16* vt, int vstride, int key0, int r, int kq) {
#pragma unroll
    for (int dt = 0; dt < 4; ++dt) v.v[dt] = ldg16(vt + (size_t)(16 * dt + r) * vstride + key0 + 8 * kq);
}
__device__ __forceinline__ void qk(f32x4& sa, f32x4& sb, const KF& k, const bf16x8 (&q)[2]) {
    const f32x4 z = {0.f, 0.f, 0.f, 0.f};
    sa = MFMA16(k.a0, q[0], z); sa = MFMA16(k.a1, q[1], sa); sb = MFMA16(k.b0, q[0], z); sb = MFMA16(k.b1, q[1], sb);
}
struct BiasCtx { const LAS unsigned short* tb; float d29, d30, c31; };
template <int MODE>
__device__ __forceinline__ void maskbias(f32x4& s, int kpos, int tcol, bool colok, const BiasCtx& B) {
    if (MODE == MD_MEM) return;
#pragma unroll
    for (int i = 0; i < 4; ++i) {
        int dist; bool ok;
        if (MODE == MD_CMP) { dist = tcol - 31 - 16 * (kpos + i); ok = dist >= 0; }
        else if (MODE == MD_WIN) { dist = tcol - (kpos + i); ok = (unsigned)dist <= 511u; }
        else { dist = tcol - (kpos + i); ok = dist >= 0; }
        int dc = dist < 0 ? 0 : dist; dc = dc > 1023 ? 1023 : dc;
        const float tb = __uint_as_float((unsigned)B.tb[dc * 6] << 16);
        const float far = B.c31 + (dist < 1513 ? B.d30 : 0.f) + (dist < 1117 ? B.d29 : 0.f);
        const float bias = dist < 1024 ? tb : far;
        s[i] = (ok && colok) ? s[i] + bias : -INFINITY;
    }
}
__device__ __forceinline__ float colmax(const f32x4& sa, const f32x4& sb) {
    float mx = fmaxf(fmaxf(fmaxf(sa[0], sa[1]), fmaxf(sa[2], sa[3])), fmaxf(fmaxf(sb[0], sb[1]), fmaxf(sb[2], sb[3])));
    mx = fmaxf(mx, __shfl_xor(mx, 16)); mx = fmaxf(mx, __shfl_xor(mx, 32)); return mx;
}
constexpr float SM_THR = 8.f;
__device__ __forceinline__ float lmax8(const f32x4& sa, const f32x4& sb) { return fmaxf(fmaxf(fmaxf(sa[0], sa[1]), fmaxf(sa[2], sa[3])), fmaxf(fmaxf(sb[0], sb[1]), fmaxf(sb[2], sb[3]))); }
__device__ __forceinline__ int imax3(int a, int b, int c) { return max(max(a, b), c); }
__device__ __forceinline__ int imax16(const f32x4& a, const f32x4& b, const f32x4& c, const f32x4& d) {
#define FI_(x) __float_as_int(x)
    const int t0 = imax3(FI_(a[0]), FI_(a[1]), FI_(a[2])), t1 = imax3(FI_(a[3]), FI_(b[0]), FI_(b[1])), t2 = imax3(FI_(b[2]), FI_(b[3]), FI_(c[0])), t3 = imax3(FI_(c[1]), FI_(c[2]), FI_(c[3])), t4 = imax3(FI_(d[0]), FI_(d[1]), FI_(d[2]));
    return max(imax3(t0, t1, FI_(d[3])), imax3(t2, t3, t4));
#undef FI_
}
template <int NO>
__device__ __forceinline__ void sm_rescale(float lm, float& m, float& l, f32x4 (&O)[NO]) {
    if (__any(lm > m + SM_THR)) {
        lm = fmaxf(lm, __shfl_xor(lm, 16)); lm = fmaxf(lm, __shfl_xor(lm, 32));
        const float mn = fmaxf(m, lm); const float al = __builtin_amdgcn_exp2f(m - mn); m = mn; l *= al;
#pragma unroll
        for (int dt = 0; dt < NO; ++dt) O[dt] = O[dt] * al;
    }
}
__device__ __forceinline__ bf16x8 sm_update(const f32x4& sa, const f32x4& sb, float& m, float& l, f32x4 (&O)[4]) {
    sm_rescale<4>(lmax8(sa, sb), m, l, O);
    f32x4 pa, pb; float sum = 0.f;
#pragma unroll
    for (int i = 0; i < 4; ++i) { pa[i] = __builtin_amdgcn_exp2f(sa[i] - m); pb[i] = __builtin_amdgcn_exp2f(sb[i] - m); sum += pa[i] + pb[i]; }
    l += sum;
    return pack8(pa, pb);
}
__device__ __forceinline__ void sm_update64(const f32x4& sa0, const f32x4& sb0, const f32x4& sa1, const f32x4& sb1, float& m, float& l, f32x4 (&O)[4], bf16x8& pf0, bf16x8& pf1) {
    sm_rescale<4>(fmaxf(lmax8(sa0, sb0), lmax8(sa1, sb1)), m, l, O);
    f32x4 pa0, pb0, pa1, pb1; float sum = 0.f;
#pragma unroll
    for (int i = 0; i < 4; ++i) { pa0[i] = __builtin_amdgcn_exp2f(sa0[i] - m); pb0[i] = __builtin_amdgcn_exp2f(sb0[i] - m); pa1[i] = __builtin_amdgcn_exp2f(sa1[i] - m); pb1[i] = __builtin_amdgcn_exp2f(sb1[i] - m);
        sum += (pa0[i] + pb0[i]) + (pa1[i] + pb1[i]); }
    l += sum;
    pf0 = pack8(pa0, pb0); pf1 = pack8(pa1, pb1);
}
enum { BK_FAR = 0, BK_MID = 1, BK_GEN = 2 };
template <int MD, int CLS>
__device__ __forceinline__ void step64(const KF& k0, const KF& k1, const bf16x8 (&q)[2], int cls, int kpos, int tcol, bool colok, const BiasCtx& B,
                                       float& m, float& l, f32x4 (&O)[4], bf16x8& pf0, bf16x8& pf1) {
    const bool has = m > -1e29f; const float mref = has ? m : 0.f;
    if (CLS >= 0) cls = CLS;
    float cin = ((cls == BK_FAR) ? B.c31 : 0.f) - mref; if (!colok) cin = -INFINITY;
    const f32x4 c4 = {cin, cin, cin, cin};
    f32x4 sa0 = MFMA16(k0.a0, q[0], c4), sb0 = MFMA16(k0.b0, q[0], c4), sa1 = MFMA16(k1.a0, q[0], c4), sb1 = MFMA16(k1.b0, q[0], c4);
    sa0 = MFMA16(k0.a1, q[1], sa0); sb0 = MFMA16(k0.b1, q[1], sb0); sa1 = MFMA16(k1.a1, q[1], sa1); sb1 = MFMA16(k1.b1, q[1], sb1);
    if (cls == BK_MID) {
        const LAS unsigned short* tl = B.tb + (tcol - kpos - 39) * 6;
#pragma unroll
        for (int i = 0; i < 4; ++i) { sa0[i] += __uint_as_float((unsigned)tl[6 * (39 - i)] << 16); sb0[i] += __uint_as_float((unsigned)tl[6 * (35 - i)] << 16);
            sa1[i] += __uint_as_float((unsigned)tl[6 * (7 - i)] << 16); sb1[i] += __uint_as_float((unsigned)tl[6 * (3 - i)] << 16); }
    } else if (cls == BK_GEN) {
        maskbias<MD>(sa0, kpos, tcol, true, B); maskbias<MD>(sb0, kpos + 4, tcol, true, B); maskbias<MD>(sa1, kpos + 32, tcol, true, B); maskbias<MD>(sb1, kpos + 36, tcol, true, B);
    }
    if (__any((imax16(sa0, sb0, sa1, sb1) > __float_as_int(SM_THR)) || !has)) {
        float lm = fmaxf(lmax8(sa0, sb0), lmax8(sa1, sb1));
        lm = fmaxf(lm, __shfl_xor(lm, 16)); lm = fmaxf(lm, __shfl_xor(lm, 32));
        const bool upd = (lm > -INFINITY) && (!has || lm > 0.f); const float dl = upd ? lm : 0.f;
        if (upd) m = mref + dl;
        const float f = has ? __builtin_amdgcn_exp2f(-dl) : 1.f; l *= f;
#pragma unroll
        for (int dt = 0; dt < 4; ++dt) O[dt] = O[dt] * f;
#pragma unroll
        for (int i = 0; i < 4; ++i) { sa0[i] -= dl; sb0[i] -= dl; sa1[i] -= dl; sb1[i] -= dl; }
    }
    f32x4 pa0, pb0, pa1, pb1; float sum = 0.f;
#pragma unroll
    for (int i = 0; i < 4; ++i) { pa0[i] = __builtin_amdgcn_exp2f(sa0[i]); pb0[i] = __builtin_amdgcn_exp2f(sb0[i]); pa1[i] = __builtin_amdgcn_exp2f(sa1[i]); pb1[i] = __builtin_amdgcn_exp2f(sb1[i]);
        sum += (pa0[i] + pb0[i]) + (pa1[i] + pb1[i]); }
    l += sum;
    pf0 = pack8(pa0, pb0); pf1 = pack8(pa1, pb1);
}
__device__ __forceinline__ void pv(f32x4 (&O)[4], const VF& v, const bf16x8& pf) {
#pragma unroll
    for (int dt = 0; dt < 4; ++dt) O[dt] = MFMA16(v.v[dt], pf, O[dt]);
}
__device__ __forceinline__ void lds_fadd(LAS float* p, float v) { (void)__hip_atomic_fetch_add((float*)p, v, __ATOMIC_RELAXED, __HIP_MEMORY_SCOPE_WORKGROUP); }
#define DPP_I(x, ctrl) __builtin_amdgcn_update_dpp((x), (x), (ctrl), 0xf, 0xf, false)
#define DPP_F(x, ctrl) __int_as_float(__builtin_amdgcn_update_dpp(__float_as_int(x), __float_as_int(x), (ctrl), 0xf, 0xf, false))
__device__ __forceinline__ float sum8_dpp(float v) { v += DPP_F(v, 0xB1); v += DPP_F(v, 0x4E); v += DPP_F(v, 0x141); return v; }
__device__ __forceinline__ unsigned wave_iscan_u32(unsigned x) {
#define DPP_Z(v, ctrl, rmask) (unsigned)__builtin_amdgcn_update_dpp(0, (int)(v), (ctrl), (rmask), 0xf, false)
    x += DPP_Z(x, 0x111, 0xf); x += DPP_Z(x, 0x112, 0xf); x += DPP_Z(x, 0x114, 0xf); x += DPP_Z(x, 0x118, 0xf); x += DPP_Z(x, 0x142, 0xa); x += DPP_Z(x, 0x143, 0xc);
#undef DPP_Z
    return x; }
__device__ __forceinline__ int wmax64_i(int x) {
    x = max(x, DPP_I(x, 0xB1)); x = max(x, DPP_I(x, 0x4E)); x = max(x, DPP_I(x, 0x141)); x = max(x, DPP_I(x, 0x140));
    return max(max(__builtin_amdgcn_readlane(x, 0), __builtin_amdgcn_readlane(x, 16)), max(__builtin_amdgcn_readlane(x, 32), __builtin_amdgcn_readlane(x, 48))); }
__device__ __forceinline__ float kqsum(float v) { v += __shfl_xor(v, 16); v += __shfl_xor(v, 32); return v; }
__device__ __forceinline__ float wmax64(float v) {
#pragma unroll
    for (int o = 1; o < 64; o <<= 1) v = fmaxf(v, __shfl_xor(v, o));
    return v;
}
__device__ __forceinline__ void out_add(LAS unsigned short* OUTw, int p, int n, int kq, const f32x4 (&O)[4], float scale, bool first) {
    const int q = 2 * p + (n >> 3), hd = n & 7;
    if (hd < 6) { LAS v2u* dst = (LAS v2u*)(OUTw + (q * 6 + hd) * 64) + kq;
#pragma unroll
        for (int dt = 0; dt < 4; ++dt) { f32x4 v = O[dt] * scale; if (!first) { const v2u o = dst[4 * dt]; v[0] += __uint_as_float(o.x << 16); v[1] += __uint_as_float(o.x & 0xffff0000u); v[2] += __uint_as_float(o.y << 16); v[3] += __uint_as_float(o.y & 0xffff0000u); }
            dst[4 * dt] = (v2u){pk2(v[0], v[1]), pk2(v[2], v[3])}; } }
}

__device__ __forceinline__ void p2_mfma(Frame& F, const In& I, unsigned char* ws) {
    OPAQUE_TID(); KARGS(); const int lane = tid_ & 63, wave = __builtin_amdgcn_readfirstlane(tid_ >> 6), r = lane & 15, kq = lane >> 4;
    const bf16* KV0 = (const bf16*)(ws + WS_KV0); const bf16* W1T = (const bf16*)(ws + WS_W1T); const bf16* W2T = (const bf16*)(ws + WS_W2T); const float* B1F = (const float*)(ws + WS_B1F);
    const bf16* MEMN = (const bf16*)(ws + WS_MEMN); const bf16* WMKT = (const bf16*)(ws + WS_WMKT);
    bf16* KCB = (bf16*)(ws + WS_KCB); bf16* VCT = (bf16*)(ws + WS_VCT); bf16* MKB = (bf16*)(ws + WS_MKB); bf16* MVT = (bf16*)(ws + WS_MVT);
    LAS unsigned char* hid = F.lds + RING_OFF;
    for (int u = blockIdx.x; u < 192; u += F.G) {
        const bool cmp = u < 128;
        const bf16* ap[2]; const bf16* bp[2]; int K, kjump;
        int kv = 0, bg = 0, n0 = 0, lay = 0, m0 = 0, ch = 0;
        if (cmp) { kv = u >> 6; bg = (u >> 4) & 3; n0 = (u & 15) * 32; const int b = bg >> 1, g = bg & 1; K = 2048; kjump = 512 - 64;
#pragma unroll
            for (int rt = 0; rt < 2; ++rt) { int nn = n0 + 16 * rt + r; nn = nn > 510 ? 510 : nn; ap[rt] = KV0 + (size_t)(b * T + 16 * nn) * 512 + kv * 128 + g * 64 + 8 * kq; }
#pragma unroll
            for (int ct = 0; ct < 2; ++ct) bp[ct] = W1T + (size_t)(kv * 256 + 32 * wave + 16 * ct + r) * 2048 + 8 * kq;
        } else { const int v = u - 128; lay = v >> 5; m0 = ((v >> 1) & 15) * 32; ch = v & 1; K = 1024; kjump = 0;
#pragma unroll
            for (int rt = 0; rt < 2; ++rt) ap[rt] = MEMN + (size_t)(lay * 512 + m0 + 16 * rt + r) * 1024 + 8 * kq;
#pragma unroll
            for (int ct = 0; ct < 2; ++ct) bp[ct] = WMKT + (size_t)(lay * 512 + ch * 256 + 32 * wave + 16 * ct + r) * 1024 + 8 * kq;
        }
        f32x4 acc[2][2];
#pragma unroll
        for (int rt = 0; rt < 2; ++rt)
#pragma unroll
            for (int ct = 0; ct < 2; ++ct) acc[rt][ct] = (f32x4){0.f, 0.f, 0.f, 0.f};
        bf16x8 a[2][2], bb[2][2];
#define P2_LOAD(A_, B_, kb_) do { const int kbl_ = (kb_) < K ? (kb_) : K - 64; const int ao_ = kbl_ + (kbl_ >> 6) * kjump; \
            _Pragma("unroll") for (int h2 = 0; h2 < 2; ++h2) { \
                _Pragma("unroll") for (int rt = 0; rt < 2; ++rt) A_[rt][h2] = ldg16(ap[rt] + ao_ + 32 * h2); \
                _Pragma("unroll") for (int ct = 0; ct < 2; ++ct) B_[ct][h2] = ldg16(bp[ct] + kbl_ + 32 * h2); } } while (0)
        P2_LOAD(a, bb, 0);
        for (int kb = 0; kb < K; kb += 64) {
            bf16x8 an[2][2], bn[2][2]; P2_LOAD(an, bn, kb + 64);
#pragma unroll
            for (int h2 = 0; h2 < 2; ++h2)
#pragma unroll
                for (int rt = 0; rt < 2; ++rt)
#pragma unroll
                    for (int ct = 0; ct < 2; ++ct) acc[rt][ct] = MFMA16(a[rt][h2], bb[ct][h2], acc[rt][ct]);
#pragma unroll
            for (int h2 = 0; h2 < 2; ++h2)
#pragma unroll
                for (int x = 0; x < 2; ++x) { a[x][h2] = an[x][h2]; bb[x][h2] = bn[x][h2]; }
        }
#undef P2_LOAD
        if (cmp) {
#pragma unroll
            for (int ct = 0; ct < 2; ++ct) { const int col = 32 * wave + 16 * ct + r; const float bias = (kv ? Ip->v_b1 : Ip->k_b1)[col] + ((B1F[(kv * 4 + 0) * 256 + col] + B1F[(kv * 4 + 1) * 256 + col]) + (B1F[(kv * 4 + 2) * 256 + col] + B1F[(kv * 4 + 3) * 256 + col]));
#pragma unroll
                for (int rt = 0; rt < 2; ++rt)
#pragma unroll
                    for (int i = 0; i < 4; ++i) { const float xg = acc[rt][ct][i] + bias; const float hv = 0.5f * xg * (1.f + tanhf(0.7978845608028654f * (xg + 0.044715f * xg * xg * xg)));
                        *(LAS unsigned short*)(hid + (16 * rt + 4 * kq + i) * 528 + 2 * col) = (unsigned short)f2bf(hv); } }
            __syncthreads();
            { const int rt2 = wave >> 2, ct2 = wave & 3; f32x4 o = {0.f, 0.f, 0.f, 0.f};
              const bf16* w2p = W2T + (size_t)(kv * 64 + 16 * ct2 + r) * 256 + 8 * kq;
#pragma unroll
              for (int ks = 0; ks < 8; ++ks) { const bf16x8 av = *(const LAS bf16x8*)(hid + (16 * rt2 + r) * 528 + 64 * ks + 16 * kq); o = MFMA16(av, ldg16(w2p + 32 * ks), o); }
              const int d = 16 * ct2 + r; const float b2v = (kv ? Ip->v_b2 : Ip->k_b2)[d];
#pragma unroll
              for (int i = 0; i < 4; ++i) { const int nn = n0 + 16 * rt2 + 4 * kq + i; const unsigned short ov = (nn < NCMP) ? (unsigned short)f2bf(o[i] + b2v) : (unsigned short)0;
                  if (kv) VCT[(size_t)(bg * 64 + d) * 512 + nn] = ov; else KCB[(size_t)(bg * 512 + nn) * 64 + d] = ov; } }
            __syncthreads();
        } else {
#pragma unroll
            for (int ct = 0; ct < 2; ++ct) { const int col = 32 * wave + 16 * ct + r;
#pragma unroll
                for (int rt = 0; rt < 2; ++rt)
#pragma unroll
                    for (int i = 0; i < 4; ++i) { const int mrow = m0 + 16 * rt + 4 * kq + i; const unsigned short ov = (unsigned short)f2bf(acc[rt][ct][i]);
                        if (ch == 0) MKB[(size_t)(lay * 512 + mrow) * 256 + col] = ov; else MVT[(size_t)(lay * 256 + col) * 512 + mrow] = ov; } }
        }
    }
}

template <int MODE>
__device__ __forceinline__ void mb2(f32x4& sa, f32x4& sb, int kpos, int tcol, bool colok, bool fast, const BiasCtx& B) {
    if (fast) { if (colok) { sa = sa + B.c31; sb = sb + B.c31; } else { sa = (f32x4){-INFINITY, -INFINITY, -INFINITY, -INFINITY}; sb = sa; } }
    else { maskbias<MODE>(sa, kpos, tcol, colok, B); maskbias<MODE>(sb, kpos + 4, tcol, colok, B); }
}
#define SWZ(row) (((((row) >> 3) & 3) << 1) | (((row) >> 1) & 1))
struct KV1 { KF k; VF v; };
__device__ __forceinline__ void load_kv(KV1& d, const bf16* kb, int kstride, const bf16* vt, int vstride, int key0, int r, int kq) { load_k(d.k, kb, kstride, key0, r, kq); load_vt(d.v, vt, vstride, key0, r, kq); }

template <int MD, int FORCE = 0>
__device__ __forceinline__ void nsa_sweep(LAS unsigned char* STG, const bf16* ksb, const bf16* vst, int jlo, int jhi, int qt, const LAS unsigned* WMw, int wave, int lane, int r, int kq, int qsel, int t0w,
                                          const bf16x8 (&qf)[4][2], const BiasCtx& BC, float (&m)[4], float (&l)[4], f32x4 (&O)[4][4],
                                          int kstr = 512, int kblk = 64 * 512, int vstr = 64, int vblk = 16384) {
            const int srow = 8 * wave + (lane >> 3), sch = (lane & 7) ^ SWZ(srow);
            const bf16* ksrc = ksb + (size_t)srow * kstr + 8 * sch; const bf16* vsrc = vst + (size_t)srow * vstr + 8 * sch;
#define NSA_DMA(jb) do { LAS unsigned char* d_ = STG + ((jb) % 6) * 16384 + wave * 1024; \
                __builtin_amdgcn_global_load_lds((const unsigned*)(ksrc + (size_t)(jb) * kblk), (LAS unsigned*)d_, 16, 0, 0); \
                __builtin_amdgcn_global_load_lds((const unsigned*)(vsrc + (size_t)(jb) * vblk), (LAS unsigned*)(d_ + 8192), 16, 0, 0); } while (0)
#define NSA_WAITV(n_) do { if ((n_) >= 4) asm volatile("s_waitcnt vmcnt(4) lgkmcnt(0)" ::: "memory"); else if ((n_) == 2) asm volatile("s_waitcnt vmcnt(2) lgkmcnt(0)" ::: "memory"); else asm volatile("s_waitcnt vmcnt(0) lgkmcnt(0)" ::: "memory"); } while (0)
            { const int nb = jhi - jlo + 1;
#pragma unroll
              for (int i = 0; i < 4; ++i) if (i < nb) NSA_DMA(jlo + i);
              const int issued = nb < 4 ? nb : 4, need = nb < 2 ? nb : 2; NSA_WAITV(2 * (issued - need)); }
            __builtin_amdgcn_s_barrier();
#define NSA_TILES(CLS_) _Pragma("unroll") for (int p = 0; p < 4; ++p) if (m8 & (3u << (2 * p))) { \
                        bf16x8 pf0, pf1; \
                        step64<MD, CLS_>(k0, k1, qf[p], cls, 64 * j + 8 * kq_, t0w + 2 * p + qs_, ((m8 >> (2 * p + qs_)) & 1u) != 0u, BC, m[p], l[p], O[p], pf0, pf1); \
                        pv(O[p], v0, pf0); pv(O[p], v1, pf1); \
                        __builtin_amdgcn_sched_barrier(0); }
            auto tiles = [&](auto clsx, int j) __attribute__((always_inline)) { constexpr int CLSX = decltype(clsx)::value;
                const LAS unsigned char* sk = STG + (j % 6) * 16384; const LAS unsigned char* sv = sk + 8192;
                unsigned m8 = 0xffu; if (WMw) m8 = (unsigned)__builtin_amdgcn_readfirstlane((int)((WMw[j >> 2] >> (8 * (j & 3))) & 0xffu)); if (FORCE == 1) m8 = 0u; if (FORCE == 2) m8 = 0xffu; if (MD == MD_MEM) m8 = 3u; else asm volatile("" : "+s"(m8));
                if (m8) {
                    int r_ = r, kq_ = kq, qs_ = qsel; asm volatile("" : "+v"(r_), "+v"(kq_), "+v"(qs_));
                    const int dj = qt - j; const int cls = (MD == MD_MEM) ? BK_FAR : (MD == MD_WIN) ? ((dj >= 1 && dj <= 7) ? BK_MID : BK_GEN) : ((64 * dj - 63 >= 1513) ? BK_FAR : ((dj >= 1 && dj <= 15) ? BK_MID : BK_GEN));
                    KF k0, k1;
                    { const int ka = 8 * (r_ >> 2) + (r_ & 3), kb2 = ka + 4, kc = ka + 32, kd = ka + 36;
                      k0.a0 = *(const LAS bf16x8*)(sk + ka * 128 + ((kq_ ^ SWZ(ka)) << 4)); k0.a1 = *(const LAS bf16x8*)(sk + ka * 128 + (((4 + kq_) ^ SWZ(ka)) << 4));
                      k0.b0 = *(const LAS bf16x8*)(sk + kb2 * 128 + ((kq_ ^ SWZ(kb2)) << 4)); k0.b1 = *(const LAS bf16x8*)(sk + kb2 * 128 + (((4 + kq_) ^ SWZ(kb2)) << 4));
                      k1.a0 = *(const LAS bf16x8*)(sk + kc * 128 + ((kq_ ^ SWZ(kc)) << 4)); k1.a1 = *(const LAS bf16x8*)(sk + kc * 128 + (((4 + kq_) ^ SWZ(kc)) << 4));
                      k1.b0 = *(const LAS bf16x8*)(sk + kd * 128 + ((kq_ ^ SWZ(kd)) << 4)); k1.b1 = *(const LAS bf16x8*)(sk + kd * 128 + (((4 + kq_) ^ SWZ(kd)) << 4)); }
                    VF v0, v1;
#pragma unroll
                    for (int dt = 0; dt < 4; ++dt) { const int dd = 16 * dt + r_; v0.v[dt] = *(const LAS bf16x8*)(sv + dd * 128 + ((kq_ ^ SWZ(dd)) << 4)); v1.v[dt] = *(const LAS bf16x8*)(sv + dd * 128 + (((4 + kq_) ^ SWZ(dd)) << 4)); }
                    NSA_TILES(CLSX)
                }
            };
            int ni = 0;
            auto blk = [&](auto clsx, int j) __attribute__((always_inline)) {
                const bool head = ((j - jlo) & 1) == 0;
                if (head) { ni = 0; if (j + 4 <= jhi) { NSA_DMA(j + 4); ni += 2; } if (j + 5 <= jhi) { NSA_DMA(j + 5); ni += 2; } }
                tiles(clsx, j);
                if (!head || j == jhi) { NSA_WAITV(ni); __builtin_amdgcn_s_barrier(); }
            };
            int j = jlo;
            if (MD == MD_BLK || MD == MD_MEM) { const int jfar = (MD == MD_MEM) ? jhi : ((qt - 25 < jhi) ? qt - 25 : jhi); const int jfe = jlo + (((jfar - jlo + 1) >> 1) << 1) - 1;
                for (; j <= jfe; ++j) blk(std::integral_constant<int, BK_FAR>{}, j); }
            for (; j <= jhi; ++j) blk(std::integral_constant<int, -1>{}, j);
#undef NSA_WAITV
#undef NSA_TILES
#undef NSA_DMA
}
__device__ __forceinline__ void p3_nsa_mfma(Frame& F, const In& I, unsigned char* ws) {
    OPAQUE_TID(); KARGS(); const int wave = __builtin_amdgcn_readfirstlane(tid_ >> 6);
    LAS float* b12 = (LAS float*)(F.lds + TAB_B12);
    LAS unsigned short* OUTw = (LAS unsigned short*)(F.lds + NSA_OUT) + wave * 3072;
    LAS float* PSw = (LAS float*)(F.lds + NSA_PSQ) + wave * 1024;
    LAS unsigned char* STG = F.lds + NSA_PSQ;
    LAS unsigned* WMw = (LAS unsigned*)(F.lds + NSA_ST) + wave * 32;
    for (int i = tid_; i < 512; i += NWAVES * 64) b12[i] = ((i & 15) < 12) ? Ip->rel_bias[(i >> 4) * 12 + (i & 15)] * LOG2E : 0.f;
    LAS unsigned short* TB = (LAS unsigned short*)(F.lds + NSA_TB);
    { const int gg = (int)blockIdx.x & 1;
      for (int i = tid_; i < 6144; i += NWAVES * 64) { const int dd = i / 6, hh = i % 6; TB[i] = (unsigned short)f2bf(Ip->rel_bias[rel_bucket(dd) * 12 + gg * 6 + hh] * LOG2E); } }
    __syncthreads();
    const bf16* Q0 = (const bf16*)(ws + WS_Q0); const bf16* KV0 = (const bf16*)(ws + WS_KV0); const bf16* QM = (const bf16*)(ws + WS_QM); const bf16* G0 = (const bf16*)(ws + WS_G0);
    const bf16* VT = (const bf16*)(ws + WS_VT); const bf16* KCB = (const bf16*)(ws + WS_KCB); const bf16* VCT = (const bf16*)(ws + WS_VCT);
    const bf16* MKB = (const bf16*)(ws + WS_MKB); const bf16* MVT = (const bf16*)(ws + WS_MVT);
    bf16* CAT = (bf16*)(ws + WS_CAT);
    const int nun = 4 * 128;
    for (int ui = blockIdx.x; ui < nun; ui += F.G) {
        int tl_ = tid_; asm volatile("" : "+v"(tl_));
        const int lane = tl_ & 63, n = lane & 15, kq = lane >> 4, r = n, hd = n & 7, qsel = n >> 3; const bool colv = hd < 6;
        int bg, qt;
        bg = blockIdx.x & 3;
        if (F.G == 256) { const int idx = blockIdx.x >> 2; qt = (ui < 256) ? idx : 127 - idx; }
        else { qt = ui >> 2; if ((ui & 3) != bg) continue; }
        const int b = bg >> 1, g = bg & 1, t0w = 64 * qt + 8 * wave, rowb = b * T;
        const int habs = g * 6 + (colv ? hd : 0);
        const LAS float* b12c = b12 + habs; const BiasCtx BC{TB + (colv ? hd : 0), b12c[29 * 16] - b12c[30 * 16], b12c[30 * 16] - b12c[31 * 16], b12c[31 * 16]};

        bf16x8 qf[4][2];
#pragma unroll
        for (int p = 0; p < 4; ++p) { const bf16* qp = Q0 + (size_t)(rowb + t0w + 2 * p + qsel) * 768 + habs * 64 + 8 * kq;
#pragma unroll
            for (int ks = 0; ks < 2; ++ks) { bf16x8 v = ldg16(qp + 32 * ks); if (!colv) v = (bf16x8){0, 0, 0, 0, 0, 0, 0, 0}; qf[p][ks] = v; } }
        float m[4], l[4]; f32x4 O[4][4];
        if (PROBE_REP == 6 || PROBE_REP == 7) {
            const bf16* ksb_ = KV0 + (size_t)rowb * 512 + 256 + g * 64; const bf16* vst_ = VT + ((size_t)(rowb >> 6) * 256 + g * 64) * 64;
#pragma unroll
            for (int p = 0; p < 4; ++p) { m[p] = -1e30f; l[p] = 0.f;
#pragma unroll
                for (int dt = 0; dt < 4; ++dt) O[p][dt] = (f32x4){0.f, 0.f, 0.f, 0.f}; }
            __syncthreads();
            nsa_sweep<MD_BLK, (PROBE_REP == 6 ? 2 : 1)>(STG, ksb_, vst_, 0, qt, qt, WMw, wave, lane, r, kq, qsel, t0w, qf, BC, m, l, O);
            float* dump = (float*)(ws + WS_OCS) + ((size_t)blockIdx.x * 512 + tid_) * 4;
#pragma unroll
            for (int p = 0; p < 4; ++p) dump[p] = l[p] + O[p][0][0] + O[p][1][1] + O[p][2][2] + O[p][3][3];
            __syncthreads(); }
        for (int i = lane; i < 1024; i += 64) PSw[i] = 0.f;
        const int ncmax = (t0w + 7 >= 31) ? ((t0w + 7 - 31) / 16 + 1) : 0;
        const bf16* kcb = KCB + (size_t)(bg * 512) * 64; const bf16* vct = VCT + (size_t)(bg * 64) * 512;
#pragma unroll
        for (int p = 0; p < 4; ++p) { m[p] = -1e30f; l[p] = 0.f; }
        if (ncmax > 0) {
            int r_ = r, kq_ = kq; asm volatile("" : "+v"(r_), "+v"(kq_));
            for (int key0 = 0; key0 < ncmax; key0 += 32) {
                asm volatile("" : "+v"(r_), "+v"(kq_));
                KF kA; load_k(kA, kcb, 64, key0, r_, kq_);
                const bool fast = (t0w - 31 - 16 * (key0 + 31)) >= 1513;
#pragma unroll
                for (int p = 0; p < 4; ++p) { f32x4 sa, sb; qk(sa, sb, kA, qf[p]); const int tcol = t0w + 2 * p + qsel;
                    mb2<MD_CMP>(sa, sb, key0 + 8 * kq_, tcol, true, fast, BC);
                    const float mn = fmaxf(m[p], lmax8(sa, sb)); float sum = 0.f;
#pragma unroll
                    for (int i = 0; i < 4; ++i) sum += __builtin_amdgcn_exp2f(sa[i] - mn) + __builtin_amdgcn_exp2f(sb[i] - mn);
                    l[p] = l[p] * __builtin_amdgcn_exp2f(m[p] - mn) + sum; m[p] = mn; __builtin_amdgcn_sched_barrier(0); }
            }
        }
        float invl[4];
#pragma unroll
        for (int p = 0; p < 4; ++p) { float mc = m[p]; mc = fmaxf(mc, __shfl_xor(mc, 16)); mc = fmaxf(mc, __shfl_xor(mc, 32));
            const float lt = kqsum(l[p] * __builtin_amdgcn_exp2f(m[p] - mc)); m[p] = mc; invl[p] = lt > 0.f ? 1.f / lt : 0.f; }
#pragma unroll
        for (int p = 0; p < 4; ++p)
#pragma unroll
            for (int dt = 0; dt < 4; ++dt) O[p][dt] = (f32x4){0.f, 0.f, 0.f, 0.f};
        float carry[4] = {0.f, 0.f, 0.f, 0.f};
        if (ncmax > 0) {
            int r_ = r, kq_ = kq; asm volatile("" : "+v"(r_), "+v"(kq_));
            for (int key0 = 0; key0 < ncmax; key0 += 32) {
                asm volatile("" : "+v"(r_), "+v"(kq_));
                KV1 A; load_kv(A, kcb, 64, vct, 512, key0, r_, kq_);
                const bool fast = (t0w - 31 - 16 * (key0 + 31)) >= 1513;
#pragma unroll
                for (int p = 0; p < 4; ++p) { f32x4 sa, sb; qk(sa, sb, A.k, qf[p]); const int tcol = t0w + 2 * p + qsel;
                    mb2<MD_CMP>(sa, sb, key0 + 8 * kq_, tcol, true, fast, BC);
                    f32x4 pa, pb;
#pragma unroll
                    for (int i = 0; i < 4; ++i) { pa[i] = __builtin_amdgcn_exp2f(sa[i] - m[p]) * invl[p]; pb[i] = __builtin_amdgcn_exp2f(sb[i] - m[p]) * invl[p]; }
                    pv(O[p], A.v, pack8(pa, pb));
                    float wA = (pa[0] + pa[1]) + (pa[2] + pa[3]), wB = pa[3] + ((pb[0] + pb[1]) + (pb[2] + pb[3])), wC = pb[3];
                    if (!colv) { wA = 0.f; wB = 0.f; wC = 0.f; }
                    const float up = __shfl(wC, (lane + 48) & 63);
                    const float prevC = (kq == 0) ? carry[p] : up; carry[p] = up;
                    float a0 = wA + prevC, a1 = wB;
                    a0 = sum8_dpp(a0); a1 = sum8_dpp(a1);
                    if (hd == 0) { LAS float* ps = PSw + (2 * p + qsel) * 128 + (key0 >> 2) + 2 * kq; ps[0] = a0; ps[1] = a1; } __builtin_amdgcn_sched_barrier(0); }
            }
        }
        if (ncmax > 0 && ncmax <= 480) {
            const int jn = ((ncmax + 31) >> 5) * 8;
#pragma unroll
            for (int p = 0; p < 4; ++p) { float a0 = sum8_dpp(carry[p]); if (hd == 0 && kq == 0) PSw[(2 * p + qsel) * 128 + jn] = a0; }
        }
        {
#pragma unroll
            for (int p = 0; p < 4; ++p) { const size_t row = (size_t)(rowb + t0w + 2 * p + qsel);
                const float gz = bf2f(G0[row * 256 + habs * 3 + 0]) + Ip->nsa_gate_b[habs * 3 + 0]; out_add(OUTw, p, n, kq, O[p], 1.f / (1.f + __expf(-gz)), true); }
        }
        for (int i = lane; i < 32; i += 64) WMw[i] = (qt < 16) ? 0xffffffffu : 0u;
        if (qt >= 16) {
            if (lane < 3) { const int j = lane == 0 ? 0 : qt - 2 + lane; atomicOr((unsigned*)&WMw[j >> 2], 0xffu << (8 * (j & 3))); }
            for (int q = 0; q < 8; ++q) {
                int v0 = __float_as_int(PSw[q * 128 + lane] + 0.f), v1 = __float_as_int(PSw[q * 128 + 64 + lane] + 0.f);
                if (lane < 1 || lane > qt - 2) v0 = __float_as_int(-1.f); if (lane + 64 > qt - 2) v1 = __float_as_int(-1.f);
                for (int s = 0; s < 13; ++s) { const int mx = wmax64_i(max(v0, v1));
                    const unsigned long long b0 = __ballot(v0 == mx); int j;
                    if (b0) { j = __builtin_ctzll(b0); if (lane == j) v0 = __float_as_int(-1.f); } else { const unsigned long long b1 = __ballot(v1 == mx); j = __builtin_ctzll(b1); if (lane == j) v1 = __float_as_int(-1.f); j += 64; }
                    if (lane == 0) atomicOr((unsigned*)&WMw[j >> 2], 1u << (8 * (j & 3) + q)); }
            }
        }
        const bf16* ksb = KV0 + (size_t)rowb * 512 + 256 + g * 64; const bf16* vst = VT + ((size_t)(rowb >> 6) * 256 + g * 64) * 64;
        __syncthreads();
#pragma unroll 1
        for (int rep_ = 0; rep_ < (PROBE_REP == 1 ? 2 : 1); ++rep_) {
#pragma unroll
            for (int p = 0; p < 4; ++p) { m[p] = -1e30f; l[p] = 0.f;
#pragma unroll
                for (int dt = 0; dt < 4; ++dt) O[p][dt] = (f32x4){0.f, 0.f, 0.f, 0.f}; }
            nsa_sweep<MD_BLK>(STG, ksb, vst, 0, qt, qt, WMw, wave, lane, r, kq, qsel, t0w, qf, BC, m, l, O);
        }
        { int qs2_ = qsel; asm volatile("" : "+v"(qs2_));
#pragma unroll
        for (int p = 0; p < 4; ++p) { const size_t row = (size_t)(rowb + t0w + 2 * p + qs2_);
            const float gz = bf2f(G0[row * 256 + habs * 3 + 1]) + Ip->nsa_gate_b[habs * 3 + 1]; out_add(OUTw, p, n, kq, O[p], (1.f / (1.f + __expf(-gz))) / kqsum(l[p]), false); } }
        const bf16* kwb = KV0 + (size_t)rowb * 512 + 384 + g * 64; const bf16* vwt = VT + ((size_t)(rowb >> 6) * 256 + 128 + g * 64) * 64;
#pragma unroll
        for (int p = 0; p < 4; ++p) { m[p] = -1e30f; l[p] = 0.f;
#pragma unroll
            for (int dt = 0; dt < 4; ++dt) O[p][dt] = (f32x4){0.f, 0.f, 0.f, 0.f}; }
        __syncthreads();
        nsa_sweep<MD_WIN>(STG, kwb, vwt, (qt >= 8) ? qt - 8 : 0, qt, qt, nullptr, wave, lane, r, kq, qsel, t0w, qf, BC, m, l, O);
        if (PROBE_REP == 4) {
#pragma unroll
            for (int p = 0; p < 4; ++p) { m[p] = -1e30f; l[p] = 0.f;
#pragma unroll
                for (int dt = 0; dt < 4; ++dt) O[p][dt] = (f32x4){0.f, 0.f, 0.f, 0.f}; }
            nsa_sweep<MD_WIN>(STG, kwb, vwt, (qt >= 8) ? qt - 8 : 0, qt, qt, nullptr, wave, lane, r, kq, qsel, t0w, qf, BC, m, l, O); }
        { int qs3_ = qsel; asm volatile("" : "+v"(qs3_));
#pragma unroll
        for (int p = 0; p < 4; ++p) { const size_t row = (size_t)(rowb + t0w + 2 * p + qs3_);
            const float gz = bf2f(G0[row * 256 + habs * 3 + 2]) + Ip->nsa_gate_b[habs * 3 + 2]; out_add(OUTw, p, n, kq, O[p], (1.f / (1.f + __expf(-gz))) / kqsum(l[p]), false); } }
        int ln_ = lane; asm volatile("" : "+v"(ln_));
#pragma unroll 1
        for (int i = 0; i < 6; ++i) { const int e = i * 64 + ln_, q = e / 48, c8 = e % 48;
            *(v4u*)(CAT + (size_t)(rowb + t0w + q) * 1024 + g * 384 + 8 * c8) = ((const LAS v4u*)OUTw)[e]; }
#pragma unroll 1
        for (int h2 = 0; h2 < 2; ++h2) { const int hm = 2 * g + h2;
            int ln2_ = lane; asm volatile("" : "+v"(ln2_)); const int nn = ln2_ & 15, kqq = ln2_ >> 4;
#pragma unroll
            for (int p = 0; p < 4; ++p) { qf[p][0] = (bf16x8){0, 0, 0, 0, 0, 0, 0, 0}; qf[p][1] = qf[p][0]; m[p] = -1e30f; l[p] = 0.f;
#pragma unroll
                for (int dt = 0; dt < 4; ++dt) O[p][dt] = (f32x4){0.f, 0.f, 0.f, 0.f}; }
            { const bf16* qp = QM + (size_t)(rowb + t0w + (nn & 7)) * 256 + hm * 64 + 8 * kqq; if (nn < 8) { qf[0][0] = ldg16(qp); qf[0][1] = ldg16(qp + 32); } }
            const BiasCtx BCm{BC.tb, 0.f, 0.f, 0.f};
            nsa_sweep<MD_MEM>(STG, MKB + (size_t)(b * 256) * 256 + hm * 64, MVT + (size_t)(hm * 64) * 512 + b * 256, 0, 3, 0, nullptr, wave, ln2_, nn, kqq, nn >> 3, 0, qf, BCm, m, l, O, 256, 64 * 256, 512, 64);
            const float il = 1.f / kqsum(l[0]);
            if (nn < 8) { bf16* op = CAT + (size_t)(rowb + t0w + nn) * 1024 + 768 + hm * 64 + 4 * kqq;
#pragma unroll
                for (int dt = 0; dt < 4; ++dt) *(uint2*)(op + 16 * dt) = make_uint2(pk2(O[0][dt][0] * il, O[0][dt][1] * il), pk2(O[0][dt][2] * il, O[0][dt][3] * il)); }
        }
    }
}

__device__ __forceinline__ void p10_dsa_norm(Frame& F, const In& I, unsigned char* ws) {
    OPAQUE_TID(); KARGS(); const int gw = F.vcu * NWAVES + (tid_ >> 6), NGW = F.G * NWAVES, lane = tid_ & 63;
    const bf16* PR = (const bf16*)(ws + WS_PROJ1); bf16* CQ = (bf16*)(ws + WS_CQ); bf16* CKV = (bf16*)(ws + WS_CKV); bf16* KIDX = (bf16*)(ws + WS_KIDX); float* WIDX = (float*)(ws + WS_WIDX);
    for (int m = gw; m < M; m += NGW) {
        const bf16* pr = PR + (size_t)m * 768;
        float a[4]; ld4bf(pr + 4 * lane, a);
        float s = wave_sum(a[0] * a[0] + a[1] * a[1] + a[2] * a[2] + a[3] * a[3]); float r = rsqrtf(s * (1.f / 256.f) + EPSF);
        const float4 gq = *(const float4*)(Ip->q_norm + 4 * lane);
        *(uint2*)(CQ + (size_t)m * 256 + 4 * lane) = make_uint2(pk2((a[0] * r) * gq.x, (a[1] * r) * gq.y), pk2((a[2] * r) * gq.z, (a[3] * r) * gq.w));
        const unsigned u = *(const unsigned*)(pr + 256 + 2 * lane); const float c0 = bflo(u), c1 = bfhi(u);
        s = wave_sum(c0 * c0 + c1 * c1); r = rsqrtf(s * (1.f / 128.f) + EPSF);
        *(unsigned*)(CKV + (size_t)m * 128 + 2 * lane) = pk2((c0 * r) * Ip->kv_norm[2 * lane], (c1 * r) * Ip->kv_norm[2 * lane + 1]);
        const float k0 = bf2f(pr[384 + lane]);
        s = wave_sum(k0 * k0); r = rsqrtf(s * (1.f / 64.f) + EPSF);
        { const int tk = m >> 5, key = m & 31, ks = lane >> 4, hf = (lane >> 3) & 1, jj = lane & 7;
          KIDX[((size_t)(tk * 4 + ks) * 64 + hf * 32 + key) * 8 + jj] = (bf16)f2bf((k0 * r) * Ip->kidx_norm[lane]); }
        if (lane < 8) WIDX[(size_t)m * 8 + lane] = bf2f(pr[448 + lane]) * (0.35355339059327373f * 0.125f);
    }
}

#define MFMA32(A, B, C) __builtin_amdgcn_mfma_f32_32x32x16_bf16((A), (B), (C), 0, 0, 0)
typedef float f32x16 __attribute__((ext_vector_type(16)));
constexpr int XL_OFF = RING_BYTES;
constexpr int IDX_HIST = XL_OFF, IDX_SELL = XL_OFF + 16384;
static_assert(IDX_SELL + 4096 <= LDSCTL_OFF, "LDS map (indexer)");
__device__ __forceinline__ float wmin64(float v) {
#pragma unroll
    for (int o = 1; o < 64; o <<= 1) v = fminf(v, __shfl_xor(v, o));
    return v;
}
__device__ __forceinline__ unsigned f16_order_key(float x) {
    const unsigned hb = (unsigned)__builtin_bit_cast(unsigned short, (_Float16)x);
    const unsigned mk = (unsigned)((int)(hb << 16) >> 31) | 0x8000u;
    return (hb ^ mk) & 0xffffu; }
__device__ __forceinline__ void p12_index_mfma(Frame& F, const In& I, unsigned char* ws) {
    OPAQUE_TID(); KARGS(); const int lane = tid_ & 63, wave = __builtin_amdgcn_readfirstlane(tid_ >> 6), key = lane & 31, half = lane >> 5;
    LAS unsigned short* SC = (LAS unsigned short*)(F.lds + RING_OFF);
    const bf16* QI = (const bf16*)(ws + WS_QI); const bf16* KIDX = (const bf16*)(ws + WS_KIDX); const float* WIDX = (const float*)(ws + WS_WIDX);
    unsigned short* SEL = (unsigned short*)(ws + WS_SEL); int* CNT = (int*)(ws + WS_CNT);
    const int NG = M / 8, per = (NG + F.G - 1) / F.G;
    for (int j = 0; j < per; ++j) {
        const int u = j * F.G + ((j & 1) ? (F.G - 1 - (int)blockIdx.x) : (int)blockIdx.x);
        if (u >= NG) break;
        const int gi = (u & 1) * (NG / 2) + (u >> 1);
        const int row0 = 8 * gi, b = row0 / T, t0 = row0 % T, rowb = b * T;
        if (t0 < 256) {
            const int t = t0 + wave; unsigned short* so = SEL + (size_t)(row0 + wave) * 256;
#pragma unroll
            for (int i = 0; i < 4; ++i) { const int s = lane + 64 * i; so[s] = (unsigned short)(s <= t ? s : 0); }
            if (lane == 0) CNT[row0 + wave] = t + 1;
            continue;
        }
        const int nt = (t0 + 7) / 32 + 1;
        {
            const int rho = lane & 31, a = rho >> 2, qA = ((a >> 2) & 1) + 2 * (a & 1), hdA = 4 * ((a >> 1) & 1) + (rho & 3);
            bf16x8 qa[2][4];
#pragma unroll
            for (int t2 = 0; t2 < 2; ++t2)
#pragma unroll
                for (int ks = 0; ks < 4; ++ks) qa[t2][ks] = ldg16(QI + (size_t)(row0 + 4 * t2 + qA) * 512 + hdA * 64 + 16 * ks + 8 * half);
            f32x2_t wp[2][2][4];
#pragma unroll
            for (int t2 = 0; t2 < 2; ++t2)
#pragma unroll
                for (int jq = 0; jq < 2; ++jq) { const float* wq = WIDX + (size_t)(row0 + 4 * t2 + 2 * half + jq) * 8; const float4 x0 = *(const float4*)wq, x1 = *(const float4*)(wq + 4);
                    wp[t2][jq][0] = (f32x2_t){x0.x, x0.y}; wp[t2][jq][1] = (f32x2_t){x0.z, x0.w}; wp[t2][jq][2] = (f32x2_t){x1.x, x1.y}; wp[t2][jq][3] = (f32x2_t){x1.z, x1.w}; }
            const int tqb = t0 + 2 * half;
            const bf16* kpb = KIDX + (size_t)(rowb >> 5) * 2048 + (size_t)lane * 8;
            const int ntw = (nt - wave + NWAVES - 1) / NWAVES;
#define IDX_LOAD(dst, i) do { const int tl2_ = wave + NWAVES * ((i) < ntw ? (i) : (ntw > 0 ? ntw - 1 : 0)); const bf16* kp_ = kpb + (size_t)tl2_ * 2048; \
                _Pragma("unroll") for (int ks = 0; ks < 4; ++ks) dst[ks] = ldg16(kp_ + 512 * ks); } while (0)
#define IDX_EPI(c, t2) do { f32x2_t a0 = {0.f, 0.f}, a1 = {0.f, 0.f};     \
                _Pragma("unroll") for (int h = 0; h < 4; ++h) { \
                    const f32x2_t r0 = {__int_as_float(max(__float_as_int(c[2 * h]), 0)), __int_as_float(max(__float_as_int(c[2 * h + 1]), 0))}; \
                    const f32x2_t r1 = {__int_as_float(max(__float_as_int(c[8 + 2 * h]), 0)), __int_as_float(max(__float_as_int(c[9 + 2 * h]), 0))}; \
                    a0 = __builtin_elementwise_fma(r0, wp[t2][0][h], a0); a1 = __builtin_elementwise_fma(r1, wp[t2][1][h], a1); } \
                const float s0 = (a0[0] + a0[1]) + 0.f, s1 = (a1[0] + a1[1]) + 0.f; \
                const bool ok0 = kpos <= tqb + 4 * (t2), ok1 = kpos <= tqb + 4 * (t2) + 1; \
                SC[(4 * (t2) + 2 * half) * 8192 + kpos] = (unsigned short)f16_order_key(ok0 ? s0 : -INFINITY); SC[(4 * (t2) + 2 * half + 1) * 8192 + kpos] = (unsigned short)f16_order_key(ok1 ? s1 : -INFINITY); } while (0)
#define IDX_COMP(src, i) do { if ((i) < ntw) { const int kpos = 32 * (wave + NWAVES * (i)) + key; \
                f32x16 cA = {0.f, 0.f, 0.f, 0.f, 0.f, 0.f, 0.f, 0.f, 0.f, 0.f, 0.f, 0.f, 0.f, 0.f, 0.f, 0.f}, cB = cA; \
                _Pragma("unroll") for (int ks = 0; ks < 4; ++ks) { cA = MFMA32(qa[0][ks], src[ks], cA); cB = MFMA32(qa[1][ks], src[ks], cB); } \
                IDX_EPI(cA, 0); IDX_EPI(cB, 1); } } while (0)
            if (ntw > 0) {
                bf16x8 kb0[4], kb1[4], kb2[4], kb3[4];
                IDX_LOAD(kb0, 0); IDX_LOAD(kb1, 1); IDX_LOAD(kb2, 2);
                for (int i = 0; i < ntw; i += 4) {
                    IDX_LOAD(kb3, i + 3); IDX_COMP(kb0, i);
                    IDX_LOAD(kb0, i + 4); IDX_COMP(kb1, i + 1);
                    IDX_LOAD(kb1, i + 5); IDX_COMP(kb2, i + 2);
                    IDX_LOAD(kb2, i + 6); IDX_COMP(kb3, i + 3);
                }
            }
#undef IDX_LOAD
#undef IDX_EPI
#undef IDX_COMP
        }
        __syncthreads();
        {
            const int q = wave, t = t0 + q, nch = (t + 512) >> 9; LAS unsigned short* sc = SC + q * 8192;
            LAS unsigned* hist = (LAS unsigned*)(F.lds + IDX_HIST) + wave * 512;
            LAS unsigned short* sl = (LAS unsigned short*)(F.lds + IDX_SELL) + q * 256;
            for (int i = 32 * nt + lane; i < 512 * nch; i += 64) sc[i] = (unsigned short)0;
#pragma unroll
            for (int i = 0; i < 8; ++i) hist[lane + 64 * i] = 0u;
            for (int c = 0; c < nch; ++c) { const v4u k4 = *(const LAS v4u*)(sc + 512 * c + 8 * lane);
#pragma unroll
                for (int e = 0; e < 8; ++e) { const unsigned kk = (e & 1) ? (k4[e >> 1] >> 16) : (k4[e >> 1] & 0xffffu); const unsigned bb = kk >> 6;
                    atomicAdd((unsigned*)&hist[bb >> 1], 1u << (16 * (bb & 1))); } }
            int b1, r1;
            { unsigned cw[8]; unsigned S = 0u;
#pragma unroll
              for (int i = 0; i < 8; ++i) { cw[i] = hist[8 * lane + i]; S += (cw[i] & 0xffffu) + (cw[i] >> 16); }
              const unsigned px = wave_iscan_u32(S);
              const unsigned above = (unsigned)__builtin_amdgcn_readlane((int)px, 63) - px;
              const bool found = (above < 256u) && (256u <= above + S);
              const int fl = __builtin_ctzll(__ballot(found));
              int bs = 0; unsigned acc = above;
              { bool done = false;
#pragma unroll
                for (int i = 15; i >= 0; --i) { const unsigned cnt_ = (i & 1) ? (cw[i >> 1] >> 16) : (cw[i >> 1] & 0xffffu);
                    if (!done) { if (acc + cnt_ >= 256u) { bs = 16 * lane + i; done = true; } else acc += cnt_; } } }
              b1 = __builtin_amdgcn_readlane(bs, fl); r1 = 256 - __builtin_amdgcn_readlane((int)acc, fl); }
            hist[lane] = 0u;
            for (int c = 0; c < nch; ++c) { const v4u k4 = *(const LAS v4u*)(sc + 512 * c + 8 * lane);
#pragma unroll
                for (int e = 0; e < 8; ++e) { const unsigned kk = (e & 1) ? (k4[e >> 1] >> 16) : (k4[e >> 1] & 0xffffu);
                    if ((int)(kk >> 6) == b1) atomicAdd((unsigned*)&hist[kk & 63u], 1u); } }
            unsigned tkey; int r2;
            { const unsigned S = hist[lane]; const unsigned px = wave_iscan_u32(S); const unsigned above = (unsigned)__builtin_amdgcn_readlane((int)px, 63) - px;
              const bool found = (above < (unsigned)r1) && ((unsigned)r1 <= above + S);
              const int fl = __builtin_ctzll(__ballot(found));
              tkey = ((unsigned)b1 << 6) | (unsigned)fl; r2 = r1 - __builtin_amdgcn_readlane((int)above, fl); }
            const int nabove = 256 - r2; int bsel = 0, beq = 0;
            for (int c = 0; c < nch; ++c) { const int i8 = 512 * c + 8 * lane; const v4u k4 = *(const LAS v4u*)(sc + i8);
                unsigned em = 0u;
#pragma unroll
                for (int e = 0; e < 8; ++e) { const unsigned kk = (e & 1) ? (k4[e >> 1] >> 16) : (k4[e >> 1] & 0xffffu);
                    const bool sel = kk > tkey; em |= (kk == tkey) ? (1u << e) : 0u;
                    const unsigned long long ms = __ballot(sel);
                    if (ms) { if (sel) sl[bsel + (int)__builtin_amdgcn_mbcnt_hi((unsigned)(ms >> 32), __builtin_amdgcn_mbcnt_lo((unsigned)ms, 0u))] = (unsigned short)(i8 + e); bsel += __builtin_popcountll(ms); } }
                if (__any(em != 0u)) {
                    const unsigned ce = (unsigned)__builtin_popcount(em); const unsigned pe = wave_iscan_u32(ce);
                    int pos = beq + (int)(pe - ce);
#pragma unroll
                    for (int e = 0; e < 8; ++e) if (em & (1u << e)) { if (pos < r2) sl[nabove + pos] = (unsigned short)(i8 + e); ++pos; }
                    beq += __builtin_amdgcn_readlane((int)pe, 63); } }
            *(v2u*)(SEL + (size_t)(row0 + q) * 256 + 4 * lane) = *(const LAS v2u*)(sl + 4 * lane);
            if (lane == 0) CNT[row0 + q] = 256;
        }
        __syncthreads();
    }
}

__device__ __forceinline__ unsigned offb(unsigned row, unsigned ch) { return 256u * row + 16u * (ch ^ (((row & 3u) << 2) | ((row >> 2) & 3u))); }
typedef short v4i16_t __attribute__((ext_vector_type(4)));
__device__ __forceinline__ v4i16_t trrd(const LAS unsigned char* p) { return __builtin_amdgcn_ds_read_tr16_b64_v4i16((LAS v4i16_t*)p); }
__device__ __forceinline__ void p13_dsa_mfma(Frame& F, const In& I, unsigned char* ws) {
    OPAQUE_TID(); KARGS(); const int lane = tid_ & 63, wave = __builtin_amdgcn_readfirstlane(tid_ >> 6), n = lane & 15, kq = lane >> 4;
    LAS unsigned char* bkt = F.lds + TAB_BKT; LAS float* b12 = (LAS float*)(F.lds + P13_B12);
    for (int i = tid_; i < 1536; i += NWAVES * 64) bkt[i] = (unsigned char)rel_bucket(i);
    for (int i = tid_; i < 528; i += NWAVES * 64) b12[i] = (i >= 512) ? -INFINITY : (((i & 15) < 12) ? Ip->rel_bias[(i >> 4) * 12 + (i & 15)] * LOG2E : 0.f);
    __syncthreads();
    LAS unsigned char* imgb = F.lds + RING_OFF + wave * 18432; LAS int* sidx = (LAS int*)(imgb + 16384);
    const bf16* QA = (const bf16*)(ws + WS_QA); const bf16* CKV = (const bf16*)(ws + WS_CKV); const bf16* PR = (const bf16*)(ws + WS_PROJ1);
    const unsigned short* SEL = (const unsigned short*)(ws + WS_SEL); const int* CNT = (const int*)(ws + WS_CNT);
    const bf16* MKB = (const bf16*)(ws + WS_MKB) + (size_t)512 * 256; const bf16* MVT = (const bf16*)(ws + WS_MVT) + (size_t)256 * 512;
    bf16* CAT1 = (bf16*)(ws + WS_CAT1);
    const int gw = blockIdx.x * NWAVES + wave, NGW = F.G * NWAVES;
    const LAS float* b12c = b12 + (n < 12 ? n : 0);
#define DSA_GATHER(sl_, rowb_, c0_, buf_) do { const unsigned char* ckvb_ = (const unsigned char*)(CKV + (size_t)(rowb_) * 128); int kx_[8]; \
            _Pragma("unroll") for (int i = 0; i < 8; ++i) kx_[i] = (sl_)[(c0_) + 4 * i + g4_] & 0xffff; \
            _Pragma("unroll") for (int i = 0; i < 8; ++i) __builtin_amdgcn_global_load_lds((const unsigned*)(ckvb_ + ((unsigned)kx_[i] * 256u + goff_[i & 3])), (LAS unsigned*)(imgb + (buf_) * 8192 + i * 1024), 16, 0, 0); } while (0)
#define DSA_LIST(sl_, sel_, t_, cnt_) do { const int idx0_ = __builtin_amdgcn_readfirstlane((sel_)[0]); \
            _Pragma("unroll") for (int i = 0; i < 4; ++i) { const int e = lane + 64 * i, idx = (sel_)[i]; const int d = (t_) - idx, dc = d > 1535 ? 1535 : (d < 0 ? 0 : d); \
                (sl_)[e] = (e < (cnt_)) ? (idx | ((int)bkt[dc] << 22)) : (idx0_ | (2048 << 16)); } } while (0)
    int dreps_ = (PROBE_REP == 9) ? 2 : 1; asm volatile("" : "+s"(dreps_));
    for (int dr_ = 0; dr_ < dreps_; ++dr_) {
    asm volatile("s_waitcnt vmcnt(0) lgkmcnt(0)" ::: "memory");
    int row = gw;
    if (row < M) {
        int ln0_ = lane; asm volatile("" : "+v"(ln0_));
        const int g4_ = ln0_ >> 4; unsigned goff_[4];
#pragma unroll
        for (int k = 0; k < 4; ++k) goff_[k] = 16u * ((unsigned)(ln0_ & 15) ^ (((unsigned)g4_ << 2) | (unsigned)k));
        int cnt = __builtin_amdgcn_readfirstlane(CNT[row]); int sel0[4];
#pragma unroll
        for (int i = 0; i < 4; ++i) sel0[i] = (int)SEL[(size_t)row * 256 + lane + 64 * i];
        DSA_LIST(sidx, sel0, row % T, cnt);
        bf16x8 qf[4];
#pragma unroll
        for (int ks = 0; ks < 4; ++ks) { bf16x8 v = ldg16(QA + (size_t)row * 1536 + (n < 12 ? n : 0) * 128 + 32 * ks + 8 * kq); if (n >= 12) v = (bf16x8){0, 0, 0, 0, 0, 0, 0, 0}; qf[ks] = v; }
        asm volatile("s_waitcnt lgkmcnt(0)" ::: "memory");
        DSA_GATHER(sidx, (row / T) * T, 0, 0);
        int lb = 0, ib = 0;
        for (; row < M; row += NGW) {
            const int t = row % T, rown = (row + NGW < M) ? row + NGW : row; const bool hasn = row + NGW < M;
            int ln_ = lane; asm volatile("" : "+v"(ln_));
            int seln[4] = {0, 0, 0, 0}; int cntn_v = 0; bf16x8 qfn[4];
#pragma unroll
            for (int ks = 0; ks < 4; ++ks) qfn[ks] = (bf16x8){0, 0, 0, 0, 0, 0, 0, 0};
#define DSA_NEXT_LOADS() do { cntn_v = CNT[rown]; \
                _Pragma("unroll") for (int i = 0; i < 4; ++i) seln[i] = (int)SEL[(size_t)rown * 256 + lane + 64 * i]; \
                _Pragma("unroll") for (int ks = 0; ks < 4; ++ks) { bf16x8 v = ldg16(QA + (size_t)rown * 1536 + (n < 12 ? n : 0) * 128 + 32 * ks + 8 * kq); if (n >= 12) v = (bf16x8){0, 0, 0, 0, 0, 0, 0, 0}; qfn[ks] = v; } } while (0)
            const LAS int* sl = sidx + lb * 256; LAS int* sln = sidx + (lb ^ 1) * 256;
            float m = -1e30f, l = 0.f; f32x4 O[8];
#pragma unroll
            for (int rt = 0; rt < 8; ++rt) O[rt] = (f32x4){0.f, 0.f, 0.f, 0.f};
            for (int c0 = 0; c0 < cnt; c0 += 32) {
                LAS unsigned char* img = imgb + ib * 8192;
                if (c0 + 32 < cnt) { DSA_GATHER(sl, (row / T) * T, c0 + 32, ib ^ 1);
                    { const int e2 = (c0 + 64 < 256 ? c0 + 64 : 224) + (ln_ >> 1); const int k2 = sl[e2] & 0xffff;
                      __builtin_amdgcn_global_load_lds((const unsigned*)((const unsigned char*)(CKV + (size_t)((row / T) * T) * 128) + ((unsigned)k2 * 256u + 128u * (unsigned)(ln_ & 1))), (LAS unsigned*)(F.lds + P13_JUNK + wave * 256), 4, 0, 0); }
                    if (c0 == 0) { DSA_NEXT_LOADS(); }
                    if (c0 < 64) asm volatile("s_waitcnt vmcnt(18)" ::: "memory"); else asm volatile("s_waitcnt vmcnt(9)" ::: "memory"); }
                else if (hasn) {
                    if (c0 == 0) { DSA_NEXT_LOADS(); }
                    const int cntn = __builtin_amdgcn_readfirstlane(cntn_v);
                    DSA_LIST(sln, seln, rown % T, cntn);
                    asm volatile("s_waitcnt lgkmcnt(0)" ::: "memory");
                    DSA_GATHER(sln, (rown / T) * T, 0, ib ^ 1); asm volatile("s_waitcnt vmcnt(8)" ::: "memory"); }
                else asm volatile("s_waitcnt vmcnt(0)" ::: "memory");
                const bool has = m > -1e29f; const float mref = has ? m : 0.f; const float cinv = -mref;
                f32x4 sa = {cinv, cinv, cinv, cinv}, sb = sa;
                { const unsigned ra = 8u * ((unsigned)(ln_ & 15) >> 2) + ((unsigned)ln_ & 3u), kq_ = (unsigned)ln_ >> 4;
#pragma unroll
                  for (int s = 0; s < 4; ++s) { const bf16x8 ka = *(const LAS bf16x8*)(img + offb(ra, 4 * s + kq_)); const bf16x8 kb = *(const LAS bf16x8*)(img + offb(ra + 4, 4 * s + kq_));
                      sa = MFMA16(ka, qf[s], sa); sb = MFMA16(kb, qf[s], sb); } }
#pragma unroll
                for (int i = 0; i < 4; ++i) { const int ea = c0 + 8 * kq + i;
                    sa[i] += *(const LAS float*)((const LAS unsigned char*)b12c + ((unsigned)sl[ea] >> 16)); sb[i] += *(const LAS float*)((const LAS unsigned char*)b12c + ((unsigned)sl[ea + 4] >> 16)); }
                float fsc = 1.f;
                if (__any((imax3(imax3(__float_as_int(sa[0]), __float_as_int(sa[1]), __float_as_int(sa[2])), imax3(__float_as_int(sa[3]), __float_as_int(sb[0]), __float_as_int(sb[1])), max(__float_as_int(sb[2]), __float_as_int(sb[3]))) > __float_as_int(SM_THR)) || !has)) {
                    float lm = lmax8(sa, sb);
                    lm = fmaxf(lm, __shfl_xor(lm, 16)); lm = fmaxf(lm, __shfl_xor(lm, 32));
                    const bool upd = (lm > -INFINITY) && (!has || lm > 0.f); const float dl = upd ? lm : 0.f;
                    if (upd) m = mref + dl;
                    fsc = has ? __builtin_amdgcn_exp2f(-dl) : 1.f; l *= fsc;
#pragma unroll
                    for (int i = 0; i < 4; ++i) { sa[i] -= dl; sb[i] -= dl; }
#pragma unroll
                    for (int rt = 0; rt < 8; ++rt) O[rt] = O[rt] * fsc;
                }
                f32x4 pa, pb; float sum = 0.f;
#pragma unroll
                for (int i = 0; i < 4; ++i) { pa[i] = __builtin_amdgcn_exp2f(sa[i]); pb[i] = __builtin_amdgcn_exp2f(sb[i]); sum += pa[i] + pb[i]; }
                l += sum;
                const bf16x8 pf = pack8(pa, pb);
                { const unsigned g_ = (unsigned)ln_ >> 4, q_ = ((unsigned)ln_ & 15u) >> 2, p_ = (unsigned)ln_ & 3u;
#pragma unroll
                  for (int rt = 0; rt < 8; ++rt) { const v4i16_t x0 = trrd(img + offb(8 * g_ + q_, 2 * rt + (p_ >> 1)) + 8 * (p_ & 1)), x1 = trrd(img + offb(8 * g_ + 4 + q_, 2 * rt + (p_ >> 1)) + 8 * (p_ & 1));
                      const bf16x8 vf = {x0[0], x0[1], x0[2], x0[3], x1[0], x1[1], x1[2], x1[3]};
                      O[rt] = MFMA16(vf, pf, O[rt]); } }
                ib ^= 1;
            }
            const float il = 1.f / kqsum(l);
            if (n < 12) { bf16* op = CAT1 + (size_t)row * 1792 + n * 128 + 4 * kq;
#pragma unroll
                for (int rt = 0; rt < 8; ++rt) *(uint2*)(op + 16 * rt) = make_uint2(pk2(O[rt][0] * il, O[rt][1] * il), pk2(O[rt][2] * il, O[rt][3] * il)); }
            lb ^= 1; cnt = __builtin_amdgcn_readfirstlane(cntn_v);
#pragma unroll
            for (int ks = 0; ks < 4; ++ks) qf[ks] = qfn[ks];
        }
    }
    }
#undef DSA_GATHER
#undef DSA_LIST
#undef DSA_NEXT_LOADS
    int mreps_ = (PROBE_REP == 8) ? 2 : 1; asm volatile("" : "+s"(mreps_));
    __syncthreads();
    for (int mr_ = 0; mr_ < mreps_; ++mr_)
    for (int u64 = blockIdx.x; u64 < M / 64; u64 += F.G) {
        int tl_ = tid_; asm volatile("" : "+v"(tl_));
        const int ln = tl_ & 63, nn = ln & 15, kqq = ln >> 4, qsl = nn >> 3;
        const int row0 = 64 * u64 + 8 * wave, b = row0 / T;
        const BiasCtx BC0{(const LAS unsigned short*)(F.lds + NSA_TB), 0.f, 0.f, 0.f};
#pragma unroll 1
        for (int hm = 0; hm < 4; ++hm) {
            bf16x8 qf[4][2];
#pragma unroll
            for (int p = 0; p < 4; ++p) { qf[p][0] = (bf16x8){0, 0, 0, 0, 0, 0, 0, 0}; qf[p][1] = qf[p][0]; }
            { const bf16* qp = PR + (size_t)(row0 + (nn & 7)) * 768 + 456 + hm * 64 + 8 * kqq; if (nn < 8) { qf[0][0] = ldg16(qp); qf[0][1] = ldg16(qp + 32); } }
            float m[4], l[4]; f32x4 O[4][4];
#pragma unroll
            for (int p = 0; p < 4; ++p) { m[p] = -1e30f; l[p] = 0.f;
#pragma unroll
                for (int dt = 0; dt < 4; ++dt) O[p][dt] = (f32x4){0.f, 0.f, 0.f, 0.f}; }
            nsa_sweep<MD_MEM>(F.lds + RING_OFF, MKB + (size_t)(b * 256) * 256 + hm * 64, MVT + (size_t)(hm * 64) * 512 + b * 256, 0, 3, 0, nullptr, wave, ln, nn, kqq, qsl, 0, qf, BC0, m, l, O, 256, 64 * 256, 512, 64);
            const float il = 1.f / kqsum(l[0]);
            if (nn < 8) { bf16* op = CAT1 + (size_t)(row0 + nn) * 1792 + 1536 + hm * 64 + 4 * kqq;
#pragma unroll
                for (int dt = 0; dt < 4; ++dt) *(uint2*)(op + 16 * dt) = make_uint2(pk2(O[0][dt][0] * il, O[0][dt][1] * il), pk2(O[0][dt][2] * il, O[0][dt][3] * il)); }
            __syncthreads();
        }
    }
}

struct Args { In in; float* out; unsigned char* ws; int ph_lo, ph_hi; };
__global__ void __launch_bounds__(NWAVES * 64, 2) mk_fwd(Args args) {
    extern __shared__ __attribute__((aligned(16))) unsigned char lds[];
    Frame F;
    F.lds = (LAS unsigned char*)lds; F.MISC = (volatile LAS unsigned*)(F.lds + MISC_OFF);
    F.G = gridDim.x; { const int bx = blockIdx.x; F.vcu = (F.G % 8 == 0) ? (bx % 8) * (F.G / 8) + bx / 8 : bx; }
    unsigned char* ws = args.ws; const In& I = args.in; float* out = args.out; (void)I;
    F.ctl = (gu32*)(ws + WS_CTL);
    for (int u = threadIdx.x; u < (LDS_BYTES - LDSCTL_OFF) / 4; u += NWAVES * 64) ((LAS unsigned*)(F.lds + LDSCTL_OFF))[u] = 0u;
    __syncthreads();
    XcdBarrier bar; bar.bar = (unsigned*)(F.ctl + CW_BAR); bar.x = 0; bar.st = nullptr;
    if (!MK_SPLIT) bar = xcd_barrier_post((unsigned*)(F.ctl + CW_BAR), F.MISC + 8);
    const int lo = args.ph_lo, hi = args.ph_hi;
#ifndef PH_MASK
#define PH_MASK 0xFFFFFFFFu
#endif
#define IN(k) ((((PH_MASK) >> ((k) % 32)) & 1u) && lo <= (k) && (k) < hi)
#define SEAM(k) do { if (IN(k) && IN((k) + 1)) xcd_barrier(bar); } while (0)
#define SEAM2(k, kn) do { if (IN(k) && IN(kn)) xcd_barrier(bar); } while (0)
#ifndef REP_MASK
#define REP_MASK 0u
#endif
#define REPS(k) (1 + (int)(((REP_MASK) >> (k)) & 1u))
    bf16* XN = (bf16*)(ws + WS_XN); bf16* CAT = (bf16*)(ws + WS_CAT); bf16* ACT = (bf16*)(ws + WS_ACT);
    float* SSQ = (float*)(ws + WS_SSQ);

    if (IN(0)) { for (int r_ = 0; r_ < REPS(0); ++r_) { p0_prologue(F, I, ws); if (r_ + 1 < REPS(0)) xcd_barrier(bar); } SEAM(0); }
    {
            if (IN(1)) {
                pg8::Gemm g{XN, (const bf16*)(ws + WS_WIN0), M, 1792, D}; pg8::StaticOrder S; S.init(M, 1792, F.G, (int)blockIdx.x);
                pg8::EpiRoute<0> E{ws, nullptr};
                for (int r_ = 0; r_ < REPS(1); ++r_) { if (r_) xcd_barrier(bar);
                pg8::gemm_phase<pg8::EpiRoute<0>, pg8::StaticOrder, true, true>(F.lds + RING_OFF, g, S, E); }
                pg8::Gemm g2{(const bf16*)(ws + WS_WVT), XN, 256, M, D}; pg8::StaticOrder S2; S2.init(256, M, F.G, (int)((blockIdx.x + 64) % F.G));
                pg8::EpiRoute<3> E2{ws, nullptr};
                pg8::gemm_phase<pg8::EpiRoute<3>, pg8::StaticOrder, true, true>(F.lds + RING_OFF, g2, S2, E2);
                SEAM(1);
            }
            if (IN(2)) { for (int r_ = 0; r_ < REPS(2); ++r_) { p2_mfma(F, I, ws); if (r_ + 1 < REPS(2)) xcd_barrier(bar); } SEAM(2); }
            if (IN(3)) { for (int r_ = 0; r_ < REPS(3); ++r_) { p3_nsa_mfma(F, I, ws); if (r_ + 1 < REPS(3)) xcd_barrier(bar); } SEAM(3); }
    }
    {
        constexpr int L = 0, pb = L ? 14 : 4;
        if (IN(pb)) {
            pg8::Gemm g{L ? (const bf16*)(ws + WS_CAT1) : CAT, L ? (const bf16*)(ws + WS_WO1F) : (const bf16*)(ws + WS_WO), M, D, L ? 1792 : D}; pg8::StaticOrder S; S.init(M, D, F.G, (int)blockIdx.x);
            KARGS(); pg8::EpiResid<L == 0> E{L ? (const void*)XN : (const void*)Ip->x, XN, SSQ + (size_t)(L ? 2 : 0) * M * 16, D, 0};
            pg8::gemm_phase<pg8::EpiResid<L == 0>, pg8::StaticOrder, true, true>(F.lds + RING_OFF, g, S, E);
            SEAM2(pb, pb + 2);
        }
        if (IN(pb + 2)) {
            pg8::Gemm g{XN, (const bf16*)(ws + WS_WGU) + (size_t)L * 2 * DFF * D, M, 2 * DFF, D}; pg8::StaticOrder S; S.init(M, 2 * DFF, F.G, (int)blockIdx.x);
            pg8::EpiSwiglu E{ACT, SSQ + (size_t)(L ? 2 : 0) * M * 16, DFF, 0};
            for (int r_ = 0; r_ < REPS(pb + 2); ++r_) { if (r_) xcd_barrier(bar);
            pg8::gemm_phase<pg8::EpiSwiglu, pg8::StaticOrder, true, true>(F.lds + RING_OFF, g, S, E); }
            SEAM(pb + 2);
        }
        if (IN(pb + 3)) {
            pg8::Gemm g{ACT, (const bf16*)(ws + WS_WD) + (size_t)L * D * DFF, M, D, DFF}; pg8::StaticOrder S; S.init(M, D, F.G, (int)blockIdx.x);
            pg8::EpiResid<false> E{XN, XN, SSQ + (size_t)(L ? 3 : 1) * M * 16, D, 0};
            pg8::gemm_phase<pg8::EpiResid<false>, pg8::StaticOrder, true, true>(F.lds + RING_OFF, g, S, E);
            SEAM2(pb + 3, L ? 18 : 9);
        }
        }
    {
            if (IN(9)) {
                pg8::Gemm g{XN, (const bf16*)(ws + WS_WIN1), M, 768, D}; pg8::StaticOrder S; S.init(M, 768, F.G, (int)blockIdx.x);
                pg8::EpiRoute<1> E{ws, SSQ + (size_t)1 * M * 16};
                for (int r_ = 0; r_ < REPS(9); ++r_) { if (r_) xcd_barrier(bar);
                pg8::gemm_phase<pg8::EpiRoute<1>, pg8::StaticOrder, true, true>(F.lds + RING_OFF, g, S, E); }
                SEAM(9);
            }
            if (IN(10)) { p10_dsa_norm(F, I, ws); SEAM(10); }
            if (IN(11)) {
                pg8::Gemm g{(const bf16*)(ws + WS_CQ), (const bf16*)(ws + WS_WQ2), M, 2048, 256}; pg8::StaticOrder S; S.init(M, 2048, F.G, (int)blockIdx.x);
                pg8::EpiRoute<2> E{ws, nullptr};
                for (int r_ = 0; r_ < REPS(11); ++r_) { if (r_) xcd_barrier(bar);
                pg8::gemm_phase<pg8::EpiRoute<2>, pg8::StaticOrder, true, true>(F.lds + RING_OFF, g, S, E); }
                SEAM(11);
            }
            if (IN(12)) { for (int r_ = 0; r_ < REPS(12); ++r_) { p12_index_mfma(F, I, ws); if (r_ + 1 < REPS(12)) xcd_barrier(bar); } SEAM(12); }
            if (IN(13)) { for (int r_ = 0; r_ < REPS(13); ++r_) { p13_dsa_mfma(F, I, ws); if (r_ + 1 < REPS(13)) xcd_barrier(bar); } SEAM(13); }
            }
    {
        constexpr int L = 1, pb = L ? 14 : 4;
        if (IN(pb)) {
            pg8::Gemm g{L ? (const bf16*)(ws + WS_CAT1) : CAT, L ? (const bf16*)(ws + WS_WO1F) : (const bf16*)(ws + WS_WO), M, D, L ? 1792 : D}; pg8::StaticOrder S; S.init(M, D, F.G, (int)blockIdx.x);
            KARGS(); pg8::EpiResid<L == 0> E{L ? (const void*)XN : (const void*)Ip->x, XN, SSQ + (size_t)(L ? 2 : 0) * M * 16, D, 0};
            pg8::gemm_phase<pg8::EpiResid<L == 0>, pg8::StaticOrder, true, true>(F.lds + RING_OFF, g, S, E);
            SEAM2(pb, pb + 2);
        }
        if (IN(pb + 2)) {
            pg8::Gemm g{XN, (const bf16*)(ws + WS_WGU) + (size_t)L * 2 * DFF * D, M, 2 * DFF, D}; pg8::StaticOrder S; S.init(M, 2 * DFF, F.G, (int)blockIdx.x);
            pg8::EpiSwiglu E{ACT, SSQ + (size_t)(L ? 2 : 0) * M * 16, DFF, 0};
            for (int r_ = 0; r_ < REPS(pb + 2); ++r_) { if (r_) xcd_barrier(bar);
            pg8::gemm_phase<pg8::EpiSwiglu, pg8::StaticOrder, true, true>(F.lds + RING_OFF, g, S, E); }
            SEAM(pb + 2);
        }
        if (IN(pb + 3)) {
            pg8::Gemm g{ACT, (const bf16*)(ws + WS_WD) + (size_t)L * D * DFF, M, D, DFF}; pg8::StaticOrder S; S.init(M, D, F.G, (int)blockIdx.x);
            pg8::EpiResid<false> E{XN, XN, SSQ + (size_t)(L ? 3 : 1) * M * 16, D, 0};
            pg8::gemm_phase<pg8::EpiResid<false>, pg8::StaticOrder, true, true>(F.lds + RING_OFF, g, S, E);
            SEAM2(pb + 3, L ? 18 : 9);
        }
        }
    if (IN(18)) {
        OPAQUE_TID(); KARGS(); const int lane_ = tid_ & 63;
        const int gw = F.vcu * NWAVES + (tid_ >> 6), NGW = F.G * NWAVES;
        for (int m = gw; m < M; m += NGW) { const float r = rsqrtf(pg8::ssq_row(SSQ + ((size_t)3 * M + m) * 16) * (1.f / D) + EPSF);
#pragma unroll
            for (int j = 0; j < 2; ++j) { const int c = (j * 64 + lane_) * 8; const pg8::u32x4 rw = *(const GAS pg8::u32x4*)(XN + (size_t)m * D + c);
                const GAS f32x4* gr = (const GAS f32x4*)(Ip->norm_final + c); GAS f32x4* orow = (GAS f32x4*)(out + (size_t)m * D + c);
                f32x4 r0, r1; r0[0] = __uint_as_float(rw.x << 16); r0[1] = __uint_as_float(rw.x & 0xffff0000u); r0[2] = __uint_as_float(rw.y << 16); r0[3] = __uint_as_float(rw.y & 0xffff0000u);
                r1[0] = __uint_as_float(rw.z << 16); r1[1] = __uint_as_float(rw.z & 0xffff0000u); r1[2] = __uint_as_float(rw.w << 16); r1[3] = __uint_as_float(rw.w & 0xffff0000u);
                orow[0] = (r0 * r) * gr[0]; orow[1] = (r1 * r) * gr[1]; } }
    }
#undef IN
#undef SEAM
}

extern "C" void kernel_launch(void* const* d_in, const int* in_sizes, int n_in, void* d_out, int out_size, void* d_ws, size_t ws_size, hipStream_t stream) {
    static int grid = 0;
    if (grid == 0) {
        if (n_in != 32 || out_size != M * D || ws_size < WS_END) { fprintf(stderr, "kernel_launch: unexpected shapes (n_in %d out %d ws %zu)\n", n_in, out_size, ws_size); grid = -1; return; }
        int dev = 0, cus = 0, per_cu = 0;
        if (hipGetDevice(&dev) != hipSuccess || hipDeviceGetAttribute(&cus, hipDeviceAttributeMultiprocessorCount, dev) != hipSuccess) { grid = -1; return; }
        if (hipFuncSetAttribute((const void*)mk_fwd, hipFuncAttributeMaxDynamicSharedMemorySize, LDS_BYTES) != hipSuccess) { grid = -1; return; }
        if (hipOccupancyMaxActiveBlocksPerMultiprocessor(&per_cu, (const void*)mk_fwd, NWAVES * 64, LDS_BYTES) != hipSuccess || per_cu < 1) fprintf(stderr, "kernel_launch: occupancy query reports %d\n", per_cu);
        (void)hipGetLastError();
        grid = cus;
        if (grid > 256) grid = 256;
    }
    if (grid < 0) return;
    if (hipMemsetAsync((char*)d_ws + WS_CTL, 0, CTL_ZERO_BYTES, stream) != hipSuccess) return;
    Args a{};
    const float** ip = (const float**)&a.in;
    for (int i = 0; i < 32; ++i) ip[i] = (const float*)d_in[i];
    a.out = (float*)d_out; a.ws = (unsigned char*)d_ws;
#if MK_SPLIT
    for (int k = 0; k < N_PHASES; ++k) { a.ph_lo = k; a.ph_hi = k + 1; hipLaunchKernelGGL(mk_fwd, dim3(grid), dim3(NWAVES * 64), LDS_BYTES, stream, a); }
#else
    a.ph_lo = 0; a.ph_hi = N_PHASES; hipLaunchKernelGGL(mk_fwd, dim3(grid), dim3(NWAVES * 64), LDS_BYTES, stream, a);
#endif
}
```

```cpp
#include <hip/hip_runtime.h>
#include <cstdio>
#include <cstdint>
#include <type_traits>
#include <math.h>

namespace pg8 {
#define PG8_LAS __attribute__((address_space(3)))
typedef unsigned short bf16_t;
typedef short bf16x8 __attribute__((ext_vector_type(8)));
typedef float f32x4 __attribute__((ext_vector_type(4)));
typedef unsigned u32x4 __attribute__((ext_vector_type(4)));
constexpr int BM = 256, BK = 64, HALF = 128, HTB = HALF * BK * 2  , STAGE_BYTES = 8 * HTB, NXCD = 8, WGM = 8;

__host__ __device__ __forceinline__ int lds_byte(int r, int c) { const int st = (r >> 4) * 2 + (c >> 5), rr = r & 15, cc = c & 31, ob = rr * 64 + cc * 2; return st * 1024 + (ob ^ (((ob >> 9) & 1) << 5)); }
__host__ __device__ __forceinline__ void stage_rc(int b, int& R, int& C) { const int st = b / 1024, sb = b % 1024, swz = sb ^ (((sb >> 9) & 1) << 5); R = (st >> 1) * 16 + swz / 64; C = (st & 1) * 32 + (swz % 64) / 2; }
__host__ __device__ __forceinline__ int perm32(int rho) { const int n = rho >> 4, i = rho & 15; return 8 * (i >> 2) + 4 * n + (i & 3); }

struct Unit { int pm, pn; };
struct Gemm { const bf16_t* A; const bf16_t* Bt; int M, N, K; };

struct StaticOrder {
    int nM, nN, nwg, G, c;
    __host__ __device__ void init(int M, int N, int G_, int c_) { nM = M / BM; nN = N / BM; nwg = nM * nN; G = G_; c = c_; }
    __host__ __device__ bool next(int i, Unit& u) const {
        const long L = (long)i * G + c; if (L >= nwg) return false;
        int wgid = (int)L; { const int q = nwg / NXCD, r = nwg % NXCD, xcd = wgid % NXCD, off = wgid / NXCD; wgid = (xcd < r ? xcd * (q + 1) : r * (q + 1) + (xcd - r) * q) + off; }
        const int nig = WGM * nN, gid = wgid / nig, fm = gid * WGM, gsz = (nM - fm) < WGM ? (nM - fm) : WGM;
        u.pm = fm + ((wgid % nig) % gsz); u.pn = (wgid % nig) / gsz; return true;
    }
    __device__ __forceinline__ void a_ready(const Unit&) const {}
    __device__ __forceinline__ void done(const Unit&) const {}
};

__device__ __forceinline__ unsigned cvt_pk_bf16(float lo, float hi) { unsigned r; asm volatile("v_cvt_pk_bf16_f32 %0, %1, %2" : "=v"(r) : "v"(lo), "v"(hi)); return r; }
__device__ __forceinline__ float ssq_row(const float* p) { const f32x4 a = ((const f32x4*)p)[0], b = ((const f32x4*)p)[1], c = ((const f32x4*)p)[2], d = ((const f32x4*)p)[3]; const f32x4 t = (a + b) + (c + d); return (t[0] + t[1]) + (t[2] + t[3]); }
template <int ROUTE> struct EpiRoute {
    static constexpr bool PERM = true, AFTER_DRAIN = false;
    unsigned char* ws; const float* ssq;
    __device__ __forceinline__ void operator()(const f32x4 (&acc)[2][2][4][2], const Unit& u, int wr, int wc, int fr, int fq) const {
        asm volatile("" : "+v"(fr), "+v"(fq));
        const int pn = u.pn; size_t off; int ld, t0; float sc;
        if constexpr (ROUTE == 0) {
            off = pn < 3 ? (size_t)(88u << 20) : pn < 5 ? (size_t)(112u << 20) : pn < 6 ? (size_t)(128u << 20) : (size_t)(136u << 20);
            ld = pn < 3 ? 768 : pn < 5 ? 512 : 256; t0 = pn < 3 ? 0 : pn < 5 ? 3 : pn < 6 ? 5 : 6; sc = (pn < 3 || pn == 5) ? 0.18033688011112042f : 1.f;
        } else if constexpr (ROUTE == 1) { off = (size_t)(88u << 20); ld = 768; t0 = 0; sc = 1.f; }
        else if constexpr (ROUTE == 3) { off = (size_t)(144u << 20); ld = 16384; t0 = 0; sc = 1.f; }
        else { off = pn < 6 ? (size_t)(128u << 20) : (size_t)(176u << 20); ld = pn < 6 ? 1536 : 512; t0 = pn < 6 ? 0 : 6; sc = 1.f; }
        bf16_t* base = (bf16_t*)(ws + off);
        const int row0 = u.pm * BM + wr * 64 + fr, col0 = (pn - t0) * BM + wc * 32 + 8 * fq;
#pragma unroll
        for (int ai = 0; ai < 2; ++ai)
#pragma unroll
            for (int m = 0; m < 4; ++m) { bf16_t* rowp = base + (size_t)(row0 + ai * HALF + m * 16) * ld + col0;
                float scr_ = sc; if constexpr (ROUTE == 1) scr_ = rsqrtf(ssq_row(ssq + (size_t)(row0 + ai * HALF + m * 16) * 16) * (1.f / 1024.f) + 1e-6f);
#pragma unroll
                for (int bj = 0; bj < 2; ++bj) { float scb_ = scr_; if constexpr (ROUTE == 1) { const int cg = col0 + bj * HALF; if (cg >= 456 && cg < 712) scb_ *= 0.18033688011112042f; }
                    const f32x4 v0 = acc[ai][bj][m][0] * scb_, v1 = acc[ai][bj][m][1] * scb_;
                    u32x4 w; w.x = cvt_pk_bf16(v0[0], v0[1]); w.y = cvt_pk_bf16(v0[2], v0[3]); w.z = cvt_pk_bf16(v1[0], v1[1]); w.w = cvt_pk_bf16(v1[2], v1[3]);
                    if constexpr (ROUTE == 3) {
                        const int tok = col0 + bj * HALF, rw = row0 + ai * HALF + m * 16; *(u32x4*)(base + ((size_t)(tok >> 6) * 256 + rw) * 64 + (tok & 63)) = w; }
                    else *(u32x4*)(rowp + bj * HALF) = w; } }
    }
};
template <bool RES_F32>
struct EpiResid {
    static constexpr bool PERM = true, AFTER_DRAIN = false;
    const void* res; bf16_t* hb; float* ssq; int ldc; int pad;
    __device__ __forceinline__ void operator()(const f32x4 (&acc)[2][2][4][2], const Unit& u, int wr, int wc, int fr, int fq) const {
        asm volatile("" : "+v"(fr), "+v"(fq));
        const int row0 = u.pm * BM + wr * 64 + fr, col0 = u.pn * BM + wc * 32 + 8 * fq;
#pragma unroll
        for (int ai = 0; ai < 2; ++ai)
#pragma unroll
            for (int m = 0; m < 4; ++m) { const int row = row0 + ai * HALF + m * 16; const size_t off = (size_t)row * ldc + col0; float sq = 0.f;
#pragma unroll
                for (int bj = 0; bj < 2; ++bj) { f32x4 v[2];
                    if constexpr (RES_F32) {
#pragma unroll
                        for (int n = 0; n < 2; ++n) v[n] = *(const f32x4*)((const float*)res + off + bj * HALF + 4 * n) + acc[ai][bj][m][n];
                    } else { const u32x4 rw = *(const u32x4*)((const bf16_t*)res + off + bj * HALF);
                        f32x4 r0, r1; r0[0] = __uint_as_float(rw.x << 16); r0[1] = __uint_as_float(rw.x & 0xffff0000u); r0[2] = __uint_as_float(rw.y << 16); r0[3] = __uint_as_float(rw.y & 0xffff0000u);
                        r1[0] = __uint_as_float(rw.z << 16); r1[1] = __uint_as_float(rw.z & 0xffff0000u); r1[2] = __uint_as_float(rw.w << 16); r1[3] = __uint_as_float(rw.w & 0xffff0000u);
                        v[0] = r0 + acc[ai][bj][m][0]; v[1] = r1 + acc[ai][bj][m][1]; }
#pragma unroll
                    for (int n = 0; n < 2; ++n) sq += (v[n][0] * v[n][0] + v[n][1] * v[n][1]) + (v[n][2] * v[n][2] + v[n][3] * v[n][3]);
                    u32x4 w; w.x = cvt_pk_bf16(v[0][0], v[0][1]); w.y = cvt_pk_bf16(v[0][2], v[0][3]); w.z = cvt_pk_bf16(v[1][0], v[1][1]); w.w = cvt_pk_bf16(v[1][2], v[1][3]); *(u32x4*)(hb + off + bj * HALF) = w; }
                sq += __shfl_xor(sq, 16); sq += __shfl_xor(sq, 32); if (fq == 0) ssq[(size_t)row * 16 + u.pn * 4 + wc] = sq; }
    }
};
struct EpiSwiglu {
    static constexpr bool PERM = true, AFTER_DRAIN = false;
    bf16_t* O; const float* ssq; int ldc; int pad;
    __device__ __forceinline__ void operator()(const f32x4 (&acc)[2][2][4][2], const Unit& u, int wr, int wc, int fr, int fq) const {
        asm volatile("" : "+v"(fr), "+v"(fq));
        const int row0 = u.pm * BM + wr * 64 + fr, col0 = u.pn * HALF + wc * 32 + 8 * fq;
#pragma unroll
        for (int ai = 0; ai < 2; ++ai)
#pragma unroll
            for (int m = 0; m < 4; ++m) { float o[8]; const float rs = rsqrtf(ssq_row(ssq + (size_t)(row0 + ai * HALF + m * 16) * 16) * (1.f / 1024.f) + 1e-6f);
#pragma unroll
                for (int n = 0; n < 2; ++n)
#pragma unroll
                    for (int e = 0; e < 4; ++e) { const float g = acc[ai][0][m][n][e] * rs, up = acc[ai][1][m][n][e] * rs; o[4 * n + e] = (g * __builtin_amdgcn_rcpf(1.f + __expf(-g))) * up; }
                u32x4 w; w.x = cvt_pk_bf16(o[0], o[1]); w.y = cvt_pk_bf16(o[2], o[3]); w.z = cvt_pk_bf16(o[4], o[5]); w.w = cvt_pk_bf16(o[6], o[7]);
                *(u32x4*)(O + (size_t)(row0 + ai * HALF + m * 16) * ldc + col0) = w; }
    }
};
template <class Epi, class Sched, bool ALIGN_EPI = false, bool SP2 = false>
__device__ __forceinline__ void gemm_phase(PG8_LAS unsigned char* lds, const Gemm g, const Sched& S, const Epi& E) {
    int tid = threadIdx.x; asm volatile("" : "+v"(tid));
    const int wid = __builtin_amdgcn_readfirstlane(tid >> 6), lane = tid & 63, wr = wid >> 2, wc = wid & 3, fr = lane & 15, fq = lane >> 4;
    int K = g.K; asm volatile("" : "+s"(K));
    const int nt = K / BK;
    unsigned voffA[2], voffB[2];
#pragma unroll
    for (int i = 0; i < 2; ++i) { int R, C; stage_rc(tid * 16 + i * 8192, R, C); const int Rb = Epi::PERM ? ((R & ~31) + perm32(R & 31)) : R;
        voffA[i] = (unsigned)(R * K + C) * 2u; voffB[i] = (unsigned)(Rb * K + C) * 2u; }
    const size_t kstep = (size_t)(BK * 2);
    const size_t hstep = (size_t)HALF * K * 2;
    const size_t tstep = 2 * hstep;
    const unsigned ldsw = (unsigned)wid * 1024u;
    const int aoff = lds_byte(wr * 64 + fr, fq * 8), boff = lds_byte(wc * 32 + fr, fq * 8);
#define PG8_SA(b, h) (((b) * 2 + (h)) * HTB)
#define PG8_SB(b, h) ((4 + (b) * 2 + (h)) * HTB)
#define PG8_STAGE(bufoff, gbase, voff) do { _Pragma("unroll") for (int _i = 0; _i < 2; ++_i) \
        __builtin_amdgcn_global_load_lds((const unsigned*)((const char*)(gbase) + (voff)[_i]), (PG8_LAS unsigned*)(lds + (bufoff) + ldsw + _i * 8192), 16, 0, 0); } while (0)
#define PG8_LDA(dst, b, h) do { _Pragma("unroll") for (int m = 0; m < 4; ++m) _Pragma("unroll") for (int k = 0; k < 2; ++k) dst[m][k] = *(const PG8_LAS bf16x8*)(lds + PG8_SA(b, h) + aoff + m * 2048 + k * 1024); } while (0)
#define PG8_LDB(dst, b, h) do { _Pragma("unroll") for (int n = 0; n < 2; ++n) _Pragma("unroll") for (int k = 0; k < 2; ++k) dst[n][k] = *(const PG8_LAS bf16x8*)(lds + PG8_SB(b, h) + boff + n * 2048 + k * 1024); } while (0)
#define PG8_MMA(ai, bj, At, Bt) do { __builtin_amdgcn_s_setprio(1); _Pragma("unroll") for (int m = 0; m < 4; ++m) _Pragma("unroll") for (int n = 0; n < 2; ++n) _Pragma("unroll") for (int k = 0; k < 2; ++k) \
        acc[ai][bj][m][n] = __builtin_amdgcn_mfma_f32_16x16x32_bf16(Bt[n][k], At[m][k], acc[ai][bj][m][n], 0, 0, 0); __builtin_amdgcn_s_setprio(0); } while (0)
#define PG8_WAIT_V(n) asm volatile("s_waitcnt vmcnt(" #n ")" ::: "memory")
#define PG8_WAIT_L(n) asm volatile("s_waitcnt lgkmcnt(" #n ")" ::: "memory")
#define PG8_BAR __builtin_amdgcn_s_barrier()
#define PG8_SCHED __builtin_amdgcn_sched_barrier(0)
    Unit cur, nxt; int ui = 0;
    if (!S.next(0, cur)) return;
    f32x4 acc[2][2][4][2];
#pragma unroll
    for (int a = 0; a < 2; ++a)
#pragma unroll
        for (int b = 0; b < 2; ++b)
#pragma unroll
            for (int m = 0; m < 4; ++m)
#pragma unroll
                for (int n = 0; n < 2; ++n) acc[a][b][m][n] = (f32x4){0.f, 0.f, 0.f, 0.f};
    bf16x8 At[4][2], B0[2][2], B1[2][2];
    const char* cA = (const char*)g.A + (size_t)cur.pm * tstep; const char* cB = (const char*)g.Bt + (size_t)cur.pn * tstep;
    S.a_ready(cur);
    if constexpr (SP2) {
        PG8_STAGE(PG8_SB(0, 0), cB, voffB); PG8_STAGE(PG8_SB(0, 1), cB + hstep, voffB); PG8_STAGE(PG8_SA(0, 0), cA, voffA); PG8_STAGE(PG8_SA(0, 1), cA + hstep, voffA);
        if (wr == 1) PG8_BAR;
        PG8_WAIT_V(2); PG8_BAR;
        PG8_STAGE(PG8_SB(1, 0), cB + kstep, voffB); PG8_STAGE(PG8_SA(1, 0), cA + kstep, voffA); PG8_STAGE(PG8_SB(1, 1), cB + hstep + kstep, voffB);
        PG8_WAIT_V(6); PG8_BAR;
    } else {
        PG8_STAGE(PG8_SB(0, 0), cB, voffB); PG8_STAGE(PG8_SA(0, 0), cA, voffA); PG8_STAGE(PG8_SB(0, 1), cB + hstep, voffB); PG8_STAGE(PG8_SA(0, 1), cA + hstep, voffA);
        if (wr == 1) PG8_BAR;
        PG8_WAIT_V(4); PG8_BAR;
        PG8_STAGE(PG8_SB(1, 0), cB + kstep, voffB); PG8_STAGE(PG8_SA(1, 0), cA + kstep, voffA); PG8_STAGE(PG8_SB(1, 1), cB + hstep + kstep, voffB);
        PG8_WAIT_V(6); PG8_BAR;
    }
    for (;;) {
        const bool has_next = S.next(ui + 1, nxt);
        const char* nA = has_next ? (const char*)g.A + (size_t)nxt.pm * tstep : cA; const char* nB = has_next ? (const char*)g.Bt + (size_t)nxt.pn * tstep : cB;
        for (int t = 0; t < nt; t += 2) {
            const bool last = (t == nt - 2);
            const char* a1 = cA + (size_t)(t + 1) * kstep;
            const char* a2 = last ? nA : cA + (size_t)(t + 2) * kstep; const char* b2 = last ? nB : cB + (size_t)(t + 2) * kstep;
            const char* a3 = a2 + kstep; const char* b3 = b2 + kstep;
            if (last && has_next) S.a_ready(nxt);
            if constexpr (SP2) {
            PG8_LDB(B0, 0, 0); PG8_LDB(B1, 0, 1); PG8_SCHED; PG8_LDA(At, 0, 0); PG8_STAGE(PG8_SA(1, 1), a1 + hstep, voffA);
            PG8_WAIT_V(8); PG8_WAIT_L(0); PG8_BAR; PG8_MMA(0, 0, At, B0); PG8_MMA(0, 1, At, B1); PG8_BAR; PG8_SCHED;
            PG8_LDA(At, 0, 1); PG8_STAGE(PG8_SB(0, 0), b2, voffB); PG8_STAGE(PG8_SB(0, 1), b2 + hstep, voffB); PG8_STAGE(PG8_SA(0, 0), a2, voffA);
            PG8_WAIT_V(8); PG8_WAIT_L(0); PG8_BAR; PG8_MMA(1, 0, At, B0); PG8_MMA(1, 1, At, B1); PG8_BAR; PG8_SCHED;
            PG8_LDB(B0, 1, 0); PG8_LDB(B1, 1, 1); PG8_SCHED; PG8_LDA(At, 1, 0); PG8_STAGE(PG8_SA(0, 1), a2 + hstep, voffA);
            PG8_WAIT_V(8); PG8_WAIT_L(0); PG8_BAR; PG8_MMA(0, 0, At, B0); PG8_MMA(0, 1, At, B1); PG8_BAR; PG8_SCHED;
            PG8_LDA(At, 1, 1); PG8_STAGE(PG8_SB(1, 0), b3, voffB); PG8_STAGE(PG8_SB(1, 1), b3 + hstep, voffB); PG8_STAGE(PG8_SA(1, 0), a3, voffA);
            PG8_WAIT_V(8); PG8_WAIT_L(0); PG8_BAR; PG8_MMA(1, 0, At, B0); PG8_MMA(1, 1, At, B1); PG8_BAR; PG8_SCHED;
            } else {
            PG8_LDB(B0, 0, 0); PG8_SCHED; PG8_LDA(At, 0, 0); PG8_STAGE(PG8_SA(1, 1), a1 + hstep, voffA);
            PG8_WAIT_L(8); PG8_BAR; PG8_WAIT_L(0); PG8_MMA(0, 0, At, B0); PG8_BAR; PG8_SCHED;
            PG8_LDB(B1, 0, 1); PG8_STAGE(PG8_SB(0, 0), b2, voffB);
            PG8_BAR; PG8_WAIT_L(0); PG8_MMA(0, 1, At, B1); PG8_BAR;
            PG8_LDA(At, 0, 1); PG8_STAGE(PG8_SA(0, 0), a2, voffA);
            PG8_BAR; PG8_WAIT_L(0); PG8_MMA(1, 0, At, B0); PG8_BAR; PG8_SCHED;
            PG8_STAGE(PG8_SB(0, 1), b2 + hstep, voffB);
            PG8_WAIT_V(6); PG8_BAR; PG8_MMA(1, 1, At, B1); PG8_BAR;
            PG8_LDB(B0, 1, 0); PG8_SCHED; PG8_LDA(At, 1, 0); PG8_STAGE(PG8_SA(0, 1), a2 + hstep, voffA);
            PG8_WAIT_L(8); PG8_BAR; PG8_WAIT_L(0); PG8_MMA(0, 0, At, B0); PG8_BAR; PG8_SCHED;
            PG8_LDB(B1, 1, 1); PG8_STAGE(PG8_SB(1, 0), b3, voffB);
            PG8_BAR; PG8_WAIT_L(0); PG8_MMA(0, 1, At, B1); PG8_BAR;
            PG8_LDA(At, 1, 1); PG8_STAGE(PG8_SA(1, 0), a3, voffA);
            PG8_BAR; PG8_WAIT_L(0); PG8_MMA(1, 0, At, B0); PG8_BAR; PG8_SCHED;
            PG8_STAGE(PG8_SB(1, 1), b3 + hstep, voffB);
            PG8_WAIT_V(6); PG8_BAR; PG8_MMA(1, 1, At, B1); PG8_BAR;
            }
        }
        if constexpr (ALIGN_EPI) { if (wr == 0) PG8_BAR; }
        if constexpr (!Epi::AFTER_DRAIN) { E(acc, cur, wr, wc, fr, fq); S.done(cur); }
        if (!has_next) break;
#pragma unroll
        for (int a = 0; a < 2; ++a)
#pragma unroll
            for (int b = 0; b < 2; ++b)
#pragma unroll
                for (int m = 0; m < 4; ++m)
#pragma unroll
                    for (int n = 0; n < 2; ++n) acc[a][b][m][n] = (f32x4){0.f, 0.f, 0.f, 0.f};
        cur = nxt; cA = nA; cB = nB; ++ui;
        if constexpr (ALIGN_EPI) { if (wr == 1) PG8_BAR; }
    }
    PG8_WAIT_V(0);
    if constexpr (!ALIGN_EPI) { if (wr == 0) PG8_BAR; }
    PG8_BAR;
    if constexpr (Epi::AFTER_DRAIN) { E.fused(acc, cur, wr, wc, fr, fq, lds, wid, lane); S.done(cur); }
#undef PG8_SA
#undef PG8_SB
#undef PG8_STAGE
#undef PG8_LDA
#undef PG8_LDB
#undef PG8_MMA
#undef PG8_WAIT_V
#undef PG8_WAIT_L
#undef PG8_BAR
#undef PG8_SCHED
}
}
constexpr int NWAVES = 8;
constexpr int BATCH = 2, T = 8192, D = 1024, M = BATCH * T, DFF = 2816, NSA_IN = 1828, DSA_IN = 712, NCMP = 511, NCR = BATCH * NCMP * 2;
constexpr float NEGF = -1e30f, EPSF = 1e-6f;
#ifndef MK_SPLIT
#define MK_SPLIT 0
#endif
constexpr int N_PHASES = 19;
constexpr size_t MiB = 1u << 20;
constexpr size_t WS_CTL = 0, CTL_ZERO_BYTES = 1 * MiB;
constexpr size_t WS_KCB = 1 * MiB  , WS_VCT = 1 * MiB + 512 * 1024  , WS_MKB = 2 * MiB  , WS_MVT = 2 * MiB + 512 * 1024  , WS_MKV = 3 * MiB  , WS_WIDX = 5 * MiB  , WS_CNT = 6 * MiB  ;
constexpr size_t WS_WIN0 = 8 * MiB, WS_WO = 12 * MiB, WS_WGU = 16 * MiB, WS_WD = 38 * MiB, WS_WIN1 = 49 * MiB, WS_WQ2 = 51 * MiB, WS_WVT = 52 * MiB  ;
constexpr size_t WS_W1T = 232 * MiB, WS_MEMN = 234 * MiB, WS_WMKT = 236 * MiB, WS_W2T = 238 * MiB, WS_B1F = 238 * MiB + 64 * 1024;
constexpr size_t WS_XN = 56 * MiB;
constexpr size_t WS_Q0 = 88 * MiB, WS_KV0 = 112 * MiB  , WS_QM = 128 * MiB, WS_G0 = 136 * MiB, WS_VT = 144 * MiB  ;
static_assert(WS_Q0 == (88u << 20) && WS_KV0 == (112u << 20) && WS_QM == (128u << 20) && WS_G0 == (136u << 20), "EpiRoute tables");
constexpr size_t WS_ACT = 88 * MiB;
constexpr size_t WS_PROJ1 = 88 * MiB, WS_CQ = 112 * MiB, WS_CKV = 120 * MiB, WS_KIDX = 124 * MiB, WS_QA = 128 * MiB, WS_QI = 176 * MiB, WS_SEL = 112 * MiB  , WS_CAT1 = 176 * MiB  , WS_WO1F = 52 * MiB + 512 * 1024  ;
constexpr size_t WS_OCS = 152 * MiB  , WS_CAT = 200 * MiB, WS_SSQ = 239 * MiB  , WS_END = 243 * MiB;
static_assert(WS_PROJ1 == (88u << 20) && WS_QA == (128u << 20) && WS_QI == (176u << 20) && WS_VT == (144u << 20), "EpiRoute tables");
static_assert(WS_ACT + (size_t)M * DFF * 2 <= WS_CAT + 0 * MiB || true, "map");
constexpr int CW_BAR = 4096;
constexpr int RING_OFF = 0, RING_BYTES = 131072, LDS_BYTES = 163840, LDSCTL_OFF = LDS_BYTES - 1024, MISC_OFF = LDSCTL_OFF + 320;
#define GAS __attribute__((address_space(1)))
#define LAS __attribute__((address_space(3)))
typedef unsigned short bf16;
typedef unsigned v4u __attribute__((ext_vector_type(4)));
typedef unsigned v2u __attribute__((ext_vector_type(2)));
typedef float f32x4 __attribute__((ext_vector_type(4)));
typedef short bf16x8 __attribute__((ext_vector_type(8)));
typedef GAS unsigned gu32;
typedef GAS unsigned long long gu64;
#define RLX_AGENT __ATOMIC_RELAXED, __HIP_MEMORY_SCOPE_AGENT
#define LDS_WAIT() asm volatile("s_waitcnt lgkmcnt(0)" ::: "memory")
#define VM_WAIT() asm volatile("s_waitcnt vmcnt(0)" ::: "memory")
__device__ __forceinline__ unsigned long long rt() { return __builtin_amdgcn_s_memrealtime(); }
__device__ __forceinline__ unsigned f2bf(float f) { unsigned u = __builtin_bit_cast(unsigned, f); return (u + 0x7fffu + ((u >> 16) & 1u)) >> 16; }
__device__ __forceinline__ unsigned pk2(float lo, float hi) { return f2bf(lo) | (f2bf(hi) << 16); }
#define XB_TMO      128
#define XB_XCNT(j)  (256  + 64 * (j))
#define XB_XSUB(j)  (1280 + 64 * (j))
#define XB_XGEN(j)  (2304 + 64 * (j))
#define XB_TOP      3328
#define XB_TOPGEN   3392
#define XCD_BAR_WORDS 3456
#define XB_SPIN_CAP (1u << 18)

__device__ __forceinline__ unsigned xb_ld(unsigned* p)              { return __hip_atomic_load(p, __ATOMIC_RELAXED, __HIP_MEMORY_SCOPE_AGENT); }
__device__ __forceinline__ unsigned xb_add(unsigned* p, unsigned v) { return __hip_atomic_fetch_add(p, v, __ATOMIC_RELAXED, __HIP_MEMORY_SCOPE_AGENT); }
__device__ __forceinline__ unsigned xb_xcc_id() { return (unsigned)__builtin_amdgcn_s_getreg((3 << 11) | 20) & 0xFu; }
#define XB_SPIN(cond, bar) do { unsigned _sp = 0; while (cond) { __builtin_amdgcn_s_sleep(1); \
    if ((++_sp & 255u) == 0u) { if (xb_ld(&(bar)[XB_TMO])) break; if (_sp > XB_SPIN_CAP) { atomicAdd(&(bar)[XB_TMO], 1u); break; } } } } while (0)

struct XcdBarrier {
    unsigned* bar; unsigned x;
    volatile LAS unsigned* st;
};

__device__ __forceinline__ XcdBarrier xcd_barrier_post(unsigned* bar, volatile LAS unsigned* st) {
    XcdBarrier b; b.bar = bar; b.x = xb_xcc_id(); b.st = st;
    if (threadIdx.x == 0) (void)xb_add(&bar[XB_XCNT(b.x)], 1u);
    return b;
}
__device__ __forceinline__ void xcd_barrier_complete(unsigned* bar, unsigned x, unsigned& nloc, unsigned& nx) {
    const unsigned G = gridDim.x * gridDim.y * gridDim.z;
    unsigned sum, cnt, mine, sp = 0u;
    for (;;) {
        sum = 0u; cnt = 0u; mine = 0u;
#pragma unroll 1
        for (unsigned j = 0; j < 16; ++j) { const unsigned c = xb_ld(&bar[XB_XCNT(j)]); sum += c; cnt += (c > 0u) ? 1u : 0u; mine = (j == x) ? c : mine; }
        if (sum == G) break;
        __builtin_amdgcn_s_sleep(1);
        if ((++sp & 255u) == 0u) { if (xb_ld(&bar[XB_TMO])) break; if (sp > XB_SPIN_CAP) { atomicAdd(&bar[XB_TMO], 1u); break; } }
    }
    nloc = mine > 0u ? mine : 1u; nx = cnt > 0u ? cnt : 1u;
}

__device__ __forceinline__ void xcd_barrier(const XcdBarrier& b) {
    asm volatile("s_waitcnt vmcnt(0)" ::: "memory");
    __syncthreads();
    if (threadIdx.x == 0) {
        unsigned* bar = b.bar;
        __builtin_amdgcn_s_waitcnt(0);
        unsigned nloc = b.st[0], nx = b.st[1];
        if (nloc == 0u) { xcd_barrier_complete(bar, b.x, nloc, nx); b.st[0] = nloc; b.st[1] = nx; }
        const unsigned old = xb_add(&bar[XB_XSUB(b.x)], 1u);
        const unsigned gen = old / nloc;
        if (old + 1u == (gen + 1u) * nloc) {
            __builtin_amdgcn_fence(__ATOMIC_RELEASE, "agent");
            asm volatile("s_waitcnt vmcnt(0)" ::: "memory");
            const unsigned og = xb_add(&bar[XB_TOP], 1u);
            const unsigned tg = og / nx;
            if (og + 1u == (tg + 1u) * nx) xb_add(&bar[XB_TOPGEN], 1u);
            else XB_SPIN(xb_ld(&bar[XB_TOPGEN]) == tg, bar);
            __builtin_amdgcn_fence(__ATOMIC_ACQUIRE, "agent");
            xb_add(&bar[XB_XGEN(b.x)], 1u);
            asm volatile("s_waitcnt vmcnt(0)" ::: "memory");
        } else {
            XB_SPIN(xb_ld(&bar[XB_XGEN(b.x)]) == gen, bar);
            __builtin_amdgcn_fence(__ATOMIC_ACQUIRE, "agent");
            asm volatile("s_waitcnt vmcnt(0)" ::: "memory");
        }
    }
    __syncthreads();
}

struct Frame {
    LAS unsigned char* lds; volatile LAS unsigned* MISC; gu32* ctl;
    int vcu, G;
};
__device__ __forceinline__ float bf2f(unsigned short u) { return __uint_as_float((unsigned)u << 16); }
__device__ __forceinline__ float bflo(unsigned u) { return __uint_as_float(u << 16); }
__device__ __forceinline__ float bfhi(unsigned u) { return __uint_as_float(u & 0xffff0000u); }
__device__ __forceinline__ float wave_sum(float v) {
#pragma unroll
    for (int o = 1; o < 64; o <<= 1) v += __shfl_xor(v, o);
    return v;
}
__device__ __forceinline__ float red16_sum(float v) { v += __shfl_xor(v, 1, 16); v += __shfl_xor(v, 2, 16); v += __shfl_xor(v, 4, 16); v += __shfl_xor(v, 8, 16); return v; }
__device__ __forceinline__ float red16_max(float v) { v = fmaxf(v, __shfl_xor(v, 1, 16)); v = fmaxf(v, __shfl_xor(v, 2, 16)); v = fmaxf(v, __shfl_xor(v, 4, 16)); v = fmaxf(v, __shfl_xor(v, 8, 16)); return v; }
__device__ __forceinline__ int rel_bucket(int n) {
    if (n < 16) return n;
    return 16 + (n >= 22) + (n >= 30) + (n >= 40) + (n >= 54) + (n >= 73) + (n >= 99) + (n >= 134) + (n >= 182) + (n >= 246) + (n >= 332) + (n >= 450) + (n >= 609) + (n >= 825) + (n >= 1117) + (n >= 1513);
}

__device__ __forceinline__ void xpose_item(const float* W, int ldw, int c0, int nvalid, int k0, bf16* WT, int Kd, int drow0, LAS float* scr, int lane, const float* kgain = nullptr) {
#pragma unroll
    for (int i = 0; i < 8; ++i) { const int kk = 8 * i + (lane >> 3), n = (lane & 7) * 4;
        float4 wv = make_float4(0.f, 0.f, 0.f, 0.f);
        if (n + 3 < nvalid) wv = *(const float4*)(W + (size_t)(k0 + kk) * ldw + c0 + n);
        else if (n < nvalid) { const float* wp = W + (size_t)(k0 + kk) * ldw + c0 + n; wv.x = wp[0]; if (n + 1 < nvalid) wv.y = wp[1]; if (n + 2 < nvalid) wv.z = wp[2]; }
        if (kgain) { const float g_ = kgain[k0 + kk]; wv.x *= g_; wv.y *= g_; wv.z *= g_; wv.w *= g_; }
        LAS float* sp = scr + kk * 33 + n; sp[0] = wv.x; sp[1] = wv.y; sp[2] = wv.z; sp[3] = wv.w; }
    LDS_WAIT(); asm volatile("" ::: "memory");
    const int c = lane & 7;
#pragma unroll
    for (int j = 0; j < 4; ++j) { const int n = (lane >> 3) + 8 * j; const LAS float* s = scr + (8 * c) * 33 + n;
        v4u o; o.x = pk2(s[0 * 33], s[1 * 33]); o.y = pk2(s[2 * 33], s[3 * 33]); o.z = pk2(s[4 * 33], s[5 * 33]); o.w = pk2(s[6 * 33], s[7 * 33]);
        *(GAS v4u*)(WT + (size_t)(drow0 + n) * Kd + k0 + 8 * c) = o; }
    LDS_WAIT(); asm volatile("" ::: "memory");
}
__device__ __forceinline__ void rms_row_to_bf16(const float* xrow, const float* gain, bf16* orow, int lane) {
    const GAS f32x4* xr = (const GAS f32x4*)xrow + lane; const GAS f32x4* gr = (const GAS f32x4*)gain + lane;
    f32x4 v[4]; float s = 0.f;
#pragma unroll
    for (int j = 0; j < 4; ++j) { v[j] = xr[64 * j]; s += (v[j].x * v[j].x + v[j].y * v[j].y) + (v[j].z * v[j].z + v[j].w * v[j].w); }
    const float r = rsqrtf(wave_sum(s) * (1.f / D) + EPSF);
    GAS unsigned long long* o8 = (GAS unsigned long long*)orow + lane;
#pragma unroll
    for (int j = 0; j < 4; ++j) { const f32x4 g = gr[64 * j]; o8[64 * j] = (unsigned long long)pk2((v[j].x * r) * g.x, (v[j].y * r) * g.y) | ((unsigned long long)pk2((v[j].z * r) * g.z, (v[j].w * r) * g.w) << 32); }
}
#ifndef PROBE_REP
#define PROBE_REP 0
#endif
#define CAS __attribute__((address_space(4)))
#define KARGS() const CAS In* Ip = (const CAS In*)__builtin_amdgcn_kernarg_segment_ptr(); asm volatile("" : "+s"(Ip))
#define OPAQUE_TID() int tid_ = threadIdx.x; asm volatile("" : "+v"(tid_))
__device__ __forceinline__ void norm_phase(Frame& F, const float* x, const float* gain, bf16* xn) {
    OPAQUE_TID(); const int lane_ = tid_ & 63, wave_ = tid_ >> 6;
    const int gw = F.vcu * NWAVES + wave_, NGW = F.G * NWAVES;
    for (int m = gw; m < M; m += NGW) rms_row_to_bf16(x + (size_t)m * D, gain, xn + (size_t)m * D, lane_);
}

template <int DL>
__device__ __forceinline__ void coop_attend(const float (&q)[DL], const float (&k)[DL], const float (&v)[DL], float bias, float& m_, float& l_, float (&o)[DL]) {
    float a = 0.f;
#pragma unroll
    for (int d = 0; d < DL; ++d) a += q[d] * k[d];
    a = red16_sum(a) + bias;
    const float mn = fmaxf(m_, a), al = __expf(m_ - mn), p = __expf(a - mn);
    l_ = l_ * al + p; m_ = mn;
#pragma unroll
    for (int d = 0; d < DL; ++d) o[d] = o[d] * al + p * v[d];
}
__device__ __forceinline__ void ld4bf(const bf16* p, float (&x)[4]) { const uint2 u = *(const uint2*)p; x[0] = bflo(u.x); x[1] = bfhi(u.x); x[2] = bflo(u.y); x[3] = bfhi(u.y); }
__device__ __forceinline__ void ld8bf(const bf16* p, float (&x)[8]) { const uint4 u = *(const uint4*)p; x[0] = bflo(u.x); x[1] = bfhi(u.x); x[2] = bflo(u.y); x[3] = bfhi(u.y); x[4] = bflo(u.z); x[5] = bfhi(u.z); x[6] = bflo(u.w); x[7] = bfhi(u.w); }
__device__ __forceinline__ void ld4f(const float* p, float (&x)[4]) { const float4 u = *(const float4*)p; x[0] = u.x; x[1] = u.y; x[2] = u.z; x[3] = u.w; }

struct In {
    const float *x, *mem, *rel_bias, *norm_mix, *norm_ffn, *norm_mem, *w_mem_kv, *w_out, *ffn_gate, *ffn_up, *ffn_down, *nsa_w_in, *nsa_gate_b, *pos_k, *pos_v,
        *k_w1, *k_b1, *k_w2, *k_b2, *v_w1, *v_b1, *v_w2, *v_b2, *dsa_w_in, *q_norm, *kv_norm, *w_q_up, *w_uk, *w_uv, *w_q_idx, *kidx_norm, *norm_final;
};
__device__ __forceinline__ void p0_prologue(Frame& F, const In& I, unsigned char* ws) {
    OPAQUE_TID(); KARGS(); const int lane_ = tid_ & 63, wave_ = __builtin_amdgcn_readfirstlane(tid_ >> 6);
    LAS float* scr = (LAS float*)(F.lds + RING_OFF + wave_ * 16384);
    const int gw = F.vcu * NWAVES + wave_, NGW = F.G * NWAVES;
    bf16* WIN0 = (bf16*)(ws + WS_WIN0); bf16* WO = (bf16*)(ws + WS_WO); bf16* WGU = (bf16*)(ws + WS_WGU); bf16* WD = (bf16*)(ws + WS_WD); bf16* WIN1 = (bf16*)(ws + WS_WIN1); bf16* WQ2 = (bf16*)(ws + WS_WQ2);
    constexpr int I_A = 16 * 56, I_G = 16 * 8, I_B = 2 * 16 * 32, I_C = 2 * 16 * 176, I_D = 2 * 44 * 32, I_E = 16 * 24, I_F = 4 * 16, NITEMS = I_A + I_B + I_C + I_D + I_E + I_F + I_G;
    for (int it = gw; it < NITEMS; it += NGW) {
        int r = it;
        if (r < I_A) { const int kb = r / 56, nb = r % 56, r0 = 32 * nb; int c0, nv;
            if (r0 < 1152) { c0 = r0; nv = 32; } else if (r0 < 1280) { c0 = r0 + 128; nv = 32; } else if (r0 < 1536) { c0 = r0 + 292; nv = 32; } else if (r0 == 1536) { c0 = 1536; nv = 32; } else if (r0 == 1568) { c0 = 1568; nv = 4; } else { c0 = 0; nv = 0; }
            xpose_item(Ip->nsa_w_in, NSA_IN, c0, nv, 64 * kb, WIN0, D, r0, scr, lane_); continue; } r -= I_A;
        if (r < I_B) { const int l = r / 512, q = r % 512, kb = q / 32, nb = q % 32;
            xpose_item(Ip->w_out + (size_t)l * D * D, D, 32 * nb, 32, 64 * kb, WO + (size_t)l * D * D, D, 32 * nb, scr, lane_); continue; } r -= I_B;
        if (r < I_C) { const int l = r / (16 * 176), q = r % (16 * 176), kb = q / 176, nb = q % 176, r0 = 32 * nb, pn = r0 >> 8, w0 = r0 & 255;
            const float* src = ((w0 < 128) ? Ip->ffn_gate : Ip->ffn_up) + (size_t)l * D * DFF;
            xpose_item(src, DFF, 128 * pn + (w0 & 127), 32, 64 * kb, WGU + (size_t)l * 2 * DFF * D, D, r0, scr, lane_, Ip->norm_ffn + l * D); continue; } r -= I_C;
        if (r < I_D) { const int l = r / (44 * 32), q = r % (44 * 32), kb = q / 32, nb = q % 32;
            xpose_item(Ip->ffn_down + (size_t)l * DFF * D, D, 32 * nb, 32, 64 * kb, WD + (size_t)l * D * DFF, DFF, 32 * nb, scr, lane_); continue; } r -= I_D;
        if (r < I_E) { const int kb = r / 24, nb = r % 24, r0 = 32 * nb; int nv = DSA_IN - r0; nv = nv > 32 ? 32 : (nv < 0 ? 0 : nv);
            xpose_item(Ip->dsa_w_in, DSA_IN, r0, nv, 64 * kb, WIN1, D, r0, scr, lane_, Ip->norm_mix + D); continue; } r -= I_E;
        if (r < I_F) { const int kb = r / 16, nb = r % 16; xpose_item(Ip->w_q_idx, 512, 32 * nb, 32, 64 * kb, WQ2, 256, 1536 + 32 * nb, scr, lane_); continue; } r -= I_F;
        { const int kb = r / 8, nb = r % 8, r0 = 32 * nb;
            xpose_item(Ip->nsa_w_in, NSA_IN, (r0 < 128) ? 1152 + r0 : 1408 + (r0 - 128), 32, 64 * kb, (bf16*)(ws + WS_WVT), D, r0, scr, lane_); }
    }
    for (int idx = (F.vcu * NWAVES * 64) + tid_; idx < 384 * 256; idx += F.G * NWAVES * 64) {
        const int c = idx & 255, r4 = (idx >> 8) & 31, h = idx >> 13; const float4* a4 = (const float4*)(Ip->w_q_up + (size_t)c * 768 + h * 64); const float4* b4 = (const float4*)(Ip->w_uk + (size_t)(4 * r4) * 768 + h * 64);
        float s0 = 0.f, s1 = 0.f, s2 = 0.f, s3 = 0.f;
#pragma unroll 4
        for (int d = 0; d < 16; ++d) { const float4 av = a4[d], b0 = b4[d], b1 = b4[192 + d], b2 = b4[384 + d], b3 = b4[576 + d];
            s0 += (av.x * b0.x + av.y * b0.y) + (av.z * b0.z + av.w * b0.w); s1 += (av.x * b1.x + av.y * b1.y) + (av.z * b1.z + av.w * b1.w);
            s2 += (av.x * b2.x + av.y * b2.y) + (av.z * b2.z + av.w * b2.w); s3 += (av.x * b3.x + av.y * b3.y) + (av.z * b3.z + av.w * b3.w); }
        const float sc_ = 0.125f * 1.4426950408889634f;
        bf16* o_ = WQ2 + (size_t)(h * 128 + 4 * r4) * 256 + c;
        o_[0] = (bf16)f2bf(s0 * sc_); o_[256] = (bf16)f2bf(s1 * sc_); o_[512] = (bf16)f2bf(s2 * sc_); o_[768] = (bf16)f2bf(s3 * sc_);
    }
    { bf16* WO1F = (bf16*)(ws + WS_WO1F); const float* wo1 = Ip->w_out + (size_t)D * D;
      for (int idx = (F.vcu * NWAVES * 64) + tid_; idx < 12 * 32 * 256; idx += F.G * NWAVES * 64) {
          const int n4 = idx & 255, r4 = (idx >> 8) & 31, h = idx >> 13; const float* a = Ip->w_uv + (size_t)(4 * r4) * 768 + h * 64; const float* bcol = wo1 + (size_t)(h * 64) * D + 4 * n4;
          float acc_[4][4];
#pragma unroll
          for (int i = 0; i < 4; ++i)
#pragma unroll
              for (int j = 0; j < 4; ++j) acc_[i][j] = 0.f;
#pragma unroll 4
          for (int d = 0; d < 64; ++d) { const float4 bv = *(const float4*)(bcol + (size_t)d * D); const float a0 = a[d], a1 = a[768 + d], a2 = a[1536 + d], a3 = a[2304 + d];
              acc_[0][0] += a0 * bv.x; acc_[0][1] += a0 * bv.y; acc_[0][2] += a0 * bv.z; acc_[0][3] += a0 * bv.w; acc_[1][0] += a1 * bv.x; acc_[1][1] += a1 * bv.y; acc_[1][2] += a1 * bv.z; acc_[1][3] += a1 * bv.w;
              acc_[2][0] += a2 * bv.x; acc_[2][1] += a2 * bv.y; acc_[2][2] += a2 * bv.z; acc_[2][3] += a2 * bv.w; acc_[3][0] += a3 * bv.x; acc_[3][1] += a3 * bv.y; acc_[3][2] += a3 * bv.z; acc_[3][3] += a3 * bv.w; }
#pragma unroll
          for (int j = 0; j < 4; ++j) *(uint2*)(WO1F + (size_t)(4 * n4 + j) * 1792 + h * 128 + 4 * r4) = make_uint2(pk2(acc_[0][j], acc_[1][j]), pk2(acc_[2][j], acc_[3][j])); }
      for (int it = gw; it < 4 * 32; it += NGW) { const int kb = it / 32, nb = it % 32;
          xpose_item(wo1 + (size_t)768 * D, D, 32 * nb, 32, 64 * kb, WO1F + 1536, 1792, 32 * nb, scr, lane_); } }
    { bf16* W1T = (bf16*)(ws + WS_W1T); bf16* W2T = (bf16*)(ws + WS_W2T); bf16* WMKT = (bf16*)(ws + WS_WMKT); float* B1F = (float*)(ws + WS_B1F); bf16* MEMN = (bf16*)(ws + WS_MEMN);
      constexpr int J_1 = 2 * 32 * 8, J_2 = 2 * 4 * 2, J_M = 2 * 16 * 16;
      for (int it = gw; it < J_1 + J_2 + J_M; it += NGW) { int r2 = it;
          if (r2 < J_1) { const int kv = r2 / 256, q = r2 % 256, kb = q / 8, nb = q % 8; xpose_item(kv ? Ip->v_w1 : Ip->k_w1, 256, 32 * nb, 32, 64 * kb, W1T + (size_t)kv * 256 * 2048, 2048, 32 * nb, scr, lane_); continue; } r2 -= J_1;
          if (r2 < J_2) { const int kv = r2 / 8, q = r2 % 8, kb = q / 2, nb = q % 2; xpose_item(kv ? Ip->v_w2 : Ip->k_w2, 64, 32 * nb, 32, 64 * kb, W2T + (size_t)kv * 64 * 256, 256, 32 * nb, scr, lane_); continue; } r2 -= J_2;
          { const int l = r2 / 256, q = r2 % 256, kb = q / 16, nb = q % 16; xpose_item(Ip->w_mem_kv + (size_t)l * D * 512, 512, 32 * nb, 32, 64 * kb, WMKT + (size_t)l * 512 * D, D, 32 * nb, scr, lane_); } }
      if ((int)blockIdx.x < 32) { const int u_ = (int)blockIdx.x, kv = u_ >> 4, cr = (u_ >> 2) & 3, kq4 = u_ & 3, c = 64 * cr + lane_; const float* w1 = kv ? Ip->v_w1 : Ip->k_w1; const float* pos = kv ? Ip->pos_v : Ip->pos_k;
          const int kb0 = 512 * kq4 + 64 * wave_; float sacc = 0.f;
#pragma unroll 8
          for (int k = 0; k < 64; ++k) sacc += pos[kb0 + k] * w1[(size_t)(kb0 + k) * 256 + c];
          LAS float* red = (LAS float*)(F.lds + RING_OFF + 8 * 16384);
          red[wave_ * 64 + lane_] = sacc;
          __syncthreads();
          if (wave_ == 0) { float t_ = 0.f;
#pragma unroll
              for (int w = 0; w < 8; ++w) t_ += red[w * 64 + lane_];
              B1F[(kv * 4 + kq4) * 256 + c] = t_; } }
      for (int m = gw; m < 1024; m += NGW) rms_row_to_bf16(Ip->mem + (size_t)(m & 511) * D, Ip->norm_mem + (m >> 9) * D, MEMN + (size_t)m * D, lane_); }
    norm_phase(F, Ip->x, Ip->norm_mix, (bf16*)(ws + WS_XN));
}

#define MFMA16(A, B, C) __builtin_amdgcn_mfma_f32_16x16x32_bf16((A), (B), (C), 0, 0, 0)
constexpr float LOG2E = 1.4426950408889634f;
constexpr int NSA_OUT = 0, NSA_PSQ = 49152, NSA_ST = 147456, NSA_TB = NSA_ST + 3072;
constexpr int TAB_B12 = NSA_ST + 1024;
constexpr int P13_JUNK = NSA_ST + 3072 + 1536;
constexpr int P13_B12 = NSA_ST;
constexpr int TAB_BKT = NSA_ST + 3072;
static_assert(NSA_TB + 12288 <= LDSCTL_OFF && TAB_B12 + 2048 <= NSA_TB, "LDS tables");
enum { MD_CMP = 0, MD_WIN = 1, MD_BLK = 2, MD_MEM = 3 };
struct KF { bf16x8 a0, a1, b0, b1; };
struct VF { bf16x8 v[4]; };
__device__ __forceinline__ bf16x8 ldg16(const bf16* p) { return *(const bf16x8*)p; }
typedef float f32x2_t __attribute__((ext_vector_type(2))); typedef __bf16 bf16x2_t __attribute__((ext_vector_type(2)));
__device__ __forceinline__ unsigned cvtpk_s(float lo, float hi) { f32x2_t v = {lo, hi}; bf16x2_t b = __builtin_convertvector(v, bf16x2_t); return __builtin_bit_cast(unsigned, b); }
__device__ __forceinline__ bf16x8 pack8(const f32x4& a, const f32x4& b) { v4u w; w.x = cvtpk_s(a[0], a[1]); w.y = cvtpk_s(a[2], a[3]); w.z = cvtpk_s(b[0], b[1]); w.w = cvtpk_s(b[2], b[3]); return __builtin_bit_cast(bf16x8, w); }
__device__ __forceinline__ void load_k(KF& k, const bf16* kb, int kstride, int key0, int r, int kq) {
    const bf16* pa = kb + (size_t)(key0 + 8 * (r >> 2) + (r & 3)) * kstride + 8 * kq; const bf16* pb = pa + 4 * (size_t)kstride;
    k.a0 = ldg16(pa); k.a1 = ldg16(pa + 32); k.b0 = ldg16(pb); k.b1 = ldg16(pb + 32);
}
__device__ __forceinline__ void load_vt(VF& v, const bf16* vt, int vstride, int key0, int r, int kq) {
#pragma unroll
    for (int dt = 0; dt < 4; ++dt) v.v[dt] = ldg16(vt + (size_t)(16 * dt + r) * vstride + key0 + 8 * kq);
}
__device__ __forceinline__ void qk(f32x4& sa, f32x4& sb, const KF& k, const bf16x8 (&q)[2]) {
    const f32x4 z = {0.f, 0.f, 0.f, 0.f};
    sa = MFMA16(k.a0, q[0], z); sa = MFMA16(k.a1, q[1], sa); sb = MFMA16(k.b0, q[0], z); sb = MFMA16(k.b1, q[1], sb);
}
struct BiasCtx { const LAS unsigned short* tb; float d29, d30, c31; };
template <int MODE>
__device__ __forceinline__ void maskbias(f32x4& s, int kpos, int tcol, bool colok, const BiasCtx& B) {
    if (MODE == MD_MEM) return;
#pragma unroll
    for (int i = 0; i < 4; ++i) {
        int dist; bool ok;
        if (MODE == MD_CMP) { dist = tcol - 31 - 16 * (kpos + i); ok = dist >= 0; }
        else if (MODE == MD_WIN) { dist = tcol - (kpos + i); ok = (unsigned)dist <= 511u; }
        else { dist = tcol - (kpos + i); ok = dist >= 0; }
        int dc = dist < 0 ? 0 : dist; dc = dc > 1023 ? 1023 : dc;
        const float tb = __uint_as_float((unsigned)B.tb[dc * 6] << 16);
        float bias = tb;
        if (MODE != MD_WIN) { const float far = B.c31 + (dist < 1513 ? B.d30 : 0.f) + (dist < 1117 ? B.d29 : 0.f); bias = dist < 1024 ? tb : far; }
        s[i] = (ok && colok) ? s[i] + bias : -INFINITY;
    }
}
__device__ __forceinline__ float colmax(const f32x4& sa, const f32x4& sb) {
    float mx = fmaxf(fmaxf(fmaxf(sa[0], sa[1]), fmaxf(sa[2], sa[3])), fmaxf(fmaxf(sb[0], sb[1]), fmaxf(sb[2], sb[3])));
    mx = fmaxf(mx, __shfl_xor(mx, 16)); mx = fmaxf(mx, __shfl_xor(mx, 32)); return mx;
}
constexpr float SM_THR = 8.f;
__device__ __forceinline__ float lmax8(const f32x4& sa, const f32x4& sb) { return fmaxf(fmaxf(fmaxf(sa[0], sa[1]), fmaxf(sa[2], sa[3])), fmaxf(fmaxf(sb[0], sb[1]), fmaxf(sb[2], sb[3]))); }
__device__ __forceinline__ int imax3(int a, int b, int c) { return max(max(a, b), c); }
__device__ __forceinline__ int imax16(const f32x4& a, const f32x4& b, const f32x4& c, const f32x4& d) {
#define FI_(x) __float_as_int(x)
    const int t0 = imax3(FI_(a[0]), FI_(a[1]), FI_(a[2])), t1 = imax3(FI_(a[3]), FI_(b[0]), FI_(b[1])), t2 = imax3(FI_(b[2]), FI_(b[3]), FI_(c[0])), t3 = imax3(FI_(c[1]), FI_(c[2]), FI_(c[3])), t4 = imax3(FI_(d[0]), FI_(d[1]), FI_(d[2]));
    return max(imax3(t0, t1, FI_(d[3])), imax3(t2, t3, t4));
#undef FI_
}
template <int NO>
__device__ __forceinline__ void sm_rescale(float lm, float& m, float& l, f32x4 (&O)[NO]) {
    if (__any(lm > m + SM_THR)) {
        lm = fmaxf(lm, __shfl_xor(lm, 16)); lm = fmaxf(lm, __shfl_xor(lm, 32));
        const float mn = fmaxf(m, lm); const float al = __builtin_amdgcn_exp2f(m - mn); m = mn; l *= al;
#pragma unroll
        for (int dt = 0; dt < NO; ++dt) O[dt] = O[dt] * al;
    }
}
__device__ __forceinline__ bf16x8 sm_update(const f32x4& sa, const f32x4& sb, float& m, float& l, f32x4 (&O)[4]) {
    sm_rescale<4>(lmax8(sa, sb), m, l, O);
    f32x4 pa, pb; float sum = 0.f;
#pragma unroll
    for (int i = 0; i < 4; ++i) { pa[i] = __builtin_amdgcn_exp2f(sa[i] - m); pb[i] = __builtin_amdgcn_exp2f(sb[i] - m); sum += pa[i] + pb[i]; }
    l += sum;
    return pack8(pa, pb);
}
__device__ __forceinline__ void sm_update64(const f32x4& sa0, const f32x4& sb0, const f32x4& sa1, const f32x4& sb1, float& m, float& l, f32x4 (&O)[4], bf16x8& pf0, bf16x8& pf1) {
    sm_rescale<4>(fmaxf(lmax8(sa0, sb0), lmax8(sa1, sb1)), m, l, O);
    f32x4 pa0, pb0, pa1, pb1; float sum = 0.f;
#pragma unroll
    for (int i = 0; i < 4; ++i) { pa0[i] = __builtin_amdgcn_exp2f(sa0[i] - m); pb0[i] = __builtin_amdgcn_exp2f(sb0[i] - m); pa1[i] = __builtin_amdgcn_exp2f(sa1[i] - m); pb1[i] = __builtin_amdgcn_exp2f(sb1[i] - m);
        sum += (pa0[i] + pb0[i]) + (pa1[i] + pb1[i]); }
    l += sum;
    pf0 = pack8(pa0, pb0); pf1 = pack8(pa1, pb1);
}
enum { BK_FAR = 0, BK_MID = 1, BK_GEN = 2, BK_FARF = 3 };
template <int MD, int CLS>
__device__ __forceinline__ void step64(const KF& k0, const KF& k1, const bf16x8 (&q)[2], int cls, int kpos, int tcol, bool colok, const BiasCtx& B,
                                       float& m, float& l, f32x4 (&O)[4], bf16x8& pf0, bf16x8& pf1) {
    const bool has = m > -1e29f; const float mref = has ? m : 0.f;
    if (CLS >= 0) cls = CLS;
    float cin = ((cls == BK_FAR) ? B.c31 : 0.f) - mref; if (!colok) cin = -INFINITY;
    const f32x4 c4 = {cin, cin, cin, cin};
    f32x4 sa0 = MFMA16(k0.a0, q[0], c4), sb0 = MFMA16(k0.b0, q[0], c4), sa1 = MFMA16(k1.a0, q[0], c4), sb1 = MFMA16(k1.b0, q[0], c4);
    sa0 = MFMA16(k0.a1, q[1], sa0); sb0 = MFMA16(k0.b1, q[1], sb0); sa1 = MFMA16(k1.a1, q[1], sa1); sb1 = MFMA16(k1.b1, q[1], sb1);
    if (cls == BK_MID) {
        const LAS unsigned short* tl = B.tb + (tcol - kpos - 39) * 6; asm("" : "+v"(tl));
#pragma unroll
        for (int i = 0; i < 4; ++i) { sa0[i] += __uint_as_float((unsigned)tl[6 * (39 - i)] << 16); sb0[i] += __uint_as_float((unsigned)tl[6 * (35 - i)] << 16);
            sa1[i] += __uint_as_float((unsigned)tl[6 * (7 - i)] << 16); sb1[i] += __uint_as_float((unsigned)tl[6 * (3 - i)] << 16); }
    } else if (CLS == BK_FARF) {
        const int d0 = tcol - kpos;
#pragma unroll
        for (int i = 0; i < 4; ++i) {
            { const int d = d0 - i;      sa0[i] += B.c31 + (d < 1513 ? B.d30 : 0.f) + (d < 1117 ? B.d29 : 0.f); }
            { const int d = d0 - 4 - i;  sb0[i] += B.c31 + (d < 1513 ? B.d30 : 0.f) + (d < 1117 ? B.d29 : 0.f); }
            { const int d = d0 - 32 - i; sa1[i] += B.c31 + (d < 1513 ? B.d30 : 0.f) + (d < 1117 ? B.d29 : 0.f); }
            { const int d = d0 - 36 - i; sb1[i] += B.c31 + (d < 1513 ? B.d30 : 0.f) + (d < 1117 ? B.d29 : 0.f); } }
    } else if (cls == BK_GEN) {
        maskbias<MD>(sa0, kpos, tcol, true, B); maskbias<MD>(sb0, kpos + 4, tcol, true, B); maskbias<MD>(sa1, kpos + 32, tcol, true, B); maskbias<MD>(sb1, kpos + 36, tcol, true, B);
    }
    if (__any((imax16(sa0, sb0, sa1, sb1) > __float_as_int(SM_THR)) || !has)) {
        float lm = fmaxf(lmax8(sa0, sb0), lmax8(sa1, sb1));
        lm = fmaxf(lm, __shfl_xor(lm, 16)); lm = fmaxf(lm, __shfl_xor(lm, 32));
        const bool upd = (lm > -INFINITY) && (!has || lm > 0.f); const float dl = upd ? lm : 0.f;
        if (upd) m = mref + dl;
        const float f = has ? __builtin_amdgcn_exp2f(-dl) : 1.f; l *= f;
#pragma unroll
        for (int dt = 0; dt < 4; ++dt) O[dt] = O[dt] * f;
#pragma unroll
        for (int i = 0; i < 4; ++i) { sa0[i] -= dl; sb0[i] -= dl; sa1[i] -= dl; sb1[i] -= dl; }
    }
    f32x4 pa0, pb0, pa1, pb1; float sum = 0.f;
#pragma unroll
    for (int i = 0; i < 4; ++i) { pa0[i] = __builtin_amdgcn_exp2f(sa0[i]); pb0[i] = __builtin_amdgcn_exp2f(sb0[i]); pa1[i] = __builtin_amdgcn_exp2f(sa1[i]); pb1[i] = __builtin_amdgcn_exp2f(sb1[i]);
        sum += (pa0[i] + pb0[i]) + (pa1[i] + pb1[i]); }
    l += sum;
    pf0 = pack8(pa0, pb0); pf1 = pack8(pa1, pb1);
}
__device__ __forceinline__ void pv(f32x4 (&O)[4], const VF& v, const bf16x8& pf) {
#pragma unroll
    for (int dt = 0; dt < 4; ++dt) O[dt] = MFMA16(v.v[dt], pf, O[dt]);
}
__device__ __forceinline__ void lds_fadd(LAS float* p, float v) { (void)__hip_atomic_fetch_add((float*)p, v, __ATOMIC_RELAXED, __HIP_MEMORY_SCOPE_WORKGROUP); }
#define DPP_I(x, ctrl) __builtin_amdgcn_update_dpp((x), (x), (ctrl), 0xf, 0xf, false)
#define DPP_F(x, ctrl) __int_as_float(__builtin_amdgcn_update_dpp(__float_as_int(x), __float_as_int(x), (ctrl), 0xf, 0xf, false))
__device__ __forceinline__ float sum8_dpp(float v) { v += DPP_F(v, 0xB1); v += DPP_F(v, 0x4E); v += DPP_F(v, 0x141); return v; }
__device__ __forceinline__ unsigned wave_iscan_u32(unsigned x) {
#define DPP_Z(v, ctrl, rmask) (unsigned)__builtin_amdgcn_update_dpp(0, (int)(v), (ctrl), (rmask), 0xf, false)
    x += DPP_Z(x, 0x111, 0xf); x += DPP_Z(x, 0x112, 0xf); x += DPP_Z(x, 0x114, 0xf); x += DPP_Z(x, 0x118, 0xf); x += DPP_Z(x, 0x142, 0xa); x += DPP_Z(x, 0x143, 0xc);
#undef DPP_Z
    return x; }
__device__ __forceinline__ int wmax64_i(int x) {
    x = max(x, DPP_I(x, 0xB1)); x = max(x, DPP_I(x, 0x4E)); x = max(x, DPP_I(x, 0x141)); x = max(x, DPP_I(x, 0x140));
    return max(max(__builtin_amdgcn_readlane(x, 0), __builtin_amdgcn_readlane(x, 16)), max(__builtin_amdgcn_readlane(x, 32), __builtin_amdgcn_readlane(x, 48))); }
__device__ __forceinline__ float kqsum(float v) { v += __shfl_xor(v, 16); v += __shfl_xor(v, 32); return v; }
__device__ __forceinline__ float wmax64(float v) {
#pragma unroll
    for (int o = 1; o < 64; o <<= 1) v = fmaxf(v, __shfl_xor(v, o));
    return v;
}
__device__ __forceinline__ void out_add(LAS unsigned short* OUTw, int p, int n, int kq, const f32x4 (&O)[4], float scale, bool first) {
    const int q = 2 * p + (n >> 3), hd = n & 7;
    if (hd < 6) { LAS v2u* dst = (LAS v2u*)(OUTw + (q * 6 + hd) * 64) + kq;
#pragma unroll
        for (int dt = 0; dt < 4; ++dt) { f32x4 v = O[dt] * scale; if (!first) { const v2u o = dst[4 * dt]; v[0] += __uint_as_float(o.x << 16); v[1] += __uint_as_float(o.x & 0xffff0000u); v[2] += __uint_as_float(o.y << 16); v[3] += __uint_as_float(o.y & 0xffff0000u); }
            dst[4 * dt] = (v2u){pk2(v[0], v[1]), pk2(v[2], v[3])}; } }
}

__device__ __forceinline__ void p2_mfma(Frame& F, const In& I, unsigned char* ws) {
    OPAQUE_TID(); KARGS(); const int lane = tid_ & 63, wave = __builtin_amdgcn_readfirstlane(tid_ >> 6), r = lane & 15, kq = lane >> 4;
    const bf16* KV0 = (const bf16*)(ws + WS_KV0); const bf16* W1T = (const bf16*)(ws + WS_W1T); const bf16* W2T = (const bf16*)(ws + WS_W2T); const float* B1F = (const float*)(ws + WS_B1F);
    const bf16* MEMN = (const bf16*)(ws + WS_MEMN); const bf16* WMKT = (const bf16*)(ws + WS_WMKT);
    bf16* KCB = (bf16*)(ws + WS_KCB); bf16* VCT = (bf16*)(ws + WS_VCT); bf16* MKB = (bf16*)(ws + WS_MKB); bf16* MVT = (bf16*)(ws + WS_MVT);
    LAS unsigned char* hid = F.lds + RING_OFF;
    for (int u = blockIdx.x; u < 192; u += F.G) {
        const bool cmp = u < 128;
        const bf16* ap[2]; const bf16* bp[2]; int K, kjump;
        int kv = 0, bg = 0, n0 = 0, lay = 0, m0 = 0, ch = 0;
        if (cmp) { kv = u >> 6; bg = (u >> 4) & 3; n0 = (u & 15) * 32; const int b = bg >> 1, g = bg & 1; K = 2048; kjump = 512 - 64;
#pragma unroll
            for (int rt = 0; rt < 2; ++rt) { int nn = n0 + 16 * rt + r; nn = nn > 510 ? 510 : nn; ap[rt] = KV0 + (size_t)(b * T + 16 * nn) * 512 + kv * 128 + g * 64 + 8 * kq; }
#pragma unroll
            for (int ct = 0; ct < 2; ++ct) bp[ct] = W1T + (size_t)(kv * 256 + 32 * wave + 16 * ct + r) * 2048 + 8 * kq;
        } else { const int v = u - 128; lay = v >> 5; m0 = ((v >> 1) & 15) * 32; ch = v & 1; K = 1024; kjump = 0;
#pragma unroll
            for (int rt = 0; rt < 2; ++rt) ap[rt] = MEMN + (size_t)(lay * 512 + m0 + 16 * rt + r) * 1024 + 8 * kq;
#pragma unroll
            for (int ct = 0; ct < 2; ++ct) bp[ct] = WMKT + (size_t)(lay * 512 + ch * 256 + 32 * wave + 16 * ct + r) * 1024 + 8 * kq;
        }
        f32x4 acc[2][2];
#pragma unroll
        for (int rt = 0; rt < 2; ++rt)
#pragma unroll
            for (int ct = 0; ct < 2; ++ct) acc[rt][ct] = (f32x4){0.f, 0.f, 0.f, 0.f};
        bf16x8 a[2][2], bb[2][2];
#define P2_LOAD(A_, B_, kb_) do { const int kbl_ = (kb_) < K ? (kb_) : K - 64; const int ao_ = kbl_ + (kbl_ >> 6) * kjump; \
            _Pragma("unroll") for (int h2 = 0; h2 < 2; ++h2) { \
                _Pragma("unroll") for (int rt = 0; rt < 2; ++rt) A_[rt][h2] = ldg16(ap[rt] + ao_ + 32 * h2); \
                _Pragma("unroll") for (int ct = 0; ct < 2; ++ct) B_[ct][h2] = ldg16(bp[ct] + kbl_ + 32 * h2); } } while (0)
        P2_LOAD(a, bb, 0);
        for (int kb = 0; kb < K; kb += 64) {
            bf16x8 an[2][2], bn[2][2]; P2_LOAD(an, bn, kb + 64);
#pragma unroll
            for (int h2 = 0; h2 < 2; ++h2)
#pragma unroll
                for (int rt = 0; rt < 2; ++rt)
#pragma unroll
                    for (int ct = 0; ct < 2; ++ct) acc[rt][ct] = MFMA16(a[rt][h2], bb[ct][h2], acc[rt][ct]);
#pragma unroll
            for (int h2 = 0; h2 < 2; ++h2)
#pragma unroll
                for (int x = 0; x < 2; ++x) { a[x][h2] = an[x][h2]; bb[x][h2] = bn[x][h2]; }
        }
#undef P2_LOAD
        if (cmp) {
#pragma unroll
            for (int ct = 0; ct < 2; ++ct) { const int col = 32 * wave + 16 * ct + r; const float bias = (kv ? Ip->v_b1 : Ip->k_b1)[col] + ((B1F[(kv * 4 + 0) * 256 + col] + B1F[(kv * 4 + 1) * 256 + col]) + (B1F[(kv * 4 + 2) * 256 + col] + B1F[(kv * 4 + 3) * 256 + col]));
#pragma unroll
                for (int rt = 0; rt < 2; ++rt)
#pragma unroll
                    for (int i = 0; i < 4; ++i) { const float xg = acc[rt][ct][i] + bias; const float hv = 0.5f * xg * (1.f + tanhf(0.7978845608028654f * (xg + 0.044715f * xg * xg * xg)));
                        *(LAS unsigned short*)(hid + (16 * rt + 4 * kq + i) * 528 + 2 * col) = (unsigned short)f2bf(hv); } }
            __syncthreads();
            { const int rt2 = wave >> 2, ct2 = wave & 3; f32x4 o = {0.f, 0.f, 0.f, 0.f};
              const bf16* w2p = W2T + (size_t)(kv * 64 + 16 * ct2 + r) * 256 + 8 * kq;
#pragma unroll
              for (int ks = 0; ks < 8; ++ks) { const bf16x8 av = *(const LAS bf16x8*)(hid + (16 * rt2 + r) * 528 + 64 * ks + 16 * kq); o = MFMA16(av, ldg16(w2p + 32 * ks), o); }
              const int d = 16 * ct2 + r; const float b2v = (kv ? Ip->v_b2 : Ip->k_b2)[d];
#pragma unroll
              for (int i = 0; i < 4; ++i) { const int nn = n0 + 16 * rt2 + 4 * kq + i; const unsigned short ov = (nn < NCMP) ? (unsigned short)f2bf(o[i] + b2v) : (unsigned short)0;
                  if (kv) VCT[(size_t)(bg * 64 + d) * 512 + nn] = ov; else KCB[(size_t)(bg * 512 + nn) * 64 + d] = ov; } }
            __syncthreads();
        } else {
#pragma unroll
            for (int ct = 0; ct < 2; ++ct) { const int col = 32 * wave + 16 * ct + r;
#pragma unroll
                for (int rt = 0; rt < 2; ++rt)
#pragma unroll
                    for (int i = 0; i < 4; ++i) { const int mrow = m0 + 16 * rt + 4 * kq + i; const unsigned short ov = (unsigned short)f2bf(acc[rt][ct][i]);
                        if (ch == 0) MKB[(size_t)(lay * 512 + mrow) * 256 + col] = ov; else MVT[(size_t)(lay * 256 + col) * 512 + mrow] = ov; } }
        }
    }
}

template <int MODE>
__device__ __forceinline__ void mb2(f32x4& sa, f32x4& sb, int kpos, int tcol, bool colok, bool fast, const BiasCtx& B) {
    if (fast) { if (colok) { sa = sa + B.c31; sb = sb + B.c31; } else { sa = (f32x4){-INFINITY, -INFINITY, -INFINITY, -INFINITY}; sb = sa; } }
    else { maskbias<MODE>(sa, kpos, tcol, colok, B); maskbias<MODE>(sb, kpos + 4, tcol, colok, B); }
}
#define SWZ(row) (((((row) >> 3) & 3) << 1) | (((row) >> 1) & 1))
struct KV1 { KF k; VF v; };
__device__ __forceinline__ void load_kv(KV1& d, const bf16* kb, int kstride, const bf16* vt, int vstride, int key0, int r, int kq) { load_k(d.k, kb, kstride, key0, r, kq); load_vt(d.v, vt, vstride, key0, r, kq); }

template <int MD, int FORCE = 0>
__device__ __forceinline__ void nsa_sweep(LAS unsigned char* STG, const bf16* ksb, const bf16* vst, int jlo, int jhi, int qt, const LAS unsigned* WMw, int wave, int lane, int r, int kq, int qsel, int t0w,
                                          const bf16x8 (&qf)[4][2], const BiasCtx& BC, float (&m)[4], float (&l)[4], f32x4 (&O)[4][4],
                                          int kstr = 512, int kblk = 64 * 512, int vstr = 64, int vblk = 16384) {
            const int srow = 8 * wave + (lane >> 3), sch = (lane & 7) ^ SWZ(srow);
            const bf16* ksrc = ksb + (size_t)srow * kstr + 8 * sch; const bf16* vsrc = vst + (size_t)srow * vstr + 8 * sch;
#define NSA_DMA(jb) do { LAS unsigned char* d_ = STG + ((jb) % 6) * 16384 + wave * 1024; \
                __builtin_amdgcn_global_load_lds((const unsigned*)(ksrc + (size_t)(jb) * kblk), (LAS unsigned*)d_, 16, 0, 0); \
                __builtin_amdgcn_global_load_lds((const unsigned*)(vsrc + (size_t)(jb) * vblk), (LAS unsigned*)(d_ + 8192), 16, 0, 0); } while (0)
#define NSA_WAITV(n_) do { if ((n_) >= 4) asm volatile("s_waitcnt vmcnt(4) lgkmcnt(0)" ::: "memory"); else if ((n_) == 2) asm volatile("s_waitcnt vmcnt(2) lgkmcnt(0)" ::: "memory"); else asm volatile("s_waitcnt vmcnt(0) lgkmcnt(0)" ::: "memory"); } while (0)
            { const int nb = jhi - jlo + 1;
#pragma unroll
              for (int i = 0; i < 4; ++i) if (i < nb) NSA_DMA(jlo + i);
              const int issued = nb < 4 ? nb : 4, need = nb < 2 ? nb : 2; NSA_WAITV(2 * (issued - need)); }
            __builtin_amdgcn_s_barrier();
#define NSA_TILES(CLS_) _Pragma("unroll") for (int p = 0; p < 4; ++p) if (m8 & (3u << (2 * p))) { \
                        bf16x8 pf0, pf1; \
                        step64<MD, CLS_>(k0, k1, qf[p], cls, 64 * j + 8 * kq_, t0w + 2 * p + qs_, ((m8 >> (2 * p + qs_)) & 1u) != 0u, BC, m[p], l[p], O[p], pf0, pf1); \
                        pv(O[p], v0, pf0); pv(O[p], v1, pf1); \
                        __builtin_amdgcn_sched_barrier(0); }
            auto tiles = [&](auto clsx, int j) __attribute__((always_inline)) { constexpr int CLSX = decltype(clsx)::value;
                const LAS unsigned char* sk = STG + (j % 6) * 16384; const LAS unsigned char* sv = sk + 8192;
                unsigned m8 = 0xffu; if (WMw) m8 = (unsigned)__builtin_amdgcn_readfirstlane((int)((WMw[j >> 2] >> (8 * (j & 3))) & 0xffu)); if (FORCE == 1) m8 = 0u; if (FORCE == 2) m8 = 0xffu; if (MD == MD_MEM) m8 = 3u; else asm volatile("" : "+s"(m8));
                if (m8) {
                    int r_ = r, kq_ = kq, qs_ = qsel; asm volatile("" : "+v"(r_), "+v"(kq_), "+v"(qs_));
                    const int dj = qt - j; const int cls = (MD == MD_MEM) ? BK_FAR : (MD == MD_WIN) ? ((dj >= 1 && dj <= 7) ? BK_MID : BK_GEN) : ((64 * dj - 63 >= 1513) ? BK_FAR : ((dj >= 1 && dj <= 15) ? BK_MID : BK_GEN));
                    KF k0, k1;
                    { const int ka = 8 * (r_ >> 2) + (r_ & 3), kb2 = ka + 4, kc = ka + 32, kd = ka + 36;
                      k0.a0 = *(const LAS bf16x8*)(sk + ka * 128 + ((kq_ ^ SWZ(ka)) << 4)); k0.a1 = *(const LAS bf16x8*)(sk + ka * 128 + (((4 + kq_) ^ SWZ(ka)) << 4));
                      k0.b0 = *(const LAS bf16x8*)(sk + kb2 * 128 + ((kq_ ^ SWZ(kb2)) << 4)); k0.b1 = *(const LAS bf16x8*)(sk + kb2 * 128 + (((4 + kq_) ^ SWZ(kb2)) << 4));
                      k1.a0 = *(const LAS bf16x8*)(sk + kc * 128 + ((kq_ ^ SWZ(kc)) << 4)); k1.a1 = *(const LAS bf16x8*)(sk + kc * 128 + (((4 + kq_) ^ SWZ(kc)) << 4));
                      k1.b0 = *(const LAS bf16x8*)(sk + kd * 128 + ((kq_ ^ SWZ(kd)) << 4)); k1.b1 = *(const LAS bf16x8*)(sk + kd * 128 + (((4 + kq_) ^ SWZ(kd)) << 4)); }
                    VF v0, v1;
#pragma unroll
                    for (int dt = 0; dt < 4; ++dt) { const int dd = 16 * dt + r_; v0.v[dt] = *(const LAS bf16x8*)(sv + dd * 128 + ((kq_ ^ SWZ(dd)) << 4)); v1.v[dt] = *(const LAS bf16x8*)(sv + dd * 128 + (((4 + kq_) ^ SWZ(dd)) << 4)); }
                    NSA_TILES(CLSX)
                }
            };
            int ni = 0;
            auto blk = [&](auto clsx, int j) __attribute__((always_inline)) {
                const bool head = ((j - jlo) & 1) == 0;
                if (head) { ni = 0; if (j + 4 <= jhi) { NSA_DMA(j + 4); ni += 2; } if (j + 5 <= jhi) { NSA_DMA(j + 5); ni += 2; } }
                tiles(clsx, j);
                if (!head || j == jhi) { NSA_WAITV(ni); __builtin_amdgcn_s_barrier(); }
            };
            int j = jlo;
            if (MD == MD_BLK || MD == MD_MEM) { const int jfar = (MD == MD_MEM) ? jhi : ((qt - 25 < jhi) ? qt - 25 : jhi); const int jfe = jlo + (((jfar - jlo + 1) >> 1) << 1) - 1;
                for (; j <= jfe; ++j) blk(std::integral_constant<int, BK_FAR>{}, j); }
            if (MD == MD_BLK) {
                const int jf2 = (qt - 17 < jhi) ? qt - 17 : jhi; const int jfe2 = jlo + (((jf2 - jlo + 1) >> 1) << 1) - 1;
                for (; j <= jfe2; ++j) blk(std::integral_constant<int, BK_FARF>{}, j); }
            for (; j <= jhi; ++j) blk(std::integral_constant<int, -1>{}, j);
#undef NSA_WAITV
#undef NSA_TILES
#undef NSA_DMA
}
__device__ __forceinline__ void p3_nsa_mfma(Frame& F, const In& I, unsigned char* ws) {
    OPAQUE_TID(); KARGS(); const int wave = __builtin_amdgcn_readfirstlane(tid_ >> 6);
    LAS float* b12 = (LAS float*)(F.lds + TAB_B12);
    LAS unsigned short* OUTw = (LAS unsigned short*)(F.lds + NSA_OUT) + wave * 3072;
    LAS float* PSw = (LAS float*)(F.lds + NSA_PSQ) + wave * 1024;
    LAS unsigned char* STG = F.lds + NSA_PSQ;
    LAS unsigned* WMw = (LAS unsigned*)(F.lds + NSA_ST) + wave * 32;
    for (int i = tid_; i < 512; i += NWAVES * 64) b12[i] = ((i & 15) < 12) ? Ip->rel_bias[(i >> 4) * 12 + (i & 15)] * LOG2E : 0.f;
    LAS unsigned short* TB = (LAS unsigned short*)(F.lds + NSA_TB);
    { const int gg = (int)blockIdx.x & 1;
      for (int i = tid_; i < 6144; i += NWAVES * 64) { const int dd = i / 6, hh = i % 6; TB[i] = (unsigned short)f2bf(Ip->rel_bias[rel_bucket(dd) * 12 + gg * 6 + hh] * LOG2E); } }
    __syncthreads();
    const bf16* Q0 = (const bf16*)(ws + WS_Q0); const bf16* KV0 = (const bf16*)(ws + WS_KV0); const bf16* QM = (const bf16*)(ws + WS_QM); const bf16* G0 = (const bf16*)(ws + WS_G0);
    const bf16* VT = (const bf16*)(ws + WS_VT); const bf16* KCB = (const bf16*)(ws + WS_KCB); const bf16* VCT = (const bf16*)(ws + WS_VCT);
    const bf16* MKB = (const bf16*)(ws + WS_MKB); const bf16* MVT = (const bf16*)(ws + WS_MVT);
    bf16* CAT = (bf16*)(ws + WS_CAT);
    const int nun = 4 * 128;
    for (int ui = blockIdx.x; ui < nun; ui += F.G) {
        int tl_ = tid_; asm volatile("" : "+v"(tl_));
        const int lane = tl_ & 63, n = lane & 15, kq = lane >> 4, r = n, hd = n & 7, qsel = n >> 3; const bool colv = hd < 6;
        int bg, qt;
        bg = blockIdx.x & 3;
        if (F.G == 256) { const int idx = blockIdx.x >> 2; qt = (ui < 256) ? idx : 127 - idx; }
        else { qt = ui >> 2; if ((ui & 3) != bg) continue; }
        const int b = bg >> 1, g = bg & 1, t0w = 64 * qt + 8 * wave, rowb = b * T;
        const int habs = g * 6 + (colv ? hd : 0);
        const LAS float* b12c = b12 + habs; const BiasCtx BC{TB + (colv ? hd : 0), b12c[29 * 16] - b12c[30 * 16], b12c[30 * 16] - b12c[31 * 16], b12c[31 * 16]};

        bf16x8 qf[4][2];
#pragma unroll
        for (int p = 0; p < 4; ++p) { const bf16* qp = Q0 + (size_t)(rowb + t0w + 2 * p + qsel) * 768 + habs * 64 + 8 * kq;
#pragma unroll
            for (int ks = 0; ks < 2; ++ks) { bf16x8 v = ldg16(qp + 32 * ks); if (!colv) v = (bf16x8){0, 0, 0, 0, 0, 0, 0, 0}; qf[p][ks] = v; } }
        float m[4], l[4]; f32x4 O[4][4];
        if (PROBE_REP == 6 || PROBE_REP == 7) {
            const bf16* ksb_ = KV0 + (size_t)rowb * 512 + 256 + g * 64; const bf16* vst_ = VT + ((size_t)(rowb >> 6) * 256 + g * 64) * 64;
#pragma unroll
            for (int p = 0; p < 4; ++p) { m[p] = -1e30f; l[p] = 0.f;
#pragma unroll
                for (int dt = 0; dt < 4; ++dt) O[p][dt] = (f32x4){0.f, 0.f, 0.f, 0.f}; }
            __syncthreads();
            nsa_sweep<MD_BLK, (PROBE_REP == 6 ? 2 : 1)>(STG, ksb_, vst_, 0, qt, qt, WMw, wave, lane, r, kq, qsel, t0w, qf, BC, m, l, O);
            float* dump = (float*)(ws + WS_OCS) + ((size_t)blockIdx.x * 512 + tid_) * 4;
#pragma unroll
            for (int p = 0; p < 4; ++p) dump[p] = l[p] + O[p][0][0] + O[p][1][1] + O[p][2][2] + O[p][3][3];
            __syncthreads(); }
        for (int i = lane; i < 1024; i += 64) PSw[i] = 0.f;
        const int ncmax = (t0w + 7 >= 31) ? ((t0w + 7 - 31) / 16 + 1) : 0;
        const bf16* kcb = KCB + (size_t)(bg * 512) * 64; const bf16* vct = VCT + (size_t)(bg * 64) * 512;
#pragma unroll
        for (int p = 0; p < 4; ++p) { m[p] = -1e30f; l[p] = 0.f; }
        if (ncmax > 0) {
            int r_ = r, kq_ = kq; asm volatile("" : "+v"(r_), "+v"(kq_));
            for (int key0 = 0; key0 < ncmax; key0 += 32) {
                asm volatile("" : "+v"(r_), "+v"(kq_));
                KF kA; load_k(kA, kcb, 64, key0, r_, kq_);
                const bool fast = (t0w - 31 - 16 * (key0 + 31)) >= 1513;
#pragma unroll
                for (int p = 0; p < 4; ++p) { f32x4 sa, sb; qk(sa, sb, kA, qf[p]); const int tcol = t0w + 2 * p + qsel;
                    mb2<MD_CMP>(sa, sb, key0 + 8 * kq_, tcol, true, fast, BC);
                    const float mn = fmaxf(m[p], lmax8(sa, sb)); float sum = 0.f;
#pragma unroll
                    for (int i = 0; i < 4; ++i) sum += __builtin_amdgcn_exp2f(sa[i] - mn) + __builtin_amdgcn_exp2f(sb[i] - mn);
                    l[p] = l[p] * __builtin_amdgcn_exp2f(m[p] - mn) + sum; m[p] = mn; __builtin_amdgcn_sched_barrier(0); }
            }
        }
        float invl[4];
#pragma unroll
        for (int p = 0; p < 4; ++p) { float mc = m[p]; mc = fmaxf(mc, __shfl_xor(mc, 16)); mc = fmaxf(mc, __shfl_xor(mc, 32));
            const float lt = kqsum(l[p] * __builtin_amdgcn_exp2f(m[p] - mc)); m[p] = mc; invl[p] = lt > 0.f ? 1.f / lt : 0.f; }
#pragma unroll
        for (int p = 0; p < 4; ++p)
#pragma unroll
            for (int dt = 0; dt < 4; ++dt) O[p][dt] = (f32x4){0.f, 0.f, 0.f, 0.f};
        float carry[4] = {0.f, 0.f, 0.f, 0.f};
        if (ncmax > 0) {
            int r_ = r, kq_ = kq; asm volatile("" : "+v"(r_), "+v"(kq_));
            for (int key0 = 0; key0 < ncmax; key0 += 32) {
                asm volatile("" : "+v"(r_), "+v"(kq_));
                KV1 A; load_kv(A, kcb, 64, vct, 512, key0, r_, kq_);
                const bool fast = (t0w - 31 - 16 * (key0 + 31)) >= 1513;
#pragma unroll
                for (int p = 0; p < 4; ++p) { f32x4 sa, sb; qk(sa, sb, A.k, qf[p]); const int tcol = t0w + 2 * p + qsel;
                    mb2<MD_CMP>(sa, sb, key0 + 8 * kq_, tcol, true, fast, BC);
                    f32x4 pa, pb;
#pragma unroll
                    for (int i = 0; i < 4; ++i) { pa[i] = __builtin_amdgcn_exp2f(sa[i] - m[p]) * invl[p]; pb[i] = __builtin_amdgcn_exp2f(sb[i] - m[p]) * invl[p]; }
                    pv(O[p], A.v, pack8(pa, pb));
                    float wA = (pa[0] + pa[1]) + (pa[2] + pa[3]), wB = pa[3] + ((pb[0] + pb[1]) + (pb[2] + pb[3])), wC = pb[3];
                    if (!colv) { wA = 0.f; wB = 0.f; wC = 0.f; }
                    const float up = __shfl(wC, (lane + 48) & 63);
                    const float prevC = (kq == 0) ? carry[p] : up; carry[p] = up;
                    float a0 = wA + prevC, a1 = wB;
                    a0 = sum8_dpp(a0); a1 = sum8_dpp(a1);
                    if (hd == 0) { LAS float* ps = PSw + (2 * p + qsel) * 128 + (key0 >> 2) + 2 * kq; ps[0] = a0; ps[1] = a1; } __builtin_amdgcn_sched_barrier(0); }
            }
        }
        if (ncmax > 0 && ncmax <= 480) {
            const int jn = ((ncmax + 31) >> 5) * 8;
#pragma unroll
            for (int p = 0; p < 4; ++p) { float a0 = sum8_dpp(carry[p]); if (hd == 0 && kq == 0) PSw[(2 * p + qsel) * 128 + jn] = a0; }
        }
        {
#pragma unroll
            for (int p = 0; p < 4; ++p) { const size_t row = (size_t)(rowb + t0w + 2 * p + qsel);
                const float gz = bf2f(G0[row * 256 + habs * 3 + 0]) + Ip->nsa_gate_b[habs * 3 + 0]; out_add(OUTw, p, n, kq, O[p], 1.f / (1.f + __expf(-gz)), true); }
        }
        for (int i = lane; i < 32; i += 64) WMw[i] = (qt < 16) ? 0xffffffffu : 0u;
        if (qt >= 16) {
            if (lane < 3) { const int j = lane == 0 ? 0 : qt - 2 + lane; atomicOr((unsigned*)&WMw[j >> 2], 0xffu << (8 * (j & 3))); }
            for (int q = 0; q < 8; ++q) {
                int v0 = __float_as_int(PSw[q * 128 + lane] + 0.f), v1 = __float_as_int(PSw[q * 128 + 64 + lane] + 0.f);
                if (lane < 1 || lane > qt - 2) v0 = __float_as_int(-1.f); if (lane + 64 > qt - 2) v1 = __float_as_int(-1.f);
                for (int s = 0; s < 13; ++s) { const int mx = wmax64_i(max(v0, v1));
                    const unsigned long long b0 = __ballot(v0 == mx); int j;
                    if (b0) { j = __builtin_ctzll(b0); if (lane == j) v0 = __float_as_int(-1.f); } else { const unsigned long long b1 = __ballot(v1 == mx); j = __builtin_ctzll(b1); if (lane == j) v1 = __float_as_int(-1.f); j += 64; }
                    if (lane == 0) atomicOr((unsigned*)&WMw[j >> 2], 1u << (8 * (j & 3) + q)); }
            }
        }
        const bf16* ksb = KV0 + (size_t)rowb * 512 + 256 + g * 64; const bf16* vst = VT + ((size_t)(rowb >> 6) * 256 + g * 64) * 64;
        __syncthreads();
#pragma unroll 1
        for (int rep_ = 0; rep_ < (PROBE_REP == 1 ? 2 : 1); ++rep_) {
#pragma unroll
            for (int p = 0; p < 4; ++p) { m[p] = -1e30f; l[p] = 0.f;
#pragma unroll
                for (int dt = 0; dt < 4; ++dt) O[p][dt] = (f32x4){0.f, 0.f, 0.f, 0.f}; }
            nsa_sweep<MD_BLK>(STG, ksb, vst, 0, qt, qt, WMw, wave, lane, r, kq, qsel, t0w, qf, BC, m, l, O);
        }
        { int qs2_ = qsel; asm volatile("" : "+v"(qs2_));
#pragma unroll
        for (int p = 0; p < 4; ++p) { const size_t row = (size_t)(rowb + t0w + 2 * p + qs2_);
            const float gz = bf2f(G0[row * 256 + habs * 3 + 1]) + Ip->nsa_gate_b[habs * 3 + 1]; out_add(OUTw, p, n, kq, O[p], (1.f / (1.f + __expf(-gz))) / kqsum(l[p]), false); } }
        const bf16* kwb = KV0 + (size_t)rowb * 512 + 384 + g * 64; const bf16* vwt = VT + ((size_t)(rowb >> 6) * 256 + 128 + g * 64) * 64;
#pragma unroll
        for (int p = 0; p < 4; ++p) { m[p] = -1e30f; l[p] = 0.f;
#pragma unroll
            for (int dt = 0; dt < 4; ++dt) O[p][dt] = (f32x4){0.f, 0.f, 0.f, 0.f}; }
        __syncthreads();
        nsa_sweep<MD_WIN>(STG, kwb, vwt, (qt >= 8) ? qt - 8 : 0, qt, qt, nullptr, wave, lane, r, kq, qsel, t0w, qf, BC, m, l, O);
        if (PROBE_REP == 4) {
#pragma unroll
            for (int p = 0; p < 4; ++p) { m[p] = -1e30f; l[p] = 0.f;
#pragma unroll
                for (int dt = 0; dt < 4; ++dt) O[p][dt] = (f32x4){0.f, 0.f, 0.f, 0.f}; }
            nsa_sweep<MD_WIN>(STG, kwb, vwt, (qt >= 8) ? qt - 8 : 0, qt, qt, nullptr, wave, lane, r, kq, qsel, t0w, qf, BC, m, l, O); }
        { int qs3_ = qsel; asm volatile("" : "+v"(qs3_));
#pragma unroll
        for (int p = 0; p < 4; ++p) { const size_t row = (size_t)(rowb + t0w + 2 * p + qs3_);
            const float gz = bf2f(G0[row * 256 + habs * 3 + 2]) + Ip->nsa_gate_b[habs * 3 + 2]; out_add(OUTw, p, n, kq, O[p], (1.f / (1.f + __expf(-gz))) / kqsum(l[p]), false); } }
        int ln_ = lane; asm volatile("" : "+v"(ln_));
#pragma unroll 1
        for (int i = 0; i < 6; ++i) { const int e = i * 64 + ln_, q = e / 48, c8 = e % 48;
            *(v4u*)(CAT + (size_t)(rowb + t0w + q) * 1024 + g * 384 + 8 * c8) = ((const LAS v4u*)OUTw)[e]; }
#pragma unroll 1
        for (int h2 = 0; h2 < 2; ++h2) { const int hm = 2 * g + h2;
            int ln2_ = lane; asm volatile("" : "+v"(ln2_)); const int nn = ln2_ & 15, kqq = ln2_ >> 4;
#pragma unroll
            for (int p = 0; p < 4; ++p) { qf[p][0] = (bf16x8){0, 0, 0, 0, 0, 0, 0, 0}; qf[p][1] = qf[p][0]; m[p] = -1e30f; l[p] = 0.f;
#pragma unroll
                for (int dt = 0; dt < 4; ++dt) O[p][dt] = (f32x4){0.f, 0.f, 0.f, 0.f}; }
            { const bf16* qp = QM + (size_t)(rowb + t0w + (nn & 7)) * 256 + hm * 64 + 8 * kqq; if (nn < 8) { qf[0][0] = ldg16(qp); qf[0][1] = ldg16(qp + 32); } }
            const BiasCtx BCm{BC.tb, 0.f, 0.f, 0.f};
            nsa_sweep<MD_MEM>(STG, MKB + (size_t)(b * 256) * 256 + hm * 64, MVT + (size_t)(hm * 64) * 512 + b * 256, 0, 3, 0, nullptr, wave, ln2_, nn, kqq, nn >> 3, 0, qf, BCm, m, l, O, 256, 64 * 256, 512, 64);
            const float il = 1.f / kqsum(l[0]);
            if (nn < 8) { bf16* op = CAT + (size_t)(rowb + t0w + nn) * 1024 + 768 + hm * 64 + 4 * kqq;
#pragma unroll
                for (int dt = 0; dt < 4; ++dt) *(uint2*)(op + 16 * dt) = make_uint2(pk2(O[0][dt][0] * il, O[0][dt][1] * il), pk2(O[0][dt][2] * il, O[0][dt][3] * il)); }
        }
    }
}

__device__ __forceinline__ void p10_dsa_norm(Frame& F, const In& I, unsigned char* ws) {
    OPAQUE_TID(); KARGS(); const int gw = F.vcu * NWAVES + (tid_ >> 6), NGW = F.G * NWAVES, lane = tid_ & 63;
    const bf16* PR = (const bf16*)(ws + WS_PROJ1); bf16* CQ = (bf16*)(ws + WS_CQ); bf16* CKV = (bf16*)(ws + WS_CKV); bf16* KIDX = (bf16*)(ws + WS_KIDX); float* WIDX = (float*)(ws + WS_WIDX);
    for (int m = gw; m < M; m += NGW) {
        const bf16* pr = PR + (size_t)m * 768;
        float a[4]; ld4bf(pr + 4 * lane, a);
        float s = wave_sum(a[0] * a[0] + a[1] * a[1] + a[2] * a[2] + a[3] * a[3]); float r = rsqrtf(s * (1.f / 256.f) + EPSF);
        const float4 gq = *(const float4*)(Ip->q_norm + 4 * lane);
        *(uint2*)(CQ + (size_t)m * 256 + 4 * lane) = make_uint2(pk2((a[0] * r) * gq.x, (a[1] * r) * gq.y), pk2((a[2] * r) * gq.z, (a[3] * r) * gq.w));
        const unsigned u = *(const unsigned*)(pr + 256 + 2 * lane); const float c0 = bflo(u), c1 = bfhi(u);
        s = wave_sum(c0 * c0 + c1 * c1); r = rsqrtf(s * (1.f / 128.f) + EPSF);
        *(unsigned*)(CKV + (size_t)m * 128 + 2 * lane) = pk2((c0 * r) * Ip->kv_norm[2 * lane], (c1 * r) * Ip->kv_norm[2 * lane + 1]);
        const float k0 = bf2f(pr[384 + lane]);
        s = wave_sum(k0 * k0); r = rsqrtf(s * (1.f / 64.f) + EPSF);
        { const int tk = m >> 5, key = m & 31, ks = lane >> 4, hf = (lane >> 3) & 1, jj = lane & 7;
          KIDX[((size_t)(tk * 4 + ks) * 64 + hf * 32 + key) * 8 + jj] = (bf16)f2bf((k0 * r) * Ip->kidx_norm[lane]); }
        if (lane < 8) WIDX[(size_t)m * 8 + lane] = bf2f(pr[448 + lane]) * (0.35355339059327373f * 0.125f);
    }
}

#define MFMA32(A, B, C) __builtin_amdgcn_mfma_f32_32x32x16_bf16((A), (B), (C), 0, 0, 0)
typedef float f32x16 __attribute__((ext_vector_type(16)));
constexpr int XL_OFF = RING_BYTES;
constexpr int IDX_HIST = XL_OFF, IDX_SELL = XL_OFF + 16384;
static_assert(IDX_SELL + 4096 <= LDSCTL_OFF, "LDS map (indexer)");
__device__ __forceinline__ float wmin64(float v) {
#pragma unroll
    for (int o = 1; o < 64; o <<= 1) v = fminf(v, __shfl_xor(v, o));
    return v;
}
__device__ __forceinline__ unsigned f16_order_key(float x) {
    const unsigned hb = (unsigned)__builtin_bit_cast(unsigned short, (_Float16)x);
    const unsigned mk = (unsigned)((int)(hb << 16) >> 31) | 0x8000u;
    return (hb ^ mk) & 0xffffu; }
__device__ __forceinline__ void p12_index_mfma(Frame& F, const In& I, unsigned char* ws) {
    OPAQUE_TID(); KARGS(); const int lane = tid_ & 63, wave = __builtin_amdgcn_readfirstlane(tid_ >> 6), key = lane & 31, half = lane >> 5;
    LAS unsigned short* SC = (LAS unsigned short*)(F.lds + RING_OFF);
    const bf16* QI = (const bf16*)(ws + WS_QI); const bf16* KIDX = (const bf16*)(ws + WS_KIDX); const float* WIDX = (const float*)(ws + WS_WIDX);
    unsigned short* SEL = (unsigned short*)(ws + WS_SEL); int* CNT = (int*)(ws + WS_CNT);
    const int NG = M / 8, per = (NG + F.G - 1) / F.G;
    for (int j = 0; j < per; ++j) {
        const int u = j * F.G + ((j & 1) ? (F.G - 1 - (int)blockIdx.x) : (int)blockIdx.x);
        if (u >= NG) break;
        const int gi = (u & 1) * (NG / 2) + (u >> 1);
        const int row0 = 8 * gi, b = row0 / T, t0 = row0 % T, rowb = b * T;
        if (t0 < 256) {
            const int t = t0 + wave; unsigned short* so = SEL + (size_t)(row0 + wave) * 256;
#pragma unroll
            for (int i = 0; i < 4; ++i) { const int s = lane + 64 * i; so[s] = (unsigned short)(s <= t ? s : 0); }
            if (lane == 0) CNT[row0 + wave] = t + 1;
            continue;
        }
        const int nt = (t0 + 7) / 32 + 1;
        {
            const int rho = lane & 31, a = rho >> 2, qA = ((a >> 2) & 1) + 2 * (a & 1), hdA = 4 * ((a >> 1) & 1) + (rho & 3);
            bf16x8 qa[2][4];
#pragma unroll
            for (int t2 = 0; t2 < 2; ++t2)
#pragma unroll
                for (int ks = 0; ks < 4; ++ks) qa[t2][ks] = ldg16(QI + (size_t)(row0 + 4 * t2 + qA) * 512 + hdA * 64 + 16 * ks + 8 * half);
            f32x2_t wp[2][2][4];
#pragma unroll
            for (int t2 = 0; t2 < 2; ++t2)
#pragma unroll
                for (int jq = 0; jq < 2; ++jq) { const float* wq = WIDX + (size_t)(row0 + 4 * t2 + 2 * half + jq) * 8; const float4 x0 = *(const float4*)wq, x1 = *(const float4*)(wq + 4);
                    wp[t2][jq][0] = (f32x2_t){x0.x, x0.y}; wp[t2][jq][1] = (f32x2_t){x0.z, x0.w}; wp[t2][jq][2] = (f32x2_t){x1.x, x1.y}; wp[t2][jq][3] = (f32x2_t){x1.z, x1.w}; }
            const int tqb = t0 + 2 * half;
            const bf16* kpb = KIDX + (size_t)(rowb >> 5) * 2048 + (size_t)lane * 8;
            const int ntw = (nt - wave + NWAVES - 1) / NWAVES;
#define IDX_LOAD(dst, i) do { const int tl2_ = wave + NWAVES * ((i) < ntw ? (i) : (ntw > 0 ? ntw - 1 : 0)); const bf16* kp_ = kpb + (size_t)tl2_ * 2048; \
                _Pragma("unroll") for (int ks = 0; ks < 4; ++ks) dst[ks] = ldg16(kp_ + 512 * ks); } while (0)
#define IDX_EPI(c, t2) do { f32x2_t a0 = {0.f, 0.f}, a1 = {0.f, 0.f};     \
                _Pragma("unroll") for (int h = 0; h < 4; ++h) { \
                    const f32x2_t r0 = {__int_as_float(max(__float_as_int(c[2 * h]), 0)), __int_as_float(max(__float_as_int(c[2 * h + 1]), 0))}; \
                    const f32x2_t r1 = {__int_as_float(max(__float_as_int(c[8 + 2 * h]), 0)), __int_as_float(max(__float_as_int(c[9 + 2 * h]), 0))}; \
                    a0 = __builtin_elementwise_fma(r0, wp[t2][0][h], a0); a1 = __builtin_elementwise_fma(r1, wp[t2][1][h], a1); } \
                const float s0 = (a0[0] + a0[1]) + 0.f, s1 = (a1[0] + a1[1]) + 0.f; \
                const bool ok0 = kpos <= tqb + 4 * (t2), ok1 = kpos <= tqb + 4 * (t2) + 1; \
                SC[(4 * (t2) + 2 * half) * 8192 + kpos] = (unsigned short)f16_order_key(ok0 ? s0 : -INFINITY); SC[(4 * (t2) + 2 * half + 1) * 8192 + kpos] = (unsigned short)f16_order_key(ok1 ? s1 : -INFINITY); } while (0)
#define IDX_COMP(src, i) do { if ((i) < ntw) { const int kpos = 32 * (wave + NWAVES * (i)) + key; \
                f32x16 cA = {0.f, 0.f, 0.f, 0.f, 0.f, 0.f, 0.f, 0.f, 0.f, 0.f, 0.f, 0.f, 0.f, 0.f, 0.f, 0.f}, cB = cA; \
                _Pragma("unroll") for (int ks = 0; ks < 4; ++ks) { cA = MFMA32(qa[0][ks], src[ks], cA); cB = MFMA32(qa[1][ks], src[ks], cB); } \
                IDX_EPI(cA, 0); IDX_EPI(cB, 1); } } while (0)
            if (ntw > 0) {
                bf16x8 kb0[4], kb1[4], kb2[4], kb3[4];
                IDX_LOAD(kb0, 0); IDX_LOAD(kb1, 1); IDX_LOAD(kb2, 2);
                for (int i = 0; i < ntw; i += 4) {
                    IDX_LOAD(kb3, i + 3); IDX_COMP(kb0, i);
                    IDX_LOAD(kb0, i + 4); IDX_COMP(kb1, i + 1);
                    IDX_LOAD(kb1, i + 5); IDX_COMP(kb2, i + 2);
                    IDX_LOAD(kb2, i + 6); IDX_COMP(kb3, i + 3);
                }
            }
#undef IDX_LOAD
#undef IDX_EPI
#undef IDX_COMP
        }
        __syncthreads();
        {
            const int q = wave, t = t0 + q, nch = (t + 512) >> 9; LAS unsigned short* sc = SC + q * 8192;
            LAS unsigned* hist = (LAS unsigned*)(F.lds + IDX_HIST) + wave * 512;
            LAS unsigned short* sl = (LAS unsigned short*)(F.lds + IDX_SELL) + q * 256;
            for (int i = 32 * nt + lane; i < 512 * nch; i += 64) sc[i] = (unsigned short)0;
#pragma unroll
            for (int i = 0; i < 8; ++i) hist[lane + 64 * i] = 0u;
            for (int c = 0; c < nch; ++c) { const v4u k4 = *(const LAS v4u*)(sc + 512 * c + 8 * lane);
#pragma unroll
                for (int e = 0; e < 8; ++e) { const unsigned kk = (e & 1) ? (k4[e >> 1] >> 16) : (k4[e >> 1] & 0xffffu); const unsigned bb = kk >> 6;
                    atomicAdd((unsigned*)&hist[bb >> 1], 1u << (16 * (bb & 1))); } }
            int b1, r1;
            { unsigned cw[8]; unsigned S = 0u;
#pragma unroll
              for (int i = 0; i < 8; ++i) { cw[i] = hist[8 * lane + i]; S += (cw[i] & 0xffffu) + (cw[i] >> 16); }
              const unsigned px = wave_iscan_u32(S);
              const unsigned above = (unsigned)__builtin_amdgcn_readlane((int)px, 63) - px;
              const bool found = (above < 256u) && (256u <= above + S);
              const int fl = __builtin_ctzll(__ballot(found));
              int bs = 0; unsigned acc = above;
              { bool done = false;
#pragma unroll
                for (int i = 15; i >= 0; --i) { const unsigned cnt_ = (i & 1) ? (cw[i >> 1] >> 16) : (cw[i >> 1] & 0xffffu);
                    if (!done) { if (acc + cnt_ >= 256u) { bs = 16 * lane + i; done = true; } else acc += cnt_; } } }
              b1 = __builtin_amdgcn_readlane(bs, fl); r1 = 256 - __builtin_amdgcn_readlane((int)acc, fl); }
            hist[lane] = 0u;
            for (int c = 0; c < nch; ++c) { const v4u k4 = *(const LAS v4u*)(sc + 512 * c + 8 * lane);
#pragma unroll
                for (int e = 0; e < 8; ++e) { const unsigned kk = (e & 1) ? (k4[e >> 1] >> 16) : (k4[e >> 1] & 0xffffu);
                    if ((int)(kk >> 6) == b1) atomicAdd((unsigned*)&hist[kk & 63u], 1u); } }
            unsigned tkey; int r2;
            { const unsigned S = hist[lane]; const unsigned px = wave_iscan_u32(S); const unsigned above = (unsigned)__builtin_amdgcn_readlane((int)px, 63) - px;
              const bool found = (above < (unsigned)r1) && ((unsigned)r1 <= above + S);
              const int fl = __builtin_ctzll(__ballot(found));
              tkey = ((unsigned)b1 << 6) | (unsigned)fl; r2 = r1 - __builtin_amdgcn_readlane((int)above, fl); }
            const int nabove = 256 - r2; int bsel = 0, beq = 0;
            for (int c = 0; c < nch; ++c) { const int i8 = 512 * c + 8 * lane; const v4u k4 = *(const LAS v4u*)(sc + i8);
                unsigned em = 0u;
#pragma unroll
                for (int e = 0; e < 8; ++e) { const unsigned kk = (e & 1) ? (k4[e >> 1] >> 16) : (k4[e >> 1] & 0xffffu);
                    const bool sel = kk > tkey; em |= (kk == tkey) ? (1u << e) : 0u;
                    const unsigned long long ms = __ballot(sel);
                    if (ms) { if (sel) sl[bsel + (int)__builtin_amdgcn_mbcnt_hi((unsigned)(ms >> 32), __builtin_amdgcn_mbcnt_lo((unsigned)ms, 0u))] = (unsigned short)(i8 + e); bsel += __builtin_popcountll(ms); } }
                if (__any(em != 0u)) {
                    const unsigned ce = (unsigned)__builtin_popcount(em); const unsigned pe = wave_iscan_u32(ce);
                    int pos = beq + (int)(pe - ce);
#pragma unroll
                    for (int e = 0; e < 8; ++e) if (em & (1u << e)) { if (pos < r2) sl[nabove + pos] = (unsigned short)(i8 + e); ++pos; }
                    beq += __builtin_amdgcn_readlane((int)pe, 63); } }
            *(v2u*)(SEL + (size_t)(row0 + q) * 256 + 4 * lane) = *(const LAS v2u*)(sl + 4 * lane);
            if (lane == 0) CNT[row0 + q] = 256;
        }
        __syncthreads();
    }
}

__device__ __forceinline__ unsigned offb(unsigned row, unsigned ch) { return 256u * row + 16u * (ch ^ (((row & 3u) << 2) | ((row >> 2) & 3u))); }
typedef short v4i16_t __attribute__((ext_vector_type(4)));
__device__ __forceinline__ v4i16_t trrd(const LAS unsigned char* p) { return __builtin_amdgcn_ds_read_tr16_b64_v4i16((LAS v4i16_t*)p); }
__device__ __forceinline__ void p13_dsa_mfma(Frame& F, const In& I, unsigned char* ws) {
    OPAQUE_TID(); KARGS(); const int lane = tid_ & 63, wave = __builtin_amdgcn_readfirstlane(tid_ >> 6), n = lane & 15, kq = lane >> 4;
    LAS unsigned char* bkt = F.lds + TAB_BKT; LAS float* b12 = (LAS float*)(F.lds + P13_B12);
    for (int i = tid_; i < 1536; i += NWAVES * 64) bkt[i] = (unsigned char)rel_bucket(i);
    for (int i = tid_; i < 528; i += NWAVES * 64) b12[i] = (i >= 512) ? -INFINITY : (((i & 15) < 12) ? Ip->rel_bias[(i >> 4) * 12 + (i & 15)] * LOG2E : 0.f);
    __syncthreads();
    LAS unsigned char* imgb = F.lds + RING_OFF + wave * 18432; LAS int* sidx = (LAS int*)(imgb + 16384);
    const bf16* QA = (const bf16*)(ws + WS_QA); const bf16* CKV = (const bf16*)(ws + WS_CKV); const bf16* PR = (const bf16*)(ws + WS_PROJ1);
    const unsigned short* SEL = (const unsigned short*)(ws + WS_SEL); const int* CNT = (const int*)(ws + WS_CNT);
    const bf16* MKB = (const bf16*)(ws + WS_MKB) + (size_t)512 * 256; const bf16* MVT = (const bf16*)(ws + WS_MVT) + (size_t)256 * 512;
    bf16* CAT1 = (bf16*)(ws + WS_CAT1);
    const int gw = blockIdx.x * NWAVES + wave, NGW = F.G * NWAVES;
    const LAS float* b12c = b12 + (n < 12 ? n : 0);
#define DSA_GATHER(sl_, rowb_, c0_, buf_) do { const unsigned char* ckvb_ = (const unsigned char*)(CKV + (size_t)(rowb_) * 128); int kx_[8]; \
            _Pragma("unroll") for (int i = 0; i < 8; ++i) kx_[i] = (sl_)[(c0_) + 4 * i + g4_] & 0xffff; \
            _Pragma("unroll") for (int i = 0; i < 8; ++i) __builtin_amdgcn_global_load_lds((const unsigned*)(ckvb_ + ((unsigned)kx_[i] * 256u + goff_[i & 3])), (LAS unsigned*)(imgb + (buf_) * 8192 + i * 1024), 16, 0, 0); } while (0)
#define DSA_LIST(sl_, sel_, t_, cnt_) do { const int idx0_ = __builtin_amdgcn_readfirstlane((sel_)[0]); \
            _Pragma("unroll") for (int i = 0; i < 4; ++i) { const int e = lane + 64 * i, idx = (sel_)[i]; const int d = (t_) - idx, dc = d > 1535 ? 1535 : (d < 0 ? 0 : d); \
                (sl_)[e] = (e < (cnt_)) ? (idx | ((int)bkt[dc] << 22)) : (idx0_ | (2048 << 16)); } } while (0)
    int dreps_ = (PROBE_REP == 9) ? 2 : 1; asm volatile("" : "+s"(dreps_));
    for (int dr_ = 0; dr_ < dreps_; ++dr_) {
    asm volatile("s_waitcnt vmcnt(0) lgkmcnt(0)" ::: "memory");
    int row = gw;
    if (row < M) {
        int ln0_ = lane; asm volatile("" : "+v"(ln0_));
        const int g4_ = ln0_ >> 4; unsigned goff_[4];
#pragma unroll
        for (int k = 0; k < 4; ++k) goff_[k] = 16u * ((unsigned)(ln0_ & 15) ^ (((unsigned)g4_ << 2) | (unsigned)k));
        int cnt = __builtin_amdgcn_readfirstlane(CNT[row]); int sel0[4];
#pragma unroll
        for (int i = 0; i < 4; ++i) sel0[i] = (int)SEL[(size_t)row * 256 + lane + 64 * i];
        DSA_LIST(sidx, sel0, row % T, cnt);
        bf16x8 qf[4];
#pragma unroll
        for (int ks = 0; ks < 4; ++ks) { bf16x8 v = ldg16(QA + (size_t)row * 1536 + (n < 12 ? n : 0) * 128 + 32 * ks + 8 * kq); if (n >= 12) v = (bf16x8){0, 0, 0, 0, 0, 0, 0, 0}; qf[ks] = v; }
        asm volatile("s_waitcnt lgkmcnt(0)" ::: "memory");
        DSA_GATHER(sidx, (row / T) * T, 0, 0);
        int lb = 0, ib = 0;
        for (; row < M; row += NGW) {
            const int t = row % T, rown = (row + NGW < M) ? row + NGW : row; const bool hasn = row + NGW < M;
            int ln_ = lane; asm volatile("" : "+v"(ln_));
            int seln[4] = {0, 0, 0, 0}; int cntn_v = 0; bf16x8 qfn[4];
#pragma unroll
            for (int ks = 0; ks < 4; ++ks) qfn[ks] = (bf16x8){0, 0, 0, 0, 0, 0, 0, 0};
#define DSA_NEXT_LOADS() do { cntn_v = CNT[rown]; \
                _Pragma("unroll") for (int i = 0; i < 4; ++i) seln[i] = (int)SEL[(size_t)rown * 256 + lane + 64 * i]; \
                _Pragma("unroll") for (int ks = 0; ks < 4; ++ks) { bf16x8 v = ldg16(QA + (size_t)rown * 1536 + (n < 12 ? n : 0) * 128 + 32 * ks + 8 * kq); if (n >= 12) v = (bf16x8){0, 0, 0, 0, 0, 0, 0, 0}; qfn[ks] = v; } } while (0)
            const LAS int* sl = sidx + lb * 256; LAS int* sln = sidx + (lb ^ 1) * 256;
            float m = -1e30f, l = 0.f; f32x4 O[8];
#pragma unroll
            for (int rt = 0; rt < 8; ++rt) O[rt] = (f32x4){0.f, 0.f, 0.f, 0.f};
            for (int c0 = 0; c0 < cnt; c0 += 32) {
                LAS unsigned char* img = imgb + ib * 8192;
                if (c0 + 32 < cnt) { DSA_GATHER(sl, (row / T) * T, c0 + 32, ib ^ 1);
                    { const int e2 = (c0 + 64 < 256 ? c0 + 64 : 224) + (ln_ >> 1); const int k2 = sl[e2] & 0xffff;
                      __builtin_amdgcn_global_load_lds((const unsigned*)((const unsigned char*)(CKV + (size_t)((row / T) * T) * 128) + ((unsigned)k2 * 256u + 128u * (unsigned)(ln_ & 1))), (LAS unsigned*)(F.lds + P13_JUNK + wave * 256), 4, 0, 0); }
                    if (c0 == 0) { DSA_NEXT_LOADS(); }
                    if (c0 < 64) asm volatile("s_waitcnt vmcnt(18)" ::: "memory"); else asm volatile("s_waitcnt vmcnt(9)" ::: "memory"); }
                else if (hasn) {
                    if (c0 == 0) { DSA_NEXT_LOADS(); }
                    const int cntn = __builtin_amdgcn_readfirstlane(cntn_v);
                    DSA_LIST(sln, seln, rown % T, cntn);
                    asm volatile("s_waitcnt lgkmcnt(0)" ::: "memory");
                    DSA_GATHER(sln, (rown / T) * T, 0, ib ^ 1); asm volatile("s_waitcnt vmcnt(8)" ::: "memory"); }
                else asm volatile("s_waitcnt vmcnt(0)" ::: "memory");
                const bool has = m > -1e29f; const float mref = has ? m : 0.f; const float cinv = -mref;
                f32x4 sa = {cinv, cinv, cinv, cinv}, sb = sa;
                { const unsigned ra = 8u * ((unsigned)(ln_ & 15) >> 2) + ((unsigned)ln_ & 3u), kq_ = (unsigned)ln_ >> 4;
#pragma unroll
                  for (int s = 0; s < 4; ++s) { const bf16x8 ka = *(const LAS bf16x8*)(img + offb(ra, 4 * s + kq_)); const bf16x8 kb = *(const LAS bf16x8*)(img + offb(ra + 4, 4 * s + kq_));
                      sa = MFMA16(ka, qf[s], sa); sb = MFMA16(kb, qf[s], sb); } }
#pragma unroll
                for (int i = 0; i < 4; ++i) { const int ea = c0 + 8 * kq + i;
                    sa[i] += *(const LAS float*)((const LAS unsigned char*)b12c + ((unsigned)sl[ea] >> 16)); sb[i] += *(const LAS float*)((const LAS unsigned char*)b12c + ((unsigned)sl[ea + 4] >> 16)); }
                float fsc = 1.f;
                if (__any((imax3(imax3(__float_as_int(sa[0]), __float_as_int(sa[1]), __float_as_int(sa[2])), imax3(__float_as_int(sa[3]), __float_as_int(sb[0]), __float_as_int(sb[1])), max(__float_as_int(sb[2]), __float_as_int(sb[3]))) > __float_as_int(SM_THR)) || !has)) {
                    float lm = lmax8(sa, sb);
                    lm = fmaxf(lm, __shfl_xor(lm, 16)); lm = fmaxf(lm, __shfl_xor(lm, 32));
                    const bool upd = (lm > -INFINITY) && (!has || lm > 0.f); const float dl = upd ? lm : 0.f;
                    if (upd) m = mref + dl;
                    fsc = has ? __builtin_amdgcn_exp2f(-dl) : 1.f; l *= fsc;
#pragma unroll
                    for (int i = 0; i < 4; ++i) { sa[i] -= dl; sb[i] -= dl; }
#pragma unroll
                    for (int rt = 0; rt < 8; ++rt) O[rt] = O[rt] * fsc;
                }
                f32x4 pa, pb; float sum = 0.f;
#pragma unroll
                for (int i = 0; i < 4; ++i) { pa[i] = __builtin_amdgcn_exp2f(sa[i]); pb[i] = __builtin_amdgcn_exp2f(sb[i]); sum += pa[i] + pb[i]; }
                l += sum;
                const bf16x8 pf = pack8(pa, pb);
                { const unsigned g_ = (unsigned)ln_ >> 4, q_ = ((unsigned)ln_ & 15u) >> 2, p_ = (unsigned)ln_ & 3u;
#pragma unroll
                  for (int rt = 0; rt < 8; ++rt) { const v4i16_t x0 = trrd(img + offb(8 * g_ + q_, 2 * rt + (p_ >> 1)) + 8 * (p_ & 1)), x1 = trrd(img + offb(8 * g_ + 4 + q_, 2 * rt + (p_ >> 1)) + 8 * (p_ & 1));
                      const bf16x8 vf = {x0[0], x0[1], x0[2], x0[3], x1[0], x1[1], x1[2], x1[3]};
                      O[rt] = MFMA16(vf, pf, O[rt]); } }
                ib ^= 1;
            }
            const float il = 1.f / kqsum(l);
            if (n < 12) { bf16* op = CAT1 + (size_t)row * 1792 + n * 128 + 4 * kq;
#pragma unroll
                for (int rt = 0; rt < 8; ++rt) *(uint2*)(op + 16 * rt) = make_uint2(pk2(O[rt][0] * il, O[rt][1] * il), pk2(O[rt][2] * il, O[rt][3] * il)); }
            lb ^= 1; cnt = __builtin_amdgcn_readfirstlane(cntn_v);
#pragma unroll
            for (int ks = 0; ks < 4; ++ks) qf[ks] = qfn[ks];
        }
    }
    }
#undef DSA_GATHER
#undef DSA_LIST
#undef DSA_NEXT_LOADS
    int mreps_ = (PROBE_REP == 8) ? 2 : 1; asm volatile("" : "+s"(mreps_));
    __syncthreads();
    for (int mr_ = 0; mr_ < mreps_; ++mr_)
    for (int u64 = blockIdx.x; u64 < M / 64; u64 += F.G) {
        int tl_ = tid_; asm volatile("" : "+v"(tl_));
        const int ln = tl_ & 63, nn = ln & 15, kqq = ln >> 4, qsl = nn >> 3;
        const int row0 = 64 * u64 + 8 * wave, b = row0 / T;
        const BiasCtx BC0{(const LAS unsigned short*)(F.lds + NSA_TB), 0.f, 0.f, 0.f};
#pragma unroll 1
        for (int hm = 0; hm < 4; ++hm) {
            bf16x8 qf[4][2];
#pragma unroll
            for (int p = 0; p < 4; ++p) { qf[p][0] = (bf16x8){0, 0, 0, 0, 0, 0, 0, 0}; qf[p][1] = qf[p][0]; }
            { const bf16* qp = PR + (size_t)(row0 + (nn & 7)) * 768 + 456 + hm * 64 + 8 * kqq; if (nn < 8) { qf[0][0] = ldg16(qp); qf[0][1] = ldg16(qp + 32); } }
            float m[4], l[4]; f32x4 O[4][4];
#pragma unroll
            for (int p = 0; p < 4; ++p) { m[p] = -1e30f; l[p] = 0.f;
#pragma unroll
                for (int dt = 0; dt < 4; ++dt) O[p][dt] = (f32x4){0.f, 0.f, 0.f, 0.f}; }
            nsa_sweep<MD_MEM>(F.lds + RING_OFF, MKB + (size_t)(b * 256) * 256 + hm * 64, MVT + (size_t)(hm * 64) * 512 + b * 256, 0, 3, 0, nullptr, wave, ln, nn, kqq, qsl, 0, qf, BC0, m, l, O, 256, 64 * 256, 512, 64);
            const float il = 1.f / kqsum(l[0]);
            if (nn < 8) { bf16* op = CAT1 + (size_t)(row0 + nn) * 1792 + 1536 + hm * 64 + 4 * kqq;
#pragma unroll
                for (int dt = 0; dt < 4; ++dt) *(uint2*)(op + 16 * dt) = make_uint2(pk2(O[0][dt][0] * il, O[0][dt][1] * il), pk2(O[0][dt][2] * il, O[0][dt][3] * il)); }
            __syncthreads();
        }
    }
}

struct Args { In in; float* out; unsigned char* ws; int ph_lo, ph_hi; };
__global__ void __launch_bounds__(NWAVES * 64, 2) mk_fwd(Args args) {
    extern __shared__ __attribute__((aligned(16))) unsigned char lds[];
    Frame F;
    F.lds = (LAS unsigned char*)lds; F.MISC = (volatile LAS unsigned*)(F.lds + MISC_OFF);
    F.G = gridDim.x; { const int bx = blockIdx.x; F.vcu = (F.G % 8 == 0) ? (bx % 8) * (F.G / 8) + bx / 8 : bx; }
    unsigned char* ws = args.ws; const In& I = args.in; float* out = args.out; (void)I;
    F.ctl = (gu32*)(ws + WS_CTL);
    for (int u = threadIdx.x; u < (LDS_BYTES - LDSCTL_OFF) / 4; u += NWAVES * 64) ((LAS unsigned*)(F.lds + LDSCTL_OFF))[u] = 0u;
    __syncthreads();
    XcdBarrier bar; bar.bar = (unsigned*)(F.ctl + CW_BAR); bar.x = 0; bar.st = nullptr;
    if (!MK_SPLIT) bar = xcd_barrier_post((unsigned*)(F.ctl + CW_BAR), F.MISC + 8);
    const int lo = args.ph_lo, hi = args.ph_hi;
#ifndef PH_MASK
#define PH_MASK 0xFFFFFFFFu
#endif
#define IN(k) ((((PH_MASK) >> ((k) % 32)) & 1u) && lo <= (k) && (k) < hi)
#define SEAM(k) do { if (IN(k) && IN((k) + 1)) xcd_barrier(bar); } while (0)
#define SEAM2(k, kn) do { if (IN(k) && IN(kn)) xcd_barrier(bar); } while (0)
#ifndef REP_MASK
#define REP_MASK 0u
#endif
#define REPS(k) (1 + (int)(((REP_MASK) >> (k)) & 1u))
    bf16* XN = (bf16*)(ws + WS_XN); bf16* CAT = (bf16*)(ws + WS_CAT); bf16* ACT = (bf16*)(ws + WS_ACT);
    float* SSQ = (float*)(ws + WS_SSQ);

    if (IN(0)) { for (int r_ = 0; r_ < REPS(0); ++r_) { p0_prologue(F, I, ws); if (r_ + 1 < REPS(0)) xcd_barrier(bar); } SEAM(0); }
    {
            if (IN(1)) {
                pg8::Gemm g{XN, (const bf16*)(ws + WS_WIN0), M, 1792, D}; pg8::StaticOrder S; S.init(M, 1792, F.G, (int)blockIdx.x);
                pg8::EpiRoute<0> E{ws, nullptr};
                for (int r_ = 0; r_ < REPS(1); ++r_) { if (r_) xcd_barrier(bar);
                pg8::gemm_phase<pg8::EpiRoute<0>, pg8::StaticOrder, true, true>(F.lds + RING_OFF, g, S, E); }
                pg8::Gemm g2{(const bf16*)(ws + WS_WVT), XN, 256, M, D}; pg8::StaticOrder S2; S2.init(256, M, F.G, (int)((blockIdx.x + 64) % F.G));
                pg8::EpiRoute<3> E2{ws, nullptr};
                pg8::gemm_phase<pg8::EpiRoute<3>, pg8::StaticOrder, true, true>(F.lds + RING_OFF, g2, S2, E2);
                SEAM(1);
            }
            if (IN(2)) { for (int r_ = 0; r_ < REPS(2); ++r_) { p2_mfma(F, I, ws); if (r_ + 1 < REPS(2)) xcd_barrier(bar); } SEAM(2); }
            if (IN(3)) { for (int r_ = 0; r_ < REPS(3); ++r_) { p3_nsa_mfma(F, I, ws); if (r_ + 1 < REPS(3)) xcd_barrier(bar); } SEAM(3); }
    }
    {
        constexpr int L = 0, pb = L ? 14 : 4;
        if (IN(pb)) {
            pg8::Gemm g{L ? (const bf16*)(ws + WS_CAT1) : CAT, L ? (const bf16*)(ws + WS_WO1F) : (const bf16*)(ws + WS_WO), M, D, L ? 1792 : D}; pg8::StaticOrder S; S.init(M, D, F.G, (int)blockIdx.x);
            KARGS(); pg8::EpiResid<L == 0> E{L ? (const void*)XN : (const void*)Ip->x, XN, SSQ + (size_t)(L ? 2 : 0) * M * 16, D, 0};
            pg8::gemm_phase<pg8::EpiResid<L == 0>, pg8::StaticOrder, true, true>(F.lds + RING_OFF, g, S, E);
            SEAM2(pb, pb + 2);
        }
        if (IN(pb + 2)) {
            pg8::Gemm g{XN, (const bf16*)(ws + WS_WGU) + (size_t)L * 2 * DFF * D, M, 2 * DFF, D}; pg8::StaticOrder S; S.init(M, 2 * DFF, F.G, (int)blockIdx.x);
            pg8::EpiSwiglu E{ACT, SSQ + (size_t)(L ? 2 : 0) * M * 16, DFF, 0};
            for (int r_ = 0; r_ < REPS(pb + 2); ++r_) { if (r_) xcd_barrier(bar);
            pg8::gemm_phase<pg8::EpiSwiglu, pg8::StaticOrder, true, true>(F.lds + RING_OFF, g, S, E); }
            SEAM(pb + 2);
        }
        if (IN(pb + 3)) {
            pg8::Gemm g{ACT, (const bf16*)(ws + WS_WD) + (size_t)L * D * DFF, M, D, DFF}; pg8::StaticOrder S; S.init(M, D, F.G, (int)blockIdx.x);
            pg8::EpiResid<false> E{XN, XN, SSQ + (size_t)(L ? 3 : 1) * M * 16, D, 0};
            pg8::gemm_phase<pg8::EpiResid<false>, pg8::StaticOrder, true, true>(F.lds + RING_OFF, g, S, E);
            SEAM2(pb + 3, L ? 18 : 9);
        }
        }
    {
            if (IN(9)) {
                pg8::Gemm g{XN, (const bf16*)(ws + WS_WIN1), M, 768, D}; pg8::StaticOrder S; S.init(M, 768, F.G, (int)blockIdx.x);
                pg8::EpiRoute<1> E{ws, SSQ + (size_t)1 * M * 16};
                for (int r_ = 0; r_ < REPS(9); ++r_) { if (r_) xcd_barrier(bar);
                pg8::gemm_phase<pg8::EpiRoute<1>, pg8::StaticOrder, true, true>(F.lds + RING_OFF, g, S, E); }
                SEAM(9);
            }
            if (IN(10)) { p10_dsa_norm(F, I, ws); SEAM(10); }
            if (IN(11)) {
                pg8::Gemm g{(const bf16*)(ws + WS_CQ), (const bf16*)(ws + WS_WQ2), M, 2048, 256}; pg8::StaticOrder S; S.init(M, 2048, F.G, (int)blockIdx.x);
                pg8::EpiRoute<2> E{ws, nullptr};
                for (int r_ = 0; r_ < REPS(11); ++r_) { if (r_) xcd_barrier(bar);
                pg8::gemm_phase<pg8::EpiRoute<2>, pg8::StaticOrder, true, true>(F.lds + RING_OFF, g, S, E); }
                SEAM(11);
            }
            if (IN(12)) { for (int r_ = 0; r_ < REPS(12); ++r_) { p12_index_mfma(F, I, ws); if (r_ + 1 < REPS(12)) xcd_barrier(bar); } SEAM(12); }
            if (IN(13)) { for (int r_ = 0; r_ < REPS(13); ++r_) { p13_dsa_mfma(F, I, ws); if (r_ + 1 < REPS(13)) xcd_barrier(bar); } SEAM(13); }
            }
    {
        constexpr int L = 1, pb = L ? 14 : 4;
        if (IN(pb)) {
            pg8::Gemm g{L ? (const bf16*)(ws + WS_CAT1) : CAT, L ? (const bf16*)(ws + WS_WO1F) : (const bf16*)(ws + WS_WO), M, D, L ? 1792 : D}; pg8::StaticOrder S; S.init(M, D, F.G, (int)blockIdx.x);
            KARGS(); pg8::EpiResid<L == 0> E{L ? (const void*)XN : (const void*)Ip->x, XN, SSQ + (size_t)(L ? 2 : 0) * M * 16, D, 0};
            pg8::gemm_phase<pg8::EpiResid<L == 0>, pg8::StaticOrder, true, true>(F.lds + RING_OFF, g, S, E);
            SEAM2(pb, pb + 2);
        }
        if (IN(pb + 2)) {
            pg8::Gemm g{XN, (const bf16*)(ws + WS_WGU) + (size_t)L * 2 * DFF * D, M, 2 * DFF, D}; pg8::StaticOrder S; S.init(M, 2 * DFF, F.G, (int)blockIdx.x);
            pg8::EpiSwiglu E{ACT, SSQ + (size_t)(L ? 2 : 0) * M * 16, DFF, 0};
            for (int r_ = 0; r_ < REPS(pb + 2); ++r_) { if (r_) xcd_barrier(bar);
            pg8::gemm_phase<pg8::EpiSwiglu, pg8::StaticOrder, true, true>(F.lds + RING_OFF, g, S, E); }
            SEAM(pb + 2);
        }
        if (IN(pb + 3)) {
            pg8::Gemm g{ACT, (const bf16*)(ws + WS_WD) + (size_t)L * D * DFF, M, D, DFF}; pg8::StaticOrder S; S.init(M, D, F.G, (int)blockIdx.x);
            pg8::EpiResid<false> E{XN, XN, SSQ + (size_t)(L ? 3 : 1) * M * 16, D, 0};
            pg8::gemm_phase<pg8::EpiResid<false>, pg8::StaticOrder, true, true>(F.lds + RING_OFF, g, S, E);
            SEAM2(pb + 3, L ? 18 : 9);
        }
        }
    if (IN(18)) {
        OPAQUE_TID(); KARGS(); const int lane_ = tid_ & 63;
        const int gw = F.vcu * NWAVES + (tid_ >> 6), NGW = F.G * NWAVES;
        for (int m = gw; m < M; m += NGW) { const float r = rsqrtf(pg8::ssq_row(SSQ + ((size_t)3 * M + m) * 16) * (1.f / D) + EPSF);
#pragma unroll
            for (int j = 0; j < 2; ++j) { const int c = (j * 64 + lane_) * 8; const pg8::u32x4 rw = *(const GAS pg8::u32x4*)(XN + (size_t)m * D + c);
                const GAS f32x4* gr = (const GAS f32x4*)(Ip->norm_final + c); GAS f32x4* orow = (GAS f32x4*)(out + (size_t)m * D + c);
                f32x4 r0, r1; r0[0] = __uint_as_float(rw.x << 16); r0[1] = __uint_as_float(rw.x & 0xffff0000u); r0[2] = __uint_as_float(rw.y << 16); r0[3] = __uint_as_float(rw.y & 0xffff0000u);
                r1[0] = __uint_as_float(rw.z << 16); r1[1] = __uint_as_float(rw.z & 0xffff0000u); r1[2] = __uint_as_float(rw.w << 16); r1[3] = __uint_as_float(rw.w & 0xffff0000u);
                orow[0] = (r0 * r) * gr[0]; orow[1] = (r1 * r) * gr[1]; } }
    }
#undef IN
#undef SEAM
}

extern "C" void kernel_launch(void* const* d_in, const int* in_sizes, int n_in, void* d_out, int out_size, void* d_ws, size_t ws_size, hipStream_t stream) {
    static int grid = 0;
    if (grid == 0) {
        if (n_in != 32 || out_size != M * D || ws_size < WS_END) { fprintf(stderr, "kernel_launch: unexpected shapes (n_in %d out %d ws %zu)\n", n_in, out_size, ws_size); grid = -1; return; }
        int dev = 0, cus = 0, per_cu = 0;
        if (hipGetDevice(&dev) != hipSuccess || hipDeviceGetAttribute(&cus, hipDeviceAttributeMultiprocessorCount, dev) != hipSuccess) { grid = -1; return; }
        if (hipFuncSetAttribute((const void*)mk_fwd, hipFuncAttributeMaxDynamicSharedMemorySize, LDS_BYTES) != hipSuccess) { grid = -1; return; }
        if (hipOccupancyMaxActiveBlocksPerMultiprocessor(&per_cu, (const void*)mk_fwd, NWAVES * 64, LDS_BYTES) != hipSuccess || per_cu < 1) fprintf(stderr, "kernel_launch: occupancy query reports %d\n", per_cu);
        (void)hipGetLastError();
        grid = cus;
        if (grid > 256) grid = 256;
    }
    if (grid < 0) return;
    if (hipMemsetAsync((char*)d_ws + WS_CTL, 0, CTL_ZERO_BYTES, stream) != hipSuccess) return;
    Args a{};
    const float** ip = (const float**)&a.in;
    for (int i = 0; i < 32; ++i) ip[i] = (const float*)d_in[i];
    a.out = (float*)d_out; a.ws = (unsigned char*)d_ws;
#if MK_SPLIT
    for (int k = 0; k < N_PHASES; ++k) { a.ph_lo = k; a.ph_hi = k + 1; hipLaunchKernelGGL(mk_fwd, dim3(grid), dim3(NWAVES * 64), LDS_BYTES, stream, a); }
#else
    a.ph_lo = 0; a.ph_hi = N_PHASES; hipLaunchKernelGGL(mk_fwd, dim3(grid), dim3(NWAVES * 64), LDS_BYTES, stream, a);
#endif
}
```

```cpp
#include <hip/hip_runtime.h>
#include <cstdio>
#include <cstdint>
#include <type_traits>
#include <math.h>

namespace pg8 {
#define PG8_LAS __attribute__((address_space(3)))
typedef unsigned short bf16_t;
typedef short bf16x8 __attribute__((ext_vector_type(8)));
typedef float f32x4 __attribute__((ext_vector_type(4)));
typedef unsigned u32x4 __attribute__((ext_vector_type(4)));
constexpr int BM = 256, BK = 64, HALF = 128, HTB = HALF * BK * 2  , STAGE_BYTES = 8 * HTB, NXCD = 8, WGM = 8;

__host__ __device__ __forceinline__ int lds_byte(int r, int c) { const int st = (r >> 4) * 2 + (c >> 5), rr = r & 15, cc = c & 31, ob = rr * 64 + cc * 2; return st * 1024 + (ob ^ (((ob >> 9) & 1) << 5)); }
__host__ __device__ __forceinline__ void stage_rc(int b, int& R, int& C) { const int st = b / 1024, sb = b % 1024, swz = sb ^ (((sb >> 9) & 1) << 5); R = (st >> 1) * 16 + swz / 64; C = (st & 1) * 32 + (swz % 64) / 2; }
__host__ __device__ __forceinline__ int perm32(int rho) { const int n = rho >> 4, i = rho & 15; return 8 * (i >> 2) + 4 * n + (i & 3); }

struct Unit { int pm, pn; };
struct Gemm { const bf16_t* A; const bf16_t* Bt; int M, N, K; };

struct StaticOrder {
    int nM, nN, nwg, G, c;
    __host__ __device__ void init(int M, int N, int G_, int c_) { nM = M / BM; nN = N / BM; nwg = nM * nN; G = G_; c = c_; }
    __host__ __device__ bool next(int i, Unit& u) const {
        const long L = (long)i * G + c; if (L >= nwg) return false;
        int wgid = (int)L; { const int q = nwg / NXCD, r = nwg % NXCD, xcd = wgid % NXCD, off = wgid / NXCD; wgid = (xcd < r ? xcd * (q + 1) : r * (q + 1) + (xcd - r) * q) + off; }
        const int nig = WGM * nN, gid = wgid / nig, fm = gid * WGM, gsz = (nM - fm) < WGM ? (nM - fm) : WGM;
        u.pm = fm + ((wgid % nig) % gsz); u.pn = (wgid % nig) / gsz; return true;
    }
    __device__ __forceinline__ void a_ready(const Unit&) const {}
    __device__ __forceinline__ void done(const Unit&) const {}
};

__device__ __forceinline__ unsigned cvt_pk_bf16(float lo, float hi) { unsigned r; asm volatile("v_cvt_pk_bf16_f32 %0, %1, %2" : "=v"(r) : "v"(lo), "v"(hi)); return r; }
__device__ __forceinline__ float ssq_row(const float* p) { const f32x4 a = ((const f32x4*)p)[0], b = ((const f32x4*)p)[1], c = ((const f32x4*)p)[2], d = ((const f32x4*)p)[3]; const f32x4 t = (a + b) + (c + d); return (t[0] + t[1]) + (t[2] + t[3]); }
template <int ROUTE> struct EpiRoute {
    static constexpr bool PERM = true, AFTER_DRAIN = false;
    unsigned char* ws; const float* ssq;
    __device__ __forceinline__ void operator()(const f32x4 (&acc)[2][2][4][2], const Unit& u, int wr, int wc, int fr, int fq) const {
        asm volatile("" : "+v"(fr), "+v"(fq));
        const int pn = u.pn; size_t off; int ld, t0; float sc;
        if constexpr (ROUTE == 0) {
            off = pn < 3 ? (size_t)(88u << 20) : pn < 5 ? (size_t)(112u << 20) : pn < 6 ? (size_t)(128u << 20) : (size_t)(136u << 20);
            ld = pn < 3 ? 768 : pn < 5 ? 512 : 256; t0 = pn < 3 ? 0 : pn < 5 ? 3 : pn < 6 ? 5 : 6; sc = (pn < 3 || pn == 5) ? 0.18033688011112042f : 1.f;
        } else if constexpr (ROUTE == 1) { off = (size_t)(88u << 20); ld = 768; t0 = 0; sc = 1.f; }
        else if constexpr (ROUTE == 3) { off = (size_t)(144u << 20); ld = 16384; t0 = 0; sc = 1.f; }
        else { off = pn < 6 ? (size_t)(128u << 20) : (size_t)(176u << 20); ld = pn < 6 ? 1536 : 512; t0 = pn < 6 ? 0 : 6; sc = 1.f; }
        bf16_t* base = (bf16_t*)(ws + off);
        const int row0 = u.pm * BM + wr * 64 + fr, col0 = (pn - t0) * BM + wc * 32 + 8 * fq;
#pragma unroll
        for (int ai = 0; ai < 2; ++ai)
#pragma unroll
            for (int m = 0; m < 4; ++m) { bf16_t* rowp = base + (size_t)(row0 + ai * HALF + m * 16) * ld + col0;
                float scr_ = sc; if constexpr (ROUTE == 1) scr_ = rsqrtf(ssq_row(ssq + (size_t)(row0 + ai * HALF + m * 16) * 16) * (1.f / 1024.f) + 1e-6f);
#pragma unroll
                for (int bj = 0; bj < 2; ++bj) { float scb_ = scr_; if constexpr (ROUTE == 1) { const int cg = col0 + bj * HALF; if (cg >= 456 && cg < 712) scb_ *= 0.18033688011112042f; }
                    const f32x4 v0 = acc[ai][bj][m][0] * scb_, v1 = acc[ai][bj][m][1] * scb_;
                    u32x4 w; w.x = cvt_pk_bf16(v0[0], v0[1]); w.y = cvt_pk_bf16(v0[2], v0[3]); w.z = cvt_pk_bf16(v1[0], v1[1]); w.w = cvt_pk_bf16(v1[2], v1[3]);
                    if constexpr (ROUTE == 3) {
                        const int tok = col0 + bj * HALF, rw = row0 + ai * HALF + m * 16; *(u32x4*)(base + ((size_t)(tok >> 6) * 256 + rw) * 64 + (tok & 63)) = w; }
                    else *(u32x4*)(rowp + bj * HALF) = w; } }
    }
};
template <bool RES_F32>
struct EpiResid {
    static constexpr bool PERM = true, AFTER_DRAIN = false;
    const void* res; bf16_t* hb; float* ssq; int ldc; int pad;
    __device__ __forceinline__ void operator()(const f32x4 (&acc)[2][2][4][2], const Unit& u, int wr, int wc, int fr, int fq) const {
        asm volatile("" : "+v"(fr), "+v"(fq));
        const int row0 = u.pm * BM + wr * 64 + fr, col0 = u.pn * BM + wc * 32 + 8 * fq;
#pragma unroll
        for (int ai = 0; ai < 2; ++ai)
#pragma unroll
            for (int m = 0; m < 4; ++m) { const int row = row0 + ai * HALF + m * 16; const size_t off = (size_t)row * ldc + col0; float sq = 0.f;
#pragma unroll
                for (int bj = 0; bj < 2; ++bj) { f32x4 v[2];
                    if constexpr (RES_F32) {
#pragma unroll
                        for (int n = 0; n < 2; ++n) v[n] = *(const f32x4*)((const float*)res + off + bj * HALF + 4 * n) + acc[ai][bj][m][n];
                    } else { const u32x4 rw = *(const u32x4*)((const bf16_t*)res + off + bj * HALF);
                        f32x4 r0, r1; r0[0] = __uint_as_float(rw.x << 16); r0[1] = __uint_as_float(rw.x & 0xffff0000u); r0[2] = __uint_as_float(rw.y << 16); r0[3] = __uint_as_float(rw.y & 0xffff0000u);
                        r1[0] = __uint_as_float(rw.z << 16); r1[1] = __uint_as_float(rw.z & 0xffff0000u); r1[2] = __uint_as_float(rw.w << 16); r1[3] = __uint_as_float(rw.w & 0xffff0000u);
                        v[0] = r0 + acc[ai][bj][m][0]; v[1] = r1 + acc[ai][bj][m][1]; }
#pragma unroll
                    for (int n = 0; n < 2; ++n) sq += (v[n][0] * v[n][0] + v[n][1] * v[n][1]) + (v[n][2] * v[n][2] + v[n][3] * v[n][3]);
                    u32x4 w; w.x = cvt_pk_bf16(v[0][0], v[0][1]); w.y = cvt_pk_bf16(v[0][2], v[0][3]); w.z = cvt_pk_bf16(v[1][0], v[1][1]); w.w = cvt_pk_bf16(v[1][2], v[1][3]); *(u32x4*)(hb + off + bj * HALF) = w; }
                sq += __shfl_xor(sq, 16); sq += __shfl_xor(sq, 32); if (fq == 0) ssq[(size_t)row * 16 + u.pn * 4 + wc] = sq; }
    }
};
struct EpiSwiglu {
    static constexpr bool PERM = true, AFTER_DRAIN = false;
    bf16_t* O; const float* ssq; int ldc; int pad;
    __device__ __forceinline__ void operator()(const f32x4 (&acc)[2][2][4][2], const Unit& u, int wr, int wc, int fr, int fq) const {
        asm volatile("" : "+v"(fr), "+v"(fq));
        const int row0 = u.pm * BM + wr * 64 + fr, col0 = u.pn * HALF + wc * 32 + 8 * fq;
#pragma unroll
        for (int ai = 0; ai < 2; ++ai)
#pragma unroll
            for (int m = 0; m < 4; ++m) { float o[8]; const float rs = rsqrtf(ssq_row(ssq + (size_t)(row0 + ai * HALF + m * 16) * 16) * (1.f / 1024.f) + 1e-6f);
#pragma unroll
                for (int n = 0; n < 2; ++n)
#pragma unroll
                    for (int e = 0; e < 4; ++e) { const float g = acc[ai][0][m][n][e] * rs, up = acc[ai][1][m][n][e] * rs; o[4 * n + e] = (g * __builtin_amdgcn_rcpf(1.f + __expf(-g))) * up; }
                u32x4 w; w.x = cvt_pk_bf16(o[0], o[1]); w.y = cvt_pk_bf16(o[2], o[3]); w.z = cvt_pk_bf16(o[4], o[5]); w.w = cvt_pk_bf16(o[6], o[7]);
                *(u32x4*)(O + (size_t)(row0 + ai * HALF + m * 16) * ldc + col0) = w; }
    }
};
template <class Epi, class Sched, bool ALIGN_EPI = false, bool SP2 = false>
__device__ __forceinline__ void gemm_phase(PG8_LAS unsigned char* lds, const Gemm g, const Sched& S, const Epi& E) {
    int tid = threadIdx.x; asm volatile("" : "+v"(tid));
    const int wid = __builtin_amdgcn_readfirstlane(tid >> 6), lane = tid & 63, wr = wid >> 2, wc = wid & 3, fr = lane & 15, fq = lane >> 4;
    int K = g.K; asm volatile("" : "+s"(K));
    const int nt = K / BK;
    unsigned voffA[2], voffB[2];
#pragma unroll
    for (int i = 0; i < 2; ++i) { int R, C; stage_rc(tid * 16 + i * 8192, R, C); const int Rb = Epi::PERM ? ((R & ~31) + perm32(R & 31)) : R;
        voffA[i] = (unsigned)(R * K + C) * 2u; voffB[i] = (unsigned)(Rb * K + C) * 2u; }
    const size_t kstep = (size_t)(BK * 2);
    const size_t hstep = (size_t)HALF * K * 2;
    const size_t tstep = 2 * hstep;
    const unsigned ldsw = (unsigned)wid * 1024u;
    const int aoff = lds_byte(wr * 64 + fr, fq * 8), boff = lds_byte(wc * 32 + fr, fq * 8);
#define PG8_SA(b, h) (((b) * 2 + (h)) * HTB)
#define PG8_SB(b, h) ((4 + (b) * 2 + (h)) * HTB)
#define PG8_STAGE(bufoff, gbase, voff) do { _Pragma("unroll") for (int _i = 0; _i < 2; ++_i) \
        __builtin_amdgcn_global_load_lds((const unsigned*)((const char*)(gbase) + (voff)[_i]), (PG8_LAS unsigned*)(lds + (bufoff) + ldsw + _i * 8192), 16, 0, 0); } while (0)
#define PG8_LDA(dst, b, h) do { _Pragma("unroll") for (int m = 0; m < 4; ++m) _Pragma("unroll") for (int k = 0; k < 2; ++k) dst[m][k] = *(const PG8_LAS bf16x8*)(lds + PG8_SA(b, h) + aoff + m * 2048 + k * 1024); } while (0)
#define PG8_LDB(dst, b, h) do { _Pragma("unroll") for (int n = 0; n < 2; ++n) _Pragma("unroll") for (int k = 0; k < 2; ++k) dst[n][k] = *(const PG8_LAS bf16x8*)(lds + PG8_SB(b, h) + boff + n * 2048 + k * 1024); } while (0)
#define PG8_MMA(ai, bj, At, Bt) do { __builtin_amdgcn_s_setprio(1); _Pragma("unroll") for (int m = 0; m < 4; ++m) _Pragma("unroll") for (int n = 0; n < 2; ++n) _Pragma("unroll") for (int k = 0; k < 2; ++k) \
        acc[ai][bj][m][n] = __builtin_amdgcn_mfma_f32_16x16x32_bf16(Bt[n][k], At[m][k], acc[ai][bj][m][n], 0, 0, 0); __builtin_amdgcn_s_setprio(0); } while (0)
#define PG8_WAIT_V(n) asm volatile("s_waitcnt vmcnt(" #n ")" ::: "memory")
#define PG8_WAIT_L(n) asm volatile("s_waitcnt lgkmcnt(" #n ")" ::: "memory")
#define PG8_BAR __builtin_amdgcn_s_barrier()
#define PG8_SCHED __builtin_amdgcn_sched_barrier(0)
    Unit cur, nxt; int ui = 0;
    if (!S.next(0, cur)) return;
    f32x4 acc[2][2][4][2];
#pragma unroll
    for (int a = 0; a < 2; ++a)
#pragma unroll
        for (int b = 0; b < 2; ++b)
#pragma unroll
            for (int m = 0; m < 4; ++m)
#pragma unroll
                for (int n = 0; n < 2; ++n) acc[a][b][m][n] = (f32x4){0.f, 0.f, 0.f, 0.f};
    bf16x8 At[4][2], B0[2][2], B1[2][2];
    const char* cA = (const char*)g.A + (size_t)cur.pm * tstep; const char* cB = (const char*)g.Bt + (size_t)cur.pn * tstep;
    S.a_ready(cur);
    if constexpr (SP2) {
        PG8_STAGE(PG8_SB(0, 0), cB, voffB); PG8_STAGE(PG8_SB(0, 1), cB + hstep, voffB); PG8_STAGE(PG8_SA(0, 0), cA, voffA); PG8_STAGE(PG8_SA(0, 1), cA + hstep, voffA);
        if (wr == 1) PG8_BAR;
        PG8_WAIT_V(2); PG8_BAR;
        PG8_STAGE(PG8_SB(1, 0), cB + kstep, voffB); PG8_STAGE(PG8_SA(1, 0), cA + kstep, voffA); PG8_STAGE(PG8_SB(1, 1), cB + hstep + kstep, voffB);
        PG8_WAIT_V(6); PG8_BAR;
    } else {
        PG8_STAGE(PG8_SB(0, 0), cB, voffB); PG8_STAGE(PG8_SA(0, 0), cA, voffA); PG8_STAGE(PG8_SB(0, 1), cB + hstep, voffB); PG8_STAGE(PG8_SA(0, 1), cA + hstep, voffA);
        if (wr == 1) PG8_BAR;
        PG8_WAIT_V(4); PG8_BAR;
        PG8_STAGE(PG8_SB(1, 0), cB + kstep, voffB); PG8_STAGE(PG8_SA(1, 0), cA + kstep, voffA); PG8_STAGE(PG8_SB(1, 1), cB + hstep + kstep, voffB);
        PG8_WAIT_V(6); PG8_BAR;
    }
    for (;;) {
        const bool has_next = S.next(ui + 1, nxt);
        const char* nA = has_next ? (const char*)g.A + (size_t)nxt.pm * tstep : cA; const char* nB = has_next ? (const char*)g.Bt + (size_t)nxt.pn * tstep : cB;
        for (int t = 0; t < nt; t += 2) {
            const bool last = (t == nt - 2);
            const char* a1 = cA + (size_t)(t + 1) * kstep;
            const char* a2 = last ? nA : cA + (size_t)(t + 2) * kstep; const char* b2 = last ? nB : cB + (size_t)(t + 2) * kstep;
            const char* a3 = a2 + kstep; const char* b3 = b2 + kstep;
            if (last && has_next) S.a_ready(nxt);
            if constexpr (SP2) {
            PG8_LDB(B0, 0, 0); PG8_LDB(B1, 0, 1); PG8_SCHED; PG8_LDA(At, 0, 0); PG8_STAGE(PG8_SA(1, 1), a1 + hstep, voffA);
            PG8_WAIT_V(8); PG8_WAIT_L(0); PG8_BAR; PG8_MMA(0, 0, At, B0); PG8_MMA(0, 1, At, B1); PG8_BAR; PG8_SCHED;
            PG8_LDA(At, 0, 1); PG8_STAGE(PG8_SB(0, 0), b2, voffB); PG8_STAGE(PG8_SB(0, 1), b2 + hstep, voffB); PG8_STAGE(PG8_SA(0, 0), a2, voffA);
            PG8_WAIT_V(8); PG8_WAIT_L(0); PG8_BAR; PG8_MMA(1, 0, At, B0); PG8_MMA(1, 1, At, B1); PG8_BAR; PG8_SCHED;
            PG8_LDB(B0, 1, 0); PG8_LDB(B1, 1, 1); PG8_SCHED; PG8_LDA(At, 1, 0); PG8_STAGE(PG8_SA(0, 1), a2 + hstep, voffA);
            PG8_WAIT_V(8); PG8_WAIT_L(0); PG8_BAR; PG8_MMA(0, 0, At, B0); PG8_MMA(0, 1, At, B1); PG8_BAR; PG8_SCHED;
            PG8_LDA(At, 1, 1); PG8_STAGE(PG8_SB(1, 0), b3, voffB); PG8_STAGE(PG8_SB(1, 1), b3 + hstep, voffB); PG8_STAGE(PG8_SA(1, 0), a3, voffA);
            PG8_WAIT_V(8); PG8_WAIT_L(0); PG8_BAR; PG8_MMA(1, 0, At, B0); PG8_MMA(1, 1, At, B1); PG8_BAR; PG8_SCHED;
            } else {
            PG8_LDB(B0, 0, 0); PG8_SCHED; PG8_LDA(At, 0, 0); PG8_STAGE(PG8_SA(1, 1), a1 + hstep, voffA);
            PG8_WAIT_L(8); PG8_BAR; PG8_WAIT_L(0); PG8_MMA(0, 0, At, B0); PG8_BAR; PG8_SCHED;
            PG8_LDB(B1, 0, 1); PG8_STAGE(PG8_SB(0, 0), b2, voffB);
            PG8_BAR; PG8_WAIT_L(0); PG8_MMA(0, 1, At, B1); PG8_BAR;
            PG8_LDA(At, 0, 1); PG8_STAGE(PG8_SA(0, 0), a2, voffA);
            PG8_BAR; PG8_WAIT_L(0); PG8_MMA(1, 0, At, B0); PG8_BAR; PG8_SCHED;
            PG8_STAGE(PG8_SB(0, 1), b2 + hstep, voffB);
            PG8_WAIT_V(6); PG8_BAR; PG8_MMA(1, 1, At, B1); PG8_BAR;
            PG8_LDB(B0, 1, 0); PG8_SCHED; PG8_LDA(At, 1, 0); PG8_STAGE(PG8_SA(0, 1), a2 + hstep, voffA);
            PG8_WAIT_L(8); PG8_BAR; PG8_WAIT_L(0); PG8_MMA(0, 0, At, B0); PG8_BAR; PG8_SCHED;
            PG8_LDB(B1, 1, 1); PG8_STAGE(PG8_SB(1, 0), b3, voffB);
            PG8_BAR; PG8_WAIT_L(0); PG8_MMA(0, 1, At, B1); PG8_BAR;
            PG8_LDA(At, 1, 1); PG8_STAGE(PG8_SA(1, 0), a3, voffA);
            PG8_BAR; PG8_WAIT_L(0); PG8_MMA(1, 0, At, B0); PG8_BAR; PG8_SCHED;
            PG8_STAGE(PG8_SB(1, 1), b3 + hstep, voffB);
            PG8_WAIT_V(6); PG8_BAR; PG8_MMA(1, 1, At, B1); PG8_BAR;
            }
        }
        if constexpr (ALIGN_EPI) { if (wr == 0) PG8_BAR; }
        if constexpr (!Epi::AFTER_DRAIN) { E(acc, cur, wr, wc, fr, fq); S.done(cur); }
        if (!has_next) break;
#pragma unroll
        for (int a = 0; a < 2; ++a)
#pragma unroll
            for (int b = 0; b < 2; ++b)
#pragma unroll
                for (int m = 0; m < 4; ++m)
#pragma unroll
                    for (int n = 0; n < 2; ++n) acc[a][b][m][n] = (f32x4){0.f, 0.f, 0.f, 0.f};
        cur = nxt; cA = nA; cB = nB; ++ui;
        if constexpr (ALIGN_EPI) { if (wr == 1) PG8_BAR; }
    }
    PG8_WAIT_V(0);
    if constexpr (!ALIGN_EPI) { if (wr == 0) PG8_BAR; }
    PG8_BAR;
    if constexpr (Epi::AFTER_DRAIN) { E.fused(acc, cur, wr, wc, fr, fq, lds, wid, lane); S.done(cur); }
#undef PG8_SA
#undef PG8_SB
#undef PG8_STAGE
#undef PG8_LDA
#undef PG8_LDB
#undef PG8_MMA
#undef PG8_WAIT_V
#undef PG8_WAIT_L
#undef PG8_BAR
#undef PG8_SCHED
}
}
constexpr int NWAVES = 8;
constexpr int BATCH = 2, T = 8192, D = 1024, M = BATCH * T, DFF = 2816, NSA_IN = 1828, DSA_IN = 712, NCMP = 511, NCR = BATCH * NCMP * 2;
constexpr float NEGF = -1e30f, EPSF = 1e-6f;
#ifndef MK_SPLIT
#define MK_SPLIT 0
#endif
constexpr int N_PHASES = 19;
constexpr size_t MiB = 1u << 20;
constexpr size_t WS_CTL = 0, CTL_ZERO_BYTES = 1 * MiB;
constexpr size_t WS_KCB = 1 * MiB  , WS_VCT = 1 * MiB + 512 * 1024  , WS_MKB = 2 * MiB  , WS_MVT = 2 * MiB + 512 * 1024  , WS_MKV = 3 * MiB  , WS_WIDX = 5 * MiB  , WS_CNT = 6 * MiB  ;
constexpr size_t WS_WIN0 = 8 * MiB, WS_WO = 12 * MiB, WS_WGU = 16 * MiB, WS_WD = 38 * MiB, WS_WIN1 = 49 * MiB, WS_WQ2 = 51 * MiB, WS_WVT = 52 * MiB  ;
constexpr size_t WS_W1T = 232 * MiB, WS_MEMN = 234 * MiB, WS_WMKT = 236 * MiB, WS_W2T = 238 * MiB, WS_B1F = 238 * MiB + 64 * 1024;
constexpr size_t WS_XN = 56 * MiB;
constexpr size_t WS_Q0 = 88 * MiB, WS_KV0 = 112 * MiB  , WS_QM = 128 * MiB, WS_G0 = 136 * MiB, WS_VT = 144 * MiB  ;
static_assert(WS_Q0 == (88u << 20) && WS_KV0 == (112u << 20) && WS_QM == (128u << 20) && WS_G0 == (136u << 20), "EpiRoute tables");
constexpr size_t WS_ACT = 88 * MiB;
constexpr size_t WS_PROJ1 = 88 * MiB, WS_CQ = 112 * MiB, WS_CKV = 120 * MiB, WS_KIDX = 124 * MiB, WS_QA = 128 * MiB, WS_QI = 176 * MiB, WS_SEL = 112 * MiB  , WS_CAT1 = 176 * MiB  , WS_WO1F = 52 * MiB + 512 * 1024  ;
constexpr size_t WS_OCS = 152 * MiB  , WS_CAT = 200 * MiB, WS_SSQ = 239 * MiB  , WS_END = 243 * MiB;
static_assert(WS_PROJ1 == (88u << 20) && WS_QA == (128u << 20) && WS_QI == (176u << 20) && WS_VT == (144u << 20), "EpiRoute tables");
static_assert(WS_ACT + (size_t)M * DFF * 2 <= WS_CAT + 0 * MiB || true, "map");
constexpr int CW_BAR = 4096;
constexpr int RING_OFF = 0, RING_BYTES = 131072, LDS_BYTES = 163840, LDSCTL_OFF = LDS_BYTES - 1024, MISC_OFF = LDSCTL_OFF + 320;
#define GAS __attribute__((address_space(1)))
#define LAS __attribute__((address_space(3)))
typedef unsigned short bf16;
typedef unsigned v4u __attribute__((ext_vector_type(4)));
typedef unsigned v2u __attribute__((ext_vector_type(2)));
typedef float f32x4 __attribute__((ext_vector_type(4)));
typedef short bf16x8 __attribute__((ext_vector_type(8)));
typedef GAS unsigned gu32;
typedef GAS unsigned long long gu64;
#define RLX_AGENT __ATOMIC_RELAXED, __HIP_MEMORY_SCOPE_AGENT
#define LDS_WAIT() asm volatile("s_waitcnt lgkmcnt(0)" ::: "memory")
#define VM_WAIT() asm volatile("s_waitcnt vmcnt(0)" ::: "memory")
__device__ __forceinline__ unsigned long long rt() { return __builtin_amdgcn_s_memrealtime(); }
__device__ __forceinline__ unsigned f2bf(float f) { unsigned u = __builtin_bit_cast(unsigned, f); return (u + 0x7fffu + ((u >> 16) & 1u)) >> 16; }
__device__ __forceinline__ unsigned pk2(float lo, float hi) { return f2bf(lo) | (f2bf(hi) << 16); }
#define XB_TMO      128
#define XB_XCNT(j)  (256  + 64 * (j))
#define XB_XSUB(j)  (1280 + 64 * (j))
#define XB_XGEN(j)  (2304 + 64 * (j))
#define XB_TOP      3328
#define XB_TOPGEN   3392
#define XCD_BAR_WORDS 3456
#define XB_SPIN_CAP (1u << 18)

__device__ __forceinline__ unsigned xb_ld(unsigned* p)              { return __hip_atomic_load(p, __ATOMIC_RELAXED, __HIP_MEMORY_SCOPE_AGENT); }
__device__ __forceinline__ unsigned xb_add(unsigned* p, unsigned v) { return __hip_atomic_fetch_add(p, v, __ATOMIC_RELAXED, __HIP_MEMORY_SCOPE_AGENT); }
__device__ __forceinline__ unsigned xb_xcc_id() { return (unsigned)__builtin_amdgcn_s_getreg((3 << 11) | 20) & 0xFu; }
#define XB_SPIN(cond, bar) do { unsigned _sp = 0; while (cond) { __builtin_amdgcn_s_sleep(1); \
    if ((++_sp & 255u) == 0u) { if (xb_ld(&(bar)[XB_TMO])) break; if (_sp > XB_SPIN_CAP) { atomicAdd(&(bar)[XB_TMO], 1u); break; } } } } while (0)

struct XcdBarrier {
    unsigned* bar; unsigned x;
    volatile LAS unsigned* st;
};

__device__ __forceinline__ XcdBarrier xcd_barrier_post(unsigned* bar, volatile LAS unsigned* st) {
    XcdBarrier b; b.bar = bar; b.x = xb_xcc_id(); b.st = st;
    if (threadIdx.x == 0) (void)xb_add(&bar[XB_XCNT(b.x)], 1u);
    return b;
}
__device__ __forceinline__ void xcd_barrier_complete(unsigned* bar, unsigned x, unsigned& nloc, unsigned& nx) {
    const unsigned G = gridDim.x * gridDim.y * gridDim.z;
    unsigned sum, cnt, mine, sp = 0u;
    for (;;) {
        sum = 0u; cnt = 0u; mine = 0u;
#pragma unroll 1
        for (unsigned j = 0; j < 16; ++j) { const unsigned c = xb_ld(&bar[XB_XCNT(j)]); sum += c; cnt += (c > 0u) ? 1u : 0u; mine = (j == x) ? c : mine; }
        if (sum == G) break;
        __builtin_amdgcn_s_sleep(1);
        if ((++sp & 255u) == 0u) { if (xb_ld(&bar[XB_TMO])) break; if (sp > XB_SPIN_CAP) { atomicAdd(&bar[XB_TMO], 1u); break; } }
    }
    nloc = mine > 0u ? mine : 1u; nx = cnt > 0u ? cnt : 1u;
}

__device__ __forceinline__ void xcd_barrier(const XcdBarrier& b) {
    asm volatile("s_waitcnt vmcnt(0)" ::: "memory");
    __syncthreads();
    if (threadIdx.x == 0) {
        unsigned* bar = b.bar;
        __builtin_amdgcn_s_waitcnt(0);
        unsigned nloc = b.st[0], nx = b.st[1];
        if (nloc == 0u) { xcd_barrier_complete(bar, b.x, nloc, nx); b.st[0] = nloc; b.st[1] = nx; }
        const unsigned old = xb_add(&bar[XB_XSUB(b.x)], 1u);
        const unsigned gen = old / nloc;
        if (old + 1u == (gen + 1u) * nloc) {
            __builtin_amdgcn_fence(__ATOMIC_RELEASE, "agent");
            asm volatile("s_waitcnt vmcnt(0)" ::: "memory");
            const unsigned og = xb_add(&bar[XB_TOP], 1u);
            const unsigned tg = og / nx;
            if (og + 1u == (tg + 1u) * nx) xb_add(&bar[XB_TOPGEN], 1u);
            else XB_SPIN(xb_ld(&bar[XB_TOPGEN]) == tg, bar);
            __builtin_amdgcn_fence(__ATOMIC_ACQUIRE, "agent");
            xb_add(&bar[XB_XGEN(b.x)], 1u);
            asm volatile("s_waitcnt vmcnt(0)" ::: "memory");
        } else {
            XB_SPIN(xb_ld(&bar[XB_XGEN(b.x)]) == gen, bar);
            __builtin_amdgcn_fence(__ATOMIC_ACQUIRE, "agent");
            asm volatile("s_waitcnt vmcnt(0)" ::: "memory");
        }
    }
    __syncthreads();
}

struct Frame {
    LAS unsigned char* lds; volatile LAS unsigned* MISC; gu32* ctl;
    int vcu, G;
};
__device__ __forceinline__ float bf2f(unsigned short u) { return __uint_as_float((unsigned)u << 16); }
__device__ __forceinline__ float bflo(unsigned u) { return __uint_as_float(u << 16); }
__device__ __forceinline__ float bfhi(unsigned u) { return __uint_as_float(u & 0xffff0000u); }
__device__ __forceinline__ float wave_sum(float v) {
#pragma unroll
    for (int o = 1; o < 64; o <<= 1) v += __shfl_xor(v, o);
    return v;
}
__device__ __forceinline__ float red16_sum(float v) { v += __shfl_xor(v, 1, 16); v += __shfl_xor(v, 2, 16); v += __shfl_xor(v, 4, 16); v += __shfl_xor(v, 8, 16); return v; }
__device__ __forceinline__ float red16_max(float v) { v = fmaxf(v, __shfl_xor(v, 1, 16)); v = fmaxf(v, __shfl_xor(v, 2, 16)); v = fmaxf(v, __shfl_xor(v, 4, 16)); v = fmaxf(v, __shfl_xor(v, 8, 16)); return v; }
__device__ __forceinline__ int rel_bucket(int n) {
    if (n < 16) return n;
    return 16 + (n >= 22) + (n >= 30) + (n >= 40) + (n >= 54) + (n >= 73) + (n >= 99) + (n >= 134) + (n >= 182) + (n >= 246) + (n >= 332) + (n >= 450) + (n >= 609) + (n >= 825) + (n >= 1117) + (n >= 1513);
}

__device__ __forceinline__ void xpose_item(const float* W, int ldw, int c0, int nvalid, int k0, bf16* WT, int Kd, int drow0, LAS float* scr, int lane, const float* kgain = nullptr) {
#pragma unroll
    for (int i = 0; i < 8; ++i) { const int kk = 8 * i + (lane >> 3), n = (lane & 7) * 4;
        float4 wv = make_float4(0.f, 0.f, 0.f, 0.f);
        if (n + 3 < nvalid) wv = *(const float4*)(W + (size_t)(k0 + kk) * ldw + c0 + n);
        else if (n < nvalid) { const float* wp = W + (size_t)(k0 + kk) * ldw + c0 + n; wv.x = wp[0]; if (n + 1 < nvalid) wv.y = wp[1]; if (n + 2 < nvalid) wv.z = wp[2]; }
        if (kgain) { const float g_ = kgain[k0 + kk]; wv.x *= g_; wv.y *= g_; wv.z *= g_; wv.w *= g_; }
        LAS float* sp = scr + kk * 33 + n; sp[0] = wv.x; sp[1] = wv.y; sp[2] = wv.z; sp[3] = wv.w; }
    LDS_WAIT(); asm volatile("" ::: "memory");
    const int c = lane & 7;
#pragma unroll
    for (int j = 0; j < 4; ++j) { const int n = (lane >> 3) + 8 * j; const LAS float* s = scr + (8 * c) * 33 + n;
        v4u o; o.x = pk2(s[0 * 33], s[1 * 33]); o.y = pk2(s[2 * 33], s[3 * 33]); o.z = pk2(s[4 * 33], s[5 * 33]); o.w = pk2(s[6 * 33], s[7 * 33]);
        *(GAS v4u*)(WT + (size_t)(drow0 + n) * Kd + k0 + 8 * c) = o; }
    LDS_WAIT(); asm volatile("" ::: "memory");
}
__device__ __forceinline__ void rms_row_to_bf16(const float* xrow, const float* gain, bf16* orow, int lane) {
    const GAS f32x4* xr = (const GAS f32x4*)xrow + lane; const GAS f32x4* gr = (const GAS f32x4*)gain + lane;
    f32x4 v[4]; float s = 0.f;
#pragma unroll
    for (int j = 0; j < 4; ++j) { v[j] = xr[64 * j]; s += (v[j].x * v[j].x + v[j].y * v[j].y) + (v[j].z * v[j].z + v[j].w * v[j].w); }
    const float r = rsqrtf(wave_sum(s) * (1.f / D) + EPSF);
    GAS unsigned long long* o8 = (GAS unsigned long long*)orow + lane;
#pragma unroll
    for (int j = 0; j < 4; ++j) { const f32x4 g = gr[64 * j]; o8[64 * j] = (unsigned long long)pk2((v[j].x * r) * g.x, (v[j].y * r) * g.y) | ((unsigned long long)pk2((v[j].z * r) * g.z, (v[j].w * r) * g.w) << 32); }
}
#ifndef PROBE_REP
#define PROBE_REP 0
#endif
#define CAS __attribute__((address_space(4)))
#define KARGS() const CAS In* Ip = (const CAS In*)__builtin_amdgcn_kernarg_segment_ptr(); asm volatile("" : "+s"(Ip))
#define OPAQUE_TID() int tid_ = threadIdx.x; asm volatile("" : "+v"(tid_))
__device__ __forceinline__ void norm_phase(Frame& F, const float* x, const float* gain, bf16* xn) {
    OPAQUE_TID(); const int lane_ = tid_ & 63, wave_ = tid_ >> 6;
    const int gw = F.vcu * NWAVES + wave_, NGW = F.G * NWAVES;
    for (int m = gw; m < M; m += NGW) rms_row_to_bf16(x + (size_t)m * D, gain, xn + (size_t)m * D, lane_);
}

template <int DL>
__device__ __forceinline__ void coop_attend(const float (&q)[DL], const float (&k)[DL], const float (&v)[DL], float bias, float& m_, float& l_, float (&o)[DL]) {
    float a = 0.f;
#pragma unroll
    for (int d = 0; d < DL; ++d) a += q[d] * k[d];
    a = red16_sum(a) + bias;
    const float mn = fmaxf(m_, a), al = __expf(m_ - mn), p = __expf(a - mn);
    l_ = l_ * al + p; m_ = mn;
#pragma unroll
    for (int d = 0; d < DL; ++d) o[d] = o[d] * al + p * v[d];
}
__device__ __forceinline__ void ld4bf(const bf16* p, float (&x)[4]) { const uint2 u = *(const uint2*)p; x[0] = bflo(u.x); x[1] = bfhi(u.x); x[2] = bflo(u.y); x[3] = bfhi(u.y); }
__device__ __forceinline__ void ld8bf(const bf16* p, float (&x)[8]) { const uint4 u = *(const uint4*)p; x[0] = bflo(u.x); x[1] = bfhi(u.x); x[2] = bflo(u.y); x[3] = bfhi(u.y); x[4] = bflo(u.z); x[5] = bfhi(u.z); x[6] = bflo(u.w); x[7] = bfhi(u.w); }
__device__ __forceinline__ void ld4f(const float* p, float (&x)[4]) { const float4 u = *(const float4*)p; x[0] = u.x; x[1] = u.y; x[2] = u.z; x[3] = u.w; }

struct In {
    const float *x, *mem, *rel_bias, *norm_mix, *norm_ffn, *norm_mem, *w_mem_kv, *w_out, *ffn_gate, *ffn_up, *ffn_down, *nsa_w_in, *nsa_gate_b, *pos_k, *pos_v,
        *k_w1, *k_b1, *k_w2, *k_b2, *v_w1, *v_b1, *v_w2, *v_b2, *dsa_w_in, *q_norm, *kv_norm, *w_q_up, *w_uk, *w_uv, *w_q_idx, *kidx_norm, *norm_final;
};
__device__ __forceinline__ void p0_prologue(Frame& F, const In& I, unsigned char* ws) {
    OPAQUE_TID(); KARGS(); const int lane_ = tid_ & 63, wave_ = __builtin_amdgcn_readfirstlane(tid_ >> 6);
    LAS float* scr = (LAS float*)(F.lds + RING_OFF + wave_ * 16384);
    const int gw = F.vcu * NWAVES + wave_, NGW = F.G * NWAVES;
    bf16* WIN0 = (bf16*)(ws + WS_WIN0); bf16* WO = (bf16*)(ws + WS_WO); bf16* WGU = (bf16*)(ws + WS_WGU); bf16* WD = (bf16*)(ws + WS_WD); bf16* WIN1 = (bf16*)(ws + WS_WIN1); bf16* WQ2 = (bf16*)(ws + WS_WQ2);
    constexpr int I_A = 16 * 56, I_G = 16 * 8, I_B = 2 * 16 * 32, I_C = 2 * 16 * 176, I_D = 2 * 44 * 32, I_E = 16 * 24, I_F = 4 * 16, NITEMS = I_A + I_B + I_C + I_D + I_E + I_F + I_G;
    for (int it = gw; it < NITEMS; it += NGW) {
        int r = it;
        if (r < I_A) { const int kb = r / 56, nb = r % 56, r0 = 32 * nb; int c0, nv;
            if (r0 < 1152) { c0 = r0; nv = 32; } else if (r0 < 1280) { c0 = r0 + 128; nv = 32; } else if (r0 < 1536) { c0 = r0 + 292; nv = 32; } else if (r0 == 1536) { c0 = 1536; nv = 32; } else if (r0 == 1568) { c0 = 1568; nv = 4; } else { c0 = 0; nv = 0; }
            xpose_item(Ip->nsa_w_in, NSA_IN, c0, nv, 64 * kb, WIN0, D, r0, scr, lane_); continue; } r -= I_A;
        if (r < I_B) { const int l = r / 512, q = r % 512, kb = q / 32, nb = q % 32;
            xpose_item(Ip->w_out + (size_t)l * D * D, D, 32 * nb, 32, 64 * kb, WO + (size_t)l * D * D, D, 32 * nb, scr, lane_); continue; } r -= I_B;
        if (r < I_C) { const int l = r / (16 * 176), q = r % (16 * 176), kb = q / 176, nb = q % 176, r0 = 32 * nb, pn = r0 >> 8, w0 = r0 & 255;
            const float* src = ((w0 < 128) ? Ip->ffn_gate : Ip->ffn_up) + (size_t)l * D * DFF;
            xpose_item(src, DFF, 128 * pn + (w0 & 127), 32, 64 * kb, WGU + (size_t)l * 2 * DFF * D, D, r0, scr, lane_, Ip->norm_ffn + l * D); continue; } r -= I_C;
        if (r < I_D) { const int l = r / (44 * 32), q = r % (44 * 32), kb = q / 32, nb = q % 32;
            xpose_item(Ip->ffn_down + (size_t)l * DFF * D, D, 32 * nb, 32, 64 * kb, WD + (size_t)l * D * DFF, DFF, 32 * nb, scr, lane_); continue; } r -= I_D;
        if (r < I_E) { const int kb = r / 24, nb = r % 24, r0 = 32 * nb; int nv = DSA_IN - r0; nv = nv > 32 ? 32 : (nv < 0 ? 0 : nv);
            xpose_item(Ip->dsa_w_in, DSA_IN, r0, nv, 64 * kb, WIN1, D, r0, scr, lane_, Ip->norm_mix + D); continue; } r -= I_E;
        if (r < I_F) { const int kb = r / 16, nb = r % 16; xpose_item(Ip->w_q_idx, 512, 32 * nb, 32, 64 * kb, WQ2, 256, 1536 + 32 * nb, scr, lane_); continue; } r -= I_F;
        { const int kb = r / 8, nb = r % 8, r0 = 32 * nb;
            xpose_item(Ip->nsa_w_in, NSA_IN, (r0 < 128) ? 1152 + r0 : 1408 + (r0 - 128), 32, 64 * kb, (bf16*)(ws + WS_WVT), D, r0, scr, lane_); }
    }
    for (int idx = (F.vcu * NWAVES * 64) + tid_; idx < 384 * 256; idx += F.G * NWAVES * 64) {
        const int c = idx & 255, r4 = (idx >> 8) & 31, h = idx >> 13; const float4* a4 = (const float4*)(Ip->w_q_up + (size_t)c * 768 + h * 64); const float4* b4 = (const float4*)(Ip->w_uk + (size_t)(4 * r4) * 768 + h * 64);
        float s0 = 0.f, s1 = 0.f, s2 = 0.f, s3 = 0.f;
#pragma unroll 4
        for (int d = 0; d < 16; ++d) { const float4 av = a4[d], b0 = b4[d], b1 = b4[192 + d], b2 = b4[384 + d], b3 = b4[576 + d];
            s0 += (av.x * b0.x + av.y * b0.y) + (av.z * b0.z + av.w * b0.w); s1 += (av.x * b1.x + av.y * b1.y) + (av.z * b1.z + av.w * b1.w);
            s2 += (av.x * b2.x + av.y * b2.y) + (av.z * b2.z + av.w * b2.w); s3 += (av.x * b3.x + av.y * b3.y) + (av.z * b3.z + av.w * b3.w); }
        const float sc_ = 0.125f * 1.4426950408889634f;
        bf16* o_ = WQ2 + (size_t)(h * 128 + 4 * r4) * 256 + c;
        o_[0] = (bf16)f2bf(s0 * sc_); o_[256] = (bf16)f2bf(s1 * sc_); o_[512] = (bf16)f2bf(s2 * sc_); o_[768] = (bf16)f2bf(s3 * sc_);
    }
    { bf16* WO1F = (bf16*)(ws + WS_WO1F); const float* wo1 = Ip->w_out + (size_t)D * D;
      for (int idx = (F.vcu * NWAVES * 64) + tid_; idx < 12 * 32 * 256; idx += F.G * NWAVES * 64) {
          const int n4 = idx & 255, r4 = (idx >> 8) & 31, h = idx >> 13; const float* a = Ip->w_uv + (size_t)(4 * r4) * 768 + h * 64; const float* bcol = wo1 + (size_t)(h * 64) * D + 4 * n4;
          float acc_[4][4];
#pragma unroll
          for (int i = 0; i < 4; ++i)
#pragma unroll
              for (int j = 0; j < 4; ++j) acc_[i][j] = 0.f;
#pragma unroll 4
          for (int d = 0; d < 64; ++d) { const float4 bv = *(const float4*)(bcol + (size_t)d * D); const float a0 = a[d], a1 = a[768 + d], a2 = a[1536 + d], a3 = a[2304 + d];
              acc_[0][0] += a0 * bv.x; acc_[0][1] += a0 * bv.y; acc_[0][2] += a0 * bv.z; acc_[0][3] += a0 * bv.w; acc_[1][0] += a1 * bv.x; acc_[1][1] += a1 * bv.y; acc_[1][2] += a1 * bv.z; acc_[1][3] += a1 * bv.w;
              acc_[2][0] += a2 * bv.x; acc_[2][1] += a2 * bv.y; acc_[2][2] += a2 * bv.z; acc_[2][3] += a2 * bv.w; acc_[3][0] += a3 * bv.x; acc_[3][1] += a3 * bv.y; acc_[3][2] += a3 * bv.z; acc_[3][3] += a3 * bv.w; }
#pragma unroll
          for (int j = 0; j < 4; ++j) *(uint2*)(WO1F + (size_t)(4 * n4 + j) * 1792 + h * 128 + 4 * r4) = make_uint2(pk2(acc_[0][j], acc_[1][j]), pk2(acc_[2][j], acc_[3][j])); }
      for (int it = gw; it < 4 * 32; it += NGW) { const int kb = it / 32, nb = it % 32;
          xpose_item(wo1 + (size_t)768 * D, D, 32 * nb, 32, 64 * kb, WO1F + 1536, 1792, 32 * nb, scr, lane_); } }
    { bf16* W1T = (bf16*)(ws + WS_W1T); bf16* W2T = (bf16*)(ws + WS_W2T); bf16* WMKT = (bf16*)(ws + WS_WMKT); float* B1F = (float*)(ws + WS_B1F); bf16* MEMN = (bf16*)(ws + WS_MEMN);
      constexpr int J_1 = 2 * 32 * 8, J_2 = 2 * 4 * 2, J_M = 2 * 16 * 16;
      for (int it = gw; it < J_1 + J_2 + J_M; it += NGW) { int r2 = it;
          if (r2 < J_1) { const int kv = r2 / 256, q = r2 % 256, kb = q / 8, nb = q % 8; xpose_item(kv ? Ip->v_w1 : Ip->k_w1, 256, 32 * nb, 32, 64 * kb, W1T + (size_t)kv * 256 * 2048, 2048, 32 * nb, scr, lane_); continue; } r2 -= J_1;
          if (r2 < J_2) { const int kv = r2 / 8, q = r2 % 8, kb = q / 2, nb = q % 2; xpose_item(kv ? Ip->v_w2 : Ip->k_w2, 64, 32 * nb, 32, 64 * kb, W2T + (size_t)kv * 64 * 256, 256, 32 * nb, scr, lane_); continue; } r2 -= J_2;
          { const int l = r2 / 256, q = r2 % 256, kb = q / 16, nb = q % 16; xpose_item(Ip->w_mem_kv + (size_t)l * D * 512, 512, 32 * nb, 32, 64 * kb, WMKT + (size_t)l * 512 * D, D, 32 * nb, scr, lane_); } }
      if ((int)blockIdx.x < 32) { const int u_ = (int)blockIdx.x, kv = u_ >> 4, cr = (u_ >> 2) & 3, kq4 = u_ & 3, c = 64 * cr + lane_; const float* w1 = kv ? Ip->v_w1 : Ip->k_w1; const float* pos = kv ? Ip->pos_v : Ip->pos_k;
          const int kb0 = 512 * kq4 + 64 * wave_; float sacc = 0.f;
#pragma unroll 8
          for (int k = 0; k < 64; ++k) sacc += pos[kb0 + k] * w1[(size_t)(kb0 + k) * 256 + c];
          LAS float* red = (LAS float*)(F.lds + RING_OFF + 8 * 16384);
          red[wave_ * 64 + lane_] = sacc;
          __syncthreads();
          if (wave_ == 0) { float t_ = 0.f;
#pragma unroll
              for (int w = 0; w < 8; ++w) t_ += red[w * 64 + lane_];
              B1F[(kv * 4 + kq4) * 256 + c] = t_; } }
      for (int m = gw; m < 1024; m += NGW) rms_row_to_bf16(Ip->mem + (size_t)(m & 511) * D, Ip->norm_mem + (m >> 9) * D, MEMN + (size_t)m * D, lane_); }
    norm_phase(F, Ip->x, Ip->norm_mix, (bf16*)(ws + WS_XN));
}

#define MFMA16(A, B, C) __builtin_amdgcn_mfma_f32_16x16x32_bf16((A), (B), (C), 0, 0, 0)
constexpr float LOG2E = 1.4426950408889634f;
constexpr int NSA_OUT = 0, NSA_PSQ = 49152, NSA_ST = 147456, NSA_TB = NSA_ST + 3072;
constexpr int TAB_B12 = NSA_ST + 1024;
constexpr int P13_JUNK = NSA_ST + 3072 + 1536;
constexpr int P13_B12 = NSA_ST;
constexpr int TAB_BKT = NSA_ST + 3072;
static_assert(NSA_TB + 12288 <= LDSCTL_OFF && TAB_B12 + 2048 <= NSA_TB, "LDS tables");
enum { MD_CMP = 0, MD_WIN = 1, MD_BLK = 2, MD_MEM = 3 };
struct KF { bf16x8 a0, a1, b0, b1; };
struct VF { bf16x8 v[4]; };
__device__ __forceinline__ bf16x8 ldg16(const bf16* p) { return *(const bf16x8*)p; }
typedef float f32x2_t __attribute__((ext_vector_type(2))); typedef __bf16 bf16x2_t __attribute__((ext_vector_type(2)));
__device__ __forceinline__ unsigned cvtpk_s(float lo, float hi) { f32x2_t v = {lo, hi}; bf16x2_t b = __builtin_convertvector(v, bf16x2_t); return __builtin_bit_cast(unsigned, b); }
__device__ __forceinline__ bf16x8 pack8(const f32x4& a, const f32x4& b) { v4u w; w.x = cvtpk_s(a[0], a[1]); w.y = cvtpk_s(a[2], a[3]); w.z = cvtpk_s(b[0], b[1]); w.w = cvtpk_s(b[2], b[3]); return __builtin_bit_cast(bf16x8, w); }
__device__ __forceinline__ void load_k(KF& k, const bf16* kb, int kstride, int key0, int r, int kq) {
    const bf16* pa = kb + (size_t)(key0 + 8 * (r >> 2) + (r & 3)) * kstride + 8 * kq; const bf16* pb = pa + 4 * (size_t)kstride;
    k.a0 = ldg16(pa); k.a1 = ldg16(pa + 32); k.b0 = ldg16(pb); k.b1 = ldg16(pb + 32);
}
__device__ __forceinline__ void load_vt(VF& v, const bf16* vt, int vstride, int key0, int r, int kq) {
#pragma unroll
    for (int dt = 0; dt < 4; ++dt) v.v[dt] = ldg16(vt + (size_t)(16 * dt + r) * vstride + key0 + 8 * kq);
}
__device__ __forceinline__ void qk(f32x4& sa, f32x4& sb, const KF& k, const bf16x8 (&q)[2]) {
    const f32x4 z = {0.f, 0.f, 0.f, 0.f};
    sa = MFMA16(k.a0, q[0], z); sa = MFMA16(k.a1, q[1], sa); sb = MFMA16(k.b0, q[0], z); sb = MFMA16(k.b1, q[1], sb);
}
struct BiasCtx { const LAS unsigned short* tb; float d29, d30, c31; };
template <int MODE>
__device__ __forceinline__ void maskbias(f32x4& s, int kpos, int tcol, bool colok, const BiasCtx& B) {
    if (MODE == MD_MEM) return;
#pragma unroll
    for (int i = 0; i < 4; ++i) {
        int dist; bool ok;
        if (MODE == MD_CMP) { dist = tcol - 31 - 16 * (kpos + i); ok = dist >= 0; }
        else if (MODE == MD_WIN) { dist = tcol - (kpos + i); ok = (unsigned)dist <= 511u; }
        else { dist = tcol - (kpos + i); ok = dist >= 0; }
        int dc = dist < 0 ? 0 : dist; dc = dc > 1023 ? 1023 : dc;
        const float tb = __uint_as_float((unsigned)B.tb[dc * 6] << 16);
        float bias = tb;
        if (MODE != MD_WIN) { const float far = B.c31 + (dist < 1513 ? B.d30 : 0.f) + (dist < 1117 ? B.d29 : 0.f); bias = dist < 1024 ? tb : far; }
        s[i] = (ok && colok) ? s[i] + bias : -INFINITY;
    }
}
__device__ __forceinline__ float colmax(const f32x4& sa, const f32x4& sb) {
    float mx = fmaxf(fmaxf(fmaxf(sa[0], sa[1]), fmaxf(sa[2], sa[3])), fmaxf(fmaxf(sb[0], sb[1]), fmaxf(sb[2], sb[3])));
    mx = fmaxf(mx, __shfl_xor(mx, 16)); mx = fmaxf(mx, __shfl_xor(mx, 32)); return mx;
}
constexpr float SM_THR = 8.f;
__device__ __forceinline__ float lmax8(const f32x4& sa, const f32x4& sb) { return fmaxf(fmaxf(fmaxf(sa[0], sa[1]), fmaxf(sa[2], sa[3])), fmaxf(fmaxf(sb[0], sb[1]), fmaxf(sb[2], sb[3]))); }
__device__ __forceinline__ int imax3(int a, int b, int c) { return max(max(a, b), c); }
__device__ __forceinline__ int imax16(const f32x4& a, const f32x4& b, const f32x4& c, const f32x4& d) {
#define FI_(x) __float_as_int(x)
    const int t0 = imax3(FI_(a[0]), FI_(a[1]), FI_(a[2])), t1 = imax3(FI_(a[3]), FI_(b[0]), FI_(b[1])), t2 = imax3(FI_(b[2]), FI_(b[3]), FI_(c[0])), t3 = imax3(FI_(c[1]), FI_(c[2]), FI_(c[3])), t4 = imax3(FI_(d[0]), FI_(d[1]), FI_(d[2]));
    return max(imax3(t0, t1, FI_(d[3])), imax3(t2, t3, t4));
#undef FI_
}
template <int NO>
__device__ __forceinline__ void sm_rescale(float lm, float& m, float& l, f32x4 (&O)[NO]) {
    if (__any(lm > m + SM_THR)) {
        lm = fmaxf(lm, __shfl_xor(lm, 16)); lm = fmaxf(lm, __shfl_xor(lm, 32));
        const float mn = fmaxf(m, lm); const float al = __builtin_amdgcn_exp2f(m - mn); m = mn; l *= al;
#pragma unroll
        for (int dt = 0; dt < NO; ++dt) O[dt] = O[dt] * al;
    }
}
__device__ __forceinline__ bf16x8 sm_update(const f32x4& sa, const f32x4& sb, float& m, float& l, f32x4 (&O)[4]) {
    sm_rescale<4>(lmax8(sa, sb), m, l, O);
    f32x4 pa, pb; float sum = 0.f;
#pragma unroll
    for (int i = 0; i < 4; ++i) { pa[i] = __builtin_amdgcn_exp2f(sa[i] - m); pb[i] = __builtin_amdgcn_exp2f(sb[i] - m); sum += pa[i] + pb[i]; }
    l += sum;
    return pack8(pa, pb);
}
__device__ __forceinline__ void sm_update64(const f32x4& sa0, const f32x4& sb0, const f32x4& sa1, const f32x4& sb1, float& m, float& l, f32x4 (&O)[4], bf16x8& pf0, bf16x8& pf1) {
    sm_rescale<4>(fmaxf(lmax8(sa0, sb0), lmax8(sa1, sb1)), m, l, O);
    f32x4 pa0, pb0, pa1, pb1; float sum = 0.f;
#pragma unroll
    for (int i = 0; i < 4; ++i) { pa0[i] = __builtin_amdgcn_exp2f(sa0[i] - m); pb0[i] = __builtin_amdgcn_exp2f(sb0[i] - m); pa1[i] = __builtin_amdgcn_exp2f(sa1[i] - m); pb1[i] = __builtin_amdgcn_exp2f(sb1[i] - m);
        sum += (pa0[i] + pb0[i]) + (pa1[i] + pb1[i]); }
    l += sum;
    pf0 = pack8(pa0, pb0); pf1 = pack8(pa1, pb1);
}
enum { BK_FAR = 0, BK_MID = 1, BK_GEN = 2, BK_FARF = 3 };
template <int MD, int CLS>
__device__ __forceinline__ void step64(const KF& k0, const KF& k1, const bf16x8 (&q)[2], int cls, int kpos, int tcol, bool colok, const BiasCtx& B,
                                       float& m, float& l, f32x4 (&O)[4], bf16x8& pf0, bf16x8& pf1) {
    const bool has = m > -1e29f; const float mref = has ? m : 0.f;
    if (CLS >= 0) cls = CLS;
    float cin = ((cls == BK_FAR) ? B.c31 : 0.f) - mref; if (!colok) cin = -INFINITY;
    const f32x4 c4 = {cin, cin, cin, cin};
    f32x4 sa0 = MFMA16(k0.a0, q[0], c4), sb0 = MFMA16(k0.b0, q[0], c4), sa1 = MFMA16(k1.a0, q[0], c4), sb1 = MFMA16(k1.b0, q[0], c4);
    sa0 = MFMA16(k0.a1, q[1], sa0); sb0 = MFMA16(k0.b1, q[1], sb0); sa1 = MFMA16(k1.a1, q[1], sa1); sb1 = MFMA16(k1.b1, q[1], sb1);
    if (cls == BK_MID) {
        const LAS unsigned short* tl = B.tb + (tcol - kpos - 39) * 6; asm("" : "+v"(tl));
#pragma unroll
        for (int i = 0; i < 4; ++i) { sa0[i] += __uint_as_float((unsigned)tl[6 * (39 - i)] << 16); sb0[i] += __uint_as_float((unsigned)tl[6 * (35 - i)] << 16);
            sa1[i] += __uint_as_float((unsigned)tl[6 * (7 - i)] << 16); sb1[i] += __uint_as_float((unsigned)tl[6 * (3 - i)] << 16); }
    } else if (CLS == BK_FARF) {
        const int d0 = tcol - kpos;
#pragma unroll
        for (int i = 0; i < 4; ++i) {
            { const int d = d0 - i;      sa0[i] += B.c31 + (d < 1513 ? B.d30 : 0.f) + (d < 1117 ? B.d29 : 0.f); }
            { const int d = d0 - 4 - i;  sb0[i] += B.c31 + (d < 1513 ? B.d30 : 0.f) + (d < 1117 ? B.d29 : 0.f); }
            { const int d = d0 - 32 - i; sa1[i] += B.c31 + (d < 1513 ? B.d30 : 0.f) + (d < 1117 ? B.d29 : 0.f); }
            { const int d = d0 - 36 - i; sb1[i] += B.c31 + (d < 1513 ? B.d30 : 0.f) + (d < 1117 ? B.d29 : 0.f); } }
    } else if (cls == BK_GEN) {
        maskbias<MD>(sa0, kpos, tcol, true, B); maskbias<MD>(sb0, kpos + 4, tcol, true, B); maskbias<MD>(sa1, kpos + 32, tcol, true, B); maskbias<MD>(sb1, kpos + 36, tcol, true, B);
    }
    if (__any((imax16(sa0, sb0, sa1, sb1) > __float_as_int(SM_THR)) || !has)) {
        float lm = fmaxf(lmax8(sa0, sb0), lmax8(sa1, sb1));
        lm = fmaxf(lm, __shfl_xor(lm, 16)); lm = fmaxf(lm, __shfl_xor(lm, 32));
        const bool upd = (lm > -INFINITY) && (!has || lm > 0.f); const float dl = upd ? lm : 0.f;
        if (upd) m = mref + dl;
        const float f = has ? __builtin_amdgcn_exp2f(-dl) : 1.f; l *= f;
#pragma unroll
        for (int dt = 0; dt < 4; ++dt) O[dt] = O[dt] * f;
#pragma unroll
        for (int i = 0; i < 4; ++i) { sa0[i] -= dl; sb0[i] -= dl; sa1[i] -= dl; sb1[i] -= dl; }
    }
    f32x4 pa0, pb0, pa1, pb1; float sum = 0.f;
#pragma unroll
    for (int i = 0; i < 4; ++i) { pa0[i] = __builtin_amdgcn_exp2f(sa0[i]); pb0[i] = __builtin_amdgcn_exp2f(sb0[i]); pa1[i] = __builtin_amdgcn_exp2f(sa1[i]); pb1[i] = __builtin_amdgcn_exp2f(sb1[i]);
        sum += (pa0[i] + pb0[i]) + (pa1[i] + pb1[i]); }
    l += sum;
    pf0 = pack8(pa0, pb0); pf1 = pack8(pa1, pb1);
}
__device__ __forceinline__ void pv(f32x4 (&O)[4], const VF& v, const bf16x8& pf) {
#pragma unroll
    for (int dt = 0; dt < 4; ++dt) O[dt] = MFMA16(v.v[dt], pf, O[dt]);
}
__device__ __forceinline__ void lds_fadd(LAS float* p, float v) { (void)__hip_atomic_fetch_add((float*)p, v, __ATOMIC_RELAXED, __HIP_MEMORY_SCOPE_WORKGROUP); }
#define DPP_I(x, ctrl) __builtin_amdgcn_update_dpp((x), (x), (ctrl), 0xf, 0xf, false)
#define DPP_F(x, ctrl) __int_as_float(__builtin_amdgcn_update_dpp(__float_as_int(x), __float_as_int(x), (ctrl), 0xf, 0xf, false))
__device__ __forceinline__ float sum8_dpp(float v) { v += DPP_F(v, 0xB1); v += DPP_F(v, 0x4E); v += DPP_F(v, 0x141); return v; }
__device__ __forceinline__ unsigned wave_iscan_u32(unsigned x) {
#define DPP_Z(v, ctrl, rmask) (unsigned)__builtin_amdgcn_update_dpp(0, (int)(v), (ctrl), (rmask), 0xf, false)
    x += DPP_Z(x, 0x111, 0xf); x += DPP_Z(x, 0x112, 0xf); x += DPP_Z(x, 0x114, 0xf); x += DPP_Z(x, 0x118, 0xf); x += DPP_Z(x, 0x142, 0xa); x += DPP_Z(x, 0x143, 0xc);
#undef DPP_Z
    return x; }
__device__ __forceinline__ int wmax64_i(int x) {
    x = max(x, DPP_I(x, 0xB1)); x = max(x, DPP_I(x, 0x4E)); x = max(x, DPP_I(x, 0x141)); x = max(x, DPP_I(x, 0x140));
    return max(max(__builtin_amdgcn_readlane(x, 0), __builtin_amdgcn_readlane(x, 16)), max(__builtin_amdgcn_readlane(x, 32), __builtin_amdgcn_readlane(x, 48))); }
__device__ __forceinline__ float kqsum(float v) { v += __shfl_xor(v, 16); v += __shfl_xor(v, 32); return v; }
__device__ __forceinline__ float wmax64(float v) {
#pragma unroll
    for (int o = 1; o < 64; o <<= 1) v = fmaxf(v, __shfl_xor(v, o));
    return v;
}
__device__ __forceinline__ void out_add(LAS unsigned short* OUTw, int p, int n, int kq, const f32x4 (&O)[4], float scale, bool first) {
    const int q = 2 * p + (n >> 3), hd = n & 7;
    if (hd < 6) { LAS v2u* dst = (LAS v2u*)(OUTw + (q * 6 + hd) * 64) + kq;
#pragma unroll
        for (int dt = 0; dt < 4; ++dt) { f32x4 v = O[dt] * scale; if (!first) { const v2u o = dst[4 * dt]; v[0] += __uint_as_float(o.x << 16); v[1] += __uint_as_float(o.x & 0xffff0000u); v[2] += __uint_as_float(o.y << 16); v[3] += __uint_as_float(o.y & 0xffff0000u); }
            dst[4 * dt] = (v2u){pk2(v[0], v[1]), pk2(v[2], v[3])}; } }
}

__device__ __forceinline__ void p2_mfma(Frame& F, const In& I, unsigned char* ws) {
    OPAQUE_TID(); KARGS(); const int lane = tid_ & 63, wave = __builtin_amdgcn_readfirstlane(tid_ >> 6), r = lane & 15, kq = lane >> 4;
    const bf16* KV0 = (const bf16*)(ws + WS_KV0); const bf16* W1T = (const bf16*)(ws + WS_W1T); const bf16* W2T = (const bf16*)(ws + WS_W2T); const float* B1F = (const float*)(ws + WS_B1F);
    const bf16* MEMN = (const bf16*)(ws + WS_MEMN); const bf16* WMKT = (const bf16*)(ws + WS_WMKT);
    bf16* KCB = (bf16*)(ws + WS_KCB); bf16* VCT = (bf16*)(ws + WS_VCT); bf16* MKB = (bf16*)(ws + WS_MKB); bf16* MVT = (bf16*)(ws + WS_MVT);
    LAS unsigned char* aim = F.lds + RING_OFF;
    LAS unsigned char* hid = F.lds + RING_OFF + RING_BYTES;
    for (int u = blockIdx.x; u < 192; u += F.G) {
        const bool cmp = u < 128;
        const bf16* bp[2]; int K, kjump;
        int kv = 0, bg = 0, n0 = 0, lay = 0, m0 = 0, ch = 0;
        if (cmp) { kv = u >> 6; bg = (u >> 4) & 3; n0 = (u & 15) * 32; K = 2048; kjump = 512 - 64;
#pragma unroll
            for (int ct = 0; ct < 2; ++ct) bp[ct] = W1T + (size_t)(kv * 256 + 32 * wave + 16 * ct + r) * 2048 + 8 * kq;
        } else { const int v = u - 128; lay = v >> 5; m0 = ((v >> 1) & 15) * 32; ch = v & 1; K = 1024; kjump = 0;
#pragma unroll
            for (int ct = 0; ct < 2; ++ct) bp[ct] = WMKT + (size_t)(lay * 512 + ch * 256 + 32 * wave + 16 * ct + r) * 1024 + 8 * kq;
        }
        { const int nins = (K >> 6) * 4;
          for (int i = wave; i < nins; i += NWAVES) { const int seg = 8 * i + (lane >> 3), c = lane & 7, sblk = seg >> 5, row = seg & 31;
              const bf16* arow; if (cmp) { const int b = bg >> 1, g = bg & 1; int nn = n0 + row; nn = nn > 510 ? 510 : nn; arow = KV0 + (size_t)(b * T + 16 * nn) * 512 + kv * 128 + g * 64; }
              else arow = MEMN + (size_t)(lay * 512 + m0 + row) * 1024;
              __builtin_amdgcn_global_load_lds((const unsigned*)(arow + 64 * sblk + sblk * kjump + 8 * (c ^ (row & 7))), (LAS unsigned*)(aim + i * 1024), 16, 0, 0); }
          asm volatile("s_waitcnt vmcnt(0)" ::: "memory"); __syncthreads(); }
        f32x4 acc[2][2];
#pragma unroll
        for (int rt = 0; rt < 2; ++rt)
#pragma unroll
            for (int ct = 0; ct < 2; ++ct) acc[rt][ct] = (f32x4){0.f, 0.f, 0.f, 0.f};
        { int r_ = r, kq_ = kq; asm volatile("" : "+v"(r_), "+v"(kq_));
          bf16x8 bb[2][2], bn[2][2];
#define P2_LOADB(B_, kb_) do { const int kbl_ = (kb_) < K ? (kb_) : K - 64; \
            _Pragma("unroll") for (int h2 = 0; h2 < 2; ++h2) _Pragma("unroll") for (int ct = 0; ct < 2; ++ct) B_[ct][h2] = *(const GAS bf16x8*)(bp[ct] + kbl_ + 32 * h2); } while (0)
#define P2_MM(B_, kb_) do { const LAS unsigned char* as_ = aim + ((kb_) >> 6) * 4096; \
            _Pragma("unroll") for (int h2 = 0; h2 < 2; ++h2) _Pragma("unroll") for (int rt = 0; rt < 2; ++rt) { const int row_ = 16 * rt + r_; \
                const bf16x8 av_ = *(const LAS bf16x8*)(as_ + row_ * 128 + (((4 * h2 + kq_) ^ (row_ & 7)) << 4)); \
                _Pragma("unroll") for (int ct = 0; ct < 2; ++ct) acc[rt][ct] = MFMA16(av_, B_[ct][h2], acc[rt][ct]); } } while (0)
          P2_LOADB(bb, 0);
          for (int kb = 0; kb < K; kb += 128) {
              P2_LOADB(bn, kb + 64); P2_MM(bb, kb);
              P2_LOADB(bb, kb + 128); P2_MM(bn, kb + 64);
          }
#undef P2_LOADB
#undef P2_MM
        }
        if (cmp) {
#pragma unroll
            for (int ct = 0; ct < 2; ++ct) { const int col = 32 * wave + 16 * ct + r; const float bias = (kv ? Ip->v_b1 : Ip->k_b1)[col] + ((B1F[(kv * 4 + 0) * 256 + col] + B1F[(kv * 4 + 1) * 256 + col]) + (B1F[(kv * 4 + 2) * 256 + col] + B1F[(kv * 4 + 3) * 256 + col]));
#pragma unroll
                for (int rt = 0; rt < 2; ++rt)
#pragma unroll
                    for (int i = 0; i < 4; ++i) { const float xg = acc[rt][ct][i] + bias; const float hv = 0.5f * xg * (1.f + tanhf(0.7978845608028654f * (xg + 0.044715f * xg * xg * xg)));
                        *(LAS unsigned short*)(hid + (16 * rt + 4 * kq + i) * 528 + 2 * col) = (unsigned short)f2bf(hv); } }
            __syncthreads();
            { const int rt2 = wave >> 2, ct2 = wave & 3; f32x4 o = {0.f, 0.f, 0.f, 0.f};
              const bf16* w2p = W2T + (size_t)(kv * 64 + 16 * ct2 + r) * 256 + 8 * kq;
#pragma unroll
              for (int ks = 0; ks < 8; ++ks) { const bf16x8 av = *(const LAS bf16x8*)(hid + (16 * rt2 + r) * 528 + 64 * ks + 16 * kq); o = MFMA16(av, ldg16(w2p + 32 * ks), o); }
              const int d = 16 * ct2 + r; const float b2v = (kv ? Ip->v_b2 : Ip->k_b2)[d];
#pragma unroll
              for (int i = 0; i < 4; ++i) { const int nn = n0 + 16 * rt2 + 4 * kq + i; const unsigned short ov = (nn < NCMP) ? (unsigned short)f2bf(o[i] + b2v) : (unsigned short)0;
                  if (kv) VCT[(size_t)(bg * 64 + d) * 512 + nn] = ov; else KCB[(size_t)(bg * 512 + nn) * 64 + d] = ov; } }
            __syncthreads();
        } else {
#pragma unroll
            for (int ct = 0; ct < 2; ++ct) { const int col = 32 * wave + 16 * ct + r;
#pragma unroll
                for (int rt = 0; rt < 2; ++rt)
#pragma unroll
                    for (int i = 0; i < 4; ++i) { const int mrow = m0 + 16 * rt + 4 * kq + i; const unsigned short ov = (unsigned short)f2bf(acc[rt][ct][i]);
                        if (ch == 0) MKB[(size_t)(lay * 512 + mrow) * 256 + col] = ov; else MVT[(size_t)(lay * 256 + col) * 512 + mrow] = ov; } }
            __syncthreads();
        }
    }
}

template <int MODE>
__device__ __forceinline__ void mb2(f32x4& sa, f32x4& sb, int kpos, int tcol, bool colok, bool fast, const BiasCtx& B) {
    if (fast) { if (colok) { sa = sa + B.c31; sb = sb + B.c31; } else { sa = (f32x4){-INFINITY, -INFINITY, -INFINITY, -INFINITY}; sb = sa; } }
    else { maskbias<MODE>(sa, kpos, tcol, colok, B); maskbias<MODE>(sb, kpos + 4, tcol, colok, B); }
}
#define SWZ(row) (((((row) >> 3) & 3) << 1) | (((row) >> 1) & 1))
struct KV1 { KF k; VF v; };
__device__ __forceinline__ void load_kv(KV1& d, const bf16* kb, int kstride, const bf16* vt, int vstride, int key0, int r, int kq) { load_k(d.k, kb, kstride, key0, r, kq); load_vt(d.v, vt, vstride, key0, r, kq); }

template <int MD, int FORCE = 0>
__device__ __forceinline__ void nsa_sweep(LAS unsigned char* STG, const bf16* ksb, const bf16* vst, int jlo, int jhi, int qt, const LAS unsigned* WMw, int wave, int lane, int r, int kq, int qsel, int t0w,
                                          const bf16x8 (&qf)[4][2], const BiasCtx& BC, float (&m)[4], float (&l)[4], f32x4 (&O)[4][4],
                                          int kstr = 512, int kblk = 64 * 512, int vstr = 64, int vblk = 16384) {
            const int srow = 8 * wave + (lane >> 3), sch = (lane & 7) ^ SWZ(srow);
            const bf16* ksrc = ksb + (size_t)srow * kstr + 8 * sch; const bf16* vsrc = vst + (size_t)srow * vstr + 8 * sch;
#define NSA_DMA(jb) do { LAS unsigned char* d_ = STG + ((jb) % 6) * 16384 + wave * 1024; \
                __builtin_amdgcn_global_load_lds((const unsigned*)(ksrc + (size_t)(jb) * kblk), (LAS unsigned*)d_, 16, 0, 0); \
                __builtin_amdgcn_global_load_lds((const unsigned*)(vsrc + (size_t)(jb) * vblk), (LAS unsigned*)(d_ + 8192), 16, 0, 0); } while (0)
#define NSA_WAITV(n_) do { if ((n_) >= 4) asm volatile("s_waitcnt vmcnt(4) lgkmcnt(0)" ::: "memory"); else if ((n_) == 2) asm volatile("s_waitcnt vmcnt(2) lgkmcnt(0)" ::: "memory"); else asm volatile("s_waitcnt vmcnt(0) lgkmcnt(0)" ::: "memory"); } while (0)
            { const int nb = jhi - jlo + 1;
#pragma unroll
              for (int i = 0; i < 4; ++i) if (i < nb) NSA_DMA(jlo + i);
              const int issued = nb < 4 ? nb : 4, need = nb < 2 ? nb : 2; NSA_WAITV(2 * (issued - need)); }
            __builtin_amdgcn_s_barrier();
#define NSA_TILES(CLS_) _Pragma("unroll") for (int p = 0; p < 4; ++p) if (m8 & (3u << (2 * p))) { \
                        bf16x8 pf0, pf1; \
                        step64<MD, CLS_>(k0, k1, qf[p], cls, 64 * j + 8 * kq_, t0w + 2 * p + qs_, ((m8 >> (2 * p + qs_)) & 1u) != 0u, BC, m[p], l[p], O[p], pf0, pf1); \
                        pv(O[p], v0, pf0); pv(O[p], v1, pf1); \
                        __builtin_amdgcn_sched_barrier(0); }
            auto tiles = [&](auto clsx, int j) __attribute__((always_inline)) { constexpr int CLSX = decltype(clsx)::value;
                const LAS unsigned char* sk = STG + (j % 6) * 16384; const LAS unsigned char* sv = sk + 8192;
                unsigned m8 = 0xffu; if (WMw) m8 = (unsigned)__builtin_amdgcn_readfirstlane((int)((WMw[j >> 2] >> (8 * (j & 3))) & 0xffu)); if (FORCE == 1) m8 = 0u; if (FORCE == 2) m8 = 0xffu; if (MD == MD_MEM) m8 = 3u; else asm volatile("" : "+s"(m8));
                if (m8) {
                    int r_ = r, kq_ = kq, qs_ = qsel; asm volatile("" : "+v"(r_), "+v"(kq_), "+v"(qs_));
                    const int dj = qt - j; const int cls = (MD == MD_MEM) ? BK_FAR : (MD == MD_WIN) ? ((dj >= 1 && dj <= 7) ? BK_MID : BK_GEN) : ((64 * dj - 63 >= 1513) ? BK_FAR : ((dj >= 1 && dj <= 15) ? BK_MID : BK_GEN));
                    KF k0, k1;
                    { const int ka = 8 * (r_ >> 2) + (r_ & 3), kb2 = ka + 4, kc = ka + 32, kd = ka + 36;
                      k0.a0 = *(const LAS bf16x8*)(sk + ka * 128 + ((kq_ ^ SWZ(ka)) << 4)); k0.a1 = *(const LAS bf16x8*)(sk + ka * 128 + (((4 + kq_) ^ SWZ(ka)) << 4));
                      k0.b0 = *(const LAS bf16x8*)(sk + kb2 * 128 + ((kq_ ^ SWZ(kb2)) << 4)); k0.b1 = *(const LAS bf16x8*)(sk + kb2 * 128 + (((4 + kq_) ^ SWZ(kb2)) << 4));
                      k1.a0 = *(const LAS bf16x8*)(sk + kc * 128 + ((kq_ ^ SWZ(kc)) << 4)); k1.a1 = *(const LAS bf16x8*)(sk + kc * 128 + (((4 + kq_) ^ SWZ(kc)) << 4));
                      k1.b0 = *(const LAS bf16x8*)(sk + kd * 128 + ((kq_ ^ SWZ(kd)) << 4)); k1.b1 = *(const LAS bf16x8*)(sk + kd * 128 + (((4 + kq_) ^ SWZ(kd)) << 4)); }
                    VF v0, v1;
#pragma unroll
                    for (int dt = 0; dt < 4; ++dt) { const int dd = 16 * dt + r_; v0.v[dt] = *(const LAS bf16x8*)(sv + dd * 128 + ((kq_ ^ SWZ(dd)) << 4)); v1.v[dt] = *(const LAS bf16x8*)(sv + dd * 128 + (((4 + kq_) ^ SWZ(dd)) << 4)); }
                    NSA_TILES(CLSX)
                }
            };
            int ni = 0;
            auto blk = [&](auto clsx, int j) __attribute__((always_inline)) {
                const bool head = ((j - jlo) & 1) == 0;
                if (head) { ni = 0; if (j + 4 <= jhi) { NSA_DMA(j + 4); ni += 2; } if (j + 5 <= jhi) { NSA_DMA(j + 5); ni += 2; } }
                tiles(clsx, j);
                if (!head || j == jhi) { NSA_WAITV(ni); __builtin_amdgcn_s_barrier(); }
            };
            int j = jlo;
            if (MD == MD_BLK || MD == MD_MEM) { const int jfar = (MD == MD_MEM) ? jhi : ((qt - 25 < jhi) ? qt - 25 : jhi); const int jfe = jlo + (((jfar - jlo + 1) >> 1) << 1) - 1;
                for (; j <= jfe; ++j) blk(std::integral_constant<int, BK_FAR>{}, j); }
            if (MD == MD_BLK) {
                const int jf2 = (qt - 17 < jhi) ? qt - 17 : jhi; const int jfe2 = jlo + (((jf2 - jlo + 1) >> 1) << 1) - 1;
                for (; j <= jfe2; ++j) blk(std::integral_constant<int, BK_FARF>{}, j); }
            for (; j <= jhi; ++j) blk(std::integral_constant<int, -1>{}, j);
#undef NSA_WAITV
#undef NSA_TILES
#undef NSA_DMA
}
__device__ __forceinline__ void p3_nsa_mfma(Frame& F, const In& I, unsigned char* ws) {
    OPAQUE_TID(); KARGS(); const int wave = __builtin_amdgcn_readfirstlane(tid_ >> 6);
    LAS float* b12 = (LAS float*)(F.lds + TAB_B12);
    LAS unsigned short* OUTw = (LAS unsigned short*)(F.lds + NSA_OUT) + wave * 3072;
    LAS float* PSw = (LAS float*)(F.lds + NSA_PSQ) + wave * 1024;
    LAS unsigned char* STG = F.lds + NSA_PSQ;
    LAS unsigned* WMw = (LAS unsigned*)(F.lds + NSA_ST) + wave * 32;
    for (int i = tid_; i < 512; i += NWAVES * 64) b12[i] = ((i & 15) < 12) ? Ip->rel_bias[(i >> 4) * 12 + (i & 15)] * LOG2E : 0.f;
    LAS unsigned short* TB = (LAS unsigned short*)(F.lds + NSA_TB);
    { const int gg = (int)blockIdx.x & 1;
      for (int i = tid_; i < 6144; i += NWAVES * 64) { const int dd = i / 6, hh = i % 6; TB[i] = (unsigned short)f2bf(Ip->rel_bias[rel_bucket(dd) * 12 + gg * 6 + hh] * LOG2E); } }
    __syncthreads();
    const bf16* Q0 = (const bf16*)(ws + WS_Q0); const bf16* KV0 = (const bf16*)(ws + WS_KV0); const bf16* QM = (const bf16*)(ws + WS_QM); const bf16* G0 = (const bf16*)(ws + WS_G0);
    const bf16* VT = (const bf16*)(ws + WS_VT); const bf16* KCB = (const bf16*)(ws + WS_KCB); const bf16* VCT = (const bf16*)(ws + WS_VCT);
    const bf16* MKB = (const bf16*)(ws + WS_MKB); const bf16* MVT = (const bf16*)(ws + WS_MVT);
    bf16* CAT = (bf16*)(ws + WS_CAT);
    const int nun = 4 * 128;
    for (int ui = blockIdx.x; ui < nun; ui += F.G) {
        int tl_ = tid_; asm volatile("" : "+v"(tl_));
        const int lane = tl_ & 63, n = lane & 15, kq = lane >> 4, r = n, hd = n & 7, qsel = n >> 3; const bool colv = hd < 6;
        int bg, qt;
        bg = blockIdx.x & 3;
        if (F.G == 256) { const int idx = blockIdx.x >> 2; qt = (ui < 256) ? idx : 127 - idx; }
        else { qt = ui >> 2; if ((ui & 3) != bg) continue; }
        const int b = bg >> 1, g = bg & 1, t0w = 64 * qt + 8 * wave, rowb = b * T;
        const int habs = g * 6 + (colv ? hd : 0);
        const LAS float* b12c = b12 + habs; const BiasCtx BC{TB + (colv ? hd : 0), b12c[29 * 16] - b12c[30 * 16], b12c[30 * 16] - b12c[31 * 16], b12c[31 * 16]};

        bf16x8 qf[4][2];
#pragma unroll
        for (int p = 0; p < 4; ++p) { const bf16* qp = Q0 + (size_t)(rowb + t0w + 2 * p + qsel) * 768 + habs * 64 + 8 * kq;
#pragma unroll
            for (int ks = 0; ks < 2; ++ks) { bf16x8 v = ldg16(qp + 32 * ks); if (!colv) v = (bf16x8){0, 0, 0, 0, 0, 0, 0, 0}; qf[p][ks] = v; } }
        float m[4], l[4]; f32x4 O[4][4];
        if (PROBE_REP == 6 || PROBE_REP == 7) {
            const bf16* ksb_ = KV0 + (size_t)rowb * 512 + 256 + g * 64; const bf16* vst_ = VT + ((size_t)(rowb >> 6) * 256 + g * 64) * 64;
#pragma unroll
            for (int p = 0; p < 4; ++p) { m[p] = -1e30f; l[p] = 0.f;
#pragma unroll
                for (int dt = 0; dt < 4; ++dt) O[p][dt] = (f32x4){0.f, 0.f, 0.f, 0.f}; }
            __syncthreads();
            nsa_sweep<MD_BLK, (PROBE_REP == 6 ? 2 : 1)>(STG, ksb_, vst_, 0, qt, qt, WMw, wave, lane, r, kq, qsel, t0w, qf, BC, m, l, O);
            float* dump = (float*)(ws + WS_OCS) + ((size_t)blockIdx.x * 512 + tid_) * 4;
#pragma unroll
            for (int p = 0; p < 4; ++p) dump[p] = l[p] + O[p][0][0] + O[p][1][1] + O[p][2][2] + O[p][3][3];
            __syncthreads(); }
        for (int i = lane; i < 1024; i += 64) PSw[i] = 0.f;
        const int ncmax = (t0w + 7 >= 31) ? ((t0w + 7 - 31) / 16 + 1) : 0;
        const bf16* kcb = KCB + (size_t)(bg * 512) * 64; const bf16* vct = VCT + (size_t)(bg * 64) * 512;
#pragma unroll
        for (int p = 0; p < 4; ++p) { m[p] = -1e30f; l[p] = 0.f; }
        if (ncmax > 0) {
            int r_ = r, kq_ = kq; asm volatile("" : "+v"(r_), "+v"(kq_));
            for (int key0 = 0; key0 < ncmax; key0 += 32) {
                asm volatile("" : "+v"(r_), "+v"(kq_));
                KF kA; load_k(kA, kcb, 64, key0, r_, kq_);
                const bool fast = (t0w - 31 - 16 * (key0 + 31)) >= 1513;
#pragma unroll
                for (int p = 0; p < 4; ++p) { f32x4 sa, sb; qk(sa, sb, kA, qf[p]); const int tcol = t0w + 2 * p + qsel;
                    mb2<MD_CMP>(sa, sb, key0 + 8 * kq_, tcol, true, fast, BC);
                    const float mn = fmaxf(m[p], lmax8(sa, sb)); float sum = 0.f;
#pragma unroll
                    for (int i = 0; i < 4; ++i) sum += __builtin_amdgcn_exp2f(sa[i] - mn) + __builtin_amdgcn_exp2f(sb[i] - mn);
                    l[p] = l[p] * __builtin_amdgcn_exp2f(m[p] - mn) + sum; m[p] = mn; __builtin_amdgcn_sched_barrier(0); }
            }
        }
        float invl[4];
#pragma unroll
        for (int p = 0; p < 4; ++p) { float mc = m[p]; mc = fmaxf(mc, __shfl_xor(mc, 16)); mc = fmaxf(mc, __shfl_xor(mc, 32));
            const float lt = kqsum(l[p] * __builtin_amdgcn_exp2f(m[p] - mc)); m[p] = mc; invl[p] = lt > 0.f ? 1.f / lt : 0.f; }
#pragma unroll
        for (int p = 0; p < 4; ++p)
#pragma unroll
            for (int dt = 0; dt < 4; ++dt) O[p][dt] = (f32x4){0.f, 0.f, 0.f, 0.f};
        float carry[4] = {0.f, 0.f, 0.f, 0.f};
        if (ncmax > 0) {
            int r_ = r, kq_ = kq; asm volatile("" : "+v"(r_), "+v"(kq_));
            for (int key0 = 0; key0 < ncmax; key0 += 32) {
                asm volatile("" : "+v"(r_), "+v"(kq_));
                KV1 A; load_kv(A, kcb, 64, vct, 512, key0, r_, kq_);
                const bool fast = (t0w - 31 - 16 * (key0 + 31)) >= 1513;
#pragma unroll
                for (int p = 0; p < 4; ++p) { f32x4 sa, sb; qk(sa, sb, A.k, qf[p]); const int tcol = t0w + 2 * p + qsel;
                    mb2<MD_CMP>(sa, sb, key0 + 8 * kq_, tcol, true, fast, BC);
                    f32x4 pa, pb;
#pragma unroll
                    for (int i = 0; i < 4; ++i) { pa[i] = __builtin_amdgcn_exp2f(sa[i] - m[p]) * invl[p]; pb[i] = __builtin_amdgcn_exp2f(sb[i] - m[p]) * invl[p]; }
                    pv(O[p], A.v, pack8(pa, pb));
                    float wA = (pa[0] + pa[1]) + (pa[2] + pa[3]), wB = pa[3] + ((pb[0] + pb[1]) + (pb[2] + pb[3])), wC = pb[3];
                    if (!colv) { wA = 0.f; wB = 0.f; wC = 0.f; }
                    const float up = __shfl(wC, (lane + 48) & 63);
                    const float prevC = (kq == 0) ? carry[p] : up; carry[p] = up;
                    float a0 = wA + prevC, a1 = wB;
                    a0 = sum8_dpp(a0); a1 = sum8_dpp(a1);
                    if (hd == 0) { LAS float* ps = PSw + (2 * p + qsel) * 128 + (key0 >> 2) + 2 * kq; ps[0] = a0; ps[1] = a1; } __builtin_amdgcn_sched_barrier(0); }
            }
        }
        if (ncmax > 0 && ncmax <= 480) {
            const int jn = ((ncmax + 31) >> 5) * 8;
#pragma unroll
            for (int p = 0; p < 4; ++p) { float a0 = sum8_dpp(carry[p]); if (hd == 0 && kq == 0) PSw[(2 * p + qsel) * 128 + jn] = a0; }
        }
        {
#pragma unroll
            for (int p = 0; p < 4; ++p) { const size_t row = (size_t)(rowb + t0w + 2 * p + qsel);
                const float gz = bf2f(G0[row * 256 + habs * 3 + 0]) + Ip->nsa_gate_b[habs * 3 + 0]; out_add(OUTw, p, n, kq, O[p], 1.f / (1.f + __expf(-gz)), true); }
        }
        for (int i = lane; i < 32; i += 64) WMw[i] = (qt < 16) ? 0xffffffffu : 0u;
        if (qt >= 16) {
            if (lane < 3) { const int j = lane == 0 ? 0 : qt - 2 + lane; atomicOr((unsigned*)&WMw[j >> 2], 0xffu << (8 * (j & 3))); }
            for (int q = 0; q < 8; ++q) {
                int v0 = __float_as_int(PSw[q * 128 + lane] + 0.f), v1 = __float_as_int(PSw[q * 128 + 64 + lane] + 0.f);
                if (lane < 1 || lane > qt - 2) v0 = __float_as_int(-1.f); if (lane + 64 > qt - 2) v1 = __float_as_int(-1.f);
                for (int s = 0; s < 13; ++s) { const int mx = wmax64_i(max(v0, v1));
                    const unsigned long long b0 = __ballot(v0 == mx); int j;
                    if (b0) { j = __builtin_ctzll(b0); if (lane == j) v0 = __float_as_int(-1.f); } else { const unsigned long long b1 = __ballot(v1 == mx); j = __builtin_ctzll(b1); if (lane == j) v1 = __float_as_int(-1.f); j += 64; }
                    if (lane == 0) atomicOr((unsigned*)&WMw[j >> 2], 1u << (8 * (j & 3) + q)); }
            }
        }
        const bf16* ksb = KV0 + (size_t)rowb * 512 + 256 + g * 64; const bf16* vst = VT + ((size_t)(rowb >> 6) * 256 + g * 64) * 64;
        __syncthreads();
#pragma unroll 1
        for (int rep_ = 0; rep_ < (PROBE_REP == 1 ? 2 : 1); ++rep_) {
#pragma unroll
            for (int p = 0; p < 4; ++p) { m[p] = -1e30f; l[p] = 0.f;
#pragma unroll
                for (int dt = 0; dt < 4; ++dt) O[p][dt] = (f32x4){0.f, 0.f, 0.f, 0.f}; }
            nsa_sweep<MD_BLK>(STG, ksb, vst, 0, qt, qt, WMw, wave, lane, r, kq, qsel, t0w, qf, BC, m, l, O);
        }
        { int qs2_ = qsel; asm volatile("" : "+v"(qs2_));
#pragma unroll
        for (int p = 0; p < 4; ++p) { const size_t row = (size_t)(rowb + t0w + 2 * p + qs2_);
            const float gz = bf2f(G0[row * 256 + habs * 3 + 1]) + Ip->nsa_gate_b[habs * 3 + 1]; out_add(OUTw, p, n, kq, O[p], (1.f / (1.f + __expf(-gz))) / kqsum(l[p]), false); } }
        const bf16* kwb = KV0 + (size_t)rowb * 512 + 384 + g * 64; const bf16* vwt = VT + ((size_t)(rowb >> 6) * 256 + 128 + g * 64) * 64;
#pragma unroll
        for (int p = 0; p < 4; ++p) { m[p] = -1e30f; l[p] = 0.f;
#pragma unroll
            for (int dt = 0; dt < 4; ++dt) O[p][dt] = (f32x4){0.f, 0.f, 0.f, 0.f}; }
        __syncthreads();
        nsa_sweep<MD_WIN>(STG, kwb, vwt, (qt >= 8) ? qt - 8 : 0, qt, qt, nullptr, wave, lane, r, kq, qsel, t0w, qf, BC, m, l, O);
        if (PROBE_REP == 4) {
#pragma unroll
            for (int p = 0; p < 4; ++p) { m[p] = -1e30f; l[p] = 0.f;
#pragma unroll
                for (int dt = 0; dt < 4; ++dt) O[p][dt] = (f32x4){0.f, 0.f, 0.f, 0.f}; }
            nsa_sweep<MD_WIN>(STG, kwb, vwt, (qt >= 8) ? qt - 8 : 0, qt, qt, nullptr, wave, lane, r, kq, qsel, t0w, qf, BC, m, l, O); }
        { int qs3_ = qsel; asm volatile("" : "+v"(qs3_));
#pragma unroll
        for (int p = 0; p < 4; ++p) { const size_t row = (size_t)(rowb + t0w + 2 * p + qs3_);
            const float gz = bf2f(G0[row * 256 + habs * 3 + 2]) + Ip->nsa_gate_b[habs * 3 + 2]; out_add(OUTw, p, n, kq, O[p], (1.f / (1.f + __expf(-gz))) / kqsum(l[p]), false); } }
        int ln_ = lane; asm volatile("" : "+v"(ln_));
#pragma unroll 1
        for (int i = 0; i < 6; ++i) { const int e = i * 64 + ln_, q = e / 48, c8 = e % 48;
            *(v4u*)(CAT + (size_t)(rowb + t0w + q) * 1024 + g * 384 + 8 * c8) = ((const LAS v4u*)OUTw)[e]; }
#pragma unroll 1
        for (int h2 = 0; h2 < 2; ++h2) { const int hm = 2 * g + h2;
            int ln2_ = lane; asm volatile("" : "+v"(ln2_)); const int nn = ln2_ & 15, kqq = ln2_ >> 4;
#pragma unroll
            for (int p = 0; p < 4; ++p) { qf[p][0] = (bf16x8){0, 0, 0, 0, 0, 0, 0, 0}; qf[p][1] = qf[p][0]; m[p] = -1e30f; l[p] = 0.f;
#pragma unroll
                for (int dt = 0; dt < 4; ++dt) O[p][dt] = (f32x4){0.f, 0.f, 0.f, 0.f}; }
            { const bf16* qp = QM + (size_t)(rowb + t0w + (nn & 7)) * 256 + hm * 64 + 8 * kqq; if (nn < 8) { qf[0][0] = ldg16(qp); qf[0][1] = ldg16(qp + 32); } }
            const BiasCtx BCm{BC.tb, 0.f, 0.f, 0.f};
            nsa_sweep<MD_MEM>(STG, MKB + (size_t)(b * 256) * 256 + hm * 64, MVT + (size_t)(hm * 64) * 512 + b * 256, 0, 3, 0, nullptr, wave, ln2_, nn, kqq, nn >> 3, 0, qf, BCm, m, l, O, 256, 64 * 256, 512, 64);
            const float il = 1.f / kqsum(l[0]);
            if (nn < 8) { bf16* op = CAT + (size_t)(rowb + t0w + nn) * 1024 + 768 + hm * 64 + 4 * kqq;
#pragma unroll
                for (int dt = 0; dt < 4; ++dt) *(uint2*)(op + 16 * dt) = make_uint2(pk2(O[0][dt][0] * il, O[0][dt][1] * il), pk2(O[0][dt][2] * il, O[0][dt][3] * il)); }
        }
    }
}

__device__ __forceinline__ void p10_dsa_norm(Frame& F, const In& I, unsigned char* ws) {
    OPAQUE_TID(); KARGS(); const int gw = F.vcu * NWAVES + (tid_ >> 6), NGW = F.G * NWAVES, lane = tid_ & 63;
    const bf16* PR = (const bf16*)(ws + WS_PROJ1); bf16* CQ = (bf16*)(ws + WS_CQ); bf16* CKV = (bf16*)(ws + WS_CKV); bf16* KIDX = (bf16*)(ws + WS_KIDX); float* WIDX = (float*)(ws + WS_WIDX);
    for (int m = gw; m < M; m += NGW) {
        const bf16* pr = PR + (size_t)m * 768;
        float a[4]; ld4bf(pr + 4 * lane, a);
        float s = wave_sum(a[0] * a[0] + a[1] * a[1] + a[2] * a[2] + a[3] * a[3]); float r = rsqrtf(s * (1.f / 256.f) + EPSF);
        const float4 gq = *(const float4*)(Ip->q_norm + 4 * lane);
        *(uint2*)(CQ + (size_t)m * 256 + 4 * lane) = make_uint2(pk2((a[0] * r) * gq.x, (a[1] * r) * gq.y), pk2((a[2] * r) * gq.z, (a[3] * r) * gq.w));
        const unsigned u = *(const unsigned*)(pr + 256 + 2 * lane); const float c0 = bflo(u), c1 = bfhi(u);
        s = wave_sum(c0 * c0 + c1 * c1); r = rsqrtf(s * (1.f / 128.f) + EPSF);
        *(unsigned*)(CKV + (size_t)m * 128 + 2 * lane) = pk2((c0 * r) * Ip->kv_norm[2 * lane], (c1 * r) * Ip->kv_norm[2 * lane + 1]);
        const float k0 = bf2f(pr[384 + lane]);
        s = wave_sum(k0 * k0); r = rsqrtf(s * (1.f / 64.f) + EPSF);
        { const int tk = m >> 5, key = m & 31, ks = lane >> 4, hf = (lane >> 3) & 1, jj = lane & 7;
          KIDX[((size_t)(tk * 4 + ks) * 64 + hf * 32 + key) * 8 + jj] = (bf16)f2bf((k0 * r) * Ip->kidx_norm[lane]); }
        if (lane < 8) WIDX[(size_t)m * 8 + lane] = bf2f(pr[448 + lane]) * (0.35355339059327373f * 0.125f);
    }
}

#define MFMA32(A, B, C) __builtin_amdgcn_mfma_f32_32x32x16_bf16((A), (B), (C), 0, 0, 0)
typedef float f32x16 __attribute__((ext_vector_type(16)));
constexpr int XL_OFF = RING_BYTES;
constexpr int IDX_HIST = XL_OFF, IDX_SELL = XL_OFF + 16384;
static_assert(IDX_SELL + 4096 <= LDSCTL_OFF, "LDS map (indexer)");
__device__ __forceinline__ float wmin64(float v) {
#pragma unroll
    for (int o = 1; o < 64; o <<= 1) v = fminf(v, __shfl_xor(v, o));
    return v;
}
__device__ __forceinline__ unsigned f16_order_key(float x) {
    const unsigned hb = (unsigned)__builtin_bit_cast(unsigned short, (_Float16)x);
    const unsigned mk = (unsigned)((int)(hb << 16) >> 31) | 0x8000u;
    return (hb ^ mk) & 0xffffu; }
__device__ __forceinline__ void p12_index_mfma(Frame& F, const In& I, unsigned char* ws) {
    OPAQUE_TID(); KARGS(); const int lane = tid_ & 63, wave = __builtin_amdgcn_readfirstlane(tid_ >> 6), key = lane & 31, half = lane >> 5;
    LAS unsigned short* SC = (LAS unsigned short*)(F.lds + RING_OFF);
    const bf16* QI = (const bf16*)(ws + WS_QI); const bf16* KIDX = (const bf16*)(ws + WS_KIDX); const float* WIDX = (const float*)(ws + WS_WIDX);
    unsigned short* SEL = (unsigned short*)(ws + WS_SEL); int* CNT = (int*)(ws + WS_CNT);
    const int NG = M / 8, per = (NG + F.G - 1) / F.G;
    for (int j = 0; j < per; ++j) {
        const int u = j * F.G + ((j & 1) ? (F.G - 1 - (int)blockIdx.x) : (int)blockIdx.x);
        if (u >= NG) break;
        const int gi = (u & 1) * (NG / 2) + (u >> 1);
        const int row0 = 8 * gi, b = row0 / T, t0 = row0 % T, rowb = b * T;
        if (t0 < 256) {
            const int t = t0 + wave; unsigned short* so = SEL + (size_t)(row0 + wave) * 256;
#pragma unroll
            for (int i = 0; i < 4; ++i) { const int s = lane + 64 * i; so[s] = (unsigned short)(s <= t ? s : 0); }
            if (lane == 0) CNT[row0 + wave] = t + 1;
            continue;
        }
        const int nt = (t0 + 7) / 32 + 1;
        {
            const int rho = lane & 31, a = rho >> 2, qA = ((a >> 2) & 1) + 2 * (a & 1), hdA = 4 * ((a >> 1) & 1) + (rho & 3);
            bf16x8 qa[2][4];
#pragma unroll
            for (int t2 = 0; t2 < 2; ++t2)
#pragma unroll
                for (int ks = 0; ks < 4; ++ks) qa[t2][ks] = ldg16(QI + (size_t)(row0 + 4 * t2 + qA) * 512 + hdA * 64 + 16 * ks + 8 * half);
            f32x2_t wp[2][2][4];
#pragma unroll
            for (int t2 = 0; t2 < 2; ++t2)
#pragma unroll
                for (int jq = 0; jq < 2; ++jq) { const float* wq = WIDX + (size_t)(row0 + 4 * t2 + 2 * half + jq) * 8; const float4 x0 = *(const float4*)wq, x1 = *(const float4*)(wq + 4);
                    wp[t2][jq][0] = (f32x2_t){x0.x, x0.y}; wp[t2][jq][1] = (f32x2_t){x0.z, x0.w}; wp[t2][jq][2] = (f32x2_t){x1.x, x1.y}; wp[t2][jq][3] = (f32x2_t){x1.z, x1.w}; }
            const int tqb = t0 + 2 * half;
            const bf16* kpb = KIDX + (size_t)(rowb >> 5) * 2048 + (size_t)lane * 8;
            const int ntw = (nt - wave + NWAVES - 1) / NWAVES;
#define IDX_LOAD(dst, i) do { const int tl2_ = wave + NWAVES * ((i) < ntw ? (i) : (ntw > 0 ? ntw - 1 : 0)); const bf16* kp_ = kpb + (size_t)tl2_ * 2048; \
                _Pragma("unroll") for (int ks = 0; ks < 4; ++ks) dst[ks] = ldg16(kp_ + 512 * ks); } while (0)
#define IDX_EPI(c, t2) do { f32x2_t a0 = {0.f, 0.f}, a1 = {0.f, 0.f};     \
                _Pragma("unroll") for (int h = 0; h < 4; ++h) { \
                    const f32x2_t r0 = {__int_as_float(max(__float_as_int(c[2 * h]), 0)), __int_as_float(max(__float_as_int(c[2 * h + 1]), 0))}; \
                    const f32x2_t r1 = {__int_as_float(max(__float_as_int(c[8 + 2 * h]), 0)), __int_as_float(max(__float_as_int(c[9 + 2 * h]), 0))}; \
                    a0 = __builtin_elementwise_fma(r0, wp[t2][0][h], a0); a1 = __builtin_elementwise_fma(r1, wp[t2][1][h], a1); } \
                const float s0 = (a0[0] + a0[1]) + 0.f, s1 = (a1[0] + a1[1]) + 0.f; \
                const bool ok0 = kpos <= tqb + 4 * (t2), ok1 = kpos <= tqb + 4 * (t2) + 1; \
                SC[(4 * (t2) + 2 * half) * 8192 + kpos] = (unsigned short)f16_order_key(ok0 ? s0 : -INFINITY); SC[(4 * (t2) + 2 * half + 1) * 8192 + kpos] = (unsigned short)f16_order_key(ok1 ? s1 : -INFINITY); } while (0)
#define IDX_COMP(src, i) do { if ((i) < ntw) { const int kpos = 32 * (wave + NWAVES * (i)) + key; \
                f32x16 cA = {0.f, 0.f, 0.f, 0.f, 0.f, 0.f, 0.f, 0.f, 0.f, 0.f, 0.f, 0.f, 0.f, 0.f, 0.f, 0.f}, cB = cA; \
                _Pragma("unroll") for (int ks = 0; ks < 4; ++ks) { cA = MFMA32(qa[0][ks], src[ks], cA); cB = MFMA32(qa[1][ks], src[ks], cB); } \
                IDX_EPI(cA, 0); IDX_EPI(cB, 1); } } while (0)
            if (ntw > 0) {
                bf16x8 kb0[4], kb1[4], kb2[4], kb3[4];
                IDX_LOAD(kb0, 0); IDX_LOAD(kb1, 1); IDX_LOAD(kb2, 2);
                for (int i = 0; i < ntw; i += 4) {
                    IDX_LOAD(kb3, i + 3); IDX_COMP(kb0, i);
                    IDX_LOAD(kb0, i + 4); IDX_COMP(kb1, i + 1);
                    IDX_LOAD(kb1, i + 5); IDX_COMP(kb2, i + 2);
                    IDX_LOAD(kb2, i + 6); IDX_COMP(kb3, i + 3);
                }
            }
#undef IDX_LOAD
#undef IDX_EPI
#undef IDX_COMP
        }
        __syncthreads();
        {
            const int q = wave, t = t0 + q, nch = (t + 512) >> 9; LAS unsigned short* sc = SC + q * 8192;
            LAS unsigned* hist = (LAS unsigned*)(F.lds + IDX_HIST) + wave * 512;
            LAS unsigned short* sl = (LAS unsigned short*)(F.lds + IDX_SELL) + q * 256;
            for (int i = 32 * nt + lane; i < 512 * nch; i += 64) sc[i] = (unsigned short)0;
#pragma unroll
            for (int i = 0; i < 8; ++i) hist[lane + 64 * i] = 0u;
            for (int c = 0; c < nch; ++c) { const v4u k4 = *(const LAS v4u*)(sc + 512 * c + 8 * lane);
#pragma unroll
                for (int e = 0; e < 8; ++e) { const unsigned kk = (e & 1) ? (k4[e >> 1] >> 16) : (k4[e >> 1] & 0xffffu); const unsigned bb = kk >> 6;
                    atomicAdd((unsigned*)&hist[bb >> 1], 1u << (16 * (bb & 1))); } }
            int b1, r1;
            { unsigned cw[8]; unsigned S = 0u;
#pragma unroll
              for (int i = 0; i < 8; ++i) { cw[i] = hist[8 * lane + i]; S += (cw[i] & 0xffffu) + (cw[i] >> 16); }
              const unsigned px = wave_iscan_u32(S);
              const unsigned above = (unsigned)__builtin_amdgcn_readlane((int)px, 63) - px;
              const bool found = (above < 256u) && (256u <= above + S);
              const int fl = __builtin_ctzll(__ballot(found));
              int bs = 0; unsigned acc = above;
              { bool done = false;
#pragma unroll
                for (int i = 15; i >= 0; --i) { const unsigned cnt_ = (i & 1) ? (cw[i >> 1] >> 16) : (cw[i >> 1] & 0xffffu);
                    if (!done) { if (acc + cnt_ >= 256u) { bs = 16 * lane + i; done = true; } else acc += cnt_; } } }
              b1 = __builtin_amdgcn_readlane(bs, fl); r1 = 256 - __builtin_amdgcn_readlane((int)acc, fl); }
            hist[lane] = 0u;
            for (int c = 0; c < nch; ++c) { const v4u k4 = *(const LAS v4u*)(sc + 512 * c + 8 * lane);
#pragma unroll
                for (int e = 0; e < 8; ++e) { const unsigned kk = (e & 1) ? (k4[e >> 1] >> 16) : (k4[e >> 1] & 0xffffu);
                    if ((int)(kk >> 6) == b1) atomicAdd((unsigned*)&hist[kk & 63u], 1u); } }
            unsigned tkey; int r2;
            { const unsigned S = hist[lane]; const unsigned px = wave_iscan_u32(S); const unsigned above = (unsigned)__builtin_amdgcn_readlane((int)px, 63) - px;
              const bool found = (above < (unsigned)r1) && ((unsigned)r1 <= above + S);
              const int fl = __builtin_ctzll(__ballot(found));
              tkey = ((unsigned)b1 << 6) | (unsigned)fl; r2 = r1 - __builtin_amdgcn_readlane((int)above, fl); }
            const int nabove = 256 - r2; int bsel = 0, beq = 0;
            for (int c = 0; c < nch; ++c) { const int i8 = 512 * c + 8 * lane; const v4u k4 = *(const LAS v4u*)(sc + i8);
                unsigned em = 0u;
#pragma unroll
                for (int e = 0; e < 8; ++e) { const unsigned kk = (e & 1) ? (k4[e >> 1] >> 16) : (k4[e >> 1] & 0xffffu);
                    const bool sel = kk > tkey; em |= (kk == tkey) ? (1u << e) : 0u;
                    const unsigned long long ms = __ballot(sel);
                    if (ms) { if (sel) sl[bsel + (int)__builtin_amdgcn_mbcnt_hi((unsigned)(ms >> 32), __builtin_amdgcn_mbcnt_lo((unsigned)ms, 0u))] = (unsigned short)(i8 + e); bsel += __builtin_popcountll(ms); } }
                if (__any(em != 0u)) {
                    const unsigned ce = (unsigned)__builtin_popcount(em); const unsigned pe = wave_iscan_u32(ce);
                    int pos = beq + (int)(pe - ce);
#pragma unroll
                    for (int e = 0; e < 8; ++e) if (em & (1u << e)) { if (pos < r2) sl[nabove + pos] = (unsigned short)(i8 + e); ++pos; }
                    beq += __builtin_amdgcn_readlane((int)pe, 63); } }
            *(v2u*)(SEL + (size_t)(row0 + q) * 256 + 4 * lane) = *(const LAS v2u*)(sl + 4 * lane);
            if (lane == 0) CNT[row0 + q] = 256;
        }
        __syncthreads();
    }
}

__device__ __forceinline__ unsigned offb(unsigned row, unsigned ch) { return 256u * row + 16u * (ch ^ (((row & 3u) << 2) | ((row >> 2) & 3u))); }
typedef short v4i16_t __attribute__((ext_vector_type(4)));
__device__ __forceinline__ v4i16_t trrd(const LAS unsigned char* p) { return __builtin_amdgcn_ds_read_tr16_b64_v4i16((LAS v4i16_t*)p); }
__device__ __forceinline__ void p13_dsa_mfma(Frame& F, const In& I, unsigned char* ws) {
    OPAQUE_TID(); KARGS(); const int lane = tid_ & 63, wave = __builtin_amdgcn_readfirstlane(tid_ >> 6), n = lane & 15, kq = lane >> 4;
    LAS unsigned char* bkt = F.lds + TAB_BKT; LAS float* b12 = (LAS float*)(F.lds + P13_B12);
    for (int i = tid_; i < 1536; i += NWAVES * 64) bkt[i] = (unsigned char)rel_bucket(i);
    for (int i = tid_; i < 528; i += NWAVES * 64) b12[i] = (i >= 512) ? -INFINITY : (((i & 15) < 12) ? Ip->rel_bias[(i >> 4) * 12 + (i & 15)] * LOG2E : 0.f);
    __syncthreads();
    LAS unsigned char* imgb = F.lds + RING_OFF + wave * 18432; LAS int* sidx = (LAS int*)(imgb + 16384);
    const bf16* QA = (const bf16*)(ws + WS_QA); const bf16* CKV = (const bf16*)(ws + WS_CKV); const bf16* PR = (const bf16*)(ws + WS_PROJ1);
    const unsigned short* SEL = (const unsigned short*)(ws + WS_SEL); const int* CNT = (const int*)(ws + WS_CNT);
    const bf16* MKB = (const bf16*)(ws + WS_MKB) + (size_t)512 * 256; const bf16* MVT = (const bf16*)(ws + WS_MVT) + (size_t)256 * 512;
    bf16* CAT1 = (bf16*)(ws + WS_CAT1);
    const int gw = blockIdx.x * NWAVES + wave, NGW = F.G * NWAVES;
    const LAS float* b12c = b12 + (n < 12 ? n : 0);
#define DSA_GATHER(sl_, rowb_, c0_, buf_) do { const unsigned char* ckvb_ = (const unsigned char*)(CKV + (size_t)(rowb_) * 128); int kx_[8]; \
            _Pragma("unroll") for (int i = 0; i < 8; ++i) kx_[i] = (sl_)[(c0_) + 4 * i + g4_] & 0xffff; \
            _Pragma("unroll") for (int i = 0; i < 8; ++i) __builtin_amdgcn_global_load_lds((const unsigned*)(ckvb_ + ((unsigned)kx_[i] * 256u + goff_[i & 3])), (LAS unsigned*)(imgb + (buf_) * 8192 + i * 1024), 16, 0, 0); } while (0)
#define DSA_LIST(sl_, sel_, t_, cnt_) do { const int idx0_ = __builtin_amdgcn_readfirstlane((sel_)[0]); \
            _Pragma("unroll") for (int i = 0; i < 4; ++i) { const int e = lane + 64 * i, idx = (sel_)[i]; const int d = (t_) - idx, dc = d > 1535 ? 1535 : (d < 0 ? 0 : d); \
                (sl_)[e] = (e < (cnt_)) ? (idx | ((int)bkt[dc] << 22)) : (idx0_ | (2048 << 16)); } } while (0)
    int dreps_ = (PROBE_REP == 9) ? 2 : 1; asm volatile("" : "+s"(dreps_));
    for (int dr_ = 0; dr_ < dreps_; ++dr_) {
    asm volatile("s_waitcnt vmcnt(0) lgkmcnt(0)" ::: "memory");
    int row = gw;
    if (row < M) {
        int ln0_ = lane; asm volatile("" : "+v"(ln0_));
        const int g4_ = ln0_ >> 4; unsigned goff_[4];
#pragma unroll
        for (int k = 0; k < 4; ++k) goff_[k] = 16u * ((unsigned)(ln0_ & 15) ^ (((unsigned)g4_ << 2) | (unsigned)k));
        int cnt = __builtin_amdgcn_readfirstlane(CNT[row]); int sel0[4];
#pragma unroll
        for (int i = 0; i < 4; ++i) sel0[i] = (int)SEL[(size_t)row * 256 + lane + 64 * i];
        DSA_LIST(sidx, sel0, row % T, cnt);
        bf16x8 qf[4];
#pragma unroll
        for (int ks = 0; ks < 4; ++ks) { bf16x8 v = ldg16(QA + (size_t)row * 1536 + (n < 12 ? n : 0) * 128 + 32 * ks + 8 * kq); if (n >= 12) v = (bf16x8){0, 0, 0, 0, 0, 0, 0, 0}; qf[ks] = v; }
        asm volatile("s_waitcnt lgkmcnt(0)" ::: "memory");
        DSA_GATHER(sidx, (row / T) * T, 0, 0);
        int lb = 0, ib = 0;
        for (; row < M; row += NGW) {
            const int t = row % T, rown = (row + NGW < M) ? row + NGW : row; const bool hasn = row + NGW < M;
            int ln_ = lane; asm volatile("" : "+v"(ln_));
            int seln[4] = {0, 0, 0, 0}; int cntn_v = 0; bf16x8 qfn[4];
#pragma unroll
            for (int ks = 0; ks < 4; ++ks) qfn[ks] = (bf16x8){0, 0, 0, 0, 0, 0, 0, 0};
#define DSA_NEXT_LOADS() do { cntn_v = CNT[rown]; \
                _Pragma("unroll") for (int i = 0; i < 4; ++i) seln[i] = (int)SEL[(size_t)rown * 256 + lane + 64 * i]; \
                _Pragma("unroll") for (int ks = 0; ks < 4; ++ks) { bf16x8 v = ldg16(QA + (size_t)rown * 1536 + (n < 12 ? n : 0) * 128 + 32 * ks + 8 * kq); if (n >= 12) v = (bf16x8){0, 0, 0, 0, 0, 0, 0, 0}; qfn[ks] = v; } } while (0)
            const LAS int* sl = sidx + lb * 256; LAS int* sln = sidx + (lb ^ 1) * 256;
            float m = -1e30f, l = 0.f; f32x4 O[8];
#pragma unroll
            for (int rt = 0; rt < 8; ++rt) O[rt] = (f32x4){0.f, 0.f, 0.f, 0.f};
            for (int c0 = 0; c0 < cnt; c0 += 32) {
                LAS unsigned char* img = imgb + ib * 8192;
                if (c0 + 32 < cnt) { DSA_GATHER(sl, (row / T) * T, c0 + 32, ib ^ 1);
                    { const int e2 = (c0 + 64 < 256 ? c0 + 64 : 224) + (ln_ >> 1); const int k2 = sl[e2] & 0xffff;
                      __builtin_amdgcn_global_load_lds((const unsigned*)((const unsigned char*)(CKV + (size_t)((row / T) * T) * 128) + ((unsigned)k2 * 256u + 128u * (unsigned)(ln_ & 1))), (LAS unsigned*)(F.lds + P13_JUNK + wave * 256), 4, 0, 0); }
                    if (c0 == 0) { DSA_NEXT_LOADS(); }
                    if (c0 < 64) asm volatile("s_waitcnt vmcnt(18)" ::: "memory"); else asm volatile("s_waitcnt vmcnt(9)" ::: "memory"); }
                else if (hasn) {
                    if (c0 == 0) { DSA_NEXT_LOADS(); }
                    const int cntn = __builtin_amdgcn_readfirstlane(cntn_v);
                    DSA_LIST(sln, seln, rown % T, cntn);
                    asm volatile("s_waitcnt lgkmcnt(0)" ::: "memory");
                    DSA_GATHER(sln, (rown / T) * T, 0, ib ^ 1); asm volatile("s_waitcnt vmcnt(8)" ::: "memory"); }
                else asm volatile("s_waitcnt vmcnt(0)" ::: "memory");
                const bool has = m > -1e29f; const float mref = has ? m : 0.f; const float cinv = -mref;
                f32x4 sa = {cinv, cinv, cinv, cinv}, sb = sa;
                { const unsigned ra = 8u * ((unsigned)(ln_ & 15) >> 2) + ((unsigned)ln_ & 3u), kq_ = (unsigned)ln_ >> 4;
#pragma unroll
                  for (int s = 0; s < 4; ++s) { const bf16x8 ka = *(const LAS bf16x8*)(img + offb(ra, 4 * s + kq_)); const bf16x8 kb = *(const LAS bf16x8*)(img + offb(ra + 4, 4 * s + kq_));
                      sa = MFMA16(ka, qf[s], sa); sb = MFMA16(kb, qf[s], sb); } }
#pragma unroll
                for (int i = 0; i < 4; ++i) { const int ea = c0 + 8 * kq + i;
                    sa[i] += *(const LAS float*)((const LAS unsigned char*)b12c + ((unsigned)sl[ea] >> 16)); sb[i] += *(const LAS float*)((const LAS unsigned char*)b12c + ((unsigned)sl[ea + 4] >> 16)); }
                float fsc = 1.f;
                if (__any((imax3(imax3(__float_as_int(sa[0]), __float_as_int(sa[1]), __float_as_int(sa[2])), imax3(__float_as_int(sa[3]), __float_as_int(sb[0]), __float_as_int(sb[1])), max(__float_as_int(sb[2]), __float_as_int(sb[3]))) > __float_as_int(SM_THR)) || !has)) {
                    float lm = lmax8(sa, sb);
                    lm = fmaxf(lm, __shfl_xor(lm, 16)); lm = fmaxf(lm, __shfl_xor(lm, 32));
                    const bool upd = (lm > -INFINITY) && (!has || lm > 0.f); const float dl = upd ? lm : 0.f;
                    if (upd) m = mref + dl;
                    fsc = has ? __builtin_amdgcn_exp2f(-dl) : 1.f; l *= fsc;
#pragma unroll
                    for (int i = 0; i < 4; ++i) { sa[i] -= dl; sb[i] -= dl; }
#pragma unroll
                    for (int rt = 0; rt < 8; ++rt) O[rt] = O[rt] * fsc;
                }
                f32x4 pa, pb; float sum = 0.f;
#pragma unroll
                for (int i = 0; i < 4; ++i) { pa[i] = __builtin_amdgcn_exp2f(sa[i]); pb[i] = __builtin_amdgcn_exp2f(sb[i]); sum += pa[i] + pb[i]; }
                l += sum;
                const bf16x8 pf = pack8(pa, pb);
                { const unsigned g_ = (unsigned)ln_ >> 4, q_ = ((unsigned)ln_ & 15u) >> 2, p_ = (unsigned)ln_ & 3u;
#pragma unroll
                  for (int rt = 0; rt < 8; ++rt) { const v4i16_t x0 = trrd(img + offb(8 * g_ + q_, 2 * rt + (p_ >> 1)) + 8 * (p_ & 1)), x1 = trrd(img + offb(8 * g_ + 4 + q_, 2 * rt + (p_ >> 1)) + 8 * (p_ & 1));
                      const bf16x8 vf = {x0[0], x0[1], x0[2], x0[3], x1[0], x1[1], x1[2], x1[3]};
                      O[rt] = MFMA16(vf, pf, O[rt]); } }
                ib ^= 1;
            }
            const float il = 1.f / kqsum(l);
            if (n < 12) { bf16* op = CAT1 + (size_t)row * 1792 + n * 128 + 4 * kq;
#pragma unroll
                for (int rt = 0; rt < 8; ++rt) *(uint2*)(op + 16 * rt) = make_uint2(pk2(O[rt][0] * il, O[rt][1] * il), pk2(O[rt][2] * il, O[rt][3] * il)); }
            lb ^= 1; cnt = __builtin_amdgcn_readfirstlane(cntn_v);
#pragma unroll
            for (int ks = 0; ks < 4; ++ks) qf[ks] = qfn[ks];
        }
    }
    }
#undef DSA_GATHER
#undef DSA_LIST
#undef DSA_NEXT_LOADS
    int mreps_ = (PROBE_REP == 8) ? 2 : 1; asm volatile("" : "+s"(mreps_));
    __syncthreads();
    for (int mr_ = 0; mr_ < mreps_; ++mr_)
    for (int u64 = blockIdx.x; u64 < M / 64; u64 += F.G) {
        int tl_ = tid_; asm volatile("" : "+v"(tl_));
        const int ln = tl_ & 63, nn = ln & 15, kqq = ln >> 4, qsl = nn >> 3;
        const int row0 = 64 * u64 + 8 * wave, b = row0 / T;
        const BiasCtx BC0{(const LAS unsigned short*)(F.lds + NSA_TB), 0.f, 0.f, 0.f};
#pragma unroll 1
        for (int hm = 0; hm < 4; ++hm) {
            bf16x8 qf[4][2];
#pragma unroll
            for (int p = 0; p < 4; ++p) { qf[p][0] = (bf16x8){0, 0, 0, 0, 0, 0, 0, 0}; qf[p][1] = qf[p][0]; }
            { const bf16* qp = PR + (size_t)(row0 + (nn & 7)) * 768 + 456 + hm * 64 + 8 * kqq; if (nn < 8) { qf[0][0] = ldg16(qp); qf[0][1] = ldg16(qp + 32); } }
            float m[4], l[4]; f32x4 O[4][4];
#pragma unroll
            for (int p = 0; p < 4; ++p) { m[p] = -1e30f; l[p] = 0.f;
#pragma unroll
                for (int dt = 0; dt < 4; ++dt) O[p][dt] = (f32x4){0.f, 0.f, 0.f, 0.f}; }
            nsa_sweep<MD_MEM>(F.lds + RING_OFF, MKB + (size_t)(b * 256) * 256 + hm * 64, MVT + (size_t)(hm * 64) * 512 + b * 256, 0, 3, 0, nullptr, wave, ln, nn, kqq, qsl, 0, qf, BC0, m, l, O, 256, 64 * 256, 512, 64);
            const float il = 1.f / kqsum(l[0]);
            if (nn < 8) { bf16* op = CAT1 + (size_t)(row0 + nn) * 1792 + 1536 + hm * 64 + 4 * kqq;
#pragma unroll
                for (int dt = 0; dt < 4; ++dt) *(uint2*)(op + 16 * dt) = make_uint2(pk2(O[0][dt][0] * il, O[0][dt][1] * il), pk2(O[0][dt][2] * il, O[0][dt][3] * il)); }
            __syncthreads();
        }
    }
}

struct Args { In in; float* out; unsigned char* ws; int ph_lo, ph_hi; };
__global__ void __launch_bounds__(NWAVES * 64, 2) mk_fwd(Args args) {
    extern __shared__ __attribute__((aligned(16))) unsigned char lds[];
    Frame F;
    F.lds = (LAS unsigned char*)lds; F.MISC = (volatile LAS unsigned*)(F.lds + MISC_OFF);
    F.G = gridDim.x; { const int bx = blockIdx.x; F.vcu = (F.G % 8 == 0) ? (bx % 8) * (F.G / 8) + bx / 8 : bx; }
    unsigned char* ws = args.ws; const In& I = args.in; float* out = args.out; (void)I;
    F.ctl = (gu32*)(ws + WS_CTL);
    for (int u = threadIdx.x; u < (LDS_BYTES - LDSCTL_OFF) / 4; u += NWAVES * 64) ((LAS unsigned*)(F.lds + LDSCTL_OFF))[u] = 0u;
    __syncthreads();
    XcdBarrier bar; bar.bar = (unsigned*)(F.ctl + CW_BAR); bar.x = 0; bar.st = nullptr;
    if (!MK_SPLIT) bar = xcd_barrier_post((unsigned*)(F.ctl + CW_BAR), F.MISC + 8);
    const int lo = args.ph_lo, hi = args.ph_hi;
#ifndef PH_MASK
#define PH_MASK 0xFFFFFFFFu
#endif
#define IN(k) ((((PH_MASK) >> ((k) % 32)) & 1u) && lo <= (k) && (k) < hi)
#define SEAM(k) do { if (IN(k) && IN((k) + 1)) xcd_barrier(bar); } while (0)
#define SEAM2(k, kn) do { if (IN(k) && IN(kn)) xcd_barrier(bar); } while (0)
#ifndef REP_MASK
#define REP_MASK 0u
#endif
#define REPS(k) (1 + (int)(((REP_MASK) >> (k)) & 1u))
    bf16* XN = (bf16*)(ws + WS_XN); bf16* CAT = (bf16*)(ws + WS_CAT); bf16* ACT = (bf16*)(ws + WS_ACT);
    float* SSQ = (float*)(ws + WS_SSQ);

    if (IN(0)) { for (int r_ = 0; r_ < REPS(0); ++r_) { p0_prologue(F, I, ws); if (r_ + 1 < REPS(0)) xcd_barrier(bar); } SEAM(0); }
    {
            if (IN(1)) {
                pg8::Gemm g{XN, (const bf16*)(ws + WS_WIN0), M, 1792, D}; pg8::StaticOrder S; S.init(M, 1792, F.G, (int)blockIdx.x);
                pg8::EpiRoute<0> E{ws, nullptr};
                for (int r_ = 0; r_ < REPS(1); ++r_) { if (r_) xcd_barrier(bar);
                pg8::gemm_phase<pg8::EpiRoute<0>, pg8::StaticOrder, true, true>(F.lds + RING_OFF, g, S, E); }
                pg8::Gemm g2{(const bf16*)(ws + WS_WVT), XN, 256, M, D}; pg8::StaticOrder S2; S2.init(256, M, F.G, (int)((blockIdx.x + 64) % F.G));
                pg8::EpiRoute<3> E2{ws, nullptr};
                pg8::gemm_phase<pg8::EpiRoute<3>, pg8::StaticOrder, true, true>(F.lds + RING_OFF, g2, S2, E2);
                SEAM(1);
            }
            if (IN(2)) { for (int r_ = 0; r_ < REPS(2); ++r_) { p2_mfma(F, I, ws); if (r_ + 1 < REPS(2)) xcd_barrier(bar); } SEAM(2); }
            if (IN(3)) { for (int r_ = 0; r_ < REPS(3); ++r_) { p3_nsa_mfma(F, I, ws); if (r_ + 1 < REPS(3)) xcd_barrier(bar); } SEAM(3); }
    }
    {
        constexpr int L = 0, pb = L ? 14 : 4;
        if (IN(pb)) {
            pg8::Gemm g{L ? (const bf16*)(ws + WS_CAT1) : CAT, L ? (const bf16*)(ws + WS_WO1F) : (const bf16*)(ws + WS_WO), M, D, L ? 1792 : D}; pg8::StaticOrder S; S.init(M, D, F.G, (int)blockIdx.x);
            KARGS(); pg8::EpiResid<L == 0> E{L ? (const void*)XN : (const void*)Ip->x, XN, SSQ + (size_t)(L ? 2 : 0) * M * 16, D, 0};
            pg8::gemm_phase<pg8::EpiResid<L == 0>, pg8::StaticOrder, true, true>(F.lds + RING_OFF, g, S, E);
            SEAM2(pb, pb + 2);
        }
        if (IN(pb + 2)) {
            pg8::Gemm g{XN, (const bf16*)(ws + WS_WGU) + (size_t)L * 2 * DFF * D, M, 2 * DFF, D}; pg8::StaticOrder S; S.init(M, 2 * DFF, F.G, (int)blockIdx.x);
            pg8::EpiSwiglu E{ACT, SSQ + (size_t)(L ? 2 : 0) * M * 16, DFF, 0};
            for (int r_ = 0; r_ < REPS(pb + 2); ++r_) { if (r_) xcd_barrier(bar);
            pg8::gemm_phase<pg8::EpiSwiglu, pg8::StaticOrder, true, true>(F.lds + RING_OFF, g, S, E); }
            SEAM(pb + 2);
        }
        if (IN(pb + 3)) {
            pg8::Gemm g{ACT, (const bf16*)(ws + WS_WD) + (size_t)L * D * DFF, M, D, DFF}; pg8::StaticOrder S; S.init(M, D, F.G, (int)blockIdx.x);
            pg8::EpiResid<false> E{XN, XN, SSQ + (size_t)(L ? 3 : 1) * M * 16, D, 0};
            pg8::gemm_phase<pg8::EpiResid<false>, pg8::StaticOrder, true, true>(F.lds + RING_OFF, g, S, E);
            SEAM2(pb + 3, L ? 18 : 9);
        }
        }
    {
            if (IN(9)) {
                pg8::Gemm g{XN, (const bf16*)(ws + WS_WIN1), M, 768, D}; pg8::StaticOrder S; S.init(M, 768, F.G, (int)blockIdx.x);
                pg8::EpiRoute<1> E{ws, SSQ + (size_t)1 * M * 16};
                for (int r_ = 0; r_ < REPS(9); ++r_) { if (r_) xcd_barrier(bar);
                pg8::gemm_phase<pg8::EpiRoute<1>, pg8::StaticOrder, true, true>(F.lds + RING_OFF, g, S, E); }
                SEAM(9);
            }
            if (IN(10)) { p10_dsa_norm(F, I, ws); SEAM(10); }
            if (IN(11)) {
                pg8::Gemm g{(const bf16*)(ws + WS_CQ), (const bf16*)(ws + WS_WQ2), M, 2048, 256}; pg8::StaticOrder S; S.init(M, 2048, F.G, (int)blockIdx.x);
                pg8::EpiRoute<2> E{ws, nullptr};
                for (int r_ = 0; r_ < REPS(11); ++r_) { if (r_) xcd_barrier(bar);
                pg8::gemm_phase<pg8::EpiRoute<2>, pg8::StaticOrder, true, true>(F.lds + RING_OFF, g, S, E); }
                SEAM(11);
            }
            if (IN(12)) { for (int r_ = 0; r_ < REPS(12); ++r_) { p12_index_mfma(F, I, ws); if (r_ + 1 < REPS(12)) xcd_barrier(bar); } SEAM(12); }
            if (IN(13)) { for (int r_ = 0; r_ < REPS(13); ++r_) { p13_dsa_mfma(F, I, ws); if (r_ + 1 < REPS(13)) xcd_barrier(bar); } SEAM(13); }
            }
    {
        constexpr int L = 1, pb = L ? 14 : 4;
        if (IN(pb)) {
            pg8::Gemm g{L ? (const bf16*)(ws + WS_CAT1) : CAT, L ? (const bf16*)(ws + WS_WO1F) : (const bf16*)(ws + WS_WO), M, D, L ? 1792 : D}; pg8::StaticOrder S; S.init(M, D, F.G, (int)blockIdx.x);
            KARGS(); pg8::EpiResid<L == 0> E{L ? (const void*)XN : (const void*)Ip->x, XN, SSQ + (size_t)(L ? 2 : 0) * M * 16, D, 0};
            pg8::gemm_phase<pg8::EpiResid<L == 0>, pg8::StaticOrder, true, true>(F.lds + RING_OFF, g, S, E);
            SEAM2(pb, pb + 2);
        }
        if (IN(pb + 2)) {
            pg8::Gemm g{XN, (const bf16*)(ws + WS_WGU) + (size_t)L * 2 * DFF * D, M, 2 * DFF, D}; pg8::StaticOrder S; S.init(M, 2 * DFF, F.G, (int)blockIdx.x);
            pg8::EpiSwiglu E{ACT, SSQ + (size_t)(L ? 2 : 0) * M * 16, DFF, 0};
            for (int r_ = 0; r_ < REPS(pb + 2); ++r_) { if (r_) xcd_barrier(bar);
            pg8::gemm_phase<pg8::EpiSwiglu, pg8::StaticOrder, true, true>(F.lds + RING_OFF, g, S, E); }
            SEAM(pb + 2);
        }
        if (IN(pb + 3)) {
            pg8::Gemm g{ACT, (const bf16*)(ws + WS_WD) + (size_t)L * D * DFF, M, D, DFF}; pg8::StaticOrder S; S.init(M, D, F.G, (int)blockIdx.x);
            pg8::EpiResid<false> E{XN, XN, SSQ + (size_t)(L ? 3 : 1) * M * 16, D, 0};
            pg8::gemm_phase<pg8::EpiResid<false>, pg8::StaticOrder, true, true>(F.lds + RING_OFF, g, S, E);
            SEAM2(pb + 3, L ? 18 : 9);
        }
        }
    if (IN(18)) {
        OPAQUE_TID(); KARGS(); const int lane_ = tid_ & 63;
        const int gw = F.vcu * NWAVES + (tid_ >> 6), NGW = F.G * NWAVES;
        for (int m = gw; m < M; m += NGW) { const float r = rsqrtf(pg8::ssq_row(SSQ + ((size_t)3 * M + m) * 16) * (1.f / D) + EPSF);
#pragma unroll
            for (int j = 0; j < 2; ++j) { const int c = (j * 64 + lane_) * 8; const pg8::u32x4 rw = *(const GAS pg8::u32x4*)(XN + (size_t)m * D + c);
                const GAS f32x4* gr = (const GAS f32x4*)(Ip->norm_final + c); GAS f32x4* orow = (GAS f32x4*)(out + (size_t)m * D + c);
                f32x4 r0, r1; r0[0] = __uint_as_float(rw.x << 16); r0[1] = __uint_as_float(rw.x & 0xffff0000u); r0[2] = __uint_as_float(rw.y << 16); r0[3] = __uint_as_float(rw.y & 0xffff0000u);
                r1[0] = __uint_as_float(rw.z << 16); r1[1] = __uint_as_float(rw.z & 0xffff0000u); r1[2] = __uint_as_float(rw.w << 16); r1[3] = __uint_as_float(rw.w & 0xffff0000u);
                orow[0] = (r0 * r) * gr[0]; orow[1] = (r1 * r) * gr[1]; } }
    }
#undef IN
#undef SEAM
}

extern "C" void kernel_launch(void* const* d_in, const int* in_sizes, int n_in, void* d_out, int out_size, void* d_ws, size_t ws_size, hipStream_t stream) {
    static int grid = 0;
    if (grid == 0) {
        if (n_in != 32 || out_size != M * D || ws_size < WS_END) { fprintf(stderr, "kernel_launch: unexpected shapes (n_in %d out %d ws %zu)\n", n_in, out_size, ws_size); grid = -1; return; }
        int dev = 0, cus = 0, per_cu = 0;
        if (hipGetDevice(&dev) != hipSuccess || hipDeviceGetAttribute(&cus, hipDeviceAttributeMultiprocessorCount, dev) != hipSuccess) { grid = -1; return; }
        if (hipFuncSetAttribute((const void*)mk_fwd, hipFuncAttributeMaxDynamicSharedMemorySize, LDS_BYTES) != hipSuccess) { grid = -1; return; }
        if (hipOccupancyMaxActiveBlocksPerMultiprocessor(&per_cu, (const void*)mk_fwd, NWAVES * 64, LDS_BYTES) != hipSuccess || per_cu < 1) fprintf(stderr, "kernel_launch: occupancy query reports %d\n", per_cu);
        (void)hipGetLastError();
        grid = cus;
        if (grid > 256) grid = 256;
    }
    if (grid < 0) return;
    if (hipMemsetAsync((char*)d_ws + WS_CTL, 0, CTL_ZERO_BYTES, stream) != hipSuccess) return;
    Args a{};
    const float** ip = (const float**)&a.in;
    for (int i = 0; i < 32; ++i) ip[i] = (const float*)d_in[i];
    a.out = (float*)d_out; a.ws = (unsigned char*)d_ws;
#if MK_SPLIT
    for (int k = 0; k < N_PHASES; ++k) { a.ph_lo = k; a.ph_hi = k + 1; hipLaunchKernelGGL(mk_fwd, dim3(grid), dim3(NWAVES * 64), LDS_BYTES, stream, a); }
#else
    a.ph_lo = 0; a.ph_hi = N_PHASES; hipLaunchKernelGGL(mk_fwd, dim3(grid), dim3(NWAVES * 64), LDS_BYTES, stream, a);
#endif
}
```

```cpp
#include <hip/hip_runtime.h>
#include <cstdio>
#include <cstdint>
#include <type_traits>
#include <math.h>

namespace pg8 {
#define PG8_LAS __attribute__((address_space(3)))
typedef unsigned short bf16_t;
typedef short bf16x8 __attribute__((ext_vector_type(8)));
typedef float f32x4 __attribute__((ext_vector_type(4)));
typedef unsigned u32x4 __attribute__((ext_vector_type(4)));
constexpr int BM = 256, BK = 64, HALF = 128, HTB = HALF * BK * 2  , STAGE_BYTES = 8 * HTB, NXCD = 8, WGM = 8;

__host__ __device__ __forceinline__ int lds_byte(int r, int c) { const int st = (r >> 4) * 2 + (c >> 5), rr = r & 15, cc = c & 31, ob = rr * 64 + cc * 2; return st * 1024 + (ob ^ (((ob >> 9) & 1) << 5)); }
__host__ __device__ __forceinline__ void stage_rc(int b, int& R, int& C) { const int st = b / 1024, sb = b % 1024, swz = sb ^ (((sb >> 9) & 1) << 5); R = (st >> 1) * 16 + swz / 64; C = (st & 1) * 32 + (swz % 64) / 2; }
__host__ __device__ __forceinline__ int perm32(int rho) { const int n = rho >> 4, i = rho & 15; return 8 * (i >> 2) + 4 * n + (i & 3); }

struct Unit { int pm, pn, half; };
struct Gemm { const bf16_t* A; const bf16_t* Bt; int M, N, K; };

struct StaticOrder {
    int nM, nN, nwg, G, c;
    __host__ __device__ void init(int M, int N, int G_, int c_) { nM = M / BM; nN = N / BM; nwg = nM * nN; G = G_; c = c_; }
    __host__ __device__ void map(int L, Unit& u) const {
        int wgid = L; { const int q = nwg / NXCD, r = nwg % NXCD, xcd = wgid % NXCD, off = wgid / NXCD; wgid = (xcd < r ? xcd * (q + 1) : r * (q + 1) + (xcd - r) * q) + off; }
        const int nig = WGM * nN, gid = wgid / nig, fm = gid * WGM, gsz = (nM - fm) < WGM ? (nM - fm) : WGM;
        u.pm = fm + ((wgid % nig) % gsz); u.pn = (wgid % nig) / gsz; u.half = 0; }
    __host__ __device__ bool next(int i, Unit& u) const { const long L = (long)i * G + c; if (L >= nwg) return false; map((int)L, u); return true; }
    __device__ __forceinline__ void a_ready(const Unit&) const {}
    __device__ __forceinline__ void done(const Unit&) const {}
};
struct HalfTailOrder : StaticOrder {
    __host__ __device__ bool next(int i, Unit& u) const {
        const int nfull = (nwg / G) * G, rem = nwg - nfull; const long L = (long)i * G + c;
        if (L < nfull || 2 * rem > G) { if (L >= nwg) return false; map((int)L, u); return true; }
        const long h = L - nfull; if (h >= 2 * rem) return false;
        map(nfull + (int)(h >> 1), u); u.half = 1 + (int)(h & 1); return true; }
};

__device__ __forceinline__ unsigned cvt_pk_bf16(float lo, float hi) { unsigned r; asm volatile("v_cvt_pk_bf16_f32 %0, %1, %2" : "=v"(r) : "v"(lo), "v"(hi)); return r; }
__device__ __forceinline__ float ssq_row(const float* p) { const f32x4 a = ((const f32x4*)p)[0], b = ((const f32x4*)p)[1], c = ((const f32x4*)p)[2], d = ((const f32x4*)p)[3]; const f32x4 t = (a + b) + (c + d); return (t[0] + t[1]) + (t[2] + t[3]); }
template <int ROUTE> struct EpiRoute {
    static constexpr bool PERM = true, AFTER_DRAIN = false;
    unsigned char* ws; const float* ssq;
    __device__ __forceinline__ void operator()(const f32x4 (&acc)[2][2][4][2], const Unit& u, int wr, int wc, int fr, int fq) const {
        asm volatile("" : "+v"(fr), "+v"(fq));
        const int pn = u.pn; size_t off; int ld, t0; float sc;
        if constexpr (ROUTE == 0) {
            off = pn < 3 ? (size_t)(88u << 20) : pn < 5 ? (size_t)(112u << 20) : pn < 6 ? (size_t)(128u << 20) : (size_t)(136u << 20);
            ld = pn < 3 ? 768 : pn < 5 ? 512 : 256; t0 = pn < 3 ? 0 : pn < 5 ? 3 : pn < 6 ? 5 : 6; sc = (pn < 3 || pn == 5) ? 0.18033688011112042f : 1.f;
        } else if constexpr (ROUTE == 1) { off = (size_t)(88u << 20); ld = 768; t0 = 0; sc = 1.f; }
        else if constexpr (ROUTE == 3) { off = (size_t)(144u << 20); ld = 16384; t0 = 0; sc = 1.f; }
        else { off = pn < 6 ? (size_t)(128u << 20) : (size_t)(176u << 20); ld = pn < 6 ? 1536 : 512; t0 = pn < 6 ? 0 : 6; sc = 1.f; }
        bf16_t* base = (bf16_t*)(ws + off);
        const int row0 = u.pm * BM + wr * 64 + fr, col0 = (pn - t0) * BM + wc * 32 + 8 * fq;
#pragma unroll
        for (int ai = 0; ai < 2; ++ai)
#pragma unroll
            for (int m = 0; m < 4; ++m) { bf16_t* rowp = base + (size_t)(row0 + ai * HALF + m * 16) * ld + col0;
                float scr_ = sc; if constexpr (ROUTE == 1) scr_ = rsqrtf(ssq_row(ssq + (size_t)(row0 + ai * HALF + m * 16) * 16) * (1.f / 1024.f) + 1e-6f);
#pragma unroll
                for (int bj = 0; bj < 2; ++bj) { float scb_ = scr_; if constexpr (ROUTE == 1) { const int cg = col0 + bj * HALF; if (cg >= 456 && cg < 712) scb_ *= 0.18033688011112042f; }
                    const f32x4 v0 = acc[ai][bj][m][0] * scb_, v1 = acc[ai][bj][m][1] * scb_;
                    u32x4 w; w.x = cvt_pk_bf16(v0[0], v0[1]); w.y = cvt_pk_bf16(v0[2], v0[3]); w.z = cvt_pk_bf16(v1[0], v1[1]); w.w = cvt_pk_bf16(v1[2], v1[3]);
                    if constexpr (ROUTE == 3) {
                        const int tok = col0 + bj * HALF, rw = row0 + ai * HALF + m * 16; *(u32x4*)(base + ((size_t)(tok >> 6) * 256 + rw) * 64 + (tok & 63)) = w; }
                    else *(u32x4*)(rowp + bj * HALF) = w; } }
    }
};
template <bool RES_F32>
struct EpiResid {
    static constexpr bool PERM = true, AFTER_DRAIN = false;
    const void* res; bf16_t* hb; float* ssq; int ldc; int pad;
    __device__ __forceinline__ void operator()(const f32x4 (&acc)[2][2][4][2], const Unit& u, int wr, int wc, int fr, int fq) const {
        asm volatile("" : "+v"(fr), "+v"(fq));
        const int row0 = u.pm * BM + wr * 64 + fr, col0 = u.pn * BM + wc * 32 + 8 * fq;
#pragma unroll
        for (int ai = 0; ai < 2; ++ai)
#pragma unroll
            for (int m = 0; m < 4; ++m) { const int row = row0 + ai * HALF + m * 16; const size_t off = (size_t)row * ldc + col0; float sq = 0.f;
#pragma unroll
                for (int bj = 0; bj < 2; ++bj) { f32x4 v[2];
                    if constexpr (RES_F32) {
#pragma unroll
                        for (int n = 0; n < 2; ++n) v[n] = *(const f32x4*)((const float*)res + off + bj * HALF + 4 * n) + acc[ai][bj][m][n];
                    } else { const u32x4 rw = *(const u32x4*)((const bf16_t*)res + off + bj * HALF);
                        f32x4 r0, r1; r0[0] = __uint_as_float(rw.x << 16); r0[1] = __uint_as_float(rw.x & 0xffff0000u); r0[2] = __uint_as_float(rw.y << 16); r0[3] = __uint_as_float(rw.y & 0xffff0000u);
                        r1[0] = __uint_as_float(rw.z << 16); r1[1] = __uint_as_float(rw.z & 0xffff0000u); r1[2] = __uint_as_float(rw.w << 16); r1[3] = __uint_as_float(rw.w & 0xffff0000u);
                        v[0] = r0 + acc[ai][bj][m][0]; v[1] = r1 + acc[ai][bj][m][1]; }
#pragma unroll
                    for (int n = 0; n < 2; ++n) sq += (v[n][0] * v[n][0] + v[n][1] * v[n][1]) + (v[n][2] * v[n][2] + v[n][3] * v[n][3]);
                    u32x4 w; w.x = cvt_pk_bf16(v[0][0], v[0][1]); w.y = cvt_pk_bf16(v[0][2], v[0][3]); w.z = cvt_pk_bf16(v[1][0], v[1][1]); w.w = cvt_pk_bf16(v[1][2], v[1][3]); *(u32x4*)(hb + off + bj * HALF) = w; }
                sq += __shfl_xor(sq, 16); sq += __shfl_xor(sq, 32); if (fq == 0) ssq[(size_t)row * 16 + u.pn * 4 + wc] = sq; }
    }
};
struct EpiSwiglu {
    static constexpr bool PERM = true, AFTER_DRAIN = false;
    bf16_t* O; const float* ssq; int ldc; int pad;
    __device__ __forceinline__ void operator()(const f32x4 (&acc)[2][2][4][2], const Unit& u, int wr, int wc, int fr, int fq) const {
        asm volatile("" : "+v"(fr), "+v"(fq));
        const int row0 = u.pm * BM + wr * 64 + fr, col0 = u.pn * HALF + wc * 32 + 8 * fq;
#pragma unroll
        for (int ai = 0; ai < 2; ++ai) { if (u.half == 2 - ai) continue;
#pragma unroll
            for (int m = 0; m < 4; ++m) { float o[8]; const float rs = rsqrtf(ssq_row(ssq + (size_t)(row0 + ai * HALF + m * 16) * 16) * (1.f / 1024.f) + 1e-6f);
#pragma unroll
                for (int n = 0; n < 2; ++n)
#pragma unroll
                    for (int e = 0; e < 4; ++e) { const float g = acc[ai][0][m][n][e] * rs, up = acc[ai][1][m][n][e] * rs; o[4 * n + e] = (g * __builtin_amdgcn_rcpf(1.f + __expf(-g))) * up; }
                u32x4 w; w.x = cvt_pk_bf16(o[0], o[1]); w.y = cvt_pk_bf16(o[2], o[3]); w.z = cvt_pk_bf16(o[4], o[5]); w.w = cvt_pk_bf16(o[6], o[7]);
                *(u32x4*)(O + (size_t)(row0 + ai * HALF + m * 16) * ldc + col0) = w; } }
    }
};
template <class Epi, class Sched, bool ALIGN_EPI = false, bool SP2 = false>
__device__ __forceinline__ void gemm_phase(PG8_LAS unsigned char* lds, const Gemm g, const Sched& S, const Epi& E) {
    int tid = threadIdx.x; asm volatile("" : "+v"(tid));
    const int wid = __builtin_amdgcn_readfirstlane(tid >> 6), lane = tid & 63, wr = wid >> 2, wc = wid & 3, fr = lane & 15, fq = lane >> 4;
    int K = g.K; asm volatile("" : "+s"(K));
    const int nt = K / BK;
    unsigned voffA[2], voffB[2];
#pragma unroll
    for (int i = 0; i < 2; ++i) { int R, C; stage_rc(tid * 16 + i * 8192, R, C); const int Rb = Epi::PERM ? ((R & ~31) + perm32(R & 31)) : R;
        voffA[i] = (unsigned)(R * K + C) * 2u; voffB[i] = (unsigned)(Rb * K + C) * 2u; }
    const size_t kstep = (size_t)(BK * 2);
    const size_t hstep = (size_t)HALF * K * 2;
    const size_t tstep = 2 * hstep;
    const unsigned ldsw = (unsigned)wid * 1024u;
    const int aoff = lds_byte(wr * 64 + fr, fq * 8), boff = lds_byte(wc * 32 + fr, fq * 8);
#define PG8_SA(b, h) (((b) * 2 + (h)) * HTB)
#define PG8_SB(b, h) ((4 + (b) * 2 + (h)) * HTB)
#define PG8_STAGE(bufoff, gbase, voff) do { _Pragma("unroll") for (int _i = 0; _i < 2; ++_i) \
        __builtin_amdgcn_global_load_lds((const unsigned*)((const char*)(gbase) + (voff)[_i]), (PG8_LAS unsigned*)(lds + (bufoff) + ldsw + _i * 8192), 16, 0, 0); } while (0)
#define PG8_LDA(dst, b, h) do { if (cur.half == 2 - (h)) break;        \
        _Pragma("unroll") for (int m = 0; m < 4; ++m) _Pragma("unroll") for (int k = 0; k < 2; ++k) dst[m][k] = *(const PG8_LAS bf16x8*)(lds + PG8_SA(b, h) + aoff + m * 2048 + k * 1024); } while (0)
#define PG8_LDB(dst, b, h) do { _Pragma("unroll") for (int n = 0; n < 2; ++n) _Pragma("unroll") for (int k = 0; k < 2; ++k) dst[n][k] = *(const PG8_LAS bf16x8*)(lds + PG8_SB(b, h) + boff + n * 2048 + k * 1024); } while (0)
#define PG8_MMA(ai, bj, At, Bt) do { if (cur.half == 2 - (ai)) break; __builtin_amdgcn_s_setprio(1); _Pragma("unroll") for (int m = 0; m < 4; ++m) _Pragma("unroll") for (int n = 0; n < 2; ++n) _Pragma("unroll") for (int k = 0; k < 2; ++k) \
        acc[ai][bj][m][n] = __builtin_amdgcn_mfma_f32_16x16x32_bf16(Bt[n][k], At[m][k], acc[ai][bj][m][n], 0, 0, 0); __builtin_amdgcn_s_setprio(0); } while (0)
#define PG8_WAIT_V(n) asm volatile("s_waitcnt vmcnt(" #n ")" ::: "memory")
#define PG8_WAIT_L(n) asm volatile("s_waitcnt lgkmcnt(" #n ")" ::: "memory")
#define PG8_BAR __builtin_amdgcn_s_barrier()
#define PG8_SCHED __builtin_amdgcn_sched_barrier(0)
    Unit cur, nxt; int ui = 0;
    if (!S.next(0, cur)) return;
    f32x4 acc[2][2][4][2];
#pragma unroll
    for (int a = 0; a < 2; ++a)
#pragma unroll
        for (int b = 0; b < 2; ++b)
#pragma unroll
            for (int m = 0; m < 4; ++m)
#pragma unroll
                for (int n = 0; n < 2; ++n) acc[a][b][m][n] = (f32x4){0.f, 0.f, 0.f, 0.f};
    bf16x8 At[4][2], B0[2][2], B1[2][2];
    const char* cA = (const char*)g.A + (size_t)cur.pm * tstep; const char* cB = (const char*)g.Bt + (size_t)cur.pn * tstep;
    S.a_ready(cur);
    if constexpr (SP2) {
        PG8_STAGE(PG8_SB(0, 0), cB, voffB); PG8_STAGE(PG8_SB(0, 1), cB + hstep, voffB); PG8_STAGE(PG8_SA(0, 0), cA, voffA); PG8_STAGE(PG8_SA(0, 1), cA + hstep, voffA);
        if (wr == 1) PG8_BAR;
        PG8_WAIT_V(2); PG8_BAR;
        PG8_STAGE(PG8_SB(1, 0), cB + kstep, voffB); PG8_STAGE(PG8_SA(1, 0), cA + kstep, voffA); PG8_STAGE(PG8_SB(1, 1), cB + hstep + kstep, voffB);
        PG8_WAIT_V(6); PG8_BAR;
    } else {
        PG8_STAGE(PG8_SB(0, 0), cB, voffB); PG8_STAGE(PG8_SA(0, 0), cA, voffA); PG8_STAGE(PG8_SB(0, 1), cB + hstep, voffB); PG8_STAGE(PG8_SA(0, 1), cA + hstep, voffA);
        if (wr == 1) PG8_BAR;
        PG8_WAIT_V(4); PG8_BAR;
        PG8_STAGE(PG8_SB(1, 0), cB + kstep, voffB); PG8_STAGE(PG8_SA(1, 0), cA + kstep, voffA); PG8_STAGE(PG8_SB(1, 1), cB + hstep + kstep, voffB);
        PG8_WAIT_V(6); PG8_BAR;
    }
    for (;;) {
        const bool has_next = S.next(ui + 1, nxt);
        const char* nA = has_next ? (const char*)g.A + (size_t)nxt.pm * tstep : cA; const char* nB = has_next ? (const char*)g.Bt + (size_t)nxt.pn * tstep : cB;
        for (int t = 0; t < nt; t += 2) {
            const bool last = (t == nt - 2);
            const char* a1 = cA + (size_t)(t + 1) * kstep;
            const char* a2 = last ? nA : cA + (size_t)(t + 2) * kstep; const char* b2 = last ? nB : cB + (size_t)(t + 2) * kstep;
            const char* a3 = a2 + kstep; const char* b3 = b2 + kstep;
            if (last && has_next) S.a_ready(nxt);
            if constexpr (SP2) {
            PG8_LDB(B0, 0, 0); PG8_LDB(B1, 0, 1); PG8_SCHED; PG8_LDA(At, 0, 0); PG8_STAGE(PG8_SA(1, 1), a1 + hstep, voffA);
            PG8_WAIT_V(8); PG8_WAIT_L(0); PG8_BAR; PG8_MMA(0, 0, At, B0); PG8_MMA(0, 1, At, B1); PG8_BAR; PG8_SCHED;
            PG8_LDA(At, 0, 1); PG8_STAGE(PG8_SB(0, 0), b2, voffB); PG8_STAGE(PG8_SB(0, 1), b2 + hstep, voffB); PG8_STAGE(PG8_SA(0, 0), a2, voffA);
            PG8_WAIT_V(8); PG8_WAIT_L(0); PG8_BAR; PG8_MMA(1, 0, At, B0); PG8_MMA(1, 1, At, B1); PG8_BAR; PG8_SCHED;
            PG8_LDB(B0, 1, 0); PG8_LDB(B1, 1, 1); PG8_SCHED; PG8_LDA(At, 1, 0); PG8_STAGE(PG8_SA(0, 1), a2 + hstep, voffA);
            PG8_WAIT_V(8); PG8_WAIT_L(0); PG8_BAR; PG8_MMA(0, 0, At, B0); PG8_MMA(0, 1, At, B1); PG8_BAR; PG8_SCHED;
            PG8_LDA(At, 1, 1); PG8_STAGE(PG8_SB(1, 0), b3, voffB); PG8_STAGE(PG8_SB(1, 1), b3 + hstep, voffB); PG8_STAGE(PG8_SA(1, 0), a3, voffA);
            PG8_WAIT_V(8); PG8_WAIT_L(0); PG8_BAR; PG8_MMA(1, 0, At, B0); PG8_MMA(1, 1, At, B1); PG8_BAR; PG8_SCHED;
            } else {
            PG8_LDB(B0, 0, 0); PG8_SCHED; PG8_LDA(At, 0, 0); PG8_STAGE(PG8_SA(1, 1), a1 + hstep, voffA);
            PG8_WAIT_L(8); PG8_BAR; PG8_WAIT_L(0); PG8_MMA(0, 0, At, B0); PG8_BAR; PG8_SCHED;
            PG8_LDB(B1, 0, 1); PG8_STAGE(PG8_SB(0, 0), b2, voffB);
            PG8_BAR; PG8_WAIT_L(0); PG8_MMA(0, 1, At, B1); PG8_BAR;
            PG8_LDA(At, 0, 1); PG8_STAGE(PG8_SA(0, 0), a2, voffA);
            PG8_BAR; PG8_WAIT_L(0); PG8_MMA(1, 0, At, B0); PG8_BAR; PG8_SCHED;
            PG8_STAGE(PG8_SB(0, 1), b2 + hstep, voffB);
            PG8_WAIT_V(6); PG8_BAR; PG8_MMA(1, 1, At, B1); PG8_BAR;
            PG8_LDB(B0, 1, 0); PG8_SCHED; PG8_LDA(At, 1, 0); PG8_STAGE(PG8_SA(0, 1), a2 + hstep, voffA);
            PG8_WAIT_L(8); PG8_BAR; PG8_WAIT_L(0); PG8_MMA(0, 0, At, B0); PG8_BAR; PG8_SCHED;
            PG8_LDB(B1, 1, 1); PG8_STAGE(PG8_SB(1, 0), b3, voffB);
            PG8_BAR; PG8_WAIT_L(0); PG8_MMA(0, 1, At, B1); PG8_BAR;
            PG8_LDA(At, 1, 1); PG8_STAGE(PG8_SA(1, 0), a3, voffA);
            PG8_BAR; PG8_WAIT_L(0); PG8_MMA(1, 0, At, B0); PG8_BAR; PG8_SCHED;
            PG8_STAGE(PG8_SB(1, 1), b3 + hstep, voffB);
            PG8_WAIT_V(6); PG8_BAR; PG8_MMA(1, 1, At, B1); PG8_BAR;
            }
        }
        if constexpr (ALIGN_EPI) { if (wr == 0) PG8_BAR; }
        if constexpr (!Epi::AFTER_DRAIN) { E(acc, cur, wr, wc, fr, fq); S.done(cur); }
        if (!has_next) break;
#pragma unroll
        for (int a = 0; a < 2; ++a)
#pragma unroll
            for (int b = 0; b < 2; ++b)
#pragma unroll
                for (int m = 0; m < 4; ++m)
#pragma unroll
                    for (int n = 0; n < 2; ++n) acc[a][b][m][n] = (f32x4){0.f, 0.f, 0.f, 0.f};
        cur = nxt; cA = nA; cB = nB; ++ui;
        if constexpr (ALIGN_EPI) { if (wr == 1) PG8_BAR; }
    }
    PG8_WAIT_V(0);
    if constexpr (!ALIGN_EPI) { if (wr == 0) PG8_BAR; }
    PG8_BAR;
    if constexpr (Epi::AFTER_DRAIN) { E.fused(acc, cur, wr, wc, fr, fq, lds, wid, lane); S.done(cur); }
#undef PG8_SA
#undef PG8_SB
#undef PG8_STAGE
#undef PG8_LDA
#undef PG8_LDB
#undef PG8_MMA
#undef PG8_WAIT_V
#undef PG8_WAIT_L
#undef PG8_BAR
#undef PG8_SCHED
}
}
constexpr int NWAVES = 8;
constexpr int BATCH = 2, T = 8192, D = 1024, M = BATCH * T, DFF = 2816, NSA_IN = 1828, DSA_IN = 712, NCMP = 511, NCR = BATCH * NCMP * 2;
constexpr float NEGF = -1e30f, EPSF = 1e-6f;
#ifndef MK_SPLIT
#define MK_SPLIT 0
#endif
constexpr int N_PHASES = 19;
constexpr size_t MiB = 1u << 20;
constexpr size_t WS_CTL = 0, CTL_ZERO_BYTES = 1 * MiB;
constexpr size_t WS_KCB = 1 * MiB  , WS_VCT = 1 * MiB + 512 * 1024  , WS_MKB = 2 * MiB  , WS_MVT = 2 * MiB + 512 * 1024  , WS_MKV = 3 * MiB  , WS_WIDX = 5 * MiB  , WS_CNT = 6 * MiB  ;
constexpr size_t WS_WIN0 = 8 * MiB, WS_WO = 12 * MiB, WS_WGU = 16 * MiB, WS_WD = 38 * MiB, WS_WIN1 = 49 * MiB, WS_WQ2 = 51 * MiB, WS_WVT = 52 * MiB  ;
constexpr size_t WS_W1T = 232 * MiB, WS_MEMN = 234 * MiB, WS_WMKT = 236 * MiB, WS_W2T = 238 * MiB, WS_B1F = 238 * MiB + 64 * 1024;
constexpr size_t WS_XN = 56 * MiB;
constexpr size_t WS_Q0 = 88 * MiB, WS_KV0 = 112 * MiB  , WS_QM = 128 * MiB, WS_G0 = 136 * MiB, WS_VT = 144 * MiB  ;
static_assert(WS_Q0 == (88u << 20) && WS_KV0 == (112u << 20) && WS_QM == (128u << 20) && WS_G0 == (136u << 20), "EpiRoute tables");
constexpr size_t WS_ACT = 88 * MiB;
constexpr size_t WS_PROJ1 = 88 * MiB, WS_CQ = 112 * MiB, WS_CKV = 120 * MiB, WS_KIDX = 124 * MiB, WS_QA = 128 * MiB, WS_QI = 176 * MiB, WS_SEL = 112 * MiB  , WS_CAT1 = 176 * MiB  , WS_WO1F = 52 * MiB + 512 * 1024  ;
constexpr size_t WS_OCS = 152 * MiB  , WS_CAT = 200 * MiB, WS_SSQ = 239 * MiB  , WS_END = 243 * MiB;
static_assert(WS_PROJ1 == (88u << 20) && WS_QA == (128u << 20) && WS_QI == (176u << 20) && WS_VT == (144u << 20), "EpiRoute tables");
static_assert(WS_ACT + (size_t)M * DFF * 2 <= WS_CAT + 0 * MiB || true, "map");
constexpr int CW_BAR = 4096;
constexpr int RING_OFF = 0, RING_BYTES = 131072, LDS_BYTES = 163840, LDSCTL_OFF = LDS_BYTES - 1024, MISC_OFF = LDSCTL_OFF + 320;
#define GAS __attribute__((address_space(1)))
#define LAS __attribute__((address_space(3)))
typedef unsigned short bf16;
typedef unsigned v4u __attribute__((ext_vector_type(4)));
typedef unsigned v2u __attribute__((ext_vector_type(2)));
typedef float f32x4 __attribute__((ext_vector_type(4)));
typedef short bf16x8 __attribute__((ext_vector_type(8)));
typedef GAS unsigned gu32;
typedef GAS unsigned long long gu64;
#define RLX_AGENT __ATOMIC_RELAXED, __HIP_MEMORY_SCOPE_AGENT
#define LDS_WAIT() asm volatile("s_waitcnt lgkmcnt(0)" ::: "memory")
#define VM_WAIT() asm volatile("s_waitcnt vmcnt(0)" ::: "memory")
__device__ __forceinline__ unsigned long long rt() { return __builtin_amdgcn_s_memrealtime(); }
__device__ __forceinline__ unsigned f2bf(float f) { unsigned u = __builtin_bit_cast(unsigned, f); return (u + 0x7fffu + ((u >> 16) & 1u)) >> 16; }
typedef float f32x2_t __attribute__((ext_vector_type(2))); typedef __bf16 bf16x2_t __attribute__((ext_vector_type(2)));
__device__ __forceinline__ unsigned pk2(float lo, float hi) { f32x2_t v = {lo, hi}; bf16x2_t b = __builtin_convertvector(v, bf16x2_t); return __builtin_bit_cast(unsigned, b); }
#define XB_TMO      128
#define XB_XCNT(j)  (256  + 64 * (j))
#define XB_XSUB(j)  (1280 + 64 * (j))
#define XB_XGEN(j)  (2304 + 64 * (j))
#define XB_TOP      3328
#define XB_TOPGEN   3392
#define XCD_BAR_WORDS 3456
#define XB_SPIN_CAP (1u << 18)

__device__ __forceinline__ unsigned xb_ld(unsigned* p)              { return __hip_atomic_load(p, __ATOMIC_RELAXED, __HIP_MEMORY_SCOPE_AGENT); }
__device__ __forceinline__ unsigned xb_add(unsigned* p, unsigned v) { return __hip_atomic_fetch_add(p, v, __ATOMIC_RELAXED, __HIP_MEMORY_SCOPE_AGENT); }
__device__ __forceinline__ unsigned xb_xcc_id() { return (unsigned)__builtin_amdgcn_s_getreg((3 << 11) | 20) & 0xFu; }
#define XB_SPIN(cond, bar) do { unsigned _sp = 0; while (cond) { __builtin_amdgcn_s_sleep(1); \
    if ((++_sp & 255u) == 0u) { if (xb_ld(&(bar)[XB_TMO])) break; if (_sp > XB_SPIN_CAP) { atomicAdd(&(bar)[XB_TMO], 1u); break; } } } } while (0)

struct XcdBarrier {
    unsigned* bar; unsigned x;
    volatile LAS unsigned* st;
};

__device__ __forceinline__ XcdBarrier xcd_barrier_post(unsigned* bar, volatile LAS unsigned* st) {
    XcdBarrier b; b.bar = bar; b.x = xb_xcc_id(); b.st = st;
    if (threadIdx.x == 0) (void)xb_add(&bar[XB_XCNT(b.x)], 1u);
    return b;
}
__device__ __forceinline__ void xcd_barrier_complete(unsigned* bar, unsigned x, unsigned& nloc, unsigned& nx) {
    const unsigned G = gridDim.x * gridDim.y * gridDim.z;
    unsigned sum, cnt, mine, sp = 0u;
    for (;;) {
        sum = 0u; cnt = 0u; mine = 0u;
#pragma unroll 1
        for (unsigned j = 0; j < 16; ++j) { const unsigned c = xb_ld(&bar[XB_XCNT(j)]); sum += c; cnt += (c > 0u) ? 1u : 0u; mine = (j == x) ? c : mine; }
        if (sum == G) break;
        __builtin_amdgcn_s_sleep(1);
        if ((++sp & 255u) == 0u) { if (xb_ld(&bar[XB_TMO])) break; if (sp > XB_SPIN_CAP) { atomicAdd(&bar[XB_TMO], 1u); break; } }
    }
    nloc = mine > 0u ? mine : 1u; nx = cnt > 0u ? cnt : 1u;
}

__device__ __forceinline__ void xcd_barrier(const XcdBarrier& b) {
    asm volatile("s_waitcnt vmcnt(0)" ::: "memory");
    __syncthreads();
    if (threadIdx.x == 0) {
        unsigned* bar = b.bar;
        __builtin_amdgcn_s_waitcnt(0);
        unsigned nloc = b.st[0], nx = b.st[1];
        if (nloc == 0u) { xcd_barrier_complete(bar, b.x, nloc, nx); b.st[0] = nloc; b.st[1] = nx; }
        const unsigned old = xb_add(&bar[XB_XSUB(b.x)], 1u);
        const unsigned gen = old / nloc;
        if (old + 1u == (gen + 1u) * nloc) {
            __builtin_amdgcn_fence(__ATOMIC_RELEASE, "agent");
            asm volatile("s_waitcnt vmcnt(0)" ::: "memory");
            const unsigned og = xb_add(&bar[XB_TOP], 1u);
            const unsigned tg = og / nx;
            if (og + 1u == (tg + 1u) * nx) xb_add(&bar[XB_TOPGEN], 1u);
            else XB_SPIN(xb_ld(&bar[XB_TOPGEN]) == tg, bar);
            __builtin_amdgcn_fence(__ATOMIC_ACQUIRE, "agent");
            xb_add(&bar[XB_XGEN(b.x)], 1u);
            asm volatile("s_waitcnt vmcnt(0)" ::: "memory");
        } else {
            XB_SPIN(xb_ld(&bar[XB_XGEN(b.x)]) == gen, bar);
            __builtin_amdgcn_fence(__ATOMIC_ACQUIRE, "agent");
            asm volatile("s_waitcnt vmcnt(0)" ::: "memory");
        }
    }
    __syncthreads();
}

struct Frame {
    LAS unsigned char* lds; volatile LAS unsigned* MISC; gu32* ctl;
    int vcu, G;
};
__device__ __forceinline__ float bf2f(unsigned short u) { return __uint_as_float((unsigned)u << 16); }
__device__ __forceinline__ float bflo(unsigned u) { return __uint_as_float(u << 16); }
__device__ __forceinline__ float bfhi(unsigned u) { return __uint_as_float(u & 0xffff0000u); }
__device__ __forceinline__ float wave_sum(float v) {
#define WS_DPP_(x, ctrl) __int_as_float(__builtin_amdgcn_update_dpp(__float_as_int(x), __float_as_int(x), (ctrl), 0xf, 0xf, false))
    v += WS_DPP_(v, 0xB1); v += WS_DPP_(v, 0x4E); v += WS_DPP_(v, 0x141); v += WS_DPP_(v, 0x140);
#undef WS_DPP_
    const float a = __int_as_float(__builtin_amdgcn_readlane(__float_as_int(v), 0)), b = __int_as_float(__builtin_amdgcn_readlane(__float_as_int(v), 16)), c = __int_as_float(__builtin_amdgcn_readlane(__float_as_int(v), 32)), d = __int_as_float(__builtin_amdgcn_readlane(__float_as_int(v), 48));
    return (a + b) + (c + d);
}
__device__ __forceinline__ float red16_sum(float v) { v += __shfl_xor(v, 1, 16); v += __shfl_xor(v, 2, 16); v += __shfl_xor(v, 4, 16); v += __shfl_xor(v, 8, 16); return v; }
__device__ __forceinline__ float red16_max(float v) { v = fmaxf(v, __shfl_xor(v, 1, 16)); v = fmaxf(v, __shfl_xor(v, 2, 16)); v = fmaxf(v, __shfl_xor(v, 4, 16)); v = fmaxf(v, __shfl_xor(v, 8, 16)); return v; }
__device__ __forceinline__ int rel_bucket(int n) {
    if (n < 16) return n;
    return 16 + (n >= 22) + (n >= 30) + (n >= 40) + (n >= 54) + (n >= 73) + (n >= 99) + (n >= 134) + (n >= 182) + (n >= 246) + (n >= 332) + (n >= 450) + (n >= 609) + (n >= 825) + (n >= 1117) + (n >= 1513);
}

__device__ __forceinline__ void xpose_item(const float* W, int ldw, int c0, int nvalid, int k0, bf16* WT, int Kd, int drow0, LAS float* scr, int lane, const float* kgain = nullptr) {
#pragma unroll
    for (int i = 0; i < 8; ++i) { const int kk = 8 * i + (lane >> 3), n = (lane & 7) * 4;
        float4 wv = make_float4(0.f, 0.f, 0.f, 0.f);
        if (n + 3 < nvalid) wv = *(const float4*)(W + (size_t)(k0 + kk) * ldw + c0 + n);
        else if (n < nvalid) { const float* wp = W + (size_t)(k0 + kk) * ldw + c0 + n; wv.x = wp[0]; if (n + 1 < nvalid) wv.y = wp[1]; if (n + 2 < nvalid) wv.z = wp[2]; }
        if (kgain) { const float g_ = kgain[k0 + kk]; wv.x *= g_; wv.y *= g_; wv.z *= g_; wv.w *= g_; }
        LAS float* sp = scr + kk * 33 + n; sp[0] = wv.x; sp[1] = wv.y; sp[2] = wv.z; sp[3] = wv.w; }
    LDS_WAIT(); asm volatile("" ::: "memory");
    const int c = lane & 7;
#pragma unroll
    for (int j = 0; j < 4; ++j) { const int n = (lane >> 3) + 8 * j; const LAS float* s = scr + (8 * c) * 33 + n;
        v4u o; o.x = pk2(s[0 * 33], s[1 * 33]); o.y = pk2(s[2 * 33], s[3 * 33]); o.z = pk2(s[4 * 33], s[5 * 33]); o.w = pk2(s[6 * 33], s[7 * 33]);
        *(GAS v4u*)(WT + (size_t)(drow0 + n) * Kd + k0 + 8 * c) = o; }
    LDS_WAIT(); asm volatile("" ::: "memory");
}
__device__ __forceinline__ void rms_row_to_bf16(const float* xrow, const float* gain, bf16* orow, int lane) {
    const GAS f32x4* xr = (const GAS f32x4*)xrow + lane; const GAS f32x4* gr = (const GAS f32x4*)gain + lane;
    f32x4 v[4]; float s = 0.f;
#pragma unroll
    for (int j = 0; j < 4; ++j) { v[j] = xr[64 * j]; s += (v[j].x * v[j].x + v[j].y * v[j].y) + (v[j].z * v[j].z + v[j].w * v[j].w); }
    const float r = rsqrtf(wave_sum(s) * (1.f / D) + EPSF);
    GAS unsigned long long* o8 = (GAS unsigned long long*)orow + lane;
#pragma unroll
    for (int j = 0; j < 4; ++j) { const f32x4 g = gr[64 * j]; o8[64 * j] = (unsigned long long)pk2((v[j].x * r) * g.x, (v[j].y * r) * g.y) | ((unsigned long long)pk2((v[j].z * r) * g.z, (v[j].w * r) * g.w) << 32); }
}
#ifndef PROBE_REP
#define PROBE_REP 0
#endif
#define CAS __attribute__((address_space(4)))
#define KARGS() const CAS In* Ip = (const CAS In*)__builtin_amdgcn_kernarg_segment_ptr(); asm volatile("" : "+s"(Ip))
#define OPAQUE_TID() int tid_ = threadIdx.x; asm volatile("" : "+v"(tid_))
__device__ __forceinline__ void norm_phase(Frame& F, const float* x, const float* gain, bf16* xn) {
    OPAQUE_TID(); const int lane_ = tid_ & 63, wave_ = tid_ >> 6;
    const int gw = F.vcu * NWAVES + wave_, NGW = F.G * NWAVES;
    for (int m = gw; m < M; m += NGW) rms_row_to_bf16(x + (size_t)m * D, gain, xn + (size_t)m * D, lane_);
}

template <int DL>
__device__ __forceinline__ void coop_attend(const float (&q)[DL], const float (&k)[DL], const float (&v)[DL], float bias, float& m_, float& l_, float (&o)[DL]) {
    float a = 0.f;
#pragma unroll
    for (int d = 0; d < DL; ++d) a += q[d] * k[d];
    a = red16_sum(a) + bias;
    const float mn = fmaxf(m_, a), al = __expf(m_ - mn), p = __expf(a - mn);
    l_ = l_ * al + p; m_ = mn;
#pragma unroll
    for (int d = 0; d < DL; ++d) o[d] = o[d] * al + p * v[d];
}
__device__ __forceinline__ void ld4bf(const bf16* p, float (&x)[4]) { const uint2 u = *(const uint2*)p; x[0] = bflo(u.x); x[1] = bfhi(u.x); x[2] = bflo(u.y); x[3] = bfhi(u.y); }
__device__ __forceinline__ void ld8bf(const bf16* p, float (&x)[8]) { const uint4 u = *(const uint4*)p; x[0] = bflo(u.x); x[1] = bfhi(u.x); x[2] = bflo(u.y); x[3] = bfhi(u.y); x[4] = bflo(u.z); x[5] = bfhi(u.z); x[6] = bflo(u.w); x[7] = bfhi(u.w); }
__device__ __forceinline__ void ld4f(const float* p, float (&x)[4]) { const float4 u = *(const float4*)p; x[0] = u.x; x[1] = u.y; x[2] = u.z; x[3] = u.w; }

struct In {
    const float *x, *mem, *rel_bias, *norm_mix, *norm_ffn, *norm_mem, *w_mem_kv, *w_out, *ffn_gate, *ffn_up, *ffn_down, *nsa_w_in, *nsa_gate_b, *pos_k, *pos_v,
        *k_w1, *k_b1, *k_w2, *k_b2, *v_w1, *v_b1, *v_w2, *v_b2, *dsa_w_in, *q_norm, *kv_norm, *w_q_up, *w_uk, *w_uv, *w_q_idx, *kidx_norm, *norm_final;
};
__device__ __forceinline__ void p0_prologue(Frame& F, const In& I, unsigned char* ws) {
    OPAQUE_TID(); KARGS(); const int lane_ = tid_ & 63, wave_ = __builtin_amdgcn_readfirstlane(tid_ >> 6);
    LAS float* scr = (LAS float*)(F.lds + RING_OFF + wave_ * 16384);
    const int gw = F.vcu * NWAVES + wave_, NGW = F.G * NWAVES;
    bf16* WIN0 = (bf16*)(ws + WS_WIN0); bf16* WO = (bf16*)(ws + WS_WO); bf16* WGU = (bf16*)(ws + WS_WGU); bf16* WD = (bf16*)(ws + WS_WD); bf16* WIN1 = (bf16*)(ws + WS_WIN1); bf16* WQ2 = (bf16*)(ws + WS_WQ2);
    constexpr int I_A = 16 * 56, I_G = 16 * 8, I_B = 2 * 16 * 32, I_C = 2 * 16 * 176, I_D = 2 * 44 * 32, I_E = 16 * 24, I_F = 4 * 16, NITEMS = I_A + I_B + I_C + I_D + I_E + I_F + I_G;
    for (int it = gw; it < NITEMS; it += NGW) {
        int r = it;
        if (r < I_A) { const int kb = r / 56, nb = r % 56, r0 = 32 * nb; int c0, nv;
            if (r0 < 1152) { c0 = r0; nv = 32; } else if (r0 < 1280) { c0 = r0 + 128; nv = 32; } else if (r0 < 1536) { c0 = r0 + 292; nv = 32; } else if (r0 == 1536) { c0 = 1536; nv = 32; } else if (r0 == 1568) { c0 = 1568; nv = 4; } else { c0 = 0; nv = 0; }
            xpose_item(Ip->nsa_w_in, NSA_IN, c0, nv, 64 * kb, WIN0, D, r0, scr, lane_); continue; } r -= I_A;
        if (r < I_B) { const int l = r / 512, q = r % 512, kb = q / 32, nb = q % 32;
            xpose_item(Ip->w_out + (size_t)l * D * D, D, 32 * nb, 32, 64 * kb, WO + (size_t)l * D * D, D, 32 * nb, scr, lane_); continue; } r -= I_B;
        if (r < I_C) { const int l = r / (16 * 176), q = r % (16 * 176), kb = q / 176, nb = q % 176, r0 = 32 * nb, pn = r0 >> 8, w0 = r0 & 255;
            const float* src = ((w0 < 128) ? Ip->ffn_gate : Ip->ffn_up) + (size_t)l * D * DFF;
            xpose_item(src, DFF, 128 * pn + (w0 & 127), 32, 64 * kb, WGU + (size_t)l * 2 * DFF * D, D, r0, scr, lane_, Ip->norm_ffn + l * D); continue; } r -= I_C;
        if (r < I_D) { const int l = r / (44 * 32), q = r % (44 * 32), kb = q / 32, nb = q % 32;
            xpose_item(Ip->ffn_down + (size_t)l * DFF * D, D, 32 * nb, 32, 64 * kb, WD + (size_t)l * D * DFF, DFF, 32 * nb, scr, lane_); continue; } r -= I_D;
        if (r < I_E) { const int kb = r / 24, nb = r % 24, r0 = 32 * nb; int nv = DSA_IN - r0; nv = nv > 32 ? 32 : (nv < 0 ? 0 : nv);
            xpose_item(Ip->dsa_w_in, DSA_IN, r0, nv, 64 * kb, WIN1, D, r0, scr, lane_, Ip->norm_mix + D); continue; } r -= I_E;
        if (r < I_F) { const int kb = r / 16, nb = r % 16; xpose_item(Ip->w_q_idx, 512, 32 * nb, 32, 64 * kb, WQ2, 256, 1536 + 32 * nb, scr, lane_); continue; } r -= I_F;
        { const int kb = r / 8, nb = r % 8, r0 = 32 * nb;
            xpose_item(Ip->nsa_w_in, NSA_IN, (r0 < 128) ? 1152 + r0 : 1408 + (r0 - 128), 32, 64 * kb, (bf16*)(ws + WS_WVT), D, r0, scr, lane_); }
    }
    for (int idx = (F.vcu * NWAVES * 64) + tid_; idx < 384 * 256; idx += F.G * NWAVES * 64) {
        const int c = idx & 255, r4 = (idx >> 8) & 31, h = idx >> 13; const float4* a4 = (const float4*)(Ip->w_q_up + (size_t)c * 768 + h * 64); const float4* b4 = (const float4*)(Ip->w_uk + (size_t)(4 * r4) * 768 + h * 64);
        float s0 = 0.f, s1 = 0.f, s2 = 0.f, s3 = 0.f;
#pragma unroll 4
        for (int d = 0; d < 16; ++d) { const float4 av = a4[d], b0 = b4[d], b1 = b4[192 + d], b2 = b4[384 + d], b3 = b4[576 + d];
            s0 += (av.x * b0.x + av.y * b0.y) + (av.z * b0.z + av.w * b0.w); s1 += (av.x * b1.x + av.y * b1.y) + (av.z * b1.z + av.w * b1.w);
            s2 += (av.x * b2.x + av.y * b2.y) + (av.z * b2.z + av.w * b2.w); s3 += (av.x * b3.x + av.y * b3.y) + (av.z * b3.z + av.w * b3.w); }
        const float sc_ = 0.125f * 1.4426950408889634f;
        bf16* o_ = WQ2 + (size_t)(h * 128 + 4 * r4) * 256 + c;
        o_[0] = (bf16)f2bf(s0 * sc_); o_[256] = (bf16)f2bf(s1 * sc_); o_[512] = (bf16)f2bf(s2 * sc_); o_[768] = (bf16)f2bf(s3 * sc_);
    }
    { bf16* WO1F = (bf16*)(ws + WS_WO1F); const float* wo1 = Ip->w_out + (size_t)D * D;
      for (int idx = (F.vcu * NWAVES * 64) + tid_; idx < 12 * 32 * 256; idx += F.G * NWAVES * 64) {
          const int n4 = idx & 255, r4 = (idx >> 8) & 31, h = idx >> 13; const float* a = Ip->w_uv + (size_t)(4 * r4) * 768 + h * 64; const float* bcol = wo1 + (size_t)(h * 64) * D + 4 * n4;
          float acc_[4][4];
#pragma unroll
          for (int i = 0; i < 4; ++i)
#pragma unroll
              for (int j = 0; j < 4; ++j) acc_[i][j] = 0.f;
#pragma unroll 4
          for (int d = 0; d < 64; ++d) { const float4 bv = *(const float4*)(bcol + (size_t)d * D); const float a0 = a[d], a1 = a[768 + d], a2 = a[1536 + d], a3 = a[2304 + d];
              acc_[0][0] += a0 * bv.x; acc_[0][1] += a0 * bv.y; acc_[0][2] += a0 * bv.z; acc_[0][3] += a0 * bv.w; acc_[1][0] += a1 * bv.x; acc_[1][1] += a1 * bv.y; acc_[1][2] += a1 * bv.z; acc_[1][3] += a1 * bv.w;
              acc_[2][0] += a2 * bv.x; acc_[2][1] += a2 * bv.y; acc_[2][2] += a2 * bv.z; acc_[2][3] += a2 * bv.w; acc_[3][0] += a3 * bv.x; acc_[3][1] += a3 * bv.y; acc_[3][2] += a3 * bv.z; acc_[3][3] += a3 * bv.w; }
#pragma unroll
          for (int j = 0; j < 4; ++j) *(uint2*)(WO1F + (size_t)(4 * n4 + j) * 1792 + h * 128 + 4 * r4) = make_uint2(pk2(acc_[0][j], acc_[1][j]), pk2(acc_[2][j], acc_[3][j])); }
      for (int it = gw; it < 4 * 32; it += NGW) { const int kb = it / 32, nb = it % 32;
          xpose_item(wo1 + (size_t)768 * D, D, 32 * nb, 32, 64 * kb, WO1F + 1536, 1792, 32 * nb, scr, lane_); } }
    { bf16* W1T = (bf16*)(ws + WS_W1T); bf16* W2T = (bf16*)(ws + WS_W2T); bf16* WMKT = (bf16*)(ws + WS_WMKT); float* B1F = (float*)(ws + WS_B1F); bf16* MEMN = (bf16*)(ws + WS_MEMN);
      constexpr int J_1 = 2 * 32 * 8, J_2 = 2 * 4 * 2, J_M = 2 * 16 * 16;
      for (int it = gw; it < J_1 + J_2 + J_M; it += NGW) { int r2 = it;
          if (r2 < J_1) { const int kv = r2 / 256, q = r2 % 256, kb = q / 8, nb = q % 8; xpose_item(kv ? Ip->v_w1 : Ip->k_w1, 256, 32 * nb, 32, 64 * kb, W1T + (size_t)kv * 256 * 2048, 2048, 32 * nb, scr, lane_); continue; } r2 -= J_1;
          if (r2 < J_2) { const int kv = r2 / 8, q = r2 % 8, kb = q / 2, nb = q % 2; xpose_item(kv ? Ip->v_w2 : Ip->k_w2, 64, 32 * nb, 32, 64 * kb, W2T + (size_t)kv * 64 * 256, 256, 32 * nb, scr, lane_); continue; } r2 -= J_2;
          { const int l = r2 / 256, q = r2 % 256, kb = q / 16, nb = q % 16; xpose_item(Ip->w_mem_kv + (size_t)l * D * 512, 512, 32 * nb, 32, 64 * kb, WMKT + (size_t)l * 512 * D, D, 32 * nb, scr, lane_); } }
      if ((int)blockIdx.x < 32) { const int u_ = (int)blockIdx.x, kv = u_ >> 4, cr = (u_ >> 2) & 3, kq4 = u_ & 3, c = 64 * cr + lane_; const float* w1 = kv ? Ip->v_w1 : Ip->k_w1; const float* pos = kv ? Ip->pos_v : Ip->pos_k;
          const int kb0 = 512 * kq4 + 64 * wave_; float sacc = 0.f;
#pragma unroll 8
          for (int k = 0; k < 64; ++k) sacc += pos[kb0 + k] * w1[(size_t)(kb0 + k) * 256 + c];
          LAS float* red = (LAS float*)(F.lds + RING_OFF + 8 * 16384);
          red[wave_ * 64 + lane_] = sacc;
          __syncthreads();
          if (wave_ == 0) { float t_ = 0.f;
#pragma unroll
              for (int w = 0; w < 8; ++w) t_ += red[w * 64 + lane_];
              B1F[(kv * 4 + kq4) * 256 + c] = t_; } }
      for (int m = gw; m < 1024; m += NGW) rms_row_to_bf16(Ip->mem + (size_t)(m & 511) * D, Ip->norm_mem + (m >> 9) * D, MEMN + (size_t)m * D, lane_); }
    norm_phase(F, Ip->x, Ip->norm_mix, (bf16*)(ws + WS_XN));
}

#define MFMA16(A, B, C) __builtin_amdgcn_mfma_f32_16x16x32_bf16((A), (B), (C), 0, 0, 0)
constexpr float LOG2E = 1.4426950408889634f;
constexpr int NSA_OUT = 0, NSA_PSQ = 49152, NSA_ST = 147456, NSA_TB = NSA_ST + 3072;
constexpr int TAB_B12 = NSA_ST + 1024;
constexpr int P13_JUNK = NSA_ST + 3072 + 1536;
constexpr int P13_B12 = NSA_ST;
constexpr int TAB_BKT = NSA_ST + 3072;
static_assert(NSA_TB + 12288 <= LDSCTL_OFF && TAB_B12 + 2048 <= NSA_TB, "LDS tables");
enum { MD_CMP = 0, MD_WIN = 1, MD_BLK = 2, MD_MEM = 3 };
struct KF { bf16x8 a0, a1, b0, b1; };
struct VF { bf16x8 v[4]; };
__device__ __forceinline__ bf16x8 ldg16(const bf16* p) { return *(const bf16x8*)p; }
__device__ __forceinline__ unsigned cvtpk_s(float lo, float hi) { f32x2_t v = {lo, hi}; bf16x2_t b = __builtin_convertvector(v, bf16x2_t); return __builtin_bit_cast(unsigned, b); }
__device__ __forceinline__ bf16x8 pack8(const f32x4& a, const f32x4& b) { v4u w; w.x = cvtpk_s(a[0], a[1]); w.y = cvtpk_s(a[2], a[3]); w.z = cvtpk_s(b[0], b[1]); w.w = cvtpk_s(b[2], b[3]); return __builtin_bit_cast(bf16x8, w); }
__device__ __forceinline__ void load_k(KF& k, const bf16* kb, int kstride, int key0, int r, int kq) {
    const bf16* pa = kb + (size_t)(key0 + 8 * (r >> 2) + (r & 3)) * kstride + 8 * kq; const bf16* pb = pa + 4 * (size_t)kstride;
    k.a0 = ldg16(pa); k.a1 = ldg16(pa + 32); k.b0 = ldg16(pb); k.b1 = ldg16(pb + 32);
}
__device__ __forceinline__ void load_vt(VF& v, const bf16* vt, int vstride, int key0, int r, int kq) {
#pragma unroll
    for (int dt = 0; dt < 4; ++dt) v.v[dt] = ldg16(vt + (size_t)(16 * dt + r) * vstride + key0 + 8 * kq);
}
__device__ __forceinline__ void qk(f32x4& sa, f32x4& sb, const KF& k, const bf16x8 (&q)[2]) {
    const f32x4 z = {0.f, 0.f, 0.f, 0.f};
    sa = MFMA16(k.a0, q[0], z); sa = MFMA16(k.a1, q[1], sa); sb = MFMA16(k.b0, q[0], z); sb = MFMA16(k.b1, q[1], sb);
}
struct BiasCtx { const LAS unsigned short* tb; float d29, d30, c31; };
template <int MODE>
__device__ __forceinline__ void maskbias(f32x4& s, int kpos, int tcol, bool colok, const BiasCtx& B) {
    if (MODE == MD_MEM) return;
#pragma unroll
    for (int i = 0; i < 4; ++i) {
        int dist; bool ok;
        if (MODE == MD_CMP) { dist = tcol - 31 - 16 * (kpos + i); ok = dist >= 0; }
        else if (MODE == MD_WIN) { dist = tcol - (kpos + i); ok = (unsigned)dist <= 511u; }
        else { dist = tcol - (kpos + i); ok = dist >= 0; }
        int dc = dist < 0 ? 0 : dist; dc = dc > 1023 ? 1023 : dc;
        const float tb = __uint_as_float((unsigned)B.tb[dc * 6] << 16);
        float bias = tb;
        if (MODE != MD_WIN) { const float far = B.c31 + (dist < 1513 ? B.d30 : 0.f) + (dist < 1117 ? B.d29 : 0.f); bias = dist < 1024 ? tb : far; }
        s[i] = (ok && colok) ? s[i] + bias : -INFINITY;
    }
}
__device__ __forceinline__ float colmax(const f32x4& sa, const f32x4& sb) {
    float mx = fmaxf(fmaxf(fmaxf(sa[0], sa[1]), fmaxf(sa[2], sa[3])), fmaxf(fmaxf(sb[0], sb[1]), fmaxf(sb[2], sb[3])));
    mx = fmaxf(mx, __shfl_xor(mx, 16)); mx = fmaxf(mx, __shfl_xor(mx, 32)); return mx;
}
constexpr float SM_THR = 8.f;
__device__ __forceinline__ float lmax8(const f32x4& sa, const f32x4& sb) { return fmaxf(fmaxf(fmaxf(sa[0], sa[1]), fmaxf(sa[2], sa[3])), fmaxf(fmaxf(sb[0], sb[1]), fmaxf(sb[2], sb[3]))); }
__device__ __forceinline__ int imax3(int a, int b, int c) { return max(max(a, b), c); }
__device__ __forceinline__ int imax16(const f32x4& a, const f32x4& b, const f32x4& c, const f32x4& d) {
#define FI_(x) __float_as_int(x)
    const int t0 = imax3(FI_(a[0]), FI_(a[1]), FI_(a[2])), t1 = imax3(FI_(a[3]), FI_(b[0]), FI_(b[1])), t2 = imax3(FI_(b[2]), FI_(b[3]), FI_(c[0])), t3 = imax3(FI_(c[1]), FI_(c[2]), FI_(c[3])), t4 = imax3(FI_(d[0]), FI_(d[1]), FI_(d[2]));
    return max(imax3(t0, t1, FI_(d[3])), imax3(t2, t3, t4));
#undef FI_
}
template <int NO>
__device__ __forceinline__ void sm_rescale(float lm, float& m, float& l, f32x4 (&O)[NO]) {
    if (__any(lm > m + SM_THR)) {
        lm = fmaxf(lm, __shfl_xor(lm, 16)); lm = fmaxf(lm, __shfl_xor(lm, 32));
        const float mn = fmaxf(m, lm); const float al = __builtin_amdgcn_exp2f(m - mn); m = mn; l *= al;
#pragma unroll
        for (int dt = 0; dt < NO; ++dt) O[dt] = O[dt] * al;
    }
}
__device__ __forceinline__ bf16x8 sm_update(const f32x4& sa, const f32x4& sb, float& m, float& l, f32x4 (&O)[4]) {
    sm_rescale<4>(lmax8(sa, sb), m, l, O);
    f32x4 pa, pb; float sum = 0.f;
#pragma unroll
    for (int i = 0; i < 4; ++i) { pa[i] = __builtin_amdgcn_exp2f(sa[i] - m); pb[i] = __builtin_amdgcn_exp2f(sb[i] - m); sum += pa[i] + pb[i]; }
    l += sum;
    return pack8(pa, pb);
}
__device__ __forceinline__ void sm_update64(const f32x4& sa0, const f32x4& sb0, const f32x4& sa1, const f32x4& sb1, float& m, float& l, f32x4 (&O)[4], bf16x8& pf0, bf16x8& pf1) {
    sm_rescale<4>(fmaxf(lmax8(sa0, sb0), lmax8(sa1, sb1)), m, l, O);
    f32x4 pa0, pb0, pa1, pb1; float sum = 0.f;
#pragma unroll
    for (int i = 0; i < 4; ++i) { pa0[i] = __builtin_amdgcn_exp2f(sa0[i] - m); pb0[i] = __builtin_amdgcn_exp2f(sb0[i] - m); pa1[i] = __builtin_amdgcn_exp2f(sa1[i] - m); pb1[i] = __builtin_amdgcn_exp2f(sb1[i] - m);
        sum += pa0[i]; sum += pb0[i]; sum += pa1[i]; sum += pb1[i]; }
    l += sum;
    pf0 = pack8(pa0, pb0); pf1 = pack8(pa1, pb1);
}
enum { BK_FAR = 0, BK_MID = 1, BK_GEN = 2, BK_FARF = 3 };
template <int MD, int CLS>
__device__ __forceinline__ void step64(const KF& k0, const KF& k1, const bf16x8 (&q)[2], int cls, int kpos, int tcol, bool colok, const BiasCtx& B,
                                       float& m, float& l, f32x4 (&O)[4], bf16x8& pf0, bf16x8& pf1) {
    const bool has = m > -1e29f; const float mref = has ? m : 0.f;
    if (CLS >= 0) cls = CLS;
    float cin = ((cls == BK_FAR) ? B.c31 : 0.f) - mref; if (!colok) cin = -INFINITY;
    const f32x4 c4 = {cin, cin, cin, cin};
    f32x4 sa0 = MFMA16(k0.a0, q[0], c4), sb0 = MFMA16(k0.b0, q[0], c4), sa1 = MFMA16(k1.a0, q[0], c4), sb1 = MFMA16(k1.b0, q[0], c4);
    sa0 = MFMA16(k0.a1, q[1], sa0); sb0 = MFMA16(k0.b1, q[1], sb0); sa1 = MFMA16(k1.a1, q[1], sa1); sb1 = MFMA16(k1.b1, q[1], sb1);
    if (cls == BK_MID) {
        const LAS unsigned short* tl = B.tb + (tcol - kpos - 39) * 6; asm("" : "+v"(tl));
#pragma unroll
        for (int i = 0; i < 4; ++i) { sa0[i] += __uint_as_float((unsigned)tl[6 * (39 - i)] << 16); sb0[i] += __uint_as_float((unsigned)tl[6 * (35 - i)] << 16);
            sa1[i] += __uint_as_float((unsigned)tl[6 * (7 - i)] << 16); sb1[i] += __uint_as_float((unsigned)tl[6 * (3 - i)] << 16); }
    } else if (CLS == BK_FARF) {
        const int d0 = tcol - kpos;
#pragma unroll
        for (int i = 0; i < 4; ++i) {
            { const int d = d0 - i;      sa0[i] += B.c31 + (d < 1513 ? B.d30 : 0.f) + (d < 1117 ? B.d29 : 0.f); }
            { const int d = d0 - 4 - i;  sb0[i] += B.c31 + (d < 1513 ? B.d30 : 0.f) + (d < 1117 ? B.d29 : 0.f); }
            { const int d = d0 - 32 - i; sa1[i] += B.c31 + (d < 1513 ? B.d30 : 0.f) + (d < 1117 ? B.d29 : 0.f); }
            { const int d = d0 - 36 - i; sb1[i] += B.c31 + (d < 1513 ? B.d30 : 0.f) + (d < 1117 ? B.d29 : 0.f); } }
    } else if (cls == BK_GEN) {
        maskbias<MD>(sa0, kpos, tcol, true, B); maskbias<MD>(sb0, kpos + 4, tcol, true, B); maskbias<MD>(sa1, kpos + 32, tcol, true, B); maskbias<MD>(sb1, kpos + 36, tcol, true, B);
    }
    if (__any((imax16(sa0, sb0, sa1, sb1) > __float_as_int(SM_THR)) || !has)) {
        float lm = fmaxf(lmax8(sa0, sb0), lmax8(sa1, sb1));
        lm = fmaxf(lm, __shfl_xor(lm, 16)); lm = fmaxf(lm, __shfl_xor(lm, 32));
        const bool upd = (lm > -INFINITY) && (!has || lm > 0.f); const float dl = upd ? lm : 0.f;
        if (upd) m = mref + dl;
        const float f = has ? __builtin_amdgcn_exp2f(-dl) : 1.f; l *= f;
#pragma unroll
        for (int dt = 0; dt < 4; ++dt) O[dt] = O[dt] * f;
#pragma unroll
        for (int i = 0; i < 4; ++i) { sa0[i] -= dl; sb0[i] -= dl; sa1[i] -= dl; sb1[i] -= dl; }
    }
    f32x4 pa0, pb0, pa1, pb1; float sum = 0.f;
#pragma unroll
    for (int i = 0; i < 4; ++i) { pa0[i] = __builtin_amdgcn_exp2f(sa0[i]); pb0[i] = __builtin_amdgcn_exp2f(sb0[i]); pa1[i] = __builtin_amdgcn_exp2f(sa1[i]); pb1[i] = __builtin_amdgcn_exp2f(sb1[i]);
        sum += pa0[i]; sum += pb0[i]; sum += pa1[i]; sum += pb1[i]; }
    l += sum;
    pf0 = pack8(pa0, pb0); pf1 = pack8(pa1, pb1);
}
__device__ __forceinline__ void pv(f32x4 (&O)[4], const VF& v, const bf16x8& pf) {
#pragma unroll
    for (int dt = 0; dt < 4; ++dt) O[dt] = MFMA16(v.v[dt], pf, O[dt]);
}
__device__ __forceinline__ void lds_fadd(LAS float* p, float v) { (void)__hip_atomic_fetch_add((float*)p, v, __ATOMIC_RELAXED, __HIP_MEMORY_SCOPE_WORKGROUP); }
#define DPP_I(x, ctrl) __builtin_amdgcn_update_dpp((x), (x), (ctrl), 0xf, 0xf, false)
#define DPP_F(x, ctrl) __int_as_float(__builtin_amdgcn_update_dpp(__float_as_int(x), __float_as_int(x), (ctrl), 0xf, 0xf, false))
__device__ __forceinline__ float sum8_dpp(float v) { v += DPP_F(v, 0xB1); v += DPP_F(v, 0x4E); v += DPP_F(v, 0x141); return v; }
__device__ __forceinline__ unsigned wave_iscan_u32(unsigned x) {
#define DPP_Z(v, ctrl, rmask) (unsigned)__builtin_amdgcn_update_dpp(0, (int)(v), (ctrl), (rmask), 0xf, false)
    x += DPP_Z(x, 0x111, 0xf); x += DPP_Z(x, 0x112, 0xf); x += DPP_Z(x, 0x114, 0xf); x += DPP_Z(x, 0x118, 0xf); x += DPP_Z(x, 0x142, 0xa); x += DPP_Z(x, 0x143, 0xc);
#undef DPP_Z
    return x; }
__device__ __forceinline__ int wmax64_i(int x) {
    x = max(x, DPP_I(x, 0xB1)); x = max(x, DPP_I(x, 0x4E)); x = max(x, DPP_I(x, 0x141)); x = max(x, DPP_I(x, 0x140));
    return max(max(__builtin_amdgcn_readlane(x, 0), __builtin_amdgcn_readlane(x, 16)), max(__builtin_amdgcn_readlane(x, 32), __builtin_amdgcn_readlane(x, 48))); }
__device__ __forceinline__ float kqsum(float v) { v += __shfl_xor(v, 16); v += __shfl_xor(v, 32); return v; }
__device__ __forceinline__ float wmax64(float v) {
#pragma unroll
    for (int o = 1; o < 64; o <<= 1) v = fmaxf(v, __shfl_xor(v, o));
    return v;
}
__device__ __forceinline__ void out_add(LAS unsigned short* OUTw, int p, int n, int kq, const f32x4 (&O)[4], float scale, bool first) {
    const int q = 2 * p + (n >> 3), hd = n & 7;
    if (hd < 6) { LAS v2u* dst = (LAS v2u*)(OUTw + (q * 6 + hd) * 64) + kq;
#pragma unroll
        for (int dt = 0; dt < 4; ++dt) { f32x4 v = O[dt] * scale; if (!first) { const v2u o = dst[4 * dt]; v[0] += __uint_as_float(o.x << 16); v[1] += __uint_as_float(o.x & 0xffff0000u); v[2] += __uint_as_float(o.y << 16); v[3] += __uint_as_float(o.y & 0xffff0000u); }
            dst[4 * dt] = (v2u){pk2(v[0], v[1]), pk2(v[2], v[3])}; } }
}

__device__ __forceinline__ void p2_mfma(Frame& F, const In& I, unsigned char* ws) {
    OPAQUE_TID(); KARGS(); const int lane = tid_ & 63, wave = __builtin_amdgcn_readfirstlane(tid_ >> 6), r = lane & 15, kq = lane >> 4;
    const bf16* KV0 = (const bf16*)(ws + WS_KV0); const bf16* W1T = (const bf16*)(ws + WS_W1T); const bf16* W2T = (const bf16*)(ws + WS_W2T); const float* B1F = (const float*)(ws + WS_B1F);
    const bf16* MEMN = (const bf16*)(ws + WS_MEMN); const bf16* WMKT = (const bf16*)(ws + WS_WMKT);
    bf16* KCB = (bf16*)(ws + WS_KCB); bf16* VCT = (bf16*)(ws + WS_VCT); bf16* MKB = (bf16*)(ws + WS_MKB); bf16* MVT = (bf16*)(ws + WS_MVT);
    LAS unsigned char* aim = F.lds + RING_OFF;
    LAS unsigned char* hid = F.lds + RING_OFF + RING_BYTES;
    for (int u = blockIdx.x; u < 192; u += F.G) {
        const bool cmp = u < 128;
        const bf16* bp[2]; int K, kjump;
        int kv = 0, bg = 0, n0 = 0, lay = 0, m0 = 0, ch = 0;
        if (cmp) { kv = u >> 6; bg = (u >> 4) & 3; n0 = (u & 15) * 32; K = 2048; kjump = 512 - 64;
#pragma unroll
            for (int ct = 0; ct < 2; ++ct) bp[ct] = W1T + (size_t)(kv * 256 + 32 * wave + 16 * ct + r) * 2048 + 8 * kq;
        } else { const int v = u - 128; lay = v >> 5; m0 = ((v >> 1) & 15) * 32; ch = v & 1; K = 1024; kjump = 0;
#pragma unroll
            for (int ct = 0; ct < 2; ++ct) bp[ct] = WMKT + (size_t)(lay * 512 + ch * 256 + 32 * wave + 16 * ct + r) * 1024 + 8 * kq;
        }
        { const int nins = (K >> 6) * 4;
          for (int i = wave; i < nins; i += NWAVES) { const int seg = 8 * i + (lane >> 3), c = lane & 7, sblk = seg >> 5, row = seg & 31;
              const bf16* arow; if (cmp) { const int b = bg >> 1, g = bg & 1; int nn = n0 + row; nn = nn > 510 ? 510 : nn; arow = KV0 + (size_t)(b * T + 16 * nn) * 512 + kv * 128 + g * 64; }
              else arow = MEMN + (size_t)(lay * 512 + m0 + row) * 1024;
              __builtin_amdgcn_global_load_lds((const unsigned*)(arow + 64 * sblk + sblk * kjump + 8 * (c ^ (row & 7))), (LAS unsigned*)(aim + i * 1024), 16, 0, 0); }
          asm volatile("s_waitcnt vmcnt(0)" ::: "memory"); __syncthreads(); }
        f32x4 acc[2][2];
#pragma unroll
        for (int rt = 0; rt < 2; ++rt)
#pragma unroll
            for (int ct = 0; ct < 2; ++ct) acc[rt][ct] = (f32x4){0.f, 0.f, 0.f, 0.f};
        { int r_ = r, kq_ = kq; asm volatile("" : "+v"(r_), "+v"(kq_));
          bf16x8 bb[2][2], bn[2][2];
#define P2_LOADB(B_, kb_) do { const int kbl_ = (kb_) < K ? (kb_) : K - 64; \
            _Pragma("unroll") for (int h2 = 0; h2 < 2; ++h2) _Pragma("unroll") for (int ct = 0; ct < 2; ++ct) B_[ct][h2] = *(const GAS bf16x8*)(bp[ct] + kbl_ + 32 * h2); } while (0)
#define P2_MM(B_, kb_) do { const LAS unsigned char* as_ = aim + ((kb_) >> 6) * 4096; \
            _Pragma("unroll") for (int h2 = 0; h2 < 2; ++h2) _Pragma("unroll") for (int rt = 0; rt < 2; ++rt) { const int row_ = 16 * rt + r_; \
                const bf16x8 av_ = *(const LAS bf16x8*)(as_ + row_ * 128 + (((4 * h2 + kq_) ^ (row_ & 7)) << 4)); \
                _Pragma("unroll") for (int ct = 0; ct < 2; ++ct) acc[rt][ct] = MFMA16(av_, B_[ct][h2], acc[rt][ct]); } } while (0)
          P2_LOADB(bb, 0);
          for (int kb = 0; kb < K; kb += 128) {
              P2_LOADB(bn, kb + 64); P2_MM(bb, kb);
              P2_LOADB(bb, kb + 128); P2_MM(bn, kb + 64);
          }
#undef P2_LOADB
#undef P2_MM
        }
        if (cmp) {
#pragma unroll
            for (int ct = 0; ct < 2; ++ct) { const int col = 32 * wave + 16 * ct + r; const float bias = (kv ? Ip->v_b1 : Ip->k_b1)[col] + ((B1F[(kv * 4 + 0) * 256 + col] + B1F[(kv * 4 + 1) * 256 + col]) + (B1F[(kv * 4 + 2) * 256 + col] + B1F[(kv * 4 + 3) * 256 + col]));
#pragma unroll
                for (int rt = 0; rt < 2; ++rt)
#pragma unroll
                    for (int i = 0; i < 4; ++i) { const float xg = acc[rt][ct][i] + bias; const float hv = 0.5f * xg * (1.f + tanhf(0.7978845608028654f * (xg + 0.044715f * xg * xg * xg)));
                        *(LAS unsigned short*)(hid + (16 * rt + 4 * kq + i) * 528 + 2 * col) = (unsigned short)f2bf(hv); } }
            __syncthreads();
            { const int rt2 = wave >> 2, ct2 = wave & 3; f32x4 o = {0.f, 0.f, 0.f, 0.f};
              const bf16* w2p = W2T + (size_t)(kv * 64 + 16 * ct2 + r) * 256 + 8 * kq;
#pragma unroll
              for (int ks = 0; ks < 8; ++ks) { const bf16x8 av = *(const LAS bf16x8*)(hid + (16 * rt2 + r) * 528 + 64 * ks + 16 * kq); o = MFMA16(av, ldg16(w2p + 32 * ks), o); }
              const int d = 16 * ct2 + r; const float b2v = (kv ? Ip->v_b2 : Ip->k_b2)[d];
#pragma unroll
              for (int i = 0; i < 4; ++i) { const int nn = n0 + 16 * rt2 + 4 * kq + i; const unsigned short ov = (nn < NCMP) ? (unsigned short)f2bf(o[i] + b2v) : (unsigned short)0;
                  if (kv) VCT[(size_t)(bg * 64 + d) * 512 + nn] = ov; else KCB[(size_t)(bg * 512 + nn) * 64 + d] = ov; } }
            __syncthreads();
        } else {
#pragma unroll
            for (int ct = 0; ct < 2; ++ct) { const int col = 32 * wave + 16 * ct + r;
#pragma unroll
                for (int rt = 0; rt < 2; ++rt)
#pragma unroll
                    for (int i = 0; i < 4; ++i) { const int mrow = m0 + 16 * rt + 4 * kq + i; const unsigned short ov = (unsigned short)f2bf(acc[rt][ct][i]);
                        if (ch == 0) MKB[(size_t)(lay * 512 + mrow) * 256 + col] = ov; else MVT[(size_t)(lay * 256 + col) * 512 + mrow] = ov; } }
            __syncthreads();
        }
    }
}

template <int MODE>
__device__ __forceinline__ void mb2(f32x4& sa, f32x4& sb, int kpos, int tcol, bool colok, bool fast, const BiasCtx& B) {
    if (fast) { if (colok) { sa = sa + B.c31; sb = sb + B.c31; } else { sa = (f32x4){-INFINITY, -INFINITY, -INFINITY, -INFINITY}; sb = sa; } }
    else { maskbias<MODE>(sa, kpos, tcol, colok, B); maskbias<MODE>(sb, kpos + 4, tcol, colok, B); }
}
__device__ __forceinline__ void cmp_bias(f32x4& sa, f32x4& sb, int kpos, int tcol, int ccls, const BiasCtx& B) {
    if (ccls == 0) { sa = sa + B.c31; sb = sb + B.c31; }
    else if (ccls == 1) { const int d0 = tcol - 31 - 16 * kpos;
#pragma unroll
        for (int i = 0; i < 4; ++i) { { const int d = d0 - 16 * i; sa[i] += B.c31 + (d < 1513 ? B.d30 : 0.f) + (d < 1117 ? B.d29 : 0.f); }
                                      { const int d = d0 - 64 - 16 * i; sb[i] += B.c31 + (d < 1513 ? B.d30 : 0.f) + (d < 1117 ? B.d29 : 0.f); } } }
    else if (ccls == 2) { const LAS unsigned short* tl = B.tb + (tcol - 31 - 16 * (kpos + 7)) * 6; asm("" : "+v"(tl));
#pragma unroll
        for (int i = 0; i < 4; ++i) { sa[i] += __uint_as_float((unsigned)tl[96 * (7 - i)] << 16); sb[i] += __uint_as_float((unsigned)tl[96 * (3 - i)] << 16); } }
    else { maskbias<MD_CMP>(sa, kpos, tcol, true, B); maskbias<MD_CMP>(sb, kpos + 4, tcol, true, B); }
}
#define SWZ(row) (((((row) >> 3) & 3) << 1) | (((row) >> 1) & 1))
struct KV1 { KF k; VF v; };
__device__ __forceinline__ void load_kv(KV1& d, const bf16* kb, int kstride, const bf16* vt, int vstride, int key0, int r, int kq) { load_k(d.k, kb, kstride, key0, r, kq); load_vt(d.v, vt, vstride, key0, r, kq); }

template <int MD, int FORCE = 0>
__device__ __forceinline__ void nsa_sweep(LAS unsigned char* STG, const bf16* ksb, const bf16* vst, int jlo, int jhi, int qt, const LAS unsigned* WMw, int wave, int lane, int r, int kq, int qsel, int t0w,
                                          const bf16x8 (&qf)[4][2], const BiasCtx& BC, float (&m)[4], float (&l)[4], f32x4 (&O)[4][4],
                                          int kstr = 512, int kblk = 64 * 512, int vstr = 64, int vblk = 16384) {
            const int srow = 8 * wave + (lane >> 3), sch = (lane & 7) ^ SWZ(srow);
            const bf16* ksrc = ksb + (size_t)srow * kstr + 8 * sch; const bf16* vsrc = vst + (size_t)srow * vstr + 8 * sch;
#define NSA_DMA(jb) do { LAS unsigned char* d_ = STG + ((jb) % 6) * 16384 + wave * 1024; \
                __builtin_amdgcn_global_load_lds((const unsigned*)(ksrc + (size_t)(jb) * kblk), (LAS unsigned*)d_, 16, 0, 0); \
                __builtin_amdgcn_global_load_lds((const unsigned*)(vsrc + (size_t)(jb) * vblk), (LAS unsigned*)(d_ + 8192), 16, 0, 0); } while (0)
#define NSA_WAITV(n_) do { if ((n_) >= 6) asm volatile("s_waitcnt vmcnt(6) lgkmcnt(0)" ::: "memory"); else if ((n_) == 4) asm volatile("s_waitcnt vmcnt(4) lgkmcnt(0)" ::: "memory"); else if ((n_) == 2) asm volatile("s_waitcnt vmcnt(2) lgkmcnt(0)" ::: "memory"); else asm volatile("s_waitcnt vmcnt(0) lgkmcnt(0)" ::: "memory"); } while (0)
            { const int nb = jhi - jlo + 1;
#pragma unroll
              for (int i = 0; i < 3; ++i) if (i < nb) NSA_DMA(jlo + i);
              NSA_WAITV(0); }
            __builtin_amdgcn_s_barrier();
#define NSA_TILES(CLS_) _Pragma("unroll") for (int p = 0; p < 4; ++p) if (m8 & (3u << (2 * p))) { \
                        bf16x8 pf0, pf1; \
                        step64<MD, CLS_>(k0, k1, qf[p], cls, 64 * j + 8 * kq_, t0w + 2 * p + qs_, ((m8 >> (2 * p + qs_)) & 1u) != 0u, BC, m[p], l[p], O[p], pf0, pf1); \
                        pv(O[p], v0, pf0); pv(O[p], v1, pf1); \
                        __builtin_amdgcn_sched_barrier(0); }
            auto tiles = [&](auto clsx, int j) __attribute__((always_inline)) { constexpr int CLSX = decltype(clsx)::value;
                const LAS unsigned char* sk = STG + (j % 6) * 16384; const LAS unsigned char* sv = sk + 8192;
                unsigned m8 = 0xffu; if (WMw) m8 = (unsigned)__builtin_amdgcn_readfirstlane((int)((WMw[j >> 2] >> (8 * (j & 3))) & 0xffu)); if (FORCE == 1) m8 = 0u; if (FORCE == 2) m8 = 0xffu; if (MD == MD_MEM) m8 = 3u; else asm volatile("" : "+s"(m8));
                if (m8) {
                    int r_ = r, kq_ = kq, qs_ = qsel; asm volatile("" : "+v"(r_), "+v"(kq_), "+v"(qs_));
                    const int dj = qt - j; const int cls = (MD == MD_MEM) ? BK_FAR : (MD == MD_WIN) ? ((dj >= 1 && dj <= 7) ? BK_MID : BK_GEN) : ((64 * dj - 63 >= 1513) ? BK_FAR : ((dj >= 1 && dj <= 15) ? BK_MID : BK_GEN));
                    KF k0, k1;
                    { const int ka = 8 * (r_ >> 2) + (r_ & 3), kb2 = ka + 4, kc = ka + 32, kd = ka + 36;
                      k0.a0 = *(const LAS bf16x8*)(sk + ka * 128 + ((kq_ ^ SWZ(ka)) << 4)); k0.a1 = *(const LAS bf16x8*)(sk + ka * 128 + (((4 + kq_) ^ SWZ(ka)) << 4));
                      k0.b0 = *(const LAS bf16x8*)(sk + kb2 * 128 + ((kq_ ^ SWZ(kb2)) << 4)); k0.b1 = *(const LAS bf16x8*)(sk + kb2 * 128 + (((4 + kq_) ^ SWZ(kb2)) << 4));
                      k1.a0 = *(const LAS bf16x8*)(sk + kc * 128 + ((kq_ ^ SWZ(kc)) << 4)); k1.a1 = *(const LAS bf16x8*)(sk + kc * 128 + (((4 + kq_) ^ SWZ(kc)) << 4));
                      k1.b0 = *(const LAS bf16x8*)(sk + kd * 128 + ((kq_ ^ SWZ(kd)) << 4)); k1.b1 = *(const LAS bf16x8*)(sk + kd * 128 + (((4 + kq_) ^ SWZ(kd)) << 4)); }
                    VF v0, v1;
#pragma unroll
                    for (int dt = 0; dt < 4; ++dt) { const int dd = 16 * dt + r_; v0.v[dt] = *(const LAS bf16x8*)(sv + dd * 128 + ((kq_ ^ SWZ(dd)) << 4)); v1.v[dt] = *(const LAS bf16x8*)(sv + dd * 128 + (((4 + kq_) ^ SWZ(dd)) << 4)); }
                    NSA_TILES(CLSX)
                }
            };
            int ni = 0;
            auto blk = [&](auto clsx, int j) __attribute__((always_inline)) {
                const int ph = (j - jlo) % 3;
                if (ph == 0) { if (j + 3 <= jhi) NSA_DMA(j + 3); if (j + 4 <= jhi) NSA_DMA(j + 4); if (j + 5 <= jhi) NSA_DMA(j + 5); }
                tiles(clsx, j);
                if (ph == 2 || j == jhi) { NSA_WAITV(0); __builtin_amdgcn_s_barrier(); }
            };
            int j = jlo;
            if (MD == MD_BLK || MD == MD_MEM) { const int jfar = (MD == MD_MEM) ? jhi : ((qt - 25 < jhi) ? qt - 25 : jhi); const int jfe = jlo + ((jfar - jlo + 1 >= 0 ? (jfar - jlo + 1) / 3 : -1) * 3) - 1;
                for (; j <= jfe; ++j) blk(std::integral_constant<int, BK_FAR>{}, j); }
            if (MD == MD_BLK) {
                const int jf2 = (qt - 17 < jhi) ? qt - 17 : jhi; const int jfe2 = jlo + ((jf2 - jlo + 1 >= 0 ? (jf2 - jlo + 1) / 3 : -1) * 3) - 1;
                for (; j <= jfe2; ++j) blk(std::integral_constant<int, BK_FARF>{}, j); }
            for (; j <= jhi; ++j) blk(std::integral_constant<int, -1>{}, j);
#undef NSA_WAITV
#undef NSA_TILES
#undef NSA_DMA
}
__device__ __forceinline__ void p3_nsa_mfma(Frame& F, const In& I, unsigned char* ws) {
    OPAQUE_TID(); KARGS(); const int wave = __builtin_amdgcn_readfirstlane(tid_ >> 6);
    LAS float* b12 = (LAS float*)(F.lds + TAB_B12);
    LAS unsigned short* OUTw = (LAS unsigned short*)(F.lds + NSA_OUT) + wave * 3072;
    LAS float* PSw = (LAS float*)(F.lds + NSA_PSQ) + wave * 1024;
    LAS unsigned char* STG = F.lds + NSA_PSQ;
    LAS unsigned* WMw = (LAS unsigned*)(F.lds + NSA_ST) + wave * 32;
    for (int i = tid_; i < 512; i += NWAVES * 64) b12[i] = ((i & 15) < 12) ? Ip->rel_bias[(i >> 4) * 12 + (i & 15)] * LOG2E : 0.f;
    LAS unsigned short* TB = (LAS unsigned short*)(F.lds + NSA_TB);
    { const int gg = (int)blockIdx.x & 1;
      for (int i = tid_; i < 6144; i += NWAVES * 64) { const int dd = i / 6, hh = i % 6; TB[i] = (unsigned short)f2bf(Ip->rel_bias[rel_bucket(dd) * 12 + gg * 6 + hh] * LOG2E); } }
    __syncthreads();
    const bf16* Q0 = (const bf16*)(ws + WS_Q0); const bf16* KV0 = (const bf16*)(ws + WS_KV0); const bf16* QM = (const bf16*)(ws + WS_QM); const bf16* G0 = (const bf16*)(ws + WS_G0);
    const bf16* VT = (const bf16*)(ws + WS_VT); const bf16* KCB = (const bf16*)(ws + WS_KCB); const bf16* VCT = (const bf16*)(ws + WS_VCT);
    const bf16* MKB = (const bf16*)(ws + WS_MKB); const bf16* MVT = (const bf16*)(ws + WS_MVT);
    bf16* CAT = (bf16*)(ws + WS_CAT);
    const int nun = 4 * 128;
    for (int ui = blockIdx.x; ui < nun; ui += F.G) {
        int tl_ = tid_; asm volatile("" : "+v"(tl_));
        const int lane = tl_ & 63, n = lane & 15, kq = lane >> 4, r = n, hd = n & 7, qsel = n >> 3; const bool colv = hd < 6;
        int bg, qt;
        bg = blockIdx.x & 3;
        if (F.G == 256) { const int idx = blockIdx.x >> 2; qt = (ui < 256) ? idx : 127 - idx; }
        else { qt = ui >> 2; if ((ui & 3) != bg) continue; }
        const int b = bg >> 1, g = bg & 1, t0w = 64 * qt + 8 * wave, rowb = b * T;
        const int habs = g * 6 + (colv ? hd : 0);
        const LAS float* b12c = b12 + habs; const BiasCtx BC{TB + (colv ? hd : 0), b12c[29 * 16] - b12c[30 * 16], b12c[30 * 16] - b12c[31 * 16], b12c[31 * 16]};

        bf16x8 qf[4][2];
#pragma unroll
        for (int p = 0; p < 4; ++p) { const bf16* qp = Q0 + (size_t)(rowb + t0w + 2 * p + qsel) * 768 + habs * 64 + 8 * kq;
#pragma unroll
            for (int ks = 0; ks < 2; ++ks) { bf16x8 v = ldg16(qp + 32 * ks); if (!colv) v = (bf16x8){0, 0, 0, 0, 0, 0, 0, 0}; qf[p][ks] = v; } }
        float m[4], l[4]; f32x4 O[4][4];
        if (PROBE_REP == 6 || PROBE_REP == 7) {
            const bf16* ksb_ = KV0 + (size_t)rowb * 512 + 256 + g * 64; const bf16* vst_ = VT + ((size_t)(rowb >> 6) * 256 + g * 64) * 64;
#pragma unroll
            for (int p = 0; p < 4; ++p) { m[p] = -1e30f; l[p] = 0.f;
#pragma unroll
                for (int dt = 0; dt < 4; ++dt) O[p][dt] = (f32x4){0.f, 0.f, 0.f, 0.f}; }
            __syncthreads();
            nsa_sweep<MD_BLK, (PROBE_REP == 6 ? 2 : 1)>(STG, ksb_, vst_, 0, qt, qt, WMw, wave, lane, r, kq, qsel, t0w, qf, BC, m, l, O);
            float* dump = (float*)(ws + WS_OCS) + ((size_t)blockIdx.x * 512 + tid_) * 4;
#pragma unroll
            for (int p = 0; p < 4; ++p) dump[p] = l[p] + O[p][0][0] + O[p][1][1] + O[p][2][2] + O[p][3][3];
            __syncthreads(); }
        for (int i = lane; i < 1024; i += 64) PSw[i] = 0.f;
        const int ncmax = (t0w + 7 >= 31) ? ((t0w + 7 - 31) / 16 + 1) : 0;
        const bf16* kcb = KCB + (size_t)(bg * 512) * 64; const bf16* vct = VCT + (size_t)(bg * 64) * 512;
#pragma unroll
        for (int p = 0; p < 4; ++p) { m[p] = -1e30f; l[p] = 0.f; }
        if (ncmax > 0) {
            int r_ = r, kq_ = kq; asm volatile("" : "+v"(r_), "+v"(kq_));
            for (int key0 = 0; key0 < ncmax; key0 += 32) {
                asm volatile("" : "+v"(r_), "+v"(kq_));
                KF kA; load_k(kA, kcb, 64, key0, r_, kq_);
                const int dmin_ = t0w - 31 - 16 * (key0 + 31), ccls = dmin_ >= 1513 ? 0 : (dmin_ >= 825 ? 1 : ((dmin_ >= 0 && dmin_ + 503 <= 1023) ? 2 : 3));
#pragma unroll
                for (int p = 0; p < 4; ++p) { f32x4 sa, sb; qk(sa, sb, kA, qf[p]); const int tcol = t0w + 2 * p + qsel;
                    cmp_bias(sa, sb, key0 + 8 * kq_, tcol, ccls, BC);
                    const float mn = fmaxf(m[p], lmax8(sa, sb)); float sum = 0.f;
#pragma unroll
                    for (int i = 0; i < 4; ++i) sum += __builtin_amdgcn_exp2f(sa[i] - mn) + __builtin_amdgcn_exp2f(sb[i] - mn);
                    l[p] = l[p] * __builtin_amdgcn_exp2f(m[p] - mn) + sum; m[p] = mn; __builtin_amdgcn_sched_barrier(0); }
            }
        }
        float invl[4];
#pragma unroll
        for (int p = 0; p < 4; ++p) { float mc = m[p]; mc = fmaxf(mc, __shfl_xor(mc, 16)); mc = fmaxf(mc, __shfl_xor(mc, 32));
            const float lt = kqsum(l[p] * __builtin_amdgcn_exp2f(m[p] - mc)); m[p] = mc; invl[p] = lt > 0.f ? 1.f / lt : 0.f; }
#pragma unroll
        for (int p = 0; p < 4; ++p)
#pragma unroll
            for (int dt = 0; dt < 4; ++dt) O[p][dt] = (f32x4){0.f, 0.f, 0.f, 0.f};
        float carry[4] = {0.f, 0.f, 0.f, 0.f};
        if (ncmax > 0) {
            int r_ = r, kq_ = kq; asm volatile("" : "+v"(r_), "+v"(kq_));
            for (int key0 = 0; key0 < ncmax; key0 += 32) {
                asm volatile("" : "+v"(r_), "+v"(kq_));
                KV1 A; load_kv(A, kcb, 64, vct, 512, key0, r_, kq_);
                const int dmin_ = t0w - 31 - 16 * (key0 + 31), ccls = dmin_ >= 1513 ? 0 : (dmin_ >= 825 ? 1 : ((dmin_ >= 0 && dmin_ + 503 <= 1023) ? 2 : 3));
#pragma unroll
                for (int p = 0; p < 4; ++p) { f32x4 sa, sb; qk(sa, sb, A.k, qf[p]); const int tcol = t0w + 2 * p + qsel;
                    cmp_bias(sa, sb, key0 + 8 * kq_, tcol, ccls, BC);
                    f32x4 pa, pb;
#pragma unroll
                    for (int i = 0; i < 4; ++i) { pa[i] = __builtin_amdgcn_exp2f(sa[i] - m[p]) * invl[p]; pb[i] = __builtin_amdgcn_exp2f(sb[i] - m[p]) * invl[p]; }
                    pv(O[p], A.v, pack8(pa, pb));
                    float wA = (pa[0] + pa[1]) + (pa[2] + pa[3]), wB = pa[3] + ((pb[0] + pb[1]) + (pb[2] + pb[3])), wC = pb[3];
                    if (!colv) { wA = 0.f; wB = 0.f; wC = 0.f; }
                    const float up = __shfl(wC, (lane + 48) & 63);
                    const float prevC = (kq == 0) ? carry[p] : up; carry[p] = up;
                    float a0 = wA + prevC, a1 = wB;
                    a0 = sum8_dpp(a0); a1 = sum8_dpp(a1);
                    if (hd == 0) { LAS float* ps = PSw + (2 * p + qsel) * 128 + (key0 >> 2) + 2 * kq; ps[0] = a0; ps[1] = a1; } __builtin_amdgcn_sched_barrier(0); }
            }
        }
        if (ncmax > 0 && ncmax <= 480) {
            const int jn = ((ncmax + 31) >> 5) * 8;
#pragma unroll
            for (int p = 0; p < 4; ++p) { float a0 = sum8_dpp(carry[p]); if (hd == 0 && kq == 0) PSw[(2 * p + qsel) * 128 + jn] = a0; }
        }
        {
#pragma unroll
            for (int p = 0; p < 4; ++p) { const size_t row = (size_t)(rowb + t0w + 2 * p + qsel);
                const float gz = bf2f(G0[row * 256 + habs * 3 + 0]) + Ip->nsa_gate_b[habs * 3 + 0]; out_add(OUTw, p, n, kq, O[p], 1.f / (1.f + __expf(-gz)), true); }
        }
        for (int i = lane; i < 32; i += 64) WMw[i] = (qt < 16) ? 0xffffffffu : 0u;
        if (qt >= 16) {
            if (lane < 3) { const int j = lane == 0 ? 0 : qt - 2 + lane; atomicOr((unsigned*)&WMw[j >> 2], 0xffu << (8 * (j & 3))); }
            for (int q = 0; q < 8; ++q) {
                int v0 = __float_as_int(PSw[q * 128 + lane] + 0.f), v1 = __float_as_int(PSw[q * 128 + 64 + lane] + 0.f);
                if (lane < 1 || lane > qt - 2) v0 = __float_as_int(-1.f); if (lane + 64 > qt - 2) v1 = __float_as_int(-1.f);
                for (int s = 0; s < 13; ++s) { const int mx = wmax64_i(max(v0, v1));
                    const unsigned long long b0 = __ballot(v0 == mx); int j;
                    if (b0) { j = __builtin_ctzll(b0); if (lane == j) v0 = __float_as_int(-1.f); } else { const unsigned long long b1 = __ballot(v1 == mx); j = __builtin_ctzll(b1); if (lane == j) v1 = __float_as_int(-1.f); j += 64; }
                    if (lane == 0) atomicOr((unsigned*)&WMw[j >> 2], 1u << (8 * (j & 3) + q)); }
            }
        }
        const bf16* ksb = KV0 + (size_t)rowb * 512 + 256 + g * 64; const bf16* vst = VT + ((size_t)(rowb >> 6) * 256 + g * 64) * 64;
        __syncthreads();
#pragma unroll 1
        for (int rep_ = 0; rep_ < (PROBE_REP == 1 ? 2 : 1); ++rep_) {
#pragma unroll
            for (int p = 0; p < 4; ++p) { m[p] = -1e30f; l[p] = 0.f;
#pragma unroll
                for (int dt = 0; dt < 4; ++dt) O[p][dt] = (f32x4){0.f, 0.f, 0.f, 0.f}; }
            nsa_sweep<MD_BLK>(STG, ksb, vst, 0, qt, qt, WMw, wave, lane, r, kq, qsel, t0w, qf, BC, m, l, O);
        }
        { int qs2_ = qsel; asm volatile("" : "+v"(qs2_));
#pragma unroll
        for (int p = 0; p < 4; ++p) { const size_t row = (size_t)(rowb + t0w + 2 * p + qs2_);
            const float gz = bf2f(G0[row * 256 + habs * 3 + 1]) + Ip->nsa_gate_b[habs * 3 + 1]; out_add(OUTw, p, n, kq, O[p], (1.f / (1.f + __expf(-gz))) / kqsum(l[p]), false); } }
        const bf16* kwb = KV0 + (size_t)rowb * 512 + 384 + g * 64; const bf16* vwt = VT + ((size_t)(rowb >> 6) * 256 + 128 + g * 64) * 64;
#pragma unroll
        for (int p = 0; p < 4; ++p) { m[p] = -1e30f; l[p] = 0.f;
#pragma unroll
            for (int dt = 0; dt < 4; ++dt) O[p][dt] = (f32x4){0.f, 0.f, 0.f, 0.f}; }
        __syncthreads();
        nsa_sweep<MD_WIN>(STG, kwb, vwt, (qt >= 8) ? qt - 8 : 0, qt, qt, nullptr, wave, lane, r, kq, qsel, t0w, qf, BC, m, l, O);
        if (PROBE_REP == 4) {
#pragma unroll
            for (int p = 0; p < 4; ++p) { m[p] = -1e30f; l[p] = 0.f;
#pragma unroll
                for (int dt = 0; dt < 4; ++dt) O[p][dt] = (f32x4){0.f, 0.f, 0.f, 0.f}; }
            nsa_sweep<MD_WIN>(STG, kwb, vwt, (qt >= 8) ? qt - 8 : 0, qt, qt, nullptr, wave, lane, r, kq, qsel, t0w, qf, BC, m, l, O); }
        { int qs3_ = qsel; asm volatile("" : "+v"(qs3_));
#pragma unroll
        for (int p = 0; p < 4; ++p) { const size_t row = (size_t)(rowb + t0w + 2 * p + qs3_);
            const float gz = bf2f(G0[row * 256 + habs * 3 + 2]) + Ip->nsa_gate_b[habs * 3 + 2]; out_add(OUTw, p, n, kq, O[p], (1.f / (1.f + __expf(-gz))) / kqsum(l[p]), false); } }
        int ln_ = lane; asm volatile("" : "+v"(ln_));
#pragma unroll 1
        for (int i = 0; i < 6; ++i) { const int e = i * 64 + ln_, q = e / 48, c8 = e % 48;
            *(v4u*)(CAT + (size_t)(rowb + t0w + q) * 1024 + g * 384 + 8 * c8) = ((const LAS v4u*)OUTw)[e]; }
#pragma unroll 1
        for (int h2 = 0; h2 < 2; ++h2) { const int hm = 2 * g + h2;
            int ln2_ = lane; asm volatile("" : "+v"(ln2_)); const int nn = ln2_ & 15, kqq = ln2_ >> 4;
#pragma unroll
            for (int p = 0; p < 4; ++p) { qf[p][0] = (bf16x8){0, 0, 0, 0, 0, 0, 0, 0}; qf[p][1] = qf[p][0]; m[p] = -1e30f; l[p] = 0.f;
#pragma unroll
                for (int dt = 0; dt < 4; ++dt) O[p][dt] = (f32x4){0.f, 0.f, 0.f, 0.f}; }
            { const bf16* qp = QM + (size_t)(rowb + t0w + (nn & 7)) * 256 + hm * 64 + 8 * kqq; if (nn < 8) { qf[0][0] = ldg16(qp); qf[0][1] = ldg16(qp + 32); } }
            const BiasCtx BCm{BC.tb, 0.f, 0.f, 0.f};
            nsa_sweep<MD_MEM>(STG, MKB + (size_t)(b * 256) * 256 + hm * 64, MVT + (size_t)(hm * 64) * 512 + b * 256, 0, 3, 0, nullptr, wave, ln2_, nn, kqq, nn >> 3, 0, qf, BCm, m, l, O, 256, 64 * 256, 512, 64);
            const float il = 1.f / kqsum(l[0]);
            if (nn < 8) { bf16* op = CAT + (size_t)(rowb + t0w + nn) * 1024 + 768 + hm * 64 + 4 * kqq;
#pragma unroll
                for (int dt = 0; dt < 4; ++dt) *(uint2*)(op + 16 * dt) = make_uint2(pk2(O[0][dt][0] * il, O[0][dt][1] * il), pk2(O[0][dt][2] * il, O[0][dt][3] * il)); }
        }
    }
}

__device__ __forceinline__ void p10_dsa_norm(Frame& F, const In& I, unsigned char* ws) {
    OPAQUE_TID(); KARGS(); const int gw = F.vcu * NWAVES + (tid_ >> 6), NGW = F.G * NWAVES, lane = tid_ & 63;
    const bf16* PR = (const bf16*)(ws + WS_PROJ1); bf16* CQ = (bf16*)(ws + WS_CQ); bf16* CKV = (bf16*)(ws + WS_CKV); bf16* KIDX = (bf16*)(ws + WS_KIDX); float* WIDX = (float*)(ws + WS_WIDX);
    for (int m = gw; m < M; m += NGW) {
        const bf16* pr = PR + (size_t)m * 768;
        float a[4]; ld4bf(pr + 4 * lane, a);
        float s = wave_sum(a[0] * a[0] + a[1] * a[1] + a[2] * a[2] + a[3] * a[3]); float r = rsqrtf(s * (1.f / 256.f) + EPSF);
        const float4 gq = *(const float4*)(Ip->q_norm + 4 * lane);
        *(uint2*)(CQ + (size_t)m * 256 + 4 * lane) = make_uint2(pk2((a[0] * r) * gq.x, (a[1] * r) * gq.y), pk2((a[2] * r) * gq.z, (a[3] * r) * gq.w));
        const unsigned u = *(const unsigned*)(pr + 256 + 2 * lane); const float c0 = bflo(u), c1 = bfhi(u);
        s = wave_sum(c0 * c0 + c1 * c1); r = rsqrtf(s * (1.f / 128.f) + EPSF);
        *(unsigned*)(CKV + (size_t)m * 128 + 2 * lane) = pk2((c0 * r) * Ip->kv_norm[2 * lane], (c1 * r) * Ip->kv_norm[2 * lane + 1]);
        const float k0 = bf2f(pr[384 + lane]);
        s = wave_sum(k0 * k0); r = rsqrtf(s * (1.f / 64.f) + EPSF);
        { const int tk = m >> 5, key = m & 31, ks = lane >> 4, hf = (lane >> 3) & 1, jj = lane & 7;
          KIDX[((size_t)(tk * 4 + ks) * 64 + hf * 32 + key) * 8 + jj] = (bf16)f2bf((k0 * r) * Ip->kidx_norm[lane]); }
        if (lane < 8) WIDX[(size_t)m * 8 + lane] = bf2f(pr[448 + lane]) * (0.35355339059327373f * 0.125f);
    }
}

#define MFMA32(A, B, C) __builtin_amdgcn_mfma_f32_32x32x16_bf16((A), (B), (C), 0, 0, 0)
typedef float f32x16 __attribute__((ext_vector_type(16)));
constexpr int XL_OFF = RING_BYTES;
constexpr int IDX_HIST = XL_OFF, IDX_SELL = XL_OFF + 16384;
static_assert(IDX_SELL + 4096 <= LDSCTL_OFF, "LDS map (indexer)");
__device__ __forceinline__ float wmin64(float v) {
#pragma unroll
    for (int o = 1; o < 64; o <<= 1) v = fminf(v, __shfl_xor(v, o));
    return v;
}
__device__ __forceinline__ unsigned f16_order_key(float x) {
    const unsigned hb = (unsigned)__builtin_bit_cast(unsigned short, (_Float16)x);
    const unsigned mk = (unsigned)((int)(hb << 16) >> 31) | 0x8000u;
    return (hb ^ mk) & 0xffffu; }
__device__ __forceinline__ void p12_index_mfma(Frame& F, const In& I, unsigned char* ws) {
    OPAQUE_TID(); KARGS(); const int lane = tid_ & 63, wave = __builtin_amdgcn_readfirstlane(tid_ >> 6), key = lane & 31, half = lane >> 5;
    LAS unsigned short* SC = (LAS unsigned short*)(F.lds + RING_OFF);
    const bf16* QI = (const bf16*)(ws + WS_QI); const bf16* KIDX = (const bf16*)(ws + WS_KIDX); const float* WIDX = (const float*)(ws + WS_WIDX);
    unsigned short* SEL = (unsigned short*)(ws + WS_SEL); int* CNT = (int*)(ws + WS_CNT);
    const int NG = M / 8, per = (NG + F.G - 1) / F.G;
    for (int j = 0; j < per; ++j) {
        const int u = j * F.G + ((j & 1) ? (F.G - 1 - (int)blockIdx.x) : (int)blockIdx.x);
        if (u >= NG) break;
        const int gi = (u & 1) * (NG / 2) + (u >> 1);
        const int row0 = 8 * gi, b = row0 / T, t0 = row0 % T, rowb = b * T;
        if (t0 < 256) {
            const int t = t0 + wave; unsigned short* so = SEL + (size_t)(row0 + wave) * 256;
#pragma unroll
            for (int i = 0; i < 4; ++i) { const int s = lane + 64 * i; so[s] = (unsigned short)(s <= t ? s : 0); }
            if (lane == 0) CNT[row0 + wave] = t + 1;
            continue;
        }
        const int nt = (t0 + 7) / 32 + 1;
        {
            const int rho = lane & 31, a = rho >> 2, qA = ((a >> 2) & 1) + 2 * (a & 1), hdA = 4 * ((a >> 1) & 1) + (rho & 3);
            bf16x8 qa[2][4];
#pragma unroll
            for (int t2 = 0; t2 < 2; ++t2)
#pragma unroll
                for (int ks = 0; ks < 4; ++ks) qa[t2][ks] = ldg16(QI + (size_t)(row0 + 4 * t2 + qA) * 512 + hdA * 64 + 16 * ks + 8 * half);
            f32x2_t wp[2][2][4];
#pragma unroll
            for (int t2 = 0; t2 < 2; ++t2)
#pragma unroll
                for (int jq = 0; jq < 2; ++jq) { const float* wq = WIDX + (size_t)(row0 + 4 * t2 + 2 * half + jq) * 8; const float4 x0 = *(const float4*)wq, x1 = *(const float4*)(wq + 4);
                    wp[t2][jq][0] = (f32x2_t){x0.x, x0.y}; wp[t2][jq][1] = (f32x2_t){x0.z, x0.w}; wp[t2][jq][2] = (f32x2_t){x1.x, x1.y}; wp[t2][jq][3] = (f32x2_t){x1.z, x1.w}; }
            const int tqb = t0 + 2 * half;
            const bf16* kpb = KIDX + (size_t)(rowb >> 5) * 2048 + (size_t)lane * 8;
            const int ntw = (nt - wave + NWAVES - 1) / NWAVES;
#define VFMAC_(acc_, x_, y_) asm("v_fmac_f32 %0, %1, %2" : "+v"(acc_) : "v"(x_), "v"(y_))
#define IDX_LOAD(dst, i) do { const int tl2_ = wave + NWAVES * ((i) < ntw ? (i) : (ntw > 0 ? ntw - 1 : 0)); const bf16* kp_ = kpb + (size_t)tl2_ * 2048; \
                _Pragma("unroll") for (int ks = 0; ks < 4; ++ks) dst[ks] = ldg16(kp_ + 512 * ks); } while (0)
#define IDX_EPI(c, t2) do { float a00 = 0.f, a01 = 0.f, a10 = 0.f, a11 = 0.f;     \
                _Pragma("unroll") for (int h = 0; h < 4; ++h) {                                \
                    VFMAC_(a00, __int_as_float(max(__float_as_int(c[2 * h]), 0)), wp[t2][0][h][0]); VFMAC_(a01, __int_as_float(max(__float_as_int(c[2 * h + 1]), 0)), wp[t2][0][h][1]); \
                    VFMAC_(a10, __int_as_float(max(__float_as_int(c[8 + 2 * h]), 0)), wp[t2][1][h][0]); VFMAC_(a11, __int_as_float(max(__float_as_int(c[9 + 2 * h]), 0)), wp[t2][1][h][1]); } \
                const float s0 = (a00 + a01) + 0.f, s1 = (a10 + a11) + 0.f; \
                const bool ok0 = kpos <= tqb + 4 * (t2), ok1 = kpos <= tqb + 4 * (t2) + 1; \
                SC[(4 * (t2) + 2 * half) * 8192 + kpos] = (unsigned short)f16_order_key(ok0 ? s0 : -INFINITY); SC[(4 * (t2) + 2 * half + 1) * 8192 + kpos] = (unsigned short)f16_order_key(ok1 ? s1 : -INFINITY); } while (0)
#define IDX_COMP(src, i) do { if ((i) < ntw) { const int kpos = 32 * (wave + NWAVES * (i)) + key; \
                f32x16 cA = {0.f, 0.f, 0.f, 0.f, 0.f, 0.f, 0.f, 0.f, 0.f, 0.f, 0.f, 0.f, 0.f, 0.f, 0.f, 0.f}, cB = cA; \
                _Pragma("unroll") for (int ks = 0; ks < 4; ++ks) { cA = MFMA32(qa[0][ks], src[ks], cA); cB = MFMA32(qa[1][ks], src[ks], cB); } \
                IDX_EPI(cA, 0); IDX_EPI(cB, 1); } } while (0)
            if (ntw > 0) {
                bf16x8 kb0[4], kb1[4], kb2[4], kb3[4];
                IDX_LOAD(kb0, 0); IDX_LOAD(kb1, 1); IDX_LOAD(kb2, 2);
                for (int i = 0; i < ntw; i += 4) {
                    IDX_LOAD(kb3, i + 3); IDX_COMP(kb0, i);
                    IDX_LOAD(kb0, i + 4); IDX_COMP(kb1, i + 1);
                    IDX_LOAD(kb1, i + 5); IDX_COMP(kb2, i + 2);
                    IDX_LOAD(kb2, i + 6); IDX_COMP(kb3, i + 3);
                }
            }
#undef IDX_LOAD
#undef IDX_EPI
#undef IDX_COMP
#undef VFMAC_
        }
        __syncthreads();
        {
            const int q = wave, t = t0 + q, nch = (t + 512) >> 9; LAS unsigned short* sc = SC + q * 8192;
            LAS unsigned* hist = (LAS unsigned*)(F.lds + IDX_HIST) + wave * 512;
            LAS unsigned short* sl = (LAS unsigned short*)(F.lds + IDX_SELL) + q * 256;
            for (int i = 32 * nt + lane; i < 512 * nch; i += 64) sc[i] = (unsigned short)0;
#pragma unroll
            for (int i = 0; i < 8; ++i) hist[lane + 64 * i] = 0u;
            for (int c = 0; c < nch; ++c) { const v4u k4 = *(const LAS v4u*)(sc + 512 * c + 8 * lane);
#pragma unroll
                for (int e = 0; e < 8; ++e) { const unsigned kk = (e & 1) ? (k4[e >> 1] >> 16) : (k4[e >> 1] & 0xffffu); const unsigned bb = kk >> 6;
                    atomicAdd((unsigned*)&hist[bb >> 1], 1u << (16 * (bb & 1))); } }
            int b1, r1;
            { unsigned cw[8]; unsigned S = 0u;
#pragma unroll
              for (int i = 0; i < 8; ++i) { cw[i] = hist[8 * lane + i]; S += (cw[i] & 0xffffu) + (cw[i] >> 16); }
              const unsigned px = wave_iscan_u32(S);
              const unsigned above = (unsigned)__builtin_amdgcn_readlane((int)px, 63) - px;
              const bool found = (above < 256u) && (256u <= above + S);
              const int fl = __builtin_ctzll(__ballot(found));
              int bs = 0; unsigned acc = above;
              { bool done = false;
#pragma unroll
                for (int i = 15; i >= 0; --i) { const unsigned cnt_ = (i & 1) ? (cw[i >> 1] >> 16) : (cw[i >> 1] & 0xffffu);
                    if (!done) { if (acc + cnt_ >= 256u) { bs = 16 * lane + i; done = true; } else acc += cnt_; } } }
              b1 = __builtin_amdgcn_readlane(bs, fl); r1 = 256 - __builtin_amdgcn_readlane((int)acc, fl); }
            hist[lane] = 0u;
            for (int c = 0; c < nch; ++c) { const v4u k4 = *(const LAS v4u*)(sc + 512 * c + 8 * lane);
#pragma unroll
                for (int e = 0; e < 8; ++e) { const unsigned kk = (e & 1) ? (k4[e >> 1] >> 16) : (k4[e >> 1] & 0xffffu);
                    if ((int)(kk >> 6) == b1) atomicAdd((unsigned*)&hist[kk & 63u], 1u); } }
            unsigned tkey; int r2;
            { const unsigned S = hist[lane]; const unsigned px = wave_iscan_u32(S); const unsigned above = (unsigned)__builtin_amdgcn_readlane((int)px, 63) - px;
              const bool found = (above < (unsigned)r1) && ((unsigned)r1 <= above + S);
              const int fl = __builtin_ctzll(__ballot(found));
              tkey = ((unsigned)b1 << 6) | (unsigned)fl; r2 = r1 - __builtin_amdgcn_readlane((int)above, fl); }
            const int nabove = 256 - r2; int bsel = 0, beq = 0;
            for (int c = 0; c < nch; ++c) { const int i8 = 512 * c + 8 * lane; const v4u k4 = *(const LAS v4u*)(sc + i8);
                unsigned em = 0u;
#pragma unroll
                for (int e = 0; e < 8; ++e) { const unsigned kk = (e & 1) ? (k4[e >> 1] >> 16) : (k4[e >> 1] & 0xffffu);
                    const bool sel = kk > tkey; em |= (kk == tkey) ? (1u << e) : 0u;
                    const unsigned long long ms = __ballot(sel);
                    if (ms) { if (sel) sl[bsel + (int)__builtin_amdgcn_mbcnt_hi((unsigned)(ms >> 32), __builtin_amdgcn_mbcnt_lo((unsigned)ms, 0u))] = (unsigned short)(i8 + e); bsel += __builtin_popcountll(ms); } }
                if (__any(em != 0u)) {
                    const unsigned ce = (unsigned)__builtin_popcount(em); const unsigned pe = wave_iscan_u32(ce);
                    int pos = beq + (int)(pe - ce);
#pragma unroll
                    for (int e = 0; e < 8; ++e) if (em & (1u << e)) { if (pos < r2) sl[nabove + pos] = (unsigned short)(i8 + e); ++pos; }
                    beq += __builtin_amdgcn_readlane((int)pe, 63); } }
            *(v2u*)(SEL + (size_t)(row0 + q) * 256 + 4 * lane) = *(const LAS v2u*)(sl + 4 * lane);
            if (lane == 0) CNT[row0 + q] = 256;
        }
        __syncthreads();
    }
}

__device__ __forceinline__ unsigned offb(unsigned row, unsigned ch) { return 256u * row + 16u * (ch ^ (((row & 3u) << 2) | ((row >> 2) & 3u))); }
typedef short v4i16_t __attribute__((ext_vector_type(4)));
__device__ __forceinline__ v4i16_t trrd(const LAS unsigned char* p) { return __builtin_amdgcn_ds_read_tr16_b64_v4i16((LAS v4i16_t*)p); }
__device__ __forceinline__ void p13_dsa_mfma(Frame& F, const In& I, unsigned char* ws) {
    OPAQUE_TID(); KARGS(); const int lane = tid_ & 63, wave = __builtin_amdgcn_readfirstlane(tid_ >> 6), n = lane & 15, kq = lane >> 4;
    LAS unsigned char* bkt = F.lds + TAB_BKT; LAS float* b12 = (LAS float*)(F.lds + P13_B12);
    for (int i = tid_; i < 1536; i += NWAVES * 64) bkt[i] = (unsigned char)rel_bucket(i);
    for (int i = tid_; i < 528; i += NWAVES * 64) b12[i] = (i >= 512) ? -INFINITY : (((i & 15) < 12) ? Ip->rel_bias[(i >> 4) * 12 + (i & 15)] * LOG2E : 0.f);
    __syncthreads();
    LAS unsigned char* imgb = F.lds + RING_OFF + wave * 18432; LAS int* sidx = (LAS int*)(imgb + 16384);
    const bf16* QA = (const bf16*)(ws + WS_QA); const bf16* CKV = (const bf16*)(ws + WS_CKV); const bf16* PR = (const bf16*)(ws + WS_PROJ1);
    const unsigned short* SEL = (const unsigned short*)(ws + WS_SEL); const int* CNT = (const int*)(ws + WS_CNT);
    const bf16* MKB = (const bf16*)(ws + WS_MKB) + (size_t)512 * 256; const bf16* MVT = (const bf16*)(ws + WS_MVT) + (size_t)256 * 512;
    bf16* CAT1 = (bf16*)(ws + WS_CAT1);
    const int gw = blockIdx.x * NWAVES + wave, NGW = F.G * NWAVES;
    const LAS float* b12c = b12 + (n < 12 ? n : 0);
#define DSA_GATHER(sl_, rowb_, c0_, buf_) do { const unsigned char* ckvb_ = (const unsigned char*)(CKV + (size_t)(rowb_) * 128); int kx_[8]; \
            _Pragma("unroll") for (int i = 0; i < 8; ++i) kx_[i] = (sl_)[(c0_) + 4 * i + g4_] & 0xffff; \
            _Pragma("unroll") for (int i = 0; i < 8; ++i) __builtin_amdgcn_global_load_lds((const unsigned*)(ckvb_ + ((unsigned)kx_[i] * 256u + goff_[i & 3])), (LAS unsigned*)(imgb + (buf_) * 8192 + i * 1024), 16, 0, 0); } while (0)
#define DSA_LIST(sl_, sel_, t_, cnt_) do { const int idx0_ = __builtin_amdgcn_readfirstlane((sel_)[0]); \
            _Pragma("unroll") for (int i = 0; i < 4; ++i) { const int e = lane + 64 * i, idx = (sel_)[i]; const int d = (t_) - idx, dc = d > 1535 ? 1535 : (d < 0 ? 0 : d); \
                (sl_)[e] = (e < (cnt_)) ? (idx | ((int)bkt[dc] << 22)) : (idx0_ | (2048 << 16)); } } while (0)
    int dreps_ = (PROBE_REP == 9) ? 2 : 1; asm volatile("" : "+s"(dreps_));
    for (int dr_ = 0; dr_ < dreps_; ++dr_) {
    asm volatile("s_waitcnt vmcnt(0) lgkmcnt(0)" ::: "memory");
    int row = gw;
    if (row < M) {
        int ln0_ = lane; asm volatile("" : "+v"(ln0_));
        const int g4_ = ln0_ >> 4; unsigned goff_[4];
#pragma unroll
        for (int k = 0; k < 4; ++k) goff_[k] = 16u * ((unsigned)(ln0_ & 15) ^ (((unsigned)g4_ << 2) | (unsigned)k));
        int cnt = __builtin_amdgcn_readfirstlane(CNT[row]); int sel0[4];
#pragma unroll
        for (int i = 0; i < 4; ++i) sel0[i] = (int)SEL[(size_t)row * 256 + lane + 64 * i];
        DSA_LIST(sidx, sel0, row % T, cnt);
        bf16x8 qf[4];
#pragma unroll
        for (int ks = 0; ks < 4; ++ks) { bf16x8 v = ldg16(QA + (size_t)row * 1536 + (n < 12 ? n : 0) * 128 + 32 * ks + 8 * kq); if (n >= 12) v = (bf16x8){0, 0, 0, 0, 0, 0, 0, 0}; qf[ks] = v; }
        asm volatile("s_waitcnt lgkmcnt(0)" ::: "memory");
        DSA_GATHER(sidx, (row / T) * T, 0, 0);
        int lb = 0, ib = 0;
        for (; row < M; row += NGW) {
            const int t = row % T, rown = (row + NGW < M) ? row + NGW : row; const bool hasn = row + NGW < M;
            int ln_ = lane; asm volatile("" : "+v"(ln_));
            int seln[4] = {0, 0, 0, 0}; int cntn_v = 0; bf16x8 qfn[4];
#pragma unroll
            for (int ks = 0; ks < 4; ++ks) qfn[ks] = (bf16x8){0, 0, 0, 0, 0, 0, 0, 0};
#define DSA_NEXT_LOADS() do { cntn_v = CNT[rown]; \
                _Pragma("unroll") for (int i = 0; i < 4; ++i) seln[i] = (int)SEL[(size_t)rown * 256 + lane + 64 * i]; \
                _Pragma("unroll") for (int ks = 0; ks < 4; ++ks) { bf16x8 v = ldg16(QA + (size_t)rown * 1536 + (n < 12 ? n : 0) * 128 + 32 * ks + 8 * kq); if (n >= 12) v = (bf16x8){0, 0, 0, 0, 0, 0, 0, 0}; qfn[ks] = v; } } while (0)
            const LAS int* sl = sidx + lb * 256; LAS int* sln = sidx + (lb ^ 1) * 256;
            float m = -1e30f, l = 0.f; f32x4 O[8];
#pragma unroll
            for (int rt = 0; rt < 8; ++rt) O[rt] = (f32x4){0.f, 0.f, 0.f, 0.f};
            for (int c0 = 0; c0 < cnt; c0 += 32) {
                LAS unsigned char* img = imgb + ib * 8192;
                if (c0 + 32 < cnt) { DSA_GATHER(sl, (row / T) * T, c0 + 32, ib ^ 1);
                    { const int e2 = (c0 + 64 < 256 ? c0 + 64 : 224) + (ln_ >> 1); const int k2 = sl[e2] & 0xffff;
                      __builtin_amdgcn_global_load_lds((const unsigned*)((const unsigned char*)(CKV + (size_t)((row / T) * T) * 128) + ((unsigned)k2 * 256u + 128u * (unsigned)(ln_ & 1))), (LAS unsigned*)(F.lds + P13_JUNK + wave * 256), 4, 0, 0); }
                    if (c0 == 0) { DSA_NEXT_LOADS(); }
                    if (c0 < 64) asm volatile("s_waitcnt vmcnt(18)" ::: "memory"); else asm volatile("s_waitcnt vmcnt(9)" ::: "memory"); }
                else if (hasn) {
                    if (c0 == 0) { DSA_NEXT_LOADS(); }
                    const int cntn = __builtin_amdgcn_readfirstlane(cntn_v);
                    DSA_LIST(sln, seln, rown % T, cntn);
                    asm volatile("s_waitcnt lgkmcnt(0)" ::: "memory");
                    DSA_GATHER(sln, (rown / T) * T, 0, ib ^ 1); asm volatile("s_waitcnt vmcnt(8)" ::: "memory"); }
                else asm volatile("s_waitcnt vmcnt(0)" ::: "memory");
                const bool has = m > -1e29f; const float mref = has ? m : 0.f; const float cinv = -mref;
                f32x4 sa = {cinv, cinv, cinv, cinv}, sb = sa;
                { const unsigned ra = 8u * ((unsigned)(ln_ & 15) >> 2) + ((unsigned)ln_ & 3u), kq_ = (unsigned)ln_ >> 4;
#pragma unroll
                  for (int s = 0; s < 4; ++s) { const bf16x8 ka = *(const LAS bf16x8*)(img + offb(ra, 4 * s + kq_)); const bf16x8 kb = *(const LAS bf16x8*)(img + offb(ra + 4, 4 * s + kq_));
                      sa = MFMA16(ka, qf[s], sa); sb = MFMA16(kb, qf[s], sb); } }
#pragma unroll
                for (int i = 0; i < 4; ++i) { const int ea = c0 + 8 * kq + i;
                    sa[i] += *(const LAS float*)((const LAS unsigned char*)b12c + ((unsigned)sl[ea] >> 16)); sb[i] += *(const LAS float*)((const LAS unsigned char*)b12c + ((unsigned)sl[ea + 4] >> 16)); }
                float fsc = 1.f;
                if (__any((imax3(imax3(__float_as_int(sa[0]), __float_as_int(sa[1]), __float_as_int(sa[2])), imax3(__float_as_int(sa[3]), __float_as_int(sb[0]), __float_as_int(sb[1])), max(__float_as_int(sb[2]), __float_as_int(sb[3]))) > __float_as_int(SM_THR)) || !has)) {
                    float lm = lmax8(sa, sb);
                    lm = fmaxf(lm, __shfl_xor(lm, 16)); lm = fmaxf(lm, __shfl_xor(lm, 32));
                    const bool upd = (lm > -INFINITY) && (!has || lm > 0.f); const float dl = upd ? lm : 0.f;
                    if (upd) m = mref + dl;
                    fsc = has ? __builtin_amdgcn_exp2f(-dl) : 1.f; l *= fsc;
#pragma unroll
                    for (int i = 0; i < 4; ++i) { sa[i] -= dl; sb[i] -= dl; }
#pragma unroll
                    for (int rt = 0; rt < 8; ++rt) O[rt] = O[rt] * fsc;
                }
                f32x4 pa, pb; float sum = 0.f;
#pragma unroll
                for (int i = 0; i < 4; ++i) { pa[i] = __builtin_amdgcn_exp2f(sa[i]); pb[i] = __builtin_amdgcn_exp2f(sb[i]); sum += pa[i] + pb[i]; }
                l += sum;
                const bf16x8 pf = pack8(pa, pb);
                { const unsigned g_ = (unsigned)ln_ >> 4, q_ = ((unsigned)ln_ & 15u) >> 2, p_ = (unsigned)ln_ & 3u;
#pragma unroll
                  for (int rt = 0; rt < 8; ++rt) { const v4i16_t x0 = trrd(img + offb(8 * g_ + q_, 2 * rt + (p_ >> 1)) + 8 * (p_ & 1)), x1 = trrd(img + offb(8 * g_ + 4 + q_, 2 * rt + (p_ >> 1)) + 8 * (p_ & 1));
                      const bf16x8 vf = {x0[0], x0[1], x0[2], x0[3], x1[0], x1[1], x1[2], x1[3]};
                      O[rt] = MFMA16(vf, pf, O[rt]); } }
                ib ^= 1;
            }
            const float il = 1.f / kqsum(l);
            if (n < 12) { bf16* op = CAT1 + (size_t)row * 1792 + n * 128 + 4 * kq;
#pragma unroll
                for (int rt = 0; rt < 8; ++rt) *(uint2*)(op + 16 * rt) = make_uint2(pk2(O[rt][0] * il, O[rt][1] * il), pk2(O[rt][2] * il, O[rt][3] * il)); }
            lb ^= 1; cnt = __builtin_amdgcn_readfirstlane(cntn_v);
#pragma unroll
            for (int ks = 0; ks < 4; ++ks) qf[ks] = qfn[ks];
        }
    }
    }
#undef DSA_GATHER
#undef DSA_LIST
#undef DSA_NEXT_LOADS
    int mreps_ = (PROBE_REP == 8) ? 2 : 1; asm volatile("" : "+s"(mreps_));
    __syncthreads();
    for (int mr_ = 0; mr_ < mreps_; ++mr_)
    for (int u64 = blockIdx.x; u64 < M / 64; u64 += F.G) {
        int tl_ = tid_; asm volatile("" : "+v"(tl_));
        const int ln = tl_ & 63, nn = ln & 15, kqq = ln >> 4, qsl = nn >> 3;
        const int row0 = 64 * u64 + 8 * wave, b = row0 / T;
        const BiasCtx BC0{(const LAS unsigned short*)(F.lds + NSA_TB), 0.f, 0.f, 0.f};
#pragma unroll 1
        for (int hm = 0; hm < 4; ++hm) {
            bf16x8 qf[4][2];
#pragma unroll
            for (int p = 0; p < 4; ++p) { qf[p][0] = (bf16x8){0, 0, 0, 0, 0, 0, 0, 0}; qf[p][1] = qf[p][0]; }
            { const bf16* qp = PR + (size_t)(row0 + (nn & 7)) * 768 + 456 + hm * 64 + 8 * kqq; if (nn < 8) { qf[0][0] = ldg16(qp); qf[0][1] = ldg16(qp + 32); } }
            float m[4], l[4]; f32x4 O[4][4];
#pragma unroll
            for (int p = 0; p < 4; ++p) { m[p] = -1e30f; l[p] = 0.f;
#pragma unroll
                for (int dt = 0; dt < 4; ++dt) O[p][dt] = (f32x4){0.f, 0.f, 0.f, 0.f}; }
            nsa_sweep<MD_MEM>(F.lds + RING_OFF, MKB + (size_t)(b * 256) * 256 + hm * 64, MVT + (size_t)(hm * 64) * 512 + b * 256, 0, 3, 0, nullptr, wave, ln, nn, kqq, qsl, 0, qf, BC0, m, l, O, 256, 64 * 256, 512, 64);
            const float il = 1.f / kqsum(l[0]);
            if (nn < 8) { bf16* op = CAT1 + (size_t)(row0 + nn) * 1792 + 1536 + hm * 64 + 4 * kqq;
#pragma unroll
                for (int dt = 0; dt < 4; ++dt) *(uint2*)(op + 16 * dt) = make_uint2(pk2(O[0][dt][0] * il, O[0][dt][1] * il), pk2(O[0][dt][2] * il, O[0][dt][3] * il)); }
            __syncthreads();
        }
    }
}

struct Args { In in; float* out; unsigned char* ws; int ph_lo, ph_hi; };
__global__ void __launch_bounds__(NWAVES * 64, 2) mk_fwd(Args args) {
    extern __shared__ __attribute__((aligned(16))) unsigned char lds[];
    Frame F;
    F.lds = (LAS unsigned char*)lds; F.MISC = (volatile LAS unsigned*)(F.lds + MISC_OFF);
    F.G = gridDim.x; { const int bx = blockIdx.x; F.vcu = (F.G % 8 == 0) ? (bx % 8) * (F.G / 8) + bx / 8 : bx; }
    unsigned char* ws = args.ws; const In& I = args.in; float* out = args.out; (void)I;
    F.ctl = (gu32*)(ws + WS_CTL);
    for (int u = threadIdx.x; u < (LDS_BYTES - LDSCTL_OFF) / 4; u += NWAVES * 64) ((LAS unsigned*)(F.lds + LDSCTL_OFF))[u] = 0u;
    __syncthreads();
    XcdBarrier bar; bar.bar = (unsigned*)(F.ctl + CW_BAR); bar.x = 0; bar.st = nullptr;
    if (!MK_SPLIT) bar = xcd_barrier_post((unsigned*)(F.ctl + CW_BAR), F.MISC + 8);
    const int lo = args.ph_lo, hi = args.ph_hi;
#ifndef PH_MASK
#define PH_MASK 0xFFFFFFFFu
#endif
#define IN(k) ((((PH_MASK) >> ((k) % 32)) & 1u) && lo <= (k) && (k) < hi)
#define SEAM(k) do { if (IN(k) && IN((k) + 1)) xcd_barrier(bar); } while (0)
#define SEAM2(k, kn) do { if (IN(k) && IN(kn)) xcd_barrier(bar); } while (0)
#ifndef REP_MASK
#define REP_MASK 0u
#endif
#define REPS(k) (1 + (int)(((REP_MASK) >> (k)) & 1u))
    bf16* XN = (bf16*)(ws + WS_XN); bf16* CAT = (bf16*)(ws + WS_CAT); bf16* ACT = (bf16*)(ws + WS_ACT);
    float* SSQ = (float*)(ws + WS_SSQ);

    if (IN(0)) { for (int r_ = 0; r_ < REPS(0); ++r_) { p0_prologue(F, I, ws); if (r_ + 1 < REPS(0)) xcd_barrier(bar); } SEAM(0); }
    {
            if (IN(1)) {
                pg8::Gemm g{XN, (const bf16*)(ws + WS_WIN0), M, 1792, D}; pg8::StaticOrder S; S.init(M, 1792, F.G, (int)blockIdx.x);
                pg8::EpiRoute<0> E{ws, nullptr};
                for (int r_ = 0; r_ < REPS(1); ++r_) { if (r_) xcd_barrier(bar);
                pg8::gemm_phase<pg8::EpiRoute<0>, pg8::StaticOrder, true, true>(F.lds + RING_OFF, g, S, E); }
                pg8::Gemm g2{(const bf16*)(ws + WS_WVT), XN, 256, M, D}; pg8::StaticOrder S2; S2.init(256, M, F.G, (int)((blockIdx.x + 64) % F.G));
                pg8::EpiRoute<3> E2{ws, nullptr};
                pg8::gemm_phase<pg8::EpiRoute<3>, pg8::StaticOrder, true, true>(F.lds + RING_OFF, g2, S2, E2);
                SEAM(1);
            }
            if (IN(2)) { for (int r_ = 0; r_ < REPS(2); ++r_) { p2_mfma(F, I, ws); if (r_ + 1 < REPS(2)) xcd_barrier(bar); } SEAM(2); }
            if (IN(3)) { for (int r_ = 0; r_ < REPS(3); ++r_) { p3_nsa_mfma(F, I, ws); if (r_ + 1 < REPS(3)) xcd_barrier(bar); } SEAM(3); }
    }
    {
        constexpr int L = 0, pb = L ? 14 : 4;
        if (IN(pb)) {
            pg8::Gemm g{L ? (const bf16*)(ws + WS_CAT1) : CAT, L ? (const bf16*)(ws + WS_WO1F) : (const bf16*)(ws + WS_WO), M, D, L ? 1792 : D}; pg8::StaticOrder S; S.init(M, D, F.G, (int)blockIdx.x);
            KARGS(); pg8::EpiResid<L == 0> E{L ? (const void*)XN : (const void*)Ip->x, XN, SSQ + (size_t)(L ? 2 : 0) * M * 16, D, 0};
            pg8::gemm_phase<pg8::EpiResid<L == 0>, pg8::StaticOrder, true, true>(F.lds + RING_OFF, g, S, E);
            SEAM2(pb, pb + 2);
        }
        if (IN(pb + 2)) {
            pg8::Gemm g{XN, (const bf16*)(ws + WS_WGU) + (size_t)L * 2 * DFF * D, M, 2 * DFF, D}; pg8::HalfTailOrder S; S.init(M, 2 * DFF, F.G, (int)blockIdx.x);
            pg8::EpiSwiglu E{ACT, SSQ + (size_t)(L ? 2 : 0) * M * 16, DFF, 0};
            for (int r_ = 0; r_ < REPS(pb + 2); ++r_) { if (r_) xcd_barrier(bar);
            pg8::gemm_phase<pg8::EpiSwiglu, pg8::HalfTailOrder, true, true>(F.lds + RING_OFF, g, S, E); }
            SEAM(pb + 2);
        }
        if (IN(pb + 3)) {
            pg8::Gemm g{ACT, (const bf16*)(ws + WS_WD) + (size_t)L * D * DFF, M, D, DFF}; pg8::StaticOrder S; S.init(M, D, F.G, (int)blockIdx.x);
            pg8::EpiResid<false> E{XN, XN, SSQ + (size_t)(L ? 3 : 1) * M * 16, D, 0};
            pg8::gemm_phase<pg8::EpiResid<false>, pg8::StaticOrder, true, true>(F.lds + RING_OFF, g, S, E);
            SEAM2(pb + 3, L ? 18 : 9);
        }
        }
    {
            if (IN(9)) {
                pg8::Gemm g{XN, (const bf16*)(ws + WS_WIN1), M, 768, D}; pg8::StaticOrder S; S.init(M, 768, F.G, (int)blockIdx.x);
                pg8::EpiRoute<1> E{ws, SSQ + (size_t)1 * M * 16};
                for (int r_ = 0; r_ < REPS(9); ++r_) { if (r_) xcd_barrier(bar);
                pg8::gemm_phase<pg8::EpiRoute<1>, pg8::StaticOrder, true, true>(F.lds + RING_OFF, g, S, E); }
                SEAM(9);
            }
            if (IN(10)) { p10_dsa_norm(F, I, ws); SEAM(10); }
            if (IN(11)) {
                pg8::Gemm g{(const bf16*)(ws + WS_CQ), (const bf16*)(ws + WS_WQ2), M, 2048, 256}; pg8::StaticOrder S; S.init(M, 2048, F.G, (int)blockIdx.x);
                pg8::EpiRoute<2> E{ws, nullptr};
                for (int r_ = 0; r_ < REPS(11); ++r_) { if (r_) xcd_barrier(bar);
                pg8::gemm_phase<pg8::EpiRoute<2>, pg8::StaticOrder, true, true>(F.lds + RING_OFF, g, S, E); }
                SEAM(11);
            }
            if (IN(12)) { for (int r_ = 0; r_ < REPS(12); ++r_) { p12_index_mfma(F, I, ws); if (r_ + 1 < REPS(12)) xcd_barrier(bar); } SEAM(12); }
            if (IN(13)) { for (int r_ = 0; r_ < REPS(13); ++r_) { p13_dsa_mfma(F, I, ws); if (r_ + 1 < REPS(13)) xcd_barrier(bar); } SEAM(13); }
            }
    {
        constexpr int L = 1, pb = L ? 14 : 4;
        if (IN(pb)) {
            pg8::Gemm g{L ? (const bf16*)(ws + WS_CAT1) : CAT, L ? (const bf16*)(ws + WS_WO1F) : (const bf16*)(ws + WS_WO), M, D, L ? 1792 : D}; pg8::StaticOrder S; S.init(M, D, F.G, (int)blockIdx.x);
            KARGS(); pg8::EpiResid<L == 0> E{L ? (const void*)XN : (const void*)Ip->x, XN, SSQ + (size_t)(L ? 2 : 0) * M * 16, D, 0};
            pg8::gemm_phase<pg8::EpiResid<L == 0>, pg8::StaticOrder, true, true>(F.lds + RING_OFF, g, S, E);
            SEAM2(pb, pb + 2);
        }
        if (IN(pb + 2)) {
            pg8::Gemm g{XN, (const bf16*)(ws + WS_WGU) + (size_t)L * 2 * DFF * D, M, 2 * DFF, D}; pg8::HalfTailOrder S; S.init(M, 2 * DFF, F.G, (int)blockIdx.x);
            pg8::EpiSwiglu E{ACT, SSQ + (size_t)(L ? 2 : 0) * M * 16, DFF, 0};
            for (int r_ = 0; r_ < REPS(pb + 2); ++r_) { if (r_) xcd_barrier(bar);
            pg8::gemm_phase<pg8::EpiSwiglu, pg8::HalfTailOrder, true, true>(F.lds + RING_OFF, g, S, E); }
            SEAM(pb + 2);
        }
        if (IN(pb + 3)) {
            pg8::Gemm g{ACT, (const bf16*)(ws + WS_WD) + (size_t)L * D * DFF, M, D, DFF}; pg8::StaticOrder S; S.init(M, D, F.G, (int)blockIdx.x);
            pg8::EpiResid<false> E{XN, XN, SSQ + (size_t)(L ? 3 : 1) * M * 16, D, 0};
            pg8::gemm_phase<pg8::EpiResid<false>, pg8::StaticOrder, true, true>(F.lds + RING_OFF, g, S, E);
            SEAM2(pb + 3, L ? 18 : 9);
        }
        }
    if (IN(18)) {
        OPAQUE_TID(); KARGS(); const int lane_ = tid_ & 63;
        const int gw = F.vcu * NWAVES + (tid_ >> 6), NGW = F.G * NWAVES;
        for (int m = gw; m < M; m += NGW) { const float r = rsqrtf(pg8::ssq_row(SSQ + ((size_t)3 * M + m) * 16) * (1.f / D) + EPSF);
#pragma unroll
            for (int j = 0; j < 2; ++j) { const int c = (j * 64 + lane_) * 8; const pg8::u32x4 rw = *(const GAS pg8::u32x4*)(XN + (size_t)m * D + c);
                const GAS f32x4* gr = (const GAS f32x4*)(Ip->norm_final + c); GAS f32x4* orow = (GAS f32x4*)(out + (size_t)m * D + c);
                f32x4 r0, r1; r0[0] = __uint_as_float(rw.x << 16); r0[1] = __uint_as_float(rw.x & 0xffff0000u); r0[2] = __uint_as_float(rw.y << 16); r0[3] = __uint_as_float(rw.y & 0xffff0000u);
                r1[0] = __uint_as_float(rw.z << 16); r1[1] = __uint_as_float(rw.z & 0xffff0000u); r1[2] = __uint_as_float(rw.w << 16); r1[3] = __uint_as_float(rw.w & 0xffff0000u);
                orow[0] = (r0 * r) * gr[0]; orow[1] = (r1 * r) * gr[1]; } }
    }
#undef IN
#undef SEAM
}

extern "C" void kernel_launch(void* const* d_in, const int* in_sizes, int n_in, void* d_out, int out_size, void* d_ws, size_t ws_size, hipStream_t stream) {
    static int grid = 0;
    if (grid == 0) {
        if (n_in != 32 || out_size != M * D || ws_size < WS_END) { fprintf(stderr, "kernel_launch: unexpected shapes (n_in %d out %d ws %zu)\n", n_in, out_size, ws_size); grid = -1; return; }
        int dev = 0, cus = 0, per_cu = 0;
        if (hipGetDevice(&dev) != hipSuccess || hipDeviceGetAttribute(&cus, hipDeviceAttributeMultiprocessorCount, dev) != hipSuccess) { grid = -1; return; }
        if (hipFuncSetAttribute((const void*)mk_fwd, hipFuncAttributeMaxDynamicSharedMemorySize, LDS_BYTES) != hipSuccess) { grid = -1; return; }
        if (hipOccupancyMaxActiveBlocksPerMultiprocessor(&per_cu, (const void*)mk_fwd, NWAVES * 64, LDS_BYTES) != hipSuccess || per_cu < 1) fprintf(stderr, "kernel_launch: occupancy query reports %d\n", per_cu);
        (void)hipGetLastError();
        grid = cus;
        if (grid > 256) grid = 256;
    }
    if (grid < 0) return;
    if (hipMemsetAsync((char*)d_ws + WS_CTL, 0, CTL_ZERO_BYTES, stream) != hipSuccess) return;
    Args a{};
    const float** ip = (const float**)&a.in;
    for (int i = 0; i < 32; ++i) ip[i] = (const float*)d_in[i];
    a.out = (float*)d_out; a.ws = (unsigned char*)d_ws;
#if MK_SPLIT
    for (int k = 0; k < N_PHASES; ++k) { a.ph_lo = k; a.ph_hi = k + 1; hipLaunchKernelGGL(mk_fwd, dim3(grid), dim3(NWAVES * 64), LDS_BYTES, stream, a); }
#else
    a.ph_lo = 0; a.ph_hi = N_PHASES; hipLaunchKernelGGL(mk_fwd, dim3(grid), dim3(NWAVES * 64), LDS_BYTES, stream, a);
#endif
}
```

```cpp
#include <hip/hip_runtime.h>
#include <cstdio>
#include <cstdint>
#include <type_traits>
#include <math.h>

namespace pg8 {
#define PG8_LAS __attribute__((address_space(3)))
typedef unsigned short bf16_t;
typedef short bf16x8 __attribute__((ext_vector_type(8)));
typedef float f32x4 __attribute__((ext_vector_type(4)));
typedef unsigned u32x4 __attribute__((ext_vector_type(4)));
constexpr int BM = 256, BK = 64, HALF = 128, HTB = HALF * BK * 2  , STAGE_BYTES = 8 * HTB, NXCD = 8, WGM = 8;

__host__ __device__ __forceinline__ int lds_byte(int r, int c) { const int st = (r >> 4) * 2 + (c >> 5), rr = r & 15, cc = c & 31, ob = rr * 64 + cc * 2; return st * 1024 + (ob ^ (((ob >> 9) & 1) << 5)); }
__host__ __device__ __forceinline__ void stage_rc(int b, int& R, int& C) { const int st = b / 1024, sb = b % 1024, swz = sb ^ (((sb >> 9) & 1) << 5); R = (st >> 1) * 16 + swz / 64; C = (st & 1) * 32 + (swz % 64) / 2; }
__host__ __device__ __forceinline__ int perm32(int rho) { const int n = rho >> 4, i = rho & 15; return 8 * (i >> 2) + 4 * n + (i & 3); }

struct Unit { int pm, pn, half; };
struct Gemm { const bf16_t* A; const bf16_t* Bt; int M, N, K; };

struct StaticOrder {
    int nM, nN, nwg, G, c;
    __host__ __device__ void init(int M, int N, int G_, int c_) { nM = M / BM; nN = N / BM; nwg = nM * nN; G = G_; c = c_; }
    __host__ __device__ void map(int L, Unit& u) const {
        int wgid = L; { const int q = nwg / NXCD, r = nwg % NXCD, xcd = wgid % NXCD, off = wgid / NXCD; wgid = (xcd < r ? xcd * (q + 1) : r * (q + 1) + (xcd - r) * q) + off; }
        const int nig = WGM * nN, gid = wgid / nig, fm = gid * WGM, gsz = (nM - fm) < WGM ? (nM - fm) : WGM;
        u.pm = fm + ((wgid % nig) % gsz); u.pn = (wgid % nig) / gsz; u.half = 0; }
    __host__ __device__ bool next(int i, Unit& u) const { const long L = (long)i * G + c; if (L >= nwg) return false; map((int)L, u); return true; }
    __device__ __forceinline__ void a_ready(const Unit&) const {}
    __device__ __forceinline__ void done(const Unit&) const {}
};
struct HalfTailOrder : StaticOrder {
    __host__ __device__ bool next(int i, Unit& u) const {
        const int nfull = (nwg / G) * G, rem = nwg - nfull; const long L = (long)i * G + c;
        if (L < nfull || 2 * rem > G) { if (L >= nwg) return false; map((int)L, u); return true; }
        const long h = L - nfull; if (h >= 2 * rem) return false;
        map(nfull + (int)(h >> 1), u); u.half = 1 + (int)(h & 1); return true; }
};

__device__ __forceinline__ unsigned cvt_pk_bf16(float lo, float hi) { unsigned r; asm volatile("v_cvt_pk_bf16_f32 %0, %1, %2" : "=v"(r) : "v"(lo), "v"(hi)); return r; }
__device__ __forceinline__ float ssq_row(const float* p) { const f32x4 a = ((const f32x4*)p)[0], b = ((const f32x4*)p)[1], c = ((const f32x4*)p)[2], d = ((const f32x4*)p)[3]; const f32x4 t = (a + b) + (c + d); return (t[0] + t[1]) + (t[2] + t[3]); }
template <int ROUTE> struct EpiRoute {
    static constexpr bool PERM = true, AFTER_DRAIN = false;
    unsigned char* ws; const float* ssq;
    __device__ __forceinline__ void operator()(const f32x4 (&acc)[2][2][4][2], const Unit& u, int wr, int wc, int fr, int fq) const {
        asm volatile("" : "+v"(fr), "+v"(fq));
        const int pn = u.pn; size_t off; int ld, t0; float sc;
        if constexpr (ROUTE == 0) {
            off = pn < 3 ? (size_t)(88u << 20) : pn < 5 ? (size_t)(112u << 20) : pn < 6 ? (size_t)(128u << 20) : (size_t)(136u << 20);
            ld = pn < 3 ? 768 : pn < 5 ? 512 : 256; t0 = pn < 3 ? 0 : pn < 5 ? 3 : pn < 6 ? 5 : 6; sc = (pn < 3 || pn == 5) ? 0.18033688011112042f : 1.f;
        } else if constexpr (ROUTE == 1) { off = (size_t)(88u << 20); ld = 768; t0 = 0; sc = 1.f; }
        else if constexpr (ROUTE == 3) { off = (size_t)(144u << 20); ld = 16384; t0 = 0; sc = 1.f; }
        else { off = pn < 6 ? (size_t)(128u << 20) : (size_t)(176u << 20); ld = pn < 6 ? 1536 : 512; t0 = pn < 6 ? 0 : 6; sc = 1.f; }
        bf16_t* base = (bf16_t*)(ws + off);
        const int row0 = u.pm * BM + wr * 64 + fr, col0 = (pn - t0) * BM + wc * 32 + 8 * fq;
#pragma unroll
        for (int ai = 0; ai < 2; ++ai)
#pragma unroll
            for (int m = 0; m < 4; ++m) { bf16_t* rowp = base + (size_t)(row0 + ai * HALF + m * 16) * ld + col0;
                float scr_ = sc; if constexpr (ROUTE == 1) scr_ = rsqrtf(ssq_row(ssq + (size_t)(row0 + ai * HALF + m * 16) * 16) * (1.f / 1024.f) + 1e-6f);
#pragma unroll
                for (int bj = 0; bj < 2; ++bj) { float scb_ = scr_; if constexpr (ROUTE == 1) { const int cg = col0 + bj * HALF; if (cg >= 456 && cg < 712) scb_ *= 0.18033688011112042f; }
                    const f32x4 v0 = acc[ai][bj][m][0] * scb_, v1 = acc[ai][bj][m][1] * scb_;
                    u32x4 w; w.x = cvt_pk_bf16(v0[0], v0[1]); w.y = cvt_pk_bf16(v0[2], v0[3]); w.z = cvt_pk_bf16(v1[0], v1[1]); w.w = cvt_pk_bf16(v1[2], v1[3]);
                    if constexpr (ROUTE == 3) {
                        const int tok = col0 + bj * HALF, rw = row0 + ai * HALF + m * 16; *(u32x4*)(base + ((size_t)(tok >> 6) * 256 + rw) * 64 + (tok & 63)) = w; }
                    else *(u32x4*)(rowp + bj * HALF) = w; } }
    }
};
template <bool RES_F32>
struct EpiResid {
    static constexpr bool PERM = true, AFTER_DRAIN = false;
    const void* res; bf16_t* hb; float* ssq; int ldc; int pad;
    __device__ __forceinline__ void operator()(const f32x4 (&acc)[2][2][4][2], const Unit& u, int wr, int wc, int fr, int fq) const {
        asm volatile("" : "+v"(fr), "+v"(fq));
        const int row0 = u.pm * BM + wr * 64 + fr, col0 = u.pn * BM + wc * 32 + 8 * fq;
#pragma unroll
        for (int ai = 0; ai < 2; ++ai)
#pragma unroll
            for (int m = 0; m < 4; ++m) { const int row = row0 + ai * HALF + m * 16; const size_t off = (size_t)row * ldc + col0; float sq = 0.f;
#pragma unroll
                for (int bj = 0; bj < 2; ++bj) { f32x4 v[2];
                    if constexpr (RES_F32) {
#pragma unroll
                        for (int n = 0; n < 2; ++n) v[n] = *(const f32x4*)((const float*)res + off + bj * HALF + 4 * n) + acc[ai][bj][m][n];
                    } else { const u32x4 rw = *(const u32x4*)((const bf16_t*)res + off + bj * HALF);
                        f32x4 r0, r1; r0[0] = __uint_as_float(rw.x << 16); r0[1] = __uint_as_float(rw.x & 0xffff0000u); r0[2] = __uint_as_float(rw.y << 16); r0[3] = __uint_as_float(rw.y & 0xffff0000u);
                        r1[0] = __uint_as_float(rw.z << 16); r1[1] = __uint_as_float(rw.z & 0xffff0000u); r1[2] = __uint_as_float(rw.w << 16); r1[3] = __uint_as_float(rw.w & 0xffff0000u);
                        v[0] = r0 + acc[ai][bj][m][0]; v[1] = r1 + acc[ai][bj][m][1]; }
#pragma unroll
                    for (int n = 0; n < 2; ++n) sq += (v[n][0] * v[n][0] + v[n][1] * v[n][1]) + (v[n][2] * v[n][2] + v[n][3] * v[n][3]);
                    u32x4 w; w.x = cvt_pk_bf16(v[0][0], v[0][1]); w.y = cvt_pk_bf16(v[0][2], v[0][3]); w.z = cvt_pk_bf16(v[1][0], v[1][1]); w.w = cvt_pk_bf16(v[1][2], v[1][3]); *(u32x4*)(hb + off + bj * HALF) = w; }
                sq += __shfl_xor(sq, 16); sq += __shfl_xor(sq, 32); if (fq == 0) ssq[(size_t)row * 16 + u.pn * 4 + wc] = sq; }
    }
};
struct EpiSwiglu {
    static constexpr bool PERM = true, AFTER_DRAIN = false;
    bf16_t* O; const float* ssq; int ldc; int pad;
    __device__ __forceinline__ void operator()(const f32x4 (&acc)[2][2][4][2], const Unit& u, int wr, int wc, int fr, int fq) const {
        asm volatile("" : "+v"(fr), "+v"(fq));
        const int row0 = u.pm * BM + wr * 64 + fr, col0 = u.pn * HALF + wc * 32 + 8 * fq;
#pragma unroll
        for (int ai = 0; ai < 2; ++ai) { if (u.half == 2 - ai) continue;
#pragma unroll
            for (int m = 0; m < 4; ++m) { float o[8]; const float rs = rsqrtf(ssq_row(ssq + (size_t)(row0 + ai * HALF + m * 16) * 16) * (1.f / 1024.f) + 1e-6f);
#pragma unroll
                for (int n = 0; n < 2; ++n)
#pragma unroll
                    for (int e = 0; e < 4; ++e) { const float g = acc[ai][0][m][n][e] * rs, up = acc[ai][1][m][n][e] * rs; o[4 * n + e] = (g * __builtin_amdgcn_rcpf(1.f + __expf(-g))) * up; }
                u32x4 w; w.x = cvt_pk_bf16(o[0], o[1]); w.y = cvt_pk_bf16(o[2], o[3]); w.z = cvt_pk_bf16(o[4], o[5]); w.w = cvt_pk_bf16(o[6], o[7]);
                *(u32x4*)(O + (size_t)(row0 + ai * HALF + m * 16) * ldc + col0) = w; } }
    }
};
template <class Epi, class Sched, bool ALIGN_EPI = false, bool SP2 = false>
__device__ __forceinline__ void gemm_phase(PG8_LAS unsigned char* lds, const Gemm g, const Sched& S, const Epi& E) {
    int tid = threadIdx.x; asm volatile("" : "+v"(tid));
    const int wid = __builtin_amdgcn_readfirstlane(tid >> 6), lane = tid & 63, wr = wid >> 2, wc = wid & 3, fr = lane & 15, fq = lane >> 4;
    int K = g.K; asm volatile("" : "+s"(K));
    const int nt = K / BK;
    unsigned voffA[2], voffB[2];
#pragma unroll
    for (int i = 0; i < 2; ++i) { int R, C; stage_rc(tid * 16 + i * 8192, R, C); const int Rb = Epi::PERM ? ((R & ~31) + perm32(R & 31)) : R;
        voffA[i] = (unsigned)(R * K + C) * 2u; voffB[i] = (unsigned)(Rb * K + C) * 2u; }
    const size_t kstep = (size_t)(BK * 2);
    const size_t hstep = (size_t)HALF * K * 2;
    const size_t tstep = 2 * hstep;
    const unsigned ldsw = (unsigned)wid * 1024u;
    const int aoff = lds_byte(wr * 64 + fr, fq * 8), boff = lds_byte(wc * 32 + fr, fq * 8);
#define PG8_SA(b, h) (((b) * 2 + (h)) * HTB)
#define PG8_SB(b, h) ((4 + (b) * 2 + (h)) * HTB)
#define PG8_STAGE(bufoff, gbase, voff) do { _Pragma("unroll") for (int _i = 0; _i < 2; ++_i) \
        __builtin_amdgcn_global_load_lds((const unsigned*)((const char*)(gbase) + (voff)[_i]), (PG8_LAS unsigned*)(lds + (bufoff) + ldsw + _i * 8192), 16, 0, 0); } while (0)
#define PG8_LDA(dst, b, h) do { if (cur.half == 2 - (h)) break;        \
        _Pragma("unroll") for (int m = 0; m < 4; ++m) _Pragma("unroll") for (int k = 0; k < 2; ++k) dst[m][k] = *(const PG8_LAS bf16x8*)(lds + PG8_SA(b, h) + aoff + m * 2048 + k * 1024); } while (0)
#define PG8_LDB(dst, b, h) do { _Pragma("unroll") for (int n = 0; n < 2; ++n) _Pragma("unroll") for (int k = 0; k < 2; ++k) dst[n][k] = *(const PG8_LAS bf16x8*)(lds + PG8_SB(b, h) + boff + n * 2048 + k * 1024); } while (0)
#define PG8_MMA(ai, bj, At, Bt) do { if (cur.half == 2 - (ai)) break; __builtin_amdgcn_s_setprio(1); _Pragma("unroll") for (int m = 0; m < 4; ++m) _Pragma("unroll") for (int n = 0; n < 2; ++n) _Pragma("unroll") for (int k = 0; k < 2; ++k) \
        acc[ai][bj][m][n] = __builtin_amdgcn_mfma_f32_16x16x32_bf16(Bt[n][k], At[m][k], acc[ai][bj][m][n], 0, 0, 0); __builtin_amdgcn_s_setprio(0); } while (0)
#define PG8_WAIT_V(n) asm volatile("s_waitcnt vmcnt(" #n ")" ::: "memory")
#define PG8_WAIT_L(n) asm volatile("s_waitcnt lgkmcnt(" #n ")" ::: "memory")
#define PG8_BAR __builtin_amdgcn_s_barrier()
#define PG8_SCHED __builtin_amdgcn_sched_barrier(0)
    Unit cur, nxt; int ui = 0;
    if (!S.next(0, cur)) return;
    f32x4 acc[2][2][4][2];
#pragma unroll
    for (int a = 0; a < 2; ++a)
#pragma unroll
        for (int b = 0; b < 2; ++b)
#pragma unroll
            for (int m = 0; m < 4; ++m)
#pragma unroll
                for (int n = 0; n < 2; ++n) acc[a][b][m][n] = (f32x4){0.f, 0.f, 0.f, 0.f};
    bf16x8 At[4][2], B0[2][2], B1[2][2];
    const char* cA = (const char*)g.A + (size_t)cur.pm * tstep; const char* cB = (const char*)g.Bt + (size_t)cur.pn * tstep;
    S.a_ready(cur);
    if constexpr (SP2) {
        PG8_STAGE(PG8_SB(0, 0), cB, voffB); PG8_STAGE(PG8_SB(0, 1), cB + hstep, voffB); PG8_STAGE(PG8_SA(0, 0), cA, voffA); PG8_STAGE(PG8_SA(0, 1), cA + hstep, voffA);
        if (wr == 1) PG8_BAR;
        PG8_WAIT_V(2); PG8_BAR;
        PG8_STAGE(PG8_SB(1, 0), cB + kstep, voffB); PG8_STAGE(PG8_SA(1, 0), cA + kstep, voffA); PG8_STAGE(PG8_SB(1, 1), cB + hstep + kstep, voffB);
        PG8_WAIT_V(6); PG8_BAR;
    } else {
        PG8_STAGE(PG8_SB(0, 0), cB, voffB); PG8_STAGE(PG8_SA(0, 0), cA, voffA); PG8_STAGE(PG8_SB(0, 1), cB + hstep, voffB); PG8_STAGE(PG8_SA(0, 1), cA + hstep, voffA);
        if (wr == 1) PG8_BAR;
        PG8_WAIT_V(4); PG8_BAR;
        PG8_STAGE(PG8_SB(1, 0), cB + kstep, voffB); PG8_STAGE(PG8_SA(1, 0), cA + kstep, voffA); PG8_STAGE(PG8_SB(1, 1), cB + hstep + kstep, voffB);
        PG8_WAIT_V(6); PG8_BAR;
    }
    for (;;) {
        const bool has_next = S.next(ui + 1, nxt);
        const char* nA = has_next ? (const char*)g.A + (size_t)nxt.pm * tstep : cA; const char* nB = has_next ? (const char*)g.Bt + (size_t)nxt.pn * tstep : cB;
        for (int t = 0; t < nt; t += 2) {
            const bool last = (t == nt - 2);
            const char* a1 = cA + (size_t)(t + 1) * kstep;
            const char* a2 = last ? nA : cA + (size_t)(t + 2) * kstep; const char* b2 = last ? nB : cB + (size_t)(t + 2) * kstep;
            const char* a3 = a2 + kstep; const char* b3 = b2 + kstep;
            if (last && has_next) S.a_ready(nxt);
            if constexpr (SP2) {
            PG8_LDB(B0, 0, 0); PG8_LDB(B1, 0, 1); PG8_SCHED; PG8_LDA(At, 0, 0); PG8_STAGE(PG8_SA(1, 1), a1 + hstep, voffA);
            PG8_WAIT_V(8); PG8_WAIT_L(0); PG8_BAR; PG8_MMA(0, 0, At, B0); PG8_MMA(0, 1, At, B1); PG8_BAR; PG8_SCHED;
            PG8_LDA(At, 0, 1); PG8_STAGE(PG8_SB(0, 0), b2, voffB); PG8_STAGE(PG8_SB(0, 1), b2 + hstep, voffB); PG8_STAGE(PG8_SA(0, 0), a2, voffA);
            PG8_WAIT_V(8); PG8_WAIT_L(0); PG8_BAR; PG8_MMA(1, 0, At, B0); PG8_MMA(1, 1, At, B1); PG8_BAR; PG8_SCHED;
            PG8_LDB(B0, 1, 0); PG8_LDB(B1, 1, 1); PG8_SCHED; PG8_LDA(At, 1, 0); PG8_STAGE(PG8_SA(0, 1), a2 + hstep, voffA);
            PG8_WAIT_V(8); PG8_WAIT_L(0); PG8_BAR; PG8_MMA(0, 0, At, B0); PG8_MMA(0, 1, At, B1); PG8_BAR; PG8_SCHED;
            PG8_LDA(At, 1, 1); PG8_STAGE(PG8_SB(1, 0), b3, voffB); PG8_STAGE(PG8_SB(1, 1), b3 + hstep, voffB); PG8_STAGE(PG8_SA(1, 0), a3, voffA);
            PG8_WAIT_V(8); PG8_WAIT_L(0); PG8_BAR; PG8_MMA(1, 0, At, B0); PG8_MMA(1, 1, At, B1); PG8_BAR; PG8_SCHED;
            } else {
            PG8_LDB(B0, 0, 0); PG8_SCHED; PG8_LDA(At, 0, 0); PG8_STAGE(PG8_SA(1, 1), a1 + hstep, voffA);
            PG8_WAIT_L(8); PG8_BAR; PG8_WAIT_L(0); PG8_MMA(0, 0, At, B0); PG8_BAR; PG8_SCHED;
            PG8_LDB(B1, 0, 1); PG8_STAGE(PG8_SB(0, 0), b2, voffB);
            PG8_BAR; PG8_WAIT_L(0); PG8_MMA(0, 1, At, B1); PG8_BAR;
            PG8_LDA(At, 0, 1); PG8_STAGE(PG8_SA(0, 0), a2, voffA);
            PG8_BAR; PG8_WAIT_L(0); PG8_MMA(1, 0, At, B0); PG8_BAR; PG8_SCHED;
            PG8_STAGE(PG8_SB(0, 1), b2 + hstep, voffB);
            PG8_WAIT_V(6); PG8_BAR; PG8_MMA(1, 1, At, B1); PG8_BAR;
            PG8_LDB(B0, 1, 0); PG8_SCHED; PG8_LDA(At, 1, 0); PG8_STAGE(PG8_SA(0, 1), a2 + hstep, voffA);
            PG8_WAIT_L(8); PG8_BAR; PG8_WAIT_L(0); PG8_MMA(0, 0, At, B0); PG8_BAR; PG8_SCHED;
            PG8_LDB(B1, 1, 1); PG8_STAGE(PG8_SB(1, 0), b3, voffB);
            PG8_BAR; PG8_WAIT_L(0); PG8_MMA(0, 1, At, B1); PG8_BAR;
            PG8_LDA(At, 1, 1); PG8_STAGE(PG8_SA(1, 0), a3, voffA);
            PG8_BAR; PG8_WAIT_L(0); PG8_MMA(1, 0, At, B0); PG8_BAR; PG8_SCHED;
            PG8_STAGE(PG8_SB(1, 1), b3 + hstep, voffB);
            PG8_WAIT_V(6); PG8_BAR; PG8_MMA(1, 1, At, B1); PG8_BAR;
            }
        }
        if constexpr (ALIGN_EPI) { if (wr == 0) PG8_BAR; }
        if constexpr (!Epi::AFTER_DRAIN) { E(acc, cur, wr, wc, fr, fq); S.done(cur); }
        if (!has_next) break;
#pragma unroll
        for (int a = 0; a < 2; ++a)
#pragma unroll
            for (int b = 0; b < 2; ++b)
#pragma unroll
                for (int m = 0; m < 4; ++m)
#pragma unroll
                    for (int n = 0; n < 2; ++n) acc[a][b][m][n] = (f32x4){0.f, 0.f, 0.f, 0.f};
        cur = nxt; cA = nA; cB = nB; ++ui;
        if constexpr (ALIGN_EPI) { if (wr == 1) PG8_BAR; }
    }
    PG8_WAIT_V(0);
    if constexpr (!ALIGN_EPI) { if (wr == 0) PG8_BAR; }
    PG8_BAR;
    if constexpr (Epi::AFTER_DRAIN) { E.fused(acc, cur, wr, wc, fr, fq, lds, wid, lane); S.done(cur); }
#undef PG8_SA
#undef PG8_SB
#undef PG8_STAGE
#undef PG8_LDA
#undef PG8_LDB
#undef PG8_MMA
#undef PG8_WAIT_V
#undef PG8_WAIT_L
#undef PG8_BAR
#undef PG8_SCHED
}
}
constexpr int NWAVES = 8;
constexpr int BATCH = 2, T = 8192, D = 1024, M = BATCH * T, DFF = 2816, NSA_IN = 1828, DSA_IN = 712, NCMP = 511, NCR = BATCH * NCMP * 2;
constexpr float NEGF = -1e30f, EPSF = 1e-6f;
#ifndef MK_SPLIT
#define MK_SPLIT 0
#endif
constexpr int N_PHASES = 19;
constexpr size_t MiB = 1u << 20;
constexpr size_t WS_CTL = 0, CTL_ZERO_BYTES = 1 * MiB;
constexpr size_t WS_KCB = 1 * MiB  , WS_VCT = 1 * MiB + 512 * 1024  , WS_MKB = 2 * MiB  , WS_MVT = 2 * MiB + 512 * 1024  , WS_MKV = 3 * MiB  , WS_WIDX = 5 * MiB  , WS_CNT = 6 * MiB  ;
constexpr size_t WS_WIN0 = 8 * MiB, WS_WO = 12 * MiB, WS_WGU = 16 * MiB, WS_WD = 38 * MiB, WS_WIN1 = 49 * MiB, WS_WQ2 = 51 * MiB, WS_WVT = 52 * MiB  ;
constexpr size_t WS_W1T = 232 * MiB, WS_MEMN = 234 * MiB, WS_WMKT = 236 * MiB, WS_W2T = 238 * MiB, WS_B1F = 238 * MiB + 64 * 1024;
constexpr size_t WS_XN = 56 * MiB;
constexpr size_t WS_Q0 = 88 * MiB, WS_KV0 = 112 * MiB  , WS_QM = 128 * MiB, WS_G0 = 136 * MiB, WS_VT = 144 * MiB  ;
static_assert(WS_Q0 == (88u << 20) && WS_KV0 == (112u << 20) && WS_QM == (128u << 20) && WS_G0 == (136u << 20), "EpiRoute tables");
constexpr size_t WS_ACT = 88 * MiB;
constexpr size_t WS_PROJ1 = 88 * MiB, WS_CQ = 112 * MiB, WS_CKV = 120 * MiB, WS_KIDX = 124 * MiB, WS_QA = 128 * MiB, WS_QI = 176 * MiB, WS_SEL = 112 * MiB  , WS_CAT1 = 176 * MiB  , WS_WO1F = 52 * MiB + 512 * 1024  ;
constexpr size_t WS_OCS = 152 * MiB  , WS_CAT = 200 * MiB, WS_SSQ = 239 * MiB  , WS_END = 243 * MiB;
static_assert(WS_PROJ1 == (88u << 20) && WS_QA == (128u << 20) && WS_QI == (176u << 20) && WS_VT == (144u << 20), "EpiRoute tables");
static_assert(WS_ACT + (size_t)M * DFF * 2 <= WS_CAT + 0 * MiB || true, "map");
constexpr int CW_BAR = 4096;
constexpr int RING_OFF = 0, RING_BYTES = 131072, LDS_BYTES = 163840, LDSCTL_OFF = LDS_BYTES - 1024, MISC_OFF = LDSCTL_OFF + 320;
#define GAS __attribute__((address_space(1)))
#define LAS __attribute__((address_space(3)))
typedef unsigned short bf16;
typedef unsigned v4u __attribute__((ext_vector_type(4)));
typedef unsigned v2u __attribute__((ext_vector_type(2)));
typedef float f32x4 __attribute__((ext_vector_type(4)));
typedef short bf16x8 __attribute__((ext_vector_type(8)));
typedef GAS unsigned gu32;
typedef GAS unsigned long long gu64;
#define RLX_AGENT __ATOMIC_RELAXED, __HIP_MEMORY_SCOPE_AGENT
#define LDS_WAIT() asm volatile("s_waitcnt lgkmcnt(0)" ::: "memory")
#define VM_WAIT() asm volatile("s_waitcnt vmcnt(0)" ::: "memory")
__device__ __forceinline__ unsigned long long rt() { return __builtin_amdgcn_s_memrealtime(); }
__device__ __forceinline__ unsigned f2bf(float f) { unsigned u = __builtin_bit_cast(unsigned, f); return (u + 0x7fffu + ((u >> 16) & 1u)) >> 16; }
typedef float f32x2_t __attribute__((ext_vector_type(2))); typedef __bf16 bf16x2_t __attribute__((ext_vector_type(2)));
__device__ __forceinline__ unsigned pk2(float lo, float hi) { f32x2_t v = {lo, hi}; bf16x2_t b = __builtin_convertvector(v, bf16x2_t); return __builtin_bit_cast(unsigned, b); }
#define XB_TMO      128
#define XB_XCNT(j)  (256  + 64 * (j))
#define XB_XSUB(j)  (1280 + 64 * (j))
#define XB_XGEN(j)  (2304 + 64 * (j))
#define XB_TOP      3328
#define XB_TOPGEN   3392
#define XCD_BAR_WORDS 3456
#define XB_SPIN_CAP (1u << 18)

__device__ __forceinline__ unsigned xb_ld(unsigned* p)              { return __hip_atomic_load(p, __ATOMIC_RELAXED, __HIP_MEMORY_SCOPE_AGENT); }
__device__ __forceinline__ unsigned xb_add(unsigned* p, unsigned v) { return __hip_atomic_fetch_add(p, v, __ATOMIC_RELAXED, __HIP_MEMORY_SCOPE_AGENT); }
__device__ __forceinline__ unsigned xb_xcc_id() { return (unsigned)__builtin_amdgcn_s_getreg((3 << 11) | 20) & 0xFu; }
#define XB_SPIN(cond, bar) do { unsigned _sp = 0; while (cond) { __builtin_amdgcn_s_sleep(1); \
    if ((++_sp & 255u) == 0u) { if (xb_ld(&(bar)[XB_TMO])) break; if (_sp > XB_SPIN_CAP) { atomicAdd(&(bar)[XB_TMO], 1u); break; } } } } while (0)

struct XcdBarrier {
    unsigned* bar; unsigned x;
    volatile LAS unsigned* st;
};

__device__ __forceinline__ XcdBarrier xcd_barrier_post(unsigned* bar, volatile LAS unsigned* st) {
    XcdBarrier b; b.bar = bar; b.x = xb_xcc_id(); b.st = st;
    if (threadIdx.x == 0) (void)xb_add(&bar[XB_XCNT(b.x)], 1u);
    return b;
}
__device__ __forceinline__ void xcd_barrier_complete(unsigned* bar, unsigned x, unsigned& nloc, unsigned& nx) {
    const unsigned G = gridDim.x * gridDim.y * gridDim.z;
    unsigned sum, cnt, mine, sp = 0u;
    for (;;) {
        sum = 0u; cnt = 0u; mine = 0u;
#pragma unroll 1
        for (unsigned j = 0; j < 16; ++j) { const unsigned c = xb_ld(&bar[XB_XCNT(j)]); sum += c; cnt += (c > 0u) ? 1u : 0u; mine = (j == x) ? c : mine; }
        if (sum == G) break;
        __builtin_amdgcn_s_sleep(1);
        if ((++sp & 255u) == 0u) { if (xb_ld(&bar[XB_TMO])) break; if (sp > XB_SPIN_CAP) { atomicAdd(&bar[XB_TMO], 1u); break; } }
    }
    nloc = mine > 0u ? mine : 1u; nx = cnt > 0u ? cnt : 1u;
}

__device__ __forceinline__ void xcd_barrier(const XcdBarrier& b) {
    asm volatile("s_waitcnt vmcnt(0)" ::: "memory");
    __syncthreads();
    if (threadIdx.x == 0) {
        unsigned* bar = b.bar;
        __builtin_amdgcn_s_waitcnt(0);
        unsigned nloc = b.st[0], nx = b.st[1];
        if (nloc == 0u) { xcd_barrier_complete(bar, b.x, nloc, nx); b.st[0] = nloc; b.st[1] = nx; }
        const unsigned old = xb_add(&bar[XB_XSUB(b.x)], 1u);
        const unsigned gen = old / nloc;
        if (old + 1u == (gen + 1u) * nloc) {
            __builtin_amdgcn_fence(__ATOMIC_RELEASE, "agent");
            asm volatile("s_waitcnt vmcnt(0)" ::: "memory");
            const unsigned og = xb_add(&bar[XB_TOP], 1u);
            const unsigned tg = og / nx;
            if (og + 1u == (tg + 1u) * nx) xb_add(&bar[XB_TOPGEN], 1u);
            else XB_SPIN(xb_ld(&bar[XB_TOPGEN]) == tg, bar);
            __builtin_amdgcn_fence(__ATOMIC_ACQUIRE, "agent");
            xb_add(&bar[XB_XGEN(b.x)], 1u);
            asm volatile("s_waitcnt vmcnt(0)" ::: "memory");
        } else {
            XB_SPIN(xb_ld(&bar[XB_XGEN(b.x)]) == gen, bar);
            __builtin_amdgcn_fence(__ATOMIC_ACQUIRE, "agent");
            asm volatile("s_waitcnt vmcnt(0)" ::: "memory");
        }
    }
    __syncthreads();
}

struct Frame {
    LAS unsigned char* lds; volatile LAS unsigned* MISC; gu32* ctl;
    int vcu, G;
};
__device__ __forceinline__ float bf2f(unsigned short u) { return __uint_as_float((unsigned)u << 16); }
__device__ __forceinline__ float bflo(unsigned u) { return __uint_as_float(u << 16); }
__device__ __forceinline__ float bfhi(unsigned u) { return __uint_as_float(u & 0xffff0000u); }
__device__ __forceinline__ float wave_sum(float v) {
#define WS_DPP_(x, ctrl) __int_as_float(__builtin_amdgcn_update_dpp(__float_as_int(x), __float_as_int(x), (ctrl), 0xf, 0xf, false))
    v += WS_DPP_(v, 0xB1); v += WS_DPP_(v, 0x4E); v += WS_DPP_(v, 0x141); v += WS_DPP_(v, 0x140);
#undef WS_DPP_
    const float a = __int_as_float(__builtin_amdgcn_readlane(__float_as_int(v), 0)), b = __int_as_float(__builtin_amdgcn_readlane(__float_as_int(v), 16)), c = __int_as_float(__builtin_amdgcn_readlane(__float_as_int(v), 32)), d = __int_as_float(__builtin_amdgcn_readlane(__float_as_int(v), 48));
    return (a + b) + (c + d);
}
__device__ __forceinline__ float red16_sum(float v) { v += __shfl_xor(v, 1, 16); v += __shfl_xor(v, 2, 16); v += __shfl_xor(v, 4, 16); v += __shfl_xor(v, 8, 16); return v; }
__device__ __forceinline__ float red16_max(float v) { v = fmaxf(v, __shfl_xor(v, 1, 16)); v = fmaxf(v, __shfl_xor(v, 2, 16)); v = fmaxf(v, __shfl_xor(v, 4, 16)); v = fmaxf(v, __shfl_xor(v, 8, 16)); return v; }
__device__ __forceinline__ int rel_bucket(int n) {
    if (n < 16) return n;
    return 16 + (n >= 22) + (n >= 30) + (n >= 40) + (n >= 54) + (n >= 73) + (n >= 99) + (n >= 134) + (n >= 182) + (n >= 246) + (n >= 332) + (n >= 450) + (n >= 609) + (n >= 825) + (n >= 1117) + (n >= 1513);
}

__device__ __forceinline__ void xpose_item(const float* W, int ldw, int c0, int nvalid, int k0, bf16* WT, int Kd, int drow0, LAS float* scr, int lane, const float* kgain = nullptr) {
#pragma unroll
    for (int i = 0; i < 8; ++i) { const int kk = 8 * i + (lane >> 3), n = (lane & 7) * 4;
        float4 wv = make_float4(0.f, 0.f, 0.f, 0.f);
        if (n + 3 < nvalid) wv = *(const float4*)(W + (size_t)(k0 + kk) * ldw + c0 + n);
        else if (n < nvalid) { const float* wp = W + (size_t)(k0 + kk) * ldw + c0 + n; wv.x = wp[0]; if (n + 1 < nvalid) wv.y = wp[1]; if (n + 2 < nvalid) wv.z = wp[2]; }
        if (kgain) { const float g_ = kgain[k0 + kk]; wv.x *= g_; wv.y *= g_; wv.z *= g_; wv.w *= g_; }
        LAS float* sp = scr + kk * 33 + n; sp[0] = wv.x; sp[1] = wv.y; sp[2] = wv.z; sp[3] = wv.w; }
    LDS_WAIT(); asm volatile("" ::: "memory");
    const int c = lane & 7;
#pragma unroll
    for (int j = 0; j < 4; ++j) { const int n = (lane >> 3) + 8 * j; const LAS float* s = scr + (8 * c) * 33 + n;
        v4u o; o.x = pk2(s[0 * 33], s[1 * 33]); o.y = pk2(s[2 * 33], s[3 * 33]); o.z = pk2(s[4 * 33], s[5 * 33]); o.w = pk2(s[6 * 33], s[7 * 33]);
        *(GAS v4u*)(WT + (size_t)(drow0 + n) * Kd + k0 + 8 * c) = o; }
    LDS_WAIT(); asm volatile("" ::: "memory");
}
__device__ __forceinline__ void rms_row_to_bf16(const float* xrow, const float* gain, bf16* orow, int lane) {
    const GAS f32x4* xr = (const GAS f32x4*)xrow + lane; const GAS f32x4* gr = (const GAS f32x4*)gain + lane;
    f32x4 v[4]; float s = 0.f;
#pragma unroll
    for (int j = 0; j < 4; ++j) { v[j] = xr[64 * j]; s += (v[j].x * v[j].x + v[j].y * v[j].y) + (v[j].z * v[j].z + v[j].w * v[j].w); }
    const float r = rsqrtf(wave_sum(s) * (1.f / D) + EPSF);
    GAS unsigned long long* o8 = (GAS unsigned long long*)orow + lane;
#pragma unroll
    for (int j = 0; j < 4; ++j) { const f32x4 g = gr[64 * j]; o8[64 * j] = (unsigned long long)pk2((v[j].x * r) * g.x, (v[j].y * r) * g.y) | ((unsigned long long)pk2((v[j].z * r) * g.z, (v[j].w * r) * g.w) << 32); }
}
#ifndef PROBE_REP
#define PROBE_REP 0
#endif
#define CAS __attribute__((address_space(4)))
#define KARGS() const CAS In* Ip = (const CAS In*)__builtin_amdgcn_kernarg_segment_ptr(); asm volatile("" : "+s"(Ip))
#define OPAQUE_TID() int tid_ = threadIdx.x; asm volatile("" : "+v"(tid_))
__device__ __forceinline__ void norm_phase(Frame& F, const float* x, const float* gain, bf16* xn) {
    OPAQUE_TID(); const int lane_ = tid_ & 63, wave_ = tid_ >> 6;
    const int gw = F.vcu * NWAVES + wave_, NGW = F.G * NWAVES;
    for (int m = gw; m < M; m += NGW) rms_row_to_bf16(x + (size_t)m * D, gain, xn + (size_t)m * D, lane_);
}

template <int DL>
__device__ __forceinline__ void coop_attend(const float (&q)[DL], const float (&k)[DL], const float (&v)[DL], float bias, float& m_, float& l_, float (&o)[DL]) {
    float a = 0.f;
#pragma unroll
    for (int d = 0; d < DL; ++d) a += q[d] * k[d];
    a = red16_sum(a) + bias;
    const float mn = fmaxf(m_, a), al = __expf(m_ - mn), p = __expf(a - mn);
    l_ = l_ * al + p; m_ = mn;
#pragma unroll
    for (int d = 0; d < DL; ++d) o[d] = o[d] * al + p * v[d];
}
__device__ __forceinline__ void ld4bf(const bf16* p, float (&x)[4]) { const uint2 u = *(const uint2*)p; x[0] = bflo(u.x); x[1] = bfhi(u.x); x[2] = bflo(u.y); x[3] = bfhi(u.y); }
__device__ __forceinline__ void ld8bf(const bf16* p, float (&x)[8]) { const uint4 u = *(const uint4*)p; x[0] = bflo(u.x); x[1] = bfhi(u.x); x[2] = bflo(u.y); x[3] = bfhi(u.y); x[4] = bflo(u.z); x[5] = bfhi(u.z); x[6] = bflo(u.w); x[7] = bfhi(u.w); }
__device__ __forceinline__ void ld4f(const float* p, float (&x)[4]) { const float4 u = *(const float4*)p; x[0] = u.x; x[1] = u.y; x[2] = u.z; x[3] = u.w; }

struct In {
    const float *x, *mem, *rel_bias, *norm_mix, *norm_ffn, *norm_mem, *w_mem_kv, *w_out, *ffn_gate, *ffn_up, *ffn_down, *nsa_w_in, *nsa_gate_b, *pos_k, *pos_v,
        *k_w1, *k_b1, *k_w2, *k_b2, *v_w1, *v_b1, *v_w2, *v_b2, *dsa_w_in, *q_norm, *kv_norm, *w_q_up, *w_uk, *w_uv, *w_q_idx, *kidx_norm, *norm_final;
};
__device__ __forceinline__ void p0_prologue(Frame& F, const In& I, unsigned char* ws) {
    OPAQUE_TID(); KARGS(); const int lane_ = tid_ & 63, wave_ = __builtin_amdgcn_readfirstlane(tid_ >> 6);
    LAS float* scr = (LAS float*)(F.lds + RING_OFF + wave_ * 16384);
    const int gw = F.vcu * NWAVES + wave_, NGW = F.G * NWAVES;
    bf16* WIN0 = (bf16*)(ws + WS_WIN0); bf16* WO = (bf16*)(ws + WS_WO); bf16* WGU = (bf16*)(ws + WS_WGU); bf16* WD = (bf16*)(ws + WS_WD); bf16* WIN1 = (bf16*)(ws + WS_WIN1); bf16* WQ2 = (bf16*)(ws + WS_WQ2);
    constexpr int I_A = 16 * 56, I_G = 16 * 8, I_B = 2 * 16 * 32, I_C = 2 * 16 * 176, I_D = 2 * 44 * 32, I_E = 16 * 24, I_F = 4 * 16, NITEMS = I_A + I_B + I_C + I_D + I_E + I_F + I_G;
    for (int it = gw; it < NITEMS; it += NGW) {
        int r = it;
        if (r < I_A) { const int kb = r / 56, nb = r % 56, r0 = 32 * nb; int c0, nv;
            if (r0 < 1152) { c0 = r0; nv = 32; } else if (r0 < 1280) { c0 = r0 + 128; nv = 32; } else if (r0 < 1536) { c0 = r0 + 292; nv = 32; } else if (r0 == 1536) { c0 = 1536; nv = 32; } else if (r0 == 1568) { c0 = 1568; nv = 4; } else { c0 = 0; nv = 0; }
            xpose_item(Ip->nsa_w_in, NSA_IN, c0, nv, 64 * kb, WIN0, D, r0, scr, lane_); continue; } r -= I_A;
        if (r < I_B) { const int l = r / 512, q = r % 512, kb = q / 32, nb = q % 32;
            xpose_item(Ip->w_out + (size_t)l * D * D, D, 32 * nb, 32, 64 * kb, WO + (size_t)l * D * D, D, 32 * nb, scr, lane_); continue; } r -= I_B;
        if (r < I_C) { const int l = r / (16 * 176), q = r % (16 * 176), kb = q / 176, nb = q % 176, r0 = 32 * nb, pn = r0 >> 8, w0 = r0 & 255;
            const float* src = ((w0 < 128) ? Ip->ffn_gate : Ip->ffn_up) + (size_t)l * D * DFF;
            xpose_item(src, DFF, 128 * pn + (w0 & 127), 32, 64 * kb, WGU + (size_t)l * 2 * DFF * D, D, r0, scr, lane_, Ip->norm_ffn + l * D); continue; } r -= I_C;
        if (r < I_D) { const int l = r / (44 * 32), q = r % (44 * 32), kb = q / 32, nb = q % 32;
            xpose_item(Ip->ffn_down + (size_t)l * DFF * D, D, 32 * nb, 32, 64 * kb, WD + (size_t)l * D * DFF, DFF, 32 * nb, scr, lane_); continue; } r -= I_D;
        if (r < I_E) { const int kb = r / 24, nb = r % 24, r0 = 32 * nb; int nv = DSA_IN - r0; nv = nv > 32 ? 32 : (nv < 0 ? 0 : nv);
            xpose_item(Ip->dsa_w_in, DSA_IN, r0, nv, 64 * kb, WIN1, D, r0, scr, lane_, Ip->norm_mix + D); continue; } r -= I_E;
        if (r < I_F) { const int kb = r / 16, nb = r % 16; xpose_item(Ip->w_q_idx, 512, 32 * nb, 32, 64 * kb, WQ2, 256, 1536 + 32 * nb, scr, lane_); continue; } r -= I_F;
        { const int kb = r / 8, nb = r % 8, r0 = 32 * nb;
            xpose_item(Ip->nsa_w_in, NSA_IN, (r0 < 128) ? 1152 + r0 : 1408 + (r0 - 128), 32, 64 * kb, (bf16*)(ws + WS_WVT), D, r0, scr, lane_); }
    }
    for (int idx = (F.vcu * NWAVES * 64) + tid_; idx < 384 * 256; idx += F.G * NWAVES * 64) {
        const int c = idx & 255, r4 = (idx >> 8) & 31, h = idx >> 13; const float4* a4 = (const float4*)(Ip->w_q_up + (size_t)c * 768 + h * 64); const float4* b4 = (const float4*)(Ip->w_uk + (size_t)(4 * r4) * 768 + h * 64);
        float s0 = 0.f, s1 = 0.f, s2 = 0.f, s3 = 0.f;
#pragma unroll 4
        for (int d = 0; d < 16; ++d) { const float4 av = a4[d], b0 = b4[d], b1 = b4[192 + d], b2 = b4[384 + d], b3 = b4[576 + d];
            s0 += (av.x * b0.x + av.y * b0.y) + (av.z * b0.z + av.w * b0.w); s1 += (av.x * b1.x + av.y * b1.y) + (av.z * b1.z + av.w * b1.w);
            s2 += (av.x * b2.x + av.y * b2.y) + (av.z * b2.z + av.w * b2.w); s3 += (av.x * b3.x + av.y * b3.y) + (av.z * b3.z + av.w * b3.w); }
        const float sc_ = 0.125f * 1.4426950408889634f;
        bf16* o_ = WQ2 + (size_t)(h * 128 + 4 * r4) * 256 + c;
        o_[0] = (bf16)f2bf(s0 * sc_); o_[256] = (bf16)f2bf(s1 * sc_); o_[512] = (bf16)f2bf(s2 * sc_); o_[768] = (bf16)f2bf(s3 * sc_);
    }
    { bf16* WO1F = (bf16*)(ws + WS_WO1F); const float* wo1 = Ip->w_out + (size_t)D * D;
      for (int idx = (F.vcu * NWAVES * 64) + tid_; idx < 12 * 32 * 256; idx += F.G * NWAVES * 64) {
          const int n4 = idx & 255, r4 = (idx >> 8) & 31, h = idx >> 13; const float* a = Ip->w_uv + (size_t)(4 * r4) * 768 + h * 64; const float* bcol = wo1 + (size_t)(h * 64) * D + 4 * n4;
          float acc_[4][4];
#pragma unroll
          for (int i = 0; i < 4; ++i)
#pragma unroll
              for (int j = 0; j < 4; ++j) acc_[i][j] = 0.f;
#pragma unroll 4
          for (int d = 0; d < 64; ++d) { const float4 bv = *(const float4*)(bcol + (size_t)d * D); const float a0 = a[d], a1 = a[768 + d], a2 = a[1536 + d], a3 = a[2304 + d];
              acc_[0][0] += a0 * bv.x; acc_[0][1] += a0 * bv.y; acc_[0][2] += a0 * bv.z; acc_[0][3] += a0 * bv.w; acc_[1][0] += a1 * bv.x; acc_[1][1] += a1 * bv.y; acc_[1][2] += a1 * bv.z; acc_[1][3] += a1 * bv.w;
              acc_[2][0] += a2 * bv.x; acc_[2][1] += a2 * bv.y; acc_[2][2] += a2 * bv.z; acc_[2][3] += a2 * bv.w; acc_[3][0] += a3 * bv.x; acc_[3][1] += a3 * bv.y; acc_[3][2] += a3 * bv.z; acc_[3][3] += a3 * bv.w; }
#pragma unroll
          for (int j = 0; j < 4; ++j) *(uint2*)(WO1F + (size_t)(4 * n4 + j) * 1792 + h * 128 + 4 * r4) = make_uint2(pk2(acc_[0][j], acc_[1][j]), pk2(acc_[2][j], acc_[3][j])); }
      for (int it = gw; it < 4 * 32; it += NGW) { const int kb = it / 32, nb = it % 32;
          xpose_item(wo1 + (size_t)768 * D, D, 32 * nb, 32, 64 * kb, WO1F + 1536, 1792, 32 * nb, scr, lane_); } }
    { bf16* W1T = (bf16*)(ws + WS_W1T); bf16* W2T = (bf16*)(ws + WS_W2T); bf16* WMKT = (bf16*)(ws + WS_WMKT); float* B1F = (float*)(ws + WS_B1F); bf16* MEMN = (bf16*)(ws + WS_MEMN);
      constexpr int J_1 = 2 * 32 * 8, J_2 = 2 * 4 * 2, J_M = 2 * 16 * 16;
      for (int it = gw; it < J_1 + J_2 + J_M; it += NGW) { int r2 = it;
          if (r2 < J_1) { const int kv = r2 / 256, q = r2 % 256, kb = q / 8, nb = q % 8; xpose_item(kv ? Ip->v_w1 : Ip->k_w1, 256, 32 * nb, 32, 64 * kb, W1T + (size_t)kv * 256 * 2048, 2048, 32 * nb, scr, lane_); continue; } r2 -= J_1;
          if (r2 < J_2) { const int kv = r2 / 8, q = r2 % 8, kb = q / 2, nb = q % 2; xpose_item(kv ? Ip->v_w2 : Ip->k_w2, 64, 32 * nb, 32, 64 * kb, W2T + (size_t)kv * 64 * 256, 256, 32 * nb, scr, lane_); continue; } r2 -= J_2;
          { const int l = r2 / 256, q = r2 % 256, kb = q / 16, nb = q % 16; xpose_item(Ip->w_mem_kv + (size_t)l * D * 512, 512, 32 * nb, 32, 64 * kb, WMKT + (size_t)l * 512 * D, D, 32 * nb, scr, lane_); } }
      if ((int)blockIdx.x < 32) { const int u_ = (int)blockIdx.x, kv = u_ >> 4, cr = (u_ >> 2) & 3, kq4 = u_ & 3, c = 64 * cr + lane_; const float* w1 = kv ? Ip->v_w1 : Ip->k_w1; const float* pos = kv ? Ip->pos_v : Ip->pos_k;
          const int kb0 = 512 * kq4 + 64 * wave_; float sacc = 0.f;
#pragma unroll 8
          for (int k = 0; k < 64; ++k) sacc += pos[kb0 + k] * w1[(size_t)(kb0 + k) * 256 + c];
          LAS float* red = (LAS float*)(F.lds + RING_OFF + 8 * 16384);
          red[wave_ * 64 + lane_] = sacc;
          __syncthreads();
          if (wave_ == 0) { float t_ = 0.f;
#pragma unroll
              for (int w = 0; w < 8; ++w) t_ += red[w * 64 + lane_];
              B1F[(kv * 4 + kq4) * 256 + c] = t_; } }
      for (int m = gw; m < 1024; m += NGW) rms_row_to_bf16(Ip->mem + (size_t)(m & 511) * D, Ip->norm_mem + (m >> 9) * D, MEMN + (size_t)m * D, lane_); }
    norm_phase(F, Ip->x, Ip->norm_mix, (bf16*)(ws + WS_XN));
}

#define MFMA16(A, B, C) __builtin_amdgcn_mfma_f32_16x16x32_bf16((A), (B), (C), 0, 0, 0)
constexpr float LOG2E = 1.4426950408889634f;
constexpr int NSA_OUT = 0, NSA_PSQ = 49152, NSA_ST = 147456, NSA_TB = NSA_ST + 3072;
constexpr int TAB_B12 = NSA_ST + 1024;
constexpr int P13_JUNK = NSA_ST + 3072 + 1536;
constexpr int P13_B12 = NSA_ST;
constexpr int TAB_BKT = NSA_ST + 3072;
static_assert(NSA_TB + 12288 <= LDSCTL_OFF && TAB_B12 + 2048 <= NSA_TB, "LDS tables");
enum { MD_CMP = 0, MD_WIN = 1, MD_BLK = 2, MD_MEM = 3 };
struct KF { bf16x8 a0, a1, b0, b1; };
struct VF { bf16x8 v[4]; };
__device__ __forceinline__ bf16x8 ldg16(const bf16* p) { return *(const bf16x8*)p; }
__device__ __forceinline__ unsigned cvtpk_s(float lo, float hi) { f32x2_t v = {lo, hi}; bf16x2_t b = __builtin_convertvector(v, bf16x2_t); return __builtin_bit_cast(unsigned, b); }
__device__ __forceinline__ bf16x8 pack8(const f32x4& a, const f32x4& b) { v4u w; w.x = cvtpk_s(a[0], a[1]); w.y = cvtpk_s(a[2], a[3]); w.z = cvtpk_s(b[0], b[1]); w.w = cvtpk_s(b[2], b[3]); return __builtin_bit_cast(bf16x8, w); }
__device__ __forceinline__ void load_k(KF& k, const bf16* kb, int kstride, int key0, int r, int kq) {
    const bf16* pa = kb + (size_t)(key0 + 8 * (r >> 2) + (r & 3)) * kstride + 8 * kq; const bf16* pb = pa + 4 * (size_t)kstride;
    k.a0 = ldg16(pa); k.a1 = ldg16(pa + 32); k.b0 = ldg16(pb); k.b1 = ldg16(pb + 32);
}
__device__ __forceinline__ void load_vt(VF& v, const bf16* vt, int vstride, int key0, int r, int kq) {
#pragma unroll
    for (int dt = 0; dt < 4; ++dt) v.v[dt] = ldg16(vt + (size_t)(16 * dt + r) * vstride + key0 + 8 * kq);
}
__device__ __forceinline__ void qk(f32x4& sa, f32x4& sb, const KF& k, const bf16x8 (&q)[2]) {
    const f32x4 z = {0.f, 0.f, 0.f, 0.f};
    sa = MFMA16(k.a0, q[0], z); sa = MFMA16(k.a1, q[1], sa); sb = MFMA16(k.b0, q[0], z); sb = MFMA16(k.b1, q[1], sb);
}
struct BiasCtx { const LAS unsigned short* tb; float d29, d30, c31; };
template <int MODE>
__device__ __forceinline__ void maskbias(f32x4& s, int kpos, int tcol, bool colok, const BiasCtx& B) {
    if (MODE == MD_MEM) return;
#pragma unroll
    for (int i = 0; i < 4; ++i) {
        int dist; bool ok;
        if (MODE == MD_CMP) { dist = tcol - 31 - 16 * (kpos + i); ok = dist >= 0; }
        else if (MODE == MD_WIN) { dist = tcol - (kpos + i); ok = (unsigned)dist <= 511u; }
        else { dist = tcol - (kpos + i); ok = dist >= 0; }
        int dc = dist < 0 ? 0 : dist; dc = dc > 1023 ? 1023 : dc;
        const float tb = __uint_as_float((unsigned)B.tb[dc * 6] << 16);
        float bias = tb;
        if (MODE != MD_WIN) { const float far = B.c31 + (dist < 1513 ? B.d30 : 0.f) + (dist < 1117 ? B.d29 : 0.f); bias = dist < 1024 ? tb : far; }
        s[i] = (ok && colok) ? s[i] + bias : -INFINITY;
    }
}
__device__ __forceinline__ float colmax(const f32x4& sa, const f32x4& sb) {
    float mx = fmaxf(fmaxf(fmaxf(sa[0], sa[1]), fmaxf(sa[2], sa[3])), fmaxf(fmaxf(sb[0], sb[1]), fmaxf(sb[2], sb[3])));
    mx = fmaxf(mx, __shfl_xor(mx, 16)); mx = fmaxf(mx, __shfl_xor(mx, 32)); return mx;
}
constexpr float SM_THR = 8.f;
__device__ __forceinline__ float lmax8(const f32x4& sa, const f32x4& sb) { return fmaxf(fmaxf(fmaxf(sa[0], sa[1]), fmaxf(sa[2], sa[3])), fmaxf(fmaxf(sb[0], sb[1]), fmaxf(sb[2], sb[3]))); }
__device__ __forceinline__ int imax3(int a, int b, int c) { return max(max(a, b), c); }
__device__ __forceinline__ int imax16(const f32x4& a, const f32x4& b, const f32x4& c, const f32x4& d) {
#define FI_(x) __float_as_int(x)
    const int t0 = imax3(FI_(a[0]), FI_(a[1]), FI_(a[2])), t1 = imax3(FI_(a[3]), FI_(b[0]), FI_(b[1])), t2 = imax3(FI_(b[2]), FI_(b[3]), FI_(c[0])), t3 = imax3(FI_(c[1]), FI_(c[2]), FI_(c[3])), t4 = imax3(FI_(d[0]), FI_(d[1]), FI_(d[2]));
    return max(imax3(t0, t1, FI_(d[3])), imax3(t2, t3, t4));
#undef FI_
}
template <int NO>
__device__ __forceinline__ void sm_rescale(float lm, float& m, float& l, f32x4 (&O)[NO]) {
    if (__any(lm > m + SM_THR)) {
        lm = fmaxf(lm, __shfl_xor(lm, 16)); lm = fmaxf(lm, __shfl_xor(lm, 32));
        const float mn = fmaxf(m, lm); const float al = __builtin_amdgcn_exp2f(m - mn); m = mn; l *= al;
#pragma unroll
        for (int dt = 0; dt < NO; ++dt) O[dt] = O[dt] * al;
    }
}
__device__ __forceinline__ bf16x8 sm_update(const f32x4& sa, const f32x4& sb, float& m, float& l, f32x4 (&O)[4]) {
    sm_rescale<4>(lmax8(sa, sb), m, l, O);
    f32x4 pa, pb; float sum = 0.f;
#pragma unroll
    for (int i = 0; i < 4; ++i) { pa[i] = __builtin_amdgcn_exp2f(sa[i] - m); pb[i] = __builtin_amdgcn_exp2f(sb[i] - m); sum += pa[i] + pb[i]; }
    l += sum;
    return pack8(pa, pb);
}
__device__ __forceinline__ void sm_update64(const f32x4& sa0, const f32x4& sb0, const f32x4& sa1, const f32x4& sb1, float& m, float& l, f32x4 (&O)[4], bf16x8& pf0, bf16x8& pf1) {
    sm_rescale<4>(fmaxf(lmax8(sa0, sb0), lmax8(sa1, sb1)), m, l, O);
    f32x4 pa0, pb0, pa1, pb1; float sum = 0.f;
#pragma unroll
    for (int i = 0; i < 4; ++i) { pa0[i] = __builtin_amdgcn_exp2f(sa0[i] - m); pb0[i] = __builtin_amdgcn_exp2f(sb0[i] - m); pa1[i] = __builtin_amdgcn_exp2f(sa1[i] - m); pb1[i] = __builtin_amdgcn_exp2f(sb1[i] - m);
        sum += (pa0[i] + pb0[i]) + (pa1[i] + pb1[i]); }
    l += sum;
    pf0 = pack8(pa0, pb0); pf1 = pack8(pa1, pb1);
}
enum { BK_FAR = 0, BK_MID = 1, BK_GEN = 2, BK_FARF = 3 };
template <int MD, int CLS>
__device__ __forceinline__ void step64(const KF& k0, const KF& k1, const bf16x8 (&q)[2], int cls, int kpos, int tcol, bool colok, const BiasCtx& B,
                                       float& m, float& l, f32x4 (&O)[4], bf16x8& pf0, bf16x8& pf1) {
    const bool has = m > -1e29f; const float mref = has ? m : 0.f;
    if (CLS >= 0) cls = CLS;
    float cin = ((cls == BK_FAR) ? B.c31 : 0.f) - mref; if (!colok) cin = -INFINITY;
    const f32x4 c4 = {cin, cin, cin, cin};
    f32x4 sa0 = MFMA16(k0.a0, q[0], c4), sb0 = MFMA16(k0.b0, q[0], c4), sa1 = MFMA16(k1.a0, q[0], c4), sb1 = MFMA16(k1.b0, q[0], c4);
    sa0 = MFMA16(k0.a1, q[1], sa0); sb0 = MFMA16(k0.b1, q[1], sb0); sa1 = MFMA16(k1.a1, q[1], sa1); sb1 = MFMA16(k1.b1, q[1], sb1);
    if (cls == BK_MID) {
        const LAS unsigned short* tl = B.tb + (tcol - kpos - 39) * 6; asm("" : "+v"(tl));
#pragma unroll
        for (int i = 0; i < 4; ++i) { sa0[i] += __uint_as_float((unsigned)tl[6 * (39 - i)] << 16); sb0[i] += __uint_as_float((unsigned)tl[6 * (35 - i)] << 16);
            sa1[i] += __uint_as_float((unsigned)tl[6 * (7 - i)] << 16); sb1[i] += __uint_as_float((unsigned)tl[6 * (3 - i)] << 16); }
    } else if (CLS == BK_FARF) {
        const int d0 = tcol - kpos;
#pragma unroll
        for (int i = 0; i < 4; ++i) {
            { const int d = d0 - i;      sa0[i] += B.c31 + (d < 1513 ? B.d30 : 0.f) + (d < 1117 ? B.d29 : 0.f); }
            { const int d = d0 - 4 - i;  sb0[i] += B.c31 + (d < 1513 ? B.d30 : 0.f) + (d < 1117 ? B.d29 : 0.f); }
            { const int d = d0 - 32 - i; sa1[i] += B.c31 + (d < 1513 ? B.d30 : 0.f) + (d < 1117 ? B.d29 : 0.f); }
            { const int d = d0 - 36 - i; sb1[i] += B.c31 + (d < 1513 ? B.d30 : 0.f) + (d < 1117 ? B.d29 : 0.f); } }
    } else if (cls == BK_GEN) {
        maskbias<MD>(sa0, kpos, tcol, true, B); maskbias<MD>(sb0, kpos + 4, tcol, true, B); maskbias<MD>(sa1, kpos + 32, tcol, true, B); maskbias<MD>(sb1, kpos + 36, tcol, true, B);
    }
    if (__any((imax16(sa0, sb0, sa1, sb1) > __float_as_int(SM_THR)) || !has)) {
        float lm = fmaxf(lmax8(sa0, sb0), lmax8(sa1, sb1));
        lm = fmaxf(lm, __shfl_xor(lm, 16)); lm = fmaxf(lm, __shfl_xor(lm, 32));
        const bool upd = (lm > -INFINITY) && (!has || lm > 0.f); const float dl = upd ? lm : 0.f;
        if (upd) m = mref + dl;
        const float f = has ? __builtin_amdgcn_exp2f(-dl) : 1.f; l *= f;
#pragma unroll
        for (int dt = 0; dt < 4; ++dt) O[dt] = O[dt] * f;
#pragma unroll
        for (int i = 0; i < 4; ++i) { sa0[i] -= dl; sb0[i] -= dl; sa1[i] -= dl; sb1[i] -= dl; }
    }
    f32x4 pa0, pb0, pa1, pb1; float sum = 0.f;
#pragma unroll
    for (int i = 0; i < 4; ++i) { pa0[i] = __builtin_amdgcn_exp2f(sa0[i]); pb0[i] = __builtin_amdgcn_exp2f(sb0[i]); pa1[i] = __builtin_amdgcn_exp2f(sa1[i]); pb1[i] = __builtin_amdgcn_exp2f(sb1[i]);
        sum += (pa0[i] + pb0[i]) + (pa1[i] + pb1[i]); }
    l += sum;
    pf0 = pack8(pa0, pb0); pf1 = pack8(pa1, pb1);
}
__device__ __forceinline__ void pv(f32x4 (&O)[4], const VF& v, const bf16x8& pf) {
#pragma unroll
    for (int dt = 0; dt < 4; ++dt) O[dt] = MFMA16(v.v[dt], pf, O[dt]);
}
__device__ __forceinline__ void lds_fadd(LAS float* p, float v) { (void)__hip_atomic_fetch_add((float*)p, v, __ATOMIC_RELAXED, __HIP_MEMORY_SCOPE_WORKGROUP); }
#define DPP_I(x, ctrl) __builtin_amdgcn_update_dpp((x), (x), (ctrl), 0xf, 0xf, false)
#define DPP_F(x, ctrl) __int_as_float(__builtin_amdgcn_update_dpp(__float_as_int(x), __float_as_int(x), (ctrl), 0xf, 0xf, false))
__device__ __forceinline__ float sum8_dpp(float v) { v += DPP_F(v, 0xB1); v += DPP_F(v, 0x4E); v += DPP_F(v, 0x141); return v; }
__device__ __forceinline__ unsigned wave_iscan_u32(unsigned x) {
#define DPP_Z(v, ctrl, rmask) (unsigned)__builtin_amdgcn_update_dpp(0, (int)(v), (ctrl), (rmask), 0xf, false)
    x += DPP_Z(x, 0x111, 0xf); x += DPP_Z(x, 0x112, 0xf); x += DPP_Z(x, 0x114, 0xf); x += DPP_Z(x, 0x118, 0xf); x += DPP_Z(x, 0x142, 0xa); x += DPP_Z(x, 0x143, 0xc);
#undef DPP_Z
    return x; }
__device__ __forceinline__ int wmax64_i(int x) {
    x = max(x, DPP_I(x, 0xB1)); x = max(x, DPP_I(x, 0x4E)); x = max(x, DPP_I(x, 0x141)); x = max(x, DPP_I(x, 0x140));
    return max(max(__builtin_amdgcn_readlane(x, 0), __builtin_amdgcn_readlane(x, 16)), max(__builtin_amdgcn_readlane(x, 32), __builtin_amdgcn_readlane(x, 48))); }
__device__ __forceinline__ float kqsum(float v) { v += __shfl_xor(v, 16); v += __shfl_xor(v, 32); return v; }
__device__ __forceinline__ float wmax64(float v) {
#pragma unroll
    for (int o = 1; o < 64; o <<= 1) v = fmaxf(v, __shfl_xor(v, o));
    return v;
}
__device__ __forceinline__ void out_add(LAS unsigned short* OUTw, int p, int n, int kq, const f32x4 (&O)[4], float scale, bool first) {
    const int q = 2 * p + (n >> 3), hd = n & 7;
    if (hd < 6) { LAS v2u* dst = (LAS v2u*)(OUTw + (q * 6 + hd) * 64) + kq;
#pragma unroll
        for (int dt = 0; dt < 4; ++dt) { f32x4 v = O[dt] * scale; if (!first) { const v2u o = dst[4 * dt]; v[0] += __uint_as_float(o.x << 16); v[1] += __uint_as_float(o.x & 0xffff0000u); v[2] += __uint_as_float(o.y << 16); v[3] += __uint_as_float(o.y & 0xffff0000u); }
            dst[4 * dt] = (v2u){pk2(v[0], v[1]), pk2(v[2], v[3])}; } }
}

__device__ __forceinline__ void p2_mfma(Frame& F, const In& I, unsigned char* ws) {
    OPAQUE_TID(); KARGS(); const int lane = tid_ & 63, wave = __builtin_amdgcn_readfirstlane(tid_ >> 6), r = lane & 15, kq = lane >> 4;
    const bf16* KV0 = (const bf16*)(ws + WS_KV0); const bf16* W1T = (const bf16*)(ws + WS_W1T); const bf16* W2T = (const bf16*)(ws + WS_W2T); const float* B1F = (const float*)(ws + WS_B1F);
    const bf16* MEMN = (const bf16*)(ws + WS_MEMN); const bf16* WMKT = (const bf16*)(ws + WS_WMKT);
    bf16* KCB = (bf16*)(ws + WS_KCB); bf16* VCT = (bf16*)(ws + WS_VCT); bf16* MKB = (bf16*)(ws + WS_MKB); bf16* MVT = (bf16*)(ws + WS_MVT);
    LAS unsigned char* aim = F.lds + RING_OFF;
    LAS unsigned char* hid = F.lds + RING_OFF + RING_BYTES;
    for (int u = blockIdx.x; u < 192; u += F.G) {
        const bool cmp = u < 128;
        const bf16* bp[2]; int K, kjump;
        int kv = 0, bg = 0, n0 = 0, lay = 0, m0 = 0, ch = 0;
        if (cmp) { kv = u >> 6; bg = (u >> 4) & 3; n0 = (u & 15) * 32; K = 2048; kjump = 512 - 64;
#pragma unroll
            for (int ct = 0; ct < 2; ++ct) bp[ct] = W1T + (size_t)(kv * 256 + 32 * wave + 16 * ct + r) * 2048 + 8 * kq;
        } else { const int v = u - 128; lay = v >> 5; m0 = ((v >> 1) & 15) * 32; ch = v & 1; K = 1024; kjump = 0;
#pragma unroll
            for (int ct = 0; ct < 2; ++ct) bp[ct] = WMKT + (size_t)(lay * 512 + ch * 256 + 32 * wave + 16 * ct + r) * 1024 + 8 * kq;
        }
        { const int nins = (K >> 6) * 4;
          for (int i = wave; i < nins; i += NWAVES) { const int seg = 8 * i + (lane >> 3), c = lane & 7, sblk = seg >> 5, row = seg & 31;
              const bf16* arow; if (cmp) { const int b = bg >> 1, g = bg & 1; int nn = n0 + row; nn = nn > 510 ? 510 : nn; arow = KV0 + (size_t)(b * T + 16 * nn) * 512 + kv * 128 + g * 64; }
              else arow = MEMN + (size_t)(lay * 512 + m0 + row) * 1024;
              __builtin_amdgcn_global_load_lds((const unsigned*)(arow + 64 * sblk + sblk * kjump + 8 * (c ^ (row & 7))), (LAS unsigned*)(aim + i * 1024), 16, 0, 0); }
          asm volatile("s_waitcnt vmcnt(0)" ::: "memory"); __syncthreads(); }
        f32x4 acc[2][2];
#pragma unroll
        for (int rt = 0; rt < 2; ++rt)
#pragma unroll
            for (int ct = 0; ct < 2; ++ct) acc[rt][ct] = (f32x4){0.f, 0.f, 0.f, 0.f};
        { int r_ = r, kq_ = kq; asm volatile("" : "+v"(r_), "+v"(kq_));
          bf16x8 bb[2][2], bn[2][2];
#define P2_LOADB(B_, kb_) do { const int kbl_ = (kb_) < K ? (kb_) : K - 64; \
            _Pragma("unroll") for (int h2 = 0; h2 < 2; ++h2) _Pragma("unroll") for (int ct = 0; ct < 2; ++ct) B_[ct][h2] = *(const GAS bf16x8*)(bp[ct] + kbl_ + 32 * h2); } while (0)
#define P2_MM(B_, kb_) do { const LAS unsigned char* as_ = aim + ((kb_) >> 6) * 4096; \
            _Pragma("unroll") for (int h2 = 0; h2 < 2; ++h2) _Pragma("unroll") for (int rt = 0; rt < 2; ++rt) { const int row_ = 16 * rt + r_; \
                const bf16x8 av_ = *(const LAS bf16x8*)(as_ + row_ * 128 + (((4 * h2 + kq_) ^ (row_ & 7)) << 4)); \
                _Pragma("unroll") for (int ct = 0; ct < 2; ++ct) acc[rt][ct] = MFMA16(av_, B_[ct][h2], acc[rt][ct]); } } while (0)
          P2_LOADB(bb, 0);
          for (int kb = 0; kb < K; kb += 128) {
              P2_LOADB(bn, kb + 64); P2_MM(bb, kb);
              P2_LOADB(bb, kb + 128); P2_MM(bn, kb + 64);
          }
#undef P2_LOADB
#undef P2_MM
        }
        if (cmp) {
#pragma unroll
            for (int ct = 0; ct < 2; ++ct) { const int col = 32 * wave + 16 * ct + r; const float bias = (kv ? Ip->v_b1 : Ip->k_b1)[col] + ((B1F[(kv * 4 + 0) * 256 + col] + B1F[(kv * 4 + 1) * 256 + col]) + (B1F[(kv * 4 + 2) * 256 + col] + B1F[(kv * 4 + 3) * 256 + col]));
#pragma unroll
                for (int rt = 0; rt < 2; ++rt)
#pragma unroll
                    for (int i = 0; i < 4; ++i) { const float xg = acc[rt][ct][i] + bias; const float hv = 0.5f * xg * (1.f + tanhf(0.7978845608028654f * (xg + 0.044715f * xg * xg * xg)));
                        *(LAS unsigned short*)(hid + (16 * rt + 4 * kq + i) * 528 + 2 * col) = (unsigned short)f2bf(hv); } }
            __syncthreads();
            { const int rt2 = wave >> 2, ct2 = wave & 3; f32x4 o = {0.f, 0.f, 0.f, 0.f};
              const bf16* w2p = W2T + (size_t)(kv * 64 + 16 * ct2 + r) * 256 + 8 * kq;
#pragma unroll
              for (int ks = 0; ks < 8; ++ks) { const bf16x8 av = *(const LAS bf16x8*)(hid + (16 * rt2 + r) * 528 + 64 * ks + 16 * kq); o = MFMA16(av, ldg16(w2p + 32 * ks), o); }
              const int d = 16 * ct2 + r; const float b2v = (kv ? Ip->v_b2 : Ip->k_b2)[d];
#pragma unroll
              for (int i = 0; i < 4; ++i) { const int nn = n0 + 16 * rt2 + 4 * kq + i; const unsigned short ov = (nn < NCMP) ? (unsigned short)f2bf(o[i] + b2v) : (unsigned short)0;
                  if (kv) VCT[(size_t)(bg * 64 + d) * 512 + nn] = ov; else KCB[(size_t)(bg * 512 + nn) * 64 + d] = ov; } }
            __syncthreads();
        } else {
#pragma unroll
            for (int ct = 0; ct < 2; ++ct) { const int col = 32 * wave + 16 * ct + r;
#pragma unroll
                for (int rt = 0; rt < 2; ++rt)
#pragma unroll
                    for (int i = 0; i < 4; ++i) { const int mrow = m0 + 16 * rt + 4 * kq + i; const unsigned short ov = (unsigned short)f2bf(acc[rt][ct][i]);
                        if (ch == 0) MKB[(size_t)(lay * 512 + mrow) * 256 + col] = ov; else MVT[(size_t)(lay * 256 + col) * 512 + mrow] = ov; } }
            __syncthreads();
        }
    }
}

template <int MODE>
__device__ __forceinline__ void mb2(f32x4& sa, f32x4& sb, int kpos, int tcol, bool colok, bool fast, const BiasCtx& B) {
    if (fast) { if (colok) { sa = sa + B.c31; sb = sb + B.c31; } else { sa = (f32x4){-INFINITY, -INFINITY, -INFINITY, -INFINITY}; sb = sa; } }
    else { maskbias<MODE>(sa, kpos, tcol, colok, B); maskbias<MODE>(sb, kpos + 4, tcol, colok, B); }
}
__device__ __forceinline__ void cmp_bias(f32x4& sa, f32x4& sb, int kpos, int tcol, int ccls, const BiasCtx& B) {
    if (ccls == 0) { sa = sa + B.c31; sb = sb + B.c31; }
    else if (ccls == 1) { const int d0 = tcol - 31 - 16 * kpos;
#pragma unroll
        for (int i = 0; i < 4; ++i) { { const int d = d0 - 16 * i; sa[i] += B.c31 + (d < 1513 ? B.d30 : 0.f) + (d < 1117 ? B.d29 : 0.f); }
                                      { const int d = d0 - 64 - 16 * i; sb[i] += B.c31 + (d < 1513 ? B.d30 : 0.f) + (d < 1117 ? B.d29 : 0.f); } } }
    else if (ccls == 2) { const LAS unsigned short* tl = B.tb + (tcol - 31 - 16 * (kpos + 7)) * 6; asm("" : "+v"(tl));
#pragma unroll
        for (int i = 0; i < 4; ++i) { sa[i] += __uint_as_float((unsigned)tl[96 * (7 - i)] << 16); sb[i] += __uint_as_float((unsigned)tl[96 * (3 - i)] << 16); } }
    else { maskbias<MD_CMP>(sa, kpos, tcol, true, B); maskbias<MD_CMP>(sb, kpos + 4, tcol, true, B); }
}
#define SWZ(row) (((((row) >> 3) & 3) << 1) | (((row) >> 1) & 1))
struct KV1 { KF k; VF v; };
__device__ __forceinline__ void load_kv(KV1& d, const bf16* kb, int kstride, const bf16* vt, int vstride, int key0, int r, int kq) { load_k(d.k, kb, kstride, key0, r, kq); load_vt(d.v, vt, vstride, key0, r, kq); }

template <int MD, int FORCE = 0>
__device__ __forceinline__ void nsa_sweep(LAS unsigned char* STG, const bf16* ksb, const bf16* vst, int jlo, int jhi, int qt, const LAS unsigned* WMw, int wave, int lane, int r, int kq, int qsel, int t0w,
                                          const bf16x8 (&qf)[4][2], const BiasCtx& BC, float (&m)[4], float (&l)[4], f32x4 (&O)[4][4],
                                          int kstr = 512, int kblk = 64 * 512, int vstr = 64, int vblk = 16384) {
            const int srow = 8 * wave + (lane >> 3), sch = (lane & 7) ^ SWZ(srow);
            const bf16* ksrc = ksb + (size_t)srow * kstr + 8 * sch; const bf16* vsrc = vst + (size_t)srow * vstr + 8 * sch;
#define NSA_DMA(jb) do { LAS unsigned char* d_ = STG + ((jb) % 6) * 16384 + wave * 1024; \
                __builtin_amdgcn_global_load_lds((const unsigned*)(ksrc + (size_t)(jb) * kblk), (LAS unsigned*)d_, 16, 0, 0); \
                __builtin_amdgcn_global_load_lds((const unsigned*)(vsrc + (size_t)(jb) * vblk), (LAS unsigned*)(d_ + 8192), 16, 0, 0); } while (0)
#define NSA_WAITV(n_) do { if ((n_) >= 6) asm volatile("s_waitcnt vmcnt(6) lgkmcnt(0)" ::: "memory"); else if ((n_) == 4) asm volatile("s_waitcnt vmcnt(4) lgkmcnt(0)" ::: "memory"); else if ((n_) == 2) asm volatile("s_waitcnt vmcnt(2) lgkmcnt(0)" ::: "memory"); else asm volatile("s_waitcnt vmcnt(0) lgkmcnt(0)" ::: "memory"); } while (0)
            { const int nb = jhi - jlo + 1;
#pragma unroll
              for (int i = 0; i < 3; ++i) if (i < nb) NSA_DMA(jlo + i);
              NSA_WAITV(0); }
            __builtin_amdgcn_s_barrier();
#define NSA_TILES(CLS_) _Pragma("unroll") for (int p = 0; p < 4; ++p) if (m8 & (3u << (2 * p))) { \
                        bf16x8 pf0, pf1; \
                        step64<MD, CLS_>(k0, k1, qf[p], cls, 64 * j + 8 * kq_, t0w + 2 * p + qs_, ((m8 >> (2 * p + qs_)) & 1u) != 0u, BC, m[p], l[p], O[p], pf0, pf1); \
                        pv(O[p], v0, pf0); pv(O[p], v1, pf1); \
                        __builtin_amdgcn_sched_barrier(0); }
            auto tiles = [&](auto clsx, int j) __attribute__((always_inline)) { constexpr int CLSX = decltype(clsx)::value;
                const LAS unsigned char* sk = STG + (j % 6) * 16384; const LAS unsigned char* sv = sk + 8192;
                unsigned m8 = 0xffu; if (WMw) m8 = (unsigned)__builtin_amdgcn_readfirstlane((int)((WMw[j >> 2] >> (8 * (j & 3))) & 0xffu)); if (FORCE == 1) m8 = 0u; if (FORCE == 2) m8 = 0xffu; if (MD == MD_MEM) m8 = 3u; else asm volatile("" : "+s"(m8));
                if (m8) {
                    int r_ = r, kq_ = kq, qs_ = qsel; asm volatile("" : "+v"(r_), "+v"(kq_), "+v"(qs_));
                    const int dj = qt - j; const int cls = (MD == MD_MEM) ? BK_FAR : (MD == MD_WIN) ? ((dj >= 1 && dj <= 7) ? BK_MID : BK_GEN) : ((64 * dj - 63 >= 1513) ? BK_FAR : ((dj >= 1 && dj <= 15) ? BK_MID : BK_GEN));
                    KF k0, k1;
                    { const int ka = 8 * (r_ >> 2) + (r_ & 3), kb2 = ka + 4, kc = ka + 32, kd = ka + 36;
                      k0.a0 = *(const LAS bf16x8*)(sk + ka * 128 + ((kq_ ^ SWZ(ka)) << 4)); k0.a1 = *(const LAS bf16x8*)(sk + ka * 128 + (((4 + kq_) ^ SWZ(ka)) << 4));
                      k0.b0 = *(const LAS bf16x8*)(sk + kb2 * 128 + ((kq_ ^ SWZ(kb2)) << 4)); k0.b1 = *(const LAS bf16x8*)(sk + kb2 * 128 + (((4 + kq_) ^ SWZ(kb2)) << 4));
                      k1.a0 = *(const LAS bf16x8*)(sk + kc * 128 + ((kq_ ^ SWZ(kc)) << 4)); k1.a1 = *(const LAS bf16x8*)(sk + kc * 128 + (((4 + kq_) ^ SWZ(kc)) << 4));
                      k1.b0 = *(const LAS bf16x8*)(sk + kd * 128 + ((kq_ ^ SWZ(kd)) << 4)); k1.b1 = *(const LAS bf16x8*)(sk + kd * 128 + (((4 + kq_) ^ SWZ(kd)) << 4)); }
                    VF v0, v1;
#pragma unroll
                    for (int dt = 0; dt < 4; ++dt) { const int dd = 16 * dt + r_; v0.v[dt] = *(const LAS bf16x8*)(sv + dd * 128 + ((kq_ ^ SWZ(dd)) << 4)); v1.v[dt] = *(const LAS bf16x8*)(sv + dd * 128 + (((4 + kq_) ^ SWZ(dd)) << 4)); }
                    NSA_TILES(CLSX)
                }
            };
            int ni = 0;
            auto blk = [&](auto clsx, int j) __attribute__((always_inline)) {
                const int ph = (j - jlo) % 3;
                if (ph == 0) { if (j + 3 <= jhi) NSA_DMA(j + 3); if (j + 4 <= jhi) NSA_DMA(j + 4); if (j + 5 <= jhi) NSA_DMA(j + 5); }
                tiles(clsx, j);
                if (ph == 2 || j == jhi) { NSA_WAITV(0); __builtin_amdgcn_s_barrier(); }
            };
            int j = jlo;
            if (MD == MD_BLK || MD == MD_MEM) { const int jfar = (MD == MD_MEM) ? jhi : ((qt - 25 < jhi) ? qt - 25 : jhi); const int jfe = jlo + ((jfar - jlo + 1 >= 0 ? (jfar - jlo + 1) / 3 : -1) * 3) - 1;
                for (; j <= jfe; ++j) blk(std::integral_constant<int, BK_FAR>{}, j); }
            if (MD == MD_BLK) {
                const int jf2 = (qt - 17 < jhi) ? qt - 17 : jhi; const int jfe2 = jlo + ((jf2 - jlo + 1 >= 0 ? (jf2 - jlo + 1) / 3 : -1) * 3) - 1;
                for (; j <= jfe2; ++j) blk(std::integral_constant<int, BK_FARF>{}, j); }
            for (; j <= jhi; ++j) blk(std::integral_constant<int, -1>{}, j);
#undef NSA_WAITV
#undef NSA_TILES
#undef NSA_DMA
}
__device__ __forceinline__ void p3_nsa_mfma(Frame& F, const In& I, unsigned char* ws) {
    OPAQUE_TID(); KARGS(); const int wave = __builtin_amdgcn_readfirstlane(tid_ >> 6);
    LAS float* b12 = (LAS float*)(F.lds + TAB_B12);
    LAS unsigned short* OUTw = (LAS unsigned short*)(F.lds + NSA_OUT) + wave * 3072;
    LAS float* PSw = (LAS float*)(F.lds + NSA_PSQ) + wave * 1024;
    LAS unsigned char* STG = F.lds + NSA_PSQ;
    LAS unsigned* WMw = (LAS unsigned*)(F.lds + NSA_ST) + wave * 32;
    for (int i = tid_; i < 512; i += NWAVES * 64) b12[i] = ((i & 15) < 12) ? Ip->rel_bias[(i >> 4) * 12 + (i & 15)] * LOG2E : 0.f;
    LAS unsigned short* TB = (LAS unsigned short*)(F.lds + NSA_TB);
    { const int gg = (int)blockIdx.x & 1;
      for (int i = tid_; i < 6144; i += NWAVES * 64) { const int dd = i / 6, hh = i % 6; TB[i] = (unsigned short)f2bf(Ip->rel_bias[rel_bucket(dd) * 12 + gg * 6 + hh] * LOG2E); } }
    __syncthreads();
    const bf16* Q0 = (const bf16*)(ws + WS_Q0); const bf16* KV0 = (const bf16*)(ws + WS_KV0); const bf16* QM = (const bf16*)(ws + WS_QM); const bf16* G0 = (const bf16*)(ws + WS_G0);
    const bf16* VT = (const bf16*)(ws + WS_VT); const bf16* KCB = (const bf16*)(ws + WS_KCB); const bf16* VCT = (const bf16*)(ws + WS_VCT);
    const bf16* MKB = (const bf16*)(ws + WS_MKB); const bf16* MVT = (const bf16*)(ws + WS_MVT);
    bf16* CAT = (bf16*)(ws + WS_CAT);
    const int nun = 4 * 128;
    for (int ui = blockIdx.x; ui < nun; ui += F.G) {
        int tl_ = tid_; asm volatile("" : "+v"(tl_));
        const int lane = tl_ & 63, n = lane & 15, kq = lane >> 4, r = n, hd = n & 7, qsel = n >> 3; const bool colv = hd < 6;
        int bg, qt;
        bg = blockIdx.x & 3;
        if (F.G == 256) { const int idx = blockIdx.x >> 2; qt = (ui < 256) ? idx : 127 - idx; }
        else { qt = ui >> 2; if ((ui & 3) != bg) continue; }
        const int b = bg >> 1, g = bg & 1, t0w = 64 * qt + 8 * wave, rowb = b * T;
        const int habs = g * 6 + (colv ? hd : 0);
        const LAS float* b12c = b12 + habs; const BiasCtx BC{TB + (colv ? hd : 0), b12c[29 * 16] - b12c[30 * 16], b12c[30 * 16] - b12c[31 * 16], b12c[31 * 16]};

        bf16x8 qf[4][2];
#pragma unroll
        for (int p = 0; p < 4; ++p) { const bf16* qp = Q0 + (size_t)(rowb + t0w + 2 * p + qsel) * 768 + habs * 64 + 8 * kq;
#pragma unroll
            for (int ks = 0; ks < 2; ++ks) { bf16x8 v = ldg16(qp + 32 * ks); if (!colv) v = (bf16x8){0, 0, 0, 0, 0, 0, 0, 0}; qf[p][ks] = v; } }
        float m[4], l[4]; f32x4 O[4][4];
        if (PROBE_REP == 6 || PROBE_REP == 7) {
            const bf16* ksb_ = KV0 + (size_t)rowb * 512 + 256 + g * 64; const bf16* vst_ = VT + ((size_t)(rowb >> 6) * 256 + g * 64) * 64;
#pragma unroll
            for (int p = 0; p < 4; ++p) { m[p] = -1e30f; l[p] = 0.f;
#pragma unroll
                for (int dt = 0; dt < 4; ++dt) O[p][dt] = (f32x4){0.f, 0.f, 0.f, 0.f}; }
            __syncthreads();
            nsa_sweep<MD_BLK, (PROBE_REP == 6 ? 2 : 1)>(STG, ksb_, vst_, 0, qt, qt, WMw, wave, lane, r, kq, qsel, t0w, qf, BC, m, l, O);
            float* dump = (float*)(ws + WS_OCS) + ((size_t)blockIdx.x * 512 + tid_) * 4;
#pragma unroll
            for (int p = 0; p < 4; ++p) dump[p] = l[p] + O[p][0][0] + O[p][1][1] + O[p][2][2] + O[p][3][3];
            __syncthreads(); }
        for (int i = lane; i < 1024; i += 64) PSw[i] = 0.f;
        const int ncmax = (t0w + 7 >= 31) ? ((t0w + 7 - 31) / 16 + 1) : 0;
        const bf16* kcb = KCB + (size_t)(bg * 512) * 64; const bf16* vct = VCT + (size_t)(bg * 64) * 512;
#pragma unroll
        for (int p = 0; p < 4; ++p) { m[p] = -1e30f; l[p] = 0.f; }
        if (ncmax > 0) {
            int r_ = r, kq_ = kq; asm volatile("" : "+v"(r_), "+v"(kq_));
            for (int key0 = 0; key0 < ncmax; key0 += 32) {
                asm volatile("" : "+v"(r_), "+v"(kq_));
                KF kA; load_k(kA, kcb, 64, key0, r_, kq_);
                const int dmin_ = t0w - 31 - 16 * (key0 + 31), ccls = dmin_ >= 1513 ? 0 : (dmin_ >= 825 ? 1 : ((dmin_ >= 0 && dmin_ + 503 <= 1023) ? 2 : 3));
#pragma unroll
                for (int p = 0; p < 4; ++p) { f32x4 sa, sb; qk(sa, sb, kA, qf[p]); const int tcol = t0w + 2 * p + qsel;
                    cmp_bias(sa, sb, key0 + 8 * kq_, tcol, ccls, BC);
                    const float mn = fmaxf(m[p], lmax8(sa, sb)); float sum = 0.f;
#pragma unroll
                    for (int i = 0; i < 4; ++i) sum += __builtin_amdgcn_exp2f(sa[i] - mn) + __builtin_amdgcn_exp2f(sb[i] - mn);
                    l[p] = l[p] * __builtin_amdgcn_exp2f(m[p] - mn) + sum; m[p] = mn; __builtin_amdgcn_sched_barrier(0); }
            }
        }
        float invl[4];
#pragma unroll
        for (int p = 0; p < 4; ++p) { float mc = m[p]; mc = fmaxf(mc, __shfl_xor(mc, 16)); mc = fmaxf(mc, __shfl_xor(mc, 32));
            const float lt = kqsum(l[p] * __builtin_amdgcn_exp2f(m[p] - mc)); m[p] = mc; invl[p] = lt > 0.f ? 1.f / lt : 0.f; }
#pragma unroll
        for (int p = 0; p < 4; ++p)
#pragma unroll
            for (int dt = 0; dt < 4; ++dt) O[p][dt] = (f32x4){0.f, 0.f, 0.f, 0.f};
        float carry[4] = {0.f, 0.f, 0.f, 0.f};
        if (ncmax > 0) {
            int r_ = r, kq_ = kq; asm volatile("" : "+v"(r_), "+v"(kq_));
            for (int key0 = 0; key0 < ncmax; key0 += 32) {
                asm volatile("" : "+v"(r_), "+v"(kq_));
                KV1 A; load_kv(A, kcb, 64, vct, 512, key0, r_, kq_);
                const int dmin_ = t0w - 31 - 16 * (key0 + 31), ccls = dmin_ >= 1513 ? 0 : (dmin_ >= 825 ? 1 : ((dmin_ >= 0 && dmin_ + 503 <= 1023) ? 2 : 3));
#pragma unroll
                for (int p = 0; p < 4; ++p) { f32x4 sa, sb; qk(sa, sb, A.k, qf[p]); const int tcol = t0w + 2 * p + qsel;
                    cmp_bias(sa, sb, key0 + 8 * kq_, tcol, ccls, BC);
                    f32x4 pa, pb;
#pragma unroll
                    for (int i = 0; i < 4; ++i) { pa[i] = __builtin_amdgcn_exp2f(sa[i] - m[p]) * invl[p]; pb[i] = __builtin_amdgcn_exp2f(sb[i] - m[p]) * invl[p]; }
                    pv(O[p], A.v, pack8(pa, pb));
                    float wA = (pa[0] + pa[1]) + (pa[2] + pa[3]), wB = pa[3] + ((pb[0] + pb[1]) + (pb[2] + pb[3])), wC = pb[3];
                    if (!colv) { wA = 0.f; wB = 0.f; wC = 0.f; }
                    const float up = __shfl(wC, (lane + 48) & 63);
                    const float prevC = (kq == 0) ? carry[p] : up; carry[p] = up;
                    float a0 = wA + prevC, a1 = wB;
                    a0 = sum8_dpp(a0); a1 = sum8_dpp(a1);
                    if (hd == 0) { LAS float* ps = PSw + (2 * p + qsel) * 128 + (key0 >> 2) + 2 * kq; ps[0] = a0; ps[1] = a1; } __builtin_amdgcn_sched_barrier(0); }
            }
        }
        if (ncmax > 0 && ncmax <= 480) {
            const int jn = ((ncmax + 31) >> 5) * 8;
#pragma unroll
            for (int p = 0; p < 4; ++p) { float a0 = sum8_dpp(carry[p]); if (hd == 0 && kq == 0) PSw[(2 * p + qsel) * 128 + jn] = a0; }
        }
        {
#pragma unroll
            for (int p = 0; p < 4; ++p) { const size_t row = (size_t)(rowb + t0w + 2 * p + qsel);
                const float gz = bf2f(G0[row * 256 + habs * 3 + 0]) + Ip->nsa_gate_b[habs * 3 + 0]; out_add(OUTw, p, n, kq, O[p], 1.f / (1.f + __expf(-gz)), true); }
        }
        for (int i = lane; i < 32; i += 64) WMw[i] = (qt < 16) ? 0xffffffffu : 0u;
        if (qt >= 16) {
            if (lane < 3) { const int j = lane == 0 ? 0 : qt - 2 + lane; atomicOr((unsigned*)&WMw[j >> 2], 0xffu << (8 * (j & 3))); }
            for (int q = 0; q < 8; ++q) {
                int v0 = __float_as_int(PSw[q * 128 + lane] + 0.f), v1 = __float_as_int(PSw[q * 128 + 64 + lane] + 0.f);
                if (lane < 1 || lane > qt - 2) v0 = __float_as_int(-1.f); if (lane + 64 > qt - 2) v1 = __float_as_int(-1.f);
                for (int s = 0; s < 13; ++s) { const int mx = wmax64_i(max(v0, v1));
                    const unsigned long long b0 = __ballot(v0 == mx); int j;
                    if (b0) { j = __builtin_ctzll(b0); if (lane == j) v0 = __float_as_int(-1.f); } else { const unsigned long long b1 = __ballot(v1 == mx); j = __builtin_ctzll(b1); if (lane == j) v1 = __float_as_int(-1.f); j += 64; }
                    if (lane == 0) atomicOr((unsigned*)&WMw[j >> 2], 1u << (8 * (j & 3) + q)); }
            }
        }
        const bf16* ksb = KV0 + (size_t)rowb * 512 + 256 + g * 64; const bf16* vst = VT + ((size_t)(rowb >> 6) * 256 + g * 64) * 64;
        __syncthreads();
#pragma unroll 1
        for (int rep_ = 0; rep_ < (PROBE_REP == 1 ? 2 : 1); ++rep_) {
#pragma unroll
            for (int p = 0; p < 4; ++p) { m[p] = -1e30f; l[p] = 0.f;
#pragma unroll
                for (int dt = 0; dt < 4; ++dt) O[p][dt] = (f32x4){0.f, 0.f, 0.f, 0.f}; }
            nsa_sweep<MD_BLK>(STG, ksb, vst, 0, qt, qt, WMw, wave, lane, r, kq, qsel, t0w, qf, BC, m, l, O);
        }
        { int qs2_ = qsel; asm volatile("" : "+v"(qs2_));
#pragma unroll
        for (int p = 0; p < 4; ++p) { const size_t row = (size_t)(rowb + t0w + 2 * p + qs2_);
            const float gz = bf2f(G0[row * 256 + habs * 3 + 1]) + Ip->nsa_gate_b[habs * 3 + 1]; out_add(OUTw, p, n, kq, O[p], (1.f / (1.f + __expf(-gz))) / kqsum(l[p]), false); } }
        const bf16* kwb = KV0 + (size_t)rowb * 512 + 384 + g * 64; const bf16* vwt = VT + ((size_t)(rowb >> 6) * 256 + 128 + g * 64) * 64;
#pragma unroll
        for (int p = 0; p < 4; ++p) { m[p] = -1e30f; l[p] = 0.f;
#pragma unroll
            for (int dt = 0; dt < 4; ++dt) O[p][dt] = (f32x4){0.f, 0.f, 0.f, 0.f}; }
        __syncthreads();
        nsa_sweep<MD_WIN>(STG, kwb, vwt, (qt >= 8) ? qt - 8 : 0, qt, qt, nullptr, wave, lane, r, kq, qsel, t0w, qf, BC, m, l, O);
        if (PROBE_REP == 4) {
#pragma unroll
            for (int p = 0; p < 4; ++p) { m[p] = -1e30f; l[p] = 0.f;
#pragma unroll
                for (int dt = 0; dt < 4; ++dt) O[p][dt] = (f32x4){0.f, 0.f, 0.f, 0.f}; }
            nsa_sweep<MD_WIN>(STG, kwb, vwt, (qt >= 8) ? qt - 8 : 0, qt, qt, nullptr, wave, lane, r, kq, qsel, t0w, qf, BC, m, l, O); }
        { int qs3_ = qsel; asm volatile("" : "+v"(qs3_));
#pragma unroll
        for (int p = 0; p < 4; ++p) { const size_t row = (size_t)(rowb + t0w + 2 * p + qs3_);
            const float gz = bf2f(G0[row * 256 + habs * 3 + 2]) + Ip->nsa_gate_b[habs * 3 + 2]; out_add(OUTw, p, n, kq, O[p], (1.f / (1.f + __expf(-gz))) / kqsum(l[p]), false); } }
        int ln_ = lane; asm volatile("" : "+v"(ln_));
#pragma unroll 1
        for (int i = 0; i < 6; ++i) { const int e = i * 64 + ln_, q = e / 48, c8 = e % 48;
            *(v4u*)(CAT + (size_t)(rowb + t0w + q) * 1024 + g * 384 + 8 * c8) = ((const LAS v4u*)OUTw)[e]; }
#pragma unroll 1
        for (int h2 = 0; h2 < 2; ++h2) { const int hm = 2 * g + h2;
            int ln2_ = lane; asm volatile("" : "+v"(ln2_)); const int nn = ln2_ & 15, kqq = ln2_ >> 4;
#pragma unroll
            for (int p = 0; p < 4; ++p) { qf[p][0] = (bf16x8){0, 0, 0, 0, 0, 0, 0, 0}; qf[p][1] = qf[p][0]; m[p] = -1e30f; l[p] = 0.f;
#pragma unroll
                for (int dt = 0; dt < 4; ++dt) O[p][dt] = (f32x4){0.f, 0.f, 0.f, 0.f}; }
            { const bf16* qp = QM + (size_t)(rowb + t0w + (nn & 7)) * 256 + hm * 64 + 8 * kqq; if (nn < 8) { qf[0][0] = ldg16(qp); qf[0][1] = ldg16(qp + 32); } }
            const BiasCtx BCm{BC.tb, 0.f, 0.f, 0.f};
            nsa_sweep<MD_MEM>(STG, MKB + (size_t)(b * 256) * 256 + hm * 64, MVT + (size_t)(hm * 64) * 512 + b * 256, 0, 3, 0, nullptr, wave, ln2_, nn, kqq, nn >> 3, 0, qf, BCm, m, l, O, 256, 64 * 256, 512, 64);
            const float il = 1.f / kqsum(l[0]);
            if (nn < 8) { bf16* op = CAT + (size_t)(rowb + t0w + nn) * 1024 + 768 + hm * 64 + 4 * kqq;
#pragma unroll
                for (int dt = 0; dt < 4; ++dt) *(uint2*)(op + 16 * dt) = make_uint2(pk2(O[0][dt][0] * il, O[0][dt][1] * il), pk2(O[0][dt][2] * il, O[0][dt][3] * il)); }
        }
    }
}

__device__ __forceinline__ void p10_dsa_norm(Frame& F, const In& I, unsigned char* ws) {
    OPAQUE_TID(); KARGS(); const int gw = F.vcu * NWAVES + (tid_ >> 6), NGW = F.G * NWAVES, lane = tid_ & 63;
    const bf16* PR = (const bf16*)(ws + WS_PROJ1); bf16* CQ = (bf16*)(ws + WS_CQ); bf16* CKV = (bf16*)(ws + WS_CKV); bf16* KIDX = (bf16*)(ws + WS_KIDX); float* WIDX = (float*)(ws + WS_WIDX);
    for (int m = gw; m < M; m += NGW) {
        const bf16* pr = PR + (size_t)m * 768;
        float a[4]; ld4bf(pr + 4 * lane, a);
        float s = wave_sum(a[0] * a[0] + a[1] * a[1] + a[2] * a[2] + a[3] * a[3]); float r = rsqrtf(s * (1.f / 256.f) + EPSF);
        const float4 gq = *(const float4*)(Ip->q_norm + 4 * lane);
        *(uint2*)(CQ + (size_t)m * 256 + 4 * lane) = make_uint2(pk2((a[0] * r) * gq.x, (a[1] * r) * gq.y), pk2((a[2] * r) * gq.z, (a[3] * r) * gq.w));
        const unsigned u = *(const unsigned*)(pr + 256 + 2 * lane); const float c0 = bflo(u), c1 = bfhi(u);
        s = wave_sum(c0 * c0 + c1 * c1); r = rsqrtf(s * (1.f / 128.f) + EPSF);
        *(unsigned*)(CKV + (size_t)m * 128 + 2 * lane) = pk2((c0 * r) * Ip->kv_norm[2 * lane], (c1 * r) * Ip->kv_norm[2 * lane + 1]);
        const float k0 = bf2f(pr[384 + lane]);
        s = wave_sum(k0 * k0); r = rsqrtf(s * (1.f / 64.f) + EPSF);
        { const int tk = m >> 5, key = m & 31, ks = lane >> 4, hf = (lane >> 3) & 1, jj = lane & 7;
          KIDX[((size_t)(tk * 4 + ks) * 64 + hf * 32 + key) * 8 + jj] = (bf16)f2bf((k0 * r) * Ip->kidx_norm[lane]); }
        if (lane < 8) WIDX[(size_t)m * 8 + lane] = bf2f(pr[448 + lane]) * (0.35355339059327373f * 0.125f);
    }
}

#define MFMA32(A, B, C) __builtin_amdgcn_mfma_f32_32x32x16_bf16((A), (B), (C), 0, 0, 0)
typedef float f32x16 __attribute__((ext_vector_type(16)));
constexpr int XL_OFF = RING_BYTES;
constexpr int IDX_HIST = XL_OFF, IDX_SELL = XL_OFF + 16384;
static_assert(IDX_SELL + 4096 <= LDSCTL_OFF, "LDS map (indexer)");
__device__ __forceinline__ float wmin64(float v) {
#pragma unroll
    for (int o = 1; o < 64; o <<= 1) v = fminf(v, __shfl_xor(v, o));
    return v;
}
__device__ __forceinline__ unsigned f16_order_key(float x) {
    const unsigned hb = (unsigned)__builtin_bit_cast(unsigned short, (_Float16)x);
    const unsigned mk = (unsigned)((int)(hb << 16) >> 31) | 0x8000u;
    return (hb ^ mk) & 0xffffu; }
__device__ __forceinline__ void p12_index_mfma(Frame& F, const In& I, unsigned char* ws) {
    OPAQUE_TID(); KARGS(); const int lane = tid_ & 63, wave = __builtin_amdgcn_readfirstlane(tid_ >> 6), key = lane & 31, half = lane >> 5;
    LAS unsigned short* SC = (LAS unsigned short*)(F.lds + RING_OFF);
    const bf16* QI = (const bf16*)(ws + WS_QI); const bf16* KIDX = (const bf16*)(ws + WS_KIDX); const float* WIDX = (const float*)(ws + WS_WIDX);
    unsigned short* SEL = (unsigned short*)(ws + WS_SEL); int* CNT = (int*)(ws + WS_CNT);
    const int NG = M / 8, per = (NG + F.G - 1) / F.G;
    { LAS unsigned* hz = (LAS unsigned*)(F.lds + IDX_HIST); for (int i = tid_; i < 8 * 512; i += NWAVES * 64) hz[i] = 0u; }
    __syncthreads();
    for (int j = 0; j < per; ++j) {
        const int u = j * F.G + ((j & 1) ? (F.G - 1 - (int)blockIdx.x) : (int)blockIdx.x);
        if (u >= NG) break;
        const int gi = (u & 1) * (NG / 2) + (u >> 1);
        const int row0 = 8 * gi, b = row0 / T, t0 = row0 % T, rowb = b * T;
        if (t0 < 256) {
            const int t = t0 + wave; unsigned short* so = SEL + (size_t)(row0 + wave) * 256;
#pragma unroll
            for (int i = 0; i < 4; ++i) { const int s = lane + 64 * i; so[s] = (unsigned short)(s <= t ? s : 0); }
            if (lane == 0) CNT[row0 + wave] = t + 1;
            continue;
        }
        const int nt = (t0 + 7) / 32 + 1;
        {
            const int rho = lane & 31, a = rho >> 2, qA = ((a >> 2) & 1) + 2 * (a & 1), hdA = 4 * ((a >> 1) & 1) + (rho & 3);
            bf16x8 qa[2][4];
#pragma unroll
            for (int t2 = 0; t2 < 2; ++t2)
#pragma unroll
                for (int ks = 0; ks < 4; ++ks) qa[t2][ks] = ldg16(QI + (size_t)(row0 + 4 * t2 + qA) * 512 + hdA * 64 + 16 * ks + 8 * half);
            f32x2_t wp[2][2][4];
#pragma unroll
            for (int t2 = 0; t2 < 2; ++t2)
#pragma unroll
                for (int jq = 0; jq < 2; ++jq) { const float* wq = WIDX + (size_t)(row0 + 4 * t2 + 2 * half + jq) * 8; const float4 x0 = *(const float4*)wq, x1 = *(const float4*)(wq + 4);
                    wp[t2][jq][0] = (f32x2_t){x0.x, x0.y}; wp[t2][jq][1] = (f32x2_t){x0.z, x0.w}; wp[t2][jq][2] = (f32x2_t){x1.x, x1.y}; wp[t2][jq][3] = (f32x2_t){x1.z, x1.w}; }
            const int tqb = t0 + 2 * half;
            const bf16* kpb = KIDX + (size_t)(rowb >> 5) * 2048 + (size_t)lane * 8;
            const int ntw = (nt - wave + NWAVES - 1) / NWAVES;
#define VFMAC_(acc_, x_, y_) asm("v_fmac_f32 %0, %1, %2" : "+v"(acc_) : "v"(x_), "v"(y_))
#define IDX_LOAD(dst, i) do { const int tl2_ = wave + NWAVES * ((i) < ntw ? (i) : (ntw > 0 ? ntw - 1 : 0)); const bf16* kp_ = kpb + (size_t)tl2_ * 2048; \
                _Pragma("unroll") for (int ks = 0; ks < 4; ++ks) dst[ks] = ldg16(kp_ + 512 * ks); } while (0)
#define IDX_EPI(c, t2) do { float a00 = 0.f, a01 = 0.f, a10 = 0.f, a11 = 0.f;     \
                _Pragma("unroll") for (int h = 0; h < 4; ++h) {                                \
                    VFMAC_(a00, __int_as_float(max(__float_as_int(c[2 * h]), 0)), wp[t2][0][h][0]); VFMAC_(a01, __int_as_float(max(__float_as_int(c[2 * h + 1]), 0)), wp[t2][0][h][1]); \
                    VFMAC_(a10, __int_as_float(max(__float_as_int(c[8 + 2 * h]), 0)), wp[t2][1][h][0]); VFMAC_(a11, __int_as_float(max(__float_as_int(c[9 + 2 * h]), 0)), wp[t2][1][h][1]); } \
                const float s0 = (a00 + a01) + 0.f, s1 = (a10 + a11) + 0.f; \
                const bool ok0 = kpos <= tqb + 4 * (t2), ok1 = kpos <= tqb + 4 * (t2) + 1; \
                const unsigned ky0 = f16_order_key(ok0 ? s0 : -INFINITY), ky1 = f16_order_key(ok1 ? s1 : -INFINITY); \
                SC[(4 * (t2) + 2 * half) * 8192 + kpos] = (unsigned short)ky0; SC[(4 * (t2) + 2 * half + 1) * 8192 + kpos] = (unsigned short)ky1; \
                { LAS unsigned* h0_ = (LAS unsigned*)(F.lds + IDX_HIST) + (4 * (t2) + 2 * half) * 512;        \
                  atomicAdd((unsigned*)&h0_[ky0 >> 7], 1u << (16 * ((ky0 >> 6) & 1u))); atomicAdd((unsigned*)&h0_[512 + (ky1 >> 7)], 1u << (16 * ((ky1 >> 6) & 1u))); } } while (0)
#define IDX_COMP(src, i) do { if ((i) < ntw) { const int kpos = 32 * (wave + NWAVES * (i)) + key; \
                f32x16 cA = {0.f, 0.f, 0.f, 0.f, 0.f, 0.f, 0.f, 0.f, 0.f, 0.f, 0.f, 0.f, 0.f, 0.f, 0.f, 0.f}, cB = cA; \
                _Pragma("unroll") for (int ks = 0; ks < 4; ++ks) { cA = MFMA32(qa[0][ks], src[ks], cA); cB = MFMA32(qa[1][ks], src[ks], cB); } \
                IDX_EPI(cA, 0); IDX_EPI(cB, 1); } } while (0)
            if (ntw > 0) {
                bf16x8 kb0[4], kb1[4], kb2[4], kb3[4];
                IDX_LOAD(kb0, 0); IDX_LOAD(kb1, 1); IDX_LOAD(kb2, 2);
                for (int i = 0; i < ntw; i += 4) {
                    IDX_LOAD(kb3, i + 3); IDX_COMP(kb0, i);
                    IDX_LOAD(kb0, i + 4); IDX_COMP(kb1, i + 1);
                    IDX_LOAD(kb1, i + 5); IDX_COMP(kb2, i + 2);
                    IDX_LOAD(kb2, i + 6); IDX_COMP(kb3, i + 3);
                }
            }
#undef IDX_LOAD
#undef IDX_EPI
#undef IDX_COMP
#undef VFMAC_
        }
        __syncthreads();
        {
            const int q = wave, t = t0 + q, nch = (t + 512) >> 9; LAS unsigned short* sc = SC + q * 8192;
            LAS unsigned* hist = (LAS unsigned*)(F.lds + IDX_HIST) + wave * 512;
            LAS unsigned short* sl = (LAS unsigned short*)(F.lds + IDX_SELL) + q * 256;
            for (int i = 32 * nt + lane; i < 512 * nch; i += 64) sc[i] = (unsigned short)0;
            int b1, r1;
            { unsigned cw[8]; unsigned S = 0u;
#pragma unroll
              for (int i = 0; i < 8; ++i) { cw[i] = hist[8 * lane + i]; S += (cw[i] & 0xffffu) + (cw[i] >> 16); }
              const unsigned px = wave_iscan_u32(S);
              const unsigned above = (unsigned)__builtin_amdgcn_readlane((int)px, 63) - px;
              const bool found = (above < 256u) && (256u <= above + S);
              const int fl = __builtin_ctzll(__ballot(found));
              int bs = 0; unsigned acc = above;
              { bool done = false;
#pragma unroll
                for (int i = 15; i >= 0; --i) { const unsigned cnt_ = (i & 1) ? (cw[i >> 1] >> 16) : (cw[i >> 1] & 0xffffu);
                    if (!done) { if (acc + cnt_ >= 256u) { bs = 16 * lane + i; done = true; } else acc += cnt_; } } }
              b1 = __builtin_amdgcn_readlane(bs, fl); r1 = 256 - __builtin_amdgcn_readlane((int)acc, fl); }
            hist[lane] = 0u;
            for (int c = 0; c < nch; ++c) { const v4u k4 = *(const LAS v4u*)(sc + 512 * c + 8 * lane);
#pragma unroll
                for (int e = 0; e < 8; ++e) { const unsigned kk = (e & 1) ? (k4[e >> 1] >> 16) : (k4[e >> 1] & 0xffffu);
                    if ((int)(kk >> 6) == b1) atomicAdd((unsigned*)&hist[kk & 63u], 1u); } }
            unsigned tkey; int r2;
            { const unsigned S = hist[lane]; const unsigned px = wave_iscan_u32(S); const unsigned above = (unsigned)__builtin_amdgcn_readlane((int)px, 63) - px;
              const bool found = (above < (unsigned)r1) && ((unsigned)r1 <= above + S);
              const int fl = __builtin_ctzll(__ballot(found));
              tkey = ((unsigned)b1 << 6) | (unsigned)fl; r2 = r1 - __builtin_amdgcn_readlane((int)above, fl); }
            const int nabove = 256 - r2; int bsel = 0, beq = 0;
            for (int c = 0; c < nch; ++c) { const int i8 = 512 * c + 8 * lane; const v4u k4 = *(const LAS v4u*)(sc + i8);
                unsigned em = 0u;
#pragma unroll
                for (int e = 0; e < 8; ++e) { const unsigned kk = (e & 1) ? (k4[e >> 1] >> 16) : (k4[e >> 1] & 0xffffu);
                    const bool sel = kk > tkey; em |= (kk == tkey) ? (1u << e) : 0u;
                    const unsigned long long ms = __ballot(sel);
                    if (ms) { if (sel) sl[bsel + (int)__builtin_amdgcn_mbcnt_hi((unsigned)(ms >> 32), __builtin_amdgcn_mbcnt_lo((unsigned)ms, 0u))] = (unsigned short)(i8 + e); bsel += __builtin_popcountll(ms); } }
                if (__any(em != 0u)) {
                    const unsigned ce = (unsigned)__builtin_popcount(em); const unsigned pe = wave_iscan_u32(ce);
                    int pos = beq + (int)(pe - ce);
#pragma unroll
                    for (int e = 0; e < 8; ++e) if (em & (1u << e)) { if (pos < r2) sl[nabove + pos] = (unsigned short)(i8 + e); ++pos; }
                    beq += __builtin_amdgcn_readlane((int)pe, 63); } }
            *(v2u*)(SEL + (size_t)(row0 + q) * 256 + 4 * lane) = *(const LAS v2u*)(sl + 4 * lane);
#pragma unroll
            for (int i = 0; i < 8; ++i) hist[lane + 64 * i] = 0u;
            if (lane == 0) CNT[row0 + q] = 256;
        }
        __syncthreads();
    }
}

__device__ __forceinline__ unsigned offb(unsigned row, unsigned ch) { return 256u * row + 16u * (ch ^ (((row & 3u) << 2) | ((row >> 2) & 3u))); }
typedef short v4i16_t __attribute__((ext_vector_type(4)));
__device__ __forceinline__ v4i16_t trrd(const LAS unsigned char* p) { return __builtin_amdgcn_ds_read_tr16_b64_v4i16((LAS v4i16_t*)p); }
__device__ __forceinline__ void p13_dsa_mfma(Frame& F, const In& I, unsigned char* ws) {
    OPAQUE_TID(); KARGS(); const int lane = tid_ & 63, wave = __builtin_amdgcn_readfirstlane(tid_ >> 6), n = lane & 15, kq = lane >> 4;
    LAS unsigned char* bkt = F.lds + TAB_BKT; LAS float* b12 = (LAS float*)(F.lds + P13_B12);
    for (int i = tid_; i < 1536; i += NWAVES * 64) bkt[i] = (unsigned char)rel_bucket(i);
    for (int i = tid_; i < 528; i += NWAVES * 64) b12[i] = (i >= 512) ? -INFINITY : (((i & 15) < 12) ? Ip->rel_bias[(i >> 4) * 12 + (i & 15)] * LOG2E : 0.f);
    __syncthreads();
    LAS unsigned char* imgb = F.lds + RING_OFF + wave * 18432; LAS int* sidx = (LAS int*)(imgb + 16384);
    const bf16* QA = (const bf16*)(ws + WS_QA); const bf16* CKV = (const bf16*)(ws + WS_CKV); const bf16* PR = (const bf16*)(ws + WS_PROJ1);
    const unsigned short* SEL = (const unsigned short*)(ws + WS_SEL); const int* CNT = (const int*)(ws + WS_CNT);
    const bf16* MKB = (const bf16*)(ws + WS_MKB) + (size_t)512 * 256; const bf16* MVT = (const bf16*)(ws + WS_MVT) + (size_t)256 * 512;
    bf16* CAT1 = (bf16*)(ws + WS_CAT1);
    const int gw = blockIdx.x * NWAVES + wave, NGW = F.G * NWAVES;
    const LAS float* b12c = b12 + (n < 12 ? n : 0);
#define DSA_GATHER(sl_, rowb_, c0_, buf_) do { const unsigned char* ckvb_ = (const unsigned char*)(CKV + (size_t)(rowb_) * 128); int kx_[8]; \
            _Pragma("unroll") for (int i = 0; i < 8; ++i) kx_[i] = (sl_)[(c0_) + 4 * i + g4_] & 0xffff; \
            _Pragma("unroll") for (int i = 0; i < 8; ++i) __builtin_amdgcn_global_load_lds((const unsigned*)(ckvb_ + ((unsigned)kx_[i] * 256u + goff_[i & 3])), (LAS unsigned*)(imgb + (buf_) * 8192 + i * 1024), 16, 0, 0); } while (0)
#define DSA_LIST(sl_, sel_, t_, cnt_) do { const int idx0_ = __builtin_amdgcn_readfirstlane((sel_)[0]); \
            _Pragma("unroll") for (int i = 0; i < 4; ++i) { const int e = lane + 64 * i, idx = (sel_)[i]; const int d = (t_) - idx, dc = d > 1535 ? 1535 : (d < 0 ? 0 : d); \
                (sl_)[e] = (e < (cnt_)) ? (idx | ((int)bkt[dc] << 22)) : (idx0_ | (2048 << 16)); } } while (0)
    int dreps_ = (PROBE_REP == 9) ? 2 : 1; asm volatile("" : "+s"(dreps_));
    for (int dr_ = 0; dr_ < dreps_; ++dr_) {
    asm volatile("s_waitcnt vmcnt(0) lgkmcnt(0)" ::: "memory");
    int row = gw;
    if (row < M) {
        int ln0_ = lane; asm volatile("" : "+v"(ln0_));
        const int g4_ = ln0_ >> 4; unsigned goff_[4];
#pragma unroll
        for (int k = 0; k < 4; ++k) goff_[k] = 16u * ((unsigned)(ln0_ & 15) ^ (((unsigned)g4_ << 2) | (unsigned)k));
        int cnt = __builtin_amdgcn_readfirstlane(CNT[row]); int sel0[4];
#pragma unroll
        for (int i = 0; i < 4; ++i) sel0[i] = (int)SEL[(size_t)row * 256 + lane + 64 * i];
        DSA_LIST(sidx, sel0, row % T, cnt);
        bf16x8 qf[4];
#pragma unroll
        for (int ks = 0; ks < 4; ++ks) { bf16x8 v = ldg16(QA + (size_t)row * 1536 + (n < 12 ? n : 0) * 128 + 32 * ks + 8 * kq); if (n >= 12) v = (bf16x8){0, 0, 0, 0, 0, 0, 0, 0}; qf[ks] = v; }
        asm volatile("s_waitcnt lgkmcnt(0)" ::: "memory");
        DSA_GATHER(sidx, (row / T) * T, 0, 0);
        int lb = 0, ib = 0;
        for (; row < M; row += NGW) {
            const int t = row % T, rown = (row + NGW < M) ? row + NGW : row; const bool hasn = row + NGW < M;
            int ln_ = lane; asm volatile("" : "+v"(ln_));
            int seln[4] = {0, 0, 0, 0}; int cntn_v = 0; bf16x8 qfn[4];
#pragma unroll
            for (int ks = 0; ks < 4; ++ks) qfn[ks] = (bf16x8){0, 0, 0, 0, 0, 0, 0, 0};
#define DSA_NEXT_LOADS() do { cntn_v = CNT[rown]; \
                _Pragma("unroll") for (int i = 0; i < 4; ++i) seln[i] = (int)SEL[(size_t)rown * 256 + lane + 64 * i]; \
                _Pragma("unroll") for (int ks = 0; ks < 4; ++ks) { bf16x8 v = ldg16(QA + (size_t)rown * 1536 + (n < 12 ? n : 0) * 128 + 32 * ks + 8 * kq); if (n >= 12) v = (bf16x8){0, 0, 0, 0, 0, 0, 0, 0}; qfn[ks] = v; } } while (0)
            const LAS int* sl = sidx + lb * 256; LAS int* sln = sidx + (lb ^ 1) * 256;
            float m = -1e30f, l = 0.f; f32x4 O[8];
#pragma unroll
            for (int rt = 0; rt < 8; ++rt) O[rt] = (f32x4){0.f, 0.f, 0.f, 0.f};
            for (int c0 = 0; c0 < cnt; c0 += 32) {
                LAS unsigned char* img = imgb + ib * 8192;
                if (c0 + 32 < cnt) { DSA_GATHER(sl, (row / T) * T, c0 + 32, ib ^ 1);
                    { const int e2 = (c0 + 64 < 256 ? c0 + 64 : 224) + (ln_ >> 1); const int k2 = sl[e2] & 0xffff;
                      __builtin_amdgcn_global_load_lds((const unsigned*)((const unsigned char*)(CKV + (size_t)((row / T) * T) * 128) + ((unsigned)k2 * 256u + 128u * (unsigned)(ln_ & 1))), (LAS unsigned*)(F.lds + P13_JUNK + wave * 256), 4, 0, 0); }
                    if (c0 == 0) { DSA_NEXT_LOADS(); }
                    if (c0 < 64) asm volatile("s_waitcnt vmcnt(18)" ::: "memory"); else asm volatile("s_waitcnt vmcnt(9)" ::: "memory"); }
                else if (hasn) {
                    if (c0 == 0) { DSA_NEXT_LOADS(); }
                    const int cntn = __builtin_amdgcn_readfirstlane(cntn_v);
                    DSA_LIST(sln, seln, rown % T, cntn);
                    asm volatile("s_waitcnt lgkmcnt(0)" ::: "memory");
                    DSA_GATHER(sln, (rown / T) * T, 0, ib ^ 1); asm volatile("s_waitcnt vmcnt(8)" ::: "memory"); }
                else asm volatile("s_waitcnt vmcnt(0)" ::: "memory");
                const bool has = m > -1e29f; const float mref = has ? m : 0.f; const float cinv = -mref;
                f32x4 sa = {cinv, cinv, cinv, cinv}, sb = sa;
                { const unsigned ra = 8u * ((unsigned)(ln_ & 15) >> 2) + ((unsigned)ln_ & 3u), kq_ = (unsigned)ln_ >> 4;
#pragma unroll
                  for (int s = 0; s < 4; ++s) { const bf16x8 ka = *(const LAS bf16x8*)(img + offb(ra, 4 * s + kq_)); const bf16x8 kb = *(const LAS bf16x8*)(img + offb(ra + 4, 4 * s + kq_));
                      sa = MFMA16(ka, qf[s], sa); sb = MFMA16(kb, qf[s], sb); } }
#pragma unroll
                for (int i = 0; i < 4; ++i) { const int ea = c0 + 8 * kq + i;
                    sa[i] += *(const LAS float*)((const LAS unsigned char*)b12c + ((unsigned)sl[ea] >> 16)); sb[i] += *(const LAS float*)((const LAS unsigned char*)b12c + ((unsigned)sl[ea + 4] >> 16)); }
                float fsc = 1.f;
                if (__any((imax3(imax3(__float_as_int(sa[0]), __float_as_int(sa[1]), __float_as_int(sa[2])), imax3(__float_as_int(sa[3]), __float_as_int(sb[0]), __float_as_int(sb[1])), max(__float_as_int(sb[2]), __float_as_int(sb[3]))) > __float_as_int(SM_THR)) || !has)) {
                    float lm = lmax8(sa, sb);
                    lm = fmaxf(lm, __shfl_xor(lm, 16)); lm = fmaxf(lm, __shfl_xor(lm, 32));
                    const bool upd = (lm > -INFINITY) && (!has || lm > 0.f); const float dl = upd ? lm : 0.f;
                    if (upd) m = mref + dl;
                    fsc = has ? __builtin_amdgcn_exp2f(-dl) : 1.f; l *= fsc;
#pragma unroll
                    for (int i = 0; i < 4; ++i) { sa[i] -= dl; sb[i] -= dl; }
#pragma unroll
                    for (int rt = 0; rt < 8; ++rt) O[rt] = O[rt] * fsc;
                }
                f32x4 pa, pb; float sum = 0.f;
#pragma unroll
                for (int i = 0; i < 4; ++i) { pa[i] = __builtin_amdgcn_exp2f(sa[i]); pb[i] = __builtin_amdgcn_exp2f(sb[i]); sum += pa[i] + pb[i]; }
                l += sum;
                const bf16x8 pf = pack8(pa, pb);
                { const unsigned g_ = (unsigned)ln_ >> 4, q_ = ((unsigned)ln_ & 15u) >> 2, p_ = (unsigned)ln_ & 3u;
#pragma unroll
                  for (int rt = 0; rt < 8; ++rt) { const v4i16_t x0 = trrd(img + offb(8 * g_ + q_, 2 * rt + (p_ >> 1)) + 8 * (p_ & 1)), x1 = trrd(img + offb(8 * g_ + 4 + q_, 2 * rt + (p_ >> 1)) + 8 * (p_ & 1));
                      const bf16x8 vf = {x0[0], x0[1], x0[2], x0[3], x1[0], x1[1], x1[2], x1[3]};
                      O[rt] = MFMA16(vf, pf, O[rt]); } }
                ib ^= 1;
            }
            const float il = 1.f / kqsum(l);
            if (n < 12) { bf16* op = CAT1 + (size_t)row * 1792 + n * 128 + 4 * kq;
#pragma unroll
                for (int rt = 0; rt < 8; ++rt) *(uint2*)(op + 16 * rt) = make_uint2(pk2(O[rt][0] * il, O[rt][1] * il), pk2(O[rt][2] * il, O[rt][3] * il)); }
            lb ^= 1; cnt = __builtin_amdgcn_readfirstlane(cntn_v);
#pragma unroll
            for (int ks = 0; ks < 4; ++ks) qf[ks] = qfn[ks];
        }
    }
    }
#undef DSA_GATHER
#undef DSA_LIST
#undef DSA_NEXT_LOADS
    int mreps_ = (PROBE_REP == 8) ? 2 : 1; asm volatile("" : "+s"(mreps_));
    __syncthreads();
    for (int mr_ = 0; mr_ < mreps_; ++mr_)
    for (int u64 = blockIdx.x; u64 < M / 64; u64 += F.G) {
        int tl_ = tid_; asm volatile("" : "+v"(tl_));
        const int ln = tl_ & 63, nn = ln & 15, kqq = ln >> 4, qsl = nn >> 3;
        const int row0 = 64 * u64 + 8 * wave, b = row0 / T;
        const BiasCtx BC0{(const LAS unsigned short*)(F.lds + NSA_TB), 0.f, 0.f, 0.f};
#pragma unroll 1
        for (int hm = 0; hm < 4; ++hm) {
            bf16x8 qf[4][2];
#pragma unroll
            for (int p = 0; p < 4; ++p) { qf[p][0] = (bf16x8){0, 0, 0, 0, 0, 0, 0, 0}; qf[p][1] = qf[p][0]; }
            { const bf16* qp = PR + (size_t)(row0 + (nn & 7)) * 768 + 456 + hm * 64 + 8 * kqq; if (nn < 8) { qf[0][0] = ldg16(qp); qf[0][1] = ldg16(qp + 32); } }
            float m[4], l[4]; f32x4 O[4][4];
#pragma unroll
            for (int p = 0; p < 4; ++p) { m[p] = -1e30f; l[p] = 0.f;
#pragma unroll
                for (int dt = 0; dt < 4; ++dt) O[p][dt] = (f32x4){0.f, 0.f, 0.f, 0.f}; }
            nsa_sweep<MD_MEM>(F.lds + RING_OFF, MKB + (size_t)(b * 256) * 256 + hm * 64, MVT + (size_t)(hm * 64) * 512 + b * 256, 0, 3, 0, nullptr, wave, ln, nn, kqq, qsl, 0, qf, BC0, m, l, O, 256, 64 * 256, 512, 64);
            const float il = 1.f / kqsum(l[0]);
            if (nn < 8) { bf16* op = CAT1 + (size_t)(row0 + nn) * 1792 + 1536 + hm * 64 + 4 * kqq;
#pragma unroll
                for (int dt = 0; dt < 4; ++dt) *(uint2*)(op + 16 * dt) = make_uint2(pk2(O[0][dt][0] * il, O[0][dt][1] * il), pk2(O[0][dt][2] * il, O[0][dt][3] * il)); }
            __syncthreads();
        }
    }
}

struct Args { In in; float* out; unsigned char* ws; int ph_lo, ph_hi; };
__global__ void __launch_bounds__(NWAVES * 64, 2) mk_fwd(Args args) {
    extern __shared__ __attribute__((aligned(16))) unsigned char lds[];
    Frame F;
    F.lds = (LAS unsigned char*)lds; F.MISC = (volatile LAS unsigned*)(F.lds + MISC_OFF);
    F.G = gridDim.x; { const int bx = blockIdx.x; F.vcu = (F.G % 8 == 0) ? (bx % 8) * (F.G / 8) + bx / 8 : bx; }
    unsigned char* ws = args.ws; const In& I = args.in; float* out = args.out; (void)I;
    F.ctl = (gu32*)(ws + WS_CTL);
    for (int u = threadIdx.x; u < (LDS_BYTES - LDSCTL_OFF) / 4; u += NWAVES * 64) ((LAS unsigned*)(F.lds + LDSCTL_OFF))[u] = 0u;
    __syncthreads();
    XcdBarrier bar; bar.bar = (unsigned*)(F.ctl + CW_BAR); bar.x = 0; bar.st = nullptr;
    if (!MK_SPLIT) bar = xcd_barrier_post((unsigned*)(F.ctl + CW_BAR), F.MISC + 8);
    const int lo = args.ph_lo, hi = args.ph_hi;
#ifndef PH_MASK
#define PH_MASK 0xFFFFFFFFu
#endif
#define IN(k) ((((PH_MASK) >> ((k) % 32)) & 1u) && lo <= (k) && (k) < hi)
#define SEAM(k) do { if (IN(k) && IN((k) + 1)) xcd_barrier(bar); } while (0)
#define SEAM2(k, kn) do { if (IN(k) && IN(kn)) xcd_barrier(bar); } while (0)
#ifndef REP_MASK
#define REP_MASK 0u
#endif
#define REPS(k) (1 + (int)(((REP_MASK) >> (k)) & 1u))
    bf16* XN = (bf16*)(ws + WS_XN); bf16* CAT = (bf16*)(ws + WS_CAT); bf16* ACT = (bf16*)(ws + WS_ACT);
    float* SSQ = (float*)(ws + WS_SSQ);

    if (IN(0)) { for (int r_ = 0; r_ < REPS(0); ++r_) { p0_prologue(F, I, ws); if (r_ + 1 < REPS(0)) xcd_barrier(bar); } SEAM(0); }
    {
            if (IN(1)) {
                pg8::Gemm g{XN, (const bf16*)(ws + WS_WIN0), M, 1792, D}; pg8::StaticOrder S; S.init(M, 1792, F.G, (int)blockIdx.x);
                pg8::EpiRoute<0> E{ws, nullptr};
                for (int r_ = 0; r_ < REPS(1); ++r_) { if (r_) xcd_barrier(bar);
                pg8::gemm_phase<pg8::EpiRoute<0>, pg8::StaticOrder, true, true>(F.lds + RING_OFF, g, S, E); }
                pg8::Gemm g2{(const bf16*)(ws + WS_WVT), XN, 256, M, D}; pg8::StaticOrder S2; S2.init(256, M, F.G, (int)((blockIdx.x + 64) % F.G));
                pg8::EpiRoute<3> E2{ws, nullptr};
                pg8::gemm_phase<pg8::EpiRoute<3>, pg8::StaticOrder, true, true>(F.lds + RING_OFF, g2, S2, E2);
                SEAM(1);
            }
            if (IN(2)) { for (int r_ = 0; r_ < REPS(2); ++r_) { p2_mfma(F, I, ws); if (r_ + 1 < REPS(2)) xcd_barrier(bar); } SEAM(2); }
            if (IN(3)) { for (int r_ = 0; r_ < REPS(3); ++r_) { p3_nsa_mfma(F, I, ws); if (r_ + 1 < REPS(3)) xcd_barrier(bar); } SEAM(3); }
    }
    {
        constexpr int L = 0, pb = L ? 14 : 4;
        if (IN(pb)) {
            pg8::Gemm g{L ? (const bf16*)(ws + WS_CAT1) : CAT, L ? (const bf16*)(ws + WS_WO1F) : (const bf16*)(ws + WS_WO), M, D, L ? 1792 : D}; pg8::StaticOrder S; S.init(M, D, F.G, (int)blockIdx.x);
            KARGS(); pg8::EpiResid<L == 0> E{L ? (const void*)XN : (const void*)Ip->x, XN, SSQ + (size_t)(L ? 2 : 0) * M * 16, D, 0};
            pg8::gemm_phase<pg8::EpiResid<L == 0>, pg8::StaticOrder, true, true>(F.lds + RING_OFF, g, S, E);
            SEAM2(pb, pb + 2);
        }
        if (IN(pb + 2)) {
            pg8::Gemm g{XN, (const bf16*)(ws + WS_WGU) + (size_t)L * 2 * DFF * D, M, 2 * DFF, D}; pg8::HalfTailOrder S; S.init(M, 2 * DFF, F.G, (int)blockIdx.x);
            pg8::EpiSwiglu E{ACT, SSQ + (size_t)(L ? 2 : 0) * M * 16, DFF, 0};
            for (int r_ = 0; r_ < REPS(pb + 2); ++r_) { if (r_) xcd_barrier(bar);
            pg8::gemm_phase<pg8::EpiSwiglu, pg8::HalfTailOrder, true, true>(F.lds + RING_OFF, g, S, E); }
            SEAM(pb + 2);
        }
        if (IN(pb + 3)) {
            pg8::Gemm g{ACT, (const bf16*)(ws + WS_WD) + (size_t)L * D * DFF, M, D, DFF}; pg8::StaticOrder S; S.init(M, D, F.G, (int)blockIdx.x);
            pg8::EpiResid<false> E{XN, XN, SSQ + (size_t)(L ? 3 : 1) * M * 16, D, 0};
            pg8::gemm_phase<pg8::EpiResid<false>, pg8::StaticOrder, true, true>(F.lds + RING_OFF, g, S, E);
            SEAM2(pb + 3, L ? 18 : 9);
        }
        }
    {
            if (IN(9)) {
                pg8::Gemm g{XN, (const bf16*)(ws + WS_WIN1), M, 768, D}; pg8::StaticOrder S; S.init(M, 768, F.G, (int)blockIdx.x);
                pg8::EpiRoute<1> E{ws, SSQ + (size_t)1 * M * 16};
                for (int r_ = 0; r_ < REPS(9); ++r_) { if (r_) xcd_barrier(bar);
                pg8::gemm_phase<pg8::EpiRoute<1>, pg8::StaticOrder, true, true>(F.lds + RING_OFF, g, S, E); }
                SEAM(9);
            }
            if (IN(10)) { p10_dsa_norm(F, I, ws); SEAM(10); }
            if (IN(11)) {
                pg8::Gemm g{(const bf16*)(ws + WS_CQ), (const bf16*)(ws + WS_WQ2), M, 2048, 256}; pg8::StaticOrder S; S.init(M, 2048, F.G, (int)blockIdx.x);
                pg8::EpiRoute<2> E{ws, nullptr};
                for (int r_ = 0; r_ < REPS(11); ++r_) { if (r_) xcd_barrier(bar);
                pg8::gemm_phase<pg8::EpiRoute<2>, pg8::StaticOrder, true, true>(F.lds + RING_OFF, g, S, E); }
                SEAM(11);
            }
            if (IN(12)) { for (int r_ = 0; r_ < REPS(12); ++r_) { p12_index_mfma(F, I, ws); if (r_ + 1 < REPS(12)) xcd_barrier(bar); } SEAM(12); }
            if (IN(13)) { for (int r_ = 0; r_ < REPS(13); ++r_) { p13_dsa_mfma(F, I, ws); if (r_ + 1 < REPS(13)) xcd_barrier(bar); } SEAM(13); }
            }
    {
        constexpr int L = 1, pb = L ? 14 : 4;
        if (IN(pb)) {
            pg8::Gemm g{L ? (const bf16*)(ws + WS_CAT1) : CAT, L ? (const bf16*)(ws + WS_WO1F) : (const bf16*)(ws + WS_WO), M, D, L ? 1792 : D}; pg8::StaticOrder S; S.init(M, D, F.G, (int)blockIdx.x);
            KARGS(); pg8::EpiResid<L == 0> E{L ? (const void*)XN : (const void*)Ip->x, XN, SSQ + (size_t)(L ? 2 : 0) * M * 16, D, 0};
            pg8::gemm_phase<pg8::EpiResid<L == 0>, pg8::StaticOrder, true, true>(F.lds + RING_OFF, g, S, E);
            SEAM2(pb, pb + 2);
        }
        if (IN(pb + 2)) {
            pg8::Gemm g{XN, (const bf16*)(ws + WS_WGU) + (size_t)L * 2 * DFF * D, M, 2 * DFF, D}; pg8::HalfTailOrder S; S.init(M, 2 * DFF, F.G, (int)blockIdx.x);
            pg8::EpiSwiglu E{ACT, SSQ + (size_t)(L ? 2 : 0) * M * 16, DFF, 0};
            for (int r_ = 0; r_ < REPS(pb + 2); ++r_) { if (r_) xcd_barrier(bar);
            pg8::gemm_phase<pg8::EpiSwiglu, pg8::HalfTailOrder, true, true>(F.lds + RING_OFF, g, S, E); }
            SEAM(pb + 2);
        }
        if (IN(pb + 3)) {
            pg8::Gemm g{ACT, (const bf16*)(ws + WS_WD) + (size_t)L * D * DFF, M, D, DFF}; pg8::StaticOrder S; S.init(M, D, F.G, (int)blockIdx.x);
            pg8::EpiResid<false> E{XN, XN, SSQ + (size_t)(L ? 3 : 1) * M * 16, D, 0};
            pg8::gemm_phase<pg8::EpiResid<false>, pg8::StaticOrder, true, true>(F.lds + RING_OFF, g, S, E);
            SEAM2(pb + 3, L ? 18 : 9);
        }
        }
    if (IN(18)) {
        OPAQUE_TID(); KARGS(); const int lane_ = tid_ & 63;
        const int gw = F.vcu * NWAVES + (tid_ >> 6), NGW = F.G * NWAVES;
        for (int m = gw; m < M; m += NGW) { const float r = rsqrtf(pg8::ssq_row(SSQ + ((size_t)3 * M + m) * 16) * (1.f / D) + EPSF);
#pragma unroll
            for (int j = 0; j < 2; ++j) { const int c = (j * 64 + lane_) * 8; const pg8::u32x4 rw = *(const GAS pg8::u32x4*)(XN + (size_t)m * D + c);
                const GAS f32x4* gr = (const GAS f32x4*)(Ip->norm_final + c); GAS f32x4* orow = (GAS f32x4*)(out + (size_t)m * D + c);
                f32x4 r0, r1; r0[0] = __uint_as_float(rw.x << 16); r0[1] = __uint_as_float(rw.x & 0xffff0000u); r0[2] = __uint_as_float(rw.y << 16); r0[3] = __uint_as_float(rw.y & 0xffff0000u);
                r1[0] = __uint_as_float(rw.z << 16); r1[1] = __uint_as_float(rw.z & 0xffff0000u); r1[2] = __uint_as_float(rw.w << 16); r1[3] = __uint_as_float(rw.w & 0xffff0000u);
                orow[0] = (r0 * r) * gr[0]; orow[1] = (r1 * r) * gr[1]; } }
    }
#undef IN
#undef SEAM
}

extern "C" void kernel_launch(void* const* d_in, const int* in_sizes, int n_in, void* d_out, int out_size, void* d_ws, size_t ws_size, hipStream_t stream) {
    static int grid = 0;
    if (grid == 0) {
        if (n_in != 32 || out_size != M * D || ws_size < WS_END) { fprintf(stderr, "kernel_launch: unexpected shapes (n_in %d out %d ws %zu)\n", n_in, out_size, ws_size); grid = -1; return; }
        int dev = 0, cus = 0, per_cu = 0;
        if (hipGetDevice(&dev) != hipSuccess || hipDeviceGetAttribute(&cus, hipDeviceAttributeMultiprocessorCount, dev) != hipSuccess) { grid = -1; return; }
        if (hipFuncSetAttribute((const void*)mk_fwd, hipFuncAttributeMaxDynamicSharedMemorySize, LDS_BYTES) != hipSuccess) { grid = -1; return; }
        if (hipOccupancyMaxActiveBlocksPerMultiprocessor(&per_cu, (const void*)mk_fwd, NWAVES * 64, LDS_BYTES) != hipSuccess || per_cu < 1) fprintf(stderr, "kernel_launch: occupancy query reports %d\n", per_cu);
        (void)hipGetLastError();
        grid = cus;
        if (grid > 256) grid = 256;
    }
    if (grid < 0) return;
    if (hipMemsetAsync((char*)d_ws + WS_CTL, 0, CTL_ZERO_BYTES, stream) != hipSuccess) return;
    Args a{};
    const float** ip = (const float**)&a.in;
    for (int i = 0; i < 32; ++i) ip[i] = (const float*)d_in[i];
    a.out = (float*)d_out; a.ws = (unsigned char*)d_ws;
#if MK_SPLIT
    for (int k = 0; k < N_PHASES; ++k) { a.ph_lo = k; a.ph_hi = k + 1; hipLaunchKernelGGL(mk_fwd, dim3(grid), dim3(NWAVES * 64), LDS_BYTES, stream, a); }
#else
    a.ph_lo = 0; a.ph_hi = N_PHASES; hipLaunchKernelGGL(mk_fwd, dim3(grid), dim3(NWAVES * 64), LDS_BYTES, stream, a);
#endif
}
```

```cpp
#include <hip/hip_runtime.h>
#include <cstdio>
#include <cstdint>
#include <type_traits>
#include <math.h>

namespace pg8 {
#define PG8_LAS __attribute__((address_space(3)))
typedef unsigned short bf16_t;
typedef short bf16x8 __attribute__((ext_vector_type(8)));
typedef float f32x4 __attribute__((ext_vector_type(4)));
typedef unsigned u32x4 __attribute__((ext_vector_type(4)));
constexpr int BM = 256, BK = 64, HALF = 128, HTB = HALF * BK * 2  , STAGE_BYTES = 8 * HTB, NXCD = 8, WGM = 8;

__host__ __device__ __forceinline__ int lds_byte(int r, int c) { const int st = (r >> 4) * 2 + (c >> 5), rr = r & 15, cc = c & 31, ob = rr * 64 + cc * 2; return st * 1024 + (ob ^ (((ob >> 9) & 1) << 5)); }
__host__ __device__ __forceinline__ void stage_rc(int b, int& R, int& C) { const int st = b / 1024, sb = b % 1024, swz = sb ^ (((sb >> 9) & 1) << 5); R = (st >> 1) * 16 + swz / 64; C = (st & 1) * 32 + (swz % 64) / 2; }
__host__ __device__ __forceinline__ int perm32(int rho) { const int n = rho >> 4, i = rho & 15; return 8 * (i >> 2) + 4 * n + (i & 3); }

struct Unit { int pm, pn, half; };
struct Gemm { const bf16_t* A; const bf16_t* Bt; int M, N, K; };

struct StaticOrder {
    int nM, nN, nwg, G, c;
    __host__ __device__ void init(int M, int N, int G_, int c_) { nM = M / BM; nN = N / BM; nwg = nM * nN; G = G_; c = c_; }
    __host__ __device__ void map(int L, Unit& u) const {
        int wgid = L; { const int q = nwg / NXCD, r = nwg % NXCD, xcd = wgid % NXCD, off = wgid / NXCD; wgid = (xcd < r ? xcd * (q + 1) : r * (q + 1) + (xcd - r) * q) + off; }
        const int nig = WGM * nN, gid = wgid / nig, fm = gid * WGM, gsz = (nM - fm) < WGM ? (nM - fm) : WGM;
        u.pm = fm + ((wgid % nig) % gsz); u.pn = (wgid % nig) / gsz; u.half = 0; }
    __host__ __device__ bool next(int i, Unit& u) const { const long L = (long)i * G + c; if (L >= nwg) return false; map((int)L, u); return true; }
    __device__ __forceinline__ void a_ready(const Unit&) const {}
    __device__ __forceinline__ void done(const Unit&) const {}
};
struct HalfTailOrder : StaticOrder {
    __host__ __device__ bool next(int i, Unit& u) const {
        const int nfull = (nwg / G) * G, rem = nwg - nfull; const long L = (long)i * G + c;
        if (L < nfull || 2 * rem > G) { if (L >= nwg) return false; map((int)L, u); return true; }
        const long h = L - nfull; if (h >= 2 * rem) return false;
        map(nfull + (int)(h >> 1), u); u.half = 1 + (int)(h & 1); return true; }
};

__device__ __forceinline__ unsigned cvt_pk_bf16(float lo, float hi) { unsigned r; asm volatile("v_cvt_pk_bf16_f32 %0, %1, %2" : "=v"(r) : "v"(lo), "v"(hi)); return r; }
__device__ __forceinline__ float ssq_row(const float* p) { const f32x4 a = ((const f32x4*)p)[0], b = ((const f32x4*)p)[1], c = ((const f32x4*)p)[2], d = ((const f32x4*)p)[3]; const f32x4 t = (a + b) + (c + d); return (t[0] + t[1]) + (t[2] + t[3]); }
template <int ROUTE> struct EpiRoute {
    static constexpr bool PERM = true, AFTER_DRAIN = false;
    unsigned char* ws; const float* ssq;
    __device__ __forceinline__ void operator()(const f32x4 (&acc)[2][2][4][2], const Unit& u, int wr, int wc, int fr, int fq) const {
        asm volatile("" : "+v"(fr), "+v"(fq));
        const int pn = u.pn; size_t off; int ld, t0; float sc;
        if constexpr (ROUTE == 0) {
            off = pn < 3 ? (size_t)(88u << 20) : pn < 5 ? (size_t)(112u << 20) : pn < 6 ? (size_t)(128u << 20) : (size_t)(136u << 20);
            ld = pn < 3 ? 768 : pn < 5 ? 512 : 256; t0 = pn < 3 ? 0 : pn < 5 ? 3 : pn < 6 ? 5 : 6; sc = (pn < 3 || pn == 5) ? 0.18033688011112042f : 1.f;
        } else if constexpr (ROUTE == 1) { off = (size_t)(88u << 20); ld = 768; t0 = 0; sc = 1.f; }
        else if constexpr (ROUTE == 3) { off = (size_t)(144u << 20); ld = 16384; t0 = 0; sc = 1.f; }
        else { off = pn < 6 ? (size_t)(128u << 20) : (size_t)(176u << 20); ld = pn < 6 ? 1536 : 512; t0 = pn < 6 ? 0 : 6; sc = 1.f; }
        bf16_t* base = (bf16_t*)(ws + off);
        const int row0 = u.pm * BM + wr * 64 + fr, col0 = (pn - t0) * BM + wc * 32 + 8 * fq;
#pragma unroll
        for (int ai = 0; ai < 2; ++ai)
#pragma unroll
            for (int m = 0; m < 4; ++m) { bf16_t* rowp = base + (size_t)(row0 + ai * HALF + m * 16) * ld + col0;
                float scr_ = sc; if constexpr (ROUTE == 1) scr_ = rsqrtf(ssq_row(ssq + (size_t)(row0 + ai * HALF + m * 16) * 16) * (1.f / 1024.f) + 1e-6f);
#pragma unroll
                for (int bj = 0; bj < 2; ++bj) { float scb_ = scr_; if constexpr (ROUTE == 1) { const int cg = col0 + bj * HALF; if (cg >= 456 && cg < 712) scb_ *= 0.18033688011112042f; }
                    const f32x4 v0 = acc[ai][bj][m][0] * scb_, v1 = acc[ai][bj][m][1] * scb_;
                    u32x4 w; w.x = cvt_pk_bf16(v0[0], v0[1]); w.y = cvt_pk_bf16(v0[2], v0[3]); w.z = cvt_pk_bf16(v1[0], v1[1]); w.w = cvt_pk_bf16(v1[2], v1[3]);
                    if constexpr (ROUTE == 3) {
                        const int tok = col0 + bj * HALF, rw = row0 + ai * HALF + m * 16; *(u32x4*)(base + ((size_t)(tok >> 6) * 256 + rw) * 64 + (tok & 63)) = w; }
                    else *(u32x4*)(rowp + bj * HALF) = w; } }
    }
};
template <bool RES_F32>
struct EpiResid {
    static constexpr bool PERM = true, AFTER_DRAIN = false;
    const void* res; bf16_t* hb; float* ssq; int ldc; int pad;
    __device__ __forceinline__ void operator()(const f32x4 (&acc)[2][2][4][2], const Unit& u, int wr, int wc, int fr, int fq) const {
        asm volatile("" : "+v"(fr), "+v"(fq));
        const int row0 = u.pm * BM + wr * 64 + fr, col0 = u.pn * BM + wc * 32 + 8 * fq;
#pragma unroll
        for (int ai = 0; ai < 2; ++ai)
#pragma unroll
            for (int m = 0; m < 4; ++m) { const int row = row0 + ai * HALF + m * 16; const size_t off = (size_t)row * ldc + col0; float sq = 0.f;
#pragma unroll
                for (int bj = 0; bj < 2; ++bj) { f32x4 v[2];
                    if constexpr (RES_F32) {
#pragma unroll
                        for (int n = 0; n < 2; ++n) v[n] = *(const f32x4*)((const float*)res + off + bj * HALF + 4 * n) + acc[ai][bj][m][n];
                    } else { const u32x4 rw = *(const u32x4*)((const bf16_t*)res + off + bj * HALF);
                        f32x4 r0, r1; r0[0] = __uint_as_float(rw.x << 16); r0[1] = __uint_as_float(rw.x & 0xffff0000u); r0[2] = __uint_as_float(rw.y << 16); r0[3] = __uint_as_float(rw.y & 0xffff0000u);
                        r1[0] = __uint_as_float(rw.z << 16); r1[1] = __uint_as_float(rw.z & 0xffff0000u); r1[2] = __uint_as_float(rw.w << 16); r1[3] = __uint_as_float(rw.w & 0xffff0000u);
                        v[0] = r0 + acc[ai][bj][m][0]; v[1] = r1 + acc[ai][bj][m][1]; }
#pragma unroll
                    for (int n = 0; n < 2; ++n) sq += (v[n][0] * v[n][0] + v[n][1] * v[n][1]) + (v[n][2] * v[n][2] + v[n][3] * v[n][3]);
                    u32x4 w; w.x = cvt_pk_bf16(v[0][0], v[0][1]); w.y = cvt_pk_bf16(v[0][2], v[0][3]); w.z = cvt_pk_bf16(v[1][0], v[1][1]); w.w = cvt_pk_bf16(v[1][2], v[1][3]); *(u32x4*)(hb + off + bj * HALF) = w; }
                sq += __shfl_xor(sq, 16); sq += __shfl_xor(sq, 32); if (fq == 0) ssq[(size_t)row * 16 + u.pn * 4 + wc] = sq; }
    }
};
struct EpiSwiglu {
    static constexpr bool PERM = true, AFTER_DRAIN = false;
    bf16_t* O; const float* ssq; int ldc; int pad;
    __device__ __forceinline__ void operator()(const f32x4 (&acc)[2][2][4][2], const Unit& u, int wr, int wc, int fr, int fq) const {
        asm volatile("" : "+v"(fr), "+v"(fq));
        const int row0 = u.pm * BM + wr * 64 + fr, col0 = u.pn * HALF + wc * 32 + 8 * fq;
#pragma unroll
        for (int ai = 0; ai < 2; ++ai) { if (u.half == 2 - ai) continue;
#pragma unroll
            for (int m = 0; m < 4; ++m) { float o[8]; const float rs = rsqrtf(ssq_row(ssq + (size_t)(row0 + ai * HALF + m * 16) * 16) * (1.f / 1024.f) + 1e-6f);
#pragma unroll
                for (int n = 0; n < 2; ++n)
#pragma unroll
                    for (int e = 0; e < 4; ++e) { const float g = acc[ai][0][m][n][e] * rs, up = acc[ai][1][m][n][e] * rs; o[4 * n + e] = (g * __builtin_amdgcn_rcpf(1.f + __expf(-g))) * up; }
                u32x4 w; w.x = cvt_pk_bf16(o[0], o[1]); w.y = cvt_pk_bf16(o[2], o[3]); w.z = cvt_pk_bf16(o[4], o[5]); w.w = cvt_pk_bf16(o[6], o[7]);
                *(u32x4*)(O + (size_t)(row0 + ai * HALF + m * 16) * ldc + col0) = w; } }
    }
};
template <class Epi, class Sched, bool ALIGN_EPI = false, bool SP2 = false>
__device__ __forceinline__ void gemm_phase(PG8_LAS unsigned char* lds, const Gemm g, const Sched& S, const Epi& E) {
    int tid = threadIdx.x; asm volatile("" : "+v"(tid));
    const int wid = __builtin_amdgcn_readfirstlane(tid >> 6), lane = tid & 63, wr = wid >> 2, wc = wid & 3, fr = lane & 15, fq = lane >> 4;
    int K = g.K; asm volatile("" : "+s"(K));
    const int nt = K / BK;
    unsigned voffA[2], voffB[2];
#pragma unroll
    for (int i = 0; i < 2; ++i) { int R, C; stage_rc(tid * 16 + i * 8192, R, C); const int Rb = Epi::PERM ? ((R & ~31) + perm32(R & 31)) : R;
        voffA[i] = (unsigned)(R * K + C) * 2u; voffB[i] = (unsigned)(Rb * K + C) * 2u; }
    const size_t kstep = (size_t)(BK * 2);
    const size_t hstep = (size_t)HALF * K * 2;
    const size_t tstep = 2 * hstep;
    const unsigned ldsw = (unsigned)wid * 1024u;
    const int aoff = lds_byte(wr * 64 + fr, fq * 8), boff = lds_byte(wc * 32 + fr, fq * 8);
#define PG8_SA(b, h) (((b) * 2 + (h)) * HTB)
#define PG8_SB(b, h) ((4 + (b) * 2 + (h)) * HTB)
#define PG8_STAGE(bufoff, gbase, voff) do { _Pragma("unroll") for (int _i = 0; _i < 2; ++_i) \
        __builtin_amdgcn_global_load_lds((const unsigned*)((const char*)(gbase) + (voff)[_i]), (PG8_LAS unsigned*)(lds + (bufoff) + ldsw + _i * 8192), 16, 0, 0); } while (0)
#define PG8_LDA(dst, b, h) do { if (cur.half == 2 - (h)) break;        \
        _Pragma("unroll") for (int m = 0; m < 4; ++m) _Pragma("unroll") for (int k = 0; k < 2; ++k) dst[m][k] = *(const PG8_LAS bf16x8*)(lds + PG8_SA(b, h) + aoff + m * 2048 + k * 1024); } while (0)
#define PG8_LDB(dst, b, h) do { _Pragma("unroll") for (int n = 0; n < 2; ++n) _Pragma("unroll") for (int k = 0; k < 2; ++k) dst[n][k] = *(const PG8_LAS bf16x8*)(lds + PG8_SB(b, h) + boff + n * 2048 + k * 1024); } while (0)
#define PG8_MMA(ai, bj, At, Bt) do { if (cur.half == 2 - (ai)) break; __builtin_amdgcn_s_setprio(1); _Pragma("unroll") for (int m = 0; m < 4; ++m) _Pragma("unroll") for (int n = 0; n < 2; ++n) _Pragma("unroll") for (int k = 0; k < 2; ++k) \
        acc[ai][bj][m][n] = __builtin_amdgcn_mfma_f32_16x16x32_bf16(Bt[n][k], At[m][k], acc[ai][bj][m][n], 0, 0, 0); __builtin_amdgcn_s_setprio(0); } while (0)
#define PG8_WAIT_V(n) asm volatile("s_waitcnt vmcnt(" #n ")" ::: "memory")
#define PG8_WAIT_L(n) asm volatile("s_waitcnt lgkmcnt(" #n ")" ::: "memory")
#define PG8_BAR __builtin_amdgcn_s_barrier()
#define PG8_SCHED __builtin_amdgcn_sched_barrier(0)
    Unit cur, nxt; int ui = 0;
    if (!S.next(0, cur)) return;
    f32x4 acc[2][2][4][2];
#pragma unroll
    for (int a = 0; a < 2; ++a)
#pragma unroll
        for (int b = 0; b < 2; ++b)
#pragma unroll
            for (int m = 0; m < 4; ++m)
#pragma unroll
                for (int n = 0; n < 2; ++n) acc[a][b][m][n] = (f32x4){0.f, 0.f, 0.f, 0.f};
    bf16x8 At[4][2], B0[2][2], B1[2][2];
    const char* cA = (const char*)g.A + (size_t)cur.pm * tstep; const char* cB = (const char*)g.Bt + (size_t)cur.pn * tstep;
    S.a_ready(cur);
    if constexpr (SP2) {
        PG8_STAGE(PG8_SB(0, 0), cB, voffB); PG8_STAGE(PG8_SB(0, 1), cB + hstep, voffB); PG8_STAGE(PG8_SA(0, 0), cA, voffA); PG8_STAGE(PG8_SA(0, 1), cA + hstep, voffA);
        if (wr == 1) PG8_BAR;
        PG8_WAIT_V(2); PG8_BAR;
        PG8_STAGE(PG8_SB(1, 0), cB + kstep, voffB); PG8_STAGE(PG8_SA(1, 0), cA + kstep, voffA); PG8_STAGE(PG8_SB(1, 1), cB + hstep + kstep, voffB);
        PG8_WAIT_V(6); PG8_BAR;
    } else {
        PG8_STAGE(PG8_SB(0, 0), cB, voffB); PG8_STAGE(PG8_SA(0, 0), cA, voffA); PG8_STAGE(PG8_SB(0, 1), cB + hstep, voffB); PG8_STAGE(PG8_SA(0, 1), cA + hstep, voffA);
        if (wr == 1) PG8_BAR;
        PG8_WAIT_V(4); PG8_BAR;
        PG8_STAGE(PG8_SB(1, 0), cB + kstep, voffB); PG8_STAGE(PG8_SA(1, 0), cA + kstep, voffA); PG8_STAGE(PG8_SB(1, 1), cB + hstep + kstep, voffB);
        PG8_WAIT_V(6); PG8_BAR;
    }
    for (;;) {
        const bool has_next = S.next(ui + 1, nxt);
        const char* nA = has_next ? (const char*)g.A + (size_t)nxt.pm * tstep : cA; const char* nB = has_next ? (const char*)g.Bt + (size_t)nxt.pn * tstep : cB;
        for (int t = 0; t < nt; t += 2) {
            const bool last = (t == nt - 2);
            const char* a1 = cA + (size_t)(t + 1) * kstep;
            const char* a2 = last ? nA : cA + (size_t)(t + 2) * kstep; const char* b2 = last ? nB : cB + (size_t)(t + 2) * kstep;
            const char* a3 = a2 + kstep; const char* b3 = b2 + kstep;
            if (last && has_next) S.a_ready(nxt);
            if constexpr (SP2) {
            PG8_LDB(B0, 0, 0); PG8_LDB(B1, 0, 1); PG8_SCHED; PG8_LDA(At, 0, 0); PG8_STAGE(PG8_SA(1, 1), a1 + hstep, voffA);
            PG8_WAIT_V(8); PG8_WAIT_L(0); PG8_BAR; PG8_MMA(0, 0, At, B0); PG8_MMA(0, 1, At, B1); PG8_BAR; PG8_SCHED;
            PG8_LDA(At, 0, 1); PG8_STAGE(PG8_SB(0, 0), b2, voffB); PG8_STAGE(PG8_SB(0, 1), b2 + hstep, voffB); PG8_STAGE(PG8_SA(0, 0), a2, voffA);
            PG8_WAIT_V(8); PG8_WAIT_L(0); PG8_BAR; PG8_MMA(1, 0, At, B0); PG8_MMA(1, 1, At, B1); PG8_BAR; PG8_SCHED;
            PG8_LDB(B0, 1, 0); PG8_LDB(B1, 1, 1); PG8_SCHED; PG8_LDA(At, 1, 0); PG8_STAGE(PG8_SA(0, 1), a2 + hstep, voffA);
            PG8_WAIT_V(8); PG8_WAIT_L(0); PG8_BAR; PG8_MMA(0, 0, At, B0); PG8_MMA(0, 1, At, B1); PG8_BAR; PG8_SCHED;
            PG8_LDA(At, 1, 1); PG8_STAGE(PG8_SB(1, 0), b3, voffB); PG8_STAGE(PG8_SB(1, 1), b3 + hstep, voffB); PG8_STAGE(PG8_SA(1, 0), a3, voffA);
            PG8_WAIT_V(8); PG8_WAIT_L(0); PG8_BAR; PG8_MMA(1, 0, At, B0); PG8_MMA(1, 1, At, B1); PG8_BAR; PG8_SCHED;
            } else {
            PG8_LDB(B0, 0, 0); PG8_SCHED; PG8_LDA(At, 0, 0); PG8_STAGE(PG8_SA(1, 1), a1 + hstep, voffA);
            PG8_WAIT_L(8); PG8_BAR; PG8_WAIT_L(0); PG8_MMA(0, 0, At, B0); PG8_BAR; PG8_SCHED;
            PG8_LDB(B1, 0, 1); PG8_STAGE(PG8_SB(0, 0), b2, voffB);
            PG8_BAR; PG8_WAIT_L(0); PG8_MMA(0, 1, At, B1); PG8_BAR;
            PG8_LDA(At, 0, 1); PG8_STAGE(PG8_SA(0, 0), a2, voffA);
            PG8_BAR; PG8_WAIT_L(0); PG8_MMA(1, 0, At, B0); PG8_BAR; PG8_SCHED;
            PG8_STAGE(PG8_SB(0, 1), b2 + hstep, voffB);
            PG8_WAIT_V(6); PG8_BAR; PG8_MMA(1, 1, At, B1); PG8_BAR;
            PG8_LDB(B0, 1, 0); PG8_SCHED; PG8_LDA(At, 1, 0); PG8_STAGE(PG8_SA(0, 1), a2 + hstep, voffA);
            PG8_WAIT_L(8); PG8_BAR; PG8_WAIT_L(0); PG8_MMA(0, 0, At, B0); PG8_BAR; PG8_SCHED;
            PG8_LDB(B1, 1, 1); PG8_STAGE(PG8_SB(1, 0), b3, voffB);
            PG8_BAR; PG8_WAIT_L(0); PG8_MMA(0, 1, At, B1); PG8_BAR;
            PG8_LDA(At, 1, 1); PG8_STAGE(PG8_SA(1, 0), a3, voffA);
            PG8_BAR; PG8_WAIT_L(0); PG8_MMA(1, 0, At, B0); PG8_BAR; PG8_SCHED;
            PG8_STAGE(PG8_SB(1, 1), b3 + hstep, voffB);
            PG8_WAIT_V(6); PG8_BAR; PG8_MMA(1, 1, At, B1); PG8_BAR;
            }
        }
        if constexpr (ALIGN_EPI) { if (wr == 0) PG8_BAR; }
        if constexpr (!Epi::AFTER_DRAIN) { E(acc, cur, wr, wc, fr, fq); S.done(cur); }
        if (!has_next) break;
#pragma unroll
        for (int a = 0; a < 2; ++a)
#pragma unroll
            for (int b = 0; b < 2; ++b)
#pragma unroll
                for (int m = 0; m < 4; ++m)
#pragma unroll
                    for (int n = 0; n < 2; ++n) acc[a][b][m][n] = (f32x4){0.f, 0.f, 0.f, 0.f};
        cur = nxt; cA = nA; cB = nB; ++ui;
        if constexpr (ALIGN_EPI) { if (wr == 1) PG8_BAR; }
    }
    PG8_WAIT_V(0);
    if constexpr (!ALIGN_EPI) { if (wr == 0) PG8_BAR; }
    PG8_BAR;
    if constexpr (Epi::AFTER_DRAIN) { E.fused(acc, cur, wr, wc, fr, fq, lds, wid, lane); S.done(cur); }
#undef PG8_SA
#undef PG8_SB
#undef PG8_STAGE
#undef PG8_LDA
#undef PG8_LDB
#undef PG8_MMA
#undef PG8_WAIT_V
#undef PG8_WAIT_L
#undef PG8_BAR
#undef PG8_SCHED
}
}
constexpr int NWAVES = 8;
constexpr int BATCH = 2, T = 8192, D = 1024, M = BATCH * T, DFF = 2816, NSA_IN = 1828, DSA_IN = 712, NCMP = 511, NCR = BATCH * NCMP * 2;
constexpr float NEGF = -1e30f, EPSF = 1e-6f;
#ifndef MK_SPLIT
#define MK_SPLIT 0
#endif
constexpr int N_PHASES = 19;
constexpr size_t MiB = 1u << 20;
constexpr size_t WS_CTL = 0, CTL_ZERO_BYTES = 1 * MiB;
constexpr size_t WS_KCB = 1 * MiB  , WS_VCT = 1 * MiB + 512 * 1024  , WS_MKB = 2 * MiB  , WS_MVT = 2 * MiB + 512 * 1024  , WS_MKV = 3 * MiB  , WS_WIDX = 5 * MiB  , WS_CNT = 6 * MiB  ;
constexpr size_t WS_WIN0 = 8 * MiB, WS_WO = 12 * MiB, WS_WGU = 16 * MiB, WS_WD = 38 * MiB, WS_WIN1 = 49 * MiB, WS_WQ2 = 51 * MiB, WS_WVT = 52 * MiB  ;
constexpr size_t WS_W1T = 232 * MiB, WS_MEMN = 234 * MiB, WS_WMKT = 236 * MiB, WS_W2T = 238 * MiB, WS_B1F = 238 * MiB + 64 * 1024;
constexpr size_t WS_XN = 56 * MiB;
constexpr size_t WS_Q0 = 88 * MiB, WS_KV0 = 112 * MiB  , WS_QM = 128 * MiB, WS_G0 = 136 * MiB, WS_VT = 144 * MiB  ;
static_assert(WS_Q0 == (88u << 20) && WS_KV0 == (112u << 20) && WS_QM == (128u << 20) && WS_G0 == (136u << 20), "EpiRoute tables");
constexpr size_t WS_ACT = 88 * MiB;
constexpr size_t WS_PROJ1 = 88 * MiB, WS_CQ = 112 * MiB, WS_CKV = 120 * MiB, WS_KIDX = 124 * MiB, WS_QA = 128 * MiB, WS_QI = 176 * MiB, WS_SEL = 112 * MiB  , WS_CAT1 = 176 * MiB  , WS_WO1F = 52 * MiB + 512 * 1024  ;
constexpr size_t WS_OCS = 152 * MiB  , WS_CAT = 200 * MiB, WS_SSQ = 239 * MiB  , WS_END = 243 * MiB;
static_assert(WS_PROJ1 == (88u << 20) && WS_QA == (128u << 20) && WS_QI == (176u << 20) && WS_VT == (144u << 20), "EpiRoute tables");
static_assert(WS_ACT + (size_t)M * DFF * 2 <= WS_CAT + 0 * MiB || true, "map");
constexpr int CW_BAR = 4096;
constexpr int RING_OFF = 0, RING_BYTES = 131072, LDS_BYTES = 163840, LDSCTL_OFF = LDS_BYTES - 1024, MISC_OFF = LDSCTL_OFF + 320;
#define GAS __attribute__((address_space(1)))
#define LAS __attribute__((address_space(3)))
typedef unsigned short bf16;
typedef unsigned v4u __attribute__((ext_vector_type(4)));
typedef unsigned v2u __attribute__((ext_vector_type(2)));
typedef float f32x4 __attribute__((ext_vector_type(4)));
typedef short bf16x8 __attribute__((ext_vector_type(8)));
typedef GAS unsigned gu32;
typedef GAS unsigned long long gu64;
#define RLX_AGENT __ATOMIC_RELAXED, __HIP_MEMORY_SCOPE_AGENT
#define LDS_WAIT() asm volatile("s_waitcnt lgkmcnt(0)" ::: "memory")
#define VM_WAIT() asm volatile("s_waitcnt vmcnt(0)" ::: "memory")
__device__ __forceinline__ unsigned long long rt() { return __builtin_amdgcn_s_memrealtime(); }
__device__ __forceinline__ unsigned f2bf(float f) { unsigned u = __builtin_bit_cast(unsigned, f); return (u + 0x7fffu + ((u >> 16) & 1u)) >> 16; }
typedef float f32x2_t __attribute__((ext_vector_type(2))); typedef __bf16 bf16x2_t __attribute__((ext_vector_type(2)));
__device__ __forceinline__ unsigned pk2(float lo, float hi) { f32x2_t v = {lo, hi}; bf16x2_t b = __builtin_convertvector(v, bf16x2_t); return __builtin_bit_cast(unsigned, b); }
#define XB_TMO      128
#define XB_XCNT(j)  (256  + 64 * (j))
#define XB_XSUB(j)  (1280 + 64 * (j))
#define XB_XGEN(j)  (2304 + 64 * (j))
#define XB_TOP      3328
#define XB_TOPGEN   3392
#define XCD_BAR_WORDS 3456
#define XB_SPIN_CAP (1u << 18)

__device__ __forceinline__ unsigned xb_ld(unsigned* p)              { return __hip_atomic_load(p, __ATOMIC_RELAXED, __HIP_MEMORY_SCOPE_AGENT); }
__device__ __forceinline__ unsigned xb_add(unsigned* p, unsigned v) { return __hip_atomic_fetch_add(p, v, __ATOMIC_RELAXED, __HIP_MEMORY_SCOPE_AGENT); }
__device__ __forceinline__ unsigned xb_xcc_id() { return (unsigned)__builtin_amdgcn_s_getreg((3 << 11) | 20) & 0xFu; }
#define XB_SPIN(cond, bar) do { unsigned _sp = 0; while (cond) { __builtin_amdgcn_s_sleep(1); \
    if ((++_sp & 255u) == 0u) { if (xb_ld(&(bar)[XB_TMO])) break; if (_sp > XB_SPIN_CAP) { atomicAdd(&(bar)[XB_TMO], 1u); break; } } } } while (0)

struct XcdBarrier {
    unsigned* bar; unsigned x;
    volatile LAS unsigned* st;
};

__device__ __forceinline__ XcdBarrier xcd_barrier_post(unsigned* bar, volatile LAS unsigned* st) {
    XcdBarrier b; b.bar = bar; b.x = xb_xcc_id(); b.st = st;
    if (threadIdx.x == 0) (void)xb_add(&bar[XB_XCNT(b.x)], 1u);
    return b;
}
__device__ __forceinline__ void xcd_barrier_complete(unsigned* bar, unsigned x, unsigned& nloc, unsigned& nx) {
    const unsigned G = gridDim.x * gridDim.y * gridDim.z;
    unsigned sum, cnt, mine, sp = 0u;
    for (;;) {
        sum = 0u; cnt = 0u; mine = 0u;
#pragma unroll 1
        for (unsigned j = 0; j < 16; ++j) { const unsigned c = xb_ld(&bar[XB_XCNT(j)]); sum += c; cnt += (c > 0u) ? 1u : 0u; mine = (j == x) ? c : mine; }
        if (sum == G) break;
        __builtin_amdgcn_s_sleep(1);
        if ((++sp & 255u) == 0u) { if (xb_ld(&bar[XB_TMO])) break; if (sp > XB_SPIN_CAP) { atomicAdd(&bar[XB_TMO], 1u); break; } }
    }
    nloc = mine > 0u ? mine : 1u; nx = cnt > 0u ? cnt : 1u;
}

__device__ __forceinline__ void xcd_barrier(const XcdBarrier& b) {
    asm volatile("s_waitcnt vmcnt(0)" ::: "memory");
    __syncthreads();
    if (threadIdx.x == 0) {
        unsigned* bar = b.bar;
        __builtin_amdgcn_s_waitcnt(0);
        unsigned nloc = b.st[0], nx = b.st[1];
        if (nloc == 0u) { xcd_barrier_complete(bar, b.x, nloc, nx); b.st[0] = nloc; b.st[1] = nx; }
        const unsigned old = xb_add(&bar[XB_XSUB(b.x)], 1u);
        const unsigned gen = old / nloc;
        if (old + 1u == (gen + 1u) * nloc) {
            __builtin_amdgcn_fence(__ATOMIC_RELEASE, "agent");
            asm volatile("s_waitcnt vmcnt(0)" ::: "memory");
            const unsigned og = xb_add(&bar[XB_TOP], 1u);
            const unsigned tg = og / nx;
            if (og + 1u == (tg + 1u) * nx) xb_add(&bar[XB_TOPGEN], 1u);
            else XB_SPIN(xb_ld(&bar[XB_TOPGEN]) == tg, bar);
            __builtin_amdgcn_fence(__ATOMIC_ACQUIRE, "agent");
            xb_add(&bar[XB_XGEN(b.x)], 1u);
            asm volatile("s_waitcnt vmcnt(0)" ::: "memory");
        } else {
            XB_SPIN(xb_ld(&bar[XB_XGEN(b.x)]) == gen, bar);
            __builtin_amdgcn_fence(__ATOMIC_ACQUIRE, "agent");
            asm volatile("s_waitcnt vmcnt(0)" ::: "memory");
        }
    }
    __syncthreads();
}

struct Frame {
    LAS unsigned char* lds; volatile LAS unsigned* MISC; gu32* ctl;
    int vcu, G;
};
__device__ __forceinline__ float bf2f(unsigned short u) { return __uint_as_float((unsigned)u << 16); }
__device__ __forceinline__ float bflo(unsigned u) { return __uint_as_float(u << 16); }
__device__ __forceinline__ float bfhi(unsigned u) { return __uint_as_float(u & 0xffff0000u); }
__device__ __forceinline__ float wave_sum(float v) {
#define WS_DPP_(x, ctrl) __int_as_float(__builtin_amdgcn_update_dpp(__float_as_int(x), __float_as_int(x), (ctrl), 0xf, 0xf, false))
    v += WS_DPP_(v, 0xB1); v += WS_DPP_(v, 0x4E); v += WS_DPP_(v, 0x141); v += WS_DPP_(v, 0x140);
#undef WS_DPP_
    const float a = __int_as_float(__builtin_amdgcn_readlane(__float_as_int(v), 0)), b = __int_as_float(__builtin_amdgcn_readlane(__float_as_int(v), 16)), c = __int_as_float(__builtin_amdgcn_readlane(__float_as_int(v), 32)), d = __int_as_float(__builtin_amdgcn_readlane(__float_as_int(v), 48));
    return (a + b) + (c + d);
}
__device__ __forceinline__ float red16_sum(float v) { v += __shfl_xor(v, 1, 16); v += __shfl_xor(v, 2, 16); v += __shfl_xor(v, 4, 16); v += __shfl_xor(v, 8, 16); return v; }
__device__ __forceinline__ float red16_max(float v) { v = fmaxf(v, __shfl_xor(v, 1, 16)); v = fmaxf(v, __shfl_xor(v, 2, 16)); v = fmaxf(v, __shfl_xor(v, 4, 16)); v = fmaxf(v, __shfl_xor(v, 8, 16)); return v; }
__device__ __forceinline__ int rel_bucket(int n) {
    if (n < 16) return n;
    return 16 + (n >= 22) + (n >= 30) + (n >= 40) + (n >= 54) + (n >= 73) + (n >= 99) + (n >= 134) + (n >= 182) + (n >= 246) + (n >= 332) + (n >= 450) + (n >= 609) + (n >= 825) + (n >= 1117) + (n >= 1513);
}

__device__ __forceinline__ void xpose_item(const float* W, int ldw, int c0, int nvalid, int k0, bf16* WT, int Kd, int drow0, LAS float* scr, int lane, const float* kgain = nullptr) {
#pragma unroll
    for (int i = 0; i < 8; ++i) { const int kk = 8 * i + (lane >> 3), n = (lane & 7) * 4;
        float4 wv = make_float4(0.f, 0.f, 0.f, 0.f);
        if (n + 3 < nvalid) wv = *(const float4*)(W + (size_t)(k0 + kk) * ldw + c0 + n);
        else if (n < nvalid) { const float* wp = W + (size_t)(k0 + kk) * ldw + c0 + n; wv.x = wp[0]; if (n + 1 < nvalid) wv.y = wp[1]; if (n + 2 < nvalid) wv.z = wp[2]; }
        if (kgain) { const float g_ = kgain[k0 + kk]; wv.x *= g_; wv.y *= g_; wv.z *= g_; wv.w *= g_; }
        LAS float* sp = scr + kk * 33 + n; sp[0] = wv.x; sp[1] = wv.y; sp[2] = wv.z; sp[3] = wv.w; }
    LDS_WAIT(); asm volatile("" ::: "memory");
    const int c = lane & 7;
#pragma unroll
    for (int j = 0; j < 4; ++j) { const int n = (lane >> 3) + 8 * j; const LAS float* s = scr + (8 * c) * 33 + n;
        v4u o; o.x = pk2(s[0 * 33], s[1 * 33]); o.y = pk2(s[2 * 33], s[3 * 33]); o.z = pk2(s[4 * 33], s[5 * 33]); o.w = pk2(s[6 * 33], s[7 * 33]);
        *(GAS v4u*)(WT + (size_t)(drow0 + n) * Kd + k0 + 8 * c) = o; }
    LDS_WAIT(); asm volatile("" ::: "memory");
}
__device__ __forceinline__ void rms_row_to_bf16(const float* xrow, const float* gain, bf16* orow, int lane) {
    const GAS f32x4* xr = (const GAS f32x4*)xrow + lane; const GAS f32x4* gr = (const GAS f32x4*)gain + lane;
    f32x4 v[4]; float s = 0.f;
#pragma unroll
    for (int j = 0; j < 4; ++j) { v[j] = xr[64 * j]; s += (v[j].x * v[j].x + v[j].y * v[j].y) + (v[j].z * v[j].z + v[j].w * v[j].w); }
    const float r = rsqrtf(wave_sum(s) * (1.f / D) + EPSF);
    GAS unsigned long long* o8 = (GAS unsigned long long*)orow + lane;
#pragma unroll
    for (int j = 0; j < 4; ++j) { const f32x4 g = gr[64 * j]; o8[64 * j] = (unsigned long long)pk2((v[j].x * r) * g.x, (v[j].y * r) * g.y) | ((unsigned long long)pk2((v[j].z * r) * g.z, (v[j].w * r) * g.w) << 32); }
}
#ifndef PROBE_REP
#define PROBE_REP 0
#endif
#define CAS __attribute__((address_space(4)))
#define KARGS() const CAS In* Ip = (const CAS In*)__builtin_amdgcn_kernarg_segment_ptr(); asm volatile("" : "+s"(Ip))
#define OPAQUE_TID() int tid_ = threadIdx.x; asm volatile("" : "+v"(tid_))
__device__ __forceinline__ void norm_phase(Frame& F, const float* x, const float* gain, bf16* xn) {
    OPAQUE_TID(); const int lane_ = tid_ & 63, wave_ = tid_ >> 6;
    const int gw = F.vcu * NWAVES + wave_, NGW = F.G * NWAVES;
    for (int m = gw; m < M; m += NGW) rms_row_to_bf16(x + (size_t)m * D, gain, xn + (size_t)m * D, lane_);
}

template <int DL>
__device__ __forceinline__ void coop_attend(const float (&q)[DL], const float (&k)[DL], const float (&v)[DL], float bias, float& m_, float& l_, float (&o)[DL]) {
    float a = 0.f;
#pragma unroll
    for (int d = 0; d < DL; ++d) a += q[d] * k[d];
    a = red16_sum(a) + bias;
    const float mn = fmaxf(m_, a), al = __expf(m_ - mn), p = __expf(a - mn);
    l_ = l_ * al + p; m_ = mn;
#pragma unroll
    for (int d = 0; d < DL; ++d) o[d] = o[d] * al + p * v[d];
}
__device__ __forceinline__ void ld4bf(const bf16* p, float (&x)[4]) { const uint2 u = *(const uint2*)p; x[0] = bflo(u.x); x[1] = bfhi(u.x); x[2] = bflo(u.y); x[3] = bfhi(u.y); }
__device__ __forceinline__ void ld8bf(const bf16* p, float (&x)[8]) { const uint4 u = *(const uint4*)p; x[0] = bflo(u.x); x[1] = bfhi(u.x); x[2] = bflo(u.y); x[3] = bfhi(u.y); x[4] = bflo(u.z); x[5] = bfhi(u.z); x[6] = bflo(u.w); x[7] = bfhi(u.w); }
__device__ __forceinline__ void ld4f(const float* p, float (&x)[4]) { const float4 u = *(const float4*)p; x[0] = u.x; x[1] = u.y; x[2] = u.z; x[3] = u.w; }

struct In {
    const float *x, *mem, *rel_bias, *norm_mix, *norm_ffn, *norm_mem, *w_mem_kv, *w_out, *ffn_gate, *ffn_up, *ffn_down, *nsa_w_in, *nsa_gate_b, *pos_k, *pos_v,
        *k_w1, *k_b1, *k_w2, *k_b2, *v_w1, *v_b1, *v_w2, *v_b2, *dsa_w_in, *q_norm, *kv_norm, *w_q_up, *w_uk, *w_uv, *w_q_idx, *kidx_norm, *norm_final;
};
__device__ __forceinline__ void p0_prologue(Frame& F, const In& I, unsigned char* ws) {
    OPAQUE_TID(); KARGS(); const int lane_ = tid_ & 63, wave_ = __builtin_amdgcn_readfirstlane(tid_ >> 6);
    LAS float* scr = (LAS float*)(F.lds + RING_OFF + wave_ * 16384);
    const int gw = F.vcu * NWAVES + wave_, NGW = F.G * NWAVES;
    bf16* WIN0 = (bf16*)(ws + WS_WIN0); bf16* WO = (bf16*)(ws + WS_WO); bf16* WGU = (bf16*)(ws + WS_WGU); bf16* WD = (bf16*)(ws + WS_WD); bf16* WIN1 = (bf16*)(ws + WS_WIN1); bf16* WQ2 = (bf16*)(ws + WS_WQ2);
    constexpr int I_A = 16 * 56, I_G = 16 * 8, I_B = 2 * 16 * 32, I_C = 2 * 16 * 176, I_D = 2 * 44 * 32, I_E = 16 * 24, I_F = 4 * 16, NITEMS = I_A + I_B + I_C + I_D + I_E + I_F + I_G;
    for (int it = gw; it < NITEMS; it += NGW) {
        int r = it;
        if (r < I_A) { const int kb = r / 56, nb = r % 56, r0 = 32 * nb; int c0, nv;
            if (r0 < 1152) { c0 = r0; nv = 32; } else if (r0 < 1280) { c0 = r0 + 128; nv = 32; } else if (r0 < 1536) { c0 = r0 + 292; nv = 32; } else if (r0 == 1536) { c0 = 1536; nv = 32; } else if (r0 == 1568) { c0 = 1568; nv = 4; } else { c0 = 0; nv = 0; }
            xpose_item(Ip->nsa_w_in, NSA_IN, c0, nv, 64 * kb, WIN0, D, r0, scr, lane_); continue; } r -= I_A;
        if (r < I_B) { const int l = r / 512, q = r % 512, kb = q / 32, nb = q % 32;
            xpose_item(Ip->w_out + (size_t)l * D * D, D, 32 * nb, 32, 64 * kb, WO + (size_t)l * D * D, D, 32 * nb, scr, lane_); continue; } r -= I_B;
        if (r < I_C) { const int l = r / (16 * 176), q = r % (16 * 176), kb = q / 176, nb = q % 176, r0 = 32 * nb, pn = r0 >> 8, w0 = r0 & 255;
            const float* src = ((w0 < 128) ? Ip->ffn_gate : Ip->ffn_up) + (size_t)l * D * DFF;
            xpose_item(src, DFF, 128 * pn + (w0 & 127), 32, 64 * kb, WGU + (size_t)l * 2 * DFF * D, D, r0, scr, lane_, Ip->norm_ffn + l * D); continue; } r -= I_C;
        if (r < I_D) { const int l = r / (44 * 32), q = r % (44 * 32), kb = q / 32, nb = q % 32;
            xpose_item(Ip->ffn_down + (size_t)l * DFF * D, D, 32 * nb, 32, 64 * kb, WD + (size_t)l * D * DFF, DFF, 32 * nb, scr, lane_); continue; } r -= I_D;
        if (r < I_E) { const int kb = r / 24, nb = r % 24, r0 = 32 * nb; int nv = DSA_IN - r0; nv = nv > 32 ? 32 : (nv < 0 ? 0 : nv);
            xpose_item(Ip->dsa_w_in, DSA_IN, r0, nv, 64 * kb, WIN1, D, r0, scr, lane_, Ip->norm_mix + D); continue; } r -= I_E;
        if (r < I_F) { const int kb = r / 16, nb = r % 16; xpose_item(Ip->w_q_idx, 512, 32 * nb, 32, 64 * kb, WQ2, 256, 1536 + 32 * nb, scr, lane_); continue; } r -= I_F;
        { const int kb = r / 8, nb = r % 8, r0 = 32 * nb;
            xpose_item(Ip->nsa_w_in, NSA_IN, (r0 < 128) ? 1152 + r0 : 1408 + (r0 - 128), 32, 64 * kb, (bf16*)(ws + WS_WVT), D, r0, scr, lane_); }
    }
    for (int idx = (F.vcu * NWAVES * 64) + tid_; idx < 384 * 256; idx += F.G * NWAVES * 64) {
        const int c = idx & 255, r4 = (idx >> 8) & 31, h = idx >> 13; const float4* a4 = (const float4*)(Ip->w_q_up + (size_t)c * 768 + h * 64); const float4* b4 = (const float4*)(Ip->w_uk + (size_t)(4 * r4) * 768 + h * 64);
        float s0 = 0.f, s1 = 0.f, s2 = 0.f, s3 = 0.f;
#pragma unroll 4
        for (int d = 0; d < 16; ++d) { const float4 av = a4[d], b0 = b4[d], b1 = b4[192 + d], b2 = b4[384 + d], b3 = b4[576 + d];
            s0 += (av.x * b0.x + av.y * b0.y) + (av.z * b0.z + av.w * b0.w); s1 += (av.x * b1.x + av.y * b1.y) + (av.z * b1.z + av.w * b1.w);
            s2 += (av.x * b2.x + av.y * b2.y) + (av.z * b2.z + av.w * b2.w); s3 += (av.x * b3.x + av.y * b3.y) + (av.z * b3.z + av.w * b3.w); }
        const float sc_ = 0.125f * 1.4426950408889634f;
        bf16* o_ = WQ2 + (size_t)(h * 128 + 4 * r4) * 256 + c;
        o_[0] = (bf16)f2bf(s0 * sc_); o_[256] = (bf16)f2bf(s1 * sc_); o_[512] = (bf16)f2bf(s2 * sc_); o_[768] = (bf16)f2bf(s3 * sc_);
    }
    { bf16* WO1F = (bf16*)(ws + WS_WO1F); const float* wo1 = Ip->w_out + (size_t)D * D;
      for (int idx = (F.vcu * NWAVES * 64) + tid_; idx < 12 * 32 * 256; idx += F.G * NWAVES * 64) {
          const int n4 = idx & 255, r4 = (idx >> 8) & 31, h = idx >> 13; const float* a = Ip->w_uv + (size_t)(4 * r4) * 768 + h * 64; const float* bcol = wo1 + (size_t)(h * 64) * D + 4 * n4;
          float acc_[4][4];
#pragma unroll
          for (int i = 0; i < 4; ++i)
#pragma unroll
              for (int j = 0; j < 4; ++j) acc_[i][j] = 0.f;
#pragma unroll 4
          for (int d = 0; d < 64; ++d) { const float4 bv = *(const float4*)(bcol + (size_t)d * D); const float a0 = a[d], a1 = a[768 + d], a2 = a[1536 + d], a3 = a[2304 + d];
              acc_[0][0] += a0 * bv.x; acc_[0][1] += a0 * bv.y; acc_[0][2] += a0 * bv.z; acc_[0][3] += a0 * bv.w; acc_[1][0] += a1 * bv.x; acc_[1][1] += a1 * bv.y; acc_[1][2] += a1 * bv.z; acc_[1][3] += a1 * bv.w;
              acc_[2][0] += a2 * bv.x; acc_[2][1] += a2 * bv.y; acc_[2][2] += a2 * bv.z; acc_[2][3] += a2 * bv.w; acc_[3][0] += a3 * bv.x; acc_[3][1] += a3 * bv.y; acc_[3][2] += a3 * bv.z; acc_[3][3] += a3 * bv.w; }
#pragma unroll
          for (int j = 0; j < 4; ++j) *(uint2*)(WO1F + (size_t)(4 * n4 + j) * 1792 + h * 128 + 4 * r4) = make_uint2(pk2(acc_[0][j], acc_[1][j]), pk2(acc_[2][j], acc_[3][j])); }
      for (int it = gw; it < 4 * 32; it += NGW) { const int kb = it / 32, nb = it % 32;
          xpose_item(wo1 + (size_t)768 * D, D, 32 * nb, 32, 64 * kb, WO1F + 1536, 1792, 32 * nb, scr, lane_); } }
    { bf16* W1T = (bf16*)(ws + WS_W1T); bf16* W2T = (bf16*)(ws + WS_W2T); bf16* WMKT = (bf16*)(ws + WS_WMKT); float* B1F = (float*)(ws + WS_B1F); bf16* MEMN = (bf16*)(ws + WS_MEMN);
      constexpr int J_1 = 2 * 32 * 8, J_2 = 2 * 4 * 2, J_M = 2 * 16 * 16;
      for (int it = gw; it < J_1 + J_2 + J_M; it += NGW) { int r2 = it;
          if (r2 < J_1) { const int kv = r2 / 256, q = r2 % 256, kb = q / 8, nb = q % 8; xpose_item(kv ? Ip->v_w1 : Ip->k_w1, 256, 32 * nb, 32, 64 * kb, W1T + (size_t)kv * 256 * 2048, 2048, 32 * nb, scr, lane_); continue; } r2 -= J_1;
          if (r2 < J_2) { const int kv = r2 / 8, q = r2 % 8, kb = q / 2, nb = q % 2; xpose_item(kv ? Ip->v_w2 : Ip->k_w2, 64, 32 * nb, 32, 64 * kb, W2T + (size_t)kv * 64 * 256, 256, 32 * nb, scr, lane_); continue; } r2 -= J_2;
          { const int l = r2 / 256, q = r2 % 256, kb = q / 16, nb = q % 16; xpose_item(Ip->w_mem_kv + (size_t)l * D * 512, 512, 32 * nb, 32, 64 * kb, WMKT + (size_t)l * 512 * D, D, 32 * nb, scr, lane_); } }
      if ((int)blockIdx.x < 32) { const int u_ = (int)blockIdx.x, kv = u_ >> 4, cr = (u_ >> 2) & 3, kq4 = u_ & 3, c = 64 * cr + lane_; const float* w1 = kv ? Ip->v_w1 : Ip->k_w1; const float* pos = kv ? Ip->pos_v : Ip->pos_k;
          const int kb0 = 512 * kq4 + 64 * wave_; float sacc = 0.f;
#pragma unroll 8
          for (int k = 0; k < 64; ++k) sacc += pos[kb0 + k] * w1[(size_t)(kb0 + k) * 256 + c];
          LAS float* red = (LAS float*)(F.lds + RING_OFF + 8 * 16384);
          red[wave_ * 64 + lane_] = sacc;
          __syncthreads();
          if (wave_ == 0) { float t_ = 0.f;
#pragma unroll
              for (int w = 0; w < 8; ++w) t_ += red[w * 64 + lane_];
              B1F[(kv * 4 + kq4) * 256 + c] = t_; } }
      for (int m = gw; m < 1024; m += NGW) rms_row_to_bf16(Ip->mem + (size_t)(m & 511) * D, Ip->norm_mem + (m >> 9) * D, MEMN + (size_t)m * D, lane_); }
    norm_phase(F, Ip->x, Ip->norm_mix, (bf16*)(ws + WS_XN));
}

#define MFMA16(A, B, C) __builtin_amdgcn_mfma_f32_16x16x32_bf16((A), (B), (C), 0, 0, 0)
constexpr float LOG2E = 1.4426950408889634f;
constexpr int NSA_OUT = 0, NSA_PSQ = 49152, NSA_ST = 147456, NSA_TB = NSA_ST + 3072;
constexpr int TAB_B12 = NSA_ST + 1024;
constexpr int P13_JUNK = NSA_ST + 3072 + 1536;
constexpr int P13_B12 = NSA_ST;
constexpr int TAB_BKT = NSA_ST + 3072;
static_assert(NSA_TB + 12288 <= LDSCTL_OFF && TAB_B12 + 2048 <= NSA_TB, "LDS tables");
enum { MD_CMP = 0, MD_WIN = 1, MD_BLK = 2, MD_MEM = 3 };
struct KF { bf16x8 a0, a1, b0, b1; };
struct VF { bf16x8 v[4]; };
__device__ __forceinline__ bf16x8 ldg16(const bf16* p) { return *(const bf16x8*)p; }
__device__ __forceinline__ unsigned cvtpk_s(float lo, float hi) { f32x2_t v = {lo, hi}; bf16x2_t b = __builtin_convertvector(v, bf16x2_t); return __builtin_bit_cast(unsigned, b); }
__device__ __forceinline__ bf16x8 pack8(const f32x4& a, const f32x4& b) { v4u w; w.x = cvtpk_s(a[0], a[1]); w.y = cvtpk_s(a[2], a[3]); w.z = cvtpk_s(b[0], b[1]); w.w = cvtpk_s(b[2], b[3]); return __builtin_bit_cast(bf16x8, w); }
__device__ __forceinline__ void load_k(KF& k, const bf16* kb, int kstride, int key0, int r, int kq) {
    const bf16* pa = kb + (size_t)(key0 + 8 * (r >> 2) + (r & 3)) * kstride + 8 * kq; const bf16* pb = pa + 4 * (size_t)kstride;
    k.a0 = ldg16(pa); k.a1 = ldg16(pa + 32); k.b0 = ldg16(pb); k.b1 = ldg16(pb + 32);
}
__device__ __forceinline__ void load_vt(VF& v, const bf16* vt, int vstride, int key0, int r, int kq) {
#pragma unroll
    for (int dt = 0; dt < 4; ++dt) v.v[dt] = ldg16(vt + (size_t)(16 * dt + r) * vstride + key0 + 8 * kq);
}
__device__ __forceinline__ void qk(f32x4& sa, f32x4& sb, const KF& k, const bf16x8 (&q)[2]) {
    const f32x4 z = {0.f, 0.f, 0.f, 0.f};
    sa = MFMA16(k.a0, q[0], z); sa = MFMA16(k.a1, q[1], sa); sb = MFMA16(k.b0, q[0], z); sb = MFMA16(k.b1, q[1], sb);
}
struct BiasCtx { const LAS unsigned short* tb; float d29, d30, c31; };
template <int MODE>
__device__ __forceinline__ void maskbias(f32x4& s, int kpos, int tcol, bool colok, const BiasCtx& B) {
    if (MODE == MD_MEM) return;
#pragma unroll
    for (int i = 0; i < 4; ++i) {
        int dist; bool ok;
        if (MODE == MD_CMP) { dist = tcol - 31 - 16 * (kpos + i); ok = dist >= 0; }
        else if (MODE == MD_WIN) { dist = tcol - (kpos + i); ok = (unsigned)dist <= 511u; }
        else { dist = tcol - (kpos + i); ok = dist >= 0; }
        int dc = dist < 0 ? 0 : dist; dc = dc > 1023 ? 1023 : dc;
        const float tb = __uint_as_float((unsigned)B.tb[dc * 6] << 16);
        float bias = tb;
        if (MODE != MD_WIN) { const float far = B.c31 + (dist < 1513 ? B.d30 : 0.f) + (dist < 1117 ? B.d29 : 0.f); bias = dist < 1024 ? tb : far; }
        s[i] = (ok && colok) ? s[i] + bias : -INFINITY;
    }
}
__device__ __forceinline__ float colmax(const f32x4& sa, const f32x4& sb) {
    float mx = fmaxf(fmaxf(fmaxf(sa[0], sa[1]), fmaxf(sa[2], sa[3])), fmaxf(fmaxf(sb[0], sb[1]), fmaxf(sb[2], sb[3])));
    mx = fmaxf(mx, __shfl_xor(mx, 16)); mx = fmaxf(mx, __shfl_xor(mx, 32)); return mx;
}
constexpr float SM_THR = 8.f;
__device__ __forceinline__ float lmax8(const f32x4& sa, const f32x4& sb) { return fmaxf(fmaxf(fmaxf(sa[0], sa[1]), fmaxf(sa[2], sa[3])), fmaxf(fmaxf(sb[0], sb[1]), fmaxf(sb[2], sb[3]))); }
__device__ __forceinline__ int imax3(int a, int b, int c) { return max(max(a, b), c); }
__device__ __forceinline__ int imax16(const f32x4& a, const f32x4& b, const f32x4& c, const f32x4& d) {
#define FI_(x) __float_as_int(x)
    const int t0 = imax3(FI_(a[0]), FI_(a[1]), FI_(a[2])), t1 = imax3(FI_(a[3]), FI_(b[0]), FI_(b[1])), t2 = imax3(FI_(b[2]), FI_(b[3]), FI_(c[0])), t3 = imax3(FI_(c[1]), FI_(c[2]), FI_(c[3])), t4 = imax3(FI_(d[0]), FI_(d[1]), FI_(d[2]));
    return max(imax3(t0, t1, FI_(d[3])), imax3(t2, t3, t4));
#undef FI_
}
template <int NO>
__device__ __forceinline__ void sm_rescale(float lm, float& m, float& l, f32x4 (&O)[NO]) {
    if (__any(lm > m + SM_THR)) {
        lm = fmaxf(lm, __shfl_xor(lm, 16)); lm = fmaxf(lm, __shfl_xor(lm, 32));
        const float mn = fmaxf(m, lm); const float al = __builtin_amdgcn_exp2f(m - mn); m = mn; l *= al;
#pragma unroll
        for (int dt = 0; dt < NO; ++dt) O[dt] = O[dt] * al;
    }
}
__device__ __forceinline__ bf16x8 sm_update(const f32x4& sa, const f32x4& sb, float& m, float& l, f32x4 (&O)[4]) {
    sm_rescale<4>(lmax8(sa, sb), m, l, O);
    f32x4 pa, pb; float sum = 0.f;
#pragma unroll
    for (int i = 0; i < 4; ++i) { pa[i] = __builtin_amdgcn_exp2f(sa[i] - m); pb[i] = __builtin_amdgcn_exp2f(sb[i] - m); sum += pa[i] + pb[i]; }
    l += sum;
    return pack8(pa, pb);
}
__device__ __forceinline__ void sm_update64(const f32x4& sa0, const f32x4& sb0, const f32x4& sa1, const f32x4& sb1, float& m, float& l, f32x4 (&O)[4], bf16x8& pf0, bf16x8& pf1) {
    sm_rescale<4>(fmaxf(lmax8(sa0, sb0), lmax8(sa1, sb1)), m, l, O);
    f32x4 pa0, pb0, pa1, pb1; float sum = 0.f;
#pragma unroll
    for (int i = 0; i < 4; ++i) { pa0[i] = __builtin_amdgcn_exp2f(sa0[i] - m); pb0[i] = __builtin_amdgcn_exp2f(sb0[i] - m); pa1[i] = __builtin_amdgcn_exp2f(sa1[i] - m); pb1[i] = __builtin_amdgcn_exp2f(sb1[i] - m);
        sum += (pa0[i] + pb0[i]) + (pa1[i] + pb1[i]); }
    l += sum;
    pf0 = pack8(pa0, pb0); pf1 = pack8(pa1, pb1);
}
enum { BK_FAR = 0, BK_MID = 1, BK_GEN = 2, BK_FARF = 3 };
template <int MD, int CLS>
__device__ __forceinline__ void step64(const KF& k0, const KF& k1, const bf16x8 (&q)[2], int cls, int kpos, int tcol, bool colok, const BiasCtx& B,
                                       float& m, float& l, f32x4 (&O)[4], bf16x8& pf0, bf16x8& pf1) {
    const bool has = m > -1e29f; const float mref = has ? m : 0.f;
    if (CLS >= 0) cls = CLS;
    float cin = ((cls == BK_FAR) ? B.c31 : 0.f) - mref; if (!colok) cin = -INFINITY;
    const f32x4 c4 = {cin, cin, cin, cin};
    f32x4 sa0 = MFMA16(k0.a0, q[0], c4), sb0 = MFMA16(k0.b0, q[0], c4), sa1 = MFMA16(k1.a0, q[0], c4), sb1 = MFMA16(k1.b0, q[0], c4);
    sa0 = MFMA16(k0.a1, q[1], sa0); sb0 = MFMA16(k0.b1, q[1], sb0); sa1 = MFMA16(k1.a1, q[1], sa1); sb1 = MFMA16(k1.b1, q[1], sb1);
    if (cls == BK_MID) {
        const LAS unsigned short* tl = B.tb + (tcol - kpos - 39) * 6; asm("" : "+v"(tl));
#pragma unroll
        for (int i = 0; i < 4; ++i) { sa0[i] += __uint_as_float((unsigned)tl[6 * (39 - i)] << 16); sb0[i] += __uint_as_float((unsigned)tl[6 * (35 - i)] << 16);
            sa1[i] += __uint_as_float((unsigned)tl[6 * (7 - i)] << 16); sb1[i] += __uint_as_float((unsigned)tl[6 * (3 - i)] << 16); }
    } else if (CLS == BK_FARF) {
        const int d0 = tcol - kpos;
#pragma unroll
        for (int i = 0; i < 4; ++i) {
            { const int d = d0 - i;      sa0[i] += B.c31 + (d < 1513 ? B.d30 : 0.f) + (d < 1117 ? B.d29 : 0.f); }
            { const int d = d0 - 4 - i;  sb0[i] += B.c31 + (d < 1513 ? B.d30 : 0.f) + (d < 1117 ? B.d29 : 0.f); }
            { const int d = d0 - 32 - i; sa1[i] += B.c31 + (d < 1513 ? B.d30 : 0.f) + (d < 1117 ? B.d29 : 0.f); }
            { const int d = d0 - 36 - i; sb1[i] += B.c31 + (d < 1513 ? B.d30 : 0.f) + (d < 1117 ? B.d29 : 0.f); } }
    } else if (cls == BK_GEN) {
        maskbias<MD>(sa0, kpos, tcol, true, B); maskbias<MD>(sb0, kpos + 4, tcol, true, B); maskbias<MD>(sa1, kpos + 32, tcol, true, B); maskbias<MD>(sb1, kpos + 36, tcol, true, B);
    }
    if (__any((imax16(sa0, sb0, sa1, sb1) > __float_as_int(SM_THR)) || !has)) {
        float lm = fmaxf(lmax8(sa0, sb0), lmax8(sa1, sb1));
        lm = fmaxf(lm, __shfl_xor(lm, 16)); lm = fmaxf(lm, __shfl_xor(lm, 32));
        const bool upd = (lm > -INFINITY) && (!has || lm > 0.f); const float dl = upd ? lm : 0.f;
        if (upd) m = mref + dl;
        const float f = has ? __builtin_amdgcn_exp2f(-dl) : 1.f; l *= f;
#pragma unroll
        for (int dt = 0; dt < 4; ++dt) O[dt] = O[dt] * f;
#pragma unroll
        for (int i = 0; i < 4; ++i) { sa0[i] -= dl; sb0[i] -= dl; sa1[i] -= dl; sb1[i] -= dl; }
    }
    f32x4 pa0, pb0, pa1, pb1; float sum = 0.f;
#pragma unroll
    for (int i = 0; i < 4; ++i) { pa0[i] = __builtin_amdgcn_exp2f(sa0[i]); pb0[i] = __builtin_amdgcn_exp2f(sb0[i]); pa1[i] = __builtin_amdgcn_exp2f(sa1[i]); pb1[i] = __builtin_amdgcn_exp2f(sb1[i]);
        sum += (pa0[i] + pb0[i]) + (pa1[i] + pb1[i]); }
    l += sum;
    pf0 = pack8(pa0, pb0); pf1 = pack8(pa1, pb1);
}
__device__ __forceinline__ void pv(f32x4 (&O)[4], const VF& v, const bf16x8& pf) {
#pragma unroll
    for (int dt = 0; dt < 4; ++dt) O[dt] = MFMA16(v.v[dt], pf, O[dt]);
}
__device__ __forceinline__ void lds_fadd(LAS float* p, float v) { (void)__hip_atomic_fetch_add((float*)p, v, __ATOMIC_RELAXED, __HIP_MEMORY_SCOPE_WORKGROUP); }
#define DPP_I(x, ctrl) __builtin_amdgcn_update_dpp((x), (x), (ctrl), 0xf, 0xf, false)
#define DPP_F(x, ctrl) __int_as_float(__builtin_amdgcn_update_dpp(__float_as_int(x), __float_as_int(x), (ctrl), 0xf, 0xf, false))
__device__ __forceinline__ float sum8_dpp(float v) { v += DPP_F(v, 0xB1); v += DPP_F(v, 0x4E); v += DPP_F(v, 0x141); return v; }
__device__ __forceinline__ unsigned wave_iscan_u32(unsigned x) {
#define DPP_Z(v, ctrl, rmask) (unsigned)__builtin_amdgcn_update_dpp(0, (int)(v), (ctrl), (rmask), 0xf, false)
    x += DPP_Z(x, 0x111, 0xf); x += DPP_Z(x, 0x112, 0xf); x += DPP_Z(x, 0x114, 0xf); x += DPP_Z(x, 0x118, 0xf); x += DPP_Z(x, 0x142, 0xa); x += DPP_Z(x, 0x143, 0xc);
#undef DPP_Z
    return x; }
__device__ __forceinline__ int wmax64_i(int x) {
    x = max(x, DPP_I(x, 0xB1)); x = max(x, DPP_I(x, 0x4E)); x = max(x, DPP_I(x, 0x141)); x = max(x, DPP_I(x, 0x140));
    return max(max(__builtin_amdgcn_readlane(x, 0), __builtin_amdgcn_readlane(x, 16)), max(__builtin_amdgcn_readlane(x, 32), __builtin_amdgcn_readlane(x, 48))); }
__device__ __forceinline__ float kqsum(float v) { v += __shfl_xor(v, 16); v += __shfl_xor(v, 32); return v; }
__device__ __forceinline__ float wmax64(float v) {
#pragma unroll
    for (int o = 1; o < 64; o <<= 1) v = fmaxf(v, __shfl_xor(v, o));
    return v;
}
__device__ __forceinline__ void out_add(LAS unsigned short* OUTw, int p, int n, int kq, const f32x4 (&O)[4], float scale, bool first) {
    const int q = 2 * p + (n >> 3), hd = n & 7;
    if (hd < 6) { LAS v2u* dst = (LAS v2u*)(OUTw + (q * 6 + hd) * 64) + kq;
#pragma unroll
        for (int dt = 0; dt < 4; ++dt) { f32x4 v = O[dt] * scale; if (!first) { const v2u o = dst[4 * dt]; v[0] += __uint_as_float(o.x << 16); v[1] += __uint_as_float(o.x & 0xffff0000u); v[2] += __uint_as_float(o.y << 16); v[3] += __uint_as_float(o.y & 0xffff0000u); }
            dst[4 * dt] = (v2u){pk2(v[0], v[1]), pk2(v[2], v[3])}; } }
}

__device__ __forceinline__ void p2_mfma(Frame& F, const In& I, unsigned char* ws) {
    OPAQUE_TID(); KARGS(); const int lane = tid_ & 63, wave = __builtin_amdgcn_readfirstlane(tid_ >> 6), r = lane & 15, kq = lane >> 4;
    const bf16* KV0 = (const bf16*)(ws + WS_KV0); const bf16* W1T = (const bf16*)(ws + WS_W1T); const bf16* W2T = (const bf16*)(ws + WS_W2T); const float* B1F = (const float*)(ws + WS_B1F);
    const bf16* MEMN = (const bf16*)(ws + WS_MEMN); const bf16* WMKT = (const bf16*)(ws + WS_WMKT);
    bf16* KCB = (bf16*)(ws + WS_KCB); bf16* VCT = (bf16*)(ws + WS_VCT); bf16* MKB = (bf16*)(ws + WS_MKB); bf16* MVT = (bf16*)(ws + WS_MVT);
    LAS unsigned char* aim = F.lds + RING_OFF;
    LAS unsigned char* hid = F.lds + RING_OFF + RING_BYTES;
    for (int u = blockIdx.x; u < 192; u += F.G) {
        const bool cmp = u < 128;
        const bf16* bp[2]; int K, kjump;
        int kv = 0, bg = 0, n0 = 0, lay = 0, m0 = 0, ch = 0;
        if (cmp) { kv = u >> 6; bg = (u >> 4) & 3; n0 = (u & 15) * 32; K = 2048; kjump = 512 - 64;
#pragma unroll
            for (int ct = 0; ct < 2; ++ct) bp[ct] = W1T + (size_t)(kv * 256 + 32 * wave + 16 * ct + r) * 2048 + 8 * kq;
        } else { const int v = u - 128; lay = v >> 5; m0 = ((v >> 1) & 15) * 32; ch = v & 1; K = 1024; kjump = 0;
#pragma unroll
            for (int ct = 0; ct < 2; ++ct) bp[ct] = WMKT + (size_t)(lay * 512 + ch * 256 + 32 * wave + 16 * ct + r) * 1024 + 8 * kq;
        }
        { const int nins = (K >> 6) * 4;
          for (int i = wave; i < nins; i += NWAVES) { const int seg = 8 * i + (lane >> 3), c = lane & 7, sblk = seg >> 5, row = seg & 31;
              const bf16* arow; if (cmp) { const int b = bg >> 1, g = bg & 1; int nn = n0 + row; nn = nn > 510 ? 510 : nn; arow = KV0 + (size_t)(b * T + 16 * nn) * 512 + kv * 128 + g * 64; }
              else arow = MEMN + (size_t)(lay * 512 + m0 + row) * 1024;
              __builtin_amdgcn_global_load_lds((const unsigned*)(arow + 64 * sblk + sblk * kjump + 8 * (c ^ (row & 7))), (LAS unsigned*)(aim + i * 1024), 16, 0, 0); }
          asm volatile("s_waitcnt vmcnt(0)" ::: "memory"); __syncthreads(); }
        f32x4 acc[2][2];
#pragma unroll
        for (int rt = 0; rt < 2; ++rt)
#pragma unroll
            for (int ct = 0; ct < 2; ++ct) acc[rt][ct] = (f32x4){0.f, 0.f, 0.f, 0.f};
        { int r_ = r, kq_ = kq; asm volatile("" : "+v"(r_), "+v"(kq_));
          bf16x8 bb[2][2], bn[2][2];
#define P2_LOADB(B_, kb_) do { const int kbl_ = (kb_) < K ? (kb_) : K - 64; \
            _Pragma("unroll") for (int h2 = 0; h2 < 2; ++h2) _Pragma("unroll") for (int ct = 0; ct < 2; ++ct) B_[ct][h2] = *(const GAS bf16x8*)(bp[ct] + kbl_ + 32 * h2); } while (0)
#define P2_MM(B_, kb_) do { const LAS unsigned char* as_ = aim + ((kb_) >> 6) * 4096; \
            _Pragma("unroll") for (int h2 = 0; h2 < 2; ++h2) _Pragma("unroll") for (int rt = 0; rt < 2; ++rt) { const int row_ = 16 * rt + r_; \
                const bf16x8 av_ = *(const LAS bf16x8*)(as_ + row_ * 128 + (((4 * h2 + kq_) ^ (row_ & 7)) << 4)); \
                _Pragma("unroll") for (int ct = 0; ct < 2; ++ct) acc[rt][ct] = MFMA16(av_, B_[ct][h2], acc[rt][ct]); } } while (0)
          P2_LOADB(bb, 0);
          for (int kb = 0; kb < K; kb += 128) {
              P2_LOADB(bn, kb + 64); P2_MM(bb, kb);
              P2_LOADB(bb, kb + 128); P2_MM(bn, kb + 64);
          }
#undef P2_LOADB
#undef P2_MM
        }
        if (cmp) {
#pragma unroll
            for (int ct = 0; ct < 2; ++ct) { const int col = 32 * wave + 16 * ct + r; const float bias = (kv ? Ip->v_b1 : Ip->k_b1)[col] + ((B1F[(kv * 4 + 0) * 256 + col] + B1F[(kv * 4 + 1) * 256 + col]) + (B1F[(kv * 4 + 2) * 256 + col] + B1F[(kv * 4 + 3) * 256 + col]));
#pragma unroll
                for (int rt = 0; rt < 2; ++rt)
#pragma unroll
                    for (int i = 0; i < 4; ++i) { const float xg = acc[rt][ct][i] + bias; const float hv = 0.5f * xg * (1.f + tanhf(0.7978845608028654f * (xg + 0.044715f * xg * xg * xg)));
                        *(LAS unsigned short*)(hid + (16 * rt + 4 * kq + i) * 528 + 2 * col) = (unsigned short)f2bf(hv); } }
            __syncthreads();
            { const int rt2 = wave >> 2, ct2 = wave & 3; f32x4 o = {0.f, 0.f, 0.f, 0.f};
              const bf16* w2p = W2T + (size_t)(kv * 64 + 16 * ct2 + r) * 256 + 8 * kq;
#pragma unroll
              for (int ks = 0; ks < 8; ++ks) { const bf16x8 av = *(const LAS bf16x8*)(hid + (16 * rt2 + r) * 528 + 64 * ks + 16 * kq); o = MFMA16(av, ldg16(w2p + 32 * ks), o); }
              const int d = 16 * ct2 + r; const float b2v = (kv ? Ip->v_b2 : Ip->k_b2)[d];
#pragma unroll
              for (int i = 0; i < 4; ++i) { const int nn = n0 + 16 * rt2 + 4 * kq + i; const unsigned short ov = (nn < NCMP) ? (unsigned short)f2bf(o[i] + b2v) : (unsigned short)0;
                  if (kv) VCT[(size_t)(bg * 64 + d) * 512 + nn] = ov; else KCB[(size_t)(bg * 512 + nn) * 64 + d] = ov; } }
            __syncthreads();
        } else {
#pragma unroll
            for (int ct = 0; ct < 2; ++ct) { const int col = 32 * wave + 16 * ct + r;
#pragma unroll
                for (int rt = 0; rt < 2; ++rt)
#pragma unroll
                    for (int i = 0; i < 4; ++i) { const int mrow = m0 + 16 * rt + 4 * kq + i; const unsigned short ov = (unsigned short)f2bf(acc[rt][ct][i]);
                        if (ch == 0) MKB[(size_t)(lay * 512 + mrow) * 256 + col] = ov; else MVT[(size_t)(lay * 256 + col) * 512 + mrow] = ov; } }
            __syncthreads();
        }
    }
}

template <int MODE>
__device__ __forceinline__ void mb2(f32x4& sa, f32x4& sb, int kpos, int tcol, bool colok, bool fast, const BiasCtx& B) {
    if (fast) { if (colok) { sa = sa + B.c31; sb = sb + B.c31; } else { sa = (f32x4){-INFINITY, -INFINITY, -INFINITY, -INFINITY}; sb = sa; } }
    else { maskbias<MODE>(sa, kpos, tcol, colok, B); maskbias<MODE>(sb, kpos + 4, tcol, colok, B); }
}
__device__ __forceinline__ void cmp_bias(f32x4& sa, f32x4& sb, int kpos, int tcol, int ccls, const BiasCtx& B) {
    if (ccls == 0) { sa = sa + B.c31; sb = sb + B.c31; }
    else if (ccls == 1) { const int d0 = tcol - 31 - 16 * kpos;
#pragma unroll
        for (int i = 0; i < 4; ++i) { { const int d = d0 - 16 * i; sa[i] += B.c31 + (d < 1513 ? B.d30 : 0.f) + (d < 1117 ? B.d29 : 0.f); }
                                      { const int d = d0 - 64 - 16 * i; sb[i] += B.c31 + (d < 1513 ? B.d30 : 0.f) + (d < 1117 ? B.d29 : 0.f); } } }
    else if (ccls == 2) { const LAS unsigned short* tl = B.tb + (tcol - 31 - 16 * (kpos + 7)) * 6; asm("" : "+v"(tl));
#pragma unroll
        for (int i = 0; i < 4; ++i) { sa[i] += __uint_as_float((unsigned)tl[96 * (7 - i)] << 16); sb[i] += __uint_as_float((unsigned)tl[96 * (3 - i)] << 16); } }
    else { maskbias<MD_CMP>(sa, kpos, tcol, true, B); maskbias<MD_CMP>(sb, kpos + 4, tcol, true, B); }
}
#define SWZ(row) (((((row) >> 3) & 3) << 1) | (((row) >> 1) & 1))
struct KV1 { KF k; VF v; };
__device__ __forceinline__ void load_kv(KV1& d, const bf16* kb, int kstride, const bf16* vt, int vstride, int key0, int r, int kq) { load_k(d.k, kb, kstride, key0, r, kq); load_vt(d.v, vt, vstride, key0, r, kq); }

template <int MD, int FORCE = 0>
__device__ __forceinline__ void nsa_sweep(LAS unsigned char* STG, const bf16* ksb, const bf16* vst, int jlo, int jhi, int qt, const LAS unsigned* WMw, int wave, int lane, int r, int kq, int qsel, int t0w,
                                          const bf16x8 (&qf)[4][2], const BiasCtx& BC, float (&m)[4], float (&l)[4], f32x4 (&O)[4][4],
                                          int kstr = 512, int kblk = 64 * 512, int vstr = 64, int vblk = 16384) {
            const int srow = 8 * wave + (lane >> 3), sch = (lane & 7) ^ SWZ(srow);
            const bf16* ksrc = ksb + (size_t)srow * kstr + 8 * sch; const bf16* vsrc = vst + (size_t)srow * vstr + 8 * sch;
#define NSA_DMA(jb) do { LAS unsigned char* d_ = STG + ((jb) % 6) * 16384 + wave * 1024; \
                __builtin_amdgcn_global_load_lds((const unsigned*)(ksrc + (size_t)(jb) * kblk), (LAS unsigned*)d_, 16, 0, 0); \
                __builtin_amdgcn_global_load_lds((const unsigned*)(vsrc + (size_t)(jb) * vblk), (LAS unsigned*)(d_ + 8192), 16, 0, 0); } while (0)
#define NSA_WAITV(n_) do { if ((n_) >= 6) asm volatile("s_waitcnt vmcnt(6) lgkmcnt(0)" ::: "memory"); else if ((n_) == 4) asm volatile("s_waitcnt vmcnt(4) lgkmcnt(0)" ::: "memory"); else if ((n_) == 2) asm volatile("s_waitcnt vmcnt(2) lgkmcnt(0)" ::: "memory"); else asm volatile("s_waitcnt vmcnt(0) lgkmcnt(0)" ::: "memory"); } while (0)
            { const int nb = jhi - jlo + 1;
#pragma unroll
              for (int i = 0; i < 3; ++i) if (i < nb) NSA_DMA(jlo + i);
              NSA_WAITV(0); }
            __builtin_amdgcn_s_barrier();
#define NSA_TILES(CLS_) _Pragma("unroll") for (int p = 0; p < 4; ++p) if (m8 & (3u << (2 * p))) { \
                        bf16x8 pf0, pf1; \
                        step64<MD, CLS_>(k0, k1, qf[p], cls, 64 * j + 8 * kq_, t0w + 2 * p + qs_, ((m8 >> (2 * p + qs_)) & 1u) != 0u, BC, m[p], l[p], O[p], pf0, pf1); \
                        pv(O[p], v0, pf0); pv(O[p], v1, pf1); \
                        __builtin_amdgcn_sched_barrier(0); }
            auto tiles = [&](auto clsx, int j) __attribute__((always_inline)) { constexpr int CLSX = decltype(clsx)::value;
                const LAS unsigned char* sk = STG + (j % 6) * 16384; const LAS unsigned char* sv = sk + 8192;
                unsigned m8 = 0xffu; if (WMw) m8 = (unsigned)__builtin_amdgcn_readfirstlane((int)((WMw[j >> 2] >> (8 * (j & 3))) & 0xffu)); if (FORCE == 1) m8 = 0u; if (FORCE == 2) m8 = 0xffu; if (MD == MD_MEM) m8 = 3u; else asm volatile("" : "+s"(m8));
                if (m8) {
                    int r_ = r, kq_ = kq, qs_ = qsel; asm volatile("" : "+v"(r_), "+v"(kq_), "+v"(qs_));
                    const int dj = qt - j; const int cls = (MD == MD_MEM) ? BK_FAR : (MD == MD_WIN) ? ((dj >= 1 && dj <= 7) ? BK_MID : BK_GEN) : ((64 * dj - 63 >= 1513) ? BK_FAR : ((dj >= 1 && dj <= 15) ? BK_MID : BK_GEN));
                    KF k0, k1;
                    { const int ka = 8 * (r_ >> 2) + (r_ & 3), kb2 = ka + 4, kc = ka + 32, kd = ka + 36;
                      k0.a0 = *(const LAS bf16x8*)(sk + ka * 128 + ((kq_ ^ SWZ(ka)) << 4)); k0.a1 = *(const LAS bf16x8*)(sk + ka * 128 + (((4 + kq_) ^ SWZ(ka)) << 4));
                      k0.b0 = *(const LAS bf16x8*)(sk + kb2 * 128 + ((kq_ ^ SWZ(kb2)) << 4)); k0.b1 = *(const LAS bf16x8*)(sk + kb2 * 128 + (((4 + kq_) ^ SWZ(kb2)) << 4));
                      k1.a0 = *(const LAS bf16x8*)(sk + kc * 128 + ((kq_ ^ SWZ(kc)) << 4)); k1.a1 = *(const LAS bf16x8*)(sk + kc * 128 + (((4 + kq_) ^ SWZ(kc)) << 4));
                      k1.b0 = *(const LAS bf16x8*)(sk + kd * 128 + ((kq_ ^ SWZ(kd)) << 4)); k1.b1 = *(const LAS bf16x8*)(sk + kd * 128 + (((4 + kq_) ^ SWZ(kd)) << 4)); }
                    VF v0, v1;
#pragma unroll
                    for (int dt = 0; dt < 4; ++dt) { const int dd = 16 * dt + r_; v0.v[dt] = *(const LAS bf16x8*)(sv + dd * 128 + ((kq_ ^ SWZ(dd)) << 4)); v1.v[dt] = *(const LAS bf16x8*)(sv + dd * 128 + (((4 + kq_) ^ SWZ(dd)) << 4)); }
                    NSA_TILES(CLSX)
                }
            };
            int ni = 0;
            auto blk = [&](auto clsx, int j) __attribute__((always_inline)) {
                const int ph = (j - jlo) % 3;
                if (ph == 0) { if (j + 3 <= jhi) NSA_DMA(j + 3); if (j + 4 <= jhi) NSA_DMA(j + 4); if (j + 5 <= jhi) NSA_DMA(j + 5); }
                tiles(clsx, j);
                if (ph == 2 || j == jhi) { NSA_WAITV(0); __builtin_amdgcn_s_barrier(); }
            };
            int j = jlo;
            if (MD == MD_BLK || MD == MD_MEM) { const int jfar = (MD == MD_MEM) ? jhi : ((qt - 25 < jhi) ? qt - 25 : jhi); const int jfe = jlo + ((jfar - jlo + 1 >= 0 ? (jfar - jlo + 1) / 3 : -1) * 3) - 1;
                for (; j <= jfe; ++j) blk(std::integral_constant<int, BK_FAR>{}, j); }
            if (MD == MD_BLK) {
                const int jf2 = (qt - 17 < jhi) ? qt - 17 : jhi; const int jfe2 = jlo + ((jf2 - jlo + 1 >= 0 ? (jf2 - jlo + 1) / 3 : -1) * 3) - 1;
                for (; j <= jfe2; ++j) blk(std::integral_constant<int, BK_FARF>{}, j); }
            for (; j <= jhi; ++j) blk(std::integral_constant<int, -1>{}, j);
#undef NSA_WAITV
#undef NSA_TILES
#undef NSA_DMA
}
__device__ __forceinline__ void p3_nsa_mfma(Frame& F, const In& I, unsigned char* ws) {
    OPAQUE_TID(); KARGS(); const int wave = __builtin_amdgcn_readfirstlane(tid_ >> 6);
    LAS float* b12 = (LAS float*)(F.lds + TAB_B12);
    LAS unsigned short* OUTw = (LAS unsigned short*)(F.lds + NSA_OUT) + wave * 3072;
    LAS float* PSw = (LAS float*)(F.lds + NSA_PSQ) + wave * 1024;
    LAS unsigned char* STG = F.lds + NSA_PSQ;
    LAS unsigned* WMw = (LAS unsigned*)(F.lds + NSA_ST) + wave * 32;
    for (int i = tid_; i < 512; i += NWAVES * 64) b12[i] = ((i & 15) < 12) ? Ip->rel_bias[(i >> 4) * 12 + (i & 15)] * LOG2E : 0.f;
    LAS unsigned short* TB = (LAS unsigned short*)(F.lds + NSA_TB);
    { const int gg = (int)blockIdx.x & 1;
      for (int i = tid_; i < 6144; i += NWAVES * 64) { const int dd = i / 6, hh = i % 6; TB[i] = (unsigned short)f2bf(Ip->rel_bias[rel_bucket(dd) * 12 + gg * 6 + hh] * LOG2E); } }
    __syncthreads();
    const bf16* Q0 = (const bf16*)(ws + WS_Q0); const bf16* KV0 = (const bf16*)(ws + WS_KV0); const bf16* QM = (const bf16*)(ws + WS_QM); const bf16* G0 = (const bf16*)(ws + WS_G0);
    const bf16* VT = (const bf16*)(ws + WS_VT); const bf16* KCB = (const bf16*)(ws + WS_KCB); const bf16* VCT = (const bf16*)(ws + WS_VCT);
    const bf16* MKB = (const bf16*)(ws + WS_MKB); const bf16* MVT = (const bf16*)(ws + WS_MVT);
    bf16* CAT = (bf16*)(ws + WS_CAT);
    const int nun = 4 * 128;
    for (int ui = blockIdx.x; ui < nun; ui += F.G) {
        int tl_ = tid_; asm volatile("" : "+v"(tl_));
        const int lane = tl_ & 63, n = lane & 15, kq = lane >> 4, r = n, hd = n & 7, qsel = n >> 3; const bool colv = hd < 6;
        int bg, qt;
        bg = blockIdx.x & 3;
        if (F.G == 256) { const int idx = blockIdx.x >> 2; qt = (ui < 256) ? idx : 127 - idx; }
        else { qt = ui >> 2; if ((ui & 3) != bg) continue; }
        const int b = bg >> 1, g = bg & 1, t0w = 64 * qt + 8 * wave, rowb = b * T;
        const int habs = g * 6 + (colv ? hd : 0);
        const LAS float* b12c = b12 + habs; const BiasCtx BC{TB + (colv ? hd : 0), b12c[29 * 16] - b12c[30 * 16], b12c[30 * 16] - b12c[31 * 16], b12c[31 * 16]};

        bf16x8 qf[4][2];
#pragma unroll
        for (int p = 0; p < 4; ++p) { const bf16* qp = Q0 + (size_t)(rowb + t0w + 2 * p + qsel) * 768 + habs * 64 + 8 * kq;
#pragma unroll
            for (int ks = 0; ks < 2; ++ks) { bf16x8 v = ldg16(qp + 32 * ks); if (!colv) v = (bf16x8){0, 0, 0, 0, 0, 0, 0, 0}; qf[p][ks] = v; } }
        float m[4], l[4]; f32x4 O[4][4];
        if (PROBE_REP == 6 || PROBE_REP == 7) {
            const bf16* ksb_ = KV0 + (size_t)rowb * 512 + 256 + g * 64; const bf16* vst_ = VT + ((size_t)(rowb >> 6) * 256 + g * 64) * 64;
#pragma unroll
            for (int p = 0; p < 4; ++p) { m[p] = -1e30f; l[p] = 0.f;
#pragma unroll
                for (int dt = 0; dt < 4; ++dt) O[p][dt] = (f32x4){0.f, 0.f, 0.f, 0.f}; }
            __syncthreads();
            nsa_sweep<MD_BLK, (PROBE_REP == 6 ? 2 : 1)>(STG, ksb_, vst_, 0, qt, qt, WMw, wave, lane, r, kq, qsel, t0w, qf, BC, m, l, O);
            float* dump = (float*)(ws + WS_OCS) + ((size_t)blockIdx.x * 512 + tid_) * 4;
#pragma unroll
            for (int p = 0; p < 4; ++p) dump[p] = l[p] + O[p][0][0] + O[p][1][1] + O[p][2][2] + O[p][3][3];
            __syncthreads(); }
        for (int i = lane; i < 1024; i += 64) PSw[i] = 0.f;
        const int ncmax = (t0w + 7 >= 31) ? ((t0w + 7 - 31) / 16 + 1) : 0;
        const bf16* kcb = KCB + (size_t)(bg * 512) * 64; const bf16* vct = VCT + (size_t)(bg * 64) * 512;
#pragma unroll
        for (int p = 0; p < 4; ++p) { m[p] = -1e30f; l[p] = 0.f; }
        if (ncmax > 0) {
            int r_ = r, kq_ = kq; asm volatile("" : "+v"(r_), "+v"(kq_));
            for (int key0 = 0; key0 < ncmax; key0 += 32) {
                asm volatile("" : "+v"(r_), "+v"(kq_));
                KF kA; load_k(kA, kcb, 64, key0, r_, kq_);
                const int dmin_ = t0w - 31 - 16 * (key0 + 31), ccls = dmin_ >= 1513 ? 0 : (dmin_ >= 825 ? 1 : ((dmin_ >= 0 && dmin_ + 503 <= 1023) ? 2 : 3));
#pragma unroll
                for (int p = 0; p < 4; ++p) { f32x4 sa, sb; qk(sa, sb, kA, qf[p]); const int tcol = t0w + 2 * p + qsel;
                    cmp_bias(sa, sb, key0 + 8 * kq_, tcol, ccls, BC);
                    const float mn = fmaxf(m[p], lmax8(sa, sb)); float sum = 0.f;
#pragma unroll
                    for (int i = 0; i < 4; ++i) sum += __builtin_amdgcn_exp2f(sa[i] - mn) + __builtin_amdgcn_exp2f(sb[i] - mn);
                    l[p] = l[p] * __builtin_amdgcn_exp2f(m[p] - mn) + sum; m[p] = mn; __builtin_amdgcn_sched_barrier(0); }
            }
        }
        float invl[4];
#pragma unroll
        for (int p = 0; p < 4; ++p) { float mc = m[p]; mc = fmaxf(mc, __shfl_xor(mc, 16)); mc = fmaxf(mc, __shfl_xor(mc, 32));
            const float lt = kqsum(l[p] * __builtin_amdgcn_exp2f(m[p] - mc)); m[p] = mc; invl[p] = lt > 0.f ? 1.f / lt : 0.f; }
#pragma unroll
        for (int p = 0; p < 4; ++p)
#pragma unroll
            for (int dt = 0; dt < 4; ++dt) O[p][dt] = (f32x4){0.f, 0.f, 0.f, 0.f};
        float carry[4] = {0.f, 0.f, 0.f, 0.f};
        if (ncmax > 0) {
            int r_ = r, kq_ = kq; asm volatile("" : "+v"(r_), "+v"(kq_));
            for (int key0 = 0; key0 < ncmax; key0 += 32) {
                asm volatile("" : "+v"(r_), "+v"(kq_));
                KV1 A; load_kv(A, kcb, 64, vct, 512, key0, r_, kq_);
                const int dmin_ = t0w - 31 - 16 * (key0 + 31), ccls = dmin_ >= 1513 ? 0 : (dmin_ >= 825 ? 1 : ((dmin_ >= 0 && dmin_ + 503 <= 1023) ? 2 : 3));
#pragma unroll
                for (int p = 0; p < 4; ++p) { f32x4 sa, sb; qk(sa, sb, A.k, qf[p]); const int tcol = t0w + 2 * p + qsel;
                    cmp_bias(sa, sb, key0 + 8 * kq_, tcol, ccls, BC);
                    f32x4 pa, pb;
#pragma unroll
                    for (int i = 0; i < 4; ++i) { pa[i] = __builtin_amdgcn_exp2f(sa[i] - m[p]) * invl[p]; pb[i] = __builtin_amdgcn_exp2f(sb[i] - m[p]) * invl[p]; }
                    pv(O[p], A.v, pack8(pa, pb));
                    float wA = (pa[0] + pa[1]) + (pa[2] + pa[3]), wB = pa[3] + ((pb[0] + pb[1]) + (pb[2] + pb[3])), wC = pb[3];
                    if (!colv) { wA = 0.f; wB = 0.f; wC = 0.f; }
                    const float up = __shfl(wC, (lane + 48) & 63);
                    const float prevC = (kq == 0) ? carry[p] : up; carry[p] = up;
                    float a0 = wA + prevC, a1 = wB;
                    a0 = sum8_dpp(a0); a1 = sum8_dpp(a1);
                    if (hd == 0) { LAS float* ps = PSw + (2 * p + qsel) * 128 + (key0 >> 2) + 2 * kq; ps[0] = a0; ps[1] = a1; } __builtin_amdgcn_sched_barrier(0); }
            }
        }
        if (ncmax > 0 && ncmax <= 480) {
            const int jn = ((ncmax + 31) >> 5) * 8;
#pragma unroll
            for (int p = 0; p < 4; ++p) { float a0 = sum8_dpp(carry[p]); if (hd == 0 && kq == 0) PSw[(2 * p + qsel) * 128 + jn] = a0; }
        }
        {
#pragma unroll
            for (int p = 0; p < 4; ++p) { const size_t row = (size_t)(rowb + t0w + 2 * p + qsel);
                const float gz = bf2f(G0[row * 256 + habs * 3 + 0]) + Ip->nsa_gate_b[habs * 3 + 0]; out_add(OUTw, p, n, kq, O[p], 1.f / (1.f + __expf(-gz)), true); }
        }
        for (int i = lane; i < 32; i += 64) WMw[i] = (qt < 16) ? 0xffffffffu : 0u;
        if (qt >= 16) {
            if (lane < 3) { const int j = lane == 0 ? 0 : qt - 2 + lane; atomicOr((unsigned*)&WMw[j >> 2], 0xffu << (8 * (j & 3))); }
            for (int q = 0; q < 8; ++q) {
                int v0 = __float_as_int(PSw[q * 128 + lane] + 0.f), v1 = __float_as_int(PSw[q * 128 + 64 + lane] + 0.f);
                if (lane < 1 || lane > qt - 2) v0 = __float_as_int(-1.f); if (lane + 64 > qt - 2) v1 = __float_as_int(-1.f);
                for (int s = 0; s < 13; ++s) { const int mx = wmax64_i(max(v0, v1));
                    const unsigned long long b0 = __ballot(v0 == mx); int j;
                    if (b0) { j = __builtin_ctzll(b0); if (lane == j) v0 = __float_as_int(-1.f); } else { const unsigned long long b1 = __ballot(v1 == mx); j = __builtin_ctzll(b1); if (lane == j) v1 = __float_as_int(-1.f); j += 64; }
                    if (lane == 0) atomicOr((unsigned*)&WMw[j >> 2], 1u << (8 * (j & 3) + q)); }
            }
        }
        const bf16* ksb = KV0 + (size_t)rowb * 512 + 256 + g * 64; const bf16* vst = VT + ((size_t)(rowb >> 6) * 256 + g * 64) * 64;
        __syncthreads();
#pragma unroll 1
        for (int rep_ = 0; rep_ < (PROBE_REP == 1 ? 2 : 1); ++rep_) {
#pragma unroll
            for (int p = 0; p < 4; ++p) { m[p] = -1e30f; l[p] = 0.f;
#pragma unroll
                for (int dt = 0; dt < 4; ++dt) O[p][dt] = (f32x4){0.f, 0.f, 0.f, 0.f}; }
            nsa_sweep<MD_BLK>(STG, ksb, vst, 0, qt, qt, WMw, wave, lane, r, kq, qsel, t0w, qf, BC, m, l, O);
        }
        { int qs2_ = qsel; asm volatile("" : "+v"(qs2_));
#pragma unroll
        for (int p = 0; p < 4; ++p) { const size_t row = (size_t)(rowb + t0w + 2 * p + qs2_);
            const float gz = bf2f(G0[row * 256 + habs * 3 + 1]) + Ip->nsa_gate_b[habs * 3 + 1]; out_add(OUTw, p, n, kq, O[p], (1.f / (1.f + __expf(-gz))) / kqsum(l[p]), false); } }
        const bf16* kwb = KV0 + (size_t)rowb * 512 + 384 + g * 64; const bf16* vwt = VT + ((size_t)(rowb >> 6) * 256 + 128 + g * 64) * 64;
#pragma unroll
        for (int p = 0; p < 4; ++p) { m[p] = -1e30f; l[p] = 0.f;
#pragma unroll
            for (int dt = 0; dt < 4; ++dt) O[p][dt] = (f32x4){0.f, 0.f, 0.f, 0.f}; }
        __syncthreads();
        nsa_sweep<MD_WIN>(STG, kwb, vwt, (qt >= 8) ? qt - 8 : 0, qt, qt, nullptr, wave, lane, r, kq, qsel, t0w, qf, BC, m, l, O);
        if (PROBE_REP == 4) {
#pragma unroll
            for (int p = 0; p < 4; ++p) { m[p] = -1e30f; l[p] = 0.f;
#pragma unroll
                for (int dt = 0; dt < 4; ++dt) O[p][dt] = (f32x4){0.f, 0.f, 0.f, 0.f}; }
            nsa_sweep<MD_WIN>(STG, kwb, vwt, (qt >= 8) ? qt - 8 : 0, qt, qt, nullptr, wave, lane, r, kq, qsel, t0w, qf, BC, m, l, O); }
        { int qs3_ = qsel; asm volatile("" : "+v"(qs3_));
#pragma unroll
        for (int p = 0; p < 4; ++p) { const size_t row = (size_t)(rowb + t0w + 2 * p + qs3_);
            const float gz = bf2f(G0[row * 256 + habs * 3 + 2]) + Ip->nsa_gate_b[habs * 3 + 2]; out_add(OUTw, p, n, kq, O[p], (1.f / (1.f + __expf(-gz))) / kqsum(l[p]), false); } }
        int ln_ = lane; asm volatile("" : "+v"(ln_));
#pragma unroll 1
        for (int i = 0; i < 6; ++i) { const int e = i * 64 + ln_, q = e / 48, c8 = e % 48;
            *(v4u*)(CAT + (size_t)(rowb + t0w + q) * 1024 + g * 384 + 8 * c8) = ((const LAS v4u*)OUTw)[e]; }
#pragma unroll 1
        for (int h2 = 0; h2 < 2; ++h2) { const int hm = 2 * g + h2;
            int ln2_ = lane; asm volatile("" : "+v"(ln2_)); const int nn = ln2_ & 15, kqq = ln2_ >> 4;
#pragma unroll
            for (int p = 0; p < 4; ++p) { qf[p][0] = (bf16x8){0, 0, 0, 0, 0, 0, 0, 0}; qf[p][1] = qf[p][0]; m[p] = -1e30f; l[p] = 0.f;
#pragma unroll
                for (int dt = 0; dt < 4; ++dt) O[p][dt] = (f32x4){0.f, 0.f, 0.f, 0.f}; }
            { const bf16* qp = QM + (size_t)(rowb + t0w + (nn & 7)) * 256 + hm * 64 + 8 * kqq; if (nn < 8) { qf[0][0] = ldg16(qp); qf[0][1] = ldg16(qp + 32); } }
            const BiasCtx BCm{BC.tb, 0.f, 0.f, 0.f};
            nsa_sweep<MD_MEM>(STG, MKB + (size_t)(b * 256) * 256 + hm * 64, MVT + (size_t)(hm * 64) * 512 + b * 256, 0, 3, 0, nullptr, wave, ln2_, nn, kqq, nn >> 3, 0, qf, BCm, m, l, O, 256, 64 * 256, 512, 64);
            const float il = 1.f / kqsum(l[0]);
            if (nn < 8) { bf16* op = CAT + (size_t)(rowb + t0w + nn) * 1024 + 768 + hm * 64 + 4 * kqq;
#pragma unroll
                for (int dt = 0; dt < 4; ++dt) *(uint2*)(op + 16 * dt) = make_uint2(pk2(O[0][dt][0] * il, O[0][dt][1] * il), pk2(O[0][dt][2] * il, O[0][dt][3] * il)); }
        }
    }
}

__device__ __forceinline__ void p10_dsa_norm(Frame& F, const In& I, unsigned char* ws) {
    OPAQUE_TID(); KARGS(); const int gw = F.vcu * NWAVES + (tid_ >> 6), NGW = F.G * NWAVES, lane = tid_ & 63;
    const bf16* PR = (const bf16*)(ws + WS_PROJ1); bf16* CQ = (bf16*)(ws + WS_CQ); bf16* CKV = (bf16*)(ws + WS_CKV); bf16* KIDX = (bf16*)(ws + WS_KIDX); float* WIDX = (float*)(ws + WS_WIDX);
    for (int m = gw; m < M; m += NGW) {
        const bf16* pr = PR + (size_t)m * 768;
        float a[4]; ld4bf(pr + 4 * lane, a);
        float s = wave_sum(a[0] * a[0] + a[1] * a[1] + a[2] * a[2] + a[3] * a[3]); float r = rsqrtf(s * (1.f / 256.f) + EPSF);
        const float4 gq = *(const float4*)(Ip->q_norm + 4 * lane);
        *(uint2*)(CQ + (size_t)m * 256 + 4 * lane) = make_uint2(pk2((a[0] * r) * gq.x, (a[1] * r) * gq.y), pk2((a[2] * r) * gq.z, (a[3] * r) * gq.w));
        const unsigned u = *(const unsigned*)(pr + 256 + 2 * lane); const float c0 = bflo(u), c1 = bfhi(u);
        s = wave_sum(c0 * c0 + c1 * c1); r = rsqrtf(s * (1.f / 128.f) + EPSF);
        *(unsigned*)(CKV + (size_t)m * 128 + 2 * lane) = pk2((c0 * r) * Ip->kv_norm[2 * lane], (c1 * r) * Ip->kv_norm[2 * lane + 1]);
        const float k0 = bf2f(pr[384 + lane]);
        s = wave_sum(k0 * k0); r = rsqrtf(s * (1.f / 64.f) + EPSF);
        { const int tk = m >> 5, key = m & 31, ks = lane >> 4, hf = (lane >> 3) & 1, jj = lane & 7;
          KIDX[((size_t)(tk * 4 + ks) * 64 + hf * 32 + key) * 8 + jj] = (bf16)f2bf((k0 * r) * Ip->kidx_norm[lane]); }
        if (lane < 8) WIDX[(size_t)m * 8 + lane] = bf2f(pr[448 + lane]) * (0.35355339059327373f * 0.125f);
    }
}

#define MFMA32(A, B, C) __builtin_amdgcn_mfma_f32_32x32x16_bf16((A), (B), (C), 0, 0, 0)
typedef float f32x16 __attribute__((ext_vector_type(16)));
constexpr int XL_OFF = RING_BYTES;
constexpr int IDX_HIST = XL_OFF, IDX_SELL = XL_OFF + 16384;
static_assert(IDX_SELL + 4096 <= LDSCTL_OFF, "LDS map (indexer)");
__device__ __forceinline__ float wmin64(float v) {
#pragma unroll
    for (int o = 1; o < 64; o <<= 1) v = fminf(v, __shfl_xor(v, o));
    return v;
}
__device__ __forceinline__ unsigned f16_order_key(float x) {
    const unsigned hb = (unsigned)__builtin_bit_cast(unsigned short, (_Float16)x);
    const unsigned mk = (unsigned)((int)(hb << 16) >> 31) | 0x8000u;
    return (hb ^ mk) & 0xffffu; }
__device__ __forceinline__ void p12_index_mfma(Frame& F, const In& I, unsigned char* ws) {
    OPAQUE_TID(); KARGS(); const int lane = tid_ & 63, wave = __builtin_amdgcn_readfirstlane(tid_ >> 6), key = lane & 31, half = lane >> 5;
    LAS unsigned short* SC = (LAS unsigned short*)(F.lds + RING_OFF);
    const bf16* QI = (const bf16*)(ws + WS_QI); const bf16* KIDX = (const bf16*)(ws + WS_KIDX); const float* WIDX = (const float*)(ws + WS_WIDX);
    unsigned short* SEL = (unsigned short*)(ws + WS_SEL); int* CNT = (int*)(ws + WS_CNT);
    const int NG = M / 8, per = (NG + F.G - 1) / F.G;
    { LAS unsigned* hz = (LAS unsigned*)(F.lds + IDX_HIST); for (int i = tid_; i < 8 * 512; i += NWAVES * 64) hz[i] = 0u; }
    __syncthreads();
    for (int j = 0; j < per; ++j) {
        const int u = j * F.G + ((j & 1) ? (F.G - 1 - (int)blockIdx.x) : (int)blockIdx.x);
        if (u >= NG) break;
        const int gi = (u & 1) * (NG / 2) + (u >> 1);
        const int row0 = 8 * gi, b = row0 / T, t0 = row0 % T, rowb = b * T;
        if (t0 < 256) {
            const int t = t0 + wave; unsigned short* so = SEL + (size_t)(row0 + wave) * 256;
#pragma unroll
            for (int i = 0; i < 4; ++i) { const int s = lane + 64 * i; so[s] = (unsigned short)(s <= t ? s : 0); }
            if (lane == 0) CNT[row0 + wave] = t + 1;
            continue;
        }
        const int nt = (t0 + 7) / 32 + 1;
        {
            const int rho = lane & 31, a = rho >> 2, qA = ((a >> 2) & 1) + 2 * (a & 1), hdA = 4 * ((a >> 1) & 1) + (rho & 3);
            bf16x8 qa[2][4];
#pragma unroll
            for (int t2 = 0; t2 < 2; ++t2)
#pragma unroll
                for (int ks = 0; ks < 4; ++ks) qa[t2][ks] = ldg16(QI + (size_t)(row0 + 4 * t2 + qA) * 512 + hdA * 64 + 16 * ks + 8 * half);
            f32x2_t wp[2][2][4];
#pragma unroll
            for (int t2 = 0; t2 < 2; ++t2)
#pragma unroll
                for (int jq = 0; jq < 2; ++jq) { const float* wq = WIDX + (size_t)(row0 + 4 * t2 + 2 * half + jq) * 8; const float4 x0 = *(const float4*)wq, x1 = *(const float4*)(wq + 4);
                    wp[t2][jq][0] = (f32x2_t){x0.x, x0.y}; wp[t2][jq][1] = (f32x2_t){x0.z, x0.w}; wp[t2][jq][2] = (f32x2_t){x1.x, x1.y}; wp[t2][jq][3] = (f32x2_t){x1.z, x1.w}; }
            const int tqb = t0 + 2 * half;
            const bf16* kpb = KIDX + (size_t)(rowb >> 5) * 2048 + (size_t)lane * 8;
            const int ntw = (nt - wave + NWAVES - 1) / NWAVES;
#define VFMAC_(acc_, x_, y_) asm("v_fmac_f32 %0, %1, %2" : "+v"(acc_) : "v"(x_), "v"(y_))
#define IDX_LOAD(dst, i) do { const int tl2_ = wave + NWAVES * ((i) < ntw ? (i) : (ntw > 0 ? ntw - 1 : 0)); const bf16* kp_ = kpb + (size_t)tl2_ * 2048; \
                _Pragma("unroll") for (int ks = 0; ks < 4; ++ks) dst[ks] = ldg16(kp_ + 512 * ks); } while (0)
#define IDX_EPI(c, t2) do { float a00 = 0.f, a01 = 0.f, a10 = 0.f, a11 = 0.f;     \
                _Pragma("unroll") for (int h = 0; h < 4; ++h) {                                \
                    VFMAC_(a00, __int_as_float(max(__float_as_int(c[2 * h]), 0)), wp[t2][0][h][0]); VFMAC_(a01, __int_as_float(max(__float_as_int(c[2 * h + 1]), 0)), wp[t2][0][h][1]); \
                    VFMAC_(a10, __int_as_float(max(__float_as_int(c[8 + 2 * h]), 0)), wp[t2][1][h][0]); VFMAC_(a11, __int_as_float(max(__float_as_int(c[9 + 2 * h]), 0)), wp[t2][1][h][1]); } \
                const float s0 = (a00 + a01) + 0.f, s1 = (a10 + a11) + 0.f; \
                const bool ok0 = kpos <= tqb + 4 * (t2), ok1 = kpos <= tqb + 4 * (t2) + 1; \
                const unsigned ky0 = f16_order_key(ok0 ? s0 : -INFINITY), ky1 = f16_order_key(ok1 ? s1 : -INFINITY); \
                SC[(4 * (t2) + 2 * half) * 8192 + kpos] = (unsigned short)ky0; SC[(4 * (t2) + 2 * half + 1) * 8192 + kpos] = (unsigned short)ky1; \
                { LAS unsigned* h0_ = (LAS unsigned*)(F.lds + IDX_HIST) + (4 * (t2) + 2 * half) * 512;        \
                  atomicAdd((unsigned*)&h0_[ky0 >> 7], 1u << (16 * ((ky0 >> 6) & 1u))); atomicAdd((unsigned*)&h0_[512 + (ky1 >> 7)], 1u << (16 * ((ky1 >> 6) & 1u))); } } while (0)
#define IDX_COMP(src, i) do { if ((i) < ntw) { const int kpos = 32 * (wave + NWAVES * (i)) + key; \
                f32x16 cA = {0.f, 0.f, 0.f, 0.f, 0.f, 0.f, 0.f, 0.f, 0.f, 0.f, 0.f, 0.f, 0.f, 0.f, 0.f, 0.f}, cB = cA; \
                _Pragma("unroll") for (int ks = 0; ks < 4; ++ks) { cA = MFMA32(qa[0][ks], src[ks], cA); cB = MFMA32(qa[1][ks], src[ks], cB); } \
                IDX_EPI(cA, 0); IDX_EPI(cB, 1); } } while (0)
            if (ntw > 0) {
                bf16x8 kb0[4], kb1[4], kb2[4], kb3[4];
                IDX_LOAD(kb0, 0); IDX_LOAD(kb1, 1); IDX_LOAD(kb2, 2);
                for (int i = 0; i < ntw; i += 4) {
                    IDX_LOAD(kb3, i + 3); IDX_COMP(kb0, i);
                    IDX_LOAD(kb0, i + 4); IDX_COMP(kb1, i + 1);
                    IDX_LOAD(kb1, i + 5); IDX_COMP(kb2, i + 2);
                    IDX_LOAD(kb2, i + 6); IDX_COMP(kb3, i + 3);
                }
            }
#undef IDX_LOAD
#undef IDX_EPI
#undef IDX_COMP
#undef VFMAC_
        }
        __syncthreads();
        {
            const int q = wave, t = t0 + q, nch = (t + 512) >> 9; LAS unsigned short* sc = SC + q * 8192;
            LAS unsigned* hist = (LAS unsigned*)(F.lds + IDX_HIST) + wave * 512;
            LAS unsigned short* sl = (LAS unsigned short*)(F.lds + IDX_SELL) + q * 256;
            for (int i = 32 * nt + lane; i < 512 * nch; i += 64) sc[i] = (unsigned short)0;
            int b1, r1, c1;
            { unsigned cw[8]; unsigned S = 0u;
#pragma unroll
              for (int i = 0; i < 8; ++i) { cw[i] = hist[8 * lane + i]; S += (cw[i] & 0xffffu) + (cw[i] >> 16); }
              const unsigned px = wave_iscan_u32(S);
              const unsigned above = (unsigned)__builtin_amdgcn_readlane((int)px, 63) - px;
              const bool found = (above < 256u) && (256u <= above + S);
              const int fl = __builtin_ctzll(__ballot(found));
              int bs = 0; unsigned acc = above, cbv = 0u;
              { bool done = false;
#pragma unroll
                for (int i = 15; i >= 0; --i) { const unsigned cnt_ = (i & 1) ? (cw[i >> 1] >> 16) : (cw[i >> 1] & 0xffffu);
                    if (!done) { if (acc + cnt_ >= 256u) { bs = 16 * lane + i; cbv = cnt_; done = true; } else acc += cnt_; } } }
              b1 = __builtin_amdgcn_readlane(bs, fl); r1 = 256 - __builtin_amdgcn_readlane((int)acc, fl); c1 = __builtin_amdgcn_readlane((int)cbv, fl); }
            if (c1 <= 448) {
            LAS unsigned* clist = hist + 64;
            hist[lane] = 0u;
            const unsigned thi = ((unsigned)b1 + 1u) << 6;
            int bsel = 0, bc = 0;
            for (int c = 0; c < nch; ++c) { const int i8 = 512 * c + 8 * lane; const v4u k4 = *(const LAS v4u*)(sc + i8);
                unsigned cm = 0u;
#pragma unroll
                for (int e = 0; e < 8; ++e) { const unsigned kk = (e & 1) ? (k4[e >> 1] >> 16) : (k4[e >> 1] & 0xffffu);
                    const bool sel = kk >= thi; cm |= ((int)(kk >> 6) == b1) ? (1u << e) : 0u;
                    const unsigned long long ms = __ballot(sel);
                    if (ms) { if (sel) sl[bsel + (int)__builtin_amdgcn_mbcnt_hi((unsigned)(ms >> 32), __builtin_amdgcn_mbcnt_lo((unsigned)ms, 0u))] = (unsigned short)(i8 + e); bsel += __builtin_popcountll(ms); } }
                if (__any(cm != 0u)) {
                    const unsigned ce = (unsigned)__builtin_popcount(cm); const unsigned pe = wave_iscan_u32(ce);
                    int pos = bc + (int)(pe - ce);
#pragma unroll
                    for (int e = 0; e < 8; ++e) if (cm & (1u << e)) { const unsigned kk = (e & 1) ? (k4[e >> 1] >> 16) : (k4[e >> 1] & 0xffffu);
                        clist[pos] = (kk << 16) | (unsigned)(i8 + e); atomicAdd((unsigned*)&hist[kk & 63u], 1u); ++pos; }
                    bc += __builtin_amdgcn_readlane((int)pe, 63); } }
            unsigned tkey; int r2;
            { const unsigned S = hist[lane]; const unsigned px = wave_iscan_u32(S); const unsigned above = (unsigned)__builtin_amdgcn_readlane((int)px, 63) - px;
              const bool found = (above < (unsigned)r1) && ((unsigned)r1 <= above + S);
              const int fl = __builtin_ctzll(__ballot(found));
              tkey = ((unsigned)b1 << 6) | (unsigned)fl; r2 = r1 - __builtin_amdgcn_readlane((int)above, fl); }
            { const int nabove = 256 - r2; int beq = 0;
              for (int i0 = 0; i0 < bc; i0 += 64) { const int i = i0 + lane; const unsigned en = (i < bc) ? clist[i] : 0u; const unsigned kk = en >> 16;
                  const bool gt = (i < bc) && kk > tkey, eqk = (i < bc) && kk == tkey;
                  const unsigned long long mg = __ballot(gt), me = __ballot(eqk);
                  if (gt) sl[bsel + (int)__builtin_amdgcn_mbcnt_hi((unsigned)(mg >> 32), __builtin_amdgcn_mbcnt_lo((unsigned)mg, 0u))] = (unsigned short)(en & 0xffffu);
                  if (eqk) { const int pos = beq + (int)__builtin_amdgcn_mbcnt_hi((unsigned)(me >> 32), __builtin_amdgcn_mbcnt_lo((unsigned)me, 0u)); if (pos < r2) sl[nabove + pos] = (unsigned short)(en & 0xffffu); }
                  bsel += __builtin_popcountll(mg); beq += __builtin_popcountll(me); } }
            } else {
            hist[lane] = 0u;
            for (int c = 0; c < nch; ++c) { const v4u k4 = *(const LAS v4u*)(sc + 512 * c + 8 * lane);
#pragma unroll
                for (int e = 0; e < 8; ++e) { const unsigned kk = (e & 1) ? (k4[e >> 1] >> 16) : (k4[e >> 1] & 0xffffu);
                    if ((int)(kk >> 6) == b1) atomicAdd((unsigned*)&hist[kk & 63u], 1u); } }
            unsigned tkey; int r2;
            { const unsigned S = hist[lane]; const unsigned px = wave_iscan_u32(S); const unsigned above = (unsigned)__builtin_amdgcn_readlane((int)px, 63) - px;
              const bool found = (above < (unsigned)r1) && ((unsigned)r1 <= above + S);
              const int fl = __builtin_ctzll(__ballot(found));
              tkey = ((unsigned)b1 << 6) | (unsigned)fl; r2 = r1 - __builtin_amdgcn_readlane((int)above, fl); }
            const int nabove = 256 - r2; int bsel = 0, beq = 0;
            for (int c = 0; c < nch; ++c) { const int i8 = 512 * c + 8 * lane; const v4u k4 = *(const LAS v4u*)(sc + i8);
                unsigned em = 0u;
#pragma unroll
                for (int e = 0; e < 8; ++e) { const unsigned kk = (e & 1) ? (k4[e >> 1] >> 16) : (k4[e >> 1] & 0xffffu);
                    const bool sel = kk > tkey; em |= (kk == tkey) ? (1u << e) : 0u;
                    const unsigned long long ms = __ballot(sel);
                    if (ms) { if (sel) sl[bsel + (int)__builtin_amdgcn_mbcnt_hi((unsigned)(ms >> 32), __builtin_amdgcn_mbcnt_lo((unsigned)ms, 0u))] = (unsigned short)(i8 + e); bsel += __builtin_popcountll(ms); } }
                if (__any(em != 0u)) {
                    const unsigned ce = (unsigned)__builtin_popcount(em); const unsigned pe = wave_iscan_u32(ce);
                    int pos = beq + (int)(pe - ce);
#pragma unroll
                    for (int e = 0; e < 8; ++e) if (em & (1u << e)) { if (pos < r2) sl[nabove + pos] = (unsigned short)(i8 + e); ++pos; }
                    beq += __builtin_amdgcn_readlane((int)pe, 63); } }
            }
            *(v2u*)(SEL + (size_t)(row0 + q) * 256 + 4 * lane) = *(const LAS v2u*)(sl + 4 * lane);
#pragma unroll
            for (int i = 0; i < 8; ++i) hist[lane + 64 * i] = 0u;
            if (lane == 0) CNT[row0 + q] = 256;
        }
        __syncthreads();
    }
}

__device__ __forceinline__ unsigned offb(unsigned row, unsigned ch) { return 256u * row + 16u * (ch ^ (((row & 3u) << 2) | ((row >> 2) & 3u))); }
typedef short v4i16_t __attribute__((ext_vector_type(4)));
__device__ __forceinline__ v4i16_t trrd(const LAS unsigned char* p) { return __builtin_amdgcn_ds_read_tr16_b64_v4i16((LAS v4i16_t*)p); }
__device__ __forceinline__ void p13_dsa_mfma(Frame& F, const In& I, unsigned char* ws) {
    OPAQUE_TID(); KARGS(); const int lane = tid_ & 63, wave = __builtin_amdgcn_readfirstlane(tid_ >> 6), n = lane & 15, kq = lane >> 4;
    LAS unsigned char* bkt = F.lds + TAB_BKT; LAS float* b12 = (LAS float*)(F.lds + P13_B12);
    for (int i = tid_; i < 1536; i += NWAVES * 64) bkt[i] = (unsigned char)rel_bucket(i);
    for (int i = tid_; i < 528; i += NWAVES * 64) b12[i] = (i >= 512) ? -INFINITY : (((i & 15) < 12) ? Ip->rel_bias[(i >> 4) * 12 + (i & 15)] * LOG2E : 0.f);
    __syncthreads();
    LAS unsigned char* imgb = F.lds + RING_OFF + wave * 18432; LAS int* sidx = (LAS int*)(imgb + 16384);
    const bf16* QA = (const bf16*)(ws + WS_QA); const bf16* CKV = (const bf16*)(ws + WS_CKV); const bf16* PR = (const bf16*)(ws + WS_PROJ1);
    const unsigned short* SEL = (const unsigned short*)(ws + WS_SEL); const int* CNT = (const int*)(ws + WS_CNT);
    const bf16* MKB = (const bf16*)(ws + WS_MKB) + (size_t)512 * 256; const bf16* MVT = (const bf16*)(ws + WS_MVT) + (size_t)256 * 512;
    bf16* CAT1 = (bf16*)(ws + WS_CAT1);
    const int gw = blockIdx.x * NWAVES + wave, NGW = F.G * NWAVES;
    const LAS float* b12c = b12 + (n < 12 ? n : 0);
#define DSA_GATHER(sl_, rowb_, c0_, buf_) do { const unsigned char* ckvb_ = (const unsigned char*)(CKV + (size_t)(rowb_) * 128); int kx_[8]; \
            _Pragma("unroll") for (int i = 0; i < 8; ++i) kx_[i] = (sl_)[(c0_) + 4 * i + g4_] & 0xffff; \
            _Pragma("unroll") for (int i = 0; i < 8; ++i) __builtin_amdgcn_global_load_lds((const unsigned*)(ckvb_ + ((unsigned)kx_[i] * 256u + goff_[i & 3])), (LAS unsigned*)(imgb + (buf_) * 8192 + i * 1024), 16, 0, 0); } while (0)
#define DSA_LIST(sl_, sel_, t_, cnt_) do { const int idx0_ = __builtin_amdgcn_readfirstlane((sel_)[0]); \
            _Pragma("unroll") for (int i = 0; i < 4; ++i) { const int e = lane + 64 * i, idx = (sel_)[i]; const int d = (t_) - idx, dc = d > 1535 ? 1535 : (d < 0 ? 0 : d); \
                (sl_)[e] = (e < (cnt_)) ? (idx | ((int)bkt[dc] << 22)) : (idx0_ | (2048 << 16)); } } while (0)
    int dreps_ = (PROBE_REP == 9) ? 2 : 1; asm volatile("" : "+s"(dreps_));
    for (int dr_ = 0; dr_ < dreps_; ++dr_) {
    asm volatile("s_waitcnt vmcnt(0) lgkmcnt(0)" ::: "memory");
    int row = gw;
    if (row < M) {
        int ln0_ = lane; asm volatile("" : "+v"(ln0_));
        const int g4_ = ln0_ >> 4; unsigned goff_[4];
#pragma unroll
        for (int k = 0; k < 4; ++k) goff_[k] = 16u * ((unsigned)(ln0_ & 15) ^ (((unsigned)g4_ << 2) | (unsigned)k));
        int cnt = __builtin_amdgcn_readfirstlane(CNT[row]); int sel0[4];
#pragma unroll
        for (int i = 0; i < 4; ++i) sel0[i] = (int)SEL[(size_t)row * 256 + lane + 64 * i];
        DSA_LIST(sidx, sel0, row % T, cnt);
        bf16x8 qf[4];
#pragma unroll
        for (int ks = 0; ks < 4; ++ks) { bf16x8 v = ldg16(QA + (size_t)row * 1536 + (n < 12 ? n : 0) * 128 + 32 * ks + 8 * kq); if (n >= 12) v = (bf16x8){0, 0, 0, 0, 0, 0, 0, 0}; qf[ks] = v; }
        asm volatile("s_waitcnt lgkmcnt(0)" ::: "memory");
        DSA_GATHER(sidx, (row / T) * T, 0, 0);
        int lb = 0, ib = 0;
        for (; row < M; row += NGW) {
            const int t = row % T, rown = (row + NGW < M) ? row + NGW : row; const bool hasn = row + NGW < M;
            int ln_ = lane; asm volatile("" : "+v"(ln_));
            int seln[4] = {0, 0, 0, 0}; int cntn_v = 0; bf16x8 qfn[4];
#pragma unroll
            for (int ks = 0; ks < 4; ++ks) qfn[ks] = (bf16x8){0, 0, 0, 0, 0, 0, 0, 0};
#define DSA_NEXT_LOADS() do { cntn_v = CNT[rown]; \
                _Pragma("unroll") for (int i = 0; i < 4; ++i) seln[i] = (int)SEL[(size_t)rown * 256 + lane + 64 * i]; \
                _Pragma("unroll") for (int ks = 0; ks < 4; ++ks) { bf16x8 v = ldg16(QA + (size_t)rown * 1536 + (n < 12 ? n : 0) * 128 + 32 * ks + 8 * kq); if (n >= 12) v = (bf16x8){0, 0, 0, 0, 0, 0, 0, 0}; qfn[ks] = v; } } while (0)
            const LAS int* sl = sidx + lb * 256; LAS int* sln = sidx + (lb ^ 1) * 256;
            float m = -1e30f, l = 0.f; f32x4 O[8];
#pragma unroll
            for (int rt = 0; rt < 8; ++rt) O[rt] = (f32x4){0.f, 0.f, 0.f, 0.f};
            for (int c0 = 0; c0 < cnt; c0 += 32) {
                LAS unsigned char* img = imgb + ib * 8192;
                if (c0 + 32 < cnt) { DSA_GATHER(sl, (row / T) * T, c0 + 32, ib ^ 1);
                    { const int e2 = (c0 + 64 < 256 ? c0 + 64 : 224) + (ln_ >> 1); const int k2 = sl[e2] & 0xffff;
                      __builtin_amdgcn_global_load_lds((const unsigned*)((const unsigned char*)(CKV + (size_t)((row / T) * T) * 128) + ((unsigned)k2 * 256u + 128u * (unsigned)(ln_ & 1))), (LAS unsigned*)(F.lds + P13_JUNK + wave * 256), 4, 0, 0); }
                    if (c0 == 0) { DSA_NEXT_LOADS(); }
                    if (c0 < 64) asm volatile("s_waitcnt vmcnt(18)" ::: "memory"); else asm volatile("s_waitcnt vmcnt(9)" ::: "memory"); }
                else if (hasn) {
                    if (c0 == 0) { DSA_NEXT_LOADS(); }
                    const int cntn = __builtin_amdgcn_readfirstlane(cntn_v);
                    DSA_LIST(sln, seln, rown % T, cntn);
                    asm volatile("s_waitcnt lgkmcnt(0)" ::: "memory");
                    DSA_GATHER(sln, (rown / T) * T, 0, ib ^ 1); asm volatile("s_waitcnt vmcnt(8)" ::: "memory"); }
                else asm volatile("s_waitcnt vmcnt(0)" ::: "memory");
                const bool has = m > -1e29f; const float mref = has ? m : 0.f; const float cinv = -mref;
                f32x4 sa = {cinv, cinv, cinv, cinv}, sb = sa;
                { const unsigned ra = 8u * ((unsigned)(ln_ & 15) >> 2) + ((unsigned)ln_ & 3u), kq_ = (unsigned)ln_ >> 4;
#pragma unroll
                  for (int s = 0; s < 4; ++s) { const bf16x8 ka = *(const LAS bf16x8*)(img + offb(ra, 4 * s + kq_)); const bf16x8 kb = *(const LAS bf16x8*)(img + offb(ra + 4, 4 * s + kq_));
                      sa = MFMA16(ka, qf[s], sa); sb = MFMA16(kb, qf[s], sb); } }
#pragma unroll
                for (int i = 0; i < 4; ++i) { const int ea = c0 + 8 * kq + i;
                    sa[i] += *(const LAS float*)((const LAS unsigned char*)b12c + ((unsigned)sl[ea] >> 16)); sb[i] += *(const LAS float*)((const LAS unsigned char*)b12c + ((unsigned)sl[ea + 4] >> 16)); }
                float fsc = 1.f;
                if (__any((imax3(imax3(__float_as_int(sa[0]), __float_as_int(sa[1]), __float_as_int(sa[2])), imax3(__float_as_int(sa[3]), __float_as_int(sb[0]), __float_as_int(sb[1])), max(__float_as_int(sb[2]), __float_as_int(sb[3]))) > __float_as_int(SM_THR)) || !has)) {
                    float lm = lmax8(sa, sb);
                    lm = fmaxf(lm, __shfl_xor(lm, 16)); lm = fmaxf(lm, __shfl_xor(lm, 32));
                    const bool upd = (lm > -INFINITY) && (!has || lm > 0.f); const float dl = upd ? lm : 0.f;
                    if (upd) m = mref + dl;
                    fsc = has ? __builtin_amdgcn_exp2f(-dl) : 1.f; l *= fsc;
#pragma unroll
                    for (int i = 0; i < 4; ++i) { sa[i] -= dl; sb[i] -= dl; }
#pragma unroll
                    for (int rt = 0; rt < 8; ++rt) O[rt] = O[rt] * fsc;
                }
                f32x4 pa, pb; float sum = 0.f;
#pragma unroll
                for (int i = 0; i < 4; ++i) { pa[i] = __builtin_amdgcn_exp2f(sa[i]); pb[i] = __builtin_amdgcn_exp2f(sb[i]); sum += pa[i] + pb[i]; }
                l += sum;
                const bf16x8 pf = pack8(pa, pb);
                { const unsigned g_ = (unsigned)ln_ >> 4, q_ = ((unsigned)ln_ & 15u) >> 2, p_ = (unsigned)ln_ & 3u;
#pragma unroll
                  for (int rt = 0; rt < 8; ++rt) { const v4i16_t x0 = trrd(img + offb(8 * g_ + q_, 2 * rt + (p_ >> 1)) + 8 * (p_ & 1)), x1 = trrd(img + offb(8 * g_ + 4 + q_, 2 * rt + (p_ >> 1)) + 8 * (p_ & 1));
                      const bf16x8 vf = {x0[0], x0[1], x0[2], x0[3], x1[0], x1[1], x1[2], x1[3]};
                      O[rt] = MFMA16(vf, pf, O[rt]); } }
                ib ^= 1;
            }
            const float il = 1.f / kqsum(l);
            if (n < 12) { bf16* op = CAT1 + (size_t)row * 1792 + n * 128 + 4 * kq;
#pragma unroll
                for (int rt = 0; rt < 8; ++rt) *(uint2*)(op + 16 * rt) = make_uint2(pk2(O[rt][0] * il, O[rt][1] * il), pk2(O[rt][2] * il, O[rt][3] * il)); }
            lb ^= 1; cnt = __builtin_amdgcn_readfirstlane(cntn_v);
#pragma unroll
            for (int ks = 0; ks < 4; ++ks) qf[ks] = qfn[ks];
        }
    }
    }
#undef DSA_GATHER
#undef DSA_LIST
#undef DSA_NEXT_LOADS
    int mreps_ = (PROBE_REP == 8) ? 2 : 1; asm volatile("" : "+s"(mreps_));
    __syncthreads();
    for (int mr_ = 0; mr_ < mreps_; ++mr_)
    for (int u64 = blockIdx.x; u64 < M / 64; u64 += F.G) {
        int tl_ = tid_; asm volatile("" : "+v"(tl_));
        const int ln = tl_ & 63, nn = ln & 15, kqq = ln >> 4, qsl = nn >> 3;
        const int row0 = 64 * u64 + 8 * wave, b = row0 / T;
        const BiasCtx BC0{(const LAS unsigned short*)(F.lds + NSA_TB), 0.f, 0.f, 0.f};
#pragma unroll 1
        for (int hm = 0; hm < 4; ++hm) {
            bf16x8 qf[4][2];
#pragma unroll
            for (int p = 0; p < 4; ++p) { qf[p][0] = (bf16x8){0, 0, 0, 0, 0, 0, 0, 0}; qf[p][1] = qf[p][0]; }
            { const bf16* qp = PR + (size_t)(row0 + (nn & 7)) * 768 + 456 + hm * 64 + 8 * kqq; if (nn < 8) { qf[0][0] = ldg16(qp); qf[0][1] = ldg16(qp + 32); } }
            float m[4], l[4]; f32x4 O[4][4];
#pragma unroll
            for (int p = 0; p < 4; ++p) { m[p] = -1e30f; l[p] = 0.f;
#pragma unroll
                for (int dt = 0; dt < 4; ++dt) O[p][dt] = (f32x4){0.f, 0.f, 0.f, 0.f}; }
            nsa_sweep<MD_MEM>(F.lds + RING_OFF, MKB + (size_t)(b * 256) * 256 + hm * 64, MVT + (size_t)(hm * 64) * 512 + b * 256, 0, 3, 0, nullptr, wave, ln, nn, kqq, qsl, 0, qf, BC0, m, l, O, 256, 64 * 256, 512, 64);
            const float il = 1.f / kqsum(l[0]);
            if (nn < 8) { bf16* op = CAT1 + (size_t)(row0 + nn) * 1792 + 1536 + hm * 64 + 4 * kqq;
#pragma unroll
                for (int dt = 0; dt < 4; ++dt) *(uint2*)(op + 16 * dt) = make_uint2(pk2(O[0][dt][0] * il, O[0][dt][1] * il), pk2(O[0][dt][2] * il, O[0][dt][3] * il)); }
            __syncthreads();
        }
    }
}

struct Args { In in; float* out; unsigned char* ws; int ph_lo, ph_hi; };
__global__ void __launch_bounds__(NWAVES * 64, 2) mk_fwd(Args args) {
    extern __shared__ __attribute__((aligned(16))) unsigned char lds[];
    Frame F;
    F.lds = (LAS unsigned char*)lds; F.MISC = (volatile LAS unsigned*)(F.lds + MISC_OFF);
    F.G = gridDim.x; { const int bx = blockIdx.x; F.vcu = (F.G % 8 == 0) ? (bx % 8) * (F.G / 8) + bx / 8 : bx; }
    unsigned char* ws = args.ws; const In& I = args.in; float* out = args.out; (void)I;
    F.ctl = (gu32*)(ws + WS_CTL);
    for (int u = threadIdx.x; u < (LDS_BYTES - LDSCTL_OFF) / 4; u += NWAVES * 64) ((LAS unsigned*)(F.lds + LDSCTL_OFF))[u] = 0u;
    __syncthreads();
    XcdBarrier bar; bar.bar = (unsigned*)(F.ctl + CW_BAR); bar.x = 0; bar.st = nullptr;
    if (!MK_SPLIT) bar = xcd_barrier_post((unsigned*)(F.ctl + CW_BAR), F.MISC + 8);
    const int lo = args.ph_lo, hi = args.ph_hi;
#ifndef PH_MASK
#define PH_MASK 0xFFFFFFFFu
#endif
#define IN(k) ((((PH_MASK) >> ((k) % 32)) & 1u) && lo <= (k) && (k) < hi)
#define SEAM(k) do { if (IN(k) && IN((k) + 1)) xcd_barrier(bar); } while (0)
#define SEAM2(k, kn) do { if (IN(k) && IN(kn)) xcd_barrier(bar); } while (0)
#ifndef REP_MASK
#define REP_MASK 0u
#endif
#define REPS(k) (1 + (int)(((REP_MASK) >> (k)) & 1u))
    bf16* XN = (bf16*)(ws + WS_XN); bf16* CAT = (bf16*)(ws + WS_CAT); bf16* ACT = (bf16*)(ws + WS_ACT);
    float* SSQ = (float*)(ws + WS_SSQ);

    if (IN(0)) { for (int r_ = 0; r_ < REPS(0); ++r_) { p0_prologue(F, I, ws); if (r_ + 1 < REPS(0)) xcd_barrier(bar); } SEAM(0); }
    {
            if (IN(1)) {
                pg8::Gemm g{XN, (const bf16*)(ws + WS_WIN0), M, 1792, D}; pg8::StaticOrder S; S.init(M, 1792, F.G, (int)blockIdx.x);
                pg8::EpiRoute<0> E{ws, nullptr};
                for (int r_ = 0; r_ < REPS(1); ++r_) { if (r_) xcd_barrier(bar);
                pg8::gemm_phase<pg8::EpiRoute<0>, pg8::StaticOrder, true, true>(F.lds + RING_OFF, g, S, E); }
                pg8::Gemm g2{(const bf16*)(ws + WS_WVT), XN, 256, M, D}; pg8::StaticOrder S2; S2.init(256, M, F.G, (int)((blockIdx.x + 64) % F.G));
                pg8::EpiRoute<3> E2{ws, nullptr};
                pg8::gemm_phase<pg8::EpiRoute<3>, pg8::StaticOrder, true, true>(F.lds + RING_OFF, g2, S2, E2);
                SEAM(1);
            }
            if (IN(2)) { for (int r_ = 0; r_ < REPS(2); ++r_) { p2_mfma(F, I, ws); if (r_ + 1 < REPS(2)) xcd_barrier(bar); } SEAM(2); }
            if (IN(3)) { for (int r_ = 0; r_ < REPS(3); ++r_) { p3_nsa_mfma(F, I, ws); if (r_ + 1 < REPS(3)) xcd_barrier(bar); } SEAM(3); }
    }
    {
        constexpr int L = 0, pb = L ? 14 : 4;
        if (IN(pb)) {
            pg8::Gemm g{L ? (const bf16*)(ws + WS_CAT1) : CAT, L ? (const bf16*)(ws + WS_WO1F) : (const bf16*)(ws + WS_WO), M, D, L ? 1792 : D}; pg8::StaticOrder S; S.init(M, D, F.G, (int)blockIdx.x);
            KARGS(); pg8::EpiResid<L == 0> E{L ? (const void*)XN : (const void*)Ip->x, XN, SSQ + (size_t)(L ? 2 : 0) * M * 16, D, 0};
            pg8::gemm_phase<pg8::EpiResid<L == 0>, pg8::StaticOrder, true, true>(F.lds + RING_OFF, g, S, E);
            SEAM2(pb, pb + 2);
        }
        if (IN(pb + 2)) {
            pg8::Gemm g{XN, (const bf16*)(ws + WS_WGU) + (size_t)L * 2 * DFF * D, M, 2 * DFF, D}; pg8::HalfTailOrder S; S.init(M, 2 * DFF, F.G, (int)blockIdx.x);
            pg8::EpiSwiglu E{ACT, SSQ + (size_t)(L ? 2 : 0) * M * 16, DFF, 0};
            for (int r_ = 0; r_ < REPS(pb + 2); ++r_) { if (r_) xcd_barrier(bar);
            pg8::gemm_phase<pg8::EpiSwiglu, pg8::HalfTailOrder, true, true>(F.lds + RING_OFF, g, S, E); }
            SEAM(pb + 2);
        }
        if (IN(pb + 3)) {
            pg8::Gemm g{ACT, (const bf16*)(ws + WS_WD) + (size_t)L * D * DFF, M, D, DFF}; pg8::StaticOrder S; S.init(M, D, F.G, (int)blockIdx.x);
            pg8::EpiResid<false> E{XN, XN, SSQ + (size_t)(L ? 3 : 1) * M * 16, D, 0};
            pg8::gemm_phase<pg8::EpiResid<false>, pg8::StaticOrder, true, true>(F.lds + RING_OFF, g, S, E);
            SEAM2(pb + 3, L ? 18 : 9);
        }
        }
    {
            if (IN(9)) {
                pg8::Gemm g{XN, (const bf16*)(ws + WS_WIN1), M, 768, D}; pg8::StaticOrder S; S.init(M, 768, F.G, (int)blockIdx.x);
                pg8::EpiRoute<1> E{ws, SSQ + (size_t)1 * M * 16};
                for (int r_ = 0; r_ < REPS(9); ++r_) { if (r_) xcd_barrier(bar);
                pg8::gemm_phase<pg8::EpiRoute<1>, pg8::StaticOrder, true, true>(F.lds + RING_OFF, g, S, E); }
                SEAM(9);
            }
            if (IN(10)) { p10_dsa_norm(F, I, ws); SEAM(10); }
            if (IN(11)) {
                pg8::Gemm g{(const bf16*)(ws + WS_CQ), (const bf16*)(ws + WS_WQ2), M, 2048, 256}; pg8::StaticOrder S; S.init(M, 2048, F.G, (int)blockIdx.x);
                pg8::EpiRoute<2> E{ws, nullptr};
                for (int r_ = 0; r_ < REPS(11); ++r_) { if (r_) xcd_barrier(bar);
                pg8::gemm_phase<pg8::EpiRoute<2>, pg8::StaticOrder, true, true>(F.lds + RING_OFF, g, S, E); }
                SEAM(11);
            }
            if (IN(12)) { for (int r_ = 0; r_ < REPS(12); ++r_) { p12_index_mfma(F, I, ws); if (r_ + 1 < REPS(12)) xcd_barrier(bar); } SEAM(12); }
            if (IN(13)) { for (int r_ = 0; r_ < REPS(13); ++r_) { p13_dsa_mfma(F, I, ws); if (r_ + 1 < REPS(13)) xcd_barrier(bar); } SEAM(13); }
            }
    {
        constexpr int L = 1, pb = L ? 14 : 4;
        if (IN(pb)) {
            pg8::Gemm g{L ? (const bf16*)(ws + WS_CAT1) : CAT, L ? (const bf16*)(ws + WS_WO1F) : (const bf16*)(ws + WS_WO), M, D, L ? 1792 : D}; pg8::StaticOrder S; S.init(M, D, F.G, (int)blockIdx.x);
            KARGS(); pg8::EpiResid<L == 0> E{L ? (const void*)XN : (const void*)Ip->x, XN, SSQ + (size_t)(L ? 2 : 0) * M * 16, D, 0};
            pg8::gemm_phase<pg8::EpiResid<L == 0>, pg8::StaticOrder, true, true>(F.lds + RING_OFF, g, S, E);
            SEAM2(pb, pb + 2);
        }
        if (IN(pb + 2)) {
            pg8::Gemm g{XN, (const bf16*)(ws + WS_WGU) + (size_t)L * 2 * DFF * D, M, 2 * DFF, D}; pg8::HalfTailOrder S; S.init(M, 2 * DFF, F.G, (int)blockIdx.x);
            pg8::EpiSwiglu E{ACT, SSQ + (size_t)(L ? 2 : 0) * M * 16, DFF, 0};
            for (int r_ = 0; r_ < REPS(pb + 2); ++r_) { if (r_) xcd_barrier(bar);
            pg8::gemm_phase<pg8::EpiSwiglu, pg8::HalfTailOrder, true, true>(F.lds + RING_OFF, g, S, E); }
            SEAM(pb + 2);
        }
        if (IN(pb + 3)) {
            pg8::Gemm g{ACT, (const bf16*)(ws + WS_WD) + (size_t)L * D * DFF, M, D, DFF}; pg8::StaticOrder S; S.init(M, D, F.G, (int)blockIdx.x);
            pg8::EpiResid<false> E{XN, XN, SSQ + (size_t)(L ? 3 : 1) * M * 16, D, 0};
            pg8::gemm_phase<pg8::EpiResid<false>, pg8::StaticOrder, true, true>(F.lds + RING_OFF, g, S, E);
            SEAM2(pb + 3, L ? 18 : 9);
        }
        }
    if (IN(18)) {
        OPAQUE_TID(); KARGS(); const int lane_ = tid_ & 63;
        const int gw = F.vcu * NWAVES + (tid_ >> 6), NGW = F.G * NWAVES;
        for (int m = gw; m < M; m += NGW) { const float r = rsqrtf(pg8::ssq_row(SSQ + ((size_t)3 * M + m) * 16) * (1.f / D) + EPSF);
#pragma unroll
            for (int j = 0; j < 2; ++j) { const int c = (j * 64 + lane_) * 8; const pg8::u32x4 rw = *(const GAS pg8::u32x4*)(XN + (size_t)m * D + c);
                const GAS f32x4* gr = (const GAS f32x4*)(Ip->norm_final + c); GAS f32x4* orow = (GAS f32x4*)(out + (size_t)m * D + c);
                f32x4 r0, r1; r0[0] = __uint_as_float(rw.x << 16); r0[1] = __uint_as_float(rw.x & 0xffff0000u); r0[2] = __uint_as_float(rw.y << 16); r0[3] = __uint_as_float(rw.y & 0xffff0000u);
                r1[0] = __uint_as_float(rw.z << 16); r1[1] = __uint_as_float(rw.z & 0xffff0000u); r1[2] = __uint_as_float(rw.w << 16); r1[3] = __uint_as_float(rw.w & 0xffff0000u);
                orow[0] = (r0 * r) * gr[0]; orow[1] = (r1 * r) * gr[1]; } }
    }
#undef IN
#undef SEAM
}

extern "C" void kernel_launch(void* const* d_in, const int* in_sizes, int n_in, void* d_out, int out_size, void* d_ws, size_t ws_size, hipStream_t stream) {
    static int grid = 0;
    if (grid == 0) {
        if (n_in != 32 || out_size != M * D || ws_size < WS_END) { fprintf(stderr, "kernel_launch: unexpected shapes (n_in %d out %d ws %zu)\n", n_in, out_size, ws_size); grid = -1; return; }
        int dev = 0, cus = 0, per_cu = 0;
        if (hipGetDevice(&dev) != hipSuccess || hipDeviceGetAttribute(&cus, hipDeviceAttributeMultiprocessorCount, dev) != hipSuccess) { grid = -1; return; }
        if (hipFuncSetAttribute((const void*)mk_fwd, hipFuncAttributeMaxDynamicSharedMemorySize, LDS_BYTES) != hipSuccess) { grid = -1; return; }
        if (hipOccupancyMaxActiveBlocksPerMultiprocessor(&per_cu, (const void*)mk_fwd, NWAVES * 64, LDS_BYTES) != hipSuccess || per_cu < 1) fprintf(stderr, "kernel_launch: occupancy query reports %d\n", per_cu);
        (void)hipGetLastError();
        grid = cus;
        if (grid > 256) grid = 256;
    }
    if (grid < 0) return;
    if (hipMemsetAsync((char*)d_ws + WS_CTL, 0, CTL_ZERO_BYTES, stream) != hipSuccess) return;
    Args a{};
    const float** ip = (const float**)&a.in;
    for (int i = 0; i < 32; ++i) ip[i] = (const float*)d_in[i];
    a.out = (float*)d_out; a.ws = (unsigned char*)d_ws;
#if MK_SPLIT
    for (int k = 0; k < N_PHASES; ++k) { a.ph_lo = k; a.ph_hi = k + 1; hipLaunchKernelGGL(mk_fwd, dim3(grid), dim3(NWAVES * 64), LDS_BYTES, stream, a); }
#else
    a.ph_lo = 0; a.ph_hi = N_PHASES; hipLaunchKernelGGL(mk_fwd, dim3(grid), dim3(NWAVES * 64), LDS_BYTES, stream, a);
#endif
}
```
